# Optimizing an MI355X kernel written in HIP

```python
import jax, jax.numpy as jnp
from jax import lax
import numpy as np

D_MODEL = 1024
BATCH = 32
SEQ = 2048
DEPTH = 2

HEAD_DIM = 64
BLOCK = 128
EPS = 1e-6
FOX_HEADS = 4
MLA_HEADS = 4
MLA_Q_RANK = 256
MLA_KV_RANK = 128
MLA_NOPE_DIM = 64
MLA_ROPE_DIM = 32
MLA_V_DIM = 64
ROPE_THETA = 10000.0
SWA_HEADS = 4
SWA_KV_HEADS = 2
WINDOW = 128
DSA_HEADS = 4
DSA_IDX_HEADS = 8
DSA_IDX_DIM = 32
DSA_TOPK_MAX = 256
N_ALIBI = SWA_HEADS + DSA_HEADS
N_EXPERTS = 16
N_GROUPS = 4
EXPERTS_PER_GROUP = N_EXPERTS // N_GROUPS
TOP_K_EXPERTS = 2
D_EXPERT = 256

IN_SIZES = (
    FOX_HEADS * HEAD_DIM, FOX_HEADS * HEAD_DIM, FOX_HEADS * HEAD_DIM, FOX_HEADS,
    MLA_Q_RANK, MLA_KV_RANK, MLA_ROPE_DIM,
    SWA_HEADS * HEAD_DIM, SWA_KV_HEADS * HEAD_DIM, SWA_KV_HEADS * HEAD_DIM,
    DSA_HEADS * HEAD_DIM, HEAD_DIM, HEAD_DIM,
    DSA_IDX_HEADS * DSA_IDX_DIM, DSA_IDX_DIM, DSA_IDX_HEADS,
)
N_IN = sum(IN_SIZES)
D_MIX = FOX_HEADS * HEAD_DIM + MLA_HEADS * MLA_V_DIM + SWA_HEADS * HEAD_DIM + DSA_HEADS * HEAD_DIM

kernel_name = 'hybrid_fox_mla_swa_dsa_moe_block'


def rmsnorm(x, g):
    xf = x.astype(jnp.float32)
    y = xf * lax.rsqrt(jnp.mean(xf * xf, axis=-1, keepdims=True) + EPS)
    return (y * g.astype(jnp.float32)).astype(x.dtype)


def rope(x, pos):
    half = x.shape[-1] // 2
    inv = ROPE_THETA ** (-jnp.arange(half, dtype=jnp.float32) / half)
    ang = pos.astype(jnp.float32)[:, None] * inv[None, :]
    cos = jnp.cos(ang)[None, :, None, :]
    sin = jnp.sin(ang)[None, :, None, :]
    x1 = x[..., :half].astype(jnp.float32)
    x2 = x[..., half:].astype(jnp.float32)
    return jnp.concatenate([x1 * cos - x2 * sin, x2 * cos + x1 * sin], axis=-1).astype(x.dtype)


def causal_block_attention(q, k, v, log_forget=None):
    B, S, H, Dq = q.shape
    nb = S // BLOCK
    scale = Dq ** -0.5
    key_pos = jnp.arange(S)
    cum = None if log_forget is None else jnp.cumsum(log_forget.astype(jnp.float32), axis=1).swapaxes(1, 2)

    def one_block(i):
        start = i * BLOCK
        q_pos = start + jnp.arange(BLOCK)
        qi = lax.dynamic_slice_in_dim(q, start, BLOCK, axis=1)
        s = jnp.einsum('bqhd,bkhd->bhqk', qi, k, preferred_element_type=jnp.float32) * scale
        if cum is not None:
            ci = lax.dynamic_slice_in_dim(cum, start, BLOCK, axis=2)
            s = s + ci[..., :, None] - cum[..., None, :]
        causal = key_pos[None, :] <= q_pos[:, None]
        s = jnp.where(causal[None, None], s, -jnp.inf)
        p = jax.nn.softmax(s, axis=-1)
        return jnp.einsum('bhqk,bkhd->bqhd', p.astype(v.dtype), v)

    out = lax.map(one_block, jnp.arange(nb))
    return out.swapaxes(0, 1).reshape(B, S, H * v.shape[-1])


def sliding_window_sink_attention(q, k, v, sinks, slopes):
    B, S, Hq, Dh = q.shape
    Hkv = k.shape[2]
    G = Hq // Hkv
    nb = S // BLOCK
    scale = Dh ** -0.5
    qb = q.reshape(B, nb, BLOCK, Hkv, G, Dh)
    kb = k.reshape(B, nb, BLOCK, Hkv, Dh)
    vb = v.reshape(B, nb, BLOCK, Hkv, Dh)
    pad = ((0, 0), (1, 0), (0, 0), (0, 0), (0, 0))
    k_band = jnp.concatenate([jnp.pad(kb, pad)[:, :-1], kb], axis=2)
    v_band = jnp.concatenate([jnp.pad(vb, pad)[:, :-1], vb], axis=2)
    s = jnp.einsum('bnqhgd,bnkhd->bnhgqk', qb, k_band, preferred_element_type=jnp.float32) * scale
    qi = jnp.arange(BLOCK)[:, None]
    kj = jnp.arange(2 * BLOCK)[None, :]
    dist = qi - kj + BLOCK
    key_pos = jnp.arange(nb)[:, None, None] * BLOCK - BLOCK + kj[None]
    valid = (dist >= 0)[None] & (dist < WINDOW)[None] & (key_pos >= 0)
    alibi = slopes.astype(jnp.float32).reshape(Hkv, G, 1, 1) * dist.astype(jnp.float32)
    s = s - alibi
    s = jnp.where(valid[None, :, None, None], s, -jnp.inf)
    sink_col = jnp.broadcast_to(sinks.astype(jnp.float32).reshape(1, 1, Hkv, G, 1, 1), s.shape[:-1] + (1,))
    p = jax.nn.softmax(jnp.concatenate([s, sink_col], axis=-1), axis=-1)[..., :-1]
    out = jnp.einsum('bnhgqk,bnkhd->bnqhgd', p.astype(v.dtype), v_band)
    return out.reshape(B, S, Hq * Dh)


def dsa_attention(q, k, v, q_idx, k_idx, w_idx, slopes):
    B, S, H, Dh = q.shape
    top_k = min(DSA_TOPK_MAX, S // 4)
    nb = S // BLOCK
    scale = Dh ** -0.5
    key_pos = jnp.arange(S)
    w_idx = w_idx.astype(jnp.float32) * (DSA_IDX_HEADS ** -0.5) * (DSA_IDX_DIM ** -0.5)
    gather = jax.vmap(lambda table, idx: table[idx])
    slopes = slopes.astype(jnp.float32)

    def one_block(i):
        start = i * BLOCK
        q_pos = start + jnp.arange(BLOCK)
        qi = lax.dynamic_slice_in_dim(q, start, BLOCK, axis=1)
        qii = lax.dynamic_slice_in_dim(q_idx, start, BLOCK, axis=1)
        wi = lax.dynamic_slice_in_dim(w_idx, start, BLOCK, axis=1)
        idx_logits = jnp.einsum('bqhe,bke->bqhk', qii, k_idx, preferred_element_type=jnp.float32)
        score = jnp.einsum('bqh,bqhk->bqk', wi, jax.nn.relu(idx_logits))
        causal = key_pos[None, :] <= q_pos[:, None]
        score = jnp.where(causal[None], score, -jnp.inf)
        _, sel = lax.top_k(score, top_k)
        k_sel = gather(k, sel)
        v_sel = gather(v, sel)
        logits = jnp.einsum('bqhd,bqkd->bhqk', qi, k_sel, preferred_element_type=jnp.float32) * scale
        dist = (q_pos[None, :, None] - sel).astype(jnp.float32)
        logits = logits - slopes[None, :, None, None] * dist[:, None]
        ok = (sel <= q_pos[None, :, None])[:, None]
        logits = jnp.where(ok, logits, -jnp.inf)
        p = jax.nn.softmax(logits, axis=-1)
        return jnp.einsum('bhqk,bqkd->bqhd', p.astype(v.dtype), v_sel)

    out = lax.map(one_block, jnp.arange(nb))
    return out.swapaxes(0, 1).reshape(B, S, H * Dh)


def hybrid_mixer(h, w_in, b_forget, g_q_mla, w_q_up, g_kv_mla, w_kv_up, sinks, w_out):
    B, S, _ = h.shape
    pos = jnp.arange(S)
    alibi = 2.0 ** (-jnp.arange(1, N_ALIBI + 1, dtype=jnp.float32) * (8.0 / N_ALIBI))
    proj = jnp.einsum('bsd,dn->bsn', h, w_in)
    split_points = np.cumsum(IN_SIZES)[:-1].tolist()
    (a_q, a_k, a_v, a_f, b_cq, b_ckv, b_kr, c_q, c_k, c_v,
     d_q, d_k, d_v, d_qi, d_ki, d_wi) = jnp.split(proj, split_points, axis=-1)

    log_f = jax.nn.log_sigmoid(a_f.astype(jnp.float32) + b_forget.astype(jnp.float32))
    out_a = causal_block_attention(a_q.reshape(B, S, FOX_HEADS, HEAD_DIM),
                                   a_k.reshape(B, S, FOX_HEADS, HEAD_DIM),
                                   a_v.reshape(B, S, FOX_HEADS, HEAD_DIM), log_f)

    q_full = jnp.einsum('bsr,rn->bsn', rmsnorm(b_cq, g_q_mla), w_q_up).reshape(B, S, MLA_HEADS, MLA_NOPE_DIM + MLA_ROPE_DIM)
    kv_full = jnp.einsum('bsr,rn->bsn', rmsnorm(b_ckv, g_kv_mla), w_kv_up).reshape(B, S, MLA_HEADS, MLA_NOPE_DIM + MLA_V_DIM)
    q_nope, q_rot = q_full[..., :MLA_NOPE_DIM], q_full[..., MLA_NOPE_DIM:]
    k_nope, v_mla = kv_full[..., :MLA_NOPE_DIM], kv_full[..., MLA_NOPE_DIM:]
    k_rot = jnp.broadcast_to(rope(b_kr[:, :, None, :], pos), (B, S, MLA_HEADS, MLA_ROPE_DIM))
    q_mla = jnp.concatenate([q_nope, rope(q_rot, pos)], axis=-1)
    k_mla = jnp.concatenate([k_nope, k_rot], axis=-1)
    out_b = causal_block_attention(q_mla, k_mla, v_mla)

    out_c = sliding_window_sink_attention(c_q.reshape(B, S, SWA_HEADS, HEAD_DIM),
                                          c_k.reshape(B, S, SWA_KV_HEADS, HEAD_DIM),
                                          c_v.reshape(B, S, SWA_KV_HEADS, HEAD_DIM),
                                          sinks, alibi[:SWA_HEADS])

    out_d = dsa_attention(d_q.reshape(B, S, DSA_HEADS, HEAD_DIM), d_k, d_v,
                          d_qi.reshape(B, S, DSA_IDX_HEADS, DSA_IDX_DIM), d_ki, d_wi,
                          alibi[SWA_HEADS:])

    merged = jnp.concatenate([out_a, out_b, out_c, out_d], axis=-1)
    return jnp.einsum('bsm,md->bsd', merged, w_out)


def grouped_moe(h, w_router, b_router, w_gate, w_up, w_down):
    B, S, D = h.shape
    t = h.reshape(B * S, D)
    scores = jax.nn.sigmoid(jnp.einsum('td,de->te', t, w_router, preferred_element_type=jnp.float32))
    biased = scores + b_router.astype(jnp.float32)
    grouped = biased.reshape(-1, N_GROUPS, EXPERTS_PER_GROUP)
    group_score = lax.top_k(grouped, 2)[0].sum(-1)
    best_group = jnp.argmax(group_score, axis=-1)
    in_group = jax.nn.one_hot(best_group, N_GROUPS, dtype=jnp.bool_)[:, :, None]
    masked = jnp.where(in_group, grouped, -jnp.inf).reshape(-1, N_EXPERTS)
    _, expert_idx = lax.top_k(masked, TOP_K_EXPERTS)
    w = jnp.take_along_axis(scores, expert_idx, axis=1)
    w = w / jnp.sum(w, axis=-1, keepdims=True)
    gates = jnp.sum(jax.nn.one_hot(expert_idx, N_EXPERTS, dtype=jnp.float32) * w[..., None], axis=1)
    out = jnp.zeros((t.shape[0], D), jnp.float32)
    for e in range(N_EXPERTS):
        hid = jax.nn.silu(t @ w_gate[e]) * (t @ w_up[e])
        out = out + gates[:, e:e + 1] * (hid @ w_down[e]).astype(jnp.float32)
    return out.astype(h.dtype).reshape(B, S, D)


def setup_inputs(seed: int = 0) -> dict:
    key = jax.random.key(seed)
    ks = jax.random.split(key, 24)
    f32 = jnp.float32
    nrm = lambda k, shape, s: jax.random.normal(k, shape, f32) * s
    D = D_MODEL
    return {
        'x': nrm(ks[0], (BATCH, SEQ, D), 1.0),
        'c': nrm(ks[1], (BATCH, D), 1.0),
        'w_ada': nrm(ks[2], (DEPTH, D, 6 * D), 0.5 * D ** -0.5),
        'b_ada': nrm(ks[3], (DEPTH, 6 * D), 0.02),
        'g_norm1': 1.0 + nrm(ks[4], (DEPTH, D), 0.02),
        'w_in': nrm(ks[5], (DEPTH, D, N_IN), D ** -0.5),
        'b_forget': 1.0 + nrm(ks[6], (DEPTH, FOX_HEADS), 0.1),
        'g_q_mla': 1.0 + nrm(ks[7], (DEPTH, MLA_Q_RANK), 0.02),
        'w_q_up': nrm(ks[8], (DEPTH, MLA_Q_RANK, MLA_HEADS * (MLA_NOPE_DIM + MLA_ROPE_DIM)), MLA_Q_RANK ** -0.5),
        'g_kv_mla': 1.0 + nrm(ks[9], (DEPTH, MLA_KV_RANK), 0.02),
        'w_kv_up': nrm(ks[10], (DEPTH, MLA_KV_RANK, MLA_HEADS * (MLA_NOPE_DIM + MLA_V_DIM)), MLA_KV_RANK ** -0.5),
        'sinks': nrm(ks[11], (DEPTH, SWA_HEADS), 0.5),
        'w_out': nrm(ks[12], (DEPTH, D_MIX, D), D_MIX ** -0.5),
        'g_norm2': 1.0 + nrm(ks[13], (DEPTH, D), 0.02),
        'w_router': nrm(ks[14], (D, N_EXPERTS), D ** -0.5),
        'b_router': nrm(ks[15], (N_EXPERTS,), 0.01),
        'w_gate': nrm(ks[16], (DEPTH, N_EXPERTS, D, D_EXPERT), D ** -0.5),
        'w_up': nrm(ks[17], (DEPTH, N_EXPERTS, D, D_EXPERT), D ** -0.5),
        'w_down': nrm(ks[18], (DEPTH, N_EXPERTS, D_EXPERT, D), D_EXPERT ** -0.5),
        'g_final': 1.0 + nrm(ks[19], (D,), 0.02),
    }


def reference(x, c, w_ada, b_ada, g_norm1, w_in, b_forget, g_q_mla, w_q_up, g_kv_mla, w_kv_up,
              sinks, w_out, g_norm2, w_router, b_router, w_gate, w_up, w_down, g_final):
    c_act = jax.nn.silu(c)
    for l in range(DEPTH):
        mod = jnp.einsum('bd,dn->bn', c_act, w_ada[l]) + b_ada[l]
        sh1, sc1, gt1, sh2, sc2, gt2 = jnp.split(mod[:, None, :], 6, axis=-1)
        h = rmsnorm(x, g_norm1[l]) * (1.0 + sc1) + sh1
        x = x + gt1 * hybrid_mixer(h, w_in[l], b_forget[l], g_q_mla[l], w_q_up[l], g_kv_mla[l],
                                   w_kv_up[l], sinks[l], w_out[l])
        h = rmsnorm(x, g_norm2[l]) * (1.0 + sc2) + sh2
        x = x + gt2 * grouped_moe(h, w_router, b_router, w_gate[l], w_up[l], w_down[l])
    return rmsnorm(x, g_final)
```

```cpp
#include <hip/hip_runtime.h>
#include <stdint.h>

namespace {
constexpr int D = 1024, NB = 32, S = 2048, T = NB * S, NIN = 2380, NMOD = 6144;
constexpr int OFF_AQ = 0, OFF_AK = 256, OFF_AV = 512, OFF_AF = 768, OFF_BCQ = 772, OFF_BCKV = 1028, OFF_BKR = 1156,
              OFF_CQ = 1188, OFF_CK = 1444, OFF_CV = 1572, OFF_DQ = 1700, OFF_DK = 1956, OFF_DV = 2020,
              OFF_DQI = 2084, OFF_DKI = 2340, OFF_DWI = 2372;
constexpr float EPS = 1e-6f;

__global__ void __launch_bounds__(256) k_mod(const float* __restrict__ c, const float* __restrict__ w_ada,
                                             const float* __restrict__ b_ada, float* __restrict__ mod) {
    const int n = blockIdx.x * 256 + threadIdx.x, b = blockIdx.y, l = blockIdx.z;
    __shared__ float ca[1024];
    for (int d = threadIdx.x; d < 1024; d += 256) { const float v = c[b * 1024 + d]; ca[d] = v / (1.f + expf(-v)); }
    __syncthreads();
    const float* w = w_ada + (size_t)l * 1024 * NMOD + n;
    float acc = 0.f;
    for (int d = 0; d < 1024; ++d) acc += ca[d] * w[(size_t)d * NMOD];
    mod[((size_t)l * NB + b) * NMOD + n] = acc + b_ada[l * NMOD + n];
}

template <bool COMBINE, bool FINAL>
__global__ void __launch_bounds__(256) k_norm(const float* xin, float* xout, const float* __restrict__ ys,
                                              const float* __restrict__ gt_prev  , const float* __restrict__ g,
                                              const float* __restrict__ sh, const float* __restrict__ sc  ,
                                              float* __restrict__ h) {
    const int t = blockIdx.x, b = t / S, d = threadIdx.x * 4;
    float4 v = *(const float4*)(xin + (size_t)t * D + d);
    if (COMBINE) {
        const float4 y0 = *(const float4*)(ys + ((size_t)t * 2 + 0) * D + d), y1 = *(const float4*)(ys + ((size_t)t * 2 + 1) * D + d);
        const float4 gt = *(const float4*)(gt_prev + (size_t)b * NMOD + d);
        v.x += gt.x * (y0.x + y1.x); v.y += gt.y * (y0.y + y1.y); v.z += gt.z * (y0.z + y1.z); v.w += gt.w * (y0.w + y1.w);
    }
    float ss = v.x * v.x + v.y * v.y + v.z * v.z + v.w * v.w;
    for (int o = 32; o > 0; o >>= 1) ss += __shfl_xor(ss, o);
    __shared__ float red[4];
    if ((threadIdx.x & 63) == 0) red[threadIdx.x >> 6] = ss;
    __syncthreads();
    ss = red[0] + red[1] + red[2] + red[3];
    const float r = rsqrtf(ss * (1.0f / D) + EPS);
    const float4 gg = *(const float4*)(g + d);
    float4 y; y.x = v.x * r * gg.x; y.y = v.y * r * gg.y; y.z = v.z * r * gg.z; y.w = v.w * r * gg.w;
    if (FINAL) { *(float4*)(xout + (size_t)t * D + d) = y; }
    else {
        *(float4*)(xout + (size_t)t * D + d) = v;
        const float4 a = *(const float4*)(sc + (size_t)b * NMOD + d), s4 = *(const float4*)(sh + (size_t)b * NMOD + d);
        y.x = y.x * (1.f + a.x) + s4.x; y.y = y.y * (1.f + a.y) + s4.y; y.z = y.z * (1.f + a.z) + s4.z; y.w = y.w * (1.f + a.w) + s4.w;
        *(float4*)(h + (size_t)t * D + d) = y;
    }
}

template <int EPI>
__global__ void __launch_bounds__(256) k_gemm(const float* __restrict__ A, int lda, const float* __restrict__ Bm, int ldb,
                                              float* __restrict__ C, int ldc, int M, int N, int K, const float* __restrict__ gate, int b0) {
    __shared__ float As[16][68];
    __shared__ float Bs[16][68];
    const int tid = threadIdx.x, tx = tid & 15, ty = tid >> 4;
    const int m0 = blockIdx.y * 64, n0 = blockIdx.x * 64;
    float acc[4][4];
#pragma unroll
    for (int i = 0; i < 4; ++i)
#pragma unroll
        for (int j = 0; j < 4; ++j) acc[i][j] = 0.f;
    for (int k0 = 0; k0 < K; k0 += 16) {
        { const int r = tid >> 2, c4 = (tid & 3) * 4; const float4 v = *(const float4*)(A + (size_t)(m0 + r) * lda + k0 + c4);
          As[c4][r] = v.x; As[c4 + 1][r] = v.y; As[c4 + 2][r] = v.z; As[c4 + 3][r] = v.w; }
        { const int r = tid >> 4, c4 = (tid & 15) * 4;
#pragma unroll
          for (int j = 0; j < 4; ++j) { const int n = n0 + c4 + j; Bs[r][c4 + j] = n < N ? Bm[(size_t)(k0 + r) * ldb + n] : 0.f; } }
        __syncthreads();
#pragma unroll
        for (int kk = 0; kk < 16; ++kk) {
            float a[4], bb[4];
#pragma unroll
            for (int i = 0; i < 4; ++i) { a[i] = As[kk][ty * 4 + i]; bb[i] = Bs[kk][tx * 4 + i]; }
#pragma unroll
            for (int i = 0; i < 4; ++i)
#pragma unroll
                for (int j = 0; j < 4; ++j) acc[i][j] += a[i] * bb[j];
        }
        __syncthreads();
    }
#pragma unroll
    for (int i = 0; i < 4; ++i) {
        const int row = m0 + ty * 4 + i;
#pragma unroll
        for (int j = 0; j < 4; ++j) {
            const int col = n0 + tx * 4 + j;
            if (col < N) {
                float* p = C + (size_t)row * ldc + col;
                if (EPI == 0) *p = acc[i][j];
                else *p = *p + gate[(size_t)(b0 + row / S) * NMOD + col] * acc[i][j];
            }
        }
    }
}

__global__ void k_fox(const float* __restrict__ proj, const float* __restrict__ bf, float* __restrict__ cum, int nb) {
    const int id = blockIdx.x * blockDim.x + threadIdx.x;
    if (id >= nb * 4) return;
    const int b = id >> 2, h = id & 3;
    float run = 0.f; const float bias = bf[h];
    for (int t = 0; t < S; ++t) {
        const float z = proj[(size_t)(b * S + t) * NIN + OFF_AF + h] + bias;
        const float lf = fminf(z, 0.f) - log1pf(expf(-fabsf(z)));
        run += lf; cum[(size_t)id * S + t] = run;
    }
}

__global__ void __launch_bounds__(256) k_mla(const float* __restrict__ proj, const float* __restrict__ gq, const float* __restrict__ wq,
                                             const float* __restrict__ gkv, const float* __restrict__ wkv,
                                             float* __restrict__ qm, float* __restrict__ km, float* __restrict__ vm) {
    constexpr int TP = 8;
    __shared__ float cq[TP][256]; __shared__ float ckv[TP][128]; __shared__ float kr[TP][32];
    __shared__ float qf[TP][384]; __shared__ float kvf[TP][512];
    const int tid = threadIdx.x, tok0 = blockIdx.x * TP;
    for (int i = tid; i < TP * 256; i += 256) { const int j = i >> 8, cidx = i & 255; cq[j][cidx] = proj[(size_t)(tok0 + j) * NIN + OFF_BCQ + cidx]; }
    for (int i = tid; i < TP * 128; i += 256) { const int j = i >> 7, cidx = i & 127; ckv[j][cidx] = proj[(size_t)(tok0 + j) * NIN + OFF_BCKV + cidx]; }
    { const int j = tid >> 5, cidx = tid & 31; kr[j][cidx] = proj[(size_t)(tok0 + j) * NIN + OFF_BKR + cidx]; }
    __syncthreads();
    {
        const int j = tid >> 5, ln = tid & 31;
        float s1 = 0.f, s2 = 0.f;
        for (int i = ln; i < 256; i += 32) s1 += cq[j][i] * cq[j][i];
        for (int i = ln; i < 128; i += 32) s2 += ckv[j][i] * ckv[j][i];
        for (int o = 16; o > 0; o >>= 1) { s1 += __shfl_xor(s1, o); s2 += __shfl_xor(s2, o); }
        const float r1 = rsqrtf(s1 * (1.f / 256.f) + EPS), r2 = rsqrtf(s2 * (1.f / 128.f) + EPS);
        __syncthreads();
        for (int i = ln; i < 256; i += 32) cq[j][i] = cq[j][i] * r1 * gq[i];
        for (int i = ln; i < 128; i += 32) ckv[j][i] = ckv[j][i] * r2 * gkv[i];
    }
    __syncthreads();
    for (int o = tid; o < 384 + 512; o += 256) {
        float acc[TP];
#pragma unroll
        for (int j = 0; j < TP; ++j) acc[j] = 0.f;
        if (o < 384) {
            for (int i = 0; i < 256; ++i) { const float w = wq[i * 384 + o];
#pragma unroll
                for (int j = 0; j < TP; ++j) acc[j] += cq[j][i] * w; }
#pragma unroll
            for (int j = 0; j < TP; ++j) qf[j][o] = acc[j];
        } else {
            const int o2 = o - 384;
            for (int i = 0; i < 128; ++i) { const float w = wkv[i * 512 + o2];
#pragma unroll
                for (int j = 0; j < TP; ++j) acc[j] += ckv[j][i] * w; }
#pragma unroll
            for (int j = 0; j < TP; ++j) kvf[j][o2] = acc[j];
        }
    }
    __syncthreads();
    for (int i = tid; i < TP * 384; i += 256) {
        const int j = i / 384, r = i % 384, hh = r / 96, cc = r % 96;
        const int tok = tok0 + j, pos = tok % S;
        float qv, kv;
        if (cc < 64) { qv = qf[j][hh * 96 + cc]; kv = kvf[j][hh * 128 + cc]; }
        else {
            const int ii = (cc - 64) & 15; const bool hi = cc >= 80;
            const float inv = powf(10000.0f, -(float)ii / 16.0f);
            const float ang = (float)pos * inv, cs = cosf(ang), sn = sinf(ang);
            const float q1 = qf[j][hh * 96 + 64 + ii], q2 = qf[j][hh * 96 + 80 + ii];
            const float k1 = kr[j][ii], k2 = kr[j][16 + ii];
            qv = hi ? (q2 * cs + q1 * sn) : (q1 * cs - q2 * sn);
            kv = hi ? (k2 * cs + k1 * sn) : (k1 * cs - k2 * sn);
        }
        qm[(size_t)tok * 384 + r] = qv; km[(size_t)tok * 384 + r] = kv;
    }
    for (int i = tid; i < TP * 256; i += 256) {
        const int j = i >> 8, r = i & 255, hh = r >> 6, cc = r & 63;
        vm[(size_t)(tok0 + j) * 256 + r] = kvf[j][hh * 128 + 64 + cc];
    }
}

__global__ void __launch_bounds__(256) k_dsa_select(const float* __restrict__ proj, uint32_t* __restrict__ mask) {
    __shared__ float sc[4][2048]; __shared__ float qs[4][256]; __shared__ float wsd[4][8];
    const int tid = threadIdx.x, wave = tid >> 6, lane = tid & 63;
    const int tok = blockIdx.x * 4 + wave, b = tok / S, t = tok % S, n = t + 1;
    for (int i = lane; i < 256; i += 64) qs[wave][i] = proj[(size_t)tok * NIN + OFF_DQI + i];
    if (lane < 8) wsd[wave][lane] = proj[(size_t)tok * NIN + OFF_DWI + lane] * (0.35355339059327373f * 0.17677669529663687f);
    __syncthreads();
    for (int s = lane; s < n; s += 64) {
        const float* kp = proj + (size_t)(b * S + s) * NIN + OFF_DKI;
        float kk[32];
#pragma unroll
        for (int i = 0; i < 32; i += 4) { const float4 v = *(const float4*)(kp + i); kk[i] = v.x; kk[i + 1] = v.y; kk[i + 2] = v.z; kk[i + 3] = v.w; }
        float score = 0.f;
#pragma unroll 1
        for (int h = 0; h < 8; ++h) {
            float d = 0.f;
#pragma unroll
            for (int i = 0; i < 32; ++i) d += qs[wave][h * 32 + i] * kk[i];
            score += wsd[wave][h] * fmaxf(d, 0.f);
        }
        uint32_t u = __float_as_uint(score); if (u == 0x80000000u) u = 0u;
        u = (u & 0x80000000u) ? ~u : (u | 0x80000000u);
        sc[wave][s] = __uint_as_float(u);
    }
    for (int s = n + lane; s < 2048; s += 64) sc[wave][s] = 0.f;
    __syncthreads();
    uint32_t* mrow = mask + (size_t)tok * 64;
    if (n <= 256) {
        for (int ch = 0; ch < 32; ++ch) {
            const int s = ch * 64 + lane; const unsigned long long bal = __ballot(s < n);
            if (lane == 0) { mrow[ch * 2] = (uint32_t)bal; mrow[ch * 2 + 1] = (uint32_t)(bal >> 32); }
        }
        return;
    }
    const uint32_t* keys = (const uint32_t*)&sc[wave][0];
    uint32_t thr = 0u;
    for (int bit = 31; bit >= 0; --bit) {
        const uint32_t cand = thr | (1u << bit);
        int cnt = 0;
        for (int i = 0; i < 32; ++i) cnt += (keys[i * 64 + lane] >= cand) ? 1 : 0;
        for (int o = 32; o > 0; o >>= 1) cnt += __shfl_xor(cnt, o);
        if (cnt >= 256) thr = cand;
    }
    int ngt = 0;
    for (int i = 0; i < 32; ++i) ngt += (keys[i * 64 + lane] > thr) ? 1 : 0;
    for (int o = 32; o > 0; o >>= 1) ngt += __shfl_xor(ngt, o);
    const int need = 256 - ngt;
    int running = 0;
    const unsigned long long lt = (lane == 0) ? 0ull : (~0ull >> (64 - lane));
    for (int i = 0; i < 32; ++i) {
        const uint32_t key = keys[i * 64 + lane];
        const bool eq = key == thr;
        const unsigned long long be = __ballot(eq);
        const int rank = running + __popcll(be & lt);
        const bool sel = (key > thr) || (eq && rank < need);
        running += __popcll(be);
        const unsigned long long bs = __ballot(sel);
        if (lane == 0) { mrow[i * 2] = (uint32_t)bs; mrow[i * 2 + 1] = (uint32_t)(bs >> 32); }
    }
}

struct AttnArgs {
    const float* q; const float* k; const float* v; int ldq, ldk, ldv;
    int hq_stride, hk_stride, hv_stride;
    int kv_div;
    const float* cum;
    const uint32_t* mask;
    const float* sinks;
    float* out; int out_off;
    float scale; int slope_base;
};
template <int VAR>
__global__ void __launch_bounds__(128) k_attn_naive(AttnArgs a) {
    constexpr int DQ = (VAR == 1) ? 96 : 64;
    const int t = blockIdx.x * 128 + threadIdx.x, head = blockIdx.y, b = blockIdx.z;
    const size_t tok = (size_t)b * S + t;
    const float* qp = a.q + tok * a.ldq + head * a.hq_stride;
    const float* kb = a.k + (size_t)b * S * a.ldk + (head / a.kv_div) * a.hk_stride;
    const float* vb = a.v + (size_t)b * S * a.ldv + (head / a.kv_div) * a.hv_stride;
    float q[DQ];
#pragma unroll
    for (int d = 0; d < DQ; ++d) q[d] = qp[d] * a.scale;
    float acc[64];
#pragma unroll
    for (int d = 0; d < 64; ++d) acc[d] = 0.f;
    float m = -INFINITY, l = 0.f;
    const float slope = (VAR >= 2) ? exp2f(-(float)(a.slope_base + head + 1)) : 0.f;
    const float ct = (VAR == 0) ? a.cum[((size_t)b * 4 + head) * S + t] : 0.f;
    const int s_lo = (VAR == 2) ? (t - 127 > 0 ? t - 127 : 0) : 0;
    for (int s = s_lo; s <= t; ++s) {
        if (VAR == 3) { const uint32_t w = a.mask[tok * 64 + (s >> 5)]; if (!((w >> (s & 31)) & 1u)) continue; }
        const float* kp = kb + (size_t)s * a.ldk;
        float dot = 0.f;
#pragma unroll
        for (int d = 0; d < DQ; d += 4) { const float4 kv = *(const float4*)(kp + d); dot += q[d] * kv.x + q[d + 1] * kv.y + q[d + 2] * kv.z + q[d + 3] * kv.w; }
        float logit = dot;
        if (VAR == 0) logit += ct - a.cum[((size_t)b * 4 + head) * S + s];
        if (VAR >= 2) logit -= slope * (float)(t - s);
        const float mn = fmaxf(m, logit), alpha = __expf(m - mn), p = __expf(logit - mn);
        l = l * alpha + p; m = mn;
        const float* vp = vb + (size_t)s * a.ldv;
#pragma unroll
        for (int d = 0; d < 64; d += 4) { const float4 vv = *(const float4*)(vp + d);
            acc[d] = acc[d] * alpha + p * vv.x; acc[d + 1] = acc[d + 1] * alpha + p * vv.y; acc[d + 2] = acc[d + 2] * alpha + p * vv.z; acc[d + 3] = acc[d + 3] * alpha + p * vv.w; }
    }
    if (VAR == 2) l += __expf(a.sinks[head] - m);
    const float inv = 1.f / l;
    float* op = a.out + tok * 1024 + a.out_off + head * 64;
#pragma unroll
    for (int d = 0; d < 64; d += 4) { float4 o; o.x = acc[d] * inv; o.y = acc[d + 1] * inv; o.z = acc[d + 2] * inv; o.w = acc[d + 3] * inv; *(float4*)(op + d) = o; }
}

__global__ void __launch_bounds__(256) k_route(const float* __restrict__ h, const float* __restrict__ wr, const float* __restrict__ br,
                                               int* __restrict__ cnt, int* __restrict__ list, float* __restrict__ rw) {
    __shared__ float sg[16][17];
    const int tid = threadIdx.x, tl = tid >> 4, e = tid & 15, tok = blockIdx.x * 16 + tl;
    const float* hp = h + (size_t)tok * D;
    float acc = 0.f;
    for (int d = 0; d < D; ++d) acc += hp[d] * wr[d * 16 + e];
    sg[tl][e] = 1.f / (1.f + expf(-acc));
    __syncthreads();
    if (e == 0) {
        float sc[16], bi[16];
#pragma unroll
        for (int i = 0; i < 16; ++i) { sc[i] = sg[tl][i]; bi[i] = sc[i] + br[i]; }
        int bg = 0; float bgs = -INFINITY;
#pragma unroll
        for (int g = 0; g < 4; ++g) {
            float m1 = -INFINITY, m2 = -INFINITY;
#pragma unroll
            for (int j = 0; j < 4; ++j) { const float v = bi[g * 4 + j]; if (v > m1) { m2 = m1; m1 = v; } else if (v > m2) m2 = v; }
            const float gs = m1 + m2; if (gs > bgs) { bgs = gs; bg = g; }
        }
        int i1 = 0; float v1 = -INFINITY;
        for (int j = 0; j < 4; ++j) { const float v = bi[bg * 4 + j]; if (v > v1) { v1 = v; i1 = j; } }
        int i2 = 0; float v2 = -INFINITY;
        for (int j = 0; j < 4; ++j) { if (j == i1) continue; const float v = bi[bg * 4 + j]; if (v > v2) { v2 = v; i2 = j; } }
        const int e1 = bg * 4 + i1, e2 = bg * 4 + i2;
        const float w1 = sc[e1], w2 = sc[e2], ws = w1 + w2;
        const int s1 = atomicAdd(&cnt[e1], 1); list[(size_t)e1 * T + s1] = tok * 2 + 0; rw[tok * 2 + 0] = w1 / ws;
        const int s2 = atomicAdd(&cnt[e2], 1); list[(size_t)e2 * T + s2] = tok * 2 + 1; rw[tok * 2 + 1] = w2 / ws;
    }
}

__global__ void __launch_bounds__(256) k_moe_naive(const float* __restrict__ h, const float* __restrict__ wg, const float* __restrict__ wu,
                                                   const float* __restrict__ wd, const int* __restrict__ cnt, const int* __restrict__ list,
                                                   const float* __restrict__ rw, float* __restrict__ ys) {
    constexpr int TP = 8;
    __shared__ float hs[TP][1024]; __shared__ float hid[TP][256]; __shared__ int sl[TP];
    const int e = blockIdx.y, c0 = blockIdx.x * TP, n = cnt[e];
    if (c0 >= n) return;
    const int tid = threadIdx.x;
    if (tid < TP) sl[tid] = (c0 + tid < n) ? list[(size_t)e * T + c0 + tid] : -1;
    __syncthreads();
    for (int i = tid; i < TP * 1024; i += 256) { const int j = i >> 10, d = i & 1023; hs[j][d] = sl[j] >= 0 ? h[(size_t)(sl[j] >> 1) * D + d] : 0.f; }
    __syncthreads();
    {
        const float* g = wg + (size_t)e * 1024 * 256 + tid; const float* u = wu + (size_t)e * 1024 * 256 + tid;
        float ga[TP], ua[TP];
#pragma unroll
        for (int j = 0; j < TP; ++j) { ga[j] = 0.f; ua[j] = 0.f; }
        for (int d = 0; d < 1024; ++d) { const float a = g[(size_t)d * 256], bb = u[(size_t)d * 256];
#pragma unroll
            for (int j = 0; j < TP; ++j) { ga[j] += hs[j][d] * a; ua[j] += hs[j][d] * bb; } }
#pragma unroll
        for (int j = 0; j < TP; ++j) hid[j][tid] = ga[j] / (1.f + expf(-ga[j])) * ua[j];
    }
    __syncthreads();
    float acc[TP][4];
#pragma unroll
    for (int j = 0; j < TP; ++j)
#pragma unroll
        for (int i = 0; i < 4; ++i) acc[j][i] = 0.f;
    const float* dn = wd + (size_t)e * 256 * 1024;
    for (int k = 0; k < 256; ++k) {
        float w[4];
#pragma unroll
        for (int i = 0; i < 4; ++i) w[i] = dn[(size_t)k * 1024 + tid + 256 * i];
#pragma unroll
        for (int j = 0; j < TP; ++j)
#pragma unroll
            for (int i = 0; i < 4; ++i) acc[j][i] += hid[j][k] * w[i];
    }
#pragma unroll
    for (int j = 0; j < TP; ++j) if (sl[j] >= 0) { const float w = rw[sl[j]];
#pragma unroll
        for (int i = 0; i < 4; ++i) ys[(size_t)sl[j] * D + tid + 256 * i] = w * acc[j][i]; }
}
}

extern "C" void kernel_launch(void* const* d_in, const int* in_sizes, int n_in, void* d_out, int out_size, void* d_ws, size_t ws_size,
                              hipStream_t stream) {
    const float* x = (const float*)d_in[0];   const float* c = (const float*)d_in[1];
    const float* w_ada = (const float*)d_in[2]; const float* b_ada = (const float*)d_in[3];
    const float* g_norm1 = (const float*)d_in[4]; const float* w_in = (const float*)d_in[5];
    const float* b_forget = (const float*)d_in[6]; const float* g_q_mla = (const float*)d_in[7];
    const float* w_q_up = (const float*)d_in[8]; const float* g_kv_mla = (const float*)d_in[9];
    const float* w_kv_up = (const float*)d_in[10]; const float* sinks = (const float*)d_in[11];
    const float* w_out = (const float*)d_in[12]; const float* g_norm2 = (const float*)d_in[13];
    const float* w_router = (const float*)d_in[14]; const float* b_router = (const float*)d_in[15];
    const float* w_gate = (const float*)d_in[16]; const float* w_up = (const float*)d_in[17];
    const float* w_down = (const float*)d_in[18]; const float* g_final = (const float*)d_in[19];
    float* xo = (float*)d_out;
    char* ws = (char*)d_ws;
    size_t off = 0;
    auto carve = [&](size_t bytes) { char* p = ws + off; off += (bytes + 255) & ~(size_t)255; return p; };
    int* cnt = (int*)carve(256);
    float* mod = (float*)carve((size_t)2 * NB * NMOD * 4);
    float* h = (float*)carve((size_t)T * D * 4);
    const size_t region = off;
    constexpr int TH = T / 2, NBH = NB / 2;
    float* proj = (float*)carve((size_t)TH * NIN * 4);
    float* qm = (float*)carve((size_t)TH * 384 * 4);
    float* km = (float*)carve((size_t)TH * 384 * 4);
    float* vm = (float*)carve((size_t)TH * 256 * 4);
    float* cum = (float*)carve((size_t)NBH * 4 * S * 4);
    uint32_t* mask = (uint32_t*)carve((size_t)TH * 64 * 4);
    float* merged = (float*)carve((size_t)TH * D * 4);
    const size_t end_mixer = off;
    off = region;
    float* ys = (float*)carve((size_t)T * 2 * D * 4);
    int* list = (int*)carve((size_t)16 * T * 4);
    float* rw = (float*)carve((size_t)T * 2 * 4);
    const size_t end_moe = off;
    if ((end_mixer > end_moe ? end_mixer : end_moe) > ws_size) return;

    k_mod<<<dim3(NMOD / 256, NB, 2), 256, 0, stream>>>(c, w_ada, b_ada, mod);
    for (int l = 0; l < 2; ++l) {
        const float* modl = mod + (size_t)l * NB * NMOD;
        if (l == 0) k_norm<false, false><<<T, 256, 0, stream>>>(x, xo, nullptr, nullptr, g_norm1 + l * D, modl + 0, modl + 1024, h);
        else        k_norm<true, false><<<T, 256, 0, stream>>>(xo, xo, ys, mod + (size_t)(l - 1) * NB * NMOD + 5 * 1024, g_norm1 + l * D, modl + 0, modl + 1024, h);
        for (int half = 0; half < 2; ++half) {
            const int b0 = half * NBH;
            const float* hh = h + (size_t)half * TH * D;
            k_gemm<0><<<dim3((NIN + 63) / 64, TH / 64), 256, 0, stream>>>(hh, D, w_in + (size_t)l * D * NIN, NIN, proj, NIN, TH, NIN, D, nullptr, 0);
            k_fox<<<1, 64, 0, stream>>>(proj, b_forget + l * 4, cum, NBH);
            k_mla<<<TH / 8, 256, 0, stream>>>(proj, g_q_mla + l * 256, w_q_up + (size_t)l * 256 * 384, g_kv_mla + l * 128, w_kv_up + (size_t)l * 128 * 512, qm, km, vm);
            k_dsa_select<<<TH / 4, 256, 0, stream>>>(proj, mask);
            AttnArgs a{};
            a.out = merged; a.cum = cum; a.mask = mask; a.sinks = sinks + l * 4;
            a.q = proj + OFF_AQ; a.k = proj + OFF_AK; a.v = proj + OFF_AV; a.ldq = a.ldk = a.ldv = NIN; a.hq_stride = a.hk_stride = a.hv_stride = 64; a.kv_div = 1;
            a.out_off = 0; a.scale = 0.125f; a.slope_base = 0;
            k_attn_naive<0><<<dim3(S / 128, 4, NBH), 128, 0, stream>>>(a);
            a.q = qm; a.k = km; a.v = vm; a.ldq = 384; a.ldk = 384; a.ldv = 256; a.hq_stride = 96; a.hk_stride = 96; a.hv_stride = 64; a.kv_div = 1;
            a.out_off = 256; a.scale = 0.10206207261596577f;
            k_attn_naive<1><<<dim3(S / 128, 4, NBH), 128, 0, stream>>>(a);
            a.q = proj + OFF_CQ; a.k = proj + OFF_CK; a.v = proj + OFF_CV; a.ldq = a.ldk = a.ldv = NIN; a.hq_stride = a.hk_stride = a.hv_stride = 64; a.kv_div = 2;
            a.out_off = 512; a.scale = 0.125f; a.slope_base = 0;
            k_attn_naive<2><<<dim3(S / 128, 4, NBH), 128, 0, stream>>>(a);
            a.q = proj + OFF_DQ; a.k = proj + OFF_DK; a.v = proj + OFF_DV; a.hq_stride = 64; a.hk_stride = 0; a.hv_stride = 0; a.kv_div = 1;
            a.out_off = 768; a.scale = 0.125f; a.slope_base = 4;
            k_attn_naive<3><<<dim3(S / 128, 4, NBH), 128, 0, stream>>>(a);
            k_gemm<1><<<dim3(D / 64, TH / 64), 256, 0, stream>>>(merged, D, w_out + (size_t)l * D * D, D, xo + (size_t)half * TH * D, D, TH, D, D, modl + 2 * 1024, b0);
        }
        k_norm<false, false><<<T, 256, 0, stream>>>(xo, xo, nullptr, nullptr, g_norm2 + l * D, modl + 3 * 1024, modl + 4 * 1024, h);
        (void)hipMemsetAsync(cnt, 0, 256, stream);
        k_route<<<T / 16, 256, 0, stream>>>(h, w_router, b_router, cnt, list, rw);
        k_moe_naive<<<dim3(T / 8, 16), 256, 0, stream>>>(h, w_gate + (size_t)l * 16 * D * 256, w_up + (size_t)l * 16 * D * 256, w_down + (size_t)l * 16 * 256 * D, cnt, list, rw, ys);
    }
    k_norm<true, true><<<T, 256, 0, stream>>>(xo, xo, ys, mod + (size_t)1 * NB * NMOD + 5 * 1024, g_final, nullptr, nullptr, nullptr);
}
```

```cpp
#include <hip/hip_runtime.h>
#include <stdint.h>

#define XB_TMO      128
#define XB_XCNT(j)  (256  + 64 * (j))
#define XB_XSUB(j)  (1280 + 64 * (j))
#define XB_XGEN(j)  (2304 + 64 * (j))
#define XB_TOP      3328
#define XB_TOPGEN   3392
#define XCD_BAR_WORDS 3456
#define XB_SPIN_CAP (1u << 23)
#define LAS __attribute__((address_space(3)))

__device__ __forceinline__ unsigned xb_ld(unsigned* p)              { return __hip_atomic_load(p, __ATOMIC_RELAXED, __HIP_MEMORY_SCOPE_AGENT); }
__device__ __forceinline__ unsigned xb_add(unsigned* p, unsigned v) { return __hip_atomic_fetch_add(p, v, __ATOMIC_RELAXED, __HIP_MEMORY_SCOPE_AGENT); }
__device__ __forceinline__ unsigned xb_xcc_id() { return (unsigned)__builtin_amdgcn_s_getreg((3 << 11) | 20) & 0xFu; }
#define XB_SPIN(cond, bar) do { unsigned _sp = 0; while (cond) { __builtin_amdgcn_s_sleep(1); \
    if ((++_sp & 255u) == 0u) { if (xb_ld(&(bar)[XB_TMO])) break; if (_sp > XB_SPIN_CAP) { atomicAdd(&(bar)[XB_TMO], 1u); break; } } } } while (0)

struct XcdBarrier { unsigned* bar; unsigned x; volatile LAS unsigned* st; };

__device__ __forceinline__ XcdBarrier xcd_barrier_post(unsigned* bar, volatile LAS unsigned* st) {
    XcdBarrier b; b.bar = bar; b.x = xb_xcc_id(); b.st = st;
    if (threadIdx.x == 0) (void)xb_add(&bar[XB_XCNT(b.x)], 1u);
    return b;
}
__device__ __forceinline__ void xcd_barrier_complete(unsigned* bar, unsigned x, unsigned& nloc, unsigned& nx) {
    const unsigned G = gridDim.x * gridDim.y * gridDim.z;
    unsigned sum, cnt, mine, sp = 0u;
    for (;;) {
        sum = 0u; cnt = 0u; mine = 0u;
#pragma unroll
        for (unsigned j = 0; j < 16; ++j) { const unsigned c = xb_ld(&bar[XB_XCNT(j)]); sum += c; cnt += (c > 0u) ? 1u : 0u; mine = (j == x) ? c : mine; }
        if (sum == G) break;
        __builtin_amdgcn_s_sleep(1);
        if ((++sp & 255u) == 0u) { if (xb_ld(&bar[XB_TMO])) break; if (sp > XB_SPIN_CAP) { atomicAdd(&bar[XB_TMO], 1u); break; } }
    }
    nloc = mine > 0u ? mine : 1u; nx = cnt > 0u ? cnt : 1u;
}
__device__ __forceinline__ void xcd_barrier(const XcdBarrier& b) {
    asm volatile("s_waitcnt vmcnt(0)" ::: "memory");
    __syncthreads();
    if (threadIdx.x == 0) {
        unsigned* bar = b.bar;
        __builtin_amdgcn_s_waitcnt(0);
        unsigned nloc = b.st[0], nx = b.st[1];
        if (nloc == 0u) { xcd_barrier_complete(bar, b.x, nloc, nx); b.st[0] = nloc; b.st[1] = nx; }
        const unsigned old = xb_add(&bar[XB_XSUB(b.x)], 1u);
        const unsigned gen = old / nloc;
        if (old + 1u == (gen + 1u) * nloc) {
            __builtin_amdgcn_fence(__ATOMIC_RELEASE, "agent");
            asm volatile("s_waitcnt vmcnt(0)" ::: "memory");
            const unsigned og = xb_add(&bar[XB_TOP], 1u);
            const unsigned tg = og / nx;
            if (og + 1u == (tg + 1u) * nx) xb_add(&bar[XB_TOPGEN], 1u);
            else XB_SPIN(xb_ld(&bar[XB_TOPGEN]) == tg, bar);
            __builtin_amdgcn_fence(__ATOMIC_ACQUIRE, "agent");
            xb_add(&bar[XB_XGEN(b.x)], 1u);
            asm volatile("s_waitcnt vmcnt(0)" ::: "memory");
        } else {
            XB_SPIN(xb_ld(&bar[XB_XGEN(b.x)]) == gen, bar);
            __builtin_amdgcn_fence(__ATOMIC_ACQUIRE, "agent");
            asm volatile("s_waitcnt vmcnt(0)" ::: "memory");
        }
    }
    __syncthreads();
}

namespace {
constexpr int D = 1024, NB = 32, S = 2048, T = NB * S, NIN = 2380, NMOD = 6144;
constexpr int OFF_AQ = 0, OFF_AK = 256, OFF_AV = 512, OFF_AF = 768, OFF_BCQ = 772, OFF_BCKV = 1028, OFF_BKR = 1156,
              OFF_CQ = 1188, OFF_CK = 1444, OFF_CV = 1572, OFF_DQ = 1700, OFF_DK = 1956, OFF_DV = 2020,
              OFF_DQI = 2084, OFF_DKI = 2340, OFF_DWI = 2372;
constexpr float EPS = 1e-6f;
constexpr int TH = T / 2, NBH = NB / 2;
constexpr int LDS_BYTES = 49152;

struct Params {
    const float *x, *c, *w_ada, *b_ada, *g_norm1, *w_in, *b_forget, *g_q_mla, *w_q_up, *g_kv_mla, *w_kv_up, *sinks, *w_out, *g_norm2,
                *w_router, *b_router, *w_gate, *w_up, *w_down, *g_final;
    float* xo; unsigned* bar; int* cnt; float* mod; float* h; float* proj; float* qm; float* km; float* vm; float* cum; uint32_t* mask;
    float* merged; float* ys; int* list; float* rw;
};

__device__ __forceinline__ void b_mod(const Params& p, int vb, int tid, char* smem) {
    const int bx = vb % 24, b = (vb / 24) % NB, l = vb / (24 * NB);
    const int n = bx * 256 + tid;
    float* ca = (float*)smem;
    for (int d = tid; d < 1024; d += 256) { const float v = p.c[b * 1024 + d]; ca[d] = v / (1.f + expf(-v)); }
    __syncthreads();
    const float* w = p.w_ada + (size_t)l * 1024 * NMOD + n;
    float acc = 0.f;
    for (int d = 0; d < 1024; ++d) acc += ca[d] * w[(size_t)d * NMOD];
    p.mod[((size_t)l * NB + b) * NMOD + n] = acc + p.b_ada[l * NMOD + n];
}

template <bool COMBINE, bool FINAL>
__device__ __forceinline__ void b_norm(const float* xin, float* xout, const float* ys, const float* gt_prev, const float* g,
                                       const float* sh, const float* sc, float* h, int t, int tid, char* smem) {
    const int b = t / S, d = tid * 4;
    float4 v = *(const float4*)(xin + (size_t)t * D + d);
    if (COMBINE) {
        const float4 y0 = *(const float4*)(ys + ((size_t)t * 2 + 0) * D + d), y1 = *(const float4*)(ys + ((size_t)t * 2 + 1) * D + d);
        const float4 gt = *(const float4*)(gt_prev + (size_t)b * NMOD + d);
        v.x += gt.x * (y0.x + y1.x); v.y += gt.y * (y0.y + y1.y); v.z += gt.z * (y0.z + y1.z); v.w += gt.w * (y0.w + y1.w);
    }
    float ss = v.x * v.x + v.y * v.y + v.z * v.z + v.w * v.w;
    for (int o = 32; o > 0; o >>= 1) ss += __shfl_xor(ss, o);
    float* red = (float*)smem;
    if ((tid & 63) == 0) red[tid >> 6] = ss;
    __syncthreads();
    ss = red[0] + red[1] + red[2] + red[3];
    const float r = rsqrtf(ss * (1.0f / D) + EPS);
    const float4 gg = *(const float4*)(g + d);
    float4 y; y.x = v.x * r * gg.x; y.y = v.y * r * gg.y; y.z = v.z * r * gg.z; y.w = v.w * r * gg.w;
    if (FINAL) { *(float4*)(xout + (size_t)t * D + d) = y; }
    else {
        *(float4*)(xout + (size_t)t * D + d) = v;
        const float4 a = *(const float4*)(sc + (size_t)b * NMOD + d), s4 = *(const float4*)(sh + (size_t)b * NMOD + d);
        y.x = y.x * (1.f + a.x) + s4.x; y.y = y.y * (1.f + a.y) + s4.y; y.z = y.z * (1.f + a.z) + s4.z; y.w = y.w * (1.f + a.w) + s4.w;
        *(float4*)(h + (size_t)t * D + d) = y;
    }
}

template <int EPI>
__device__ __forceinline__ void b_gemm(const float* __restrict__ A, int lda, const float* __restrict__ Bm, int ldb, float* C, int ldc,
                                       int N, int K, const float* __restrict__ gate, int b0, int bx, int by, int tid, char* smem) {
    float (*As)[68] = (float (*)[68])smem;
    float (*Bs)[68] = (float (*)[68])(smem + 16 * 68 * 4);
    const int tx = tid & 15, ty = tid >> 4;
    const int m0 = by * 64, n0 = bx * 64;
    float acc[4][4];
#pragma unroll
    for (int i = 0; i < 4; ++i)
#pragma unroll
        for (int j = 0; j < 4; ++j) acc[i][j] = 0.f;
    for (int k0 = 0; k0 < K; k0 += 16) {
        { const int r = tid >> 2, c4 = (tid & 3) * 4; const float4 v = *(const float4*)(A + (size_t)(m0 + r) * lda + k0 + c4);
          As[c4][r] = v.x; As[c4 + 1][r] = v.y; As[c4 + 2][r] = v.z; As[c4 + 3][r] = v.w; }
        { const int r = tid >> 4, c4 = (tid & 15) * 4;
#pragma unroll
          for (int j = 0; j < 4; ++j) { const int n = n0 + c4 + j; Bs[r][c4 + j] = n < N ? Bm[(size_t)(k0 + r) * ldb + n] : 0.f; } }
        __syncthreads();
#pragma unroll
        for (int kk = 0; kk < 16; ++kk) {
            float a[4], bb[4];
#pragma unroll
            for (int i = 0; i < 4; ++i) { a[i] = As[kk][ty * 4 + i]; bb[i] = Bs[kk][tx * 4 + i]; }
#pragma unroll
            for (int i = 0; i < 4; ++i)
#pragma unroll
                for (int j = 0; j < 4; ++j) acc[i][j] += a[i] * bb[j];
        }
        __syncthreads();
    }
#pragma unroll
    for (int i = 0; i < 4; ++i) {
        const int row = m0 + ty * 4 + i;
#pragma unroll
        for (int j = 0; j < 4; ++j) {
            const int col = n0 + tx * 4 + j;
            if (col < N) {
                float* q = C + (size_t)row * ldc + col;
                if (EPI == 0) *q = acc[i][j];
                else *q = *q + gate[(size_t)(b0 + row / S) * NMOD + col] * acc[i][j];
            }
        }
    }
}

__device__ __forceinline__ void b_fox(const float* __restrict__ proj, const float* __restrict__ bf, float* __restrict__ cum, int tid) {
    if (tid < NBH * 4) {
        const int b = tid >> 2, h = tid & 3;
        float run = 0.f; const float bias = bf[h];
        for (int t = 0; t < S; ++t) {
            const float z = proj[(size_t)(b * S + t) * NIN + OFF_AF + h] + bias;
            const float lf = fminf(z, 0.f) - log1pf(expf(-fabsf(z)));
            run += lf; cum[(size_t)tid * S + t] = run;
        }
    }
}

__device__ __forceinline__ void b_mla(const float* __restrict__ proj, const float* __restrict__ gq, const float* __restrict__ wq,
                                      const float* __restrict__ gkv, const float* __restrict__ wkv, float* __restrict__ qm,
                                      float* __restrict__ km, float* __restrict__ vm, int vb, int tid, char* smem) {
    constexpr int TP = 8;
    float (*cq)[256] = (float (*)[256])smem;
    float (*ckv)[128] = (float (*)[128])(smem + 8192);
    float (*kr)[32] = (float (*)[32])(smem + 12288);
    float (*qf)[384] = (float (*)[384])(smem + 13312);
    float (*kvf)[512] = (float (*)[512])(smem + 25600);
    const int tok0 = vb * TP;
    for (int i = tid; i < TP * 256; i += 256) { const int j = i >> 8, cidx = i & 255; cq[j][cidx] = proj[(size_t)(tok0 + j) * NIN + OFF_BCQ + cidx]; }
    for (int i = tid; i < TP * 128; i += 256) { const int j = i >> 7, cidx = i & 127; ckv[j][cidx] = proj[(size_t)(tok0 + j) * NIN + OFF_BCKV + cidx]; }
    { const int j = tid >> 5, cidx = tid & 31; kr[j][cidx] = proj[(size_t)(tok0 + j) * NIN + OFF_BKR + cidx]; }
    __syncthreads();
    {
        const int j = tid >> 5, ln = tid & 31;
        float s1 = 0.f, s2 = 0.f;
        for (int i = ln; i < 256; i += 32) s1 += cq[j][i] * cq[j][i];
        for (int i = ln; i < 128; i += 32) s2 += ckv[j][i] * ckv[j][i];
        for (int o = 16; o > 0; o >>= 1) { s1 += __shfl_xor(s1, o); s2 += __shfl_xor(s2, o); }
        const float r1 = rsqrtf(s1 * (1.f / 256.f) + EPS), r2 = rsqrtf(s2 * (1.f / 128.f) + EPS);
        __syncthreads();
        for (int i = ln; i < 256; i += 32) cq[j][i] = cq[j][i] * r1 * gq[i];
        for (int i = ln; i < 128; i += 32) ckv[j][i] = ckv[j][i] * r2 * gkv[i];
    }
    __syncthreads();
    for (int o = tid; o < 384 + 512; o += 256) {
        float acc[TP];
#pragma unroll
        for (int j = 0; j < TP; ++j) acc[j] = 0.f;
        if (o < 384) {
            for (int i = 0; i < 256; ++i) { const float w = wq[i * 384 + o];
#pragma unroll
                for (int j = 0; j < TP; ++j) acc[j] += cq[j][i] * w; }
#pragma unroll
            for (int j = 0; j < TP; ++j) qf[j][o] = acc[j];
        } else {
            const int o2 = o - 384;
            for (int i = 0; i < 128; ++i) { const float w = wkv[i * 512 + o2];
#pragma unroll
                for (int j = 0; j < TP; ++j) acc[j] += ckv[j][i] * w; }
#pragma unroll
            for (int j = 0; j < TP; ++j) kvf[j][o2] = acc[j];
        }
    }
    __syncthreads();
    for (int i = tid; i < TP * 384; i += 256) {
        const int j = i / 384, r = i % 384, hh = r / 96, cc = r % 96;
        const int tok = tok0 + j, pos = tok % S;
        float qv, kv;
        if (cc < 64) { qv = qf[j][hh * 96 + cc]; kv = kvf[j][hh * 128 + cc]; }
        else {
            const int ii = (cc - 64) & 15; const bool hi = cc >= 80;
            const float inv = powf(10000.0f, -(float)ii / 16.0f);
            const float ang = (float)pos * inv, cs = cosf(ang), sn = sinf(ang);
            const float q1 = qf[j][hh * 96 + 64 + ii], q2 = qf[j][hh * 96 + 80 + ii];
            const float k1 = kr[j][ii], k2 = kr[j][16 + ii];
            qv = hi ? (q2 * cs + q1 * sn) : (q1 * cs - q2 * sn);
            kv = hi ? (k2 * cs + k1 * sn) : (k1 * cs - k2 * sn);
        }
        qm[(size_t)tok * 384 + r] = qv; km[(size_t)tok * 384 + r] = kv;
    }
    for (int i = tid; i < TP * 256; i += 256) {
        const int j = i >> 8, r = i & 255, hh = r >> 6, cc = r & 63;
        vm[(size_t)(tok0 + j) * 256 + r] = kvf[j][hh * 128 + 64 + cc];
    }
}

__device__ __forceinline__ void b_dsa_select(const float* __restrict__ proj, uint32_t* __restrict__ mask, int vb, int tid, char* smem) {
    float (*sc)[2048] = (float (*)[2048])smem;
    float (*qs)[256] = (float (*)[256])(smem + 32768);
    float (*wsd)[8] = (float (*)[8])(smem + 36864);
    const int wave = tid >> 6, lane = tid & 63;
    const int tok = vb * 4 + wave, b = tok / S, t = tok % S, n = t + 1;
    for (int i = lane; i < 256; i += 64) qs[wave][i] = proj[(size_t)tok * NIN + OFF_DQI + i];
    if (lane < 8) wsd[wave][lane] = proj[(size_t)tok * NIN + OFF_DWI + lane] * (0.35355339059327373f * 0.17677669529663687f);
    __syncthreads();
    for (int s = lane; s < n; s += 64) {
        const float* kp = proj + (size_t)(b * S + s) * NIN + OFF_DKI;
        float kk[32];
#pragma unroll
        for (int i = 0; i < 32; i += 4) { const float4 v = *(const float4*)(kp + i); kk[i] = v.x; kk[i + 1] = v.y; kk[i + 2] = v.z; kk[i + 3] = v.w; }
        float score = 0.f;
#pragma unroll 1
        for (int h = 0; h < 8; ++h) {
            float d = 0.f;
#pragma unroll
            for (int i = 0; i < 32; ++i) d += qs[wave][h * 32 + i] * kk[i];
            score += wsd[wave][h] * fmaxf(d, 0.f);
        }
        uint32_t u = __float_as_uint(score); if (u == 0x80000000u) u = 0u;
        u = (u & 0x80000000u) ? ~u : (u | 0x80000000u);
        sc[wave][s] = __uint_as_float(u);
    }
    for (int s = n + lane; s < 2048; s += 64) sc[wave][s] = 0.f;
    __syncthreads();
    uint32_t* mrow = mask + (size_t)tok * 64;
    if (n <= 256) {
        for (int ch = 0; ch < 32; ++ch) {
            const int s = ch * 64 + lane; const unsigned long long bal = __ballot(s < n);
            if (lane == 0) { mrow[ch * 2] = (uint32_t)bal; mrow[ch * 2 + 1] = (uint32_t)(bal >> 32); }
        }
    } else {
        const uint32_t* keys = (const uint32_t*)&sc[wave][0];
        uint32_t thr = 0u;
        for (int bit = 31; bit >= 0; --bit) {
            const uint32_t cand = thr | (1u << bit);
            int cnt = 0;
            for (int i = 0; i < 32; ++i) cnt += (keys[i * 64 + lane] >= cand) ? 1 : 0;
            for (int o = 32; o > 0; o >>= 1) cnt += __shfl_xor(cnt, o);
            if (cnt >= 256) thr = cand;
        }
        int ngt = 0;
        for (int i = 0; i < 32; ++i) ngt += (keys[i * 64 + lane] > thr) ? 1 : 0;
        for (int o = 32; o > 0; o >>= 1) ngt += __shfl_xor(ngt, o);
        const int need = 256 - ngt;
        int running = 0;
        const unsigned long long lt = (lane == 0) ? 0ull : (~0ull >> (64 - lane));
        for (int i = 0; i < 32; ++i) {
            const uint32_t key = keys[i * 64 + lane];
            const bool eq = key == thr;
            const unsigned long long be = __ballot(eq);
            const int rank = running + __popcll(be & lt);
            const bool sel = (key > thr) || (eq && rank < need);
            running += __popcll(be);
            const unsigned long long bs = __ballot(sel);
            if (lane == 0) { mrow[i * 2] = (uint32_t)bs; mrow[i * 2 + 1] = (uint32_t)(bs >> 32); }
        }
    }
}

struct AttnArgs {
    const float* q; const float* k; const float* v; int ldq, ldk, ldv;
    int hq_stride, hk_stride, hv_stride; int kv_div;
    const float* cum; const uint32_t* mask; const float* sinks;
    float* out; int out_off; float scale; int slope_base;
};
template <int VAR>
__device__ __forceinline__ void b_attn(const AttnArgs& a, int vb, int tid) {
    constexpr int DQ = (VAR == 1) ? 96 : 64;
    const int bx = vb % (S / 256), head = (vb / (S / 256)) & 3, b = vb / ((S / 256) * 4);
    const int t = bx * 256 + tid;
    const size_t tok = (size_t)b * S + t;
    const float* qp = a.q + tok * a.ldq + head * a.hq_stride;
    const float* kb = a.k + (size_t)b * S * a.ldk + (head / a.kv_div) * a.hk_stride;
    const float* vb_ = a.v + (size_t)b * S * a.ldv + (head / a.kv_div) * a.hv_stride;
    float q[DQ];
#pragma unroll
    for (int d = 0; d < DQ; ++d) q[d] = qp[d] * a.scale;
    float acc[64];
#pragma unroll
    for (int d = 0; d < 64; ++d) acc[d] = 0.f;
    float m = -INFINITY, l = 0.f;
    const float slope = (VAR >= 2) ? exp2f(-(float)(a.slope_base + head + 1)) : 0.f;
    const float ct = (VAR == 0) ? a.cum[((size_t)b * 4 + head) * S + t] : 0.f;
    const int s_lo = (VAR == 2) ? (t - 127 > 0 ? t - 127 : 0) : 0;
    for (int s = s_lo; s <= t; ++s) {
        if (VAR == 3) { const uint32_t w = a.mask[tok * 64 + (s >> 5)]; if (!((w >> (s & 31)) & 1u)) continue; }
        const float* kp = kb + (size_t)s * a.ldk;
        float dot = 0.f;
#pragma unroll
        for (int d = 0; d < DQ; d += 4) { const float4 kv = *(const float4*)(kp + d); dot += q[d] * kv.x + q[d + 1] * kv.y + q[d + 2] * kv.z + q[d + 3] * kv.w; }
        float logit = dot;
        if (VAR == 0) logit += ct - a.cum[((size_t)b * 4 + head) * S + s];
        if (VAR >= 2) logit -= slope * (float)(t - s);
        const float mn = fmaxf(m, logit), alpha = __expf(m - mn), pp = __expf(logit - mn);
        l = l * alpha + pp; m = mn;
        const float* vp = vb_ + (size_t)s * a.ldv;
#pragma unroll
        for (int d = 0; d < 64; d += 4) { const float4 vv = *(const float4*)(vp + d);
            acc[d] = acc[d] * alpha + pp * vv.x; acc[d + 1] = acc[d + 1] * alpha + pp * vv.y; acc[d + 2] = acc[d + 2] * alpha + pp * vv.z; acc[d + 3] = acc[d + 3] * alpha + pp * vv.w; }
    }
    if (VAR == 2) l += __expf(a.sinks[head] - m);
    const float inv = 1.f / l;
    float* op = a.out + tok * 1024 + a.out_off + head * 64;
#pragma unroll
    for (int d = 0; d < 64; d += 4) { float4 o; o.x = acc[d] * inv; o.y = acc[d + 1] * inv; o.z = acc[d + 2] * inv; o.w = acc[d + 3] * inv; *(float4*)(op + d) = o; }
}

__device__ __forceinline__ void b_route(const float* __restrict__ h, const float* __restrict__ wr, const float* __restrict__ br,
                                        int* __restrict__ cnt, int* __restrict__ list, float* __restrict__ rw, int vb, int tid, char* smem) {
    float (*sg)[17] = (float (*)[17])smem;
    const int tl = tid >> 4, e = tid & 15, tok = vb * 16 + tl;
    const float* hp = h + (size_t)tok * D;
    float acc = 0.f;
    for (int d = 0; d < D; ++d) acc += hp[d] * wr[d * 16 + e];
    sg[tl][e] = 1.f / (1.f + expf(-acc));
    __syncthreads();
    if (e == 0) {
        float sc[16], bi[16];
#pragma unroll
        for (int i = 0; i < 16; ++i) { sc[i] = sg[tl][i]; bi[i] = sc[i] + br[i]; }
        int bg = 0; float bgs = -INFINITY;
#pragma unroll
        for (int g = 0; g < 4; ++g) {
            float m1 = -INFINITY, m2 = -INFINITY;
#pragma unroll
            for (int j = 0; j < 4; ++j) { const float v = bi[g * 4 + j]; if (v > m1) { m2 = m1; m1 = v; } else if (v > m2) m2 = v; }
            const float gs = m1 + m2; if (gs > bgs) { bgs = gs; bg = g; }
        }
        float b4[4], s4[4];
#pragma unroll
        for (int g = 0; g < 4; ++g)
#pragma unroll
            for (int j = 0; j < 4; ++j) if (g == bg) { b4[j] = bi[g * 4 + j]; s4[j] = sc[g * 4 + j]; }
        int i1 = 0; float v1 = -INFINITY;
#pragma unroll
        for (int j = 0; j < 4; ++j) { if (b4[j] > v1) { v1 = b4[j]; i1 = j; } }
        int i2 = 0; float v2 = -INFINITY;
#pragma unroll
        for (int j = 0; j < 4; ++j) { if (j != i1 && b4[j] > v2) { v2 = b4[j]; i2 = j; } }
        float w1 = 0.f, w2 = 0.f;
#pragma unroll
        for (int j = 0; j < 4; ++j) { if (j == i1) w1 = s4[j]; if (j == i2) w2 = s4[j]; }
        const int e1 = bg * 4 + i1, e2 = bg * 4 + i2;
        const float ws = w1 + w2;
        const int s1 = atomicAdd(&cnt[e1], 1); list[(size_t)e1 * T + s1] = tok * 2 + 0; rw[tok * 2 + 0] = w1 / ws;
        const int s2 = atomicAdd(&cnt[e2], 1); list[(size_t)e2 * T + s2] = tok * 2 + 1; rw[tok * 2 + 1] = w2 / ws;
    }
}

__device__ __forceinline__ void b_moe(const float* __restrict__ h, const float* __restrict__ wg, const float* __restrict__ wu,
                                      const float* __restrict__ wd, const int* cnt, const int* list, const float* rw,
                                      float* __restrict__ ys, int chunk, int e, int tid, char* smem) {
    constexpr int TP = 8;
    float (*hs)[1024] = (float (*)[1024])smem;
    float (*hid)[256] = (float (*)[256])(smem + 32768);
    int* sl = (int*)(smem + 40960);
    const int c0 = chunk * TP, n = cnt[e];
    if (c0 >= n) return;
    if (tid < TP) sl[tid] = (c0 + tid < n) ? list[(size_t)e * T + c0 + tid] : -1;
    __syncthreads();
    for (int i = tid; i < TP * 1024; i += 256) { const int j = i >> 10, d = i & 1023; hs[j][d] = sl[j] >= 0 ? h[(size_t)(sl[j] >> 1) * D + d] : 0.f; }
    __syncthreads();
    {
        const float* g = wg + (size_t)e * 1024 * 256 + tid; const float* u = wu + (size_t)e * 1024 * 256 + tid;
        float ga[TP], ua[TP];
#pragma unroll
        for (int j = 0; j < TP; ++j) { ga[j] = 0.f; ua[j] = 0.f; }
        for (int d = 0; d < 1024; ++d) { const float a = g[(size_t)d * 256], bb = u[(size_t)d * 256];
#pragma unroll
            for (int j = 0; j < TP; ++j) { ga[j] += hs[j][d] * a; ua[j] += hs[j][d] * bb; } }
#pragma unroll
        for (int j = 0; j < TP; ++j) hid[j][tid] = ga[j] / (1.f + expf(-ga[j])) * ua[j];
    }
    __syncthreads();
    float acc[TP][4];
#pragma unroll
    for (int j = 0; j < TP; ++j)
#pragma unroll
        for (int i = 0; i < 4; ++i) acc[j][i] = 0.f;
    const float* dn = wd + (size_t)e * 256 * 1024;
    for (int k = 0; k < 256; ++k) {
        float w[4];
#pragma unroll
        for (int i = 0; i < 4; ++i) w[i] = dn[(size_t)k * 1024 + tid + 256 * i];
#pragma unroll
        for (int j = 0; j < TP; ++j)
#pragma unroll
            for (int i = 0; i < 4; ++i) acc[j][i] += hid[j][k] * w[i];
    }
#pragma unroll
    for (int j = 0; j < TP; ++j) if (sl[j] >= 0) { const float w = rw[sl[j]];
#pragma unroll
        for (int i = 0; i < 4; ++i) ys[(size_t)sl[j] * D + tid + 256 * i] = w * acc[j][i]; }
}

#define PHASE_LOOP(nvb) for (int vb = blockIdx.x; vb < (nvb); vb += gridDim.x)
#define END_BODY __syncthreads()

__global__ void __launch_bounds__(256, 1) fwd(Params p) {
    extern __shared__ __attribute__((aligned(16))) char smem_raw[];
    char* smem = smem_raw + 16;
    const int tid = threadIdx.x;
    if (tid == 0) *(uint4*)smem_raw = make_uint4(0u, 0u, 0u, 0u);
    __syncthreads();
    XcdBarrier bar = xcd_barrier_post(p.bar, (volatile LAS unsigned*)smem_raw);

    PHASE_LOOP(24 * NB * 2) { b_mod(p, vb, tid, smem); END_BODY; }
    xcd_barrier(bar);
    for (int l = 0; l < 2; ++l) {
        const float* modl = p.mod + (size_t)l * NB * NMOD;
        if (l == 0) { PHASE_LOOP(T) { b_norm<false, false>(p.x, p.xo, nullptr, nullptr, p.g_norm1, modl, modl + 1024, p.h, vb, tid, smem); END_BODY; } }
        else { PHASE_LOOP(T) { b_norm<true, false>(p.xo, p.xo, p.ys, p.mod + 5 * 1024, p.g_norm1 + D, modl, modl + 1024, p.h, vb, tid, smem); END_BODY; } }
        xcd_barrier(bar);
        for (int half = 0; half < 2; ++half) {
            const int b0 = half * NBH;
            const float* hh = p.h + (size_t)half * TH * D;
            { const int nx = (NIN + 63) / 64;
              PHASE_LOOP(nx * (TH / 64)) { b_gemm<0>(hh, D, p.w_in + (size_t)l * D * NIN, NIN, p.proj, NIN, NIN, D, nullptr, 0, vb % nx, vb / nx, tid, smem); END_BODY; } }
            xcd_barrier(bar);
            if (blockIdx.x == gridDim.x - 1) b_fox(p.proj, p.b_forget + l * 4, p.cum, tid);
            PHASE_LOOP(TH / 8) { b_mla(p.proj, p.g_q_mla + l * 256, p.w_q_up + (size_t)l * 256 * 384, p.g_kv_mla + l * 128, p.w_kv_up + (size_t)l * 128 * 512, p.qm, p.km, p.vm, vb, tid, smem); END_BODY; }
            PHASE_LOOP(TH / 4) { b_dsa_select(p.proj, p.mask, vb, tid, smem); END_BODY; }
            xcd_barrier(bar);
            {
                AttnArgs a;
                a.out = p.merged; a.cum = p.cum; a.mask = p.mask; a.sinks = p.sinks + l * 4;
                a.q = p.proj + OFF_AQ; a.k = p.proj + OFF_AK; a.v = p.proj + OFF_AV; a.ldq = a.ldk = a.ldv = NIN; a.hq_stride = a.hk_stride = a.hv_stride = 64; a.kv_div = 1;
                a.out_off = 0; a.scale = 0.125f; a.slope_base = 0;
                PHASE_LOOP((S / 256) * 4 * NBH) b_attn<0>(a, vb, tid);
                a.q = p.qm; a.k = p.km; a.v = p.vm; a.ldq = 384; a.ldk = 384; a.ldv = 256; a.hq_stride = 96; a.hk_stride = 96; a.hv_stride = 64; a.kv_div = 1;
                a.out_off = 256; a.scale = 0.10206207261596577f;
                PHASE_LOOP((S / 256) * 4 * NBH) b_attn<1>(a, vb, tid);
                a.q = p.proj + OFF_CQ; a.k = p.proj + OFF_CK; a.v = p.proj + OFF_CV; a.ldq = a.ldk = a.ldv = NIN; a.hq_stride = a.hk_stride = a.hv_stride = 64; a.kv_div = 2;
                a.out_off = 512; a.scale = 0.125f; a.slope_base = 0;
                PHASE_LOOP((S / 256) * 4 * NBH) b_attn<2>(a, vb, tid);
                a.q = p.proj + OFF_DQ; a.k = p.proj + OFF_DK; a.v = p.proj + OFF_DV; a.hq_stride = 64; a.hk_stride = 0; a.hv_stride = 0; a.kv_div = 1;
                a.out_off = 768; a.scale = 0.125f; a.slope_base = 4;
                PHASE_LOOP((S / 256) * 4 * NBH) b_attn<3>(a, vb, tid);
            }
            xcd_barrier(bar);
            PHASE_LOOP((D / 64) * (TH / 64)) { b_gemm<1>(p.merged, D, p.w_out + (size_t)l * D * D, D, p.xo + (size_t)half * TH * D, D, D, D, modl + 2 * 1024, b0, vb % (D / 64), vb / (D / 64), tid, smem); END_BODY; }
            xcd_barrier(bar);
        }
        PHASE_LOOP(T) { b_norm<false, false>(p.xo, p.xo, nullptr, nullptr, p.g_norm2 + l * D, modl + 3 * 1024, modl + 4 * 1024, p.h, vb, tid, smem); END_BODY; }
        xcd_barrier(bar);
        PHASE_LOOP(T / 16) { b_route(p.h, p.w_router, p.b_router, p.cnt + l * 16, p.list, p.rw, vb, tid, smem); END_BODY; }
        xcd_barrier(bar);
        PHASE_LOOP((T / 8) * 16) { b_moe(p.h, p.w_gate + (size_t)l * 16 * D * 256, p.w_up + (size_t)l * 16 * D * 256, p.w_down + (size_t)l * 16 * 256 * D,
                                         p.cnt + l * 16, p.list, p.rw, p.ys, vb % (T / 8), vb / (T / 8), tid, smem); END_BODY; }
        xcd_barrier(bar);
    }
    PHASE_LOOP(T) { b_norm<true, true>(p.xo, p.xo, p.ys, p.mod + (size_t)NB * NMOD + 5 * 1024, p.g_final, nullptr, nullptr, nullptr, vb, tid, smem); END_BODY; }
}
}

extern "C" void kernel_launch(void* const* d_in, const int* in_sizes, int n_in, void* d_out, int out_size, void* d_ws, size_t ws_size,
                              hipStream_t stream) {
    Params p{};
    p.x = (const float*)d_in[0]; p.c = (const float*)d_in[1]; p.w_ada = (const float*)d_in[2]; p.b_ada = (const float*)d_in[3];
    p.g_norm1 = (const float*)d_in[4]; p.w_in = (const float*)d_in[5]; p.b_forget = (const float*)d_in[6]; p.g_q_mla = (const float*)d_in[7];
    p.w_q_up = (const float*)d_in[8]; p.g_kv_mla = (const float*)d_in[9]; p.w_kv_up = (const float*)d_in[10]; p.sinks = (const float*)d_in[11];
    p.w_out = (const float*)d_in[12]; p.g_norm2 = (const float*)d_in[13]; p.w_router = (const float*)d_in[14]; p.b_router = (const float*)d_in[15];
    p.w_gate = (const float*)d_in[16]; p.w_up = (const float*)d_in[17]; p.w_down = (const float*)d_in[18]; p.g_final = (const float*)d_in[19];
    p.xo = (float*)d_out;
    char* ws = (char*)d_ws;
    size_t off = 0;
    auto carve = [&](size_t bytes) { char* q = ws + off; off += (bytes + 255) & ~(size_t)255; return q; };
    p.bar = (unsigned*)carve((size_t)XCD_BAR_WORDS * 4);
    p.cnt = (int*)carve(512);
    const size_t zero_bytes = off;
    p.mod = (float*)carve((size_t)2 * NB * NMOD * 4);
    p.h = (float*)carve((size_t)T * D * 4);
    const size_t region = off;
    p.proj = (float*)carve((size_t)TH * NIN * 4);
    p.qm = (float*)carve((size_t)TH * 384 * 4);
    p.km = (float*)carve((size_t)TH * 384 * 4);
    p.vm = (float*)carve((size_t)TH * 256 * 4);
    p.cum = (float*)carve((size_t)NBH * 4 * S * 4);
    p.mask = (uint32_t*)carve((size_t)TH * 64 * 4);
    p.merged = (float*)carve((size_t)TH * D * 4);
    const size_t end_mixer = off;
    off = region;
    p.ys = (float*)carve((size_t)T * 2 * D * 4);
    p.list = (int*)carve((size_t)16 * T * 4);
    p.rw = (float*)carve((size_t)T * 2 * 4);
    const size_t end_moe = off;
    if ((end_mixer > end_moe ? end_mixer : end_moe) > ws_size) return;

    static int grid = 0;
    if (!grid) {
        int dev = 0, cus = 0, per_cu = 0;
        (void)hipGetDevice(&dev);
        (void)hipDeviceGetAttribute(&cus, hipDeviceAttributeMultiprocessorCount, dev);
        (void)hipOccupancyMaxActiveBlocksPerMultiprocessor(&per_cu, fwd, 256, LDS_BYTES);
        if (cus <= 0) cus = 256;
        grid = cus;
    }
    (void)hipMemsetAsync(ws, 0, zero_bytes, stream);
    fwd<<<dim3(grid), dim3(256), LDS_BYTES, stream>>>(p);
}
```

```cpp
#define FAST_PREP 1
#define FAST_DSA 1
#define FAST_ATTN 15
#define ATTN_VMASK 15
#define FAST_MOE 1
#include <hip/hip_runtime.h>
#include <stdint.h>
#define LAS3 __attribute__((address_space(3)))
namespace {
typedef unsigned short bf16_t;
typedef short bf16x8 __attribute__((ext_vector_type(8)));
typedef short bf16x4 __attribute__((ext_vector_type(4)));
typedef float f32x4 __attribute__((ext_vector_type(4)));
typedef float f32x2 __attribute__((ext_vector_type(2)));
typedef unsigned u32x4 __attribute__((ext_vector_type(4)));
typedef unsigned u32x2 __attribute__((ext_vector_type(2)));

constexpr int D = 1024, NB = 32, S = 2048, T = NB * S, NIN = 2380, NP = 2560, NMOD = 6144;
constexpr int OFF_AQ = 0, OFF_AK = 256, OFF_AV = 512, OFF_AF = 768, OFF_BCQ = 772, OFF_BCKV = 1028, OFF_BKR = 1156,
              OFF_CQ = 1188, OFF_CK = 1444, OFF_CV = 1572, OFF_DQ = 1700, OFF_DK = 1956, OFF_DV = 2020,
              OFF_DQI = 2084, OFF_DKI = 2340, OFF_DWI = 2372;
constexpr int PC_AQ = 0, PC_AK = 256, PC_AV = 512, PC_BCQ = 768, PC_BCKV = 1024, PC_BKR = 1152, PC_CQ = 1184, PC_CK = 1440, PC_CV = 1568,
              PC_DQ = 1696, PC_DK = 1952, PC_DV = 2016, PC_DQI = 2080, PC_DKI = 2336, PC_DWI = 2368, PC_AF = 2376;
constexpr float EPS = 1e-6f;
constexpr float LOG2E = 1.4426950408889634f;
constexpr int ECAP = T;
constexpr int HIDROWS = 2 * T + 16 * 256;

__host__ __device__ __forceinline__ int orig_col(int n) { return n < 768 ? n : (n < 2376 ? n + 4 : (n < 2380 ? n - 1608 : -1)); }
__device__ __forceinline__ float bf2f(bf16_t v) { return __uint_as_float((unsigned)v << 16); }
__device__ __forceinline__ bf16_t f2bf(float f) { unsigned u = __float_as_uint(f); u += 0x7FFFu + ((u >> 16) & 1u); return (bf16_t)(u >> 16); }
typedef __bf16 bf16x2_native __attribute__((ext_vector_type(2)));
__device__ __forceinline__ unsigned cvt_pk_bf16(float lo, float hi) { const f32x2 v = {lo, hi}; return __builtin_bit_cast(unsigned, __builtin_convertvector(v, bf16x2_native)); }
__device__ __forceinline__ float bflo(unsigned w) { return __uint_as_float(w << 16); }
__device__ __forceinline__ float bfhi(unsigned w) { return __uint_as_float(w & 0xFFFF0000u); }
__device__ __forceinline__ float wave_sum(float v) {
#pragma unroll
    for (int o = 32; o > 0; o >>= 1) v += __shfl_xor(v, o);
    return v;
}
}

namespace pg8 {
#define PG8_LAS __attribute__((address_space(3)))
constexpr int BM = 256, BK = 64, HALF = 128, HTB = HALF * BK * 2, STAGE_BYTES = 8 * HTB, NXCD = 8, WGM = 8;

__host__ __device__ __forceinline__ int lds_byte(int r, int c) { const int st = (r >> 4) * 2 + (c >> 5), rr = r & 15, cc = c & 31, ob = rr * 64 + cc * 2; return st * 1024 + (ob ^ (((ob >> 9) & 1) << 5)); }
__host__ __device__ __forceinline__ void stage_rc(int b, int& R, int& C) { const int st = b / 1024, sb = b % 1024, swz = sb ^ (((sb >> 9) & 1) << 5); R = (st >> 1) * 16 + swz / 64; C = (st & 1) * 32 + (swz % 64) / 2; }
__host__ __device__ __forceinline__ int perm32(int rho) { const int n = rho >> 4, i = rho & 15; return 8 * (i >> 2) + 4 * n + (i & 3); }

struct Unit { int pm, pn, e, mt; };
struct Gemm { const bf16_t* A; const bf16_t* Bt; int K; int lda; size_t bstride; };

struct StaticOrder {
    int nM, nN, nwg, G, c;
    __host__ __device__ void init(int M, int N, int G_, int c_) { nM = M / BM; nN = N / BM; nwg = nM * nN; G = G_; c = c_; }
    __host__ __device__ bool next(int i, Unit& u) const {
        const long L = (long)i * G + c; if (L >= nwg) return false;
        int wgid = (int)L; { const int q = nwg / NXCD, r = nwg % NXCD, xcd = wgid % NXCD, off = wgid / NXCD; wgid = (xcd < r ? xcd * (q + 1) : r * (q + 1) + (xcd - r) * q) + off; }
        const int nig = WGM * nN, gid = wgid / nig, fm = gid * WGM, gsz = (nM - fm) < WGM ? (nM - fm) : WGM;
        u.pm = fm + ((wgid % nig) % gsz); u.pn = (wgid % nig) / gsz; u.e = 0; u.mt = 0; return true;
    }
    __device__ __forceinline__ int arow(const Unit& u, int r) const { return u.pm * BM + r; }
};

template <class Epi, class Sched, bool GATHER>
__device__ __forceinline__ void gemm_phase(PG8_LAS unsigned char* lds, const Gemm g, const Sched& S, const Epi& E) {
    const int tid = threadIdx.x, wid = __builtin_amdgcn_readfirstlane(tid >> 6), lane = tid & 63, wr = wid >> 2, wc = wid & 3, fr = lane & 15, fq = lane >> 4;
    const int K = g.K, nt = K / BK, lda = g.lda;
    int Ra[2], Ca[2]; unsigned voffB[2], voffA[2];
#pragma unroll
    for (int i = 0; i < 2; ++i) { int R, C; stage_rc(tid * 16 + i * 8192, R, C); const int Rb = Epi::PERM ? ((R & ~31) + perm32(R & 31)) : R;
        Ra[i] = R; Ca[i] = C; voffB[i] = (unsigned)(Rb * K + C) * 2u; voffA[i] = (unsigned)(R * lda + C) * 2u; }
    const size_t kstep = (size_t)(BK * 2);
    const size_t hstepB = (size_t)HALF * K * 2;
    const size_t tstepB = 2 * hstepB;
    const size_t hstepA = (size_t)HALF * lda * 2, tstepA = 2 * hstepA;
    const unsigned ldsw = (unsigned)wid * 1024u;
    const int aoff = lds_byte(wr * 64 + fr, fq * 8), boff = lds_byte(wc * 32 + fr, fq * 8);
#define PG8_SA(b, h) (((b) * 2 + (h)) * HTB)
#define PG8_SB(b, h) ((4 + (b) * 2 + (h)) * HTB)
#define PG8_STAGE(bufoff, gbase, voff) do { _Pragma("unroll") for (int _i = 0; _i < 2; ++_i) \
        __builtin_amdgcn_global_load_lds((const unsigned*)((const char*)(gbase) + (voff)[_i]), (PG8_LAS unsigned*)(lds + (bufoff) + ldsw + _i * 8192), 16, 0, 0); } while (0)
#define PG8_STAGEA(bufoff, kptr, VO, h) do { _Pragma("unroll") for (int _i = 0; _i < 2; ++_i) { \
        const char* _src; if constexpr (GATHER) _src = (const char*)(kptr) + (VO)[_i][h]; else _src = (const char*)(kptr) + (size_t)(h) * hstepA + voffA[_i]; \
        __builtin_amdgcn_global_load_lds((const unsigned*)_src, (PG8_LAS unsigned*)(lds + (bufoff) + ldsw + _i * 8192), 16, 0, 0); } } while (0)
#define PG8_LDA(dst, b, h) do { _Pragma("unroll") for (int m = 0; m < 4; ++m) _Pragma("unroll") for (int k = 0; k < 2; ++k) dst[m][k] = *(const PG8_LAS bf16x8*)(lds + PG8_SA(b, h) + aoff + m * 2048 + k * 1024); } while (0)
#define PG8_LDB(dst, b, h) do { _Pragma("unroll") for (int n = 0; n < 2; ++n) _Pragma("unroll") for (int k = 0; k < 2; ++k) dst[n][k] = *(const PG8_LAS bf16x8*)(lds + PG8_SB(b, h) + boff + n * 2048 + k * 1024); } while (0)
#define PG8_MMA(ai, bj, At, Bt) do { __builtin_amdgcn_s_setprio(1); _Pragma("unroll") for (int m = 0; m < 4; ++m) _Pragma("unroll") for (int n = 0; n < 2; ++n) _Pragma("unroll") for (int k = 0; k < 2; ++k) \
        acc[ai][bj][m][n] = __builtin_amdgcn_mfma_f32_16x16x32_bf16(Bt[n][k], At[m][k], acc[ai][bj][m][n], 0, 0, 0); __builtin_amdgcn_s_setprio(0); } while (0)
#define PG8_WAIT_V(n) asm volatile("s_waitcnt vmcnt(" #n ")" ::: "memory")
#define PG8_WAIT_L(n) asm volatile("s_waitcnt lgkmcnt(" #n ")" ::: "memory")
#define PG8_BAR __builtin_amdgcn_s_barrier()
#define PG8_SCHED __builtin_amdgcn_sched_barrier(0)
#define PG8_SETV(V, u) do { _Pragma("unroll") for (int _i = 0; _i < 2; ++_i) _Pragma("unroll") for (int _h = 0; _h < 2; ++_h) { \
        const int _row = GATHER ? S.arow(u, _h * HALF + Ra[_i]) : ((u).pm * BM + _h * HALF + Ra[_i]); V[_i][_h] = (unsigned)(((size_t)_row * lda + Ca[_i]) * 2); } } while (0)
    Unit cur, nxt; int ui = 0;
    if (!S.next(0, cur)) return;
    f32x4 acc[2][2][4][2];
#pragma unroll
    for (int a = 0; a < 2; ++a)
#pragma unroll
        for (int b = 0; b < 2; ++b)
#pragma unroll
            for (int m = 0; m < 4; ++m)
#pragma unroll
                for (int n = 0; n < 2; ++n) acc[a][b][m][n] = (f32x4){0.f, 0.f, 0.f, 0.f};
    bf16x8 At[4][2], B0[2][2], B1[2][2];
    unsigned vA[2][2], vN[2][2];
    if constexpr (GATHER) { PG8_SETV(vA, cur); }
    const char* cA = (const char*)g.A + (GATHER ? (size_t)0 : (size_t)cur.pm * tstepA);
    const char* cB = (const char*)g.Bt + ((size_t)cur.e * g.bstride) * 2 + (size_t)cur.pn * tstepB;
    PG8_STAGE(PG8_SB(0, 0), cB, voffB); PG8_STAGE(PG8_SB(0, 1), cB + hstepB, voffB); PG8_STAGEA(PG8_SA(0, 0), cA, vA, 0); PG8_STAGEA(PG8_SA(0, 1), cA, vA, 1);
    if (wr == 1) PG8_BAR;
    PG8_WAIT_V(2); PG8_BAR;
    PG8_STAGE(PG8_SB(1, 0), cB + kstep, voffB); PG8_STAGEA(PG8_SA(1, 0), cA + kstep, vA, 0); PG8_STAGE(PG8_SB(1, 1), cB + hstepB + kstep, voffB);
    PG8_WAIT_V(6); PG8_BAR;
    for (;;) {
        const bool has_next = S.next(ui + 1, nxt);
        if constexpr (GATHER) { if (has_next) { PG8_SETV(vN, nxt); }
        else {
#pragma unroll
            for (int _i = 0; _i < 2; ++_i)
#pragma unroll
                for (int _h = 0; _h < 2; ++_h) vN[_i][_h] = vA[_i][_h];
        } }
        const char* nA = (!GATHER && has_next) ? (const char*)g.A + (size_t)nxt.pm * tstepA : cA;
        const char* nB = has_next ? (const char*)g.Bt + ((size_t)nxt.e * g.bstride) * 2 + (size_t)nxt.pn * tstepB : cB;
        for (int t = 0; t < nt; t += 2) {
            const bool last = (t == nt - 2);
            const char* a1 = cA + (size_t)(t + 1) * kstep;
            const char* a2 = last ? nA : cA + (size_t)(t + 2) * kstep; const char* b2 = last ? nB : cB + (size_t)(t + 2) * kstep;
            const char* a3 = a2 + kstep; const char* b3 = b2 + kstep;
            unsigned v2[2][2];
            if constexpr (GATHER) {
#pragma unroll
            for (int _i = 0; _i < 2; ++_i)
#pragma unroll
                for (int _h = 0; _h < 2; ++_h) v2[_i][_h] = last ? vN[_i][_h] : vA[_i][_h];
            }
            PG8_LDB(B0, 0, 0); PG8_LDB(B1, 0, 1); PG8_SCHED; PG8_LDA(At, 0, 0); PG8_STAGEA(PG8_SA(1, 1), a1, vA, 1);
            PG8_WAIT_V(8); PG8_WAIT_L(0); PG8_BAR; PG8_MMA(0, 0, At, B0); PG8_MMA(0, 1, At, B1); PG8_BAR; PG8_SCHED;
            PG8_LDA(At, 0, 1); PG8_STAGE(PG8_SB(0, 0), b2, voffB); PG8_STAGE(PG8_SB(0, 1), b2 + hstepB, voffB); PG8_STAGEA(PG8_SA(0, 0), a2, v2, 0);
            PG8_WAIT_V(8); PG8_WAIT_L(0); PG8_BAR; PG8_MMA(1, 0, At, B0); PG8_MMA(1, 1, At, B1); PG8_BAR; PG8_SCHED;
            PG8_LDB(B0, 1, 0); PG8_LDB(B1, 1, 1); PG8_SCHED; PG8_LDA(At, 1, 0); PG8_STAGEA(PG8_SA(0, 1), a2, v2, 1);
            PG8_WAIT_V(8); PG8_WAIT_L(0); PG8_BAR; PG8_MMA(0, 0, At, B0); PG8_MMA(0, 1, At, B1); PG8_BAR; PG8_SCHED;
            PG8_LDA(At, 1, 1); PG8_STAGE(PG8_SB(1, 0), b3, voffB); PG8_STAGE(PG8_SB(1, 1), b3 + hstepB, voffB); PG8_STAGEA(PG8_SA(1, 0), a3, v2, 0);
            PG8_WAIT_V(8); PG8_WAIT_L(0); PG8_BAR; PG8_MMA(1, 0, At, B0); PG8_MMA(1, 1, At, B1); PG8_BAR; PG8_SCHED;
        }
        if (wr == 0) PG8_BAR;
        E(acc, cur, wr, wc, fr, fq);
        if (!has_next) break;
#pragma unroll
        for (int a = 0; a < 2; ++a)
#pragma unroll
            for (int b = 0; b < 2; ++b)
#pragma unroll
                for (int m = 0; m < 4; ++m)
#pragma unroll
                    for (int n = 0; n < 2; ++n) acc[a][b][m][n] = (f32x4){0.f, 0.f, 0.f, 0.f};
        cur = nxt; cB = nB; cA = nA; ++ui;
        if constexpr (GATHER) {
#pragma unroll
        for (int _i = 0; _i < 2; ++_i)
#pragma unroll
            for (int _h = 0; _h < 2; ++_h) vA[_i][_h] = vN[_i][_h];
        }
        if (wr == 1) PG8_BAR;
    }
    PG8_WAIT_V(0);
    PG8_BAR;
#undef PG8_SA
#undef PG8_SB
#undef PG8_STAGE
#undef PG8_STAGEA
#undef PG8_LDA
#undef PG8_LDB
#undef PG8_MMA
#undef PG8_WAIT_V
#undef PG8_WAIT_L
#undef PG8_BAR
#undef PG8_SCHED
#undef PG8_SETV
}
}

namespace {
struct Params {
    const float *x, *c, *w_ada, *b_ada, *g_norm1, *w_in, *b_forget, *g_q_mla, *w_q_up, *g_kv_mla, *w_kv_up, *sinks, *w_out, *g_norm2,
                *w_router, *b_router, *w_gate, *w_up, *w_down, *g_final;
    float* xo;
    unsigned* ctl;
    float* mod;
    bf16_t* WinT;
    bf16_t* WoutT;
    bf16_t* WqT;
    bf16_t* WkvT;
    bf16_t* WguT;
    bf16_t* WdT;
    float* ropetab;
    float* rq; float* rkv;
    float* cbF;
    uint32_t* mask;
    bf16_t* h;
    bf16_t* proj;
    bf16_t* qm; bf16_t* km; bf16_t* vm;
    bf16_t* merged;
    bf16_t* hid;
    bf16_t* ys;
    int* list;
    float* rw;
};
constexpr int CW_BAR = 0;
constexpr int CW_CNT = 3584;
constexpr int CW_QA = 3648;
constexpr int CW_QD = 3840;
constexpr int CW_WORDS = 4096;
}

namespace {
template <class F>
__device__ __forceinline__ void conv_job(bf16_t* __restrict__ dst, int nrows, int K, F f, int gtid, int gthreads) {
    const int k8n = K >> 3; const long items = (long)nrows * k8n;
    for (long it = gtid; it < items; it += gthreads) {
        const int n = (int)(it % nrows), k0 = (int)(it / nrows) * 8;
        float v[8];
#pragma unroll
        for (int j = 0; j < 8; ++j) v[j] = f(n, k0 + j);
        u32x4 w; w.x = cvt_pk_bf16(v[0], v[1]); w.y = cvt_pk_bf16(v[2], v[3]); w.z = cvt_pk_bf16(v[4], v[5]); w.w = cvt_pk_bf16(v[6], v[7]);
        *(u32x4*)(dst + (size_t)n * K + k0) = w;
    }
}
struct FWin { const float* w; __device__ float operator()(int n, int k) const { const int o = orig_col(n); return o >= 0 ? w[(size_t)k * NIN + o] : 0.f; } };
struct FT { const float* w; int ld; __device__ float operator()(int n, int k) const { return w[(size_t)k * ld + n]; } };
struct FTg { const float* w; const float* g; int ld, nmax; __device__ float operator()(int n, int k) const { return n < nmax ? g[k] * w[(size_t)k * ld + n] : 0.f; } };
struct FGu { const float* wg; long du; __device__ float operator()(int n, int k) const { const int q = n >> 5, r = n & 31, col = 16 * q + (r & 15); const long sel = (r < 16) ? 0l : du; return wg[sel + (long)k * 256 + col]; } };

__device__ __forceinline__ void phase_p0(const Params& p, char* lds) {
    const int tid = threadIdx.x, gtid = blockIdx.x * blockDim.x + tid, gthreads = gridDim.x * blockDim.x;
    for (int l = 0; l < 2; ++l) {
        conv_job(p.WinT + (size_t)l * NP * D, NP, D, FWin{p.w_in + (size_t)l * D * NIN}, gtid, gthreads);
        conv_job(p.WoutT + (size_t)l * D * D, D, D, FT{p.w_out + (size_t)l * D * D, D}, gtid, gthreads);
        conv_job(p.WqT + (size_t)l * 512 * 256, 512, 256, FTg{p.w_q_up + (size_t)l * 256 * 384, p.g_q_mla + l * 256, 384, 384}, gtid, gthreads);
        conv_job(p.WkvT + (size_t)l * 512 * 128, 512, 128, FTg{p.w_kv_up + (size_t)l * 128 * 512, p.g_kv_mla + l * 128, 512, 512}, gtid, gthreads);
        for (int e = 0; e < 16; ++e) {
            const size_t le = (size_t)l * 16 + e;
            conv_job(p.WguT + le * 512 * 1024, 512, 1024, FGu{p.w_gate + le * 1024 * 256, (long)(p.w_up - p.w_gate)}, gtid, gthreads);
            conv_job(p.WdT + le * 1024 * 256, 1024, 256, FT{p.w_down + le * 256 * 1024, 1024}, gtid, gthreads);
        }
    }
    for (int it = gtid; it < 2048 * 16; it += gthreads) {
        const int pos = it >> 4, i = it & 15;
        const float inv = powf(10000.0f, -(float)i / 16.0f), ang = (float)pos * inv;
        p.ropetab[it * 2] = cosf(ang); p.ropetab[it * 2 + 1] = sinf(ang);
    }
    float* ca = (float*)lds;
    for (int i = tid; i < NB * 1024; i += 512) { const float v = p.c[i]; ca[i] = v / (1.f + __expf(-v)); }
    __syncthreads();
    for (int u = blockIdx.x; u < 2 * (NMOD / 128); u += gridDim.x) {
        const int l = u / (NMOD / 128), n = (u % (NMOD / 128)) * 128 + (tid & 127), bg = tid >> 7;
        const float* w = p.w_ada + (size_t)l * 1024 * NMOD + n;
        float acc[8];
#pragma unroll
        for (int j = 0; j < 8; ++j) acc[j] = 0.f;
        for (int d = 0; d < 1024; ++d) { const float wv = w[(size_t)d * NMOD];
#pragma unroll
            for (int j = 0; j < 8; ++j) acc[j] += ca[(bg * 8 + j) * 1024 + d] * wv; }
        const float bias = p.b_ada[l * NMOD + n];
#pragma unroll
        for (int j = 0; j < 8; ++j) p.mod[((size_t)l * NB + bg * 8 + j) * NMOD + n] = acc[j] + bias;
    }
    __syncthreads();
}

template <int MODE>
__device__ __forceinline__ void phase_norm1(const Params& p, int l) {
    const int tid = threadIdx.x, w = tid >> 6, lane = tid & 63;
    const float* xin = (MODE == 0) ? p.x : p.xo;
    const float* g = (MODE == 2) ? p.g_final : p.g_norm1 + l * D;
    const float* modl = p.mod + (size_t)(MODE == 2 ? 1 : l) * NB * NMOD;
    const float* modp = p.mod + (size_t)(MODE == 2 ? 1 : (l > 0 ? l - 1 : 0)) * NB * NMOD;
    for (int t = blockIdx.x * 8 + w; t < T; t += gridDim.x * 8) {
        const int b = t >> 11;
        f32x4 v[4];
#pragma unroll
        for (int k = 0; k < 4; ++k) v[k] = *(const f32x4*)(xin + (size_t)t * D + 4 * lane + 256 * k);
        if (MODE >= 1) {
#pragma unroll
            for (int k = 0; k < 4; ++k) {
                const int col = 4 * lane + 256 * k;
                const u32x2 y0 = *(const u32x2*)(p.ys + ((size_t)t * 2 + 0) * D + col), y1 = *(const u32x2*)(p.ys + ((size_t)t * 2 + 1) * D + col);
                const f32x4 gt = *(const f32x4*)(modp + (size_t)b * NMOD + 5 * 1024 + col);
                v[k][0] += gt[0] * (bflo(y0.x) + bflo(y1.x)); v[k][1] += gt[1] * (bfhi(y0.x) + bfhi(y1.x));
                v[k][2] += gt[2] * (bflo(y0.y) + bflo(y1.y)); v[k][3] += gt[3] * (bfhi(y0.y) + bfhi(y1.y));
            }
        }
        float ss = 0.f;
#pragma unroll
        for (int k = 0; k < 4; ++k) ss += v[k][0] * v[k][0] + v[k][1] * v[k][1] + v[k][2] * v[k][2] + v[k][3] * v[k][3];
        ss = wave_sum(ss);
        const float r = rsqrtf(ss * (1.0f / D) + EPS);
#pragma unroll
        for (int k = 0; k < 4; ++k) {
            const int col = 4 * lane + 256 * k;
            const f32x4 gg = *(const f32x4*)(g + col);
            f32x4 y = v[k] * r * gg;
            if (MODE == 2) { *(f32x4*)(p.xo + (size_t)t * D + col) = y; }
            else {
                if (MODE == 0 || MODE == 1) *(f32x4*)(p.xo + (size_t)t * D + col) = v[k];
                const f32x4 sc = *(const f32x4*)(modl + (size_t)b * NMOD + 1024 + col), sh = *(const f32x4*)(modl + (size_t)b * NMOD + col);
                y = y * (1.f + sc) + sh;
                u32x2 o; o.x = cvt_pk_bf16(y[0], y[1]); o.y = cvt_pk_bf16(y[2], y[3]);
                *(u32x2*)(p.h + (size_t)t * D + col) = o;
            }
        }
    }
}
}

namespace {
using pg8::Unit;
struct EpiStoreBf16 {
    static constexpr bool PERM = true;
    bf16_t* O; int ldc;
    __device__ __forceinline__ void operator()(const f32x4 (&acc)[2][2][4][2], const Unit& u, int wr, int wc, int fr_, int fq_) const {
        int fr = fr_, fq = fq_; asm volatile("" : "+v"(fr), "+v"(fq));
        const int row0 = u.pm * 256 + wr * 64 + fr, col0 = u.pn * 256 + wc * 32 + 8 * fq;
#pragma unroll
        for (int ai = 0; ai < 2; ++ai)
#pragma unroll
            for (int m = 0; m < 4; ++m) { bf16_t* rowp = O + (size_t)(row0 + ai * 128 + m * 16) * ldc + col0;
#pragma unroll
                for (int bj = 0; bj < 2; ++bj) { const f32x4 v0 = acc[ai][bj][m][0], v1 = acc[ai][bj][m][1];
                    u32x4 w; w.x = cvt_pk_bf16(v0[0], v0[1]); w.y = cvt_pk_bf16(v0[2], v0[3]); w.z = cvt_pk_bf16(v1[0], v1[1]); w.w = cvt_pk_bf16(v1[2], v1[3]);
                    *(u32x4*)(rowp + bj * 128) = w; } }
    }
};
struct EpiResidual {
    static constexpr bool PERM = false;
    float* x; const float* gate;
    __device__ __forceinline__ void operator()(const f32x4 (&acc)[2][2][4][2], const Unit& u, int wr, int wc, int fr_, int fq_) const {
        int fr = fr_, fq = fq_; asm volatile("" : "+v"(fr), "+v"(fq));
        const int row0 = u.pm * 256 + wr * 64 + fr, col0 = u.pn * 256 + wc * 32 + 4 * fq;
        const int b = (u.pm * 256) >> 11;
        f32x4 gv[2][2];
#pragma unroll
        for (int bj = 0; bj < 2; ++bj)
#pragma unroll
            for (int n = 0; n < 2; ++n) gv[bj][n] = *(const f32x4*)(gate + (size_t)b * NMOD + col0 + bj * 128 + n * 16);
#pragma unroll
        for (int ai = 0; ai < 2; ++ai)
#pragma unroll
            for (int m = 0; m < 4; ++m) { float* rowp = x + (size_t)(row0 + ai * 128 + m * 16) * D + col0;
#pragma unroll
                for (int bj = 0; bj < 2; ++bj)
#pragma unroll
                    for (int n = 0; n < 2; ++n) { f32x4* q = (f32x4*)(rowp + bj * 128 + n * 16); *q = *q + gv[bj][n] * acc[ai][bj][m][n]; } }
    }
};
struct EpiMlaQ {
    static constexpr bool PERM = false;
    bf16_t* qm; const float* rq; const float* ropetab;
    __device__ __forceinline__ void operator()(const f32x4 (&acc)[2][2][4][2], const Unit& u, int wr, int wc, int fr_, int fq_) const {
        int fr = fr_, fq = fq_; asm volatile("" : "+v"(fr), "+v"(fq));
        const int row0 = u.pm * 256 + wr * 64 + fr;
#pragma unroll
        for (int bj = 0; bj < 2; ++bj) {
            const int base32 = u.pn * 256 + bj * 128 + wc * 32;
            if (base32 >= 384) continue;
            const bool rot = (base32 % 96) == 64;
#pragma unroll
            for (int ai = 0; ai < 2; ++ai)
#pragma unroll
                for (int m = 0; m < 4; ++m) {
                    const int row = row0 + ai * 128 + m * 16; const float r = rq[row];
                    f32x4 a0 = acc[ai][bj][m][0] * r, a1 = acc[ai][bj][m][1] * r;
                    if (rot) {
                        const int pos = row & (S - 1);
                        const f32x4 cs0 = *(const f32x4*)(ropetab + (size_t)(pos * 16 + 4 * fq) * 2), cs1 = *(const f32x4*)(ropetab + (size_t)(pos * 16 + 4 * fq) * 2 + 4);
                        const float c[4] = {cs0[0], cs0[2], cs1[0], cs1[2]}, s[4] = {cs0[1], cs0[3], cs1[1], cs1[3]};
                        f32x4 o0, o1;
#pragma unroll
                        for (int j = 0; j < 4; ++j) { o0[j] = a0[j] * c[j] - a1[j] * s[j]; o1[j] = a1[j] * c[j] + a0[j] * s[j]; }
                        a0 = o0; a1 = o1;
                    }
                    bf16_t* q = qm + (size_t)row * 384 + base32 + 4 * fq;
                    u32x2 w0, w1; w0.x = cvt_pk_bf16(a0[0], a0[1]); w0.y = cvt_pk_bf16(a0[2], a0[3]); w1.x = cvt_pk_bf16(a1[0], a1[1]); w1.y = cvt_pk_bf16(a1[2], a1[3]);
                    *(u32x2*)q = w0; *(u32x2*)(q + 16) = w1;
                    asm volatile("" ::: "memory");
                }
        }
    }
};
struct EpiMlaKV {
    static constexpr bool PERM = true;
    bf16_t* km; bf16_t* vm; const float* rkv;
    __device__ __forceinline__ void operator()(const f32x4 (&acc)[2][2][4][2], const Unit& u, int wr, int wc, int fr_, int fq_) const {
        int fr = fr_, fq = fq_; asm volatile("" : "+v"(fr), "+v"(fq));
        const int row0 = u.pm * 256 + wr * 64 + fr;
#pragma unroll
        for (int bj = 0; bj < 2; ++bj) {
            const int head = u.pn * 2 + bj, wcol = wc * 32 + 8 * fq;
#pragma unroll
            for (int ai = 0; ai < 2; ++ai)
#pragma unroll
                for (int m = 0; m < 4; ++m) {
                    const int row = row0 + ai * 128 + m * 16; const float r = rkv[row];
                    const f32x4 v0 = acc[ai][bj][m][0] * r, v1 = acc[ai][bj][m][1] * r;
                    u32x4 w; w.x = cvt_pk_bf16(v0[0], v0[1]); w.y = cvt_pk_bf16(v0[2], v0[3]); w.z = cvt_pk_bf16(v1[0], v1[1]); w.w = cvt_pk_bf16(v1[2], v1[3]);
                    bf16_t* q = (wcol < 64) ? km + (size_t)row * 384 + head * 96 + wcol : vm + (size_t)row * 256 + head * 64 + (wcol - 64);
                    *(u32x4*)q = w;
                    asm volatile("" ::: "memory");
                }
        }
    }
};
struct EpiGateUp {
    static constexpr bool PERM = false;
    bf16_t* hid;
    __device__ __forceinline__ void operator()(const f32x4 (&acc)[2][2][4][2], const Unit& u, int wr, int wc, int fr_, int fq_) const {
        int fr = fr_, fq = fq_; asm volatile("" : "+v"(fr), "+v"(fq));
        const int row0 = u.pm * 256 + wr * 64 + fr;
#pragma unroll
        for (int ai = 0; ai < 2; ++ai)
#pragma unroll
            for (int m = 0; m < 4; ++m) { bf16_t* rowp = hid + (size_t)(row0 + ai * 128 + m * 16) * 256;
#pragma unroll
                for (int bj = 0; bj < 2; ++bj) { const f32x4 gt = acc[ai][bj][m][0], up = acc[ai][bj][m][1];
                    f32x4 o;
#pragma unroll
                    for (int j = 0; j < 4; ++j) o[j] = gt[j] / (1.f + __expf(-gt[j])) * up[j];
                    u32x2 w; w.x = cvt_pk_bf16(o[0], o[1]); w.y = cvt_pk_bf16(o[2], o[3]);
                    *(u32x2*)(rowp + 16 * (u.pn * 8 + bj * 4 + wc) + 4 * fq) = w; } }
    }
};
struct EpiDown {
    static constexpr bool PERM = true;
    bf16_t* ys; const int* list; const float* rw; const int* cnt;
    __device__ __forceinline__ void operator()(const f32x4 (&acc)[2][2][4][2], const Unit& u, int wr, int wc, int fr_, int fq_) const {
        int fr = fr_, fq = fq_; asm volatile("" : "+v"(fr), "+v"(fq));
        const int n = cnt[u.e]; const int* le = list + (size_t)u.e * ECAP;
        const int col0 = u.pn * 256 + wc * 32 + 8 * fq;
#pragma unroll
        for (int ai = 0; ai < 2; ++ai)
#pragma unroll
            for (int m = 0; m < 4; ++m) {
                const int lr = u.mt * 256 + ai * 128 + wr * 64 + m * 16 + fr;
                if (lr < n) {
                    const int slot = le[lr]; const float w8 = rw[slot];
                    bf16_t* rowp = ys + (size_t)slot * D + col0;
#pragma unroll
                    for (int bj = 0; bj < 2; ++bj) { const f32x4 v0 = acc[ai][bj][m][0] * w8, v1 = acc[ai][bj][m][1] * w8;
                        u32x4 w; w.x = cvt_pk_bf16(v0[0], v0[1]); w.y = cvt_pk_bf16(v0[2], v0[3]); w.z = cvt_pk_bf16(v1[0], v1[1]); w.w = cvt_pk_bf16(v1[2], v1[3]);
                        *(u32x4*)(rowp + bj * 128) = w; }
                }
            }
    }
};
struct MoeOrder {
    int pre[17];
    int NT, G, c; const int* list; const int* cnt;
    __device__ __forceinline__ void init(const int* cnt_, const int* list_, int NT_, int G_, int c_) {
        cnt = cnt_; list = list_; NT = NT_; G = G_; c = c_; int a = 0;
#pragma unroll
        for (int e = 0; e < 16; ++e) { pre[e] = a; a += (cnt_[e] + 255) >> 8; }
        pre[16] = a;
    }
    __device__ __forceinline__ bool next(int i, Unit& u) const {
        const int L = i * G + c; if (L >= pre[16] * NT) return false;
        const int t = L / NT; int e = 0;
#pragma unroll
        for (int k = 1; k < 16; ++k) e += (t >= pre[k]) ? 1 : 0;
        int pe = 0;
#pragma unroll
        for (int k = 0; k < 16; ++k) pe = (k == e) ? pre[k] : pe;
        u.e = e; u.mt = t - pe; u.pm = t; u.pn = L - t * NT; return true;
    }
    __device__ __forceinline__ int arow(const Unit& u, int r) const { const int lr = u.mt * 256 + r; return lr < cnt[u.e] ? (list[(size_t)u.e * ECAP + lr] >> 1) : 0; }
};
}

namespace {
__device__ __forceinline__ void phase_prep(const Params& p, int l) {
    const int tid = threadIdx.x, w = tid >> 6, lane = tid & 63;
    const int gw = blockIdx.x * 8 + w, nw = gridDim.x * 8;
    for (int sq = gw; sq < NB * 4; sq += nw) {
        const int b = sq >> 2, hh = sq & 3; const float bias = p.b_forget[l * 4 + hh];
        float lf[32]; float run = 0.f;
#pragma unroll
        for (int j = 0; j < 32; ++j) {
            const float z = bf2f(p.proj[(size_t)(b * S + lane * 32 + j) * NP + PC_AF + hh]) + bias;
            run += fminf(z, 0.f) - log1pf(__expf(-fabsf(z)));
            lf[j] = run;
        }
        float incl = run;
#pragma unroll
        for (int o = 1; o < 64; o <<= 1) { const float t2 = __shfl_up(incl, o); if (lane >= o) incl += t2; }
        const float excl = incl - run;
#pragma unroll
        for (int j = 0; j < 32; ++j) p.cbF[(size_t)sq * S + lane * 32 + j] = -(excl + lf[j]) * LOG2E;
    }
    for (int t = gw; t < T; t += nw) {
        const bf16_t* row = p.proj + (size_t)t * NP;
        const u32x2 cq = *(const u32x2*)(row + PC_BCQ + 4 * lane);
        const unsigned ck = *(const unsigned*)(row + PC_BCKV + 2 * lane);
        float s1 = bflo(cq.x) * bflo(cq.x) + bfhi(cq.x) * bfhi(cq.x) + bflo(cq.y) * bflo(cq.y) + bfhi(cq.y) * bfhi(cq.y);
        float s2 = bflo(ck) * bflo(ck) + bfhi(ck) * bfhi(ck);
        s1 = wave_sum(s1); s2 = wave_sum(s2);
        const float kr = (lane < 32) ? bf2f(row[PC_BKR + lane]) : 0.f;
        const float kr2 = __shfl(kr, (lane + 16) & 63);
        if (lane == 0) { p.rq[t] = rsqrtf(s1 * (1.f / 256.f) + EPS); p.rkv[t] = rsqrtf(s2 * (1.f / 128.f) + EPS); }
        if (lane < 16) {
            const int pos = t & (S - 1);
            const float cs = p.ropetab[(pos * 16 + lane) * 2], sn = p.ropetab[(pos * 16 + lane) * 2 + 1];
            const bf16_t o1 = f2bf(kr * cs - kr2 * sn), o2 = f2bf(kr2 * cs + kr * sn);
            bf16_t* kmr = p.km + (size_t)t * 384;
#pragma unroll
            for (int hh = 0; hh < 4; ++hh) { kmr[hh * 96 + 64 + lane] = o1; kmr[hh * 96 + 80 + lane] = o2; }
        }
    }
}

__device__ __forceinline__ void phase_route(const Params& p, int l, char* lds) {
    const int tid = threadIdx.x, w = tid >> 6, lane = tid & 63;
    float* wrT = (float*)lds;
    for (int i = tid; i < 16 * 1024; i += 512) { const int e = i >> 10, d = i & 1023; wrT[i] = p.w_router[d * 16 + e]; }
    __syncthreads();
    const float* g = p.g_norm2 + l * D;
    const float* modl = p.mod + (size_t)l * NB * NMOD;
    int* cnt = (int*)(p.ctl + CW_CNT) + l * 16;
    for (int t = blockIdx.x * 8 + w; t < T; t += gridDim.x * 8) {
        const int b = t >> 11;
        f32x4 v[4];
#pragma unroll
        for (int k = 0; k < 4; ++k) v[k] = *(const f32x4*)(p.xo + (size_t)t * D + 4 * lane + 256 * k);
        float ss = 0.f;
#pragma unroll
        for (int k = 0; k < 4; ++k) ss += v[k][0] * v[k][0] + v[k][1] * v[k][1] + v[k][2] * v[k][2] + v[k][3] * v[k][3];
        ss = wave_sum(ss);
        const float r = rsqrtf(ss * (1.0f / D) + EPS);
        float lg[16];
#pragma unroll
        for (int e = 0; e < 16; ++e) lg[e] = 0.f;
#pragma unroll
        for (int k = 0; k < 4; ++k) {
            const int col = 4 * lane + 256 * k;
            const f32x4 gg = *(const f32x4*)(g + col);
            const f32x4 sc = *(const f32x4*)(modl + (size_t)b * NMOD + 4 * 1024 + col), sh = *(const f32x4*)(modl + (size_t)b * NMOD + 3 * 1024 + col);
            const f32x4 y = v[k] * r * gg * (1.f + sc) + sh;
            u32x2 o; o.x = cvt_pk_bf16(y[0], y[1]); o.y = cvt_pk_bf16(y[2], y[3]);
            *(u32x2*)(p.h + (size_t)t * D + col) = o;
#pragma unroll
            for (int e = 0; e < 16; ++e) { const f32x4 wv = *(const f32x4*)(wrT + e * 1024 + col); lg[e] += y[0] * wv[0] + y[1] * wv[1] + y[2] * wv[2] + y[3] * wv[3]; }
            asm volatile("" ::: "memory");
        }
#pragma unroll
        for (int e = 0; e < 16; ++e) lg[e] = wave_sum(lg[e]);
        if (lane == 0) {
            float sc[16], bi[16];
#pragma unroll
            for (int e = 0; e < 16; ++e) { sc[e] = 1.f / (1.f + expf(-lg[e])); bi[e] = sc[e] + p.b_router[e]; }
            int bg = 0; float bgs = -INFINITY;
#pragma unroll
            for (int gi = 0; gi < 4; ++gi) {
                float m1 = -INFINITY, m2 = -INFINITY;
#pragma unroll
                for (int j = 0; j < 4; ++j) { const float vv = bi[gi * 4 + j]; if (vv > m1) { m2 = m1; m1 = vv; } else if (vv > m2) m2 = vv; }
                const float gs = m1 + m2; if (gs > bgs) { bgs = gs; bg = gi; }
            }
            float b4[4], s4[4];
#pragma unroll
            for (int gi = 0; gi < 4; ++gi)
#pragma unroll
                for (int j = 0; j < 4; ++j) if (gi == bg) { b4[j] = bi[gi * 4 + j]; s4[j] = sc[gi * 4 + j]; }
            int i1 = 0; float v1 = -INFINITY;
#pragma unroll
            for (int j = 0; j < 4; ++j) { if (b4[j] > v1) { v1 = b4[j]; i1 = j; } }
            int i2 = 0; float v2 = -INFINITY;
#pragma unroll
            for (int j = 0; j < 4; ++j) { if (j != i1 && b4[j] > v2) { v2 = b4[j]; i2 = j; } }
            float w1 = 0.f, w2 = 0.f;
#pragma unroll
            for (int j = 0; j < 4; ++j) { if (j == i1) w1 = s4[j]; if (j == i2) w2 = s4[j]; }
            const int e1 = bg * 4 + i1, e2 = bg * 4 + i2; const float ws = w1 + w2;
            const int s1 = atomicAdd(&cnt[e1], 1); p.list[(size_t)e1 * ECAP + s1] = t * 2 + 0; p.rw[t * 2 + 0] = w1 / ws;
            const int s2 = atomicAdd(&cnt[e2], 1); p.list[(size_t)e2 * ECAP + s2] = t * 2 + 1; p.rw[t * 2 + 1] = w2 / ws;
        }
    }
    __syncthreads();
}
}

namespace {
constexpr int AT_KB = 0;
constexpr int AT_KR = 16384;
constexpr int AT_VB = 24576;
constexpr int AT_CB = 40960;
constexpr int AT_CTL = 41472;
constexpr int AT_LDS = 41984;
constexpr float NEGBIG = -1.0e30f;

template <int VAR>
__device__ __forceinline__ void attn_unit(const Params& p, int l, int b, int hx, int qb, LAS3 char* lds) {
    typedef LAS3 bf16x4 lds_bf16x4;
    constexpr int KC = (VAR == 1) ? 3 : 2;
    const int tid = threadIdx.x, w = __builtin_amdgcn_readfirstlane(tid >> 6), lane = tid & 63, i = lane & 15, g = lane >> 4;
    const bf16_t *Qp, *Kp, *Vp; int ldq, ldk, ldv, q0, j0, j1, ocol; float c1, slope2 = 0.f;
    if (VAR == 0) { Qp = p.proj + PC_AQ + hx * 64; Kp = p.proj + PC_AK + hx * 64; Vp = p.proj + PC_AV + hx * 64; ldq = ldk = ldv = NP;
                    q0 = qb * 256 + 32 * w; j0 = 0; j1 = 4 * qb + 3; ocol = hx * 64; c1 = 0.125f * LOG2E; }
    else if (VAR == 1) { Qp = p.qm + hx * 96; Kp = p.km + hx * 96; Vp = p.vm + hx * 64; ldq = 384; ldk = 384; ldv = 256;
                    q0 = qb * 256 + 32 * w; j0 = 0; j1 = 4 * qb + 3; ocol = 256 + hx * 64; c1 = 0.10206207261596577f * LOG2E; }
    else if (VAR == 2) { const int qh = hx * 2 + (w >> 2); Qp = p.proj + PC_CQ + qh * 64; Kp = p.proj + PC_CK + hx * 64; Vp = p.proj + PC_CV + hx * 64; ldq = ldk = ldv = NP;
                    q0 = qb * 128 + 32 * (w & 3); j0 = 2 * qb - 2 > 0 ? 2 * qb - 2 : 0; j1 = 2 * qb + 1; ocol = 512 + qh * 64; c1 = 0.125f * LOG2E;
                    slope2 = exp2f(-(float)(qh + 1)) * LOG2E; }
    else { const int hd = w >> 1; Qp = p.proj + PC_DQ + hd * 64; Kp = p.proj + PC_DK; Vp = p.proj + PC_DV; ldq = ldk = ldv = NP;
                    q0 = qb * 64 + 32 * (w & 1); j0 = 0; j1 = qb; ocol = 768 + hd * 64; c1 = 0.125f * LOG2E; slope2 = exp2f(-(float)(hd + 5)) * LOG2E; }
    const size_t tok0 = (size_t)b * S;
    bf16x8 qf[2][KC];
#pragma unroll
    for (int qt = 0; qt < 2; ++qt)
#pragma unroll
        for (int kc = 0; kc < KC; ++kc) qf[qt][kc] = *(const bf16x8*)(Qp + (tok0 + q0 + 16 * qt + i) * ldq + kc * 32 + 8 * g);
    f32x4 o[2][4];
#pragma unroll
    for (int qt = 0; qt < 2; ++qt)
#pragma unroll
        for (int dt = 0; dt < 4; ++dt) o[qt][dt] = (f32x4){0.f, 0.f, 0.f, 0.f};
    float mrow[2] = {NEGBIG, NEGBIG}, lsum[2] = {0.f, 0.f};
    const int sr = tid >> 3, sc8 = tid & 7;
    const int kdst = sr * 128 + ((sc8 ^ ((sr >> 1) & 7)) << 4);
    const int vdst = sr * 128 + (((((sc8 >> 1) ^ ((sr >> 1) & 3)) << 1) | (sc8 & 1)) << 4);
    const int rr = (tid & 255) >> 2, rc4 = tid & 3;
    const int rdst = rr * 64 + ((rc4 ^ ((rr >> 1) & 3)) << 4);
    u32x4 kst, vst, rst = {0u, 0u, 0u, 0u}; float cst = 0.f;
    u32x2 mw[2] = {{0u, 0u}, {0u, 0u}}, mwn[2] = {{0u, 0u}, {0u, 0u}};
#define AT_LOAD(j) do { const size_t _kr = tok0 + 64 * (j) + sr; \
        kst = *(const u32x4*)(Kp + _kr * ldk + sc8 * 8); vst = *(const u32x4*)(Vp + _kr * ldv + sc8 * 8); \
        if (VAR == 1 && tid < 256) rst = *(const u32x4*)(Kp + (tok0 + 64 * (j) + rr) * ldk + 64 + rc4 * 8); \
        if (VAR == 0 && tid < 64) cst = p.cbF[((size_t)b * 4 + hx) * S + 64 * (j) + tid]; \
        if (VAR == 3) { _Pragma("unroll") for (int _q = 0; _q < 2; ++_q) mwn[_q] = *(const u32x2*)(p.mask + (tok0 + q0 + 16 * _q + i) * 64 + 2 * (j)); } } while (0)
#define AT_WRITE(buf) do { *(LAS3 u32x4*)(lds + AT_KB + (buf) * 8192 + kdst) = kst; *(LAS3 u32x4*)(lds + AT_VB + (buf) * 8192 + vdst) = vst; \
        if (VAR == 1 && tid < 256) *(LAS3 u32x4*)(lds + AT_KR + (buf) * 4096 + rdst) = rst; \
        if (VAR == 0 && tid < 64) *(LAS3 float*)(lds + AT_CB + (buf) * 256 + tid * 4) = cst; } while (0)
    AT_LOAD(j0);
    AT_WRITE(j0 & 1);
    if (VAR == 3) { mw[0] = mwn[0]; mw[1] = mwn[1]; }
    __syncthreads();
    const int swk = (i >> 1) & 7;
    for (int j = j0; j <= j1; ++j) {
        const int buf = j & 1;
        if (j < j1) AT_LOAD(j + 1);
        bool need = (64 * j <= q0 + 31);
        if (VAR == 2) need = need && (64 * j + 63 >= q0 - 127);
        if (need) {
            const LAS3 char* Kb = lds + AT_KB + buf * 8192; const LAS3 char* Vb = lds + AT_VB + buf * 8192;
            f32x4 s[2][4];
#pragma unroll
            for (int mt = 0; mt < 4; ++mt) {
                s[0][mt] = (f32x4){0.f, 0.f, 0.f, 0.f}; s[1][mt] = (f32x4){0.f, 0.f, 0.f, 0.f};
#pragma unroll
                for (int kc = 0; kc < 2; ++kc) {
                    const bf16x8 kf = *(const LAS3 bf16x8*)(Kb + (mt * 16 + i) * 128 + (((kc * 4 + g) ^ swk) << 4));
                    s[0][mt] = __builtin_amdgcn_mfma_f32_16x16x32_bf16(kf, qf[0][kc], s[0][mt], 0, 0, 0);
                    s[1][mt] = __builtin_amdgcn_mfma_f32_16x16x32_bf16(kf, qf[1][kc], s[1][mt], 0, 0, 0);
                }
                if (VAR == 1) {
                    const bf16x8 kf = *(const LAS3 bf16x8*)(lds + AT_KR + buf * 4096 + (mt * 16 + i) * 64 + ((g ^ (swk & 3)) << 4));
                    s[0][mt] = __builtin_amdgcn_mfma_f32_16x16x32_bf16(kf, qf[0][KC - 1], s[0][mt], 0, 0, 0);
                    s[1][mt] = __builtin_amdgcn_mfma_f32_16x16x32_bf16(kf, qf[1][KC - 1], s[1][mt], 0, 0, 0);
                }
            }
            bool full = (64 * j + 63 <= q0);
            if (VAR == 2) full = full && (64 * j >= q0 - 96);
            if (VAR == 3) full = false;
            bf16x8 pf[2][2];
#pragma unroll
            for (int qt = 0; qt < 2; ++qt) {
                const int t = q0 + 16 * qt + i;
                float x[4][4];
#pragma unroll
                for (int mt = 0; mt < 4; ++mt) {
                    f32x4 cb = {0.f, 0.f, 0.f, 0.f};
                    if (VAR == 0) cb = *(const LAS3 f32x4*)(lds + AT_CB + buf * 256 + (16 * mt + 4 * g) * 4);
#pragma unroll
                    for (int r = 0; r < 4; ++r) {
                        const int key = 64 * j + 16 * mt + 4 * g + r;
                        float v = s[qt][mt][r] * c1;
                        if (VAR == 0) v += cb[r];
                        if (VAR == 2) v += slope2 * (float)(key - t);
                        if (VAR == 3) v += slope2 * (float)key;
                        if (!full) {
                            bool ok;
                            if (VAR == 0 || VAR == 1) ok = key <= t;
                            else if (VAR == 2) ok = (key <= t) && (key > t - 128);
                            else { const int kk = 16 * mt + 4 * g + r; ok = (((kk < 32) ? (mw[qt].x >> kk) : (mw[qt].y >> (kk - 32))) & 1u) != 0u; }
                            v = ok ? v : NEGBIG;
                        }
                        x[mt][r] = v;
                    }
                }
                float mx = x[0][0];
#pragma unroll
                for (int mt = 0; mt < 4; ++mt)
#pragma unroll
                    for (int r = 0; r < 4; ++r) mx = fmaxf(mx, x[mt][r]);
                mx = fmaxf(mx, __shfl_xor(mx, 16)); mx = fmaxf(mx, __shfl_xor(mx, 32));
                const float mn = fmaxf(mrow[qt], mx), alpha = __builtin_amdgcn_exp2f(mrow[qt] - mn);
                mrow[qt] = mn;
                float ps = 0.f;
#pragma unroll
                for (int mt = 0; mt < 4; ++mt)
#pragma unroll
                    for (int r = 0; r < 4; ++r) { x[mt][r] = __builtin_amdgcn_exp2f(x[mt][r] - mn); ps += x[mt][r]; }
                lsum[qt] = lsum[qt] * alpha + ps;
#pragma unroll
                for (int dt = 0; dt < 4; ++dt) o[qt][dt] = o[qt][dt] * alpha;
#pragma unroll
                for (int c = 0; c < 2; ++c) {
                    u32x4 pk; pk.x = cvt_pk_bf16(x[2 * c][0], x[2 * c][1]); pk.y = cvt_pk_bf16(x[2 * c][2], x[2 * c][3]);
                    pk.z = cvt_pk_bf16(x[2 * c + 1][0], x[2 * c + 1][1]); pk.w = cvt_pk_bf16(x[2 * c + 1][2], x[2 * c + 1][3]);
                    pf[qt][c] = __builtin_bit_cast(bf16x8, pk);
                }
            }
            const int q4 = i >> 2, p4 = i & 3;
#pragma unroll
            for (int c = 0; c < 2; ++c) {
                const int row0 = 32 * c + 4 * g + q4, swv = (row0 >> 1) & 3;
#pragma unroll
                for (int dt = 0; dt < 4; ++dt) {
                    const LAS3 char* a0 = Vb + row0 * 128 + ((dt ^ swv) << 5) + p4 * 8;
                    const bf16x4 v0 = __builtin_amdgcn_ds_read_tr16_b64_v4i16((lds_bf16x4*)(a0));
                    const bf16x4 v1 = __builtin_amdgcn_ds_read_tr16_b64_v4i16((lds_bf16x4*)(a0 + 16 * 128));
                    const bf16x8 vf = {v0[0], v0[1], v0[2], v0[3], v1[0], v1[1], v1[2], v1[3]};
                    o[0][dt] = __builtin_amdgcn_mfma_f32_16x16x32_bf16(vf, pf[0][c], o[0][dt], 0, 0, 0);
                    o[1][dt] = __builtin_amdgcn_mfma_f32_16x16x32_bf16(vf, pf[1][c], o[1][dt], 0, 0, 0);
                }
            }
        }
        if (j < j1) { AT_WRITE(buf ^ 1); if (VAR == 3) { mw[0] = mwn[0]; mw[1] = mwn[1]; } }
        __syncthreads();
    }
#undef AT_LOAD
#undef AT_WRITE
#pragma unroll
    for (int qt = 0; qt < 2; ++qt) {
        float lt = lsum[qt]; lt += __shfl_xor(lt, 16); lt += __shfl_xor(lt, 32);
        if (VAR == 2) lt += __builtin_amdgcn_exp2f(p.sinks[l * 4 + hx * 2 + (w >> 2)] * LOG2E - mrow[qt]);
        const float inv = 1.f / lt;
        bf16_t* op = p.merged + (tok0 + q0 + 16 * qt + i) * D + ocol + 4 * g;
#pragma unroll
        for (int dt = 0; dt < 4; ++dt) { const f32x4 v = o[qt][dt] * inv; u32x2 w2; w2.x = cvt_pk_bf16(v[0], v[1]); w2.y = cvt_pk_bf16(v[2], v[3]); *(u32x2*)(op + 16 * dt) = w2; }
    }
}

__device__ __forceinline__ void phase_attn(const Params& p, int l, LAS3 char* lds) {
    const int tid = threadIdx.x;
    unsigned* qhead = p.ctl + CW_QA + 64 * l;
    volatile LAS3 int* bc = (volatile LAS3 int*)(lds + AT_CTL);
    for (;;) {
        if (tid == 0) *bc = (int)__hip_atomic_fetch_add(qhead, 1u, __ATOMIC_RELAXED, __HIP_MEMORY_SCOPE_AGENT);
        __syncthreads();
        const int idx = __builtin_amdgcn_readfirstlane(*bc);
        __syncthreads();
        if (idx >= 4096) break;
#ifndef ATTN_VMASK
#define ATTN_VMASK 15
#endif
        if (idx < 3072) {
            const int lvl = 7 - idx / 384, rem = idx % 384;
            if (rem < 128) { if (ATTN_VMASK & 2) attn_unit<1>(p, l, rem >> 2, rem & 3, lvl, lds); }
            else if (rem < 256) { if (ATTN_VMASK & 1) attn_unit<0>(p, l, (rem - 128) >> 2, rem & 3, lvl, lds); }
            else { const int d = rem - 256; if (ATTN_VMASK & 8) attn_unit<3>(p, l, d & 31, 0, 4 * lvl + 3 - (d >> 5), lds); }
        } else { const int c = idx - 3072; if (ATTN_VMASK & 4) attn_unit<2>(p, l, c >> 5, (c >> 4) & 1, c & 15, lds); }
    }
}
}

namespace {
constexpr int DS_LD = 2052;
constexpr int DS_CTL = 16 * DS_LD * 4;
constexpr int DS_LDS = DS_CTL + 64;

__device__ __forceinline__ void dsa_unit(const Params& p, int u, LAS3 char* lds) {
    const int tid = threadIdx.x, w = __builtin_amdgcn_readfirstlane(tid >> 6), lane = tid & 63, i = lane & 15, g = lane >> 4;
    const int b = u >> 7, t0 = (u & 127) * 16;
    const size_t tok0 = (size_t)b * S;
    uint32_t* mbase = p.mask + (tok0 + t0) * 64;
    if (t0 + 16 <= 256) {
#pragma unroll
        for (int qq = 0; qq < 2; ++qq) {
            const int q = 2 * w + qq, n = t0 + q + 1;
            if (lane < 32) { const int lo = lane * 64; unsigned long long bits = (n >= lo + 64) ? ~0ull : (n <= lo ? 0ull : ((1ull << (n - lo)) - 1ull));
                u32x2 o; o.x = (unsigned)bits; o.y = (unsigned)(bits >> 32); *(u32x2*)(mbase + q * 64 + 2 * lane) = o; }
        }
        return;
    }
    const int nreg = (t0 + 16 + 63) >> 6;
    const int ntile = nreg * 4;
    bf16x8 qf[8]; float wq[8];
    {
        const bf16_t* qrow = p.proj + (tok0 + t0 + i) * NP;
#pragma unroll
        for (int h = 0; h < 8; ++h) qf[h] = *(const bf16x8*)(qrow + PC_DQI + h * 32 + 8 * g);
        const u32x4 ww = *(const u32x4*)(qrow + PC_DWI);
        const float sc = 0.35355339059327373f * 0.17677669529663687f;
        wq[0] = bflo(ww.x) * sc; wq[1] = bfhi(ww.x) * sc; wq[2] = bflo(ww.y) * sc; wq[3] = bfhi(ww.y) * sc;
        wq[4] = bflo(ww.z) * sc; wq[5] = bfhi(ww.z) * sc; wq[6] = bflo(ww.w) * sc; wq[7] = bfhi(ww.w) * sc;
    }
    const int tq = t0 + i;
    for (int kt = w; kt < ntile; kt += 8) {
        const bf16x8 kf = *(const bf16x8*)(p.proj + (tok0 + 16 * kt + i) * NP + PC_DKI + 8 * g);
        f32x4 sc4 = {0.f, 0.f, 0.f, 0.f};
#pragma unroll
        for (int h = 0; h < 8; ++h) {
            const f32x4 c = __builtin_amdgcn_mfma_f32_16x16x32_bf16(kf, qf[h], (f32x4){0.f, 0.f, 0.f, 0.f}, 0, 0, 0);
#pragma unroll
            for (int r = 0; r < 4; ++r) sc4[r] += wq[h] * fmaxf(c[r], 0.f);
        }
        u32x4 ko;
#pragma unroll
        for (int r = 0; r < 4; ++r) {
            const int key = 16 * kt + 4 * g + r;
            unsigned uu = __float_as_uint(sc4[r]); if (uu == 0x80000000u) uu = 0u;
            uu = (uu & 0x80000000u) ? ~uu : (uu | 0x80000000u);
            ko[r] = (key <= tq) ? uu : 0u;
        }
        *(LAS3 u32x4*)(lds + ((size_t)i * DS_LD + 16 * kt + 4 * g) * 4) = ko;
    }
    __syncthreads();
#pragma unroll 1
    for (int qq = 0; qq < 2; ++qq) {
        const int q = 2 * w + qq, n = t0 + q + 1;
        unsigned long long mine = 0ull;
        if (n <= 256) {
            if (lane < 32) { const int lo = lane * 64; mine = (n >= lo + 64) ? ~0ull : (n <= lo ? 0ull : ((1ull << (n - lo)) - 1ull)); }
        } else {
            const LAS3 unsigned* kp = (const LAS3 unsigned*)(lds + (size_t)q * DS_LD * 4);
            unsigned key[32];
#pragma unroll
            for (int r = 0; r < 32; ++r) key[r] = (r < nreg) ? kp[r * 64 + lane] : 0u;
            unsigned thr = 0u; bool exact = false;
            for (int bit = 31; bit >= 0; --bit) {
                const unsigned cand = thr | (1u << bit);
                int cnt = 0;
#pragma unroll
                for (int r = 0; r < 32; ++r) cnt += __popcll(__ballot(key[r] >= cand));
                if (cnt >= 256) { thr = cand; if (cnt == 256) { exact = true; break; } }
            }
            int need = 0;
            if (!exact) { int ngt = 0;
#pragma unroll
                for (int r = 0; r < 32; ++r) ngt += __popcll(__ballot(key[r] > thr));
                need = 256 - ngt; }
            int running = 0;
            const unsigned long long lt = (lane == 0) ? 0ull : (~0ull >> (64 - lane));
#pragma unroll
            for (int r = 0; r < 32; ++r) {
                unsigned long long bs;
                if (exact) bs = __ballot(key[r] >= thr);
                else {
                    const bool eq = key[r] == thr;
                    const unsigned long long be = __ballot(eq);
                    const int rank = running + __popcll(be & lt);
                    bs = __ballot((key[r] > thr) || (eq && rank < need));
                    running += __popcll(be);
                }
                if (lane == r) mine = bs;
            }
        }
        if (lane < 32) { u32x2 o; o.x = (unsigned)mine; o.y = (unsigned)(mine >> 32); *(u32x2*)(mbase + q * 64 + 2 * lane) = o; }
    }
    __syncthreads();
}

__device__ __forceinline__ void phase_dsa(const Params& p, int l, LAS3 char* lds) {
    const int tid = threadIdx.x;
    unsigned* qhead = p.ctl + CW_QD + 64 * l;
    volatile LAS3 int* bc = (volatile LAS3 int*)(lds + DS_CTL);
    for (;;) {
        if (tid == 0) *bc = (int)__hip_atomic_fetch_add(qhead, 1u, __ATOMIC_RELAXED, __HIP_MEMORY_SCOPE_AGENT);
        __syncthreads();
        const int idx = __builtin_amdgcn_readfirstlane(*bc);
        __syncthreads();
        if (idx >= 4096) break;
        const int pb = 127 - (idx >> 5), b = idx & 31;
        dsa_unit(p, b * 128 + pb, lds);
    }
}
}

namespace {
constexpr int LDS_BYTES = 147456;
constexpr int NTHREADS = 512;

template <int PH>
__device__ __forceinline__ void run_phase(const Params& p, int l, unsigned char* smem) {
    LAS3 char* lds = (LAS3 char*)smem;
    PG8_LAS unsigned char* glds = (PG8_LAS unsigned char*)smem;
    const int G = gridDim.x, c = blockIdx.x;
    if constexpr (PH == 0) phase_p0(p, (char*)smem);
    if constexpr (PH == 1) { if (l == 0) phase_norm1<0>(p, 0); else phase_norm1<1>(p, l); }
    if constexpr (PH == 2) { pg8::Gemm g{p.h, p.WinT + (size_t)l * NP * D, D, D, 0}; pg8::StaticOrder S; S.init(T, NP, G, c);
        EpiStoreBf16 E{p.proj, NP}; pg8::gemm_phase<EpiStoreBf16, pg8::StaticOrder, false>(glds, g, S, E); }
    if constexpr (PH == 3) phase_prep(p, l);
    if constexpr (PH == 4) { pg8::Gemm g{p.proj + PC_BCQ, p.WqT + (size_t)l * 512 * 256, 256, NP, 0}; pg8::StaticOrder S; S.init(T, 512, G, c);
          EpiMlaQ E{p.qm, p.rq, p.ropetab}; pg8::gemm_phase<EpiMlaQ, pg8::StaticOrder, false>(glds, g, S, E); }
    if constexpr (PH == 12) { pg8::Gemm g{p.proj + PC_BCKV, p.WkvT + (size_t)l * 512 * 128, 128, NP, 0}; pg8::StaticOrder S; S.init(T, 512, G, c);
          EpiMlaKV E{p.km, p.vm, p.rkv}; pg8::gemm_phase<EpiMlaKV, pg8::StaticOrder, false>(glds, g, S, E); }
    if constexpr (PH == 13) phase_dsa(p, l, lds);
    if constexpr (PH == 5) phase_attn(p, l, lds);
    if constexpr (PH == 6) { pg8::Gemm g{p.merged, p.WoutT + (size_t)l * D * D, D, D, 0}; pg8::StaticOrder S; S.init(T, D, G, c);
        EpiResidual E{p.xo, p.mod + (size_t)l * NB * NMOD + 2 * 1024}; pg8::gemm_phase<EpiResidual, pg8::StaticOrder, false>(glds, g, S, E); }
    if constexpr (PH == 7) phase_route(p, l, (char*)smem);
    if constexpr (PH == 8) { const int* cnt = (const int*)(p.ctl + CW_CNT) + l * 16;
        pg8::Gemm g{p.h, p.WguT + (size_t)l * 16 * 512 * 1024, 1024, D, (size_t)512 * 1024}; MoeOrder S; S.init(cnt, p.list, 2, G, c);
        EpiGateUp E{p.hid}; pg8::gemm_phase<EpiGateUp, MoeOrder, true>(glds, g, S, E); }
    if constexpr (PH == 9) { const int* cnt = (const int*)(p.ctl + CW_CNT) + l * 16;
        pg8::Gemm g{p.hid, p.WdT + (size_t)l * 16 * 1024 * 256, 256, 256, (size_t)1024 * 256}; MoeOrder S; S.init(cnt, p.list, 4, G, c);
        EpiDown E{p.ys, p.list, p.rw, cnt}; pg8::gemm_phase<EpiDown, MoeOrder, false>(glds, g, S, E); }
    if constexpr (PH == 10) phase_norm1<2>(p, 1);
    if constexpr (PH == 11) phase_norm1<0>(p, l);
}
template <int PH>
__global__ void __launch_bounds__(NTHREADS, 2) k_ph(Params p, int l) {
    extern __shared__ __attribute__((aligned(16))) unsigned char smem[];
    run_phase<PH>(p, l, smem);
}
}

namespace {
__global__ void n_fox(const bf16_t* __restrict__ proj, const float* __restrict__ bf, float* __restrict__ cbF) {
    const int id = blockIdx.x * blockDim.x + threadIdx.x;
    if (id >= NB * 4) return;
    const int b = id >> 2, h = id & 3;
    float run = 0.f; const float bias = bf[h];
    for (int t = 0; t < S; ++t) {
        const float z = bf2f(proj[(size_t)(b * S + t) * NP + PC_AF + h]) + bias;
        run += fminf(z, 0.f) - log1pf(expf(-fabsf(z)));
        cbF[(size_t)id * S + t] = -run * LOG2E;
    }
}
__global__ void __launch_bounds__(256) n_mla(const bf16_t* __restrict__ proj, const float* __restrict__ gq, const float* __restrict__ wq,
                                             const float* __restrict__ gkv, const float* __restrict__ wkv,
                                             bf16_t* __restrict__ qm, bf16_t* __restrict__ km, bf16_t* __restrict__ vm) {
    constexpr int TP = 8;
    __shared__ float cq[TP][256]; __shared__ float ckv[TP][128]; __shared__ float kr[TP][32];
    __shared__ float qf[TP][384]; __shared__ float kvf[TP][512];
    const int tid = threadIdx.x, tok0 = blockIdx.x * TP;
    for (int i = tid; i < TP * 256; i += 256) { const int j = i >> 8, cidx = i & 255; cq[j][cidx] = bf2f(proj[(size_t)(tok0 + j) * NP + PC_BCQ + cidx]); }
    for (int i = tid; i < TP * 128; i += 256) { const int j = i >> 7, cidx = i & 127; ckv[j][cidx] = bf2f(proj[(size_t)(tok0 + j) * NP + PC_BCKV + cidx]); }
    { const int j = tid >> 5, cidx = tid & 31; kr[j][cidx] = bf2f(proj[(size_t)(tok0 + j) * NP + PC_BKR + cidx]); }
    __syncthreads();
    {
        const int j = tid >> 5, ln = tid & 31;
        float s1 = 0.f, s2 = 0.f;
        for (int i = ln; i < 256; i += 32) s1 += cq[j][i] * cq[j][i];
        for (int i = ln; i < 128; i += 32) s2 += ckv[j][i] * ckv[j][i];
        for (int o = 16; o > 0; o >>= 1) { s1 += __shfl_xor(s1, o); s2 += __shfl_xor(s2, o); }
        const float r1 = rsqrtf(s1 * (1.f / 256.f) + EPS), r2 = rsqrtf(s2 * (1.f / 128.f) + EPS);
        __syncthreads();
        for (int i = ln; i < 256; i += 32) cq[j][i] = cq[j][i] * r1 * gq[i];
        for (int i = ln; i < 128; i += 32) ckv[j][i] = ckv[j][i] * r2 * gkv[i];
    }
    __syncthreads();
    for (int o = tid; o < 384 + 512; o += 256) {
        float acc[TP];
#pragma unroll
        for (int j = 0; j < TP; ++j) acc[j] = 0.f;
        if (o < 384) {
            for (int i = 0; i < 256; ++i) { const float w = wq[i * 384 + o];
#pragma unroll
                for (int j = 0; j < TP; ++j) acc[j] += cq[j][i] * w; }
#pragma unroll
            for (int j = 0; j < TP; ++j) qf[j][o] = acc[j];
        } else {
            const int o2 = o - 384;
            for (int i = 0; i < 128; ++i) { const float w = wkv[i * 512 + o2];
#pragma unroll
                for (int j = 0; j < TP; ++j) acc[j] += ckv[j][i] * w; }
#pragma unroll
            for (int j = 0; j < TP; ++j) kvf[j][o2] = acc[j];
        }
    }
    __syncthreads();
    for (int i = tid; i < TP * 384; i += 256) {
        const int j = i / 384, r = i % 384, hh = r / 96, cc = r % 96;
        const int tok = tok0 + j, pos = tok % S;
        float qv, kv;
        if (cc < 64) { qv = qf[j][hh * 96 + cc]; kv = kvf[j][hh * 128 + cc]; }
        else {
            const int ii = (cc - 64) & 15; const bool hi = cc >= 80;
            const float inv = powf(10000.0f, -(float)ii / 16.0f);
            const float ang = (float)pos * inv, cs = cosf(ang), sn = sinf(ang);
            const float q1 = qf[j][hh * 96 + 64 + ii], q2 = qf[j][hh * 96 + 80 + ii];
            const float k1 = kr[j][ii], k2 = kr[j][16 + ii];
            qv = hi ? (q2 * cs + q1 * sn) : (q1 * cs - q2 * sn);
            kv = hi ? (k2 * cs + k1 * sn) : (k1 * cs - k2 * sn);
        }
        qm[(size_t)tok * 384 + r] = f2bf(qv); km[(size_t)tok * 384 + r] = f2bf(kv);
    }
    for (int i = tid; i < TP * 256; i += 256) {
        const int j = i >> 8, r = i & 255, hh = r >> 6, cc = r & 63;
        vm[(size_t)(tok0 + j) * 256 + r] = f2bf(kvf[j][hh * 128 + 64 + cc]);
    }
}
__global__ void __launch_bounds__(256) n_dsa(const bf16_t* __restrict__ proj, uint32_t* __restrict__ mask) {
    __shared__ float sc[4][2048]; __shared__ float qs[4][256]; __shared__ float wsd[4][8];
    const int tid = threadIdx.x, wave = tid >> 6, lane = tid & 63;
    const int tok = blockIdx.x * 4 + wave, b = tok / S, t = tok % S, n = t + 1;
    for (int i = lane; i < 256; i += 64) qs[wave][i] = bf2f(proj[(size_t)tok * NP + PC_DQI + i]);
    if (lane < 8) wsd[wave][lane] = bf2f(proj[(size_t)tok * NP + PC_DWI + lane]) * (0.35355339059327373f * 0.17677669529663687f);
    __syncthreads();
    for (int s = lane; s < n; s += 64) {
        const bf16_t* kp = proj + (size_t)(b * S + s) * NP + PC_DKI;
        float kk[32];
#pragma unroll
        for (int i = 0; i < 32; ++i) kk[i] = bf2f(kp[i]);
        float score = 0.f;
#pragma unroll 1
        for (int h = 0; h < 8; ++h) {
            float d = 0.f;
#pragma unroll
            for (int i = 0; i < 32; ++i) d += qs[wave][h * 32 + i] * kk[i];
            score += wsd[wave][h] * fmaxf(d, 0.f);
        }
        uint32_t u = __float_as_uint(score); if (u == 0x80000000u) u = 0u;
        u = (u & 0x80000000u) ? ~u : (u | 0x80000000u);
        sc[wave][s] = __uint_as_float(u);
    }
    for (int s = n + lane; s < 2048; s += 64) sc[wave][s] = 0.f;
    __syncthreads();
    uint32_t* mrow = mask + (size_t)tok * 64;
    if (n <= 256) {
        for (int ch = 0; ch < 32; ++ch) {
            const int s = ch * 64 + lane; const unsigned long long bal = __ballot(s < n);
            if (lane == 0) { mrow[ch * 2] = (uint32_t)bal; mrow[ch * 2 + 1] = (uint32_t)(bal >> 32); }
        }
        return;
    }
    const uint32_t* keys = (const uint32_t*)&sc[wave][0];
    uint32_t thr = 0u;
    for (int bit = 31; bit >= 0; --bit) {
        const uint32_t cand = thr | (1u << bit);
        int cnt = 0;
        for (int i = 0; i < 32; ++i) cnt += (keys[i * 64 + lane] >= cand) ? 1 : 0;
        for (int o = 32; o > 0; o >>= 1) cnt += __shfl_xor(cnt, o);
        if (cnt >= 256) thr = cand;
    }
    int ngt = 0;
    for (int i = 0; i < 32; ++i) ngt += (keys[i * 64 + lane] > thr) ? 1 : 0;
    for (int o = 32; o > 0; o >>= 1) ngt += __shfl_xor(ngt, o);
    const int need = 256 - ngt;
    int running = 0;
    const unsigned long long lt = (lane == 0) ? 0ull : (~0ull >> (64 - lane));
    for (int i = 0; i < 32; ++i) {
        const uint32_t key = keys[i * 64 + lane];
        const bool eq = key == thr;
        const unsigned long long be = __ballot(eq);
        const int rank = running + __popcll(be & lt);
        const bool sel = (key > thr) || (eq && rank < need);
        running += __popcll(be);
        const unsigned long long bs = __ballot(sel);
        if (lane == 0) { mrow[i * 2] = (uint32_t)bs; mrow[i * 2 + 1] = (uint32_t)(bs >> 32); }
    }
}
struct NAttnArgs {
    const bf16_t* q; const bf16_t* k; const bf16_t* v; int ldq, ldk, ldv; int hq_stride, hk_stride, hv_stride; int kv_div;
    const float* cbF; const uint32_t* mask; const float* sinks; bf16_t* out; int out_off; float scale; int slope_base;
};
template <int VAR>
__global__ void __launch_bounds__(128) n_attn(NAttnArgs a) {
    constexpr int DQ = (VAR == 1) ? 96 : 64;
    const int t = blockIdx.x * 128 + threadIdx.x, head = blockIdx.y, b = blockIdx.z;
    const size_t tok = (size_t)b * S + t;
    const bf16_t* qp = a.q + tok * a.ldq + head * a.hq_stride;
    const bf16_t* kb = a.k + (size_t)b * S * a.ldk + (head / a.kv_div) * a.hk_stride;
    const bf16_t* vb = a.v + (size_t)b * S * a.ldv + (head / a.kv_div) * a.hv_stride;
    float q[DQ];
#pragma unroll
    for (int d = 0; d < DQ; ++d) q[d] = bf2f(qp[d]) * a.scale;
    float acc[64];
#pragma unroll
    for (int d = 0; d < 64; ++d) acc[d] = 0.f;
    float m = -INFINITY, l = 0.f;
    const float slope = (VAR >= 2) ? exp2f(-(float)(a.slope_base + head + 1)) : 0.f;
    const int s_lo = (VAR == 2) ? (t - 127 > 0 ? t - 127 : 0) : 0;
    for (int s = s_lo; s <= t; ++s) {
        if (VAR == 3) { const uint32_t w = a.mask[tok * 64 + (s >> 5)]; if (!((w >> (s & 31)) & 1u)) continue; }
        const bf16_t* kp = kb + (size_t)s * a.ldk;
        float dot = 0.f;
#pragma unroll
        for (int d = 0; d < DQ; d += 8) { const u32x4 kv = *(const u32x4*)(kp + d);
            dot += q[d] * bflo(kv.x) + q[d + 1] * bfhi(kv.x) + q[d + 2] * bflo(kv.y) + q[d + 3] * bfhi(kv.y) + q[d + 4] * bflo(kv.z) + q[d + 5] * bfhi(kv.z) + q[d + 6] * bflo(kv.w) + q[d + 7] * bfhi(kv.w); }
        float logit = dot;
        if (VAR == 0) logit += a.cbF[((size_t)b * 4 + head) * S + s] * 0.6931471805599453f;
        if (VAR >= 2) logit -= slope * (float)(t - s);
        const float mn = fmaxf(m, logit), alpha = __expf(m - mn), pp = __expf(logit - mn);
        l = l * alpha + pp; m = mn;
        const bf16_t* vp = vb + (size_t)s * a.ldv;
#pragma unroll
        for (int d = 0; d < 64; d += 8) { const u32x4 vv = *(const u32x4*)(vp + d);
            acc[d] = acc[d] * alpha + pp * bflo(vv.x); acc[d + 1] = acc[d + 1] * alpha + pp * bfhi(vv.x); acc[d + 2] = acc[d + 2] * alpha + pp * bflo(vv.y); acc[d + 3] = acc[d + 3] * alpha + pp * bfhi(vv.y);
            acc[d + 4] = acc[d + 4] * alpha + pp * bflo(vv.z); acc[d + 5] = acc[d + 5] * alpha + pp * bfhi(vv.z); acc[d + 6] = acc[d + 6] * alpha + pp * bflo(vv.w); acc[d + 7] = acc[d + 7] * alpha + pp * bfhi(vv.w); }
    }
    if (VAR == 2) l += __expf(a.sinks[head] - m);
    const float inv = 1.f / l;
    bf16_t* op = a.out + tok * 1024 + a.out_off + head * 64;
#pragma unroll
    for (int d = 0; d < 64; d += 2) *(unsigned*)(op + d) = cvt_pk_bf16(acc[d] * inv, acc[d + 1] * inv);
}
template <bool COMBINE, bool FINAL>
__global__ void __launch_bounds__(256) n_norm(const float* xin, float* xout, const float* __restrict__ ys, const float* __restrict__ gt_prev,
                                              const float* __restrict__ g, const float* __restrict__ sh, const float* __restrict__ sc, float* __restrict__ h) {
    const int t = blockIdx.x, b = t / S, d = threadIdx.x * 4;
    float4 v = *(const float4*)(xin + (size_t)t * D + d);
    if (COMBINE) {
        const float4 y0 = *(const float4*)(ys + ((size_t)t * 2 + 0) * D + d), y1 = *(const float4*)(ys + ((size_t)t * 2 + 1) * D + d);
        const float4 gt = *(const float4*)(gt_prev + (size_t)b * NMOD + d);
        v.x += gt.x * (y0.x + y1.x); v.y += gt.y * (y0.y + y1.y); v.z += gt.z * (y0.z + y1.z); v.w += gt.w * (y0.w + y1.w);
    }
    float ss = v.x * v.x + v.y * v.y + v.z * v.z + v.w * v.w;
    for (int o = 32; o > 0; o >>= 1) ss += __shfl_xor(ss, o);
    __shared__ float red[4];
    if ((threadIdx.x & 63) == 0) red[threadIdx.x >> 6] = ss;
    __syncthreads();
    ss = red[0] + red[1] + red[2] + red[3];
    const float r = rsqrtf(ss * (1.0f / D) + EPS);
    const float4 gg = *(const float4*)(g + d);
    float4 y; y.x = v.x * r * gg.x; y.y = v.y * r * gg.y; y.z = v.z * r * gg.z; y.w = v.w * r * gg.w;
    if (FINAL) { *(float4*)(xout + (size_t)t * D + d) = y; }
    else {
        *(float4*)(xout + (size_t)t * D + d) = v;
        const float4 a = *(const float4*)(sc + (size_t)b * NMOD + d), s4 = *(const float4*)(sh + (size_t)b * NMOD + d);
        y.x = y.x * (1.f + a.x) + s4.x; y.y = y.y * (1.f + a.y) + s4.y; y.z = y.z * (1.f + a.z) + s4.z; y.w = y.w * (1.f + a.w) + s4.w;
        *(float4*)(h + (size_t)t * D + d) = y;
    }
}
__global__ void __launch_bounds__(256) n_route(const float* __restrict__ h, const float* __restrict__ wr, const float* __restrict__ br,
                                               int* __restrict__ cnt, int* __restrict__ list, float* __restrict__ rw) {
    __shared__ float sg[16][17];
    const int tid = threadIdx.x, tl = tid >> 4, e = tid & 15, tok = blockIdx.x * 16 + tl;
    const float* hp = h + (size_t)tok * D;
    float acc = 0.f;
    for (int d = 0; d < D; ++d) acc += hp[d] * wr[d * 16 + e];
    sg[tl][e] = 1.f / (1.f + expf(-acc));
    __syncthreads();
    if (e == 0) {
        float sc[16], bi[16];
#pragma unroll
        for (int i = 0; i < 16; ++i) { sc[i] = sg[tl][i]; bi[i] = sc[i] + br[i]; }
        int bg = 0; float bgs = -INFINITY;
#pragma unroll
        for (int g = 0; g < 4; ++g) {
            float m1 = -INFINITY, m2 = -INFINITY;
#pragma unroll
            for (int j = 0; j < 4; ++j) { const float v = bi[g * 4 + j]; if (v > m1) { m2 = m1; m1 = v; } else if (v > m2) m2 = v; }
            const float gs = m1 + m2; if (gs > bgs) { bgs = gs; bg = g; }
        }
        int i1 = 0; float v1 = -INFINITY;
        for (int j = 0; j < 4; ++j) { const float v = bi[bg * 4 + j]; if (v > v1) { v1 = v; i1 = j; } }
        int i2 = 0; float v2 = -INFINITY;
        for (int j = 0; j < 4; ++j) { if (j == i1) continue; const float v = bi[bg * 4 + j]; if (v > v2) { v2 = v; i2 = j; } }
        const int e1 = bg * 4 + i1, e2 = bg * 4 + i2;
        const float w1 = sc[e1], w2 = sc[e2], ws = w1 + w2;
        const int s1 = atomicAdd(&cnt[e1], 1); list[(size_t)e1 * ECAP + s1] = tok * 2 + 0; rw[tok * 2 + 0] = w1 / ws;
        const int s2 = atomicAdd(&cnt[e2], 1); list[(size_t)e2 * ECAP + s2] = tok * 2 + 1; rw[tok * 2 + 1] = w2 / ws;
    }
}
__global__ void __launch_bounds__(256) n_moe(const float* __restrict__ h, const float* __restrict__ wg, const float* __restrict__ wu,
                                             const float* __restrict__ wd, const int* __restrict__ cnt, const int* __restrict__ list,
                                             const float* __restrict__ rw, float* __restrict__ ys) {
    constexpr int TP = 8;
    __shared__ float hs[TP][1024]; __shared__ float hid[TP][256]; __shared__ int sl[TP];
    const int e = blockIdx.y, c0 = blockIdx.x * TP, n = cnt[e];
    if (c0 >= n) return;
    const int tid = threadIdx.x;
    if (tid < TP) sl[tid] = (c0 + tid < n) ? list[(size_t)e * ECAP + c0 + tid] : -1;
    __syncthreads();
    for (int i = tid; i < TP * 1024; i += 256) { const int j = i >> 10, d = i & 1023; hs[j][d] = sl[j] >= 0 ? h[(size_t)(sl[j] >> 1) * D + d] : 0.f; }
    __syncthreads();
    {
        const float* g = wg + (size_t)e * 1024 * 256 + tid; const float* u = wu + (size_t)e * 1024 * 256 + tid;
        float ga[TP], ua[TP];
#pragma unroll
        for (int j = 0; j < TP; ++j) { ga[j] = 0.f; ua[j] = 0.f; }
        for (int d = 0; d < 1024; ++d) { const float a = g[(size_t)d * 256], bb = u[(size_t)d * 256];
#pragma unroll
            for (int j = 0; j < TP; ++j) { ga[j] += hs[j][d] * a; ua[j] += hs[j][d] * bb; } }
#pragma unroll
        for (int j = 0; j < TP; ++j) hid[j][tid] = ga[j] / (1.f + expf(-ga[j])) * ua[j];
    }
    __syncthreads();
    float acc[TP][4];
#pragma unroll
    for (int j = 0; j < TP; ++j)
#pragma unroll
        for (int i = 0; i < 4; ++i) acc[j][i] = 0.f;
    const float* dn = wd + (size_t)e * 256 * 1024;
    for (int k = 0; k < 256; ++k) {
        float w[4];
#pragma unroll
        for (int i = 0; i < 4; ++i) w[i] = dn[(size_t)k * 1024 + tid + 256 * i];
#pragma unroll
        for (int j = 0; j < TP; ++j)
#pragma unroll
            for (int i = 0; i < 4; ++i) acc[j][i] += hid[j][k] * w[i];
    }
#pragma unroll
    for (int j = 0; j < TP; ++j) if (sl[j] >= 0) { const float w = rw[sl[j]];
#pragma unroll
        for (int i = 0; i < 4; ++i) ys[(size_t)sl[j] * D + tid + 256 * i] = w * acc[j][i]; }
}
}


#ifndef FAST_PREP
#define FAST_PREP 0
#endif
#ifndef FAST_DSA
#define FAST_DSA 0
#endif
#ifndef FAST_ATTN
#define FAST_ATTN 0
#endif
#ifndef FAST_MOE
#define FAST_MOE 0
#endif

template <int PH> static void launch_ph(const Params& p, int l, int grid, hipStream_t stream) {
    static bool attr = false;
    if (!attr) { (void)hipFuncSetAttribute((const void*)k_ph<PH>, hipFuncAttributeMaxDynamicSharedMemorySize, LDS_BYTES); attr = true; }
    k_ph<PH><<<dim3(grid), dim3(NTHREADS), LDS_BYTES, stream>>>(p, l);
}

extern "C" void kernel_launch(void* const* d_in, const int* in_sizes, int n_in, void* d_out, int out_size, void* d_ws, size_t ws_size,
                              hipStream_t stream) {
    Params p{};
    p.x = (const float*)d_in[0]; p.c = (const float*)d_in[1]; p.w_ada = (const float*)d_in[2]; p.b_ada = (const float*)d_in[3];
    p.g_norm1 = (const float*)d_in[4]; p.w_in = (const float*)d_in[5]; p.b_forget = (const float*)d_in[6]; p.g_q_mla = (const float*)d_in[7];
    p.w_q_up = (const float*)d_in[8]; p.g_kv_mla = (const float*)d_in[9]; p.w_kv_up = (const float*)d_in[10]; p.sinks = (const float*)d_in[11];
    p.w_out = (const float*)d_in[12]; p.g_norm2 = (const float*)d_in[13]; p.w_router = (const float*)d_in[14]; p.b_router = (const float*)d_in[15];
    p.w_gate = (const float*)d_in[16]; p.w_up = (const float*)d_in[17]; p.w_down = (const float*)d_in[18]; p.g_final = (const float*)d_in[19];
    p.xo = (float*)d_out;
    char* ws = (char*)d_ws;
    size_t off = 0;
    auto carve = [&](size_t bytes) { char* q = ws + off; off += (bytes + 255) & ~(size_t)255; return q; };
    p.ctl = (unsigned*)carve((size_t)CW_WORDS * 4);
    p.mod = (float*)carve((size_t)2 * NB * NMOD * 4);
    p.WinT = (bf16_t*)carve((size_t)2 * NP * D * 2);
    p.WoutT = (bf16_t*)carve((size_t)2 * D * D * 2);
    p.WqT = (bf16_t*)carve((size_t)2 * 512 * 256 * 2);
    p.WkvT = (bf16_t*)carve((size_t)2 * 512 * 128 * 2);
    p.WguT = (bf16_t*)carve((size_t)2 * 16 * 512 * 1024 * 2);
    p.WdT = (bf16_t*)carve((size_t)2 * 16 * 1024 * 256 * 2);
    p.ropetab = (float*)carve((size_t)2048 * 16 * 2 * 4);
    p.rq = (float*)carve((size_t)T * 4); p.rkv = (float*)carve((size_t)T * 4);
    p.cbF = (float*)carve((size_t)NB * 4 * S * 4);
    p.mask = (uint32_t*)carve((size_t)T * 64 * 4);
    p.list = (int*)carve((size_t)16 * ECAP * 4);
    p.rw = (float*)carve((size_t)T * 2 * 4);
    p.h = (bf16_t*)carve((size_t)T * D * 2);
    const size_t off_h = off - (((size_t)T * D * 2 + 255) & ~(size_t)255);
    const size_t off_proj = off;
    p.proj = (bf16_t*)carve((size_t)T * NP * 2);
    p.qm = (bf16_t*)carve((size_t)T * 384 * 2);
    p.km = (bf16_t*)carve((size_t)T * 384 * 2);
    p.vm = (bf16_t*)carve((size_t)T * 256 * 2);
    p.merged = (bf16_t*)carve((size_t)T * D * 2);
    size_t need = off;
    off = off_proj;
    p.hid = (bf16_t*)carve((size_t)HIDROWS * 256 * 2);
    p.ys = (bf16_t*)carve((size_t)T * 2 * D * 2);
    if (off > need) need = off;
    off = off_h;
    float* h32 = (float*)carve((size_t)T * D * 4);
    float* ys32 = (float*)carve((size_t)T * 2 * D * 4);
    if (!FAST_MOE && off > need) need = off;
    if (need > ws_size) return;

    static int grid = 0;
    if (!grid) { int dev = 0, cus = 0; (void)hipGetDevice(&dev); (void)hipDeviceGetAttribute(&cus, hipDeviceAttributeMultiprocessorCount, dev); grid = cus > 0 ? cus : 256; }
    (void)hipMemsetAsync(p.ctl, 0, (size_t)CW_WORDS * 4, stream);
    launch_ph<0>(p, 0, grid, stream);
    for (int l = 0; l < 2; ++l) {
        const float* modl = p.mod + (size_t)l * NB * NMOD;
        int* cnt = (int*)(p.ctl + CW_CNT) + l * 16;
        if (l == 0 || FAST_MOE) launch_ph<1>(p, l, grid, stream);
        else {
            n_norm<true, false><<<T, 256, 0, stream>>>(p.xo, p.xo, ys32, p.mod + 5 * 1024, p.g_norm1 + l * D, modl, modl + 1024, h32);
            Params p2 = p; p2.x = p.xo; launch_ph<11>(p2, l, grid, stream);
        }
        launch_ph<2>(p, l, grid, stream);
#if FAST_PREP
        launch_ph<3>(p, l, grid, stream);
        launch_ph<4>(p, l, grid, stream);
        launch_ph<12>(p, l, grid, stream);
#else
        n_fox<<<2, 64, 0, stream>>>(p.proj, p.b_forget + l * 4, p.cbF);
        n_mla<<<T / 8, 256, 0, stream>>>(p.proj, p.g_q_mla + l * 256, p.w_q_up + (size_t)l * 256 * 384, p.g_kv_mla + l * 128, p.w_kv_up + (size_t)l * 128 * 512, p.qm, p.km, p.vm);
#endif
#if FAST_DSA
        launch_ph<13>(p, l, grid, stream);
#else
        n_dsa<<<T / 4, 256, 0, stream>>>(p.proj, p.mask);
#endif
        {
        NAttnArgs a{};
        a.out = p.merged; a.cbF = p.cbF; a.mask = p.mask; a.sinks = p.sinks + l * 4;
        a.q = p.proj + PC_AQ; a.k = p.proj + PC_AK; a.v = p.proj + PC_AV; a.ldq = a.ldk = a.ldv = NP; a.hq_stride = a.hk_stride = a.hv_stride = 64; a.kv_div = 1;
        a.out_off = 0; a.scale = 0.125f; a.slope_base = 0;
        if (!(FAST_ATTN & 1)) n_attn<0><<<dim3(S / 128, 4, NB), 128, 0, stream>>>(a);
        a.q = p.qm; a.k = p.km; a.v = p.vm; a.ldq = 384; a.ldk = 384; a.ldv = 256; a.hq_stride = 96; a.hk_stride = 96; a.hv_stride = 64; a.kv_div = 1;
        a.out_off = 256; a.scale = 0.10206207261596577f;
        if (!(FAST_ATTN & 2)) n_attn<1><<<dim3(S / 128, 4, NB), 128, 0, stream>>>(a);
        a.q = p.proj + PC_CQ; a.k = p.proj + PC_CK; a.v = p.proj + PC_CV; a.ldq = a.ldk = a.ldv = NP; a.hq_stride = a.hk_stride = a.hv_stride = 64; a.kv_div = 2;
        a.out_off = 512; a.scale = 0.125f; a.slope_base = 0;
        if (!(FAST_ATTN & 4)) n_attn<2><<<dim3(S / 128, 4, NB), 128, 0, stream>>>(a);
        a.q = p.proj + PC_DQ; a.k = p.proj + PC_DK; a.v = p.proj + PC_DV; a.hq_stride = 64; a.hk_stride = 0; a.hv_stride = 0; a.kv_div = 1;
        a.out_off = 768; a.scale = 0.125f; a.slope_base = 4;
        if (!(FAST_ATTN & 8)) n_attn<3><<<dim3(S / 128, 4, NB), 128, 0, stream>>>(a);
        if (FAST_ATTN) launch_ph<5>(p, l, grid, stream);
        }
        launch_ph<6>(p, l, grid, stream);
#if FAST_MOE
        launch_ph<7>(p, l, grid, stream);
        launch_ph<8>(p, l, grid, stream);
        launch_ph<9>(p, l, grid, stream);
#else
        n_norm<false, false><<<T, 256, 0, stream>>>(p.xo, p.xo, nullptr, nullptr, p.g_norm2 + l * D, modl + 3 * 1024, modl + 4 * 1024, h32);
        n_route<<<T / 16, 256, 0, stream>>>(h32, p.w_router, p.b_router, cnt, p.list, p.rw);
        n_moe<<<dim3(T / 8, 16), 256, 0, stream>>>(h32, p.w_gate + (size_t)l * 16 * D * 256, p.w_up + (size_t)l * 16 * D * 256, p.w_down + (size_t)l * 16 * 256 * D, cnt, p.list, p.rw, ys32);
#endif
    }
#if FAST_MOE
    launch_ph<10>(p, 1, grid, stream);
#else
    n_norm<true, true><<<T, 256, 0, stream>>>(p.xo, p.xo, ys32, p.mod + (size_t)NB * NMOD + 5 * 1024, p.g_final, nullptr, nullptr, nullptr);
#endif
}
```

```cpp
#include <hip/hip_runtime.h>
#include <stdint.h>
#define XB_TMO      128
#define XB_XCNT(j)  (256  + 64 * (j))
#define XB_XSUB(j)  (1280 + 64 * (j))
#define XB_XGEN(j)  (2304 + 64 * (j))
#define XB_TOP      3328
#define XB_TOPGEN   3392
#define XCD_BAR_WORDS 3456
#define XB_SPIN_CAP (1u << 20)
#define LAS __attribute__((address_space(3)))

__device__ __forceinline__ unsigned xb_ld(unsigned* p)              { return __hip_atomic_load(p, __ATOMIC_RELAXED, __HIP_MEMORY_SCOPE_AGENT); }
__device__ __forceinline__ unsigned xb_add(unsigned* p, unsigned v) { return __hip_atomic_fetch_add(p, v, __ATOMIC_RELAXED, __HIP_MEMORY_SCOPE_AGENT); }
__device__ __forceinline__ unsigned xb_xcc_id() { return (unsigned)__builtin_amdgcn_s_getreg((3 << 11) | 20) & 0xFu; }
#define XB_SPIN(cond, bar) do { unsigned _sp = 0; while (cond) { __builtin_amdgcn_s_sleep(1); \
    if ((++_sp & 255u) == 0u) { if (xb_ld(&(bar)[XB_TMO])) break; if (_sp > XB_SPIN_CAP) { atomicAdd(&(bar)[XB_TMO], 1u); break; } } } } while (0)

struct XcdBarrier { unsigned* bar; unsigned x; volatile LAS unsigned* st; int wid; };
__device__ __forceinline__ bool xb_leader(int wid) { return wid == 0 && __builtin_amdgcn_mbcnt_hi(~0u, __builtin_amdgcn_mbcnt_lo(~0u, 0u)) == 0u; }

__device__ __forceinline__ XcdBarrier xcd_barrier_post(unsigned* bar, volatile LAS unsigned* st, int wid) {
    XcdBarrier b; b.bar = bar; b.x = xb_xcc_id(); b.st = st; b.wid = wid;
    if (xb_leader(wid)) (void)xb_add(&bar[XB_XCNT(b.x)], 1u);
    return b;
}
__device__ __forceinline__ void xcd_barrier_complete(unsigned* bar, unsigned x, unsigned& nloc, unsigned& nx) {
    const unsigned G = gridDim.x * gridDim.y * gridDim.z;
    unsigned sum, cnt, mine, sp = 0u;
    for (;;) {
        sum = 0u; cnt = 0u; mine = 0u;
#pragma unroll
        for (unsigned j = 0; j < 16; ++j) { const unsigned c = xb_ld(&bar[XB_XCNT(j)]); sum += c; cnt += (c > 0u) ? 1u : 0u; mine = (j == x) ? c : mine; }
        if (sum == G) break;
        __builtin_amdgcn_s_sleep(1);
        if ((++sp & 255u) == 0u) { if (xb_ld(&bar[XB_TMO])) break; if (sp > XB_SPIN_CAP) { atomicAdd(&bar[XB_TMO], 1u); break; } }
    }
    nloc = mine > 0u ? mine : 1u; nx = cnt > 0u ? cnt : 1u;
}
__device__ __forceinline__ void xcd_barrier(const XcdBarrier& b) {
    asm volatile("s_waitcnt vmcnt(0)" ::: "memory");
    __syncthreads();
    if (xb_leader(b.wid)) {
        unsigned* bar = b.bar;
        __builtin_amdgcn_s_waitcnt(0);
        unsigned nloc = b.st[0], nx = b.st[1];
        if (nloc == 0u) { xcd_barrier_complete(bar, b.x, nloc, nx); b.st[0] = nloc; b.st[1] = nx; }
        const unsigned old = xb_add(&bar[XB_XSUB(b.x)], 1u);
        const unsigned gen = old / nloc;
        if (old + 1u == (gen + 1u) * nloc) {
            __builtin_amdgcn_fence(__ATOMIC_RELEASE, "agent");
            asm volatile("s_waitcnt vmcnt(0)" ::: "memory");
            const unsigned og = xb_add(&bar[XB_TOP], 1u);
            const unsigned tg = og / nx;
            if (og + 1u == (tg + 1u) * nx) xb_add(&bar[XB_TOPGEN], 1u);
            else XB_SPIN(xb_ld(&bar[XB_TOPGEN]) == tg, bar);
            __builtin_amdgcn_fence(__ATOMIC_ACQUIRE, "agent");
            xb_add(&bar[XB_XGEN(b.x)], 1u);
            asm volatile("s_waitcnt vmcnt(0)" ::: "memory");
        } else {
            XB_SPIN(xb_ld(&bar[XB_XGEN(b.x)]) == gen, bar);
            __builtin_amdgcn_fence(__ATOMIC_ACQUIRE, "agent");
            asm volatile("s_waitcnt vmcnt(0)" ::: "memory");
        }
    }
    __syncthreads();
}

#define LAS3 __attribute__((address_space(3)))
namespace {
typedef unsigned short bf16_t;
typedef short bf16x8 __attribute__((ext_vector_type(8)));
typedef short bf16x4 __attribute__((ext_vector_type(4)));
typedef float f32x4 __attribute__((ext_vector_type(4)));
typedef float f32x2 __attribute__((ext_vector_type(2)));
typedef unsigned u32x4 __attribute__((ext_vector_type(4)));
typedef unsigned u32x2 __attribute__((ext_vector_type(2)));

constexpr int D = 1024, NB = 32, S = 2048, T = NB * S, NIN = 2380, NP = 2560, NMOD = 6144;
constexpr int OFF_AQ = 0, OFF_AK = 256, OFF_AV = 512, OFF_AF = 768, OFF_BCQ = 772, OFF_BCKV = 1028, OFF_BKR = 1156,
              OFF_CQ = 1188, OFF_CK = 1444, OFF_CV = 1572, OFF_DQ = 1700, OFF_DK = 1956, OFF_DV = 2020,
              OFF_DQI = 2084, OFF_DKI = 2340, OFF_DWI = 2372;
constexpr int PC_AQ = 0, PC_AK = 256, PC_AV = 512, PC_BCQ = 768, PC_BCKV = 1024, PC_BKR = 1152, PC_CQ = 1184, PC_CK = 1440, PC_CV = 1568,
              PC_DQ = 1696, PC_DK = 1952, PC_DV = 2016, PC_DQI = 2080, PC_DKI = 2336, PC_DWI = 2368, PC_AF = 2376;
constexpr float EPS = 1e-6f;
constexpr float LOG2E = 1.4426950408889634f;
constexpr int ECAP = T;
constexpr int HIDROWS = 2 * T + 16 * 256;

__host__ __device__ __forceinline__ int orig_col(int n) { return n < 768 ? n : (n < 2376 ? n + 4 : (n < 2380 ? n - 1608 : -1)); }
__device__ __forceinline__ int opaque_tid(int wid) {
    int t = wid * 64 + (int)__builtin_amdgcn_mbcnt_hi(~0u, __builtin_amdgcn_mbcnt_lo(~0u, 0u));
    asm volatile("" : "+v"(t)); return t; }
__device__ __forceinline__ float bf2f(bf16_t v) { return __uint_as_float((unsigned)v << 16); }
__device__ __forceinline__ bf16_t f2bf(float f) { unsigned u = __float_as_uint(f); u += 0x7FFFu + ((u >> 16) & 1u); return (bf16_t)(u >> 16); }
typedef __bf16 bf16x2_native __attribute__((ext_vector_type(2)));
__device__ __forceinline__ unsigned cvt_pk_bf16(float lo, float hi) { const f32x2 v = {lo, hi}; return __builtin_bit_cast(unsigned, __builtin_convertvector(v, bf16x2_native)); }
__device__ __forceinline__ float bflo(unsigned w) { return __uint_as_float(w << 16); }
__device__ __forceinline__ float bfhi(unsigned w) { return __uint_as_float(w & 0xFFFF0000u); }
__device__ __forceinline__ float wave_sum(float v) {
#pragma unroll
    for (int o = 32; o > 0; o >>= 1) v += __shfl_xor(v, o);
    return v;
}
}

namespace pg8 {
#define PG8_LAS __attribute__((address_space(3)))
constexpr int BM = 256, BK = 64, HALF = 128, HTB = HALF * BK * 2, STAGE_BYTES = 8 * HTB, NXCD = 8, WGM = 8;

__host__ __device__ __forceinline__ int lds_byte(int r, int c) { const int st = (r >> 4) * 2 + (c >> 5), rr = r & 15, cc = c & 31, ob = rr * 64 + cc * 2; return st * 1024 + (ob ^ (((ob >> 9) & 1) << 5)); }
__host__ __device__ __forceinline__ void stage_rc(int b, int& R, int& C) { const int st = b / 1024, sb = b % 1024, swz = sb ^ (((sb >> 9) & 1) << 5); R = (st >> 1) * 16 + swz / 64; C = (st & 1) * 32 + (swz % 64) / 2; }
__host__ __device__ __forceinline__ int perm32(int rho) { const int n = rho >> 4, i = rho & 15; return 8 * (i >> 2) + 4 * n + (i & 3); }

struct Unit { int pm, pn, e, mt; };
struct Gemm { const bf16_t* A; const bf16_t* Bt; int K; int lda; size_t bstride; };

struct StaticOrder {
    int nM, nN, nwg, G, c;
    __host__ __device__ void init(int M, int N, int G_, int c_) { nM = M / BM; nN = N / BM; nwg = nM * nN; G = G_; c = c_; }
    __host__ __device__ bool next(int i, Unit& u) const {
        const long L = (long)i * G + c; if (L >= nwg) return false;
        int wgid = (int)L; { const int q = nwg / NXCD, r = nwg % NXCD, xcd = wgid % NXCD, off = wgid / NXCD; wgid = (xcd < r ? xcd * (q + 1) : r * (q + 1) + (xcd - r) * q) + off; }
        const int nig = WGM * nN, gid = wgid / nig, fm = gid * WGM, gsz = (nM - fm) < WGM ? (nM - fm) : WGM;
        u.pm = fm + ((wgid % nig) % gsz); u.pn = (wgid % nig) / gsz; u.e = 0; u.mt = 0; return true;
    }
    __device__ __forceinline__ int arow(const Unit& u, int r) const { return u.pm * BM + r; }
};

template <class Epi, class Sched, bool GATHER>
__device__ __forceinline__ void gemm_phase(PG8_LAS unsigned char* lds, const Gemm g, const Sched& S, const Epi& E, int wave_index) {
    const int tid = opaque_tid(wave_index), wid = __builtin_amdgcn_readfirstlane(tid >> 6), lane = tid & 63, wr = wid >> 2, wc = wid & 3, fr = lane & 15, fq = lane >> 4;
    int K_ = g.K; asm volatile("" : "+s"(K_));
    const int K = K_, nt = K / BK, lda = g.lda;
    int Ra[2], Ca[2]; unsigned voffB[2], voffA[2];
#pragma unroll
    for (int i = 0; i < 2; ++i) { int R, C; stage_rc(tid * 16 + i * 8192, R, C); const int Rb = Epi::PERM ? ((R & ~31) + perm32(R & 31)) : R;
        Ra[i] = R; Ca[i] = C; voffB[i] = (unsigned)(Rb * K + C) * 2u; voffA[i] = (unsigned)(R * lda + C) * 2u; }
    const size_t kstep = (size_t)(BK * 2);
    const size_t hstepB = (size_t)HALF * K * 2;
    const size_t tstepB = 2 * hstepB;
    const size_t hstepA = (size_t)HALF * lda * 2, tstepA = 2 * hstepA;
    const unsigned ldsw = (unsigned)wid * 1024u;
    const int aoff = lds_byte(wr * 64 + fr, fq * 8), boff = lds_byte(wc * 32 + fr, fq * 8);
#define PG8_SA(b, h) (((b) * 2 + (h)) * HTB)
#define PG8_SB(b, h) ((4 + (b) * 2 + (h)) * HTB)
#define PG8_STAGE(bufoff, gbase, voff) do { _Pragma("unroll") for (int _i = 0; _i < 2; ++_i) \
        __builtin_amdgcn_global_load_lds((const unsigned*)((const char*)(gbase) + (voff)[_i]), (PG8_LAS unsigned*)(lds + (bufoff) + ldsw + _i * 8192), 16, 0, 0); } while (0)
#define PG8_STAGEA(bufoff, kptr, VO, h) do { _Pragma("unroll") for (int _i = 0; _i < 2; ++_i) { \
        const char* _src; if constexpr (GATHER) _src = (const char*)(kptr) + (VO)[_i][h]; else _src = (const char*)(kptr) + (size_t)(h) * hstepA + voffA[_i]; \
        __builtin_amdgcn_global_load_lds((const unsigned*)_src, (PG8_LAS unsigned*)(lds + (bufoff) + ldsw + _i * 8192), 16, 0, 0); } } while (0)
#define PG8_LDA(dst, b, h) do { _Pragma("unroll") for (int m = 0; m < 4; ++m) _Pragma("unroll") for (int k = 0; k < 2; ++k) dst[m][k] = *(const PG8_LAS bf16x8*)(lds + PG8_SA(b, h) + aoff + m * 2048 + k * 1024); } while (0)
#define PG8_LDB(dst, b, h) do { _Pragma("unroll") for (int n = 0; n < 2; ++n) _Pragma("unroll") for (int k = 0; k < 2; ++k) dst[n][k] = *(const PG8_LAS bf16x8*)(lds + PG8_SB(b, h) + boff + n * 2048 + k * 1024); } while (0)
#define PG8_MMA(ai, bj, At, Bt) do { __builtin_amdgcn_s_setprio(1); _Pragma("unroll") for (int m = 0; m < 4; ++m) _Pragma("unroll") for (int n = 0; n < 2; ++n) _Pragma("unroll") for (int k = 0; k < 2; ++k) \
        acc[ai][bj][m][n] = __builtin_amdgcn_mfma_f32_16x16x32_bf16(Bt[n][k], At[m][k], acc[ai][bj][m][n], 0, 0, 0); __builtin_amdgcn_s_setprio(0); } while (0)
#define PG8_WAIT_V(n) asm volatile("s_waitcnt vmcnt(" #n ")" ::: "memory")
#define PG8_WAIT_L(n) asm volatile("s_waitcnt lgkmcnt(" #n ")" ::: "memory")
#define PG8_BAR __builtin_amdgcn_s_barrier()
#define PG8_SCHED __builtin_amdgcn_sched_barrier(0)
#define PG8_SETV(V, u) do { _Pragma("unroll") for (int _i = 0; _i < 2; ++_i) _Pragma("unroll") for (int _h = 0; _h < 2; ++_h) { \
        const int _row = GATHER ? S.arow(u, _h * HALF + Ra[_i]) : ((u).pm * BM + _h * HALF + Ra[_i]); V[_i][_h] = (unsigned)(((size_t)_row * lda + Ca[_i]) * 2); } } while (0)
    Unit cur, nxt; int ui = 0;
    if (!S.next(0, cur)) return;
    f32x4 acc[2][2][4][2];
#pragma unroll
    for (int a = 0; a < 2; ++a)
#pragma unroll
        for (int b = 0; b < 2; ++b)
#pragma unroll
            for (int m = 0; m < 4; ++m)
#pragma unroll
                for (int n = 0; n < 2; ++n) acc[a][b][m][n] = (f32x4){0.f, 0.f, 0.f, 0.f};
    bf16x8 At[4][2], B0[2][2], B1[2][2];
    unsigned vA[2][2], vN[2][2];
    if constexpr (GATHER) { PG8_SETV(vA, cur); }
    const char* cA = (const char*)g.A + (GATHER ? (size_t)0 : (size_t)cur.pm * tstepA);
    const char* cB = (const char*)g.Bt + ((size_t)cur.e * g.bstride) * 2 + (size_t)cur.pn * tstepB;
    PG8_STAGE(PG8_SB(0, 0), cB, voffB); PG8_STAGE(PG8_SB(0, 1), cB + hstepB, voffB); PG8_STAGEA(PG8_SA(0, 0), cA, vA, 0); PG8_STAGEA(PG8_SA(0, 1), cA, vA, 1);
    if (wr == 1) PG8_BAR;
    PG8_WAIT_V(2); PG8_BAR;
    PG8_STAGE(PG8_SB(1, 0), cB + kstep, voffB); PG8_STAGEA(PG8_SA(1, 0), cA + kstep, vA, 0); PG8_STAGE(PG8_SB(1, 1), cB + hstepB + kstep, voffB);
    PG8_WAIT_V(6); PG8_BAR;
    for (;;) {
        const bool has_next = S.next(ui + 1, nxt);
        if constexpr (GATHER) { if (has_next) { PG8_SETV(vN, nxt); }
        else {
#pragma unroll
            for (int _i = 0; _i < 2; ++_i)
#pragma unroll
                for (int _h = 0; _h < 2; ++_h) vN[_i][_h] = vA[_i][_h];
        } }
        const char* nA = (!GATHER && has_next) ? (const char*)g.A + (size_t)nxt.pm * tstepA : cA;
        const char* nB = has_next ? (const char*)g.Bt + ((size_t)nxt.e * g.bstride) * 2 + (size_t)nxt.pn * tstepB : cB;
#pragma unroll 1
        for (int t = 0; t < nt; t += 2) {
            const bool last = (t == nt - 2);
            const char* a1 = cA + (size_t)(t + 1) * kstep;
            const char* a2 = last ? nA : cA + (size_t)(t + 2) * kstep; const char* b2 = last ? nB : cB + (size_t)(t + 2) * kstep;
            const char* a3 = a2 + kstep; const char* b3 = b2 + kstep;
            unsigned v2[2][2];
            if constexpr (GATHER) {
#pragma unroll
            for (int _i = 0; _i < 2; ++_i)
#pragma unroll
                for (int _h = 0; _h < 2; ++_h) v2[_i][_h] = last ? vN[_i][_h] : vA[_i][_h];
            }
            PG8_LDB(B0, 0, 0); PG8_LDB(B1, 0, 1); PG8_SCHED; PG8_LDA(At, 0, 0); PG8_STAGEA(PG8_SA(1, 1), a1, vA, 1);
            PG8_WAIT_V(8); PG8_WAIT_L(0); PG8_BAR; PG8_MMA(0, 0, At, B0); PG8_MMA(0, 1, At, B1); PG8_BAR; PG8_SCHED;
            PG8_LDA(At, 0, 1); PG8_STAGE(PG8_SB(0, 0), b2, voffB); PG8_STAGE(PG8_SB(0, 1), b2 + hstepB, voffB); PG8_STAGEA(PG8_SA(0, 0), a2, v2, 0);
            PG8_WAIT_V(8); PG8_WAIT_L(0); PG8_BAR; PG8_MMA(1, 0, At, B0); PG8_MMA(1, 1, At, B1); PG8_BAR; PG8_SCHED;
            PG8_LDB(B0, 1, 0); PG8_LDB(B1, 1, 1); PG8_SCHED; PG8_LDA(At, 1, 0); PG8_STAGEA(PG8_SA(0, 1), a2, v2, 1);
            PG8_WAIT_V(8); PG8_WAIT_L(0); PG8_BAR; PG8_MMA(0, 0, At, B0); PG8_MMA(0, 1, At, B1); PG8_BAR; PG8_SCHED;
            PG8_LDA(At, 1, 1); PG8_STAGE(PG8_SB(1, 0), b3, voffB); PG8_STAGE(PG8_SB(1, 1), b3 + hstepB, voffB); PG8_STAGEA(PG8_SA(1, 0), a3, v2, 0);
            PG8_WAIT_V(8); PG8_WAIT_L(0); PG8_BAR; PG8_MMA(1, 0, At, B0); PG8_MMA(1, 1, At, B1); PG8_BAR; PG8_SCHED;
        }
        if (wr == 0) PG8_BAR;
        E(acc, cur, wr, wc, fr, fq);
        if (!has_next) break;
#pragma unroll
        for (int a = 0; a < 2; ++a)
#pragma unroll
            for (int b = 0; b < 2; ++b)
#pragma unroll
                for (int m = 0; m < 4; ++m)
#pragma unroll
                    for (int n = 0; n < 2; ++n) acc[a][b][m][n] = (f32x4){0.f, 0.f, 0.f, 0.f};
        cur = nxt; cB = nB; cA = nA; ++ui;
        if constexpr (GATHER) {
#pragma unroll
        for (int _i = 0; _i < 2; ++_i)
#pragma unroll
            for (int _h = 0; _h < 2; ++_h) vA[_i][_h] = vN[_i][_h];
        }
        if (wr == 1) PG8_BAR;
    }
    PG8_WAIT_V(0);
    PG8_BAR;
#undef PG8_SA
#undef PG8_SB
#undef PG8_STAGE
#undef PG8_STAGEA
#undef PG8_LDA
#undef PG8_LDB
#undef PG8_MMA
#undef PG8_WAIT_V
#undef PG8_WAIT_L
#undef PG8_BAR
#undef PG8_SCHED
#undef PG8_SETV
}
}

namespace {
struct Params {
    const float *x, *c, *w_ada, *b_ada, *g_norm1, *w_in, *b_forget, *g_q_mla, *w_q_up, *g_kv_mla, *w_kv_up, *sinks, *w_out, *g_norm2,
                *w_router, *b_router, *w_gate, *w_up, *w_down, *g_final;
    float* xo;
    unsigned* ctl;
    float* mod;
    bf16_t* WinT;
    bf16_t* WoutT;
    bf16_t* WqT;
    bf16_t* WkvT;
    bf16_t* WguT;
    bf16_t* WdT;
    float* ropetab;
    float* rq; float* rkv;
    float* cbF;
    uint32_t* mask;
    bf16_t* h;
    bf16_t* proj;
    bf16_t* qm; bf16_t* km; bf16_t* vm;
    bf16_t* merged;
    bf16_t* hid;
    bf16_t* ys;
    int* list;
    float* rw;
    int wid;
};
constexpr int CW_BAR = 0;
constexpr int CW_CNT = 3584;
constexpr int CW_QA = 3648;
constexpr int CW_QD = 3840;
constexpr int CW_WORDS = 4096;
}

namespace {
template <class F>
__device__ __forceinline__ void conv_job(bf16_t* __restrict__ dst, int nrows, int K, F f, int gtid, int gthreads) {
    const int k8n = K >> 3; const long items = (long)nrows * k8n;
    for (long it = gtid; it < items; it += gthreads) {
        const int n = (int)(it % nrows), k0 = (int)(it / nrows) * 8;
        float v[8];
#pragma unroll
        for (int j = 0; j < 8; ++j) v[j] = f(n, k0 + j);
        u32x4 w; w.x = cvt_pk_bf16(v[0], v[1]); w.y = cvt_pk_bf16(v[2], v[3]); w.z = cvt_pk_bf16(v[4], v[5]); w.w = cvt_pk_bf16(v[6], v[7]);
        *(u32x4*)(dst + (size_t)n * K + k0) = w;
    }
}
struct FWin { const float* w; __device__ float operator()(int n, int k) const { const int o = orig_col(n); return o >= 0 ? w[(size_t)k * NIN + o] : 0.f; } };
struct FT { const float* w; int ld; __device__ float operator()(int n, int k) const { return w[(size_t)k * ld + n]; } };
struct FTg { const float* w; const float* g; int ld, nmax; __device__ float operator()(int n, int k) const { return n < nmax ? g[k] * w[(size_t)k * ld + n] : 0.f; } };
struct FGu { const float* wg; long du; __device__ float operator()(int n, int k) const { const int q = n >> 5, r = n & 31, col = 16 * q + (r & 15); const long sel = (r < 16) ? 0l : du; return wg[sel + (long)k * 256 + col]; } };

__device__ __forceinline__ void phase_p0(const Params& p, char* lds) {
    const int tid = opaque_tid(p.wid), gtid = blockIdx.x * blockDim.x + tid, gthreads = gridDim.x * blockDim.x;
    for (int l = 0; l < 2; ++l) {
        conv_job(p.WinT + (size_t)l * NP * D, NP, D, FWin{p.w_in + (size_t)l * D * NIN}, gtid, gthreads);
        conv_job(p.WoutT + (size_t)l * D * D, D, D, FT{p.w_out + (size_t)l * D * D, D}, gtid, gthreads);
        conv_job(p.WqT + (size_t)l * 512 * 256, 512, 256, FTg{p.w_q_up + (size_t)l * 256 * 384, p.g_q_mla + l * 256, 384, 384}, gtid, gthreads);
        conv_job(p.WkvT + (size_t)l * 512 * 128, 512, 128, FTg{p.w_kv_up + (size_t)l * 128 * 512, p.g_kv_mla + l * 128, 512, 512}, gtid, gthreads);
        for (int e = 0; e < 16; ++e) {
            const size_t le = (size_t)l * 16 + e;
            conv_job(p.WguT + le * 512 * 1024, 512, 1024, FGu{p.w_gate + le * 1024 * 256, (long)(p.w_up - p.w_gate)}, gtid, gthreads);
            conv_job(p.WdT + le * 1024 * 256, 1024, 256, FT{p.w_down + le * 256 * 1024, 1024}, gtid, gthreads);
        }
    }
    for (int it = gtid; it < 2048 * 16; it += gthreads) {
        const int pos = it >> 4, i = it & 15;
        const float inv = powf(10000.0f, -(float)i / 16.0f), ang = (float)pos * inv;
        p.ropetab[it * 2] = cosf(ang); p.ropetab[it * 2 + 1] = sinf(ang);
    }
    float* ca = (float*)lds;
    for (int i = tid; i < NB * 1024; i += 512) { const float v = p.c[i]; ca[i] = v / (1.f + __expf(-v)); }
    __syncthreads();
    for (int u = blockIdx.x; u < 2 * (NMOD / 128); u += gridDim.x) {
        const int l = u / (NMOD / 128), n = (u % (NMOD / 128)) * 128 + (tid & 127), bg = tid >> 7;
        const float* w = p.w_ada + (size_t)l * 1024 * NMOD + n;
        float acc[8];
#pragma unroll
        for (int j = 0; j < 8; ++j) acc[j] = 0.f;
        for (int d = 0; d < 1024; ++d) { const float wv = w[(size_t)d * NMOD];
#pragma unroll
            for (int j = 0; j < 8; ++j) acc[j] += ca[(bg * 8 + j) * 1024 + d] * wv; }
        const float bias = p.b_ada[l * NMOD + n];
#pragma unroll
        for (int j = 0; j < 8; ++j) p.mod[((size_t)l * NB + bg * 8 + j) * NMOD + n] = acc[j] + bias;
    }
    __syncthreads();
}

template <int MODE>
__device__ __forceinline__ void phase_norm1(const Params& p, int l) {
    const int tid = opaque_tid(p.wid), w = tid >> 6, lane = tid & 63;
    const float* xin = (MODE == 0) ? p.x : p.xo;
    const float* g = (MODE == 2) ? p.g_final : p.g_norm1 + l * D;
    const float* modl = p.mod + (size_t)(MODE == 2 ? 1 : l) * NB * NMOD;
    const float* modp = p.mod + (size_t)(MODE == 2 ? 1 : (l > 0 ? l - 1 : 0)) * NB * NMOD;
    for (int t = blockIdx.x * 8 + w; t < T; t += gridDim.x * 8) {
        const int b = t >> 11;
        f32x4 v[4];
#pragma unroll
        for (int k = 0; k < 4; ++k) v[k] = *(const f32x4*)(xin + (size_t)t * D + 4 * lane + 256 * k);
        if (MODE >= 1) {
#pragma unroll
            for (int k = 0; k < 4; ++k) {
                const int col = 4 * lane + 256 * k;
                const u32x2 y0 = *(const u32x2*)(p.ys + ((size_t)t * 2 + 0) * D + col), y1 = *(const u32x2*)(p.ys + ((size_t)t * 2 + 1) * D + col);
                const f32x4 gt = *(const f32x4*)(modp + (size_t)b * NMOD + 5 * 1024 + col);
                v[k][0] += gt[0] * (bflo(y0.x) + bflo(y1.x)); v[k][1] += gt[1] * (bfhi(y0.x) + bfhi(y1.x));
                v[k][2] += gt[2] * (bflo(y0.y) + bflo(y1.y)); v[k][3] += gt[3] * (bfhi(y0.y) + bfhi(y1.y));
            }
        }
        float ss = 0.f;
#pragma unroll
        for (int k = 0; k < 4; ++k) ss += v[k][0] * v[k][0] + v[k][1] * v[k][1] + v[k][2] * v[k][2] + v[k][3] * v[k][3];
        ss = wave_sum(ss);
        const float r = rsqrtf(ss * (1.0f / D) + EPS);
#pragma unroll
        for (int k = 0; k < 4; ++k) {
            const int col = 4 * lane + 256 * k;
            const f32x4 gg = *(const f32x4*)(g + col);
            f32x4 y = v[k] * r * gg;
            if (MODE == 2) { *(f32x4*)(p.xo + (size_t)t * D + col) = y; }
            else {
                if (MODE == 0 || MODE == 1) *(f32x4*)(p.xo + (size_t)t * D + col) = v[k];
                const f32x4 sc = *(const f32x4*)(modl + (size_t)b * NMOD + 1024 + col), sh = *(const f32x4*)(modl + (size_t)b * NMOD + col);
                y = y * (1.f + sc) + sh;
                u32x2 o; o.x = cvt_pk_bf16(y[0], y[1]); o.y = cvt_pk_bf16(y[2], y[3]);
                *(u32x2*)(p.h + (size_t)t * D + col) = o;
            }
        }
    }
}
}

namespace {
using pg8::Unit;
struct EpiStoreBf16 {
    static constexpr bool PERM = true;
    bf16_t* O; int ldc;
    __device__ __forceinline__ void operator()(const f32x4 (&acc)[2][2][4][2], const Unit& u, int wr, int wc, int fr_, int fq_) const {
        int fr = fr_, fq = fq_; asm volatile("" : "+v"(fr), "+v"(fq));
        const int row0 = u.pm * 256 + wr * 64 + fr, col0 = u.pn * 256 + wc * 32 + 8 * fq;
#pragma unroll
        for (int ai = 0; ai < 2; ++ai)
#pragma unroll
            for (int m = 0; m < 4; ++m) { bf16_t* rowp = O + (size_t)(row0 + ai * 128 + m * 16) * ldc + col0;
#pragma unroll
                for (int bj = 0; bj < 2; ++bj) { const f32x4 v0 = acc[ai][bj][m][0], v1 = acc[ai][bj][m][1];
                    u32x4 w; w.x = cvt_pk_bf16(v0[0], v0[1]); w.y = cvt_pk_bf16(v0[2], v0[3]); w.z = cvt_pk_bf16(v1[0], v1[1]); w.w = cvt_pk_bf16(v1[2], v1[3]);
                    *(u32x4*)(rowp + bj * 128) = w; } }
    }
};
struct EpiResidual {
    static constexpr bool PERM = false;
    float* x; const float* gate;
    __device__ __forceinline__ void operator()(const f32x4 (&acc)[2][2][4][2], const Unit& u, int wr, int wc, int fr_, int fq_) const {
        int fr = fr_, fq = fq_; asm volatile("" : "+v"(fr), "+v"(fq));
        const int row0 = u.pm * 256 + wr * 64 + fr, col0 = u.pn * 256 + wc * 32 + 4 * fq;
        const int b = (u.pm * 256) >> 11;
        f32x4 gv[2][2];
#pragma unroll
        for (int bj = 0; bj < 2; ++bj)
#pragma unroll
            for (int n = 0; n < 2; ++n) gv[bj][n] = *(const f32x4*)(gate + (size_t)b * NMOD + col0 + bj * 128 + n * 16);
#pragma unroll
        for (int ai = 0; ai < 2; ++ai)
#pragma unroll
            for (int m = 0; m < 4; ++m) { float* rowp = x + (size_t)(row0 + ai * 128 + m * 16) * D + col0;
#pragma unroll
                for (int bj = 0; bj < 2; ++bj)
#pragma unroll
                    for (int n = 0; n < 2; ++n) { f32x4* q = (f32x4*)(rowp + bj * 128 + n * 16); *q = *q + gv[bj][n] * acc[ai][bj][m][n]; } }
    }
};
struct EpiMlaQ {
    static constexpr bool PERM = true;
    bf16_t* qm;
    __device__ __forceinline__ void operator()(const f32x4 (&acc)[2][2][4][2], const Unit& u, int wr, int wc, int fr_, int fq_) const {
        int fr = fr_, fq = fq_; asm volatile("" : "+v"(fr), "+v"(fq));
        const int row0 = u.pm * 256 + wr * 64 + fr;
#pragma unroll
        for (int bj = 0; bj < 2; ++bj) {
            const int col0 = u.pn * 256 + bj * 128 + wc * 32;
            if (col0 >= 384) continue;
#pragma unroll
            for (int ai = 0; ai < 2; ++ai)
#pragma unroll
                for (int m = 0; m < 4; ++m) { const f32x4 v0 = acc[ai][bj][m][0], v1 = acc[ai][bj][m][1];
                    u32x4 w; w.x = cvt_pk_bf16(v0[0], v0[1]); w.y = cvt_pk_bf16(v0[2], v0[3]); w.z = cvt_pk_bf16(v1[0], v1[1]); w.w = cvt_pk_bf16(v1[2], v1[3]);
                    *(u32x4*)(qm + (size_t)(row0 + ai * 128 + m * 16) * 384 + col0 + 8 * fq) = w; }
        }
    }
};
struct EpiMlaKV {
    static constexpr bool PERM = true;
    bf16_t* km; bf16_t* vm;
    __device__ __forceinline__ void operator()(const f32x4 (&acc)[2][2][4][2], const Unit& u, int wr, int wc, int fr_, int fq_) const {
        int fr = fr_, fq = fq_; asm volatile("" : "+v"(fr), "+v"(fq));
        const int row0 = u.pm * 256 + wr * 64 + fr;
#pragma unroll
        for (int bj = 0; bj < 2; ++bj) {
            const int head = u.pn * 2 + bj, wcol = wc * 32 + 8 * fq;
#pragma unroll
            for (int ai = 0; ai < 2; ++ai)
#pragma unroll
                for (int m = 0; m < 4; ++m) {
                    const int row = row0 + ai * 128 + m * 16;
                    const f32x4 v0 = acc[ai][bj][m][0], v1 = acc[ai][bj][m][1];
                    u32x4 w; w.x = cvt_pk_bf16(v0[0], v0[1]); w.y = cvt_pk_bf16(v0[2], v0[3]); w.z = cvt_pk_bf16(v1[0], v1[1]); w.w = cvt_pk_bf16(v1[2], v1[3]);
                    bf16_t* q = (wcol < 64) ? km + (size_t)row * 384 + head * 96 + wcol : vm + (size_t)row * 256 + head * 64 + (wcol - 64);
                    *(u32x4*)q = w;
                    asm volatile("" ::: "memory");
                }
        }
    }
};
struct EpiGateUp {
    static constexpr bool PERM = false;
    bf16_t* hid;
    __device__ __forceinline__ void operator()(const f32x4 (&acc)[2][2][4][2], const Unit& u, int wr, int wc, int fr_, int fq_) const {
        int fr = fr_, fq = fq_; asm volatile("" : "+v"(fr), "+v"(fq));
        const int row0 = u.pm * 256 + wr * 64 + fr;
#pragma unroll
        for (int ai = 0; ai < 2; ++ai)
#pragma unroll
            for (int m = 0; m < 4; ++m) { bf16_t* rowp = hid + (size_t)(row0 + ai * 128 + m * 16) * 256;
#pragma unroll
                for (int bj = 0; bj < 2; ++bj) { const f32x4 gt = acc[ai][bj][m][0], up = acc[ai][bj][m][1];
                    f32x4 o;
#pragma unroll
                    for (int j = 0; j < 4; ++j) o[j] = gt[j] / (1.f + __expf(-gt[j])) * up[j];
                    u32x2 w; w.x = cvt_pk_bf16(o[0], o[1]); w.y = cvt_pk_bf16(o[2], o[3]);
                    *(u32x2*)(rowp + 16 * (u.pn * 8 + bj * 4 + wc) + 4 * fq) = w; } }
    }
};
struct EpiDown {
    static constexpr bool PERM = true;
    bf16_t* ys; const int* list; const float* rw; const int* cnt;
    __device__ __forceinline__ void operator()(const f32x4 (&acc)[2][2][4][2], const Unit& u, int wr, int wc, int fr_, int fq_) const {
        int fr = fr_, fq = fq_; asm volatile("" : "+v"(fr), "+v"(fq));
        const int n = cnt[u.e]; const int* le = list + (size_t)u.e * ECAP;
        const int col0 = u.pn * 256 + wc * 32 + 8 * fq;
#pragma unroll
        for (int ai = 0; ai < 2; ++ai)
#pragma unroll
            for (int m = 0; m < 4; ++m) {
                const int lr = u.mt * 256 + ai * 128 + wr * 64 + m * 16 + fr;
                if (lr < n) {
                    const int slot = le[lr]; const float w8 = rw[slot];
                    bf16_t* rowp = ys + (size_t)slot * D + col0;
#pragma unroll
                    for (int bj = 0; bj < 2; ++bj) { const f32x4 v0 = acc[ai][bj][m][0] * w8, v1 = acc[ai][bj][m][1] * w8;
                        u32x4 w; w.x = cvt_pk_bf16(v0[0], v0[1]); w.y = cvt_pk_bf16(v0[2], v0[3]); w.z = cvt_pk_bf16(v1[0], v1[1]); w.w = cvt_pk_bf16(v1[2], v1[3]);
                        *(u32x4*)(rowp + bj * 128) = w; }
                }
            }
    }
};
struct MoeOrder {
    int pre[17];
    int NT, G, c; const int* list; const int* cnt;
    __device__ __forceinline__ void init(const int* cnt_, const int* list_, int NT_, int G_, int c_) {
        cnt = cnt_; list = list_; NT = NT_; G = G_; c = c_; int a = 0;
#pragma unroll
        for (int e = 0; e < 16; ++e) { pre[e] = a; a += (cnt_[e] + 255) >> 8; }
        pre[16] = a;
    }
    __device__ __forceinline__ bool next(int i, Unit& u) const {
        const int L = i * G + c; if (L >= pre[16] * NT) return false;
        const int t = L / NT; int e = 0;
#pragma unroll
        for (int k = 1; k < 16; ++k) e += (t >= pre[k]) ? 1 : 0;
        int pe = 0;
#pragma unroll
        for (int k = 0; k < 16; ++k) pe = (k == e) ? pre[k] : pe;
        u.e = e; u.mt = t - pe; u.pm = t; u.pn = L - t * NT; return true;
    }
    __device__ __forceinline__ int arow(const Unit& u, int r) const { const int lr = u.mt * 256 + r; return lr < cnt[u.e] ? (list[(size_t)u.e * ECAP + lr] >> 1) : 0; }
};
}

namespace {
__device__ __forceinline__ void phase_prep(const Params& p, int l) {
    const int tid = opaque_tid(p.wid), w = tid >> 6, lane = tid & 63;
    const int gw = blockIdx.x * 8 + w, nw = gridDim.x * 8;
    for (int sq = gw; sq < NB * 4; sq += nw) {
        const int b = sq >> 2, hh = sq & 3; const float bias = p.b_forget[l * 4 + hh];
        float lf[32]; float run = 0.f;
#pragma unroll
        for (int j = 0; j < 32; ++j) {
            const float z = bf2f(p.proj[(size_t)(b * S + lane * 32 + j) * NP + PC_AF + hh]) + bias;
            run += fminf(z, 0.f) - log1pf(__expf(-fabsf(z)));
            lf[j] = run;
        }
        float incl = run;
#pragma unroll
        for (int o = 1; o < 64; o <<= 1) { const float t2 = __shfl_up(incl, o); if (lane >= o) incl += t2; }
        const float excl = incl - run;
#pragma unroll
        for (int j = 0; j < 32; ++j) p.cbF[(size_t)sq * S + lane * 32 + j] = -(excl + lf[j]) * LOG2E;
    }
    for (int t = gw; t < T; t += nw) {
        const bf16_t* row = p.proj + (size_t)t * NP;
        const u32x2 cq = *(const u32x2*)(row + PC_BCQ + 4 * lane);
        const unsigned ck = *(const unsigned*)(row + PC_BCKV + 2 * lane);
        float s1 = bflo(cq.x) * bflo(cq.x) + bfhi(cq.x) * bfhi(cq.x) + bflo(cq.y) * bflo(cq.y) + bfhi(cq.y) * bfhi(cq.y);
        float s2 = bflo(ck) * bflo(ck) + bfhi(ck) * bfhi(ck);
        s1 = wave_sum(s1); s2 = wave_sum(s2);
        const float kr = (lane < 32) ? bf2f(row[PC_BKR + lane]) : 0.f;
        const float kr2 = __shfl(kr, (lane + 16) & 63);
        {
            const float r1 = rsqrtf(s1 * (1.f / 256.f) + EPS), r2 = rsqrtf(s2 * (1.f / 128.f) + EPS);
            u32x2 o; o.x = cvt_pk_bf16(bflo(cq.x) * r1, bfhi(cq.x) * r1); o.y = cvt_pk_bf16(bflo(cq.y) * r1, bfhi(cq.y) * r1);
            *(u32x2*)(p.proj + (size_t)t * NP + PC_BCQ + 4 * lane) = o;
            *(unsigned*)(p.proj + (size_t)t * NP + PC_BCKV + 2 * lane) = cvt_pk_bf16(bflo(ck) * r2, bfhi(ck) * r2);
        }
        if (lane < 16) {
            const int pos = t & (S - 1);
            const float cs = p.ropetab[(pos * 16 + lane) * 2], sn = p.ropetab[(pos * 16 + lane) * 2 + 1];
            const bf16_t o1 = f2bf(kr * cs - kr2 * sn), o2 = f2bf(kr2 * cs + kr * sn);
            bf16_t* kmr = p.km + (size_t)t * 384;
#pragma unroll
            for (int hh = 0; hh < 4; ++hh) { kmr[hh * 96 + 64 + lane] = o1; kmr[hh * 96 + 80 + lane] = o2; }
        }
    }
}

__device__ __forceinline__ void phase_route(const Params& p, int l, char* lds) {
    const int tid = opaque_tid(p.wid), w = tid >> 6, lane = tid & 63;
    float* wrT = (float*)lds;
    for (int i = tid; i < 16 * 1024; i += 512) { const int e = i >> 10, d = i & 1023; wrT[i] = p.w_router[d * 16 + e]; }
    __syncthreads();
    const float* g = p.g_norm2 + l * D;
    const float* modl = p.mod + (size_t)l * NB * NMOD;
    int* cnt = (int*)(p.ctl + CW_CNT) + l * 16;
    for (int t = blockIdx.x * 8 + w; t < T; t += gridDim.x * 8) {
        const int b = t >> 11;
        f32x4 v[4];
#pragma unroll
        for (int k = 0; k < 4; ++k) v[k] = *(const f32x4*)(p.xo + (size_t)t * D + 4 * lane + 256 * k);
        float ss = 0.f;
#pragma unroll
        for (int k = 0; k < 4; ++k) ss += v[k][0] * v[k][0] + v[k][1] * v[k][1] + v[k][2] * v[k][2] + v[k][3] * v[k][3];
        ss = wave_sum(ss);
        const float r = rsqrtf(ss * (1.0f / D) + EPS);
        float lg[16];
#pragma unroll
        for (int e = 0; e < 16; ++e) lg[e] = 0.f;
#pragma unroll
        for (int k = 0; k < 4; ++k) {
            const int col = 4 * lane + 256 * k;
            const f32x4 gg = *(const f32x4*)(g + col);
            const f32x4 sc = *(const f32x4*)(modl + (size_t)b * NMOD + 4 * 1024 + col), sh = *(const f32x4*)(modl + (size_t)b * NMOD + 3 * 1024 + col);
            const f32x4 y = v[k] * r * gg * (1.f + sc) + sh;
            u32x2 o; o.x = cvt_pk_bf16(y[0], y[1]); o.y = cvt_pk_bf16(y[2], y[3]);
            *(u32x2*)(p.h + (size_t)t * D + col) = o;
#pragma unroll
            for (int e = 0; e < 16; ++e) { const f32x4 wv = *(const f32x4*)(wrT + e * 1024 + col); lg[e] += y[0] * wv[0] + y[1] * wv[1] + y[2] * wv[2] + y[3] * wv[3]; }
            asm volatile("" ::: "memory");
        }
#pragma unroll
        for (int e = 0; e < 16; ++e) lg[e] = wave_sum(lg[e]);
        if (lane == 0) {
            float sc[16], bi[16];
#pragma unroll
            for (int e = 0; e < 16; ++e) { sc[e] = 1.f / (1.f + expf(-lg[e])); bi[e] = sc[e] + p.b_router[e]; }
            int bg = 0; float bgs = -INFINITY;
#pragma unroll
            for (int gi = 0; gi < 4; ++gi) {
                float m1 = -INFINITY, m2 = -INFINITY;
#pragma unroll
                for (int j = 0; j < 4; ++j) { const float vv = bi[gi * 4 + j]; if (vv > m1) { m2 = m1; m1 = vv; } else if (vv > m2) m2 = vv; }
                const float gs = m1 + m2; if (gs > bgs) { bgs = gs; bg = gi; }
            }
            float b4[4], s4[4];
#pragma unroll
            for (int gi = 0; gi < 4; ++gi)
#pragma unroll
                for (int j = 0; j < 4; ++j) if (gi == bg) { b4[j] = bi[gi * 4 + j]; s4[j] = sc[gi * 4 + j]; }
            int i1 = 0; float v1 = -INFINITY;
#pragma unroll
            for (int j = 0; j < 4; ++j) { if (b4[j] > v1) { v1 = b4[j]; i1 = j; } }
            int i2 = 0; float v2 = -INFINITY;
#pragma unroll
            for (int j = 0; j < 4; ++j) { if (j != i1 && b4[j] > v2) { v2 = b4[j]; i2 = j; } }
            float w1 = 0.f, w2 = 0.f;
#pragma unroll
            for (int j = 0; j < 4; ++j) { if (j == i1) w1 = s4[j]; if (j == i2) w2 = s4[j]; }
            const int e1 = bg * 4 + i1, e2 = bg * 4 + i2; const float ws = w1 + w2;
            const int s1 = atomicAdd(&cnt[e1], 1); p.list[(size_t)e1 * ECAP + s1] = t * 2 + 0; p.rw[t * 2 + 0] = w1 / ws;
            const int s2 = atomicAdd(&cnt[e2], 1); p.list[(size_t)e2 * ECAP + s2] = t * 2 + 1; p.rw[t * 2 + 1] = w2 / ws;
        }
    }
    __syncthreads();
}
}

namespace {
constexpr int AT_KB = 0;
constexpr int AT_KR = 16384;
constexpr int AT_VB = 24576;
constexpr int AT_CB = 40960;
constexpr int AT_CTL = 41472;
constexpr int AT_LDS = 41984;
constexpr float NEGBIG = -1.0e30f;

template <int VAR>
__device__ __forceinline__ void attn_unit(const Params& p, int l, int b, int hx, int qb, LAS3 char* lds) {
    typedef LAS3 bf16x4 lds_bf16x4;
    constexpr int KC = (VAR == 1) ? 3 : 2;
    const int tid = opaque_tid(p.wid), w = __builtin_amdgcn_readfirstlane(tid >> 6), lane = tid & 63, i = lane & 15, g = lane >> 4;
    const bf16_t *Qp, *Kp, *Vp; int ldq, ldk, ldv, q0, j0, j1, ocol; float c1, slope2 = 0.f;
    if (VAR == 0) { Qp = p.proj + PC_AQ + hx * 64; Kp = p.proj + PC_AK + hx * 64; Vp = p.proj + PC_AV + hx * 64; ldq = ldk = ldv = NP;
                    q0 = qb * 256 + 32 * w; j0 = 0; j1 = 4 * qb + 3; ocol = hx * 64; c1 = 0.125f * LOG2E; }
    else if (VAR == 1) { Qp = p.qm + hx * 96; Kp = p.km + hx * 96; Vp = p.vm + hx * 64; ldq = 384; ldk = 384; ldv = 256;
                    q0 = qb * 256 + 32 * w; j0 = 0; j1 = 4 * qb + 3; ocol = 256 + hx * 64; c1 = 0.10206207261596577f * LOG2E; }
    else if (VAR == 2) { const int qh = hx * 2 + (w >> 2); Qp = p.proj + PC_CQ + qh * 64; Kp = p.proj + PC_CK + hx * 64; Vp = p.proj + PC_CV + hx * 64; ldq = ldk = ldv = NP;
                    q0 = qb * 128 + 32 * (w & 3); j0 = 2 * qb - 2 > 0 ? 2 * qb - 2 : 0; j1 = 2 * qb + 1; ocol = 512 + qh * 64; c1 = 0.125f * LOG2E;
                    slope2 = exp2f(-(float)(qh + 1)) * LOG2E; }
    else { const int hd = w >> 1; Qp = p.proj + PC_DQ + hd * 64; Kp = p.proj + PC_DK; Vp = p.proj + PC_DV; ldq = ldk = ldv = NP;
                    q0 = qb * 64 + 32 * (w & 1); j0 = 0; j1 = qb; ocol = 768 + hd * 64; c1 = 0.125f * LOG2E; slope2 = exp2f(-(float)(hd + 5)) * LOG2E; }
    const size_t tok0 = (size_t)b * S;
    bf16x8 qf[2][KC];
#pragma unroll
    for (int qt = 0; qt < 2; ++qt)
#pragma unroll
        for (int kc = 0; kc < KC; ++kc) qf[qt][kc] = *(const bf16x8*)(Qp + (tok0 + q0 + 16 * qt + i) * ldq + kc * 32 + 8 * g);
    if (VAR == 1) {
#pragma unroll
        for (int qt = 0; qt < 2; ++qt) {
            const int pos = q0 + 16 * qt + i;
            const u32x4 mine = __builtin_bit_cast(u32x4, qf[qt][KC - 1]);
            u32x4 oth; oth.x = __shfl_xor(mine.x, 32); oth.y = __shfl_xor(mine.y, 32); oth.z = __shfl_xor(mine.z, 32); oth.w = __shfl_xor(mine.w, 32);
            const float* rt = p.ropetab + (size_t)(pos * 16 + (g & 1) * 8) * 2;
            const float sg = (g < 2) ? -1.f : 1.f;
            u32x4 res;
#pragma unroll
            for (int e2 = 0; e2 < 4; ++e2) {
                const f32x4 cs = *(const f32x4*)(rt + e2 * 4);
                const unsigned mw_ = e2 == 0 ? mine.x : e2 == 1 ? mine.y : e2 == 2 ? mine.z : mine.w, ow_ = e2 == 0 ? oth.x : e2 == 1 ? oth.y : e2 == 2 ? oth.z : oth.w;
                const float r0 = bflo(mw_) * cs[0] + sg * bflo(ow_) * cs[1], r1 = bfhi(mw_) * cs[2] + sg * bfhi(ow_) * cs[3];
                const unsigned pk = cvt_pk_bf16(r0, r1);
                if (e2 == 0) res.x = pk; else if (e2 == 1) res.y = pk; else if (e2 == 2) res.z = pk; else res.w = pk;
            }
            qf[qt][KC - 1] = __builtin_bit_cast(bf16x8, res);
        }
    }
    f32x4 o[2][4];
#pragma unroll
    for (int qt = 0; qt < 2; ++qt)
#pragma unroll
        for (int dt = 0; dt < 4; ++dt) o[qt][dt] = (f32x4){0.f, 0.f, 0.f, 0.f};
    float mrow[2] = {NEGBIG, NEGBIG}, lsum[2] = {0.f, 0.f};
    const int sr = tid >> 3, sc8 = tid & 7;
    const int kdst = sr * 128 + ((sc8 ^ ((sr >> 1) & 7)) << 4);
    const int vdst = sr * 128 + (((((sc8 >> 1) ^ ((sr >> 1) & 3)) << 1) | (sc8 & 1)) << 4);
    const int rr = (tid & 255) >> 2, rc4 = tid & 3;
    const int rdst = rr * 64 + ((rc4 ^ ((rr >> 1) & 3)) << 4);
    u32x4 kst, vst, rst = {0u, 0u, 0u, 0u}; float cst = 0.f;
    u32x2 mw[2] = {{0u, 0u}, {0u, 0u}}, mwn[2] = {{0u, 0u}, {0u, 0u}};
#define AT_LOAD(j) do { const size_t _kr = tok0 + 64 * (j) + sr; \
        kst = *(const u32x4*)(Kp + _kr * ldk + sc8 * 8); vst = *(const u32x4*)(Vp + _kr * ldv + sc8 * 8); \
        if (VAR == 1 && tid < 256) rst = *(const u32x4*)(Kp + (tok0 + 64 * (j) + rr) * ldk + 64 + rc4 * 8); \
        if (VAR == 0 && tid < 64) cst = p.cbF[((size_t)b * 4 + hx) * S + 64 * (j) + tid]; \
        if (VAR == 3) { _Pragma("unroll") for (int _q = 0; _q < 2; ++_q) mwn[_q] = *(const u32x2*)(p.mask + (tok0 + q0 + 16 * _q + i) * 64 + 2 * (j)); } } while (0)
#define AT_WRITE(buf) do { *(LAS3 u32x4*)(lds + AT_KB + (buf) * 8192 + kdst) = kst; *(LAS3 u32x4*)(lds + AT_VB + (buf) * 8192 + vdst) = vst; \
        if (VAR == 1 && tid < 256) *(LAS3 u32x4*)(lds + AT_KR + (buf) * 4096 + rdst) = rst; \
        if (VAR == 0 && tid < 64) *(LAS3 float*)(lds + AT_CB + (buf) * 256 + tid * 4) = cst; } while (0)
    AT_LOAD(j0);
    AT_WRITE(j0 & 1);
    if (VAR == 3) { mw[0] = mwn[0]; mw[1] = mwn[1]; }
    __syncthreads();
    const int swk = (i >> 1) & 7;
    for (int j = j0; j <= j1; ++j) {
        const int buf = j & 1;
        if (j < j1) AT_LOAD(j + 1);
        bool need = (64 * j <= q0 + 31);
        if (VAR == 2) need = need && (64 * j + 63 >= q0 - 127);
        if (need) {
            const LAS3 char* Kb = lds + AT_KB + buf * 8192; const LAS3 char* Vb = lds + AT_VB + buf * 8192;
            f32x4 s[2][4];
#pragma unroll
            for (int mt = 0; mt < 4; ++mt) {
                s[0][mt] = (f32x4){0.f, 0.f, 0.f, 0.f}; s[1][mt] = (f32x4){0.f, 0.f, 0.f, 0.f};
#pragma unroll
                for (int kc = 0; kc < 2; ++kc) {
                    const bf16x8 kf = *(const LAS3 bf16x8*)(Kb + (mt * 16 + i) * 128 + (((kc * 4 + g) ^ swk) << 4));
                    s[0][mt] = __builtin_amdgcn_mfma_f32_16x16x32_bf16(kf, qf[0][kc], s[0][mt], 0, 0, 0);
                    s[1][mt] = __builtin_amdgcn_mfma_f32_16x16x32_bf16(kf, qf[1][kc], s[1][mt], 0, 0, 0);
                }
                if (VAR == 1) {
                    const bf16x8 kf = *(const LAS3 bf16x8*)(lds + AT_KR + buf * 4096 + (mt * 16 + i) * 64 + ((g ^ (swk & 3)) << 4));
                    s[0][mt] = __builtin_amdgcn_mfma_f32_16x16x32_bf16(kf, qf[0][KC - 1], s[0][mt], 0, 0, 0);
                    s[1][mt] = __builtin_amdgcn_mfma_f32_16x16x32_bf16(kf, qf[1][KC - 1], s[1][mt], 0, 0, 0);
                }
            }
            bool full = (64 * j + 63 <= q0);
            if (VAR == 2) full = full && (64 * j >= q0 - 96);
            if (VAR == 3) full = false;
            bf16x8 pf[2][2];
#pragma unroll
            for (int qt = 0; qt < 2; ++qt) {
                const int t = q0 + 16 * qt + i;
                float x[4][4];
#pragma unroll
                for (int mt = 0; mt < 4; ++mt) {
                    f32x4 cb = {0.f, 0.f, 0.f, 0.f};
                    if (VAR == 0) cb = *(const LAS3 f32x4*)(lds + AT_CB + buf * 256 + (16 * mt + 4 * g) * 4);
#pragma unroll
                    for (int r = 0; r < 4; ++r) {
                        const int key = 64 * j + 16 * mt + 4 * g + r;
                        float v = s[qt][mt][r] * c1;
                        if (VAR == 0) v += cb[r];
                        if (VAR == 2) v += slope2 * (float)(key - t);
                        if (VAR == 3) v += slope2 * (float)key;
                        if (!full) {
                            bool ok;
                            if (VAR == 0 || VAR == 1) ok = key <= t;
                            else if (VAR == 2) ok = (key <= t) && (key > t - 128);
                            else { const int kk = 16 * mt + 4 * g + r; ok = (((kk < 32) ? (mw[qt].x >> kk) : (mw[qt].y >> (kk - 32))) & 1u) != 0u; }
                            v = ok ? v : NEGBIG;
                        }
                        x[mt][r] = v;
                    }
                }
                float mx = x[0][0];
#pragma unroll
                for (int mt = 0; mt < 4; ++mt)
#pragma unroll
                    for (int r = 0; r < 4; ++r) mx = fmaxf(mx, x[mt][r]);
                mx = fmaxf(mx, __shfl_xor(mx, 16)); mx = fmaxf(mx, __shfl_xor(mx, 32));
                const float mn = fmaxf(mrow[qt], mx), alpha = __builtin_amdgcn_exp2f(mrow[qt] - mn);
                mrow[qt] = mn;
                float ps = 0.f;
#pragma unroll
                for (int mt = 0; mt < 4; ++mt)
#pragma unroll
                    for (int r = 0; r < 4; ++r) { x[mt][r] = __builtin_amdgcn_exp2f(x[mt][r] - mn); ps += x[mt][r]; }
                lsum[qt] = lsum[qt] * alpha + ps;
#pragma unroll
                for (int dt = 0; dt < 4; ++dt) o[qt][dt] = o[qt][dt] * alpha;
#pragma unroll
                for (int c = 0; c < 2; ++c) {
                    u32x4 pk; pk.x = cvt_pk_bf16(x[2 * c][0], x[2 * c][1]); pk.y = cvt_pk_bf16(x[2 * c][2], x[2 * c][3]);
                    pk.z = cvt_pk_bf16(x[2 * c + 1][0], x[2 * c + 1][1]); pk.w = cvt_pk_bf16(x[2 * c + 1][2], x[2 * c + 1][3]);
                    pf[qt][c] = __builtin_bit_cast(bf16x8, pk);
                }
            }
            const int q4 = i >> 2, p4 = i & 3;
#pragma unroll
            for (int c = 0; c < 2; ++c) {
                const int row0 = 32 * c + 4 * g + q4, swv = (row0 >> 1) & 3;
#pragma unroll
                for (int dt = 0; dt < 4; ++dt) {
                    const LAS3 char* a0 = Vb + row0 * 128 + ((dt ^ swv) << 5) + p4 * 8;
                    const bf16x4 v0 = __builtin_amdgcn_ds_read_tr16_b64_v4i16((lds_bf16x4*)(a0));
                    const bf16x4 v1 = __builtin_amdgcn_ds_read_tr16_b64_v4i16((lds_bf16x4*)(a0 + 16 * 128));
                    const bf16x8 vf = {v0[0], v0[1], v0[2], v0[3], v1[0], v1[1], v1[2], v1[3]};
                    o[0][dt] = __builtin_amdgcn_mfma_f32_16x16x32_bf16(vf, pf[0][c], o[0][dt], 0, 0, 0);
                    o[1][dt] = __builtin_amdgcn_mfma_f32_16x16x32_bf16(vf, pf[1][c], o[1][dt], 0, 0, 0);
                }
            }
        }
        if (j < j1) { AT_WRITE(buf ^ 1); if (VAR == 3) { mw[0] = mwn[0]; mw[1] = mwn[1]; } }
        __syncthreads();
    }
#undef AT_LOAD
#undef AT_WRITE
#pragma unroll
    for (int qt = 0; qt < 2; ++qt) {
        float lt = lsum[qt]; lt += __shfl_xor(lt, 16); lt += __shfl_xor(lt, 32);
        if (VAR == 2) lt += __builtin_amdgcn_exp2f(p.sinks[l * 4 + hx * 2 + (w >> 2)] * LOG2E - mrow[qt]);
        const float inv = 1.f / lt;
        bf16_t* op = p.merged + (tok0 + q0 + 16 * qt + i) * D + ocol + 4 * g;
#pragma unroll
        for (int dt = 0; dt < 4; ++dt) { const f32x4 v = o[qt][dt] * inv; u32x2 w2; w2.x = cvt_pk_bf16(v[0], v[1]); w2.y = cvt_pk_bf16(v[2], v[3]); *(u32x2*)(op + 16 * dt) = w2; }
    }
}

__device__ __forceinline__ void phase_attn(const Params& p, int l, LAS3 char* lds) {
    const int tid = opaque_tid(p.wid);
    unsigned* qhead = p.ctl + CW_QA + 64 * l;
    volatile LAS3 int* bc = (volatile LAS3 int*)(lds + AT_CTL);
    for (;;) {
        if (tid == 0) *bc = (int)__hip_atomic_fetch_add(qhead, 1u, __ATOMIC_RELAXED, __HIP_MEMORY_SCOPE_AGENT);
        __syncthreads();
        const int idx = __builtin_amdgcn_readfirstlane(*bc);
        __syncthreads();
        if (idx >= 4096) break;
#ifndef ATTN_VMASK
#define ATTN_VMASK 15
#endif
        if (idx < 3072) {
            const int lvl = 7 - idx / 384, rem = idx % 384;
            if (rem < 128) { if (ATTN_VMASK & 2) attn_unit<1>(p, l, rem >> 2, rem & 3, lvl, lds); }
            else if (rem < 256) { if (ATTN_VMASK & 1) attn_unit<0>(p, l, (rem - 128) >> 2, rem & 3, lvl, lds); }
            else { const int d = rem - 256; if (ATTN_VMASK & 8) attn_unit<3>(p, l, d & 31, 0, 4 * lvl + 3 - (d >> 5), lds); }
        } else { const int c = idx - 3072; if (ATTN_VMASK & 4) attn_unit<2>(p, l, c >> 5, (c >> 4) & 1, c & 15, lds); }
    }
}
}

namespace {
constexpr int DS_LD = 2052;
constexpr int DS_CTL = 16 * DS_LD * 4;
constexpr int DS_LDS = DS_CTL + 64;

__device__ __forceinline__ void dsa_unit(const Params& p, int u, LAS3 char* lds) {
    const int tid = opaque_tid(p.wid), w = __builtin_amdgcn_readfirstlane(tid >> 6), lane = tid & 63, i = lane & 15, g = lane >> 4;
    const int b = u >> 7, t0 = (u & 127) * 16;
    const size_t tok0 = (size_t)b * S;
    uint32_t* mbase = p.mask + (tok0 + t0) * 64;
    if (t0 + 16 <= 256) {
#pragma unroll
        for (int qq = 0; qq < 2; ++qq) {
            const int q = 2 * w + qq, n = t0 + q + 1;
            if (lane < 32) { const int lo = lane * 64; unsigned long long bits = (n >= lo + 64) ? ~0ull : (n <= lo ? 0ull : ((1ull << (n - lo)) - 1ull));
                u32x2 o; o.x = (unsigned)bits; o.y = (unsigned)(bits >> 32); *(u32x2*)(mbase + q * 64 + 2 * lane) = o; }
        }
        return;
    }
    const int nreg = (t0 + 16 + 63) >> 6;
    const int ntile = nreg * 4;
    bf16x8 qf[8]; float wq[8];
    {
        const bf16_t* qrow = p.proj + (tok0 + t0 + i) * NP;
#pragma unroll
        for (int h = 0; h < 8; ++h) qf[h] = *(const bf16x8*)(qrow + PC_DQI + h * 32 + 8 * g);
        const u32x4 ww = *(const u32x4*)(qrow + PC_DWI);
        const float sc = 0.35355339059327373f * 0.17677669529663687f;
        wq[0] = bflo(ww.x) * sc; wq[1] = bfhi(ww.x) * sc; wq[2] = bflo(ww.y) * sc; wq[3] = bfhi(ww.y) * sc;
        wq[4] = bflo(ww.z) * sc; wq[5] = bfhi(ww.z) * sc; wq[6] = bflo(ww.w) * sc; wq[7] = bfhi(ww.w) * sc;
    }
    const int tq = t0 + i;
    for (int kt = w; kt < ntile; kt += 8) {
        const bf16x8 kf = *(const bf16x8*)(p.proj + (tok0 + 16 * kt + i) * NP + PC_DKI + 8 * g);
        f32x4 sc4 = {0.f, 0.f, 0.f, 0.f};
#pragma unroll
        for (int h = 0; h < 8; ++h) {
            const f32x4 c = __builtin_amdgcn_mfma_f32_16x16x32_bf16(kf, qf[h], (f32x4){0.f, 0.f, 0.f, 0.f}, 0, 0, 0);
#pragma unroll
            for (int r = 0; r < 4; ++r) sc4[r] += wq[h] * fmaxf(c[r], 0.f);
        }
        u32x4 ko;
#pragma unroll
        for (int r = 0; r < 4; ++r) {
            const int key = 16 * kt + 4 * g + r;
            unsigned uu = __float_as_uint(sc4[r]); if (uu == 0x80000000u) uu = 0u;
            uu = (uu & 0x80000000u) ? ~uu : (uu | 0x80000000u);
            ko[r] = (key <= tq) ? uu : 0u;
        }
        *(LAS3 u32x4*)(lds + ((size_t)i * DS_LD + 16 * kt + 4 * g) * 4) = ko;
    }
    __syncthreads();
#pragma unroll 1
    for (int qq = 0; qq < 2; ++qq) {
        const int q = 2 * w + qq, n = t0 + q + 1;
        unsigned long long mine = 0ull;
        if (n <= 256) {
            if (lane < 32) { const int lo = lane * 64; mine = (n >= lo + 64) ? ~0ull : (n <= lo ? 0ull : ((1ull << (n - lo)) - 1ull)); }
        } else {
            const LAS3 unsigned* kp = (const LAS3 unsigned*)(lds + (size_t)q * DS_LD * 4);
            unsigned key[32];
            int nv = nreg * 64; asm volatile("" : "+s"(nv));
#pragma unroll
            for (int r = 0; r < 32; ++r) { const unsigned v = kp[r * 64 + lane]; key[r] = (r * 64 + lane < nv) ? v : 0u; }
            unsigned thr = 0u; bool exact = false;
            for (int bit = 31; bit >= 0; --bit) {
                const unsigned cand = thr | (1u << bit);
                int cnt = 0;
#pragma unroll
                for (int r = 0; r < 32; ++r) { cnt += __popcll(__ballot(key[r] >= cand)); if ((r & 3) == 3) asm volatile("" : "+s"(cnt)); }
                if (cnt >= 256) { thr = cand; if (cnt == 256) { exact = true; break; } }
            }
            int need = 0;
            if (!exact) { int ngt = 0;
#pragma unroll
                for (int r = 0; r < 32; ++r) { ngt += __popcll(__ballot(key[r] > thr)); if ((r & 3) == 3) asm volatile("" : "+s"(ngt)); }
                need = 256 - ngt; }
            int running = 0;
            const unsigned long long lt = (lane == 0) ? 0ull : (~0ull >> (64 - lane));
#pragma unroll
            for (int r = 0; r < 32; ++r) {
                unsigned long long bs;
                if (exact) bs = __ballot(key[r] >= thr);
                else {
                    const bool eq = key[r] == thr;
                    const unsigned long long be = __ballot(eq);
                    const int rank = running + __popcll(be & lt);
                    bs = __ballot((key[r] > thr) || (eq && rank < need));
                    running += __popcll(be);
                }
                { int ln = lane; asm volatile("" : "+v"(ln)); if (ln == r) mine = bs; }
            }
        }
        if (lane < 32) { u32x2 o; o.x = (unsigned)mine; o.y = (unsigned)(mine >> 32); *(u32x2*)(mbase + q * 64 + 2 * lane) = o; }
    }
    __syncthreads();
}

__device__ __forceinline__ void phase_dsa(const Params& p, int l, LAS3 char* lds) {
    const int tid = opaque_tid(p.wid);
    unsigned* qhead = p.ctl + CW_QD + 64 * l;
    volatile LAS3 int* bc = (volatile LAS3 int*)(lds + DS_CTL);
    for (;;) {
        if (tid == 0) *bc = (int)__hip_atomic_fetch_add(qhead, 1u, __ATOMIC_RELAXED, __HIP_MEMORY_SCOPE_AGENT);
        __syncthreads();
        const int idx = __builtin_amdgcn_readfirstlane(*bc);
        __syncthreads();
        if (idx >= 4096) break;
        const int pb = 127 - (idx >> 5), b = idx & 31;
        dsa_unit(p, b * 128 + pb, lds);
    }
}
}

namespace {
constexpr int LDS_BYTES = 147456;
constexpr int NTHREADS = 512;

template <int PH>
__device__ __forceinline__ void run_phase(const Params& p, int l, unsigned char* smem) {
    LAS3 char* lds = (LAS3 char*)smem;
    PG8_LAS unsigned char* glds = (PG8_LAS unsigned char*)smem;
    const int G = gridDim.x, c = blockIdx.x;
    if constexpr (PH == 0) phase_p0(p, (char*)smem);
    if constexpr (PH == 1) { if (l == 0) phase_norm1<0>(p, 0); else phase_norm1<1>(p, l); }
    if constexpr (PH == 2) { pg8::Gemm g{p.h, p.WinT + (size_t)l * NP * D, D, D, 0}; pg8::StaticOrder S; S.init(T, NP, G, c);
        EpiStoreBf16 E{p.proj, NP}; pg8::gemm_phase<EpiStoreBf16, pg8::StaticOrder, false>(glds, g, S, E, p.wid); }
    if constexpr (PH == 3) phase_prep(p, l);
    if constexpr (PH == 4) { pg8::Gemm g{p.proj + PC_BCQ, p.WqT + (size_t)l * 512 * 256, 256, NP, 0}; pg8::StaticOrder S; S.init(T, 512, G, c);
          EpiMlaQ E{p.qm}; pg8::gemm_phase<EpiMlaQ, pg8::StaticOrder, false>(glds, g, S, E, p.wid); }
    if constexpr (PH == 12) { pg8::Gemm g{p.proj + PC_BCKV, p.WkvT + (size_t)l * 512 * 128, 128, NP, 0}; pg8::StaticOrder S; S.init(T, 512, G, c);
          EpiMlaKV E{p.km, p.vm}; pg8::gemm_phase<EpiMlaKV, pg8::StaticOrder, false>(glds, g, S, E, p.wid); }
    if constexpr (PH == 13) phase_dsa(p, l, lds);
    if constexpr (PH == 5) phase_attn(p, l, lds);
    if constexpr (PH == 6) { pg8::Gemm g{p.merged, p.WoutT + (size_t)l * D * D, D, D, 0}; pg8::StaticOrder S; S.init(T, D, G, c);
        EpiResidual E{p.xo, p.mod + (size_t)l * NB * NMOD + 2 * 1024}; pg8::gemm_phase<EpiResidual, pg8::StaticOrder, false>(glds, g, S, E, p.wid); }
    if constexpr (PH == 7) phase_route(p, l, (char*)smem);
    if constexpr (PH == 8) { const int* cnt = (const int*)(p.ctl + CW_CNT) + l * 16;
        pg8::Gemm g{p.h, p.WguT + (size_t)l * 16 * 512 * 1024, 1024, D, (size_t)512 * 1024}; MoeOrder S; S.init(cnt, p.list, 2, G, c);
        EpiGateUp E{p.hid}; pg8::gemm_phase<EpiGateUp, MoeOrder, true>(glds, g, S, E, p.wid); }
    if constexpr (PH == 9) { const int* cnt = (const int*)(p.ctl + CW_CNT) + l * 16;
        pg8::Gemm g{p.hid, p.WdT + (size_t)l * 16 * 1024 * 256, 256, 256, (size_t)1024 * 256}; MoeOrder S; S.init(cnt, p.list, 4, G, c);
        EpiDown E{p.ys, p.list, p.rw, cnt}; pg8::gemm_phase<EpiDown, MoeOrder, false>(glds, g, S, E, p.wid); }
    if constexpr (PH == 10) phase_norm1<2>(p, 1);
    if constexpr (PH == 11) phase_norm1<0>(p, l);
}
template <int PH>
__global__ void __launch_bounds__(NTHREADS, 2) k_ph(Params p, int l) {
    extern __shared__ __attribute__((aligned(16))) unsigned char smem[];
    p.wid = __builtin_amdgcn_readfirstlane(threadIdx.x >> 6);
    run_phase<PH>(p, l, smem);
}
}


namespace {
struct KArgs { const float* in[20]; float* xo; char* ws; };
constexpr size_t al256(size_t b) { return (b + 255) & ~(size_t)255; }
constexpr size_t WS_CTL = 0;
constexpr size_t WS_MOD = WS_CTL + al256((size_t)CW_WORDS * 4);
constexpr size_t WS_WIN = WS_MOD + al256((size_t)2 * NB * NMOD * 4);
constexpr size_t WS_WOUT = WS_WIN + al256((size_t)2 * NP * D * 2);
constexpr size_t WS_WQ = WS_WOUT + al256((size_t)2 * D * D * 2);
constexpr size_t WS_WKV = WS_WQ + al256((size_t)2 * 512 * 256 * 2);
constexpr size_t WS_WGU = WS_WKV + al256((size_t)2 * 512 * 128 * 2);
constexpr size_t WS_WD = WS_WGU + al256((size_t)2 * 16 * 512 * 1024 * 2);
constexpr size_t WS_ROPE = WS_WD + al256((size_t)2 * 16 * 1024 * 256 * 2);
constexpr size_t WS_RQ = WS_ROPE + al256((size_t)2048 * 16 * 2 * 4);
constexpr size_t WS_RKV = WS_RQ + al256((size_t)T * 4);
constexpr size_t WS_CBF = WS_RKV + al256((size_t)T * 4);
constexpr size_t WS_MASK = WS_CBF + al256((size_t)NB * 4 * S * 4);
constexpr size_t WS_LIST = WS_MASK + al256((size_t)T * 64 * 4);
constexpr size_t WS_RW = WS_LIST + al256((size_t)16 * ECAP * 4);
constexpr size_t WS_H = WS_RW + al256((size_t)T * 2 * 4);
constexpr size_t WS_PROJ = WS_H + al256((size_t)T * D * 2);
constexpr size_t WS_QM = WS_PROJ + al256((size_t)T * NP * 2);
constexpr size_t WS_KM = WS_QM + al256((size_t)T * 384 * 2);
constexpr size_t WS_VM = WS_KM + al256((size_t)T * 384 * 2);
constexpr size_t WS_MERGED = WS_VM + al256((size_t)T * 256 * 2);
constexpr size_t WS_END1 = WS_MERGED + al256((size_t)T * D * 2);
constexpr size_t WS_HID = WS_PROJ;
constexpr size_t WS_YS = WS_HID + al256((size_t)HIDROWS * 256 * 2);
constexpr size_t WS_END2 = WS_YS + al256((size_t)T * 2 * D * 2);
constexpr size_t WS_NEED = WS_END1 > WS_END2 ? WS_END1 : WS_END2;
static_assert(WS_END2 <= WS_MERGED, "MoE overlay must not reach the merged buffer");

__device__ __forceinline__ Params make_params(const KArgs& a) {
    Params p;
    p.x = a.in[0]; p.c = a.in[1]; p.w_ada = a.in[2]; p.b_ada = a.in[3]; p.g_norm1 = a.in[4]; p.w_in = a.in[5]; p.b_forget = a.in[6]; p.g_q_mla = a.in[7];
    p.w_q_up = a.in[8]; p.g_kv_mla = a.in[9]; p.w_kv_up = a.in[10]; p.sinks = a.in[11]; p.w_out = a.in[12]; p.g_norm2 = a.in[13]; p.w_router = a.in[14];
    p.b_router = a.in[15]; p.w_gate = a.in[16]; p.w_up = a.in[17]; p.w_down = a.in[18]; p.g_final = a.in[19];
    p.xo = a.xo; char* ws = a.ws;
    p.ctl = (unsigned*)(ws + WS_CTL); p.mod = (float*)(ws + WS_MOD); p.WinT = (bf16_t*)(ws + WS_WIN); p.WoutT = (bf16_t*)(ws + WS_WOUT);
    p.WqT = (bf16_t*)(ws + WS_WQ); p.WkvT = (bf16_t*)(ws + WS_WKV); p.WguT = (bf16_t*)(ws + WS_WGU); p.WdT = (bf16_t*)(ws + WS_WD);
    p.ropetab = (float*)(ws + WS_ROPE); p.rq = (float*)(ws + WS_RQ); p.rkv = (float*)(ws + WS_RKV); p.cbF = (float*)(ws + WS_CBF);
    p.mask = (uint32_t*)(ws + WS_MASK); p.list = (int*)(ws + WS_LIST); p.rw = (float*)(ws + WS_RW); p.h = (bf16_t*)(ws + WS_H);
    p.proj = (bf16_t*)(ws + WS_PROJ); p.qm = (bf16_t*)(ws + WS_QM); p.km = (bf16_t*)(ws + WS_KM); p.vm = (bf16_t*)(ws + WS_VM);
    p.merged = (bf16_t*)(ws + WS_MERGED); p.hid = (bf16_t*)(ws + WS_HID); p.ys = (bf16_t*)(ws + WS_YS);
    return p;
}
template <int PH>
__device__ __forceinline__ void phase(int l, unsigned char* smem, int wid) {
    typedef const __attribute__((address_space(4))) KArgs* KA4;
    KA4 ka = (KA4)__builtin_amdgcn_kernarg_segment_ptr();
    asm volatile("" : "+s"(ka));
    KArgs a;
#pragma unroll
    for (int i = 0; i < 20; ++i) a.in[i] = ka->in[i];
    a.xo = ka->xo; a.ws = ka->ws;
    Params p = make_params(a); p.wid = wid;
    run_phase<PH>(p, l, smem);
}
__global__ void __launch_bounds__(NTHREADS, 2) fwd(KArgs args) {
    extern __shared__ __attribute__((aligned(16))) unsigned char smem[];
    volatile LAS unsigned* st = (volatile LAS unsigned*)(smem + LDS_BYTES - 16);
    const int wid = __builtin_amdgcn_readfirstlane(threadIdx.x >> 6);
    if (xb_leader(wid)) { st[0] = 0u; st[1] = 0u; st[2] = 0u; st[3] = 0u; }
    __syncthreads();
    XcdBarrier bar = xcd_barrier_post((unsigned*)(args.ws + WS_CTL) + CW_BAR, st, wid);
    phase<0>(0, smem, wid);
    xcd_barrier(bar);
#define LAYER(l) do { \
        phase<1>(l, smem, wid);  xcd_barrier(bar); \
        phase<2>(l, smem, wid);  xcd_barrier(bar); \
        phase<3>(l, smem, wid);  xcd_barrier(bar); \
        phase<4>(l, smem, wid);  phase<12>(l, smem, wid);  phase<13>(l, smem, wid);  xcd_barrier(bar); \
        phase<5>(l, smem, wid);  xcd_barrier(bar); \
        phase<6>(l, smem, wid);  xcd_barrier(bar); \
        phase<7>(l, smem, wid);  xcd_barrier(bar); \
        phase<8>(l, smem, wid);  xcd_barrier(bar); \
        phase<9>(l, smem, wid);  xcd_barrier(bar); } while (0)
    LAYER(0);
    LAYER(1);
    phase<10>(1, smem, wid);
}
}

extern "C" void kernel_launch(void* const* d_in, const int* in_sizes, int n_in, void* d_out, int out_size, void* d_ws, size_t ws_size,
                              hipStream_t stream) {
    KArgs a{};
    for (int i = 0; i < 20; ++i) a.in[i] = (const float*)d_in[i];
    a.xo = (float*)d_out; a.ws = (char*)d_ws;
    if (WS_NEED > ws_size) return;

    static int grid = 0;
    if (!grid) {
        int dev = 0, cus = 0, per_cu = 0;
        (void)hipGetDevice(&dev);
        (void)hipDeviceGetAttribute(&cus, hipDeviceAttributeMultiprocessorCount, dev);
        (void)hipFuncSetAttribute((const void*)fwd, hipFuncAttributeMaxDynamicSharedMemorySize, LDS_BYTES);
        (void)hipOccupancyMaxActiveBlocksPerMultiprocessor(&per_cu, (const void*)fwd, NTHREADS, LDS_BYTES);
        grid = cus > 0 ? cus : 256;
    }
    (void)hipMemsetAsync(a.ws + WS_CTL, 0, (size_t)CW_WORDS * 4, stream);
    fwd<<<dim3(grid), dim3(NTHREADS), LDS_BYTES, stream>>>(a);
}
```

```cpp
#include <hip/hip_runtime.h>
#include <stdint.h>
#define XB_TMO      128
#define XB_XCNT(j)  (256  + 64 * (j))
#define XB_XSUB(j)  (1280 + 64 * (j))
#define XB_XGEN(j)  (2304 + 64 * (j))
#define XB_TOP      3328
#define XB_TOPGEN   3392
#define XCD_BAR_WORDS 3456
#define XB_SPIN_CAP (1u << 20)
#define LAS __attribute__((address_space(3)))

__device__ __forceinline__ unsigned xb_ld(unsigned* p)              { return __hip_atomic_load(p, __ATOMIC_RELAXED, __HIP_MEMORY_SCOPE_AGENT); }
__device__ __forceinline__ unsigned xb_add(unsigned* p, unsigned v) { return __hip_atomic_fetch_add(p, v, __ATOMIC_RELAXED, __HIP_MEMORY_SCOPE_AGENT); }
__device__ __forceinline__ unsigned xb_xcc_id() { return (unsigned)__builtin_amdgcn_s_getreg((3 << 11) | 20) & 0xFu; }
#define XB_SPIN(cond, bar) do { unsigned _sp = 0; while (cond) { __builtin_amdgcn_s_sleep(1); \
    if ((++_sp & 255u) == 0u) { if (xb_ld(&(bar)[XB_TMO])) break; if (_sp > XB_SPIN_CAP) { atomicAdd(&(bar)[XB_TMO], 1u); break; } } } } while (0)

struct XcdBarrier { unsigned* bar; unsigned x; volatile LAS unsigned* st; int wid; };
__device__ __forceinline__ bool xb_leader(int wid) { return wid == 0 && __builtin_amdgcn_mbcnt_hi(~0u, __builtin_amdgcn_mbcnt_lo(~0u, 0u)) == 0u; }

__device__ __forceinline__ XcdBarrier xcd_barrier_post(unsigned* bar, volatile LAS unsigned* st, int wid) {
    XcdBarrier b; b.bar = bar; b.x = xb_xcc_id(); b.st = st; b.wid = wid;
    if (xb_leader(wid)) (void)xb_add(&bar[XB_XCNT(b.x)], 1u);
    return b;
}
__device__ __forceinline__ void xcd_barrier_complete(unsigned* bar, unsigned x, unsigned& nloc, unsigned& nx) {
    const unsigned G = gridDim.x * gridDim.y * gridDim.z;
    unsigned sum, cnt, mine, sp = 0u;
    for (;;) {
        sum = 0u; cnt = 0u; mine = 0u;
#pragma unroll
        for (unsigned j = 0; j < 16; ++j) { const unsigned c = xb_ld(&bar[XB_XCNT(j)]); sum += c; cnt += (c > 0u) ? 1u : 0u; mine = (j == x) ? c : mine; }
        if (sum == G) break;
        __builtin_amdgcn_s_sleep(1);
        if ((++sp & 255u) == 0u) { if (xb_ld(&bar[XB_TMO])) break; if (sp > XB_SPIN_CAP) { atomicAdd(&bar[XB_TMO], 1u); break; } }
    }
    nloc = mine > 0u ? mine : 1u; nx = cnt > 0u ? cnt : 1u;
}
__device__ __forceinline__ void xcd_barrier(const XcdBarrier& b) {
    asm volatile("s_waitcnt vmcnt(0)" ::: "memory");
    __syncthreads();
    if (xb_leader(b.wid)) {
        unsigned* bar = b.bar;
        __builtin_amdgcn_s_waitcnt(0);
        unsigned nloc = b.st[0], nx = b.st[1];
        if (nloc == 0u) { xcd_barrier_complete(bar, b.x, nloc, nx); b.st[0] = nloc; b.st[1] = nx; }
        const unsigned old = xb_add(&bar[XB_XSUB(b.x)], 1u);
        const unsigned gen = old / nloc;
        if (old + 1u == (gen + 1u) * nloc) {
            __builtin_amdgcn_fence(__ATOMIC_RELEASE, "agent");
            asm volatile("s_waitcnt vmcnt(0)" ::: "memory");
            const unsigned og = xb_add(&bar[XB_TOP], 1u);
            const unsigned tg = og / nx;
            if (og + 1u == (tg + 1u) * nx) xb_add(&bar[XB_TOPGEN], 1u);
            else XB_SPIN(xb_ld(&bar[XB_TOPGEN]) == tg, bar);
            __builtin_amdgcn_fence(__ATOMIC_ACQUIRE, "agent");
            xb_add(&bar[XB_XGEN(b.x)], 1u);
            asm volatile("s_waitcnt vmcnt(0)" ::: "memory");
        } else {
            XB_SPIN(xb_ld(&bar[XB_XGEN(b.x)]) == gen, bar);
            __builtin_amdgcn_fence(__ATOMIC_ACQUIRE, "agent");
            asm volatile("s_waitcnt vmcnt(0)" ::: "memory");
        }
    }
    __syncthreads();
}

#define LAS3 __attribute__((address_space(3)))
namespace {
typedef unsigned short bf16_t;
typedef short bf16x8 __attribute__((ext_vector_type(8)));
typedef short bf16x4 __attribute__((ext_vector_type(4)));
typedef float f32x4 __attribute__((ext_vector_type(4)));
typedef float f32x2 __attribute__((ext_vector_type(2)));
typedef unsigned u32x4 __attribute__((ext_vector_type(4)));
typedef unsigned u32x2 __attribute__((ext_vector_type(2)));

constexpr int D = 1024, NB = 32, S = 2048, T = NB * S, NIN = 2380, NP = 2560, NMOD = 6144;
constexpr int OFF_AQ = 0, OFF_AK = 256, OFF_AV = 512, OFF_AF = 768, OFF_BCQ = 772, OFF_BCKV = 1028, OFF_BKR = 1156,
              OFF_CQ = 1188, OFF_CK = 1444, OFF_CV = 1572, OFF_DQ = 1700, OFF_DK = 1956, OFF_DV = 2020,
              OFF_DQI = 2084, OFF_DKI = 2340, OFF_DWI = 2372;
constexpr int PC_AQ = 0, PC_AK = 256, PC_AV = 512, PC_BCQ = 768, PC_BCKV = 1024, PC_BKR = 1152, PC_CQ = 1184, PC_CK = 1440, PC_CV = 1568,
              PC_DQ = 1696, PC_DK = 1952, PC_DV = 2016, PC_DQI = 2080, PC_DKI = 2336, PC_DWI = 2368, PC_AF = 2376;
constexpr float EPS = 1e-6f;
constexpr float LOG2E = 1.4426950408889634f;
constexpr int ECAP = T;
constexpr int HIDROWS = 2 * T + 16 * 256;

__host__ __device__ __forceinline__ int orig_col(int n) { return n < 768 ? n : (n < 2376 ? n + 4 : (n < 2380 ? n - 1608 : -1)); }
__device__ __forceinline__ int opaque_tid(int wid) {
    int t = wid * 64 + (int)__builtin_amdgcn_mbcnt_hi(~0u, __builtin_amdgcn_mbcnt_lo(~0u, 0u));
    asm volatile("" : "+v"(t)); return t; }
__device__ __forceinline__ float bf2f(bf16_t v) { return __uint_as_float((unsigned)v << 16); }
__device__ __forceinline__ bf16_t f2bf(float f) { unsigned u = __float_as_uint(f); u += 0x7FFFu + ((u >> 16) & 1u); return (bf16_t)(u >> 16); }
typedef __bf16 bf16x2_native __attribute__((ext_vector_type(2)));
__device__ __forceinline__ unsigned cvt_pk_bf16(float lo, float hi) { const f32x2 v = {lo, hi}; return __builtin_bit_cast(unsigned, __builtin_convertvector(v, bf16x2_native)); }
__device__ __forceinline__ float bflo(unsigned w) { return __uint_as_float(w << 16); }
__device__ __forceinline__ float bfhi(unsigned w) { return __uint_as_float(w & 0xFFFF0000u); }
__device__ __forceinline__ float wave_sum(float v) {
#pragma unroll
    for (int o = 32; o > 0; o >>= 1) v += __shfl_xor(v, o);
    return v;
}
}

namespace pg8 {
#define PG8_LAS __attribute__((address_space(3)))
constexpr int BM = 256, BK = 64, HALF = 128, HTB = HALF * BK * 2, STAGE_BYTES = 8 * HTB, NXCD = 8, WGM = 8;

__host__ __device__ __forceinline__ int lds_byte(int r, int c) { const int st = (r >> 4) * 2 + (c >> 5), rr = r & 15, cc = c & 31, ob = rr * 64 + cc * 2; return st * 1024 + (ob ^ (((ob >> 9) & 1) << 5)); }
__host__ __device__ __forceinline__ void stage_rc(int b, int& R, int& C) { const int st = b / 1024, sb = b % 1024, swz = sb ^ (((sb >> 9) & 1) << 5); R = (st >> 1) * 16 + swz / 64; C = (st & 1) * 32 + (swz % 64) / 2; }
__host__ __device__ __forceinline__ int perm32(int rho) { const int n = rho >> 4, i = rho & 15; return 8 * (i >> 2) + 4 * n + (i & 3); }

struct Unit { int pm, pn, e, mt; };
struct Gemm { const bf16_t* A; const bf16_t* Bt; int K; int lda; size_t bstride; };

struct StaticOrder {
    int nM, nN, nwg, G, c;
    __host__ __device__ void init(int M, int N, int G_, int c_) { nM = M / BM; nN = N / BM; nwg = nM * nN; G = G_; c = c_; }
    __host__ __device__ bool next(int i, Unit& u) const {
        const long L = (long)i * G + c; if (L >= nwg) return false;
        int wgid = (int)L; { const int q = nwg / NXCD, r = nwg % NXCD, xcd = wgid % NXCD, off = wgid / NXCD; wgid = (xcd < r ? xcd * (q + 1) : r * (q + 1) + (xcd - r) * q) + off; }
        const int nig = WGM * nN, gid = wgid / nig, fm = gid * WGM, gsz = (nM - fm) < WGM ? (nM - fm) : WGM;
        u.pm = fm + ((wgid % nig) % gsz); u.pn = (wgid % nig) / gsz; u.e = 0; u.mt = 0; return true;
    }
    __device__ __forceinline__ int arow(const Unit& u, int r) const { return u.pm * BM + r; }
};

template <class Epi, class Sched, bool GATHER>
__device__ __forceinline__ void gemm_phase(PG8_LAS unsigned char* lds, const Gemm g, const Sched& S, const Epi& E, int wave_index) {
    const int tid = opaque_tid(wave_index), wid = __builtin_amdgcn_readfirstlane(tid >> 6), lane = tid & 63, wr = wid >> 2, wc = wid & 3, fr = lane & 15, fq = lane >> 4;
    int K_ = g.K; asm volatile("" : "+s"(K_));
    const int K = K_, nt = K / BK, lda = g.lda;
    int Ra[2], Ca[2]; unsigned voffB[2], voffA[2];
#pragma unroll
    for (int i = 0; i < 2; ++i) { int R, C; stage_rc(tid * 16 + i * 8192, R, C); const int Rb = Epi::PERM ? ((R & ~31) + perm32(R & 31)) : R;
        Ra[i] = R; Ca[i] = C; voffB[i] = (unsigned)(Rb * K + C) * 2u; voffA[i] = (unsigned)(R * lda + C) * 2u; }
    const size_t kstep = (size_t)(BK * 2);
    const size_t hstepB = (size_t)HALF * K * 2;
    const size_t tstepB = 2 * hstepB;
    const size_t hstepA = (size_t)HALF * lda * 2, tstepA = 2 * hstepA;
    const unsigned ldsw = (unsigned)wid * 1024u;
    const int aoff = lds_byte(wr * 64 + fr, fq * 8), boff = lds_byte(wc * 32 + fr, fq * 8);
#define PG8_SA(b, h) (((b) * 2 + (h)) * HTB)
#define PG8_SB(b, h) ((4 + (b) * 2 + (h)) * HTB)
#define PG8_STAGE(bufoff, gbase, voff) do { _Pragma("unroll") for (int _i = 0; _i < 2; ++_i) \
        __builtin_amdgcn_global_load_lds((const unsigned*)((const char*)(gbase) + (voff)[_i]), (PG8_LAS unsigned*)(lds + (bufoff) + ldsw + _i * 8192), 16, 0, 0); } while (0)
#define PG8_STAGEA(bufoff, kptr, VO, h) do { _Pragma("unroll") for (int _i = 0; _i < 2; ++_i) { \
        const char* _src; if constexpr (GATHER) _src = (const char*)(kptr) + (VO)[_i][h]; else _src = (const char*)(kptr) + (size_t)(h) * hstepA + voffA[_i]; \
        __builtin_amdgcn_global_load_lds((const unsigned*)_src, (PG8_LAS unsigned*)(lds + (bufoff) + ldsw + _i * 8192), 16, 0, 0); } } while (0)
#define PG8_LDA(dst, b, h) do { _Pragma("unroll") for (int m = 0; m < 4; ++m) _Pragma("unroll") for (int k = 0; k < 2; ++k) dst[m][k] = *(const PG8_LAS bf16x8*)(lds + PG8_SA(b, h) + aoff + m * 2048 + k * 1024); } while (0)
#define PG8_LDB(dst, b, h) do { _Pragma("unroll") for (int n = 0; n < 2; ++n) _Pragma("unroll") for (int k = 0; k < 2; ++k) dst[n][k] = *(const PG8_LAS bf16x8*)(lds + PG8_SB(b, h) + boff + n * 2048 + k * 1024); } while (0)
#define PG8_MMA(ai, bj, At, Bt) do { __builtin_amdgcn_s_setprio(1); _Pragma("unroll") for (int m = 0; m < 4; ++m) _Pragma("unroll") for (int n = 0; n < 2; ++n) _Pragma("unroll") for (int k = 0; k < 2; ++k) \
        acc[ai][bj][m][n] = __builtin_amdgcn_mfma_f32_16x16x32_bf16(Bt[n][k], At[m][k], acc[ai][bj][m][n], 0, 0, 0); __builtin_amdgcn_s_setprio(0); } while (0)
#define PG8_WAIT_V(n) asm volatile("s_waitcnt vmcnt(" #n ")" ::: "memory")
#define PG8_WAIT_L(n) asm volatile("s_waitcnt lgkmcnt(" #n ")" ::: "memory")
#define PG8_BAR __builtin_amdgcn_s_barrier()
#define PG8_SCHED __builtin_amdgcn_sched_barrier(0)
#define PG8_SETV(V, u) do { _Pragma("unroll") for (int _i = 0; _i < 2; ++_i) _Pragma("unroll") for (int _h = 0; _h < 2; ++_h) { \
        const int _row = GATHER ? S.arow(u, _h * HALF + Ra[_i]) : ((u).pm * BM + _h * HALF + Ra[_i]); V[_i][_h] = (unsigned)(((size_t)_row * lda + Ca[_i]) * 2); } } while (0)
    Unit cur, nxt; int ui = 0;
    if (!S.next(0, cur)) return;
    f32x4 acc[2][2][4][2];
#pragma unroll
    for (int a = 0; a < 2; ++a)
#pragma unroll
        for (int b = 0; b < 2; ++b)
#pragma unroll
            for (int m = 0; m < 4; ++m)
#pragma unroll
                for (int n = 0; n < 2; ++n) acc[a][b][m][n] = (f32x4){0.f, 0.f, 0.f, 0.f};
    bf16x8 At[4][2], B0[2][2], B1[2][2];
    unsigned vA[2][2], vN[2][2];
    if constexpr (GATHER) { PG8_SETV(vA, cur); }
    const char* cA = (const char*)g.A + (GATHER ? (size_t)0 : (size_t)cur.pm * tstepA);
    const char* cB = (const char*)g.Bt + ((size_t)cur.e * g.bstride) * 2 + (size_t)cur.pn * tstepB;
    PG8_STAGE(PG8_SB(0, 0), cB, voffB); PG8_STAGE(PG8_SB(0, 1), cB + hstepB, voffB); PG8_STAGEA(PG8_SA(0, 0), cA, vA, 0); PG8_STAGEA(PG8_SA(0, 1), cA, vA, 1);
    if (wr == 1) PG8_BAR;
    PG8_WAIT_V(2); PG8_BAR;
    PG8_STAGE(PG8_SB(1, 0), cB + kstep, voffB); PG8_STAGEA(PG8_SA(1, 0), cA + kstep, vA, 0); PG8_STAGE(PG8_SB(1, 1), cB + hstepB + kstep, voffB);
    PG8_WAIT_V(6); PG8_BAR;
    for (;;) {
        const bool has_next = S.next(ui + 1, nxt);
        if constexpr (GATHER) { if (has_next) { PG8_SETV(vN, nxt); }
        else {
#pragma unroll
            for (int _i = 0; _i < 2; ++_i)
#pragma unroll
                for (int _h = 0; _h < 2; ++_h) vN[_i][_h] = vA[_i][_h];
        } }
        const char* nA = (!GATHER && has_next) ? (const char*)g.A + (size_t)nxt.pm * tstepA : cA;
        const char* nB = has_next ? (const char*)g.Bt + ((size_t)nxt.e * g.bstride) * 2 + (size_t)nxt.pn * tstepB : cB;
#pragma unroll 1
        for (int t = 0; t < nt; t += 2) {
            const bool last = (t == nt - 2);
            const char* a1 = cA + (size_t)(t + 1) * kstep;
            const char* a2 = last ? nA : cA + (size_t)(t + 2) * kstep; const char* b2 = last ? nB : cB + (size_t)(t + 2) * kstep;
            const char* a3 = a2 + kstep; const char* b3 = b2 + kstep;
            unsigned v2[2][2];
            if constexpr (GATHER) {
#pragma unroll
            for (int _i = 0; _i < 2; ++_i)
#pragma unroll
                for (int _h = 0; _h < 2; ++_h) v2[_i][_h] = last ? vN[_i][_h] : vA[_i][_h];
            }
            PG8_LDB(B0, 0, 0); PG8_LDB(B1, 0, 1); PG8_SCHED; PG8_LDA(At, 0, 0); PG8_STAGEA(PG8_SA(1, 1), a1, vA, 1);
            PG8_WAIT_V(8); PG8_WAIT_L(0); PG8_BAR; PG8_MMA(0, 0, At, B0); PG8_MMA(0, 1, At, B1); PG8_BAR; PG8_SCHED;
            PG8_LDA(At, 0, 1); PG8_STAGE(PG8_SB(0, 0), b2, voffB); PG8_STAGE(PG8_SB(0, 1), b2 + hstepB, voffB); PG8_STAGEA(PG8_SA(0, 0), a2, v2, 0);
            PG8_WAIT_V(8); PG8_WAIT_L(0); PG8_BAR; PG8_MMA(1, 0, At, B0); PG8_MMA(1, 1, At, B1); PG8_BAR; PG8_SCHED;
            PG8_LDB(B0, 1, 0); PG8_LDB(B1, 1, 1); PG8_SCHED; PG8_LDA(At, 1, 0); PG8_STAGEA(PG8_SA(0, 1), a2, v2, 1);
            PG8_WAIT_V(8); PG8_WAIT_L(0); PG8_BAR; PG8_MMA(0, 0, At, B0); PG8_MMA(0, 1, At, B1); PG8_BAR; PG8_SCHED;
            PG8_LDA(At, 1, 1); PG8_STAGE(PG8_SB(1, 0), b3, voffB); PG8_STAGE(PG8_SB(1, 1), b3 + hstepB, voffB); PG8_STAGEA(PG8_SA(1, 0), a3, v2, 0);
            PG8_WAIT_V(8); PG8_WAIT_L(0); PG8_BAR; PG8_MMA(1, 0, At, B0); PG8_MMA(1, 1, At, B1); PG8_BAR; PG8_SCHED;
        }
        if (wr == 0) PG8_BAR;
        E(acc, cur, wr, wc, fr, fq);
        if (!has_next) break;
#pragma unroll
        for (int a = 0; a < 2; ++a)
#pragma unroll
            for (int b = 0; b < 2; ++b)
#pragma unroll
                for (int m = 0; m < 4; ++m)
#pragma unroll
                    for (int n = 0; n < 2; ++n) acc[a][b][m][n] = (f32x4){0.f, 0.f, 0.f, 0.f};
        cur = nxt; cB = nB; cA = nA; ++ui;
        if constexpr (GATHER) {
#pragma unroll
        for (int _i = 0; _i < 2; ++_i)
#pragma unroll
            for (int _h = 0; _h < 2; ++_h) vA[_i][_h] = vN[_i][_h];
        }
        if (wr == 1) PG8_BAR;
    }
    PG8_WAIT_V(0);
    PG8_BAR;
#undef PG8_SA
#undef PG8_SB
#undef PG8_STAGE
#undef PG8_STAGEA
#undef PG8_LDA
#undef PG8_LDB
#undef PG8_MMA
#undef PG8_WAIT_V
#undef PG8_WAIT_L
#undef PG8_BAR
#undef PG8_SCHED
#undef PG8_SETV
}
}

namespace {
struct Params {
    const float *x, *c, *w_ada, *b_ada, *g_norm1, *w_in, *b_forget, *g_q_mla, *w_q_up, *g_kv_mla, *w_kv_up, *sinks, *w_out, *g_norm2,
                *w_router, *b_router, *w_gate, *w_up, *w_down, *g_final;
    float* xo;
    unsigned* ctl;
    float* mod;
    bf16_t* WinT;
    bf16_t* WoutT;
    bf16_t* WqT;
    bf16_t* WkvT;
    bf16_t* WguT;
    bf16_t* WdT;
    float* ropetab;
    float* rq; float* rkv;
    float* cbF;
    uint32_t* mask;
    bf16_t* h;
    bf16_t* proj;
    bf16_t* qm; bf16_t* km; bf16_t* vm;
    bf16_t* merged;
    bf16_t* hid;
    bf16_t* ys;
    int* list;
    float* rw;
    int wid;
    int qslot;
};
constexpr int CW_BAR = 0;
constexpr int CW_CNT = 3584;
constexpr int CW_QA = 3648;
constexpr int CW_QD = 3840;
constexpr int CW_WORDS = 4096;
}

namespace {
template <class F>
__device__ __forceinline__ void conv_job(bf16_t* __restrict__ dst, int nrows, int K, F f, int gtid, int gthreads) {
    const int k8n = K >> 3; const long items = (long)nrows * k8n;
    for (long it = gtid; it < items; it += gthreads) {
        const int n = (int)(it % nrows), k0 = (int)(it / nrows) * 8;
        float v[8];
#pragma unroll
        for (int j = 0; j < 8; ++j) v[j] = f(n, k0 + j);
        u32x4 w; w.x = cvt_pk_bf16(v[0], v[1]); w.y = cvt_pk_bf16(v[2], v[3]); w.z = cvt_pk_bf16(v[4], v[5]); w.w = cvt_pk_bf16(v[6], v[7]);
        *(u32x4*)(dst + (size_t)n * K + k0) = w;
    }
}
struct FWin { const float* w; __device__ float operator()(int n, int k) const { const int o = orig_col(n); return o >= 0 ? w[(size_t)k * NIN + o] : 0.f; } };
struct FT { const float* w; int ld; __device__ float operator()(int n, int k) const { return w[(size_t)k * ld + n]; } };
struct FTg { const float* w; const float* g; int ld, nmax; __device__ float operator()(int n, int k) const { return n < nmax ? g[k] * w[(size_t)k * ld + n] : 0.f; } };
struct FGu { const float* wg; long du; __device__ float operator()(int n, int k) const { const int q = n >> 5, r = n & 31, col = 16 * q + (r & 15); const long sel = (r < 16) ? 0l : du; return wg[sel + (long)k * 256 + col]; } };

__device__ __forceinline__ void phase_p0(const Params& p, char* lds) {
    const int tid = opaque_tid(p.wid), gtid = blockIdx.x * blockDim.x + tid, gthreads = gridDim.x * blockDim.x;
    for (int l = 0; l < 2; ++l) {
        conv_job(p.WinT + (size_t)l * NP * D, NP, D, FWin{p.w_in + (size_t)l * D * NIN}, gtid, gthreads);
        conv_job(p.WoutT + (size_t)l * D * D, D, D, FT{p.w_out + (size_t)l * D * D, D}, gtid, gthreads);
        conv_job(p.WqT + (size_t)l * 512 * 256, 512, 256, FTg{p.w_q_up + (size_t)l * 256 * 384, p.g_q_mla + l * 256, 384, 384}, gtid, gthreads);
        conv_job(p.WkvT + (size_t)l * 512 * 128, 512, 128, FTg{p.w_kv_up + (size_t)l * 128 * 512, p.g_kv_mla + l * 128, 512, 512}, gtid, gthreads);
        for (int e = 0; e < 16; ++e) {
            const size_t le = (size_t)l * 16 + e;
            conv_job(p.WguT + le * 512 * 1024, 512, 1024, FGu{p.w_gate + le * 1024 * 256, (long)(p.w_up - p.w_gate)}, gtid, gthreads);
            conv_job(p.WdT + le * 1024 * 256, 1024, 256, FT{p.w_down + le * 256 * 1024, 1024}, gtid, gthreads);
        }
    }
    for (int it = gtid; it < 2048 * 16; it += gthreads) {
        const int pos = it >> 4, i = it & 15;
        const float inv = powf(10000.0f, -(float)i / 16.0f), ang = (float)pos * inv;
        p.ropetab[it * 2] = cosf(ang); p.ropetab[it * 2 + 1] = sinf(ang);
    }
    float* ca = (float*)lds;
    for (int i = tid; i < NB * 1024; i += 512) { const float v = p.c[i]; ca[i] = v / (1.f + __expf(-v)); }
    __syncthreads();
    for (int u = blockIdx.x; u < 2 * (NMOD / 128); u += gridDim.x) {
        const int l = u / (NMOD / 128), n = (u % (NMOD / 128)) * 128 + (tid & 127), bg = tid >> 7;
        const float* w = p.w_ada + (size_t)l * 1024 * NMOD + n;
        float acc[8];
#pragma unroll
        for (int j = 0; j < 8; ++j) acc[j] = 0.f;
        for (int d = 0; d < 1024; ++d) { const float wv = w[(size_t)d * NMOD];
#pragma unroll
            for (int j = 0; j < 8; ++j) acc[j] += ca[(bg * 8 + j) * 1024 + d] * wv; }
        const float bias = p.b_ada[l * NMOD + n];
#pragma unroll
        for (int j = 0; j < 8; ++j) p.mod[((size_t)l * NB + bg * 8 + j) * NMOD + n] = acc[j] + bias;
    }
    __syncthreads();
}

template <int MODE>
__device__ __forceinline__ void phase_norm1(const Params& p, int l) {
    const int tid = opaque_tid(p.wid), w = tid >> 6, lane = tid & 63;
    const float* xin = (MODE == 0) ? p.x : p.xo;
    const float* g = (MODE == 2) ? p.g_final : p.g_norm1 + l * D;
    const float* modl = p.mod + (size_t)(MODE == 2 ? 1 : l) * NB * NMOD;
    const float* modp = p.mod + (size_t)(MODE == 2 ? 1 : (l > 0 ? l - 1 : 0)) * NB * NMOD;
    for (int t = blockIdx.x * 8 + w; t < T; t += gridDim.x * 8) {
        const int b = t >> 11;
        f32x4 v[4];
#pragma unroll
        for (int k = 0; k < 4; ++k) v[k] = *(const f32x4*)(xin + (size_t)t * D + 4 * lane + 256 * k);
        if (MODE >= 1) {
#pragma unroll
            for (int k = 0; k < 4; ++k) {
                const int col = 4 * lane + 256 * k;
                const u32x2 y0 = *(const u32x2*)(p.ys + ((size_t)t * 2 + 0) * D + col), y1 = *(const u32x2*)(p.ys + ((size_t)t * 2 + 1) * D + col);
                const f32x4 gt = *(const f32x4*)(modp + (size_t)b * NMOD + 5 * 1024 + col);
                v[k][0] += gt[0] * (bflo(y0.x) + bflo(y1.x)); v[k][1] += gt[1] * (bfhi(y0.x) + bfhi(y1.x));
                v[k][2] += gt[2] * (bflo(y0.y) + bflo(y1.y)); v[k][3] += gt[3] * (bfhi(y0.y) + bfhi(y1.y));
            }
        }
        float ss = 0.f;
#pragma unroll
        for (int k = 0; k < 4; ++k) ss += v[k][0] * v[k][0] + v[k][1] * v[k][1] + v[k][2] * v[k][2] + v[k][3] * v[k][3];
        ss = wave_sum(ss);
        const float r = rsqrtf(ss * (1.0f / D) + EPS);
#pragma unroll
        for (int k = 0; k < 4; ++k) {
            const int col = 4 * lane + 256 * k;
            const f32x4 gg = *(const f32x4*)(g + col);
            f32x4 y = v[k] * r * gg;
            if (MODE == 2) { *(f32x4*)(p.xo + (size_t)t * D + col) = y; }
            else {
                if (MODE == 0 || MODE == 1) *(f32x4*)(p.xo + (size_t)t * D + col) = v[k];
                const f32x4 sc = *(const f32x4*)(modl + (size_t)b * NMOD + 1024 + col), sh = *(const f32x4*)(modl + (size_t)b * NMOD + col);
                y = y * (1.f + sc) + sh;
                u32x2 o; o.x = cvt_pk_bf16(y[0], y[1]); o.y = cvt_pk_bf16(y[2], y[3]);
                *(u32x2*)(p.h + (size_t)t * D + col) = o;
            }
        }
    }
}
}

namespace {
using pg8::Unit;
struct EpiStoreBf16 {
    static constexpr bool PERM = true;
    bf16_t* O; int ldc;
    __device__ __forceinline__ void operator()(const f32x4 (&acc)[2][2][4][2], const Unit& u, int wr, int wc, int fr_, int fq_) const {
        int fr = fr_, fq = fq_; asm volatile("" : "+v"(fr), "+v"(fq));
        const int row0 = u.pm * 256 + wr * 64 + fr, col0 = u.pn * 256 + wc * 32 + 8 * fq;
#pragma unroll
        for (int ai = 0; ai < 2; ++ai)
#pragma unroll
            for (int m = 0; m < 4; ++m) { bf16_t* rowp = O + (size_t)(row0 + ai * 128 + m * 16) * ldc + col0;
#pragma unroll
                for (int bj = 0; bj < 2; ++bj) { const f32x4 v0 = acc[ai][bj][m][0], v1 = acc[ai][bj][m][1];
                    u32x4 w; w.x = cvt_pk_bf16(v0[0], v0[1]); w.y = cvt_pk_bf16(v0[2], v0[3]); w.z = cvt_pk_bf16(v1[0], v1[1]); w.w = cvt_pk_bf16(v1[2], v1[3]);
                    *(u32x4*)(rowp + bj * 128) = w; } }
    }
};
struct EpiResidual {
    static constexpr bool PERM = false;
    float* x; const float* gate;
    __device__ __forceinline__ void operator()(const f32x4 (&acc)[2][2][4][2], const Unit& u, int wr, int wc, int fr_, int fq_) const {
        int fr = fr_, fq = fq_; asm volatile("" : "+v"(fr), "+v"(fq));
        const int row0 = u.pm * 256 + wr * 64 + fr, col0 = u.pn * 256 + wc * 32 + 4 * fq;
        const int b = (u.pm * 256) >> 11;
        f32x4 gv[2][2];
#pragma unroll
        for (int bj = 0; bj < 2; ++bj)
#pragma unroll
            for (int n = 0; n < 2; ++n) gv[bj][n] = *(const f32x4*)(gate + (size_t)b * NMOD + col0 + bj * 128 + n * 16);
#pragma unroll
        for (int ai = 0; ai < 2; ++ai)
#pragma unroll
            for (int m = 0; m < 4; ++m) { float* rowp = x + (size_t)(row0 + ai * 128 + m * 16) * D + col0;
#pragma unroll
                for (int bj = 0; bj < 2; ++bj)
#pragma unroll
                    for (int n = 0; n < 2; ++n) { f32x4* q = (f32x4*)(rowp + bj * 128 + n * 16); *q = *q + gv[bj][n] * acc[ai][bj][m][n]; } }
    }
};
struct EpiMlaQ {
    static constexpr bool PERM = true;
    bf16_t* qm;
    __device__ __forceinline__ void operator()(const f32x4 (&acc)[2][2][4][2], const Unit& u, int wr, int wc, int fr_, int fq_) const {
        int fr = fr_, fq = fq_; asm volatile("" : "+v"(fr), "+v"(fq));
        const int row0 = u.pm * 256 + wr * 64 + fr;
#pragma unroll
        for (int bj = 0; bj < 2; ++bj) {
            const int col0 = u.pn * 256 + bj * 128 + wc * 32;
            if (col0 >= 384) continue;
#pragma unroll
            for (int ai = 0; ai < 2; ++ai)
#pragma unroll
                for (int m = 0; m < 4; ++m) { const f32x4 v0 = acc[ai][bj][m][0], v1 = acc[ai][bj][m][1];
                    u32x4 w; w.x = cvt_pk_bf16(v0[0], v0[1]); w.y = cvt_pk_bf16(v0[2], v0[3]); w.z = cvt_pk_bf16(v1[0], v1[1]); w.w = cvt_pk_bf16(v1[2], v1[3]);
                    *(u32x4*)(qm + (size_t)(row0 + ai * 128 + m * 16) * 384 + col0 + 8 * fq) = w; }
        }
    }
};
struct EpiMlaKV {
    static constexpr bool PERM = true;
    bf16_t* km; bf16_t* vm;
    __device__ __forceinline__ void operator()(const f32x4 (&acc)[2][2][4][2], const Unit& u, int wr, int wc, int fr_, int fq_) const {
        int fr = fr_, fq = fq_; asm volatile("" : "+v"(fr), "+v"(fq));
        const int row0 = u.pm * 256 + wr * 64 + fr;
#pragma unroll
        for (int bj = 0; bj < 2; ++bj) {
            const int head = u.pn * 2 + bj, wcol = wc * 32 + 8 * fq;
#pragma unroll
            for (int ai = 0; ai < 2; ++ai)
#pragma unroll
                for (int m = 0; m < 4; ++m) {
                    const int row = row0 + ai * 128 + m * 16;
                    const f32x4 v0 = acc[ai][bj][m][0], v1 = acc[ai][bj][m][1];
                    u32x4 w; w.x = cvt_pk_bf16(v0[0], v0[1]); w.y = cvt_pk_bf16(v0[2], v0[3]); w.z = cvt_pk_bf16(v1[0], v1[1]); w.w = cvt_pk_bf16(v1[2], v1[3]);
                    bf16_t* q = (wcol < 64) ? km + (size_t)row * 384 + head * 96 + wcol : vm + (size_t)row * 256 + head * 64 + (wcol - 64);
                    *(u32x4*)q = w;
                    asm volatile("" ::: "memory");
                }
        }
    }
};
struct EpiGateUp {
    static constexpr bool PERM = false;
    bf16_t* hid;
    __device__ __forceinline__ void operator()(const f32x4 (&acc)[2][2][4][2], const Unit& u, int wr, int wc, int fr_, int fq_) const {
        int fr = fr_, fq = fq_; asm volatile("" : "+v"(fr), "+v"(fq));
        const int row0 = u.pm * 256 + wr * 64 + fr;
#pragma unroll
        for (int ai = 0; ai < 2; ++ai)
#pragma unroll
            for (int m = 0; m < 4; ++m) { bf16_t* rowp = hid + (size_t)(row0 + ai * 128 + m * 16) * 256;
#pragma unroll
                for (int bj = 0; bj < 2; ++bj) { const f32x4 gt = acc[ai][bj][m][0], up = acc[ai][bj][m][1];
                    f32x4 o;
#pragma unroll
                    for (int j = 0; j < 4; ++j) o[j] = gt[j] / (1.f + __expf(-gt[j])) * up[j];
                    u32x2 w; w.x = cvt_pk_bf16(o[0], o[1]); w.y = cvt_pk_bf16(o[2], o[3]);
                    *(u32x2*)(rowp + 16 * (u.pn * 8 + bj * 4 + wc) + 4 * fq) = w; } }
    }
};
struct EpiDown {
    static constexpr bool PERM = true;
    bf16_t* ys; const int* list; const float* rw; const int* cnt;
    __device__ __forceinline__ void operator()(const f32x4 (&acc)[2][2][4][2], const Unit& u, int wr, int wc, int fr_, int fq_) const {
        int fr = fr_, fq = fq_; asm volatile("" : "+v"(fr), "+v"(fq));
        const int n = cnt[u.e]; const int* le = list + (size_t)u.e * ECAP;
        const int col0 = u.pn * 256 + wc * 32 + 8 * fq;
#pragma unroll
        for (int ai = 0; ai < 2; ++ai)
#pragma unroll
            for (int m = 0; m < 4; ++m) {
                const int lr = u.mt * 256 + ai * 128 + wr * 64 + m * 16 + fr;
                if (lr < n) {
                    const int slot = le[lr]; const float w8 = rw[slot];
                    bf16_t* rowp = ys + (size_t)slot * D + col0;
#pragma unroll
                    for (int bj = 0; bj < 2; ++bj) { const f32x4 v0 = acc[ai][bj][m][0] * w8, v1 = acc[ai][bj][m][1] * w8;
                        u32x4 w; w.x = cvt_pk_bf16(v0[0], v0[1]); w.y = cvt_pk_bf16(v0[2], v0[3]); w.z = cvt_pk_bf16(v1[0], v1[1]); w.w = cvt_pk_bf16(v1[2], v1[3]);
                        *(u32x4*)(rowp + bj * 128) = w; }
                }
            }
    }
};
struct MoeOrder {
    int pre[17];
    int NT, G, c; const int* list; const int* cnt;
    __device__ __forceinline__ void init(const int* cnt_, const int* list_, int NT_, int G_, int c_) {
        cnt = cnt_; list = list_; NT = NT_; G = G_; c = c_; int a = 0;
#pragma unroll
        for (int e = 0; e < 16; ++e) { pre[e] = a; a += (cnt_[e] + 255) >> 8; }
        pre[16] = a;
    }
    __device__ __forceinline__ bool next(int i, Unit& u) const {
        const int L = i * G + c; if (L >= pre[16] * NT) return false;
        const int t = L / NT; int e = 0;
#pragma unroll
        for (int k = 1; k < 16; ++k) e += (t >= pre[k]) ? 1 : 0;
        int pe = 0;
#pragma unroll
        for (int k = 0; k < 16; ++k) pe = (k == e) ? pre[k] : pe;
        u.e = e; u.mt = t - pe; u.pm = t; u.pn = L - t * NT; return true;
    }
    __device__ __forceinline__ int arow(const Unit& u, int r) const { const int lr = u.mt * 256 + r; return lr < cnt[u.e] ? (list[(size_t)u.e * ECAP + lr] >> 1) : 0; }
};
}

namespace {
__device__ __forceinline__ void phase_prep(const Params& p, int l) {
    const int tid = opaque_tid(p.wid), w = tid >> 6, lane = tid & 63;
    const int gw = blockIdx.x * 8 + w, nw = gridDim.x * 8;
    for (int sq = gw; sq < NB * 4; sq += nw) {
        const int b = sq >> 2, hh = sq & 3; const float bias = p.b_forget[l * 4 + hh];
        float lf[32]; float run = 0.f;
#pragma unroll
        for (int j = 0; j < 32; ++j) {
            const float z = bf2f(p.proj[(size_t)(b * S + lane * 32 + j) * NP + PC_AF + hh]) + bias;
            run += fminf(z, 0.f) - log1pf(__expf(-fabsf(z)));
            lf[j] = run;
        }
        float incl = run;
#pragma unroll
        for (int o = 1; o < 64; o <<= 1) { const float t2 = __shfl_up(incl, o); if (lane >= o) incl += t2; }
        const float excl = incl - run;
#pragma unroll
        for (int j = 0; j < 32; ++j) p.cbF[(size_t)sq * S + lane * 32 + j] = -(excl + lf[j]) * LOG2E;
    }
    for (int t = gw; t < T; t += nw) {
        const bf16_t* row = p.proj + (size_t)t * NP;
        const u32x2 cq = *(const u32x2*)(row + PC_BCQ + 4 * lane);
        const unsigned ck = *(const unsigned*)(row + PC_BCKV + 2 * lane);
        float s1 = bflo(cq.x) * bflo(cq.x) + bfhi(cq.x) * bfhi(cq.x) + bflo(cq.y) * bflo(cq.y) + bfhi(cq.y) * bfhi(cq.y);
        float s2 = bflo(ck) * bflo(ck) + bfhi(ck) * bfhi(ck);
        s1 = wave_sum(s1); s2 = wave_sum(s2);
        const float kr = (lane < 32) ? bf2f(row[PC_BKR + lane]) : 0.f;
        const float kr2 = __shfl(kr, (lane + 16) & 63);
        {
            const float r1 = rsqrtf(s1 * (1.f / 256.f) + EPS), r2 = rsqrtf(s2 * (1.f / 128.f) + EPS);
            u32x2 o; o.x = cvt_pk_bf16(bflo(cq.x) * r1, bfhi(cq.x) * r1); o.y = cvt_pk_bf16(bflo(cq.y) * r1, bfhi(cq.y) * r1);
            *(u32x2*)(p.proj + (size_t)t * NP + PC_BCQ + 4 * lane) = o;
            *(unsigned*)(p.proj + (size_t)t * NP + PC_BCKV + 2 * lane) = cvt_pk_bf16(bflo(ck) * r2, bfhi(ck) * r2);
        }
        if (lane < 16) {
            const int pos = t & (S - 1);
            const float cs = p.ropetab[(pos * 16 + lane) * 2], sn = p.ropetab[(pos * 16 + lane) * 2 + 1];
            const bf16_t o1 = f2bf(kr * cs - kr2 * sn), o2 = f2bf(kr2 * cs + kr * sn);
            bf16_t* kmr = p.km + (size_t)t * 384;
#pragma unroll
            for (int hh = 0; hh < 4; ++hh) { kmr[hh * 96 + 64 + lane] = o1; kmr[hh * 96 + 80 + lane] = o2; }
        }
    }
}

__device__ __forceinline__ void phase_route(const Params& p, int l, char* lds) {
    const int tid = opaque_tid(p.wid), w = tid >> 6, lane = tid & 63;
    float* wrT = (float*)lds;
    int* lcnt = (int*)(lds + 65536);
    int* lbase = (int*)(lds + 65536 + 64);
    int* tsel = (int*)(lds + 65536 + 128);
    for (int i = tid; i < 16 * 1024; i += 512) { const int e = i >> 10, d = i & 1023; wrT[i] = p.w_router[d * 16 + e]; }
    const float* g = p.g_norm2 + l * D;
    const float* modl = p.mod + (size_t)l * NB * NMOD;
    int* cnt = (int*)(p.ctl + CW_CNT) + l * 16 + 32 * p.qslot;
    int* list = p.list + (size_t)p.qslot * 16 * ECAP;
    for (int chunk = blockIdx.x; chunk < T / 256; chunk += gridDim.x) {
        if (tid < 16) lcnt[tid] = 0;
        __syncthreads();
        for (int it = 0; it < 32; ++it) {
            const int li = w * 32 + it, t = chunk * 256 + li;
            const int b = t >> 11;
            f32x4 v[4];
#pragma unroll
            for (int k = 0; k < 4; ++k) v[k] = *(const f32x4*)(p.xo + (size_t)t * D + 4 * lane + 256 * k);
            float ss = 0.f;
#pragma unroll
            for (int k = 0; k < 4; ++k) ss += v[k][0] * v[k][0] + v[k][1] * v[k][1] + v[k][2] * v[k][2] + v[k][3] * v[k][3];
            ss = wave_sum(ss);
            const float r = rsqrtf(ss * (1.0f / D) + EPS);
            float lg[16];
#pragma unroll
            for (int e = 0; e < 16; ++e) lg[e] = 0.f;
#pragma unroll
            for (int k = 0; k < 4; ++k) {
                const int col = 4 * lane + 256 * k;
                const f32x4 gg = *(const f32x4*)(g + col);
                const f32x4 sc = *(const f32x4*)(modl + (size_t)b * NMOD + 4 * 1024 + col), sh = *(const f32x4*)(modl + (size_t)b * NMOD + 3 * 1024 + col);
                const f32x4 y = v[k] * r * gg * (1.f + sc) + sh;
                u32x2 o; o.x = cvt_pk_bf16(y[0], y[1]); o.y = cvt_pk_bf16(y[2], y[3]);
                *(u32x2*)(p.h + (size_t)t * D + col) = o;
#pragma unroll
                for (int e = 0; e < 16; ++e) { const f32x4 wv = *(const f32x4*)(wrT + e * 1024 + col); lg[e] += y[0] * wv[0] + y[1] * wv[1] + y[2] * wv[2] + y[3] * wv[3]; }
                asm volatile("" ::: "memory");
            }
#pragma unroll
            for (int e = 0; e < 16; ++e) lg[e] = wave_sum(lg[e]);
            if (lane == 0) {
                float sc[16], bi[16];
#pragma unroll
                for (int e = 0; e < 16; ++e) { sc[e] = 1.f / (1.f + expf(-lg[e])); bi[e] = sc[e] + p.b_router[e]; }
                int bg = 0; float bgs = -INFINITY;
#pragma unroll
                for (int gi = 0; gi < 4; ++gi) {
                    float m1 = -INFINITY, m2 = -INFINITY;
#pragma unroll
                    for (int j = 0; j < 4; ++j) { const float vv = bi[gi * 4 + j]; if (vv > m1) { m2 = m1; m1 = vv; } else if (vv > m2) m2 = vv; }
                    const float gs = m1 + m2; if (gs > bgs) { bgs = gs; bg = gi; }
                }
                float b4[4], s4[4];
#pragma unroll
                for (int gi = 0; gi < 4; ++gi)
#pragma unroll
                    for (int j = 0; j < 4; ++j) if (gi == bg) { b4[j] = bi[gi * 4 + j]; s4[j] = sc[gi * 4 + j]; }
                int i1 = 0; float v1 = -INFINITY;
#pragma unroll
                for (int j = 0; j < 4; ++j) { if (b4[j] > v1) { v1 = b4[j]; i1 = j; } }
                int i2 = 0; float v2 = -INFINITY;
#pragma unroll
                for (int j = 0; j < 4; ++j) { if (j != i1 && b4[j] > v2) { v2 = b4[j]; i2 = j; } }
                float w1 = 0.f, w2 = 0.f;
#pragma unroll
                for (int j = 0; j < 4; ++j) { if (j == i1) w1 = s4[j]; if (j == i2) w2 = s4[j]; }
                const int e1 = bg * 4 + i1, e2 = bg * 4 + i2; const float ws = w1 + w2;
                const int r1 = atomicAdd(&lcnt[e1], 1), r2 = atomicAdd(&lcnt[e2], 1);
                tsel[li * 2 + 0] = (e1 << 16) | r1; tsel[li * 2 + 1] = (e2 << 16) | r2;
                p.rw[t * 2 + 0] = w1 / ws; p.rw[t * 2 + 1] = w2 / ws;
            }
        }
        __syncthreads();
        if (tid < 16) lbase[tid] = atomicAdd(&cnt[tid], lcnt[tid]);
        __syncthreads();
        { const int v = tsel[tid], e = v >> 16, rk = v & 0xFFFF; list[(size_t)e * ECAP + lbase[e] + rk] = (chunk * 256 + (tid >> 1)) * 2 + (tid & 1); }
        __syncthreads();
    }
}
}

namespace {
constexpr int AT_KB = 0;
constexpr int AT_KR = 16384;
constexpr int AT_VB = 24576;
constexpr int AT_CB = 40960;
constexpr int AT_CTL = 41472;
constexpr int AT_LDS = 41984;
constexpr float NEGBIG = -1.0e30f;

template <int VAR>
__device__ __forceinline__ void attn_unit(const Params& p, int l, int b, int hx, int qb, LAS3 char* lds) {
    typedef LAS3 bf16x4 lds_bf16x4;
    constexpr int KC = (VAR == 1) ? 3 : 2;
    const int tid = opaque_tid(p.wid), w = __builtin_amdgcn_readfirstlane(tid >> 6), lane = tid & 63, i = lane & 15, g = lane >> 4;
    const bf16_t *Qp, *Kp, *Vp; int ldq, ldk, ldv, q0, j0, j1, ocol; float c1, slope2 = 0.f;
    if (VAR == 0) { Qp = p.proj + PC_AQ + hx * 64; Kp = p.proj + PC_AK + hx * 64; Vp = p.proj + PC_AV + hx * 64; ldq = ldk = ldv = NP;
                    q0 = qb * 256 + 32 * w; j0 = 0; j1 = 4 * qb + 3; ocol = hx * 64; c1 = 0.125f * LOG2E; }
    else if (VAR == 1) { Qp = p.qm + hx * 96; Kp = p.km + hx * 96; Vp = p.vm + hx * 64; ldq = 384; ldk = 384; ldv = 256;
                    q0 = qb * 256 + 32 * w; j0 = 0; j1 = 4 * qb + 3; ocol = 256 + hx * 64; c1 = 0.10206207261596577f * LOG2E; }
    else if (VAR == 2) { const int qh = hx * 2 + (w >> 2); Qp = p.proj + PC_CQ + qh * 64; Kp = p.proj + PC_CK + hx * 64; Vp = p.proj + PC_CV + hx * 64; ldq = ldk = ldv = NP;
                    q0 = qb * 128 + 32 * (w & 3); j0 = 2 * qb - 2 > 0 ? 2 * qb - 2 : 0; j1 = 2 * qb + 1; ocol = 512 + qh * 64; c1 = 0.125f * LOG2E;
                    slope2 = exp2f(-(float)(qh + 1)) * LOG2E; }
    else { const int hd = w >> 1; Qp = p.proj + PC_DQ + hd * 64; Kp = p.proj + PC_DK; Vp = p.proj + PC_DV; ldq = ldk = ldv = NP;
                    q0 = qb * 64 + 32 * (w & 1); j0 = 0; j1 = qb; ocol = 768 + hd * 64; c1 = 0.125f * LOG2E; slope2 = exp2f(-(float)(hd + 5)) * LOG2E; }
    const size_t tok0 = (size_t)b * S;
    bf16x8 qf[2][KC];
#pragma unroll
    for (int qt = 0; qt < 2; ++qt)
#pragma unroll
        for (int kc = 0; kc < KC; ++kc) qf[qt][kc] = *(const bf16x8*)(Qp + (tok0 + q0 + 16 * qt + i) * ldq + kc * 32 + 8 * g);
    if (VAR == 1) {
#pragma unroll
        for (int qt = 0; qt < 2; ++qt) {
            const int pos = q0 + 16 * qt + i;
            const u32x4 mine = __builtin_bit_cast(u32x4, qf[qt][KC - 1]);
            u32x4 oth; oth.x = __shfl_xor(mine.x, 32); oth.y = __shfl_xor(mine.y, 32); oth.z = __shfl_xor(mine.z, 32); oth.w = __shfl_xor(mine.w, 32);
            const float* rt = p.ropetab + (size_t)(pos * 16 + (g & 1) * 8) * 2;
            const float sg = (g < 2) ? -1.f : 1.f;
            u32x4 res;
#pragma unroll
            for (int e2 = 0; e2 < 4; ++e2) {
                const f32x4 cs = *(const f32x4*)(rt + e2 * 4);
                const unsigned mw_ = e2 == 0 ? mine.x : e2 == 1 ? mine.y : e2 == 2 ? mine.z : mine.w, ow_ = e2 == 0 ? oth.x : e2 == 1 ? oth.y : e2 == 2 ? oth.z : oth.w;
                const float r0 = bflo(mw_) * cs[0] + sg * bflo(ow_) * cs[1], r1 = bfhi(mw_) * cs[2] + sg * bfhi(ow_) * cs[3];
                const unsigned pk = cvt_pk_bf16(r0, r1);
                if (e2 == 0) res.x = pk; else if (e2 == 1) res.y = pk; else if (e2 == 2) res.z = pk; else res.w = pk;
            }
            qf[qt][KC - 1] = __builtin_bit_cast(bf16x8, res);
        }
    }
    f32x4 o[2][4];
#pragma unroll
    for (int qt = 0; qt < 2; ++qt)
#pragma unroll
        for (int dt = 0; dt < 4; ++dt) o[qt][dt] = (f32x4){0.f, 0.f, 0.f, 0.f};
    float mrow[2] = {NEGBIG, NEGBIG}, lsum[2] = {0.f, 0.f};
    const int sr = tid >> 3, sc8 = tid & 7;
    const int kdst = sr * 128 + ((sc8 ^ ((sr >> 1) & 7)) << 4);
    const int vdst = sr * 128 + (((((sc8 >> 1) ^ ((sr >> 1) & 3)) << 1) | (sc8 & 1)) << 4);
    const int rr = (tid & 255) >> 2, rc4 = tid & 3;
    const int rdst = rr * 64 + ((rc4 ^ ((rr >> 1) & 3)) << 4);
    u32x4 kst, vst, rst = {0u, 0u, 0u, 0u}; float cst = 0.f;
    u32x2 mw[2] = {{0u, 0u}, {0u, 0u}}, mwn[2] = {{0u, 0u}, {0u, 0u}};
#define AT_LOAD(j) do { const size_t _kr = tok0 + 64 * (j) + sr; \
        kst = *(const u32x4*)(Kp + _kr * ldk + sc8 * 8); vst = *(const u32x4*)(Vp + _kr * ldv + sc8 * 8); \
        if (VAR == 1 && tid < 256) rst = *(const u32x4*)(Kp + (tok0 + 64 * (j) + rr) * ldk + 64 + rc4 * 8); \
        if (VAR == 0 && tid < 64) cst = p.cbF[((size_t)b * 4 + hx) * S + 64 * (j) + tid]; \
        if (VAR == 3) { _Pragma("unroll") for (int _q = 0; _q < 2; ++_q) mwn[_q] = *(const u32x2*)(p.mask + (tok0 + q0 + 16 * _q + i) * 64 + 2 * (j)); } } while (0)
#define AT_WRITE(buf) do { *(LAS3 u32x4*)(lds + AT_KB + (buf) * 8192 + kdst) = kst; *(LAS3 u32x4*)(lds + AT_VB + (buf) * 8192 + vdst) = vst; \
        if (VAR == 1 && tid < 256) *(LAS3 u32x4*)(lds + AT_KR + (buf) * 4096 + rdst) = rst; \
        if (VAR == 0 && tid < 64) *(LAS3 float*)(lds + AT_CB + (buf) * 256 + tid * 4) = cst; } while (0)
    AT_LOAD(j0);
    AT_WRITE(j0 & 1);
    if (VAR == 3) { mw[0] = mwn[0]; mw[1] = mwn[1]; }
    __syncthreads();
    const int swk = (i >> 1) & 7;
    for (int j = j0; j <= j1; ++j) {
        const int buf = j & 1;
        if (j < j1) AT_LOAD(j + 1);
        bool need = (64 * j <= q0 + 31);
        if (VAR == 2) need = need && (64 * j + 63 >= q0 - 127);
        if (need) {
            const LAS3 char* Kb = lds + AT_KB + buf * 8192; const LAS3 char* Vb = lds + AT_VB + buf * 8192;
            f32x4 s[2][4];
#pragma unroll
            for (int mt = 0; mt < 4; ++mt) {
                s[0][mt] = (f32x4){0.f, 0.f, 0.f, 0.f}; s[1][mt] = (f32x4){0.f, 0.f, 0.f, 0.f};
#pragma unroll
                for (int kc = 0; kc < 2; ++kc) {
                    const bf16x8 kf = *(const LAS3 bf16x8*)(Kb + (mt * 16 + i) * 128 + (((kc * 4 + g) ^ swk) << 4));
                    s[0][mt] = __builtin_amdgcn_mfma_f32_16x16x32_bf16(kf, qf[0][kc], s[0][mt], 0, 0, 0);
                    s[1][mt] = __builtin_amdgcn_mfma_f32_16x16x32_bf16(kf, qf[1][kc], s[1][mt], 0, 0, 0);
                }
                if (VAR == 1) {
                    const bf16x8 kf = *(const LAS3 bf16x8*)(lds + AT_KR + buf * 4096 + (mt * 16 + i) * 64 + ((g ^ (swk & 3)) << 4));
                    s[0][mt] = __builtin_amdgcn_mfma_f32_16x16x32_bf16(kf, qf[0][KC - 1], s[0][mt], 0, 0, 0);
                    s[1][mt] = __builtin_amdgcn_mfma_f32_16x16x32_bf16(kf, qf[1][KC - 1], s[1][mt], 0, 0, 0);
                }
            }
            bool full = (64 * j + 63 <= q0);
            if (VAR == 2) full = full && (64 * j >= q0 - 96);
            if (VAR == 3) full = false;
            bf16x8 pf[2][2];
#pragma unroll
            for (int qt = 0; qt < 2; ++qt) {
                const int t = q0 + 16 * qt + i;
                float x[4][4];
#pragma unroll
                for (int mt = 0; mt < 4; ++mt) {
                    f32x4 cb = {0.f, 0.f, 0.f, 0.f};
                    if (VAR == 0) cb = *(const LAS3 f32x4*)(lds + AT_CB + buf * 256 + (16 * mt + 4 * g) * 4);
#pragma unroll
                    for (int r = 0; r < 4; ++r) {
                        const int key = 64 * j + 16 * mt + 4 * g + r;
                        float v = s[qt][mt][r] * c1;
                        if (VAR == 0) v += cb[r];
                        if (VAR == 2) v += slope2 * (float)(key - t);
                        if (VAR == 3) v += slope2 * (float)key;
                        if (!full) {
                            bool ok;
                            if (VAR == 0 || VAR == 1) ok = key <= t;
                            else if (VAR == 2) ok = (key <= t) && (key > t - 128);
                            else { const int kk = 16 * mt + 4 * g + r; ok = (((kk < 32) ? (mw[qt].x >> kk) : (mw[qt].y >> (kk - 32))) & 1u) != 0u; }
                            v = ok ? v : NEGBIG;
                        }
                        x[mt][r] = v;
                    }
                }
                float mx = x[0][0];
#pragma unroll
                for (int mt = 0; mt < 4; ++mt)
#pragma unroll
                    for (int r = 0; r < 4; ++r) mx = fmaxf(mx, x[mt][r]);
                mx = fmaxf(mx, __shfl_xor(mx, 16)); mx = fmaxf(mx, __shfl_xor(mx, 32));
                const float mn = fmaxf(mrow[qt], mx), alpha = __builtin_amdgcn_exp2f(mrow[qt] - mn);
                mrow[qt] = mn;
                float ps = 0.f;
#pragma unroll
                for (int mt = 0; mt < 4; ++mt)
#pragma unroll
                    for (int r = 0; r < 4; ++r) { x[mt][r] = __builtin_amdgcn_exp2f(x[mt][r] - mn); ps += x[mt][r]; }
                lsum[qt] = lsum[qt] * alpha + ps;
#pragma unroll
                for (int dt = 0; dt < 4; ++dt) o[qt][dt] = o[qt][dt] * alpha;
#pragma unroll
                for (int c = 0; c < 2; ++c) {
                    u32x4 pk; pk.x = cvt_pk_bf16(x[2 * c][0], x[2 * c][1]); pk.y = cvt_pk_bf16(x[2 * c][2], x[2 * c][3]);
                    pk.z = cvt_pk_bf16(x[2 * c + 1][0], x[2 * c + 1][1]); pk.w = cvt_pk_bf16(x[2 * c + 1][2], x[2 * c + 1][3]);
                    pf[qt][c] = __builtin_bit_cast(bf16x8, pk);
                }
            }
            const int q4 = i >> 2, p4 = i & 3;
#pragma unroll
            for (int c = 0; c < 2; ++c) {
                const int row0 = 32 * c + 4 * g + q4, swv = (row0 >> 1) & 3;
#pragma unroll
                for (int dt = 0; dt < 4; ++dt) {
                    const LAS3 char* a0 = Vb + row0 * 128 + ((dt ^ swv) << 5) + p4 * 8;
                    const bf16x4 v0 = __builtin_amdgcn_ds_read_tr16_b64_v4i16((lds_bf16x4*)(a0));
                    const bf16x4 v1 = __builtin_amdgcn_ds_read_tr16_b64_v4i16((lds_bf16x4*)(a0 + 16 * 128));
                    const bf16x8 vf = {v0[0], v0[1], v0[2], v0[3], v1[0], v1[1], v1[2], v1[3]};
                    o[0][dt] = __builtin_amdgcn_mfma_f32_16x16x32_bf16(vf, pf[0][c], o[0][dt], 0, 0, 0);
                    o[1][dt] = __builtin_amdgcn_mfma_f32_16x16x32_bf16(vf, pf[1][c], o[1][dt], 0, 0, 0);
                }
            }
        }
        if (j < j1) { AT_WRITE(buf ^ 1); if (VAR == 3) { mw[0] = mwn[0]; mw[1] = mwn[1]; } }
        __syncthreads();
    }
#undef AT_LOAD
#undef AT_WRITE
#pragma unroll
    for (int qt = 0; qt < 2; ++qt) {
        float lt = lsum[qt]; lt += __shfl_xor(lt, 16); lt += __shfl_xor(lt, 32);
        if (VAR == 2) lt += __builtin_amdgcn_exp2f(p.sinks[l * 4 + hx * 2 + (w >> 2)] * LOG2E - mrow[qt]);
        const float inv = 1.f / lt;
        bf16_t* op = p.merged + (tok0 + q0 + 16 * qt + i) * D + ocol + 4 * g;
#pragma unroll
        for (int dt = 0; dt < 4; ++dt) { const f32x4 v = o[qt][dt] * inv; u32x2 w2; w2.x = cvt_pk_bf16(v[0], v[1]); w2.y = cvt_pk_bf16(v[2], v[3]); *(u32x2*)(op + 16 * dt) = w2; }
    }
}

__device__ __forceinline__ void phase_attn(const Params& p, int l, LAS3 char* lds) {
    const int tid = opaque_tid(p.wid);
    unsigned* qhead = p.ctl + CW_QA + 64 * (l + 2 * p.qslot);
    volatile LAS3 int* bc = (volatile LAS3 int*)(lds + AT_CTL);
    for (;;) {
        if (tid == 0) *bc = (int)__hip_atomic_fetch_add(qhead, 1u, __ATOMIC_RELAXED, __HIP_MEMORY_SCOPE_AGENT);
        __syncthreads();
        const int idx = __builtin_amdgcn_readfirstlane(*bc);
        __syncthreads();
        if (idx >= 4096) break;
#ifndef ATTN_VMASK
#define ATTN_VMASK 15
#endif
        if (idx < 3072) {
            const int lvl = 7 - idx / 384, rem = idx % 384;
            if (rem < 128) { if (ATTN_VMASK & 2) attn_unit<1>(p, l, rem >> 2, rem & 3, lvl, lds); }
            else if (rem < 256) { if (ATTN_VMASK & 1) attn_unit<0>(p, l, (rem - 128) >> 2, rem & 3, lvl, lds); }
            else { const int d = rem - 256; if (ATTN_VMASK & 8) attn_unit<3>(p, l, d & 31, 0, 4 * lvl + 3 - (d >> 5), lds); }
        } else { const int c = idx - 3072; if (ATTN_VMASK & 4) attn_unit<2>(p, l, c >> 5, (c >> 4) & 1, c & 15, lds); }
    }
}
}

namespace {
constexpr int DS_LD = 2052;
constexpr int DS_CTL = 16 * DS_LD * 4;
constexpr int DS_LDS = DS_CTL + 64;

__device__ __forceinline__ void dsa_unit(const Params& p, int u, LAS3 char* lds) {
    const int tid = opaque_tid(p.wid), w = __builtin_amdgcn_readfirstlane(tid >> 6), lane = tid & 63, i = lane & 15, g = lane >> 4;
    const int b = u >> 7, t0 = (u & 127) * 16;
    const size_t tok0 = (size_t)b * S;
    uint32_t* mbase = p.mask + (tok0 + t0) * 64;
    if (t0 + 16 <= 256) {
#pragma unroll
        for (int qq = 0; qq < 2; ++qq) {
            const int q = 2 * w + qq, n = t0 + q + 1;
            if (lane < 32) { const int lo = lane * 64; unsigned long long bits = (n >= lo + 64) ? ~0ull : (n <= lo ? 0ull : ((1ull << (n - lo)) - 1ull));
                u32x2 o; o.x = (unsigned)bits; o.y = (unsigned)(bits >> 32); *(u32x2*)(mbase + q * 64 + 2 * lane) = o; }
        }
        return;
    }
    const int nreg = (t0 + 16 + 63) >> 6;
    const int ntile = nreg * 4;
    bf16x8 qf[8]; float wq[8];
    {
        const bf16_t* qrow = p.proj + (tok0 + t0 + i) * NP;
#pragma unroll
        for (int h = 0; h < 8; ++h) qf[h] = *(const bf16x8*)(qrow + PC_DQI + h * 32 + 8 * g);
        const u32x4 ww = *(const u32x4*)(qrow + PC_DWI);
        const float sc = 0.35355339059327373f * 0.17677669529663687f;
        wq[0] = bflo(ww.x) * sc; wq[1] = bfhi(ww.x) * sc; wq[2] = bflo(ww.y) * sc; wq[3] = bfhi(ww.y) * sc;
        wq[4] = bflo(ww.z) * sc; wq[5] = bfhi(ww.z) * sc; wq[6] = bflo(ww.w) * sc; wq[7] = bfhi(ww.w) * sc;
    }
    const int tq = t0 + i;
    for (int kt = w; kt < ntile; kt += 8) {
        const bf16x8 kf = *(const bf16x8*)(p.proj + (tok0 + 16 * kt + i) * NP + PC_DKI + 8 * g);
        f32x4 sc4 = {0.f, 0.f, 0.f, 0.f};
#pragma unroll
        for (int h = 0; h < 8; ++h) {
            const f32x4 c = __builtin_amdgcn_mfma_f32_16x16x32_bf16(kf, qf[h], (f32x4){0.f, 0.f, 0.f, 0.f}, 0, 0, 0);
#pragma unroll
            for (int r = 0; r < 4; ++r) sc4[r] += wq[h] * fmaxf(c[r], 0.f);
        }
        u32x4 ko;
#pragma unroll
        for (int r = 0; r < 4; ++r) {
            const int key = 16 * kt + 4 * g + r;
            unsigned uu = __float_as_uint(sc4[r]); if (uu == 0x80000000u) uu = 0u;
            uu = (uu & 0x80000000u) ? ~uu : (uu | 0x80000000u);
            ko[r] = (key <= tq) ? uu : 0u;
        }
        *(LAS3 u32x4*)(lds + ((size_t)i * DS_LD + 16 * kt + 4 * g) * 4) = ko;
    }
    __syncthreads();
#pragma unroll 1
    for (int qq = 0; qq < 2; ++qq) {
        const int q = 2 * w + qq, n = t0 + q + 1;
        unsigned long long mine = 0ull;
        if (n <= 256) {
            if (lane < 32) { const int lo = lane * 64; mine = (n >= lo + 64) ? ~0ull : (n <= lo ? 0ull : ((1ull << (n - lo)) - 1ull)); }
        } else {
            const LAS3 unsigned* kp = (const LAS3 unsigned*)(lds + (size_t)q * DS_LD * 4);
            unsigned key[32];
            int nv = nreg * 64; asm volatile("" : "+s"(nv));
#pragma unroll
            for (int r = 0; r < 32; ++r) { const unsigned v = kp[r * 64 + lane]; key[r] = (r * 64 + lane < nv) ? v : 0u; }
            unsigned thr = 0u; bool exact = false;
            for (int bit = 31; bit >= 0; --bit) {
                const unsigned cand = thr | (1u << bit);
                int cnt = 0;
#pragma unroll
                for (int r = 0; r < 32; ++r) { cnt += __popcll(__ballot(key[r] >= cand)); if ((r & 3) == 3) asm volatile("" : "+s"(cnt)); }
                if (cnt >= 256) { thr = cand; if (cnt == 256) { exact = true; break; } }
            }
            int need = 0;
            if (!exact) { int ngt = 0;
#pragma unroll
                for (int r = 0; r < 32; ++r) { ngt += __popcll(__ballot(key[r] > thr)); if ((r & 3) == 3) asm volatile("" : "+s"(ngt)); }
                need = 256 - ngt; }
            int running = 0;
            const unsigned long long lt = (lane == 0) ? 0ull : (~0ull >> (64 - lane));
#pragma unroll
            for (int r = 0; r < 32; ++r) {
                unsigned long long bs;
                if (exact) bs = __ballot(key[r] >= thr);
                else {
                    const bool eq = key[r] == thr;
                    const unsigned long long be = __ballot(eq);
                    const int rank = running + __popcll(be & lt);
                    bs = __ballot((key[r] > thr) || (eq && rank < need));
                    running += __popcll(be);
                }
                { int ln = lane; asm volatile("" : "+v"(ln)); if (ln == r) mine = bs; }
            }
        }
        if (lane < 32) { u32x2 o; o.x = (unsigned)mine; o.y = (unsigned)(mine >> 32); *(u32x2*)(mbase + q * 64 + 2 * lane) = o; }
    }
    __syncthreads();
}

__device__ __forceinline__ void phase_dsa(const Params& p, int l, LAS3 char* lds) {
    const int tid = opaque_tid(p.wid);
    unsigned* qhead = p.ctl + CW_QD + 64 * (l + 2 * p.qslot);
    volatile LAS3 int* bc = (volatile LAS3 int*)(lds + DS_CTL);
    for (;;) {
        if (tid == 0) *bc = (int)__hip_atomic_fetch_add(qhead, 1u, __ATOMIC_RELAXED, __HIP_MEMORY_SCOPE_AGENT);
        __syncthreads();
        const int idx = __builtin_amdgcn_readfirstlane(*bc);
        __syncthreads();
        if (idx >= 4096) break;
        const int pb = 127 - (idx >> 5), b = idx & 31;
        dsa_unit(p, b * 128 + pb, lds);
    }
}
}

namespace {
constexpr int LDS_BYTES = 147456;
constexpr int NTHREADS = 512;

template <int PH>
__device__ __forceinline__ void run_phase(const Params& p, int l, unsigned char* smem) {
    LAS3 char* lds = (LAS3 char*)smem;
    PG8_LAS unsigned char* glds = (PG8_LAS unsigned char*)smem;
    const int G = gridDim.x, c = blockIdx.x;
    if constexpr (PH == 0) phase_p0(p, (char*)smem);
    if constexpr (PH == 1) { if (l == 0) phase_norm1<0>(p, 0); else phase_norm1<1>(p, l); }
    if constexpr (PH == 2) { pg8::Gemm g{p.h, p.WinT + (size_t)l * NP * D, D, D, 0}; pg8::StaticOrder S; S.init(T, NP, G, c);
        EpiStoreBf16 E{p.proj, NP}; pg8::gemm_phase<EpiStoreBf16, pg8::StaticOrder, false>(glds, g, S, E, p.wid); }
    if constexpr (PH == 3) phase_prep(p, l);
    if constexpr (PH == 4) { pg8::Gemm g{p.proj + PC_BCQ, p.WqT + (size_t)l * 512 * 256, 256, NP, 0}; pg8::StaticOrder S; S.init(T, 512, G, c);
          EpiMlaQ E{p.qm}; pg8::gemm_phase<EpiMlaQ, pg8::StaticOrder, false>(glds, g, S, E, p.wid); }
    if constexpr (PH == 12) { pg8::Gemm g{p.proj + PC_BCKV, p.WkvT + (size_t)l * 512 * 128, 128, NP, 0}; pg8::StaticOrder S; S.init(T, 512, G, c);
          EpiMlaKV E{p.km, p.vm}; pg8::gemm_phase<EpiMlaKV, pg8::StaticOrder, false>(glds, g, S, E, p.wid); }
    if constexpr (PH == 13) phase_dsa(p, l, lds);
    if constexpr (PH == 5) phase_attn(p, l, lds);
    if constexpr (PH == 6) { pg8::Gemm g{p.merged, p.WoutT + (size_t)l * D * D, D, D, 0}; pg8::StaticOrder S; S.init(T, D, G, c);
        EpiResidual E{p.xo, p.mod + (size_t)l * NB * NMOD + 2 * 1024}; pg8::gemm_phase<EpiResidual, pg8::StaticOrder, false>(glds, g, S, E, p.wid); }
    if constexpr (PH == 7) phase_route(p, l, (char*)smem);
    if constexpr (PH == 8) { const int* cnt = (const int*)(p.ctl + CW_CNT) + l * 16;
        pg8::Gemm g{p.h, p.WguT + (size_t)l * 16 * 512 * 1024, 1024, D, (size_t)512 * 1024}; MoeOrder S; S.init(cnt, p.list, 2, G, c);
        EpiGateUp E{p.hid}; pg8::gemm_phase<EpiGateUp, MoeOrder, true>(glds, g, S, E, p.wid); }
    if constexpr (PH == 9) { const int* cnt = (const int*)(p.ctl + CW_CNT) + l * 16;
        pg8::Gemm g{p.hid, p.WdT + (size_t)l * 16 * 1024 * 256, 256, 256, (size_t)1024 * 256}; MoeOrder S; S.init(cnt, p.list, 4, G, c);
        EpiDown E{p.ys, p.list, p.rw, cnt}; pg8::gemm_phase<EpiDown, MoeOrder, false>(glds, g, S, E, p.wid); }
    if constexpr (PH == 10) phase_norm1<2>(p, 1);
    if constexpr (PH == 11) phase_norm1<0>(p, l);
}
template <int PH>
__global__ void __launch_bounds__(NTHREADS, 2) k_ph(Params p, int l) {
    extern __shared__ __attribute__((aligned(16))) unsigned char smem[];
    p.wid = __builtin_amdgcn_readfirstlane(threadIdx.x >> 6); p.qslot = 0;
    run_phase<PH>(p, l, smem);
}
}


namespace {
#ifndef REP_PH
#define REP_PH -1
#endif
#define REP(X, l) do { if (REP_PH == X) { xcd_barrier(bar); phase<X>(l, smem, wid, 1); } } while (0)
struct KArgs { const float* in[20]; float* xo; char* ws; };
constexpr size_t al256(size_t b) { return (b + 255) & ~(size_t)255; }
constexpr size_t WS_CTL = 0;
constexpr size_t WS_MOD = WS_CTL + al256((size_t)CW_WORDS * 4);
constexpr size_t WS_WIN = WS_MOD + al256((size_t)2 * NB * NMOD * 4);
constexpr size_t WS_WOUT = WS_WIN + al256((size_t)2 * NP * D * 2);
constexpr size_t WS_WQ = WS_WOUT + al256((size_t)2 * D * D * 2);
constexpr size_t WS_WKV = WS_WQ + al256((size_t)2 * 512 * 256 * 2);
constexpr size_t WS_WGU = WS_WKV + al256((size_t)2 * 512 * 128 * 2);
constexpr size_t WS_WD = WS_WGU + al256((size_t)2 * 16 * 512 * 1024 * 2);
constexpr size_t WS_ROPE = WS_WD + al256((size_t)2 * 16 * 1024 * 256 * 2);
constexpr size_t WS_RQ = WS_ROPE + al256((size_t)2048 * 16 * 2 * 4);
constexpr size_t WS_RKV = WS_RQ + al256((size_t)T * 4);
constexpr size_t WS_CBF = WS_RKV + al256((size_t)T * 4);
constexpr size_t WS_MASK = WS_CBF + al256((size_t)NB * 4 * S * 4);
constexpr size_t WS_LIST = WS_MASK + al256((size_t)T * 64 * 4);
constexpr size_t WS_RW = WS_LIST + al256((size_t)2 * 16 * ECAP * 4);
constexpr size_t WS_H = WS_RW + al256((size_t)T * 2 * 4);
constexpr size_t WS_PROJ = WS_H + al256((size_t)T * D * 2);
constexpr size_t WS_QM = WS_PROJ + al256((size_t)T * NP * 2);
constexpr size_t WS_KM = WS_QM + al256((size_t)T * 384 * 2);
constexpr size_t WS_VM = WS_KM + al256((size_t)T * 384 * 2);
constexpr size_t WS_MERGED = WS_VM + al256((size_t)T * 256 * 2);
constexpr size_t WS_END1 = WS_MERGED + al256((size_t)T * D * 2);
constexpr size_t WS_HID = WS_PROJ;
constexpr size_t WS_YS = WS_HID + al256((size_t)HIDROWS * 256 * 2);
constexpr size_t WS_END2 = WS_YS + al256((size_t)T * 2 * D * 2);
constexpr size_t WS_NEED = WS_END1 > WS_END2 ? WS_END1 : WS_END2;
static_assert(WS_END2 <= WS_MERGED, "MoE overlay must not reach the merged buffer");

__device__ __forceinline__ Params make_params(const KArgs& a) {
    Params p;
    p.x = a.in[0]; p.c = a.in[1]; p.w_ada = a.in[2]; p.b_ada = a.in[3]; p.g_norm1 = a.in[4]; p.w_in = a.in[5]; p.b_forget = a.in[6]; p.g_q_mla = a.in[7];
    p.w_q_up = a.in[8]; p.g_kv_mla = a.in[9]; p.w_kv_up = a.in[10]; p.sinks = a.in[11]; p.w_out = a.in[12]; p.g_norm2 = a.in[13]; p.w_router = a.in[14];
    p.b_router = a.in[15]; p.w_gate = a.in[16]; p.w_up = a.in[17]; p.w_down = a.in[18]; p.g_final = a.in[19];
    p.xo = a.xo; char* ws = a.ws;
    p.ctl = (unsigned*)(ws + WS_CTL); p.mod = (float*)(ws + WS_MOD); p.WinT = (bf16_t*)(ws + WS_WIN); p.WoutT = (bf16_t*)(ws + WS_WOUT);
    p.WqT = (bf16_t*)(ws + WS_WQ); p.WkvT = (bf16_t*)(ws + WS_WKV); p.WguT = (bf16_t*)(ws + WS_WGU); p.WdT = (bf16_t*)(ws + WS_WD);
    p.ropetab = (float*)(ws + WS_ROPE); p.rq = (float*)(ws + WS_RQ); p.rkv = (float*)(ws + WS_RKV); p.cbF = (float*)(ws + WS_CBF);
    p.mask = (uint32_t*)(ws + WS_MASK); p.list = (int*)(ws + WS_LIST); p.rw = (float*)(ws + WS_RW); p.h = (bf16_t*)(ws + WS_H);
    p.proj = (bf16_t*)(ws + WS_PROJ); p.qm = (bf16_t*)(ws + WS_QM); p.km = (bf16_t*)(ws + WS_KM); p.vm = (bf16_t*)(ws + WS_VM);
    p.merged = (bf16_t*)(ws + WS_MERGED); p.hid = (bf16_t*)(ws + WS_HID); p.ys = (bf16_t*)(ws + WS_YS);
    return p;
}
template <int PH>
__device__ __forceinline__ void phase(int l, unsigned char* smem, int wid, int qslot = 0) {
    typedef const __attribute__((address_space(4))) KArgs* KA4;
    KA4 ka = (KA4)__builtin_amdgcn_kernarg_segment_ptr();
    asm volatile("" : "+s"(ka));
    KArgs a;
#pragma unroll
    for (int i = 0; i < 20; ++i) a.in[i] = ka->in[i];
    a.xo = ka->xo; a.ws = ka->ws;
    Params p = make_params(a); p.wid = wid; p.qslot = qslot;
    run_phase<PH>(p, l, smem);
}
__global__ void __launch_bounds__(NTHREADS, 2) fwd(KArgs args) {
    extern __shared__ __attribute__((aligned(16))) unsigned char smem[];
    volatile LAS unsigned* st = (volatile LAS unsigned*)(smem + LDS_BYTES - 16);
    const int wid = __builtin_amdgcn_readfirstlane(threadIdx.x >> 6);
    if (xb_leader(wid)) { st[0] = 0u; st[1] = 0u; st[2] = 0u; st[3] = 0u; }
    __syncthreads();
    XcdBarrier bar = xcd_barrier_post((unsigned*)(args.ws + WS_CTL) + CW_BAR, st, wid);
    phase<0>(0, smem, wid);  REP(0, 0);
    xcd_barrier(bar);
#define LAYER(l) do { \
        phase<1>(l, smem, wid);  if (l == 0) REP(1, l); xcd_barrier(bar); \
        phase<2>(l, smem, wid);  REP(2, l); xcd_barrier(bar); \
        phase<3>(l, smem, wid);  REP(3, l); xcd_barrier(bar); \
        phase<4>(l, smem, wid);  REP(4, l); phase<12>(l, smem, wid);  REP(12, l); phase<13>(l, smem, wid);  REP(13, l); xcd_barrier(bar); \
        phase<5>(l, smem, wid);  REP(5, l); xcd_barrier(bar); \
        phase<6>(l, smem, wid);  xcd_barrier(bar); \
        phase<7>(l, smem, wid);  REP(7, l); xcd_barrier(bar); \
        phase<8>(l, smem, wid);  REP(8, l); xcd_barrier(bar); \
        phase<9>(l, smem, wid);  REP(9, l); xcd_barrier(bar); } while (0)
    LAYER(0);
    LAYER(1);
    phase<10>(1, smem, wid);
}
}

extern "C" void kernel_launch(void* const* d_in, const int* in_sizes, int n_in, void* d_out, int out_size, void* d_ws, size_t ws_size,
                              hipStream_t stream) {
    KArgs a{};
    for (int i = 0; i < 20; ++i) a.in[i] = (const float*)d_in[i];
    a.xo = (float*)d_out; a.ws = (char*)d_ws;
    if (WS_NEED > ws_size) return;

    static int grid = 0;
    if (!grid) {
        int dev = 0, cus = 0, per_cu = 0;
        (void)hipGetDevice(&dev);
        (void)hipDeviceGetAttribute(&cus, hipDeviceAttributeMultiprocessorCount, dev);
        (void)hipFuncSetAttribute((const void*)fwd, hipFuncAttributeMaxDynamicSharedMemorySize, LDS_BYTES);
        (void)hipOccupancyMaxActiveBlocksPerMultiprocessor(&per_cu, (const void*)fwd, NTHREADS, LDS_BYTES);
        grid = cus > 0 ? cus : 256;
    }
    (void)hipMemsetAsync(a.ws + WS_CTL, 0, (size_t)CW_WORDS * 4, stream);
    fwd<<<dim3(grid), dim3(NTHREADS), LDS_BYTES, stream>>>(a);
}
```

```cpp
#include <hip/hip_runtime.h>
#include <stdint.h>
#define XB_TMO      128
#define XB_XCNT(j)  (256  + 64 * (j))
#define XB_XSUB(j)  (1280 + 64 * (j))
#define XB_XGEN(j)  (2304 + 64 * (j))
#define XB_TOP      3328
#define XB_TOPGEN   3392
#define XCD_BAR_WORDS 3456
#define XB_SPIN_CAP (1u << 20)
#define LAS __attribute__((address_space(3)))

__device__ __forceinline__ unsigned xb_ld(unsigned* p)              { return __hip_atomic_load(p, __ATOMIC_RELAXED, __HIP_MEMORY_SCOPE_AGENT); }
__device__ __forceinline__ unsigned xb_add(unsigned* p, unsigned v) { return __hip_atomic_fetch_add(p, v, __ATOMIC_RELAXED, __HIP_MEMORY_SCOPE_AGENT); }
__device__ __forceinline__ unsigned xb_xcc_id() { return (unsigned)__builtin_amdgcn_s_getreg((3 << 11) | 20) & 0xFu; }
#define XB_SPIN(cond, bar) do { unsigned _sp = 0; while (cond) { __builtin_amdgcn_s_sleep(1); \
    if ((++_sp & 255u) == 0u) { if (xb_ld(&(bar)[XB_TMO])) break; if (_sp > XB_SPIN_CAP) { atomicAdd(&(bar)[XB_TMO], 1u); break; } } } } while (0)

struct XcdBarrier { unsigned* bar; unsigned x; volatile LAS unsigned* st; int wid; };
__device__ __forceinline__ bool xb_leader(int wid) { return wid == 0 && __builtin_amdgcn_mbcnt_hi(~0u, __builtin_amdgcn_mbcnt_lo(~0u, 0u)) == 0u; }

__device__ __forceinline__ XcdBarrier xcd_barrier_post(unsigned* bar, volatile LAS unsigned* st, int wid) {
    XcdBarrier b; b.bar = bar; b.x = xb_xcc_id(); b.st = st; b.wid = wid;
    if (xb_leader(wid)) (void)xb_add(&bar[XB_XCNT(b.x)], 1u);
    return b;
}
__device__ __forceinline__ void xcd_barrier_complete(unsigned* bar, unsigned x, unsigned& nloc, unsigned& nx) {
    const unsigned G = gridDim.x * gridDim.y * gridDim.z;
    unsigned sum, cnt, mine, sp = 0u;
    for (;;) {
        sum = 0u; cnt = 0u; mine = 0u;
#pragma unroll
        for (unsigned j = 0; j < 16; ++j) { const unsigned c = xb_ld(&bar[XB_XCNT(j)]); sum += c; cnt += (c > 0u) ? 1u : 0u; mine = (j == x) ? c : mine; }
        if (sum == G) break;
        __builtin_amdgcn_s_sleep(1);
        if ((++sp & 255u) == 0u) { if (xb_ld(&bar[XB_TMO])) break; if (sp > XB_SPIN_CAP) { atomicAdd(&bar[XB_TMO], 1u); break; } }
    }
    nloc = mine > 0u ? mine : 1u; nx = cnt > 0u ? cnt : 1u;
}
__device__ __forceinline__ void xcd_barrier(const XcdBarrier& b) {
    asm volatile("s_waitcnt vmcnt(0)" ::: "memory");
    __syncthreads();
    if (xb_leader(b.wid)) {
        unsigned* bar = b.bar;
        __builtin_amdgcn_s_waitcnt(0);
        unsigned nloc = b.st[0], nx = b.st[1];
        if (nloc == 0u) { xcd_barrier_complete(bar, b.x, nloc, nx); b.st[0] = nloc; b.st[1] = nx; }
        const unsigned old = xb_add(&bar[XB_XSUB(b.x)], 1u);
        const unsigned gen = old / nloc;
        if (old + 1u == (gen + 1u) * nloc) {
            __builtin_amdgcn_fence(__ATOMIC_RELEASE, "agent");
            asm volatile("s_waitcnt vmcnt(0)" ::: "memory");
            const unsigned og = xb_add(&bar[XB_TOP], 1u);
            const unsigned tg = og / nx;
            if (og + 1u == (tg + 1u) * nx) xb_add(&bar[XB_TOPGEN], 1u);
            else XB_SPIN(xb_ld(&bar[XB_TOPGEN]) == tg, bar);
            __builtin_amdgcn_fence(__ATOMIC_ACQUIRE, "agent");
            xb_add(&bar[XB_XGEN(b.x)], 1u);
            asm volatile("s_waitcnt vmcnt(0)" ::: "memory");
        } else {
            XB_SPIN(xb_ld(&bar[XB_XGEN(b.x)]) == gen, bar);
            __builtin_amdgcn_fence(__ATOMIC_ACQUIRE, "agent");
            asm volatile("s_waitcnt vmcnt(0)" ::: "memory");
        }
    }
    __syncthreads();
}

#define LAS3 __attribute__((address_space(3)))
namespace {
typedef unsigned short bf16_t;
typedef short bf16x8 __attribute__((ext_vector_type(8)));
typedef short bf16x4 __attribute__((ext_vector_type(4)));
typedef float f32x4 __attribute__((ext_vector_type(4)));
typedef float f32x2 __attribute__((ext_vector_type(2)));
typedef unsigned u32x4 __attribute__((ext_vector_type(4)));
typedef unsigned u32x2 __attribute__((ext_vector_type(2)));

constexpr int D = 1024, NB = 32, S = 2048, T = NB * S, NIN = 2380, NP = 2560, NMOD = 6144;
constexpr int OFF_AQ = 0, OFF_AK = 256, OFF_AV = 512, OFF_AF = 768, OFF_BCQ = 772, OFF_BCKV = 1028, OFF_BKR = 1156,
              OFF_CQ = 1188, OFF_CK = 1444, OFF_CV = 1572, OFF_DQ = 1700, OFF_DK = 1956, OFF_DV = 2020,
              OFF_DQI = 2084, OFF_DKI = 2340, OFF_DWI = 2372;
constexpr int PC_AQ = 0, PC_AK = 256, PC_AV = 512, PC_BCQ = 768, PC_BCKV = 1024, PC_BKR = 1152, PC_CQ = 1184, PC_CK = 1440, PC_CV = 1568,
              PC_DQ = 1696, PC_DK = 1952, PC_DV = 2016, PC_DQI = 2080, PC_DKI = 2336, PC_DWI = 2368, PC_AF = 2376;
constexpr float EPS = 1e-6f;
constexpr float LOG2E = 1.4426950408889634f;
constexpr int ECAP = T;
constexpr int HIDROWS = 2 * T + 16 * 256;

__host__ __device__ __forceinline__ int orig_col(int n) { return n < 768 ? n : (n < 2376 ? n + 4 : (n < 2380 ? n - 1608 : -1)); }
__device__ __forceinline__ int opaque_tid(int wid) {
    int t = wid * 64 + (int)__builtin_amdgcn_mbcnt_hi(~0u, __builtin_amdgcn_mbcnt_lo(~0u, 0u));
    asm volatile("" : "+v"(t)); return t; }
__device__ __forceinline__ float bf2f(bf16_t v) { return __uint_as_float((unsigned)v << 16); }
__device__ __forceinline__ bf16_t f2bf(float f) { unsigned u = __float_as_uint(f); u += 0x7FFFu + ((u >> 16) & 1u); return (bf16_t)(u >> 16); }
typedef __bf16 bf16x2_native __attribute__((ext_vector_type(2)));
__device__ __forceinline__ unsigned cvt_pk_bf16(float lo, float hi) { const f32x2 v = {lo, hi}; return __builtin_bit_cast(unsigned, __builtin_convertvector(v, bf16x2_native)); }
__device__ __forceinline__ float bflo(unsigned w) { return __uint_as_float(w << 16); }
__device__ __forceinline__ float bfhi(unsigned w) { return __uint_as_float(w & 0xFFFF0000u); }
__device__ __forceinline__ float wave_sum(float v) {
#pragma unroll
    for (int o = 32; o > 0; o >>= 1) v += __shfl_xor(v, o);
    return v;
}
__device__ __forceinline__ int wave_reduce_add(int v) {
    v += __builtin_amdgcn_update_dpp(0, v, 0xB1, 0xF, 0xF, true);
    v += __builtin_amdgcn_update_dpp(0, v, 0x4E, 0xF, 0xF, true);
    v += __builtin_amdgcn_update_dpp(0, v, 0x141, 0xF, 0xF, true);
    v += __builtin_amdgcn_update_dpp(0, v, 0x140, 0xF, 0xF, true);
    return __builtin_amdgcn_readlane(v, 0) + __builtin_amdgcn_readlane(v, 16) + __builtin_amdgcn_readlane(v, 32) + __builtin_amdgcn_readlane(v, 48);
}
}

namespace pg8 {
#define PG8_LAS __attribute__((address_space(3)))
constexpr int BM = 256, BK = 64, HALF = 128, HTB = HALF * BK * 2, STAGE_BYTES = 8 * HTB, NXCD = 8, WGM = 8;

__host__ __device__ __forceinline__ int lds_byte(int r, int c) { const int st = (r >> 4) * 2 + (c >> 5), rr = r & 15, cc = c & 31, ob = rr * 64 + cc * 2; return st * 1024 + (ob ^ (((ob >> 9) & 1) << 5)); }
__host__ __device__ __forceinline__ void stage_rc(int b, int& R, int& C) { const int st = b / 1024, sb = b % 1024, swz = sb ^ (((sb >> 9) & 1) << 5); R = (st >> 1) * 16 + swz / 64; C = (st & 1) * 32 + (swz % 64) / 2; }
__host__ __device__ __forceinline__ int perm32(int rho) { const int n = rho >> 4, i = rho & 15; return 8 * (i >> 2) + 4 * n + (i & 3); }

struct Unit { int pm, pn, e, mt; };
struct Gemm { const bf16_t* A; const bf16_t* Bt; int K; int lda; size_t bstride; };

struct StaticOrder {
    int nM, nN, nwg, G, c;
    __host__ __device__ void init(int M, int N, int G_, int c_) { nM = M / BM; nN = N / BM; nwg = nM * nN; G = G_; c = c_; }
    __host__ __device__ bool next(int i, Unit& u) const {
        const long L = (long)i * G + c; if (L >= nwg) return false;
        int wgid = (int)L; { const int q = nwg / NXCD, r = nwg % NXCD, xcd = wgid % NXCD, off = wgid / NXCD; wgid = (xcd < r ? xcd * (q + 1) : r * (q + 1) + (xcd - r) * q) + off; }
        const int nig = WGM * nN, gid = wgid / nig, fm = gid * WGM, gsz = (nM - fm) < WGM ? (nM - fm) : WGM;
        u.pm = fm + ((wgid % nig) % gsz); u.pn = (wgid % nig) / gsz; u.e = 0; u.mt = 0; return true;
    }
    __device__ __forceinline__ int arow(const Unit& u, int r) const { return u.pm * BM + r; }
};

template <class Epi, class Sched, bool GATHER>
__device__ __forceinline__ void gemm_phase(PG8_LAS unsigned char* lds, const Gemm g, const Sched& S, const Epi& E, int wave_index) {
    const int tid = opaque_tid(wave_index), wid = __builtin_amdgcn_readfirstlane(tid >> 6), lane = tid & 63, wr = wid >> 2, wc = wid & 3, fr = lane & 15, fq = lane >> 4;
    int K_ = g.K; asm volatile("" : "+s"(K_));
    const int K = K_, nt = K / BK, lda = g.lda;
    int Ra[2], Ca[2]; unsigned voffB[2], voffA[2];
#pragma unroll
    for (int i = 0; i < 2; ++i) { int R, C; stage_rc(tid * 16 + i * 8192, R, C); const int Rb = Epi::PERM ? ((R & ~31) + perm32(R & 31)) : R;
        Ra[i] = R; Ca[i] = C; voffB[i] = (unsigned)(Rb * K + C) * 2u; voffA[i] = (unsigned)(R * lda + C) * 2u; }
    const size_t kstep = (size_t)(BK * 2);
    const size_t hstepB = (size_t)HALF * K * 2;
    const size_t tstepB = 2 * hstepB;
    const size_t hstepA = (size_t)HALF * lda * 2, tstepA = 2 * hstepA;
    const unsigned ldsw = (unsigned)wid * 1024u;
    const int aoff = lds_byte(wr * 64 + fr, fq * 8), boff = lds_byte(wc * 32 + fr, fq * 8);
#define PG8_SA(b, h) (((b) * 2 + (h)) * HTB)
#define PG8_SB(b, h) ((4 + (b) * 2 + (h)) * HTB)
#define PG8_STAGE(bufoff, gbase, voff) do { _Pragma("unroll") for (int _i = 0; _i < 2; ++_i) \
        __builtin_amdgcn_global_load_lds((const unsigned*)((const char*)(gbase) + (voff)[_i]), (PG8_LAS unsigned*)(lds + (bufoff) + ldsw + _i * 8192), 16, 0, 0); } while (0)
#define PG8_STAGEA(bufoff, kptr, VO, h) do { _Pragma("unroll") for (int _i = 0; _i < 2; ++_i) { \
        const char* _src; if constexpr (GATHER) _src = (const char*)(kptr) + (VO)[_i][h]; else _src = (const char*)(kptr) + (size_t)(h) * hstepA + voffA[_i]; \
        __builtin_amdgcn_global_load_lds((const unsigned*)_src, (PG8_LAS unsigned*)(lds + (bufoff) + ldsw + _i * 8192), 16, 0, 0); } } while (0)
#define PG8_LDA(dst, b, h) do { _Pragma("unroll") for (int m = 0; m < 4; ++m) _Pragma("unroll") for (int k = 0; k < 2; ++k) dst[m][k] = *(const PG8_LAS bf16x8*)(lds + PG8_SA(b, h) + aoff + m * 2048 + k * 1024); } while (0)
#define PG8_LDB(dst, b, h) do { _Pragma("unroll") for (int n = 0; n < 2; ++n) _Pragma("unroll") for (int k = 0; k < 2; ++k) dst[n][k] = *(const PG8_LAS bf16x8*)(lds + PG8_SB(b, h) + boff + n * 2048 + k * 1024); } while (0)
#define PG8_MMA(ai, bj, At, Bt) do { __builtin_amdgcn_s_setprio(1); _Pragma("unroll") for (int m = 0; m < 4; ++m) _Pragma("unroll") for (int n = 0; n < 2; ++n) _Pragma("unroll") for (int k = 0; k < 2; ++k) \
        acc[ai][bj][m][n] = __builtin_amdgcn_mfma_f32_16x16x32_bf16(Bt[n][k], At[m][k], acc[ai][bj][m][n], 0, 0, 0); __builtin_amdgcn_s_setprio(0); } while (0)
#define PG8_WAIT_V(n) asm volatile("s_waitcnt vmcnt(" #n ")" ::: "memory")
#define PG8_WAIT_L(n) asm volatile("s_waitcnt lgkmcnt(" #n ")" ::: "memory")
#define PG8_BAR __builtin_amdgcn_s_barrier()
#define PG8_SCHED __builtin_amdgcn_sched_barrier(0)
#define PG8_SETV(V, u) do { _Pragma("unroll") for (int _i = 0; _i < 2; ++_i) _Pragma("unroll") for (int _h = 0; _h < 2; ++_h) { \
        const int _row = GATHER ? S.arow(u, _h * HALF + Ra[_i]) : ((u).pm * BM + _h * HALF + Ra[_i]); V[_i][_h] = (unsigned)(((size_t)_row * lda + Ca[_i]) * 2); } } while (0)
    Unit cur, nxt; int ui = 0;
    if (!S.next(0, cur)) return;
    f32x4 acc[2][2][4][2];
#pragma unroll
    for (int a = 0; a < 2; ++a)
#pragma unroll
        for (int b = 0; b < 2; ++b)
#pragma unroll
            for (int m = 0; m < 4; ++m)
#pragma unroll
                for (int n = 0; n < 2; ++n) acc[a][b][m][n] = (f32x4){0.f, 0.f, 0.f, 0.f};
    bf16x8 At[4][2], B0[2][2], B1[2][2];
    unsigned vA[2][2], vN[2][2];
    if constexpr (GATHER) { PG8_SETV(vA, cur); }
    const char* cA = (const char*)g.A + (GATHER ? (size_t)0 : (size_t)cur.pm * tstepA);
    const char* cB = (const char*)g.Bt + ((size_t)cur.e * g.bstride) * 2 + (size_t)cur.pn * tstepB;
    PG8_STAGE(PG8_SB(0, 0), cB, voffB); PG8_STAGE(PG8_SB(0, 1), cB + hstepB, voffB); PG8_STAGEA(PG8_SA(0, 0), cA, vA, 0); PG8_STAGEA(PG8_SA(0, 1), cA, vA, 1);
    if (wr == 1) PG8_BAR;
    PG8_WAIT_V(2); PG8_BAR;
    PG8_STAGE(PG8_SB(1, 0), cB + kstep, voffB); PG8_STAGEA(PG8_SA(1, 0), cA + kstep, vA, 0); PG8_STAGE(PG8_SB(1, 1), cB + hstepB + kstep, voffB);
    PG8_WAIT_V(6); PG8_BAR;
    for (;;) {
        const bool has_next = S.next(ui + 1, nxt);
        if constexpr (GATHER) { if (has_next) { PG8_SETV(vN, nxt); }
        else {
#pragma unroll
            for (int _i = 0; _i < 2; ++_i)
#pragma unroll
                for (int _h = 0; _h < 2; ++_h) vN[_i][_h] = vA[_i][_h];
        } }
        const char* nA = (!GATHER && has_next) ? (const char*)g.A + (size_t)nxt.pm * tstepA : cA;
        const char* nB = has_next ? (const char*)g.Bt + ((size_t)nxt.e * g.bstride) * 2 + (size_t)nxt.pn * tstepB : cB;
#pragma unroll 1
        for (int t = 0; t < nt; t += 2) {
            const bool last = (t == nt - 2);
            const char* a1 = cA + (size_t)(t + 1) * kstep;
            const char* a2 = last ? nA : cA + (size_t)(t + 2) * kstep; const char* b2 = last ? nB : cB + (size_t)(t + 2) * kstep;
            const char* a3 = a2 + kstep; const char* b3 = b2 + kstep;
            unsigned v2[2][2];
            if constexpr (GATHER) {
#pragma unroll
            for (int _i = 0; _i < 2; ++_i)
#pragma unroll
                for (int _h = 0; _h < 2; ++_h) v2[_i][_h] = last ? vN[_i][_h] : vA[_i][_h];
            }
            PG8_LDB(B0, 0, 0); PG8_LDB(B1, 0, 1); PG8_SCHED; PG8_LDA(At, 0, 0); PG8_STAGEA(PG8_SA(1, 1), a1, vA, 1);
            PG8_WAIT_V(8); PG8_WAIT_L(0); PG8_BAR; PG8_MMA(0, 0, At, B0); PG8_MMA(0, 1, At, B1); PG8_BAR; PG8_SCHED;
            PG8_LDA(At, 0, 1); PG8_STAGE(PG8_SB(0, 0), b2, voffB); PG8_STAGE(PG8_SB(0, 1), b2 + hstepB, voffB); PG8_STAGEA(PG8_SA(0, 0), a2, v2, 0);
            PG8_WAIT_V(8); PG8_WAIT_L(0); PG8_BAR; PG8_MMA(1, 0, At, B0); PG8_MMA(1, 1, At, B1); PG8_BAR; PG8_SCHED;
            PG8_LDB(B0, 1, 0); PG8_LDB(B1, 1, 1); PG8_SCHED; PG8_LDA(At, 1, 0); PG8_STAGEA(PG8_SA(0, 1), a2, v2, 1);
            PG8_WAIT_V(8); PG8_WAIT_L(0); PG8_BAR; PG8_MMA(0, 0, At, B0); PG8_MMA(0, 1, At, B1); PG8_BAR; PG8_SCHED;
            PG8_LDA(At, 1, 1); PG8_STAGE(PG8_SB(1, 0), b3, voffB); PG8_STAGE(PG8_SB(1, 1), b3 + hstepB, voffB); PG8_STAGEA(PG8_SA(1, 0), a3, v2, 0);
            PG8_WAIT_V(8); PG8_WAIT_L(0); PG8_BAR; PG8_MMA(1, 0, At, B0); PG8_MMA(1, 1, At, B1); PG8_BAR; PG8_SCHED;
        }
        if (wr == 0) PG8_BAR;
        E(acc, cur, wr, wc, fr, fq);
        if (!has_next) break;
#pragma unroll
        for (int a = 0; a < 2; ++a)
#pragma unroll
            for (int b = 0; b < 2; ++b)
#pragma unroll
                for (int m = 0; m < 4; ++m)
#pragma unroll
                    for (int n = 0; n < 2; ++n) acc[a][b][m][n] = (f32x4){0.f, 0.f, 0.f, 0.f};
        cur = nxt; cB = nB; cA = nA; ++ui;
        if constexpr (GATHER) {
#pragma unroll
        for (int _i = 0; _i < 2; ++_i)
#pragma unroll
            for (int _h = 0; _h < 2; ++_h) vA[_i][_h] = vN[_i][_h];
        }
        if (wr == 1) PG8_BAR;
    }
    PG8_WAIT_V(0);
    PG8_BAR;
#undef PG8_SA
#undef PG8_SB
#undef PG8_STAGE
#undef PG8_STAGEA
#undef PG8_LDA
#undef PG8_LDB
#undef PG8_MMA
#undef PG8_WAIT_V
#undef PG8_WAIT_L
#undef PG8_BAR
#undef PG8_SCHED
#undef PG8_SETV
}
}

namespace {
struct Params {
    const float *x, *c, *w_ada, *b_ada, *g_norm1, *w_in, *b_forget, *g_q_mla, *w_q_up, *g_kv_mla, *w_kv_up, *sinks, *w_out, *g_norm2,
                *w_router, *b_router, *w_gate, *w_up, *w_down, *g_final;
    float* xo;
    unsigned* ctl;
    float* mod;
    bf16_t* WinT;
    bf16_t* WoutT;
    bf16_t* WqT;
    bf16_t* WkvT;
    bf16_t* WguT;
    bf16_t* WdT;
    float* ropetab;
    float* rq; float* rkv;
    float* cbF;
    uint32_t* mask;
    bf16_t* h;
    bf16_t* proj;
    bf16_t* qm; bf16_t* km; bf16_t* vm;
    bf16_t* merged;
    bf16_t* hid;
    bf16_t* ys;
    int* list;
    float* rw;
    int wid;
    int qslot;
};
constexpr int CW_BAR = 0;
constexpr int CW_CNT = 3584;
constexpr int CW_QA = 3648;
constexpr int CW_QD = 3840;
constexpr int CW_WORDS = 4096;
}

namespace {
template <class F>
__device__ __forceinline__ void conv_job(bf16_t* __restrict__ dst, int nrows, int K, F f, int gtid, int gthreads) {
    const int k8n = K >> 3; const long items = (long)nrows * k8n;
    for (long it = gtid; it < items; it += gthreads) {
        const int n = (int)(it % nrows), k0 = (int)(it / nrows) * 8;
        float v[8];
#pragma unroll
        for (int j = 0; j < 8; ++j) v[j] = f(n, k0 + j);
        u32x4 w; w.x = cvt_pk_bf16(v[0], v[1]); w.y = cvt_pk_bf16(v[2], v[3]); w.z = cvt_pk_bf16(v[4], v[5]); w.w = cvt_pk_bf16(v[6], v[7]);
        *(u32x4*)(dst + (size_t)n * K + k0) = w;
    }
}
struct FWin { const float* w; __device__ float operator()(int n, int k) const { const int o = orig_col(n); return o >= 0 ? w[(size_t)k * NIN + o] : 0.f; } };
struct FT { const float* w; int ld; __device__ float operator()(int n, int k) const { return w[(size_t)k * ld + n]; } };
struct FTg { const float* w; const float* g; int ld, nmax; __device__ float operator()(int n, int k) const { return n < nmax ? g[k] * w[(size_t)k * ld + n] : 0.f; } };
struct FGu { const float* wg; long du; __device__ float operator()(int n, int k) const { const int q = n >> 5, r = n & 31, col = 16 * q + (r & 15); const long sel = (r < 16) ? 0l : du; return wg[sel + (long)k * 256 + col]; } };

__device__ __forceinline__ void phase_p0(const Params& p, char* lds) {
    const int tid = opaque_tid(p.wid), gtid = blockIdx.x * blockDim.x + tid, gthreads = gridDim.x * blockDim.x;
    for (int l = 0; l < 2; ++l) {
        conv_job(p.WinT + (size_t)l * NP * D, NP, D, FWin{p.w_in + (size_t)l * D * NIN}, gtid, gthreads);
        conv_job(p.WoutT + (size_t)l * D * D, D, D, FT{p.w_out + (size_t)l * D * D, D}, gtid, gthreads);
        conv_job(p.WqT + (size_t)l * 512 * 256, 512, 256, FTg{p.w_q_up + (size_t)l * 256 * 384, p.g_q_mla + l * 256, 384, 384}, gtid, gthreads);
        conv_job(p.WkvT + (size_t)l * 512 * 128, 512, 128, FTg{p.w_kv_up + (size_t)l * 128 * 512, p.g_kv_mla + l * 128, 512, 512}, gtid, gthreads);
        for (int e = 0; e < 16; ++e) {
            const size_t le = (size_t)l * 16 + e;
            conv_job(p.WguT + le * 512 * 1024, 512, 1024, FGu{p.w_gate + le * 1024 * 256, (long)(p.w_up - p.w_gate)}, gtid, gthreads);
            conv_job(p.WdT + le * 1024 * 256, 1024, 256, FT{p.w_down + le * 256 * 1024, 1024}, gtid, gthreads);
        }
    }
    for (int it = gtid; it < 2048 * 16; it += gthreads) {
        const int pos = it >> 4, i = it & 15;
        const float inv = powf(10000.0f, -(float)i / 16.0f), ang = (float)pos * inv;
        p.ropetab[it * 2] = cosf(ang); p.ropetab[it * 2 + 1] = sinf(ang);
    }
    float* ca = (float*)lds;
    for (int i = tid; i < NB * 1024; i += 512) { const float v = p.c[i]; ca[i] = v / (1.f + __expf(-v)); }
    __syncthreads();
    for (int u = blockIdx.x; u < 2 * (NMOD / 128); u += gridDim.x) {
        const int l = u / (NMOD / 128), n = (u % (NMOD / 128)) * 128 + (tid & 127), bg = tid >> 7;
        const float* w = p.w_ada + (size_t)l * 1024 * NMOD + n;
        float acc[8];
#pragma unroll
        for (int j = 0; j < 8; ++j) acc[j] = 0.f;
        for (int d = 0; d < 1024; ++d) { const float wv = w[(size_t)d * NMOD];
#pragma unroll
            for (int j = 0; j < 8; ++j) acc[j] += ca[(bg * 8 + j) * 1024 + d] * wv; }
        const float bias = p.b_ada[l * NMOD + n];
#pragma unroll
        for (int j = 0; j < 8; ++j) p.mod[((size_t)l * NB + bg * 8 + j) * NMOD + n] = acc[j] + bias;
    }
    __syncthreads();
}

template <int MODE>
__device__ __forceinline__ void phase_norm1(const Params& p, int l) {
    constexpr int NT = 2;
    const int tid = opaque_tid(p.wid), w = tid >> 6, lane = tid & 63;
    const float* xin = (MODE == 0) ? p.x : p.xo;
    const float* g = (MODE == 2) ? p.g_final : p.g_norm1 + l * D;
    const float* modl = p.mod + (size_t)(MODE == 2 ? 1 : l) * NB * NMOD;
    const float* modp = p.mod + (size_t)(MODE == 2 ? 1 : (l > 0 ? l - 1 : 0)) * NB * NMOD;
    for (int t0 = (blockIdx.x * 8 + w) * NT; t0 < T; t0 += gridDim.x * 8 * NT) {
        f32x4 v[NT][4];
#pragma unroll
        for (int u = 0; u < NT; ++u)
#pragma unroll
            for (int k = 0; k < 4; ++k) v[u][k] = *(const f32x4*)(xin + (size_t)(t0 + u) * D + 4 * lane + 256 * k);
        if (MODE >= 1) {
            u32x2 y0[NT][4], y1[NT][4];
#pragma unroll
            for (int u = 0; u < NT; ++u)
#pragma unroll
                for (int k = 0; k < 4; ++k) { const int col = 4 * lane + 256 * k;
                    y0[u][k] = *(const u32x2*)(p.ys + ((size_t)(t0 + u) * 2 + 0) * D + col); y1[u][k] = *(const u32x2*)(p.ys + ((size_t)(t0 + u) * 2 + 1) * D + col); }
#pragma unroll
            for (int u = 0; u < NT; ++u) {
                const int b = (t0 + u) >> 11;
#pragma unroll
                for (int k = 0; k < 4; ++k) {
                    const int col = 4 * lane + 256 * k;
                    const f32x4 gt = *(const f32x4*)(modp + (size_t)b * NMOD + 5 * 1024 + col);
                    v[u][k][0] += gt[0] * (bflo(y0[u][k].x) + bflo(y1[u][k].x)); v[u][k][1] += gt[1] * (bfhi(y0[u][k].x) + bfhi(y1[u][k].x));
                    v[u][k][2] += gt[2] * (bflo(y0[u][k].y) + bflo(y1[u][k].y)); v[u][k][3] += gt[3] * (bfhi(y0[u][k].y) + bfhi(y1[u][k].y));
                }
            }
        }
#pragma unroll
        for (int u = 0; u < NT; ++u) {
            const int t = t0 + u, b = t >> 11;
            float ss = 0.f;
#pragma unroll
            for (int k = 0; k < 4; ++k) ss += v[u][k][0] * v[u][k][0] + v[u][k][1] * v[u][k][1] + v[u][k][2] * v[u][k][2] + v[u][k][3] * v[u][k][3];
            ss = wave_sum(ss);
            const float r = rsqrtf(ss * (1.0f / D) + EPS);
#pragma unroll
            for (int k = 0; k < 4; ++k) {
                const int col = 4 * lane + 256 * k;
                const f32x4 gg = *(const f32x4*)(g + col);
                f32x4 y = v[u][k] * r * gg;
                if (MODE == 2) { *(f32x4*)(p.xo + (size_t)t * D + col) = y; }
                else {
                    *(f32x4*)(p.xo + (size_t)t * D + col) = v[u][k];
                    const f32x4 sc = *(const f32x4*)(modl + (size_t)b * NMOD + 1024 + col), sh = *(const f32x4*)(modl + (size_t)b * NMOD + col);
                    y = y * (1.f + sc) + sh;
                    u32x2 o; o.x = cvt_pk_bf16(y[0], y[1]); o.y = cvt_pk_bf16(y[2], y[3]);
                    *(u32x2*)(p.h + (size_t)t * D + col) = o;
                }
            }
        }
    }
}
}

namespace {
using pg8::Unit;
struct EpiStoreBf16 {
    static constexpr bool PERM = true;
    bf16_t* O; int ldc;
    __device__ __forceinline__ void operator()(const f32x4 (&acc)[2][2][4][2], const Unit& u, int wr, int wc, int fr_, int fq_) const {
        int fr = fr_, fq = fq_; asm volatile("" : "+v"(fr), "+v"(fq));
        const int row0 = u.pm * 256 + wr * 64 + fr, col0 = u.pn * 256 + wc * 32 + 8 * fq;
#pragma unroll
        for (int ai = 0; ai < 2; ++ai)
#pragma unroll
            for (int m = 0; m < 4; ++m) { bf16_t* rowp = O + (size_t)(row0 + ai * 128 + m * 16) * ldc + col0;
#pragma unroll
                for (int bj = 0; bj < 2; ++bj) { const f32x4 v0 = acc[ai][bj][m][0], v1 = acc[ai][bj][m][1];
                    u32x4 w; w.x = cvt_pk_bf16(v0[0], v0[1]); w.y = cvt_pk_bf16(v0[2], v0[3]); w.z = cvt_pk_bf16(v1[0], v1[1]); w.w = cvt_pk_bf16(v1[2], v1[3]);
                    *(u32x4*)(rowp + bj * 128) = w; } }
    }
};
struct EpiResidual {
    static constexpr bool PERM = false;
    float* x; const float* gate;
    __device__ __forceinline__ void operator()(const f32x4 (&acc)[2][2][4][2], const Unit& u, int wr, int wc, int fr_, int fq_) const {
        int fr = fr_, fq = fq_; asm volatile("" : "+v"(fr), "+v"(fq));
        const int row0 = u.pm * 256 + wr * 64 + fr, col0 = u.pn * 256 + wc * 32 + 4 * fq;
        const int b = (u.pm * 256) >> 11;
        f32x4 gv[2][2];
#pragma unroll
        for (int bj = 0; bj < 2; ++bj)
#pragma unroll
            for (int n = 0; n < 2; ++n) gv[bj][n] = *(const f32x4*)(gate + (size_t)b * NMOD + col0 + bj * 128 + n * 16);
#pragma unroll
        for (int ai = 0; ai < 2; ++ai)
#pragma unroll
            for (int m = 0; m < 4; ++m) { float* rowp = x + (size_t)(row0 + ai * 128 + m * 16) * D + col0;
#pragma unroll
                for (int bj = 0; bj < 2; ++bj)
#pragma unroll
                    for (int n = 0; n < 2; ++n) { f32x4* q = (f32x4*)(rowp + bj * 128 + n * 16); *q = *q + gv[bj][n] * acc[ai][bj][m][n]; } }
    }
};
struct EpiMlaQ {
    static constexpr bool PERM = true;
    bf16_t* qm;
    __device__ __forceinline__ void operator()(const f32x4 (&acc)[2][2][4][2], const Unit& u, int wr, int wc, int fr_, int fq_) const {
        int fr = fr_, fq = fq_; asm volatile("" : "+v"(fr), "+v"(fq));
        const int row0 = u.pm * 256 + wr * 64 + fr;
#pragma unroll
        for (int bj = 0; bj < 2; ++bj) {
            const int col0 = u.pn * 256 + bj * 128 + wc * 32;
            if (col0 >= 384) continue;
#pragma unroll
            for (int ai = 0; ai < 2; ++ai)
#pragma unroll
                for (int m = 0; m < 4; ++m) { const f32x4 v0 = acc[ai][bj][m][0], v1 = acc[ai][bj][m][1];
                    u32x4 w; w.x = cvt_pk_bf16(v0[0], v0[1]); w.y = cvt_pk_bf16(v0[2], v0[3]); w.z = cvt_pk_bf16(v1[0], v1[1]); w.w = cvt_pk_bf16(v1[2], v1[3]);
                    *(u32x4*)(qm + (size_t)(row0 + ai * 128 + m * 16) * 384 + col0 + 8 * fq) = w; }
        }
    }
};
struct EpiMlaKV {
    static constexpr bool PERM = true;
    bf16_t* km; bf16_t* vm;
    __device__ __forceinline__ void operator()(const f32x4 (&acc)[2][2][4][2], const Unit& u, int wr, int wc, int fr_, int fq_) const {
        int fr = fr_, fq = fq_; asm volatile("" : "+v"(fr), "+v"(fq));
        const int row0 = u.pm * 256 + wr * 64 + fr;
#pragma unroll
        for (int bj = 0; bj < 2; ++bj) {
            const int head = u.pn * 2 + bj, wcol = wc * 32 + 8 * fq;
#pragma unroll
            for (int ai = 0; ai < 2; ++ai)
#pragma unroll
                for (int m = 0; m < 4; ++m) {
                    const int row = row0 + ai * 128 + m * 16;
                    const f32x4 v0 = acc[ai][bj][m][0], v1 = acc[ai][bj][m][1];
                    u32x4 w; w.x = cvt_pk_bf16(v0[0], v0[1]); w.y = cvt_pk_bf16(v0[2], v0[3]); w.z = cvt_pk_bf16(v1[0], v1[1]); w.w = cvt_pk_bf16(v1[2], v1[3]);
                    bf16_t* q = (wcol < 64) ? km + (size_t)row * 384 + head * 96 + wcol : vm + (size_t)row * 256 + head * 64 + (wcol - 64);
                    *(u32x4*)q = w;
                    asm volatile("" ::: "memory");
                }
        }
    }
};
struct EpiGateUp {
    static constexpr bool PERM = false;
    bf16_t* hid;
    __device__ __forceinline__ void operator()(const f32x4 (&acc)[2][2][4][2], const Unit& u, int wr, int wc, int fr_, int fq_) const {
        int fr = fr_, fq = fq_; asm volatile("" : "+v"(fr), "+v"(fq));
        const int row0 = u.pm * 256 + wr * 64 + fr;
#pragma unroll
        for (int ai = 0; ai < 2; ++ai)
#pragma unroll
            for (int m = 0; m < 4; ++m) { bf16_t* rowp = hid + (size_t)(row0 + ai * 128 + m * 16) * 256;
#pragma unroll
                for (int bj = 0; bj < 2; ++bj) { const f32x4 gt = acc[ai][bj][m][0], up = acc[ai][bj][m][1];
                    f32x4 o;
#pragma unroll
                    for (int j = 0; j < 4; ++j) o[j] = gt[j] / (1.f + __expf(-gt[j])) * up[j];
                    u32x2 w; w.x = cvt_pk_bf16(o[0], o[1]); w.y = cvt_pk_bf16(o[2], o[3]);
                    *(u32x2*)(rowp + 16 * (u.pn * 8 + bj * 4 + wc) + 4 * fq) = w; } }
    }
};
struct EpiDown {
    static constexpr bool PERM = true;
    bf16_t* ys; const int* list; const float* rw; const int* cnt;
    __device__ __forceinline__ void operator()(const f32x4 (&acc)[2][2][4][2], const Unit& u, int wr, int wc, int fr_, int fq_) const {
        int fr = fr_, fq = fq_; asm volatile("" : "+v"(fr), "+v"(fq));
        const int n = cnt[u.e]; const int* le = list + (size_t)u.e * ECAP;
        const int col0 = u.pn * 256 + wc * 32 + 8 * fq;
#pragma unroll
        for (int ai = 0; ai < 2; ++ai)
#pragma unroll
            for (int m = 0; m < 4; ++m) {
                const int lr = u.mt * 256 + ai * 128 + wr * 64 + m * 16 + fr;
                if (lr < n) {
                    const int slot = le[lr]; const float w8 = rw[slot];
                    bf16_t* rowp = ys + (size_t)slot * D + col0;
#pragma unroll
                    for (int bj = 0; bj < 2; ++bj) { const f32x4 v0 = acc[ai][bj][m][0] * w8, v1 = acc[ai][bj][m][1] * w8;
                        u32x4 w; w.x = cvt_pk_bf16(v0[0], v0[1]); w.y = cvt_pk_bf16(v0[2], v0[3]); w.z = cvt_pk_bf16(v1[0], v1[1]); w.w = cvt_pk_bf16(v1[2], v1[3]);
                        *(u32x4*)(rowp + bj * 128) = w; }
                }
            }
    }
};
struct MoeOrder {
    int pre[17];
    int NT, G, c; const int* list; const int* cnt;
    __device__ __forceinline__ void init(const int* cnt_, const int* list_, int NT_, int G_, int c_) {
        cnt = cnt_; list = list_; NT = NT_; G = G_; c = c_; int a = 0;
#pragma unroll
        for (int e = 0; e < 16; ++e) { pre[e] = a; a += (cnt_[e] + 255) >> 8; }
        pre[16] = a;
    }
    __device__ __forceinline__ bool next(int i, Unit& u) const {
        const int L = i * G + c; if (L >= pre[16] * NT) return false;
        const int t = L / NT; int e = 0;
#pragma unroll
        for (int k = 1; k < 16; ++k) e += (t >= pre[k]) ? 1 : 0;
        int pe = 0;
#pragma unroll
        for (int k = 0; k < 16; ++k) pe = (k == e) ? pre[k] : pe;
        u.e = e; u.mt = t - pe; u.pm = t; u.pn = L - t * NT; return true;
    }
    __device__ __forceinline__ int arow(const Unit& u, int r) const { const int lr = u.mt * 256 + r; return lr < cnt[u.e] ? (list[(size_t)u.e * ECAP + lr] >> 1) : 0; }
};
}

namespace {
__device__ __forceinline__ void phase_prep(const Params& p, int l) {
    const int tid = opaque_tid(p.wid), w = tid >> 6, lane = tid & 63;
    const int gw = blockIdx.x * 8 + w, nw = gridDim.x * 8;
    for (int sq = gw; sq < NB * 4; sq += nw) {
        const int b = sq >> 2, hh = sq & 3; const float bias = p.b_forget[l * 4 + hh];
        float lf[32]; float run = 0.f;
#pragma unroll
        for (int j = 0; j < 32; ++j) {
            const float z = bf2f(p.proj[(size_t)(b * S + lane * 32 + j) * NP + PC_AF + hh]) + bias;
            run += fminf(z, 0.f) - log1pf(__expf(-fabsf(z)));
            lf[j] = run;
        }
        float incl = run;
#pragma unroll
        for (int o = 1; o < 64; o <<= 1) { const float t2 = __shfl_up(incl, o); if (lane >= o) incl += t2; }
        const float excl = incl - run;
#pragma unroll
        for (int j = 0; j < 32; ++j) p.cbF[(size_t)sq * S + lane * 32 + j] = -(excl + lf[j]) * LOG2E;
    }
    for (int t = gw; t < T; t += nw) {
        const bf16_t* row = p.proj + (size_t)t * NP;
        const u32x2 cq = *(const u32x2*)(row + PC_BCQ + 4 * lane);
        const unsigned ck = *(const unsigned*)(row + PC_BCKV + 2 * lane);
        float s1 = bflo(cq.x) * bflo(cq.x) + bfhi(cq.x) * bfhi(cq.x) + bflo(cq.y) * bflo(cq.y) + bfhi(cq.y) * bfhi(cq.y);
        float s2 = bflo(ck) * bflo(ck) + bfhi(ck) * bfhi(ck);
        s1 = wave_sum(s1); s2 = wave_sum(s2);
        const float kr = (lane < 32) ? bf2f(row[PC_BKR + lane]) : 0.f;
        const float kr2 = __shfl(kr, (lane + 16) & 63);
        {
            const float r1 = rsqrtf(s1 * (1.f / 256.f) + EPS), r2 = rsqrtf(s2 * (1.f / 128.f) + EPS);
            u32x2 o; o.x = cvt_pk_bf16(bflo(cq.x) * r1, bfhi(cq.x) * r1); o.y = cvt_pk_bf16(bflo(cq.y) * r1, bfhi(cq.y) * r1);
            *(u32x2*)(p.proj + (size_t)t * NP + PC_BCQ + 4 * lane) = o;
            *(unsigned*)(p.proj + (size_t)t * NP + PC_BCKV + 2 * lane) = cvt_pk_bf16(bflo(ck) * r2, bfhi(ck) * r2);
        }
        if (lane < 16) {
            const int pos = t & (S - 1);
            const float cs = p.ropetab[(pos * 16 + lane) * 2], sn = p.ropetab[(pos * 16 + lane) * 2 + 1];
            const bf16_t o1 = f2bf(kr * cs - kr2 * sn), o2 = f2bf(kr2 * cs + kr * sn);
            bf16_t* kmr = p.km + (size_t)t * 384;
#pragma unroll
            for (int hh = 0; hh < 4; ++hh) { kmr[hh * 96 + 64 + lane] = o1; kmr[hh * 96 + 80 + lane] = o2; }
        }
    }
}

__device__ __forceinline__ void phase_route(const Params& p, int l, char* lds) {
    const int tid = opaque_tid(p.wid), w = tid >> 6, lane = tid & 63;
    float* wrT = (float*)lds;
    int* lcnt = (int*)(lds + 65536);
    int* lbase = (int*)(lds + 65536 + 64);
    int* tsel = (int*)(lds + 65536 + 128);
    for (int i = tid; i < 16 * 1024; i += 512) { const int e = i >> 10, d = i & 1023; wrT[i] = p.w_router[d * 16 + e]; }
    const float* g = p.g_norm2 + l * D;
    const float* modl = p.mod + (size_t)l * NB * NMOD;
    int* cnt = (int*)(p.ctl + CW_CNT) + l * 16 + 32 * p.qslot;
    int* list = p.list + (size_t)p.qslot * 16 * ECAP;
    for (int chunk = blockIdx.x; chunk < T / 256; chunk += gridDim.x) {
        if (tid < 16) lcnt[tid] = 0;
        __syncthreads();
        for (int it = 0; it < 32; ++it) {
            const int li = w * 32 + it, t = chunk * 256 + li;
            const int b = t >> 11;
            f32x4 v[4];
#pragma unroll
            for (int k = 0; k < 4; ++k) v[k] = *(const f32x4*)(p.xo + (size_t)t * D + 4 * lane + 256 * k);
            float ss = 0.f;
#pragma unroll
            for (int k = 0; k < 4; ++k) ss += v[k][0] * v[k][0] + v[k][1] * v[k][1] + v[k][2] * v[k][2] + v[k][3] * v[k][3];
            ss = wave_sum(ss);
            const float r = rsqrtf(ss * (1.0f / D) + EPS);
            float lg[16];
#pragma unroll
            for (int e = 0; e < 16; ++e) lg[e] = 0.f;
#pragma unroll
            for (int k = 0; k < 4; ++k) {
                const int col = 4 * lane + 256 * k;
                const f32x4 gg = *(const f32x4*)(g + col);
                const f32x4 sc = *(const f32x4*)(modl + (size_t)b * NMOD + 4 * 1024 + col), sh = *(const f32x4*)(modl + (size_t)b * NMOD + 3 * 1024 + col);
                const f32x4 y = v[k] * r * gg * (1.f + sc) + sh;
                u32x2 o; o.x = cvt_pk_bf16(y[0], y[1]); o.y = cvt_pk_bf16(y[2], y[3]);
                *(u32x2*)(p.h + (size_t)t * D + col) = o;
#pragma unroll
                for (int e = 0; e < 16; ++e) { const f32x4 wv = *(const f32x4*)(wrT + e * 1024 + col); lg[e] += y[0] * wv[0] + y[1] * wv[1] + y[2] * wv[2] + y[3] * wv[3]; }
                asm volatile("" ::: "memory");
            }
#pragma unroll
            for (int e = 0; e < 16; ++e) lg[e] = wave_sum(lg[e]);
            if (lane == 0) {
                float sc[16], bi[16];
#pragma unroll
                for (int e = 0; e < 16; ++e) { sc[e] = 1.f / (1.f + expf(-lg[e])); bi[e] = sc[e] + p.b_router[e]; }
                int bg = 0; float bgs = -INFINITY;
#pragma unroll
                for (int gi = 0; gi < 4; ++gi) {
                    float m1 = -INFINITY, m2 = -INFINITY;
#pragma unroll
                    for (int j = 0; j < 4; ++j) { const float vv = bi[gi * 4 + j]; if (vv > m1) { m2 = m1; m1 = vv; } else if (vv > m2) m2 = vv; }
                    const float gs = m1 + m2; if (gs > bgs) { bgs = gs; bg = gi; }
                }
                float b4[4], s4[4];
#pragma unroll
                for (int gi = 0; gi < 4; ++gi)
#pragma unroll
                    for (int j = 0; j < 4; ++j) if (gi == bg) { b4[j] = bi[gi * 4 + j]; s4[j] = sc[gi * 4 + j]; }
                int i1 = 0; float v1 = -INFINITY;
#pragma unroll
                for (int j = 0; j < 4; ++j) { if (b4[j] > v1) { v1 = b4[j]; i1 = j; } }
                int i2 = 0; float v2 = -INFINITY;
#pragma unroll
                for (int j = 0; j < 4; ++j) { if (j != i1 && b4[j] > v2) { v2 = b4[j]; i2 = j; } }
                float w1 = 0.f, w2 = 0.f;
#pragma unroll
                for (int j = 0; j < 4; ++j) { if (j == i1) w1 = s4[j]; if (j == i2) w2 = s4[j]; }
                const int e1 = bg * 4 + i1, e2 = bg * 4 + i2; const float ws = w1 + w2;
                const int r1 = atomicAdd(&lcnt[e1], 1), r2 = atomicAdd(&lcnt[e2], 1);
                tsel[li * 2 + 0] = (e1 << 16) | r1; tsel[li * 2 + 1] = (e2 << 16) | r2;
                p.rw[t * 2 + 0] = w1 / ws; p.rw[t * 2 + 1] = w2 / ws;
            }
        }
        __syncthreads();
        if (tid < 16) lbase[tid] = atomicAdd(&cnt[tid], lcnt[tid]);
        __syncthreads();
        { const int v = tsel[tid], e = v >> 16, rk = v & 0xFFFF; list[(size_t)e * ECAP + lbase[e] + rk] = (chunk * 256 + (tid >> 1)) * 2 + (tid & 1); }
        __syncthreads();
    }
}
}

namespace {
constexpr int AT_KB = 0;
constexpr int AT_KR = 16384;
constexpr int AT_VB = 24576;
constexpr int AT_CB = 40960;
constexpr int AT_CTL = 41472;
constexpr int AT_LDS = 41984;
constexpr float NEGBIG = -1.0e30f;

template <int VAR>
__device__ __forceinline__ void attn_unit(const Params& p, int l, int b, int hx, int qb, LAS3 char* lds) {
    typedef LAS3 bf16x4 lds_bf16x4;
    constexpr int KC = (VAR == 1) ? 3 : 2;
    const int tid = opaque_tid(p.wid), w = __builtin_amdgcn_readfirstlane(tid >> 6), lane = tid & 63, i = lane & 15, g = lane >> 4;
    const bf16_t *Qp, *Kp, *Vp; int ldq, ldk, ldv, q0, j0, j1, ocol; float c1, slope2 = 0.f;
    if (VAR == 0) { Qp = p.proj + PC_AQ + hx * 64; Kp = p.proj + PC_AK + hx * 64; Vp = p.proj + PC_AV + hx * 64; ldq = ldk = ldv = NP;
                    q0 = qb * 256 + 32 * w; j0 = 0; j1 = 4 * qb + 3; ocol = hx * 64; c1 = 0.125f * LOG2E; }
    else if (VAR == 1) { Qp = p.qm + hx * 96; Kp = p.km + hx * 96; Vp = p.vm + hx * 64; ldq = 384; ldk = 384; ldv = 256;
                    q0 = qb * 256 + 32 * w; j0 = 0; j1 = 4 * qb + 3; ocol = 256 + hx * 64; c1 = 0.10206207261596577f * LOG2E; }
    else if (VAR == 2) { const int qh = hx * 2 + (w >> 2); Qp = p.proj + PC_CQ + qh * 64; Kp = p.proj + PC_CK + hx * 64; Vp = p.proj + PC_CV + hx * 64; ldq = ldk = ldv = NP;
                    q0 = qb * 128 + 32 * (w & 3); j0 = 2 * qb - 2 > 0 ? 2 * qb - 2 : 0; j1 = 2 * qb + 1; ocol = 512 + qh * 64; c1 = 0.125f * LOG2E;
                    slope2 = exp2f(-(float)(qh + 1)) * LOG2E; }
    else { const int hd = w >> 1; Qp = p.proj + PC_DQ + hd * 64; Kp = p.proj + PC_DK; Vp = p.proj + PC_DV; ldq = ldk = ldv = NP;
                    q0 = qb * 64 + 32 * (w & 1); j0 = 0; j1 = qb; ocol = 768 + hd * 64; c1 = 0.125f * LOG2E; slope2 = exp2f(-(float)(hd + 5)) * LOG2E; }
    const size_t tok0 = (size_t)b * S;
    bf16x8 qf[2][KC];
#pragma unroll
    for (int qt = 0; qt < 2; ++qt)
#pragma unroll
        for (int kc = 0; kc < KC; ++kc) qf[qt][kc] = *(const bf16x8*)(Qp + (tok0 + q0 + 16 * qt + i) * ldq + kc * 32 + 8 * g);
    if (VAR == 1) {
#pragma unroll
        for (int qt = 0; qt < 2; ++qt) {
            const int pos = q0 + 16 * qt + i;
            const u32x4 mine = __builtin_bit_cast(u32x4, qf[qt][KC - 1]);
            u32x4 oth; oth.x = __shfl_xor(mine.x, 32); oth.y = __shfl_xor(mine.y, 32); oth.z = __shfl_xor(mine.z, 32); oth.w = __shfl_xor(mine.w, 32);
            const float* rt = p.ropetab + (size_t)(pos * 16 + (g & 1) * 8) * 2;
            const float sg = (g < 2) ? -1.f : 1.f;
            u32x4 res;
#pragma unroll
            for (int e2 = 0; e2 < 4; ++e2) {
                const f32x4 cs = *(const f32x4*)(rt + e2 * 4);
                const unsigned mw_ = e2 == 0 ? mine.x : e2 == 1 ? mine.y : e2 == 2 ? mine.z : mine.w, ow_ = e2 == 0 ? oth.x : e2 == 1 ? oth.y : e2 == 2 ? oth.z : oth.w;
                const float r0 = bflo(mw_) * cs[0] + sg * bflo(ow_) * cs[1], r1 = bfhi(mw_) * cs[2] + sg * bfhi(ow_) * cs[3];
                const unsigned pk = cvt_pk_bf16(r0, r1);
                if (e2 == 0) res.x = pk; else if (e2 == 1) res.y = pk; else if (e2 == 2) res.z = pk; else res.w = pk;
            }
            qf[qt][KC - 1] = __builtin_bit_cast(bf16x8, res);
        }
    }
    f32x4 o[2][4];
#pragma unroll
    for (int qt = 0; qt < 2; ++qt)
#pragma unroll
        for (int dt = 0; dt < 4; ++dt) o[qt][dt] = (f32x4){0.f, 0.f, 0.f, 0.f};
    float mrow[2] = {NEGBIG, NEGBIG}, lsum[2] = {0.f, 0.f};
    const int sr = tid >> 3, sc8 = tid & 7;
    const int kdst = sr * 128 + ((sc8 ^ ((sr >> 1) & 7)) << 4);
    const int vdst = sr * 128 + (((((sc8 >> 1) ^ ((sr >> 1) & 3)) << 1) | (sc8 & 1)) << 4);
    const int rr = (tid & 255) >> 2, rc4 = tid & 3;
    const int rdst = rr * 64 + ((rc4 ^ ((rr >> 1) & 3)) << 4);
    u32x4 kst, vst, rst = {0u, 0u, 0u, 0u}; float cst = 0.f;
    u32x2 mw[2] = {{0u, 0u}, {0u, 0u}}, mwn[2] = {{0u, 0u}, {0u, 0u}};
#define AT_LOAD(j) do { const size_t _kr = tok0 + 64 * (j) + sr; \
        kst = *(const u32x4*)(Kp + _kr * ldk + sc8 * 8); vst = *(const u32x4*)(Vp + _kr * ldv + sc8 * 8); \
        if (VAR == 1 && tid < 256) rst = *(const u32x4*)(Kp + (tok0 + 64 * (j) + rr) * ldk + 64 + rc4 * 8); \
        if (VAR == 0 && tid < 64) cst = p.cbF[((size_t)b * 4 + hx) * S + 64 * (j) + tid]; \
        if (VAR == 3) { _Pragma("unroll") for (int _q = 0; _q < 2; ++_q) mwn[_q] = *(const u32x2*)(p.mask + (tok0 + q0 + 16 * _q + i) * 64 + 2 * (j)); } } while (0)
#define AT_WRITE(buf) do { *(LAS3 u32x4*)(lds + AT_KB + (buf) * 8192 + kdst) = kst; *(LAS3 u32x4*)(lds + AT_VB + (buf) * 8192 + vdst) = vst; \
        if (VAR == 1 && tid < 256) *(LAS3 u32x4*)(lds + AT_KR + (buf) * 4096 + rdst) = rst; \
        if (VAR == 0 && tid < 64) *(LAS3 float*)(lds + AT_CB + (buf) * 256 + tid * 4) = cst; } while (0)
    AT_LOAD(j0);
    AT_WRITE(j0 & 1);
    if (VAR == 3) { mw[0] = mwn[0]; mw[1] = mwn[1]; }
    __syncthreads();
    const int swk = (i >> 1) & 7;
    for (int j = j0; j <= j1; ++j) {
        const int buf = j & 1;
        if (j < j1) AT_LOAD(j + 1);
        bool need = (64 * j <= q0 + 31);
        if (VAR == 2) need = need && (64 * j + 63 >= q0 - 127);
        if (need) {
            const LAS3 char* Kb = lds + AT_KB + buf * 8192; const LAS3 char* Vb = lds + AT_VB + buf * 8192;
            f32x4 s[2][4];
#pragma unroll
            for (int mt = 0; mt < 4; ++mt) {
                s[0][mt] = (f32x4){0.f, 0.f, 0.f, 0.f}; s[1][mt] = (f32x4){0.f, 0.f, 0.f, 0.f};
#pragma unroll
                for (int kc = 0; kc < 2; ++kc) {
                    const bf16x8 kf = *(const LAS3 bf16x8*)(Kb + (mt * 16 + i) * 128 + (((kc * 4 + g) ^ swk) << 4));
                    s[0][mt] = __builtin_amdgcn_mfma_f32_16x16x32_bf16(kf, qf[0][kc], s[0][mt], 0, 0, 0);
                    s[1][mt] = __builtin_amdgcn_mfma_f32_16x16x32_bf16(kf, qf[1][kc], s[1][mt], 0, 0, 0);
                }
                if (VAR == 1) {
                    const bf16x8 kf = *(const LAS3 bf16x8*)(lds + AT_KR + buf * 4096 + (mt * 16 + i) * 64 + ((g ^ (swk & 3)) << 4));
                    s[0][mt] = __builtin_amdgcn_mfma_f32_16x16x32_bf16(kf, qf[0][KC - 1], s[0][mt], 0, 0, 0);
                    s[1][mt] = __builtin_amdgcn_mfma_f32_16x16x32_bf16(kf, qf[1][KC - 1], s[1][mt], 0, 0, 0);
                }
            }
            bool full = (64 * j + 63 <= q0);
            if (VAR == 2) full = full && (64 * j >= q0 - 96);
            if (VAR == 3) full = false;
            bf16x8 pf[2][2];
#pragma unroll
            for (int qt = 0; qt < 2; ++qt) {
                const int t = q0 + 16 * qt + i;
                float x[4][4];
#pragma unroll
                for (int mt = 0; mt < 4; ++mt) {
                    f32x4 cb = {0.f, 0.f, 0.f, 0.f};
                    if (VAR == 0) cb = *(const LAS3 f32x4*)(lds + AT_CB + buf * 256 + (16 * mt + 4 * g) * 4);
#pragma unroll
                    for (int r = 0; r < 4; ++r) {
                        const int key = 64 * j + 16 * mt + 4 * g + r;
                        float v = s[qt][mt][r] * c1;
                        if (VAR == 0) v += cb[r];
                        if (VAR == 2) v += slope2 * (float)(key - t);
                        if (VAR == 3) v += slope2 * (float)key;
                        if (!full) {
                            bool ok;
                            if (VAR == 0 || VAR == 1) ok = key <= t;
                            else if (VAR == 2) ok = (key <= t) && (key > t - 128);
                            else { const int kk = 16 * mt + 4 * g + r; ok = (((kk < 32) ? (mw[qt].x >> kk) : (mw[qt].y >> (kk - 32))) & 1u) != 0u; }
                            v = ok ? v : NEGBIG;
                        }
                        x[mt][r] = v;
                    }
                }
                float mx = x[0][0];
#pragma unroll
                for (int mt = 0; mt < 4; ++mt)
#pragma unroll
                    for (int r = 0; r < 4; ++r) mx = fmaxf(mx, x[mt][r]);
                mx = fmaxf(mx, __shfl_xor(mx, 16)); mx = fmaxf(mx, __shfl_xor(mx, 32));
                const float mn = fmaxf(mrow[qt], mx), alpha = __builtin_amdgcn_exp2f(mrow[qt] - mn);
                mrow[qt] = mn;
                float ps = 0.f;
#pragma unroll
                for (int mt = 0; mt < 4; ++mt)
#pragma unroll
                    for (int r = 0; r < 4; ++r) { x[mt][r] = __builtin_amdgcn_exp2f(x[mt][r] - mn); ps += x[mt][r]; }
                lsum[qt] = lsum[qt] * alpha + ps;
#pragma unroll
                for (int dt = 0; dt < 4; ++dt) o[qt][dt] = o[qt][dt] * alpha;
#pragma unroll
                for (int c = 0; c < 2; ++c) {
                    u32x4 pk; pk.x = cvt_pk_bf16(x[2 * c][0], x[2 * c][1]); pk.y = cvt_pk_bf16(x[2 * c][2], x[2 * c][3]);
                    pk.z = cvt_pk_bf16(x[2 * c + 1][0], x[2 * c + 1][1]); pk.w = cvt_pk_bf16(x[2 * c + 1][2], x[2 * c + 1][3]);
                    pf[qt][c] = __builtin_bit_cast(bf16x8, pk);
                }
            }
            const int q4 = i >> 2, p4 = i & 3;
#pragma unroll
            for (int c = 0; c < 2; ++c) {
                const int row0 = 32 * c + 4 * g + q4, swv = (row0 >> 1) & 3;
#pragma unroll
                for (int dt = 0; dt < 4; ++dt) {
                    const LAS3 char* a0 = Vb + row0 * 128 + ((dt ^ swv) << 5) + p4 * 8;
                    const bf16x4 v0 = __builtin_amdgcn_ds_read_tr16_b64_v4i16((lds_bf16x4*)(a0));
                    const bf16x4 v1 = __builtin_amdgcn_ds_read_tr16_b64_v4i16((lds_bf16x4*)(a0 + 16 * 128));
                    const bf16x8 vf = {v0[0], v0[1], v0[2], v0[3], v1[0], v1[1], v1[2], v1[3]};
                    o[0][dt] = __builtin_amdgcn_mfma_f32_16x16x32_bf16(vf, pf[0][c], o[0][dt], 0, 0, 0);
                    o[1][dt] = __builtin_amdgcn_mfma_f32_16x16x32_bf16(vf, pf[1][c], o[1][dt], 0, 0, 0);
                }
            }
        }
        if (j < j1) { AT_WRITE(buf ^ 1); if (VAR == 3) { mw[0] = mwn[0]; mw[1] = mwn[1]; } }
        __syncthreads();
    }
#undef AT_LOAD
#undef AT_WRITE
#pragma unroll
    for (int qt = 0; qt < 2; ++qt) {
        float lt = lsum[qt]; lt += __shfl_xor(lt, 16); lt += __shfl_xor(lt, 32);
        if (VAR == 2) lt += __builtin_amdgcn_exp2f(p.sinks[l * 4 + hx * 2 + (w >> 2)] * LOG2E - mrow[qt]);
        const float inv = 1.f / lt;
        bf16_t* op = p.merged + (tok0 + q0 + 16 * qt + i) * D + ocol + 4 * g;
#pragma unroll
        for (int dt = 0; dt < 4; ++dt) { const f32x4 v = o[qt][dt] * inv; u32x2 w2; w2.x = cvt_pk_bf16(v[0], v[1]); w2.y = cvt_pk_bf16(v[2], v[3]); *(u32x2*)(op + 16 * dt) = w2; }
    }
}

__device__ __forceinline__ void phase_attn(const Params& p, int l, LAS3 char* lds) {
    const int tid = opaque_tid(p.wid);
    unsigned* qhead = p.ctl + CW_QA + 64 * (l + 2 * p.qslot);
    volatile LAS3 int* bc = (volatile LAS3 int*)(lds + AT_CTL);
    int nxt = 0;
    if (tid == 0) nxt = (int)__hip_atomic_fetch_add(qhead, 1u, __ATOMIC_RELAXED, __HIP_MEMORY_SCOPE_AGENT);
    for (;;) {
        if (tid == 0) *bc = nxt;
        __syncthreads();
        const int idx = __builtin_amdgcn_readfirstlane(*bc);
        __syncthreads();
        if (idx >= 4096) break;
        if (tid == 0) nxt = (int)__hip_atomic_fetch_add(qhead, 1u, __ATOMIC_RELAXED, __HIP_MEMORY_SCOPE_AGENT);
#ifndef ATTN_VMASK
#define ATTN_VMASK 15
#endif
        if (idx < 3072) {
            const int lvl = 7 - idx / 384, rem = idx % 384;
            if (rem < 128) { if (ATTN_VMASK & 2) attn_unit<1>(p, l, rem >> 2, rem & 3, lvl, lds); }
            else if (rem < 256) { if (ATTN_VMASK & 1) attn_unit<0>(p, l, (rem - 128) >> 2, rem & 3, lvl, lds); }
            else { const int d = rem - 256; if (ATTN_VMASK & 8) attn_unit<3>(p, l, d & 31, 0, 4 * lvl + 3 - (d >> 5), lds); }
        } else { const int c = idx - 3072; if (ATTN_VMASK & 4) attn_unit<2>(p, l, c >> 5, (c >> 4) & 1, c & 15, lds); }
    }
}
}

namespace {
constexpr int DS_LD = 2052;
constexpr int DS_CTL = 16 * DS_LD * 4;
constexpr int DS_LDS = DS_CTL + 64;

__device__ __forceinline__ void dsa_unit(const Params& p, int u, LAS3 char* lds) {
    const int tid = opaque_tid(p.wid), w = __builtin_amdgcn_readfirstlane(tid >> 6), lane = tid & 63, i = lane & 15, g = lane >> 4;
    const int b = u >> 7, t0 = (u & 127) * 16;
    const size_t tok0 = (size_t)b * S;
    uint32_t* mbase = p.mask + (tok0 + t0) * 64;
    if (t0 + 16 <= 256) {
#pragma unroll
        for (int qq = 0; qq < 2; ++qq) {
            const int q = 2 * w + qq, n = t0 + q + 1;
            if (lane < 32) { const int lo = lane * 64; unsigned long long bits = (n >= lo + 64) ? ~0ull : (n <= lo ? 0ull : ((1ull << (n - lo)) - 1ull));
                u32x2 o; o.x = (unsigned)bits; o.y = (unsigned)(bits >> 32); *(u32x2*)(mbase + q * 64 + 2 * lane) = o; }
        }
        return;
    }
    const int nreg = (t0 + 16 + 63) >> 6;
    const int ntile = nreg * 4;
    bf16x8 qf[8]; float wq[8];
    {
        const bf16_t* qrow = p.proj + (tok0 + t0 + i) * NP;
#pragma unroll
        for (int h = 0; h < 8; ++h) qf[h] = *(const bf16x8*)(qrow + PC_DQI + h * 32 + 8 * g);
        const u32x4 ww = *(const u32x4*)(qrow + PC_DWI);
        const float sc = 0.35355339059327373f * 0.17677669529663687f;
        wq[0] = bflo(ww.x) * sc; wq[1] = bfhi(ww.x) * sc; wq[2] = bflo(ww.y) * sc; wq[3] = bfhi(ww.y) * sc;
        wq[4] = bflo(ww.z) * sc; wq[5] = bfhi(ww.z) * sc; wq[6] = bflo(ww.w) * sc; wq[7] = bfhi(ww.w) * sc;
    }
    const int tq = t0 + i;
    for (int base = w; base < ntile; base += 32) {
        bf16x8 kf4[4];
#pragma unroll
        for (int uu = 0; uu < 4; ++uu) { const int kt = base + 8 * uu; if (kt < ntile) kf4[uu] = *(const bf16x8*)(p.proj + (tok0 + 16 * kt + i) * NP + PC_DKI + 8 * g); }
#pragma unroll
        for (int uu = 0; uu < 4; ++uu) {
            const int kt = base + 8 * uu;
            if (kt < ntile) {
                f32x4 sc4 = {0.f, 0.f, 0.f, 0.f};
#pragma unroll
                for (int h = 0; h < 8; ++h) {
                    const f32x4 c = __builtin_amdgcn_mfma_f32_16x16x32_bf16(kf4[uu], qf[h], (f32x4){0.f, 0.f, 0.f, 0.f}, 0, 0, 0);
#pragma unroll
                    for (int r = 0; r < 4; ++r) sc4[r] += wq[h] * fmaxf(c[r], 0.f);
                }
                u32x4 ko;
#pragma unroll
                for (int r = 0; r < 4; ++r) {
                    const int key = 16 * kt + 4 * g + r;
                    unsigned uu2 = __float_as_uint(sc4[r]); if (uu2 == 0x80000000u) uu2 = 0u;
                    uu2 = (uu2 & 0x80000000u) ? ~uu2 : (uu2 | 0x80000000u);
                    ko[r] = (key <= tq) ? uu2 : 0u;
                }
                *(LAS3 u32x4*)(lds + ((size_t)i * DS_LD + 16 * kt + 4 * g) * 4) = ko;
            }
        }
    }
    __syncthreads();
    {
        const int qA = 2 * w, qB = 2 * w + 1, nA = t0 + qA + 1, nB = t0 + qB + 1;
        const LAS3 unsigned* kpA = (const LAS3 unsigned*)(lds + (size_t)qA * DS_LD * 4);
        const LAS3 unsigned* kpB = (const LAS3 unsigned*)(lds + (size_t)qB * DS_LD * 4);
        unsigned keyA[32], keyB[32];
        const int nv = nreg * 64;
#pragma unroll
        for (int r = 0; r < 32; ++r) {
            int idx = r * 64 + lane; asm volatile("" : "+v"(idx));
            const unsigned va = kpA[r * 64 + lane], vb = kpB[r * 64 + lane];
            keyA[r] = (idx < nv) ? va : 0u; keyB[r] = (idx < nv) ? vb : 0u;
        }
        unsigned thrA = (nA <= 256) ? 1u : 0u, thrB = (nB <= 256) ? 1u : 0u;
        bool exA = (nA <= 256), exB = (nB <= 256);
        for (int bit = 31; bit >= 0; --bit) {
            if (exA && exB) break;
            const unsigned cA = exA ? 0xFFFFFFFFu : (thrA | (1u << bit)), cB = exB ? 0xFFFFFFFFu : (thrB | (1u << bit));
            int na = 0, nb = 0;
#pragma unroll
            for (int r = 0; r < 32; ++r) { na += (keyA[r] >= cA) ? 1 : 0; nb += (keyB[r] >= cB) ? 1 : 0; }
            na = wave_reduce_add(na); nb = wave_reduce_add(nb);
            if (!exA && na >= 256) { thrA = cA; exA = (na == 256); }
            if (!exB && nb >= 256) { thrB = cB; exB = (nb == 256); }
        }
#pragma unroll 1
        for (int qq = 0; qq < 2; ++qq) {
            const unsigned thr = qq ? thrB : thrA; const bool exact = qq ? exB : exA;
            unsigned long long mine = 0ull;
            int need = 0, running = 0;
            if (!exact) { int ngt = 0;
#pragma unroll
                for (int r = 0; r < 32; ++r) ngt += ((qq ? keyB[r] : keyA[r]) > thr) ? 1 : 0;
                need = 256 - wave_reduce_add(ngt); }
            const unsigned long long lt = (lane == 0) ? 0ull : (~0ull >> (64 - lane));
#pragma unroll
            for (int r = 0; r < 32; ++r) {
                const unsigned key = qq ? keyB[r] : keyA[r];
                unsigned long long bs;
                if (exact) bs = __ballot(key >= thr);
                else {
                    const bool eq = key == thr;
                    const unsigned long long be = __ballot(eq);
                    const int rank = running + __popcll(be & lt);
                    bs = __ballot((key > thr) || (eq && rank < need));
                    running += __popcll(be);
                }
                { int ln = lane; asm volatile("" : "+v"(ln)); if (ln == r) mine = bs; }
            }
            if (lane < 32) { u32x2 o; o.x = (unsigned)mine; o.y = (unsigned)(mine >> 32); *(u32x2*)(mbase + (2 * w + qq) * 64 + 2 * lane) = o; }
        }
    }
    __syncthreads();
}

__device__ __forceinline__ void phase_dsa(const Params& p, int l, LAS3 char* lds) {
    const int tid = opaque_tid(p.wid);
    unsigned* qhead = p.ctl + CW_QD + 64 * (l + 2 * p.qslot);
    volatile LAS3 int* bc = (volatile LAS3 int*)(lds + DS_CTL);
    int nxt = 0;
    if (tid == 0) nxt = (int)__hip_atomic_fetch_add(qhead, 1u, __ATOMIC_RELAXED, __HIP_MEMORY_SCOPE_AGENT);
    for (;;) {
        if (tid == 0) *bc = nxt;
        __syncthreads();
        const int idx = __builtin_amdgcn_readfirstlane(*bc);
        __syncthreads();
        if (idx >= 4096) break;
        if (tid == 0) nxt = (int)__hip_atomic_fetch_add(qhead, 1u, __ATOMIC_RELAXED, __HIP_MEMORY_SCOPE_AGENT);
        const int pb = 127 - (idx >> 5), b = idx & 31;
        dsa_unit(p, b * 128 + pb, lds);
    }
}
}

namespace {
constexpr int LDS_BYTES = 147456;
constexpr int NTHREADS = 512;

template <int PH>
__device__ __forceinline__ void run_phase(const Params& p, int l, unsigned char* smem) {
    LAS3 char* lds = (LAS3 char*)smem;
    PG8_LAS unsigned char* glds = (PG8_LAS unsigned char*)smem;
    const int G = gridDim.x, c = blockIdx.x;
    if constexpr (PH == 0) phase_p0(p, (char*)smem);
    if constexpr (PH == 1) { if (l == 0) phase_norm1<0>(p, 0); else phase_norm1<1>(p, l); }
    if constexpr (PH == 2) { pg8::Gemm g{p.h, p.WinT + (size_t)l * NP * D, D, D, 0}; pg8::StaticOrder S; S.init(T, NP, G, c);
        EpiStoreBf16 E{p.proj, NP}; pg8::gemm_phase<EpiStoreBf16, pg8::StaticOrder, false>(glds, g, S, E, p.wid); }
    if constexpr (PH == 3) phase_prep(p, l);
    if constexpr (PH == 4) { pg8::Gemm g{p.proj + PC_BCQ, p.WqT + (size_t)l * 512 * 256, 256, NP, 0}; pg8::StaticOrder S; S.init(T, 512, G, c);
          EpiMlaQ E{p.qm}; pg8::gemm_phase<EpiMlaQ, pg8::StaticOrder, false>(glds, g, S, E, p.wid); }
    if constexpr (PH == 12) { pg8::Gemm g{p.proj + PC_BCKV, p.WkvT + (size_t)l * 512 * 128, 128, NP, 0}; pg8::StaticOrder S; S.init(T, 512, G, c);
          EpiMlaKV E{p.km, p.vm}; pg8::gemm_phase<EpiMlaKV, pg8::StaticOrder, false>(glds, g, S, E, p.wid); }
    if constexpr (PH == 13) phase_dsa(p, l, lds);
    if constexpr (PH == 5) phase_attn(p, l, lds);
    if constexpr (PH == 6) { pg8::Gemm g{p.merged, p.WoutT + (size_t)l * D * D, D, D, 0}; pg8::StaticOrder S; S.init(T, D, G, c);
        EpiResidual E{p.xo, p.mod + (size_t)l * NB * NMOD + 2 * 1024}; pg8::gemm_phase<EpiResidual, pg8::StaticOrder, false>(glds, g, S, E, p.wid); }
    if constexpr (PH == 7) phase_route(p, l, (char*)smem);
    if constexpr (PH == 8) { const int* cnt = (const int*)(p.ctl + CW_CNT) + l * 16;
        pg8::Gemm g{p.h, p.WguT + (size_t)l * 16 * 512 * 1024, 1024, D, (size_t)512 * 1024}; MoeOrder S; S.init(cnt, p.list, 2, G, c);
        EpiGateUp E{p.hid}; pg8::gemm_phase<EpiGateUp, MoeOrder, true>(glds, g, S, E, p.wid); }
    if constexpr (PH == 9) { const int* cnt = (const int*)(p.ctl + CW_CNT) + l * 16;
        pg8::Gemm g{p.hid, p.WdT + (size_t)l * 16 * 1024 * 256, 256, 256, (size_t)1024 * 256}; MoeOrder S; S.init(cnt, p.list, 4, G, c);
        EpiDown E{p.ys, p.list, p.rw, cnt}; pg8::gemm_phase<EpiDown, MoeOrder, false>(glds, g, S, E, p.wid); }
    if constexpr (PH == 10) phase_norm1<2>(p, 1);
    if constexpr (PH == 11) phase_norm1<0>(p, l);
}
template <int PH>
__global__ void __launch_bounds__(NTHREADS, 2) k_ph(Params p, int l) {
    extern __shared__ __attribute__((aligned(16))) unsigned char smem[];
    p.wid = __builtin_amdgcn_readfirstlane(threadIdx.x >> 6); p.qslot = 0;
    run_phase<PH>(p, l, smem);
}
}


namespace {
#ifndef REP_PH
#define REP_PH -1
#endif
#define REP(X, l) do { if (REP_PH == X) { xcd_barrier(bar); phase<X>(l, smem, wid, 1); } } while (0)
struct KArgs { const float* in[20]; float* xo; char* ws; };
constexpr size_t al256(size_t b) { return (b + 255) & ~(size_t)255; }
constexpr size_t WS_CTL = 0;
constexpr size_t WS_MOD = WS_CTL + al256((size_t)CW_WORDS * 4);
constexpr size_t WS_WIN = WS_MOD + al256((size_t)2 * NB * NMOD * 4);
constexpr size_t WS_WOUT = WS_WIN + al256((size_t)2 * NP * D * 2);
constexpr size_t WS_WQ = WS_WOUT + al256((size_t)2 * D * D * 2);
constexpr size_t WS_WKV = WS_WQ + al256((size_t)2 * 512 * 256 * 2);
constexpr size_t WS_WGU = WS_WKV + al256((size_t)2 * 512 * 128 * 2);
constexpr size_t WS_WD = WS_WGU + al256((size_t)2 * 16 * 512 * 1024 * 2);
constexpr size_t WS_ROPE = WS_WD + al256((size_t)2 * 16 * 1024 * 256 * 2);
constexpr size_t WS_RQ = WS_ROPE + al256((size_t)2048 * 16 * 2 * 4);
constexpr size_t WS_RKV = WS_RQ + al256((size_t)T * 4);
constexpr size_t WS_CBF = WS_RKV + al256((size_t)T * 4);
constexpr size_t WS_MASK = WS_CBF + al256((size_t)NB * 4 * S * 4);
constexpr size_t WS_LIST = WS_MASK + al256((size_t)T * 64 * 4);
constexpr size_t WS_RW = WS_LIST + al256((size_t)2 * 16 * ECAP * 4);
constexpr size_t WS_H = WS_RW + al256((size_t)T * 2 * 4);
constexpr size_t WS_PROJ = WS_H + al256((size_t)T * D * 2);
constexpr size_t WS_QM = WS_PROJ + al256((size_t)T * NP * 2);
constexpr size_t WS_KM = WS_QM + al256((size_t)T * 384 * 2);
constexpr size_t WS_VM = WS_KM + al256((size_t)T * 384 * 2);
constexpr size_t WS_MERGED = WS_VM + al256((size_t)T * 256 * 2);
constexpr size_t WS_END1 = WS_MERGED + al256((size_t)T * D * 2);
constexpr size_t WS_HID = WS_PROJ;
constexpr size_t WS_YS = WS_HID + al256((size_t)HIDROWS * 256 * 2);
constexpr size_t WS_END2 = WS_YS + al256((size_t)T * 2 * D * 2);
constexpr size_t WS_NEED = WS_END1 > WS_END2 ? WS_END1 : WS_END2;
static_assert(WS_END2 <= WS_MERGED, "MoE overlay must not reach the merged buffer");

__device__ __forceinline__ Params make_params(const KArgs& a) {
    Params p;
    p.x = a.in[0]; p.c = a.in[1]; p.w_ada = a.in[2]; p.b_ada = a.in[3]; p.g_norm1 = a.in[4]; p.w_in = a.in[5]; p.b_forget = a.in[6]; p.g_q_mla = a.in[7];
    p.w_q_up = a.in[8]; p.g_kv_mla = a.in[9]; p.w_kv_up = a.in[10]; p.sinks = a.in[11]; p.w_out = a.in[12]; p.g_norm2 = a.in[13]; p.w_router = a.in[14];
    p.b_router = a.in[15]; p.w_gate = a.in[16]; p.w_up = a.in[17]; p.w_down = a.in[18]; p.g_final = a.in[19];
    p.xo = a.xo; char* ws = a.ws;
    p.ctl = (unsigned*)(ws + WS_CTL); p.mod = (float*)(ws + WS_MOD); p.WinT = (bf16_t*)(ws + WS_WIN); p.WoutT = (bf16_t*)(ws + WS_WOUT);
    p.WqT = (bf16_t*)(ws + WS_WQ); p.WkvT = (bf16_t*)(ws + WS_WKV); p.WguT = (bf16_t*)(ws + WS_WGU); p.WdT = (bf16_t*)(ws + WS_WD);
    p.ropetab = (float*)(ws + WS_ROPE); p.rq = (float*)(ws + WS_RQ); p.rkv = (float*)(ws + WS_RKV); p.cbF = (float*)(ws + WS_CBF);
    p.mask = (uint32_t*)(ws + WS_MASK); p.list = (int*)(ws + WS_LIST); p.rw = (float*)(ws + WS_RW); p.h = (bf16_t*)(ws + WS_H);
    p.proj = (bf16_t*)(ws + WS_PROJ); p.qm = (bf16_t*)(ws + WS_QM); p.km = (bf16_t*)(ws + WS_KM); p.vm = (bf16_t*)(ws + WS_VM);
    p.merged = (bf16_t*)(ws + WS_MERGED); p.hid = (bf16_t*)(ws + WS_HID); p.ys = (bf16_t*)(ws + WS_YS);
    return p;
}
template <int PH>
__device__ __forceinline__ void phase(int l, unsigned char* smem, int wid, int qslot = 0) {
    typedef const __attribute__((address_space(4))) KArgs* KA4;
    KA4 ka = (KA4)__builtin_amdgcn_kernarg_segment_ptr();
    asm volatile("" : "+s"(ka));
    KArgs a;
#pragma unroll
    for (int i = 0; i < 20; ++i) a.in[i] = ka->in[i];
    a.xo = ka->xo; a.ws = ka->ws;
    Params p = make_params(a); p.wid = wid; p.qslot = qslot;
    run_phase<PH>(p, l, smem);
}
__global__ void __launch_bounds__(NTHREADS, 2) fwd(KArgs args) {
    extern __shared__ __attribute__((aligned(16))) unsigned char smem[];
    volatile LAS unsigned* st = (volatile LAS unsigned*)(smem + LDS_BYTES - 16);
    const int wid = __builtin_amdgcn_readfirstlane(threadIdx.x >> 6);
    if (xb_leader(wid)) { st[0] = 0u; st[1] = 0u; st[2] = 0u; st[3] = 0u; }
    __syncthreads();
    XcdBarrier bar = xcd_barrier_post((unsigned*)(args.ws + WS_CTL) + CW_BAR, st, wid);
    phase<0>(0, smem, wid);  REP(0, 0);
    xcd_barrier(bar);
#define LAYER(l) do { \
        phase<1>(l, smem, wid);  if (l == 0) REP(1, l); xcd_barrier(bar); \
        phase<2>(l, smem, wid);  REP(2, l); xcd_barrier(bar); \
        phase<3>(l, smem, wid);  REP(3, l); xcd_barrier(bar); \
        phase<4>(l, smem, wid);  REP(4, l); phase<12>(l, smem, wid);  REP(12, l); phase<13>(l, smem, wid);  REP(13, l); xcd_barrier(bar); \
        phase<5>(l, smem, wid);  REP(5, l); xcd_barrier(bar); \
        phase<6>(l, smem, wid);  xcd_barrier(bar); \
        phase<7>(l, smem, wid);  REP(7, l); xcd_barrier(bar); \
        phase<8>(l, smem, wid);  REP(8, l); xcd_barrier(bar); \
        phase<9>(l, smem, wid);  REP(9, l); xcd_barrier(bar); } while (0)
    LAYER(0);
    LAYER(1);
    phase<10>(1, smem, wid);
}
}

extern "C" void kernel_launch(void* const* d_in, const int* in_sizes, int n_in, void* d_out, int out_size, void* d_ws, size_t ws_size,
                              hipStream_t stream) {
    KArgs a{};
    for (int i = 0; i < 20; ++i) a.in[i] = (const float*)d_in[i];
    a.xo = (float*)d_out; a.ws = (char*)d_ws;
    if (WS_NEED > ws_size) return;

    static int grid = 0;
    if (!grid) {
        int dev = 0, cus = 0, per_cu = 0;
        (void)hipGetDevice(&dev);
        (void)hipDeviceGetAttribute(&cus, hipDeviceAttributeMultiprocessorCount, dev);
        (void)hipFuncSetAttribute((const void*)fwd, hipFuncAttributeMaxDynamicSharedMemorySize, LDS_BYTES);
        (void)hipOccupancyMaxActiveBlocksPerMultiprocessor(&per_cu, (const void*)fwd, NTHREADS, LDS_BYTES);
        grid = cus > 0 ? cus : 256;
    }
    (void)hipMemsetAsync(a.ws + WS_CTL, 0, (size_t)CW_WORDS * 4, stream);
    fwd<<<dim3(grid), dim3(NTHREADS), LDS_BYTES, stream>>>(a);
}
```

```cpp
#include <hip/hip_runtime.h>
#include <stdint.h>
#define XB_TMO      128
#define XB_XCNT(j)  (256  + 64 * (j))
#define XB_XSUB(j)  (1280 + 64 * (j))
#define XB_XGEN(j)  (2304 + 64 * (j))
#define XB_TOP      3328
#define XB_TOPGEN   3392
#define XCD_BAR_WORDS 3456
#define XB_SPIN_CAP (1u << 20)
#define LAS __attribute__((address_space(3)))

__device__ __forceinline__ unsigned xb_ld(unsigned* p)              { return __hip_atomic_load(p, __ATOMIC_RELAXED, __HIP_MEMORY_SCOPE_AGENT); }
__device__ __forceinline__ unsigned xb_add(unsigned* p, unsigned v) { return __hip_atomic_fetch_add(p, v, __ATOMIC_RELAXED, __HIP_MEMORY_SCOPE_AGENT); }
__device__ __forceinline__ unsigned xb_xcc_id() { return (unsigned)__builtin_amdgcn_s_getreg((3 << 11) | 20) & 0xFu; }
#define XB_SPIN(cond, bar) do { unsigned _sp = 0; while (cond) { __builtin_amdgcn_s_sleep(1); \
    if ((++_sp & 255u) == 0u) { if (xb_ld(&(bar)[XB_TMO])) break; if (_sp > XB_SPIN_CAP) { atomicAdd(&(bar)[XB_TMO], 1u); break; } } } } while (0)

struct XcdBarrier { unsigned* bar; unsigned x; volatile LAS unsigned* st; int wid; };
__device__ __forceinline__ bool xb_leader(int wid) { return wid == 0 && __builtin_amdgcn_mbcnt_hi(~0u, __builtin_amdgcn_mbcnt_lo(~0u, 0u)) == 0u; }

__device__ __forceinline__ XcdBarrier xcd_barrier_post(unsigned* bar, volatile LAS unsigned* st, int wid) {
    XcdBarrier b; b.bar = bar; b.x = xb_xcc_id(); b.st = st; b.wid = wid;
    if (xb_leader(wid)) (void)xb_add(&bar[XB_XCNT(b.x)], 1u);
    return b;
}
__device__ __forceinline__ void xcd_barrier_complete(unsigned* bar, unsigned x, unsigned& nloc, unsigned& nx) {
    const unsigned G = gridDim.x * gridDim.y * gridDim.z;
    unsigned sum, cnt, mine, sp = 0u;
    for (;;) {
        sum = 0u; cnt = 0u; mine = 0u;
#pragma unroll
        for (unsigned j = 0; j < 16; ++j) { const unsigned c = xb_ld(&bar[XB_XCNT(j)]); sum += c; cnt += (c > 0u) ? 1u : 0u; mine = (j == x) ? c : mine; }
        if (sum == G) break;
        __builtin_amdgcn_s_sleep(1);
        if ((++sp & 255u) == 0u) { if (xb_ld(&bar[XB_TMO])) break; if (sp > XB_SPIN_CAP) { atomicAdd(&bar[XB_TMO], 1u); break; } }
    }
    nloc = mine > 0u ? mine : 1u; nx = cnt > 0u ? cnt : 1u;
}
__device__ __forceinline__ void xcd_barrier(const XcdBarrier& b) {
    asm volatile("s_waitcnt vmcnt(0)" ::: "memory");
    __syncthreads();
    if (xb_leader(b.wid)) {
        unsigned* bar = b.bar;
        __builtin_amdgcn_s_waitcnt(0);
        unsigned nloc = b.st[0], nx = b.st[1];
        if (nloc == 0u) { xcd_barrier_complete(bar, b.x, nloc, nx); b.st[0] = nloc; b.st[1] = nx; }
        const unsigned old = xb_add(&bar[XB_XSUB(b.x)], 1u);
        const unsigned gen = old / nloc;
        if (old + 1u == (gen + 1u) * nloc) {
            __builtin_amdgcn_fence(__ATOMIC_RELEASE, "agent");
            asm volatile("s_waitcnt vmcnt(0)" ::: "memory");
            const unsigned og = xb_add(&bar[XB_TOP], 1u);
            const unsigned tg = og / nx;
            if (og + 1u == (tg + 1u) * nx) xb_add(&bar[XB_TOPGEN], 1u);
            else XB_SPIN(xb_ld(&bar[XB_TOPGEN]) == tg, bar);
            __builtin_amdgcn_fence(__ATOMIC_ACQUIRE, "agent");
            xb_add(&bar[XB_XGEN(b.x)], 1u);
            asm volatile("s_waitcnt vmcnt(0)" ::: "memory");
        } else {
            XB_SPIN(xb_ld(&bar[XB_XGEN(b.x)]) == gen, bar);
            __builtin_amdgcn_fence(__ATOMIC_ACQUIRE, "agent");
            asm volatile("s_waitcnt vmcnt(0)" ::: "memory");
        }
    }
    __syncthreads();
}

#define LAS3 __attribute__((address_space(3)))
namespace {
typedef unsigned short bf16_t;
typedef short bf16x8 __attribute__((ext_vector_type(8)));
typedef short bf16x4 __attribute__((ext_vector_type(4)));
typedef float f32x4 __attribute__((ext_vector_type(4)));
typedef float f32x2 __attribute__((ext_vector_type(2)));
typedef unsigned u32x4 __attribute__((ext_vector_type(4)));
typedef unsigned u32x2 __attribute__((ext_vector_type(2)));

constexpr int D = 1024, NB = 32, S = 2048, T = NB * S, NIN = 2380, NP = 2560, NMOD = 6144;
constexpr int OFF_AQ = 0, OFF_AK = 256, OFF_AV = 512, OFF_AF = 768, OFF_BCQ = 772, OFF_BCKV = 1028, OFF_BKR = 1156,
              OFF_CQ = 1188, OFF_CK = 1444, OFF_CV = 1572, OFF_DQ = 1700, OFF_DK = 1956, OFF_DV = 2020,
              OFF_DQI = 2084, OFF_DKI = 2340, OFF_DWI = 2372;
constexpr int PC_AQ = 0, PC_AK = 256, PC_AV = 512, PC_BCQ = 768, PC_BCKV = 1024, PC_BKR = 1152, PC_CQ = 1184, PC_CK = 1440, PC_CV = 1568,
              PC_DQ = 1696, PC_DK = 1952, PC_DV = 2016, PC_DQI = 2080, PC_DKI = 2336, PC_DWI = 2368, PC_AF = 2376;
constexpr float EPS = 1e-6f;
constexpr float LOG2E = 1.4426950408889634f;
constexpr int ECAP = T;
constexpr int HIDROWS = 2 * T + 16 * 256;

__host__ __device__ __forceinline__ int orig_col(int n) { return n < 768 ? n : (n < 2376 ? n + 4 : (n < 2380 ? n - 1608 : -1)); }
__device__ __forceinline__ int opaque_tid(int wid) {
    int t = wid * 64 + (int)__builtin_amdgcn_mbcnt_hi(~0u, __builtin_amdgcn_mbcnt_lo(~0u, 0u));
    asm volatile("" : "+v"(t)); return t; }
__device__ __forceinline__ float bf2f(bf16_t v) { return __uint_as_float((unsigned)v << 16); }
__device__ __forceinline__ bf16_t f2bf(float f) { unsigned u = __float_as_uint(f); u += 0x7FFFu + ((u >> 16) & 1u); return (bf16_t)(u >> 16); }
typedef __bf16 bf16x2_native __attribute__((ext_vector_type(2)));
__device__ __forceinline__ unsigned cvt_pk_bf16(float lo, float hi) { const f32x2 v = {lo, hi}; return __builtin_bit_cast(unsigned, __builtin_convertvector(v, bf16x2_native)); }
__device__ __forceinline__ float bflo(unsigned w) { return __uint_as_float(w << 16); }
__device__ __forceinline__ float bfhi(unsigned w) { return __uint_as_float(w & 0xFFFF0000u); }
__device__ __forceinline__ float wave_sum(float v) {
#pragma unroll
    for (int o = 32; o > 0; o >>= 1) v += __shfl_xor(v, o);
    return v;
}
__device__ __forceinline__ float xor32_max(float x) {
    float a = x, b = x;
    asm volatile("s_nop 1\n\tv_permlane32_swap_b32 %0, %1\n\ts_nop 1" : "+v"(a), "+v"(b));
    return fmaxf(a, b);
}
__device__ __forceinline__ int wave_reduce_add(int v) {
    v += __builtin_amdgcn_update_dpp(0, v, 0xB1, 0xF, 0xF, true);
    v += __builtin_amdgcn_update_dpp(0, v, 0x4E, 0xF, 0xF, true);
    v += __builtin_amdgcn_update_dpp(0, v, 0x141, 0xF, 0xF, true);
    v += __builtin_amdgcn_update_dpp(0, v, 0x140, 0xF, 0xF, true);
    return __builtin_amdgcn_readlane(v, 0) + __builtin_amdgcn_readlane(v, 16) + __builtin_amdgcn_readlane(v, 32) + __builtin_amdgcn_readlane(v, 48);
}
}

namespace pg8 {
#define PG8_LAS __attribute__((address_space(3)))
constexpr int BM = 256, BK = 64, HALF = 128, HTB = HALF * BK * 2, STAGE_BYTES = 8 * HTB, NXCD = 8, WGM = 8;

__host__ __device__ __forceinline__ int lds_byte(int r, int c) { const int st = (r >> 4) * 2 + (c >> 5), rr = r & 15, cc = c & 31, ob = rr * 64 + cc * 2; return st * 1024 + (ob ^ (((ob >> 9) & 1) << 5)); }
__host__ __device__ __forceinline__ void stage_rc(int b, int& R, int& C) { const int st = b / 1024, sb = b % 1024, swz = sb ^ (((sb >> 9) & 1) << 5); R = (st >> 1) * 16 + swz / 64; C = (st & 1) * 32 + (swz % 64) / 2; }
__host__ __device__ __forceinline__ int perm32(int rho) { const int n = rho >> 4, i = rho & 15; return 8 * (i >> 2) + 4 * n + (i & 3); }

struct Unit { int pm, pn, e, mt; };
struct Gemm { const bf16_t* A; const bf16_t* Bt; int K; int lda; size_t bstride; };

struct StaticOrder {
    int nM, nN, nwg, G, c;
    __host__ __device__ void init(int M, int N, int G_, int c_) { nM = M / BM; nN = N / BM; nwg = nM * nN; G = G_; c = c_; }
    __host__ __device__ bool next(int i, Unit& u) const {
        const long L = (long)i * G + c; if (L >= nwg) return false;
        int wgid = (int)L; { const int q = nwg / NXCD, r = nwg % NXCD, xcd = wgid % NXCD, off = wgid / NXCD; wgid = (xcd < r ? xcd * (q + 1) : r * (q + 1) + (xcd - r) * q) + off; }
        const int nig = WGM * nN, gid = wgid / nig, fm = gid * WGM, gsz = (nM - fm) < WGM ? (nM - fm) : WGM;
        u.pm = fm + ((wgid % nig) % gsz); u.pn = (wgid % nig) / gsz; u.e = 0; u.mt = 0; return true;
    }
    __device__ __forceinline__ int arow(const Unit& u, int r) const { return u.pm * BM + r; }
};

template <class Epi, class Sched, bool GATHER>
__device__ __forceinline__ void gemm_phase(PG8_LAS unsigned char* lds, const Gemm g, const Sched& S, const Epi& E, int wave_index) {
    const int tid = opaque_tid(wave_index), wid = __builtin_amdgcn_readfirstlane(tid >> 6), lane = tid & 63, wr = wid >> 2, wc = wid & 3, fr = lane & 15, fq = lane >> 4;
    int K_ = g.K; asm volatile("" : "+s"(K_));
    const int K = K_, nt = K / BK, lda = g.lda;
    int Ra[2], Ca[2]; unsigned voffB[2], voffA[2];
#pragma unroll
    for (int i = 0; i < 2; ++i) { int R, C; stage_rc(tid * 16 + i * 8192, R, C); const int Rb = Epi::PERM ? ((R & ~31) + perm32(R & 31)) : R;
        Ra[i] = R; Ca[i] = C; voffB[i] = (unsigned)(Rb * K + C) * 2u; voffA[i] = (unsigned)(R * lda + C) * 2u; }
    const size_t kstep = (size_t)(BK * 2);
    const size_t hstepB = (size_t)HALF * K * 2;
    const size_t tstepB = 2 * hstepB;
    const size_t hstepA = (size_t)HALF * lda * 2, tstepA = 2 * hstepA;
    const unsigned ldsw = (unsigned)wid * 1024u;
    const int aoff = lds_byte(wr * 64 + fr, fq * 8), boff = lds_byte(wc * 32 + fr, fq * 8);
#define PG8_SA(b, h) (((b) * 2 + (h)) * HTB)
#define PG8_SB(b, h) ((4 + (b) * 2 + (h)) * HTB)
#define PG8_STAGE(bufoff, gbase, voff) do { _Pragma("unroll") for (int _i = 0; _i < 2; ++_i) \
        __builtin_amdgcn_global_load_lds((const unsigned*)((const char*)(gbase) + (voff)[_i]), (PG8_LAS unsigned*)(lds + (bufoff) + ldsw + _i * 8192), 16, 0, 0); } while (0)
#define PG8_STAGEA(bufoff, kptr, VO, h) do { _Pragma("unroll") for (int _i = 0; _i < 2; ++_i) { \
        const char* _src; if constexpr (GATHER) _src = (const char*)(kptr) + (VO)[_i][h]; else _src = (const char*)(kptr) + (size_t)(h) * hstepA + voffA[_i]; \
        __builtin_amdgcn_global_load_lds((const unsigned*)_src, (PG8_LAS unsigned*)(lds + (bufoff) + ldsw + _i * 8192), 16, 0, 0); } } while (0)
#define PG8_LDA(dst, b, h) do { _Pragma("unroll") for (int m = 0; m < 4; ++m) _Pragma("unroll") for (int k = 0; k < 2; ++k) dst[m][k] = *(const PG8_LAS bf16x8*)(lds + PG8_SA(b, h) + aoff + m * 2048 + k * 1024); } while (0)
#define PG8_LDB(dst, b, h) do { _Pragma("unroll") for (int n = 0; n < 2; ++n) _Pragma("unroll") for (int k = 0; k < 2; ++k) dst[n][k] = *(const PG8_LAS bf16x8*)(lds + PG8_SB(b, h) + boff + n * 2048 + k * 1024); } while (0)
#define PG8_MMA(ai, bj, At, Bt) do { __builtin_amdgcn_s_setprio(1); _Pragma("unroll") for (int m = 0; m < 4; ++m) _Pragma("unroll") for (int n = 0; n < 2; ++n) _Pragma("unroll") for (int k = 0; k < 2; ++k) \
        acc[ai][bj][m][n] = __builtin_amdgcn_mfma_f32_16x16x32_bf16(Bt[n][k], At[m][k], acc[ai][bj][m][n], 0, 0, 0); __builtin_amdgcn_s_setprio(0); } while (0)
#define PG8_WAIT_V(n) asm volatile("s_waitcnt vmcnt(" #n ")" ::: "memory")
#define PG8_WAIT_L(n) asm volatile("s_waitcnt lgkmcnt(" #n ")" ::: "memory")
#define PG8_BAR __builtin_amdgcn_s_barrier()
#define PG8_SCHED __builtin_amdgcn_sched_barrier(0)
#define PG8_SETV(V, u) do { _Pragma("unroll") for (int _i = 0; _i < 2; ++_i) _Pragma("unroll") for (int _h = 0; _h < 2; ++_h) { \
        const int _row = GATHER ? S.arow(u, _h * HALF + Ra[_i]) : ((u).pm * BM + _h * HALF + Ra[_i]); V[_i][_h] = (unsigned)(((size_t)_row * lda + Ca[_i]) * 2); } } while (0)
    Unit cur, nxt; int ui = 0;
    if (!S.next(0, cur)) return;
    f32x4 acc[2][2][4][2];
#pragma unroll
    for (int a = 0; a < 2; ++a)
#pragma unroll
        for (int b = 0; b < 2; ++b)
#pragma unroll
            for (int m = 0; m < 4; ++m)
#pragma unroll
                for (int n = 0; n < 2; ++n) acc[a][b][m][n] = (f32x4){0.f, 0.f, 0.f, 0.f};
    bf16x8 At[4][2], B0[2][2], B1[2][2];
    unsigned vA[2][2], vN[2][2];
    if constexpr (GATHER) { PG8_SETV(vA, cur); }
    const char* cA = (const char*)g.A + (GATHER ? (size_t)0 : (size_t)cur.pm * tstepA);
    const char* cB = (const char*)g.Bt + ((size_t)cur.e * g.bstride) * 2 + (size_t)cur.pn * tstepB;
    PG8_STAGE(PG8_SB(0, 0), cB, voffB); PG8_STAGE(PG8_SB(0, 1), cB + hstepB, voffB); PG8_STAGEA(PG8_SA(0, 0), cA, vA, 0); PG8_STAGEA(PG8_SA(0, 1), cA, vA, 1);
    if (wr == 1) PG8_BAR;
    PG8_WAIT_V(2); PG8_BAR;
    PG8_STAGE(PG8_SB(1, 0), cB + kstep, voffB); PG8_STAGEA(PG8_SA(1, 0), cA + kstep, vA, 0); PG8_STAGE(PG8_SB(1, 1), cB + hstepB + kstep, voffB);
    PG8_WAIT_V(6); PG8_BAR;
    for (;;) {
        const bool has_next = S.next(ui + 1, nxt);
        if constexpr (GATHER) { if (has_next) { PG8_SETV(vN, nxt); }
        else {
#pragma unroll
            for (int _i = 0; _i < 2; ++_i)
#pragma unroll
                for (int _h = 0; _h < 2; ++_h) vN[_i][_h] = vA[_i][_h];
        } }
        const char* nA = (!GATHER && has_next) ? (const char*)g.A + (size_t)nxt.pm * tstepA : cA;
        const char* nB = has_next ? (const char*)g.Bt + ((size_t)nxt.e * g.bstride) * 2 + (size_t)nxt.pn * tstepB : cB;
#pragma unroll 1
        for (int t = 0; t < nt; t += 2) {
            const bool last = (t == nt - 2);
            const char* a1 = cA + (size_t)(t + 1) * kstep;
            const char* a2 = last ? nA : cA + (size_t)(t + 2) * kstep; const char* b2 = last ? nB : cB + (size_t)(t + 2) * kstep;
            const char* a3 = a2 + kstep; const char* b3 = b2 + kstep;
            unsigned v2[2][2];
            if constexpr (GATHER) {
#pragma unroll
            for (int _i = 0; _i < 2; ++_i)
#pragma unroll
                for (int _h = 0; _h < 2; ++_h) v2[_i][_h] = last ? vN[_i][_h] : vA[_i][_h];
            }
            PG8_LDB(B0, 0, 0); PG8_LDB(B1, 0, 1); PG8_SCHED; PG8_LDA(At, 0, 0); PG8_STAGEA(PG8_SA(1, 1), a1, vA, 1);
            PG8_WAIT_V(8); PG8_WAIT_L(0); PG8_BAR; PG8_MMA(0, 0, At, B0); PG8_MMA(0, 1, At, B1); PG8_BAR; PG8_SCHED;
            PG8_LDA(At, 0, 1); PG8_STAGE(PG8_SB(0, 0), b2, voffB); PG8_STAGE(PG8_SB(0, 1), b2 + hstepB, voffB); PG8_STAGEA(PG8_SA(0, 0), a2, v2, 0);
            PG8_WAIT_V(8); PG8_WAIT_L(0); PG8_BAR; PG8_MMA(1, 0, At, B0); PG8_MMA(1, 1, At, B1); PG8_BAR; PG8_SCHED;
            PG8_LDB(B0, 1, 0); PG8_LDB(B1, 1, 1); PG8_SCHED; PG8_LDA(At, 1, 0); PG8_STAGEA(PG8_SA(0, 1), a2, v2, 1);
            PG8_WAIT_V(8); PG8_WAIT_L(0); PG8_BAR; PG8_MMA(0, 0, At, B0); PG8_MMA(0, 1, At, B1); PG8_BAR; PG8_SCHED;
            PG8_LDA(At, 1, 1); PG8_STAGE(PG8_SB(1, 0), b3, voffB); PG8_STAGE(PG8_SB(1, 1), b3 + hstepB, voffB); PG8_STAGEA(PG8_SA(1, 0), a3, v2, 0);
            PG8_WAIT_V(8); PG8_WAIT_L(0); PG8_BAR; PG8_MMA(1, 0, At, B0); PG8_MMA(1, 1, At, B1); PG8_BAR; PG8_SCHED;
        }
        if (wr == 0) PG8_BAR;
        E(acc, cur, wr, wc, fr, fq);
        if (!has_next) break;
#pragma unroll
        for (int a = 0; a < 2; ++a)
#pragma unroll
            for (int b = 0; b < 2; ++b)
#pragma unroll
                for (int m = 0; m < 4; ++m)
#pragma unroll
                    for (int n = 0; n < 2; ++n) acc[a][b][m][n] = (f32x4){0.f, 0.f, 0.f, 0.f};
        cur = nxt; cB = nB; cA = nA; ++ui;
        if constexpr (GATHER) {
#pragma unroll
        for (int _i = 0; _i < 2; ++_i)
#pragma unroll
            for (int _h = 0; _h < 2; ++_h) vA[_i][_h] = vN[_i][_h];
        }
        if (wr == 1) PG8_BAR;
    }
    PG8_WAIT_V(0);
    PG8_BAR;
#undef PG8_SA
#undef PG8_SB
#undef PG8_STAGE
#undef PG8_STAGEA
#undef PG8_LDA
#undef PG8_LDB
#undef PG8_MMA
#undef PG8_WAIT_V
#undef PG8_WAIT_L
#undef PG8_BAR
#undef PG8_SCHED
#undef PG8_SETV
}
}

namespace {
struct Params {
    const float *x, *c, *w_ada, *b_ada, *g_norm1, *w_in, *b_forget, *g_q_mla, *w_q_up, *g_kv_mla, *w_kv_up, *sinks, *w_out, *g_norm2,
                *w_router, *b_router, *w_gate, *w_up, *w_down, *g_final;
    float* xo;
    unsigned* ctl;
    float* mod;
    bf16_t* WinT;
    bf16_t* WoutT;
    bf16_t* WqT;
    bf16_t* WkvT;
    bf16_t* WguT;
    bf16_t* WdT;
    float* ropetab;
    float* rq; float* rkv;
    float* cbF;
    uint32_t* mask;
    bf16_t* h;
    bf16_t* proj;
    bf16_t* qm; bf16_t* km; bf16_t* vm;
    bf16_t* merged;
    bf16_t* hid;
    bf16_t* ys;
    int* list;
    float* rw;
    float* wl;
    int wid;
    int qslot;
    int qslot_host;
};
constexpr int CW_BAR = 0;
constexpr int CW_CNT = 3584;
constexpr int CW_QA = 3648;
constexpr int CW_QD = 4288;
constexpr int CW_WORDS = 4992;
}

namespace {
constexpr long P0_B1 = 2l * NP * 128, P0_B2 = P0_B1 + 2l * 1024 * 128, P0_B3 = P0_B2 + 2l * 512 * 32, P0_B4 = P0_B3 + 2l * 512 * 16,
               P0_B5 = P0_B4 + 32l * 512 * 128, P0_B6 = P0_B5 + 32l * 1024 * 32;
__device__ __forceinline__ bf16_t* p0_fetch(const Params& p, long it, float (&v)[8]) {
    if (it < P0_B1) {
        const int l = (int)(it / (NP * 128)), r = (int)(it % (NP * 128)), n = r % NP, k0 = (r / NP) * 8, o = orig_col(n);
        const float* w = p.w_in + (size_t)l * D * NIN;
#pragma unroll
        for (int j = 0; j < 8; ++j) v[j] = o >= 0 ? w[(size_t)(k0 + j) * NIN + o] : 0.f;
        return p.WinT + ((size_t)l * NP + n) * D + k0;
    } else if (it < P0_B2) {
        const long s = it - P0_B1; const int l = (int)(s / (1024 * 128)), r = (int)(s % (1024 * 128)), n = r & 1023, k0 = (r >> 10) * 8;
        const float* w = p.w_out + (size_t)l * D * D;
#pragma unroll
        for (int j = 0; j < 8; ++j) v[j] = w[(size_t)(k0 + j) * D + n];
        return p.WoutT + ((size_t)l * D + n) * D + k0;
    } else if (it < P0_B3) {
        const long s = it - P0_B2; const int l = (int)(s / (512 * 32)), r = (int)(s % (512 * 32)), n = r & 511, k0 = (r >> 9) * 8;
        const float* w = p.w_q_up + (size_t)l * 256 * 384; const float* g = p.g_q_mla + l * 256;
#pragma unroll
        for (int j = 0; j < 8; ++j) v[j] = n < 384 ? g[k0 + j] * w[(size_t)(k0 + j) * 384 + n] : 0.f;
        return p.WqT + ((size_t)l * 512 + n) * 256 + k0;
    } else if (it < P0_B4) {
        const long s = it - P0_B3; const int l = (int)(s / (512 * 16)), r = (int)(s % (512 * 16)), n = r & 511, k0 = (r >> 9) * 8;
        const float* w = p.w_kv_up + (size_t)l * 128 * 512; const float* g = p.g_kv_mla + l * 128;
#pragma unroll
        for (int j = 0; j < 8; ++j) v[j] = g[k0 + j] * w[(size_t)(k0 + j) * 512 + n];
        return p.WkvT + ((size_t)l * 512 + n) * 128 + k0;
    } else if (it < P0_B5) {
        const long s = it - P0_B4; const int le = (int)(s >> 16), r = (int)(s & 65535), n = r & 511, k0 = (r >> 9) * 8;
        const int q = n >> 5, rr = n & 31, col = 16 * q + (rr & 15);
        const float* w = (rr < 16 ? p.w_gate : p.w_up) + (size_t)le * 1024 * 256;
#pragma unroll
        for (int j = 0; j < 8; ++j) v[j] = w[(size_t)(k0 + j) * 256 + col];
        return p.WguT + ((size_t)le * 512 + n) * 1024 + k0;
    } else {
        const long s = it - P0_B5; const int le = (int)(s >> 15), r = (int)(s & 32767), n = r & 1023, k0 = (r >> 10) * 8;
        const float* w = p.w_down + (size_t)le * 256 * 1024;
#pragma unroll
        for (int j = 0; j < 8; ++j) v[j] = w[(size_t)(k0 + j) * 1024 + n];
        return p.WdT + ((size_t)le * 1024 + n) * 256 + k0;
    }
}
__device__ __forceinline__ void p0_store(bf16_t* dst, const float (&v)[8]) {
    u32x4 w; w.x = cvt_pk_bf16(v[0], v[1]); w.y = cvt_pk_bf16(v[2], v[3]); w.z = cvt_pk_bf16(v[4], v[5]); w.w = cvt_pk_bf16(v[6], v[7]);
    *(u32x4*)dst = w;
}

__device__ __forceinline__ void phase_p0(const Params& p, char* lds) {
    const int tid = opaque_tid(p.wid), gtid = blockIdx.x * blockDim.x + tid, gthreads = gridDim.x * blockDim.x;
    for (long it0 = gtid; it0 < P0_B6; it0 += 2l * gthreads) {
        float va[8], vb[8];
        const bool hb = it0 + gthreads < P0_B6;
        bf16_t* da = p0_fetch(p, it0, va);
        bf16_t* db = hb ? p0_fetch(p, it0 + gthreads, vb) : da;
        p0_store(da, va);
        if (hb) p0_store(db, vb);
    }
    for (int it = gtid; it < 2048 * 16; it += gthreads) {
        const int pos = it >> 4, i = it & 15;
        const float inv = powf(10000.0f, -(float)i / 16.0f), ang = (float)pos * inv;
        p.ropetab[it * 2] = cosf(ang); p.ropetab[it * 2 + 1] = sinf(ang);
    }
    float* ca = (float*)lds;
    for (int i = tid; i < NB * 1024; i += 512) { const float v = p.c[i]; ca[i] = v / (1.f + __expf(-v)); }
    __syncthreads();
    for (int u = blockIdx.x; u < 2 * (NMOD / 64); u += gridDim.x) {
        const int l = u / (NMOD / 64), n = (u % (NMOD / 64)) * 64 + (tid & 63), bg = tid >> 6;
        const float* w = p.w_ada + (size_t)l * 1024 * NMOD + n;
        float acc[4] = {0.f, 0.f, 0.f, 0.f};
        for (int d0 = 0; d0 < 1024; d0 += 8) {
            float wv[8];
#pragma unroll
            for (int q = 0; q < 8; ++q) wv[q] = w[(size_t)(d0 + q) * NMOD];
#pragma unroll
            for (int q = 0; q < 8; ++q)
#pragma unroll
                for (int j = 0; j < 4; ++j) acc[j] += ca[(bg * 4 + j) * 1024 + d0 + q] * wv[q];
        }
        const float bias = p.b_ada[l * NMOD + n];
#pragma unroll
        for (int j = 0; j < 4; ++j) p.mod[((size_t)l * NB + bg * 4 + j) * NMOD + n] = acc[j] + bias;
    }
    __syncthreads();
}

template <int MODE>
__device__ __forceinline__ void phase_norm1(const Params& p, int l) {
    constexpr int NT = 2;
    const int tid = opaque_tid(p.wid), w = tid >> 6, lane = tid & 63;
    const float* xin = (MODE == 0) ? p.x : p.xo;
    const float* g = (MODE == 2) ? p.g_final : p.g_norm1 + l * D;
    const float* modl = p.mod + (size_t)(MODE == 2 ? 1 : l) * NB * NMOD;
    const float* modp = p.mod + (size_t)(MODE == 2 ? 1 : (l > 0 ? l - 1 : 0)) * NB * NMOD;
    f32x4 gg4[4];
#pragma unroll
    for (int k = 0; k < 4; ++k) gg4[k] = *(const f32x4*)(g + 4 * lane + 256 * k);
    for (int t0 = (blockIdx.x * 8 + w) * NT; t0 < T; t0 += gridDim.x * 8 * NT) {
        const int b0 = t0 >> 11;
        f32x4 sc4[4], sh4[4], gt4[4];
        if (MODE != 2) {
#pragma unroll
            for (int k = 0; k < 4; ++k) { sc4[k] = *(const f32x4*)(modl + (size_t)b0 * NMOD + 1024 + 4 * lane + 256 * k); sh4[k] = *(const f32x4*)(modl + (size_t)b0 * NMOD + 4 * lane + 256 * k); }
        }
        if (MODE >= 1) {
#pragma unroll
            for (int k = 0; k < 4; ++k) gt4[k] = *(const f32x4*)(modp + (size_t)b0 * NMOD + 5 * 1024 + 4 * lane + 256 * k);
        }
        f32x4 v[NT][4];
#pragma unroll
        for (int u = 0; u < NT; ++u)
#pragma unroll
            for (int k = 0; k < 4; ++k) v[u][k] = *(const f32x4*)(xin + (size_t)(t0 + u) * D + 4 * lane + 256 * k);
        if (MODE >= 1) {
            u32x2 y0[NT][4], y1[NT][4];
#pragma unroll
            for (int u = 0; u < NT; ++u)
#pragma unroll
                for (int k = 0; k < 4; ++k) { const int col = 4 * lane + 256 * k;
                    y0[u][k] = *(const u32x2*)(p.ys + ((size_t)(t0 + u) * 2 + 0) * D + col); y1[u][k] = *(const u32x2*)(p.ys + ((size_t)(t0 + u) * 2 + 1) * D + col); }
#pragma unroll
            for (int u = 0; u < NT; ++u) {
                const int b = (t0 + u) >> 11;
#pragma unroll
                for (int k = 0; k < 4; ++k) {
                    const int col = 4 * lane + 256 * k;
                    const f32x4 gt = gt4[k];
                    v[u][k][0] += gt[0] * (bflo(y0[u][k].x) + bflo(y1[u][k].x)); v[u][k][1] += gt[1] * (bfhi(y0[u][k].x) + bfhi(y1[u][k].x));
                    v[u][k][2] += gt[2] * (bflo(y0[u][k].y) + bflo(y1[u][k].y)); v[u][k][3] += gt[3] * (bfhi(y0[u][k].y) + bfhi(y1[u][k].y));
                }
            }
        }
#pragma unroll
        for (int u = 0; u < NT; ++u) {
            const int t = t0 + u, b = t >> 11;
            float ss = 0.f;
#pragma unroll
            for (int k = 0; k < 4; ++k) ss += v[u][k][0] * v[u][k][0] + v[u][k][1] * v[u][k][1] + v[u][k][2] * v[u][k][2] + v[u][k][3] * v[u][k][3];
            ss = wave_sum(ss);
            const float r = rsqrtf(ss * (1.0f / D) + EPS);
#pragma unroll
            for (int k = 0; k < 4; ++k) {
                const int col = 4 * lane + 256 * k;
                f32x4 y = v[u][k] * r * gg4[k];
                if (MODE == 2) { *(f32x4*)(p.xo + (size_t)t * D + col) = y; }
                else {
                    if (MODE == 1) *(f32x4*)(p.xo + (size_t)t * D + col) = v[u][k];
                    y = y * (1.f + sc4[k]) + sh4[k];
                    u32x2 o; o.x = cvt_pk_bf16(y[0], y[1]); o.y = cvt_pk_bf16(y[2], y[3]);
                    *(u32x2*)(p.h + (size_t)t * D + col) = o;
                }
            }
        }
    }
}
}

namespace {
using pg8::Unit;
struct EpiStoreBf16 {
    static constexpr bool PERM = true;
    bf16_t* O; int ldc;
    __device__ __forceinline__ void operator()(const f32x4 (&acc)[2][2][4][2], const Unit& u, int wr, int wc, int fr_, int fq_) const {
        int fr = fr_, fq = fq_; asm volatile("" : "+v"(fr), "+v"(fq));
        const int row0 = u.pm * 256 + wr * 64 + fr, col0 = u.pn * 256 + wc * 32 + 8 * fq;
#pragma unroll
        for (int ai = 0; ai < 2; ++ai)
#pragma unroll
            for (int m = 0; m < 4; ++m) { bf16_t* rowp = O + (size_t)(row0 + ai * 128 + m * 16) * ldc + col0;
#pragma unroll
                for (int bj = 0; bj < 2; ++bj) { const f32x4 v0 = acc[ai][bj][m][0], v1 = acc[ai][bj][m][1];
                    u32x4 w; w.x = cvt_pk_bf16(v0[0], v0[1]); w.y = cvt_pk_bf16(v0[2], v0[3]); w.z = cvt_pk_bf16(v1[0], v1[1]); w.w = cvt_pk_bf16(v1[2], v1[3]);
                    *(u32x4*)(rowp + bj * 128) = w; } }
    }
};
struct EpiResidual {
    static constexpr bool PERM = false;
    const float* xin; float* x; const float* gate;
    __device__ __forceinline__ void operator()(const f32x4 (&acc)[2][2][4][2], const Unit& u, int wr, int wc, int fr_, int fq_) const {
        int fr = fr_, fq = fq_; asm volatile("" : "+v"(fr), "+v"(fq));
        const int row0 = u.pm * 256 + wr * 64 + fr, col0 = u.pn * 256 + wc * 32 + 4 * fq;
        const int b = (u.pm * 256) >> 11;
        f32x4 gv[2][2];
#pragma unroll
        for (int bj = 0; bj < 2; ++bj)
#pragma unroll
            for (int n = 0; n < 2; ++n) gv[bj][n] = *(const f32x4*)(gate + (size_t)b * NMOD + col0 + bj * 128 + n * 16);
#pragma unroll
        for (int ai = 0; ai < 2; ++ai)
#pragma unroll
            for (int m = 0; m < 4; ++m) { const size_t ro = (size_t)(row0 + ai * 128 + m * 16) * D + col0;
#pragma unroll
                for (int bj = 0; bj < 2; ++bj)
#pragma unroll
                    for (int n = 0; n < 2; ++n) { const size_t o = ro + bj * 128 + n * 16; *(f32x4*)(x + o) = *(const f32x4*)(xin + o) + gv[bj][n] * acc[ai][bj][m][n]; } }
    }
};
struct EpiMlaQ {
    static constexpr bool PERM = true;
    bf16_t* qm;
    __device__ __forceinline__ void operator()(const f32x4 (&acc)[2][2][4][2], const Unit& u, int wr, int wc, int fr_, int fq_) const {
        int fr = fr_, fq = fq_; asm volatile("" : "+v"(fr), "+v"(fq));
        const int row0 = u.pm * 256 + wr * 64 + fr;
#pragma unroll
        for (int bj = 0; bj < 2; ++bj) {
            const int col0 = u.pn * 256 + bj * 128 + wc * 32;
            if (col0 >= 384) continue;
#pragma unroll
            for (int ai = 0; ai < 2; ++ai)
#pragma unroll
                for (int m = 0; m < 4; ++m) { const f32x4 v0 = acc[ai][bj][m][0], v1 = acc[ai][bj][m][1];
                    u32x4 w; w.x = cvt_pk_bf16(v0[0], v0[1]); w.y = cvt_pk_bf16(v0[2], v0[3]); w.z = cvt_pk_bf16(v1[0], v1[1]); w.w = cvt_pk_bf16(v1[2], v1[3]);
                    *(u32x4*)(qm + (size_t)(row0 + ai * 128 + m * 16) * 384 + col0 + 8 * fq) = w; }
        }
    }
};
struct EpiMlaKV {
    static constexpr bool PERM = true;
    bf16_t* km; bf16_t* vm;
    __device__ __forceinline__ void operator()(const f32x4 (&acc)[2][2][4][2], const Unit& u, int wr, int wc, int fr_, int fq_) const {
        int fr = fr_, fq = fq_; asm volatile("" : "+v"(fr), "+v"(fq));
        const int row0 = u.pm * 256 + wr * 64 + fr;
#pragma unroll
        for (int bj = 0; bj < 2; ++bj) {
            const int head = u.pn * 2 + bj, wcol = wc * 32 + 8 * fq;
#pragma unroll
            for (int ai = 0; ai < 2; ++ai)
#pragma unroll
                for (int m = 0; m < 4; ++m) {
                    const int row = row0 + ai * 128 + m * 16;
                    const f32x4 v0 = acc[ai][bj][m][0], v1 = acc[ai][bj][m][1];
                    u32x4 w; w.x = cvt_pk_bf16(v0[0], v0[1]); w.y = cvt_pk_bf16(v0[2], v0[3]); w.z = cvt_pk_bf16(v1[0], v1[1]); w.w = cvt_pk_bf16(v1[2], v1[3]);
                    bf16_t* q = (wcol < 64) ? km + (size_t)row * 384 + head * 96 + wcol : vm + (size_t)row * 256 + head * 64 + (wcol - 64);
                    *(u32x4*)q = w;
                    asm volatile("" ::: "memory");
                }
        }
    }
};
struct EpiGateUp {
    static constexpr bool PERM = false;
    bf16_t* hid;
    __device__ __forceinline__ void operator()(const f32x4 (&acc)[2][2][4][2], const Unit& u, int wr, int wc, int fr_, int fq_) const {
        int fr = fr_, fq = fq_; asm volatile("" : "+v"(fr), "+v"(fq));
        const int row0 = u.pm * 256 + wr * 64 + fr;
#pragma unroll
        for (int ai = 0; ai < 2; ++ai)
#pragma unroll
            for (int m = 0; m < 4; ++m) { bf16_t* rowp = hid + (size_t)(row0 + ai * 128 + m * 16) * 256;
#pragma unroll
                for (int bj = 0; bj < 2; ++bj) { const f32x4 gt = acc[ai][bj][m][0], up = acc[ai][bj][m][1];
                    f32x4 o;
#pragma unroll
                    for (int j = 0; j < 4; ++j) o[j] = gt[j] / (1.f + __expf(-gt[j])) * up[j];
                    u32x2 w; w.x = cvt_pk_bf16(o[0], o[1]); w.y = cvt_pk_bf16(o[2], o[3]);
                    *(u32x2*)(rowp + 16 * (u.pn * 8 + bj * 4 + wc) + 4 * fq) = w; } }
    }
};
struct EpiDown {
    static constexpr bool PERM = true;
    bf16_t* ys; const int* list; const float* wl; const int* cnt;
    __device__ __forceinline__ void operator()(const f32x4 (&acc)[2][2][4][2], const Unit& u, int wr, int wc, int fr_, int fq_) const {
        int fr = fr_, fq = fq_; asm volatile("" : "+v"(fr), "+v"(fq));
        const int n = cnt[u.e]; const int* le = list + (size_t)u.e * ECAP; const float* we = wl + (size_t)u.e * ECAP;
        const int col0 = u.pn * 256 + wc * 32 + 8 * fq;
        int slot[8]; float w8[8];
#pragma unroll
        for (int q = 0; q < 8; ++q) { const int lr = u.mt * 256 + (q >> 2) * 128 + wr * 64 + (q & 3) * 16 + fr; slot[q] = lr < n ? le[lr] : -1; w8[q] = lr < n ? we[lr] : 0.f; }
#pragma unroll
        for (int ai = 0; ai < 2; ++ai)
#pragma unroll
            for (int m = 0; m < 4; ++m) {
                const int q = ai * 4 + m;
                if (slot[q] >= 0) {
                    bf16_t* rowp = ys + (size_t)slot[q] * D + col0;
#pragma unroll
                    for (int bj = 0; bj < 2; ++bj) { const f32x4 v0 = acc[ai][bj][m][0] * w8[q], v1 = acc[ai][bj][m][1] * w8[q];
                        u32x4 w; w.x = cvt_pk_bf16(v0[0], v0[1]); w.y = cvt_pk_bf16(v0[2], v0[3]); w.z = cvt_pk_bf16(v1[0], v1[1]); w.w = cvt_pk_bf16(v1[2], v1[3]);
                        *(u32x4*)(rowp + bj * 128) = w; }
                }
            }
    }
};
struct MoeOrder {
    int pre[17];
    int NT, G, c; const int* list; const int* cnt;
    __device__ __forceinline__ void init(const int* cnt_, const int* list_, int NT_, int G_, int c_) {
        cnt = cnt_; list = list_; NT = NT_; G = G_; c = c_; int a = 0;
#pragma unroll
        for (int e = 0; e < 16; ++e) { pre[e] = a; a += (cnt_[e] + 255) >> 8; }
        pre[16] = a;
    }
    __device__ __forceinline__ bool next(int i, Unit& u) const {
        const int L = i * G + c; if (L >= pre[16] * NT) return false;
        const int t = L / NT; int e = 0;
#pragma unroll
        for (int k = 1; k < 16; ++k) e += (t >= pre[k]) ? 1 : 0;
        int pe = 0;
#pragma unroll
        for (int k = 0; k < 16; ++k) pe = (k == e) ? pre[k] : pe;
        u.e = e; u.mt = t - pe; u.pm = t; u.pn = L - t * NT; return true;
    }
    __device__ __forceinline__ int arow(const Unit& u, int r) const { const int lr = u.mt * 256 + r; return lr < cnt[u.e] ? (list[(size_t)u.e * ECAP + lr] >> 1) : 0; }
};
}

namespace {
__device__ __forceinline__ void phase_prep(const Params& p, int l) {
    const int tid = opaque_tid(p.wid), w = tid >> 6, lane = tid & 63;
    const int gw = blockIdx.x * 8 + w, nw = gridDim.x * 8;
    for (int sq = gw; sq < NB * 4; sq += nw) {
        const int b = sq >> 2, hh = sq & 3; const float bias = p.b_forget[l * 4 + hh];
        float lf[32]; float run = 0.f;
#pragma unroll
        for (int j = 0; j < 32; ++j) {
            const float z = bf2f(p.proj[(size_t)(b * S + lane * 32 + j) * NP + PC_AF + hh]) + bias;
            run += fminf(z, 0.f) - log1pf(__expf(-fabsf(z)));
            lf[j] = run;
        }
        float incl = run;
#pragma unroll
        for (int o = 1; o < 64; o <<= 1) { const float t2 = __shfl_up(incl, o); if (lane >= o) incl += t2; }
        const float excl = incl - run;
#pragma unroll
        for (int j = 0; j < 32; ++j) p.cbF[(size_t)sq * S + lane * 32 + j] = -(excl + lf[j]) * LOG2E;
    }
    for (int t = gw; t < T; t += nw) {
        const bf16_t* row = p.proj + (size_t)t * NP;
        const u32x2 cq = *(const u32x2*)(row + PC_BCQ + 4 * lane);
        const unsigned ck = *(const unsigned*)(row + PC_BCKV + 2 * lane);
        float s1 = bflo(cq.x) * bflo(cq.x) + bfhi(cq.x) * bfhi(cq.x) + bflo(cq.y) * bflo(cq.y) + bfhi(cq.y) * bfhi(cq.y);
        float s2 = bflo(ck) * bflo(ck) + bfhi(ck) * bfhi(ck);
        s1 = wave_sum(s1); s2 = wave_sum(s2);
        const float kr = (lane < 32) ? bf2f(row[PC_BKR + lane]) : 0.f;
        const float kr2 = __shfl(kr, (lane + 16) & 63);
        {
            const float r1 = rsqrtf(s1 * (1.f / 256.f) + EPS), r2 = rsqrtf(s2 * (1.f / 128.f) + EPS);
            u32x2 o; o.x = cvt_pk_bf16(bflo(cq.x) * r1, bfhi(cq.x) * r1); o.y = cvt_pk_bf16(bflo(cq.y) * r1, bfhi(cq.y) * r1);
            *(u32x2*)(p.proj + (size_t)t * NP + PC_BCQ + 4 * lane) = o;
            *(unsigned*)(p.proj + (size_t)t * NP + PC_BCKV + 2 * lane) = cvt_pk_bf16(bflo(ck) * r2, bfhi(ck) * r2);
        }
        if (lane < 16) {
            const int pos = t & (S - 1);
            const float cs = p.ropetab[(pos * 16 + lane) * 2], sn = p.ropetab[(pos * 16 + lane) * 2 + 1];
            const bf16_t o1 = f2bf(kr * cs - kr2 * sn), o2 = f2bf(kr2 * cs + kr * sn);
            bf16_t* kmr = p.km + (size_t)t * 384;
#pragma unroll
            for (int hh = 0; hh < 4; ++hh) { kmr[hh * 96 + 64 + lane] = o1; kmr[hh * 96 + 80 + lane] = o2; }
        }
    }
}

__device__ __forceinline__ void phase_route(const Params& p, int l, char* lds) {
    const int tid = opaque_tid(p.wid), w = tid >> 6, lane = tid & 63;
    float* wrT = (float*)lds;
    int* lcnt = (int*)(lds + 65536);
    int* lbase = (int*)(lds + 65536 + 64);
    int* tsel = (int*)(lds + 65536 + 128);
    float* twt = (float*)(lds + 65536 + 128 + 2048);
    for (int i = tid; i < 16 * 1024; i += 512) { const int e = i >> 10, d = i & 1023; wrT[i] = p.w_router[d * 16 + e]; }
    const float* g = p.g_norm2 + l * D;
    const float* modl = p.mod + (size_t)l * NB * NMOD;
    int* cnt = (int*)(p.ctl + CW_CNT) + l * 16 + 32 * p.qslot;
    int* list = p.list + (size_t)p.qslot * 16 * ECAP;
    for (int chunk = blockIdx.x; chunk < T / 256; chunk += gridDim.x) {
        if (tid < 16) lcnt[tid] = 0;
        __syncthreads();
        const int b = (chunk * 256) >> 11;
        f32x4 gg4[4], sc4[4], sh4[4];
#pragma unroll
        for (int k = 0; k < 4; ++k) { const int col = 4 * lane + 256 * k; gg4[k] = *(const f32x4*)(g + col);
            sc4[k] = *(const f32x4*)(modl + (size_t)b * NMOD + 4 * 1024 + col); sh4[k] = *(const f32x4*)(modl + (size_t)b * NMOD + 3 * 1024 + col); }
        const int eown = ((lane >> 5) & 1) * 8 + ((lane >> 4) & 1) * 4 + ((lane >> 3) & 1) * 2 + ((lane >> 2) & 1);
        const float brown = p.b_router[eown];
        f32x4 vn[4];
#pragma unroll
        for (int k = 0; k < 4; ++k) vn[k] = *(const f32x4*)(p.xo + (size_t)(chunk * 256 + w * 32) * D + 4 * lane + 256 * k);
        for (int it = 0; it < 32; ++it) {
            const int li = w * 32 + it, t = chunk * 256 + li;
            f32x4 v[4];
#pragma unroll
            for (int k = 0; k < 4; ++k) v[k] = vn[k];
            if (it < 31) {
#pragma unroll
                for (int k = 0; k < 4; ++k) vn[k] = *(const f32x4*)(p.xo + (size_t)(t + 1) * D + 4 * lane + 256 * k);
            }
            float ss = 0.f;
#pragma unroll
            for (int k = 0; k < 4; ++k) ss += v[k][0] * v[k][0] + v[k][1] * v[k][1] + v[k][2] * v[k][2] + v[k][3] * v[k][3];
            ss = wave_sum(ss);
            const float r = rsqrtf(ss * (1.0f / D) + EPS);
            float lg[16];
#pragma unroll
            for (int e = 0; e < 16; ++e) lg[e] = 0.f;
#pragma unroll
            for (int k = 0; k < 4; ++k) {
                const int col = 4 * lane + 256 * k;
                const f32x4 y = v[k] * r * gg4[k] * (1.f + sc4[k]) + sh4[k];
                u32x2 o; o.x = cvt_pk_bf16(y[0], y[1]); o.y = cvt_pk_bf16(y[2], y[3]);
                *(u32x2*)(p.h + (size_t)t * D + col) = o;
#pragma unroll
                for (int e = 0; e < 16; ++e) { const f32x4 wv = *(const f32x4*)(wrT + e * 1024 + col); lg[e] += y[0] * wv[0] + y[1] * wv[1] + y[2] * wv[2] + y[3] * wv[3]; }
                asm volatile("" ::: "memory");
            }
            float a8[8], a4[4], a2[2], a1;
            { const bool hi = (lane & 32) != 0;
#pragma unroll
              for (int e = 0; e < 8; ++e) { const float send = hi ? lg[e] : lg[e + 8], keep = hi ? lg[e + 8] : lg[e]; a8[e] = keep + __shfl_xor(send, 32); } }
            { const bool hi = (lane & 16) != 0;
#pragma unroll
              for (int e = 0; e < 4; ++e) { const float send = hi ? a8[e] : a8[e + 4], keep = hi ? a8[e + 4] : a8[e]; a4[e] = keep + __shfl_xor(send, 16); } }
            { const bool hi = (lane & 8) != 0;
#pragma unroll
              for (int e = 0; e < 2; ++e) { const float send = hi ? a4[e] : a4[e + 2], keep = hi ? a4[e + 2] : a4[e]; a2[e] = keep + __shfl_xor(send, 8); } }
            { const bool hi = (lane & 4) != 0; const float send = hi ? a2[0] : a2[1], keep = hi ? a2[1] : a2[0]; a1 = keep + __shfl_xor(send, 4); }
            a1 += __shfl_xor(a1, 2); a1 += __shfl_xor(a1, 1);
            const float sown = 1.f / (1.f + expf(-a1)), bown = sown + brown;
            float sc[16], bi[16];
#pragma unroll
            for (int e = 0; e < 16; ++e) { const int src = ((e >> 3) & 1) * 32 + ((e >> 2) & 1) * 16 + ((e >> 1) & 1) * 8 + (e & 1) * 4;
                sc[e] = __builtin_bit_cast(float, __builtin_amdgcn_readlane(__builtin_bit_cast(int, sown), src));
                bi[e] = __builtin_bit_cast(float, __builtin_amdgcn_readlane(__builtin_bit_cast(int, bown), src)); }
            int bg = 0; float bgs = -INFINITY;
#pragma unroll
            for (int gi = 0; gi < 4; ++gi) {
                float m1 = -INFINITY, m2 = -INFINITY;
#pragma unroll
                for (int j = 0; j < 4; ++j) { const float vv = bi[gi * 4 + j]; if (vv > m1) { m2 = m1; m1 = vv; } else if (vv > m2) m2 = vv; }
                const float gs = m1 + m2; if (gs > bgs) { bgs = gs; bg = gi; }
            }
            float b4[4], s4[4];
#pragma unroll
            for (int gi = 0; gi < 4; ++gi)
#pragma unroll
                for (int j = 0; j < 4; ++j) if (gi == bg) { b4[j] = bi[gi * 4 + j]; s4[j] = sc[gi * 4 + j]; }
            int i1 = 0; float v1 = -INFINITY;
#pragma unroll
            for (int j = 0; j < 4; ++j) { if (b4[j] > v1) { v1 = b4[j]; i1 = j; } }
            int i2 = 0; float v2 = -INFINITY;
#pragma unroll
            for (int j = 0; j < 4; ++j) { if (j != i1 && b4[j] > v2) { v2 = b4[j]; i2 = j; } }
            float w1 = 0.f, w2 = 0.f;
#pragma unroll
            for (int j = 0; j < 4; ++j) { if (j == i1) w1 = s4[j]; if (j == i2) w2 = s4[j]; }
            if (lane == 0) {
                const int e1 = bg * 4 + i1, e2 = bg * 4 + i2; const float ws = w1 + w2;
                const int r1 = atomicAdd(&lcnt[e1], 1), r2 = atomicAdd(&lcnt[e2], 1);
                tsel[li * 2 + 0] = (e1 << 16) | r1; tsel[li * 2 + 1] = (e2 << 16) | r2;
                twt[li * 2 + 0] = w1 / ws; twt[li * 2 + 1] = w2 / ws;
            }
        }
        __syncthreads();
        if (tid < 16) lbase[tid] = atomicAdd(&cnt[tid], lcnt[tid]);
        __syncthreads();
        { const int v = tsel[tid], e = v >> 16, rk = v & 0xFFFF; const size_t pos = (size_t)e * ECAP + lbase[e] + rk;
          list[pos] = (chunk * 256 + (tid >> 1)) * 2 + (tid & 1); p.wl[pos + (size_t)p.qslot * 16 * ECAP] = twt[tid]; }
        __syncthreads();
    }
}
}

#ifndef ATTN_VMASK
#define ATTN_VMASK 15
#endif
#ifndef REPK_VMASK
#define REPK_VMASK 15
#endif
namespace {
constexpr int AT_KB = 0;
constexpr int AT_KR = 16384;
constexpr int AT_VB = 24576;
constexpr int AT_CB = 40960;
constexpr int AT_CTL = 41472;
constexpr int AT_LDS = 41984;
constexpr float NEGBIG = -1.0e30f;

template <int VAR, int KC>
__device__ __forceinline__ void attn_tile(LAS3 char* lds, const int buf, const int j, const int q0, const int i, const int g, const int swk, const float slope2,
                                          const bf16x8 (&qf)[2][KC], f32x4 (&o)[2][4], float (&mrow)[2], float (&lsum)[2], const u32x2 (&mw)[2]) {
    typedef LAS3 bf16x4 lds_bf16x4;
    bool need = (64 * j <= q0 + 31);
    if (VAR == 2) need = need && (64 * j + 63 >= q0 - 127);
    if (need) {
        const LAS3 char* Kb = lds + AT_KB + buf * 8192; const LAS3 char* Vb = lds + AT_VB + buf * 8192;
        bool full = (64 * j + 63 <= q0);
        if (VAR == 2) full = full && (64 * j >= q0 - 96);
        if (VAR == 3) full = false;
        f32x4 s[2][4];
#pragma unroll
        for (int qt = 0; qt < 2; ++qt) {
            const int t = q0 + 16 * qt + i;
#pragma unroll
            for (int mt = 0; mt < 4; ++mt) {
                f32x4 ini = {0.f, 0.f, 0.f, 0.f};
                if (VAR == 0) ini = *(const LAS3 f32x4*)(lds + AT_CB + buf * 256 + (16 * mt + 4 * g) * 4);
#pragma unroll
                for (int r = 0; r < 4; ++r) {
                    const int key = 64 * j + 16 * mt + 4 * g + r;
                    float v = ini[r];
                    if (VAR == 2) v = slope2 * (float)(key - t);
                    if (VAR == 3) v = slope2 * (float)key;
                    if (!full) {
                        bool ok;
                        if (VAR == 0 || VAR == 1) ok = key <= t;
                        else if (VAR == 2) ok = (key <= t) && (key > t - 128);
                        else { const int kk = 16 * mt + 4 * g + r; ok = (((kk < 32) ? (mw[qt].x >> kk) : (mw[qt].y >> (kk - 32))) & 1u) != 0u; }
                        v = ok ? v : NEGBIG;
                    }
                    ini[r] = v;
                }
                s[qt][mt] = ini;
            }
        }
#pragma unroll
        for (int mt = 0; mt < 4; ++mt) {
#pragma unroll
            for (int kc = 0; kc < 2; ++kc) {
                const bf16x8 kf = *(const LAS3 bf16x8*)(Kb + (mt * 16 + i) * 128 + (((kc * 4 + g) ^ swk) << 4));
                s[0][mt] = __builtin_amdgcn_mfma_f32_16x16x32_bf16(kf, qf[0][kc], s[0][mt], 0, 0, 0);
                s[1][mt] = __builtin_amdgcn_mfma_f32_16x16x32_bf16(kf, qf[1][kc], s[1][mt], 0, 0, 0);
            }
            if (VAR == 1) {
                const bf16x8 kf = *(const LAS3 bf16x8*)(lds + AT_KR + buf * 4096 + (mt * 16 + i) * 64 + ((g ^ (swk & 3)) << 4));
                s[0][mt] = __builtin_amdgcn_mfma_f32_16x16x32_bf16(kf, qf[0][KC - 1], s[0][mt], 0, 0, 0);
                s[1][mt] = __builtin_amdgcn_mfma_f32_16x16x32_bf16(kf, qf[1][KC - 1], s[1][mt], 0, 0, 0);
            }
        }
        bf16x8 pf[2][2];
#pragma unroll
        for (int qt = 0; qt < 2; ++qt) {
            float mx = fmaxf(fmaxf(s[qt][0][0], s[qt][0][1]), fmaxf(s[qt][0][2], s[qt][0][3]));
#pragma unroll
            for (int mt = 1; mt < 4; ++mt) mx = fmaxf(mx, fmaxf(fmaxf(s[qt][mt][0], s[qt][mt][1]), fmaxf(s[qt][mt][2], s[qt][mt][3])));
            mx = fmaxf(mx, __builtin_bit_cast(float, __builtin_amdgcn_ds_swizzle(__builtin_bit_cast(int, mx), 0x401F)));
            mx = xor32_max(mx);
            if (__any(mx > mrow[qt])) {
                const float mn = fmaxf(mrow[qt], mx), alpha = __builtin_amdgcn_exp2f(mrow[qt] - mn);
                mrow[qt] = mn; lsum[qt] *= alpha;
#pragma unroll
                for (int dt = 0; dt < 4; ++dt) o[qt][dt] = o[qt][dt] * alpha;
            }
            const float mn = mrow[qt];
            float ps = 0.f;
            float x[4][4];
#pragma unroll
            for (int mt = 0; mt < 4; ++mt)
#pragma unroll
                for (int r = 0; r < 4; ++r) { x[mt][r] = __builtin_amdgcn_exp2f(s[qt][mt][r] - mn); ps += x[mt][r]; }
            lsum[qt] += ps;
#pragma unroll
            for (int c = 0; c < 2; ++c) {
                u32x4 pk; pk.x = cvt_pk_bf16(x[2 * c][0], x[2 * c][1]); pk.y = cvt_pk_bf16(x[2 * c][2], x[2 * c][3]);
                pk.z = cvt_pk_bf16(x[2 * c + 1][0], x[2 * c + 1][1]); pk.w = cvt_pk_bf16(x[2 * c + 1][2], x[2 * c + 1][3]);
                pf[qt][c] = __builtin_bit_cast(bf16x8, pk);
            }
        }
        const int q4 = i >> 2, p4 = i & 3;
#pragma unroll
        for (int c = 0; c < 2; ++c) {
            const int row0 = 32 * c + 4 * g + q4, swv = (row0 >> 1) & 3;
#pragma unroll
            for (int dt = 0; dt < 4; ++dt) {
                const LAS3 char* a0 = Vb + row0 * 128 + ((dt ^ swv) << 5) + p4 * 8;
                const bf16x4 v0 = __builtin_amdgcn_ds_read_tr16_b64_v4i16((lds_bf16x4*)(a0));
                const bf16x4 v1 = __builtin_amdgcn_ds_read_tr16_b64_v4i16((lds_bf16x4*)(a0 + 16 * 128));
                const bf16x8 vf = {v0[0], v0[1], v0[2], v0[3], v1[0], v1[1], v1[2], v1[3]};
                o[0][dt] = __builtin_amdgcn_mfma_f32_16x16x32_bf16(vf, pf[0][c], o[0][dt], 0, 0, 0);
                o[1][dt] = __builtin_amdgcn_mfma_f32_16x16x32_bf16(vf, pf[1][c], o[1][dt], 0, 0, 0);
            }
        }
    }
}

template <int VAR>
__device__ __forceinline__ void attn_unit(const Params& p, int l, int b, int hx, int qb, LAS3 char* lds) {
    typedef LAS3 bf16x4 lds_bf16x4;
    constexpr int KC = (VAR == 1) ? 3 : 2;
    const int tid = opaque_tid(p.wid), w = __builtin_amdgcn_readfirstlane(tid >> 6), lane = tid & 63, i = lane & 15, g = lane >> 4;
    const bf16_t *Qp, *Kp, *Vp; int ldq, ldk, ldv, q0, j0, j1, ocol; float c1, slope2 = 0.f;
    if (VAR == 0) { Qp = p.proj + PC_AQ + hx * 64; Kp = p.proj + PC_AK + hx * 64; Vp = p.proj + PC_AV + hx * 64; ldq = ldk = ldv = NP;
                    q0 = qb * 256 + 32 * w; j0 = 0; j1 = 4 * qb + 3; ocol = hx * 64; c1 = 0.125f * LOG2E; }
    else if (VAR == 1) { Qp = p.qm + hx * 96; Kp = p.km + hx * 96; Vp = p.vm + hx * 64; ldq = 384; ldk = 384; ldv = 256;
                    q0 = qb * 256 + 32 * w; j0 = 0; j1 = 4 * qb + 3; ocol = 256 + hx * 64; c1 = 0.10206207261596577f * LOG2E; }
    else if (VAR == 2) { const int qh = hx * 2 + (w >> 2); Qp = p.proj + PC_CQ + qh * 64; Kp = p.proj + PC_CK + hx * 64; Vp = p.proj + PC_CV + hx * 64; ldq = ldk = ldv = NP;
                    q0 = qb * 128 + 32 * (w & 3); j0 = 2 * qb - 2 > 0 ? 2 * qb - 2 : 0; j1 = 2 * qb + 1; ocol = 512 + qh * 64; c1 = 0.125f * LOG2E;
                    slope2 = exp2f(-(float)(qh + 1)) * LOG2E; }
    else { const int hd = w >> 1; Qp = p.proj + PC_DQ + hd * 64; Kp = p.proj + PC_DK; Vp = p.proj + PC_DV; ldq = ldk = ldv = NP;
                    q0 = qb * 64 + 32 * (w & 1); j0 = 0; j1 = qb; ocol = 768 + hd * 64; c1 = 0.125f * LOG2E; slope2 = exp2f(-(float)(hd + 5)) * LOG2E; }
    const size_t tok0 = (size_t)b * S;
    bf16x8 qf[2][KC];
#pragma unroll
    for (int qt = 0; qt < 2; ++qt)
#pragma unroll
        for (int kc = 0; kc < KC; ++kc) qf[qt][kc] = *(const bf16x8*)(Qp + (tok0 + q0 + 16 * qt + i) * ldq + kc * 32 + 8 * g);
    if (VAR == 1) {
#pragma unroll
        for (int qt = 0; qt < 2; ++qt) {
            const int pos = q0 + 16 * qt + i;
            const u32x4 mine = __builtin_bit_cast(u32x4, qf[qt][KC - 1]);
            u32x4 oth; oth.x = __shfl_xor(mine.x, 32); oth.y = __shfl_xor(mine.y, 32); oth.z = __shfl_xor(mine.z, 32); oth.w = __shfl_xor(mine.w, 32);
            const float* rt = p.ropetab + (size_t)(pos * 16 + (g & 1) * 8) * 2;
            const float sg = (g < 2) ? -1.f : 1.f;
            u32x4 res;
#pragma unroll
            for (int e2 = 0; e2 < 4; ++e2) {
                const f32x4 cs = *(const f32x4*)(rt + e2 * 4);
                const unsigned mw_ = e2 == 0 ? mine.x : e2 == 1 ? mine.y : e2 == 2 ? mine.z : mine.w, ow_ = e2 == 0 ? oth.x : e2 == 1 ? oth.y : e2 == 2 ? oth.z : oth.w;
                const float r0 = bflo(mw_) * cs[0] + sg * bflo(ow_) * cs[1], r1 = bfhi(mw_) * cs[2] + sg * bfhi(ow_) * cs[3];
                const unsigned pk = cvt_pk_bf16(r0, r1);
                if (e2 == 0) res.x = pk; else if (e2 == 1) res.y = pk; else if (e2 == 2) res.z = pk; else res.w = pk;
            }
            qf[qt][KC - 1] = __builtin_bit_cast(bf16x8, res);
        }
    }
#pragma unroll
    for (int qt = 0; qt < 2; ++qt)
#pragma unroll
        for (int kc = 0; kc < KC; ++kc) {
            u32x4 qq = __builtin_bit_cast(u32x4, qf[qt][kc]);
            qq.x = cvt_pk_bf16(bflo(qq.x) * c1, bfhi(qq.x) * c1); qq.y = cvt_pk_bf16(bflo(qq.y) * c1, bfhi(qq.y) * c1);
            qq.z = cvt_pk_bf16(bflo(qq.z) * c1, bfhi(qq.z) * c1); qq.w = cvt_pk_bf16(bflo(qq.w) * c1, bfhi(qq.w) * c1);
            qf[qt][kc] = __builtin_bit_cast(bf16x8, qq);
        }
    f32x4 o[2][4];
#pragma unroll
    for (int qt = 0; qt < 2; ++qt)
#pragma unroll
        for (int dt = 0; dt < 4; ++dt) o[qt][dt] = (f32x4){0.f, 0.f, 0.f, 0.f};
    float mrow[2] = {NEGBIG, NEGBIG}, lsum[2] = {0.f, 0.f};
    const int sr = tid >> 3, sc8 = tid & 7;
    const int kdst = sr * 128 + ((sc8 ^ ((sr >> 1) & 7)) << 4);
    const int vdst = sr * 128 + (((((sc8 >> 1) ^ ((sr >> 1) & 3)) << 1) | (sc8 & 1)) << 4);
    const int rr = (tid & 255) >> 2, rc4 = tid & 3;
    const int rdst = rr * 64 + ((rc4 ^ ((rr >> 1) & 3)) << 4);
    u32x4 kstA, vstA, rstA = {0u, 0u, 0u, 0u}, kstB, vstB, rstB = {0u, 0u, 0u, 0u}; float cstA = 0.f, cstB = 0.f;
    u32x2 mw[2] = {{0u, 0u}, {0u, 0u}}, mwnA[2] = {{0u, 0u}, {0u, 0u}}, mwnB[2] = {{0u, 0u}, {0u, 0u}};
#define AT_LOAD(ZZ, j) do { const size_t _kr = tok0 + 64 * (j) + sr; \
        kst##ZZ = *(const u32x4*)(Kp + _kr * ldk + sc8 * 8); vst##ZZ = *(const u32x4*)(Vp + _kr * ldv + sc8 * 8); \
        if (VAR == 1 && tid < 256) rst##ZZ = *(const u32x4*)(Kp + (tok0 + 64 * (j) + rr) * ldk + 64 + rc4 * 8); \
        if (VAR == 0 && tid < 64) cst##ZZ = p.cbF[((size_t)b * 4 + hx) * S + 64 * (j) + tid]; \
        if (VAR == 3) { _Pragma("unroll") for (int _q = 0; _q < 2; ++_q) mwn##ZZ[_q] = *(const u32x2*)(p.mask + (tok0 + q0 + 16 * _q + i) * 64 + 2 * (j)); } } while (0)
#define AT_WRITE(ZZ, buf) do { *(LAS3 u32x4*)(lds + AT_KB + (buf) * 8192 + kdst) = kst##ZZ; *(LAS3 u32x4*)(lds + AT_VB + (buf) * 8192 + vdst) = vst##ZZ; \
        if (VAR == 1 && tid < 256) *(LAS3 u32x4*)(lds + AT_KR + (buf) * 4096 + rdst) = rst##ZZ; \
        if (VAR == 0 && tid < 64) *(LAS3 float*)(lds + AT_CB + (buf) * 256 + tid * 4) = cst##ZZ; \
        if (VAR == 3) { mw[0] = mwn##ZZ[0]; mw[1] = mwn##ZZ[1]; } } while (0)
    AT_LOAD(A, j0);
    if (j0 + 1 <= j1) AT_LOAD(B, j0 + 1);
    AT_WRITE(A, j0 & 1);
    __syncthreads();
    const int swk = (i >> 1) & 7;
    for (int j = j0; j <= j1; j += 2) {
        if (j + 2 <= j1) AT_LOAD(A, j + 2);
        attn_tile<VAR, KC>(lds, j & 1, j, q0, i, g, swk, slope2, qf, o, mrow, lsum, mw);
        if (j + 1 <= j1) AT_WRITE(B, (j + 1) & 1);
        __syncthreads();
        if (j + 1 > j1) break;
        if (j + 3 <= j1) AT_LOAD(B, j + 3);
        attn_tile<VAR, KC>(lds, (j + 1) & 1, j + 1, q0, i, g, swk, slope2, qf, o, mrow, lsum, mw);
        if (j + 2 <= j1) AT_WRITE(A, j & 1);
        __syncthreads();
    }
#undef AT_LOAD
#undef AT_WRITE
#pragma unroll
    for (int qt = 0; qt < 2; ++qt) {
        float lt = lsum[qt]; lt += __shfl_xor(lt, 16); lt += __shfl_xor(lt, 32);
        if (VAR == 2) lt += __builtin_amdgcn_exp2f(p.sinks[l * 4 + hx * 2 + (w >> 2)] * LOG2E - mrow[qt]);
        const float inv = 1.f / lt;
        bf16_t* op = p.merged + (tok0 + q0 + 16 * qt + i) * D + ocol + 4 * g;
#pragma unroll
        for (int dt = 0; dt < 4; ++dt) { const f32x4 v = o[qt][dt] * inv; u32x2 w2; w2.x = cvt_pk_bf16(v[0], v[1]); w2.y = cvt_pk_bf16(v[2], v[3]); *(u32x2*)(op + 16 * dt) = w2; }
    }
}

__device__ __forceinline__ void phase_attn(const Params& p, int l, LAS3 char* lds) {
    const int tid = opaque_tid(p.wid);
    unsigned* qhead = p.ctl + CW_QA + 64 * (l + 2 * p.qslot);
    volatile LAS3 int* bc = (volatile LAS3 int*)(lds + AT_CTL);
    int nxt = 0;
    if (tid == 0) nxt = (int)__hip_atomic_fetch_add(qhead, 1u, __ATOMIC_RELAXED, __HIP_MEMORY_SCOPE_AGENT);
    for (;;) {
        if (tid == 0) *bc = nxt;
        __syncthreads();
        const int idx = __builtin_amdgcn_readfirstlane(*bc);
        __syncthreads();
        if (idx >= 4096) break;
        if (tid == 0) nxt = (int)__hip_atomic_fetch_add(qhead, 1u, __ATOMIC_RELAXED, __HIP_MEMORY_SCOPE_AGENT);
        const int vmask = p.qslot ? REPK_VMASK : ATTN_VMASK;
        if (idx < 3072) {
            const int lvl = 7 - idx / 384, rem = idx % 384;
            if (rem < 128) { if (vmask & 2) attn_unit<1>(p, l, rem >> 2, rem & 3, lvl, lds); }
            else if (rem < 256) { if (vmask & 1) attn_unit<0>(p, l, (rem - 128) >> 2, rem & 3, lvl, lds); }
            else { const int d = rem - 256; if (vmask & 8) attn_unit<3>(p, l, d & 31, 0, 4 * lvl + 3 - (d >> 5), lds); }
        } else { const int c = idx - 3072; if (vmask & 4) attn_unit<2>(p, l, c >> 5, (c >> 4) & 1, c & 15, lds); }
    }
}
}

namespace {
constexpr int DS_LD = 2052;
constexpr int DS_CTL = 16 * DS_LD * 4;
constexpr int DS_LDS = DS_CTL + 64;

__device__ __forceinline__ void dsa_unit(const Params& p, int u, LAS3 char* lds) {
    const int tid = opaque_tid(p.wid), w = __builtin_amdgcn_readfirstlane(tid >> 6), lane = tid & 63, i = lane & 15, g = lane >> 4;
    const int b = u >> 7, t0 = (u & 127) * 16;
    const size_t tok0 = (size_t)b * S;
    uint32_t* mbase = p.mask + (tok0 + t0) * 64;
    if (t0 + 16 <= 256) {
#pragma unroll
        for (int qq = 0; qq < 2; ++qq) {
            const int q = 2 * w + qq, n = t0 + q + 1;
            if (lane < 32) { const int lo = lane * 64; unsigned long long bits = (n >= lo + 64) ? ~0ull : (n <= lo ? 0ull : ((1ull << (n - lo)) - 1ull));
                u32x2 o; o.x = (unsigned)bits; o.y = (unsigned)(bits >> 32); *(u32x2*)(mbase + q * 64 + 2 * lane) = o; }
        }
        return;
    }
    const int nreg = (t0 + 16 + 63) >> 6;
    const int ntile = nreg * 4;
    bf16x8 qf[8]; float wq[8];
    {
        const bf16_t* qrow = p.proj + (tok0 + t0 + i) * NP;
#pragma unroll
        for (int h = 0; h < 8; ++h) qf[h] = *(const bf16x8*)(qrow + PC_DQI + h * 32 + 8 * g);
        const u32x4 ww = *(const u32x4*)(qrow + PC_DWI);
        const float sc = 0.35355339059327373f * 0.17677669529663687f;
        wq[0] = bflo(ww.x) * sc; wq[1] = bfhi(ww.x) * sc; wq[2] = bflo(ww.y) * sc; wq[3] = bfhi(ww.y) * sc;
        wq[4] = bflo(ww.z) * sc; wq[5] = bfhi(ww.z) * sc; wq[6] = bflo(ww.w) * sc; wq[7] = bfhi(ww.w) * sc;
    }
    const int tq = t0 + i;
    for (int base = w; base < ntile; base += 32) {
        bf16x8 kf4[4];
#pragma unroll
        for (int uu = 0; uu < 4; ++uu) { const int kt = base + 8 * uu; if (kt < ntile) kf4[uu] = *(const bf16x8*)(p.proj + (tok0 + 16 * kt + i) * NP + PC_DKI + 8 * g); }
#pragma unroll
        for (int uu = 0; uu < 4; ++uu) {
            const int kt = base + 8 * uu;
            if (kt < ntile) {
                f32x4 sc4 = {0.f, 0.f, 0.f, 0.f};
#pragma unroll
                for (int h = 0; h < 8; ++h) {
                    const f32x4 c = __builtin_amdgcn_mfma_f32_16x16x32_bf16(kf4[uu], qf[h], (f32x4){0.f, 0.f, 0.f, 0.f}, 0, 0, 0);
#pragma unroll
                    for (int r = 0; r < 4; ++r) sc4[r] += wq[h] * fmaxf(c[r], 0.f);
                }
                u32x4 ko;
#pragma unroll
                for (int r = 0; r < 4; ++r) {
                    const int key = 16 * kt + 4 * g + r;
                    unsigned uu2 = __float_as_uint(sc4[r]); if (uu2 == 0x80000000u) uu2 = 0u;
                    uu2 = (uu2 & 0x80000000u) ? ~uu2 : (uu2 | 0x80000000u);
                    ko[r] = (key <= tq) ? uu2 : 0u;
                }
                *(LAS3 u32x4*)(lds + ((size_t)i * DS_LD + 16 * kt + 4 * g) * 4) = ko;
            }
        }
    }
    __syncthreads();
    {
        const int qA = 2 * w, qB = 2 * w + 1, nA = t0 + qA + 1, nB = t0 + qB + 1;
        const LAS3 unsigned* kpA = (const LAS3 unsigned*)(lds + (size_t)qA * DS_LD * 4);
        const LAS3 unsigned* kpB = (const LAS3 unsigned*)(lds + (size_t)qB * DS_LD * 4);
        unsigned keyA[32], keyB[32];
        const int nv = nreg * 64;
#pragma unroll
        for (int r = 0; r < 32; ++r) {
            int idx = r * 64 + lane; asm volatile("" : "+v"(idx));
            const unsigned va = kpA[r * 64 + lane], vb = kpB[r * 64 + lane];
            keyA[r] = (idx < nv) ? va : 0u; keyB[r] = (idx < nv) ? vb : 0u;
        }
        unsigned thrA = (nA <= 256) ? 1u : 0u, thrB = (nB <= 256) ? 1u : 0u;
        bool exA = (nA <= 256), exB = (nB <= 256);
        for (int bit = 31; bit >= 0; --bit) {
            if (exA && exB) break;
            const unsigned cA = exA ? 0xFFFFFFFFu : (thrA | (1u << bit)), cB = exB ? 0xFFFFFFFFu : (thrB | (1u << bit));
            int na = 0, nb = 0;
#pragma unroll
            for (int gq = 0; gq < 4; ++gq) if (nreg > 8 * gq) {
#pragma unroll
                for (int r = 8 * gq; r < 8 * gq + 8; ++r) { na += (keyA[r] >= cA) ? 1 : 0; nb += (keyB[r] >= cB) ? 1 : 0; } }
            na = wave_reduce_add(na); nb = wave_reduce_add(nb);
            if (!exA && na >= 256) { thrA = cA; exA = (na == 256); }
            if (!exB && nb >= 256) { thrB = cB; exB = (nb == 256); }
        }
#pragma unroll 1
        for (int qq = 0; qq < 2; ++qq) {
            const unsigned thr = qq ? thrB : thrA; const bool exact = qq ? exB : exA;
            unsigned long long mine = 0ull;
            int need = 0, running = 0;
            if (!exact) { int ngt = 0;
#pragma unroll
                for (int r = 0; r < 32; ++r) ngt += ((qq ? keyB[r] : keyA[r]) > thr) ? 1 : 0;
                need = 256 - wave_reduce_add(ngt); }
            const unsigned long long lt = (lane == 0) ? 0ull : (~0ull >> (64 - lane));
#pragma unroll
            for (int r = 0; r < 32; ++r) if (nreg > (r & ~7)) {
                const unsigned key = qq ? keyB[r] : keyA[r];
                unsigned long long bs;
                if (exact) bs = __ballot(key >= thr);
                else {
                    const bool eq = key == thr;
                    const unsigned long long be = __ballot(eq);
                    const int rank = running + __popcll(be & lt);
                    bs = __ballot((key > thr) || (eq && rank < need));
                    running += __popcll(be);
                }
                { int ln = lane; asm volatile("" : "+v"(ln)); if (ln == r) mine = bs; }
            }
            if (lane < 32) { u32x2 o; o.x = (unsigned)mine; o.y = (unsigned)(mine >> 32); *(u32x2*)(mbase + (2 * w + qq) * 64 + 2 * lane) = o; }
        }
    }
    __syncthreads();
}

__device__ __forceinline__ void phase_dsa(const Params& p, int l, LAS3 char* lds) {
    const int tid = opaque_tid(p.wid);
    unsigned* qhead = p.ctl + CW_QD + 64 * (l + 2 * p.qslot);
    volatile LAS3 int* bc = (volatile LAS3 int*)(lds + DS_CTL);
    int nxt = 0;
    if (tid == 0) nxt = (int)__hip_atomic_fetch_add(qhead, 1u, __ATOMIC_RELAXED, __HIP_MEMORY_SCOPE_AGENT);
    for (;;) {
        if (tid == 0) *bc = nxt;
        __syncthreads();
        const int idx = __builtin_amdgcn_readfirstlane(*bc);
        __syncthreads();
        if (idx >= 4096) break;
        if (tid == 0) nxt = (int)__hip_atomic_fetch_add(qhead, 1u, __ATOMIC_RELAXED, __HIP_MEMORY_SCOPE_AGENT);
        const int pb = 127 - (idx >> 5), b = idx & 31;
        dsa_unit(p, b * 128 + pb, lds);
    }
}
}

namespace {
constexpr int LDS_BYTES = 147456;
constexpr int NTHREADS = 512;

template <int PH>
__device__ __forceinline__ void run_phase(const Params& p, int l, unsigned char* smem) {
    LAS3 char* lds = (LAS3 char*)smem;
    PG8_LAS unsigned char* glds = (PG8_LAS unsigned char*)smem;
    const int G = gridDim.x, c = blockIdx.x;
    if constexpr (PH == 0) phase_p0(p, (char*)smem);
    if constexpr (PH == 1) { if (l == 0) phase_norm1<0>(p, 0); else phase_norm1<1>(p, l); }
    if constexpr (PH == 2) { pg8::Gemm g{p.h, p.WinT + (size_t)l * NP * D, D, D, 0}; pg8::StaticOrder S; S.init(T, NP, G, c);
        EpiStoreBf16 E{p.proj, NP}; pg8::gemm_phase<EpiStoreBf16, pg8::StaticOrder, false>(glds, g, S, E, p.wid); }
    if constexpr (PH == 3) phase_prep(p, l);
    if constexpr (PH == 4) { pg8::Gemm g{p.proj + PC_BCQ, p.WqT + (size_t)l * 512 * 256, 256, NP, 0}; pg8::StaticOrder S; S.init(T, 512, G, c);
          EpiMlaQ E{p.qm}; pg8::gemm_phase<EpiMlaQ, pg8::StaticOrder, false>(glds, g, S, E, p.wid); }
    if constexpr (PH == 12) { pg8::Gemm g{p.proj + PC_BCKV, p.WkvT + (size_t)l * 512 * 128, 128, NP, 0}; pg8::StaticOrder S; S.init(T, 512, G, c);
          EpiMlaKV E{p.km, p.vm}; pg8::gemm_phase<EpiMlaKV, pg8::StaticOrder, false>(glds, g, S, E, p.wid); }
    if constexpr (PH == 13) phase_dsa(p, l, lds);
    if constexpr (PH == 5) phase_attn(p, l, lds);
    if constexpr (PH == 6) { pg8::Gemm g{p.merged, p.WoutT + (size_t)l * D * D, D, D, 0}; pg8::StaticOrder S; S.init(T, D, G, c);
        EpiResidual E{l == 0 ? p.x : p.xo, p.xo, p.mod + (size_t)l * NB * NMOD + 2 * 1024}; pg8::gemm_phase<EpiResidual, pg8::StaticOrder, false>(glds, g, S, E, p.wid); }
    if constexpr (PH == 7) phase_route(p, l, (char*)smem);
    if constexpr (PH == 8) { const int* cnt = (const int*)(p.ctl + CW_CNT) + l * 16;
        pg8::Gemm g{p.h, p.WguT + (size_t)l * 16 * 512 * 1024, 1024, D, (size_t)512 * 1024}; MoeOrder S; S.init(cnt, p.list, 2, G, c);
        EpiGateUp E{p.hid}; pg8::gemm_phase<EpiGateUp, MoeOrder, true>(glds, g, S, E, p.wid); }
    if constexpr (PH == 9) { const int* cnt = (const int*)(p.ctl + CW_CNT) + l * 16;
        pg8::Gemm g{p.hid, p.WdT + (size_t)l * 16 * 1024 * 256, 256, 256, (size_t)1024 * 256}; MoeOrder S; S.init(cnt, p.list, 4, G, c);
        EpiDown E{p.ys, p.list, p.wl, cnt}; pg8::gemm_phase<EpiDown, MoeOrder, false>(glds, g, S, E, p.wid); }
    if constexpr (PH == 10) phase_norm1<2>(p, 1);
    if constexpr (PH == 11) phase_norm1<0>(p, l);
}
template <int PH>
__global__ void __launch_bounds__(NTHREADS, 2) k_ph(Params p, int l) {
    extern __shared__ __attribute__((aligned(16))) unsigned char smem[];
    p.wid = __builtin_amdgcn_readfirstlane(threadIdx.x >> 6); p.qslot = p.qslot_host;
    run_phase<PH>(p, l, smem);
}
}


namespace {
#ifndef REP_PH
#define REP_PH -1
#endif
#define REP(X, l) do { if (REP_PH == X) { xcd_barrier(bar); phase<X>(l, smem, wid, 1); } } while (0)
struct KArgs { const float* in[20]; float* xo; char* ws; };
constexpr size_t al256(size_t b) { return (b + 255) & ~(size_t)255; }
constexpr size_t WS_CTL = 0;
constexpr size_t WS_MOD = WS_CTL + al256((size_t)CW_WORDS * 4);
constexpr size_t WS_WIN = WS_MOD + al256((size_t)2 * NB * NMOD * 4);
constexpr size_t WS_WOUT = WS_WIN + al256((size_t)2 * NP * D * 2);
constexpr size_t WS_WQ = WS_WOUT + al256((size_t)2 * D * D * 2);
constexpr size_t WS_WKV = WS_WQ + al256((size_t)2 * 512 * 256 * 2);
constexpr size_t WS_WGU = WS_WKV + al256((size_t)2 * 512 * 128 * 2);
constexpr size_t WS_WD = WS_WGU + al256((size_t)2 * 16 * 512 * 1024 * 2);
constexpr size_t WS_ROPE = WS_WD + al256((size_t)2 * 16 * 1024 * 256 * 2);
constexpr size_t WS_RQ = WS_ROPE + al256((size_t)2048 * 16 * 2 * 4);
constexpr size_t WS_RKV = WS_RQ + al256((size_t)T * 4);
constexpr size_t WS_CBF = WS_RKV + al256((size_t)T * 4);
constexpr size_t WS_MASK = WS_CBF + al256((size_t)NB * 4 * S * 4);
constexpr size_t WS_LIST = WS_MASK + al256((size_t)T * 64 * 4);
constexpr size_t WS_RW = WS_LIST + al256((size_t)2 * 16 * ECAP * 4);
constexpr size_t WS_WL = WS_RW + al256((size_t)T * 2 * 4);
constexpr size_t WS_H = WS_WL + al256((size_t)2 * 16 * ECAP * 4);
constexpr size_t WS_PROJ = WS_H + al256((size_t)T * D * 2);
constexpr size_t WS_QM = WS_PROJ + al256((size_t)T * NP * 2);
constexpr size_t WS_KM = WS_QM + al256((size_t)T * 384 * 2);
constexpr size_t WS_VM = WS_KM + al256((size_t)T * 384 * 2);
constexpr size_t WS_MERGED = WS_VM + al256((size_t)T * 256 * 2);
constexpr size_t WS_END1 = WS_MERGED + al256((size_t)T * D * 2);
constexpr size_t WS_HID = WS_PROJ;
constexpr size_t WS_YS = WS_HID + al256((size_t)HIDROWS * 256 * 2);
constexpr size_t WS_END2 = WS_YS + al256((size_t)T * 2 * D * 2);
constexpr size_t WS_NEED = WS_END1 > WS_END2 ? WS_END1 : WS_END2;
static_assert(WS_END2 <= WS_MERGED, "MoE overlay must not reach the merged buffer");

__device__ __forceinline__ Params make_params(const KArgs& a) {
    Params p;
    p.x = a.in[0]; p.c = a.in[1]; p.w_ada = a.in[2]; p.b_ada = a.in[3]; p.g_norm1 = a.in[4]; p.w_in = a.in[5]; p.b_forget = a.in[6]; p.g_q_mla = a.in[7];
    p.w_q_up = a.in[8]; p.g_kv_mla = a.in[9]; p.w_kv_up = a.in[10]; p.sinks = a.in[11]; p.w_out = a.in[12]; p.g_norm2 = a.in[13]; p.w_router = a.in[14];
    p.b_router = a.in[15]; p.w_gate = a.in[16]; p.w_up = a.in[17]; p.w_down = a.in[18]; p.g_final = a.in[19];
    p.xo = a.xo; char* ws = a.ws;
    p.ctl = (unsigned*)(ws + WS_CTL); p.mod = (float*)(ws + WS_MOD); p.WinT = (bf16_t*)(ws + WS_WIN); p.WoutT = (bf16_t*)(ws + WS_WOUT);
    p.WqT = (bf16_t*)(ws + WS_WQ); p.WkvT = (bf16_t*)(ws + WS_WKV); p.WguT = (bf16_t*)(ws + WS_WGU); p.WdT = (bf16_t*)(ws + WS_WD);
    p.ropetab = (float*)(ws + WS_ROPE); p.rq = (float*)(ws + WS_RQ); p.rkv = (float*)(ws + WS_RKV); p.cbF = (float*)(ws + WS_CBF);
    p.mask = (uint32_t*)(ws + WS_MASK); p.list = (int*)(ws + WS_LIST); p.rw = (float*)(ws + WS_RW); p.wl = (float*)(ws + WS_WL); p.h = (bf16_t*)(ws + WS_H);
    p.proj = (bf16_t*)(ws + WS_PROJ); p.qm = (bf16_t*)(ws + WS_QM); p.km = (bf16_t*)(ws + WS_KM); p.vm = (bf16_t*)(ws + WS_VM);
    p.merged = (bf16_t*)(ws + WS_MERGED); p.hid = (bf16_t*)(ws + WS_HID); p.ys = (bf16_t*)(ws + WS_YS);
    return p;
}
template <int PH>
__device__ __forceinline__ void phase(int l, unsigned char* smem, int wid, int qslot = 0) {
    typedef const __attribute__((address_space(4))) KArgs* KA4;
    KA4 ka = (KA4)__builtin_amdgcn_kernarg_segment_ptr();
    asm volatile("" : "+s"(ka));
    KArgs a;
#pragma unroll
    for (int i = 0; i < 20; ++i) a.in[i] = ka->in[i];
    a.xo = ka->xo; a.ws = ka->ws;
    Params p = make_params(a); p.wid = wid; p.qslot = qslot; p.qslot_host = 0;
    run_phase<PH>(p, l, smem);
}
__global__ void __launch_bounds__(NTHREADS, 2) fwd(KArgs args) {
    extern __shared__ __attribute__((aligned(16))) unsigned char smem[];
    volatile LAS unsigned* st = (volatile LAS unsigned*)(smem + LDS_BYTES - 16);
    const int wid = __builtin_amdgcn_readfirstlane(threadIdx.x >> 6);
    if (xb_leader(wid)) { st[0] = 0u; st[1] = 0u; st[2] = 0u; st[3] = 0u; }
    __syncthreads();
    XcdBarrier bar = xcd_barrier_post((unsigned*)(args.ws + WS_CTL) + CW_BAR, st, wid);
    phase<0>(0, smem, wid);  REP(0, 0);
    xcd_barrier(bar);
#define LAYER(l) do { \
        phase<1>(l, smem, wid);  if (l == 0) REP(1, l); xcd_barrier(bar); \
        phase<2>(l, smem, wid);  REP(2, l); xcd_barrier(bar); \
        phase<3>(l, smem, wid);  REP(3, l); xcd_barrier(bar); \
        phase<4>(l, smem, wid);  REP(4, l); phase<12>(l, smem, wid);  REP(12, l); phase<13>(l, smem, wid);  REP(13, l); xcd_barrier(bar); \
        phase<5>(l, smem, wid);  REP(5, l); xcd_barrier(bar); \
        phase<6>(l, smem, wid);  xcd_barrier(bar); \
        phase<7>(l, smem, wid);  REP(7, l); xcd_barrier(bar); \
        phase<8>(l, smem, wid);  REP(8, l); xcd_barrier(bar); \
        phase<9>(l, smem, wid);  REP(9, l); xcd_barrier(bar); } while (0)
    LAYER(0);
    LAYER(1);
    phase<10>(1, smem, wid);
}
}

extern "C" void kernel_launch(void* const* d_in, const int* in_sizes, int n_in, void* d_out, int out_size, void* d_ws, size_t ws_size,
                              hipStream_t stream) {
    KArgs a{};
    for (int i = 0; i < 20; ++i) a.in[i] = (const float*)d_in[i];
    a.xo = (float*)d_out; a.ws = (char*)d_ws;
    if (WS_NEED > ws_size) return;

    static int grid = 0;
    if (!grid) {
        int dev = 0, cus = 0, per_cu = 0;
        (void)hipGetDevice(&dev);
        (void)hipDeviceGetAttribute(&cus, hipDeviceAttributeMultiprocessorCount, dev);
        (void)hipFuncSetAttribute((const void*)fwd, hipFuncAttributeMaxDynamicSharedMemorySize, LDS_BYTES);
        (void)hipOccupancyMaxActiveBlocksPerMultiprocessor(&per_cu, (const void*)fwd, NTHREADS, LDS_BYTES);
        grid = cus > 0 ? cus : 256;
    }
    (void)hipMemsetAsync(a.ws + WS_CTL, 0, (size_t)CW_WORDS * 4, stream);
    fwd<<<dim3(grid), dim3(NTHREADS), LDS_BYTES, stream>>>(a);
}
```

```cpp
#include <hip/hip_runtime.h>
#include <stdint.h>
#define XB_TMO      128
#define XB_XCNT(j)  (256  + 64 * (j))
#define XB_XSUB(j)  (1280 + 64 * (j))
#define XB_XGEN(j)  (2304 + 64 * (j))
#define XB_TOP      3328
#define XB_TOPGEN   3392
#define XCD_BAR_WORDS 3456
#define XB_SPIN_CAP (1u << 20)
#define LAS __attribute__((address_space(3)))

__device__ __forceinline__ unsigned xb_ld(unsigned* p)              { return __hip_atomic_load(p, __ATOMIC_RELAXED, __HIP_MEMORY_SCOPE_AGENT); }
__device__ __forceinline__ unsigned xb_add(unsigned* p, unsigned v) { return __hip_atomic_fetch_add(p, v, __ATOMIC_RELAXED, __HIP_MEMORY_SCOPE_AGENT); }
__device__ __forceinline__ unsigned xb_xcc_id() { return (unsigned)__builtin_amdgcn_s_getreg((3 << 11) | 20) & 0xFu; }
#define XB_SPIN(cond, bar) do { unsigned _sp = 0; while (cond) { __builtin_amdgcn_s_sleep(1); \
    if ((++_sp & 255u) == 0u) { if (xb_ld(&(bar)[XB_TMO])) break; if (_sp > XB_SPIN_CAP) { atomicAdd(&(bar)[XB_TMO], 1u); break; } } } } while (0)

struct XcdBarrier { unsigned* bar; unsigned x; volatile LAS unsigned* st; int wid; };
__device__ __forceinline__ bool xb_leader(int wid) { return wid == 0 && __builtin_amdgcn_mbcnt_hi(~0u, __builtin_amdgcn_mbcnt_lo(~0u, 0u)) == 0u; }

__device__ __forceinline__ XcdBarrier xcd_barrier_post(unsigned* bar, volatile LAS unsigned* st, int wid) {
    XcdBarrier b; b.bar = bar; b.x = xb_xcc_id(); b.st = st; b.wid = wid;
    if (xb_leader(wid)) (void)xb_add(&bar[XB_XCNT(b.x)], 1u);
    return b;
}
__device__ __forceinline__ void xcd_barrier_complete(unsigned* bar, unsigned x, unsigned& nloc, unsigned& nx) {
    const unsigned G = gridDim.x * gridDim.y * gridDim.z;
    unsigned sum, cnt, mine, sp = 0u;
    for (;;) {
        sum = 0u; cnt = 0u; mine = 0u;
#pragma unroll
        for (unsigned j = 0; j < 16; ++j) { const unsigned c = xb_ld(&bar[XB_XCNT(j)]); sum += c; cnt += (c > 0u) ? 1u : 0u; mine = (j == x) ? c : mine; }
        if (sum == G) break;
        __builtin_amdgcn_s_sleep(1);
        if ((++sp & 255u) == 0u) { if (xb_ld(&bar[XB_TMO])) break; if (sp > XB_SPIN_CAP) { atomicAdd(&bar[XB_TMO], 1u); break; } }
    }
    nloc = mine > 0u ? mine : 1u; nx = cnt > 0u ? cnt : 1u;
}
__device__ __forceinline__ void xcd_barrier(const XcdBarrier& b) {
    asm volatile("s_waitcnt vmcnt(0)" ::: "memory");
    __syncthreads();
    if (xb_leader(b.wid)) {
        unsigned* bar = b.bar;
        __builtin_amdgcn_s_waitcnt(0);
        unsigned nloc = b.st[0], nx = b.st[1];
        if (nloc == 0u) { xcd_barrier_complete(bar, b.x, nloc, nx); b.st[0] = nloc; b.st[1] = nx; }
        const unsigned old = xb_add(&bar[XB_XSUB(b.x)], 1u);
        const unsigned gen = old / nloc;
        if (old + 1u == (gen + 1u) * nloc) {
            __builtin_amdgcn_fence(__ATOMIC_RELEASE, "agent");
            asm volatile("s_waitcnt vmcnt(0)" ::: "memory");
            const unsigned og = xb_add(&bar[XB_TOP], 1u);
            const unsigned tg = og / nx;
            if (og + 1u == (tg + 1u) * nx) xb_add(&bar[XB_TOPGEN], 1u);
            else XB_SPIN(xb_ld(&bar[XB_TOPGEN]) == tg, bar);
            __builtin_amdgcn_fence(__ATOMIC_ACQUIRE, "agent");
            xb_add(&bar[XB_XGEN(b.x)], 1u);
            asm volatile("s_waitcnt vmcnt(0)" ::: "memory");
        } else {
            XB_SPIN(xb_ld(&bar[XB_XGEN(b.x)]) == gen, bar);
            __builtin_amdgcn_fence(__ATOMIC_ACQUIRE, "agent");
            asm volatile("s_waitcnt vmcnt(0)" ::: "memory");
        }
    }
    __syncthreads();
}

#define LAS3 __attribute__((address_space(3)))
namespace {
typedef unsigned short bf16_t;
typedef short bf16x8 __attribute__((ext_vector_type(8)));
typedef short bf16x4 __attribute__((ext_vector_type(4)));
typedef float f32x4 __attribute__((ext_vector_type(4)));
typedef float f32x2 __attribute__((ext_vector_type(2)));
typedef unsigned u32x4 __attribute__((ext_vector_type(4)));
typedef unsigned u32x2 __attribute__((ext_vector_type(2)));

constexpr int D = 1024, NB = 32, S = 2048, T = NB * S, NIN = 2380, NP = 2560, NMOD = 6144;
constexpr int OFF_AQ = 0, OFF_AK = 256, OFF_AV = 512, OFF_AF = 768, OFF_BCQ = 772, OFF_BCKV = 1028, OFF_BKR = 1156,
              OFF_CQ = 1188, OFF_CK = 1444, OFF_CV = 1572, OFF_DQ = 1700, OFF_DK = 1956, OFF_DV = 2020,
              OFF_DQI = 2084, OFF_DKI = 2340, OFF_DWI = 2372;
constexpr int PC_AQ = 0, PC_AK = 256, PC_AV = 512, PC_BCQ = 768, PC_BCKV = 1024, PC_BKR = 1152, PC_CQ = 1184, PC_CK = 1440, PC_CV = 1568,
              PC_DQ = 1696, PC_DK = 1952, PC_DV = 2016, PC_DQI = 2080, PC_DKI = 2336, PC_DWI = 2368, PC_AF = 2376;
constexpr float EPS = 1e-6f;
constexpr float LOG2E = 1.4426950408889634f;
constexpr int ECAP = T;
constexpr int HIDROWS = 2 * T + 16 * 256;

__host__ __device__ __forceinline__ int orig_col(int n) { return n < 768 ? n : (n < 2376 ? n + 4 : (n < 2380 ? n - 1608 : -1)); }
__device__ __forceinline__ int opaque_tid(int wid) {
    int t = wid * 64 + (int)__builtin_amdgcn_mbcnt_hi(~0u, __builtin_amdgcn_mbcnt_lo(~0u, 0u));
    asm volatile("" : "+v"(t)); return t; }
__device__ __forceinline__ float bf2f(bf16_t v) { return __uint_as_float((unsigned)v << 16); }
__device__ __forceinline__ bf16_t f2bf(float f) { unsigned u = __float_as_uint(f); u += 0x7FFFu + ((u >> 16) & 1u); return (bf16_t)(u >> 16); }
typedef __bf16 bf16x2_native __attribute__((ext_vector_type(2)));
__device__ __forceinline__ unsigned cvt_pk_bf16(float lo, float hi) { const f32x2 v = {lo, hi}; return __builtin_bit_cast(unsigned, __builtin_convertvector(v, bf16x2_native)); }
__device__ __forceinline__ float bflo(unsigned w) { return __uint_as_float(w << 16); }
__device__ __forceinline__ float bfhi(unsigned w) { return __uint_as_float(w & 0xFFFF0000u); }
__device__ __forceinline__ float wave_sum(float v) {
#pragma unroll
    for (int o = 32; o > 0; o >>= 1) v += __shfl_xor(v, o);
    return v;
}
__device__ __forceinline__ float xor32_max(float x) {
    float a = x, b = x;
    asm volatile("s_nop 1\n\tv_permlane32_swap_b32 %0, %1\n\ts_nop 1" : "+v"(a), "+v"(b));
    return fmaxf(a, b);
}
__device__ __forceinline__ int wave_reduce_add(int v) {
    v += __builtin_amdgcn_update_dpp(0, v, 0xB1, 0xF, 0xF, true);
    v += __builtin_amdgcn_update_dpp(0, v, 0x4E, 0xF, 0xF, true);
    v += __builtin_amdgcn_update_dpp(0, v, 0x141, 0xF, 0xF, true);
    v += __builtin_amdgcn_update_dpp(0, v, 0x140, 0xF, 0xF, true);
    return __builtin_amdgcn_readlane(v, 0) + __builtin_amdgcn_readlane(v, 16) + __builtin_amdgcn_readlane(v, 32) + __builtin_amdgcn_readlane(v, 48);
}
}

namespace pg8 {
#define PG8_LAS __attribute__((address_space(3)))
constexpr int BM = 256, BK = 64, HALF = 128, HTB = HALF * BK * 2, STAGE_BYTES = 8 * HTB, NXCD = 8, WGM = 8;

__host__ __device__ __forceinline__ int lds_byte(int r, int c) { const int st = (r >> 4) * 2 + (c >> 5), rr = r & 15, cc = c & 31, ob = rr * 64 + cc * 2; return st * 1024 + (ob ^ (((ob >> 9) & 1) << 5)); }
__host__ __device__ __forceinline__ void stage_rc(int b, int& R, int& C) { const int st = b / 1024, sb = b % 1024, swz = sb ^ (((sb >> 9) & 1) << 5); R = (st >> 1) * 16 + swz / 64; C = (st & 1) * 32 + (swz % 64) / 2; }
__host__ __device__ __forceinline__ int perm32(int rho) { const int n = rho >> 4, i = rho & 15; return 8 * (i >> 2) + 4 * n + (i & 3); }

struct Unit { int pm, pn, e, mt; };
struct Gemm { const bf16_t* A; const bf16_t* Bt; int K; int lda; size_t bstride; };

struct StaticOrder {
    int nM, nN, nwg, G, c;
    __host__ __device__ void init(int M, int N, int G_, int c_) { nM = M / BM; nN = N / BM; nwg = nM * nN; G = G_; c = c_; }
    __host__ __device__ bool next(int i, Unit& u) const {
        const long L = (long)i * G + c; if (L >= nwg) return false;
        int wgid = (int)L; { const int q = nwg / NXCD, r = nwg % NXCD, xcd = wgid % NXCD, off = wgid / NXCD; wgid = (xcd < r ? xcd * (q + 1) : r * (q + 1) + (xcd - r) * q) + off; }
        const int nig = WGM * nN, gid = wgid / nig, fm = gid * WGM, gsz = (nM - fm) < WGM ? (nM - fm) : WGM;
        u.pm = fm + ((wgid % nig) % gsz); u.pn = (wgid % nig) / gsz; u.e = 0; u.mt = 0; return true;
    }
    __device__ __forceinline__ int arow(const Unit& u, int r) const { return u.pm * BM + r; }
};

template <class Epi, class Sched, bool GATHER>
__device__ __forceinline__ void gemm_phase(PG8_LAS unsigned char* lds, const Gemm g, const Sched& S, const Epi& E, int wave_index) {
    const int tid = opaque_tid(wave_index), wid = __builtin_amdgcn_readfirstlane(tid >> 6), lane = tid & 63, wr = wid >> 2, wc = wid & 3, fr = lane & 15, fq = lane >> 4;
    int K_ = g.K; asm volatile("" : "+s"(K_));
    const int K = K_, nt = K / BK, lda = g.lda;
    int Ra[2], Ca[2]; unsigned voffB[2], voffA[2];
#pragma unroll
    for (int i = 0; i < 2; ++i) { int R, C; stage_rc(tid * 16 + i * 8192, R, C); const int Rb = Epi::PERM ? ((R & ~31) + perm32(R & 31)) : R;
        Ra[i] = R; Ca[i] = C; voffB[i] = (unsigned)(Rb * K + C) * 2u; voffA[i] = (unsigned)(R * lda + C) * 2u; }
    const size_t kstep = (size_t)(BK * 2);
    const size_t hstepB = (size_t)HALF * K * 2;
    const size_t tstepB = 2 * hstepB;
    const size_t hstepA = (size_t)HALF * lda * 2, tstepA = 2 * hstepA;
    const unsigned ldsw = (unsigned)wid * 1024u;
    const int aoff = lds_byte(wr * 64 + fr, fq * 8), boff = lds_byte(wc * 32 + fr, fq * 8);
#define PG8_SA(b, h) (((b) * 2 + (h)) * HTB)
#define PG8_SB(b, h) ((4 + (b) * 2 + (h)) * HTB)
#define PG8_STAGE(bufoff, gbase, voff) do { _Pragma("unroll") for (int _i = 0; _i < 2; ++_i) \
        __builtin_amdgcn_global_load_lds((const unsigned*)((const char*)(gbase) + (voff)[_i]), (PG8_LAS unsigned*)(lds + (bufoff) + ldsw + _i * 8192), 16, 0, 0); } while (0)
#define PG8_STAGEA(bufoff, kptr, VO, h) do { _Pragma("unroll") for (int _i = 0; _i < 2; ++_i) { \
        const char* _src; if constexpr (GATHER) _src = (const char*)(kptr) + (VO)[_i][h]; else _src = (const char*)(kptr) + (size_t)(h) * hstepA + voffA[_i]; \
        __builtin_amdgcn_global_load_lds((const unsigned*)_src, (PG8_LAS unsigned*)(lds + (bufoff) + ldsw + _i * 8192), 16, 0, 0); } } while (0)
#define PG8_LDA(dst, b, h) do { _Pragma("unroll") for (int m = 0; m < 4; ++m) _Pragma("unroll") for (int k = 0; k < 2; ++k) dst[m][k] = *(const PG8_LAS bf16x8*)(lds + PG8_SA(b, h) + aoff + m * 2048 + k * 1024); } while (0)
#define PG8_LDB(dst, b, h) do { _Pragma("unroll") for (int n = 0; n < 2; ++n) _Pragma("unroll") for (int k = 0; k < 2; ++k) dst[n][k] = *(const PG8_LAS bf16x8*)(lds + PG8_SB(b, h) + boff + n * 2048 + k * 1024); } while (0)
#define PG8_MMA(ai, bj, At, Bt) do { __builtin_amdgcn_s_setprio(1); _Pragma("unroll") for (int m = 0; m < 4; ++m) _Pragma("unroll") for (int n = 0; n < 2; ++n) _Pragma("unroll") for (int k = 0; k < 2; ++k) \
        acc[ai][bj][m][n] = __builtin_amdgcn_mfma_f32_16x16x32_bf16(Bt[n][k], At[m][k], acc[ai][bj][m][n], 0, 0, 0); __builtin_amdgcn_s_setprio(0); } while (0)
#define PG8_WAIT_V(n) asm volatile("s_waitcnt vmcnt(" #n ")" ::: "memory")
#define PG8_WAIT_L(n) asm volatile("s_waitcnt lgkmcnt(" #n ")" ::: "memory")
#define PG8_BAR __builtin_amdgcn_s_barrier()
#define PG8_SCHED __builtin_amdgcn_sched_barrier(0)
#define PG8_SETV(V, u) do { _Pragma("unroll") for (int _i = 0; _i < 2; ++_i) _Pragma("unroll") for (int _h = 0; _h < 2; ++_h) { \
        const int _row = GATHER ? S.arow(u, _h * HALF + Ra[_i]) : ((u).pm * BM + _h * HALF + Ra[_i]); V[_i][_h] = (unsigned)(((size_t)_row * lda + Ca[_i]) * 2); } } while (0)
    Unit cur, nxt; int ui = 0;
    if (!S.next(0, cur)) return;
    f32x4 acc[2][2][4][2];
#pragma unroll
    for (int a = 0; a < 2; ++a)
#pragma unroll
        for (int b = 0; b < 2; ++b)
#pragma unroll
            for (int m = 0; m < 4; ++m)
#pragma unroll
                for (int n = 0; n < 2; ++n) acc[a][b][m][n] = (f32x4){0.f, 0.f, 0.f, 0.f};
    bf16x8 At[4][2], B0[2][2], B1[2][2];
    unsigned vA[2][2], vN[2][2];
    if constexpr (GATHER) { PG8_SETV(vA, cur); }
    const char* cA = (const char*)g.A + (GATHER ? (size_t)0 : (size_t)cur.pm * tstepA);
    const char* cB = (const char*)g.Bt + ((size_t)cur.e * g.bstride) * 2 + (size_t)cur.pn * tstepB;
    PG8_STAGE(PG8_SB(0, 0), cB, voffB); PG8_STAGE(PG8_SB(0, 1), cB + hstepB, voffB); PG8_STAGEA(PG8_SA(0, 0), cA, vA, 0); PG8_STAGEA(PG8_SA(0, 1), cA, vA, 1);
    if (wr == 1) PG8_BAR;
    PG8_WAIT_V(2); PG8_BAR;
    PG8_STAGE(PG8_SB(1, 0), cB + kstep, voffB); PG8_STAGEA(PG8_SA(1, 0), cA + kstep, vA, 0); PG8_STAGE(PG8_SB(1, 1), cB + hstepB + kstep, voffB);
    PG8_WAIT_V(6); PG8_BAR;
    for (;;) {
        const bool has_next = S.next(ui + 1, nxt);
        if constexpr (GATHER) { if (has_next) { PG8_SETV(vN, nxt); }
        else {
#pragma unroll
            for (int _i = 0; _i < 2; ++_i)
#pragma unroll
                for (int _h = 0; _h < 2; ++_h) vN[_i][_h] = vA[_i][_h];
        } }
        const char* nA = (!GATHER && has_next) ? (const char*)g.A + (size_t)nxt.pm * tstepA : cA;
        const char* nB = has_next ? (const char*)g.Bt + ((size_t)nxt.e * g.bstride) * 2 + (size_t)nxt.pn * tstepB : cB;
#pragma unroll 1
        for (int t = 0; t < nt; t += 2) {
            const bool last = (t == nt - 2);
            const char* a1 = cA + (size_t)(t + 1) * kstep;
            const char* a2 = last ? nA : cA + (size_t)(t + 2) * kstep; const char* b2 = last ? nB : cB + (size_t)(t + 2) * kstep;
            const char* a3 = a2 + kstep; const char* b3 = b2 + kstep;
            unsigned v2[2][2];
            if constexpr (GATHER) {
#pragma unroll
            for (int _i = 0; _i < 2; ++_i)
#pragma unroll
                for (int _h = 0; _h < 2; ++_h) v2[_i][_h] = last ? vN[_i][_h] : vA[_i][_h];
            }
            PG8_LDB(B0, 0, 0); PG8_LDB(B1, 0, 1); PG8_SCHED; PG8_LDA(At, 0, 0); PG8_STAGEA(PG8_SA(1, 1), a1, vA, 1);
            PG8_WAIT_V(8); PG8_WAIT_L(0); PG8_BAR; PG8_MMA(0, 0, At, B0); PG8_MMA(0, 1, At, B1); PG8_BAR; PG8_SCHED;
            PG8_LDA(At, 0, 1); PG8_STAGE(PG8_SB(0, 0), b2, voffB); PG8_STAGE(PG8_SB(0, 1), b2 + hstepB, voffB); PG8_STAGEA(PG8_SA(0, 0), a2, v2, 0);
            PG8_WAIT_V(8); PG8_WAIT_L(0); PG8_BAR; PG8_MMA(1, 0, At, B0); PG8_MMA(1, 1, At, B1); PG8_BAR; PG8_SCHED;
            PG8_LDB(B0, 1, 0); PG8_LDB(B1, 1, 1); PG8_SCHED; PG8_LDA(At, 1, 0); PG8_STAGEA(PG8_SA(0, 1), a2, v2, 1);
            PG8_WAIT_V(8); PG8_WAIT_L(0); PG8_BAR; PG8_MMA(0, 0, At, B0); PG8_MMA(0, 1, At, B1); PG8_BAR; PG8_SCHED;
            PG8_LDA(At, 1, 1); PG8_STAGE(PG8_SB(1, 0), b3, voffB); PG8_STAGE(PG8_SB(1, 1), b3 + hstepB, voffB); PG8_STAGEA(PG8_SA(1, 0), a3, v2, 0);
            PG8_WAIT_V(8); PG8_WAIT_L(0); PG8_BAR; PG8_MMA(1, 0, At, B0); PG8_MMA(1, 1, At, B1); PG8_BAR; PG8_SCHED;
        }
        if (wr == 0) PG8_BAR;
        E(acc, cur, wr, wc, fr, fq);
        if (!has_next) break;
#pragma unroll
        for (int a = 0; a < 2; ++a)
#pragma unroll
            for (int b = 0; b < 2; ++b)
#pragma unroll
                for (int m = 0; m < 4; ++m)
#pragma unroll
                    for (int n = 0; n < 2; ++n) acc[a][b][m][n] = (f32x4){0.f, 0.f, 0.f, 0.f};
        cur = nxt; cB = nB; cA = nA; ++ui;
        if constexpr (GATHER) {
#pragma unroll
        for (int _i = 0; _i < 2; ++_i)
#pragma unroll
            for (int _h = 0; _h < 2; ++_h) vA[_i][_h] = vN[_i][_h];
        }
        if (wr == 1) PG8_BAR;
    }
    PG8_WAIT_V(0);
    PG8_BAR;
#undef PG8_SA
#undef PG8_SB
#undef PG8_STAGE
#undef PG8_STAGEA
#undef PG8_LDA
#undef PG8_LDB
#undef PG8_MMA
#undef PG8_WAIT_V
#undef PG8_WAIT_L
#undef PG8_BAR
#undef PG8_SCHED
#undef PG8_SETV
}
}

namespace {
struct Params {
    const float *x, *c, *w_ada, *b_ada, *g_norm1, *w_in, *b_forget, *g_q_mla, *w_q_up, *g_kv_mla, *w_kv_up, *sinks, *w_out, *g_norm2,
                *w_router, *b_router, *w_gate, *w_up, *w_down, *g_final;
    float* xo;
    unsigned* ctl;
    float* mod;
    bf16_t* WinT;
    bf16_t* WoutT;
    bf16_t* WqT;
    bf16_t* WkvT;
    bf16_t* WguT;
    bf16_t* WdT;
    float* ropetab;
    float* rq; float* rkv;
    float* cbF;
    uint32_t* mask;
    bf16_t* h;
    bf16_t* proj;
    bf16_t* qm; bf16_t* km; bf16_t* vm;
    bf16_t* merged;
    bf16_t* hid;
    bf16_t* ys;
    int* list;
    float* rw;
    float* wl;
    int wid;
    int qslot;
    int qslot_host;
};
constexpr int CW_BAR = 0;
constexpr int CW_CNT = 3584;
constexpr int CW_QA = 3648;
constexpr int CW_QD = 4288;
constexpr int CW_WORDS = 4992;
}

namespace {
constexpr long P0_B1 = 2l * NP * 128, P0_B2 = P0_B1 + 2l * 1024 * 128, P0_B3 = P0_B2 + 2l * 512 * 32, P0_B4 = P0_B3 + 2l * 512 * 16,
               P0_B5 = P0_B4 + 32l * 512 * 128, P0_B6 = P0_B5 + 32l * 1024 * 32;
__device__ __forceinline__ bf16_t* p0_fetch(const Params& p, long it, float (&v)[8]) {
    if (it < P0_B1) {
        const int l = (int)(it / (NP * 128)), r = (int)(it % (NP * 128)), n = r % NP, k0 = (r / NP) * 8, o = orig_col(n);
        const float* w = p.w_in + (size_t)l * D * NIN;
#pragma unroll
        for (int j = 0; j < 8; ++j) v[j] = o >= 0 ? w[(size_t)(k0 + j) * NIN + o] : 0.f;
        return p.WinT + ((size_t)l * NP + n) * D + k0;
    } else if (it < P0_B2) {
        const long s = it - P0_B1; const int l = (int)(s / (1024 * 128)), r = (int)(s % (1024 * 128)), n = r & 1023, k0 = (r >> 10) * 8;
        const float* w = p.w_out + (size_t)l * D * D;
#pragma unroll
        for (int j = 0; j < 8; ++j) v[j] = w[(size_t)(k0 + j) * D + n];
        return p.WoutT + ((size_t)l * D + n) * D + k0;
    } else if (it < P0_B3) {
        const long s = it - P0_B2; const int l = (int)(s / (512 * 32)), r = (int)(s % (512 * 32)), n = r & 511, k0 = (r >> 9) * 8;
        const float* w = p.w_q_up + (size_t)l * 256 * 384; const float* g = p.g_q_mla + l * 256;
#pragma unroll
        for (int j = 0; j < 8; ++j) v[j] = n < 384 ? g[k0 + j] * w[(size_t)(k0 + j) * 384 + n] : 0.f;
        return p.WqT + ((size_t)l * 512 + n) * 256 + k0;
    } else if (it < P0_B4) {
        const long s = it - P0_B3; const int l = (int)(s / (512 * 16)), r = (int)(s % (512 * 16)), n = r & 511, k0 = (r >> 9) * 8;
        const float* w = p.w_kv_up + (size_t)l * 128 * 512; const float* g = p.g_kv_mla + l * 128;
#pragma unroll
        for (int j = 0; j < 8; ++j) v[j] = g[k0 + j] * w[(size_t)(k0 + j) * 512 + n];
        return p.WkvT + ((size_t)l * 512 + n) * 128 + k0;
    } else if (it < P0_B5) {
        const long s = it - P0_B4; const int le = (int)(s >> 16), r = (int)(s & 65535), n = r & 511, k0 = (r >> 9) * 8;
        const int q = n >> 5, rr = n & 31, col = 16 * q + (rr & 15);
        const float* w = (rr < 16 ? p.w_gate : p.w_up) + (size_t)le * 1024 * 256;
#pragma unroll
        for (int j = 0; j < 8; ++j) v[j] = w[(size_t)(k0 + j) * 256 + col];
        return p.WguT + ((size_t)le * 512 + n) * 1024 + k0;
    } else {
        const long s = it - P0_B5; const int le = (int)(s >> 15), r = (int)(s & 32767), n = r & 1023, k0 = (r >> 10) * 8;
        const float* w = p.w_down + (size_t)le * 256 * 1024;
#pragma unroll
        for (int j = 0; j < 8; ++j) v[j] = w[(size_t)(k0 + j) * 1024 + n];
        return p.WdT + ((size_t)le * 1024 + n) * 256 + k0;
    }
}
__device__ __forceinline__ void p0_store(bf16_t* dst, const float (&v)[8]) {
    u32x4 w; w.x = cvt_pk_bf16(v[0], v[1]); w.y = cvt_pk_bf16(v[2], v[3]); w.z = cvt_pk_bf16(v[4], v[5]); w.w = cvt_pk_bf16(v[6], v[7]);
    *(u32x4*)dst = w;
}

__device__ __forceinline__ void phase_p0(const Params& p, char* lds) {
    const int tid = opaque_tid(p.wid), gtid = blockIdx.x * blockDim.x + tid, gthreads = gridDim.x * blockDim.x;
    for (long it0 = gtid; it0 < P0_B6; it0 += 2l * gthreads) {
        float va[8], vb[8];
        const bool hb = it0 + gthreads < P0_B6;
        bf16_t* da = p0_fetch(p, it0, va);
        bf16_t* db = hb ? p0_fetch(p, it0 + gthreads, vb) : da;
        p0_store(da, va);
        if (hb) p0_store(db, vb);
    }
    for (int it = gtid; it < 2048 * 16; it += gthreads) {
        const int pos = it >> 4, i = it & 15;
        const float inv = powf(10000.0f, -(float)i / 16.0f), ang = (float)pos * inv;
        p.ropetab[it * 2] = cosf(ang); p.ropetab[it * 2 + 1] = sinf(ang);
    }
    float* ca = (float*)lds;
    for (int i = tid; i < NB * 1024; i += 512) { const float v = p.c[i]; ca[i] = v / (1.f + __expf(-v)); }
    __syncthreads();
    for (int u = blockIdx.x; u < 2 * (NMOD / 64); u += gridDim.x) {
        const int l = u / (NMOD / 64), n = (u % (NMOD / 64)) * 64 + (tid & 63), bg = tid >> 6;
        const float* w = p.w_ada + (size_t)l * 1024 * NMOD + n;
        float acc[4] = {0.f, 0.f, 0.f, 0.f};
        for (int d0 = 0; d0 < 1024; d0 += 8) {
            float wv[8];
#pragma unroll
            for (int q = 0; q < 8; ++q) wv[q] = w[(size_t)(d0 + q) * NMOD];
#pragma unroll
            for (int q = 0; q < 8; ++q)
#pragma unroll
                for (int j = 0; j < 4; ++j) acc[j] += ca[(bg * 4 + j) * 1024 + d0 + q] * wv[q];
        }
        const float bias = p.b_ada[l * NMOD + n];
#pragma unroll
        for (int j = 0; j < 4; ++j) p.mod[((size_t)l * NB + bg * 4 + j) * NMOD + n] = acc[j] + bias;
    }
    __syncthreads();
}

template <int MODE>
__device__ __forceinline__ void phase_norm1(const Params& p, int l) {
#ifndef NORM_NT
#define NORM_NT 4
#endif
    constexpr int NT = NORM_NT;
    const int tid = opaque_tid(p.wid), w = tid >> 6, lane = tid & 63;
    const float* xin = (MODE == 0) ? p.x : p.xo;
    const float* g = (MODE == 2) ? p.g_final : p.g_norm1 + l * D;
    const float* modl = p.mod + (size_t)(MODE == 2 ? 1 : l) * NB * NMOD;
    const float* modp = p.mod + (size_t)(MODE == 2 ? 1 : (l > 0 ? l - 1 : 0)) * NB * NMOD;
    f32x4 gg4[4];
#pragma unroll
    for (int k = 0; k < 4; ++k) gg4[k] = *(const f32x4*)(g + 4 * lane + 256 * k);
    for (int t0 = (blockIdx.x * 8 + w) * NT; t0 < T; t0 += gridDim.x * 8 * NT) {
        const int b0 = t0 >> 11;
        f32x4 sc4[4], sh4[4], gt4[4];
        if (MODE != 2) {
#pragma unroll
            for (int k = 0; k < 4; ++k) { sc4[k] = *(const f32x4*)(modl + (size_t)b0 * NMOD + 1024 + 4 * lane + 256 * k); sh4[k] = *(const f32x4*)(modl + (size_t)b0 * NMOD + 4 * lane + 256 * k); }
        }
        if (MODE >= 1) {
#pragma unroll
            for (int k = 0; k < 4; ++k) gt4[k] = *(const f32x4*)(modp + (size_t)b0 * NMOD + 5 * 1024 + 4 * lane + 256 * k);
        }
        f32x4 v[NT][4];
#pragma unroll
        for (int u = 0; u < NT; ++u)
#pragma unroll
            for (int k = 0; k < 4; ++k) v[u][k] = *(const f32x4*)(xin + (size_t)(t0 + u) * D + 4 * lane + 256 * k);
        if (MODE >= 1) {
            u32x2 y0[NT][4], y1[NT][4];
#pragma unroll
            for (int u = 0; u < NT; ++u)
#pragma unroll
                for (int k = 0; k < 4; ++k) { const int col = 4 * lane + 256 * k;
                    y0[u][k] = *(const u32x2*)(p.ys + ((size_t)(t0 + u) * 2 + 0) * D + col); y1[u][k] = *(const u32x2*)(p.ys + ((size_t)(t0 + u) * 2 + 1) * D + col); }
#pragma unroll
            for (int u = 0; u < NT; ++u) {
                const int b = (t0 + u) >> 11;
#pragma unroll
                for (int k = 0; k < 4; ++k) {
                    const int col = 4 * lane + 256 * k;
                    const f32x4 gt = gt4[k];
                    v[u][k][0] += gt[0] * (bflo(y0[u][k].x) + bflo(y1[u][k].x)); v[u][k][1] += gt[1] * (bfhi(y0[u][k].x) + bfhi(y1[u][k].x));
                    v[u][k][2] += gt[2] * (bflo(y0[u][k].y) + bflo(y1[u][k].y)); v[u][k][3] += gt[3] * (bfhi(y0[u][k].y) + bfhi(y1[u][k].y));
                }
            }
        }
#pragma unroll
        for (int u = 0; u < NT; ++u) {
            const int t = t0 + u, b = t >> 11;
            float ss = 0.f;
#pragma unroll
            for (int k = 0; k < 4; ++k) ss += v[u][k][0] * v[u][k][0] + v[u][k][1] * v[u][k][1] + v[u][k][2] * v[u][k][2] + v[u][k][3] * v[u][k][3];
            ss = wave_sum(ss);
            const float r = rsqrtf(ss * (1.0f / D) + EPS);
#pragma unroll
            for (int k = 0; k < 4; ++k) {
                const int col = 4 * lane + 256 * k;
                f32x4 y = v[u][k] * r * gg4[k];
                if (MODE == 2) { *(f32x4*)(p.xo + (size_t)t * D + col) = y; }
                else {
                    if (MODE == 1) *(f32x4*)(p.xo + (size_t)t * D + col) = v[u][k];
                    y = y * (1.f + sc4[k]) + sh4[k];
                    u32x2 o; o.x = cvt_pk_bf16(y[0], y[1]); o.y = cvt_pk_bf16(y[2], y[3]);
                    *(u32x2*)(p.h + (size_t)t * D + col) = o;
                }
            }
        }
    }
}
}

namespace {
using pg8::Unit;
struct EpiStoreBf16 {
    static constexpr bool PERM = true;
    bf16_t* O; int ldc;
    __device__ __forceinline__ void operator()(const f32x4 (&acc)[2][2][4][2], const Unit& u, int wr, int wc, int fr_, int fq_) const {
        int fr = fr_, fq = fq_; asm volatile("" : "+v"(fr), "+v"(fq));
        const int row0 = u.pm * 256 + wr * 64 + fr, col0 = u.pn * 256 + wc * 32 + 8 * fq;
#pragma unroll
        for (int ai = 0; ai < 2; ++ai)
#pragma unroll
            for (int m = 0; m < 4; ++m) { bf16_t* rowp = O + (size_t)(row0 + ai * 128 + m * 16) * ldc + col0;
#pragma unroll
                for (int bj = 0; bj < 2; ++bj) { const f32x4 v0 = acc[ai][bj][m][0], v1 = acc[ai][bj][m][1];
                    u32x4 w; w.x = cvt_pk_bf16(v0[0], v0[1]); w.y = cvt_pk_bf16(v0[2], v0[3]); w.z = cvt_pk_bf16(v1[0], v1[1]); w.w = cvt_pk_bf16(v1[2], v1[3]);
                    *(u32x4*)(rowp + bj * 128) = w; } }
    }
};
struct EpiResidual {
    static constexpr bool PERM = false;
    const float* xin; float* x; const float* gate;
    __device__ __forceinline__ void operator()(const f32x4 (&acc)[2][2][4][2], const Unit& u, int wr, int wc, int fr_, int fq_) const {
        int fr = fr_, fq = fq_; asm volatile("" : "+v"(fr), "+v"(fq));
        const int row0 = u.pm * 256 + wr * 64 + fr, col0 = u.pn * 256 + wc * 32 + 4 * fq;
        const int b = (u.pm * 256) >> 11;
        f32x4 gv[2][2];
#pragma unroll
        for (int bj = 0; bj < 2; ++bj)
#pragma unroll
            for (int n = 0; n < 2; ++n) gv[bj][n] = *(const f32x4*)(gate + (size_t)b * NMOD + col0 + bj * 128 + n * 16);
#pragma unroll
        for (int ai = 0; ai < 2; ++ai)
#pragma unroll
            for (int m = 0; m < 4; ++m) { const size_t ro = (size_t)(row0 + ai * 128 + m * 16) * D + col0;
#pragma unroll
                for (int bj = 0; bj < 2; ++bj)
#pragma unroll
                    for (int n = 0; n < 2; ++n) { const size_t o = ro + bj * 128 + n * 16; *(f32x4*)(x + o) = *(const f32x4*)(xin + o) + gv[bj][n] * acc[ai][bj][m][n]; } }
    }
};
struct EpiMlaQ {
    static constexpr bool PERM = true;
    bf16_t* qm;
    __device__ __forceinline__ void operator()(const f32x4 (&acc)[2][2][4][2], const Unit& u, int wr, int wc, int fr_, int fq_) const {
        int fr = fr_, fq = fq_; asm volatile("" : "+v"(fr), "+v"(fq));
        const int row0 = u.pm * 256 + wr * 64 + fr;
#pragma unroll
        for (int bj = 0; bj < 2; ++bj) {
            const int col0 = u.pn * 256 + bj * 128 + wc * 32;
            if (col0 >= 384) continue;
#pragma unroll
            for (int ai = 0; ai < 2; ++ai)
#pragma unroll
                for (int m = 0; m < 4; ++m) { const f32x4 v0 = acc[ai][bj][m][0], v1 = acc[ai][bj][m][1];
                    u32x4 w; w.x = cvt_pk_bf16(v0[0], v0[1]); w.y = cvt_pk_bf16(v0[2], v0[3]); w.z = cvt_pk_bf16(v1[0], v1[1]); w.w = cvt_pk_bf16(v1[2], v1[3]);
                    *(u32x4*)(qm + (size_t)(row0 + ai * 128 + m * 16) * 384 + col0 + 8 * fq) = w; }
        }
    }
};
struct EpiMlaKV {
    static constexpr bool PERM = true;
    bf16_t* km; bf16_t* vm;
    __device__ __forceinline__ void operator()(const f32x4 (&acc)[2][2][4][2], const Unit& u, int wr, int wc, int fr_, int fq_) const {
        int fr = fr_, fq = fq_; asm volatile("" : "+v"(fr), "+v"(fq));
        const int row0 = u.pm * 256 + wr * 64 + fr;
#pragma unroll
        for (int bj = 0; bj < 2; ++bj) {
            const int head = u.pn * 2 + bj, wcol = wc * 32 + 8 * fq;
#pragma unroll
            for (int ai = 0; ai < 2; ++ai)
#pragma unroll
                for (int m = 0; m < 4; ++m) {
                    const int row = row0 + ai * 128 + m * 16;
                    const f32x4 v0 = acc[ai][bj][m][0], v1 = acc[ai][bj][m][1];
                    u32x4 w; w.x = cvt_pk_bf16(v0[0], v0[1]); w.y = cvt_pk_bf16(v0[2], v0[3]); w.z = cvt_pk_bf16(v1[0], v1[1]); w.w = cvt_pk_bf16(v1[2], v1[3]);
                    bf16_t* q = (wcol < 64) ? km + (size_t)row * 384 + head * 96 + wcol : vm + (size_t)row * 256 + head * 64 + (wcol - 64);
                    *(u32x4*)q = w;
                    asm volatile("" ::: "memory");
                }
        }
    }
};
struct EpiGateUp {
    static constexpr bool PERM = false;
    bf16_t* hid;
    __device__ __forceinline__ void operator()(const f32x4 (&acc)[2][2][4][2], const Unit& u, int wr, int wc, int fr_, int fq_) const {
        int fr = fr_, fq = fq_; asm volatile("" : "+v"(fr), "+v"(fq));
        const int row0 = u.pm * 256 + wr * 64 + fr;
#pragma unroll
        for (int ai = 0; ai < 2; ++ai)
#pragma unroll
            for (int m = 0; m < 4; ++m) { bf16_t* rowp = hid + (size_t)(row0 + ai * 128 + m * 16) * 256;
#pragma unroll
                for (int bj = 0; bj < 2; ++bj) { const f32x4 gt = acc[ai][bj][m][0], up = acc[ai][bj][m][1];
                    f32x4 o;
#pragma unroll
                    for (int j = 0; j < 4; ++j) o[j] = gt[j] / (1.f + __expf(-gt[j])) * up[j];
                    u32x2 w; w.x = cvt_pk_bf16(o[0], o[1]); w.y = cvt_pk_bf16(o[2], o[3]);
                    *(u32x2*)(rowp + 16 * (u.pn * 8 + bj * 4 + wc) + 4 * fq) = w; } }
    }
};
struct EpiDown {
    static constexpr bool PERM = true;
    bf16_t* ys; const int* list; const float* wl; const int* cnt;
    __device__ __forceinline__ void operator()(const f32x4 (&acc)[2][2][4][2], const Unit& u, int wr, int wc, int fr_, int fq_) const {
        int fr = fr_, fq = fq_; asm volatile("" : "+v"(fr), "+v"(fq));
        const int n = cnt[u.e]; const int* le = list + (size_t)u.e * ECAP; const float* we = wl + (size_t)u.e * ECAP;
        const int col0 = u.pn * 256 + wc * 32 + 8 * fq;
        int slot[8]; float w8[8];
#pragma unroll
        for (int q = 0; q < 8; ++q) { const int lr = u.mt * 256 + (q >> 2) * 128 + wr * 64 + (q & 3) * 16 + fr; slot[q] = lr < n ? le[lr] : -1; w8[q] = lr < n ? we[lr] : 0.f; }
#pragma unroll
        for (int ai = 0; ai < 2; ++ai)
#pragma unroll
            for (int m = 0; m < 4; ++m) {
                const int q = ai * 4 + m;
                if (slot[q] >= 0) {
                    bf16_t* rowp = ys + (size_t)slot[q] * D + col0;
#pragma unroll
                    for (int bj = 0; bj < 2; ++bj) { const f32x4 v0 = acc[ai][bj][m][0] * w8[q], v1 = acc[ai][bj][m][1] * w8[q];
                        u32x4 w; w.x = cvt_pk_bf16(v0[0], v0[1]); w.y = cvt_pk_bf16(v0[2], v0[3]); w.z = cvt_pk_bf16(v1[0], v1[1]); w.w = cvt_pk_bf16(v1[2], v1[3]);
                        *(u32x4*)(rowp + bj * 128) = w; }
                }
            }
    }
};
struct MoeOrder {
    int pre[17];
    int NT, G, c; const int* list; const int* cnt;
    __device__ __forceinline__ void init(const int* cnt_, const int* list_, int NT_, int G_, int c_) {
        cnt = cnt_; list = list_; NT = NT_; G = G_; c = c_; int a = 0;
#pragma unroll
        for (int e = 0; e < 16; ++e) { pre[e] = a; a += (cnt_[e] + 255) >> 8; }
        pre[16] = a;
    }
    __device__ __forceinline__ bool next(int i, Unit& u) const {
        const int L = i * G + c; if (L >= pre[16] * NT) return false;
        const int t = L / NT; int e = 0;
#pragma unroll
        for (int k = 1; k < 16; ++k) e += (t >= pre[k]) ? 1 : 0;
        int pe = 0;
#pragma unroll
        for (int k = 0; k < 16; ++k) pe = (k == e) ? pre[k] : pe;
        u.e = e; u.mt = t - pe; u.pm = t; u.pn = L - t * NT; return true;
    }
    __device__ __forceinline__ int arow(const Unit& u, int r) const { const int lr = u.mt * 256 + r; return lr < cnt[u.e] ? (list[(size_t)u.e * ECAP + lr] >> 1) : 0; }
};
}

namespace {
__device__ __forceinline__ void phase_prep(const Params& p, int l) {
    const int tid = opaque_tid(p.wid), w = tid >> 6, lane = tid & 63;
    const int gw = blockIdx.x * 8 + w, nw = gridDim.x * 8;
    for (int sq = gw; sq < NB * 4; sq += nw) {
        const int b = sq >> 2, hh = sq & 3; const float bias = p.b_forget[l * 4 + hh];
        float lf[32]; float run = 0.f;
#pragma unroll
        for (int j = 0; j < 32; ++j) {
            const float z = bf2f(p.proj[(size_t)(b * S + lane * 32 + j) * NP + PC_AF + hh]) + bias;
            run += fminf(z, 0.f) - log1pf(__expf(-fabsf(z)));
            lf[j] = run;
        }
        float incl = run;
#pragma unroll
        for (int o = 1; o < 64; o <<= 1) { const float t2 = __shfl_up(incl, o); if (lane >= o) incl += t2; }
        const float excl = incl - run;
#pragma unroll
        for (int j = 0; j < 32; ++j) p.cbF[(size_t)sq * S + lane * 32 + j] = -(excl + lf[j]) * LOG2E;
    }
    for (int t = gw; t < T; t += nw) {
        const bf16_t* row = p.proj + (size_t)t * NP;
        const u32x2 cq = *(const u32x2*)(row + PC_BCQ + 4 * lane);
        const unsigned ck = *(const unsigned*)(row + PC_BCKV + 2 * lane);
        float s1 = bflo(cq.x) * bflo(cq.x) + bfhi(cq.x) * bfhi(cq.x) + bflo(cq.y) * bflo(cq.y) + bfhi(cq.y) * bfhi(cq.y);
        float s2 = bflo(ck) * bflo(ck) + bfhi(ck) * bfhi(ck);
        s1 = wave_sum(s1); s2 = wave_sum(s2);
        const float kr = (lane < 32) ? bf2f(row[PC_BKR + lane]) : 0.f;
        const float kr2 = __shfl(kr, (lane + 16) & 63);
        {
            const float r1 = rsqrtf(s1 * (1.f / 256.f) + EPS), r2 = rsqrtf(s2 * (1.f / 128.f) + EPS);
            u32x2 o; o.x = cvt_pk_bf16(bflo(cq.x) * r1, bfhi(cq.x) * r1); o.y = cvt_pk_bf16(bflo(cq.y) * r1, bfhi(cq.y) * r1);
            *(u32x2*)(p.proj + (size_t)t * NP + PC_BCQ + 4 * lane) = o;
            *(unsigned*)(p.proj + (size_t)t * NP + PC_BCKV + 2 * lane) = cvt_pk_bf16(bflo(ck) * r2, bfhi(ck) * r2);
        }
        if (lane < 16) {
            const int pos = t & (S - 1);
            const float cs = p.ropetab[(pos * 16 + lane) * 2], sn = p.ropetab[(pos * 16 + lane) * 2 + 1];
            const bf16_t o1 = f2bf(kr * cs - kr2 * sn), o2 = f2bf(kr2 * cs + kr * sn);
            bf16_t* kmr = p.km + (size_t)t * 384;
#pragma unroll
            for (int hh = 0; hh < 4; ++hh) { kmr[hh * 96 + 64 + lane] = o1; kmr[hh * 96 + 80 + lane] = o2; }
        }
    }
}

__device__ __forceinline__ void phase_route(const Params& p, int l, char* lds) {
    const int tid = opaque_tid(p.wid), w = tid >> 6, lane = tid & 63;
    float* wrT = (float*)lds;
    int* lcnt = (int*)(lds + 65536);
    int* lbase = (int*)(lds + 65536 + 64);
    int* tsel = (int*)(lds + 65536 + 128);
    float* twt = (float*)(lds + 65536 + 128 + 2048);
    for (int i = tid; i < 16 * 1024; i += 512) { const int e = i >> 10, d = i & 1023; wrT[i] = p.w_router[d * 16 + e]; }
    const float* g = p.g_norm2 + l * D;
    const float* modl = p.mod + (size_t)l * NB * NMOD;
    int* cnt = (int*)(p.ctl + CW_CNT) + l * 16 + 32 * p.qslot;
    int* list = p.list + (size_t)p.qslot * 16 * ECAP;
    for (int chunk = blockIdx.x; chunk < T / 256; chunk += gridDim.x) {
        if (tid < 16) lcnt[tid] = 0;
        __syncthreads();
        const int b = (chunk * 256) >> 11;
        f32x4 gg4[4], sc4[4], sh4[4];
#pragma unroll
        for (int k = 0; k < 4; ++k) { const int col = 4 * lane + 256 * k; gg4[k] = *(const f32x4*)(g + col);
            sc4[k] = *(const f32x4*)(modl + (size_t)b * NMOD + 4 * 1024 + col); sh4[k] = *(const f32x4*)(modl + (size_t)b * NMOD + 3 * 1024 + col); }
        const int eown = ((lane >> 5) & 1) * 8 + ((lane >> 4) & 1) * 4 + ((lane >> 3) & 1) * 2 + ((lane >> 2) & 1);
        const float brown = p.b_router[eown];
        f32x4 vn[4];
#pragma unroll
        for (int k = 0; k < 4; ++k) vn[k] = *(const f32x4*)(p.xo + (size_t)(chunk * 256 + w * 32) * D + 4 * lane + 256 * k);
        for (int it = 0; it < 32; ++it) {
            const int li = w * 32 + it, t = chunk * 256 + li;
            f32x4 v[4];
#pragma unroll
            for (int k = 0; k < 4; ++k) v[k] = vn[k];
            if (it < 31) {
#pragma unroll
                for (int k = 0; k < 4; ++k) vn[k] = *(const f32x4*)(p.xo + (size_t)(t + 1) * D + 4 * lane + 256 * k);
            }
            float ss = 0.f;
#pragma unroll
            for (int k = 0; k < 4; ++k) ss += v[k][0] * v[k][0] + v[k][1] * v[k][1] + v[k][2] * v[k][2] + v[k][3] * v[k][3];
            ss = wave_sum(ss);
            const float r = rsqrtf(ss * (1.0f / D) + EPS);
            float lg[16];
#pragma unroll
            for (int e = 0; e < 16; ++e) lg[e] = 0.f;
#pragma unroll
            for (int k = 0; k < 4; ++k) {
                const int col = 4 * lane + 256 * k;
                const f32x4 y = v[k] * r * gg4[k] * (1.f + sc4[k]) + sh4[k];
                u32x2 o; o.x = cvt_pk_bf16(y[0], y[1]); o.y = cvt_pk_bf16(y[2], y[3]);
                *(u32x2*)(p.h + (size_t)t * D + col) = o;
#pragma unroll
                for (int e = 0; e < 16; ++e) { const f32x4 wv = *(const f32x4*)(wrT + e * 1024 + col); lg[e] += y[0] * wv[0] + y[1] * wv[1] + y[2] * wv[2] + y[3] * wv[3]; }
                asm volatile("" ::: "memory");
            }
            float a8[8], a4[4], a2[2], a1;
            { const bool hi = (lane & 32) != 0;
#pragma unroll
              for (int e = 0; e < 8; ++e) { const float send = hi ? lg[e] : lg[e + 8], keep = hi ? lg[e + 8] : lg[e]; a8[e] = keep + __shfl_xor(send, 32); } }
            { const bool hi = (lane & 16) != 0;
#pragma unroll
              for (int e = 0; e < 4; ++e) { const float send = hi ? a8[e] : a8[e + 4], keep = hi ? a8[e + 4] : a8[e]; a4[e] = keep + __shfl_xor(send, 16); } }
            { const bool hi = (lane & 8) != 0;
#pragma unroll
              for (int e = 0; e < 2; ++e) { const float send = hi ? a4[e] : a4[e + 2], keep = hi ? a4[e + 2] : a4[e]; a2[e] = keep + __shfl_xor(send, 8); } }
            { const bool hi = (lane & 4) != 0; const float send = hi ? a2[0] : a2[1], keep = hi ? a2[1] : a2[0]; a1 = keep + __shfl_xor(send, 4); }
            a1 += __shfl_xor(a1, 2); a1 += __shfl_xor(a1, 1);
            const float sown = 1.f / (1.f + expf(-a1)), bown = sown + brown;
            float sc[16], bi[16];
#pragma unroll
            for (int e = 0; e < 16; ++e) { const int src = ((e >> 3) & 1) * 32 + ((e >> 2) & 1) * 16 + ((e >> 1) & 1) * 8 + (e & 1) * 4;
                sc[e] = __builtin_bit_cast(float, __builtin_amdgcn_readlane(__builtin_bit_cast(int, sown), src));
                bi[e] = __builtin_bit_cast(float, __builtin_amdgcn_readlane(__builtin_bit_cast(int, bown), src)); }
            int bg = 0; float bgs = -INFINITY;
#pragma unroll
            for (int gi = 0; gi < 4; ++gi) {
                float m1 = -INFINITY, m2 = -INFINITY;
#pragma unroll
                for (int j = 0; j < 4; ++j) { const float vv = bi[gi * 4 + j]; if (vv > m1) { m2 = m1; m1 = vv; } else if (vv > m2) m2 = vv; }
                const float gs = m1 + m2; if (gs > bgs) { bgs = gs; bg = gi; }
            }
            float b4[4], s4[4];
#pragma unroll
            for (int gi = 0; gi < 4; ++gi)
#pragma unroll
                for (int j = 0; j < 4; ++j) if (gi == bg) { b4[j] = bi[gi * 4 + j]; s4[j] = sc[gi * 4 + j]; }
            int i1 = 0; float v1 = -INFINITY;
#pragma unroll
            for (int j = 0; j < 4; ++j) { if (b4[j] > v1) { v1 = b4[j]; i1 = j; } }
            int i2 = 0; float v2 = -INFINITY;
#pragma unroll
            for (int j = 0; j < 4; ++j) { if (j != i1 && b4[j] > v2) { v2 = b4[j]; i2 = j; } }
            float w1 = 0.f, w2 = 0.f;
#pragma unroll
            for (int j = 0; j < 4; ++j) { if (j == i1) w1 = s4[j]; if (j == i2) w2 = s4[j]; }
            if (lane == 0) {
                const int e1 = bg * 4 + i1, e2 = bg * 4 + i2; const float ws = w1 + w2;
                const int r1 = atomicAdd(&lcnt[e1], 1), r2 = atomicAdd(&lcnt[e2], 1);
                tsel[li * 2 + 0] = (e1 << 16) | r1; tsel[li * 2 + 1] = (e2 << 16) | r2;
                twt[li * 2 + 0] = w1 / ws; twt[li * 2 + 1] = w2 / ws;
            }
        }
        __syncthreads();
        if (tid < 16) lbase[tid] = atomicAdd(&cnt[tid], lcnt[tid]);
        __syncthreads();
        { const int v = tsel[tid], e = v >> 16, rk = v & 0xFFFF; const size_t pos = (size_t)e * ECAP + lbase[e] + rk;
          list[pos] = (chunk * 256 + (tid >> 1)) * 2 + (tid & 1); p.wl[pos + (size_t)p.qslot * 16 * ECAP] = twt[tid]; }
        __syncthreads();
    }
}
}

#ifndef ATTN_VMASK
#define ATTN_VMASK 15
#endif
#ifndef REPK_VMASK
#define REPK_VMASK 15
#endif
namespace {
constexpr int AT_KB = 0;
constexpr int AT_KR = 16384;
constexpr int AT_VB = 24576;
constexpr int AT_CB = 40960;
constexpr int AT_CTL = 41472;
constexpr int AT_LDS = 41984;
constexpr float NEGBIG = -1.0e30f;

template <int VAR, int KC>
__device__ __forceinline__ void attn_tile(LAS3 char* lds, const int buf, const int j, const int q0, const int i, const int g, const int swk, const float slope2,
                                          const bf16x8 (&qf)[2][KC], f32x4 (&o)[2][4], float (&mrow)[2], float (&lsum)[2], const u32x2 (&mw)[2]) {
    typedef LAS3 bf16x4 lds_bf16x4;
    bool need = (64 * j <= q0 + 31);
    if (VAR == 2) need = need && (64 * j + 63 >= q0 - 127);
    if (need) {
        const LAS3 char* Kb = lds + AT_KB + buf * 8192; const LAS3 char* Vb = lds + AT_VB + buf * 8192;
        bool full = (64 * j + 63 <= q0);
        if (VAR == 2) full = full && (64 * j >= q0 - 96);
        if (VAR == 3) full = false;
        f32x4 s[2][4];
#pragma unroll
        for (int qt = 0; qt < 2; ++qt) {
            const int t = q0 + 16 * qt + i;
            const int dbase = 64 * j + 4 * g - t;
            const float sb = slope2 * ((VAR == 2) ? (float)dbase : (float)(64 * j + 4 * g));
            unsigned wl = 0u, wh = 0u;
            if (VAR == 3) { const unsigned long long W = (((unsigned long long)mw[qt].y << 32) | mw[qt].x) >> (4 * g); wl = (unsigned)W; wh = (unsigned)(W >> 32); }
#pragma unroll
            for (int mt = 0; mt < 4; ++mt) {
                f32x4 ini = {0.f, 0.f, 0.f, 0.f};
                if (VAR == 0) ini = *(const LAS3 f32x4*)(lds + AT_CB + buf * 256 + (16 * mt + 4 * g) * 4);
#pragma unroll
                for (int r = 0; r < 4; ++r) {
                    const int c = 16 * mt + r;
                    float v = ini[r];
                    if (VAR >= 2) v = sb + slope2 * (float)c;
                    if (VAR == 3) {
                        const int m = ((int)((mt < 2 ? wl : wh) << (31 - (16 * (mt & 1) + r)))) >> 31;
                        v = __uint_as_float((__float_as_uint(v) & (unsigned)m) | (__float_as_uint(NEGBIG) & ~(unsigned)m));
                    } else if (!full) {
                        bool ok;
                        if (VAR == 2) ok = (unsigned)(dbase + c + 127) < 128u;
                        else ok = (dbase + c) <= 0;
                        v = ok ? v : NEGBIG;
                    }
                    ini[r] = v;
                }
                s[qt][mt] = ini;
            }
        }
#pragma unroll
        for (int mt = 0; mt < 4; ++mt) {
#pragma unroll
            for (int kc = 0; kc < 2; ++kc) {
                const bf16x8 kf = *(const LAS3 bf16x8*)(Kb + (mt * 16 + i) * 128 + (((kc * 4 + g) ^ swk) << 4));
                s[0][mt] = __builtin_amdgcn_mfma_f32_16x16x32_bf16(kf, qf[0][kc], s[0][mt], 0, 0, 0);
                s[1][mt] = __builtin_amdgcn_mfma_f32_16x16x32_bf16(kf, qf[1][kc], s[1][mt], 0, 0, 0);
            }
            if (VAR == 1) {
                const bf16x8 kf = *(const LAS3 bf16x8*)(lds + AT_KR + buf * 4096 + (mt * 16 + i) * 64 + ((g ^ (swk & 3)) << 4));
                s[0][mt] = __builtin_amdgcn_mfma_f32_16x16x32_bf16(kf, qf[0][KC - 1], s[0][mt], 0, 0, 0);
                s[1][mt] = __builtin_amdgcn_mfma_f32_16x16x32_bf16(kf, qf[1][KC - 1], s[1][mt], 0, 0, 0);
            }
        }
        bf16x8 pf[2][2];
#pragma unroll
        for (int qt = 0; qt < 2; ++qt) {
            float mx = fmaxf(fmaxf(s[qt][0][0], s[qt][0][1]), fmaxf(s[qt][0][2], s[qt][0][3]));
#pragma unroll
            for (int mt = 1; mt < 4; ++mt) mx = fmaxf(mx, fmaxf(fmaxf(s[qt][mt][0], s[qt][mt][1]), fmaxf(s[qt][mt][2], s[qt][mt][3])));
            mx = fmaxf(mx, __builtin_bit_cast(float, __builtin_amdgcn_ds_swizzle(__builtin_bit_cast(int, mx), 0x401F)));
            mx = xor32_max(mx);
            if (__any(mx > mrow[qt])) {
                const float mn = fmaxf(mrow[qt], mx), alpha = __builtin_amdgcn_exp2f(mrow[qt] - mn);
                mrow[qt] = mn; lsum[qt] *= alpha;
#pragma unroll
                for (int dt = 0; dt < 4; ++dt) o[qt][dt] = o[qt][dt] * alpha;
            }
            const float mn = mrow[qt];
            float ps = 0.f;
            float x[4][4];
#pragma unroll
            for (int mt = 0; mt < 4; ++mt)
#pragma unroll
                for (int r = 0; r < 4; ++r) { x[mt][r] = __builtin_amdgcn_exp2f(s[qt][mt][r] - mn); ps += x[mt][r]; }
            lsum[qt] += ps;
#pragma unroll
            for (int c = 0; c < 2; ++c) {
                u32x4 pk; pk.x = cvt_pk_bf16(x[2 * c][0], x[2 * c][1]); pk.y = cvt_pk_bf16(x[2 * c][2], x[2 * c][3]);
                pk.z = cvt_pk_bf16(x[2 * c + 1][0], x[2 * c + 1][1]); pk.w = cvt_pk_bf16(x[2 * c + 1][2], x[2 * c + 1][3]);
                pf[qt][c] = __builtin_bit_cast(bf16x8, pk);
            }
        }
        const int q4 = i >> 2, p4 = i & 3;
#pragma unroll
        for (int c = 0; c < 2; ++c) {
            const int row0 = 32 * c + 4 * g + q4, swv = (row0 >> 1) & 3;
#pragma unroll
            for (int dt = 0; dt < 4; ++dt) {
                const LAS3 char* a0 = Vb + row0 * 128 + ((dt ^ swv) << 5) + p4 * 8;
                const bf16x4 v0 = __builtin_amdgcn_ds_read_tr16_b64_v4i16((lds_bf16x4*)(a0));
                const bf16x4 v1 = __builtin_amdgcn_ds_read_tr16_b64_v4i16((lds_bf16x4*)(a0 + 16 * 128));
                const bf16x8 vf = {v0[0], v0[1], v0[2], v0[3], v1[0], v1[1], v1[2], v1[3]};
                o[0][dt] = __builtin_amdgcn_mfma_f32_16x16x32_bf16(vf, pf[0][c], o[0][dt], 0, 0, 0);
                o[1][dt] = __builtin_amdgcn_mfma_f32_16x16x32_bf16(vf, pf[1][c], o[1][dt], 0, 0, 0);
            }
        }
    }
}

template <int VAR>
__device__ __forceinline__ void attn_unit(const Params& p, int l, int b, int hx, int qb, LAS3 char* lds) {
    typedef LAS3 bf16x4 lds_bf16x4;
    constexpr int KC = (VAR == 1) ? 3 : 2;
    const int tid = opaque_tid(p.wid), w = __builtin_amdgcn_readfirstlane(tid >> 6), lane = tid & 63, i = lane & 15, g = lane >> 4;
    const bf16_t *Qp, *Kp, *Vp; int ldq, ldk, ldv, q0, j0, j1, ocol; float c1, slope2 = 0.f;
    if (VAR == 0) { Qp = p.proj + PC_AQ + hx * 64; Kp = p.proj + PC_AK + hx * 64; Vp = p.proj + PC_AV + hx * 64; ldq = ldk = ldv = NP;
                    q0 = qb * 256 + 32 * w; j0 = 0; j1 = 4 * qb + 3; ocol = hx * 64; c1 = 0.125f * LOG2E; }
    else if (VAR == 1) { Qp = p.qm + hx * 96; Kp = p.km + hx * 96; Vp = p.vm + hx * 64; ldq = 384; ldk = 384; ldv = 256;
                    q0 = qb * 256 + 32 * w; j0 = 0; j1 = 4 * qb + 3; ocol = 256 + hx * 64; c1 = 0.10206207261596577f * LOG2E; }
    else if (VAR == 2) { const int qh = hx * 2 + (w >> 2); Qp = p.proj + PC_CQ + qh * 64; Kp = p.proj + PC_CK + hx * 64; Vp = p.proj + PC_CV + hx * 64; ldq = ldk = ldv = NP;
                    q0 = qb * 128 + 32 * (w & 3); j0 = 2 * qb - 2 > 0 ? 2 * qb - 2 : 0; j1 = 2 * qb + 1; ocol = 512 + qh * 64; c1 = 0.125f * LOG2E;
                    slope2 = exp2f(-(float)(qh + 1)) * LOG2E; }
    else { const int hd = w >> 1; Qp = p.proj + PC_DQ + hd * 64; Kp = p.proj + PC_DK; Vp = p.proj + PC_DV; ldq = ldk = ldv = NP;
                    q0 = qb * 64 + 32 * (w & 1); j0 = 0; j1 = qb; ocol = 768 + hd * 64; c1 = 0.125f * LOG2E; slope2 = exp2f(-(float)(hd + 5)) * LOG2E; }
    const size_t tok0 = (size_t)b * S;
    bf16x8 qf[2][KC];
#pragma unroll
    for (int qt = 0; qt < 2; ++qt)
#pragma unroll
        for (int kc = 0; kc < KC; ++kc) qf[qt][kc] = *(const bf16x8*)(Qp + (tok0 + q0 + 16 * qt + i) * ldq + kc * 32 + 8 * g);
    if (VAR == 1) {
#pragma unroll
        for (int qt = 0; qt < 2; ++qt) {
            const int pos = q0 + 16 * qt + i;
            const u32x4 mine = __builtin_bit_cast(u32x4, qf[qt][KC - 1]);
            u32x4 oth; oth.x = __shfl_xor(mine.x, 32); oth.y = __shfl_xor(mine.y, 32); oth.z = __shfl_xor(mine.z, 32); oth.w = __shfl_xor(mine.w, 32);
            const float* rt = p.ropetab + (size_t)(pos * 16 + (g & 1) * 8) * 2;
            const float sg = (g < 2) ? -1.f : 1.f;
            u32x4 res;
#pragma unroll
            for (int e2 = 0; e2 < 4; ++e2) {
                const f32x4 cs = *(const f32x4*)(rt + e2 * 4);
                const unsigned mw_ = e2 == 0 ? mine.x : e2 == 1 ? mine.y : e2 == 2 ? mine.z : mine.w, ow_ = e2 == 0 ? oth.x : e2 == 1 ? oth.y : e2 == 2 ? oth.z : oth.w;
                const float r0 = bflo(mw_) * cs[0] + sg * bflo(ow_) * cs[1], r1 = bfhi(mw_) * cs[2] + sg * bfhi(ow_) * cs[3];
                const unsigned pk = cvt_pk_bf16(r0, r1);
                if (e2 == 0) res.x = pk; else if (e2 == 1) res.y = pk; else if (e2 == 2) res.z = pk; else res.w = pk;
            }
            qf[qt][KC - 1] = __builtin_bit_cast(bf16x8, res);
        }
    }
#pragma unroll
    for (int qt = 0; qt < 2; ++qt)
#pragma unroll
        for (int kc = 0; kc < KC; ++kc) {
            u32x4 qq = __builtin_bit_cast(u32x4, qf[qt][kc]);
            qq.x = cvt_pk_bf16(bflo(qq.x) * c1, bfhi(qq.x) * c1); qq.y = cvt_pk_bf16(bflo(qq.y) * c1, bfhi(qq.y) * c1);
            qq.z = cvt_pk_bf16(bflo(qq.z) * c1, bfhi(qq.z) * c1); qq.w = cvt_pk_bf16(bflo(qq.w) * c1, bfhi(qq.w) * c1);
            qf[qt][kc] = __builtin_bit_cast(bf16x8, qq);
        }
    f32x4 o[2][4];
#pragma unroll
    for (int qt = 0; qt < 2; ++qt)
#pragma unroll
        for (int dt = 0; dt < 4; ++dt) o[qt][dt] = (f32x4){0.f, 0.f, 0.f, 0.f};
    float mrow[2] = {NEGBIG, NEGBIG}, lsum[2] = {0.f, 0.f};
    const int sr = tid >> 3, sc8 = tid & 7;
    const int kdst = sr * 128 + ((sc8 ^ ((sr >> 1) & 7)) << 4);
    const int vdst = sr * 128 + (((((sc8 >> 1) ^ ((sr >> 1) & 3)) << 1) | (sc8 & 1)) << 4);
    const int rr = (tid & 255) >> 2, rc4 = tid & 3;
    const int rdst = rr * 64 + ((rc4 ^ ((rr >> 1) & 3)) << 4);
    u32x4 kstA, vstA, rstA = {0u, 0u, 0u, 0u}, kstB, vstB, rstB = {0u, 0u, 0u, 0u}; float cstA = 0.f, cstB = 0.f;
    u32x2 mw[2] = {{0u, 0u}, {0u, 0u}}, mwnA[2] = {{0u, 0u}, {0u, 0u}}, mwnB[2] = {{0u, 0u}, {0u, 0u}};
#define AT_LOAD(ZZ, j) do { const size_t _kr = tok0 + 64 * (j) + sr; \
        kst##ZZ = *(const u32x4*)(Kp + _kr * ldk + sc8 * 8); vst##ZZ = *(const u32x4*)(Vp + _kr * ldv + sc8 * 8); \
        if (VAR == 1 && tid < 256) rst##ZZ = *(const u32x4*)(Kp + (tok0 + 64 * (j) + rr) * ldk + 64 + rc4 * 8); \
        if (VAR == 0 && tid < 64) cst##ZZ = p.cbF[((size_t)b * 4 + hx) * S + 64 * (j) + tid]; \
        if (VAR == 3) { _Pragma("unroll") for (int _q = 0; _q < 2; ++_q) mwn##ZZ[_q] = *(const u32x2*)(p.mask + (tok0 + q0 + 16 * _q + i) * 64 + 2 * (j)); } } while (0)
#define AT_WRITE(ZZ, buf) do { *(LAS3 u32x4*)(lds + AT_KB + (buf) * 8192 + kdst) = kst##ZZ; *(LAS3 u32x4*)(lds + AT_VB + (buf) * 8192 + vdst) = vst##ZZ; \
        if (VAR == 1 && tid < 256) *(LAS3 u32x4*)(lds + AT_KR + (buf) * 4096 + rdst) = rst##ZZ; \
        if (VAR == 0 && tid < 64) *(LAS3 float*)(lds + AT_CB + (buf) * 256 + tid * 4) = cst##ZZ; \
        if (VAR == 3) { mw[0] = mwn##ZZ[0]; mw[1] = mwn##ZZ[1]; } } while (0)
    AT_LOAD(A, j0);
    if (j0 + 1 <= j1) AT_LOAD(B, j0 + 1);
    AT_WRITE(A, j0 & 1);
    __syncthreads();
    const int swk = (i >> 1) & 7;
    for (int j = j0; j <= j1; j += 2) {
        if (j + 2 <= j1) AT_LOAD(A, j + 2);
        attn_tile<VAR, KC>(lds, j & 1, j, q0, i, g, swk, slope2, qf, o, mrow, lsum, mw);
        if (j + 1 <= j1) AT_WRITE(B, (j + 1) & 1);
        __syncthreads();
        if (j + 1 > j1) break;
        if (j + 3 <= j1) AT_LOAD(B, j + 3);
        attn_tile<VAR, KC>(lds, (j + 1) & 1, j + 1, q0, i, g, swk, slope2, qf, o, mrow, lsum, mw);
        if (j + 2 <= j1) AT_WRITE(A, j & 1);
        __syncthreads();
    }
#undef AT_LOAD
#undef AT_WRITE
#pragma unroll
    for (int qt = 0; qt < 2; ++qt) {
        float lt = lsum[qt]; lt += __shfl_xor(lt, 16); lt += __shfl_xor(lt, 32);
        if (VAR == 2) lt += __builtin_amdgcn_exp2f(p.sinks[l * 4 + hx * 2 + (w >> 2)] * LOG2E - mrow[qt]);
        const float inv = 1.f / lt;
        bf16_t* op = p.merged + (tok0 + q0 + 16 * qt + i) * D + ocol + 4 * g;
#pragma unroll
        for (int dt = 0; dt < 4; ++dt) { const f32x4 v = o[qt][dt] * inv; u32x2 w2; w2.x = cvt_pk_bf16(v[0], v[1]); w2.y = cvt_pk_bf16(v[2], v[3]); *(u32x2*)(op + 16 * dt) = w2; }
    }
}

__device__ __forceinline__ void phase_attn(const Params& p, int l, LAS3 char* lds) {
    const int tid = opaque_tid(p.wid);
    unsigned* qhead = p.ctl + CW_QA + 64 * (l + 2 * p.qslot);
    volatile LAS3 int* bc = (volatile LAS3 int*)(lds + AT_CTL);
    int nxt = 0;
    if (tid == 0) nxt = (int)__hip_atomic_fetch_add(qhead, 1u, __ATOMIC_RELAXED, __HIP_MEMORY_SCOPE_AGENT);
    for (;;) {
        if (tid == 0) *bc = nxt;
        __syncthreads();
        const int idx = __builtin_amdgcn_readfirstlane(*bc);
        __syncthreads();
        if (idx >= 4096) break;
        if (tid == 0) nxt = (int)__hip_atomic_fetch_add(qhead, 1u, __ATOMIC_RELAXED, __HIP_MEMORY_SCOPE_AGENT);
        const int vmask = p.qslot ? REPK_VMASK : ATTN_VMASK;
        if (idx < 3072) {
            const int lvl = 7 - idx / 384, rem = idx % 384;
            if (rem < 128) { if (vmask & 2) attn_unit<1>(p, l, rem >> 2, rem & 3, lvl, lds); }
            else if (rem < 256) { if (vmask & 1) attn_unit<0>(p, l, (rem - 128) >> 2, rem & 3, lvl, lds); }
            else { const int d = rem - 256; if (vmask & 8) attn_unit<3>(p, l, d & 31, 0, 4 * lvl + 3 - (d >> 5), lds); }
        } else { const int c = idx - 3072; if (vmask & 4) attn_unit<2>(p, l, c >> 5, (c >> 4) & 1, c & 15, lds); }
    }
}
}

namespace {
constexpr int DS_LD = 2052;
constexpr int DS_CTL = 16 * DS_LD * 4;
constexpr int DS_LDS = DS_CTL + 64;

__device__ __forceinline__ void dsa_unit(const Params& p, int u, LAS3 char* lds) {
    const int tid = opaque_tid(p.wid), w = __builtin_amdgcn_readfirstlane(tid >> 6), lane = tid & 63, i = lane & 15, g = lane >> 4;
    const int b = u >> 7, t0 = (u & 127) * 16;
    const size_t tok0 = (size_t)b * S;
    uint32_t* mbase = p.mask + (tok0 + t0) * 64;
    if (t0 + 16 <= 256) {
#pragma unroll
        for (int qq = 0; qq < 2; ++qq) {
            const int q = 2 * w + qq, n = t0 + q + 1;
            if (lane < 32) { const int lo = lane * 64; unsigned long long bits = (n >= lo + 64) ? ~0ull : (n <= lo ? 0ull : ((1ull << (n - lo)) - 1ull));
                u32x2 o; o.x = (unsigned)bits; o.y = (unsigned)(bits >> 32); *(u32x2*)(mbase + q * 64 + 2 * lane) = o; }
        }
        return;
    }
    const int nreg = (t0 + 16 + 63) >> 6;
    const int ntile = nreg * 4;
    bf16x8 qf[8]; float wq[8];
    {
        const bf16_t* qrow = p.proj + (tok0 + t0 + i) * NP;
#pragma unroll
        for (int h = 0; h < 8; ++h) qf[h] = *(const bf16x8*)(qrow + PC_DQI + h * 32 + 8 * g);
        const u32x4 ww = *(const u32x4*)(qrow + PC_DWI);
        const float sc = 0.35355339059327373f * 0.17677669529663687f;
        wq[0] = bflo(ww.x) * sc; wq[1] = bfhi(ww.x) * sc; wq[2] = bflo(ww.y) * sc; wq[3] = bfhi(ww.y) * sc;
        wq[4] = bflo(ww.z) * sc; wq[5] = bfhi(ww.z) * sc; wq[6] = bflo(ww.w) * sc; wq[7] = bfhi(ww.w) * sc;
    }
    const int tq = t0 + i;
#ifndef DSA_EXP
#define DSA_EXP 0
#endif
    const bool exp_skip_score = (DSA_EXP == 2) && p.qslot > 0, exp_skip_sel = (DSA_EXP == 1) && p.qslot > 0, exp_nostore = (DSA_EXP != 0) && p.qslot > 0;
    if (!exp_skip_score)
    for (int base = w; base < ntile; base += 32) {
        bf16x8 kf4[4];
#pragma unroll
        for (int uu = 0; uu < 4; ++uu) { const int kt = base + 8 * uu; if (kt < ntile) kf4[uu] = *(const bf16x8*)(p.proj + (tok0 + 16 * kt + i) * NP + PC_DKI + 8 * g); }
#pragma unroll
        for (int uu = 0; uu < 4; ++uu) {
            const int kt = base + 8 * uu;
            if (kt < ntile) {
                f32x4 sc4 = {0.f, 0.f, 0.f, 0.f};
#pragma unroll
                for (int h = 0; h < 8; ++h) {
                    const f32x4 c = __builtin_amdgcn_mfma_f32_16x16x32_bf16(kf4[uu], qf[h], (f32x4){0.f, 0.f, 0.f, 0.f}, 0, 0, 0);
#pragma unroll
                    for (int r = 0; r < 4; ++r) sc4[r] += wq[h] * fmaxf(c[r], 0.f);
                }
                u32x4 ko;
#pragma unroll
                for (int r = 0; r < 4; ++r) {
                    const int key = 16 * kt + 4 * g + r;
                    unsigned uu2 = __float_as_uint(sc4[r]); if (uu2 == 0x80000000u) uu2 = 0u;
                    uu2 = (uu2 & 0x80000000u) ? ~uu2 : (uu2 | 0x80000000u);
                    ko[r] = (key <= tq) ? uu2 : 0u;
                }
                *(LAS3 u32x4*)(lds + ((size_t)i * DS_LD + 16 * kt + 4 * g) * 4) = ko;
            }
        }
    }
    __syncthreads();
    if (!exp_skip_sel)
    {
        const int qA = 2 * w, qB = 2 * w + 1, nA = t0 + qA + 1, nB = t0 + qB + 1;
        const LAS3 unsigned* kpA = (const LAS3 unsigned*)(lds + (size_t)qA * DS_LD * 4);
        const LAS3 unsigned* kpB = (const LAS3 unsigned*)(lds + (size_t)qB * DS_LD * 4);
        unsigned keyA[32], keyB[32];
        const int nv = nreg * 64;
#pragma unroll
        for (int r = 0; r < 32; ++r) {
            int idx = r * 64 + lane; asm volatile("" : "+v"(idx));
            const unsigned va = kpA[r * 64 + lane], vb = kpB[r * 64 + lane];
            keyA[r] = (idx < nv) ? va : 0u; keyB[r] = (idx < nv) ? vb : 0u;
        }
        unsigned thrA = (nA <= 256) ? 1u : 0u, thrB = (nB <= 256) ? 1u : 0u;
        bool exA = (nA <= 256), exB = (nB <= 256);
        for (int bit = 31; bit >= 0; --bit) {
            if (exA && exB) break;
            const unsigned cA = exA ? 0xFFFFFFFFu : (thrA | (1u << bit)), cB = exB ? 0xFFFFFFFFu : (thrB | (1u << bit));
            int na = 0, nb = 0;
#pragma unroll
            for (int gq = 0; gq < 4; ++gq) if (nreg > 8 * gq) {
#pragma unroll
                for (int r = 8 * gq; r < 8 * gq + 8; ++r) { na += (keyA[r] >= cA) ? 1 : 0; nb += (keyB[r] >= cB) ? 1 : 0; } }
            na = wave_reduce_add(na); nb = wave_reduce_add(nb);
            if (!exA && na >= 256) { thrA = cA; exA = (na == 256); }
            if (!exB && nb >= 256) { thrB = cB; exB = (nb == 256); }
        }
#pragma unroll 1
        for (int qq = 0; qq < 2; ++qq) {
            const unsigned thr = qq ? thrB : thrA; const bool exact = qq ? exB : exA;
            unsigned long long mine = 0ull;
            int need = 0, running = 0;
            if (!exact) { int ngt = 0;
#pragma unroll
                for (int r = 0; r < 32; ++r) ngt += ((qq ? keyB[r] : keyA[r]) > thr) ? 1 : 0;
                need = 256 - wave_reduce_add(ngt); }
            const unsigned long long lt = (lane == 0) ? 0ull : (~0ull >> (64 - lane));
#pragma unroll
            for (int r = 0; r < 32; ++r) if (nreg > (r & ~7)) {
                const unsigned key = qq ? keyB[r] : keyA[r];
                unsigned long long bs;
                if (exact) bs = __ballot(key >= thr);
                else {
                    const bool eq = key == thr;
                    const unsigned long long be = __ballot(eq);
                    const int rank = running + __popcll(be & lt);
                    bs = __ballot((key > thr) || (eq && rank < need));
                    running += __popcll(be);
                }
                { int ln = lane; asm volatile("" : "+v"(ln)); if (ln == r) mine = bs; }
            }
            if (lane < 32 && !exp_nostore) { u32x2 o; o.x = (unsigned)mine; o.y = (unsigned)(mine >> 32); *(u32x2*)(mbase + (2 * w + qq) * 64 + 2 * lane) = o; }
        }
    }
    __syncthreads();
}

__device__ __forceinline__ void phase_dsa(const Params& p, int l, LAS3 char* lds) {
    const int tid = opaque_tid(p.wid);
    unsigned* qhead = p.ctl + CW_QD + 64 * (l + 2 * p.qslot);
    volatile LAS3 int* bc = (volatile LAS3 int*)(lds + DS_CTL);
    int nxt = 0;
    if (tid == 0) nxt = (int)__hip_atomic_fetch_add(qhead, 1u, __ATOMIC_RELAXED, __HIP_MEMORY_SCOPE_AGENT);
    for (;;) {
        if (tid == 0) *bc = nxt;
        __syncthreads();
        const int idx = __builtin_amdgcn_readfirstlane(*bc);
        __syncthreads();
        if (idx >= 4096) break;
        if (tid == 0) nxt = (int)__hip_atomic_fetch_add(qhead, 1u, __ATOMIC_RELAXED, __HIP_MEMORY_SCOPE_AGENT);
        const int pb = 127 - (idx >> 5), b = idx & 31;
        dsa_unit(p, b * 128 + pb, lds);
    }
}
}

namespace {
constexpr int LDS_BYTES = 147456;
constexpr int NTHREADS = 512;

template <int PH>
__device__ __forceinline__ void run_phase(const Params& p, int l, unsigned char* smem) {
    LAS3 char* lds = (LAS3 char*)smem;
    PG8_LAS unsigned char* glds = (PG8_LAS unsigned char*)smem;
    const int G = gridDim.x, c = blockIdx.x;
    if constexpr (PH == 0) phase_p0(p, (char*)smem);
    if constexpr (PH == 1) { if (l == 0) phase_norm1<0>(p, 0); else phase_norm1<1>(p, l); }
    if constexpr (PH == 2) { pg8::Gemm g{p.h, p.WinT + (size_t)l * NP * D, D, D, 0}; pg8::StaticOrder S; S.init(T, NP, G, c);
        EpiStoreBf16 E{p.proj, NP}; pg8::gemm_phase<EpiStoreBf16, pg8::StaticOrder, false>(glds, g, S, E, p.wid); }
    if constexpr (PH == 3) phase_prep(p, l);
    if constexpr (PH == 4) { pg8::Gemm g{p.proj + PC_BCQ, p.WqT + (size_t)l * 512 * 256, 256, NP, 0}; pg8::StaticOrder S; S.init(T, 512, G, c);
          EpiMlaQ E{p.qm}; pg8::gemm_phase<EpiMlaQ, pg8::StaticOrder, false>(glds, g, S, E, p.wid); }
    if constexpr (PH == 12) { pg8::Gemm g{p.proj + PC_BCKV, p.WkvT + (size_t)l * 512 * 128, 128, NP, 0}; pg8::StaticOrder S; S.init(T, 512, G, c);
          EpiMlaKV E{p.km, p.vm}; pg8::gemm_phase<EpiMlaKV, pg8::StaticOrder, false>(glds, g, S, E, p.wid); }
    if constexpr (PH == 13) phase_dsa(p, l, lds);
    if constexpr (PH == 5) phase_attn(p, l, lds);
    if constexpr (PH == 6) { pg8::Gemm g{p.merged, p.WoutT + (size_t)l * D * D, D, D, 0}; pg8::StaticOrder S; S.init(T, D, G, c);
        EpiResidual E{l == 0 ? p.x : p.xo, p.xo, p.mod + (size_t)l * NB * NMOD + 2 * 1024}; pg8::gemm_phase<EpiResidual, pg8::StaticOrder, false>(glds, g, S, E, p.wid); }
    if constexpr (PH == 7) phase_route(p, l, (char*)smem);
    if constexpr (PH == 8) { const int* cnt = (const int*)(p.ctl + CW_CNT) + l * 16;
        pg8::Gemm g{p.h, p.WguT + (size_t)l * 16 * 512 * 1024, 1024, D, (size_t)512 * 1024}; MoeOrder S; S.init(cnt, p.list, 2, G, c);
        EpiGateUp E{p.hid}; pg8::gemm_phase<EpiGateUp, MoeOrder, true>(glds, g, S, E, p.wid); }
    if constexpr (PH == 9) { const int* cnt = (const int*)(p.ctl + CW_CNT) + l * 16;
        pg8::Gemm g{p.hid, p.WdT + (size_t)l * 16 * 1024 * 256, 256, 256, (size_t)1024 * 256}; MoeOrder S; S.init(cnt, p.list, 4, G, c);
        EpiDown E{p.ys, p.list, p.wl, cnt}; pg8::gemm_phase<EpiDown, MoeOrder, false>(glds, g, S, E, p.wid); }
    if constexpr (PH == 10) phase_norm1<2>(p, 1);
    if constexpr (PH == 11) phase_norm1<0>(p, l);
}
template <int PH>
__global__ void __launch_bounds__(NTHREADS, 2) k_ph(Params p, int l) {
    extern __shared__ __attribute__((aligned(16))) unsigned char smem[];
    p.wid = __builtin_amdgcn_readfirstlane(threadIdx.x >> 6); p.qslot = p.qslot_host;
    run_phase<PH>(p, l, smem);
}
}


namespace {
#ifndef REP_PH
#define REP_PH -1
#endif
#define REP(X, l) do { if (REP_PH == X) { xcd_barrier(bar); phase<X>(l, smem, wid, 1); } } while (0)
struct KArgs { const float* in[20]; float* xo; char* ws; };
constexpr size_t al256(size_t b) { return (b + 255) & ~(size_t)255; }
constexpr size_t WS_CTL = 0;
constexpr size_t WS_MOD = WS_CTL + al256((size_t)CW_WORDS * 4);
constexpr size_t WS_WIN = WS_MOD + al256((size_t)2 * NB * NMOD * 4);
constexpr size_t WS_WOUT = WS_WIN + al256((size_t)2 * NP * D * 2);
constexpr size_t WS_WQ = WS_WOUT + al256((size_t)2 * D * D * 2);
constexpr size_t WS_WKV = WS_WQ + al256((size_t)2 * 512 * 256 * 2);
constexpr size_t WS_WGU = WS_WKV + al256((size_t)2 * 512 * 128 * 2);
constexpr size_t WS_WD = WS_WGU + al256((size_t)2 * 16 * 512 * 1024 * 2);
constexpr size_t WS_ROPE = WS_WD + al256((size_t)2 * 16 * 1024 * 256 * 2);
constexpr size_t WS_RQ = WS_ROPE + al256((size_t)2048 * 16 * 2 * 4);
constexpr size_t WS_RKV = WS_RQ + al256((size_t)T * 4);
constexpr size_t WS_CBF = WS_RKV + al256((size_t)T * 4);
constexpr size_t WS_MASK = WS_CBF + al256((size_t)NB * 4 * S * 4);
constexpr size_t WS_LIST = WS_MASK + al256((size_t)T * 64 * 4);
constexpr size_t WS_RW = WS_LIST + al256((size_t)2 * 16 * ECAP * 4);
constexpr size_t WS_WL = WS_RW + al256((size_t)T * 2 * 4);
constexpr size_t WS_H = WS_WL + al256((size_t)2 * 16 * ECAP * 4);
constexpr size_t WS_PROJ = WS_H + al256((size_t)T * D * 2);
constexpr size_t WS_QM = WS_PROJ + al256((size_t)T * NP * 2);
constexpr size_t WS_KM = WS_QM + al256((size_t)T * 384 * 2);
constexpr size_t WS_VM = WS_KM + al256((size_t)T * 384 * 2);
constexpr size_t WS_MERGED = WS_VM + al256((size_t)T * 256 * 2);
constexpr size_t WS_END1 = WS_MERGED + al256((size_t)T * D * 2);
constexpr size_t WS_HID = WS_PROJ;
constexpr size_t WS_YS = WS_HID + al256((size_t)HIDROWS * 256 * 2);
constexpr size_t WS_END2 = WS_YS + al256((size_t)T * 2 * D * 2);
constexpr size_t WS_NEED = WS_END1 > WS_END2 ? WS_END1 : WS_END2;
static_assert(WS_END2 <= WS_MERGED, "MoE overlay must not reach the merged buffer");

__device__ __forceinline__ Params make_params(const KArgs& a) {
    Params p;
    p.x = a.in[0]; p.c = a.in[1]; p.w_ada = a.in[2]; p.b_ada = a.in[3]; p.g_norm1 = a.in[4]; p.w_in = a.in[5]; p.b_forget = a.in[6]; p.g_q_mla = a.in[7];
    p.w_q_up = a.in[8]; p.g_kv_mla = a.in[9]; p.w_kv_up = a.in[10]; p.sinks = a.in[11]; p.w_out = a.in[12]; p.g_norm2 = a.in[13]; p.w_router = a.in[14];
    p.b_router = a.in[15]; p.w_gate = a.in[16]; p.w_up = a.in[17]; p.w_down = a.in[18]; p.g_final = a.in[19];
    p.xo = a.xo; char* ws = a.ws;
    p.ctl = (unsigned*)(ws + WS_CTL); p.mod = (float*)(ws + WS_MOD); p.WinT = (bf16_t*)(ws + WS_WIN); p.WoutT = (bf16_t*)(ws + WS_WOUT);
    p.WqT = (bf16_t*)(ws + WS_WQ); p.WkvT = (bf16_t*)(ws + WS_WKV); p.WguT = (bf16_t*)(ws + WS_WGU); p.WdT = (bf16_t*)(ws + WS_WD);
    p.ropetab = (float*)(ws + WS_ROPE); p.rq = (float*)(ws + WS_RQ); p.rkv = (float*)(ws + WS_RKV); p.cbF = (float*)(ws + WS_CBF);
    p.mask = (uint32_t*)(ws + WS_MASK); p.list = (int*)(ws + WS_LIST); p.rw = (float*)(ws + WS_RW); p.wl = (float*)(ws + WS_WL); p.h = (bf16_t*)(ws + WS_H);
    p.proj = (bf16_t*)(ws + WS_PROJ); p.qm = (bf16_t*)(ws + WS_QM); p.km = (bf16_t*)(ws + WS_KM); p.vm = (bf16_t*)(ws + WS_VM);
    p.merged = (bf16_t*)(ws + WS_MERGED); p.hid = (bf16_t*)(ws + WS_HID); p.ys = (bf16_t*)(ws + WS_YS);
    return p;
}
template <int PH>
__device__ __forceinline__ void phase(int l, unsigned char* smem, int wid, int qslot = 0) {
    typedef const __attribute__((address_space(4))) KArgs* KA4;
    KA4 ka = (KA4)__builtin_amdgcn_kernarg_segment_ptr();
    asm volatile("" : "+s"(ka));
    KArgs a;
#pragma unroll
    for (int i = 0; i < 20; ++i) a.in[i] = ka->in[i];
    a.xo = ka->xo; a.ws = ka->ws;
    Params p = make_params(a); p.wid = wid; p.qslot = qslot; p.qslot_host = 0;
    run_phase<PH>(p, l, smem);
}
__global__ void __launch_bounds__(NTHREADS, 2) fwd(KArgs args) {
    extern __shared__ __attribute__((aligned(16))) unsigned char smem[];
    volatile LAS unsigned* st = (volatile LAS unsigned*)(smem + LDS_BYTES - 16);
    const int wid = __builtin_amdgcn_readfirstlane(threadIdx.x >> 6);
    if (xb_leader(wid)) { st[0] = 0u; st[1] = 0u; st[2] = 0u; st[3] = 0u; }
    __syncthreads();
    XcdBarrier bar = xcd_barrier_post((unsigned*)(args.ws + WS_CTL) + CW_BAR, st, wid);
    phase<0>(0, smem, wid);  REP(0, 0);
    xcd_barrier(bar);
#define LAYER(l) do { \
        phase<1>(l, smem, wid);  if (l == 0) REP(1, l); xcd_barrier(bar); \
        phase<2>(l, smem, wid);  REP(2, l); xcd_barrier(bar); \
        phase<3>(l, smem, wid);  REP(3, l); xcd_barrier(bar); \
        phase<4>(l, smem, wid);  REP(4, l); phase<12>(l, smem, wid);  REP(12, l); phase<13>(l, smem, wid);  REP(13, l); xcd_barrier(bar); \
        phase<5>(l, smem, wid);  REP(5, l); xcd_barrier(bar); \
        phase<6>(l, smem, wid);  xcd_barrier(bar); \
        phase<7>(l, smem, wid);  REP(7, l); xcd_barrier(bar); \
        phase<8>(l, smem, wid);  REP(8, l); xcd_barrier(bar); \
        phase<9>(l, smem, wid);  REP(9, l); xcd_barrier(bar); } while (0)
    LAYER(0);
    LAYER(1);
#ifdef REP_BAR
    for (int rb = 0; rb < REP_BAR; ++rb) xcd_barrier(bar);
#endif
    phase<10>(1, smem, wid);
}
}

extern "C" void kernel_launch(void* const* d_in, const int* in_sizes, int n_in, void* d_out, int out_size, void* d_ws, size_t ws_size,
                              hipStream_t stream) {
    KArgs a{};
    for (int i = 0; i < 20; ++i) a.in[i] = (const float*)d_in[i];
    a.xo = (float*)d_out; a.ws = (char*)d_ws;
    if (WS_NEED > ws_size) return;

    static int grid = 0;
    if (!grid) {
        int dev = 0, cus = 0, per_cu = 0;
        (void)hipGetDevice(&dev);
        (void)hipDeviceGetAttribute(&cus, hipDeviceAttributeMultiprocessorCount, dev);
        (void)hipFuncSetAttribute((const void*)fwd, hipFuncAttributeMaxDynamicSharedMemorySize, LDS_BYTES);
        (void)hipOccupancyMaxActiveBlocksPerMultiprocessor(&per_cu, (const void*)fwd, NTHREADS, LDS_BYTES);
        grid = cus > 0 ? cus : 256;
    }
    (void)hipMemsetAsync(a.ws + WS_CTL, 0, (size_t)CW_WORDS * 4, stream);
    fwd<<<dim3(grid), dim3(NTHREADS), LDS_BYTES, stream>>>(a);
}
```

```cpp
#define NORM_NT 2
#include <hip/hip_runtime.h>
#include <stdint.h>
#define XB_TMO      128
#define XB_XCNT(j)  (256  + 64 * (j))
#define XB_XSUB(j)  (1280 + 64 * (j))
#define XB_XGEN(j)  (2304 + 64 * (j))
#define XB_TOP      3328
#define XB_TOPGEN   3392
#define XCD_BAR_WORDS 3456
#define XB_SPIN_CAP (1u << 20)
#define LAS __attribute__((address_space(3)))

__device__ __forceinline__ unsigned xb_ld(unsigned* p)              { return __hip_atomic_load(p, __ATOMIC_RELAXED, __HIP_MEMORY_SCOPE_AGENT); }
__device__ __forceinline__ unsigned xb_add(unsigned* p, unsigned v) { return __hip_atomic_fetch_add(p, v, __ATOMIC_RELAXED, __HIP_MEMORY_SCOPE_AGENT); }
__device__ __forceinline__ unsigned xb_xcc_id() { return (unsigned)__builtin_amdgcn_s_getreg((3 << 11) | 20) & 0xFu; }
#define XB_SPIN(cond, bar) do { unsigned _sp = 0; while (cond) { __builtin_amdgcn_s_sleep(1); \
    if ((++_sp & 255u) == 0u) { if (xb_ld(&(bar)[XB_TMO])) break; if (_sp > XB_SPIN_CAP) { atomicAdd(&(bar)[XB_TMO], 1u); break; } } } } while (0)

struct XcdBarrier { unsigned* bar; unsigned x; volatile LAS unsigned* st; int wid; };
__device__ __forceinline__ bool xb_leader(int wid) { return wid == 0 && __builtin_amdgcn_mbcnt_hi(~0u, __builtin_amdgcn_mbcnt_lo(~0u, 0u)) == 0u; }

__device__ __forceinline__ XcdBarrier xcd_barrier_post(unsigned* bar, volatile LAS unsigned* st, int wid) {
    XcdBarrier b; b.bar = bar; b.x = xb_xcc_id(); b.st = st; b.wid = wid;
    if (xb_leader(wid)) (void)xb_add(&bar[XB_XCNT(b.x)], 1u);
    return b;
}
__device__ __forceinline__ void xcd_barrier_complete(unsigned* bar, unsigned x, unsigned& nloc, unsigned& nx) {
    const unsigned G = gridDim.x * gridDim.y * gridDim.z;
    unsigned sum, cnt, mine, sp = 0u;
    for (;;) {
        sum = 0u; cnt = 0u; mine = 0u;
#pragma unroll
        for (unsigned j = 0; j < 16; ++j) { const unsigned c = xb_ld(&bar[XB_XCNT(j)]); sum += c; cnt += (c > 0u) ? 1u : 0u; mine = (j == x) ? c : mine; }
        if (sum == G) break;
        __builtin_amdgcn_s_sleep(1);
        if ((++sp & 255u) == 0u) { if (xb_ld(&bar[XB_TMO])) break; if (sp > XB_SPIN_CAP) { atomicAdd(&bar[XB_TMO], 1u); break; } }
    }
    nloc = mine > 0u ? mine : 1u; nx = cnt > 0u ? cnt : 1u;
}
__device__ __forceinline__ void xcd_barrier(const XcdBarrier& b) {
    asm volatile("s_waitcnt vmcnt(0)" ::: "memory");
    __syncthreads();
    if (xb_leader(b.wid)) {
        unsigned* bar = b.bar;
        __builtin_amdgcn_s_waitcnt(0);
        unsigned nloc = b.st[0], nx = b.st[1];
        if (nloc == 0u) { xcd_barrier_complete(bar, b.x, nloc, nx); b.st[0] = nloc; b.st[1] = nx; }
        const unsigned old = xb_add(&bar[XB_XSUB(b.x)], 1u);
        const unsigned gen = old / nloc;
        if (old + 1u == (gen + 1u) * nloc) {
            __builtin_amdgcn_fence(__ATOMIC_RELEASE, "agent");
            asm volatile("s_waitcnt vmcnt(0)" ::: "memory");
            const unsigned og = xb_add(&bar[XB_TOP], 1u);
            const unsigned tg = og / nx;
            if (og + 1u == (tg + 1u) * nx) xb_add(&bar[XB_TOPGEN], 1u);
            else XB_SPIN(xb_ld(&bar[XB_TOPGEN]) == tg, bar);
            __builtin_amdgcn_fence(__ATOMIC_ACQUIRE, "agent");
            xb_add(&bar[XB_XGEN(b.x)], 1u);
            asm volatile("s_waitcnt vmcnt(0)" ::: "memory");
        } else {
            XB_SPIN(xb_ld(&bar[XB_XGEN(b.x)]) == gen, bar);
            __builtin_amdgcn_fence(__ATOMIC_ACQUIRE, "agent");
            asm volatile("s_waitcnt vmcnt(0)" ::: "memory");
        }
    }
    __syncthreads();
}

#define LAS3 __attribute__((address_space(3)))
namespace {
typedef unsigned short bf16_t;
typedef short bf16x8 __attribute__((ext_vector_type(8)));
typedef short bf16x4 __attribute__((ext_vector_type(4)));
typedef float f32x4 __attribute__((ext_vector_type(4)));
typedef float f32x2 __attribute__((ext_vector_type(2)));
typedef unsigned u32x4 __attribute__((ext_vector_type(4)));
typedef unsigned u32x2 __attribute__((ext_vector_type(2)));

constexpr int D = 1024, NB = 32, S = 2048, T = NB * S, NIN = 2380, NP = 2560, NMOD = 6144;
constexpr int OFF_AQ = 0, OFF_AK = 256, OFF_AV = 512, OFF_AF = 768, OFF_BCQ = 772, OFF_BCKV = 1028, OFF_BKR = 1156,
              OFF_CQ = 1188, OFF_CK = 1444, OFF_CV = 1572, OFF_DQ = 1700, OFF_DK = 1956, OFF_DV = 2020,
              OFF_DQI = 2084, OFF_DKI = 2340, OFF_DWI = 2372;
constexpr int PC_AQ = 0, PC_AK = 256, PC_AV = 512, PC_BCQ = 768, PC_BCKV = 1024, PC_BKR = 1152, PC_CQ = 1184, PC_CK = 1440, PC_CV = 1568,
              PC_DQ = 1696, PC_DK = 1952, PC_DV = 2016, PC_DQI = 2080, PC_DKI = 2336, PC_DWI = 2368, PC_AF = 2376;
constexpr float EPS = 1e-6f;
constexpr float LOG2E = 1.4426950408889634f;
constexpr int ECAP = T;
constexpr int HIDROWS = 2 * T + 16 * 256;

__host__ __device__ __forceinline__ int orig_col(int n) { return n < 768 ? n : (n < 2376 ? n + 4 : (n < 2380 ? n - 1608 : -1)); }
__device__ __forceinline__ int opaque_tid(int wid) {
    int t = wid * 64 + (int)__builtin_amdgcn_mbcnt_hi(~0u, __builtin_amdgcn_mbcnt_lo(~0u, 0u));
    asm volatile("" : "+v"(t)); return t; }
__device__ __forceinline__ float bf2f(bf16_t v) { return __uint_as_float((unsigned)v << 16); }
__device__ __forceinline__ bf16_t f2bf(float f) { unsigned u = __float_as_uint(f); u += 0x7FFFu + ((u >> 16) & 1u); return (bf16_t)(u >> 16); }
typedef __bf16 bf16x2_native __attribute__((ext_vector_type(2)));
__device__ __forceinline__ unsigned cvt_pk_bf16(float lo, float hi) { const f32x2 v = {lo, hi}; return __builtin_bit_cast(unsigned, __builtin_convertvector(v, bf16x2_native)); }
__device__ __forceinline__ float bflo(unsigned w) { return __uint_as_float(w << 16); }
__device__ __forceinline__ float bfhi(unsigned w) { return __uint_as_float(w & 0xFFFF0000u); }
__device__ __forceinline__ float wave_sum(float v) {
#pragma unroll
    for (int o = 32; o > 0; o >>= 1) v += __shfl_xor(v, o);
    return v;
}
__device__ __forceinline__ float xor32_max(float x) {
    float a = x, b = x;
    asm volatile("s_nop 1\n\tv_permlane32_swap_b32 %0, %1\n\ts_nop 1" : "+v"(a), "+v"(b));
    return fmaxf(a, b);
}
__device__ __forceinline__ int wave_reduce_add(int v) {
    v += __builtin_amdgcn_update_dpp(0, v, 0xB1, 0xF, 0xF, true);
    v += __builtin_amdgcn_update_dpp(0, v, 0x4E, 0xF, 0xF, true);
    v += __builtin_amdgcn_update_dpp(0, v, 0x141, 0xF, 0xF, true);
    v += __builtin_amdgcn_update_dpp(0, v, 0x140, 0xF, 0xF, true);
    return __builtin_amdgcn_readlane(v, 0) + __builtin_amdgcn_readlane(v, 16) + __builtin_amdgcn_readlane(v, 32) + __builtin_amdgcn_readlane(v, 48);
}
}

namespace pg8 {
#define PG8_LAS __attribute__((address_space(3)))
constexpr int BM = 256, BK = 64, HALF = 128, HTB = HALF * BK * 2, STAGE_BYTES = 8 * HTB, NXCD = 8, WGM = 8;

__host__ __device__ __forceinline__ int lds_byte(int r, int c) { const int st = (r >> 4) * 2 + (c >> 5), rr = r & 15, cc = c & 31, ob = rr * 64 + cc * 2; return st * 1024 + (ob ^ (((ob >> 9) & 1) << 5)); }
__host__ __device__ __forceinline__ void stage_rc(int b, int& R, int& C) { const int st = b / 1024, sb = b % 1024, swz = sb ^ (((sb >> 9) & 1) << 5); R = (st >> 1) * 16 + swz / 64; C = (st & 1) * 32 + (swz % 64) / 2; }
__host__ __device__ __forceinline__ int perm32(int rho) { const int n = rho >> 4, i = rho & 15; return 8 * (i >> 2) + 4 * n + (i & 3); }

struct Unit { int pm, pn, e, mt; };
struct Gemm { const bf16_t* A; const bf16_t* Bt; int K; int lda; size_t bstride; };

struct StaticOrder {
    int nM, nN, nwg, G, c;
    __host__ __device__ void init(int M, int N, int G_, int c_) { nM = M / BM; nN = N / BM; nwg = nM * nN; G = G_; c = c_; }
    __host__ __device__ bool next(int i, Unit& u) const {
        const long L = (long)i * G + c; if (L >= nwg) return false;
        int wgid = (int)L; { const int q = nwg / NXCD, r = nwg % NXCD, xcd = wgid % NXCD, off = wgid / NXCD; wgid = (xcd < r ? xcd * (q + 1) : r * (q + 1) + (xcd - r) * q) + off; }
        const int nig = WGM * nN, gid = wgid / nig, fm = gid * WGM, gsz = (nM - fm) < WGM ? (nM - fm) : WGM;
        u.pm = fm + ((wgid % nig) % gsz); u.pn = (wgid % nig) / gsz; u.e = 0; u.mt = 0; return true;
    }
    __device__ __forceinline__ int arow(const Unit& u, int r) const { return u.pm * BM + r; }
};

template <class Epi, class Sched, bool GATHER>
__device__ __forceinline__ void gemm_phase(PG8_LAS unsigned char* lds, const Gemm g, const Sched& S, const Epi& E, int wave_index) {
    const int tid = opaque_tid(wave_index), wid = __builtin_amdgcn_readfirstlane(tid >> 6), lane = tid & 63, wr = wid >> 2, wc = wid & 3, fr = lane & 15, fq = lane >> 4;
    int K_ = g.K; asm volatile("" : "+s"(K_));
    const int K = K_, nt = K / BK, lda = g.lda;
    int Ra[2], Ca[2]; unsigned voffB[2], voffA[2];
#pragma unroll
    for (int i = 0; i < 2; ++i) { int R, C; stage_rc(tid * 16 + i * 8192, R, C); const int Rb = Epi::PERM ? ((R & ~31) + perm32(R & 31)) : R;
        Ra[i] = R; Ca[i] = C; voffB[i] = (unsigned)(Rb * K + C) * 2u; voffA[i] = (unsigned)(R * lda + C) * 2u; }
    const size_t kstep = (size_t)(BK * 2);
    const size_t hstepB = (size_t)HALF * K * 2;
    const size_t tstepB = 2 * hstepB;
    const size_t hstepA = (size_t)HALF * lda * 2, tstepA = 2 * hstepA;
    const unsigned ldsw = (unsigned)wid * 1024u;
    const int aoff = lds_byte(wr * 64 + fr, fq * 8), boff = lds_byte(wc * 32 + fr, fq * 8);
#define PG8_SA(b, h) (((b) * 2 + (h)) * HTB)
#define PG8_SB(b, h) ((4 + (b) * 2 + (h)) * HTB)
#define PG8_STAGE(bufoff, gbase, voff) do { _Pragma("unroll") for (int _i = 0; _i < 2; ++_i) \
        __builtin_amdgcn_global_load_lds((const unsigned*)((const char*)(gbase) + (voff)[_i]), (PG8_LAS unsigned*)(lds + (bufoff) + ldsw + _i * 8192), 16, 0, 0); } while (0)
#define PG8_STAGEA(bufoff, kptr, VO, h) do { _Pragma("unroll") for (int _i = 0; _i < 2; ++_i) { \
        const char* _src; if constexpr (GATHER) _src = (const char*)(kptr) + (VO)[_i][h]; else _src = (const char*)(kptr) + (size_t)(h) * hstepA + voffA[_i]; \
        __builtin_amdgcn_global_load_lds((const unsigned*)_src, (PG8_LAS unsigned*)(lds + (bufoff) + ldsw + _i * 8192), 16, 0, 0); } } while (0)
#define PG8_LDA(dst, b, h) do { _Pragma("unroll") for (int m = 0; m < 4; ++m) _Pragma("unroll") for (int k = 0; k < 2; ++k) dst[m][k] = *(const PG8_LAS bf16x8*)(lds + PG8_SA(b, h) + aoff + m * 2048 + k * 1024); } while (0)
#define PG8_LDB(dst, b, h) do { _Pragma("unroll") for (int n = 0; n < 2; ++n) _Pragma("unroll") for (int k = 0; k < 2; ++k) dst[n][k] = *(const PG8_LAS bf16x8*)(lds + PG8_SB(b, h) + boff + n * 2048 + k * 1024); } while (0)
#define PG8_MMA(ai, bj, At, Bt) do { __builtin_amdgcn_s_setprio(1); _Pragma("unroll") for (int m = 0; m < 4; ++m) _Pragma("unroll") for (int n = 0; n < 2; ++n) _Pragma("unroll") for (int k = 0; k < 2; ++k) \
        acc[ai][bj][m][n] = __builtin_amdgcn_mfma_f32_16x16x32_bf16(Bt[n][k], At[m][k], acc[ai][bj][m][n], 0, 0, 0); __builtin_amdgcn_s_setprio(0); } while (0)
#define PG8_WAIT_V(n) asm volatile("s_waitcnt vmcnt(" #n ")" ::: "memory")
#define PG8_WAIT_L(n) asm volatile("s_waitcnt lgkmcnt(" #n ")" ::: "memory")
#define PG8_BAR __builtin_amdgcn_s_barrier()
#define PG8_SCHED __builtin_amdgcn_sched_barrier(0)
#define PG8_SETV(V, u) do { _Pragma("unroll") for (int _i = 0; _i < 2; ++_i) _Pragma("unroll") for (int _h = 0; _h < 2; ++_h) { \
        const int _row = GATHER ? S.arow(u, _h * HALF + Ra[_i]) : ((u).pm * BM + _h * HALF + Ra[_i]); V[_i][_h] = (unsigned)(((size_t)_row * lda + Ca[_i]) * 2); } } while (0)
    Unit cur, nxt; int ui = 0;
    if (!S.next(0, cur)) return;
    f32x4 acc[2][2][4][2];
#pragma unroll
    for (int a = 0; a < 2; ++a)
#pragma unroll
        for (int b = 0; b < 2; ++b)
#pragma unroll
            for (int m = 0; m < 4; ++m)
#pragma unroll
                for (int n = 0; n < 2; ++n) acc[a][b][m][n] = (f32x4){0.f, 0.f, 0.f, 0.f};
    bf16x8 At[4][2], B0[2][2], B1[2][2];
    unsigned vA[2][2], vN[2][2];
    if constexpr (GATHER) { PG8_SETV(vA, cur); }
    const char* cA = (const char*)g.A + (GATHER ? (size_t)0 : (size_t)cur.pm * tstepA);
    const char* cB = (const char*)g.Bt + ((size_t)cur.e * g.bstride) * 2 + (size_t)cur.pn * tstepB;
    PG8_STAGE(PG8_SB(0, 0), cB, voffB); PG8_STAGE(PG8_SB(0, 1), cB + hstepB, voffB); PG8_STAGEA(PG8_SA(0, 0), cA, vA, 0); PG8_STAGEA(PG8_SA(0, 1), cA, vA, 1);
    if (wr == 1) PG8_BAR;
    PG8_WAIT_V(2); PG8_BAR;
    PG8_STAGE(PG8_SB(1, 0), cB + kstep, voffB); PG8_STAGEA(PG8_SA(1, 0), cA + kstep, vA, 0); PG8_STAGE(PG8_SB(1, 1), cB + hstepB + kstep, voffB);
    PG8_WAIT_V(6); PG8_BAR;
    for (;;) {
        const bool has_next = S.next(ui + 1, nxt);
        if constexpr (GATHER) { if (has_next) { PG8_SETV(vN, nxt); }
        else {
#pragma unroll
            for (int _i = 0; _i < 2; ++_i)
#pragma unroll
                for (int _h = 0; _h < 2; ++_h) vN[_i][_h] = vA[_i][_h];
        } }
        const char* nA = (!GATHER && has_next) ? (const char*)g.A + (size_t)nxt.pm * tstepA : cA;
        const char* nB = has_next ? (const char*)g.Bt + ((size_t)nxt.e * g.bstride) * 2 + (size_t)nxt.pn * tstepB : cB;
#pragma unroll 1
        for (int t = 0; t < nt; t += 2) {
            const bool last = (t == nt - 2);
            const char* a1 = cA + (size_t)(t + 1) * kstep;
            const char* a2 = last ? nA : cA + (size_t)(t + 2) * kstep; const char* b2 = last ? nB : cB + (size_t)(t + 2) * kstep;
            const char* a3 = a2 + kstep; const char* b3 = b2 + kstep;
            unsigned v2[2][2];
            if constexpr (GATHER) {
#pragma unroll
            for (int _i = 0; _i < 2; ++_i)
#pragma unroll
                for (int _h = 0; _h < 2; ++_h) v2[_i][_h] = last ? vN[_i][_h] : vA[_i][_h];
            }
            PG8_LDB(B0, 0, 0); PG8_LDB(B1, 0, 1); PG8_SCHED; PG8_LDA(At, 0, 0); PG8_STAGEA(PG8_SA(1, 1), a1, vA, 1);
            PG8_WAIT_V(8); PG8_WAIT_L(0); PG8_BAR; PG8_MMA(0, 0, At, B0); PG8_MMA(0, 1, At, B1); PG8_BAR; PG8_SCHED;
            PG8_LDA(At, 0, 1); PG8_STAGE(PG8_SB(0, 0), b2, voffB); PG8_STAGE(PG8_SB(0, 1), b2 + hstepB, voffB); PG8_STAGEA(PG8_SA(0, 0), a2, v2, 0);
            PG8_WAIT_V(8); PG8_WAIT_L(0); PG8_BAR; PG8_MMA(1, 0, At, B0); PG8_MMA(1, 1, At, B1); PG8_BAR; PG8_SCHED;
            PG8_LDB(B0, 1, 0); PG8_LDB(B1, 1, 1); PG8_SCHED; PG8_LDA(At, 1, 0); PG8_STAGEA(PG8_SA(0, 1), a2, v2, 1);
            PG8_WAIT_V(8); PG8_WAIT_L(0); PG8_BAR; PG8_MMA(0, 0, At, B0); PG8_MMA(0, 1, At, B1); PG8_BAR; PG8_SCHED;
            PG8_LDA(At, 1, 1); PG8_STAGE(PG8_SB(1, 0), b3, voffB); PG8_STAGE(PG8_SB(1, 1), b3 + hstepB, voffB); PG8_STAGEA(PG8_SA(1, 0), a3, v2, 0);
            PG8_WAIT_V(8); PG8_WAIT_L(0); PG8_BAR; PG8_MMA(1, 0, At, B0); PG8_MMA(1, 1, At, B1); PG8_BAR; PG8_SCHED;
        }
        if (wr == 0) PG8_BAR;
        E(acc, cur, wr, wc, fr, fq);
        if (!has_next) break;
#pragma unroll
        for (int a = 0; a < 2; ++a)
#pragma unroll
            for (int b = 0; b < 2; ++b)
#pragma unroll
                for (int m = 0; m < 4; ++m)
#pragma unroll
                    for (int n = 0; n < 2; ++n) acc[a][b][m][n] = (f32x4){0.f, 0.f, 0.f, 0.f};
        cur = nxt; cB = nB; cA = nA; ++ui;
        if constexpr (GATHER) {
#pragma unroll
        for (int _i = 0; _i < 2; ++_i)
#pragma unroll
            for (int _h = 0; _h < 2; ++_h) vA[_i][_h] = vN[_i][_h];
        }
        if (wr == 1) PG8_BAR;
    }
    PG8_WAIT_V(0);
    PG8_BAR;
#undef PG8_SA
#undef PG8_SB
#undef PG8_STAGE
#undef PG8_STAGEA
#undef PG8_LDA
#undef PG8_LDB
#undef PG8_MMA
#undef PG8_WAIT_V
#undef PG8_WAIT_L
#undef PG8_BAR
#undef PG8_SCHED
#undef PG8_SETV
}
}

namespace {
struct Params {
    const float *x, *c, *w_ada, *b_ada, *g_norm1, *w_in, *b_forget, *g_q_mla, *w_q_up, *g_kv_mla, *w_kv_up, *sinks, *w_out, *g_norm2,
                *w_router, *b_router, *w_gate, *w_up, *w_down, *g_final;
    float* xo;
    unsigned* ctl;
    float* mod;
    bf16_t* WinT;
    bf16_t* WoutT;
    bf16_t* WqT;
    bf16_t* WkvT;
    bf16_t* WguT;
    bf16_t* WdT;
    float* ropetab;
    float* rq; float* rkv;
    float* cbF;
    bf16_t* kidx;
    uint32_t* mask;
    bf16_t* h;
    bf16_t* proj;
    bf16_t* qm; bf16_t* km; bf16_t* vm;
    bf16_t* merged;
    bf16_t* hid;
    bf16_t* ys;
    int* list;
    float* rw;
    float* wl;
    int wid;
    int qslot;
    int qslot_host;
};
constexpr int CW_BAR = 0;
constexpr int CW_CNT = 3584;
constexpr int CW_QA = 3648;
constexpr int CW_QD = 4288;
constexpr int CW_KN2 = 4992;
constexpr int CW_QN2 = CW_KN2 + 2 * NB * 4 * 32;
constexpr int CW_WORDS = CW_QN2 + 2 * NB * 4 * 8;
}

namespace {
constexpr long P0_B1 = 2l * NP * 128, P0_B2 = P0_B1 + 2l * 1024 * 128, P0_B3 = P0_B2 + 2l * 512 * 32, P0_B4 = P0_B3 + 2l * 512 * 16,
               P0_B5 = P0_B4 + 32l * 512 * 128, P0_B6 = P0_B5 + 32l * 1024 * 32;
__device__ __forceinline__ bf16_t* p0_fetch(const Params& p, long it, float (&v)[8]) {
    if (it < P0_B1) {
        const int l = (int)(it / (NP * 128)), r = (int)(it % (NP * 128)), n = r % NP, k0 = (r / NP) * 8, o = orig_col(n);
        const float* w = p.w_in + (size_t)l * D * NIN;
#pragma unroll
        for (int j = 0; j < 8; ++j) v[j] = o >= 0 ? w[(size_t)(k0 + j) * NIN + o] : 0.f;
        return p.WinT + ((size_t)l * NP + n) * D + k0;
    } else if (it < P0_B2) {
        const long s = it - P0_B1; const int l = (int)(s / (1024 * 128)), r = (int)(s % (1024 * 128)), n = r & 1023, k0 = (r >> 10) * 8;
        const float* w = p.w_out + (size_t)l * D * D;
#pragma unroll
        for (int j = 0; j < 8; ++j) v[j] = w[(size_t)(k0 + j) * D + n];
        return p.WoutT + ((size_t)l * D + n) * D + k0;
    } else if (it < P0_B3) {
        const long s = it - P0_B2; const int l = (int)(s / (512 * 32)), r = (int)(s % (512 * 32)), n = r & 511, k0 = (r >> 9) * 8;
        const float* w = p.w_q_up + (size_t)l * 256 * 384; const float* g = p.g_q_mla + l * 256;
#pragma unroll
        for (int j = 0; j < 8; ++j) v[j] = n < 384 ? g[k0 + j] * w[(size_t)(k0 + j) * 384 + n] : 0.f;
        return p.WqT + ((size_t)l * 512 + n) * 256 + k0;
    } else if (it < P0_B4) {
        const long s = it - P0_B3; const int l = (int)(s / (512 * 16)), r = (int)(s % (512 * 16)), n = r & 511, k0 = (r >> 9) * 8;
        const float* w = p.w_kv_up + (size_t)l * 128 * 512; const float* g = p.g_kv_mla + l * 128;
#pragma unroll
        for (int j = 0; j < 8; ++j) v[j] = g[k0 + j] * w[(size_t)(k0 + j) * 512 + n];
        return p.WkvT + ((size_t)l * 512 + n) * 128 + k0;
    } else if (it < P0_B5) {
        const long s = it - P0_B4; const int le = (int)(s >> 16), r = (int)(s & 65535), n = r & 511, k0 = (r >> 9) * 8;
        const int q = n >> 5, rr = n & 31, col = 16 * q + (rr & 15);
        const float* w = (rr < 16 ? p.w_gate : p.w_up) + (size_t)le * 1024 * 256;
#pragma unroll
        for (int j = 0; j < 8; ++j) v[j] = w[(size_t)(k0 + j) * 256 + col];
        return p.WguT + ((size_t)le * 512 + n) * 1024 + k0;
    } else {
        const long s = it - P0_B5; const int le = (int)(s >> 15), r = (int)(s & 32767), n = r & 1023, k0 = (r >> 10) * 8;
        const float* w = p.w_down + (size_t)le * 256 * 1024;
#pragma unroll
        for (int j = 0; j < 8; ++j) v[j] = w[(size_t)(k0 + j) * 1024 + n];
        return p.WdT + ((size_t)le * 1024 + n) * 256 + k0;
    }
}
__device__ __forceinline__ void p0_store(bf16_t* dst, const float (&v)[8]) {
    u32x4 w; w.x = cvt_pk_bf16(v[0], v[1]); w.y = cvt_pk_bf16(v[2], v[3]); w.z = cvt_pk_bf16(v[4], v[5]); w.w = cvt_pk_bf16(v[6], v[7]);
    *(u32x4*)dst = w;
}

__device__ __forceinline__ void phase_p0(const Params& p, char* lds) {
    const int tid = opaque_tid(p.wid), gtid = blockIdx.x * blockDim.x + tid, gthreads = gridDim.x * blockDim.x;
    for (long it0 = gtid; it0 < P0_B6; it0 += 2l * gthreads) {
        float va[8], vb[8];
        const bool hb = it0 + gthreads < P0_B6;
        bf16_t* da = p0_fetch(p, it0, va);
        bf16_t* db = hb ? p0_fetch(p, it0 + gthreads, vb) : da;
        p0_store(da, va);
        if (hb) p0_store(db, vb);
    }
    for (int it = gtid; it < 2048 * 16; it += gthreads) {
        const int pos = it >> 4, i = it & 15;
        const float inv = powf(10000.0f, -(float)i / 16.0f), ang = (float)pos * inv;
        p.ropetab[it * 2] = cosf(ang); p.ropetab[it * 2 + 1] = sinf(ang);
    }
    float* ca = (float*)lds;
    for (int i = tid; i < NB * 1024; i += 512) { const float v = p.c[i]; ca[i] = v / (1.f + __expf(-v)); }
    __syncthreads();
    for (int u = blockIdx.x; u < 2 * (NMOD / 64); u += gridDim.x) {
        const int l = u / (NMOD / 64), n = (u % (NMOD / 64)) * 64 + (tid & 63), bg = tid >> 6;
        const float* w = p.w_ada + (size_t)l * 1024 * NMOD + n;
        float acc[4] = {0.f, 0.f, 0.f, 0.f};
        for (int d0 = 0; d0 < 1024; d0 += 8) {
            float wv[8];
#pragma unroll
            for (int q = 0; q < 8; ++q) wv[q] = w[(size_t)(d0 + q) * NMOD];
#pragma unroll
            for (int q = 0; q < 8; ++q)
#pragma unroll
                for (int j = 0; j < 4; ++j) acc[j] += ca[(bg * 4 + j) * 1024 + d0 + q] * wv[q];
        }
        const float bias = p.b_ada[l * NMOD + n];
#pragma unroll
        for (int j = 0; j < 4; ++j) p.mod[((size_t)l * NB + bg * 4 + j) * NMOD + n] = acc[j] + bias;
    }
    __syncthreads();
}

template <int MODE>
__device__ __forceinline__ void phase_norm1(const Params& p, int l) {
#ifndef NORM_NT
#define NORM_NT 4
#endif
    constexpr int NT = NORM_NT;
    const int tid = opaque_tid(p.wid), w = tid >> 6, lane = tid & 63;
    const float* xin = (MODE == 0) ? p.x : p.xo;
    const float* g = (MODE == 2) ? p.g_final : p.g_norm1 + l * D;
    const float* modl = p.mod + (size_t)(MODE == 2 ? 1 : l) * NB * NMOD;
    const float* modp = p.mod + (size_t)(MODE == 2 ? 1 : (l > 0 ? l - 1 : 0)) * NB * NMOD;
    f32x4 gg4[4];
#pragma unroll
    for (int k = 0; k < 4; ++k) gg4[k] = *(const f32x4*)(g + 4 * lane + 256 * k);
    for (int t0 = (blockIdx.x * 8 + w) * NT; t0 < T; t0 += gridDim.x * 8 * NT) {
        const int b0 = t0 >> 11;
        f32x4 sc4[4], sh4[4], gt4[4];
        if (MODE != 2) {
#pragma unroll
            for (int k = 0; k < 4; ++k) { sc4[k] = *(const f32x4*)(modl + (size_t)b0 * NMOD + 1024 + 4 * lane + 256 * k); sh4[k] = *(const f32x4*)(modl + (size_t)b0 * NMOD + 4 * lane + 256 * k); }
        }
        if (MODE >= 1) {
#pragma unroll
            for (int k = 0; k < 4; ++k) gt4[k] = *(const f32x4*)(modp + (size_t)b0 * NMOD + 5 * 1024 + 4 * lane + 256 * k);
        }
        f32x4 v[NT][4];
#pragma unroll
        for (int u = 0; u < NT; ++u)
#pragma unroll
            for (int k = 0; k < 4; ++k) v[u][k] = *(const f32x4*)(xin + (size_t)(t0 + u) * D + 4 * lane + 256 * k);
        if (MODE >= 1) {
            u32x2 y0[NT][4], y1[NT][4];
#pragma unroll
            for (int u = 0; u < NT; ++u)
#pragma unroll
                for (int k = 0; k < 4; ++k) { const int col = 4 * lane + 256 * k;
                    y0[u][k] = *(const u32x2*)(p.ys + ((size_t)(t0 + u) * 2 + 0) * D + col); y1[u][k] = *(const u32x2*)(p.ys + ((size_t)(t0 + u) * 2 + 1) * D + col); }
#pragma unroll
            for (int u = 0; u < NT; ++u) {
                const int b = (t0 + u) >> 11;
#pragma unroll
                for (int k = 0; k < 4; ++k) {
                    const int col = 4 * lane + 256 * k;
                    const f32x4 gt = gt4[k];
                    v[u][k][0] += gt[0] * (bflo(y0[u][k].x) + bflo(y1[u][k].x)); v[u][k][1] += gt[1] * (bfhi(y0[u][k].x) + bfhi(y1[u][k].x));
                    v[u][k][2] += gt[2] * (bflo(y0[u][k].y) + bflo(y1[u][k].y)); v[u][k][3] += gt[3] * (bfhi(y0[u][k].y) + bfhi(y1[u][k].y));
                }
            }
        }
#pragma unroll
        for (int u = 0; u < NT; ++u) {
            const int t = t0 + u, b = t >> 11;
            float ss = 0.f;
#pragma unroll
            for (int k = 0; k < 4; ++k) ss += v[u][k][0] * v[u][k][0] + v[u][k][1] * v[u][k][1] + v[u][k][2] * v[u][k][2] + v[u][k][3] * v[u][k][3];
            ss = wave_sum(ss);
            const float r = rsqrtf(ss * (1.0f / D) + EPS);
#pragma unroll
            for (int k = 0; k < 4; ++k) {
                const int col = 4 * lane + 256 * k;
                f32x4 y = v[u][k] * r * gg4[k];
                if (MODE == 2) { *(f32x4*)(p.xo + (size_t)t * D + col) = y; }
                else {
                    if (MODE == 1) *(f32x4*)(p.xo + (size_t)t * D + col) = v[u][k];
                    y = y * (1.f + sc4[k]) + sh4[k];
                    u32x2 o; o.x = cvt_pk_bf16(y[0], y[1]); o.y = cvt_pk_bf16(y[2], y[3]);
                    *(u32x2*)(p.h + (size_t)t * D + col) = o;
                }
            }
        }
    }
}
}

namespace {
using pg8::Unit;
struct EpiStoreBf16 {
    static constexpr bool PERM = true;
    bf16_t* O; int ldc;
    __device__ __forceinline__ void operator()(const f32x4 (&acc)[2][2][4][2], const Unit& u, int wr, int wc, int fr_, int fq_) const {
        int fr = fr_, fq = fq_; asm volatile("" : "+v"(fr), "+v"(fq));
        const int row0 = u.pm * 256 + wr * 64 + fr, col0 = u.pn * 256 + wc * 32 + 8 * fq;
#pragma unroll
        for (int ai = 0; ai < 2; ++ai)
#pragma unroll
            for (int m = 0; m < 4; ++m) { bf16_t* rowp = O + (size_t)(row0 + ai * 128 + m * 16) * ldc + col0;
#pragma unroll
                for (int bj = 0; bj < 2; ++bj) { const f32x4 v0 = acc[ai][bj][m][0], v1 = acc[ai][bj][m][1];
                    u32x4 w; w.x = cvt_pk_bf16(v0[0], v0[1]); w.y = cvt_pk_bf16(v0[2], v0[3]); w.z = cvt_pk_bf16(v1[0], v1[1]); w.w = cvt_pk_bf16(v1[2], v1[3]);
                    *(u32x4*)(rowp + bj * 128) = w; } }
    }
};
struct EpiResidual {
    static constexpr bool PERM = false;
    const float* xin; float* x; const float* gate;
    __device__ __forceinline__ void operator()(const f32x4 (&acc)[2][2][4][2], const Unit& u, int wr, int wc, int fr_, int fq_) const {
        int fr = fr_, fq = fq_; asm volatile("" : "+v"(fr), "+v"(fq));
        const int row0 = u.pm * 256 + wr * 64 + fr, col0 = u.pn * 256 + wc * 32 + 4 * fq;
        const int b = (u.pm * 256) >> 11;
        f32x4 gv[2][2];
#pragma unroll
        for (int bj = 0; bj < 2; ++bj)
#pragma unroll
            for (int n = 0; n < 2; ++n) gv[bj][n] = *(const f32x4*)(gate + (size_t)b * NMOD + col0 + bj * 128 + n * 16);
#pragma unroll
        for (int ai = 0; ai < 2; ++ai)
#pragma unroll
            for (int m = 0; m < 4; ++m) { const size_t ro = (size_t)(row0 + ai * 128 + m * 16) * D + col0;
#pragma unroll
                for (int bj = 0; bj < 2; ++bj)
#pragma unroll
                    for (int n = 0; n < 2; ++n) { const size_t o = ro + bj * 128 + n * 16; *(f32x4*)(x + o) = *(const f32x4*)(xin + o) + gv[bj][n] * acc[ai][bj][m][n]; } }
    }
};
struct EpiMlaQ {
    static constexpr bool PERM = true;
    bf16_t* qm;
    __device__ __forceinline__ void operator()(const f32x4 (&acc)[2][2][4][2], const Unit& u, int wr, int wc, int fr_, int fq_) const {
        int fr = fr_, fq = fq_; asm volatile("" : "+v"(fr), "+v"(fq));
        const int row0 = u.pm * 256 + wr * 64 + fr;
#pragma unroll
        for (int bj = 0; bj < 2; ++bj) {
            const int col0 = u.pn * 256 + bj * 128 + wc * 32;
            if (col0 >= 384) continue;
#pragma unroll
            for (int ai = 0; ai < 2; ++ai)
#pragma unroll
                for (int m = 0; m < 4; ++m) { const f32x4 v0 = acc[ai][bj][m][0], v1 = acc[ai][bj][m][1];
                    u32x4 w; w.x = cvt_pk_bf16(v0[0], v0[1]); w.y = cvt_pk_bf16(v0[2], v0[3]); w.z = cvt_pk_bf16(v1[0], v1[1]); w.w = cvt_pk_bf16(v1[2], v1[3]);
                    *(u32x4*)(qm + (size_t)(row0 + ai * 128 + m * 16) * 384 + col0 + 8 * fq) = w; }
        }
    }
};
struct EpiMlaKV {
    static constexpr bool PERM = true;
    bf16_t* km; bf16_t* vm;
    __device__ __forceinline__ void operator()(const f32x4 (&acc)[2][2][4][2], const Unit& u, int wr, int wc, int fr_, int fq_) const {
        int fr = fr_, fq = fq_; asm volatile("" : "+v"(fr), "+v"(fq));
        const int row0 = u.pm * 256 + wr * 64 + fr;
#pragma unroll
        for (int bj = 0; bj < 2; ++bj) {
            const int head = u.pn * 2 + bj, wcol = wc * 32 + 8 * fq;
#pragma unroll
            for (int ai = 0; ai < 2; ++ai)
#pragma unroll
                for (int m = 0; m < 4; ++m) {
                    const int row = row0 + ai * 128 + m * 16;
                    const f32x4 v0 = acc[ai][bj][m][0], v1 = acc[ai][bj][m][1];
                    u32x4 w; w.x = cvt_pk_bf16(v0[0], v0[1]); w.y = cvt_pk_bf16(v0[2], v0[3]); w.z = cvt_pk_bf16(v1[0], v1[1]); w.w = cvt_pk_bf16(v1[2], v1[3]);
                    bf16_t* q = (wcol < 64) ? km + (size_t)row * 384 + head * 96 + wcol : vm + (size_t)row * 256 + head * 64 + (wcol - 64);
                    *(u32x4*)q = w;
                    asm volatile("" ::: "memory");
                }
        }
    }
};
struct EpiGateUp {
    static constexpr bool PERM = false;
    bf16_t* hid;
    __device__ __forceinline__ void operator()(const f32x4 (&acc)[2][2][4][2], const Unit& u, int wr, int wc, int fr_, int fq_) const {
        int fr = fr_, fq = fq_; asm volatile("" : "+v"(fr), "+v"(fq));
        const int row0 = u.pm * 256 + wr * 64 + fr;
#pragma unroll
        for (int ai = 0; ai < 2; ++ai)
#pragma unroll
            for (int m = 0; m < 4; ++m) { bf16_t* rowp = hid + (size_t)(row0 + ai * 128 + m * 16) * 256;
#pragma unroll
                for (int bj = 0; bj < 2; ++bj) { const f32x4 gt = acc[ai][bj][m][0], up = acc[ai][bj][m][1];
                    f32x4 o;
#pragma unroll
                    for (int j = 0; j < 4; ++j) o[j] = gt[j] / (1.f + __expf(-gt[j])) * up[j];
                    u32x2 w; w.x = cvt_pk_bf16(o[0], o[1]); w.y = cvt_pk_bf16(o[2], o[3]);
                    *(u32x2*)(rowp + 16 * (u.pn * 8 + bj * 4 + wc) + 4 * fq) = w; } }
    }
};
struct EpiDown {
    static constexpr bool PERM = true;
    bf16_t* ys; const int* list; const float* wl; const int* cnt;
    __device__ __forceinline__ void operator()(const f32x4 (&acc)[2][2][4][2], const Unit& u, int wr, int wc, int fr_, int fq_) const {
        int fr = fr_, fq = fq_; asm volatile("" : "+v"(fr), "+v"(fq));
        const int n = cnt[u.e]; const int* le = list + (size_t)u.e * ECAP; const float* we = wl + (size_t)u.e * ECAP;
        const int col0 = u.pn * 256 + wc * 32 + 8 * fq;
        int slot[8]; float w8[8];
#pragma unroll
        for (int q = 0; q < 8; ++q) { const int lr = u.mt * 256 + (q >> 2) * 128 + wr * 64 + (q & 3) * 16 + fr; slot[q] = lr < n ? le[lr] : -1; w8[q] = lr < n ? we[lr] : 0.f; }
#pragma unroll
        for (int ai = 0; ai < 2; ++ai)
#pragma unroll
            for (int m = 0; m < 4; ++m) {
                const int q = ai * 4 + m;
                if (slot[q] >= 0) {
                    bf16_t* rowp = ys + (size_t)slot[q] * D + col0;
#pragma unroll
                    for (int bj = 0; bj < 2; ++bj) { const f32x4 v0 = acc[ai][bj][m][0] * w8[q], v1 = acc[ai][bj][m][1] * w8[q];
                        u32x4 w; w.x = cvt_pk_bf16(v0[0], v0[1]); w.y = cvt_pk_bf16(v0[2], v0[3]); w.z = cvt_pk_bf16(v1[0], v1[1]); w.w = cvt_pk_bf16(v1[2], v1[3]);
                        *(u32x4*)(rowp + bj * 128) = w; }
                }
            }
    }
};
struct MoeOrder {
    int pre[17];
    int NT, G, c; const int* list; const int* cnt;
    __device__ __forceinline__ void init(const int* cnt_, const int* list_, int NT_, int G_, int c_) {
        cnt = cnt_; list = list_; NT = NT_; G = G_; c = c_; int a = 0;
#pragma unroll
        for (int e = 0; e < 16; ++e) { pre[e] = a; a += (cnt_[e] + 255) >> 8; }
        pre[16] = a;
    }
    __device__ __forceinline__ bool next(int i, Unit& u) const {
        const int L = i * G + c; if (L >= pre[16] * NT) return false;
        const int t = L / NT; int e = 0;
#pragma unroll
        for (int k = 1; k < 16; ++k) e += (t >= pre[k]) ? 1 : 0;
        int pe = 0;
#pragma unroll
        for (int k = 0; k < 16; ++k) pe = (k == e) ? pre[k] : pe;
        u.e = e; u.mt = t - pe; u.pm = t; u.pn = L - t * NT; return true;
    }
    __device__ __forceinline__ int arow(const Unit& u, int r) const { const int lr = u.mt * 256 + r; return lr < cnt[u.e] ? (list[(size_t)u.e * ECAP + lr] >> 1) : 0; }
};
}

namespace {
__device__ __forceinline__ void phase_prep(const Params& p, int l) {
    const int tid = opaque_tid(p.wid), w = tid >> 6, lane = tid & 63;
    const int gw = blockIdx.x * 8 + w, nw = gridDim.x * 8;
    for (int sq = gw; sq < NB * 4; sq += nw) {
        const int b = sq >> 2, hh = sq & 3; const float bias = p.b_forget[l * 4 + hh];
        float lf[32]; float run = 0.f;
#pragma unroll
        for (int j = 0; j < 32; ++j) {
            const float z = bf2f(p.proj[(size_t)(b * S + lane * 32 + j) * NP + PC_AF + hh]) + bias;
            run += fminf(z, 0.f) - log1pf(__expf(-fabsf(z)));
            lf[j] = run;
        }
        float incl = run;
#pragma unroll
        for (int o = 1; o < 64; o <<= 1) { const float t2 = __shfl_up(incl, o); if (lane >= o) incl += t2; }
        const float excl = incl - run;
#pragma unroll
        for (int j = 0; j < 32; ++j) p.cbF[(size_t)sq * S + lane * 32 + j] = -(excl + lf[j]) * LOG2E;
    }
    for (int c32 = gw; c32 < T / 32; c32 += nw) {
    float mxq = 0.f, mxk = 0.f;
    for (int it = 0; it < 32; ++it) {
        const int t = c32 * 32 + it;
        const bf16_t* row = p.proj + (size_t)t * NP;
        const u32x2 cq = *(const u32x2*)(row + PC_BCQ + 4 * lane);
        const unsigned ck = *(const unsigned*)(row + PC_BCKV + 2 * lane);
        float s1 = bflo(cq.x) * bflo(cq.x) + bfhi(cq.x) * bfhi(cq.x) + bflo(cq.y) * bflo(cq.y) + bfhi(cq.y) * bfhi(cq.y);
        float s2 = bflo(ck) * bflo(ck) + bfhi(ck) * bfhi(ck);
        s1 = wave_sum(s1); s2 = wave_sum(s2);
        if (lane < 4) *(u32x4*)(p.kidx + (size_t)t * 32 + 8 * lane) = *(const u32x4*)(row + PC_DKI + 8 * lane);
        {
            const u32x2 aq = *(const u32x2*)(row + PC_AQ + 4 * lane), ak = *(const u32x2*)(row + PC_AK + 4 * lane);
            float nq = bflo(aq.x) * bflo(aq.x) + bfhi(aq.x) * bfhi(aq.x) + bflo(aq.y) * bflo(aq.y) + bfhi(aq.y) * bfhi(aq.y);
            float nk = bflo(ak.x) * bflo(ak.x) + bfhi(ak.x) * bfhi(ak.x) + bflo(ak.y) * bflo(ak.y) + bfhi(ak.y) * bfhi(ak.y);
#pragma unroll
            for (int o = 8; o > 0; o >>= 1) { nq += __shfl_xor(nq, o); nk += __shfl_xor(nk, o); }
            mxq = fmaxf(mxq, nq); mxk = fmaxf(mxk, nk);
        }
        const float kr = (lane < 32) ? bf2f(row[PC_BKR + lane]) : 0.f;
        const float kr2 = __shfl(kr, (lane + 16) & 63);
        {
            const float r1 = rsqrtf(s1 * (1.f / 256.f) + EPS), r2 = rsqrtf(s2 * (1.f / 128.f) + EPS);
            u32x2 o; o.x = cvt_pk_bf16(bflo(cq.x) * r1, bfhi(cq.x) * r1); o.y = cvt_pk_bf16(bflo(cq.y) * r1, bfhi(cq.y) * r1);
            *(u32x2*)(p.proj + (size_t)t * NP + PC_BCQ + 4 * lane) = o;
            *(unsigned*)(p.proj + (size_t)t * NP + PC_BCKV + 2 * lane) = cvt_pk_bf16(bflo(ck) * r2, bfhi(ck) * r2);
        }
        if (lane < 16) {
            const int pos = t & (S - 1);
            const float cs = p.ropetab[(pos * 16 + lane) * 2], sn = p.ropetab[(pos * 16 + lane) * 2 + 1];
            const bf16_t o1 = f2bf(kr * cs - kr2 * sn), o2 = f2bf(kr2 * cs + kr * sn);
            bf16_t* kmr = p.km + (size_t)t * 384;
#pragma unroll
            for (int hh = 0; hh < 4; ++hh) { kmr[hh * 96 + 64 + lane] = o1; kmr[hh * 96 + 80 + lane] = o2; }
        }
    }
    if ((lane & 15) == 0) {
        const int t = c32 * 32, bb = t >> 11, pos = t & (S - 1), hh = lane >> 4;
        atomicMax(p.ctl + CW_KN2 + ((l * NB + bb) * 4 + hh) * 32 + (pos >> 6), __float_as_uint(mxk));
        atomicMax(p.ctl + CW_QN2 + ((l * NB + bb) * 4 + hh) * 8 + (pos >> 8), __float_as_uint(mxq));
    }
    }
}

__device__ __forceinline__ void phase_route(const Params& p, int l, char* lds) {
    const int tid = opaque_tid(p.wid), w = tid >> 6, lane = tid & 63;
    float* wrT = (float*)lds;
    int* lcnt = (int*)(lds + 65536);
    int* lbase = (int*)(lds + 65536 + 64);
    int* tsel = (int*)(lds + 65536 + 128);
    float* twt = (float*)(lds + 65536 + 128 + 2048);
    for (int i = tid; i < 16 * 1024; i += 512) { const int e = i >> 10, d = i & 1023; wrT[i] = p.w_router[d * 16 + e]; }
    const float* g = p.g_norm2 + l * D;
    const float* modl = p.mod + (size_t)l * NB * NMOD;
    int* cnt = (int*)(p.ctl + CW_CNT) + l * 16 + 32 * p.qslot;
    int* list = p.list + (size_t)p.qslot * 16 * ECAP;
    for (int chunk = blockIdx.x; chunk < T / 256; chunk += gridDim.x) {
        if (tid < 16) lcnt[tid] = 0;
        __syncthreads();
        const int b = (chunk * 256) >> 11;
        f32x4 gg4[4], sc4[4], sh4[4];
#pragma unroll
        for (int k = 0; k < 4; ++k) { const int col = 4 * lane + 256 * k; gg4[k] = *(const f32x4*)(g + col);
            sc4[k] = *(const f32x4*)(modl + (size_t)b * NMOD + 4 * 1024 + col); sh4[k] = *(const f32x4*)(modl + (size_t)b * NMOD + 3 * 1024 + col); }
        const int eown = ((lane >> 5) & 1) * 8 + ((lane >> 4) & 1) * 4 + ((lane >> 3) & 1) * 2 + ((lane >> 2) & 1);
        const float brown = p.b_router[eown];
        f32x4 vn[4];
#pragma unroll
        for (int k = 0; k < 4; ++k) vn[k] = *(const f32x4*)(p.xo + (size_t)(chunk * 256 + w * 32) * D + 4 * lane + 256 * k);
        for (int it = 0; it < 32; ++it) {
            const int li = w * 32 + it, t = chunk * 256 + li;
            f32x4 v[4];
#pragma unroll
            for (int k = 0; k < 4; ++k) v[k] = vn[k];
            if (it < 31) {
#pragma unroll
                for (int k = 0; k < 4; ++k) vn[k] = *(const f32x4*)(p.xo + (size_t)(t + 1) * D + 4 * lane + 256 * k);
            }
            float ss = 0.f;
#pragma unroll
            for (int k = 0; k < 4; ++k) ss += v[k][0] * v[k][0] + v[k][1] * v[k][1] + v[k][2] * v[k][2] + v[k][3] * v[k][3];
            ss = wave_sum(ss);
            const float r = rsqrtf(ss * (1.0f / D) + EPS);
            float lg[16];
#pragma unroll
            for (int e = 0; e < 16; ++e) lg[e] = 0.f;
#pragma unroll
            for (int k = 0; k < 4; ++k) {
                const int col = 4 * lane + 256 * k;
                const f32x4 y = v[k] * r * gg4[k] * (1.f + sc4[k]) + sh4[k];
                u32x2 o; o.x = cvt_pk_bf16(y[0], y[1]); o.y = cvt_pk_bf16(y[2], y[3]);
                *(u32x2*)(p.h + (size_t)t * D + col) = o;
#pragma unroll
                for (int e = 0; e < 16; ++e) { const f32x4 wv = *(const f32x4*)(wrT + e * 1024 + col); lg[e] += y[0] * wv[0] + y[1] * wv[1] + y[2] * wv[2] + y[3] * wv[3]; }
                asm volatile("" ::: "memory");
            }
            float a8[8], a4[4], a2[2], a1;
            { const bool hi = (lane & 32) != 0;
#pragma unroll
              for (int e = 0; e < 8; ++e) { const float send = hi ? lg[e] : lg[e + 8], keep = hi ? lg[e + 8] : lg[e]; a8[e] = keep + __shfl_xor(send, 32); } }
            { const bool hi = (lane & 16) != 0;
#pragma unroll
              for (int e = 0; e < 4; ++e) { const float send = hi ? a8[e] : a8[e + 4], keep = hi ? a8[e + 4] : a8[e]; a4[e] = keep + __shfl_xor(send, 16); } }
            { const bool hi = (lane & 8) != 0;
#pragma unroll
              for (int e = 0; e < 2; ++e) { const float send = hi ? a4[e] : a4[e + 2], keep = hi ? a4[e + 2] : a4[e]; a2[e] = keep + __shfl_xor(send, 8); } }
            { const bool hi = (lane & 4) != 0; const float send = hi ? a2[0] : a2[1], keep = hi ? a2[1] : a2[0]; a1 = keep + __shfl_xor(send, 4); }
            a1 += __shfl_xor(a1, 2); a1 += __shfl_xor(a1, 1);
            const float sown = 1.f / (1.f + expf(-a1)), bown = sown + brown;
            float sc[16], bi[16];
#pragma unroll
            for (int e = 0; e < 16; ++e) { const int src = ((e >> 3) & 1) * 32 + ((e >> 2) & 1) * 16 + ((e >> 1) & 1) * 8 + (e & 1) * 4;
                sc[e] = __builtin_bit_cast(float, __builtin_amdgcn_readlane(__builtin_bit_cast(int, sown), src));
                bi[e] = __builtin_bit_cast(float, __builtin_amdgcn_readlane(__builtin_bit_cast(int, bown), src)); }
            int bg = 0; float bgs = -INFINITY;
#pragma unroll
            for (int gi = 0; gi < 4; ++gi) {
                float m1 = -INFINITY, m2 = -INFINITY;
#pragma unroll
                for (int j = 0; j < 4; ++j) { const float vv = bi[gi * 4 + j]; if (vv > m1) { m2 = m1; m1 = vv; } else if (vv > m2) m2 = vv; }
                const float gs = m1 + m2; if (gs > bgs) { bgs = gs; bg = gi; }
            }
            float b4[4], s4[4];
#pragma unroll
            for (int gi = 0; gi < 4; ++gi)
#pragma unroll
                for (int j = 0; j < 4; ++j) if (gi == bg) { b4[j] = bi[gi * 4 + j]; s4[j] = sc[gi * 4 + j]; }
            int i1 = 0; float v1 = -INFINITY;
#pragma unroll
            for (int j = 0; j < 4; ++j) { if (b4[j] > v1) { v1 = b4[j]; i1 = j; } }
            int i2 = 0; float v2 = -INFINITY;
#pragma unroll
            for (int j = 0; j < 4; ++j) { if (j != i1 && b4[j] > v2) { v2 = b4[j]; i2 = j; } }
            float w1 = 0.f, w2 = 0.f;
#pragma unroll
            for (int j = 0; j < 4; ++j) { if (j == i1) w1 = s4[j]; if (j == i2) w2 = s4[j]; }
            if (lane == 0) {
                const int e1 = bg * 4 + i1, e2 = bg * 4 + i2; const float ws = w1 + w2;
                const int r1 = atomicAdd(&lcnt[e1], 1), r2 = atomicAdd(&lcnt[e2], 1);
                tsel[li * 2 + 0] = (e1 << 16) | r1; tsel[li * 2 + 1] = (e2 << 16) | r2;
                twt[li * 2 + 0] = w1 / ws; twt[li * 2 + 1] = w2 / ws;
            }
        }
        __syncthreads();
        if (tid < 16) lbase[tid] = atomicAdd(&cnt[tid], lcnt[tid]);
        __syncthreads();
        { const int v = tsel[tid], e = v >> 16, rk = v & 0xFFFF; const size_t pos = (size_t)e * ECAP + lbase[e] + rk;
          list[pos] = (chunk * 256 + (tid >> 1)) * 2 + (tid & 1); p.wl[pos + (size_t)p.qslot * 16 * ECAP] = twt[tid]; }
        __syncthreads();
    }
}
}

#ifndef ATTN_VMASK
#define ATTN_VMASK 15
#endif
#ifndef REPK_VMASK
#define REPK_VMASK 15
#endif
namespace {
constexpr int AT_KB = 0;
constexpr int AT_KR = 16384;
constexpr int AT_VB = 24576;
constexpr int AT_CB = 40960;
constexpr int AT_CTL = 41472;
constexpr int AT_LDS = 41984;
constexpr float NEGBIG = -1.0e30f;

template <int VAR, int KC>
__device__ __forceinline__ void attn_tile(LAS3 char* lds, const int buf, const int j, const int q0, const int i, const int g, const int swk, const float slope2,
                                          const bf16x8 (&qf)[2][KC], f32x4 (&o)[2][4], float (&mrow)[2], float (&lsum)[2], const u32x2 (&mw)[2]) {
    typedef LAS3 bf16x4 lds_bf16x4;
    bool need = (64 * j <= q0 + 31);
    if (VAR == 2) need = need && (64 * j + 63 >= q0 - 127);
    if (need) {
        const LAS3 char* Kb = lds + AT_KB + buf * 8192; const LAS3 char* Vb = lds + AT_VB + buf * 8192;
        bool full = (64 * j + 63 <= q0);
        if (VAR == 2) full = full && (64 * j >= q0 - 96);
        if (VAR == 3) full = false;
        f32x4 s[2][4];
#pragma unroll
        for (int qt = 0; qt < 2; ++qt) {
            const int t = q0 + 16 * qt + i;
            const int dbase = 64 * j + 4 * g - t;
            const float sb = slope2 * ((VAR == 2) ? (float)dbase : (float)(64 * j + 4 * g));
            unsigned wl = 0u, wh = 0u;
            if (VAR == 3) { const unsigned long long W = (((unsigned long long)mw[qt].y << 32) | mw[qt].x) >> (4 * g); wl = (unsigned)W; wh = (unsigned)(W >> 32); }
#pragma unroll
            for (int mt = 0; mt < 4; ++mt) {
                f32x4 ini = {0.f, 0.f, 0.f, 0.f};
                if (VAR == 0) ini = *(const LAS3 f32x4*)(lds + AT_CB + buf * 256 + (16 * mt + 4 * g) * 4);
#pragma unroll
                for (int r = 0; r < 4; ++r) {
                    const int c = 16 * mt + r;
                    float v = ini[r];
                    if (VAR >= 2) v = sb + slope2 * (float)c;
                    if (VAR == 3) {
                        const int m = ((int)((mt < 2 ? wl : wh) << (31 - (16 * (mt & 1) + r)))) >> 31;
                        v = __uint_as_float((__float_as_uint(v) & (unsigned)m) | (__float_as_uint(NEGBIG) & ~(unsigned)m));
                    } else if (!full) {
                        bool ok;
                        if (VAR == 2) ok = (unsigned)(dbase + c + 127) < 128u;
                        else ok = (dbase + c) <= 0;
                        v = ok ? v : NEGBIG;
                    }
                    ini[r] = v;
                }
                s[qt][mt] = ini;
            }
        }
#pragma unroll
        for (int mt = 0; mt < 4; ++mt) {
#pragma unroll
            for (int kc = 0; kc < 2; ++kc) {
                const bf16x8 kf = *(const LAS3 bf16x8*)(Kb + (mt * 16 + i) * 128 + (((kc * 4 + g) ^ swk) << 4));
                s[0][mt] = __builtin_amdgcn_mfma_f32_16x16x32_bf16(kf, qf[0][kc], s[0][mt], 0, 0, 0);
                s[1][mt] = __builtin_amdgcn_mfma_f32_16x16x32_bf16(kf, qf[1][kc], s[1][mt], 0, 0, 0);
            }
            if (VAR == 1) {
                const bf16x8 kf = *(const LAS3 bf16x8*)(lds + AT_KR + buf * 4096 + (mt * 16 + i) * 64 + ((g ^ (swk & 3)) << 4));
                s[0][mt] = __builtin_amdgcn_mfma_f32_16x16x32_bf16(kf, qf[0][KC - 1], s[0][mt], 0, 0, 0);
                s[1][mt] = __builtin_amdgcn_mfma_f32_16x16x32_bf16(kf, qf[1][KC - 1], s[1][mt], 0, 0, 0);
            }
        }
        bf16x8 pf[2][2];
#pragma unroll
        for (int qt = 0; qt < 2; ++qt) {
            float mx = fmaxf(fmaxf(s[qt][0][0], s[qt][0][1]), fmaxf(s[qt][0][2], s[qt][0][3]));
#pragma unroll
            for (int mt = 1; mt < 4; ++mt) mx = fmaxf(mx, fmaxf(fmaxf(s[qt][mt][0], s[qt][mt][1]), fmaxf(s[qt][mt][2], s[qt][mt][3])));
            mx = fmaxf(mx, __builtin_bit_cast(float, __builtin_amdgcn_ds_swizzle(__builtin_bit_cast(int, mx), 0x401F)));
            mx = xor32_max(mx);
            if (__any(mx > mrow[qt])) {
                const float mn = fmaxf(mrow[qt], mx), alpha = __builtin_amdgcn_exp2f(mrow[qt] - mn);
                mrow[qt] = mn; lsum[qt] *= alpha;
#pragma unroll
                for (int dt = 0; dt < 4; ++dt) o[qt][dt] = o[qt][dt] * alpha;
            }
            const float mn = mrow[qt];
            float ps = 0.f;
            float x[4][4];
#pragma unroll
            for (int mt = 0; mt < 4; ++mt)
#pragma unroll
                for (int r = 0; r < 4; ++r) { x[mt][r] = __builtin_amdgcn_exp2f(s[qt][mt][r] - mn); ps += x[mt][r]; }
            lsum[qt] += ps;
#pragma unroll
            for (int c = 0; c < 2; ++c) {
                u32x4 pk; pk.x = cvt_pk_bf16(x[2 * c][0], x[2 * c][1]); pk.y = cvt_pk_bf16(x[2 * c][2], x[2 * c][3]);
                pk.z = cvt_pk_bf16(x[2 * c + 1][0], x[2 * c + 1][1]); pk.w = cvt_pk_bf16(x[2 * c + 1][2], x[2 * c + 1][3]);
                pf[qt][c] = __builtin_bit_cast(bf16x8, pk);
            }
        }
        const int q4 = i >> 2, p4 = i & 3;
#pragma unroll
        for (int c = 0; c < 2; ++c) {
            const int row0 = 32 * c + 4 * g + q4, swv = (row0 >> 1) & 3;
#pragma unroll
            for (int dt = 0; dt < 4; ++dt) {
                const LAS3 char* a0 = Vb + row0 * 128 + ((dt ^ swv) << 5) + p4 * 8;
                const bf16x4 v0 = __builtin_amdgcn_ds_read_tr16_b64_v4i16((lds_bf16x4*)(a0));
                const bf16x4 v1 = __builtin_amdgcn_ds_read_tr16_b64_v4i16((lds_bf16x4*)(a0 + 16 * 128));
                const bf16x8 vf = {v0[0], v0[1], v0[2], v0[3], v1[0], v1[1], v1[2], v1[3]};
                o[0][dt] = __builtin_amdgcn_mfma_f32_16x16x32_bf16(vf, pf[0][c], o[0][dt], 0, 0, 0);
                o[1][dt] = __builtin_amdgcn_mfma_f32_16x16x32_bf16(vf, pf[1][c], o[1][dt], 0, 0, 0);
            }
        }
    }
}

template <int VAR>
__device__ __forceinline__ void attn_unit(const Params& p, int l, int b, int hx, int qb, LAS3 char* lds) {
    typedef LAS3 bf16x4 lds_bf16x4;
    constexpr int KC = (VAR == 1) ? 3 : 2;
    const int tid = opaque_tid(p.wid), w = __builtin_amdgcn_readfirstlane(tid >> 6), lane = tid & 63, i = lane & 15, g = lane >> 4;
    const bf16_t *Qp, *Kp, *Vp; int ldq, ldk, ldv, q0, j0, j1, ocol; float c1, slope2 = 0.f;
    if (VAR == 0) { Qp = p.proj + PC_AQ + hx * 64; Kp = p.proj + PC_AK + hx * 64; Vp = p.proj + PC_AV + hx * 64; ldq = ldk = ldv = NP;
                    q0 = qb * 256 + 32 * w; j0 = 0; j1 = 4 * qb + 3; ocol = hx * 64; c1 = 0.125f * LOG2E; }
    else if (VAR == 1) { Qp = p.qm + hx * 96; Kp = p.km + hx * 96; Vp = p.vm + hx * 64; ldq = 384; ldk = 384; ldv = 256;
                    q0 = qb * 256 + 32 * w; j0 = 0; j1 = 4 * qb + 3; ocol = 256 + hx * 64; c1 = 0.10206207261596577f * LOG2E; }
    else if (VAR == 2) { const int qh = hx * 2 + (w >> 2); Qp = p.proj + PC_CQ + qh * 64; Kp = p.proj + PC_CK + hx * 64; Vp = p.proj + PC_CV + hx * 64; ldq = ldk = ldv = NP;
                    q0 = qb * 128 + 32 * (w & 3); j0 = 2 * qb - 2 > 0 ? 2 * qb - 2 : 0; j1 = 2 * qb + 1; ocol = 512 + qh * 64; c1 = 0.125f * LOG2E;
                    slope2 = exp2f(-(float)(qh + 1)) * LOG2E; }
    else { const int hd = w >> 1; Qp = p.proj + PC_DQ + hd * 64; Kp = p.proj + PC_DK; Vp = p.proj + PC_DV; ldq = ldk = ldv = NP;
                    q0 = qb * 64 + 32 * (w & 1); j0 = 0; j1 = qb; ocol = 768 + hd * 64; c1 = 0.125f * LOG2E; slope2 = exp2f(-(float)(hd + 5)) * LOG2E; }
    const size_t tok0 = (size_t)b * S;
    if (VAR == 0 && qb > 0) {
        constexpr float FOX_DROP = 64.0f;
        const unsigned* kn2 = p.ctl + CW_KN2 + ((l * NB + b) * 4 + hx) * 32;
        const float* cbh = p.cbF + ((size_t)b * 4 + hx) * S;
        const float qn = c1 * sqrtf(__uint_as_float(p.ctl[CW_QN2 + ((l * NB + b) * 4 + hx) * 8 + qb]));
        float knu = 0.f;
        for (int jj = 4 * qb; jj < 4 * qb + 4; ++jj) knu = fmaxf(knu, __uint_as_float(kn2[jj]));
        const float lower = cbh[256 * qb] - qn * sqrtf(knu);
        int js = 0;
        while (js < 4 * qb && qn * sqrtf(__uint_as_float(kn2[js])) + cbh[64 * js + 63] - lower < -FOX_DROP) ++js;
        j0 = js;
    }
    bf16x8 qf[2][KC];
#pragma unroll
    for (int qt = 0; qt < 2; ++qt)
#pragma unroll
        for (int kc = 0; kc < KC; ++kc) qf[qt][kc] = *(const bf16x8*)(Qp + (tok0 + q0 + 16 * qt + i) * ldq + kc * 32 + 8 * g);
    if (VAR == 1) {
#pragma unroll
        for (int qt = 0; qt < 2; ++qt) {
            const int pos = q0 + 16 * qt + i;
            const u32x4 mine = __builtin_bit_cast(u32x4, qf[qt][KC - 1]);
            u32x4 oth; oth.x = __shfl_xor(mine.x, 32); oth.y = __shfl_xor(mine.y, 32); oth.z = __shfl_xor(mine.z, 32); oth.w = __shfl_xor(mine.w, 32);
            const float* rt = p.ropetab + (size_t)(pos * 16 + (g & 1) * 8) * 2;
            const float sg = (g < 2) ? -1.f : 1.f;
            u32x4 res;
#pragma unroll
            for (int e2 = 0; e2 < 4; ++e2) {
                const f32x4 cs = *(const f32x4*)(rt + e2 * 4);
                const unsigned mw_ = e2 == 0 ? mine.x : e2 == 1 ? mine.y : e2 == 2 ? mine.z : mine.w, ow_ = e2 == 0 ? oth.x : e2 == 1 ? oth.y : e2 == 2 ? oth.z : oth.w;
                const float r0 = bflo(mw_) * cs[0] + sg * bflo(ow_) * cs[1], r1 = bfhi(mw_) * cs[2] + sg * bfhi(ow_) * cs[3];
                const unsigned pk = cvt_pk_bf16(r0, r1);
                if (e2 == 0) res.x = pk; else if (e2 == 1) res.y = pk; else if (e2 == 2) res.z = pk; else res.w = pk;
            }
            qf[qt][KC - 1] = __builtin_bit_cast(bf16x8, res);
        }
    }
#pragma unroll
    for (int qt = 0; qt < 2; ++qt)
#pragma unroll
        for (int kc = 0; kc < KC; ++kc) {
            u32x4 qq = __builtin_bit_cast(u32x4, qf[qt][kc]);
            qq.x = cvt_pk_bf16(bflo(qq.x) * c1, bfhi(qq.x) * c1); qq.y = cvt_pk_bf16(bflo(qq.y) * c1, bfhi(qq.y) * c1);
            qq.z = cvt_pk_bf16(bflo(qq.z) * c1, bfhi(qq.z) * c1); qq.w = cvt_pk_bf16(bflo(qq.w) * c1, bfhi(qq.w) * c1);
            qf[qt][kc] = __builtin_bit_cast(bf16x8, qq);
        }
    f32x4 o[2][4];
#pragma unroll
    for (int qt = 0; qt < 2; ++qt)
#pragma unroll
        for (int dt = 0; dt < 4; ++dt) o[qt][dt] = (f32x4){0.f, 0.f, 0.f, 0.f};
    float mrow[2] = {NEGBIG, NEGBIG}, lsum[2] = {0.f, 0.f};
    const int sr = tid >> 3, sc8 = tid & 7;
    const int kdst = sr * 128 + ((sc8 ^ ((sr >> 1) & 7)) << 4);
    const int vdst = sr * 128 + (((((sc8 >> 1) ^ ((sr >> 1) & 3)) << 1) | (sc8 & 1)) << 4);
    const int rr = (tid & 255) >> 2, rc4 = tid & 3;
    const int rdst = rr * 64 + ((rc4 ^ ((rr >> 1) & 3)) << 4);
    u32x4 kstA, vstA, rstA = {0u, 0u, 0u, 0u}, kstB, vstB, rstB = {0u, 0u, 0u, 0u}; float cstA = 0.f, cstB = 0.f;
    u32x2 mw[2] = {{0u, 0u}, {0u, 0u}}, mwnA[2] = {{0u, 0u}, {0u, 0u}}, mwnB[2] = {{0u, 0u}, {0u, 0u}};
#define AT_LOAD(ZZ, j) do { const size_t _kr = tok0 + 64 * (j) + sr; \
        kst##ZZ = *(const u32x4*)(Kp + _kr * ldk + sc8 * 8); vst##ZZ = *(const u32x4*)(Vp + _kr * ldv + sc8 * 8); \
        if (VAR == 1 && tid < 256) rst##ZZ = *(const u32x4*)(Kp + (tok0 + 64 * (j) + rr) * ldk + 64 + rc4 * 8); \
        if (VAR == 0 && tid < 64) cst##ZZ = p.cbF[((size_t)b * 4 + hx) * S + 64 * (j) + tid]; \
        if (VAR == 3) { _Pragma("unroll") for (int _q = 0; _q < 2; ++_q) mwn##ZZ[_q] = *(const u32x2*)(p.mask + (tok0 + q0 + 16 * _q + i) * 64 + 2 * (j)); } } while (0)
#define AT_WRITE(ZZ, buf) do { *(LAS3 u32x4*)(lds + AT_KB + (buf) * 8192 + kdst) = kst##ZZ; *(LAS3 u32x4*)(lds + AT_VB + (buf) * 8192 + vdst) = vst##ZZ; \
        if (VAR == 1 && tid < 256) *(LAS3 u32x4*)(lds + AT_KR + (buf) * 4096 + rdst) = rst##ZZ; \
        if (VAR == 0 && tid < 64) *(LAS3 float*)(lds + AT_CB + (buf) * 256 + tid * 4) = cst##ZZ; \
        if (VAR == 3) { mw[0] = mwn##ZZ[0]; mw[1] = mwn##ZZ[1]; } } while (0)
    AT_LOAD(A, j0);
    if (j0 + 1 <= j1) AT_LOAD(B, j0 + 1);
    AT_WRITE(A, j0 & 1);
    __syncthreads();
    const int swk = (i >> 1) & 7;
    for (int j = j0; j <= j1; j += 2) {
        if (j + 2 <= j1) AT_LOAD(A, j + 2);
        attn_tile<VAR, KC>(lds, j & 1, j, q0, i, g, swk, slope2, qf, o, mrow, lsum, mw);
        if (j + 1 <= j1) AT_WRITE(B, (j + 1) & 1);
        __syncthreads();
        if (j + 1 > j1) break;
        if (j + 3 <= j1) AT_LOAD(B, j + 3);
        attn_tile<VAR, KC>(lds, (j + 1) & 1, j + 1, q0, i, g, swk, slope2, qf, o, mrow, lsum, mw);
        if (j + 2 <= j1) AT_WRITE(A, j & 1);
        __syncthreads();
    }
#undef AT_LOAD
#undef AT_WRITE
#pragma unroll
    for (int qt = 0; qt < 2; ++qt) {
        float lt = lsum[qt]; lt += __shfl_xor(lt, 16); lt += __shfl_xor(lt, 32);
        if (VAR == 2) lt += __builtin_amdgcn_exp2f(p.sinks[l * 4 + hx * 2 + (w >> 2)] * LOG2E - mrow[qt]);
        const float inv = 1.f / lt;
        bf16_t* op = p.merged + (tok0 + q0 + 16 * qt + i) * D + ocol + 4 * g;
#pragma unroll
        for (int dt = 0; dt < 4; ++dt) { const f32x4 v = o[qt][dt] * inv; u32x2 w2; w2.x = cvt_pk_bf16(v[0], v[1]); w2.y = cvt_pk_bf16(v[2], v[3]); *(u32x2*)(op + 16 * dt) = w2; }
    }
}

__device__ __forceinline__ void phase_attn(const Params& p, int l, LAS3 char* lds) {
    const int tid = opaque_tid(p.wid);
    unsigned* qhead = p.ctl + CW_QA + 64 * (l + 2 * p.qslot);
    volatile LAS3 int* bc = (volatile LAS3 int*)(lds + AT_CTL);
    int nxt = 0;
    if (tid == 0) nxt = (int)__hip_atomic_fetch_add(qhead, 1u, __ATOMIC_RELAXED, __HIP_MEMORY_SCOPE_AGENT);
    for (;;) {
        if (tid == 0) *bc = nxt;
        __syncthreads();
        const int idx = __builtin_amdgcn_readfirstlane(*bc);
        __syncthreads();
        if (idx >= 4096) break;
        if (tid == 0) nxt = (int)__hip_atomic_fetch_add(qhead, 1u, __ATOMIC_RELAXED, __HIP_MEMORY_SCOPE_AGENT);
        const int vmask = p.qslot ? REPK_VMASK : ATTN_VMASK;
        if (idx < 3072) {
            const int lvl = 7 - idx / 384, rem = idx % 384;
            if (rem < 128) { if (vmask & 2) attn_unit<1>(p, l, rem >> 2, rem & 3, lvl, lds); }
            else if (rem < 256) { if (vmask & 1) attn_unit<0>(p, l, (rem - 128) >> 2, rem & 3, lvl, lds); }
            else { const int d = rem - 256; if (vmask & 8) attn_unit<3>(p, l, d & 31, 0, 4 * lvl + 3 - (d >> 5), lds); }
        } else { const int c = idx - 3072; if (vmask & 4) attn_unit<2>(p, l, c >> 5, (c >> 4) & 1, c & 15, lds); }
    }
}
}

namespace {
constexpr int DS_LD = 2052;
constexpr int DS_CTL = 16 * DS_LD * 4;
constexpr int DS_LDS = DS_CTL + 64;

__device__ __forceinline__ void dsa_unit(const Params& p, int u, LAS3 char* lds) {
    const int tid = opaque_tid(p.wid), w = __builtin_amdgcn_readfirstlane(tid >> 6), lane = tid & 63, i = lane & 15, g = lane >> 4;
    const int b = u >> 7, t0 = (u & 127) * 16;
    const size_t tok0 = (size_t)b * S;
    uint32_t* mbase = p.mask + (tok0 + t0) * 64;
    if (t0 + 16 <= 256) {
#pragma unroll
        for (int qq = 0; qq < 2; ++qq) {
            const int q = 2 * w + qq, n = t0 + q + 1;
            if (lane < 32) { const int lo = lane * 64; unsigned long long bits = (n >= lo + 64) ? ~0ull : (n <= lo ? 0ull : ((1ull << (n - lo)) - 1ull));
                u32x2 o; o.x = (unsigned)bits; o.y = (unsigned)(bits >> 32); *(u32x2*)(mbase + q * 64 + 2 * lane) = o; }
        }
        return;
    }
    const int nreg = (t0 + 16 + 63) >> 6;
    const int ntile = nreg * 4;
    bf16x8 qf[8]; float wq[8];
    {
        const bf16_t* qrow = p.proj + (tok0 + t0 + i) * NP;
#pragma unroll
        for (int h = 0; h < 8; ++h) qf[h] = *(const bf16x8*)(qrow + PC_DQI + h * 32 + 8 * g);
        const u32x4 ww = *(const u32x4*)(qrow + PC_DWI);
        const float sc = 0.35355339059327373f * 0.17677669529663687f;
        wq[0] = bflo(ww.x) * sc; wq[1] = bfhi(ww.x) * sc; wq[2] = bflo(ww.y) * sc; wq[3] = bfhi(ww.y) * sc;
        wq[4] = bflo(ww.z) * sc; wq[5] = bfhi(ww.z) * sc; wq[6] = bflo(ww.w) * sc; wq[7] = bfhi(ww.w) * sc;
    }
    const int tq = t0 + i;
#ifndef DSA_EXP
#define DSA_EXP 0
#endif
    const bool exp_skip_score = (DSA_EXP == 2) && p.qslot > 0, exp_skip_sel = (DSA_EXP == 1) && p.qslot > 0, exp_nostore = (DSA_EXP != 0) && p.qslot > 0;
    if (!exp_skip_score)
    for (int base = w; base < ntile; base += 32) {
        bf16x8 kf4[4];
#pragma unroll
        for (int uu = 0; uu < 4; ++uu) { const int kt = base + 8 * uu; if (kt < ntile) kf4[uu] = *(const bf16x8*)(p.kidx + (tok0 + 16 * kt + i) * 32 + 8 * g); }
#pragma unroll
        for (int uu = 0; uu < 4; ++uu) {
            const int kt = base + 8 * uu;
            if (kt < ntile) {
                f32x4 sc4 = {0.f, 0.f, 0.f, 0.f};
#pragma unroll
                for (int h = 0; h < 8; ++h) {
                    const f32x4 c = __builtin_amdgcn_mfma_f32_16x16x32_bf16(kf4[uu], qf[h], (f32x4){0.f, 0.f, 0.f, 0.f}, 0, 0, 0);
#pragma unroll
                    for (int r = 0; r < 4; ++r) sc4[r] += wq[h] * fmaxf(c[r], 0.f);
                }
                u32x4 ko;
#pragma unroll
                for (int r = 0; r < 4; ++r) {
                    const int key = 16 * kt + 4 * g + r;
                    unsigned uu2 = __float_as_uint(sc4[r]); if (uu2 == 0x80000000u) uu2 = 0u;
                    uu2 = (uu2 & 0x80000000u) ? ~uu2 : (uu2 | 0x80000000u);
                    ko[r] = (key <= tq) ? uu2 : 0u;
                }
                *(LAS3 u32x4*)(lds + ((size_t)i * DS_LD + 16 * kt + 4 * g) * 4) = ko;
            }
        }
    }
    __syncthreads();
    if (!exp_skip_sel)
    {
        const int qA = 2 * w, qB = 2 * w + 1, nA = t0 + qA + 1, nB = t0 + qB + 1;
        const LAS3 unsigned* kpA = (const LAS3 unsigned*)(lds + (size_t)qA * DS_LD * 4);
        const LAS3 unsigned* kpB = (const LAS3 unsigned*)(lds + (size_t)qB * DS_LD * 4);
        unsigned keyA[32], keyB[32];
        const int nv = nreg * 64;
#pragma unroll
        for (int r = 0; r < 32; ++r) {
            int idx = r * 64 + lane; asm volatile("" : "+v"(idx));
            const unsigned va = kpA[r * 64 + lane], vb = kpB[r * 64 + lane];
            keyA[r] = (idx < nv) ? va : 0u; keyB[r] = (idx < nv) ? vb : 0u;
        }
        unsigned thrA = (nA <= 256) ? 1u : 0u, thrB = (nB <= 256) ? 1u : 0u;
        bool exA = (nA <= 256), exB = (nB <= 256);
        for (int bit = 31; bit >= 0; --bit) {
            if (exA && exB) break;
            const unsigned cA = exA ? 0xFFFFFFFFu : (thrA | (1u << bit)), cB = exB ? 0xFFFFFFFFu : (thrB | (1u << bit));
            int na = 0, nb = 0;
#pragma unroll
            for (int gq = 0; gq < 4; ++gq) if (nreg > 8 * gq) {
#pragma unroll
                for (int r = 8 * gq; r < 8 * gq + 8; ++r) { na += (keyA[r] >= cA) ? 1 : 0; nb += (keyB[r] >= cB) ? 1 : 0; } }
            na = wave_reduce_add(na); nb = wave_reduce_add(nb);
            if (!exA && na >= 256) { thrA = cA; exA = (na == 256); }
            if (!exB && nb >= 256) { thrB = cB; exB = (nb == 256); }
        }
#pragma unroll 1
        for (int qq = 0; qq < 2; ++qq) {
            const unsigned thr = qq ? thrB : thrA; const bool exact = qq ? exB : exA;
            unsigned long long mine = 0ull;
            int need = 0, running = 0;
            if (!exact) { int ngt = 0;
#pragma unroll
                for (int r = 0; r < 32; ++r) ngt += ((qq ? keyB[r] : keyA[r]) > thr) ? 1 : 0;
                need = 256 - wave_reduce_add(ngt); }
            const unsigned long long lt = (lane == 0) ? 0ull : (~0ull >> (64 - lane));
#pragma unroll
            for (int r = 0; r < 32; ++r) if (nreg > (r & ~7)) {
                const unsigned key = qq ? keyB[r] : keyA[r];
                unsigned long long bs;
                if (exact) bs = __ballot(key >= thr);
                else {
                    const bool eq = key == thr;
                    const unsigned long long be = __ballot(eq);
                    const int rank = running + __popcll(be & lt);
                    bs = __ballot((key > thr) || (eq && rank < need));
                    running += __popcll(be);
                }
                { int ln = lane; asm volatile("" : "+v"(ln)); if (ln == r) mine = bs; }
            }
            if (lane < 32 && !exp_nostore) { u32x2 o; o.x = (unsigned)mine; o.y = (unsigned)(mine >> 32); *(u32x2*)(mbase + (2 * w + qq) * 64 + 2 * lane) = o; }
        }
    }
    __syncthreads();
}

__device__ __forceinline__ void phase_dsa(const Params& p, int l, LAS3 char* lds) {
    const int tid = opaque_tid(p.wid);
    unsigned* qhead = p.ctl + CW_QD + 64 * (l + 2 * p.qslot);
    volatile LAS3 int* bc = (volatile LAS3 int*)(lds + DS_CTL);
    int nxt = 0;
    if (tid == 0) nxt = (int)__hip_atomic_fetch_add(qhead, 1u, __ATOMIC_RELAXED, __HIP_MEMORY_SCOPE_AGENT);
    for (;;) {
        if (tid == 0) *bc = nxt;
        __syncthreads();
        const int idx = __builtin_amdgcn_readfirstlane(*bc);
        __syncthreads();
        if (idx >= 4096) break;
        if (tid == 0) nxt = (int)__hip_atomic_fetch_add(qhead, 1u, __ATOMIC_RELAXED, __HIP_MEMORY_SCOPE_AGENT);
        const int pb = 127 - (idx >> 5), b = idx & 31;
        dsa_unit(p, b * 128 + pb, lds);
    }
}
}

namespace {
constexpr int LDS_BYTES = 147456;
constexpr int NTHREADS = 512;

template <int PH>
__device__ __forceinline__ void run_phase(const Params& p, int l, unsigned char* smem) {
    LAS3 char* lds = (LAS3 char*)smem;
    PG8_LAS unsigned char* glds = (PG8_LAS unsigned char*)smem;
    const int G = gridDim.x, c = blockIdx.x;
    if constexpr (PH == 0) phase_p0(p, (char*)smem);
    if constexpr (PH == 1) { if (l == 0) phase_norm1<0>(p, 0); else phase_norm1<1>(p, l); }
    if constexpr (PH == 2) { pg8::Gemm g{p.h, p.WinT + (size_t)l * NP * D, D, D, 0}; pg8::StaticOrder S; S.init(T, NP, G, c);
        EpiStoreBf16 E{p.proj, NP}; pg8::gemm_phase<EpiStoreBf16, pg8::StaticOrder, false>(glds, g, S, E, p.wid); }
    if constexpr (PH == 3) phase_prep(p, l);
    if constexpr (PH == 4) { pg8::Gemm g{p.proj + PC_BCQ, p.WqT + (size_t)l * 512 * 256, 256, NP, 0}; pg8::StaticOrder S; S.init(T, 512, G, c);
          EpiMlaQ E{p.qm}; pg8::gemm_phase<EpiMlaQ, pg8::StaticOrder, false>(glds, g, S, E, p.wid); }
    if constexpr (PH == 12) { pg8::Gemm g{p.proj + PC_BCKV, p.WkvT + (size_t)l * 512 * 128, 128, NP, 0}; pg8::StaticOrder S; S.init(T, 512, G, c);
          EpiMlaKV E{p.km, p.vm}; pg8::gemm_phase<EpiMlaKV, pg8::StaticOrder, false>(glds, g, S, E, p.wid); }
    if constexpr (PH == 13) phase_dsa(p, l, lds);
    if constexpr (PH == 5) phase_attn(p, l, lds);
    if constexpr (PH == 6) { pg8::Gemm g{p.merged, p.WoutT + (size_t)l * D * D, D, D, 0}; pg8::StaticOrder S; S.init(T, D, G, c);
        EpiResidual E{l == 0 ? p.x : p.xo, p.xo, p.mod + (size_t)l * NB * NMOD + 2 * 1024}; pg8::gemm_phase<EpiResidual, pg8::StaticOrder, false>(glds, g, S, E, p.wid); }
    if constexpr (PH == 7) phase_route(p, l, (char*)smem);
    if constexpr (PH == 8) { const int* cnt = (const int*)(p.ctl + CW_CNT) + l * 16;
        pg8::Gemm g{p.h, p.WguT + (size_t)l * 16 * 512 * 1024, 1024, D, (size_t)512 * 1024}; MoeOrder S; S.init(cnt, p.list, 2, G, c);
        EpiGateUp E{p.hid}; pg8::gemm_phase<EpiGateUp, MoeOrder, true>(glds, g, S, E, p.wid); }
    if constexpr (PH == 9) { const int* cnt = (const int*)(p.ctl + CW_CNT) + l * 16;
        pg8::Gemm g{p.hid, p.WdT + (size_t)l * 16 * 1024 * 256, 256, 256, (size_t)1024 * 256}; MoeOrder S; S.init(cnt, p.list, 4, G, c);
        EpiDown E{p.ys, p.list, p.wl, cnt}; pg8::gemm_phase<EpiDown, MoeOrder, false>(glds, g, S, E, p.wid); }
    if constexpr (PH == 10) phase_norm1<2>(p, 1);
    if constexpr (PH == 11) phase_norm1<0>(p, l);
}
template <int PH>
__global__ void __launch_bounds__(NTHREADS, 2) k_ph(Params p, int l) {
    extern __shared__ __attribute__((aligned(16))) unsigned char smem[];
    p.wid = __builtin_amdgcn_readfirstlane(threadIdx.x >> 6); p.qslot = p.qslot_host;
    run_phase<PH>(p, l, smem);
}
}


namespace {
#ifndef REP_PH
#define REP_PH -1
#endif
#define REP(X, l) do { if (REP_PH == X) { xcd_barrier(bar); phase<X>(l, smem, wid, 1); } } while (0)
struct KArgs { const float* in[20]; float* xo; char* ws; };
constexpr size_t al256(size_t b) { return (b + 255) & ~(size_t)255; }
constexpr size_t WS_CTL = 0;
constexpr size_t WS_MOD = WS_CTL + al256((size_t)CW_WORDS * 4);
constexpr size_t WS_WIN = WS_MOD + al256((size_t)2 * NB * NMOD * 4);
constexpr size_t WS_WOUT = WS_WIN + al256((size_t)2 * NP * D * 2);
constexpr size_t WS_WQ = WS_WOUT + al256((size_t)2 * D * D * 2);
constexpr size_t WS_WKV = WS_WQ + al256((size_t)2 * 512 * 256 * 2);
constexpr size_t WS_WGU = WS_WKV + al256((size_t)2 * 512 * 128 * 2);
constexpr size_t WS_WD = WS_WGU + al256((size_t)2 * 16 * 512 * 1024 * 2);
constexpr size_t WS_ROPE = WS_WD + al256((size_t)2 * 16 * 1024 * 256 * 2);
constexpr size_t WS_RQ = WS_ROPE + al256((size_t)2048 * 16 * 2 * 4);
constexpr size_t WS_RKV = WS_RQ + al256((size_t)T * 4);
constexpr size_t WS_CBF = WS_RKV + al256((size_t)T * 4);
constexpr size_t WS_KIDX = WS_CBF + al256((size_t)NB * 4 * S * 4);
constexpr size_t WS_MASK = WS_KIDX + al256((size_t)T * 32 * 2);
constexpr size_t WS_LIST = WS_MASK + al256((size_t)T * 64 * 4);
constexpr size_t WS_RW = WS_LIST + al256((size_t)2 * 16 * ECAP * 4);
constexpr size_t WS_WL = WS_RW + al256((size_t)T * 2 * 4);
constexpr size_t WS_H = WS_WL + al256((size_t)2 * 16 * ECAP * 4);
constexpr size_t WS_PROJ = WS_H + al256((size_t)T * D * 2);
constexpr size_t WS_QM = WS_PROJ + al256((size_t)T * NP * 2);
constexpr size_t WS_KM = WS_QM + al256((size_t)T * 384 * 2);
constexpr size_t WS_VM = WS_KM + al256((size_t)T * 384 * 2);
constexpr size_t WS_MERGED = WS_VM + al256((size_t)T * 256 * 2);
constexpr size_t WS_END1 = WS_MERGED + al256((size_t)T * D * 2);
constexpr size_t WS_HID = WS_PROJ;
constexpr size_t WS_YS = WS_HID + al256((size_t)HIDROWS * 256 * 2);
constexpr size_t WS_END2 = WS_YS + al256((size_t)T * 2 * D * 2);
constexpr size_t WS_NEED = WS_END1 > WS_END2 ? WS_END1 : WS_END2;
static_assert(WS_END2 <= WS_MERGED, "MoE overlay must not reach the merged buffer");

__device__ __forceinline__ Params make_params(const KArgs& a) {
    Params p;
    p.x = a.in[0]; p.c = a.in[1]; p.w_ada = a.in[2]; p.b_ada = a.in[3]; p.g_norm1 = a.in[4]; p.w_in = a.in[5]; p.b_forget = a.in[6]; p.g_q_mla = a.in[7];
    p.w_q_up = a.in[8]; p.g_kv_mla = a.in[9]; p.w_kv_up = a.in[10]; p.sinks = a.in[11]; p.w_out = a.in[12]; p.g_norm2 = a.in[13]; p.w_router = a.in[14];
    p.b_router = a.in[15]; p.w_gate = a.in[16]; p.w_up = a.in[17]; p.w_down = a.in[18]; p.g_final = a.in[19];
    p.xo = a.xo; char* ws = a.ws;
    p.ctl = (unsigned*)(ws + WS_CTL); p.mod = (float*)(ws + WS_MOD); p.WinT = (bf16_t*)(ws + WS_WIN); p.WoutT = (bf16_t*)(ws + WS_WOUT);
    p.WqT = (bf16_t*)(ws + WS_WQ); p.WkvT = (bf16_t*)(ws + WS_WKV); p.WguT = (bf16_t*)(ws + WS_WGU); p.WdT = (bf16_t*)(ws + WS_WD);
    p.ropetab = (float*)(ws + WS_ROPE); p.rq = (float*)(ws + WS_RQ); p.rkv = (float*)(ws + WS_RKV); p.cbF = (float*)(ws + WS_CBF); p.kidx = (bf16_t*)(ws + WS_KIDX);
    p.mask = (uint32_t*)(ws + WS_MASK); p.list = (int*)(ws + WS_LIST); p.rw = (float*)(ws + WS_RW); p.wl = (float*)(ws + WS_WL); p.h = (bf16_t*)(ws + WS_H);
    p.proj = (bf16_t*)(ws + WS_PROJ); p.qm = (bf16_t*)(ws + WS_QM); p.km = (bf16_t*)(ws + WS_KM); p.vm = (bf16_t*)(ws + WS_VM);
    p.merged = (bf16_t*)(ws + WS_MERGED); p.hid = (bf16_t*)(ws + WS_HID); p.ys = (bf16_t*)(ws + WS_YS);
    return p;
}
template <int PH>
__device__ __forceinline__ void phase(int l, unsigned char* smem, int wid, int qslot = 0) {
    typedef const __attribute__((address_space(4))) KArgs* KA4;
    KA4 ka = (KA4)__builtin_amdgcn_kernarg_segment_ptr();
    asm volatile("" : "+s"(ka));
    KArgs a;
#pragma unroll
    for (int i = 0; i < 20; ++i) a.in[i] = ka->in[i];
    a.xo = ka->xo; a.ws = ka->ws;
    Params p = make_params(a); p.wid = wid; p.qslot = qslot; p.qslot_host = 0;
    run_phase<PH>(p, l, smem);
}
__global__ void __launch_bounds__(NTHREADS, 2) fwd(KArgs args) {
    extern __shared__ __attribute__((aligned(16))) unsigned char smem[];
    volatile LAS unsigned* st = (volatile LAS unsigned*)(smem + LDS_BYTES - 16);
    const int wid = __builtin_amdgcn_readfirstlane(threadIdx.x >> 6);
    if (xb_leader(wid)) { st[0] = 0u; st[1] = 0u; st[2] = 0u; st[3] = 0u; }
    __syncthreads();
    XcdBarrier bar = xcd_barrier_post((unsigned*)(args.ws + WS_CTL) + CW_BAR, st, wid);
    phase<0>(0, smem, wid);  REP(0, 0);
    xcd_barrier(bar);
#define LAYER(l) do { \
        phase<1>(l, smem, wid);  if (l == 0) REP(1, l); xcd_barrier(bar); \
        phase<2>(l, smem, wid);  REP(2, l); xcd_barrier(bar); \
        phase<3>(l, smem, wid);  REP(3, l); xcd_barrier(bar); \
        phase<4>(l, smem, wid);  REP(4, l); phase<12>(l, smem, wid);  REP(12, l); phase<13>(l, smem, wid);  REP(13, l); xcd_barrier(bar); \
        phase<5>(l, smem, wid);  REP(5, l); xcd_barrier(bar); \
        phase<6>(l, smem, wid);  xcd_barrier(bar); \
        phase<7>(l, smem, wid);  REP(7, l); xcd_barrier(bar); \
        phase<8>(l, smem, wid);  REP(8, l); xcd_barrier(bar); \
        phase<9>(l, smem, wid);  REP(9, l); xcd_barrier(bar); } while (0)
    LAYER(0);
    LAYER(1);
#ifdef REP_BAR
    for (int rb = 0; rb < REP_BAR; ++rb) xcd_barrier(bar);
#endif
    phase<10>(1, smem, wid);
}
}

extern "C" void kernel_launch(void* const* d_in, const int* in_sizes, int n_in, void* d_out, int out_size, void* d_ws, size_t ws_size,
                              hipStream_t stream) {
    KArgs a{};
    for (int i = 0; i < 20; ++i) a.in[i] = (const float*)d_in[i];
    a.xo = (float*)d_out; a.ws = (char*)d_ws;
    if (WS_NEED > ws_size) return;

    static int grid = 0;
    if (!grid) {
        int dev = 0, cus = 0, per_cu = 0;
        (void)hipGetDevice(&dev);
        (void)hipDeviceGetAttribute(&cus, hipDeviceAttributeMultiprocessorCount, dev);
        (void)hipFuncSetAttribute((const void*)fwd, hipFuncAttributeMaxDynamicSharedMemorySize, LDS_BYTES);
        (void)hipOccupancyMaxActiveBlocksPerMultiprocessor(&per_cu, (const void*)fwd, NTHREADS, LDS_BYTES);
        grid = cus > 0 ? cus : 256;
    }
    (void)hipMemsetAsync(a.ws + WS_CTL, 0, (size_t)CW_WORDS * 4, stream);
    fwd<<<dim3(grid), dim3(NTHREADS), LDS_BYTES, stream>>>(a);
}
```

```cpp
#include <hip/hip_runtime.h>
#include <stdint.h>
#define XB_TMO      128
#define XB_XCNT(j)  (256  + 64 * (j))
#define XB_XSUB(j)  (1280 + 64 * (j))
#define XB_XGEN(j)  (2304 + 64 * (j))
#define XB_TOP      3328
#define XB_TOPGEN   3392
#define XCD_BAR_WORDS 3456
#define XB_SPIN_CAP (1u << 20)
#define LAS __attribute__((address_space(3)))

__device__ __forceinline__ unsigned xb_ld(unsigned* p)              { return __hip_atomic_load(p, __ATOMIC_RELAXED, __HIP_MEMORY_SCOPE_AGENT); }
__device__ __forceinline__ unsigned xb_add(unsigned* p, unsigned v) { return __hip_atomic_fetch_add(p, v, __ATOMIC_RELAXED, __HIP_MEMORY_SCOPE_AGENT); }
__device__ __forceinline__ unsigned xb_xcc_id() { return (unsigned)__builtin_amdgcn_s_getreg((3 << 11) | 20) & 0xFu; }
#define XB_SPIN(cond, bar) do { unsigned _sp = 0; while (cond) { __builtin_amdgcn_s_sleep(1); \
    if ((++_sp & 255u) == 0u) { if (xb_ld(&(bar)[XB_TMO])) break; if (_sp > XB_SPIN_CAP) { atomicAdd(&(bar)[XB_TMO], 1u); break; } } } } while (0)

struct XcdBarrier { unsigned* bar; unsigned x; volatile LAS unsigned* st; int wid; };
__device__ __forceinline__ bool xb_leader(int wid) { return wid == 0 && __builtin_amdgcn_mbcnt_hi(~0u, __builtin_amdgcn_mbcnt_lo(~0u, 0u)) == 0u; }

__device__ __forceinline__ XcdBarrier xcd_barrier_post(unsigned* bar, volatile LAS unsigned* st, int wid) {
    XcdBarrier b; b.bar = bar; b.x = xb_xcc_id(); b.st = st; b.wid = wid;
    if (xb_leader(wid)) (void)xb_add(&bar[XB_XCNT(b.x)], 1u);
    return b;
}
__device__ __forceinline__ void xcd_barrier_complete(unsigned* bar, unsigned x, unsigned& nloc, unsigned& nx) {
    const unsigned G = gridDim.x * gridDim.y * gridDim.z;
    unsigned sum, cnt, mine, sp = 0u;
    for (;;) {
        sum = 0u; cnt = 0u; mine = 0u;
#pragma unroll
        for (unsigned j = 0; j < 16; ++j) { const unsigned c = xb_ld(&bar[XB_XCNT(j)]); sum += c; cnt += (c > 0u) ? 1u : 0u; mine = (j == x) ? c : mine; }
        if (sum == G) break;
        __builtin_amdgcn_s_sleep(1);
        if ((++sp & 255u) == 0u) { if (xb_ld(&bar[XB_TMO])) break; if (sp > XB_SPIN_CAP) { atomicAdd(&bar[XB_TMO], 1u); break; } }
    }
    nloc = mine > 0u ? mine : 1u; nx = cnt > 0u ? cnt : 1u;
}
__device__ __forceinline__ void xcd_barrier(const XcdBarrier& b) {
    asm volatile("s_waitcnt vmcnt(0)" ::: "memory");
    __syncthreads();
    if (xb_leader(b.wid)) {
        unsigned* bar = b.bar;
        __builtin_amdgcn_s_waitcnt(0);
        unsigned nloc = b.st[0], nx = b.st[1];
        if (nloc == 0u) { xcd_barrier_complete(bar, b.x, nloc, nx); b.st[0] = nloc; b.st[1] = nx; }
        const unsigned old = xb_add(&bar[XB_XSUB(b.x)], 1u);
        const unsigned gen = old / nloc;
        if (old + 1u == (gen + 1u) * nloc) {
            __builtin_amdgcn_fence(__ATOMIC_RELEASE, "agent");
            asm volatile("s_waitcnt vmcnt(0)" ::: "memory");
            const unsigned og = xb_add(&bar[XB_TOP], 1u);
            const unsigned tg = og / nx;
            if (og + 1u == (tg + 1u) * nx) xb_add(&bar[XB_TOPGEN], 1u);
            else XB_SPIN(xb_ld(&bar[XB_TOPGEN]) == tg, bar);
            __builtin_amdgcn_fence(__ATOMIC_ACQUIRE, "agent");
            xb_add(&bar[XB_XGEN(b.x)], 1u);
            asm volatile("s_waitcnt vmcnt(0)" ::: "memory");
        } else {
            XB_SPIN(xb_ld(&bar[XB_XGEN(b.x)]) == gen, bar);
            __builtin_amdgcn_fence(__ATOMIC_ACQUIRE, "agent");
            asm volatile("s_waitcnt vmcnt(0)" ::: "memory");
        }
    }
    __syncthreads();
}

#define LAS3 __attribute__((address_space(3)))
namespace {
typedef unsigned short bf16_t;
typedef short bf16x8 __attribute__((ext_vector_type(8)));
typedef short bf16x4 __attribute__((ext_vector_type(4)));
typedef float f32x4 __attribute__((ext_vector_type(4)));
typedef float f32x2 __attribute__((ext_vector_type(2)));
typedef unsigned u32x4 __attribute__((ext_vector_type(4)));
typedef unsigned u32x2 __attribute__((ext_vector_type(2)));

constexpr int D = 1024, NB = 32, S = 2048, T = NB * S, NIN = 2380, NP = 2560, NMOD = 6144;
constexpr int OFF_AQ = 0, OFF_AK = 256, OFF_AV = 512, OFF_AF = 768, OFF_BCQ = 772, OFF_BCKV = 1028, OFF_BKR = 1156,
              OFF_CQ = 1188, OFF_CK = 1444, OFF_CV = 1572, OFF_DQ = 1700, OFF_DK = 1956, OFF_DV = 2020,
              OFF_DQI = 2084, OFF_DKI = 2340, OFF_DWI = 2372;
constexpr int PC_AQ = 0, PC_AK = 256, PC_AV = 512, PC_BCQ = 768, PC_BCKV = 1024, PC_BKR = 1152, PC_CQ = 1184, PC_CK = 1440, PC_CV = 1568,
              PC_DQ = 1696, PC_DK = 1952, PC_DV = 2016, PC_DQI = 2080, PC_DKI = 2336, PC_DWI = 2368, PC_AF = 2376;
constexpr float EPS = 1e-6f;
constexpr float LOG2E = 1.4426950408889634f;
constexpr int ECAP = T;
constexpr int HIDROWS = 2 * T + 16 * 256;

__host__ __device__ __forceinline__ int orig_col(int n) { return n < 768 ? n : (n < 2376 ? n + 4 : (n < 2380 ? n - 1608 : -1)); }
__device__ __forceinline__ int opaque_tid(int wid) {
    int t = wid * 64 + (int)__builtin_amdgcn_mbcnt_hi(~0u, __builtin_amdgcn_mbcnt_lo(~0u, 0u));
    asm volatile("" : "+v"(t)); return t; }
__device__ __forceinline__ float bf2f(bf16_t v) { return __uint_as_float((unsigned)v << 16); }
__device__ __forceinline__ bf16_t f2bf(float f) { unsigned u = __float_as_uint(f); u += 0x7FFFu + ((u >> 16) & 1u); return (bf16_t)(u >> 16); }
typedef __bf16 bf16x2_native __attribute__((ext_vector_type(2)));
__device__ __forceinline__ unsigned cvt_pk_bf16(float lo, float hi) { const f32x2 v = {lo, hi}; return __builtin_bit_cast(unsigned, __builtin_convertvector(v, bf16x2_native)); }
__device__ __forceinline__ float bflo(unsigned w) { return __uint_as_float(w << 16); }
__device__ __forceinline__ float bfhi(unsigned w) { return __uint_as_float(w & 0xFFFF0000u); }
__device__ __forceinline__ float wave_sum(float v) {
#pragma unroll
    for (int o = 32; o > 0; o >>= 1) v += __shfl_xor(v, o);
    return v;
}
__device__ __forceinline__ float xor32_max(float x) {
    float a = x, b = x;
    asm volatile("s_nop 1\n\tv_permlane32_swap_b32 %0, %1\n\ts_nop 1" : "+v"(a), "+v"(b));
    return fmaxf(a, b);
}
__device__ __forceinline__ int wave_reduce_add(int v) {
    v += __builtin_amdgcn_update_dpp(0, v, 0xB1, 0xF, 0xF, true);
    v += __builtin_amdgcn_update_dpp(0, v, 0x4E, 0xF, 0xF, true);
    v += __builtin_amdgcn_update_dpp(0, v, 0x141, 0xF, 0xF, true);
    v += __builtin_amdgcn_update_dpp(0, v, 0x140, 0xF, 0xF, true);
    return __builtin_amdgcn_readlane(v, 0) + __builtin_amdgcn_readlane(v, 16) + __builtin_amdgcn_readlane(v, 32) + __builtin_amdgcn_readlane(v, 48);
}
}

namespace pg8 {
#define PG8_LAS __attribute__((address_space(3)))
constexpr int BM = 256, BK = 64, HALF = 128, HTB = HALF * BK * 2, STAGE_BYTES = 8 * HTB, NXCD = 8, WGM = 8;

__host__ __device__ __forceinline__ int lds_byte(int r, int c) { const int st = (r >> 4) * 2 + (c >> 5), rr = r & 15, cc = c & 31, ob = rr * 64 + cc * 2; return st * 1024 + (ob ^ (((ob >> 9) & 1) << 5)); }
__host__ __device__ __forceinline__ void stage_rc(int b, int& R, int& C) { const int st = b / 1024, sb = b % 1024, swz = sb ^ (((sb >> 9) & 1) << 5); R = (st >> 1) * 16 + swz / 64; C = (st & 1) * 32 + (swz % 64) / 2; }
__host__ __device__ __forceinline__ int perm32(int rho) { const int n = rho >> 4, i = rho & 15; return 8 * (i >> 2) + 4 * n + (i & 3); }

struct Unit { int pm, pn, e, mt; };
struct Gemm { const bf16_t* A; const bf16_t* Bt; int K; int lda; size_t bstride; };

struct StaticOrder {
    int nM, nN, nwg, G, c;
    __host__ __device__ void init(int M, int N, int G_, int c_) { nM = M / BM; nN = N / BM; nwg = nM * nN; G = G_; c = c_; }
    __host__ __device__ bool next(int i, Unit& u) const {
        const long L = (long)i * G + c; if (L >= nwg) return false;
        int wgid = (int)L; { const int q = nwg / NXCD, r = nwg % NXCD, xcd = wgid % NXCD, off = wgid / NXCD; wgid = (xcd < r ? xcd * (q + 1) : r * (q + 1) + (xcd - r) * q) + off; }
        const int nig = WGM * nN, gid = wgid / nig, fm = gid * WGM, gsz = (nM - fm) < WGM ? (nM - fm) : WGM;
        u.pm = fm + ((wgid % nig) % gsz); u.pn = (wgid % nig) / gsz; u.e = 0; u.mt = 0; return true;
    }
    __device__ __forceinline__ int arow(const Unit& u, int r) const { return u.pm * BM + r; }
};

template <class Epi, class Sched, bool GATHER>
__device__ __forceinline__ void gemm_phase(PG8_LAS unsigned char* lds, const Gemm g, const Sched& S, const Epi& E, int wave_index) {
    const int tid = opaque_tid(wave_index), wid = __builtin_amdgcn_readfirstlane(tid >> 6), lane = tid & 63, wr = wid >> 2, wc = wid & 3, fr = lane & 15, fq = lane >> 4;
    int K_ = g.K; asm volatile("" : "+s"(K_));
    const int K = K_, nt = K / BK, lda = g.lda;
    int Ra[2], Ca[2]; unsigned voffB[2], voffA[2];
#pragma unroll
    for (int i = 0; i < 2; ++i) { int R, C; stage_rc(tid * 16 + i * 8192, R, C); const int Rb = Epi::PERM ? ((R & ~31) + perm32(R & 31)) : R;
        Ra[i] = R; Ca[i] = C; voffB[i] = (unsigned)(Rb * K + C) * 2u; voffA[i] = (unsigned)(R * lda + C) * 2u; }
    const size_t kstep = (size_t)(BK * 2);
    const size_t hstepB = (size_t)HALF * K * 2;
    const size_t tstepB = 2 * hstepB;
    const size_t hstepA = (size_t)HALF * lda * 2, tstepA = 2 * hstepA;
    const unsigned ldsw = (unsigned)wid * 1024u;
    const int aoff = lds_byte(wr * 64 + fr, fq * 8), boff = lds_byte(wc * 32 + fr, fq * 8);
#define PG8_SA(b, h) (((b) * 2 + (h)) * HTB)
#define PG8_SB(b, h) ((4 + (b) * 2 + (h)) * HTB)
#define PG8_STAGE(bufoff, gbase, voff) do { _Pragma("unroll") for (int _i = 0; _i < 2; ++_i) \
        __builtin_amdgcn_global_load_lds((const unsigned*)((const char*)(gbase) + (voff)[_i]), (PG8_LAS unsigned*)(lds + (bufoff) + ldsw + _i * 8192), 16, 0, 0); } while (0)
#define PG8_STAGEA(bufoff, kptr, VO, h) do { _Pragma("unroll") for (int _i = 0; _i < 2; ++_i) { \
        const char* _src; if constexpr (GATHER) _src = (const char*)(kptr) + (VO)[_i][h]; else _src = (const char*)(kptr) + (size_t)(h) * hstepA + voffA[_i]; \
        __builtin_amdgcn_global_load_lds((const unsigned*)_src, (PG8_LAS unsigned*)(lds + (bufoff) + ldsw + _i * 8192), 16, 0, 0); } } while (0)
#define PG8_LDA(dst, b, h) do { _Pragma("unroll") for (int m = 0; m < 4; ++m) _Pragma("unroll") for (int k = 0; k < 2; ++k) dst[m][k] = *(const PG8_LAS bf16x8*)(lds + PG8_SA(b, h) + aoff + m * 2048 + k * 1024); } while (0)
#define PG8_LDB(dst, b, h) do { _Pragma("unroll") for (int n = 0; n < 2; ++n) _Pragma("unroll") for (int k = 0; k < 2; ++k) dst[n][k] = *(const PG8_LAS bf16x8*)(lds + PG8_SB(b, h) + boff + n * 2048 + k * 1024); } while (0)
#define PG8_MMA(ai, bj, At, Bt) do { __builtin_amdgcn_s_setprio(1); _Pragma("unroll") for (int m = 0; m < 4; ++m) _Pragma("unroll") for (int n = 0; n < 2; ++n) _Pragma("unroll") for (int k = 0; k < 2; ++k) \
        acc[ai][bj][m][n] = __builtin_amdgcn_mfma_f32_16x16x32_bf16(Bt[n][k], At[m][k], acc[ai][bj][m][n], 0, 0, 0); __builtin_amdgcn_s_setprio(0); } while (0)
#define PG8_WAIT_V(n) asm volatile("s_waitcnt vmcnt(" #n ")" ::: "memory")
#define PG8_WAIT_L(n) asm volatile("s_waitcnt lgkmcnt(" #n ")" ::: "memory")
#define PG8_BAR __builtin_amdgcn_s_barrier()
#define PG8_SCHED __builtin_amdgcn_sched_barrier(0)
#define PG8_SETV(V, u) do { _Pragma("unroll") for (int _i = 0; _i < 2; ++_i) _Pragma("unroll") for (int _h = 0; _h < 2; ++_h) { \
        const int _row = GATHER ? S.arow(u, _h * HALF + Ra[_i]) : ((u).pm * BM + _h * HALF + Ra[_i]); V[_i][_h] = (unsigned)(((size_t)_row * lda + Ca[_i]) * 2); } } while (0)
    Unit cur, nxt; int ui = 0;
    if (!S.next(0, cur)) return;
    f32x4 acc[2][2][4][2];
#pragma unroll
    for (int a = 0; a < 2; ++a)
#pragma unroll
        for (int b = 0; b < 2; ++b)
#pragma unroll
            for (int m = 0; m < 4; ++m)
#pragma unroll
                for (int n = 0; n < 2; ++n) acc[a][b][m][n] = (f32x4){0.f, 0.f, 0.f, 0.f};
    bf16x8 At[4][2], B0[2][2], B1[2][2];
    unsigned vA[2][2], vN[2][2];
    if constexpr (GATHER) { PG8_SETV(vA, cur); }
    const char* cA = (const char*)g.A + (GATHER ? (size_t)0 : (size_t)cur.pm * tstepA);
    const char* cB = (const char*)g.Bt + ((size_t)cur.e * g.bstride) * 2 + (size_t)cur.pn * tstepB;
    PG8_STAGE(PG8_SB(0, 0), cB, voffB); PG8_STAGE(PG8_SB(0, 1), cB + hstepB, voffB); PG8_STAGEA(PG8_SA(0, 0), cA, vA, 0); PG8_STAGEA(PG8_SA(0, 1), cA, vA, 1);
    if (wr == 1) PG8_BAR;
    PG8_WAIT_V(2); PG8_BAR;
    PG8_STAGE(PG8_SB(1, 0), cB + kstep, voffB); PG8_STAGEA(PG8_SA(1, 0), cA + kstep, vA, 0); PG8_STAGE(PG8_SB(1, 1), cB + hstepB + kstep, voffB);
    PG8_WAIT_V(6); PG8_BAR;
    for (;;) {
        const bool has_next = S.next(ui + 1, nxt);
        if constexpr (GATHER) { if (has_next) { PG8_SETV(vN, nxt); }
        else {
#pragma unroll
            for (int _i = 0; _i < 2; ++_i)
#pragma unroll
                for (int _h = 0; _h < 2; ++_h) vN[_i][_h] = vA[_i][_h];
        } }
        const char* nA = (!GATHER && has_next) ? (const char*)g.A + (size_t)nxt.pm * tstepA : cA;
        const char* nB = has_next ? (const char*)g.Bt + ((size_t)nxt.e * g.bstride) * 2 + (size_t)nxt.pn * tstepB : cB;
#pragma unroll 1
        for (int t = 0; t < nt; t += 2) {
            const bool last = (t == nt - 2);
            const char* a1 = cA + (size_t)(t + 1) * kstep;
            const char* a2 = last ? nA : cA + (size_t)(t + 2) * kstep; const char* b2 = last ? nB : cB + (size_t)(t + 2) * kstep;
            const char* a3 = a2 + kstep; const char* b3 = b2 + kstep;
            unsigned v2[2][2];
            if constexpr (GATHER) {
#pragma unroll
            for (int _i = 0; _i < 2; ++_i)
#pragma unroll
                for (int _h = 0; _h < 2; ++_h) v2[_i][_h] = last ? vN[_i][_h] : vA[_i][_h];
            }
            PG8_LDB(B0, 0, 0); PG8_LDB(B1, 0, 1); PG8_SCHED; PG8_LDA(At, 0, 0); PG8_STAGEA(PG8_SA(1, 1), a1, vA, 1);
            PG8_WAIT_V(8); PG8_WAIT_L(0); PG8_BAR; PG8_MMA(0, 0, At, B0); PG8_MMA(0, 1, At, B1); PG8_BAR; PG8_SCHED;
            PG8_LDA(At, 0, 1); PG8_STAGE(PG8_SB(0, 0), b2, voffB); PG8_STAGE(PG8_SB(0, 1), b2 + hstepB, voffB); PG8_STAGEA(PG8_SA(0, 0), a2, v2, 0);
            PG8_WAIT_V(8); PG8_WAIT_L(0); PG8_BAR; PG8_MMA(1, 0, At, B0); PG8_MMA(1, 1, At, B1); PG8_BAR; PG8_SCHED;
            PG8_LDB(B0, 1, 0); PG8_LDB(B1, 1, 1); PG8_SCHED; PG8_LDA(At, 1, 0); PG8_STAGEA(PG8_SA(0, 1), a2, v2, 1);
            PG8_WAIT_V(8); PG8_WAIT_L(0); PG8_BAR; PG8_MMA(0, 0, At, B0); PG8_MMA(0, 1, At, B1); PG8_BAR; PG8_SCHED;
            PG8_LDA(At, 1, 1); PG8_STAGE(PG8_SB(1, 0), b3, voffB); PG8_STAGE(PG8_SB(1, 1), b3 + hstepB, voffB); PG8_STAGEA(PG8_SA(1, 0), a3, v2, 0);
            PG8_WAIT_V(8); PG8_WAIT_L(0); PG8_BAR; PG8_MMA(1, 0, At, B0); PG8_MMA(1, 1, At, B1); PG8_BAR; PG8_SCHED;
        }
        if (wr == 0) PG8_BAR;
        E(acc, cur, wr, wc, fr, fq);
        if (!has_next) break;
#pragma unroll
        for (int a = 0; a < 2; ++a)
#pragma unroll
            for (int b = 0; b < 2; ++b)
#pragma unroll
                for (int m = 0; m < 4; ++m)
#pragma unroll
                    for (int n = 0; n < 2; ++n) acc[a][b][m][n] = (f32x4){0.f, 0.f, 0.f, 0.f};
        cur = nxt; cB = nB; cA = nA; ++ui;
        if constexpr (GATHER) {
#pragma unroll
        for (int _i = 0; _i < 2; ++_i)
#pragma unroll
            for (int _h = 0; _h < 2; ++_h) vA[_i][_h] = vN[_i][_h];
        }
        if (wr == 1) PG8_BAR;
    }
    PG8_WAIT_V(0);
    PG8_BAR;
#undef PG8_SA
#undef PG8_SB
#undef PG8_STAGE
#undef PG8_STAGEA
#undef PG8_LDA
#undef PG8_LDB
#undef PG8_MMA
#undef PG8_WAIT_V
#undef PG8_WAIT_L
#undef PG8_BAR
#undef PG8_SCHED
#undef PG8_SETV
}
}

namespace {
struct Params {
    const float *x, *c, *w_ada, *b_ada, *g_norm1, *w_in, *b_forget, *g_q_mla, *w_q_up, *g_kv_mla, *w_kv_up, *sinks, *w_out, *g_norm2,
                *w_router, *b_router, *w_gate, *w_up, *w_down, *g_final;
    float* xo;
    unsigned* ctl;
    float* mod;
    bf16_t* WinT;
    bf16_t* WoutT;
    bf16_t* WqT;
    bf16_t* WkvT;
    bf16_t* WguT;
    bf16_t* WdT;
    float* ropetab;
    float* rq; float* rkv;
    float* cbF;
    bf16_t* kidx;
    uint32_t* mask;
    bf16_t* h;
    bf16_t* proj;
    bf16_t* qm; bf16_t* km; bf16_t* vm;
    bf16_t* merged;
    bf16_t* hid;
    bf16_t* ys;
    int* list;
    float* rw;
    float* wl;
    int wid;
    int qslot;
    int qslot_host;
};
constexpr int CW_BAR = 0;
constexpr int CW_CNT = 3584;
constexpr int CW_QA = 3648;
constexpr int CW_QD = 4288;
constexpr int CW_KN2 = 4992;
constexpr int CW_QN2 = CW_KN2 + 2 * NB * 4 * 32;
constexpr int CW_WORDS = CW_QN2 + 2 * NB * 4 * 8;
}

namespace {
constexpr long P0_B1 = 2l * NP * 128, P0_B2 = P0_B1 + 2l * 1024 * 128, P0_B3 = P0_B2 + 2l * 512 * 32, P0_B4 = P0_B3 + 2l * 512 * 16,
               P0_B5 = P0_B4 + 32l * 512 * 128, P0_B6 = P0_B5 + 32l * 1024 * 32;
__device__ __forceinline__ bf16_t* p0_fetch(const Params& p, long it, float (&v)[8]) {
    if (it < P0_B1) {
        const int l = (int)(it / (NP * 128)), r = (int)(it % (NP * 128)), n = r % NP, k0 = (r / NP) * 8, o = orig_col(n);
        const float* w = p.w_in + (size_t)l * D * NIN;
#pragma unroll
        for (int j = 0; j < 8; ++j) v[j] = o >= 0 ? w[(size_t)(k0 + j) * NIN + o] : 0.f;
        return p.WinT + ((size_t)l * NP + n) * D + k0;
    } else if (it < P0_B2) {
        const long s = it - P0_B1; const int l = (int)(s / (1024 * 128)), r = (int)(s % (1024 * 128)), n = r & 1023, k0 = (r >> 10) * 8;
        const float* w = p.w_out + (size_t)l * D * D;
#pragma unroll
        for (int j = 0; j < 8; ++j) v[j] = w[(size_t)(k0 + j) * D + n];
        return p.WoutT + ((size_t)l * D + n) * D + k0;
    } else if (it < P0_B3) {
        const long s = it - P0_B2; const int l = (int)(s / (512 * 32)), r = (int)(s % (512 * 32)), n = r & 511, k0 = (r >> 9) * 8;
        const float* w = p.w_q_up + (size_t)l * 256 * 384; const float* g = p.g_q_mla + l * 256;
#pragma unroll
        for (int j = 0; j < 8; ++j) v[j] = n < 384 ? g[k0 + j] * w[(size_t)(k0 + j) * 384 + n] : 0.f;
        return p.WqT + ((size_t)l * 512 + n) * 256 + k0;
    } else if (it < P0_B4) {
        const long s = it - P0_B3; const int l = (int)(s / (512 * 16)), r = (int)(s % (512 * 16)), n = r & 511, k0 = (r >> 9) * 8;
        const float* w = p.w_kv_up + (size_t)l * 128 * 512; const float* g = p.g_kv_mla + l * 128;
#pragma unroll
        for (int j = 0; j < 8; ++j) v[j] = g[k0 + j] * w[(size_t)(k0 + j) * 512 + n];
        return p.WkvT + ((size_t)l * 512 + n) * 128 + k0;
    } else if (it < P0_B5) {
        const long s = it - P0_B4; const int le = (int)(s >> 16), r = (int)(s & 65535), n = r & 511, k0 = (r >> 9) * 8;
        const int q = n >> 5, rr = n & 31, col = 16 * q + (rr & 15);
        const float* w = (rr < 16 ? p.w_gate : p.w_up) + (size_t)le * 1024 * 256;
#pragma unroll
        for (int j = 0; j < 8; ++j) v[j] = w[(size_t)(k0 + j) * 256 + col];
        return p.WguT + ((size_t)le * 512 + n) * 1024 + k0;
    } else {
        const long s = it - P0_B5; const int le = (int)(s >> 15), r = (int)(s & 32767), n = r & 1023, k0 = (r >> 10) * 8;
        const float* w = p.w_down + (size_t)le * 256 * 1024;
#pragma unroll
        for (int j = 0; j < 8; ++j) v[j] = w[(size_t)(k0 + j) * 1024 + n];
        return p.WdT + ((size_t)le * 1024 + n) * 256 + k0;
    }
}
__device__ __forceinline__ void p0_store(bf16_t* dst, const float (&v)[8]) {
    u32x4 w; w.x = cvt_pk_bf16(v[0], v[1]); w.y = cvt_pk_bf16(v[2], v[3]); w.z = cvt_pk_bf16(v[4], v[5]); w.w = cvt_pk_bf16(v[6], v[7]);
    *(u32x4*)dst = w;
}

__device__ __forceinline__ void phase_p0(const Params& p, char* lds) {
    const int tid = opaque_tid(p.wid), gtid = blockIdx.x * blockDim.x + tid, gthreads = gridDim.x * blockDim.x;
    for (long it0 = gtid; it0 < P0_B6; it0 += 2l * gthreads) {
        float va[8], vb[8];
        const bool hb = it0 + gthreads < P0_B6;
        bf16_t* da = p0_fetch(p, it0, va);
        bf16_t* db = hb ? p0_fetch(p, it0 + gthreads, vb) : da;
        p0_store(da, va);
        if (hb) p0_store(db, vb);
    }
    for (int it = gtid; it < 2048 * 16; it += gthreads) {
        const int pos = it >> 4, i = it & 15;
        const float inv = powf(10000.0f, -(float)i / 16.0f), ang = (float)pos * inv;
        p.ropetab[it * 2] = cosf(ang); p.ropetab[it * 2 + 1] = sinf(ang);
    }
    float* ca = (float*)lds;
    for (int i = tid; i < NB * 1024; i += 512) { const float v = p.c[i]; ca[i] = v / (1.f + __expf(-v)); }
    __syncthreads();
    for (int u = blockIdx.x; u < 2 * (NMOD / 64); u += gridDim.x) {
        const int l = u / (NMOD / 64), n = (u % (NMOD / 64)) * 64 + (tid & 63), bg = tid >> 6;
        const float* w = p.w_ada + (size_t)l * 1024 * NMOD + n;
        float acc[4] = {0.f, 0.f, 0.f, 0.f};
        for (int d0 = 0; d0 < 1024; d0 += 8) {
            float wv[8];
#pragma unroll
            for (int q = 0; q < 8; ++q) wv[q] = w[(size_t)(d0 + q) * NMOD];
#pragma unroll
            for (int q = 0; q < 8; ++q)
#pragma unroll
                for (int j = 0; j < 4; ++j) acc[j] += ca[(bg * 4 + j) * 1024 + d0 + q] * wv[q];
        }
        const float bias = p.b_ada[l * NMOD + n];
#pragma unroll
        for (int j = 0; j < 4; ++j) p.mod[((size_t)l * NB + bg * 4 + j) * NMOD + n] = acc[j] + bias;
    }
    __syncthreads();
}

template <int MODE>
__device__ __forceinline__ void phase_norm1(const Params& p, int l) {
#ifndef NORM_NT
#define NORM_NT 2
#endif
    constexpr int NT = NORM_NT;
    const int tid = opaque_tid(p.wid), w = tid >> 6, lane = tid & 63;
    const float* xin = (MODE == 0) ? p.x : p.xo;
    const float* g = (MODE == 2) ? p.g_final : p.g_norm1 + l * D;
    const float* modl = p.mod + (size_t)(MODE == 2 ? 1 : l) * NB * NMOD;
    const float* modp = p.mod + (size_t)(MODE == 2 ? 1 : (l > 0 ? l - 1 : 0)) * NB * NMOD;
    f32x4 gg4[4];
#pragma unroll
    for (int k = 0; k < 4; ++k) gg4[k] = *(const f32x4*)(g + 4 * lane + 256 * k);
    for (int t0 = (blockIdx.x * 8 + w) * NT; t0 < T; t0 += gridDim.x * 8 * NT) {
        const int b0 = t0 >> 11;
        f32x4 sc4[4], sh4[4], gt4[4];
        if (MODE != 2) {
#pragma unroll
            for (int k = 0; k < 4; ++k) { sc4[k] = *(const f32x4*)(modl + (size_t)b0 * NMOD + 1024 + 4 * lane + 256 * k); sh4[k] = *(const f32x4*)(modl + (size_t)b0 * NMOD + 4 * lane + 256 * k); }
        }
        if (MODE >= 1) {
#pragma unroll
            for (int k = 0; k < 4; ++k) gt4[k] = *(const f32x4*)(modp + (size_t)b0 * NMOD + 5 * 1024 + 4 * lane + 256 * k);
        }
        f32x4 v[NT][4];
#pragma unroll
        for (int u = 0; u < NT; ++u)
#pragma unroll
            for (int k = 0; k < 4; ++k) v[u][k] = *(const f32x4*)(xin + (size_t)(t0 + u) * D + 4 * lane + 256 * k);
        if (MODE >= 1) {
            u32x2 y0[NT][4], y1[NT][4];
#pragma unroll
            for (int u = 0; u < NT; ++u)
#pragma unroll
                for (int k = 0; k < 4; ++k) { const int col = 4 * lane + 256 * k;
                    y0[u][k] = *(const u32x2*)(p.ys + ((size_t)(t0 + u) * 2 + 0) * D + col); y1[u][k] = *(const u32x2*)(p.ys + ((size_t)(t0 + u) * 2 + 1) * D + col); }
#pragma unroll
            for (int u = 0; u < NT; ++u) {
                const int b = (t0 + u) >> 11;
#pragma unroll
                for (int k = 0; k < 4; ++k) {
                    const int col = 4 * lane + 256 * k;
                    const f32x4 gt = gt4[k];
                    v[u][k][0] += gt[0] * (bflo(y0[u][k].x) + bflo(y1[u][k].x)); v[u][k][1] += gt[1] * (bfhi(y0[u][k].x) + bfhi(y1[u][k].x));
                    v[u][k][2] += gt[2] * (bflo(y0[u][k].y) + bflo(y1[u][k].y)); v[u][k][3] += gt[3] * (bfhi(y0[u][k].y) + bfhi(y1[u][k].y));
                }
            }
        }
#pragma unroll
        for (int u = 0; u < NT; ++u) {
            const int t = t0 + u, b = t >> 11;
            float ss = 0.f;
#pragma unroll
            for (int k = 0; k < 4; ++k) ss += v[u][k][0] * v[u][k][0] + v[u][k][1] * v[u][k][1] + v[u][k][2] * v[u][k][2] + v[u][k][3] * v[u][k][3];
            ss = wave_sum(ss);
            const float r = rsqrtf(ss * (1.0f / D) + EPS);
#pragma unroll
            for (int k = 0; k < 4; ++k) {
                const int col = 4 * lane + 256 * k;
                f32x4 y = v[u][k] * r * gg4[k];
                if (MODE == 2) { *(f32x4*)(p.xo + (size_t)t * D + col) = y; }
                else {
                    if (MODE == 1) *(f32x4*)(p.xo + (size_t)t * D + col) = v[u][k];
                    y = y * (1.f + sc4[k]) + sh4[k];
                    u32x2 o; o.x = cvt_pk_bf16(y[0], y[1]); o.y = cvt_pk_bf16(y[2], y[3]);
                    *(u32x2*)(p.h + (size_t)t * D + col) = o;
                }
            }
        }
    }
}
}

namespace {
using pg8::Unit;
struct EpiStoreBf16 {
    static constexpr bool PERM = true;
    bf16_t* O; int ldc;
    __device__ __forceinline__ void operator()(const f32x4 (&acc)[2][2][4][2], const Unit& u, int wr, int wc, int fr_, int fq_) const {
        int fr = fr_, fq = fq_; asm volatile("" : "+v"(fr), "+v"(fq));
        const int row0 = u.pm * 256 + wr * 64 + fr, col0 = u.pn * 256 + wc * 32 + 8 * fq;
#pragma unroll
        for (int ai = 0; ai < 2; ++ai)
#pragma unroll
            for (int m = 0; m < 4; ++m) { bf16_t* rowp = O + (size_t)(row0 + ai * 128 + m * 16) * ldc + col0;
#pragma unroll
                for (int bj = 0; bj < 2; ++bj) { const f32x4 v0 = acc[ai][bj][m][0], v1 = acc[ai][bj][m][1];
                    u32x4 w; w.x = cvt_pk_bf16(v0[0], v0[1]); w.y = cvt_pk_bf16(v0[2], v0[3]); w.z = cvt_pk_bf16(v1[0], v1[1]); w.w = cvt_pk_bf16(v1[2], v1[3]);
                    *(u32x4*)(rowp + bj * 128) = w; } }
    }
};
struct EpiResidual {
    static constexpr bool PERM = false;
    const float* xin; float* x; const float* gate;
    __device__ __forceinline__ void operator()(const f32x4 (&acc)[2][2][4][2], const Unit& u, int wr, int wc, int fr_, int fq_) const {
        int fr = fr_, fq = fq_; asm volatile("" : "+v"(fr), "+v"(fq));
        const int row0 = u.pm * 256 + wr * 64 + fr, col0 = u.pn * 256 + wc * 32 + 4 * fq;
        const int b = (u.pm * 256) >> 11;
        f32x4 gv[2][2];
#pragma unroll
        for (int bj = 0; bj < 2; ++bj)
#pragma unroll
            for (int n = 0; n < 2; ++n) gv[bj][n] = *(const f32x4*)(gate + (size_t)b * NMOD + col0 + bj * 128 + n * 16);
#pragma unroll
        for (int ai = 0; ai < 2; ++ai)
#pragma unroll
            for (int m = 0; m < 4; ++m) { const size_t ro = (size_t)(row0 + ai * 128 + m * 16) * D + col0;
#pragma unroll
                for (int bj = 0; bj < 2; ++bj)
#pragma unroll
                    for (int n = 0; n < 2; ++n) { const size_t o = ro + bj * 128 + n * 16; *(f32x4*)(x + o) = *(const f32x4*)(xin + o) + gv[bj][n] * acc[ai][bj][m][n]; } }
    }
};
struct EpiMlaQ {
    static constexpr bool PERM = true;
    bf16_t* qm;
    __device__ __forceinline__ void operator()(const f32x4 (&acc)[2][2][4][2], const Unit& u, int wr, int wc, int fr_, int fq_) const {
        int fr = fr_, fq = fq_; asm volatile("" : "+v"(fr), "+v"(fq));
        const int row0 = u.pm * 256 + wr * 64 + fr;
#pragma unroll
        for (int bj = 0; bj < 2; ++bj) {
            const int col0 = u.pn * 256 + bj * 128 + wc * 32;
            if (col0 >= 384) continue;
#pragma unroll
            for (int ai = 0; ai < 2; ++ai)
#pragma unroll
                for (int m = 0; m < 4; ++m) { const f32x4 v0 = acc[ai][bj][m][0], v1 = acc[ai][bj][m][1];
                    u32x4 w; w.x = cvt_pk_bf16(v0[0], v0[1]); w.y = cvt_pk_bf16(v0[2], v0[3]); w.z = cvt_pk_bf16(v1[0], v1[1]); w.w = cvt_pk_bf16(v1[2], v1[3]);
                    *(u32x4*)(qm + (size_t)(row0 + ai * 128 + m * 16) * 384 + col0 + 8 * fq) = w; }
        }
    }
};
struct EpiMlaKV {
    static constexpr bool PERM = true;
    bf16_t* km; bf16_t* vm;
    __device__ __forceinline__ void operator()(const f32x4 (&acc)[2][2][4][2], const Unit& u, int wr, int wc, int fr_, int fq_) const {
        int fr = fr_, fq = fq_; asm volatile("" : "+v"(fr), "+v"(fq));
        const int row0 = u.pm * 256 + wr * 64 + fr;
#pragma unroll
        for (int bj = 0; bj < 2; ++bj) {
            const int head = u.pn * 2 + bj, wcol = wc * 32 + 8 * fq;
#pragma unroll
            for (int ai = 0; ai < 2; ++ai)
#pragma unroll
                for (int m = 0; m < 4; ++m) {
                    const int row = row0 + ai * 128 + m * 16;
                    const f32x4 v0 = acc[ai][bj][m][0], v1 = acc[ai][bj][m][1];
                    u32x4 w; w.x = cvt_pk_bf16(v0[0], v0[1]); w.y = cvt_pk_bf16(v0[2], v0[3]); w.z = cvt_pk_bf16(v1[0], v1[1]); w.w = cvt_pk_bf16(v1[2], v1[3]);
                    bf16_t* q = (wcol < 64) ? km + (size_t)row * 384 + head * 96 + wcol : vm + (size_t)row * 256 + head * 64 + (wcol - 64);
                    *(u32x4*)q = w;
                    asm volatile("" ::: "memory");
                }
        }
    }
};
struct EpiGateUp {
    static constexpr bool PERM = false;
    bf16_t* hid;
    __device__ __forceinline__ void operator()(const f32x4 (&acc)[2][2][4][2], const Unit& u, int wr, int wc, int fr_, int fq_) const {
        int fr = fr_, fq = fq_; asm volatile("" : "+v"(fr), "+v"(fq));
        const int row0 = u.pm * 256 + wr * 64 + fr;
#pragma unroll
        for (int ai = 0; ai < 2; ++ai)
#pragma unroll
            for (int m = 0; m < 4; ++m) { bf16_t* rowp = hid + (size_t)(row0 + ai * 128 + m * 16) * 256;
#pragma unroll
                for (int bj = 0; bj < 2; ++bj) { const f32x4 gt = acc[ai][bj][m][0], up = acc[ai][bj][m][1];
                    f32x4 o;
#pragma unroll
                    for (int j = 0; j < 4; ++j) o[j] = gt[j] / (1.f + __expf(-gt[j])) * up[j];
                    u32x2 w; w.x = cvt_pk_bf16(o[0], o[1]); w.y = cvt_pk_bf16(o[2], o[3]);
                    *(u32x2*)(rowp + 16 * (u.pn * 8 + bj * 4 + wc) + 4 * fq) = w; } }
    }
};
struct EpiDown {
    static constexpr bool PERM = true;
    bf16_t* ys; const int* list; const float* wl; const int* cnt;
    __device__ __forceinline__ void operator()(const f32x4 (&acc)[2][2][4][2], const Unit& u, int wr, int wc, int fr_, int fq_) const {
        int fr = fr_, fq = fq_; asm volatile("" : "+v"(fr), "+v"(fq));
        const int n = cnt[u.e]; const int* le = list + (size_t)u.e * ECAP; const float* we = wl + (size_t)u.e * ECAP;
        const int col0 = u.pn * 256 + wc * 32 + 8 * fq;
        int slot[8]; float w8[8];
#pragma unroll
        for (int q = 0; q < 8; ++q) { const int lr = u.mt * 256 + (q >> 2) * 128 + wr * 64 + (q & 3) * 16 + fr; slot[q] = lr < n ? le[lr] : -1; w8[q] = lr < n ? we[lr] : 0.f; }
#pragma unroll
        for (int ai = 0; ai < 2; ++ai)
#pragma unroll
            for (int m = 0; m < 4; ++m) {
                const int q = ai * 4 + m;
                if (slot[q] >= 0) {
                    bf16_t* rowp = ys + (size_t)slot[q] * D + col0;
#pragma unroll
                    for (int bj = 0; bj < 2; ++bj) { const f32x4 v0 = acc[ai][bj][m][0] * w8[q], v1 = acc[ai][bj][m][1] * w8[q];
                        u32x4 w; w.x = cvt_pk_bf16(v0[0], v0[1]); w.y = cvt_pk_bf16(v0[2], v0[3]); w.z = cvt_pk_bf16(v1[0], v1[1]); w.w = cvt_pk_bf16(v1[2], v1[3]);
                        *(u32x4*)(rowp + bj * 128) = w; }
                }
            }
    }
};
struct MoeOrder {
    int pre[17];
    int NT, G, c; const int* list; const int* cnt;
    __device__ __forceinline__ void init(const int* cnt_, const int* list_, int NT_, int G_, int c_) {
        cnt = cnt_; list = list_; NT = NT_; G = G_; c = c_; int a = 0;
#pragma unroll
        for (int e = 0; e < 16; ++e) { pre[e] = a; a += (cnt_[e] + 255) >> 8; }
        pre[16] = a;
    }
    __device__ __forceinline__ bool next(int i, Unit& u) const {
        const int L = i * G + c; if (L >= pre[16] * NT) return false;
        const int t = L / NT; int e = 0;
#pragma unroll
        for (int k = 1; k < 16; ++k) e += (t >= pre[k]) ? 1 : 0;
        int pe = 0;
#pragma unroll
        for (int k = 0; k < 16; ++k) pe = (k == e) ? pre[k] : pe;
        u.e = e; u.mt = t - pe; u.pm = t; u.pn = L - t * NT; return true;
    }
    __device__ __forceinline__ int arow(const Unit& u, int r) const { const int lr = u.mt * 256 + r; return lr < cnt[u.e] ? (list[(size_t)u.e * ECAP + lr] >> 1) : 0; }
};
}

namespace {
__device__ __forceinline__ void phase_prep(const Params& p, int l) {
    const int tid = opaque_tid(p.wid), w = tid >> 6, lane = tid & 63;
    const int gw = blockIdx.x * 8 + w, nw = gridDim.x * 8;
    for (int sq = gw; sq < NB * 4; sq += nw) {
        const int b = sq >> 2, hh = sq & 3; const float bias = p.b_forget[l * 4 + hh];
        float lf[32]; float run = 0.f;
#pragma unroll
        for (int j = 0; j < 32; ++j) {
            const float z = bf2f(p.proj[(size_t)(b * S + lane * 32 + j) * NP + PC_AF + hh]) + bias;
            run += fminf(z, 0.f) - log1pf(__expf(-fabsf(z)));
            lf[j] = run;
        }
        float incl = run;
#pragma unroll
        for (int o = 1; o < 64; o <<= 1) { const float t2 = __shfl_up(incl, o); if (lane >= o) incl += t2; }
        const float excl = incl - run;
#pragma unroll
        for (int j = 0; j < 32; ++j) p.cbF[(size_t)sq * S + lane * 32 + j] = -(excl + lf[j]) * LOG2E;
    }
    for (int c32 = gw; c32 < T / 32; c32 += nw) {
    float mxq = 0.f, mxk = 0.f;
    for (int it = 0; it < 32; ++it) {
        const int t = c32 * 32 + it;
        const bf16_t* row = p.proj + (size_t)t * NP;
        const u32x2 cq = *(const u32x2*)(row + PC_BCQ + 4 * lane);
        const unsigned ck = *(const unsigned*)(row + PC_BCKV + 2 * lane);
        float s1 = bflo(cq.x) * bflo(cq.x) + bfhi(cq.x) * bfhi(cq.x) + bflo(cq.y) * bflo(cq.y) + bfhi(cq.y) * bfhi(cq.y);
        float s2 = bflo(ck) * bflo(ck) + bfhi(ck) * bfhi(ck);
        s1 = wave_sum(s1); s2 = wave_sum(s2);
        if (lane < 4) *(u32x4*)(p.kidx + (size_t)t * 32 + 8 * lane) = *(const u32x4*)(row + PC_DKI + 8 * lane);
        {
            const u32x2 aq = *(const u32x2*)(row + PC_AQ + 4 * lane), ak = *(const u32x2*)(row + PC_AK + 4 * lane);
            float nq = bflo(aq.x) * bflo(aq.x) + bfhi(aq.x) * bfhi(aq.x) + bflo(aq.y) * bflo(aq.y) + bfhi(aq.y) * bfhi(aq.y);
            float nk = bflo(ak.x) * bflo(ak.x) + bfhi(ak.x) * bfhi(ak.x) + bflo(ak.y) * bflo(ak.y) + bfhi(ak.y) * bfhi(ak.y);
#pragma unroll
            for (int o = 8; o > 0; o >>= 1) { nq += __shfl_xor(nq, o); nk += __shfl_xor(nk, o); }
            mxq = fmaxf(mxq, nq); mxk = fmaxf(mxk, nk);
        }
        const float kr = (lane < 32) ? bf2f(row[PC_BKR + lane]) : 0.f;
        const float kr2 = __shfl(kr, (lane + 16) & 63);
        {
            const float r1 = rsqrtf(s1 * (1.f / 256.f) + EPS), r2 = rsqrtf(s2 * (1.f / 128.f) + EPS);
            u32x2 o; o.x = cvt_pk_bf16(bflo(cq.x) * r1, bfhi(cq.x) * r1); o.y = cvt_pk_bf16(bflo(cq.y) * r1, bfhi(cq.y) * r1);
            *(u32x2*)(p.proj + (size_t)t * NP + PC_BCQ + 4 * lane) = o;
            *(unsigned*)(p.proj + (size_t)t * NP + PC_BCKV + 2 * lane) = cvt_pk_bf16(bflo(ck) * r2, bfhi(ck) * r2);
        }
        if (lane < 16) {
            const int pos = t & (S - 1);
            const float cs = p.ropetab[(pos * 16 + lane) * 2], sn = p.ropetab[(pos * 16 + lane) * 2 + 1];
            const bf16_t o1 = f2bf(kr * cs - kr2 * sn), o2 = f2bf(kr2 * cs + kr * sn);
            bf16_t* kmr = p.km + (size_t)t * 384;
#pragma unroll
            for (int hh = 0; hh < 4; ++hh) { kmr[hh * 96 + 64 + lane] = o1; kmr[hh * 96 + 80 + lane] = o2; }
        }
    }
    if ((lane & 15) == 0) {
        const int t = c32 * 32, bb = t >> 11, pos = t & (S - 1), hh = lane >> 4;
        atomicMax(p.ctl + CW_KN2 + ((l * NB + bb) * 4 + hh) * 32 + (pos >> 6), __float_as_uint(mxk));
        atomicMax(p.ctl + CW_QN2 + ((l * NB + bb) * 4 + hh) * 8 + (pos >> 8), __float_as_uint(mxq));
    }
    }
}

__device__ __forceinline__ void phase_route(const Params& p, int l, char* lds) {
    const int tid = opaque_tid(p.wid), w = tid >> 6, lane = tid & 63;
    float* wrT = (float*)lds;
    int* lcnt = (int*)(lds + 65536);
    int* lbase = (int*)(lds + 65536 + 64);
    int* tsel = (int*)(lds + 65536 + 128);
    float* twt = (float*)(lds + 65536 + 128 + 2048);
    for (int i = tid; i < 16 * 1024; i += 512) { const int e = i >> 10, d = i & 1023; wrT[i] = p.w_router[d * 16 + e]; }
    const float* g = p.g_norm2 + l * D;
    const float* modl = p.mod + (size_t)l * NB * NMOD;
    int* cnt = (int*)(p.ctl + CW_CNT) + l * 16 + 32 * p.qslot;
    int* list = p.list + (size_t)p.qslot * 16 * ECAP;
    for (int chunk = blockIdx.x; chunk < T / 256; chunk += gridDim.x) {
        if (tid < 16) lcnt[tid] = 0;
        __syncthreads();
        const int b = (chunk * 256) >> 11;
        f32x4 gg4[4], sc4[4], sh4[4];
#pragma unroll
        for (int k = 0; k < 4; ++k) { const int col = 4 * lane + 256 * k; gg4[k] = *(const f32x4*)(g + col);
            sc4[k] = *(const f32x4*)(modl + (size_t)b * NMOD + 4 * 1024 + col); sh4[k] = *(const f32x4*)(modl + (size_t)b * NMOD + 3 * 1024 + col); }
        const int eown = ((lane >> 5) & 1) * 8 + ((lane >> 4) & 1) * 4 + ((lane >> 3) & 1) * 2 + ((lane >> 2) & 1);
        const float brown = p.b_router[eown];
        f32x4 vn[4];
#pragma unroll
        for (int k = 0; k < 4; ++k) vn[k] = *(const f32x4*)(p.xo + (size_t)(chunk * 256 + w * 32) * D + 4 * lane + 256 * k);
        for (int it = 0; it < 32; ++it) {
            const int li = w * 32 + it, t = chunk * 256 + li;
            f32x4 v[4];
#pragma unroll
            for (int k = 0; k < 4; ++k) v[k] = vn[k];
            if (it < 31) {
#pragma unroll
                for (int k = 0; k < 4; ++k) vn[k] = *(const f32x4*)(p.xo + (size_t)(t + 1) * D + 4 * lane + 256 * k);
            }
            float ss = 0.f;
#pragma unroll
            for (int k = 0; k < 4; ++k) ss += v[k][0] * v[k][0] + v[k][1] * v[k][1] + v[k][2] * v[k][2] + v[k][3] * v[k][3];
            ss = wave_sum(ss);
            const float r = rsqrtf(ss * (1.0f / D) + EPS);
            float lg[16];
#pragma unroll
            for (int e = 0; e < 16; ++e) lg[e] = 0.f;
#pragma unroll
            for (int k = 0; k < 4; ++k) {
                const int col = 4 * lane + 256 * k;
                const f32x4 y = v[k] * r * gg4[k] * (1.f + sc4[k]) + sh4[k];
                u32x2 o; o.x = cvt_pk_bf16(y[0], y[1]); o.y = cvt_pk_bf16(y[2], y[3]);
                *(u32x2*)(p.h + (size_t)t * D + col) = o;
#pragma unroll
                for (int e = 0; e < 16; ++e) { const f32x4 wv = *(const f32x4*)(wrT + e * 1024 + col); lg[e] += y[0] * wv[0] + y[1] * wv[1] + y[2] * wv[2] + y[3] * wv[3]; }
                asm volatile("" ::: "memory");
            }
            float a8[8], a4[4], a2[2], a1;
            { const bool hi = (lane & 32) != 0;
#pragma unroll
              for (int e = 0; e < 8; ++e) { const float send = hi ? lg[e] : lg[e + 8], keep = hi ? lg[e + 8] : lg[e]; a8[e] = keep + __shfl_xor(send, 32); } }
            { const bool hi = (lane & 16) != 0;
#pragma unroll
              for (int e = 0; e < 4; ++e) { const float send = hi ? a8[e] : a8[e + 4], keep = hi ? a8[e + 4] : a8[e]; a4[e] = keep + __shfl_xor(send, 16); } }
            { const bool hi = (lane & 8) != 0;
#pragma unroll
              for (int e = 0; e < 2; ++e) { const float send = hi ? a4[e] : a4[e + 2], keep = hi ? a4[e + 2] : a4[e]; a2[e] = keep + __shfl_xor(send, 8); } }
            { const bool hi = (lane & 4) != 0; const float send = hi ? a2[0] : a2[1], keep = hi ? a2[1] : a2[0]; a1 = keep + __shfl_xor(send, 4); }
            a1 += __shfl_xor(a1, 2); a1 += __shfl_xor(a1, 1);
            const float sown = 1.f / (1.f + expf(-a1)), bown = sown + brown;
            float sc[16], bi[16];
#pragma unroll
            for (int e = 0; e < 16; ++e) { const int src = ((e >> 3) & 1) * 32 + ((e >> 2) & 1) * 16 + ((e >> 1) & 1) * 8 + (e & 1) * 4;
                sc[e] = __builtin_bit_cast(float, __builtin_amdgcn_readlane(__builtin_bit_cast(int, sown), src));
                bi[e] = __builtin_bit_cast(float, __builtin_amdgcn_readlane(__builtin_bit_cast(int, bown), src)); }
            int bg = 0; float bgs = -INFINITY;
#pragma unroll
            for (int gi = 0; gi < 4; ++gi) {
                float m1 = -INFINITY, m2 = -INFINITY;
#pragma unroll
                for (int j = 0; j < 4; ++j) { const float vv = bi[gi * 4 + j]; if (vv > m1) { m2 = m1; m1 = vv; } else if (vv > m2) m2 = vv; }
                const float gs = m1 + m2; if (gs > bgs) { bgs = gs; bg = gi; }
            }
            float b4[4], s4[4];
#pragma unroll
            for (int gi = 0; gi < 4; ++gi)
#pragma unroll
                for (int j = 0; j < 4; ++j) if (gi == bg) { b4[j] = bi[gi * 4 + j]; s4[j] = sc[gi * 4 + j]; }
            int i1 = 0; float v1 = -INFINITY;
#pragma unroll
            for (int j = 0; j < 4; ++j) { if (b4[j] > v1) { v1 = b4[j]; i1 = j; } }
            int i2 = 0; float v2 = -INFINITY;
#pragma unroll
            for (int j = 0; j < 4; ++j) { if (j != i1 && b4[j] > v2) { v2 = b4[j]; i2 = j; } }
            float w1 = 0.f, w2 = 0.f;
#pragma unroll
            for (int j = 0; j < 4; ++j) { if (j == i1) w1 = s4[j]; if (j == i2) w2 = s4[j]; }
            if (lane == 0) {
                const int e1 = bg * 4 + i1, e2 = bg * 4 + i2; const float ws = w1 + w2;
                const int r1 = atomicAdd(&lcnt[e1], 1), r2 = atomicAdd(&lcnt[e2], 1);
                tsel[li * 2 + 0] = (e1 << 16) | r1; tsel[li * 2 + 1] = (e2 << 16) | r2;
                twt[li * 2 + 0] = w1 / ws; twt[li * 2 + 1] = w2 / ws;
            }
        }
        __syncthreads();
        if (tid < 16) lbase[tid] = atomicAdd(&cnt[tid], lcnt[tid]);
        __syncthreads();
        { const int v = tsel[tid], e = v >> 16, rk = v & 0xFFFF; const size_t pos = (size_t)e * ECAP + lbase[e] + rk;
          list[pos] = (chunk * 256 + (tid >> 1)) * 2 + (tid & 1); p.wl[pos + (size_t)p.qslot * 16 * ECAP] = twt[tid]; }
        __syncthreads();
    }
}
}

#ifndef ATTN_VMASK
#define ATTN_VMASK 15
#endif
#ifndef REPK_VMASK
#define REPK_VMASK 15
#endif
namespace {
constexpr int AT_KB = 0;
constexpr int AT_KR = 16384;
constexpr int AT_VB = 24576;
constexpr int AT_CB = 40960;
constexpr int AT_CTL = 41472;
constexpr int AT_LDS = 41984;
constexpr float NEGBIG = -1.0e30f;

template <int VAR, int KC>
__device__ __forceinline__ void attn_tile(LAS3 char* lds, const int buf, const int j, const int q0, const int i, const int g, const int swk, const float slope2,
                                          const bf16x8 (&qf)[2][KC], f32x4 (&o)[2][4], float (&mrow)[2], float (&lsum)[2], const u32x2 (&mw)[2]) {
    typedef LAS3 bf16x4 lds_bf16x4;
    bool need = (64 * j <= q0 + 31);
    if (VAR == 2) need = need && (64 * j + 63 >= q0 - 127);
    if (need) {
        const LAS3 char* Kb = lds + AT_KB + buf * 8192; const LAS3 char* Vb = lds + AT_VB + buf * 8192;
        bool full = (64 * j + 63 <= q0);
        if (VAR == 2) full = full && (64 * j >= q0 - 96);
        if (VAR == 3) full = false;
        f32x4 s[2][4];
#pragma unroll
        for (int qt = 0; qt < 2; ++qt) {
            const int t = q0 + 16 * qt + i;
            const int dbase = 64 * j + 4 * g - t;
            const float sb = slope2 * ((VAR == 2) ? (float)dbase : (float)(64 * j + 4 * g));
            unsigned wl = 0u, wh = 0u;
            if (VAR == 3) { const unsigned long long W = (((unsigned long long)mw[qt].y << 32) | mw[qt].x) >> (4 * g); wl = (unsigned)W; wh = (unsigned)(W >> 32); }
#pragma unroll
            for (int mt = 0; mt < 4; ++mt) {
                f32x4 ini = {0.f, 0.f, 0.f, 0.f};
                if (VAR == 0) ini = *(const LAS3 f32x4*)(lds + AT_CB + buf * 256 + (16 * mt + 4 * g) * 4);
#pragma unroll
                for (int r = 0; r < 4; ++r) {
                    const int c = 16 * mt + r;
                    float v = ini[r];
                    if (VAR >= 2) v = sb + slope2 * (float)c;
                    if (VAR == 3) {
                        const int m = ((int)((mt < 2 ? wl : wh) << (31 - (16 * (mt & 1) + r)))) >> 31;
                        v = __uint_as_float((__float_as_uint(v) & (unsigned)m) | (__float_as_uint(NEGBIG) & ~(unsigned)m));
                    } else if (!full) {
                        bool ok;
                        if (VAR == 2) ok = (unsigned)(dbase + c + 127) < 128u;
                        else ok = (dbase + c) <= 0;
                        v = ok ? v : NEGBIG;
                    }
                    ini[r] = v;
                }
                s[qt][mt] = ini;
            }
        }
#pragma unroll
        for (int mt = 0; mt < 4; ++mt) {
#pragma unroll
            for (int kc = 0; kc < 2; ++kc) {
                const bf16x8 kf = *(const LAS3 bf16x8*)(Kb + (mt * 16 + i) * 128 + (((kc * 4 + g) ^ swk) << 4));
                s[0][mt] = __builtin_amdgcn_mfma_f32_16x16x32_bf16(kf, qf[0][kc], s[0][mt], 0, 0, 0);
                s[1][mt] = __builtin_amdgcn_mfma_f32_16x16x32_bf16(kf, qf[1][kc], s[1][mt], 0, 0, 0);
            }
            if (VAR == 1) {
                const bf16x8 kf = *(const LAS3 bf16x8*)(lds + AT_KR + buf * 4096 + (mt * 16 + i) * 64 + ((g ^ (swk & 3)) << 4));
                s[0][mt] = __builtin_amdgcn_mfma_f32_16x16x32_bf16(kf, qf[0][KC - 1], s[0][mt], 0, 0, 0);
                s[1][mt] = __builtin_amdgcn_mfma_f32_16x16x32_bf16(kf, qf[1][KC - 1], s[1][mt], 0, 0, 0);
            }
        }
        bf16x8 pf[2][2];
#pragma unroll
        for (int qt = 0; qt < 2; ++qt) {
            float mx = fmaxf(fmaxf(s[qt][0][0], s[qt][0][1]), fmaxf(s[qt][0][2], s[qt][0][3]));
#pragma unroll
            for (int mt = 1; mt < 4; ++mt) mx = fmaxf(mx, fmaxf(fmaxf(s[qt][mt][0], s[qt][mt][1]), fmaxf(s[qt][mt][2], s[qt][mt][3])));
            mx = fmaxf(mx, __builtin_bit_cast(float, __builtin_amdgcn_ds_swizzle(__builtin_bit_cast(int, mx), 0x401F)));
            mx = xor32_max(mx);
            if (__any(mx > mrow[qt])) {
                const float mn = fmaxf(mrow[qt], mx), alpha = __builtin_amdgcn_exp2f(mrow[qt] - mn);
                mrow[qt] = mn; lsum[qt] *= alpha;
#pragma unroll
                for (int dt = 0; dt < 4; ++dt) o[qt][dt] = o[qt][dt] * alpha;
            }
            const float mn = mrow[qt];
            float ps = 0.f;
            float x[4][4];
#pragma unroll
            for (int mt = 0; mt < 4; ++mt)
#pragma unroll
                for (int r = 0; r < 4; ++r) { x[mt][r] = __builtin_amdgcn_exp2f(s[qt][mt][r] - mn); ps += x[mt][r]; }
            lsum[qt] += ps;
#pragma unroll
            for (int c = 0; c < 2; ++c) {
                u32x4 pk; pk.x = cvt_pk_bf16(x[2 * c][0], x[2 * c][1]); pk.y = cvt_pk_bf16(x[2 * c][2], x[2 * c][3]);
                pk.z = cvt_pk_bf16(x[2 * c + 1][0], x[2 * c + 1][1]); pk.w = cvt_pk_bf16(x[2 * c + 1][2], x[2 * c + 1][3]);
                pf[qt][c] = __builtin_bit_cast(bf16x8, pk);
            }
        }
        const int q4 = i >> 2, p4 = i & 3;
#pragma unroll
        for (int c = 0; c < 2; ++c) {
            const int row0 = 32 * c + 4 * g + q4, swv = (row0 >> 1) & 3;
#pragma unroll
            for (int dt = 0; dt < 4; ++dt) {
                const LAS3 char* a0 = Vb + row0 * 128 + ((dt ^ swv) << 5) + p4 * 8;
                const bf16x4 v0 = __builtin_amdgcn_ds_read_tr16_b64_v4i16((lds_bf16x4*)(a0));
                const bf16x4 v1 = __builtin_amdgcn_ds_read_tr16_b64_v4i16((lds_bf16x4*)(a0 + 16 * 128));
                const bf16x8 vf = {v0[0], v0[1], v0[2], v0[3], v1[0], v1[1], v1[2], v1[3]};
                o[0][dt] = __builtin_amdgcn_mfma_f32_16x16x32_bf16(vf, pf[0][c], o[0][dt], 0, 0, 0);
                o[1][dt] = __builtin_amdgcn_mfma_f32_16x16x32_bf16(vf, pf[1][c], o[1][dt], 0, 0, 0);
            }
        }
    }
}

template <int VAR>
__device__ __forceinline__ void attn_unit(const Params& p, int l, int b, int hx, int qb, LAS3 char* lds) {
    typedef LAS3 bf16x4 lds_bf16x4;
    constexpr int KC = (VAR == 1) ? 3 : 2;
    const int tid = opaque_tid(p.wid), w = __builtin_amdgcn_readfirstlane(tid >> 6), lane = tid & 63, i = lane & 15, g = lane >> 4;
    const bf16_t *Qp, *Kp, *Vp; int ldq, ldk, ldv, q0, j0, j1, ocol; float c1, slope2 = 0.f;
    if (VAR == 0) { Qp = p.proj + PC_AQ + hx * 64; Kp = p.proj + PC_AK + hx * 64; Vp = p.proj + PC_AV + hx * 64; ldq = ldk = ldv = NP;
                    q0 = qb * 256 + 32 * w; j0 = 0; j1 = 4 * qb + 3; ocol = hx * 64; c1 = 0.125f * LOG2E; }
    else if (VAR == 1) { Qp = p.qm + hx * 96; Kp = p.km + hx * 96; Vp = p.vm + hx * 64; ldq = 384; ldk = 384; ldv = 256;
                    q0 = qb * 256 + 32 * w; j0 = 0; j1 = 4 * qb + 3; ocol = 256 + hx * 64; c1 = 0.10206207261596577f * LOG2E; }
    else if (VAR == 2) { const int qh = hx * 2 + (w >> 2); Qp = p.proj + PC_CQ + qh * 64; Kp = p.proj + PC_CK + hx * 64; Vp = p.proj + PC_CV + hx * 64; ldq = ldk = ldv = NP;
                    q0 = qb * 128 + 32 * (w & 3); j0 = 2 * qb - 2 > 0 ? 2 * qb - 2 : 0; j1 = 2 * qb + 1; ocol = 512 + qh * 64; c1 = 0.125f * LOG2E;
                    slope2 = exp2f(-(float)(qh + 1)) * LOG2E; }
    else { const int hd = w >> 1; Qp = p.proj + PC_DQ + hd * 64; Kp = p.proj + PC_DK; Vp = p.proj + PC_DV; ldq = ldk = ldv = NP;
                    q0 = qb * 64 + 32 * (w & 1); j0 = 0; j1 = qb; ocol = 768 + hd * 64; c1 = 0.125f * LOG2E; slope2 = exp2f(-(float)(hd + 5)) * LOG2E; }
    const size_t tok0 = (size_t)b * S;
    if (VAR == 0 && qb > 0) {
        constexpr float FOX_DROP = 64.0f;
        const unsigned* kn2 = p.ctl + CW_KN2 + ((l * NB + b) * 4 + hx) * 32;
        const float* cbh = p.cbF + ((size_t)b * 4 + hx) * S;
        const float qn = c1 * sqrtf(__uint_as_float(p.ctl[CW_QN2 + ((l * NB + b) * 4 + hx) * 8 + qb]));
        float knu = 0.f;
        for (int jj = 4 * qb; jj < 4 * qb + 4; ++jj) knu = fmaxf(knu, __uint_as_float(kn2[jj]));
        const float lower = cbh[256 * qb] - qn * sqrtf(knu);
        const int jl = lane & 31;
        const bool keep = qn * sqrtf(__uint_as_float(kn2[jl])) + cbh[64 * jl + 63] - lower >= -FOX_DROP || jl >= 4 * qb;
        const unsigned long long kb = __ballot(keep) & 0xFFFFFFFFull;
        j0 = kb ? (int)__builtin_ctzll(kb) : 4 * qb;
    }
    bf16x8 qf[2][KC];
#pragma unroll
    for (int qt = 0; qt < 2; ++qt)
#pragma unroll
        for (int kc = 0; kc < KC; ++kc) qf[qt][kc] = *(const bf16x8*)(Qp + (tok0 + q0 + 16 * qt + i) * ldq + kc * 32 + 8 * g);
    const int sr = tid >> 3, sc8 = tid & 7;
    const int kdst = sr * 128 + ((sc8 ^ ((sr >> 1) & 7)) << 4);
    const int vdst = sr * 128 + (((((sc8 >> 1) ^ ((sr >> 1) & 3)) << 1) | (sc8 & 1)) << 4);
    const int rr = (tid & 255) >> 2, rc4 = tid & 3;
    const int rdst = rr * 64 + ((rc4 ^ ((rr >> 1) & 3)) << 4);
    u32x4 kstA, vstA, rstA = {0u, 0u, 0u, 0u}, kstB, vstB, rstB = {0u, 0u, 0u, 0u}; float cstA = 0.f, cstB = 0.f;
    u32x2 mw[2] = {{0u, 0u}, {0u, 0u}}, mwnA[2] = {{0u, 0u}, {0u, 0u}}, mwnB[2] = {{0u, 0u}, {0u, 0u}};
#define AT_LOAD(ZZ, j) do { const size_t _kr = tok0 + 64 * (j) + sr; \
        kst##ZZ = *(const u32x4*)(Kp + _kr * ldk + sc8 * 8); vst##ZZ = *(const u32x4*)(Vp + _kr * ldv + sc8 * 8); \
        if (VAR == 1 && tid < 256) rst##ZZ = *(const u32x4*)(Kp + (tok0 + 64 * (j) + rr) * ldk + 64 + rc4 * 8); \
        if (VAR == 0 && tid < 64) cst##ZZ = p.cbF[((size_t)b * 4 + hx) * S + 64 * (j) + tid]; \
        if (VAR == 3) { _Pragma("unroll") for (int _q = 0; _q < 2; ++_q) mwn##ZZ[_q] = *(const u32x2*)(p.mask + (tok0 + q0 + 16 * _q + i) * 64 + 2 * (j)); } } while (0)
#define AT_WRITE(ZZ, buf) do { *(LAS3 u32x4*)(lds + AT_KB + (buf) * 8192 + kdst) = kst##ZZ; *(LAS3 u32x4*)(lds + AT_VB + (buf) * 8192 + vdst) = vst##ZZ; \
        if (VAR == 1 && tid < 256) *(LAS3 u32x4*)(lds + AT_KR + (buf) * 4096 + rdst) = rst##ZZ; \
        if (VAR == 0 && tid < 64) *(LAS3 float*)(lds + AT_CB + (buf) * 256 + tid * 4) = cst##ZZ; \
        if (VAR == 3) { mw[0] = mwn##ZZ[0]; mw[1] = mwn##ZZ[1]; } } while (0)
    AT_LOAD(A, j0);
    if (j0 + 1 <= j1) AT_LOAD(B, j0 + 1);
    if (VAR == 1) {
#pragma unroll
        for (int qt = 0; qt < 2; ++qt) {
            const int pos = q0 + 16 * qt + i;
            const u32x4 mine = __builtin_bit_cast(u32x4, qf[qt][KC - 1]);
            u32x4 oth; oth.x = __shfl_xor(mine.x, 32); oth.y = __shfl_xor(mine.y, 32); oth.z = __shfl_xor(mine.z, 32); oth.w = __shfl_xor(mine.w, 32);
            const float* rt = p.ropetab + (size_t)(pos * 16 + (g & 1) * 8) * 2;
            const float sg = (g < 2) ? -1.f : 1.f;
            u32x4 res;
#pragma unroll
            for (int e2 = 0; e2 < 4; ++e2) {
                const f32x4 cs = *(const f32x4*)(rt + e2 * 4);
                const unsigned mw_ = e2 == 0 ? mine.x : e2 == 1 ? mine.y : e2 == 2 ? mine.z : mine.w, ow_ = e2 == 0 ? oth.x : e2 == 1 ? oth.y : e2 == 2 ? oth.z : oth.w;
                const float r0 = bflo(mw_) * cs[0] + sg * bflo(ow_) * cs[1], r1 = bfhi(mw_) * cs[2] + sg * bfhi(ow_) * cs[3];
                const unsigned pk = cvt_pk_bf16(r0, r1);
                if (e2 == 0) res.x = pk; else if (e2 == 1) res.y = pk; else if (e2 == 2) res.z = pk; else res.w = pk;
            }
            qf[qt][KC - 1] = __builtin_bit_cast(bf16x8, res);
        }
    }
#pragma unroll
    for (int qt = 0; qt < 2; ++qt)
#pragma unroll
        for (int kc = 0; kc < KC; ++kc) {
            u32x4 qq = __builtin_bit_cast(u32x4, qf[qt][kc]);
            qq.x = cvt_pk_bf16(bflo(qq.x) * c1, bfhi(qq.x) * c1); qq.y = cvt_pk_bf16(bflo(qq.y) * c1, bfhi(qq.y) * c1);
            qq.z = cvt_pk_bf16(bflo(qq.z) * c1, bfhi(qq.z) * c1); qq.w = cvt_pk_bf16(bflo(qq.w) * c1, bfhi(qq.w) * c1);
            qf[qt][kc] = __builtin_bit_cast(bf16x8, qq);
        }
    f32x4 o[2][4];
#pragma unroll
    for (int qt = 0; qt < 2; ++qt)
#pragma unroll
        for (int dt = 0; dt < 4; ++dt) o[qt][dt] = (f32x4){0.f, 0.f, 0.f, 0.f};
    float mrow[2] = {NEGBIG, NEGBIG}, lsum[2] = {0.f, 0.f};
    AT_WRITE(A, j0 & 1);
    __syncthreads();
    const int swk = (i >> 1) & 7;
    for (int j = j0; j <= j1; j += 2) {
        if (j + 2 <= j1) AT_LOAD(A, j + 2);
        attn_tile<VAR, KC>(lds, j & 1, j, q0, i, g, swk, slope2, qf, o, mrow, lsum, mw);
        if (j + 1 <= j1) AT_WRITE(B, (j + 1) & 1);
        __syncthreads();
        if (j + 1 > j1) break;
        if (j + 3 <= j1) AT_LOAD(B, j + 3);
        attn_tile<VAR, KC>(lds, (j + 1) & 1, j + 1, q0, i, g, swk, slope2, qf, o, mrow, lsum, mw);
        if (j + 2 <= j1) AT_WRITE(A, j & 1);
        __syncthreads();
    }
#undef AT_LOAD
#undef AT_WRITE
#pragma unroll
    for (int qt = 0; qt < 2; ++qt) {
        float lt = lsum[qt]; lt += __shfl_xor(lt, 16); lt += __shfl_xor(lt, 32);
        if (VAR == 2) lt += __builtin_amdgcn_exp2f(p.sinks[l * 4 + hx * 2 + (w >> 2)] * LOG2E - mrow[qt]);
        const float inv = 1.f / lt;
        bf16_t* op = p.merged + (tok0 + q0 + 16 * qt + i) * D + ocol + 4 * g;
#pragma unroll
        for (int dt = 0; dt < 4; ++dt) { const f32x4 v = o[qt][dt] * inv; u32x2 w2; w2.x = cvt_pk_bf16(v[0], v[1]); w2.y = cvt_pk_bf16(v[2], v[3]); *(u32x2*)(op + 16 * dt) = w2; }
    }
}

__device__ __forceinline__ void phase_attn(const Params& p, int l, LAS3 char* lds) {
    const int tid = opaque_tid(p.wid);
    unsigned* qhead = p.ctl + CW_QA + 64 * (l + 2 * p.qslot);
    volatile LAS3 int* bc = (volatile LAS3 int*)(lds + AT_CTL);
    int nxt = 0;
    if (tid == 0) nxt = (int)__hip_atomic_fetch_add(qhead, 1u, __ATOMIC_RELAXED, __HIP_MEMORY_SCOPE_AGENT);
    for (;;) {
        if (tid == 0) *bc = nxt;
        __syncthreads();
        const int idx = __builtin_amdgcn_readfirstlane(*bc);
        __syncthreads();
        if (idx >= 4096) break;
        if (tid == 0) nxt = (int)__hip_atomic_fetch_add(qhead, 1u, __ATOMIC_RELAXED, __HIP_MEMORY_SCOPE_AGENT);
        const int vmask = p.qslot ? REPK_VMASK : ATTN_VMASK;
        if (idx < 3072) {
            const int lvl = 7 - idx / 384, rem = idx % 384;
            if (rem < 128) { if (vmask & 2) attn_unit<1>(p, l, rem >> 2, rem & 3, lvl, lds); }
            else if (rem < 256) { if (vmask & 1) attn_unit<0>(p, l, (rem - 128) >> 2, rem & 3, lvl, lds); }
            else { const int d = rem - 256; if (vmask & 8) attn_unit<3>(p, l, d & 31, 0, 4 * lvl + 3 - (d >> 5), lds); }
        } else { const int c = idx - 3072; if (vmask & 4) attn_unit<2>(p, l, c >> 5, (c >> 4) & 1, c & 15, lds); }
    }
}
}

namespace {
constexpr int DS_LD = 2052;
constexpr int DS_CTL = 16 * DS_LD * 4;
constexpr int DS_LDS = DS_CTL + 64;

__device__ __forceinline__ void dsa_unit(const Params& p, int u, LAS3 char* lds) {
    const int tid = opaque_tid(p.wid), w = __builtin_amdgcn_readfirstlane(tid >> 6), lane = tid & 63, i = lane & 15, g = lane >> 4;
    const int b = u >> 7, t0 = (u & 127) * 16;
    const size_t tok0 = (size_t)b * S;
    uint32_t* mbase = p.mask + (tok0 + t0) * 64;
    if (t0 + 16 <= 256) {
#pragma unroll
        for (int qq = 0; qq < 2; ++qq) {
            const int q = 2 * w + qq, n = t0 + q + 1;
            if (lane < 32) { const int lo = lane * 64; unsigned long long bits = (n >= lo + 64) ? ~0ull : (n <= lo ? 0ull : ((1ull << (n - lo)) - 1ull));
                u32x2 o; o.x = (unsigned)bits; o.y = (unsigned)(bits >> 32); *(u32x2*)(mbase + q * 64 + 2 * lane) = o; }
        }
        return;
    }
    const int nreg = (t0 + 16 + 63) >> 6;
    const int ntile = nreg * 4;
    bf16x8 qf[8]; float wq[8];
    {
        const bf16_t* qrow = p.proj + (tok0 + t0 + i) * NP;
#pragma unroll
        for (int h = 0; h < 8; ++h) qf[h] = *(const bf16x8*)(qrow + PC_DQI + h * 32 + 8 * g);
        const u32x4 ww = *(const u32x4*)(qrow + PC_DWI);
        const float sc = 0.35355339059327373f * 0.17677669529663687f;
        wq[0] = bflo(ww.x) * sc; wq[1] = bfhi(ww.x) * sc; wq[2] = bflo(ww.y) * sc; wq[3] = bfhi(ww.y) * sc;
        wq[4] = bflo(ww.z) * sc; wq[5] = bfhi(ww.z) * sc; wq[6] = bflo(ww.w) * sc; wq[7] = bfhi(ww.w) * sc;
    }
    const int tq = t0 + i;
#ifndef DSA_EXP
#define DSA_EXP 0
#endif
    const bool exp_skip_score = (DSA_EXP == 2) && p.qslot > 0, exp_skip_sel = (DSA_EXP == 1) && p.qslot > 0, exp_nostore = (DSA_EXP != 0) && p.qslot > 0;
    if (!exp_skip_score)
    for (int base = w; base < ntile; base += 32) {
        bf16x8 kf4[4];
#pragma unroll
        for (int uu = 0; uu < 4; ++uu) { const int kt = base + 8 * uu; if (kt < ntile) kf4[uu] = *(const bf16x8*)(p.kidx + (tok0 + 16 * kt + i) * 32 + 8 * g); }
#pragma unroll
        for (int uu = 0; uu < 4; ++uu) {
            const int kt = base + 8 * uu;
            if (kt < ntile) {
                f32x4 sc4 = {0.f, 0.f, 0.f, 0.f};
#pragma unroll
                for (int h = 0; h < 8; ++h) {
                    const f32x4 c = __builtin_amdgcn_mfma_f32_16x16x32_bf16(kf4[uu], qf[h], (f32x4){0.f, 0.f, 0.f, 0.f}, 0, 0, 0);
#pragma unroll
                    for (int r = 0; r < 4; ++r) sc4[r] += wq[h] * fmaxf(c[r], 0.f);
                }
                u32x4 ko;
#pragma unroll
                for (int r = 0; r < 4; ++r) {
                    const int key = 16 * kt + 4 * g + r;
                    unsigned uu2 = __float_as_uint(sc4[r]); if (uu2 == 0x80000000u) uu2 = 0u;
                    uu2 = (uu2 & 0x80000000u) ? ~uu2 : (uu2 | 0x80000000u);
                    ko[r] = (key <= tq) ? uu2 : 0u;
                }
                *(LAS3 u32x4*)(lds + ((size_t)i * DS_LD + 16 * kt + 4 * g) * 4) = ko;
            }
        }
    }
    __syncthreads();
    if (!exp_skip_sel)
    {
        const int qA = 2 * w, qB = 2 * w + 1, nA = t0 + qA + 1, nB = t0 + qB + 1;
        const LAS3 unsigned* kpA = (const LAS3 unsigned*)(lds + (size_t)qA * DS_LD * 4);
        const LAS3 unsigned* kpB = (const LAS3 unsigned*)(lds + (size_t)qB * DS_LD * 4);
        unsigned keyA[32], keyB[32];
        const int nv = nreg * 64;
#pragma unroll
        for (int r = 0; r < 32; ++r) {
            int idx = r * 64 + lane; asm volatile("" : "+v"(idx));
            const unsigned va = kpA[r * 64 + lane], vb = kpB[r * 64 + lane];
            keyA[r] = (idx < nv) ? va : 0u; keyB[r] = (idx < nv) ? vb : 0u;
        }
        unsigned thrA = (nA <= 256) ? 1u : 0u, thrB = (nB <= 256) ? 1u : 0u;
        bool exA = (nA <= 256), exB = (nB <= 256);
        for (int bit = 31; bit >= 0; --bit) {
            if (exA && exB) break;
            const unsigned cA = exA ? 0xFFFFFFFFu : (thrA | (1u << bit)), cB = exB ? 0xFFFFFFFFu : (thrB | (1u << bit));
            int na = 0, nb = 0;
            if (!exA && !exB) {
#pragma unroll
                for (int gq = 0; gq < 4; ++gq) if (nreg > 8 * gq) {
#pragma unroll
                    for (int r = 8 * gq; r < 8 * gq + 8; ++r) { na += (keyA[r] >= cA) ? 1 : 0; nb += (keyB[r] >= cB) ? 1 : 0; } }
                na = wave_reduce_add(na); nb = wave_reduce_add(nb);
            } else if (!exA) {
#pragma unroll
                for (int gq = 0; gq < 4; ++gq) if (nreg > 8 * gq) {
#pragma unroll
                    for (int r = 8 * gq; r < 8 * gq + 8; ++r) na += (keyA[r] >= cA) ? 1 : 0; }
                na = wave_reduce_add(na);
            } else {
#pragma unroll
                for (int gq = 0; gq < 4; ++gq) if (nreg > 8 * gq) {
#pragma unroll
                    for (int r = 8 * gq; r < 8 * gq + 8; ++r) nb += (keyB[r] >= cB) ? 1 : 0; }
                nb = wave_reduce_add(nb);
            }
            if (!exA && na >= 256) { thrA = cA; exA = (na == 256); }
            if (!exB && nb >= 256) { thrB = cB; exB = (nb == 256); }
        }
#pragma unroll 1
        for (int qq = 0; qq < 2; ++qq) {
            const unsigned thr = qq ? thrB : thrA; const bool exact = qq ? exB : exA;
            unsigned long long mine = 0ull;
            int need = 0, running = 0;
            if (!exact) { int ngt = 0;
#pragma unroll
                for (int r = 0; r < 32; ++r) ngt += ((qq ? keyB[r] : keyA[r]) > thr) ? 1 : 0;
                need = 256 - wave_reduce_add(ngt); }
            const unsigned long long lt = (lane == 0) ? 0ull : (~0ull >> (64 - lane));
#pragma unroll
            for (int r = 0; r < 32; ++r) if (nreg > (r & ~7)) {
                const unsigned key = qq ? keyB[r] : keyA[r];
                unsigned long long bs;
                if (exact) bs = __ballot(key >= thr);
                else {
                    const bool eq = key == thr;
                    const unsigned long long be = __ballot(eq);
                    const int rank = running + __popcll(be & lt);
                    bs = __ballot((key > thr) || (eq && rank < need));
                    running += __popcll(be);
                }
                { int ln = lane; asm volatile("" : "+v"(ln)); if (ln == r) mine = bs; }
            }
            if (lane < 32 && !exp_nostore) { u32x2 o; o.x = (unsigned)mine; o.y = (unsigned)(mine >> 32); *(u32x2*)(mbase + (2 * w + qq) * 64 + 2 * lane) = o; }
        }
    }
    __syncthreads();
}

__device__ __forceinline__ void phase_dsa(const Params& p, int l, LAS3 char* lds) {
    const int tid = opaque_tid(p.wid);
    unsigned* qhead = p.ctl + CW_QD + 64 * (l + 2 * p.qslot);
    volatile LAS3 int* bc = (volatile LAS3 int*)(lds + DS_CTL);
    int nxt = 0;
    if (tid == 0) nxt = (int)__hip_atomic_fetch_add(qhead, 1u, __ATOMIC_RELAXED, __HIP_MEMORY_SCOPE_AGENT);
    for (;;) {
        if (tid == 0) *bc = nxt;
        __syncthreads();
        const int idx = __builtin_amdgcn_readfirstlane(*bc);
        __syncthreads();
        if (idx >= 4096) break;
        if (tid == 0) nxt = (int)__hip_atomic_fetch_add(qhead, 1u, __ATOMIC_RELAXED, __HIP_MEMORY_SCOPE_AGENT);
        const int pb = 127 - (idx >> 5), b = idx & 31;
        dsa_unit(p, b * 128 + pb, lds);
    }
}
}

namespace {
constexpr int LDS_BYTES = 147456;
constexpr int NTHREADS = 512;

template <int PH>
__device__ __forceinline__ void run_phase(const Params& p, int l, unsigned char* smem) {
    LAS3 char* lds = (LAS3 char*)smem;
    PG8_LAS unsigned char* glds = (PG8_LAS unsigned char*)smem;
    const int G = gridDim.x, c = blockIdx.x;
    if constexpr (PH == 0) phase_p0(p, (char*)smem);
    if constexpr (PH == 1) { if (l == 0) phase_norm1<0>(p, 0); else phase_norm1<1>(p, l); }
    if constexpr (PH == 2) { pg8::Gemm g{p.h, p.WinT + (size_t)l * NP * D, D, D, 0}; pg8::StaticOrder S; S.init(T, NP, G, c);
        EpiStoreBf16 E{p.proj, NP}; pg8::gemm_phase<EpiStoreBf16, pg8::StaticOrder, false>(glds, g, S, E, p.wid); }
    if constexpr (PH == 3) phase_prep(p, l);
    if constexpr (PH == 4) { pg8::Gemm g{p.proj + PC_BCQ, p.WqT + (size_t)l * 512 * 256, 256, NP, 0}; pg8::StaticOrder S; S.init(T, 512, G, c);
          EpiMlaQ E{p.qm}; pg8::gemm_phase<EpiMlaQ, pg8::StaticOrder, false>(glds, g, S, E, p.wid); }
    if constexpr (PH == 12) { pg8::Gemm g{p.proj + PC_BCKV, p.WkvT + (size_t)l * 512 * 128, 128, NP, 0}; pg8::StaticOrder S; S.init(T, 512, G, c);
          EpiMlaKV E{p.km, p.vm}; pg8::gemm_phase<EpiMlaKV, pg8::StaticOrder, false>(glds, g, S, E, p.wid); }
    if constexpr (PH == 13) phase_dsa(p, l, lds);
    if constexpr (PH == 5) phase_attn(p, l, lds);
    if constexpr (PH == 6) { pg8::Gemm g{p.merged, p.WoutT + (size_t)l * D * D, D, D, 0}; pg8::StaticOrder S; S.init(T, D, G, c);
        EpiResidual E{l == 0 ? p.x : p.xo, p.xo, p.mod + (size_t)l * NB * NMOD + 2 * 1024}; pg8::gemm_phase<EpiResidual, pg8::StaticOrder, false>(glds, g, S, E, p.wid); }
    if constexpr (PH == 7) phase_route(p, l, (char*)smem);
    if constexpr (PH == 8) { const int* cnt = (const int*)(p.ctl + CW_CNT) + l * 16;
        pg8::Gemm g{p.h, p.WguT + (size_t)l * 16 * 512 * 1024, 1024, D, (size_t)512 * 1024}; MoeOrder S; S.init(cnt, p.list, 2, G, c);
        EpiGateUp E{p.hid}; pg8::gemm_phase<EpiGateUp, MoeOrder, true>(glds, g, S, E, p.wid); }
    if constexpr (PH == 9) { const int* cnt = (const int*)(p.ctl + CW_CNT) + l * 16;
        pg8::Gemm g{p.hid, p.WdT + (size_t)l * 16 * 1024 * 256, 256, 256, (size_t)1024 * 256}; MoeOrder S; S.init(cnt, p.list, 4, G, c);
        EpiDown E{p.ys, p.list, p.wl, cnt}; pg8::gemm_phase<EpiDown, MoeOrder, false>(glds, g, S, E, p.wid); }
    if constexpr (PH == 10) phase_norm1<2>(p, 1);
    if constexpr (PH == 11) phase_norm1<0>(p, l);
}
template <int PH>
__global__ void __launch_bounds__(NTHREADS, 2) k_ph(Params p, int l) {
    extern __shared__ __attribute__((aligned(16))) unsigned char smem[];
    p.wid = __builtin_amdgcn_readfirstlane(threadIdx.x >> 6); p.qslot = p.qslot_host;
    run_phase<PH>(p, l, smem);
}
}


namespace {
#ifndef REP_PH
#define REP_PH -1
#endif
#define REP(X, l) do { if (REP_PH == X) { xcd_barrier(bar); phase<X>(l, smem, wid, 1); } } while (0)
struct KArgs { const float* in[20]; float* xo; char* ws; };
constexpr size_t al256(size_t b) { return (b + 255) & ~(size_t)255; }
constexpr size_t WS_CTL = 0;
constexpr size_t WS_MOD = WS_CTL + al256((size_t)CW_WORDS * 4);
constexpr size_t WS_WIN = WS_MOD + al256((size_t)2 * NB * NMOD * 4);
constexpr size_t WS_WOUT = WS_WIN + al256((size_t)2 * NP * D * 2);
constexpr size_t WS_WQ = WS_WOUT + al256((size_t)2 * D * D * 2);
constexpr size_t WS_WKV = WS_WQ + al256((size_t)2 * 512 * 256 * 2);
constexpr size_t WS_WGU = WS_WKV + al256((size_t)2 * 512 * 128 * 2);
constexpr size_t WS_WD = WS_WGU + al256((size_t)2 * 16 * 512 * 1024 * 2);
constexpr size_t WS_ROPE = WS_WD + al256((size_t)2 * 16 * 1024 * 256 * 2);
constexpr size_t WS_RQ = WS_ROPE + al256((size_t)2048 * 16 * 2 * 4);
constexpr size_t WS_RKV = WS_RQ + al256((size_t)T * 4);
constexpr size_t WS_CBF = WS_RKV + al256((size_t)T * 4);
constexpr size_t WS_KIDX = WS_CBF + al256((size_t)NB * 4 * S * 4);
constexpr size_t WS_MASK = WS_KIDX + al256((size_t)T * 32 * 2);
constexpr size_t WS_LIST = WS_MASK + al256((size_t)T * 64 * 4);
constexpr size_t WS_RW = WS_LIST + al256((size_t)2 * 16 * ECAP * 4);
constexpr size_t WS_WL = WS_RW + al256((size_t)T * 2 * 4);
constexpr size_t WS_H = WS_WL + al256((size_t)2 * 16 * ECAP * 4);
constexpr size_t WS_PROJ = WS_H + al256((size_t)T * D * 2);
constexpr size_t WS_QM = WS_PROJ + al256((size_t)T * NP * 2);
constexpr size_t WS_KM = WS_QM + al256((size_t)T * 384 * 2);
constexpr size_t WS_VM = WS_KM + al256((size_t)T * 384 * 2);
constexpr size_t WS_MERGED = WS_VM + al256((size_t)T * 256 * 2);
constexpr size_t WS_END1 = WS_MERGED + al256((size_t)T * D * 2);
constexpr size_t WS_HID = WS_PROJ;
constexpr size_t WS_YS = WS_HID + al256((size_t)HIDROWS * 256 * 2);
constexpr size_t WS_END2 = WS_YS + al256((size_t)T * 2 * D * 2);
constexpr size_t WS_NEED = WS_END1 > WS_END2 ? WS_END1 : WS_END2;
static_assert(WS_END2 <= WS_MERGED, "MoE overlay must not reach the merged buffer");

__device__ __forceinline__ Params make_params(const KArgs& a) {
    Params p;
    p.x = a.in[0]; p.c = a.in[1]; p.w_ada = a.in[2]; p.b_ada = a.in[3]; p.g_norm1 = a.in[4]; p.w_in = a.in[5]; p.b_forget = a.in[6]; p.g_q_mla = a.in[7];
    p.w_q_up = a.in[8]; p.g_kv_mla = a.in[9]; p.w_kv_up = a.in[10]; p.sinks = a.in[11]; p.w_out = a.in[12]; p.g_norm2 = a.in[13]; p.w_router = a.in[14];
    p.b_router = a.in[15]; p.w_gate = a.in[16]; p.w_up = a.in[17]; p.w_down = a.in[18]; p.g_final = a.in[19];
    p.xo = a.xo; char* ws = a.ws;
    p.ctl = (unsigned*)(ws + WS_CTL); p.mod = (float*)(ws + WS_MOD); p.WinT = (bf16_t*)(ws + WS_WIN); p.WoutT = (bf16_t*)(ws + WS_WOUT);
    p.WqT = (bf16_t*)(ws + WS_WQ); p.WkvT = (bf16_t*)(ws + WS_WKV); p.WguT = (bf16_t*)(ws + WS_WGU); p.WdT = (bf16_t*)(ws + WS_WD);
    p.ropetab = (float*)(ws + WS_ROPE); p.rq = (float*)(ws + WS_RQ); p.rkv = (float*)(ws + WS_RKV); p.cbF = (float*)(ws + WS_CBF); p.kidx = (bf16_t*)(ws + WS_KIDX);
    p.mask = (uint32_t*)(ws + WS_MASK); p.list = (int*)(ws + WS_LIST); p.rw = (float*)(ws + WS_RW); p.wl = (float*)(ws + WS_WL); p.h = (bf16_t*)(ws + WS_H);
    p.proj = (bf16_t*)(ws + WS_PROJ); p.qm = (bf16_t*)(ws + WS_QM); p.km = (bf16_t*)(ws + WS_KM); p.vm = (bf16_t*)(ws + WS_VM);
    p.merged = (bf16_t*)(ws + WS_MERGED); p.hid = (bf16_t*)(ws + WS_HID); p.ys = (bf16_t*)(ws + WS_YS);
    return p;
}
template <int PH>
__device__ __forceinline__ void phase(int l, unsigned char* smem, int wid, int qslot = 0) {
    typedef const __attribute__((address_space(4))) KArgs* KA4;
    KA4 ka = (KA4)__builtin_amdgcn_kernarg_segment_ptr();
    asm volatile("" : "+s"(ka));
    KArgs a;
#pragma unroll
    for (int i = 0; i < 20; ++i) a.in[i] = ka->in[i];
    a.xo = ka->xo; a.ws = ka->ws;
    Params p = make_params(a); p.wid = wid; p.qslot = qslot; p.qslot_host = 0;
    run_phase<PH>(p, l, smem);
}
__global__ void __launch_bounds__(NTHREADS, 2) fwd(KArgs args) {
    extern __shared__ __attribute__((aligned(16))) unsigned char smem[];
    volatile LAS unsigned* st = (volatile LAS unsigned*)(smem + LDS_BYTES - 16);
    const int wid = __builtin_amdgcn_readfirstlane(threadIdx.x >> 6);
    if (xb_leader(wid)) { st[0] = 0u; st[1] = 0u; st[2] = 0u; st[3] = 0u; }
    __syncthreads();
    XcdBarrier bar = xcd_barrier_post((unsigned*)(args.ws + WS_CTL) + CW_BAR, st, wid);
    phase<0>(0, smem, wid);  REP(0, 0);
    xcd_barrier(bar);
#define LAYER(l) do { \
        phase<1>(l, smem, wid);  if (l == 0) REP(1, l); xcd_barrier(bar); \
        phase<2>(l, smem, wid);  REP(2, l); xcd_barrier(bar); \
        phase<3>(l, smem, wid);  REP(3, l); xcd_barrier(bar); \
        phase<4>(l, smem, wid);  REP(4, l); phase<12>(l, smem, wid);  REP(12, l); phase<13>(l, smem, wid);  REP(13, l); xcd_barrier(bar); \
        phase<5>(l, smem, wid);  REP(5, l); xcd_barrier(bar); \
        phase<6>(l, smem, wid);  xcd_barrier(bar); \
        phase<7>(l, smem, wid);  REP(7, l); xcd_barrier(bar); \
        phase<8>(l, smem, wid);  REP(8, l); xcd_barrier(bar); \
        phase<9>(l, smem, wid);  REP(9, l); xcd_barrier(bar); } while (0)
    LAYER(0);
    LAYER(1);
#ifdef REP_BAR
    for (int rb = 0; rb < REP_BAR; ++rb) xcd_barrier(bar);
#endif
    phase<10>(1, smem, wid);
}
}

extern "C" void kernel_launch(void* const* d_in, const int* in_sizes, int n_in, void* d_out, int out_size, void* d_ws, size_t ws_size,
                              hipStream_t stream) {
    KArgs a{};
    for (int i = 0; i < 20; ++i) a.in[i] = (const float*)d_in[i];
    a.xo = (float*)d_out; a.ws = (char*)d_ws;
    if (WS_NEED > ws_size) return;

    static int grid = 0;
    if (!grid) {
        int dev = 0, cus = 0, per_cu = 0;
        (void)hipGetDevice(&dev);
        (void)hipDeviceGetAttribute(&cus, hipDeviceAttributeMultiprocessorCount, dev);
        (void)hipFuncSetAttribute((const void*)fwd, hipFuncAttributeMaxDynamicSharedMemorySize, LDS_BYTES);
        (void)hipOccupancyMaxActiveBlocksPerMultiprocessor(&per_cu, (const void*)fwd, NTHREADS, LDS_BYTES);
        grid = cus > 0 ? cus : 256;
    }
    (void)hipMemsetAsync(a.ws + WS_CTL, 0, (size_t)CW_WORDS * 4, stream);
    fwd<<<dim3(grid), dim3(NTHREADS), LDS_BYTES, stream>>>(a);
}
```

```cpp
#include <hip/hip_runtime.h>
#include <stdint.h>
#define XB_TMO      128
#define XB_XCNT(j)  (256  + 64 * (j))
#define XB_XSUB(j)  (1280 + 64 * (j))
#define XB_XGEN(j)  (2304 + 64 * (j))
#define XB_TOP      3328
#define XB_TOPGEN   3392
#define XCD_BAR_WORDS 3456
#define XB_SPIN_CAP (1u << 20)
#define LAS __attribute__((address_space(3)))

__device__ __forceinline__ unsigned xb_ld(unsigned* p)              { return __hip_atomic_load(p, __ATOMIC_RELAXED, __HIP_MEMORY_SCOPE_AGENT); }
__device__ __forceinline__ unsigned xb_add(unsigned* p, unsigned v) { return __hip_atomic_fetch_add(p, v, __ATOMIC_RELAXED, __HIP_MEMORY_SCOPE_AGENT); }
__device__ __forceinline__ unsigned xb_xcc_id() { return (unsigned)__builtin_amdgcn_s_getreg((3 << 11) | 20) & 0xFu; }
#define XB_SPIN(cond, bar) do { unsigned _sp = 0; while (cond) { __builtin_amdgcn_s_sleep(1); \
    if ((++_sp & 255u) == 0u) { if (xb_ld(&(bar)[XB_TMO])) break; if (_sp > XB_SPIN_CAP) { atomicAdd(&(bar)[XB_TMO], 1u); break; } } } } while (0)

struct XcdBarrier { unsigned* bar; unsigned x; volatile LAS unsigned* st; int wid; };
__device__ __forceinline__ bool xb_leader(int wid) { return wid == 0 && __builtin_amdgcn_mbcnt_hi(~0u, __builtin_amdgcn_mbcnt_lo(~0u, 0u)) == 0u; }

__device__ __forceinline__ XcdBarrier xcd_barrier_post(unsigned* bar, volatile LAS unsigned* st, int wid) {
    XcdBarrier b; b.bar = bar; b.x = xb_xcc_id(); b.st = st; b.wid = wid;
    if (xb_leader(wid)) (void)xb_add(&bar[XB_XCNT(b.x)], 1u);
    return b;
}
__device__ __forceinline__ void xcd_barrier_complete(unsigned* bar, unsigned x, unsigned& nloc, unsigned& nx) {
    const unsigned G = gridDim.x * gridDim.y * gridDim.z;
    unsigned sum, cnt, mine, sp = 0u;
    for (;;) {
        sum = 0u; cnt = 0u; mine = 0u;
#pragma unroll
        for (unsigned j = 0; j < 16; ++j) { const unsigned c = xb_ld(&bar[XB_XCNT(j)]); sum += c; cnt += (c > 0u) ? 1u : 0u; mine = (j == x) ? c : mine; }
        if (sum == G) break;
        __builtin_amdgcn_s_sleep(1);
        if ((++sp & 255u) == 0u) { if (xb_ld(&bar[XB_TMO])) break; if (sp > XB_SPIN_CAP) { atomicAdd(&bar[XB_TMO], 1u); break; } }
    }
    nloc = mine > 0u ? mine : 1u; nx = cnt > 0u ? cnt : 1u;
}
__device__ __forceinline__ void xcd_barrier(const XcdBarrier& b) {
    asm volatile("s_waitcnt vmcnt(0)" ::: "memory");
    __syncthreads();
    if (xb_leader(b.wid)) {
        unsigned* bar = b.bar;
        __builtin_amdgcn_s_waitcnt(0);
        unsigned nloc = b.st[0], nx = b.st[1];
        if (nloc == 0u) { xcd_barrier_complete(bar, b.x, nloc, nx); b.st[0] = nloc; b.st[1] = nx; }
        const unsigned old = xb_add(&bar[XB_XSUB(b.x)], 1u);
        const unsigned gen = old / nloc;
        if (old + 1u == (gen + 1u) * nloc) {
            __builtin_amdgcn_fence(__ATOMIC_RELEASE, "agent");
            asm volatile("s_waitcnt vmcnt(0)" ::: "memory");
            const unsigned og = xb_add(&bar[XB_TOP], 1u);
            const unsigned tg = og / nx;
            if (og + 1u == (tg + 1u) * nx) xb_add(&bar[XB_TOPGEN], 1u);
            else XB_SPIN(xb_ld(&bar[XB_TOPGEN]) == tg, bar);
            __builtin_amdgcn_fence(__ATOMIC_ACQUIRE, "agent");
            xb_add(&bar[XB_XGEN(b.x)], 1u);
            asm volatile("s_waitcnt vmcnt(0)" ::: "memory");
        } else {
            XB_SPIN(xb_ld(&bar[XB_XGEN(b.x)]) == gen, bar);
            __builtin_amdgcn_fence(__ATOMIC_ACQUIRE, "agent");
            asm volatile("s_waitcnt vmcnt(0)" ::: "memory");
        }
    }
    __syncthreads();
}

#define LAS3 __attribute__((address_space(3)))
namespace {
typedef unsigned short bf16_t;
typedef short bf16x8 __attribute__((ext_vector_type(8)));
typedef short bf16x4 __attribute__((ext_vector_type(4)));
typedef float f32x4 __attribute__((ext_vector_type(4)));
typedef float f32x2 __attribute__((ext_vector_type(2)));
typedef unsigned u32x4 __attribute__((ext_vector_type(4)));
typedef unsigned u32x2 __attribute__((ext_vector_type(2)));

constexpr int D = 1024, NB = 32, S = 2048, T = NB * S, NIN = 2380, NP = 2560, NMOD = 6144;
constexpr int OFF_AQ = 0, OFF_AK = 256, OFF_AV = 512, OFF_AF = 768, OFF_BCQ = 772, OFF_BCKV = 1028, OFF_BKR = 1156,
              OFF_CQ = 1188, OFF_CK = 1444, OFF_CV = 1572, OFF_DQ = 1700, OFF_DK = 1956, OFF_DV = 2020,
              OFF_DQI = 2084, OFF_DKI = 2340, OFF_DWI = 2372;
constexpr int PC_AQ = 0, PC_AK = 256, PC_AV = 512, PC_BCQ = 768, PC_BCKV = 1024, PC_BKR = 1152, PC_CQ = 1184, PC_CK = 1440, PC_CV = 1568,
              PC_DQ = 1696, PC_DK = 1952, PC_DV = 2016, PC_DQI = 2080, PC_DKI = 2336, PC_DWI = 2368, PC_AF = 2376;
constexpr float EPS = 1e-6f;
constexpr float LOG2E = 1.4426950408889634f;
constexpr int ECAP = T;
constexpr int HIDROWS = 2 * T + 16 * 256;

__host__ __device__ __forceinline__ int orig_col(int n) { return n < 768 ? n : (n < 2376 ? n + 4 : (n < 2380 ? n - 1608 : -1)); }
__device__ __forceinline__ int opaque_tid(int wid) {
    int t = wid * 64 + (int)__builtin_amdgcn_mbcnt_hi(~0u, __builtin_amdgcn_mbcnt_lo(~0u, 0u));
    asm volatile("" : "+v"(t)); return t; }
__device__ __forceinline__ float bf2f(bf16_t v) { return __uint_as_float((unsigned)v << 16); }
__device__ __forceinline__ bf16_t f2bf(float f) { unsigned u = __float_as_uint(f); u += 0x7FFFu + ((u >> 16) & 1u); return (bf16_t)(u >> 16); }
typedef __bf16 bf16x2_native __attribute__((ext_vector_type(2)));
__device__ __forceinline__ unsigned cvt_pk_bf16(float lo, float hi) { const f32x2 v = {lo, hi}; return __builtin_bit_cast(unsigned, __builtin_convertvector(v, bf16x2_native)); }
__device__ __forceinline__ float bflo(unsigned w) { return __uint_as_float(w << 16); }
__device__ __forceinline__ float bfhi(unsigned w) { return __uint_as_float(w & 0xFFFF0000u); }
__device__ __forceinline__ float wave_sum(float v) {
#pragma unroll
    for (int o = 32; o > 0; o >>= 1) v += __shfl_xor(v, o);
    return v;
}
__device__ __forceinline__ float xor32_max(float x) {
    float a = x, b = x;
    asm volatile("s_nop 1\n\tv_permlane32_swap_b32 %0, %1\n\ts_nop 1" : "+v"(a), "+v"(b));
    return fmaxf(a, b);
}
__device__ __forceinline__ int wave_reduce_add(int v) {
    v += __builtin_amdgcn_update_dpp(0, v, 0xB1, 0xF, 0xF, true);
    v += __builtin_amdgcn_update_dpp(0, v, 0x4E, 0xF, 0xF, true);
    v += __builtin_amdgcn_update_dpp(0, v, 0x141, 0xF, 0xF, true);
    v += __builtin_amdgcn_update_dpp(0, v, 0x140, 0xF, 0xF, true);
    return __builtin_amdgcn_readlane(v, 0) + __builtin_amdgcn_readlane(v, 16) + __builtin_amdgcn_readlane(v, 32) + __builtin_amdgcn_readlane(v, 48);
}
}

namespace pg8 {
#define PG8_LAS __attribute__((address_space(3)))
constexpr int BM = 256, BK = 64, HALF = 128, HTB = HALF * BK * 2, STAGE_BYTES = 8 * HTB, NXCD = 8, WGM = 8;

__host__ __device__ __forceinline__ int lds_byte(int r, int c) { const int st = (r >> 4) * 2 + (c >> 5), rr = r & 15, cc = c & 31, ob = rr * 64 + cc * 2; return st * 1024 + (ob ^ (((ob >> 9) & 1) << 5)); }
__host__ __device__ __forceinline__ void stage_rc(int b, int& R, int& C) { const int st = b / 1024, sb = b % 1024, swz = sb ^ (((sb >> 9) & 1) << 5); R = (st >> 1) * 16 + swz / 64; C = (st & 1) * 32 + (swz % 64) / 2; }
__host__ __device__ __forceinline__ int perm32(int rho) { const int n = rho >> 4, i = rho & 15; return 8 * (i >> 2) + 4 * n + (i & 3); }

struct Unit { int pm, pn, e, mt; };
struct Gemm { const bf16_t* A; const bf16_t* Bt; int K; int lda; size_t bstride; };

struct StaticOrder {
    int nM, nN, nwg, G, c;
    __host__ __device__ void init(int M, int N, int G_, int c_) { nM = M / BM; nN = N / BM; nwg = nM * nN; G = G_; c = c_; }
    __host__ __device__ bool next(int i, Unit& u) const {
        const long L = (long)i * G + c; if (L >= nwg) return false;
        int wgid = (int)L; { const int q = nwg / NXCD, r = nwg % NXCD, xcd = wgid % NXCD, off = wgid / NXCD; wgid = (xcd < r ? xcd * (q + 1) : r * (q + 1) + (xcd - r) * q) + off; }
        const int nig = WGM * nN, gid = wgid / nig, fm = gid * WGM, gsz = (nM - fm) < WGM ? (nM - fm) : WGM;
        u.pm = fm + ((wgid % nig) % gsz); u.pn = (wgid % nig) / gsz; u.e = 0; u.mt = 0; return true;
    }
    __device__ __forceinline__ int arow(const Unit& u, int r) const { return u.pm * BM + r; }
};

template <class Epi, class Sched, bool GATHER>
__device__ __forceinline__ void gemm_phase(PG8_LAS unsigned char* lds, const Gemm g, const Sched& S, const Epi& E, int wave_index) {
    const int tid = opaque_tid(wave_index), wid = __builtin_amdgcn_readfirstlane(tid >> 6), lane = tid & 63, wr = wid >> 2, wc = wid & 3, fr = lane & 15, fq = lane >> 4;
    int K_ = g.K; asm volatile("" : "+s"(K_));
    const int K = K_, nt = K / BK, lda = g.lda;
    int Ra[2], Ca[2]; unsigned voffB[2], voffA[2];
#pragma unroll
    for (int i = 0; i < 2; ++i) { int R, C; stage_rc(tid * 16 + i * 8192, R, C); const int Rb = Epi::PERM ? ((R & ~31) + perm32(R & 31)) : R;
        Ra[i] = R; Ca[i] = C; voffB[i] = (unsigned)(Rb * K + C) * 2u; voffA[i] = (unsigned)(R * lda + C) * 2u; }
    const size_t kstep = (size_t)(BK * 2);
    const size_t hstepB = (size_t)HALF * K * 2;
    const size_t tstepB = 2 * hstepB;
    const size_t hstepA = (size_t)HALF * lda * 2, tstepA = 2 * hstepA;
    const unsigned ldsw = (unsigned)wid * 1024u;
    const int aoff = lds_byte(wr * 64 + fr, fq * 8), boff = lds_byte(wc * 32 + fr, fq * 8);
#define PG8_SA(b, h) (((b) * 2 + (h)) * HTB)
#define PG8_SB(b, h) ((4 + (b) * 2 + (h)) * HTB)
#define PG8_STAGE(bufoff, gbase, voff) do { _Pragma("unroll") for (int _i = 0; _i < 2; ++_i) \
        __builtin_amdgcn_global_load_lds((const unsigned*)((const char*)(gbase) + (voff)[_i]), (PG8_LAS unsigned*)(lds + (bufoff) + ldsw + _i * 8192), 16, 0, 0); } while (0)
#define PG8_STAGEA(bufoff, kptr, VO, h) do { _Pragma("unroll") for (int _i = 0; _i < 2; ++_i) { \
        const char* _src; if constexpr (GATHER) _src = (const char*)(kptr) + (VO)[_i][h]; else _src = (const char*)(kptr) + (size_t)(h) * hstepA + voffA[_i]; \
        __builtin_amdgcn_global_load_lds((const unsigned*)_src, (PG8_LAS unsigned*)(lds + (bufoff) + ldsw + _i * 8192), 16, 0, 0); } } while (0)
#define PG8_LDA(dst, b, h) do { _Pragma("unroll") for (int m = 0; m < 4; ++m) _Pragma("unroll") for (int k = 0; k < 2; ++k) dst[m][k] = *(const PG8_LAS bf16x8*)(lds + PG8_SA(b, h) + aoff + m * 2048 + k * 1024); } while (0)
#define PG8_LDB(dst, b, h) do { _Pragma("unroll") for (int n = 0; n < 2; ++n) _Pragma("unroll") for (int k = 0; k < 2; ++k) dst[n][k] = *(const PG8_LAS bf16x8*)(lds + PG8_SB(b, h) + boff + n * 2048 + k * 1024); } while (0)
#define PG8_MMA(ai, bj, At, Bt) do { __builtin_amdgcn_s_setprio(1); _Pragma("unroll") for (int m = 0; m < 4; ++m) _Pragma("unroll") for (int n = 0; n < 2; ++n) _Pragma("unroll") for (int k = 0; k < 2; ++k) \
        acc[ai][bj][m][n] = __builtin_amdgcn_mfma_f32_16x16x32_bf16(Bt[n][k], At[m][k], acc[ai][bj][m][n], 0, 0, 0); __builtin_amdgcn_s_setprio(0); } while (0)
#define PG8_WAIT_V(n) asm volatile("s_waitcnt vmcnt(" #n ")" ::: "memory")
#define PG8_WAIT_L(n) asm volatile("s_waitcnt lgkmcnt(" #n ")" ::: "memory")
#define PG8_BAR __builtin_amdgcn_s_barrier()
#define PG8_SCHED __builtin_amdgcn_sched_barrier(0)
#define PG8_SETV(V, u) do { _Pragma("unroll") for (int _i = 0; _i < 2; ++_i) _Pragma("unroll") for (int _h = 0; _h < 2; ++_h) { \
        const int _row = GATHER ? S.arow(u, _h * HALF + Ra[_i]) : ((u).pm * BM + _h * HALF + Ra[_i]); V[_i][_h] = (unsigned)(((size_t)_row * lda + Ca[_i]) * 2); } } while (0)
    Unit cur, nxt; int ui = 0;
    if (!S.next(0, cur)) return;
    f32x4 acc[2][2][4][2];
#pragma unroll
    for (int a = 0; a < 2; ++a)
#pragma unroll
        for (int b = 0; b < 2; ++b)
#pragma unroll
            for (int m = 0; m < 4; ++m)
#pragma unroll
                for (int n = 0; n < 2; ++n) acc[a][b][m][n] = (f32x4){0.f, 0.f, 0.f, 0.f};
    bf16x8 At[4][2], B0[2][2], B1[2][2];
    unsigned vA[2][2], vN[2][2];
    if constexpr (GATHER) { PG8_SETV(vA, cur); }
    const char* cA = (const char*)g.A + (GATHER ? (size_t)0 : (size_t)cur.pm * tstepA);
    const char* cB = (const char*)g.Bt + ((size_t)cur.e * g.bstride) * 2 + (size_t)cur.pn * tstepB;
    PG8_STAGE(PG8_SB(0, 0), cB, voffB); PG8_STAGE(PG8_SB(0, 1), cB + hstepB, voffB); PG8_STAGEA(PG8_SA(0, 0), cA, vA, 0); PG8_STAGEA(PG8_SA(0, 1), cA, vA, 1);
    if (wr == 1) PG8_BAR;
    PG8_WAIT_V(2); PG8_BAR;
    PG8_STAGE(PG8_SB(1, 0), cB + kstep, voffB); PG8_STAGEA(PG8_SA(1, 0), cA + kstep, vA, 0); PG8_STAGE(PG8_SB(1, 1), cB + hstepB + kstep, voffB);
    PG8_WAIT_V(6); PG8_BAR;
    for (;;) {
        const bool has_next = S.next(ui + 1, nxt);
        if constexpr (GATHER) { if (has_next) { PG8_SETV(vN, nxt); }
        else {
#pragma unroll
            for (int _i = 0; _i < 2; ++_i)
#pragma unroll
                for (int _h = 0; _h < 2; ++_h) vN[_i][_h] = vA[_i][_h];
        } }
        const char* nA = (!GATHER && has_next) ? (const char*)g.A + (size_t)nxt.pm * tstepA : cA;
        const char* nB = has_next ? (const char*)g.Bt + ((size_t)nxt.e * g.bstride) * 2 + (size_t)nxt.pn * tstepB : cB;
#pragma unroll 1
        for (int t = 0; t < nt; t += 2) {
            const bool last = (t == nt - 2);
            const char* a1 = cA + (size_t)(t + 1) * kstep;
            const char* a2 = last ? nA : cA + (size_t)(t + 2) * kstep; const char* b2 = last ? nB : cB + (size_t)(t + 2) * kstep;
            const char* a3 = a2 + kstep; const char* b3 = b2 + kstep;
            unsigned v2[2][2];
            if constexpr (GATHER) {
#pragma unroll
            for (int _i = 0; _i < 2; ++_i)
#pragma unroll
                for (int _h = 0; _h < 2; ++_h) v2[_i][_h] = last ? vN[_i][_h] : vA[_i][_h];
            }
            PG8_LDB(B0, 0, 0); PG8_LDB(B1, 0, 1); PG8_SCHED; PG8_LDA(At, 0, 0); PG8_STAGEA(PG8_SA(1, 1), a1, vA, 1);
            PG8_WAIT_V(8); PG8_WAIT_L(0); PG8_BAR; PG8_MMA(0, 0, At, B0); PG8_MMA(0, 1, At, B1); PG8_BAR; PG8_SCHED;
            PG8_LDA(At, 0, 1); PG8_STAGE(PG8_SB(0, 0), b2, voffB); PG8_STAGE(PG8_SB(0, 1), b2 + hstepB, voffB); PG8_STAGEA(PG8_SA(0, 0), a2, v2, 0);
            PG8_WAIT_V(8); PG8_WAIT_L(0); PG8_BAR; PG8_MMA(1, 0, At, B0); PG8_MMA(1, 1, At, B1); PG8_BAR; PG8_SCHED;
            PG8_LDB(B0, 1, 0); PG8_LDB(B1, 1, 1); PG8_SCHED; PG8_LDA(At, 1, 0); PG8_STAGEA(PG8_SA(0, 1), a2, v2, 1);
            PG8_WAIT_V(8); PG8_WAIT_L(0); PG8_BAR; PG8_MMA(0, 0, At, B0); PG8_MMA(0, 1, At, B1); PG8_BAR; PG8_SCHED;
            PG8_LDA(At, 1, 1); PG8_STAGE(PG8_SB(1, 0), b3, voffB); PG8_STAGE(PG8_SB(1, 1), b3 + hstepB, voffB); PG8_STAGEA(PG8_SA(1, 0), a3, v2, 0);
            PG8_WAIT_V(8); PG8_WAIT_L(0); PG8_BAR; PG8_MMA(1, 0, At, B0); PG8_MMA(1, 1, At, B1); PG8_BAR; PG8_SCHED;
        }
        if (wr == 0) PG8_BAR;
        E(acc, cur, wr, wc, fr, fq);
        if (!has_next) break;
#pragma unroll
        for (int a = 0; a < 2; ++a)
#pragma unroll
            for (int b = 0; b < 2; ++b)
#pragma unroll
                for (int m = 0; m < 4; ++m)
#pragma unroll
                    for (int n = 0; n < 2; ++n) acc[a][b][m][n] = (f32x4){0.f, 0.f, 0.f, 0.f};
        cur = nxt; cB = nB; cA = nA; ++ui;
        if constexpr (GATHER) {
#pragma unroll
        for (int _i = 0; _i < 2; ++_i)
#pragma unroll
            for (int _h = 0; _h < 2; ++_h) vA[_i][_h] = vN[_i][_h];
        }
        if (wr == 1) PG8_BAR;
    }
    PG8_WAIT_V(0);
    PG8_BAR;
#undef PG8_SA
#undef PG8_SB
#undef PG8_STAGE
#undef PG8_STAGEA
#undef PG8_LDA
#undef PG8_LDB
#undef PG8_MMA
#undef PG8_WAIT_V
#undef PG8_WAIT_L
#undef PG8_BAR
#undef PG8_SCHED
#undef PG8_SETV
}
}

namespace {
struct Params {
    const float *x, *c, *w_ada, *b_ada, *g_norm1, *w_in, *b_forget, *g_q_mla, *w_q_up, *g_kv_mla, *w_kv_up, *sinks, *w_out, *g_norm2,
                *w_router, *b_router, *w_gate, *w_up, *w_down, *g_final;
    float* xo;
    bf16_t* xb;
    unsigned* ctl;
    float* mod;
    bf16_t* WinT;
    bf16_t* WoutT;
    bf16_t* WqT;
    bf16_t* WkvT;
    bf16_t* WguT;
    bf16_t* WdT;
    float* ropetab;
    float* rq; float* rkv;
    float* cbF;
    bf16_t* kidx;
    uint32_t* mask;
    bf16_t* h;
    bf16_t* proj;
    bf16_t* qm; bf16_t* km; bf16_t* vm;
    bf16_t* merged;
    bf16_t* hid;
    bf16_t* ys;
    int* list;
    float* rw;
    float* wl;
    int wid;
    int qslot;
    int qslot_host;
};
constexpr int CW_BAR = 0;
constexpr int CW_CNT = 3584;
constexpr int CW_QA = 3648;
constexpr int CW_QD = 4288;
constexpr int CW_KN2 = 4992;
constexpr int CW_QN2 = CW_KN2 + 2 * NB * 4 * 32;
constexpr int CW_WORDS = CW_QN2 + 2 * NB * 4 * 8;
}

namespace {
constexpr long P0_B1 = 2l * NP * 128, P0_B2 = P0_B1 + 2l * 1024 * 128, P0_B3 = P0_B2 + 2l * 512 * 32, P0_B4 = P0_B3 + 2l * 512 * 16,
               P0_B5 = P0_B4 + 32l * 512 * 128, P0_B6 = P0_B5 + 32l * 1024 * 32;
__device__ __forceinline__ bf16_t* p0_fetch(const Params& p, long it, float (&v)[8]) {
    if (it < P0_B1) {
        const int l = (int)(it / (NP * 128)), r = (int)(it % (NP * 128)), n = r % NP, k0 = (r / NP) * 8, o = orig_col(n);
        const float* w = p.w_in + (size_t)l * D * NIN;
#pragma unroll
        for (int j = 0; j < 8; ++j) v[j] = o >= 0 ? w[(size_t)(k0 + j) * NIN + o] : 0.f;
        return p.WinT + ((size_t)l * NP + n) * D + k0;
    } else if (it < P0_B2) {
        const long s = it - P0_B1; const int l = (int)(s / (1024 * 128)), r = (int)(s % (1024 * 128)), n = r & 1023, k0 = (r >> 10) * 8;
        const float* w = p.w_out + (size_t)l * D * D;
#pragma unroll
        for (int j = 0; j < 8; ++j) v[j] = w[(size_t)(k0 + j) * D + n];
        return p.WoutT + ((size_t)l * D + n) * D + k0;
    } else if (it < P0_B3) {
        const long s = it - P0_B2; const int l = (int)(s / (512 * 32)), r = (int)(s % (512 * 32)), n = r & 511, k0 = (r >> 9) * 8;
        const float* w = p.w_q_up + (size_t)l * 256 * 384; const float* g = p.g_q_mla + l * 256;
#pragma unroll
        for (int j = 0; j < 8; ++j) v[j] = n < 384 ? g[k0 + j] * w[(size_t)(k0 + j) * 384 + n] : 0.f;
        return p.WqT + ((size_t)l * 512 + n) * 256 + k0;
    } else if (it < P0_B4) {
        const long s = it - P0_B3; const int l = (int)(s / (512 * 16)), r = (int)(s % (512 * 16)), n = r & 511, k0 = (r >> 9) * 8;
        const float* w = p.w_kv_up + (size_t)l * 128 * 512; const float* g = p.g_kv_mla + l * 128;
#pragma unroll
        for (int j = 0; j < 8; ++j) v[j] = g[k0 + j] * w[(size_t)(k0 + j) * 512 + n];
        return p.WkvT + ((size_t)l * 512 + n) * 128 + k0;
    } else if (it < P0_B5) {
        const long s = it - P0_B4; const int le = (int)(s >> 16), r = (int)(s & 65535), n = r & 511, k0 = (r >> 9) * 8;
        const int q = n >> 5, rr = n & 31, col = 16 * q + (rr & 15);
        const float* w = (rr < 16 ? p.w_gate : p.w_up) + (size_t)le * 1024 * 256;
#pragma unroll
        for (int j = 0; j < 8; ++j) v[j] = w[(size_t)(k0 + j) * 256 + col];
        return p.WguT + ((size_t)le * 512 + n) * 1024 + k0;
    } else {
        const long s = it - P0_B5; const int le = (int)(s >> 15), r = (int)(s & 32767), n = r & 1023, k0 = (r >> 10) * 8;
        const float* w = p.w_down + (size_t)le * 256 * 1024;
#pragma unroll
        for (int j = 0; j < 8; ++j) v[j] = w[(size_t)(k0 + j) * 1024 + n];
        return p.WdT + ((size_t)le * 1024 + n) * 256 + k0;
    }
}
__device__ __forceinline__ void p0_store(bf16_t* dst, const float (&v)[8]) {
    u32x4 w; w.x = cvt_pk_bf16(v[0], v[1]); w.y = cvt_pk_bf16(v[2], v[3]); w.z = cvt_pk_bf16(v[4], v[5]); w.w = cvt_pk_bf16(v[6], v[7]);
    *(u32x4*)dst = w;
}

__device__ __forceinline__ void phase_p0(const Params& p, char* lds) {
    const int tid = opaque_tid(p.wid), gtid = blockIdx.x * blockDim.x + tid, gthreads = gridDim.x * blockDim.x;
    for (long it0 = gtid; it0 < P0_B6; it0 += 2l * gthreads) {
        float va[8], vb[8];
        const bool hb = it0 + gthreads < P0_B6;
        bf16_t* da = p0_fetch(p, it0, va);
        bf16_t* db = hb ? p0_fetch(p, it0 + gthreads, vb) : da;
        p0_store(da, va);
        if (hb) p0_store(db, vb);
    }
    for (int it = gtid; it < 2048 * 16; it += gthreads) {
        const int pos = it >> 4, i = it & 15;
        const float inv = powf(10000.0f, -(float)i / 16.0f), ang = (float)pos * inv;
        p.ropetab[it * 2] = cosf(ang); p.ropetab[it * 2 + 1] = sinf(ang);
    }
    float* ca = (float*)lds;
    for (int i = tid; i < NB * 1024; i += 512) { const float v = p.c[i]; ca[i] = v / (1.f + __expf(-v)); }
    __syncthreads();
    for (int u = blockIdx.x; u < 2 * (NMOD / 64); u += gridDim.x) {
        const int l = u / (NMOD / 64), n = (u % (NMOD / 64)) * 64 + (tid & 63), bg = tid >> 6;
        const float* w = p.w_ada + (size_t)l * 1024 * NMOD + n;
        float acc[4] = {0.f, 0.f, 0.f, 0.f};
        for (int d0 = 0; d0 < 1024; d0 += 8) {
            float wv[8];
#pragma unroll
            for (int q = 0; q < 8; ++q) wv[q] = w[(size_t)(d0 + q) * NMOD];
#pragma unroll
            for (int q = 0; q < 8; ++q)
#pragma unroll
                for (int j = 0; j < 4; ++j) acc[j] += ca[(bg * 4 + j) * 1024 + d0 + q] * wv[q];
        }
        const float bias = p.b_ada[l * NMOD + n];
#pragma unroll
        for (int j = 0; j < 4; ++j) p.mod[((size_t)l * NB + bg * 4 + j) * NMOD + n] = acc[j] + bias;
    }
    __syncthreads();
}

template <int MODE>
__device__ __forceinline__ void phase_norm1(const Params& p, int l) {
#ifndef NORM_NT
#define NORM_NT 2
#endif
    constexpr int NT = NORM_NT;
    const int tid = opaque_tid(p.wid), w = tid >> 6, lane = tid & 63;
    const float* g = (MODE == 2) ? p.g_final : p.g_norm1 + l * D;
    const float* modl = p.mod + (size_t)(MODE == 2 ? 1 : l) * NB * NMOD;
    const float* modp = p.mod + (size_t)(MODE == 2 ? 1 : (l > 0 ? l - 1 : 0)) * NB * NMOD;
    f32x4 gg4[4];
#pragma unroll
    for (int k = 0; k < 4; ++k) gg4[k] = *(const f32x4*)(g + 4 * lane + 256 * k);
    for (int t0 = (blockIdx.x * 8 + w) * NT; t0 < T; t0 += gridDim.x * 8 * NT) {
        const int b0 = t0 >> 11;
        f32x4 sc4[4], sh4[4], gt4[4];
        if (MODE != 2) {
#pragma unroll
            for (int k = 0; k < 4; ++k) { sc4[k] = *(const f32x4*)(modl + (size_t)b0 * NMOD + 1024 + 4 * lane + 256 * k); sh4[k] = *(const f32x4*)(modl + (size_t)b0 * NMOD + 4 * lane + 256 * k); }
        }
        if (MODE >= 1) {
#pragma unroll
            for (int k = 0; k < 4; ++k) gt4[k] = *(const f32x4*)(modp + (size_t)b0 * NMOD + 5 * 1024 + 4 * lane + 256 * k);
        }
        f32x4 v[NT][4];
#pragma unroll
        for (int u = 0; u < NT; ++u)
#pragma unroll
            for (int k = 0; k < 4; ++k) {
                if (MODE == 0) v[u][k] = *(const f32x4*)(p.x + (size_t)(t0 + u) * D + 4 * lane + 256 * k);
                else { const u32x2 w2 = *(const u32x2*)(p.xb + (size_t)(t0 + u) * D + 4 * lane + 256 * k); v[u][k] = (f32x4){bflo(w2.x), bfhi(w2.x), bflo(w2.y), bfhi(w2.y)}; }
            }
        if (MODE >= 1) {
            u32x2 y0[NT][4], y1[NT][4];
#pragma unroll
            for (int u = 0; u < NT; ++u)
#pragma unroll
                for (int k = 0; k < 4; ++k) { const int col = 4 * lane + 256 * k;
                    y0[u][k] = *(const u32x2*)(p.ys + ((size_t)(t0 + u) * 2 + 0) * D + col); y1[u][k] = *(const u32x2*)(p.ys + ((size_t)(t0 + u) * 2 + 1) * D + col); }
#pragma unroll
            for (int u = 0; u < NT; ++u) {
                const int b = (t0 + u) >> 11;
#pragma unroll
                for (int k = 0; k < 4; ++k) {
                    const int col = 4 * lane + 256 * k;
                    const f32x4 gt = gt4[k];
                    v[u][k][0] += gt[0] * (bflo(y0[u][k].x) + bflo(y1[u][k].x)); v[u][k][1] += gt[1] * (bfhi(y0[u][k].x) + bfhi(y1[u][k].x));
                    v[u][k][2] += gt[2] * (bflo(y0[u][k].y) + bflo(y1[u][k].y)); v[u][k][3] += gt[3] * (bfhi(y0[u][k].y) + bfhi(y1[u][k].y));
                }
            }
        }
#pragma unroll
        for (int u = 0; u < NT; ++u) {
            const int t = t0 + u, b = t >> 11;
            float ss = 0.f;
#pragma unroll
            for (int k = 0; k < 4; ++k) ss += v[u][k][0] * v[u][k][0] + v[u][k][1] * v[u][k][1] + v[u][k][2] * v[u][k][2] + v[u][k][3] * v[u][k][3];
            ss = wave_sum(ss);
            const float r = rsqrtf(ss * (1.0f / D) + EPS);
#pragma unroll
            for (int k = 0; k < 4; ++k) {
                const int col = 4 * lane + 256 * k;
                f32x4 y = v[u][k] * r * gg4[k];
                if (MODE == 2) { *(f32x4*)(p.xo + (size_t)t * D + col) = y; }
                else {
                    if (MODE == 1) { u32x2 xw; xw.x = cvt_pk_bf16(v[u][k][0], v[u][k][1]); xw.y = cvt_pk_bf16(v[u][k][2], v[u][k][3]); *(u32x2*)(p.xb + (size_t)t * D + col) = xw; }
                    y = y * (1.f + sc4[k]) + sh4[k];
                    u32x2 o; o.x = cvt_pk_bf16(y[0], y[1]); o.y = cvt_pk_bf16(y[2], y[3]);
                    *(u32x2*)(p.h + (size_t)t * D + col) = o;
                }
            }
        }
    }
}
}

namespace {
using pg8::Unit;
struct EpiStoreBf16 {
    static constexpr bool PERM = true;
    bf16_t* O; int ldc;
    __device__ __forceinline__ void operator()(const f32x4 (&acc)[2][2][4][2], const Unit& u, int wr, int wc, int fr_, int fq_) const {
        int fr = fr_, fq = fq_; asm volatile("" : "+v"(fr), "+v"(fq));
        const int row0 = u.pm * 256 + wr * 64 + fr, col0 = u.pn * 256 + wc * 32 + 8 * fq;
#pragma unroll
        for (int ai = 0; ai < 2; ++ai)
#pragma unroll
            for (int m = 0; m < 4; ++m) { bf16_t* rowp = O + (size_t)(row0 + ai * 128 + m * 16) * ldc + col0;
#pragma unroll
                for (int bj = 0; bj < 2; ++bj) { const f32x4 v0 = acc[ai][bj][m][0], v1 = acc[ai][bj][m][1];
                    u32x4 w; w.x = cvt_pk_bf16(v0[0], v0[1]); w.y = cvt_pk_bf16(v0[2], v0[3]); w.z = cvt_pk_bf16(v1[0], v1[1]); w.w = cvt_pk_bf16(v1[2], v1[3]);
                    *(u32x4*)(rowp + bj * 128) = w; } }
    }
};
struct EpiResidual {
    static constexpr bool PERM = false;
    const float* xin32; bf16_t* xb; const float* gate;
    __device__ __forceinline__ void operator()(const f32x4 (&acc)[2][2][4][2], const Unit& u, int wr, int wc, int fr_, int fq_) const {
        int fr = fr_, fq = fq_; asm volatile("" : "+v"(fr), "+v"(fq));
        const int row0 = u.pm * 256 + wr * 64 + fr, col0 = u.pn * 256 + wc * 32 + 4 * fq;
        const int b = (u.pm * 256) >> 11;
        f32x4 gv[2][2];
#pragma unroll
        for (int bj = 0; bj < 2; ++bj)
#pragma unroll
            for (int n = 0; n < 2; ++n) gv[bj][n] = *(const f32x4*)(gate + (size_t)b * NMOD + col0 + bj * 128 + n * 16);
#pragma unroll
        for (int ai = 0; ai < 2; ++ai)
#pragma unroll
            for (int m = 0; m < 4; ++m) { const size_t ro = (size_t)(row0 + ai * 128 + m * 16) * D + col0;
#pragma unroll
                for (int bj = 0; bj < 2; ++bj)
#pragma unroll
                    for (int n = 0; n < 2; ++n) { const size_t o = ro + bj * 128 + n * 16;
                        f32x4 xv;
                        if (xin32) xv = *(const f32x4*)(xin32 + o);
                        else { const u32x2 w = *(const u32x2*)(xb + o); xv = (f32x4){bflo(w.x), bfhi(w.x), bflo(w.y), bfhi(w.y)}; }
                        const f32x4 r = xv + gv[bj][n] * acc[ai][bj][m][n];
                        u32x2 ow; ow.x = cvt_pk_bf16(r[0], r[1]); ow.y = cvt_pk_bf16(r[2], r[3]);
                        *(u32x2*)(xb + o) = ow; } }
    }
};
struct EpiMlaQ {
    static constexpr bool PERM = true;
    bf16_t* qm;
    __device__ __forceinline__ void operator()(const f32x4 (&acc)[2][2][4][2], const Unit& u, int wr, int wc, int fr_, int fq_) const {
        int fr = fr_, fq = fq_; asm volatile("" : "+v"(fr), "+v"(fq));
        const int row0 = u.pm * 256 + wr * 64 + fr;
#pragma unroll
        for (int bj = 0; bj < 2; ++bj) {
            const int col0 = u.pn * 256 + bj * 128 + wc * 32;
            if (col0 >= 384) continue;
#pragma unroll
            for (int ai = 0; ai < 2; ++ai)
#pragma unroll
                for (int m = 0; m < 4; ++m) { const f32x4 v0 = acc[ai][bj][m][0], v1 = acc[ai][bj][m][1];
                    u32x4 w; w.x = cvt_pk_bf16(v0[0], v0[1]); w.y = cvt_pk_bf16(v0[2], v0[3]); w.z = cvt_pk_bf16(v1[0], v1[1]); w.w = cvt_pk_bf16(v1[2], v1[3]);
                    *(u32x4*)(qm + (size_t)(row0 + ai * 128 + m * 16) * 384 + col0 + 8 * fq) = w; }
        }
    }
};
struct EpiMlaKV {
    static constexpr bool PERM = true;
    bf16_t* km; bf16_t* vm;
    __device__ __forceinline__ void operator()(const f32x4 (&acc)[2][2][4][2], const Unit& u, int wr, int wc, int fr_, int fq_) const {
        int fr = fr_, fq = fq_; asm volatile("" : "+v"(fr), "+v"(fq));
        const int row0 = u.pm * 256 + wr * 64 + fr;
#pragma unroll
        for (int bj = 0; bj < 2; ++bj) {
            const int head = u.pn * 2 + bj, wcol = wc * 32 + 8 * fq;
#pragma unroll
            for (int ai = 0; ai < 2; ++ai)
#pragma unroll
                for (int m = 0; m < 4; ++m) {
                    const int row = row0 + ai * 128 + m * 16;
                    const f32x4 v0 = acc[ai][bj][m][0], v1 = acc[ai][bj][m][1];
                    u32x4 w; w.x = cvt_pk_bf16(v0[0], v0[1]); w.y = cvt_pk_bf16(v0[2], v0[3]); w.z = cvt_pk_bf16(v1[0], v1[1]); w.w = cvt_pk_bf16(v1[2], v1[3]);
                    bf16_t* q = (wcol < 64) ? km + (size_t)row * 384 + head * 96 + wcol : vm + (size_t)row * 256 + head * 64 + (wcol - 64);
                    *(u32x4*)q = w;
                    asm volatile("" ::: "memory");
                }
        }
    }
};
struct EpiGateUp {
    static constexpr bool PERM = false;
    bf16_t* hid;
    __device__ __forceinline__ void operator()(const f32x4 (&acc)[2][2][4][2], const Unit& u, int wr, int wc, int fr_, int fq_) const {
        int fr = fr_, fq = fq_; asm volatile("" : "+v"(fr), "+v"(fq));
        const int row0 = u.pm * 256 + wr * 64 + fr;
#pragma unroll
        for (int ai = 0; ai < 2; ++ai)
#pragma unroll
            for (int m = 0; m < 4; ++m) { bf16_t* rowp = hid + (size_t)(row0 + ai * 128 + m * 16) * 256;
#pragma unroll
                for (int bj = 0; bj < 2; ++bj) { const f32x4 gt = acc[ai][bj][m][0], up = acc[ai][bj][m][1];
                    f32x4 o;
#pragma unroll
                    for (int j = 0; j < 4; ++j) o[j] = gt[j] / (1.f + __expf(-gt[j])) * up[j];
                    u32x2 w; w.x = cvt_pk_bf16(o[0], o[1]); w.y = cvt_pk_bf16(o[2], o[3]);
                    *(u32x2*)(rowp + 16 * (u.pn * 8 + bj * 4 + wc) + 4 * fq) = w; } }
    }
};
struct EpiDown {
    static constexpr bool PERM = true;
    bf16_t* ys; const int* list; const float* wl; const int* cnt;
    __device__ __forceinline__ void operator()(const f32x4 (&acc)[2][2][4][2], const Unit& u, int wr, int wc, int fr_, int fq_) const {
        int fr = fr_, fq = fq_; asm volatile("" : "+v"(fr), "+v"(fq));
        const int n = cnt[u.e]; const int* le = list + (size_t)u.e * ECAP; const float* we = wl + (size_t)u.e * ECAP;
        const int col0 = u.pn * 256 + wc * 32 + 8 * fq;
        int slot[8]; float w8[8];
#pragma unroll
        for (int q = 0; q < 8; ++q) { const int lr = u.mt * 256 + (q >> 2) * 128 + wr * 64 + (q & 3) * 16 + fr; slot[q] = lr < n ? le[lr] : -1; w8[q] = lr < n ? we[lr] : 0.f; }
#pragma unroll
        for (int ai = 0; ai < 2; ++ai)
#pragma unroll
            for (int m = 0; m < 4; ++m) {
                const int q = ai * 4 + m;
                if (slot[q] >= 0) {
                    bf16_t* rowp = ys + (size_t)slot[q] * D + col0;
#pragma unroll
                    for (int bj = 0; bj < 2; ++bj) { const f32x4 v0 = acc[ai][bj][m][0] * w8[q], v1 = acc[ai][bj][m][1] * w8[q];
                        u32x4 w; w.x = cvt_pk_bf16(v0[0], v0[1]); w.y = cvt_pk_bf16(v0[2], v0[3]); w.z = cvt_pk_bf16(v1[0], v1[1]); w.w = cvt_pk_bf16(v1[2], v1[3]);
                        *(u32x4*)(rowp + bj * 128) = w; }
                }
            }
    }
};
struct MoeOrder {
    int pre[17];
    int NT, G, c; const int* list; const int* cnt;
    __device__ __forceinline__ void init(const int* cnt_, const int* list_, int NT_, int G_, int c_) {
        cnt = cnt_; list = list_; NT = NT_; G = G_; c = c_; int a = 0;
#pragma unroll
        for (int e = 0; e < 16; ++e) { pre[e] = a; a += (cnt_[e] + 255) >> 8; }
        pre[16] = a;
    }
    __device__ __forceinline__ bool next(int i, Unit& u) const {
        const int L = i * G + c; if (L >= pre[16] * NT) return false;
        const int t = L / NT; int e = 0;
#pragma unroll
        for (int k = 1; k < 16; ++k) e += (t >= pre[k]) ? 1 : 0;
        int pe = 0;
#pragma unroll
        for (int k = 0; k < 16; ++k) pe = (k == e) ? pre[k] : pe;
        u.e = e; u.mt = t - pe; u.pm = t; u.pn = L - t * NT; return true;
    }
    __device__ __forceinline__ int arow(const Unit& u, int r) const { const int lr = u.mt * 256 + r; return lr < cnt[u.e] ? (list[(size_t)u.e * ECAP + lr] >> 1) : 0; }
};
}

namespace {
__device__ __forceinline__ void phase_prep(const Params& p, int l) {
    const int tid = opaque_tid(p.wid), w = tid >> 6, lane = tid & 63;
    const int gw = blockIdx.x * 8 + w, nw = gridDim.x * 8;
    for (int sq = gw; sq < NB * 4; sq += nw) {
        const int b = sq >> 2, hh = sq & 3; const float bias = p.b_forget[l * 4 + hh];
        float lf[32]; float run = 0.f;
#pragma unroll
        for (int j = 0; j < 32; ++j) {
            const float z = bf2f(p.proj[(size_t)(b * S + lane * 32 + j) * NP + PC_AF + hh]) + bias;
            run += fminf(z, 0.f) - log1pf(__expf(-fabsf(z)));
            lf[j] = run;
        }
        float incl = run;
#pragma unroll
        for (int o = 1; o < 64; o <<= 1) { const float t2 = __shfl_up(incl, o); if (lane >= o) incl += t2; }
        const float excl = incl - run;
#pragma unroll
        for (int j = 0; j < 32; ++j) p.cbF[(size_t)sq * S + lane * 32 + j] = -(excl + lf[j]) * LOG2E;
    }
    for (int c32 = gw; c32 < T / 32; c32 += nw) {
    float mxq = 0.f, mxk = 0.f;
    for (int it = 0; it < 32; ++it) {
        const int t = c32 * 32 + it;
        const bf16_t* row = p.proj + (size_t)t * NP;
        const u32x2 cq = *(const u32x2*)(row + PC_BCQ + 4 * lane);
        const unsigned ck = *(const unsigned*)(row + PC_BCKV + 2 * lane);
        float s1 = bflo(cq.x) * bflo(cq.x) + bfhi(cq.x) * bfhi(cq.x) + bflo(cq.y) * bflo(cq.y) + bfhi(cq.y) * bfhi(cq.y);
        float s2 = bflo(ck) * bflo(ck) + bfhi(ck) * bfhi(ck);
        s1 = wave_sum(s1); s2 = wave_sum(s2);
        if (lane < 4) *(u32x4*)(p.kidx + (size_t)t * 32 + 8 * lane) = *(const u32x4*)(row + PC_DKI + 8 * lane);
        {
            const u32x2 aq = *(const u32x2*)(row + PC_AQ + 4 * lane), ak = *(const u32x2*)(row + PC_AK + 4 * lane);
            float nq = bflo(aq.x) * bflo(aq.x) + bfhi(aq.x) * bfhi(aq.x) + bflo(aq.y) * bflo(aq.y) + bfhi(aq.y) * bfhi(aq.y);
            float nk = bflo(ak.x) * bflo(ak.x) + bfhi(ak.x) * bfhi(ak.x) + bflo(ak.y) * bflo(ak.y) + bfhi(ak.y) * bfhi(ak.y);
#pragma unroll
            for (int o = 8; o > 0; o >>= 1) { nq += __shfl_xor(nq, o); nk += __shfl_xor(nk, o); }
            mxq = fmaxf(mxq, nq); mxk = fmaxf(mxk, nk);
        }
        const float kr = (lane < 32) ? bf2f(row[PC_BKR + lane]) : 0.f;
        const float kr2 = __shfl(kr, (lane + 16) & 63);
        {
            const float r1 = rsqrtf(s1 * (1.f / 256.f) + EPS), r2 = rsqrtf(s2 * (1.f / 128.f) + EPS);
            u32x2 o; o.x = cvt_pk_bf16(bflo(cq.x) * r1, bfhi(cq.x) * r1); o.y = cvt_pk_bf16(bflo(cq.y) * r1, bfhi(cq.y) * r1);
            *(u32x2*)(p.proj + (size_t)t * NP + PC_BCQ + 4 * lane) = o;
            *(unsigned*)(p.proj + (size_t)t * NP + PC_BCKV + 2 * lane) = cvt_pk_bf16(bflo(ck) * r2, bfhi(ck) * r2);
        }
        if (lane < 16) {
            const int pos = t & (S - 1);
            const float cs = p.ropetab[(pos * 16 + lane) * 2], sn = p.ropetab[(pos * 16 + lane) * 2 + 1];
            const bf16_t o1 = f2bf(kr * cs - kr2 * sn), o2 = f2bf(kr2 * cs + kr * sn);
            bf16_t* kmr = p.km + (size_t)t * 384;
#pragma unroll
            for (int hh = 0; hh < 4; ++hh) { kmr[hh * 96 + 64 + lane] = o1; kmr[hh * 96 + 80 + lane] = o2; }
        }
    }
    if ((lane & 15) == 0) {
        const int t = c32 * 32, bb = t >> 11, pos = t & (S - 1), hh = lane >> 4;
        atomicMax(p.ctl + CW_KN2 + ((l * NB + bb) * 4 + hh) * 32 + (pos >> 6), __float_as_uint(mxk));
        atomicMax(p.ctl + CW_QN2 + ((l * NB + bb) * 4 + hh) * 8 + (pos >> 8), __float_as_uint(mxq));
    }
    }
}

__device__ __forceinline__ void phase_route(const Params& p, int l, char* lds) {
    const int tid = opaque_tid(p.wid), w = tid >> 6, lane = tid & 63;
    float* wrT = (float*)lds;
    int* lcnt = (int*)(lds + 65536);
    int* lbase = (int*)(lds + 65536 + 64);
    int* tsel = (int*)(lds + 65536 + 128);
    float* twt = (float*)(lds + 65536 + 128 + 2048);
    for (int i = tid; i < 16 * 1024; i += 512) { const int e = i >> 10, d = i & 1023; wrT[i] = p.w_router[d * 16 + e]; }
    const float* g = p.g_norm2 + l * D;
    const float* modl = p.mod + (size_t)l * NB * NMOD;
    int* cnt = (int*)(p.ctl + CW_CNT) + l * 16 + 32 * p.qslot;
    int* list = p.list + (size_t)p.qslot * 16 * ECAP;
    for (int chunk = blockIdx.x; chunk < T / 256; chunk += gridDim.x) {
        if (tid < 16) lcnt[tid] = 0;
        __syncthreads();
        const int b = (chunk * 256) >> 11;
        f32x4 gg4[4], sc4[4], sh4[4];
#pragma unroll
        for (int k = 0; k < 4; ++k) { const int col = 4 * lane + 256 * k; gg4[k] = *(const f32x4*)(g + col);
            sc4[k] = *(const f32x4*)(modl + (size_t)b * NMOD + 4 * 1024 + col); sh4[k] = *(const f32x4*)(modl + (size_t)b * NMOD + 3 * 1024 + col); }
        const int eown = ((lane >> 5) & 1) * 8 + ((lane >> 4) & 1) * 4 + ((lane >> 3) & 1) * 2 + ((lane >> 2) & 1);
        const float brown = p.b_router[eown];
        f32x4 vn[4];
#pragma unroll
        for (int k = 0; k < 4; ++k) { const u32x2 w2 = *(const u32x2*)(p.xb + (size_t)(chunk * 256 + w * 32) * D + 4 * lane + 256 * k); vn[k] = (f32x4){bflo(w2.x), bfhi(w2.x), bflo(w2.y), bfhi(w2.y)}; }
        for (int it = 0; it < 32; ++it) {
            const int li = w * 32 + it, t = chunk * 256 + li;
            f32x4 v[4];
#pragma unroll
            for (int k = 0; k < 4; ++k) v[k] = vn[k];
            if (it < 31) {
#pragma unroll
                for (int k = 0; k < 4; ++k) { const u32x2 w2 = *(const u32x2*)(p.xb + (size_t)(t + 1) * D + 4 * lane + 256 * k); vn[k] = (f32x4){bflo(w2.x), bfhi(w2.x), bflo(w2.y), bfhi(w2.y)}; }
            }
            float ss = 0.f;
#pragma unroll
            for (int k = 0; k < 4; ++k) ss += v[k][0] * v[k][0] + v[k][1] * v[k][1] + v[k][2] * v[k][2] + v[k][3] * v[k][3];
            ss = wave_sum(ss);
            const float r = rsqrtf(ss * (1.0f / D) + EPS);
            float lg[16];
#pragma unroll
            for (int e = 0; e < 16; ++e) lg[e] = 0.f;
#pragma unroll
            for (int k = 0; k < 4; ++k) {
                const int col = 4 * lane + 256 * k;
                const f32x4 y = v[k] * r * gg4[k] * (1.f + sc4[k]) + sh4[k];
                u32x2 o; o.x = cvt_pk_bf16(y[0], y[1]); o.y = cvt_pk_bf16(y[2], y[3]);
                *(u32x2*)(p.h + (size_t)t * D + col) = o;
#pragma unroll
                for (int e = 0; e < 16; ++e) { const f32x4 wv = *(const f32x4*)(wrT + e * 1024 + col); lg[e] += y[0] * wv[0] + y[1] * wv[1] + y[2] * wv[2] + y[3] * wv[3]; }
                asm volatile("" ::: "memory");
            }
            float a8[8], a4[4], a2[2], a1;
            { const bool hi = (lane & 32) != 0;
#pragma unroll
              for (int e = 0; e < 8; ++e) { const float send = hi ? lg[e] : lg[e + 8], keep = hi ? lg[e + 8] : lg[e]; a8[e] = keep + __shfl_xor(send, 32); } }
            { const bool hi = (lane & 16) != 0;
#pragma unroll
              for (int e = 0; e < 4; ++e) { const float send = hi ? a8[e] : a8[e + 4], keep = hi ? a8[e + 4] : a8[e]; a4[e] = keep + __shfl_xor(send, 16); } }
            { const bool hi = (lane & 8) != 0;
#pragma unroll
              for (int e = 0; e < 2; ++e) { const float send = hi ? a4[e] : a4[e + 2], keep = hi ? a4[e + 2] : a4[e]; a2[e] = keep + __shfl_xor(send, 8); } }
            { const bool hi = (lane & 4) != 0; const float send = hi ? a2[0] : a2[1], keep = hi ? a2[1] : a2[0]; a1 = keep + __shfl_xor(send, 4); }
            a1 += __shfl_xor(a1, 2); a1 += __shfl_xor(a1, 1);
            const float sown = 1.f / (1.f + expf(-a1)), bown = sown + brown;
            float sc[16], bi[16];
#pragma unroll
            for (int e = 0; e < 16; ++e) { const int src = ((e >> 3) & 1) * 32 + ((e >> 2) & 1) * 16 + ((e >> 1) & 1) * 8 + (e & 1) * 4;
                sc[e] = __builtin_bit_cast(float, __builtin_amdgcn_readlane(__builtin_bit_cast(int, sown), src));
                bi[e] = __builtin_bit_cast(float, __builtin_amdgcn_readlane(__builtin_bit_cast(int, bown), src)); }
            int bg = 0; float bgs = -INFINITY;
#pragma unroll
            for (int gi = 0; gi < 4; ++gi) {
                float m1 = -INFINITY, m2 = -INFINITY;
#pragma unroll
                for (int j = 0; j < 4; ++j) { const float vv = bi[gi * 4 + j]; if (vv > m1) { m2 = m1; m1 = vv; } else if (vv > m2) m2 = vv; }
                const float gs = m1 + m2; if (gs > bgs) { bgs = gs; bg = gi; }
            }
            float b4[4], s4[4];
#pragma unroll
            for (int gi = 0; gi < 4; ++gi)
#pragma unroll
                for (int j = 0; j < 4; ++j) if (gi == bg) { b4[j] = bi[gi * 4 + j]; s4[j] = sc[gi * 4 + j]; }
            int i1 = 0; float v1 = -INFINITY;
#pragma unroll
            for (int j = 0; j < 4; ++j) { if (b4[j] > v1) { v1 = b4[j]; i1 = j; } }
            int i2 = 0; float v2 = -INFINITY;
#pragma unroll
            for (int j = 0; j < 4; ++j) { if (j != i1 && b4[j] > v2) { v2 = b4[j]; i2 = j; } }
            float w1 = 0.f, w2 = 0.f;
#pragma unroll
            for (int j = 0; j < 4; ++j) { if (j == i1) w1 = s4[j]; if (j == i2) w2 = s4[j]; }
            if (lane == 0) {
                const int e1 = bg * 4 + i1, e2 = bg * 4 + i2; const float ws = w1 + w2;
                const int r1 = atomicAdd(&lcnt[e1], 1), r2 = atomicAdd(&lcnt[e2], 1);
                tsel[li * 2 + 0] = (e1 << 16) | r1; tsel[li * 2 + 1] = (e2 << 16) | r2;
                twt[li * 2 + 0] = w1 / ws; twt[li * 2 + 1] = w2 / ws;
            }
        }
        __syncthreads();
        if (tid < 16) lbase[tid] = atomicAdd(&cnt[tid], lcnt[tid]);
        __syncthreads();
        { const int v = tsel[tid], e = v >> 16, rk = v & 0xFFFF; const size_t pos = (size_t)e * ECAP + lbase[e] + rk;
          list[pos] = (chunk * 256 + (tid >> 1)) * 2 + (tid & 1); p.wl[pos + (size_t)p.qslot * 16 * ECAP] = twt[tid]; }
        __syncthreads();
    }
}
}

#ifndef ATTN_VMASK
#define ATTN_VMASK 15
#endif
#ifndef REPK_VMASK
#define REPK_VMASK 15
#endif
#ifndef ATTN_EXP
#define ATTN_EXP 0
#endif
#define AEXP(k) (ATTN_EXP == (k) && xq)
namespace {
constexpr int AT_KB = 0;
constexpr int AT_KR = 16384;
constexpr int AT_VB = 24576;
constexpr int AT_CB = 40960;
constexpr int AT_CTL = 41472;
constexpr int AT_LDS = 41984;
constexpr float NEGBIG = -1.0e30f;

template <int VAR, int KC>
__device__ __forceinline__ void attn_tile(LAS3 char* lds, const int buf, const int j, const int q0, const int i, const int g, const int swk, const float slope2,
                                          const bf16x8 (&qf)[2][KC], f32x4 (&o)[2][4], float (&mrow)[2], float (&lsum)[2], const u32x2 (&mw)[2], const bool xq) {
    typedef LAS3 bf16x4 lds_bf16x4;
    bool need = (64 * j <= q0 + 31);
    if (VAR == 2) need = need && (64 * j + 63 >= q0 - 127);
    if (need) {
        const LAS3 char* Kb = lds + AT_KB + buf * 8192; const LAS3 char* Vb = lds + AT_VB + buf * 8192;
        bool full = (64 * j + 63 <= q0);
        if (VAR == 2) full = full && (64 * j >= q0 - 96);
        if (VAR == 3) full = false;
        f32x4 s[2][4];
#pragma unroll
        for (int qt = 0; qt < 2; ++qt) {
            const int t = q0 + 16 * qt + i;
            const int dbase = 64 * j + 4 * g - t;
            const float sb = slope2 * ((VAR == 2) ? (float)dbase : (float)(64 * j + 4 * g));
            unsigned wl = 0u, wh = 0u;
            if (VAR == 3) { const unsigned long long W = (((unsigned long long)mw[qt].y << 32) | mw[qt].x) >> (4 * g); wl = (unsigned)W; wh = (unsigned)(W >> 32); }
#pragma unroll
            for (int mt = 0; mt < 4; ++mt) {
                f32x4 ini = {0.f, 0.f, 0.f, 0.f};
                if (VAR == 0) ini = *(const LAS3 f32x4*)(lds + AT_CB + buf * 256 + (16 * mt + 4 * g) * 4);
#pragma unroll
                for (int r = 0; r < 4; ++r) {
                    const int c = 16 * mt + r;
                    float v = ini[r];
                    if (VAR >= 2) v = sb + slope2 * (float)c;
                    if (VAR == 3) {
                        const int m = ((int)((mt < 2 ? wl : wh) << (31 - (16 * (mt & 1) + r)))) >> 31;
                        v = __uint_as_float((__float_as_uint(v) & (unsigned)m) | (__float_as_uint(NEGBIG) & ~(unsigned)m));
                    } else if (!full) {
                        bool ok;
                        if (VAR == 2) ok = (unsigned)(dbase + c + 127) < 128u;
                        else ok = (dbase + c) <= 0;
                        v = ok ? v : NEGBIG;
                    }
                    ini[r] = v;
                }
                s[qt][mt] = ini;
            }
        }
        if (!AEXP(2))
#pragma unroll
        for (int mt = 0; mt < 4; ++mt) {
#pragma unroll
            for (int kc = 0; kc < 2; ++kc) {
                const bf16x8 kf = *(const LAS3 bf16x8*)(Kb + (mt * 16 + i) * 128 + (((kc * 4 + g) ^ swk) << 4));
                s[0][mt] = __builtin_amdgcn_mfma_f32_16x16x32_bf16(kf, qf[0][kc], s[0][mt], 0, 0, 0);
                s[1][mt] = __builtin_amdgcn_mfma_f32_16x16x32_bf16(kf, qf[1][kc], s[1][mt], 0, 0, 0);
            }
            if (VAR == 1) {
                const bf16x8 kf = *(const LAS3 bf16x8*)(lds + AT_KR + buf * 4096 + (mt * 16 + i) * 64 + ((g ^ (swk & 3)) << 4));
                s[0][mt] = __builtin_amdgcn_mfma_f32_16x16x32_bf16(kf, qf[0][KC - 1], s[0][mt], 0, 0, 0);
                s[1][mt] = __builtin_amdgcn_mfma_f32_16x16x32_bf16(kf, qf[1][KC - 1], s[1][mt], 0, 0, 0);
            }
        }
        bf16x8 pf[2][2];
#pragma unroll
        for (int qt = 0; qt < 2; ++qt) {
            float mx = fmaxf(fmaxf(s[qt][0][0], s[qt][0][1]), fmaxf(s[qt][0][2], s[qt][0][3]));
#pragma unroll
            for (int mt = 1; mt < 4; ++mt) mx = fmaxf(mx, fmaxf(fmaxf(s[qt][mt][0], s[qt][mt][1]), fmaxf(s[qt][mt][2], s[qt][mt][3])));
            mx = fmaxf(mx, __builtin_bit_cast(float, __builtin_amdgcn_ds_swizzle(__builtin_bit_cast(int, mx), 0x401F)));
            mx = xor32_max(mx);
            if (__any(mx > mrow[qt])) {
                const float mn = fmaxf(mrow[qt], mx), alpha = __builtin_amdgcn_exp2f(mrow[qt] - mn);
                mrow[qt] = mn; lsum[qt] *= alpha;
#pragma unroll
                for (int dt = 0; dt < 4; ++dt) o[qt][dt] = o[qt][dt] * alpha;
            }
            const float mn = mrow[qt];
            const f32x4 mn4 = {mn, mn, mn, mn};
            f32x4 ps4 = {0.f, 0.f, 0.f, 0.f};
            float x[4][4];
#pragma unroll
            for (int mt = 0; mt < 4; ++mt) {
                const f32x4 d4 = s[qt][mt] - mn4;
                f32x4 e4;
#pragma unroll
                for (int r = 0; r < 4; ++r) { e4[r] = AEXP(3) ? d4[r] : __builtin_amdgcn_exp2f(d4[r]); x[mt][r] = e4[r]; }
                ps4 += e4;
            }
            lsum[qt] += (ps4[0] + ps4[1]) + (ps4[2] + ps4[3]);
#pragma unroll
            for (int c = 0; c < 2; ++c) {
                u32x4 pk; pk.x = cvt_pk_bf16(x[2 * c][0], x[2 * c][1]); pk.y = cvt_pk_bf16(x[2 * c][2], x[2 * c][3]);
                pk.z = cvt_pk_bf16(x[2 * c + 1][0], x[2 * c + 1][1]); pk.w = cvt_pk_bf16(x[2 * c + 1][2], x[2 * c + 1][3]);
                pf[qt][c] = __builtin_bit_cast(bf16x8, pk);
            }
        }
        const int q4 = i >> 2, p4 = i & 3;
        if (!AEXP(4))
#pragma unroll
        for (int c = 0; c < 2; ++c) {
            const int row0 = 32 * c + 4 * g + q4, swv = (row0 >> 1) & 3;
#pragma unroll
            for (int dt = 0; dt < 4; ++dt) {
                const LAS3 char* a0 = Vb + row0 * 128 + ((dt ^ swv) << 5) + p4 * 8;
                const bf16x4 v0 = __builtin_amdgcn_ds_read_tr16_b64_v4i16((lds_bf16x4*)(a0));
                const bf16x4 v1 = __builtin_amdgcn_ds_read_tr16_b64_v4i16((lds_bf16x4*)(a0 + 16 * 128));
                const bf16x8 vf = {v0[0], v0[1], v0[2], v0[3], v1[0], v1[1], v1[2], v1[3]};
                o[0][dt] = __builtin_amdgcn_mfma_f32_16x16x32_bf16(vf, pf[0][c], o[0][dt], 0, 0, 0);
                o[1][dt] = __builtin_amdgcn_mfma_f32_16x16x32_bf16(vf, pf[1][c], o[1][dt], 0, 0, 0);
            }
        }
    }
}

template <int VAR>
__device__ __forceinline__ void attn_unit(const Params& p, int l, int b, int hx, int qb, LAS3 char* lds) {
    typedef LAS3 bf16x4 lds_bf16x4;
    constexpr int KC = (VAR == 1) ? 3 : 2;
    const int tid = opaque_tid(p.wid), w = __builtin_amdgcn_readfirstlane(tid >> 6), lane = tid & 63, i = lane & 15, g = lane >> 4;
    const bf16_t *Qp, *Kp, *Vp; int ldq, ldk, ldv, q0, j0, j1, ocol; float c1, slope2 = 0.f;
    if (VAR == 0) { Qp = p.proj + PC_AQ + hx * 64; Kp = p.proj + PC_AK + hx * 64; Vp = p.proj + PC_AV + hx * 64; ldq = ldk = ldv = NP;
                    q0 = qb * 256 + 32 * w; j0 = 0; j1 = 4 * qb + 3; ocol = hx * 64; c1 = 0.125f * LOG2E; }
    else if (VAR == 1) { Qp = p.qm + hx * 96; Kp = p.km + hx * 96; Vp = p.vm + hx * 64; ldq = 384; ldk = 384; ldv = 256;
                    q0 = qb * 256 + 32 * w; j0 = 0; j1 = 4 * qb + 3; ocol = 256 + hx * 64; c1 = 0.10206207261596577f * LOG2E; }
    else if (VAR == 2) { const int qh = hx * 2 + (w >> 2); Qp = p.proj + PC_CQ + qh * 64; Kp = p.proj + PC_CK + hx * 64; Vp = p.proj + PC_CV + hx * 64; ldq = ldk = ldv = NP;
                    q0 = qb * 128 + 32 * (w & 3); j0 = 2 * qb - 2 > 0 ? 2 * qb - 2 : 0; j1 = 2 * qb + 1; ocol = 512 + qh * 64; c1 = 0.125f * LOG2E;
                    slope2 = exp2f(-(float)(qh + 1)) * LOG2E; }
    else { const int hd = w >> 1; Qp = p.proj + PC_DQ + hd * 64; Kp = p.proj + PC_DK; Vp = p.proj + PC_DV; ldq = ldk = ldv = NP;
                    q0 = qb * 64 + 32 * (w & 1); j0 = 0; j1 = qb; ocol = 768 + hd * 64; c1 = 0.125f * LOG2E; slope2 = exp2f(-(float)(hd + 5)) * LOG2E; }
    const size_t tok0 = (size_t)b * S;
    const bool xq = p.qslot > 0;
    if (VAR == 0 && qb > 0) {
        constexpr float FOX_DROP = 64.0f;
        const unsigned* kn2 = p.ctl + CW_KN2 + ((l * NB + b) * 4 + hx) * 32;
        const float* cbh = p.cbF + ((size_t)b * 4 + hx) * S;
        const float qn = c1 * sqrtf(__uint_as_float(p.ctl[CW_QN2 + ((l * NB + b) * 4 + hx) * 8 + qb]));
        float knu = 0.f;
        for (int jj = 4 * qb; jj < 4 * qb + 4; ++jj) knu = fmaxf(knu, __uint_as_float(kn2[jj]));
        const float lower = cbh[256 * qb] - qn * sqrtf(knu);
        const int jl = lane & 31;
        const bool keep = qn * sqrtf(__uint_as_float(kn2[jl])) + cbh[64 * jl + 63] - lower >= -FOX_DROP || jl >= 4 * qb;
        const unsigned long long kb = __ballot(keep) & 0xFFFFFFFFull;
        j0 = kb ? (int)__builtin_ctzll(kb) : 4 * qb;
    }
    bf16x8 qf[2][KC];
#pragma unroll
    for (int qt = 0; qt < 2; ++qt)
#pragma unroll
        for (int kc = 0; kc < KC; ++kc) qf[qt][kc] = *(const bf16x8*)(Qp + (tok0 + q0 + 16 * qt + i) * ldq + kc * 32 + 8 * g);
    const int sr = tid >> 3, sc8 = tid & 7;
    const int kdst = sr * 128 + ((sc8 ^ ((sr >> 1) & 7)) << 4);
    const int vdst = sr * 128 + (((((sc8 >> 1) ^ ((sr >> 1) & 3)) << 1) | (sc8 & 1)) << 4);
    const int rr = (tid & 255) >> 2, rc4 = tid & 3;
    const int rdst = rr * 64 + ((rc4 ^ ((rr >> 1) & 3)) << 4);
    u32x4 kstA, vstA, rstA = {0u, 0u, 0u, 0u}, kstB, vstB, rstB = {0u, 0u, 0u, 0u}; float cstA = 0.f, cstB = 0.f;
    u32x2 mw[2] = {{0u, 0u}, {0u, 0u}}, mwnA[2] = {{0u, 0u}, {0u, 0u}}, mwnB[2] = {{0u, 0u}, {0u, 0u}};
#define AT_LOAD(ZZ, j) do { if (AEXP(1)) break; const size_t _kr = tok0 + 64 * (j) + sr; \
        kst##ZZ = *(const u32x4*)(Kp + _kr * ldk + sc8 * 8); vst##ZZ = *(const u32x4*)(Vp + _kr * ldv + sc8 * 8); \
        if (VAR == 1) rst##ZZ = *(const u32x4*)(Kp + (tok0 + 64 * (j) + rr) * ldk + 64 + rc4 * 8); \
        if (VAR == 0) cst##ZZ = p.cbF[((size_t)b * 4 + hx) * S + 64 * (j) + (tid & 63)]; \
        if (VAR == 3) { _Pragma("unroll") for (int _q = 0; _q < 2; ++_q) mwn##ZZ[_q] = *(const u32x2*)(p.mask + (tok0 + q0 + 16 * _q + i) * 64 + 2 * (j)); } } while (0)
#define AT_WRITE(ZZ, buf) do { if (AEXP(1)) break; *(LAS3 u32x4*)(lds + AT_KB + (buf) * 8192 + kdst) = kst##ZZ; *(LAS3 u32x4*)(lds + AT_VB + (buf) * 8192 + vdst) = vst##ZZ; \
        if (VAR == 1 && tid < 256) *(LAS3 u32x4*)(lds + AT_KR + (buf) * 4096 + rdst) = rst##ZZ; \
        if (VAR == 0 && tid < 64) *(LAS3 float*)(lds + AT_CB + (buf) * 256 + tid * 4) = cst##ZZ; \
        if (VAR == 3) { mw[0] = mwn##ZZ[0]; mw[1] = mwn##ZZ[1]; } } while (0)
    AT_LOAD(A, j0);
    AT_LOAD(B, (j0 + 1 <= j1 ? j0 + 1 : j1));
    if (VAR == 1) {
#pragma unroll
        for (int qt = 0; qt < 2; ++qt) {
            const int pos = q0 + 16 * qt + i;
            const u32x4 mine = __builtin_bit_cast(u32x4, qf[qt][KC - 1]);
            u32x4 oth; oth.x = __shfl_xor(mine.x, 32); oth.y = __shfl_xor(mine.y, 32); oth.z = __shfl_xor(mine.z, 32); oth.w = __shfl_xor(mine.w, 32);
            const float* rt = p.ropetab + (size_t)(pos * 16 + (g & 1) * 8) * 2;
            const float sg = (g < 2) ? -1.f : 1.f;
            u32x4 res;
#pragma unroll
            for (int e2 = 0; e2 < 4; ++e2) {
                const f32x4 cs = *(const f32x4*)(rt + e2 * 4);
                const unsigned mw_ = e2 == 0 ? mine.x : e2 == 1 ? mine.y : e2 == 2 ? mine.z : mine.w, ow_ = e2 == 0 ? oth.x : e2 == 1 ? oth.y : e2 == 2 ? oth.z : oth.w;
                const float r0 = bflo(mw_) * cs[0] + sg * bflo(ow_) * cs[1], r1 = bfhi(mw_) * cs[2] + sg * bfhi(ow_) * cs[3];
                const unsigned pk = cvt_pk_bf16(r0, r1);
                if (e2 == 0) res.x = pk; else if (e2 == 1) res.y = pk; else if (e2 == 2) res.z = pk; else res.w = pk;
            }
            qf[qt][KC - 1] = __builtin_bit_cast(bf16x8, res);
        }
    }
#pragma unroll
    for (int qt = 0; qt < 2; ++qt)
#pragma unroll
        for (int kc = 0; kc < KC; ++kc) {
            u32x4 qq = __builtin_bit_cast(u32x4, qf[qt][kc]);
            qq.x = cvt_pk_bf16(bflo(qq.x) * c1, bfhi(qq.x) * c1); qq.y = cvt_pk_bf16(bflo(qq.y) * c1, bfhi(qq.y) * c1);
            qq.z = cvt_pk_bf16(bflo(qq.z) * c1, bfhi(qq.z) * c1); qq.w = cvt_pk_bf16(bflo(qq.w) * c1, bfhi(qq.w) * c1);
            qf[qt][kc] = __builtin_bit_cast(bf16x8, qq);
        }
    f32x4 o[2][4];
#pragma unroll
    for (int qt = 0; qt < 2; ++qt)
#pragma unroll
        for (int dt = 0; dt < 4; ++dt) o[qt][dt] = (f32x4){0.f, 0.f, 0.f, 0.f};
    float mrow[2] = {NEGBIG, NEGBIG}, lsum[2] = {0.f, 0.f};
    AT_WRITE(A, j0 & 1);
    __syncthreads();
    const int swk = (i >> 1) & 7;
    for (int j = j0; j <= j1; j += 2) {
        AT_LOAD(A, (j + 2 <= j1 ? j + 2 : j1));
        attn_tile<VAR, KC>(lds, j & 1, j, q0, i, g, swk, slope2, qf, o, mrow, lsum, mw, xq);
        if (j + 1 <= j1) AT_WRITE(B, (j + 1) & 1);
        if (!AEXP(5)) __syncthreads();
        if (j + 1 > j1) break;
        AT_LOAD(B, (j + 3 <= j1 ? j + 3 : j1));
        attn_tile<VAR, KC>(lds, (j + 1) & 1, j + 1, q0, i, g, swk, slope2, qf, o, mrow, lsum, mw, xq);
        if (j + 2 <= j1) AT_WRITE(A, j & 1);
        if (!AEXP(5)) __syncthreads();
    }
#undef AT_LOAD
#undef AT_WRITE
#pragma unroll
    for (int qt = 0; qt < 2; ++qt) {
        float lt = lsum[qt]; lt += __shfl_xor(lt, 16); lt += __shfl_xor(lt, 32);
        if (VAR == 2) lt += __builtin_amdgcn_exp2f(p.sinks[l * 4 + hx * 2 + (w >> 2)] * LOG2E - mrow[qt]);
        const float inv = 1.f / lt;
        bf16_t* op = p.merged + (tok0 + q0 + 16 * qt + i) * D + ocol + 4 * g;
        if (!(ATTN_EXP != 0 && xq))
#pragma unroll
        for (int dt = 0; dt < 4; ++dt) { const f32x4 v = o[qt][dt] * inv; u32x2 w2; w2.x = cvt_pk_bf16(v[0], v[1]); w2.y = cvt_pk_bf16(v[2], v[3]); *(u32x2*)(op + 16 * dt) = w2; }
    }
}

__device__ __forceinline__ void phase_attn(const Params& p, int l, LAS3 char* lds) {
    const int tid = opaque_tid(p.wid);
    unsigned* qhead = p.ctl + CW_QA + 64 * (l + 2 * p.qslot);
    volatile LAS3 int* bc = (volatile LAS3 int*)(lds + AT_CTL);
    int nxt = 0;
    if (tid == 0) nxt = (int)__hip_atomic_fetch_add(qhead, 1u, __ATOMIC_RELAXED, __HIP_MEMORY_SCOPE_AGENT);
    for (;;) {
        if (tid == 0) *bc = nxt;
        __syncthreads();
        const int idx = __builtin_amdgcn_readfirstlane(*bc);
        __syncthreads();
        if (idx >= 4096) break;
        if (tid == 0) nxt = (int)__hip_atomic_fetch_add(qhead, 1u, __ATOMIC_RELAXED, __HIP_MEMORY_SCOPE_AGENT);
        const int vmask = p.qslot ? REPK_VMASK : ATTN_VMASK;
        if (idx < 3072) {
            const int lvl = 7 - idx / 384, rem = idx % 384;
            if (rem < 128) { if (vmask & 2) attn_unit<1>(p, l, rem >> 2, rem & 3, lvl, lds); }
            else if (rem < 256) { if (vmask & 1) attn_unit<0>(p, l, (rem - 128) >> 2, rem & 3, lvl, lds); }
            else { const int d = rem - 256; if (vmask & 8) attn_unit<3>(p, l, d & 31, 0, 4 * lvl + 3 - (d >> 5), lds); }
        } else { const int c = idx - 3072; if (vmask & 4) attn_unit<2>(p, l, c >> 5, (c >> 4) & 1, c & 15, lds); }
    }
}
}

namespace {
constexpr int DS_LD = 2052;
constexpr int DS_CTL = 16 * DS_LD * 4;
constexpr int DS_LDS = DS_CTL + 64;

__device__ __forceinline__ void dsa_unit(const Params& p, int u, LAS3 char* lds) {
    const int tid = opaque_tid(p.wid), w = __builtin_amdgcn_readfirstlane(tid >> 6), lane = tid & 63, i = lane & 15, g = lane >> 4;
    const int b = u >> 7, t0 = (u & 127) * 16;
    const size_t tok0 = (size_t)b * S;
    uint32_t* mbase = p.mask + (tok0 + t0) * 64;
    if (t0 + 16 <= 256) {
#pragma unroll
        for (int qq = 0; qq < 2; ++qq) {
            const int q = 2 * w + qq, n = t0 + q + 1;
            if (lane < 32) { const int lo = lane * 64; unsigned long long bits = (n >= lo + 64) ? ~0ull : (n <= lo ? 0ull : ((1ull << (n - lo)) - 1ull));
                u32x2 o; o.x = (unsigned)bits; o.y = (unsigned)(bits >> 32); *(u32x2*)(mbase + q * 64 + 2 * lane) = o; }
        }
        return;
    }
    const int nreg = (t0 + 16 + 63) >> 6;
    const int ntile = nreg * 4;
    bf16x8 qf[8]; float wq[8];
    {
        const bf16_t* qrow = p.proj + (tok0 + t0 + i) * NP;
#pragma unroll
        for (int h = 0; h < 8; ++h) qf[h] = *(const bf16x8*)(qrow + PC_DQI + h * 32 + 8 * g);
        const u32x4 ww = *(const u32x4*)(qrow + PC_DWI);
        const float sc = 0.35355339059327373f * 0.17677669529663687f;
        wq[0] = bflo(ww.x) * sc; wq[1] = bfhi(ww.x) * sc; wq[2] = bflo(ww.y) * sc; wq[3] = bfhi(ww.y) * sc;
        wq[4] = bflo(ww.z) * sc; wq[5] = bfhi(ww.z) * sc; wq[6] = bflo(ww.w) * sc; wq[7] = bfhi(ww.w) * sc;
    }
    const int tq = t0 + i;
#ifndef DSA_EXP
#define DSA_EXP 0
#endif
    const bool exp_skip_score = (DSA_EXP == 2) && p.qslot > 0, exp_skip_sel = (DSA_EXP == 1) && p.qslot > 0, exp_nostore = (DSA_EXP != 0) && p.qslot > 0;
    if (!exp_skip_score)
    for (int base = w; base < ntile; base += 32) {
        bf16x8 kf4[4];
#pragma unroll
        for (int uu = 0; uu < 4; ++uu) { const int kt = base + 8 * uu; if (kt < ntile) kf4[uu] = *(const bf16x8*)(p.kidx + (tok0 + 16 * kt + i) * 32 + 8 * g); }
#pragma unroll
        for (int uu = 0; uu < 4; ++uu) {
            const int kt = base + 8 * uu;
            if (kt < ntile) {
                f32x4 sc4 = {0.f, 0.f, 0.f, 0.f};
#pragma unroll
                for (int h = 0; h < 8; ++h) {
                    const f32x4 c = __builtin_amdgcn_mfma_f32_16x16x32_bf16(kf4[uu], qf[h], (f32x4){0.f, 0.f, 0.f, 0.f}, 0, 0, 0);
#pragma unroll
                    for (int r = 0; r < 4; ++r) sc4[r] += wq[h] * fmaxf(c[r], 0.f);
                }
                u32x4 ko;
#pragma unroll
                for (int r = 0; r < 4; ++r) {
                    const int key = 16 * kt + 4 * g + r;
                    unsigned uu2 = __float_as_uint(sc4[r]); if (uu2 == 0x80000000u) uu2 = 0u;
                    uu2 = (uu2 & 0x80000000u) ? ~uu2 : (uu2 | 0x80000000u);
                    ko[r] = (key <= tq) ? uu2 : 0u;
                }
                *(LAS3 u32x4*)(lds + ((size_t)i * DS_LD + 16 * kt + 4 * g) * 4) = ko;
            }
        }
    }
    __syncthreads();
    if (!exp_skip_sel)
    {
        const int qA = 2 * w, qB = 2 * w + 1, nA = t0 + qA + 1, nB = t0 + qB + 1;
        const LAS3 unsigned* kpA = (const LAS3 unsigned*)(lds + (size_t)qA * DS_LD * 4);
        const LAS3 unsigned* kpB = (const LAS3 unsigned*)(lds + (size_t)qB * DS_LD * 4);
        unsigned keyA[32], keyB[32];
        const int nv = nreg * 64;
#pragma unroll
        for (int r = 0; r < 32; ++r) {
            int idx = r * 64 + lane; asm volatile("" : "+v"(idx));
            const unsigned va = kpA[r * 64 + lane], vb = kpB[r * 64 + lane];
            keyA[r] = (idx < nv) ? va : 0u; keyB[r] = (idx < nv) ? vb : 0u;
        }
        unsigned thrA = (nA <= 256) ? 1u : 0u, thrB = (nB <= 256) ? 1u : 0u;
        bool exA = (nA <= 256), exB = (nB <= 256);
        for (int bit = 31; bit >= 0; --bit) {
            if (exA && exB) break;
            const unsigned cA = exA ? 0xFFFFFFFFu : (thrA | (1u << bit)), cB = exB ? 0xFFFFFFFFu : (thrB | (1u << bit));
            int na = 0, nb = 0;
            if (!exA && !exB) {
#pragma unroll
                for (int gq = 0; gq < 4; ++gq) if (nreg > 8 * gq) {
#pragma unroll
                    for (int r = 8 * gq; r < 8 * gq + 8; ++r) { na += (keyA[r] >= cA) ? 1 : 0; nb += (keyB[r] >= cB) ? 1 : 0; } }
                na = wave_reduce_add(na); nb = wave_reduce_add(nb);
            } else if (!exA) {
#pragma unroll
                for (int gq = 0; gq < 4; ++gq) if (nreg > 8 * gq) {
#pragma unroll
                    for (int r = 8 * gq; r < 8 * gq + 8; ++r) na += (keyA[r] >= cA) ? 1 : 0; }
                na = wave_reduce_add(na);
            } else {
#pragma unroll
                for (int gq = 0; gq < 4; ++gq) if (nreg > 8 * gq) {
#pragma unroll
                    for (int r = 8 * gq; r < 8 * gq + 8; ++r) nb += (keyB[r] >= cB) ? 1 : 0; }
                nb = wave_reduce_add(nb);
            }
            if (!exA && na >= 256) { thrA = cA; exA = (na == 256); }
            if (!exB && nb >= 256) { thrB = cB; exB = (nb == 256); }
        }
#pragma unroll 1
        for (int qq = 0; qq < 2; ++qq) {
            const unsigned thr = qq ? thrB : thrA; const bool exact = qq ? exB : exA;
            unsigned long long mine = 0ull;
            int need = 0, running = 0;
            if (!exact) { int ngt = 0;
#pragma unroll
                for (int r = 0; r < 32; ++r) ngt += ((qq ? keyB[r] : keyA[r]) > thr) ? 1 : 0;
                need = 256 - wave_reduce_add(ngt); }
            const unsigned long long lt = (lane == 0) ? 0ull : (~0ull >> (64 - lane));
#pragma unroll
            for (int r = 0; r < 32; ++r) if (nreg > (r & ~7)) {
                const unsigned key = qq ? keyB[r] : keyA[r];
                unsigned long long bs;
                if (exact) bs = __ballot(key >= thr);
                else {
                    const bool eq = key == thr;
                    const unsigned long long be = __ballot(eq);
                    const int rank = running + __popcll(be & lt);
                    bs = __ballot((key > thr) || (eq && rank < need));
                    running += __popcll(be);
                }
                { int ln = lane; asm volatile("" : "+v"(ln)); if (ln == r) mine = bs; }
            }
            if (lane < 32 && !exp_nostore) { u32x2 o; o.x = (unsigned)mine; o.y = (unsigned)(mine >> 32); *(u32x2*)(mbase + (2 * w + qq) * 64 + 2 * lane) = o; }
        }
    }
    __syncthreads();
}

__device__ __forceinline__ void phase_dsa(const Params& p, int l, LAS3 char* lds) {
    const int tid = opaque_tid(p.wid);
    unsigned* qhead = p.ctl + CW_QD + 64 * (l + 2 * p.qslot);
    volatile LAS3 int* bc = (volatile LAS3 int*)(lds + DS_CTL);
    int nxt = 0;
    if (tid == 0) nxt = (int)__hip_atomic_fetch_add(qhead, 1u, __ATOMIC_RELAXED, __HIP_MEMORY_SCOPE_AGENT);
    for (;;) {
        if (tid == 0) *bc = nxt;
        __syncthreads();
        const int idx = __builtin_amdgcn_readfirstlane(*bc);
        __syncthreads();
        if (idx >= 4096) break;
        if (tid == 0) nxt = (int)__hip_atomic_fetch_add(qhead, 1u, __ATOMIC_RELAXED, __HIP_MEMORY_SCOPE_AGENT);
        const int pb = 127 - (idx >> 5), b = idx & 31;
        dsa_unit(p, b * 128 + pb, lds);
    }
}
}

namespace {
constexpr int LDS_BYTES = 147456;
constexpr int NTHREADS = 512;

template <int PH>
__device__ __forceinline__ void run_phase(const Params& p, int l, unsigned char* smem) {
    LAS3 char* lds = (LAS3 char*)smem;
    PG8_LAS unsigned char* glds = (PG8_LAS unsigned char*)smem;
    const int G = gridDim.x, c = blockIdx.x;
    if constexpr (PH == 0) phase_p0(p, (char*)smem);
    if constexpr (PH == 1) { if (l == 0) phase_norm1<0>(p, 0); else phase_norm1<1>(p, l); }
    if constexpr (PH == 2) { pg8::Gemm g{p.h, p.WinT + (size_t)l * NP * D, D, D, 0}; pg8::StaticOrder S; S.init(T, NP, G, c);
        EpiStoreBf16 E{p.proj, NP}; pg8::gemm_phase<EpiStoreBf16, pg8::StaticOrder, false>(glds, g, S, E, p.wid); }
    if constexpr (PH == 3) phase_prep(p, l);
    if constexpr (PH == 4) { pg8::Gemm g{p.proj + PC_BCQ, p.WqT + (size_t)l * 512 * 256, 256, NP, 0}; pg8::StaticOrder S; S.init(T, 512, G, c);
          EpiMlaQ E{p.qm}; pg8::gemm_phase<EpiMlaQ, pg8::StaticOrder, false>(glds, g, S, E, p.wid); }
    if constexpr (PH == 12) { pg8::Gemm g{p.proj + PC_BCKV, p.WkvT + (size_t)l * 512 * 128, 128, NP, 0}; pg8::StaticOrder S; S.init(T, 512, G, c);
          EpiMlaKV E{p.km, p.vm}; pg8::gemm_phase<EpiMlaKV, pg8::StaticOrder, false>(glds, g, S, E, p.wid); }
    if constexpr (PH == 13) phase_dsa(p, l, lds);
    if constexpr (PH == 5) phase_attn(p, l, lds);
    if constexpr (PH == 6) { pg8::Gemm g{p.merged, p.WoutT + (size_t)l * D * D, D, D, 0}; pg8::StaticOrder S; S.init(T, D, G, c);
        EpiResidual E{l == 0 ? p.x : nullptr, p.xb, p.mod + (size_t)l * NB * NMOD + 2 * 1024}; pg8::gemm_phase<EpiResidual, pg8::StaticOrder, false>(glds, g, S, E, p.wid); }
    if constexpr (PH == 7) phase_route(p, l, (char*)smem);
    if constexpr (PH == 8) { const int* cnt = (const int*)(p.ctl + CW_CNT) + l * 16;
        pg8::Gemm g{p.h, p.WguT + (size_t)l * 16 * 512 * 1024, 1024, D, (size_t)512 * 1024}; MoeOrder S; S.init(cnt, p.list, 2, G, c);
        EpiGateUp E{p.hid}; pg8::gemm_phase<EpiGateUp, MoeOrder, true>(glds, g, S, E, p.wid); }
    if constexpr (PH == 9) { const int* cnt = (const int*)(p.ctl + CW_CNT) + l * 16;
        pg8::Gemm g{p.hid, p.WdT + (size_t)l * 16 * 1024 * 256, 256, 256, (size_t)1024 * 256}; MoeOrder S; S.init(cnt, p.list, 4, G, c);
        EpiDown E{p.ys, p.list, p.wl, cnt}; pg8::gemm_phase<EpiDown, MoeOrder, false>(glds, g, S, E, p.wid); }
    if constexpr (PH == 10) phase_norm1<2>(p, 1);
    if constexpr (PH == 11) phase_norm1<0>(p, l);
}
template <int PH>
__global__ void __launch_bounds__(NTHREADS, 2) k_ph(Params p, int l) {
    extern __shared__ __attribute__((aligned(16))) unsigned char smem[];
    p.wid = __builtin_amdgcn_readfirstlane(threadIdx.x >> 6); p.qslot = p.qslot_host;
    run_phase<PH>(p, l, smem);
}
}


namespace {
#ifndef REP_PH
#define REP_PH -1
#endif
#define REP(X, l) do { if (REP_PH == X) { xcd_barrier(bar); phase<X>(l, smem, wid, 1); } } while (0)
struct KArgs { const float* in[20]; float* xo; char* ws; };
constexpr size_t al256(size_t b) { return (b + 255) & ~(size_t)255; }
constexpr size_t WS_CTL = 0;
constexpr size_t WS_MOD = WS_CTL + al256((size_t)CW_WORDS * 4);
constexpr size_t WS_WIN = WS_MOD + al256((size_t)2 * NB * NMOD * 4);
constexpr size_t WS_WOUT = WS_WIN + al256((size_t)2 * NP * D * 2);
constexpr size_t WS_WQ = WS_WOUT + al256((size_t)2 * D * D * 2);
constexpr size_t WS_WKV = WS_WQ + al256((size_t)2 * 512 * 256 * 2);
constexpr size_t WS_WGU = WS_WKV + al256((size_t)2 * 512 * 128 * 2);
constexpr size_t WS_WD = WS_WGU + al256((size_t)2 * 16 * 512 * 1024 * 2);
constexpr size_t WS_ROPE = WS_WD + al256((size_t)2 * 16 * 1024 * 256 * 2);
constexpr size_t WS_RQ = WS_ROPE + al256((size_t)2048 * 16 * 2 * 4);
constexpr size_t WS_RKV = WS_RQ + al256((size_t)T * 4);
constexpr size_t WS_CBF = WS_RKV + al256((size_t)T * 4);
constexpr size_t WS_KIDX = WS_CBF + al256((size_t)NB * 4 * S * 4);
constexpr size_t WS_MASK = WS_KIDX + al256((size_t)T * 32 * 2);
constexpr size_t WS_LIST = WS_MASK + al256((size_t)T * 64 * 4);
constexpr size_t WS_RW = WS_LIST + al256((size_t)2 * 16 * ECAP * 4);
constexpr size_t WS_WL = WS_RW + al256((size_t)T * 2 * 4);
constexpr size_t WS_H = WS_WL + al256((size_t)2 * 16 * ECAP * 4);
constexpr size_t WS_PROJ = WS_H + al256((size_t)T * D * 2);
constexpr size_t WS_QM = WS_PROJ + al256((size_t)T * NP * 2);
constexpr size_t WS_KM = WS_QM + al256((size_t)T * 384 * 2);
constexpr size_t WS_VM = WS_KM + al256((size_t)T * 384 * 2);
constexpr size_t WS_MERGED = WS_VM + al256((size_t)T * 256 * 2);
constexpr size_t WS_XB = WS_MERGED + al256((size_t)T * D * 2);
constexpr size_t WS_END1 = WS_XB + al256((size_t)T * D * 2);
constexpr size_t WS_HID = WS_PROJ;
constexpr size_t WS_YS = WS_HID + al256((size_t)HIDROWS * 256 * 2);
constexpr size_t WS_END2 = WS_YS + al256((size_t)T * 2 * D * 2);
constexpr size_t WS_NEED = WS_END1 > WS_END2 ? WS_END1 : WS_END2;
static_assert(WS_END2 <= WS_MERGED, "MoE overlay must not reach the merged buffer");

__device__ __forceinline__ Params make_params(const KArgs& a) {
    Params p;
    p.x = a.in[0]; p.c = a.in[1]; p.w_ada = a.in[2]; p.b_ada = a.in[3]; p.g_norm1 = a.in[4]; p.w_in = a.in[5]; p.b_forget = a.in[6]; p.g_q_mla = a.in[7];
    p.w_q_up = a.in[8]; p.g_kv_mla = a.in[9]; p.w_kv_up = a.in[10]; p.sinks = a.in[11]; p.w_out = a.in[12]; p.g_norm2 = a.in[13]; p.w_router = a.in[14];
    p.b_router = a.in[15]; p.w_gate = a.in[16]; p.w_up = a.in[17]; p.w_down = a.in[18]; p.g_final = a.in[19];
    p.xo = a.xo; char* ws = a.ws;
    p.ctl = (unsigned*)(ws + WS_CTL); p.mod = (float*)(ws + WS_MOD); p.WinT = (bf16_t*)(ws + WS_WIN); p.WoutT = (bf16_t*)(ws + WS_WOUT);
    p.WqT = (bf16_t*)(ws + WS_WQ); p.WkvT = (bf16_t*)(ws + WS_WKV); p.WguT = (bf16_t*)(ws + WS_WGU); p.WdT = (bf16_t*)(ws + WS_WD);
    p.ropetab = (float*)(ws + WS_ROPE); p.rq = (float*)(ws + WS_RQ); p.rkv = (float*)(ws + WS_RKV); p.cbF = (float*)(ws + WS_CBF); p.kidx = (bf16_t*)(ws + WS_KIDX);
    p.mask = (uint32_t*)(ws + WS_MASK); p.list = (int*)(ws + WS_LIST); p.rw = (float*)(ws + WS_RW); p.wl = (float*)(ws + WS_WL); p.h = (bf16_t*)(ws + WS_H);
    p.proj = (bf16_t*)(ws + WS_PROJ); p.qm = (bf16_t*)(ws + WS_QM); p.km = (bf16_t*)(ws + WS_KM); p.vm = (bf16_t*)(ws + WS_VM);
    p.merged = (bf16_t*)(ws + WS_MERGED); p.xb = (bf16_t*)(ws + WS_XB); p.hid = (bf16_t*)(ws + WS_HID); p.ys = (bf16_t*)(ws + WS_YS);
    return p;
}
template <int PH>
__device__ __forceinline__ void phase(int l, unsigned char* smem, int wid, int qslot = 0) {
    typedef const __attribute__((address_space(4))) KArgs* KA4;
    KA4 ka = (KA4)__builtin_amdgcn_kernarg_segment_ptr();
    asm volatile("" : "+s"(ka));
    KArgs a;
#pragma unroll
    for (int i = 0; i < 20; ++i) a.in[i] = ka->in[i];
    a.xo = ka->xo; a.ws = ka->ws;
    Params p = make_params(a); p.wid = wid; p.qslot = qslot; p.qslot_host = 0;
    run_phase<PH>(p, l, smem);
}
__global__ void __launch_bounds__(NTHREADS, 2) fwd(KArgs args) {
    extern __shared__ __attribute__((aligned(16))) unsigned char smem[];
    volatile LAS unsigned* st = (volatile LAS unsigned*)(smem + LDS_BYTES - 16);
    const int wid = __builtin_amdgcn_readfirstlane(threadIdx.x >> 6);
    if (xb_leader(wid)) { st[0] = 0u; st[1] = 0u; st[2] = 0u; st[3] = 0u; }
    __syncthreads();
    XcdBarrier bar = xcd_barrier_post((unsigned*)(args.ws + WS_CTL) + CW_BAR, st, wid);
    phase<0>(0, smem, wid);  REP(0, 0);
    xcd_barrier(bar);
#define LAYER(l) do { \
        phase<1>(l, smem, wid);  if (l == 0) REP(1, l); xcd_barrier(bar); \
        phase<2>(l, smem, wid);  REP(2, l); xcd_barrier(bar); \
        phase<3>(l, smem, wid);  REP(3, l); xcd_barrier(bar); \
        phase<4>(l, smem, wid);  REP(4, l); phase<12>(l, smem, wid);  REP(12, l); phase<13>(l, smem, wid);  REP(13, l); xcd_barrier(bar); \
        phase<5>(l, smem, wid);  REP(5, l); xcd_barrier(bar); \
        phase<6>(l, smem, wid);  xcd_barrier(bar); \
        phase<7>(l, smem, wid);  REP(7, l); xcd_barrier(bar); \
        phase<8>(l, smem, wid);  REP(8, l); xcd_barrier(bar); \
        phase<9>(l, smem, wid);  REP(9, l); xcd_barrier(bar); } while (0)
    LAYER(0);
    LAYER(1);
#ifdef REP_BAR
    for (int rb = 0; rb < REP_BAR; ++rb) xcd_barrier(bar);
#endif
    phase<10>(1, smem, wid);
}
}

extern "C" void kernel_launch(void* const* d_in, const int* in_sizes, int n_in, void* d_out, int out_size, void* d_ws, size_t ws_size,
                              hipStream_t stream) {
    KArgs a{};
    for (int i = 0; i < 20; ++i) a.in[i] = (const float*)d_in[i];
    a.xo = (float*)d_out; a.ws = (char*)d_ws;
    if (WS_NEED > ws_size) return;

    static int grid = 0;
    if (!grid) {
        int dev = 0, cus = 0, per_cu = 0;
        (void)hipGetDevice(&dev);
        (void)hipDeviceGetAttribute(&cus, hipDeviceAttributeMultiprocessorCount, dev);
        (void)hipFuncSetAttribute((const void*)fwd, hipFuncAttributeMaxDynamicSharedMemorySize, LDS_BYTES);
        (void)hipOccupancyMaxActiveBlocksPerMultiprocessor(&per_cu, (const void*)fwd, NTHREADS, LDS_BYTES);
        grid = cus > 0 ? cus : 256;
    }
    (void)hipMemsetAsync(a.ws + WS_CTL, 0, (size_t)CW_WORDS * 4, stream);
    fwd<<<dim3(grid), dim3(NTHREADS), LDS_BYTES, stream>>>(a);
}
```

```cpp
#include <hip/hip_runtime.h>
#include <stdint.h>
#define XB_TMO      128
#define XB_XCNT(j)  (256  + 64 * (j))
#define XB_XSUB(j)  (1280 + 64 * (j))
#define XB_XGEN(j)  (2304 + 64 * (j))
#define XB_TOP      3328
#define XB_TOPGEN   3392
#define XCD_BAR_WORDS 3456
#define XB_SPIN_CAP (1u << 20)
#define LAS __attribute__((address_space(3)))

__device__ __forceinline__ unsigned xb_ld(unsigned* p)              { return __hip_atomic_load(p, __ATOMIC_RELAXED, __HIP_MEMORY_SCOPE_AGENT); }
__device__ __forceinline__ unsigned xb_add(unsigned* p, unsigned v) { return __hip_atomic_fetch_add(p, v, __ATOMIC_RELAXED, __HIP_MEMORY_SCOPE_AGENT); }
__device__ __forceinline__ unsigned xb_xcc_id() { return (unsigned)__builtin_amdgcn_s_getreg((3 << 11) | 20) & 0xFu; }
#define XB_SPIN(cond, bar) do { unsigned _sp = 0; while (cond) { __builtin_amdgcn_s_sleep(1); \
    if ((++_sp & 255u) == 0u) { if (xb_ld(&(bar)[XB_TMO])) break; if (_sp > XB_SPIN_CAP) { atomicAdd(&(bar)[XB_TMO], 1u); break; } } } } while (0)

struct XcdBarrier { unsigned* bar; unsigned x; volatile LAS unsigned* st; int wid; };
__device__ __forceinline__ bool xb_leader(int wid) { return wid == 0 && __builtin_amdgcn_mbcnt_hi(~0u, __builtin_amdgcn_mbcnt_lo(~0u, 0u)) == 0u; }

__device__ __forceinline__ XcdBarrier xcd_barrier_post(unsigned* bar, volatile LAS unsigned* st, int wid) {
    XcdBarrier b; b.bar = bar; b.x = xb_xcc_id(); b.st = st; b.wid = wid;
    if (xb_leader(wid)) (void)xb_add(&bar[XB_XCNT(b.x)], 1u);
    return b;
}
__device__ __forceinline__ void xcd_barrier_complete(unsigned* bar, unsigned x, unsigned& nloc, unsigned& nx) {
    const unsigned G = gridDim.x * gridDim.y * gridDim.z;
    unsigned sum, cnt, mine, sp = 0u;
    for (;;) {
        sum = 0u; cnt = 0u; mine = 0u;
#pragma unroll
        for (unsigned j = 0; j < 16; ++j) { const unsigned c = xb_ld(&bar[XB_XCNT(j)]); sum += c; cnt += (c > 0u) ? 1u : 0u; mine = (j == x) ? c : mine; }
        if (sum == G) break;
        __builtin_amdgcn_s_sleep(1);
        if ((++sp & 255u) == 0u) { if (xb_ld(&bar[XB_TMO])) break; if (sp > XB_SPIN_CAP) { atomicAdd(&bar[XB_TMO], 1u); break; } }
    }
    nloc = mine > 0u ? mine : 1u; nx = cnt > 0u ? cnt : 1u;
}
__device__ __forceinline__ void xcd_barrier(const XcdBarrier& b) {
    asm volatile("s_waitcnt vmcnt(0)" ::: "memory");
    __syncthreads();
    if (xb_leader(b.wid)) {
        unsigned* bar = b.bar;
        __builtin_amdgcn_s_waitcnt(0);
        unsigned nloc = b.st[0], nx = b.st[1];
        if (nloc == 0u) { xcd_barrier_complete(bar, b.x, nloc, nx); b.st[0] = nloc; b.st[1] = nx; }
        const unsigned old = xb_add(&bar[XB_XSUB(b.x)], 1u);
        const unsigned gen = old / nloc;
        if (old + 1u == (gen + 1u) * nloc) {
            __builtin_amdgcn_fence(__ATOMIC_RELEASE, "agent");
            asm volatile("s_waitcnt vmcnt(0)" ::: "memory");
            const unsigned og = xb_add(&bar[XB_TOP], 1u);
            const unsigned tg = og / nx;
            if (og + 1u == (tg + 1u) * nx) xb_add(&bar[XB_TOPGEN], 1u);
            else XB_SPIN(xb_ld(&bar[XB_TOPGEN]) == tg, bar);
            __builtin_amdgcn_fence(__ATOMIC_ACQUIRE, "agent");
            xb_add(&bar[XB_XGEN(b.x)], 1u);
            asm volatile("s_waitcnt vmcnt(0)" ::: "memory");
        } else {
            XB_SPIN(xb_ld(&bar[XB_XGEN(b.x)]) == gen, bar);
            __builtin_amdgcn_fence(__ATOMIC_ACQUIRE, "agent");
            asm volatile("s_waitcnt vmcnt(0)" ::: "memory");
        }
    }
    __syncthreads();
}

#define LAS3 __attribute__((address_space(3)))
namespace {
typedef unsigned short bf16_t;
typedef short bf16x8 __attribute__((ext_vector_type(8)));
typedef short bf16x4 __attribute__((ext_vector_type(4)));
typedef float f32x4 __attribute__((ext_vector_type(4)));
typedef float f32x2 __attribute__((ext_vector_type(2)));
typedef unsigned u32x4 __attribute__((ext_vector_type(4)));
typedef unsigned u32x2 __attribute__((ext_vector_type(2)));

constexpr int D = 1024, NB = 32, S = 2048, T = NB * S, NIN = 2380, NP = 2560, NMOD = 6144;
constexpr int OFF_AQ = 0, OFF_AK = 256, OFF_AV = 512, OFF_AF = 768, OFF_BCQ = 772, OFF_BCKV = 1028, OFF_BKR = 1156,
              OFF_CQ = 1188, OFF_CK = 1444, OFF_CV = 1572, OFF_DQ = 1700, OFF_DK = 1956, OFF_DV = 2020,
              OFF_DQI = 2084, OFF_DKI = 2340, OFF_DWI = 2372;
constexpr int PC_AQ = 0, PC_AK = 256, PC_AV = 512, PC_BCQ = 768, PC_BCKV = 1024, PC_BKR = 1152, PC_CQ = 1184, PC_CK = 1440, PC_CV = 1568,
              PC_DQ = 1696, PC_DK = 1952, PC_DV = 2016, PC_DQI = 2080, PC_DKI = 2336, PC_DWI = 2368, PC_AF = 2376;
constexpr float EPS = 1e-6f;
constexpr float LOG2E = 1.4426950408889634f;
constexpr int ECAP = T;
constexpr int HIDROWS = 2 * T + 16 * 256;

__host__ __device__ __forceinline__ int orig_col(int n) { return n < 768 ? n : (n < 2376 ? n + 4 : (n < 2380 ? n - 1608 : -1)); }
__device__ __forceinline__ int opaque_tid(int wid) {
    int t = wid * 64 + (int)__builtin_amdgcn_mbcnt_hi(~0u, __builtin_amdgcn_mbcnt_lo(~0u, 0u));
    asm volatile("" : "+v"(t)); return t; }
__device__ __forceinline__ float bf2f(bf16_t v) { return __uint_as_float((unsigned)v << 16); }
__device__ __forceinline__ bf16_t f2bf(float f) { unsigned u = __float_as_uint(f); u += 0x7FFFu + ((u >> 16) & 1u); return (bf16_t)(u >> 16); }
typedef __bf16 bf16x2_native __attribute__((ext_vector_type(2)));
__device__ __forceinline__ unsigned cvt_pk_bf16(float lo, float hi) { const f32x2 v = {lo, hi}; return __builtin_bit_cast(unsigned, __builtin_convertvector(v, bf16x2_native)); }
__device__ __forceinline__ float bflo(unsigned w) { return __uint_as_float(w << 16); }
__device__ __forceinline__ float bfhi(unsigned w) { return __uint_as_float(w & 0xFFFF0000u); }
__device__ __forceinline__ float wave_sum(float v) {
#pragma unroll
    for (int o = 32; o > 0; o >>= 1) v += __shfl_xor(v, o);
    return v;
}
__device__ __forceinline__ float xor32_max(float x) {
    float a = x, b = x;
    asm volatile("s_nop 1\n\tv_permlane32_swap_b32 %0, %1\n\ts_nop 1" : "+v"(a), "+v"(b));
    return fmaxf(a, b);
}
__device__ __forceinline__ int wave_reduce_add(int v) {
    v += __builtin_amdgcn_update_dpp(0, v, 0xB1, 0xF, 0xF, true);
    v += __builtin_amdgcn_update_dpp(0, v, 0x4E, 0xF, 0xF, true);
    v += __builtin_amdgcn_update_dpp(0, v, 0x141, 0xF, 0xF, true);
    v += __builtin_amdgcn_update_dpp(0, v, 0x140, 0xF, 0xF, true);
    return __builtin_amdgcn_readlane(v, 0) + __builtin_amdgcn_readlane(v, 16) + __builtin_amdgcn_readlane(v, 32) + __builtin_amdgcn_readlane(v, 48);
}
}

namespace pg8 {
#define PG8_LAS __attribute__((address_space(3)))
constexpr int BM = 256, BK = 64, HALF = 128, HTB = HALF * BK * 2, STAGE_BYTES = 8 * HTB, NXCD = 8, WGM = 8;

__host__ __device__ __forceinline__ int lds_byte(int r, int c) { const int st = (r >> 4) * 2 + (c >> 5), rr = r & 15, cc = c & 31, ob = rr * 64 + cc * 2; return st * 1024 + (ob ^ (((ob >> 9) & 1) << 5)); }
__host__ __device__ __forceinline__ void stage_rc(int b, int& R, int& C) { const int st = b / 1024, sb = b % 1024, swz = sb ^ (((sb >> 9) & 1) << 5); R = (st >> 1) * 16 + swz / 64; C = (st & 1) * 32 + (swz % 64) / 2; }
__host__ __device__ __forceinline__ int perm32(int rho) { const int n = rho >> 4, i = rho & 15; return 8 * (i >> 2) + 4 * n + (i & 3); }

struct Unit { int pm, pn, e, mt; };
struct Gemm { const bf16_t* A; const bf16_t* Bt; int K; int lda; size_t bstride; };

struct StaticOrder {
    int nM, nN, nwg, G, c;
    __host__ __device__ void init(int M, int N, int G_, int c_) { nM = M / BM; nN = N / BM; nwg = nM * nN; G = G_; c = c_; }
    __host__ __device__ bool next(int i, Unit& u) const {
        const long L = (long)i * G + c; if (L >= nwg) return false;
        int wgid = (int)L; { const int q = nwg / NXCD, r = nwg % NXCD, xcd = wgid % NXCD, off = wgid / NXCD; wgid = (xcd < r ? xcd * (q + 1) : r * (q + 1) + (xcd - r) * q) + off; }
        const int nig = WGM * nN, gid = wgid / nig, fm = gid * WGM, gsz = (nM - fm) < WGM ? (nM - fm) : WGM;
        u.pm = fm + ((wgid % nig) % gsz); u.pn = (wgid % nig) / gsz; u.e = 0; u.mt = 0; return true;
    }
    __device__ __forceinline__ int arow(const Unit& u, int r) const { return u.pm * BM + r; }
};

template <class Epi, class Sched, bool GATHER>
__device__ __forceinline__ void gemm_phase(PG8_LAS unsigned char* lds, const Gemm g, const Sched& S, const Epi& E, int wave_index) {
    const int tid = opaque_tid(wave_index), wid = __builtin_amdgcn_readfirstlane(tid >> 6), lane = tid & 63, wr = wid >> 2, wc = wid & 3, fr = lane & 15, fq = lane >> 4;
    int K_ = g.K; asm volatile("" : "+s"(K_));
    const int K = K_, nt = K / BK, lda = g.lda;
    int Ra[2], Ca[2]; unsigned voffB[2], voffA[2];
#pragma unroll
    for (int i = 0; i < 2; ++i) { int R, C; stage_rc(tid * 16 + i * 8192, R, C); const int Rb = Epi::PERM ? ((R & ~31) + perm32(R & 31)) : R;
        Ra[i] = R; Ca[i] = C; voffB[i] = (unsigned)(Rb * K + C) * 2u; voffA[i] = (unsigned)(R * lda + C) * 2u; }
    const size_t kstep = (size_t)(BK * 2);
    const size_t hstepB = (size_t)HALF * K * 2;
    const size_t tstepB = 2 * hstepB;
    const size_t hstepA = (size_t)HALF * lda * 2, tstepA = 2 * hstepA;
    const unsigned ldsw = (unsigned)wid * 1024u;
    const int aoff = lds_byte(wr * 64 + fr, fq * 8), boff = lds_byte(wc * 32 + fr, fq * 8);
#define PG8_SA(b, h) (((b) * 2 + (h)) * HTB)
#define PG8_SB(b, h) ((4 + (b) * 2 + (h)) * HTB)
#define PG8_STAGE(bufoff, gbase, voff) do { _Pragma("unroll") for (int _i = 0; _i < 2; ++_i) \
        __builtin_amdgcn_global_load_lds((const unsigned*)((const char*)(gbase) + (voff)[_i]), (PG8_LAS unsigned*)(lds + (bufoff) + ldsw + _i * 8192), 16, 0, 0); } while (0)
#define PG8_STAGEA(bufoff, kptr, VO, h) do { _Pragma("unroll") for (int _i = 0; _i < 2; ++_i) { \
        const char* _src; if constexpr (GATHER) _src = (const char*)(kptr) + (VO)[_i][h]; else _src = (const char*)(kptr) + (size_t)(h) * hstepA + voffA[_i]; \
        __builtin_amdgcn_global_load_lds((const unsigned*)_src, (PG8_LAS unsigned*)(lds + (bufoff) + ldsw + _i * 8192), 16, 0, 0); } } while (0)
#define PG8_LDA(dst, b, h) do { _Pragma("unroll") for (int m = 0; m < 4; ++m) _Pragma("unroll") for (int k = 0; k < 2; ++k) dst[m][k] = *(const PG8_LAS bf16x8*)(lds + PG8_SA(b, h) + aoff + m * 2048 + k * 1024); } while (0)
#define PG8_LDB(dst, b, h) do { _Pragma("unroll") for (int n = 0; n < 2; ++n) _Pragma("unroll") for (int k = 0; k < 2; ++k) dst[n][k] = *(const PG8_LAS bf16x8*)(lds + PG8_SB(b, h) + boff + n * 2048 + k * 1024); } while (0)
#define PG8_MMA(ai, bj, At, Bt) do { __builtin_amdgcn_s_setprio(1); _Pragma("unroll") for (int m = 0; m < 4; ++m) _Pragma("unroll") for (int n = 0; n < 2; ++n) _Pragma("unroll") for (int k = 0; k < 2; ++k) \
        acc[ai][bj][m][n] = __builtin_amdgcn_mfma_f32_16x16x32_bf16(Bt[n][k], At[m][k], acc[ai][bj][m][n], 0, 0, 0); __builtin_amdgcn_s_setprio(0); } while (0)
#define PG8_WAIT_V(n) asm volatile("s_waitcnt vmcnt(" #n ")" ::: "memory")
#define PG8_WAIT_L(n) asm volatile("s_waitcnt lgkmcnt(" #n ")" ::: "memory")
#define PG8_BAR __builtin_amdgcn_s_barrier()
#define PG8_SCHED __builtin_amdgcn_sched_barrier(0)
#define PG8_SETV(V, u) do { _Pragma("unroll") for (int _i = 0; _i < 2; ++_i) _Pragma("unroll") for (int _h = 0; _h < 2; ++_h) { \
        const int _row = GATHER ? S.arow(u, _h * HALF + Ra[_i]) : ((u).pm * BM + _h * HALF + Ra[_i]); V[_i][_h] = (unsigned)(((size_t)_row * lda + Ca[_i]) * 2); } } while (0)
    Unit cur, nxt; int ui = 0;
    if (!S.next(0, cur)) return;
    f32x4 acc[2][2][4][2];
#pragma unroll
    for (int a = 0; a < 2; ++a)
#pragma unroll
        for (int b = 0; b < 2; ++b)
#pragma unroll
            for (int m = 0; m < 4; ++m)
#pragma unroll
                for (int n = 0; n < 2; ++n) acc[a][b][m][n] = (f32x4){0.f, 0.f, 0.f, 0.f};
    bf16x8 At[4][2], B0[2][2], B1[2][2];
    unsigned vA[2][2], vN[2][2];
    if constexpr (GATHER) { PG8_SETV(vA, cur); }
    const char* cA = (const char*)g.A + (GATHER ? (size_t)0 : (size_t)cur.pm * tstepA);
    const char* cB = (const char*)g.Bt + ((size_t)cur.e * g.bstride) * 2 + (size_t)cur.pn * tstepB;
    PG8_STAGE(PG8_SB(0, 0), cB, voffB); PG8_STAGE(PG8_SB(0, 1), cB + hstepB, voffB); PG8_STAGEA(PG8_SA(0, 0), cA, vA, 0); PG8_STAGEA(PG8_SA(0, 1), cA, vA, 1);
    if (wr == 1) PG8_BAR;
    PG8_WAIT_V(2); PG8_BAR;
    PG8_STAGE(PG8_SB(1, 0), cB + kstep, voffB); PG8_STAGEA(PG8_SA(1, 0), cA + kstep, vA, 0); PG8_STAGE(PG8_SB(1, 1), cB + hstepB + kstep, voffB);
    PG8_WAIT_V(6); PG8_BAR;
    for (;;) {
        const bool has_next = S.next(ui + 1, nxt);
        if constexpr (GATHER) { if (has_next) { PG8_SETV(vN, nxt); }
        else {
#pragma unroll
            for (int _i = 0; _i < 2; ++_i)
#pragma unroll
                for (int _h = 0; _h < 2; ++_h) vN[_i][_h] = vA[_i][_h];
        } }
        const char* nA = (!GATHER && has_next) ? (const char*)g.A + (size_t)nxt.pm * tstepA : cA;
        const char* nB = has_next ? (const char*)g.Bt + ((size_t)nxt.e * g.bstride) * 2 + (size_t)nxt.pn * tstepB : cB;
#pragma unroll 1
        for (int t = 0; t < nt; t += 2) {
            const bool last = (t == nt - 2);
            const char* a1 = cA + (size_t)(t + 1) * kstep;
            const char* a2 = last ? nA : cA + (size_t)(t + 2) * kstep; const char* b2 = last ? nB : cB + (size_t)(t + 2) * kstep;
            const char* a3 = a2 + kstep; const char* b3 = b2 + kstep;
            unsigned v2[2][2];
            if constexpr (GATHER) {
#pragma unroll
            for (int _i = 0; _i < 2; ++_i)
#pragma unroll
                for (int _h = 0; _h < 2; ++_h) v2[_i][_h] = last ? vN[_i][_h] : vA[_i][_h];
            }
            PG8_LDB(B0, 0, 0); PG8_LDB(B1, 0, 1); PG8_SCHED; PG8_LDA(At, 0, 0); PG8_STAGEA(PG8_SA(1, 1), a1, vA, 1);
            PG8_WAIT_V(8); PG8_WAIT_L(0); PG8_BAR; PG8_MMA(0, 0, At, B0); PG8_MMA(0, 1, At, B1); PG8_BAR; PG8_SCHED;
            PG8_LDA(At, 0, 1); PG8_STAGE(PG8_SB(0, 0), b2, voffB); PG8_STAGE(PG8_SB(0, 1), b2 + hstepB, voffB); PG8_STAGEA(PG8_SA(0, 0), a2, v2, 0);
            PG8_WAIT_V(8); PG8_WAIT_L(0); PG8_BAR; PG8_MMA(1, 0, At, B0); PG8_MMA(1, 1, At, B1); PG8_BAR; PG8_SCHED;
            PG8_LDB(B0, 1, 0); PG8_LDB(B1, 1, 1); PG8_SCHED; PG8_LDA(At, 1, 0); PG8_STAGEA(PG8_SA(0, 1), a2, v2, 1);
            PG8_WAIT_V(8); PG8_WAIT_L(0); PG8_BAR; PG8_MMA(0, 0, At, B0); PG8_MMA(0, 1, At, B1); PG8_BAR; PG8_SCHED;
            PG8_LDA(At, 1, 1); PG8_STAGE(PG8_SB(1, 0), b3, voffB); PG8_STAGE(PG8_SB(1, 1), b3 + hstepB, voffB); PG8_STAGEA(PG8_SA(1, 0), a3, v2, 0);
            PG8_WAIT_V(8); PG8_WAIT_L(0); PG8_BAR; PG8_MMA(1, 0, At, B0); PG8_MMA(1, 1, At, B1); PG8_BAR; PG8_SCHED;
        }
        if (wr == 0) PG8_BAR;
        E(acc, cur, wr, wc, fr, fq);
        if (!has_next) break;
#pragma unroll
        for (int a = 0; a < 2; ++a)
#pragma unroll
            for (int b = 0; b < 2; ++b)
#pragma unroll
                for (int m = 0; m < 4; ++m)
#pragma unroll
                    for (int n = 0; n < 2; ++n) acc[a][b][m][n] = (f32x4){0.f, 0.f, 0.f, 0.f};
        cur = nxt; cB = nB; cA = nA; ++ui;
        if constexpr (GATHER) {
#pragma unroll
        for (int _i = 0; _i < 2; ++_i)
#pragma unroll
            for (int _h = 0; _h < 2; ++_h) vA[_i][_h] = vN[_i][_h];
        }
        if (wr == 1) PG8_BAR;
    }
    PG8_WAIT_V(0);
    PG8_BAR;
#undef PG8_SA
#undef PG8_SB
#undef PG8_STAGE
#undef PG8_STAGEA
#undef PG8_LDA
#undef PG8_LDB
#undef PG8_MMA
#undef PG8_WAIT_V
#undef PG8_WAIT_L
#undef PG8_BAR
#undef PG8_SCHED
#undef PG8_SETV
}
}

namespace {
struct Params {
    const float *x, *c, *w_ada, *b_ada, *g_norm1, *w_in, *b_forget, *g_q_mla, *w_q_up, *g_kv_mla, *w_kv_up, *sinks, *w_out, *g_norm2,
                *w_router, *b_router, *w_gate, *w_up, *w_down, *g_final;
    float* xo;
    bf16_t* xb;
    unsigned* ctl;
    float* mod;
    bf16_t* WinT;
    bf16_t* WoutT;
    bf16_t* WqT;
    bf16_t* WkvT;
    bf16_t* WguT;
    bf16_t* WdT;
    float* ropetab;
    float* rq; float* rkv;
    float* cbF;
    bf16_t* kidx;
    uint32_t* mask;
    bf16_t* h;
    bf16_t* proj;
    bf16_t* qm; bf16_t* km; bf16_t* vm;
    bf16_t* merged;
    bf16_t* hid;
    bf16_t* ys;
    int* list;
    float* rw;
    float* wl;
    int wid;
    int qslot;
    int qslot_host;
};
constexpr int CW_BAR = 0;
constexpr int CW_CNT = 3584;
constexpr int CW_QA = 3648;
constexpr int CW_QD = 4288;
constexpr int CW_KN2 = 4992;
constexpr int CW_QN2 = CW_KN2 + 2 * NB * 4 * 32;
constexpr int CW_WORDS = CW_QN2 + 2 * NB * 4 * 8;
}

namespace {
constexpr long P0_B1 = 2l * NP * 128, P0_B2 = P0_B1 + 2l * 1024 * 128, P0_B3 = P0_B2 + 2l * 512 * 32, P0_B4 = P0_B3 + 2l * 512 * 16,
               P0_B5 = P0_B4 + 32l * 512 * 128, P0_B6 = P0_B5 + 32l * 1024 * 32;
__device__ __forceinline__ bf16_t* p0_fetch(const Params& p, long it, float (&v)[8]) {
    if (it < P0_B1) {
        const int l = (int)(it / (NP * 128)), r = (int)(it % (NP * 128)), n = r % NP, k0 = (r / NP) * 8, o = orig_col(n);
        const float* w = p.w_in + (size_t)l * D * NIN;
#pragma unroll
        for (int j = 0; j < 8; ++j) v[j] = o >= 0 ? w[(size_t)(k0 + j) * NIN + o] : 0.f;
        return p.WinT + ((size_t)l * NP + n) * D + k0;
    } else if (it < P0_B2) {
        const long s = it - P0_B1; const int l = (int)(s / (1024 * 128)), r = (int)(s % (1024 * 128)), n = r & 1023, k0 = (r >> 10) * 8;
        const float* w = p.w_out + (size_t)l * D * D;
#pragma unroll
        for (int j = 0; j < 8; ++j) v[j] = w[(size_t)(k0 + j) * D + n];
        return p.WoutT + ((size_t)l * D + n) * D + k0;
    } else if (it < P0_B3) {
        const long s = it - P0_B2; const int l = (int)(s / (512 * 32)), r = (int)(s % (512 * 32)), n = r & 511, k0 = (r >> 9) * 8;
        const float* w = p.w_q_up + (size_t)l * 256 * 384; const float* g = p.g_q_mla + l * 256;
#pragma unroll
        for (int j = 0; j < 8; ++j) v[j] = n < 384 ? g[k0 + j] * w[(size_t)(k0 + j) * 384 + n] : 0.f;
        return p.WqT + ((size_t)l * 512 + n) * 256 + k0;
    } else if (it < P0_B4) {
        const long s = it - P0_B3; const int l = (int)(s / (512 * 16)), r = (int)(s % (512 * 16)), n = r & 511, k0 = (r >> 9) * 8;
        const float* w = p.w_kv_up + (size_t)l * 128 * 512; const float* g = p.g_kv_mla + l * 128;
#pragma unroll
        for (int j = 0; j < 8; ++j) v[j] = g[k0 + j] * w[(size_t)(k0 + j) * 512 + n];
        return p.WkvT + ((size_t)l * 512 + n) * 128 + k0;
    } else if (it < P0_B5) {
        const long s = it - P0_B4; const int le = (int)(s >> 16), r = (int)(s & 65535), n = r & 511, k0 = (r >> 9) * 8;
        const int q = n >> 5, rr = n & 31, col = 16 * q + (rr & 15);
        const float* w = (rr < 16 ? p.w_gate : p.w_up) + (size_t)le * 1024 * 256;
#pragma unroll
        for (int j = 0; j < 8; ++j) v[j] = w[(size_t)(k0 + j) * 256 + col];
        return p.WguT + ((size_t)le * 512 + n) * 1024 + k0;
    } else {
        const long s = it - P0_B5; const int le = (int)(s >> 15), r = (int)(s & 32767), n = r & 1023, k0 = (r >> 10) * 8;
        const float* w = p.w_down + (size_t)le * 256 * 1024;
#pragma unroll
        for (int j = 0; j < 8; ++j) v[j] = w[(size_t)(k0 + j) * 1024 + n];
        return p.WdT + ((size_t)le * 1024 + n) * 256 + k0;
    }
}
__device__ __forceinline__ void p0_store(bf16_t* dst, const float (&v)[8]) {
    u32x4 w; w.x = cvt_pk_bf16(v[0], v[1]); w.y = cvt_pk_bf16(v[2], v[3]); w.z = cvt_pk_bf16(v[4], v[5]); w.w = cvt_pk_bf16(v[6], v[7]);
    *(u32x4*)dst = w;
}

__device__ __forceinline__ void phase_p0(const Params& p, char* lds) {
    const int tid = opaque_tid(p.wid), gtid = blockIdx.x * blockDim.x + tid, gthreads = gridDim.x * blockDim.x;
    for (long it0 = gtid; it0 < P0_B6; it0 += 2l * gthreads) {
        float va[8], vb[8];
        const bool hb = it0 + gthreads < P0_B6;
        bf16_t* da = p0_fetch(p, it0, va);
        bf16_t* db = hb ? p0_fetch(p, it0 + gthreads, vb) : da;
        p0_store(da, va);
        if (hb) p0_store(db, vb);
    }
    for (int it = gtid; it < 2048 * 16; it += gthreads) {
        const int pos = it >> 4, i = it & 15;
        const float inv = powf(10000.0f, -(float)i / 16.0f), ang = (float)pos * inv;
        p.ropetab[it * 2] = cosf(ang); p.ropetab[it * 2 + 1] = sinf(ang);
    }
    float* ca = (float*)lds;
    for (int i = tid; i < NB * 1024; i += 512) { const float v = p.c[i]; ca[i] = v / (1.f + __expf(-v)); }
    __syncthreads();
    for (int u = blockIdx.x; u < 2 * (NMOD / 64); u += gridDim.x) {
        const int l = u / (NMOD / 64), n = (u % (NMOD / 64)) * 64 + (tid & 63), bg = tid >> 6;
        const float* w = p.w_ada + (size_t)l * 1024 * NMOD + n;
        float acc[4] = {0.f, 0.f, 0.f, 0.f};
        for (int d0 = 0; d0 < 1024; d0 += 8) {
            float wv[8];
#pragma unroll
            for (int q = 0; q < 8; ++q) wv[q] = w[(size_t)(d0 + q) * NMOD];
#pragma unroll
            for (int q = 0; q < 8; ++q)
#pragma unroll
                for (int j = 0; j < 4; ++j) acc[j] += ca[(bg * 4 + j) * 1024 + d0 + q] * wv[q];
        }
        const float bias = p.b_ada[l * NMOD + n];
#pragma unroll
        for (int j = 0; j < 4; ++j) p.mod[((size_t)l * NB + bg * 4 + j) * NMOD + n] = acc[j] + bias;
    }
    __syncthreads();
}

template <int MODE>
__device__ __forceinline__ void phase_norm1(const Params& p, int l) {
#ifndef NORM_NT
#define NORM_NT 2
#endif
    constexpr int NT = NORM_NT;
    const int tid = opaque_tid(p.wid), w = tid >> 6, lane = tid & 63;
    const float* g = (MODE == 2) ? p.g_final : p.g_norm1 + l * D;
    const float* modl = p.mod + (size_t)(MODE == 2 ? 1 : l) * NB * NMOD;
    const float* modp = p.mod + (size_t)(MODE == 2 ? 1 : (l > 0 ? l - 1 : 0)) * NB * NMOD;
    f32x4 gg4[4];
#pragma unroll
    for (int k = 0; k < 4; ++k) gg4[k] = *(const f32x4*)(g + 4 * lane + 256 * k);
    for (int t0 = (blockIdx.x * 8 + w) * NT; t0 < T; t0 += gridDim.x * 8 * NT) {
        const int b0 = t0 >> 11;
        f32x4 sc4[4], sh4[4], gt4[4];
        if (MODE != 2) {
#pragma unroll
            for (int k = 0; k < 4; ++k) { sc4[k] = *(const f32x4*)(modl + (size_t)b0 * NMOD + 1024 + 4 * lane + 256 * k); sh4[k] = *(const f32x4*)(modl + (size_t)b0 * NMOD + 4 * lane + 256 * k); }
        }
        if (MODE >= 1) {
#pragma unroll
            for (int k = 0; k < 4; ++k) gt4[k] = *(const f32x4*)(modp + (size_t)b0 * NMOD + 5 * 1024 + 4 * lane + 256 * k);
        }
        f32x4 v[NT][4];
#pragma unroll
        for (int u = 0; u < NT; ++u)
#pragma unroll
            for (int k = 0; k < 4; ++k) {
                if (MODE == 0) v[u][k] = *(const f32x4*)(p.x + (size_t)(t0 + u) * D + 4 * lane + 256 * k);
                else { const u32x2 w2 = *(const u32x2*)(p.xb + (size_t)(t0 + u) * D + 4 * lane + 256 * k); v[u][k] = (f32x4){bflo(w2.x), bfhi(w2.x), bflo(w2.y), bfhi(w2.y)}; }
            }
        if (MODE >= 1) {
            u32x2 y0[NT][4], y1[NT][4];
#pragma unroll
            for (int u = 0; u < NT; ++u)
#pragma unroll
                for (int k = 0; k < 4; ++k) { const int col = 4 * lane + 256 * k;
                    y0[u][k] = *(const u32x2*)(p.ys + ((size_t)(t0 + u) * 2 + 0) * D + col); y1[u][k] = *(const u32x2*)(p.ys + ((size_t)(t0 + u) * 2 + 1) * D + col); }
#pragma unroll
            for (int u = 0; u < NT; ++u) {
                const int b = (t0 + u) >> 11;
#pragma unroll
                for (int k = 0; k < 4; ++k) {
                    const int col = 4 * lane + 256 * k;
                    const f32x4 gt = gt4[k];
                    v[u][k][0] += gt[0] * (bflo(y0[u][k].x) + bflo(y1[u][k].x)); v[u][k][1] += gt[1] * (bfhi(y0[u][k].x) + bfhi(y1[u][k].x));
                    v[u][k][2] += gt[2] * (bflo(y0[u][k].y) + bflo(y1[u][k].y)); v[u][k][3] += gt[3] * (bfhi(y0[u][k].y) + bfhi(y1[u][k].y));
                }
            }
        }
#pragma unroll
        for (int u = 0; u < NT; ++u) {
            const int t = t0 + u, b = t >> 11;
            float ss = 0.f;
#pragma unroll
            for (int k = 0; k < 4; ++k) ss += v[u][k][0] * v[u][k][0] + v[u][k][1] * v[u][k][1] + v[u][k][2] * v[u][k][2] + v[u][k][3] * v[u][k][3];
            ss = wave_sum(ss);
            const float r = rsqrtf(ss * (1.0f / D) + EPS);
#pragma unroll
            for (int k = 0; k < 4; ++k) {
                const int col = 4 * lane + 256 * k;
                f32x4 y = v[u][k] * r * gg4[k];
                if (MODE == 2) { *(f32x4*)(p.xo + (size_t)t * D + col) = y; }
                else {
                    if (MODE == 1) { u32x2 xw; xw.x = cvt_pk_bf16(v[u][k][0], v[u][k][1]); xw.y = cvt_pk_bf16(v[u][k][2], v[u][k][3]); *(u32x2*)(p.xb + (size_t)t * D + col) = xw; }
                    y = y * (1.f + sc4[k]) + sh4[k];
                    u32x2 o; o.x = cvt_pk_bf16(y[0], y[1]); o.y = cvt_pk_bf16(y[2], y[3]);
                    *(u32x2*)(p.h + (size_t)t * D + col) = o;
                }
            }
        }
    }
}
}

namespace {
using pg8::Unit;
struct EpiStoreBf16 {
    static constexpr bool PERM = true;
    bf16_t* O; int ldc;
    __device__ __forceinline__ void operator()(const f32x4 (&acc)[2][2][4][2], const Unit& u, int wr, int wc, int fr_, int fq_) const {
        int fr = fr_, fq = fq_; asm volatile("" : "+v"(fr), "+v"(fq));
        const int row0 = u.pm * 256 + wr * 64 + fr, col0 = u.pn * 256 + wc * 32 + 8 * fq;
#pragma unroll
        for (int ai = 0; ai < 2; ++ai)
#pragma unroll
            for (int m = 0; m < 4; ++m) { bf16_t* rowp = O + (size_t)(row0 + ai * 128 + m * 16) * ldc + col0;
#pragma unroll
                for (int bj = 0; bj < 2; ++bj) { const f32x4 v0 = acc[ai][bj][m][0], v1 = acc[ai][bj][m][1];
                    u32x4 w; w.x = cvt_pk_bf16(v0[0], v0[1]); w.y = cvt_pk_bf16(v0[2], v0[3]); w.z = cvt_pk_bf16(v1[0], v1[1]); w.w = cvt_pk_bf16(v1[2], v1[3]);
                    *(u32x4*)(rowp + bj * 128) = w; } }
    }
};
struct EpiResidual {
    static constexpr bool PERM = false;
    const float* xin32; bf16_t* xb; const float* gate;
    __device__ __forceinline__ void operator()(const f32x4 (&acc)[2][2][4][2], const Unit& u, int wr, int wc, int fr_, int fq_) const {
        int fr = fr_, fq = fq_; asm volatile("" : "+v"(fr), "+v"(fq));
        const int row0 = u.pm * 256 + wr * 64 + fr, col0 = u.pn * 256 + wc * 32 + 4 * fq;
        const int b = (u.pm * 256) >> 11;
        f32x4 gv[2][2];
#pragma unroll
        for (int bj = 0; bj < 2; ++bj)
#pragma unroll
            for (int n = 0; n < 2; ++n) gv[bj][n] = *(const f32x4*)(gate + (size_t)b * NMOD + col0 + bj * 128 + n * 16);
#pragma unroll
        for (int ai = 0; ai < 2; ++ai)
#pragma unroll
            for (int m = 0; m < 4; ++m) { const size_t ro = (size_t)(row0 + ai * 128 + m * 16) * D + col0;
#pragma unroll
                for (int bj = 0; bj < 2; ++bj)
#pragma unroll
                    for (int n = 0; n < 2; ++n) { const size_t o = ro + bj * 128 + n * 16;
                        f32x4 xv;
                        if (xin32) xv = *(const f32x4*)(xin32 + o);
                        else { const u32x2 w = *(const u32x2*)(xb + o); xv = (f32x4){bflo(w.x), bfhi(w.x), bflo(w.y), bfhi(w.y)}; }
                        const f32x4 r = xv + gv[bj][n] * acc[ai][bj][m][n];
                        u32x2 ow; ow.x = cvt_pk_bf16(r[0], r[1]); ow.y = cvt_pk_bf16(r[2], r[3]);
                        *(u32x2*)(xb + o) = ow; } }
    }
};
struct EpiMlaQ {
    static constexpr bool PERM = true;
    bf16_t* qm;
    __device__ __forceinline__ void operator()(const f32x4 (&acc)[2][2][4][2], const Unit& u, int wr, int wc, int fr_, int fq_) const {
        int fr = fr_, fq = fq_; asm volatile("" : "+v"(fr), "+v"(fq));
        const int row0 = u.pm * 256 + wr * 64 + fr;
#pragma unroll
        for (int bj = 0; bj < 2; ++bj) {
            const int col0 = u.pn * 256 + bj * 128 + wc * 32;
            if (col0 >= 384) continue;
#pragma unroll
            for (int ai = 0; ai < 2; ++ai)
#pragma unroll
                for (int m = 0; m < 4; ++m) { const f32x4 v0 = acc[ai][bj][m][0], v1 = acc[ai][bj][m][1];
                    u32x4 w; w.x = cvt_pk_bf16(v0[0], v0[1]); w.y = cvt_pk_bf16(v0[2], v0[3]); w.z = cvt_pk_bf16(v1[0], v1[1]); w.w = cvt_pk_bf16(v1[2], v1[3]);
                    *(u32x4*)(qm + (size_t)(row0 + ai * 128 + m * 16) * 384 + col0 + 8 * fq) = w; }
        }
    }
};
struct EpiMlaKV {
    static constexpr bool PERM = true;
    bf16_t* km; bf16_t* vm;
    __device__ __forceinline__ void operator()(const f32x4 (&acc)[2][2][4][2], const Unit& u, int wr, int wc, int fr_, int fq_) const {
        int fr = fr_, fq = fq_; asm volatile("" : "+v"(fr), "+v"(fq));
        const int row0 = u.pm * 256 + wr * 64 + fr;
#pragma unroll
        for (int bj = 0; bj < 2; ++bj) {
            const int head = u.pn * 2 + bj, wcol = wc * 32 + 8 * fq;
#pragma unroll
            for (int ai = 0; ai < 2; ++ai)
#pragma unroll
                for (int m = 0; m < 4; ++m) {
                    const int row = row0 + ai * 128 + m * 16;
                    const f32x4 v0 = acc[ai][bj][m][0], v1 = acc[ai][bj][m][1];
                    u32x4 w; w.x = cvt_pk_bf16(v0[0], v0[1]); w.y = cvt_pk_bf16(v0[2], v0[3]); w.z = cvt_pk_bf16(v1[0], v1[1]); w.w = cvt_pk_bf16(v1[2], v1[3]);
                    bf16_t* q = (wcol < 64) ? km + (size_t)row * 384 + head * 96 + wcol : vm + (size_t)row * 256 + head * 64 + (wcol - 64);
                    *(u32x4*)q = w;
                    asm volatile("" ::: "memory");
                }
        }
    }
};
struct EpiGateUp {
    static constexpr bool PERM = false;
    bf16_t* hid;
    __device__ __forceinline__ void operator()(const f32x4 (&acc)[2][2][4][2], const Unit& u, int wr, int wc, int fr_, int fq_) const {
        int fr = fr_, fq = fq_; asm volatile("" : "+v"(fr), "+v"(fq));
        const int row0 = u.pm * 256 + wr * 64 + fr;
#pragma unroll
        for (int ai = 0; ai < 2; ++ai)
#pragma unroll
            for (int m = 0; m < 4; ++m) { bf16_t* rowp = hid + (size_t)(row0 + ai * 128 + m * 16) * 256;
#pragma unroll
                for (int bj = 0; bj < 2; ++bj) { const f32x4 gt = acc[ai][bj][m][0], up = acc[ai][bj][m][1];
                    f32x4 o;
#pragma unroll
                    for (int j = 0; j < 4; ++j) o[j] = gt[j] / (1.f + __expf(-gt[j])) * up[j];
                    u32x2 w; w.x = cvt_pk_bf16(o[0], o[1]); w.y = cvt_pk_bf16(o[2], o[3]);
                    *(u32x2*)(rowp + 16 * (u.pn * 8 + bj * 4 + wc) + 4 * fq) = w; } }
    }
};
struct EpiDown {
    static constexpr bool PERM = true;
    bf16_t* ys; const int* list; const float* wl; const int* cnt;
    __device__ __forceinline__ void operator()(const f32x4 (&acc)[2][2][4][2], const Unit& u, int wr, int wc, int fr_, int fq_) const {
        int fr = fr_, fq = fq_; asm volatile("" : "+v"(fr), "+v"(fq));
        const int n = cnt[u.e]; const int* le = list + (size_t)u.e * ECAP; const float* we = wl + (size_t)u.e * ECAP;
        const int col0 = u.pn * 256 + wc * 32 + 8 * fq;
        int slot[8]; float w8[8];
#pragma unroll
        for (int q = 0; q < 8; ++q) { const int lr = u.mt * 256 + (q >> 2) * 128 + wr * 64 + (q & 3) * 16 + fr; slot[q] = lr < n ? le[lr] : -1; w8[q] = lr < n ? we[lr] : 0.f; }
#pragma unroll
        for (int ai = 0; ai < 2; ++ai)
#pragma unroll
            for (int m = 0; m < 4; ++m) {
                const int q = ai * 4 + m;
                if (slot[q] >= 0) {
                    bf16_t* rowp = ys + (size_t)slot[q] * D + col0;
#pragma unroll
                    for (int bj = 0; bj < 2; ++bj) { const f32x4 v0 = acc[ai][bj][m][0] * w8[q], v1 = acc[ai][bj][m][1] * w8[q];
                        u32x4 w; w.x = cvt_pk_bf16(v0[0], v0[1]); w.y = cvt_pk_bf16(v0[2], v0[3]); w.z = cvt_pk_bf16(v1[0], v1[1]); w.w = cvt_pk_bf16(v1[2], v1[3]);
                        *(u32x4*)(rowp + bj * 128) = w; }
                }
            }
    }
};
struct MoeOrder {
    int pre[17];
    int NT, G, c; const int* list; const int* cnt;
    __device__ __forceinline__ void init(const int* cnt_, const int* list_, int NT_, int G_, int c_) {
        cnt = cnt_; list = list_; NT = NT_; G = G_; c = c_; int a = 0;
#pragma unroll
        for (int e = 0; e < 16; ++e) { pre[e] = a; a += (cnt_[e] + 255) >> 8; }
        pre[16] = a;
    }
    __device__ __forceinline__ bool next(int i, Unit& u) const {
        const int L = i * G + c; if (L >= pre[16] * NT) return false;
        const int t = L / NT; int e = 0;
#pragma unroll
        for (int k = 1; k < 16; ++k) e += (t >= pre[k]) ? 1 : 0;
        int pe = 0;
#pragma unroll
        for (int k = 0; k < 16; ++k) pe = (k == e) ? pre[k] : pe;
        u.e = e; u.mt = t - pe; u.pm = t; u.pn = L - t * NT; return true;
    }
    __device__ __forceinline__ int arow(const Unit& u, int r) const { const int lr = u.mt * 256 + r; return lr < cnt[u.e] ? (list[(size_t)u.e * ECAP + lr] >> 1) : 0; }
};
}

namespace {
__device__ __forceinline__ void phase_prep(const Params& p, int l) {
    const int tid = opaque_tid(p.wid), w = tid >> 6, lane = tid & 63;
    const int gw = blockIdx.x * 8 + w, nw = gridDim.x * 8;
    for (int sq = gw; sq < NB * 4; sq += nw) {
        const int b = sq >> 2, hh = sq & 3; const float bias = p.b_forget[l * 4 + hh];
        float lf[32]; float run = 0.f;
#pragma unroll
        for (int j = 0; j < 32; ++j) {
            const float z = bf2f(p.proj[(size_t)(b * S + lane * 32 + j) * NP + PC_AF + hh]) + bias;
            run += fminf(z, 0.f) - log1pf(__expf(-fabsf(z)));
            lf[j] = run;
        }
        float incl = run;
#pragma unroll
        for (int o = 1; o < 64; o <<= 1) { const float t2 = __shfl_up(incl, o); if (lane >= o) incl += t2; }
        const float excl = incl - run;
#pragma unroll
        for (int j = 0; j < 32; ++j) p.cbF[(size_t)sq * S + lane * 32 + j] = -(excl + lf[j]) * LOG2E;
    }
    for (int c32 = gw; c32 < T / 32; c32 += nw) {
    float mxq = 0.f, mxk = 0.f;
#define PREP_LOAD(tt) do { const bf16_t* _row = p.proj + (size_t)(tt) * NP; \
        n_cq = *(const u32x2*)(_row + PC_BCQ + 4 * lane); n_ck = *(const unsigned*)(_row + PC_BCKV + 2 * lane); \
        n_aq = *(const u32x2*)(_row + PC_AQ + 4 * lane); n_ak = *(const u32x2*)(_row + PC_AK + 4 * lane); \
        n_ki = *(const u32x4*)(_row + PC_DKI + 8 * (lane & 3)); n_kr = _row[PC_BKR + (lane & 31)]; } while (0)
    u32x2 n_cq, n_aq, n_ak; unsigned n_ck; u32x4 n_ki; bf16_t n_kr;
    PREP_LOAD(c32 * 32);
    for (int it = 0; it < 32; ++it) {
        const int t = c32 * 32 + it;
        const u32x2 cq = n_cq, aq = n_aq, ak = n_ak; const unsigned ck = n_ck; const u32x4 ki = n_ki; const bf16_t krb = n_kr;
        if (it < 31) PREP_LOAD(t + 1);
        float s1 = bflo(cq.x) * bflo(cq.x) + bfhi(cq.x) * bfhi(cq.x) + bflo(cq.y) * bflo(cq.y) + bfhi(cq.y) * bfhi(cq.y);
        float s2 = bflo(ck) * bflo(ck) + bfhi(ck) * bfhi(ck);
        s1 = wave_sum(s1); s2 = wave_sum(s2);
        if (lane < 4) *(u32x4*)(p.kidx + (size_t)t * 32 + 8 * lane) = ki;
        {
            float nq = bflo(aq.x) * bflo(aq.x) + bfhi(aq.x) * bfhi(aq.x) + bflo(aq.y) * bflo(aq.y) + bfhi(aq.y) * bfhi(aq.y);
            float nk = bflo(ak.x) * bflo(ak.x) + bfhi(ak.x) * bfhi(ak.x) + bflo(ak.y) * bflo(ak.y) + bfhi(ak.y) * bfhi(ak.y);
#pragma unroll
            for (int o = 8; o > 0; o >>= 1) { nq += __shfl_xor(nq, o); nk += __shfl_xor(nk, o); }
            mxq = fmaxf(mxq, nq); mxk = fmaxf(mxk, nk);
        }
        const float kr = (lane < 32) ? bf2f(krb) : 0.f;
        const float kr2 = __shfl(kr, (lane + 16) & 63);
        {
            const float r1 = rsqrtf(s1 * (1.f / 256.f) + EPS), r2 = rsqrtf(s2 * (1.f / 128.f) + EPS);
            u32x2 o; o.x = cvt_pk_bf16(bflo(cq.x) * r1, bfhi(cq.x) * r1); o.y = cvt_pk_bf16(bflo(cq.y) * r1, bfhi(cq.y) * r1);
            *(u32x2*)(p.proj + (size_t)t * NP + PC_BCQ + 4 * lane) = o;
            *(unsigned*)(p.proj + (size_t)t * NP + PC_BCKV + 2 * lane) = cvt_pk_bf16(bflo(ck) * r2, bfhi(ck) * r2);
        }
        if (lane < 16) {
            const int pos = t & (S - 1);
            const float cs = p.ropetab[(pos * 16 + lane) * 2], sn = p.ropetab[(pos * 16 + lane) * 2 + 1];
            const bf16_t o1 = f2bf(kr * cs - kr2 * sn), o2 = f2bf(kr2 * cs + kr * sn);
            bf16_t* kmr = p.km + (size_t)t * 384;
#pragma unroll
            for (int hh = 0; hh < 4; ++hh) { kmr[hh * 96 + 64 + lane] = o1; kmr[hh * 96 + 80 + lane] = o2; }
        }
    }
#undef PREP_LOAD
    if ((lane & 15) == 0) {
        const int t = c32 * 32, bb = t >> 11, pos = t & (S - 1), hh = lane >> 4;
        atomicMax(p.ctl + CW_KN2 + ((l * NB + bb) * 4 + hh) * 32 + (pos >> 6), __float_as_uint(mxk));
        atomicMax(p.ctl + CW_QN2 + ((l * NB + bb) * 4 + hh) * 8 + (pos >> 8), __float_as_uint(mxq));
    }
    }
}

__device__ __forceinline__ void phase_route(const Params& p, int l, char* lds) {
    const int tid = opaque_tid(p.wid), w = tid >> 6, lane = tid & 63;
    float* wrT = (float*)lds;
    int* lcnt = (int*)(lds + 65536);
    int* lbase = (int*)(lds + 65536 + 64);
    int* tsel = (int*)(lds + 65536 + 128);
    float* twt = (float*)(lds + 65536 + 128 + 2048);
    for (int i = tid; i < 16 * 1024; i += 512) { const int e = i >> 10, d = i & 1023; wrT[i] = p.w_router[d * 16 + e]; }
    const float* g = p.g_norm2 + l * D;
    const float* modl = p.mod + (size_t)l * NB * NMOD;
    int* cnt = (int*)(p.ctl + CW_CNT) + l * 16 + 32 * p.qslot;
    int* list = p.list + (size_t)p.qslot * 16 * ECAP;
    for (int chunk = blockIdx.x; chunk < T / 256; chunk += gridDim.x) {
        if (tid < 16) lcnt[tid] = 0;
        __syncthreads();
        const int b = (chunk * 256) >> 11;
        f32x4 gg4[4], sc4[4], sh4[4];
#pragma unroll
        for (int k = 0; k < 4; ++k) { const int col = 4 * lane + 256 * k; gg4[k] = *(const f32x4*)(g + col);
            sc4[k] = *(const f32x4*)(modl + (size_t)b * NMOD + 4 * 1024 + col); sh4[k] = *(const f32x4*)(modl + (size_t)b * NMOD + 3 * 1024 + col); }
        const int eown = ((lane >> 5) & 1) * 8 + ((lane >> 4) & 1) * 4 + ((lane >> 3) & 1) * 2 + ((lane >> 2) & 1);
        const float brown = p.b_router[eown];
        f32x4 vn[4];
#pragma unroll
        for (int k = 0; k < 4; ++k) { const u32x2 w2 = *(const u32x2*)(p.xb + (size_t)(chunk * 256 + w * 32) * D + 4 * lane + 256 * k); vn[k] = (f32x4){bflo(w2.x), bfhi(w2.x), bflo(w2.y), bfhi(w2.y)}; }
        for (int it = 0; it < 32; ++it) {
            const int li = w * 32 + it, t = chunk * 256 + li;
            f32x4 v[4];
#pragma unroll
            for (int k = 0; k < 4; ++k) v[k] = vn[k];
            if (it < 31) {
#pragma unroll
                for (int k = 0; k < 4; ++k) { const u32x2 w2 = *(const u32x2*)(p.xb + (size_t)(t + 1) * D + 4 * lane + 256 * k); vn[k] = (f32x4){bflo(w2.x), bfhi(w2.x), bflo(w2.y), bfhi(w2.y)}; }
            }
            float ss = 0.f;
#pragma unroll
            for (int k = 0; k < 4; ++k) ss += v[k][0] * v[k][0] + v[k][1] * v[k][1] + v[k][2] * v[k][2] + v[k][3] * v[k][3];
            ss = wave_sum(ss);
            const float r = rsqrtf(ss * (1.0f / D) + EPS);
            float lg[16];
#pragma unroll
            for (int e = 0; e < 16; ++e) lg[e] = 0.f;
#pragma unroll
            for (int k = 0; k < 4; ++k) {
                const int col = 4 * lane + 256 * k;
                const f32x4 y = v[k] * r * gg4[k] * (1.f + sc4[k]) + sh4[k];
                u32x2 o; o.x = cvt_pk_bf16(y[0], y[1]); o.y = cvt_pk_bf16(y[2], y[3]);
                *(u32x2*)(p.h + (size_t)t * D + col) = o;
#pragma unroll
                for (int e = 0; e < 16; ++e) { const f32x4 wv = *(const f32x4*)(wrT + e * 1024 + col); lg[e] += y[0] * wv[0] + y[1] * wv[1] + y[2] * wv[2] + y[3] * wv[3]; }
                asm volatile("" ::: "memory");
            }
            float a8[8], a4[4], a2[2], a1;
            { const bool hi = (lane & 32) != 0;
#pragma unroll
              for (int e = 0; e < 8; ++e) { const float send = hi ? lg[e] : lg[e + 8], keep = hi ? lg[e + 8] : lg[e]; a8[e] = keep + __shfl_xor(send, 32); } }
            { const bool hi = (lane & 16) != 0;
#pragma unroll
              for (int e = 0; e < 4; ++e) { const float send = hi ? a8[e] : a8[e + 4], keep = hi ? a8[e + 4] : a8[e]; a4[e] = keep + __shfl_xor(send, 16); } }
            { const bool hi = (lane & 8) != 0;
#pragma unroll
              for (int e = 0; e < 2; ++e) { const float send = hi ? a4[e] : a4[e + 2], keep = hi ? a4[e + 2] : a4[e]; a2[e] = keep + __shfl_xor(send, 8); } }
            { const bool hi = (lane & 4) != 0; const float send = hi ? a2[0] : a2[1], keep = hi ? a2[1] : a2[0]; a1 = keep + __shfl_xor(send, 4); }
            a1 += __shfl_xor(a1, 2); a1 += __shfl_xor(a1, 1);
            const float sown = 1.f / (1.f + expf(-a1)), bown = sown + brown;
            float sc[16], bi[16];
#pragma unroll
            for (int e = 0; e < 16; ++e) { const int src = ((e >> 3) & 1) * 32 + ((e >> 2) & 1) * 16 + ((e >> 1) & 1) * 8 + (e & 1) * 4;
                sc[e] = __builtin_bit_cast(float, __builtin_amdgcn_readlane(__builtin_bit_cast(int, sown), src));
                bi[e] = __builtin_bit_cast(float, __builtin_amdgcn_readlane(__builtin_bit_cast(int, bown), src)); }
            int bg = 0; float bgs = -INFINITY;
#pragma unroll
            for (int gi = 0; gi < 4; ++gi) {
                float m1 = -INFINITY, m2 = -INFINITY;
#pragma unroll
                for (int j = 0; j < 4; ++j) { const float vv = bi[gi * 4 + j]; if (vv > m1) { m2 = m1; m1 = vv; } else if (vv > m2) m2 = vv; }
                const float gs = m1 + m2; if (gs > bgs) { bgs = gs; bg = gi; }
            }
            float b4[4], s4[4];
#pragma unroll
            for (int gi = 0; gi < 4; ++gi)
#pragma unroll
                for (int j = 0; j < 4; ++j) if (gi == bg) { b4[j] = bi[gi * 4 + j]; s4[j] = sc[gi * 4 + j]; }
            int i1 = 0; float v1 = -INFINITY;
#pragma unroll
            for (int j = 0; j < 4; ++j) { if (b4[j] > v1) { v1 = b4[j]; i1 = j; } }
            int i2 = 0; float v2 = -INFINITY;
#pragma unroll
            for (int j = 0; j < 4; ++j) { if (j != i1 && b4[j] > v2) { v2 = b4[j]; i2 = j; } }
            float w1 = 0.f, w2 = 0.f;
#pragma unroll
            for (int j = 0; j < 4; ++j) { if (j == i1) w1 = s4[j]; if (j == i2) w2 = s4[j]; }
            if (lane == 0) {
                const int e1 = bg * 4 + i1, e2 = bg * 4 + i2; const float ws = w1 + w2;
                const int r1 = atomicAdd(&lcnt[e1], 1), r2 = atomicAdd(&lcnt[e2], 1);
                tsel[li * 2 + 0] = (e1 << 16) | r1; tsel[li * 2 + 1] = (e2 << 16) | r2;
                twt[li * 2 + 0] = w1 / ws; twt[li * 2 + 1] = w2 / ws;
            }
        }
        __syncthreads();
        if (tid < 16) lbase[tid] = atomicAdd(&cnt[tid], lcnt[tid]);
        __syncthreads();
        { const int v = tsel[tid], e = v >> 16, rk = v & 0xFFFF; const size_t pos = (size_t)e * ECAP + lbase[e] + rk;
          list[pos] = (chunk * 256 + (tid >> 1)) * 2 + (tid & 1); p.wl[pos + (size_t)p.qslot * 16 * ECAP] = twt[tid]; }
        __syncthreads();
    }
}
}

#ifndef ATTN_VMASK
#define ATTN_VMASK 15
#endif
#ifndef REPK_VMASK
#define REPK_VMASK 15
#endif
#ifndef ATTN_EXP
#define ATTN_EXP 0
#endif
#define AEXP(k) (ATTN_EXP == (k) && xq)
namespace {
constexpr int AT_KB = 0;
constexpr int AT_KR = 16384;
constexpr int AT_VB = 24576;
constexpr int AT_CB = 40960;
constexpr int AT_CTL = 41472;
constexpr int AT_LDS = 41984;
constexpr float NEGBIG = -1.0e30f;

template <int VAR, int KC>
__device__ __forceinline__ void attn_tile(LAS3 char* lds, const int buf, const int j, const int q0, const int i, const int g, const int swk, const float slope2,
                                          const bf16x8 (&qf)[2][KC], f32x4 (&o)[2][4], float (&mrow)[2], float (&lsum)[2], const u32x2 (&mw)[2], const bool xq) {
    typedef LAS3 bf16x4 lds_bf16x4;
    bool need = (64 * j <= q0 + 31);
    if (VAR == 2) need = need && (64 * j + 63 >= q0 - 127);
    if (need) {
        const LAS3 char* Kb = lds + AT_KB + buf * 8192; const LAS3 char* Vb = lds + AT_VB + buf * 8192;
        bool full = (64 * j + 63 <= q0);
        if (VAR == 2) full = full && (64 * j >= q0 - 96);
        if (VAR == 3) full = false;
        f32x4 s[2][4];
#pragma unroll
        for (int qt = 0; qt < 2; ++qt) {
            const int t = q0 + 16 * qt + i;
            const int dbase = 64 * j + 4 * g - t;
            const float sb = slope2 * ((VAR == 2) ? (float)dbase : (float)(64 * j + 4 * g));
            unsigned wl = 0u, wh = 0u;
            if (VAR == 3) { const unsigned long long W = (((unsigned long long)mw[qt].y << 32) | mw[qt].x) >> (4 * g); wl = (unsigned)W; wh = (unsigned)(W >> 32); }
#pragma unroll
            for (int mt = 0; mt < 4; ++mt) {
                f32x4 ini = {0.f, 0.f, 0.f, 0.f};
                if (VAR == 0) ini = *(const LAS3 f32x4*)(lds + AT_CB + buf * 256 + (16 * mt + 4 * g) * 4);
#pragma unroll
                for (int r = 0; r < 4; ++r) {
                    const int c = 16 * mt + r;
                    float v = ini[r];
                    if (VAR >= 2) v = sb + slope2 * (float)c;
                    if (VAR == 3) {
                        const int m = ((int)((mt < 2 ? wl : wh) << (31 - (16 * (mt & 1) + r)))) >> 31;
                        v = __uint_as_float((__float_as_uint(v) & (unsigned)m) | (__float_as_uint(NEGBIG) & ~(unsigned)m));
                    } else if (!full) {
                        bool ok;
                        if (VAR == 2) ok = (unsigned)(dbase + c + 127) < 128u;
                        else ok = (dbase + c) <= 0;
                        v = ok ? v : NEGBIG;
                    }
                    ini[r] = v;
                }
                s[qt][mt] = ini;
            }
        }
        if (!AEXP(2))
#pragma unroll
        for (int mt = 0; mt < 4; ++mt) {
#pragma unroll
            for (int kc = 0; kc < 2; ++kc) {
                const bf16x8 kf = *(const LAS3 bf16x8*)(Kb + (mt * 16 + i) * 128 + (((kc * 4 + g) ^ swk) << 4));
                s[0][mt] = __builtin_amdgcn_mfma_f32_16x16x32_bf16(kf, qf[0][kc], s[0][mt], 0, 0, 0);
                s[1][mt] = __builtin_amdgcn_mfma_f32_16x16x32_bf16(kf, qf[1][kc], s[1][mt], 0, 0, 0);
            }
            if (VAR == 1) {
                const bf16x8 kf = *(const LAS3 bf16x8*)(lds + AT_KR + buf * 4096 + (mt * 16 + i) * 64 + ((g ^ (swk & 3)) << 4));
                s[0][mt] = __builtin_amdgcn_mfma_f32_16x16x32_bf16(kf, qf[0][KC - 1], s[0][mt], 0, 0, 0);
                s[1][mt] = __builtin_amdgcn_mfma_f32_16x16x32_bf16(kf, qf[1][KC - 1], s[1][mt], 0, 0, 0);
            }
        }
        bf16x8 pf[2][2];
#pragma unroll
        for (int qt = 0; qt < 2; ++qt) {
            float mx = fmaxf(fmaxf(s[qt][0][0], s[qt][0][1]), fmaxf(s[qt][0][2], s[qt][0][3]));
#pragma unroll
            for (int mt = 1; mt < 4; ++mt) mx = fmaxf(mx, fmaxf(fmaxf(s[qt][mt][0], s[qt][mt][1]), fmaxf(s[qt][mt][2], s[qt][mt][3])));
            mx = fmaxf(mx, __builtin_bit_cast(float, __builtin_amdgcn_ds_swizzle(__builtin_bit_cast(int, mx), 0x401F)));
            mx = xor32_max(mx);
            if (__any(mx > mrow[qt])) {
                const float mn = fmaxf(mrow[qt], mx), alpha = __builtin_amdgcn_exp2f(mrow[qt] - mn);
                mrow[qt] = mn; lsum[qt] *= alpha;
#pragma unroll
                for (int dt = 0; dt < 4; ++dt) o[qt][dt] = o[qt][dt] * alpha;
            }
            const float mn = mrow[qt];
            const f32x4 mn4 = {mn, mn, mn, mn};
            f32x4 ps4 = {0.f, 0.f, 0.f, 0.f};
            float x[4][4];
#pragma unroll
            for (int mt = 0; mt < 4; ++mt) {
                const f32x4 d4 = s[qt][mt] - mn4;
                f32x4 e4;
#pragma unroll
                for (int r = 0; r < 4; ++r) { e4[r] = AEXP(3) ? d4[r] : __builtin_amdgcn_exp2f(d4[r]); x[mt][r] = e4[r]; }
                ps4 += e4;
            }
            lsum[qt] += (ps4[0] + ps4[1]) + (ps4[2] + ps4[3]);
#pragma unroll
            for (int c = 0; c < 2; ++c) {
                u32x4 pk; pk.x = cvt_pk_bf16(x[2 * c][0], x[2 * c][1]); pk.y = cvt_pk_bf16(x[2 * c][2], x[2 * c][3]);
                pk.z = cvt_pk_bf16(x[2 * c + 1][0], x[2 * c + 1][1]); pk.w = cvt_pk_bf16(x[2 * c + 1][2], x[2 * c + 1][3]);
                pf[qt][c] = __builtin_bit_cast(bf16x8, pk);
            }
        }
        const int q4 = i >> 2, p4 = i & 3;
        if (!AEXP(4))
#pragma unroll
        for (int c = 0; c < 2; ++c) {
            const int row0 = 32 * c + 4 * g + q4, swv = (row0 >> 1) & 3;
#pragma unroll
            for (int dt = 0; dt < 4; ++dt) {
                const LAS3 char* a0 = Vb + row0 * 128 + ((dt ^ swv) << 5) + p4 * 8;
                const bf16x4 v0 = __builtin_amdgcn_ds_read_tr16_b64_v4i16((lds_bf16x4*)(a0));
                const bf16x4 v1 = __builtin_amdgcn_ds_read_tr16_b64_v4i16((lds_bf16x4*)(a0 + 16 * 128));
                const bf16x8 vf = {v0[0], v0[1], v0[2], v0[3], v1[0], v1[1], v1[2], v1[3]};
                o[0][dt] = __builtin_amdgcn_mfma_f32_16x16x32_bf16(vf, pf[0][c], o[0][dt], 0, 0, 0);
                o[1][dt] = __builtin_amdgcn_mfma_f32_16x16x32_bf16(vf, pf[1][c], o[1][dt], 0, 0, 0);
            }
        }
    }
}

template <int VAR>
__device__ __forceinline__ void attn_unit(const Params& p, int l, int b, int hx, int qb, LAS3 char* lds) {
    typedef LAS3 bf16x4 lds_bf16x4;
    constexpr int KC = (VAR == 1) ? 3 : 2;
    const int tid = opaque_tid(p.wid), w = __builtin_amdgcn_readfirstlane(tid >> 6), lane = tid & 63, i = lane & 15, g = lane >> 4;
    const bf16_t *Qp, *Kp, *Vp; int ldq, ldk, ldv, q0, j0, j1, ocol; float c1, slope2 = 0.f;
    if (VAR == 0) { Qp = p.proj + PC_AQ + hx * 64; Kp = p.proj + PC_AK + hx * 64; Vp = p.proj + PC_AV + hx * 64; ldq = ldk = ldv = NP;
                    q0 = qb * 256 + 32 * w; j0 = 0; j1 = 4 * qb + 3; ocol = hx * 64; c1 = 0.125f * LOG2E; }
    else if (VAR == 1) { Qp = p.qm + hx * 96; Kp = p.km + hx * 96; Vp = p.vm + hx * 64; ldq = 384; ldk = 384; ldv = 256;
                    q0 = qb * 256 + 32 * w; j0 = 0; j1 = 4 * qb + 3; ocol = 256 + hx * 64; c1 = 0.10206207261596577f * LOG2E; }
    else if (VAR == 2) { const int qh = hx * 2 + (w >> 2); Qp = p.proj + PC_CQ + qh * 64; Kp = p.proj + PC_CK + hx * 64; Vp = p.proj + PC_CV + hx * 64; ldq = ldk = ldv = NP;
                    q0 = qb * 128 + 32 * (w & 3); j0 = 2 * qb - 2 > 0 ? 2 * qb - 2 : 0; j1 = 2 * qb + 1; ocol = 512 + qh * 64; c1 = 0.125f * LOG2E;
                    slope2 = exp2f(-(float)(qh + 1)) * LOG2E; }
    else { const int hd = w >> 1; Qp = p.proj + PC_DQ + hd * 64; Kp = p.proj + PC_DK; Vp = p.proj + PC_DV; ldq = ldk = ldv = NP;
                    q0 = qb * 64 + 32 * (w & 1); j0 = 0; j1 = qb; ocol = 768 + hd * 64; c1 = 0.125f * LOG2E; slope2 = exp2f(-(float)(hd + 5)) * LOG2E; }
    const size_t tok0 = (size_t)b * S;
    const bool xq = p.qslot > 0;
    if (VAR == 0 && qb > 0) {
        constexpr float FOX_DROP = 64.0f;
        const unsigned* kn2 = p.ctl + CW_KN2 + ((l * NB + b) * 4 + hx) * 32;
        const float* cbh = p.cbF + ((size_t)b * 4 + hx) * S;
        const float qn = c1 * sqrtf(__uint_as_float(p.ctl[CW_QN2 + ((l * NB + b) * 4 + hx) * 8 + qb]));
        float knu = 0.f;
        for (int jj = 4 * qb; jj < 4 * qb + 4; ++jj) knu = fmaxf(knu, __uint_as_float(kn2[jj]));
        const float lower = cbh[256 * qb] - qn * sqrtf(knu);
        const int jl = lane & 31;
        const bool keep = qn * sqrtf(__uint_as_float(kn2[jl])) + cbh[64 * jl + 63] - lower >= -FOX_DROP || jl >= 4 * qb;
        const unsigned long long kb = __ballot(keep) & 0xFFFFFFFFull;
        j0 = kb ? (int)__builtin_ctzll(kb) : 4 * qb;
    }
    bf16x8 qf[2][KC];
#pragma unroll
    for (int qt = 0; qt < 2; ++qt)
#pragma unroll
        for (int kc = 0; kc < KC; ++kc) qf[qt][kc] = *(const bf16x8*)(Qp + (tok0 + q0 + 16 * qt + i) * ldq + kc * 32 + 8 * g);
    const int sr = tid >> 3, sc8 = tid & 7;
    const int kdst = sr * 128 + ((sc8 ^ ((sr >> 1) & 7)) << 4);
    const int vdst = sr * 128 + (((((sc8 >> 1) ^ ((sr >> 1) & 3)) << 1) | (sc8 & 1)) << 4);
    const int rr = (tid & 255) >> 2, rc4 = tid & 3;
    const int rdst = rr * 64 + ((rc4 ^ ((rr >> 1) & 3)) << 4);
    u32x4 kstA, vstA, rstA = {0u, 0u, 0u, 0u}, kstB, vstB, rstB = {0u, 0u, 0u, 0u}; float cstA = 0.f, cstB = 0.f;
    u32x2 mw[2] = {{0u, 0u}, {0u, 0u}}, mwnA[2] = {{0u, 0u}, {0u, 0u}}, mwnB[2] = {{0u, 0u}, {0u, 0u}};
#define AT_LOAD(ZZ, j) do { if (AEXP(1)) break; const size_t _kr = tok0 + 64 * (j) + sr; \
        kst##ZZ = *(const u32x4*)(Kp + _kr * ldk + sc8 * 8); vst##ZZ = *(const u32x4*)(Vp + _kr * ldv + sc8 * 8); \
        if (VAR == 1) rst##ZZ = *(const u32x4*)(Kp + (tok0 + 64 * (j) + rr) * ldk + 64 + rc4 * 8); \
        if (VAR == 0) cst##ZZ = p.cbF[((size_t)b * 4 + hx) * S + 64 * (j) + (tid & 63)]; \
        if (VAR == 3) { _Pragma("unroll") for (int _q = 0; _q < 2; ++_q) mwn##ZZ[_q] = *(const u32x2*)(p.mask + (tok0 + q0 + 16 * _q + i) * 64 + 2 * (j)); } } while (0)
#define AT_WRITE(ZZ, buf) do { if (AEXP(1)) break; *(LAS3 u32x4*)(lds + AT_KB + (buf) * 8192 + kdst) = kst##ZZ; *(LAS3 u32x4*)(lds + AT_VB + (buf) * 8192 + vdst) = vst##ZZ; \
        if (VAR == 1 && tid < 256) *(LAS3 u32x4*)(lds + AT_KR + (buf) * 4096 + rdst) = rst##ZZ; \
        if (VAR == 0 && tid < 64) *(LAS3 float*)(lds + AT_CB + (buf) * 256 + tid * 4) = cst##ZZ; \
        if (VAR == 3) { mw[0] = mwn##ZZ[0]; mw[1] = mwn##ZZ[1]; } } while (0)
    AT_LOAD(A, j0);
    AT_LOAD(B, (j0 + 1 <= j1 ? j0 + 1 : j1));
    if (VAR == 1) {
#pragma unroll
        for (int qt = 0; qt < 2; ++qt) {
            const int pos = q0 + 16 * qt + i;
            const u32x4 mine = __builtin_bit_cast(u32x4, qf[qt][KC - 1]);
            u32x4 oth; oth.x = __shfl_xor(mine.x, 32); oth.y = __shfl_xor(mine.y, 32); oth.z = __shfl_xor(mine.z, 32); oth.w = __shfl_xor(mine.w, 32);
            const float* rt = p.ropetab + (size_t)(pos * 16 + (g & 1) * 8) * 2;
            const float sg = (g < 2) ? -1.f : 1.f;
            u32x4 res;
#pragma unroll
            for (int e2 = 0; e2 < 4; ++e2) {
                const f32x4 cs = *(const f32x4*)(rt + e2 * 4);
                const unsigned mw_ = e2 == 0 ? mine.x : e2 == 1 ? mine.y : e2 == 2 ? mine.z : mine.w, ow_ = e2 == 0 ? oth.x : e2 == 1 ? oth.y : e2 == 2 ? oth.z : oth.w;
                const float r0 = bflo(mw_) * cs[0] + sg * bflo(ow_) * cs[1], r1 = bfhi(mw_) * cs[2] + sg * bfhi(ow_) * cs[3];
                const unsigned pk = cvt_pk_bf16(r0, r1);
                if (e2 == 0) res.x = pk; else if (e2 == 1) res.y = pk; else if (e2 == 2) res.z = pk; else res.w = pk;
            }
            qf[qt][KC - 1] = __builtin_bit_cast(bf16x8, res);
        }
    }
#pragma unroll
    for (int qt = 0; qt < 2; ++qt)
#pragma unroll
        for (int kc = 0; kc < KC; ++kc) {
            u32x4 qq = __builtin_bit_cast(u32x4, qf[qt][kc]);
            qq.x = cvt_pk_bf16(bflo(qq.x) * c1, bfhi(qq.x) * c1); qq.y = cvt_pk_bf16(bflo(qq.y) * c1, bfhi(qq.y) * c1);
            qq.z = cvt_pk_bf16(bflo(qq.z) * c1, bfhi(qq.z) * c1); qq.w = cvt_pk_bf16(bflo(qq.w) * c1, bfhi(qq.w) * c1);
            qf[qt][kc] = __builtin_bit_cast(bf16x8, qq);
        }
    f32x4 o[2][4];
#pragma unroll
    for (int qt = 0; qt < 2; ++qt)
#pragma unroll
        for (int dt = 0; dt < 4; ++dt) o[qt][dt] = (f32x4){0.f, 0.f, 0.f, 0.f};
    float mrow[2] = {NEGBIG, NEGBIG}, lsum[2] = {0.f, 0.f};
    AT_WRITE(A, j0 & 1);
    __syncthreads();
    const int swk = (i >> 1) & 7;
    for (int j = j0; j <= j1; j += 2) {
        AT_LOAD(A, (j + 2 <= j1 ? j + 2 : j1));
        attn_tile<VAR, KC>(lds, j & 1, j, q0, i, g, swk, slope2, qf, o, mrow, lsum, mw, xq);
        if (j + 1 <= j1) AT_WRITE(B, (j + 1) & 1);
        if (!AEXP(5)) __syncthreads();
        if (j + 1 > j1) break;
        AT_LOAD(B, (j + 3 <= j1 ? j + 3 : j1));
        attn_tile<VAR, KC>(lds, (j + 1) & 1, j + 1, q0, i, g, swk, slope2, qf, o, mrow, lsum, mw, xq);
        if (j + 2 <= j1) AT_WRITE(A, j & 1);
        if (!AEXP(5)) __syncthreads();
    }
#undef AT_LOAD
#undef AT_WRITE
#pragma unroll
    for (int qt = 0; qt < 2; ++qt) {
        float lt = lsum[qt]; lt += __shfl_xor(lt, 16); lt += __shfl_xor(lt, 32);
        if (VAR == 2) lt += __builtin_amdgcn_exp2f(p.sinks[l * 4 + hx * 2 + (w >> 2)] * LOG2E - mrow[qt]);
        const float inv = 1.f / lt;
        bf16_t* op = p.merged + (tok0 + q0 + 16 * qt + i) * D + ocol + 4 * g;
        if (!(ATTN_EXP != 0 && xq))
#pragma unroll
        for (int dt = 0; dt < 4; ++dt) { const f32x4 v = o[qt][dt] * inv; u32x2 w2; w2.x = cvt_pk_bf16(v[0], v[1]); w2.y = cvt_pk_bf16(v[2], v[3]); *(u32x2*)(op + 16 * dt) = w2; }
    }
}

__device__ __forceinline__ void phase_attn(const Params& p, int l, LAS3 char* lds) {
    const int tid = opaque_tid(p.wid);
    unsigned* qhead = p.ctl + CW_QA + 64 * (l + 2 * p.qslot);
    volatile LAS3 int* bc = (volatile LAS3 int*)(lds + AT_CTL);
    int nxt = 0;
    if (tid == 0) nxt = (int)__hip_atomic_fetch_add(qhead, 1u, __ATOMIC_RELAXED, __HIP_MEMORY_SCOPE_AGENT);
    for (;;) {
        if (tid == 0) *bc = nxt;
        __syncthreads();
        const int idx = __builtin_amdgcn_readfirstlane(*bc);
        __syncthreads();
        if (idx >= 4096) break;
        if (tid == 0) nxt = (int)__hip_atomic_fetch_add(qhead, 1u, __ATOMIC_RELAXED, __HIP_MEMORY_SCOPE_AGENT);
        const int vmask = p.qslot ? REPK_VMASK : ATTN_VMASK;
        if (idx < 3072) {
            const int lvl = 7 - idx / 384, rem = idx % 384;
            if (rem < 128) { if (vmask & 2) attn_unit<1>(p, l, rem >> 2, rem & 3, lvl, lds); }
            else if (rem < 256) { if (vmask & 1) attn_unit<0>(p, l, (rem - 128) >> 2, rem & 3, lvl, lds); }
            else { const int d = rem - 256; if (vmask & 8) attn_unit<3>(p, l, d & 31, 0, 4 * lvl + 3 - (d >> 5), lds); }
        } else { const int c = idx - 3072; if (vmask & 4) attn_unit<2>(p, l, c >> 5, (c >> 4) & 1, c & 15, lds); }
    }
}
}

namespace {
constexpr int DS_LD = 2052;
constexpr int DS_CTL = 16 * DS_LD * 4;
constexpr int DS_LDS = DS_CTL + 64;

__device__ __forceinline__ void dsa_unit(const Params& p, int u, LAS3 char* lds) {
    const int tid = opaque_tid(p.wid), w = __builtin_amdgcn_readfirstlane(tid >> 6), lane = tid & 63, i = lane & 15, g = lane >> 4;
    const int b = u >> 7, t0 = (u & 127) * 16;
    const size_t tok0 = (size_t)b * S;
    uint32_t* mbase = p.mask + (tok0 + t0) * 64;
    if (t0 + 16 <= 256) {
#pragma unroll
        for (int qq = 0; qq < 2; ++qq) {
            const int q = 2 * w + qq, n = t0 + q + 1;
            if (lane < 32) { const int lo = lane * 64; unsigned long long bits = (n >= lo + 64) ? ~0ull : (n <= lo ? 0ull : ((1ull << (n - lo)) - 1ull));
                u32x2 o; o.x = (unsigned)bits; o.y = (unsigned)(bits >> 32); *(u32x2*)(mbase + q * 64 + 2 * lane) = o; }
        }
        return;
    }
    const int nreg = (t0 + 16 + 63) >> 6;
    const int ntile = nreg * 4;
    bf16x8 qf[8]; float wq[8];
    {
        const bf16_t* qrow = p.proj + (tok0 + t0 + i) * NP;
#pragma unroll
        for (int h = 0; h < 8; ++h) qf[h] = *(const bf16x8*)(qrow + PC_DQI + h * 32 + 8 * g);
        const u32x4 ww = *(const u32x4*)(qrow + PC_DWI);
        const float sc = 0.35355339059327373f * 0.17677669529663687f;
        wq[0] = bflo(ww.x) * sc; wq[1] = bfhi(ww.x) * sc; wq[2] = bflo(ww.y) * sc; wq[3] = bfhi(ww.y) * sc;
        wq[4] = bflo(ww.z) * sc; wq[5] = bfhi(ww.z) * sc; wq[6] = bflo(ww.w) * sc; wq[7] = bfhi(ww.w) * sc;
    }
    const int tq = t0 + i;
#ifndef DSA_EXP
#define DSA_EXP 0
#endif
    const bool exp_skip_score = (DSA_EXP == 2) && p.qslot > 0, exp_skip_sel = (DSA_EXP == 1) && p.qslot > 0, exp_nostore = (DSA_EXP != 0) && p.qslot > 0;
    if (!exp_skip_score)
    for (int base = w; base < ntile; base += 32) {
        bf16x8 kf4[4];
#pragma unroll
        for (int uu = 0; uu < 4; ++uu) { const int kt = base + 8 * uu; if (kt < ntile) kf4[uu] = *(const bf16x8*)(p.kidx + (tok0 + 16 * kt + i) * 32 + 8 * g); }
#pragma unroll
        for (int uu = 0; uu < 4; ++uu) {
            const int kt = base + 8 * uu;
            if (kt < ntile) {
                f32x4 sc4 = {0.f, 0.f, 0.f, 0.f};
#pragma unroll
                for (int h = 0; h < 8; ++h) {
                    const f32x4 c = __builtin_amdgcn_mfma_f32_16x16x32_bf16(kf4[uu], qf[h], (f32x4){0.f, 0.f, 0.f, 0.f}, 0, 0, 0);
#pragma unroll
                    for (int r = 0; r < 4; ++r) sc4[r] += wq[h] * fmaxf(c[r], 0.f);
                }
                u32x4 ko;
#pragma unroll
                for (int r = 0; r < 4; ++r) {
                    const int key = 16 * kt + 4 * g + r;
                    unsigned uu2 = __float_as_uint(sc4[r]); if (uu2 == 0x80000000u) uu2 = 0u;
                    uu2 = (uu2 & 0x80000000u) ? ~uu2 : (uu2 | 0x80000000u);
                    ko[r] = (key <= tq) ? uu2 : 0u;
                }
                *(LAS3 u32x4*)(lds + ((size_t)i * DS_LD + 16 * kt + 4 * g) * 4) = ko;
            }
        }
    }
    __syncthreads();
    if (!exp_skip_sel)
    {
        const int qA = 2 * w, qB = 2 * w + 1, nA = t0 + qA + 1, nB = t0 + qB + 1;
        const LAS3 unsigned* kpA = (const LAS3 unsigned*)(lds + (size_t)qA * DS_LD * 4);
        const LAS3 unsigned* kpB = (const LAS3 unsigned*)(lds + (size_t)qB * DS_LD * 4);
        unsigned keyA[32], keyB[32];
        const int nv = nreg * 64;
#pragma unroll
        for (int r = 0; r < 32; ++r) {
            int idx = r * 64 + lane; asm volatile("" : "+v"(idx));
            const unsigned va = kpA[r * 64 + lane], vb = kpB[r * 64 + lane];
            keyA[r] = (idx < nv) ? va : 0u; keyB[r] = (idx < nv) ? vb : 0u;
        }
        unsigned thrA = (nA <= 256) ? 1u : 0u, thrB = (nB <= 256) ? 1u : 0u;
        bool exA = (nA <= 256), exB = (nB <= 256);
        for (int bit = 31; bit >= 0; --bit) {
            if (exA && exB) break;
            const unsigned cA = exA ? 0xFFFFFFFFu : (thrA | (1u << bit)), cB = exB ? 0xFFFFFFFFu : (thrB | (1u << bit));
            int na = 0, nb = 0;
            if (!exA && !exB) {
#pragma unroll
                for (int gq = 0; gq < 4; ++gq) if (nreg > 8 * gq) {
#pragma unroll
                    for (int r = 8 * gq; r < 8 * gq + 8; ++r) { na += (keyA[r] >= cA) ? 1 : 0; nb += (keyB[r] >= cB) ? 1 : 0; } }
                na = wave_reduce_add(na); nb = wave_reduce_add(nb);
            } else if (!exA) {
#pragma unroll
                for (int gq = 0; gq < 4; ++gq) if (nreg > 8 * gq) {
#pragma unroll
                    for (int r = 8 * gq; r < 8 * gq + 8; ++r) na += (keyA[r] >= cA) ? 1 : 0; }
                na = wave_reduce_add(na);
            } else {
#pragma unroll
                for (int gq = 0; gq < 4; ++gq) if (nreg > 8 * gq) {
#pragma unroll
                    for (int r = 8 * gq; r < 8 * gq + 8; ++r) nb += (keyB[r] >= cB) ? 1 : 0; }
                nb = wave_reduce_add(nb);
            }
            if (!exA && na >= 256) { thrA = cA; exA = (na == 256); }
            if (!exB && nb >= 256) { thrB = cB; exB = (nb == 256); }
        }
#pragma unroll 1
        for (int qq = 0; qq < 2; ++qq) {
            const unsigned thr = qq ? thrB : thrA; const bool exact = qq ? exB : exA;
            unsigned long long mine = 0ull;
            int need = 0, running = 0;
            if (!exact) { int ngt = 0;
#pragma unroll
                for (int r = 0; r < 32; ++r) ngt += ((qq ? keyB[r] : keyA[r]) > thr) ? 1 : 0;
                need = 256 - wave_reduce_add(ngt); }
            const unsigned long long lt = (lane == 0) ? 0ull : (~0ull >> (64 - lane));
#pragma unroll
            for (int r = 0; r < 32; ++r) if (nreg > (r & ~7)) {
                const unsigned key = qq ? keyB[r] : keyA[r];
                unsigned long long bs;
                if (exact) bs = __ballot(key >= thr);
                else {
                    const bool eq = key == thr;
                    const unsigned long long be = __ballot(eq);
                    const int rank = running + __popcll(be & lt);
                    bs = __ballot((key > thr) || (eq && rank < need));
                    running += __popcll(be);
                }
                { int ln = lane; asm volatile("" : "+v"(ln)); if (ln == r) mine = bs; }
            }
            if (lane < 32 && !exp_nostore) { u32x2 o; o.x = (unsigned)mine; o.y = (unsigned)(mine >> 32); *(u32x2*)(mbase + (2 * w + qq) * 64 + 2 * lane) = o; }
        }
    }
    __syncthreads();
}

__device__ __forceinline__ void phase_dsa(const Params& p, int l, LAS3 char* lds) {
    const int tid = opaque_tid(p.wid);
    unsigned* qhead = p.ctl + CW_QD + 64 * (l + 2 * p.qslot);
    volatile LAS3 int* bc = (volatile LAS3 int*)(lds + DS_CTL);
    int nxt = 0;
    if (tid == 0) nxt = (int)__hip_atomic_fetch_add(qhead, 1u, __ATOMIC_RELAXED, __HIP_MEMORY_SCOPE_AGENT);
    for (;;) {
        if (tid == 0) *bc = nxt;
        __syncthreads();
        const int idx = __builtin_amdgcn_readfirstlane(*bc);
        __syncthreads();
        if (idx >= 4096) break;
        if (tid == 0) nxt = (int)__hip_atomic_fetch_add(qhead, 1u, __ATOMIC_RELAXED, __HIP_MEMORY_SCOPE_AGENT);
        const int pb = 127 - (idx >> 5), b = idx & 31;
        dsa_unit(p, b * 128 + pb, lds);
    }
}
}

namespace {
constexpr int LDS_BYTES = 147456;
constexpr int NTHREADS = 512;

template <int PH>
__device__ __forceinline__ void run_phase(const Params& p, int l, unsigned char* smem) {
    LAS3 char* lds = (LAS3 char*)smem;
    PG8_LAS unsigned char* glds = (PG8_LAS unsigned char*)smem;
    const int G = gridDim.x, c = blockIdx.x;
    if constexpr (PH == 0) phase_p0(p, (char*)smem);
    if constexpr (PH == 1) { if (l == 0) phase_norm1<0>(p, 0); else phase_norm1<1>(p, l); }
    if constexpr (PH == 2) { pg8::Gemm g{p.h, p.WinT + (size_t)l * NP * D, D, D, 0}; pg8::StaticOrder S; S.init(T, NP, G, c);
        EpiStoreBf16 E{p.proj, NP}; pg8::gemm_phase<EpiStoreBf16, pg8::StaticOrder, false>(glds, g, S, E, p.wid); }
    if constexpr (PH == 3) phase_prep(p, l);
    if constexpr (PH == 4) { pg8::Gemm g{p.proj + PC_BCQ, p.WqT + (size_t)l * 512 * 256, 256, NP, 0}; pg8::StaticOrder S; S.init(T, 512, G, c);
          EpiMlaQ E{p.qm}; pg8::gemm_phase<EpiMlaQ, pg8::StaticOrder, false>(glds, g, S, E, p.wid); }
    if constexpr (PH == 12) { pg8::Gemm g{p.proj + PC_BCKV, p.WkvT + (size_t)l * 512 * 128, 128, NP, 0}; pg8::StaticOrder S; S.init(T, 512, G, c);
          EpiMlaKV E{p.km, p.vm}; pg8::gemm_phase<EpiMlaKV, pg8::StaticOrder, false>(glds, g, S, E, p.wid); }
    if constexpr (PH == 13) phase_dsa(p, l, lds);
    if constexpr (PH == 5) phase_attn(p, l, lds);
    if constexpr (PH == 6) { pg8::Gemm g{p.merged, p.WoutT + (size_t)l * D * D, D, D, 0}; pg8::StaticOrder S; S.init(T, D, G, c);
        EpiResidual E{l == 0 ? p.x : nullptr, p.xb, p.mod + (size_t)l * NB * NMOD + 2 * 1024}; pg8::gemm_phase<EpiResidual, pg8::StaticOrder, false>(glds, g, S, E, p.wid); }
    if constexpr (PH == 7) phase_route(p, l, (char*)smem);
    if constexpr (PH == 8) { const int* cnt = (const int*)(p.ctl + CW_CNT) + l * 16;
        pg8::Gemm g{p.h, p.WguT + (size_t)l * 16 * 512 * 1024, 1024, D, (size_t)512 * 1024}; MoeOrder S; S.init(cnt, p.list, 2, G, c);
        EpiGateUp E{p.hid}; pg8::gemm_phase<EpiGateUp, MoeOrder, true>(glds, g, S, E, p.wid); }
    if constexpr (PH == 9) { const int* cnt = (const int*)(p.ctl + CW_CNT) + l * 16;
        pg8::Gemm g{p.hid, p.WdT + (size_t)l * 16 * 1024 * 256, 256, 256, (size_t)1024 * 256}; MoeOrder S; S.init(cnt, p.list, 4, G, c);
        EpiDown E{p.ys, p.list, p.wl, cnt}; pg8::gemm_phase<EpiDown, MoeOrder, false>(glds, g, S, E, p.wid); }
    if constexpr (PH == 10) phase_norm1<2>(p, 1);
    if constexpr (PH == 11) phase_norm1<0>(p, l);
}
template <int PH>
__global__ void __launch_bounds__(NTHREADS, 2) k_ph(Params p, int l) {
    extern __shared__ __attribute__((aligned(16))) unsigned char smem[];
    p.wid = __builtin_amdgcn_readfirstlane(threadIdx.x >> 6); p.qslot = p.qslot_host;
    run_phase<PH>(p, l, smem);
}
}


namespace {
#ifndef REP_PH
#define REP_PH -1
#endif
#define REP(X, l) do { if (REP_PH == X) { xcd_barrier(bar); phase<X>(l, smem, wid, 1); } } while (0)
struct KArgs { const float* in[20]; float* xo; char* ws; };
constexpr size_t al256(size_t b) { return (b + 255) & ~(size_t)255; }
constexpr size_t WS_CTL = 0;
constexpr size_t WS_MOD = WS_CTL + al256((size_t)CW_WORDS * 4);
constexpr size_t WS_WIN = WS_MOD + al256((size_t)2 * NB * NMOD * 4);
constexpr size_t WS_WOUT = WS_WIN + al256((size_t)2 * NP * D * 2);
constexpr size_t WS_WQ = WS_WOUT + al256((size_t)2 * D * D * 2);
constexpr size_t WS_WKV = WS_WQ + al256((size_t)2 * 512 * 256 * 2);
constexpr size_t WS_WGU = WS_WKV + al256((size_t)2 * 512 * 128 * 2);
constexpr size_t WS_WD = WS_WGU + al256((size_t)2 * 16 * 512 * 1024 * 2);
constexpr size_t WS_ROPE = WS_WD + al256((size_t)2 * 16 * 1024 * 256 * 2);
constexpr size_t WS_RQ = WS_ROPE + al256((size_t)2048 * 16 * 2 * 4);
constexpr size_t WS_RKV = WS_RQ + al256((size_t)T * 4);
constexpr size_t WS_CBF = WS_RKV + al256((size_t)T * 4);
constexpr size_t WS_KIDX = WS_CBF + al256((size_t)NB * 4 * S * 4);
constexpr size_t WS_MASK = WS_KIDX + al256((size_t)T * 32 * 2);
constexpr size_t WS_LIST = WS_MASK + al256((size_t)T * 64 * 4);
constexpr size_t WS_RW = WS_LIST + al256((size_t)2 * 16 * ECAP * 4);
constexpr size_t WS_WL = WS_RW + al256((size_t)T * 2 * 4);
constexpr size_t WS_H = WS_WL + al256((size_t)2 * 16 * ECAP * 4);
constexpr size_t WS_PROJ = WS_H + al256((size_t)T * D * 2);
constexpr size_t WS_QM = WS_PROJ + al256((size_t)T * NP * 2);
constexpr size_t WS_KM = WS_QM + al256((size_t)T * 384 * 2);
constexpr size_t WS_VM = WS_KM + al256((size_t)T * 384 * 2);
constexpr size_t WS_MERGED = WS_VM + al256((size_t)T * 256 * 2);
constexpr size_t WS_XB = WS_MERGED + al256((size_t)T * D * 2);
constexpr size_t WS_END1 = WS_XB + al256((size_t)T * D * 2);
constexpr size_t WS_HID = WS_PROJ;
constexpr size_t WS_YS = WS_HID + al256((size_t)HIDROWS * 256 * 2);
constexpr size_t WS_END2 = WS_YS + al256((size_t)T * 2 * D * 2);
constexpr size_t WS_NEED = WS_END1 > WS_END2 ? WS_END1 : WS_END2;
static_assert(WS_END2 <= WS_MERGED, "MoE overlay must not reach the merged buffer");

__device__ __forceinline__ Params make_params(const KArgs& a) {
    Params p;
    p.x = a.in[0]; p.c = a.in[1]; p.w_ada = a.in[2]; p.b_ada = a.in[3]; p.g_norm1 = a.in[4]; p.w_in = a.in[5]; p.b_forget = a.in[6]; p.g_q_mla = a.in[7];
    p.w_q_up = a.in[8]; p.g_kv_mla = a.in[9]; p.w_kv_up = a.in[10]; p.sinks = a.in[11]; p.w_out = a.in[12]; p.g_norm2 = a.in[13]; p.w_router = a.in[14];
    p.b_router = a.in[15]; p.w_gate = a.in[16]; p.w_up = a.in[17]; p.w_down = a.in[18]; p.g_final = a.in[19];
    p.xo = a.xo; char* ws = a.ws;
    p.ctl = (unsigned*)(ws + WS_CTL); p.mod = (float*)(ws + WS_MOD); p.WinT = (bf16_t*)(ws + WS_WIN); p.WoutT = (bf16_t*)(ws + WS_WOUT);
    p.WqT = (bf16_t*)(ws + WS_WQ); p.WkvT = (bf16_t*)(ws + WS_WKV); p.WguT = (bf16_t*)(ws + WS_WGU); p.WdT = (bf16_t*)(ws + WS_WD);
    p.ropetab = (float*)(ws + WS_ROPE); p.rq = (float*)(ws + WS_RQ); p.rkv = (float*)(ws + WS_RKV); p.cbF = (float*)(ws + WS_CBF); p.kidx = (bf16_t*)(ws + WS_KIDX);
    p.mask = (uint32_t*)(ws + WS_MASK); p.list = (int*)(ws + WS_LIST); p.rw = (float*)(ws + WS_RW); p.wl = (float*)(ws + WS_WL); p.h = (bf16_t*)(ws + WS_H);
    p.proj = (bf16_t*)(ws + WS_PROJ); p.qm = (bf16_t*)(ws + WS_QM); p.km = (bf16_t*)(ws + WS_KM); p.vm = (bf16_t*)(ws + WS_VM);
    p.merged = (bf16_t*)(ws + WS_MERGED); p.xb = (bf16_t*)(ws + WS_XB); p.hid = (bf16_t*)(ws + WS_HID); p.ys = (bf16_t*)(ws + WS_YS);
    return p;
}
template <int PH>
__device__ __forceinline__ void phase(int l, unsigned char* smem, int wid, int qslot = 0) {
    typedef const __attribute__((address_space(4))) KArgs* KA4;
    KA4 ka = (KA4)__builtin_amdgcn_kernarg_segment_ptr();
    asm volatile("" : "+s"(ka));
    KArgs a;
#pragma unroll
    for (int i = 0; i < 20; ++i) a.in[i] = ka->in[i];
    a.xo = ka->xo; a.ws = ka->ws;
    Params p = make_params(a); p.wid = wid; p.qslot = qslot; p.qslot_host = 0;
    run_phase<PH>(p, l, smem);
}
__global__ void __launch_bounds__(NTHREADS, 2) fwd(KArgs args) {
    extern __shared__ __attribute__((aligned(16))) unsigned char smem[];
    volatile LAS unsigned* st = (volatile LAS unsigned*)(smem + LDS_BYTES - 16);
    const int wid = __builtin_amdgcn_readfirstlane(threadIdx.x >> 6);
    if (xb_leader(wid)) { st[0] = 0u; st[1] = 0u; st[2] = 0u; st[3] = 0u; }
    __syncthreads();
    XcdBarrier bar = xcd_barrier_post((unsigned*)(args.ws + WS_CTL) + CW_BAR, st, wid);
    phase<0>(0, smem, wid);  REP(0, 0);
    xcd_barrier(bar);
#define LAYER(l) do { \
        phase<1>(l, smem, wid);  if (l == 0) REP(1, l); xcd_barrier(bar); \
        phase<2>(l, smem, wid);  REP(2, l); xcd_barrier(bar); \
        phase<3>(l, smem, wid);  REP(3, l); xcd_barrier(bar); \
        phase<4>(l, smem, wid);  REP(4, l); phase<12>(l, smem, wid);  REP(12, l); phase<13>(l, smem, wid);  REP(13, l); xcd_barrier(bar); \
        phase<5>(l, smem, wid);  REP(5, l); xcd_barrier(bar); \
        phase<6>(l, smem, wid);  xcd_barrier(bar); \
        phase<7>(l, smem, wid);  REP(7, l); xcd_barrier(bar); \
        phase<8>(l, smem, wid);  REP(8, l); xcd_barrier(bar); \
        phase<9>(l, smem, wid);  REP(9, l); xcd_barrier(bar); } while (0)
    LAYER(0);
    LAYER(1);
#ifdef REP_BAR
    for (int rb = 0; rb < REP_BAR; ++rb) xcd_barrier(bar);
#endif
    phase<10>(1, smem, wid);
}
}

extern "C" void kernel_launch(void* const* d_in, const int* in_sizes, int n_in, void* d_out, int out_size, void* d_ws, size_t ws_size,
                              hipStream_t stream) {
    KArgs a{};
    for (int i = 0; i < 20; ++i) a.in[i] = (const float*)d_in[i];
    a.xo = (float*)d_out; a.ws = (char*)d_ws;
    if (WS_NEED > ws_size) return;

    static int grid = 0;
    if (!grid) {
        int dev = 0, cus = 0, per_cu = 0;
        (void)hipGetDevice(&dev);
        (void)hipDeviceGetAttribute(&cus, hipDeviceAttributeMultiprocessorCount, dev);
        (void)hipFuncSetAttribute((const void*)fwd, hipFuncAttributeMaxDynamicSharedMemorySize, LDS_BYTES);
        (void)hipOccupancyMaxActiveBlocksPerMultiprocessor(&per_cu, (const void*)fwd, NTHREADS, LDS_BYTES);
        grid = cus > 0 ? cus : 256;
    }
    (void)hipMemsetAsync(a.ws + WS_CTL, 0, (size_t)CW_WORDS * 4, stream);
    fwd<<<dim3(grid), dim3(NTHREADS), LDS_BYTES, stream>>>(a);
}
```

```cpp
#include <hip/hip_runtime.h>
#include <stdint.h>
#define XB_TMO      128
#define XB_XCNT(j)  (256  + 64 * (j))
#define XB_XSUB(j)  (1280 + 64 * (j))
#define XB_XGEN(j)  (2304 + 64 * (j))
#define XB_TOP      3328
#define XB_TOPGEN   3392
#define XCD_BAR_WORDS 3456
#define XB_SPIN_CAP (1u << 20)
#define LAS __attribute__((address_space(3)))

__device__ __forceinline__ unsigned xb_ld(unsigned* p)              { return __hip_atomic_load(p, __ATOMIC_RELAXED, __HIP_MEMORY_SCOPE_AGENT); }
__device__ __forceinline__ unsigned xb_add(unsigned* p, unsigned v) { return __hip_atomic_fetch_add(p, v, __ATOMIC_RELAXED, __HIP_MEMORY_SCOPE_AGENT); }
__device__ __forceinline__ unsigned xb_xcc_id() { return (unsigned)__builtin_amdgcn_s_getreg((3 << 11) | 20) & 0xFu; }
#define XB_SPIN(cond, bar) do { unsigned _sp = 0; while (cond) { __builtin_amdgcn_s_sleep(1); \
    if ((++_sp & 255u) == 0u) { if (xb_ld(&(bar)[XB_TMO])) break; if (_sp > XB_SPIN_CAP) { atomicAdd(&(bar)[XB_TMO], 1u); break; } } } } while (0)

struct XcdBarrier { unsigned* bar; unsigned x; volatile LAS unsigned* st; int wid; };
__device__ __forceinline__ bool xb_leader(int wid) { return wid == 0 && __builtin_amdgcn_mbcnt_hi(~0u, __builtin_amdgcn_mbcnt_lo(~0u, 0u)) == 0u; }

__device__ __forceinline__ XcdBarrier xcd_barrier_post(unsigned* bar, volatile LAS unsigned* st, int wid) {
    XcdBarrier b; b.bar = bar; b.x = xb_xcc_id(); b.st = st; b.wid = wid;
    if (xb_leader(wid)) (void)xb_add(&bar[XB_XCNT(b.x)], 1u);
    return b;
}
__device__ __forceinline__ void xcd_barrier_complete(unsigned* bar, unsigned x, unsigned& nloc, unsigned& nx) {
    const unsigned G = gridDim.x * gridDim.y * gridDim.z;
    unsigned sum, cnt, mine, sp = 0u;
    for (;;) {
        sum = 0u; cnt = 0u; mine = 0u;
#pragma unroll
        for (unsigned j = 0; j < 16; ++j) { const unsigned c = xb_ld(&bar[XB_XCNT(j)]); sum += c; cnt += (c > 0u) ? 1u : 0u; mine = (j == x) ? c : mine; }
        if (sum == G) break;
        __builtin_amdgcn_s_sleep(1);
        if ((++sp & 255u) == 0u) { if (xb_ld(&bar[XB_TMO])) break; if (sp > XB_SPIN_CAP) { atomicAdd(&bar[XB_TMO], 1u); break; } }
    }
    nloc = mine > 0u ? mine : 1u; nx = cnt > 0u ? cnt : 1u;
}
__device__ __forceinline__ void xcd_barrier(const XcdBarrier& b) {
    asm volatile("s_waitcnt vmcnt(0)" ::: "memory");
    __syncthreads();
    if (xb_leader(b.wid)) {
        unsigned* bar = b.bar;
        __builtin_amdgcn_s_waitcnt(0);
        unsigned nloc = b.st[0], nx = b.st[1];
        if (nloc == 0u) { xcd_barrier_complete(bar, b.x, nloc, nx); b.st[0] = nloc; b.st[1] = nx; }
        const unsigned old = xb_add(&bar[XB_XSUB(b.x)], 1u);
        const unsigned gen = old / nloc;
        if (old + 1u == (gen + 1u) * nloc) {
            __builtin_amdgcn_fence(__ATOMIC_RELEASE, "agent");
            asm volatile("s_waitcnt vmcnt(0)" ::: "memory");
            const unsigned og = xb_add(&bar[XB_TOP], 1u);
            const unsigned tg = og / nx;
            if (og + 1u == (tg + 1u) * nx) xb_add(&bar[XB_TOPGEN], 1u);
            else XB_SPIN(xb_ld(&bar[XB_TOPGEN]) == tg, bar);
            __builtin_amdgcn_fence(__ATOMIC_ACQUIRE, "agent");
            xb_add(&bar[XB_XGEN(b.x)], 1u);
            asm volatile("s_waitcnt vmcnt(0)" ::: "memory");
        } else {
            XB_SPIN(xb_ld(&bar[XB_XGEN(b.x)]) == gen, bar);
            __builtin_amdgcn_fence(__ATOMIC_ACQUIRE, "agent");
            asm volatile("s_waitcnt vmcnt(0)" ::: "memory");
        }
    }
    __syncthreads();
}

#define LAS3 __attribute__((address_space(3)))
namespace {
typedef unsigned short bf16_t;
typedef short bf16x8 __attribute__((ext_vector_type(8)));
typedef short bf16x4 __attribute__((ext_vector_type(4)));
typedef float f32x4 __attribute__((ext_vector_type(4)));
typedef float f32x2 __attribute__((ext_vector_type(2)));
typedef unsigned u32x4 __attribute__((ext_vector_type(4)));
typedef unsigned u32x2 __attribute__((ext_vector_type(2)));

constexpr int D = 1024, NB = 32, S = 2048, T = NB * S, NIN = 2380, NP = 2560, NMOD = 6144;
constexpr int OFF_AQ = 0, OFF_AK = 256, OFF_AV = 512, OFF_AF = 768, OFF_BCQ = 772, OFF_BCKV = 1028, OFF_BKR = 1156,
              OFF_CQ = 1188, OFF_CK = 1444, OFF_CV = 1572, OFF_DQ = 1700, OFF_DK = 1956, OFF_DV = 2020,
              OFF_DQI = 2084, OFF_DKI = 2340, OFF_DWI = 2372;
constexpr int PC_AQ = 0, PC_AK = 256, PC_AV = 512, PC_BCQ = 768, PC_BCKV = 1024, PC_BKR = 1152, PC_CQ = 1184, PC_CK = 1440, PC_CV = 1568,
              PC_DQ = 1696, PC_DK = 1952, PC_DV = 2016, PC_DQI = 2080, PC_DKI = 2336, PC_DWI = 2368, PC_AF = 2376;
constexpr float EPS = 1e-6f;
constexpr float LOG2E = 1.4426950408889634f;
constexpr int ECAP = T;
constexpr int HIDROWS = 2 * T + 16 * 256;

__host__ __device__ __forceinline__ int orig_col(int n) { return n < 768 ? n : (n < 2376 ? n + 4 : (n < 2380 ? n - 1608 : -1)); }
__device__ __forceinline__ int opaque_tid(int wid) {
    int t = wid * 64 + (int)__builtin_amdgcn_mbcnt_hi(~0u, __builtin_amdgcn_mbcnt_lo(~0u, 0u));
    asm volatile("" : "+v"(t)); return t; }
__device__ __forceinline__ float bf2f(bf16_t v) { return __uint_as_float((unsigned)v << 16); }
__device__ __forceinline__ bf16_t f2bf(float f) { unsigned u = __float_as_uint(f); u += 0x7FFFu + ((u >> 16) & 1u); return (bf16_t)(u >> 16); }
typedef __bf16 bf16x2_native __attribute__((ext_vector_type(2)));
__device__ __forceinline__ unsigned cvt_pk_bf16(float lo, float hi) { const f32x2 v = {lo, hi}; return __builtin_bit_cast(unsigned, __builtin_convertvector(v, bf16x2_native)); }
__device__ __forceinline__ float bflo(unsigned w) { return __uint_as_float(w << 16); }
__device__ __forceinline__ float bfhi(unsigned w) { return __uint_as_float(w & 0xFFFF0000u); }
__device__ __forceinline__ float wave_sum(float v) {
#pragma unroll
    for (int o = 32; o > 0; o >>= 1) v += __shfl_xor(v, o);
    return v;
}
__device__ __forceinline__ float xor32_max(float x) {
    float a = x, b = x;
    asm volatile("s_nop 1\n\tv_permlane32_swap_b32 %0, %1\n\ts_nop 1" : "+v"(a), "+v"(b));
    return fmaxf(a, b);
}
__device__ __forceinline__ int wave_reduce_add(int v) {
    v += __builtin_amdgcn_update_dpp(0, v, 0xB1, 0xF, 0xF, true);
    v += __builtin_amdgcn_update_dpp(0, v, 0x4E, 0xF, 0xF, true);
    v += __builtin_amdgcn_update_dpp(0, v, 0x141, 0xF, 0xF, true);
    v += __builtin_amdgcn_update_dpp(0, v, 0x140, 0xF, 0xF, true);
    return __builtin_amdgcn_readlane(v, 0) + __builtin_amdgcn_readlane(v, 16) + __builtin_amdgcn_readlane(v, 32) + __builtin_amdgcn_readlane(v, 48);
}
}

namespace pg8 {
#define PG8_LAS __attribute__((address_space(3)))
constexpr int BM = 256, BK = 64, HALF = 128, HTB = HALF * BK * 2, STAGE_BYTES = 8 * HTB, NXCD = 8, WGM = 8;

__host__ __device__ __forceinline__ int lds_byte(int r, int c) { const int st = (r >> 4) * 2 + (c >> 5), rr = r & 15, cc = c & 31, ob = rr * 64 + cc * 2; return st * 1024 + (ob ^ (((ob >> 9) & 1) << 5)); }
__host__ __device__ __forceinline__ void stage_rc(int b, int& R, int& C) { const int st = b / 1024, sb = b % 1024, swz = sb ^ (((sb >> 9) & 1) << 5); R = (st >> 1) * 16 + swz / 64; C = (st & 1) * 32 + (swz % 64) / 2; }
__host__ __device__ __forceinline__ int perm32(int rho) { const int n = rho >> 4, i = rho & 15; return 8 * (i >> 2) + 4 * n + (i & 3); }

struct Unit { int pm, pn, e, mt; };
struct Gemm { const bf16_t* A; const bf16_t* Bt; int K; int lda; size_t bstride; };

struct StaticOrder {
    int nM, nN, nwg, G, c;
    __host__ __device__ void init(int M, int N, int G_, int c_) { nM = M / BM; nN = N / BM; nwg = nM * nN; G = G_; c = c_; }
    __host__ __device__ bool next(int i, Unit& u) const {
        const long L = (long)i * G + c; if (L >= nwg) return false;
        int wgid = (int)L; { const int q = nwg / NXCD, r = nwg % NXCD, xcd = wgid % NXCD, off = wgid / NXCD; wgid = (xcd < r ? xcd * (q + 1) : r * (q + 1) + (xcd - r) * q) + off; }
        const int nig = WGM * nN, gid = wgid / nig, fm = gid * WGM, gsz = (nM - fm) < WGM ? (nM - fm) : WGM;
        u.pm = fm + ((wgid % nig) % gsz); u.pn = (wgid % nig) / gsz; u.e = 0; u.mt = 0; return true;
    }
    __device__ __forceinline__ int arow(const Unit& u, int r) const { return u.pm * BM + r; }
};

template <class Epi, class Sched, bool GATHER>
__device__ __forceinline__ void gemm_phase(PG8_LAS unsigned char* lds, const Gemm g, const Sched& S, const Epi& E, int wave_index) {
    const int tid = opaque_tid(wave_index), wid = __builtin_amdgcn_readfirstlane(tid >> 6), lane = tid & 63, wr = wid >> 2, wc = wid & 3, fr = lane & 15, fq = lane >> 4;
    int K_ = g.K; asm volatile("" : "+s"(K_));
    const int K = K_, nt = K / BK, lda = g.lda;
    int Ra[2], Ca[2]; unsigned voffB[2], voffA[2];
#pragma unroll
    for (int i = 0; i < 2; ++i) { int R, C; stage_rc(tid * 16 + i * 8192, R, C); const int Rb = Epi::PERM ? ((R & ~31) + perm32(R & 31)) : R;
        Ra[i] = R; Ca[i] = C; voffB[i] = (unsigned)(Rb * K + C) * 2u; voffA[i] = (unsigned)(R * lda + C) * 2u; }
    const size_t kstep = (size_t)(BK * 2);
    const size_t hstepB = (size_t)HALF * K * 2;
    const size_t tstepB = 2 * hstepB;
    const size_t hstepA = (size_t)HALF * lda * 2, tstepA = 2 * hstepA;
    const unsigned ldsw = (unsigned)wid * 1024u;
    const int aoff = lds_byte(wr * 64 + fr, fq * 8), boff = lds_byte(wc * 32 + fr, fq * 8);
#define PG8_SA(b, h) (((b) * 2 + (h)) * HTB)
#define PG8_SB(b, h) ((4 + (b) * 2 + (h)) * HTB)
#define PG8_STAGE(bufoff, gbase, voff) do { _Pragma("unroll") for (int _i = 0; _i < 2; ++_i) \
        __builtin_amdgcn_global_load_lds((const unsigned*)((const char*)(gbase) + (voff)[_i]), (PG8_LAS unsigned*)(lds + (bufoff) + ldsw + _i * 8192), 16, 0, 0); } while (0)
#define PG8_STAGEA(bufoff, kptr, VO, h) do { _Pragma("unroll") for (int _i = 0; _i < 2; ++_i) { \
        const char* _src; if constexpr (GATHER) _src = (const char*)(kptr) + (VO)[_i][h]; else _src = (const char*)(kptr) + (size_t)(h) * hstepA + voffA[_i]; \
        __builtin_amdgcn_global_load_lds((const unsigned*)_src, (PG8_LAS unsigned*)(lds + (bufoff) + ldsw + _i * 8192), 16, 0, 0); } } while (0)
#define PG8_LDA(dst, b, h) do { _Pragma("unroll") for (int m = 0; m < 4; ++m) _Pragma("unroll") for (int k = 0; k < 2; ++k) dst[m][k] = *(const PG8_LAS bf16x8*)(lds + PG8_SA(b, h) + aoff + m * 2048 + k * 1024); } while (0)
#define PG8_LDB(dst, b, h) do { _Pragma("unroll") for (int n = 0; n < 2; ++n) _Pragma("unroll") for (int k = 0; k < 2; ++k) dst[n][k] = *(const PG8_LAS bf16x8*)(lds + PG8_SB(b, h) + boff + n * 2048 + k * 1024); } while (0)
#define PG8_MMA(ai, bj, At, Bt) do { __builtin_amdgcn_s_setprio(1); _Pragma("unroll") for (int m = 0; m < 4; ++m) _Pragma("unroll") for (int n = 0; n < 2; ++n) _Pragma("unroll") for (int k = 0; k < 2; ++k) \
        acc[ai][bj][m][n] = __builtin_amdgcn_mfma_f32_16x16x32_bf16(Bt[n][k], At[m][k], acc[ai][bj][m][n], 0, 0, 0); __builtin_amdgcn_s_setprio(0); } while (0)
#define PG8_WAIT_V(n) asm volatile("s_waitcnt vmcnt(" #n ")" ::: "memory")
#define PG8_WAIT_L(n) asm volatile("s_waitcnt lgkmcnt(" #n ")" ::: "memory")
#define PG8_BAR __builtin_amdgcn_s_barrier()
#define PG8_SCHED __builtin_amdgcn_sched_barrier(0)
#define PG8_SETV(V, u) do { _Pragma("unroll") for (int _i = 0; _i < 2; ++_i) _Pragma("unroll") for (int _h = 0; _h < 2; ++_h) { \
        const int _row = GATHER ? S.arow(u, _h * HALF + Ra[_i]) : ((u).pm * BM + _h * HALF + Ra[_i]); V[_i][_h] = (unsigned)(((size_t)_row * lda + Ca[_i]) * 2); } } while (0)
    Unit cur, nxt; int ui = 0;
    if (!S.next(0, cur)) return;
    f32x4 acc[2][2][4][2];
#pragma unroll
    for (int a = 0; a < 2; ++a)
#pragma unroll
        for (int b = 0; b < 2; ++b)
#pragma unroll
            for (int m = 0; m < 4; ++m)
#pragma unroll
                for (int n = 0; n < 2; ++n) acc[a][b][m][n] = (f32x4){0.f, 0.f, 0.f, 0.f};
    bf16x8 At[4][2], B0[2][2], B1[2][2];
    unsigned vA[2][2], vN[2][2];
    if constexpr (GATHER) { PG8_SETV(vA, cur); }
    const char* cA = (const char*)g.A + (GATHER ? (size_t)0 : (size_t)cur.pm * tstepA);
    const char* cB = (const char*)g.Bt + ((size_t)cur.e * g.bstride) * 2 + (size_t)cur.pn * tstepB;
    PG8_STAGE(PG8_SB(0, 0), cB, voffB); PG8_STAGE(PG8_SB(0, 1), cB + hstepB, voffB); PG8_STAGEA(PG8_SA(0, 0), cA, vA, 0); PG8_STAGEA(PG8_SA(0, 1), cA, vA, 1);
    if (wr == 1) PG8_BAR;
    PG8_WAIT_V(2); PG8_BAR;
    PG8_STAGE(PG8_SB(1, 0), cB + kstep, voffB); PG8_STAGEA(PG8_SA(1, 0), cA + kstep, vA, 0); PG8_STAGE(PG8_SB(1, 1), cB + hstepB + kstep, voffB);
    PG8_WAIT_V(6); PG8_BAR;
    for (;;) {
        const bool has_next = S.next(ui + 1, nxt);
        if constexpr (GATHER) { if (has_next) { PG8_SETV(vN, nxt); }
        else {
#pragma unroll
            for (int _i = 0; _i < 2; ++_i)
#pragma unroll
                for (int _h = 0; _h < 2; ++_h) vN[_i][_h] = vA[_i][_h];
        } }
        const char* nA = (!GATHER && has_next) ? (const char*)g.A + (size_t)nxt.pm * tstepA : cA;
        const char* nB = has_next ? (const char*)g.Bt + ((size_t)nxt.e * g.bstride) * 2 + (size_t)nxt.pn * tstepB : cB;
#pragma unroll 1
        for (int t = 0; t < nt; t += 2) {
            const bool last = (t == nt - 2);
            const char* a1 = cA + (size_t)(t + 1) * kstep;
            const char* a2 = last ? nA : cA + (size_t)(t + 2) * kstep; const char* b2 = last ? nB : cB + (size_t)(t + 2) * kstep;
            const char* a3 = a2 + kstep; const char* b3 = b2 + kstep;
            unsigned v2[2][2];
            if constexpr (GATHER) {
#pragma unroll
            for (int _i = 0; _i < 2; ++_i)
#pragma unroll
                for (int _h = 0; _h < 2; ++_h) v2[_i][_h] = last ? vN[_i][_h] : vA[_i][_h];
            }
            PG8_LDB(B0, 0, 0); PG8_LDB(B1, 0, 1); PG8_SCHED; PG8_LDA(At, 0, 0); PG8_STAGEA(PG8_SA(1, 1), a1, vA, 1);
            PG8_WAIT_V(8); PG8_WAIT_L(0); PG8_BAR; PG8_MMA(0, 0, At, B0); PG8_MMA(0, 1, At, B1); PG8_BAR; PG8_SCHED;
            PG8_LDA(At, 0, 1); PG8_STAGE(PG8_SB(0, 0), b2, voffB); PG8_STAGE(PG8_SB(0, 1), b2 + hstepB, voffB); PG8_STAGEA(PG8_SA(0, 0), a2, v2, 0);
            PG8_WAIT_V(8); PG8_WAIT_L(0); PG8_BAR; PG8_MMA(1, 0, At, B0); PG8_MMA(1, 1, At, B1); PG8_BAR; PG8_SCHED;
            PG8_LDB(B0, 1, 0); PG8_LDB(B1, 1, 1); PG8_SCHED; PG8_LDA(At, 1, 0); PG8_STAGEA(PG8_SA(0, 1), a2, v2, 1);
            PG8_WAIT_V(8); PG8_WAIT_L(0); PG8_BAR; PG8_MMA(0, 0, At, B0); PG8_MMA(0, 1, At, B1); PG8_BAR; PG8_SCHED;
            PG8_LDA(At, 1, 1); PG8_STAGE(PG8_SB(1, 0), b3, voffB); PG8_STAGE(PG8_SB(1, 1), b3 + hstepB, voffB); PG8_STAGEA(PG8_SA(1, 0), a3, v2, 0);
            PG8_WAIT_V(8); PG8_WAIT_L(0); PG8_BAR; PG8_MMA(1, 0, At, B0); PG8_MMA(1, 1, At, B1); PG8_BAR; PG8_SCHED;
        }
        if (wr == 0) PG8_BAR;
        E(acc, cur, wr, wc, fr, fq);
        if (!has_next) break;
#pragma unroll
        for (int a = 0; a < 2; ++a)
#pragma unroll
            for (int b = 0; b < 2; ++b)
#pragma unroll
                for (int m = 0; m < 4; ++m)
#pragma unroll
                    for (int n = 0; n < 2; ++n) acc[a][b][m][n] = (f32x4){0.f, 0.f, 0.f, 0.f};
        cur = nxt; cB = nB; cA = nA; ++ui;
        if constexpr (GATHER) {
#pragma unroll
        for (int _i = 0; _i < 2; ++_i)
#pragma unroll
            for (int _h = 0; _h < 2; ++_h) vA[_i][_h] = vN[_i][_h];
        }
        if (wr == 1) PG8_BAR;
    }
    PG8_WAIT_V(0);
    PG8_BAR;
#undef PG8_SA
#undef PG8_SB
#undef PG8_STAGE
#undef PG8_STAGEA
#undef PG8_LDA
#undef PG8_LDB
#undef PG8_MMA
#undef PG8_WAIT_V
#undef PG8_WAIT_L
#undef PG8_BAR
#undef PG8_SCHED
#undef PG8_SETV
}
}

namespace {
struct Params {
    const float *x, *c, *w_ada, *b_ada, *g_norm1, *w_in, *b_forget, *g_q_mla, *w_q_up, *g_kv_mla, *w_kv_up, *sinks, *w_out, *g_norm2,
                *w_router, *b_router, *w_gate, *w_up, *w_down, *g_final;
    float* xo;
    bf16_t* xb;
    unsigned* ctl;
    float* mod;
    bf16_t* WinT;
    bf16_t* WoutT;
    bf16_t* WqT;
    bf16_t* WkvT;
    bf16_t* WguT;
    bf16_t* WdT;
    float* ropetab;
    float* rq; float* rkv;
    float* cbF;
    bf16_t* kidx;
    uint32_t* mask;
    bf16_t* h;
    bf16_t* proj;
    bf16_t* qm; bf16_t* km; bf16_t* vm;
    bf16_t* merged;
    bf16_t* hid;
    bf16_t* ys;
    int* list;
    float* rw;
    float* wl;
    int wid;
    int qslot;
    int qslot_host;
};
constexpr int CW_BAR = 0;
constexpr int CW_CNT = 3584;
constexpr int CW_QA = 3648;
constexpr int CW_QD = 4288;
constexpr int CW_KN2 = 4992;
constexpr int CW_QN2 = CW_KN2 + 2 * NB * 4 * 32;
constexpr int CW_WORDS = CW_QN2 + 2 * NB * 4 * 8;
}

namespace {
constexpr long P0_B1 = 2l * NP * 128, P0_B2 = P0_B1 + 2l * 1024 * 128, P0_B3 = P0_B2 + 2l * 512 * 32, P0_B4 = P0_B3 + 2l * 512 * 16,
               P0_B5 = P0_B4 + 32l * 512 * 128, P0_B6 = P0_B5 + 32l * 1024 * 32;
__device__ __forceinline__ bf16_t* p0_fetch(const Params& p, long it, float (&v)[8]) {
    if (it < P0_B1) {
        const int l = (int)(it / (NP * 128)), r = (int)(it % (NP * 128)), n = r % NP, k0 = (r / NP) * 8, o = orig_col(n);
        const float* w = p.w_in + (size_t)l * D * NIN;
#pragma unroll
        for (int j = 0; j < 8; ++j) v[j] = o >= 0 ? w[(size_t)(k0 + j) * NIN + o] : 0.f;
        return p.WinT + ((size_t)l * NP + n) * D + k0;
    } else if (it < P0_B2) {
        const long s = it - P0_B1; const int l = (int)(s / (1024 * 128)), r = (int)(s % (1024 * 128)), n = r & 1023, k0 = (r >> 10) * 8;
        const float* w = p.w_out + (size_t)l * D * D;
#pragma unroll
        for (int j = 0; j < 8; ++j) v[j] = w[(size_t)(k0 + j) * D + n];
        return p.WoutT + ((size_t)l * D + n) * D + k0;
    } else if (it < P0_B3) {
        const long s = it - P0_B2; const int l = (int)(s / (512 * 32)), r = (int)(s % (512 * 32)), n = r & 511, k0 = (r >> 9) * 8;
        const float* w = p.w_q_up + (size_t)l * 256 * 384; const float* g = p.g_q_mla + l * 256;
#pragma unroll
        for (int j = 0; j < 8; ++j) v[j] = n < 384 ? g[k0 + j] * w[(size_t)(k0 + j) * 384 + n] : 0.f;
        return p.WqT + ((size_t)l * 512 + n) * 256 + k0;
    } else if (it < P0_B4) {
        const long s = it - P0_B3; const int l = (int)(s / (512 * 16)), r = (int)(s % (512 * 16)), n = r & 511, k0 = (r >> 9) * 8;
        const float* w = p.w_kv_up + (size_t)l * 128 * 512; const float* g = p.g_kv_mla + l * 128;
#pragma unroll
        for (int j = 0; j < 8; ++j) v[j] = g[k0 + j] * w[(size_t)(k0 + j) * 512 + n];
        return p.WkvT + ((size_t)l * 512 + n) * 128 + k0;
    } else if (it < P0_B5) {
        const long s = it - P0_B4; const int le = (int)(s >> 16), r = (int)(s & 65535), n = r & 511, k0 = (r >> 9) * 8;
        const int q = n >> 5, rr = n & 31, col = 16 * q + (rr & 15);
        const float* w = (rr < 16 ? p.w_gate : p.w_up) + (size_t)le * 1024 * 256;
#pragma unroll
        for (int j = 0; j < 8; ++j) v[j] = w[(size_t)(k0 + j) * 256 + col];
        return p.WguT + ((size_t)le * 512 + n) * 1024 + k0;
    } else {
        const long s = it - P0_B5; const int le = (int)(s >> 15), r = (int)(s & 32767), n = r & 1023, k0 = (r >> 10) * 8;
        const float* w = p.w_down + (size_t)le * 256 * 1024;
#pragma unroll
        for (int j = 0; j < 8; ++j) v[j] = w[(size_t)(k0 + j) * 1024 + n];
        return p.WdT + ((size_t)le * 1024 + n) * 256 + k0;
    }
}
__device__ __forceinline__ void p0_store(bf16_t* dst, const float (&v)[8]) {
    u32x4 w; w.x = cvt_pk_bf16(v[0], v[1]); w.y = cvt_pk_bf16(v[2], v[3]); w.z = cvt_pk_bf16(v[4], v[5]); w.w = cvt_pk_bf16(v[6], v[7]);
    *(u32x4*)dst = w;
}

__device__ __forceinline__ void phase_p0(const Params& p, char* lds) {
    const int tid = opaque_tid(p.wid), gtid = blockIdx.x * blockDim.x + tid, gthreads = gridDim.x * blockDim.x;
    for (long it0 = gtid; it0 < P0_B6; it0 += 2l * gthreads) {
        float va[8], vb[8];
        const bool hb = it0 + gthreads < P0_B6;
        bf16_t* da = p0_fetch(p, it0, va);
        bf16_t* db = hb ? p0_fetch(p, it0 + gthreads, vb) : da;
        p0_store(da, va);
        if (hb) p0_store(db, vb);
    }
    for (int it = gtid; it < 2048 * 16; it += gthreads) {
        const int pos = it >> 4, i = it & 15;
        const float inv = powf(10000.0f, -(float)i / 16.0f), ang = (float)pos * inv;
        p.ropetab[it * 2] = cosf(ang); p.ropetab[it * 2 + 1] = sinf(ang);
    }
    float* ca = (float*)lds;
    for (int i = tid; i < NB * 1024; i += 512) { const float v = p.c[i]; ca[i] = v / (1.f + __expf(-v)); }
    __syncthreads();
    for (int u = blockIdx.x; u < 2 * (NMOD / 64); u += gridDim.x) {
        const int l = u / (NMOD / 64), n = (u % (NMOD / 64)) * 64 + (tid & 63), bg = tid >> 6;
        const float* w = p.w_ada + (size_t)l * 1024 * NMOD + n;
        float acc[4] = {0.f, 0.f, 0.f, 0.f};
        for (int d0 = 0; d0 < 1024; d0 += 8) {
            float wv[8];
#pragma unroll
            for (int q = 0; q < 8; ++q) wv[q] = w[(size_t)(d0 + q) * NMOD];
#pragma unroll
            for (int q = 0; q < 8; ++q)
#pragma unroll
                for (int j = 0; j < 4; ++j) acc[j] += ca[(bg * 4 + j) * 1024 + d0 + q] * wv[q];
        }
        const float bias = p.b_ada[l * NMOD + n];
#pragma unroll
        for (int j = 0; j < 4; ++j) p.mod[((size_t)l * NB + bg * 4 + j) * NMOD + n] = acc[j] + bias;
    }
    __syncthreads();
}

template <int MODE>
__device__ __forceinline__ void phase_norm1(const Params& p, int l) {
#ifndef NORM_NT
#define NORM_NT 2
#endif
    constexpr int NT = NORM_NT;
    const int tid = opaque_tid(p.wid), w = tid >> 6, lane = tid & 63;
    const float* g = (MODE == 2) ? p.g_final : p.g_norm1 + l * D;
    const float* modl = p.mod + (size_t)(MODE == 2 ? 1 : l) * NB * NMOD;
    const float* modp = p.mod + (size_t)(MODE == 2 ? 1 : (l > 0 ? l - 1 : 0)) * NB * NMOD;
    f32x4 gg4[4];
#pragma unroll
    for (int k = 0; k < 4; ++k) gg4[k] = *(const f32x4*)(g + 4 * lane + 256 * k);
    for (int t0 = (blockIdx.x * 8 + w) * NT; t0 < T; t0 += gridDim.x * 8 * NT) {
        const int b0 = t0 >> 11;
        f32x4 sc4[4], sh4[4], gt4[4];
        if (MODE != 2) {
#pragma unroll
            for (int k = 0; k < 4; ++k) { sc4[k] = *(const f32x4*)(modl + (size_t)b0 * NMOD + 1024 + 4 * lane + 256 * k); sh4[k] = *(const f32x4*)(modl + (size_t)b0 * NMOD + 4 * lane + 256 * k); }
        }
        if (MODE >= 1) {
#pragma unroll
            for (int k = 0; k < 4; ++k) gt4[k] = *(const f32x4*)(modp + (size_t)b0 * NMOD + 5 * 1024 + 4 * lane + 256 * k);
        }
        f32x4 v[NT][4];
#pragma unroll
        for (int u = 0; u < NT; ++u)
#pragma unroll
            for (int k = 0; k < 4; ++k) {
                if (MODE == 0) v[u][k] = *(const f32x4*)(p.x + (size_t)(t0 + u) * D + 4 * lane + 256 * k);
                else { const u32x2 w2 = *(const u32x2*)(p.xb + (size_t)(t0 + u) * D + 4 * lane + 256 * k); v[u][k] = (f32x4){bflo(w2.x), bfhi(w2.x), bflo(w2.y), bfhi(w2.y)}; }
            }
        if (MODE >= 1) {
            u32x2 y0[NT][4], y1[NT][4];
#pragma unroll
            for (int u = 0; u < NT; ++u)
#pragma unroll
                for (int k = 0; k < 4; ++k) { const int col = 4 * lane + 256 * k;
                    y0[u][k] = *(const u32x2*)(p.ys + ((size_t)(t0 + u) * 2 + 0) * D + col); y1[u][k] = *(const u32x2*)(p.ys + ((size_t)(t0 + u) * 2 + 1) * D + col); }
#pragma unroll
            for (int u = 0; u < NT; ++u) {
                const int b = (t0 + u) >> 11;
#pragma unroll
                for (int k = 0; k < 4; ++k) {
                    const int col = 4 * lane + 256 * k;
                    const f32x4 gt = gt4[k];
                    v[u][k][0] += gt[0] * (bflo(y0[u][k].x) + bflo(y1[u][k].x)); v[u][k][1] += gt[1] * (bfhi(y0[u][k].x) + bfhi(y1[u][k].x));
                    v[u][k][2] += gt[2] * (bflo(y0[u][k].y) + bflo(y1[u][k].y)); v[u][k][3] += gt[3] * (bfhi(y0[u][k].y) + bfhi(y1[u][k].y));
                }
            }
        }
#pragma unroll
        for (int u = 0; u < NT; ++u) {
            const int t = t0 + u, b = t >> 11;
            float ss = 0.f;
#pragma unroll
            for (int k = 0; k < 4; ++k) ss += v[u][k][0] * v[u][k][0] + v[u][k][1] * v[u][k][1] + v[u][k][2] * v[u][k][2] + v[u][k][3] * v[u][k][3];
            ss = wave_sum(ss);
            const float r = rsqrtf(ss * (1.0f / D) + EPS);
#pragma unroll
            for (int k = 0; k < 4; ++k) {
                const int col = 4 * lane + 256 * k;
                f32x4 y = v[u][k] * r * gg4[k];
                if (MODE == 2) { *(f32x4*)(p.xo + (size_t)t * D + col) = y; }
                else {
                    if (MODE == 1) { u32x2 xw; xw.x = cvt_pk_bf16(v[u][k][0], v[u][k][1]); xw.y = cvt_pk_bf16(v[u][k][2], v[u][k][3]); *(u32x2*)(p.xb + (size_t)t * D + col) = xw; }
                    y = y * (1.f + sc4[k]) + sh4[k];
                    u32x2 o; o.x = cvt_pk_bf16(y[0], y[1]); o.y = cvt_pk_bf16(y[2], y[3]);
                    *(u32x2*)(p.h + (size_t)t * D + col) = o;
                }
            }
        }
    }
}
}

namespace {
using pg8::Unit;
struct EpiStoreBf16 {
    static constexpr bool PERM = true;
    bf16_t* O; int ldc;
    __device__ __forceinline__ void operator()(const f32x4 (&acc)[2][2][4][2], const Unit& u, int wr, int wc, int fr_, int fq_) const {
        int fr = fr_, fq = fq_; asm volatile("" : "+v"(fr), "+v"(fq));
        const int row0 = u.pm * 256 + wr * 64 + fr, col0 = u.pn * 256 + wc * 32 + 8 * fq;
#pragma unroll
        for (int ai = 0; ai < 2; ++ai)
#pragma unroll
            for (int m = 0; m < 4; ++m) { bf16_t* rowp = O + (size_t)(row0 + ai * 128 + m * 16) * ldc + col0;
#pragma unroll
                for (int bj = 0; bj < 2; ++bj) { const f32x4 v0 = acc[ai][bj][m][0], v1 = acc[ai][bj][m][1];
                    u32x4 w; w.x = cvt_pk_bf16(v0[0], v0[1]); w.y = cvt_pk_bf16(v0[2], v0[3]); w.z = cvt_pk_bf16(v1[0], v1[1]); w.w = cvt_pk_bf16(v1[2], v1[3]);
                    *(u32x4*)(rowp + bj * 128) = w; } }
    }
};
struct EpiResidual {
    static constexpr bool PERM = false;
    const float* xin32; bf16_t* xb; const float* gate;
    __device__ __forceinline__ void operator()(const f32x4 (&acc)[2][2][4][2], const Unit& u, int wr, int wc, int fr_, int fq_) const {
        int fr = fr_, fq = fq_; asm volatile("" : "+v"(fr), "+v"(fq));
        const int row0 = u.pm * 256 + wr * 64 + fr, col0 = u.pn * 256 + wc * 32 + 4 * fq;
        const int b = (u.pm * 256) >> 11;
        f32x4 gv[2][2];
#pragma unroll
        for (int bj = 0; bj < 2; ++bj)
#pragma unroll
            for (int n = 0; n < 2; ++n) gv[bj][n] = *(const f32x4*)(gate + (size_t)b * NMOD + col0 + bj * 128 + n * 16);
#pragma unroll
        for (int ai = 0; ai < 2; ++ai)
#pragma unroll
            for (int m = 0; m < 4; ++m) { const size_t ro = (size_t)(row0 + ai * 128 + m * 16) * D + col0;
#pragma unroll
                for (int bj = 0; bj < 2; ++bj)
#pragma unroll
                    for (int n = 0; n < 2; ++n) { const size_t o = ro + bj * 128 + n * 16;
                        f32x4 xv;
                        if (xin32) xv = *(const f32x4*)(xin32 + o);
                        else { const u32x2 w = *(const u32x2*)(xb + o); xv = (f32x4){bflo(w.x), bfhi(w.x), bflo(w.y), bfhi(w.y)}; }
                        const f32x4 r = xv + gv[bj][n] * acc[ai][bj][m][n];
                        u32x2 ow; ow.x = cvt_pk_bf16(r[0], r[1]); ow.y = cvt_pk_bf16(r[2], r[3]);
                        *(u32x2*)(xb + o) = ow; } }
    }
};
struct EpiMlaQ {
    static constexpr bool PERM = true;
    bf16_t* qm;
    __device__ __forceinline__ void operator()(const f32x4 (&acc)[2][2][4][2], const Unit& u, int wr, int wc, int fr_, int fq_) const {
        int fr = fr_, fq = fq_; asm volatile("" : "+v"(fr), "+v"(fq));
        const int row0 = u.pm * 256 + wr * 64 + fr;
#pragma unroll
        for (int bj = 0; bj < 2; ++bj) {
            const int col0 = u.pn * 256 + bj * 128 + wc * 32;
            if (col0 >= 384) continue;
#pragma unroll
            for (int ai = 0; ai < 2; ++ai)
#pragma unroll
                for (int m = 0; m < 4; ++m) { const f32x4 v0 = acc[ai][bj][m][0], v1 = acc[ai][bj][m][1];
                    u32x4 w; w.x = cvt_pk_bf16(v0[0], v0[1]); w.y = cvt_pk_bf16(v0[2], v0[3]); w.z = cvt_pk_bf16(v1[0], v1[1]); w.w = cvt_pk_bf16(v1[2], v1[3]);
                    *(u32x4*)(qm + (size_t)(row0 + ai * 128 + m * 16) * 384 + col0 + 8 * fq) = w; }
        }
    }
};
struct EpiMlaKV {
    static constexpr bool PERM = true;
    bf16_t* km; bf16_t* vm;
    __device__ __forceinline__ void operator()(const f32x4 (&acc)[2][2][4][2], const Unit& u, int wr, int wc, int fr_, int fq_) const {
        int fr = fr_, fq = fq_; asm volatile("" : "+v"(fr), "+v"(fq));
        const int row0 = u.pm * 256 + wr * 64 + fr;
#pragma unroll
        for (int bj = 0; bj < 2; ++bj) {
            const int head = u.pn * 2 + bj, wcol = wc * 32 + 8 * fq;
#pragma unroll
            for (int ai = 0; ai < 2; ++ai)
#pragma unroll
                for (int m = 0; m < 4; ++m) {
                    const int row = row0 + ai * 128 + m * 16;
                    const f32x4 v0 = acc[ai][bj][m][0], v1 = acc[ai][bj][m][1];
                    u32x4 w; w.x = cvt_pk_bf16(v0[0], v0[1]); w.y = cvt_pk_bf16(v0[2], v0[3]); w.z = cvt_pk_bf16(v1[0], v1[1]); w.w = cvt_pk_bf16(v1[2], v1[3]);
                    bf16_t* q = (wcol < 64) ? km + (size_t)row * 384 + head * 96 + wcol : vm + (size_t)row * 256 + head * 64 + (wcol - 64);
                    *(u32x4*)q = w;
                    asm volatile("" ::: "memory");
                }
        }
    }
};
struct EpiGateUp {
    static constexpr bool PERM = false;
    bf16_t* hid;
    __device__ __forceinline__ void operator()(const f32x4 (&acc)[2][2][4][2], const Unit& u, int wr, int wc, int fr_, int fq_) const {
        int fr = fr_, fq = fq_; asm volatile("" : "+v"(fr), "+v"(fq));
        const int row0 = u.pm * 256 + wr * 64 + fr;
#pragma unroll
        for (int ai = 0; ai < 2; ++ai)
#pragma unroll
            for (int m = 0; m < 4; ++m) { bf16_t* rowp = hid + (size_t)(row0 + ai * 128 + m * 16) * 256;
#pragma unroll
                for (int bj = 0; bj < 2; ++bj) { const f32x4 gt = acc[ai][bj][m][0], up = acc[ai][bj][m][1];
                    f32x4 o;
#pragma unroll
                    for (int j = 0; j < 4; ++j) o[j] = gt[j] / (1.f + __expf(-gt[j])) * up[j];
                    u32x2 w; w.x = cvt_pk_bf16(o[0], o[1]); w.y = cvt_pk_bf16(o[2], o[3]);
                    *(u32x2*)(rowp + 16 * (u.pn * 8 + bj * 4 + wc) + 4 * fq) = w; } }
    }
};
struct EpiDown {
    static constexpr bool PERM = true;
    bf16_t* ys; const int* list; const float* wl; const int* cnt;
    __device__ __forceinline__ void operator()(const f32x4 (&acc)[2][2][4][2], const Unit& u, int wr, int wc, int fr_, int fq_) const {
        int fr = fr_, fq = fq_; asm volatile("" : "+v"(fr), "+v"(fq));
        const int n = cnt[u.e]; const int* le = list + (size_t)u.e * ECAP; const float* we = wl + (size_t)u.e * ECAP;
        const int col0 = u.pn * 256 + wc * 32 + 8 * fq;
        int slot[8]; float w8[8];
#pragma unroll
        for (int q = 0; q < 8; ++q) { const int lr = u.mt * 256 + (q >> 2) * 128 + wr * 64 + (q & 3) * 16 + fr; slot[q] = lr < n ? le[lr] : -1; w8[q] = lr < n ? we[lr] : 0.f; }
#pragma unroll
        for (int ai = 0; ai < 2; ++ai)
#pragma unroll
            for (int m = 0; m < 4; ++m) {
                const int q = ai * 4 + m;
                if (slot[q] >= 0) {
                    bf16_t* rowp = ys + (size_t)slot[q] * D + col0;
#pragma unroll
                    for (int bj = 0; bj < 2; ++bj) { const f32x4 v0 = acc[ai][bj][m][0] * w8[q], v1 = acc[ai][bj][m][1] * w8[q];
                        u32x4 w; w.x = cvt_pk_bf16(v0[0], v0[1]); w.y = cvt_pk_bf16(v0[2], v0[3]); w.z = cvt_pk_bf16(v1[0], v1[1]); w.w = cvt_pk_bf16(v1[2], v1[3]);
                        *(u32x4*)(rowp + bj * 128) = w; }
                }
            }
    }
};
struct MoeOrder {
    int pre[17];
    int NT, G, c; const int* list; const int* cnt;
    __device__ __forceinline__ void init(const int* cnt_, const int* list_, int NT_, int G_, int c_) {
        cnt = cnt_; list = list_; NT = NT_; G = G_; c = c_; int a = 0;
#pragma unroll
        for (int e = 0; e < 16; ++e) { pre[e] = a; a += (cnt_[e] + 255) >> 8; }
        pre[16] = a;
    }
    __device__ __forceinline__ bool next(int i, Unit& u) const {
        const int L = i * G + c; if (L >= pre[16] * NT) return false;
        const int t = L / NT; int e = 0;
#pragma unroll
        for (int k = 1; k < 16; ++k) e += (t >= pre[k]) ? 1 : 0;
        int pe = 0;
#pragma unroll
        for (int k = 0; k < 16; ++k) pe = (k == e) ? pre[k] : pe;
        u.e = e; u.mt = t - pe; u.pm = t; u.pn = L - t * NT; return true;
    }
    __device__ __forceinline__ int arow(const Unit& u, int r) const { const int lr = u.mt * 256 + r; return lr < cnt[u.e] ? (list[(size_t)u.e * ECAP + lr] >> 1) : 0; }
};
}

namespace {
__device__ __forceinline__ void phase_prep(const Params& p, int l) {
    const int tid = opaque_tid(p.wid), w = tid >> 6, lane = tid & 63;
    const int gw = blockIdx.x * 8 + w, nw = gridDim.x * 8;
    for (int sq = gw; sq < NB * 4; sq += nw) {
        const int b = sq >> 2, hh = sq & 3; const float bias = p.b_forget[l * 4 + hh];
        float lf[32]; float run = 0.f;
#pragma unroll
        for (int j = 0; j < 32; ++j) {
            const float z = bf2f(p.proj[(size_t)(b * S + lane * 32 + j) * NP + PC_AF + hh]) + bias;
            run += fminf(z, 0.f) - log1pf(__expf(-fabsf(z)));
            lf[j] = run;
        }
        float incl = run;
#pragma unroll
        for (int o = 1; o < 64; o <<= 1) { const float t2 = __shfl_up(incl, o); if (lane >= o) incl += t2; }
        const float excl = incl - run;
#pragma unroll
        for (int j = 0; j < 32; ++j) p.cbF[(size_t)sq * S + lane * 32 + j] = -(excl + lf[j]) * LOG2E;
    }
    for (int c32 = gw; c32 < T / 32; c32 += nw) {
    float mxq = 0.f, mxk = 0.f;
#define PREP_LOAD(tt) do { const bf16_t* _row = p.proj + (size_t)(tt) * NP; \
        n_cq = *(const u32x2*)(_row + PC_BCQ + 4 * lane); n_ck = *(const unsigned*)(_row + PC_BCKV + 2 * lane); \
        n_aq = *(const u32x2*)(_row + PC_AQ + 4 * lane); n_ak = *(const u32x2*)(_row + PC_AK + 4 * lane); \
        n_ki = *(const u32x4*)(_row + PC_DKI + 8 * (lane & 3)); n_kr = _row[PC_BKR + (lane & 31)]; } while (0)
    u32x2 n_cq, n_aq, n_ak; unsigned n_ck; u32x4 n_ki; bf16_t n_kr;
    PREP_LOAD(c32 * 32);
    for (int it = 0; it < 32; ++it) {
        const int t = c32 * 32 + it;
        const u32x2 cq = n_cq, aq = n_aq, ak = n_ak; const unsigned ck = n_ck; const u32x4 ki = n_ki; const bf16_t krb = n_kr;
        if (it < 31) PREP_LOAD(t + 1);
        float s1 = bflo(cq.x) * bflo(cq.x) + bfhi(cq.x) * bfhi(cq.x) + bflo(cq.y) * bflo(cq.y) + bfhi(cq.y) * bfhi(cq.y);
        float s2 = bflo(ck) * bflo(ck) + bfhi(ck) * bfhi(ck);
        s1 = wave_sum(s1); s2 = wave_sum(s2);
        if (lane < 4) *(u32x4*)(p.kidx + (size_t)t * 32 + 8 * lane) = ki;
        {
            float nq = bflo(aq.x) * bflo(aq.x) + bfhi(aq.x) * bfhi(aq.x) + bflo(aq.y) * bflo(aq.y) + bfhi(aq.y) * bfhi(aq.y);
            float nk = bflo(ak.x) * bflo(ak.x) + bfhi(ak.x) * bfhi(ak.x) + bflo(ak.y) * bflo(ak.y) + bfhi(ak.y) * bfhi(ak.y);
#pragma unroll
            for (int o = 8; o > 0; o >>= 1) { nq += __shfl_xor(nq, o); nk += __shfl_xor(nk, o); }
            mxq = fmaxf(mxq, nq); mxk = fmaxf(mxk, nk);
        }
        const float kr = (lane < 32) ? bf2f(krb) : 0.f;
        const float kr2 = __shfl(kr, (lane + 16) & 63);
        {
            const float r1 = rsqrtf(s1 * (1.f / 256.f) + EPS), r2 = rsqrtf(s2 * (1.f / 128.f) + EPS);
            u32x2 o; o.x = cvt_pk_bf16(bflo(cq.x) * r1, bfhi(cq.x) * r1); o.y = cvt_pk_bf16(bflo(cq.y) * r1, bfhi(cq.y) * r1);
            *(u32x2*)(p.proj + (size_t)t * NP + PC_BCQ + 4 * lane) = o;
            *(unsigned*)(p.proj + (size_t)t * NP + PC_BCKV + 2 * lane) = cvt_pk_bf16(bflo(ck) * r2, bfhi(ck) * r2);
        }
        if (lane < 16) {
            const int pos = t & (S - 1);
            const float cs = p.ropetab[(pos * 16 + lane) * 2], sn = p.ropetab[(pos * 16 + lane) * 2 + 1];
            const bf16_t o1 = f2bf(kr * cs - kr2 * sn), o2 = f2bf(kr2 * cs + kr * sn);
            bf16_t* kmr = p.km + (size_t)t * 384;
#pragma unroll
            for (int hh = 0; hh < 4; ++hh) { kmr[hh * 96 + 64 + lane] = o1; kmr[hh * 96 + 80 + lane] = o2; }
        }
    }
#undef PREP_LOAD
    if ((lane & 15) == 0) {
        const int t = c32 * 32, bb = t >> 11, pos = t & (S - 1), hh = lane >> 4;
        atomicMax(p.ctl + CW_KN2 + ((l * NB + bb) * 4 + hh) * 32 + (pos >> 6), __float_as_uint(mxk));
        atomicMax(p.ctl + CW_QN2 + ((l * NB + bb) * 4 + hh) * 8 + (pos >> 8), __float_as_uint(mxq));
    }
    }
}

__device__ __forceinline__ void phase_route(const Params& p, int l, char* lds) {
    const int tid = opaque_tid(p.wid), w = tid >> 6, lane = tid & 63;
    float* wrT = (float*)lds;
    int* lcnt = (int*)(lds + 65536);
    int* lbase = (int*)(lds + 65536 + 64);
    int* tsel = (int*)(lds + 65536 + 128);
    float* twt = (float*)(lds + 65536 + 128 + 2048);
    for (int i = tid; i < 16 * 1024; i += 512) { const int e = i >> 10, d = i & 1023; wrT[i] = p.w_router[d * 16 + e]; }
    const float* g = p.g_norm2 + l * D;
    const float* modl = p.mod + (size_t)l * NB * NMOD;
    int* cnt = (int*)(p.ctl + CW_CNT) + l * 16 + 32 * p.qslot;
    int* list = p.list + (size_t)p.qslot * 16 * ECAP;
    for (int chunk = blockIdx.x; chunk < T / 256; chunk += gridDim.x) {
        if (tid < 16) lcnt[tid] = 0;
        __syncthreads();
        const int b = (chunk * 256) >> 11;
        f32x4 gg4[4], sc4[4], sh4[4];
#pragma unroll
        for (int k = 0; k < 4; ++k) { const int col = 4 * lane + 256 * k; gg4[k] = *(const f32x4*)(g + col);
            sc4[k] = *(const f32x4*)(modl + (size_t)b * NMOD + 4 * 1024 + col); sh4[k] = *(const f32x4*)(modl + (size_t)b * NMOD + 3 * 1024 + col); }
        const int eown = ((lane >> 5) & 1) * 8 + ((lane >> 4) & 1) * 4 + ((lane >> 3) & 1) * 2 + ((lane >> 2) & 1);
        const float brown = p.b_router[eown];
        f32x4 vn[4];
#pragma unroll
        for (int k = 0; k < 4; ++k) { const u32x2 w2 = *(const u32x2*)(p.xb + (size_t)(chunk * 256 + w * 32) * D + 4 * lane + 256 * k); vn[k] = (f32x4){bflo(w2.x), bfhi(w2.x), bflo(w2.y), bfhi(w2.y)}; }
        for (int it = 0; it < 32; ++it) {
            const int li = w * 32 + it, t = chunk * 256 + li;
            f32x4 v[4];
#pragma unroll
            for (int k = 0; k < 4; ++k) v[k] = vn[k];
            if (it < 31) {
#pragma unroll
                for (int k = 0; k < 4; ++k) { const u32x2 w2 = *(const u32x2*)(p.xb + (size_t)(t + 1) * D + 4 * lane + 256 * k); vn[k] = (f32x4){bflo(w2.x), bfhi(w2.x), bflo(w2.y), bfhi(w2.y)}; }
            }
            float ss = 0.f;
#pragma unroll
            for (int k = 0; k < 4; ++k) ss += v[k][0] * v[k][0] + v[k][1] * v[k][1] + v[k][2] * v[k][2] + v[k][3] * v[k][3];
            ss = wave_sum(ss);
            const float r = rsqrtf(ss * (1.0f / D) + EPS);
            float lg[16];
#pragma unroll
            for (int e = 0; e < 16; ++e) lg[e] = 0.f;
#pragma unroll
            for (int k = 0; k < 4; ++k) {
                const int col = 4 * lane + 256 * k;
                const f32x4 y = v[k] * r * gg4[k] * (1.f + sc4[k]) + sh4[k];
                u32x2 o; o.x = cvt_pk_bf16(y[0], y[1]); o.y = cvt_pk_bf16(y[2], y[3]);
                *(u32x2*)(p.h + (size_t)t * D + col) = o;
#pragma unroll
                for (int e = 0; e < 16; ++e) { const f32x4 wv = *(const f32x4*)(wrT + e * 1024 + col); lg[e] += y[0] * wv[0] + y[1] * wv[1] + y[2] * wv[2] + y[3] * wv[3]; }
                asm volatile("" ::: "memory");
            }
            float a8[8], a4[4], a2[2], a1;
            { const bool hi = (lane & 32) != 0;
#pragma unroll
              for (int e = 0; e < 8; ++e) { const float send = hi ? lg[e] : lg[e + 8], keep = hi ? lg[e + 8] : lg[e]; a8[e] = keep + __shfl_xor(send, 32); } }
            { const bool hi = (lane & 16) != 0;
#pragma unroll
              for (int e = 0; e < 4; ++e) { const float send = hi ? a8[e] : a8[e + 4], keep = hi ? a8[e + 4] : a8[e]; a4[e] = keep + __shfl_xor(send, 16); } }
            { const bool hi = (lane & 8) != 0;
#pragma unroll
              for (int e = 0; e < 2; ++e) { const float send = hi ? a4[e] : a4[e + 2], keep = hi ? a4[e + 2] : a4[e]; a2[e] = keep + __shfl_xor(send, 8); } }
            { const bool hi = (lane & 4) != 0; const float send = hi ? a2[0] : a2[1], keep = hi ? a2[1] : a2[0]; a1 = keep + __shfl_xor(send, 4); }
            a1 += __shfl_xor(a1, 2); a1 += __shfl_xor(a1, 1);
            const float sown = 1.f / (1.f + expf(-a1)), bown = sown + brown;
            float sc[16], bi[16];
#pragma unroll
            for (int e = 0; e < 16; ++e) { const int src = ((e >> 3) & 1) * 32 + ((e >> 2) & 1) * 16 + ((e >> 1) & 1) * 8 + (e & 1) * 4;
                sc[e] = __builtin_bit_cast(float, __builtin_amdgcn_readlane(__builtin_bit_cast(int, sown), src));
                bi[e] = __builtin_bit_cast(float, __builtin_amdgcn_readlane(__builtin_bit_cast(int, bown), src)); }
            int bg = 0; float bgs = -INFINITY;
#pragma unroll
            for (int gi = 0; gi < 4; ++gi) {
                float m1 = -INFINITY, m2 = -INFINITY;
#pragma unroll
                for (int j = 0; j < 4; ++j) { const float vv = bi[gi * 4 + j]; if (vv > m1) { m2 = m1; m1 = vv; } else if (vv > m2) m2 = vv; }
                const float gs = m1 + m2; if (gs > bgs) { bgs = gs; bg = gi; }
            }
            float b4[4], s4[4];
#pragma unroll
            for (int gi = 0; gi < 4; ++gi)
#pragma unroll
                for (int j = 0; j < 4; ++j) if (gi == bg) { b4[j] = bi[gi * 4 + j]; s4[j] = sc[gi * 4 + j]; }
            int i1 = 0; float v1 = -INFINITY;
#pragma unroll
            for (int j = 0; j < 4; ++j) { if (b4[j] > v1) { v1 = b4[j]; i1 = j; } }
            int i2 = 0; float v2 = -INFINITY;
#pragma unroll
            for (int j = 0; j < 4; ++j) { if (j != i1 && b4[j] > v2) { v2 = b4[j]; i2 = j; } }
            float w1 = 0.f, w2 = 0.f;
#pragma unroll
            for (int j = 0; j < 4; ++j) { if (j == i1) w1 = s4[j]; if (j == i2) w2 = s4[j]; }
            if (lane == 0) {
                const int e1 = bg * 4 + i1, e2 = bg * 4 + i2; const float ws = w1 + w2;
                const int r1 = atomicAdd(&lcnt[e1], 1), r2 = atomicAdd(&lcnt[e2], 1);
                tsel[li * 2 + 0] = (e1 << 16) | r1; tsel[li * 2 + 1] = (e2 << 16) | r2;
                twt[li * 2 + 0] = w1 / ws; twt[li * 2 + 1] = w2 / ws;
            }
        }
        __syncthreads();
        if (tid < 16) lbase[tid] = atomicAdd(&cnt[tid], lcnt[tid]);
        __syncthreads();
        { const int v = tsel[tid], e = v >> 16, rk = v & 0xFFFF; const size_t pos = (size_t)e * ECAP + lbase[e] + rk;
          list[pos] = (chunk * 256 + (tid >> 1)) * 2 + (tid & 1); p.wl[pos + (size_t)p.qslot * 16 * ECAP] = twt[tid]; }
        __syncthreads();
    }
}
}

#ifndef ATTN_VMASK
#define ATTN_VMASK 15
#endif
#ifndef REPK_VMASK
#define REPK_VMASK 15
#endif
#ifndef ATTN_EXP
#define ATTN_EXP 0
#endif
#define AEXP(k) (ATTN_EXP == (k) && xq)
namespace {
constexpr int AT_KB = 0;
constexpr int AT_KR = 16384;
constexpr int AT_VB = 24576;
constexpr int AT_CB = 40960;
constexpr int AT_CTL = 41472;
constexpr int AT_LDS = 41984;
constexpr float NEGBIG = -1.0e30f;

template <int VAR, int KC>
__device__ __forceinline__ void attn_tile(LAS3 char* lds, const int buf, const int j, const int q0, const int i, const int g, const int swk, const float slope2,
                                          const bf16x8 (&qf)[2][KC], f32x4 (&o)[2][4], float (&mrow)[2], float (&lsum)[2], const u32x4 (&mwd)[2][4], const bool xq) {
    typedef LAS3 bf16x4 lds_bf16x4;
    bool need = (64 * j <= q0 + 31);
    if (VAR == 2) need = need && (64 * j + 63 >= q0 - 127);
    if (need) {
        const LAS3 char* Kb = lds + AT_KB + buf * 8192; const LAS3 char* Vb = lds + AT_VB + buf * 8192;
        bool full = (64 * j + 63 <= q0);
        if (VAR == 2) full = full && (64 * j >= q0 - 96);
        if (VAR == 3) full = false;
        f32x4 s[2][4];
#pragma unroll
        for (int qt = 0; qt < 2; ++qt) {
            const int t = q0 + 16 * qt + i;
            const int dbase = 64 * j + 4 * g - t;
            const float sb = slope2 * ((VAR == 2) ? (float)dbase : (float)(64 * j + 4 * g));
#pragma unroll
            for (int mt = 0; mt < 4; ++mt) {
                f32x4 ini = {0.f, 0.f, 0.f, 0.f};
                if (VAR == 0) ini = *(const LAS3 f32x4*)(lds + AT_CB + buf * 256 + (16 * mt + 4 * g) * 4);
#pragma unroll
                for (int r = 0; r < 4; ++r) {
                    const int c = 16 * mt + r;
                    float v = ini[r];
                    if (VAR >= 2) v = sb + slope2 * (float)c;
                    if (VAR == 3) {
                        const int m = ((int)(mwd[qt][mt][r] << (31 - j))) >> 31;
                        v = __uint_as_float((__float_as_uint(v) & (unsigned)m) | (__float_as_uint(NEGBIG) & ~(unsigned)m));
                    } else if (!full) {
                        bool ok;
                        if (VAR == 2) ok = (unsigned)(dbase + c + 127) < 128u;
                        else ok = (dbase + c) <= 0;
                        v = ok ? v : NEGBIG;
                    }
                    ini[r] = v;
                }
                s[qt][mt] = ini;
            }
        }
        if (!AEXP(2))
#pragma unroll
        for (int mt = 0; mt < 4; ++mt) {
#pragma unroll
            for (int kc = 0; kc < 2; ++kc) {
                const bf16x8 kf = *(const LAS3 bf16x8*)(Kb + (mt * 16 + i) * 128 + (((kc * 4 + g) ^ swk) << 4));
                s[0][mt] = __builtin_amdgcn_mfma_f32_16x16x32_bf16(kf, qf[0][kc], s[0][mt], 0, 0, 0);
                s[1][mt] = __builtin_amdgcn_mfma_f32_16x16x32_bf16(kf, qf[1][kc], s[1][mt], 0, 0, 0);
            }
            if (VAR == 1) {
                const bf16x8 kf = *(const LAS3 bf16x8*)(lds + AT_KR + buf * 4096 + (mt * 16 + i) * 64 + ((g ^ (swk & 3)) << 4));
                s[0][mt] = __builtin_amdgcn_mfma_f32_16x16x32_bf16(kf, qf[0][KC - 1], s[0][mt], 0, 0, 0);
                s[1][mt] = __builtin_amdgcn_mfma_f32_16x16x32_bf16(kf, qf[1][KC - 1], s[1][mt], 0, 0, 0);
            }
        }
        bf16x8 pf[2][2];
#pragma unroll
        for (int qt = 0; qt < 2; ++qt) {
            float mx = fmaxf(fmaxf(s[qt][0][0], s[qt][0][1]), fmaxf(s[qt][0][2], s[qt][0][3]));
#pragma unroll
            for (int mt = 1; mt < 4; ++mt) mx = fmaxf(mx, fmaxf(fmaxf(s[qt][mt][0], s[qt][mt][1]), fmaxf(s[qt][mt][2], s[qt][mt][3])));
            mx = fmaxf(mx, __builtin_bit_cast(float, __builtin_amdgcn_ds_swizzle(__builtin_bit_cast(int, mx), 0x401F)));
            mx = xor32_max(mx);
            if (__any(mx > mrow[qt])) {
                const float mn = fmaxf(mrow[qt], mx), alpha = __builtin_amdgcn_exp2f(mrow[qt] - mn);
                mrow[qt] = mn; lsum[qt] *= alpha;
#pragma unroll
                for (int dt = 0; dt < 4; ++dt) o[qt][dt] = o[qt][dt] * alpha;
            }
            const float mn = mrow[qt];
            const f32x4 mn4 = {mn, mn, mn, mn};
            f32x4 ps4 = {0.f, 0.f, 0.f, 0.f};
            float x[4][4];
#pragma unroll
            for (int mt = 0; mt < 4; ++mt) {
                const f32x4 d4 = s[qt][mt] - mn4;
                f32x4 e4;
#pragma unroll
                for (int r = 0; r < 4; ++r) { e4[r] = AEXP(3) ? d4[r] : __builtin_amdgcn_exp2f(d4[r]); x[mt][r] = e4[r]; }
                ps4 += e4;
            }
            lsum[qt] += (ps4[0] + ps4[1]) + (ps4[2] + ps4[3]);
#pragma unroll
            for (int c = 0; c < 2; ++c) {
                u32x4 pk; pk.x = cvt_pk_bf16(x[2 * c][0], x[2 * c][1]); pk.y = cvt_pk_bf16(x[2 * c][2], x[2 * c][3]);
                pk.z = cvt_pk_bf16(x[2 * c + 1][0], x[2 * c + 1][1]); pk.w = cvt_pk_bf16(x[2 * c + 1][2], x[2 * c + 1][3]);
                pf[qt][c] = __builtin_bit_cast(bf16x8, pk);
            }
        }
        const int q4 = i >> 2, p4 = i & 3;
        if (!AEXP(4))
#pragma unroll
        for (int c = 0; c < 2; ++c) {
            const int row0 = 32 * c + 4 * g + q4, swv = (row0 >> 1) & 3;
#pragma unroll
            for (int dt = 0; dt < 4; ++dt) {
                const LAS3 char* a0 = Vb + row0 * 128 + ((dt ^ swv) << 5) + p4 * 8;
                const bf16x4 v0 = __builtin_amdgcn_ds_read_tr16_b64_v4i16((lds_bf16x4*)(a0));
                const bf16x4 v1 = __builtin_amdgcn_ds_read_tr16_b64_v4i16((lds_bf16x4*)(a0 + 16 * 128));
                const bf16x8 vf = {v0[0], v0[1], v0[2], v0[3], v1[0], v1[1], v1[2], v1[3]};
                o[0][dt] = __builtin_amdgcn_mfma_f32_16x16x32_bf16(vf, pf[0][c], o[0][dt], 0, 0, 0);
                o[1][dt] = __builtin_amdgcn_mfma_f32_16x16x32_bf16(vf, pf[1][c], o[1][dt], 0, 0, 0);
            }
        }
    }
}

template <int VAR>
__device__ __forceinline__ void attn_unit(const Params& p, int l, int b, int hx, int qb, LAS3 char* lds) {
    typedef LAS3 bf16x4 lds_bf16x4;
    constexpr int KC = (VAR == 1) ? 3 : 2;
    const int tid = opaque_tid(p.wid), w = __builtin_amdgcn_readfirstlane(tid >> 6), lane = tid & 63, i = lane & 15, g = lane >> 4;
    const bf16_t *Qp, *Kp, *Vp; int ldq, ldk, ldv, q0, j0, j1, ocol; float c1, slope2 = 0.f;
    if (VAR == 0) { Qp = p.proj + PC_AQ + hx * 64; Kp = p.proj + PC_AK + hx * 64; Vp = p.proj + PC_AV + hx * 64; ldq = ldk = ldv = NP;
                    q0 = qb * 256 + 32 * w; j0 = 0; j1 = 4 * qb + 3; ocol = hx * 64; c1 = 0.125f * LOG2E; }
    else if (VAR == 1) { Qp = p.qm + hx * 96; Kp = p.km + hx * 96; Vp = p.vm + hx * 64; ldq = 384; ldk = 384; ldv = 256;
                    q0 = qb * 256 + 32 * w; j0 = 0; j1 = 4 * qb + 3; ocol = 256 + hx * 64; c1 = 0.10206207261596577f * LOG2E; }
    else if (VAR == 2) { const int qh = hx * 2 + (w >> 2); Qp = p.proj + PC_CQ + qh * 64; Kp = p.proj + PC_CK + hx * 64; Vp = p.proj + PC_CV + hx * 64; ldq = ldk = ldv = NP;
                    q0 = qb * 128 + 32 * (w & 3); j0 = 2 * qb - 2 > 0 ? 2 * qb - 2 : 0; j1 = 2 * qb + 1; ocol = 512 + qh * 64; c1 = 0.125f * LOG2E;
                    slope2 = exp2f(-(float)(qh + 1)) * LOG2E; }
    else { const int hd = w >> 1; Qp = p.proj + PC_DQ + hd * 64; Kp = p.proj + PC_DK; Vp = p.proj + PC_DV; ldq = ldk = ldv = NP;
                    q0 = qb * 64 + 32 * (w & 1); j0 = 0; j1 = qb; ocol = 768 + hd * 64; c1 = 0.125f * LOG2E; slope2 = exp2f(-(float)(hd + 5)) * LOG2E; }
    const size_t tok0 = (size_t)b * S;
    const bool xq = p.qslot > 0;
    if (VAR == 0 && qb > 0) {
        constexpr float FOX_DROP = 64.0f;
        const unsigned* kn2 = p.ctl + CW_KN2 + ((l * NB + b) * 4 + hx) * 32;
        const float* cbh = p.cbF + ((size_t)b * 4 + hx) * S;
        const float qn = c1 * sqrtf(__uint_as_float(p.ctl[CW_QN2 + ((l * NB + b) * 4 + hx) * 8 + qb]));
        float knu = 0.f;
        for (int jj = 4 * qb; jj < 4 * qb + 4; ++jj) knu = fmaxf(knu, __uint_as_float(kn2[jj]));
        const float lower = cbh[256 * qb] - qn * sqrtf(knu);
        const int jl = lane & 31;
        const bool keep = qn * sqrtf(__uint_as_float(kn2[jl])) + cbh[64 * jl + 63] - lower >= -FOX_DROP || jl >= 4 * qb;
        const unsigned long long kb = __ballot(keep) & 0xFFFFFFFFull;
        j0 = kb ? (int)__builtin_ctzll(kb) : 4 * qb;
    }
    bf16x8 qf[2][KC];
#pragma unroll
    for (int qt = 0; qt < 2; ++qt)
#pragma unroll
        for (int kc = 0; kc < KC; ++kc) qf[qt][kc] = *(const bf16x8*)(Qp + (tok0 + q0 + 16 * qt + i) * ldq + kc * 32 + 8 * g);
    const int sr = tid >> 3, sc8 = tid & 7;
    const int kdst = sr * 128 + ((sc8 ^ ((sr >> 1) & 7)) << 4);
    const int vdst = sr * 128 + (((((sc8 >> 1) ^ ((sr >> 1) & 3)) << 1) | (sc8 & 1)) << 4);
    const int rr = (tid & 255) >> 2, rc4 = tid & 3;
    const int rdst = rr * 64 + ((rc4 ^ ((rr >> 1) & 3)) << 4);
    u32x4 kstA, vstA, rstA = {0u, 0u, 0u, 0u}, kstB, vstB, rstB = {0u, 0u, 0u, 0u}; float cstA = 0.f, cstB = 0.f;
    u32x4 mwd[2][4];
#pragma unroll
    for (int qt = 0; qt < 2; ++qt)
#pragma unroll
        for (int mt = 0; mt < 4; ++mt) mwd[qt][mt] = (VAR == 3) ? *(const u32x4*)(p.mask + (tok0 + q0 + 16 * qt + i) * 64 + 16 * mt + 4 * g) : (u32x4){0u, 0u, 0u, 0u};
#define AT_LOAD(ZZ, j) do { if (AEXP(1)) break; const size_t _kr = tok0 + 64 * (j) + sr; \
        kst##ZZ = *(const u32x4*)(Kp + _kr * ldk + sc8 * 8); vst##ZZ = *(const u32x4*)(Vp + _kr * ldv + sc8 * 8); \
        if (VAR == 1) rst##ZZ = *(const u32x4*)(Kp + (tok0 + 64 * (j) + rr) * ldk + 64 + rc4 * 8); \
        if (VAR == 0) cst##ZZ = p.cbF[((size_t)b * 4 + hx) * S + 64 * (j) + (tid & 63)]; } while (0)
#define AT_WRITE(ZZ, buf) do { if (AEXP(1)) break; *(LAS3 u32x4*)(lds + AT_KB + (buf) * 8192 + kdst) = kst##ZZ; *(LAS3 u32x4*)(lds + AT_VB + (buf) * 8192 + vdst) = vst##ZZ; \
        if (VAR == 1 && tid < 256) *(LAS3 u32x4*)(lds + AT_KR + (buf) * 4096 + rdst) = rst##ZZ; \
        if (VAR == 0 && tid < 64) *(LAS3 float*)(lds + AT_CB + (buf) * 256 + tid * 4) = cst##ZZ; } while (0)
    AT_LOAD(A, j0);
    AT_LOAD(B, (j0 + 1 <= j1 ? j0 + 1 : j1));
    if (VAR == 1) {
#pragma unroll
        for (int qt = 0; qt < 2; ++qt) {
            const int pos = q0 + 16 * qt + i;
            const u32x4 mine = __builtin_bit_cast(u32x4, qf[qt][KC - 1]);
            u32x4 oth; oth.x = __shfl_xor(mine.x, 32); oth.y = __shfl_xor(mine.y, 32); oth.z = __shfl_xor(mine.z, 32); oth.w = __shfl_xor(mine.w, 32);
            const float* rt = p.ropetab + (size_t)(pos * 16 + (g & 1) * 8) * 2;
            const float sg = (g < 2) ? -1.f : 1.f;
            u32x4 res;
#pragma unroll
            for (int e2 = 0; e2 < 4; ++e2) {
                const f32x4 cs = *(const f32x4*)(rt + e2 * 4);
                const unsigned mw_ = e2 == 0 ? mine.x : e2 == 1 ? mine.y : e2 == 2 ? mine.z : mine.w, ow_ = e2 == 0 ? oth.x : e2 == 1 ? oth.y : e2 == 2 ? oth.z : oth.w;
                const float r0 = bflo(mw_) * cs[0] + sg * bflo(ow_) * cs[1], r1 = bfhi(mw_) * cs[2] + sg * bfhi(ow_) * cs[3];
                const unsigned pk = cvt_pk_bf16(r0, r1);
                if (e2 == 0) res.x = pk; else if (e2 == 1) res.y = pk; else if (e2 == 2) res.z = pk; else res.w = pk;
            }
            qf[qt][KC - 1] = __builtin_bit_cast(bf16x8, res);
        }
    }
#pragma unroll
    for (int qt = 0; qt < 2; ++qt)
#pragma unroll
        for (int kc = 0; kc < KC; ++kc) {
            u32x4 qq = __builtin_bit_cast(u32x4, qf[qt][kc]);
            qq.x = cvt_pk_bf16(bflo(qq.x) * c1, bfhi(qq.x) * c1); qq.y = cvt_pk_bf16(bflo(qq.y) * c1, bfhi(qq.y) * c1);
            qq.z = cvt_pk_bf16(bflo(qq.z) * c1, bfhi(qq.z) * c1); qq.w = cvt_pk_bf16(bflo(qq.w) * c1, bfhi(qq.w) * c1);
            qf[qt][kc] = __builtin_bit_cast(bf16x8, qq);
        }
    f32x4 o[2][4];
#pragma unroll
    for (int qt = 0; qt < 2; ++qt)
#pragma unroll
        for (int dt = 0; dt < 4; ++dt) o[qt][dt] = (f32x4){0.f, 0.f, 0.f, 0.f};
    float mrow[2] = {NEGBIG, NEGBIG}, lsum[2] = {0.f, 0.f};
    AT_WRITE(A, j0 & 1);
    __syncthreads();
    const int swk = (i >> 1) & 7;
    for (int j = j0; j <= j1; j += 2) {
        AT_LOAD(A, (j + 2 <= j1 ? j + 2 : j1));
        attn_tile<VAR, KC>(lds, j & 1, j, q0, i, g, swk, slope2, qf, o, mrow, lsum, mwd, xq);
        if (j + 1 <= j1) AT_WRITE(B, (j + 1) & 1);
        if (!AEXP(5)) __syncthreads();
        if (j + 1 > j1) break;
        AT_LOAD(B, (j + 3 <= j1 ? j + 3 : j1));
        attn_tile<VAR, KC>(lds, (j + 1) & 1, j + 1, q0, i, g, swk, slope2, qf, o, mrow, lsum, mwd, xq);
        if (j + 2 <= j1) AT_WRITE(A, j & 1);
        if (!AEXP(5)) __syncthreads();
    }
#undef AT_LOAD
#undef AT_WRITE
#pragma unroll
    for (int qt = 0; qt < 2; ++qt) {
        float lt = lsum[qt]; lt += __shfl_xor(lt, 16); lt += __shfl_xor(lt, 32);
        if (VAR == 2) lt += __builtin_amdgcn_exp2f(p.sinks[l * 4 + hx * 2 + (w >> 2)] * LOG2E - mrow[qt]);
        const float inv = 1.f / lt;
        bf16_t* op = p.merged + (tok0 + q0 + 16 * qt + i) * D + ocol + 4 * g;
        if (!(ATTN_EXP != 0 && xq))
#pragma unroll
        for (int dt = 0; dt < 4; ++dt) { const f32x4 v = o[qt][dt] * inv; u32x2 w2; w2.x = cvt_pk_bf16(v[0], v[1]); w2.y = cvt_pk_bf16(v[2], v[3]); *(u32x2*)(op + 16 * dt) = w2; }
    }
}

__device__ __forceinline__ void phase_attn(const Params& p, int l, LAS3 char* lds) {
    const int tid = opaque_tid(p.wid);
    unsigned* qhead = p.ctl + CW_QA + 64 * (l + 2 * p.qslot);
    volatile LAS3 int* bc = (volatile LAS3 int*)(lds + AT_CTL);
    int nxt = 0;
    if (tid == 0) nxt = (int)__hip_atomic_fetch_add(qhead, 1u, __ATOMIC_RELAXED, __HIP_MEMORY_SCOPE_AGENT);
    for (;;) {
        if (tid == 0) *bc = nxt;
        __syncthreads();
        const int idx = __builtin_amdgcn_readfirstlane(*bc);
        __syncthreads();
        if (idx >= 4096) break;
        if (tid == 0) nxt = (int)__hip_atomic_fetch_add(qhead, 1u, __ATOMIC_RELAXED, __HIP_MEMORY_SCOPE_AGENT);
        const int vmask = p.qslot ? REPK_VMASK : ATTN_VMASK;
        if (idx < 3072) {
            const int lvl = 7 - idx / 384, rem = idx % 384;
            if (rem < 128) { if (vmask & 2) attn_unit<1>(p, l, rem >> 2, rem & 3, lvl, lds); }
            else if (rem < 256) { if (vmask & 1) attn_unit<0>(p, l, (rem - 128) >> 2, rem & 3, lvl, lds); }
            else { const int d = rem - 256; if (vmask & 8) attn_unit<3>(p, l, d & 31, 0, 4 * lvl + 3 - (d >> 5), lds); }
        } else { const int c = idx - 3072; if (vmask & 4) attn_unit<2>(p, l, c >> 5, (c >> 4) & 1, c & 15, lds); }
    }
}
}

namespace {
constexpr int DS_LD = 2052;
constexpr int DS_CTL = 16 * DS_LD * 4;
constexpr int DS_LDS = DS_CTL + 64;

__device__ __forceinline__ void dsa_unit(const Params& p, int u, LAS3 char* lds) {
    const int tid = opaque_tid(p.wid), w = __builtin_amdgcn_readfirstlane(tid >> 6), lane = tid & 63, i = lane & 15, g = lane >> 4;
    const int b = u >> 7, t0 = (u & 127) * 16;
    const size_t tok0 = (size_t)b * S;
    uint32_t* mbase = p.mask + (tok0 + t0) * 64;
    if (t0 + 16 <= 256) {
#pragma unroll
        for (int qq = 0; qq < 2; ++qq) {
            const int q = 2 * w + qq, n = t0 + q + 1;
            const int cnt = n > lane ? ((n - lane + 63) >> 6) : 0;
            mbase[q * 64 + lane] = cnt >= 32 ? 0xFFFFFFFFu : ((1u << cnt) - 1u);
        }
        return;
    }
    const int nreg = (t0 + 16 + 63) >> 6;
    const int ntile = nreg * 4;
    bf16x8 qf[8]; float wq[8];
    {
        const bf16_t* qrow = p.proj + (tok0 + t0 + i) * NP;
#pragma unroll
        for (int h = 0; h < 8; ++h) qf[h] = *(const bf16x8*)(qrow + PC_DQI + h * 32 + 8 * g);
        const u32x4 ww = *(const u32x4*)(qrow + PC_DWI);
        const float sc = 0.35355339059327373f * 0.17677669529663687f;
        wq[0] = bflo(ww.x) * sc; wq[1] = bfhi(ww.x) * sc; wq[2] = bflo(ww.y) * sc; wq[3] = bfhi(ww.y) * sc;
        wq[4] = bflo(ww.z) * sc; wq[5] = bfhi(ww.z) * sc; wq[6] = bflo(ww.w) * sc; wq[7] = bfhi(ww.w) * sc;
    }
    const int tq = t0 + i;
#ifndef DSA_EXP
#define DSA_EXP 0
#endif
    const bool exp_skip_score = (DSA_EXP == 2) && p.qslot > 0, exp_skip_sel = (DSA_EXP == 1) && p.qslot > 0, exp_nostore = (DSA_EXP != 0) && p.qslot > 0;
    if (!exp_skip_score)
    for (int base = w; base < ntile; base += 32) {
        bf16x8 kf4[4];
#pragma unroll
        for (int uu = 0; uu < 4; ++uu) { const int kt = base + 8 * uu; if (kt < ntile) kf4[uu] = *(const bf16x8*)(p.kidx + (tok0 + 16 * kt + i) * 32 + 8 * g); }
#pragma unroll
        for (int uu = 0; uu < 4; ++uu) {
            const int kt = base + 8 * uu;
            if (kt < ntile) {
                f32x4 sc4 = {0.f, 0.f, 0.f, 0.f};
#pragma unroll
                for (int h = 0; h < 8; ++h) {
                    const f32x4 c = __builtin_amdgcn_mfma_f32_16x16x32_bf16(kf4[uu], qf[h], (f32x4){0.f, 0.f, 0.f, 0.f}, 0, 0, 0);
#pragma unroll
                    for (int r = 0; r < 4; ++r) sc4[r] += wq[h] * fmaxf(c[r], 0.f);
                }
                u32x4 ko;
#pragma unroll
                for (int r = 0; r < 4; ++r) {
                    const int key = 16 * kt + 4 * g + r;
                    unsigned uu2 = __float_as_uint(sc4[r]); if (uu2 == 0x80000000u) uu2 = 0u;
                    uu2 = (uu2 & 0x80000000u) ? ~uu2 : (uu2 | 0x80000000u);
                    ko[r] = (key <= tq) ? uu2 : 0u;
                }
                *(LAS3 u32x4*)(lds + ((size_t)i * DS_LD + 16 * kt + 4 * g) * 4) = ko;
            }
        }
    }
    __syncthreads();
    if (!exp_skip_sel)
    {
        const int qA = 2 * w, qB = 2 * w + 1;
        const LAS3 unsigned* kpA = (const LAS3 unsigned*)(lds + (size_t)qA * DS_LD * 4);
        const LAS3 unsigned* kpB = (const LAS3 unsigned*)(lds + (size_t)qB * DS_LD * 4);
        unsigned PA[32], PB[32];
        const int nv = nreg * 64;
#pragma unroll
        for (int r = 0; r < 32; ++r) {
            int idx = r * 64 + lane; asm volatile("" : "+v"(idx));
            const unsigned va = kpA[r * 64 + lane], vb = kpB[r * 64 + lane];
            PA[r] = (idx < nv) ? va : 0u; PB[r] = (idx < nv) ? vb : 0u;
        }
#define DSA_TR(P, j, m) do { _Pragma("unroll") for (int k = 0; k < 32; ++k) if ((k & (j)) == 0) { const unsigned x = P[k], y = P[k + (j)]; \
            P[k] = (x & (m)) | ((y << (j)) & ~(m)); P[k + (j)] = ((x >> (j)) & (m)) | (y & ~(m)); } } while (0)
        DSA_TR(PA, 16, 0x0000FFFFu); DSA_TR(PB, 16, 0x0000FFFFu); DSA_TR(PA, 8, 0x00FF00FFu); DSA_TR(PB, 8, 0x00FF00FFu);
        DSA_TR(PA, 4, 0x0F0F0F0Fu); DSA_TR(PB, 4, 0x0F0F0F0Fu); DSA_TR(PA, 2, 0x33333333u); DSA_TR(PB, 2, 0x33333333u);
        DSA_TR(PA, 1, 0x55555555u); DSA_TR(PB, 1, 0x55555555u);
#undef DSA_TR
        unsigned alA = 0xFFFFFFFFu, abA = 0u, selA = 0u, alB = 0xFFFFFFFFu, abB = 0u, selB = 0u;
        bool exA = false, exB = false;
#pragma unroll
        for (int bit = 31; bit >= 0; --bit) {
            if (!(exA && exB)) {
                const unsigned cA = abA | (alA & PA[bit]), cB = abB | (alB & PB[bit]);
                const int na = exA ? 0 : wave_reduce_add(__builtin_popcount(cA)), nb = exB ? 0 : wave_reduce_add(__builtin_popcount(cB));
                if (!exA) { if (na >= 256) { if (na == 256) { exA = true; selA = cA; } alA &= PA[bit]; } else { abA |= alA & PA[bit]; alA &= ~PA[bit]; } }
                if (!exB) { if (nb >= 256) { if (nb == 256) { exB = true; selB = cB; } alB &= PB[bit]; } else { abB |= alB & PB[bit]; alB &= ~PB[bit]; } }
            }
        }
        const unsigned long long lt = (lane == 0) ? 0ull : (~0ull >> (64 - lane));
#pragma unroll 1
        for (int qq = 0; qq < 2; ++qq) {
            const bool exact = qq ? exB : exA;
            unsigned sel = qq ? selB : selA;
            if (!exact) {
                const unsigned al = qq ? alB : alA, ab = qq ? abB : abA;
                const int need = 256 - wave_reduce_add(__builtin_popcount(ab));
                int running = 0; sel = ab;
                for (int r = 0; r < 32; ++r) {
                    const bool eq = ((al >> r) & 1u) != 0u;
                    const unsigned long long be = __ballot(eq);
                    if (eq && running + __popcll(be & lt) < need) sel |= 1u << r;
                    running += __popcll(be);
                }
            }
            if (!exp_nostore) mbase[(2 * w + qq) * 64 + lane] = sel;
        }
    }
    __syncthreads();
}

__device__ __forceinline__ void phase_dsa(const Params& p, int l, LAS3 char* lds) {
    const int tid = opaque_tid(p.wid);
    unsigned* qhead = p.ctl + CW_QD + 64 * (l + 2 * p.qslot);
    volatile LAS3 int* bc = (volatile LAS3 int*)(lds + DS_CTL);
    int nxt = 0;
    if (tid == 0) nxt = (int)__hip_atomic_fetch_add(qhead, 1u, __ATOMIC_RELAXED, __HIP_MEMORY_SCOPE_AGENT);
    for (;;) {
        if (tid == 0) *bc = nxt;
        __syncthreads();
        const int idx = __builtin_amdgcn_readfirstlane(*bc);
        __syncthreads();
        if (idx >= 4096) break;
        if (tid == 0) nxt = (int)__hip_atomic_fetch_add(qhead, 1u, __ATOMIC_RELAXED, __HIP_MEMORY_SCOPE_AGENT);
        const int pb = 127 - (idx >> 5), b = idx & 31;
        dsa_unit(p, b * 128 + pb, lds);
    }
}
}

namespace {
constexpr int LDS_BYTES = 147456;
constexpr int NTHREADS = 512;

template <int PH>
__device__ __forceinline__ void run_phase(const Params& p, int l, unsigned char* smem) {
    LAS3 char* lds = (LAS3 char*)smem;
    PG8_LAS unsigned char* glds = (PG8_LAS unsigned char*)smem;
    const int G = gridDim.x, c = blockIdx.x;
    if constexpr (PH == 0) phase_p0(p, (char*)smem);
    if constexpr (PH == 1) { if (l == 0) phase_norm1<0>(p, 0); else phase_norm1<1>(p, l); }
    if constexpr (PH == 2) { pg8::Gemm g{p.h, p.WinT + (size_t)l * NP * D, D, D, 0}; pg8::StaticOrder S; S.init(T, NP, G, c);
        EpiStoreBf16 E{p.proj, NP}; pg8::gemm_phase<EpiStoreBf16, pg8::StaticOrder, false>(glds, g, S, E, p.wid); }
    if constexpr (PH == 3) phase_prep(p, l);
    if constexpr (PH == 4) { pg8::Gemm g{p.proj + PC_BCQ, p.WqT + (size_t)l * 512 * 256, 256, NP, 0}; pg8::StaticOrder S; S.init(T, 512, G, c);
          EpiMlaQ E{p.qm}; pg8::gemm_phase<EpiMlaQ, pg8::StaticOrder, false>(glds, g, S, E, p.wid); }
    if constexpr (PH == 12) { pg8::Gemm g{p.proj + PC_BCKV, p.WkvT + (size_t)l * 512 * 128, 128, NP, 0}; pg8::StaticOrder S; S.init(T, 512, G, c);
          EpiMlaKV E{p.km, p.vm}; pg8::gemm_phase<EpiMlaKV, pg8::StaticOrder, false>(glds, g, S, E, p.wid); }
    if constexpr (PH == 13) phase_dsa(p, l, lds);
    if constexpr (PH == 5) phase_attn(p, l, lds);
    if constexpr (PH == 6) { pg8::Gemm g{p.merged, p.WoutT + (size_t)l * D * D, D, D, 0}; pg8::StaticOrder S; S.init(T, D, G, c);
        EpiResidual E{l == 0 ? p.x : nullptr, p.xb, p.mod + (size_t)l * NB * NMOD + 2 * 1024}; pg8::gemm_phase<EpiResidual, pg8::StaticOrder, false>(glds, g, S, E, p.wid); }
    if constexpr (PH == 7) phase_route(p, l, (char*)smem);
    if constexpr (PH == 8) { const int* cnt = (const int*)(p.ctl + CW_CNT) + l * 16;
        pg8::Gemm g{p.h, p.WguT + (size_t)l * 16 * 512 * 1024, 1024, D, (size_t)512 * 1024}; MoeOrder S; S.init(cnt, p.list, 2, G, c);
        EpiGateUp E{p.hid}; pg8::gemm_phase<EpiGateUp, MoeOrder, true>(glds, g, S, E, p.wid); }
    if constexpr (PH == 9) { const int* cnt = (const int*)(p.ctl + CW_CNT) + l * 16;
        pg8::Gemm g{p.hid, p.WdT + (size_t)l * 16 * 1024 * 256, 256, 256, (size_t)1024 * 256}; MoeOrder S; S.init(cnt, p.list, 4, G, c);
        EpiDown E{p.ys, p.list, p.wl, cnt}; pg8::gemm_phase<EpiDown, MoeOrder, false>(glds, g, S, E, p.wid); }
    if constexpr (PH == 10) phase_norm1<2>(p, 1);
    if constexpr (PH == 11) phase_norm1<0>(p, l);
}
template <int PH>
__global__ void __launch_bounds__(NTHREADS, 2) k_ph(Params p, int l) {
    extern __shared__ __attribute__((aligned(16))) unsigned char smem[];
    p.wid = __builtin_amdgcn_readfirstlane(threadIdx.x >> 6); p.qslot = p.qslot_host;
    run_phase<PH>(p, l, smem);
}
}


namespace {
#ifndef REP_PH
#define REP_PH -1
#endif
#define REP(X, l) do { if (REP_PH == X) { xcd_barrier(bar); phase<X>(l, smem, wid, 1); } } while (0)
struct KArgs { const float* in[20]; float* xo; char* ws; };
constexpr size_t al256(size_t b) { return (b + 255) & ~(size_t)255; }
constexpr size_t WS_CTL = 0;
constexpr size_t WS_MOD = WS_CTL + al256((size_t)CW_WORDS * 4);
constexpr size_t WS_WIN = WS_MOD + al256((size_t)2 * NB * NMOD * 4);
constexpr size_t WS_WOUT = WS_WIN + al256((size_t)2 * NP * D * 2);
constexpr size_t WS_WQ = WS_WOUT + al256((size_t)2 * D * D * 2);
constexpr size_t WS_WKV = WS_WQ + al256((size_t)2 * 512 * 256 * 2);
constexpr size_t WS_WGU = WS_WKV + al256((size_t)2 * 512 * 128 * 2);
constexpr size_t WS_WD = WS_WGU + al256((size_t)2 * 16 * 512 * 1024 * 2);
constexpr size_t WS_ROPE = WS_WD + al256((size_t)2 * 16 * 1024 * 256 * 2);
constexpr size_t WS_RQ = WS_ROPE + al256((size_t)2048 * 16 * 2 * 4);
constexpr size_t WS_RKV = WS_RQ + al256((size_t)T * 4);
constexpr size_t WS_CBF = WS_RKV + al256((size_t)T * 4);
constexpr size_t WS_KIDX = WS_CBF + al256((size_t)NB * 4 * S * 4);
constexpr size_t WS_MASK = WS_KIDX + al256((size_t)T * 32 * 2);
constexpr size_t WS_LIST = WS_MASK + al256((size_t)T * 64 * 4);
constexpr size_t WS_RW = WS_LIST + al256((size_t)2 * 16 * ECAP * 4);
constexpr size_t WS_WL = WS_RW + al256((size_t)T * 2 * 4);
constexpr size_t WS_H = WS_WL + al256((size_t)2 * 16 * ECAP * 4);
constexpr size_t WS_PROJ = WS_H + al256((size_t)T * D * 2);
constexpr size_t WS_QM = WS_PROJ + al256((size_t)T * NP * 2);
constexpr size_t WS_KM = WS_QM + al256((size_t)T * 384 * 2);
constexpr size_t WS_VM = WS_KM + al256((size_t)T * 384 * 2);
constexpr size_t WS_MERGED = WS_VM + al256((size_t)T * 256 * 2);
constexpr size_t WS_XB = WS_MERGED + al256((size_t)T * D * 2);
constexpr size_t WS_END1 = WS_XB + al256((size_t)T * D * 2);
constexpr size_t WS_HID = WS_PROJ;
constexpr size_t WS_YS = WS_HID + al256((size_t)HIDROWS * 256 * 2);
constexpr size_t WS_END2 = WS_YS + al256((size_t)T * 2 * D * 2);
constexpr size_t WS_NEED = WS_END1 > WS_END2 ? WS_END1 : WS_END2;
static_assert(WS_END2 <= WS_MERGED, "MoE overlay must not reach the merged buffer");

__device__ __forceinline__ Params make_params(const KArgs& a) {
    Params p;
    p.x = a.in[0]; p.c = a.in[1]; p.w_ada = a.in[2]; p.b_ada = a.in[3]; p.g_norm1 = a.in[4]; p.w_in = a.in[5]; p.b_forget = a.in[6]; p.g_q_mla = a.in[7];
    p.w_q_up = a.in[8]; p.g_kv_mla = a.in[9]; p.w_kv_up = a.in[10]; p.sinks = a.in[11]; p.w_out = a.in[12]; p.g_norm2 = a.in[13]; p.w_router = a.in[14];
    p.b_router = a.in[15]; p.w_gate = a.in[16]; p.w_up = a.in[17]; p.w_down = a.in[18]; p.g_final = a.in[19];
    p.xo = a.xo; char* ws = a.ws;
    p.ctl = (unsigned*)(ws + WS_CTL); p.mod = (float*)(ws + WS_MOD); p.WinT = (bf16_t*)(ws + WS_WIN); p.WoutT = (bf16_t*)(ws + WS_WOUT);
    p.WqT = (bf16_t*)(ws + WS_WQ); p.WkvT = (bf16_t*)(ws + WS_WKV); p.WguT = (bf16_t*)(ws + WS_WGU); p.WdT = (bf16_t*)(ws + WS_WD);
    p.ropetab = (float*)(ws + WS_ROPE); p.rq = (float*)(ws + WS_RQ); p.rkv = (float*)(ws + WS_RKV); p.cbF = (float*)(ws + WS_CBF); p.kidx = (bf16_t*)(ws + WS_KIDX);
    p.mask = (uint32_t*)(ws + WS_MASK); p.list = (int*)(ws + WS_LIST); p.rw = (float*)(ws + WS_RW); p.wl = (float*)(ws + WS_WL); p.h = (bf16_t*)(ws + WS_H);
    p.proj = (bf16_t*)(ws + WS_PROJ); p.qm = (bf16_t*)(ws + WS_QM); p.km = (bf16_t*)(ws + WS_KM); p.vm = (bf16_t*)(ws + WS_VM);
    p.merged = (bf16_t*)(ws + WS_MERGED); p.xb = (bf16_t*)(ws + WS_XB); p.hid = (bf16_t*)(ws + WS_HID); p.ys = (bf16_t*)(ws + WS_YS);
    return p;
}
template <int PH>
__device__ __forceinline__ void phase(int l, unsigned char* smem, int wid, int qslot = 0) {
    typedef const __attribute__((address_space(4))) KArgs* KA4;
    KA4 ka = (KA4)__builtin_amdgcn_kernarg_segment_ptr();
    asm volatile("" : "+s"(ka));
    KArgs a;
#pragma unroll
    for (int i = 0; i < 20; ++i) a.in[i] = ka->in[i];
    a.xo = ka->xo; a.ws = ka->ws;
    Params p = make_params(a); p.wid = wid; p.qslot = qslot; p.qslot_host = 0;
    run_phase<PH>(p, l, smem);
}
__global__ void __launch_bounds__(NTHREADS, 2) fwd(KArgs args) {
    extern __shared__ __attribute__((aligned(16))) unsigned char smem[];
    volatile LAS unsigned* st = (volatile LAS unsigned*)(smem + LDS_BYTES - 16);
    const int wid = __builtin_amdgcn_readfirstlane(threadIdx.x >> 6);
    if (xb_leader(wid)) { st[0] = 0u; st[1] = 0u; st[2] = 0u; st[3] = 0u; }
    __syncthreads();
    XcdBarrier bar = xcd_barrier_post((unsigned*)(args.ws + WS_CTL) + CW_BAR, st, wid);
    phase<0>(0, smem, wid);  REP(0, 0);
    xcd_barrier(bar);
#define LAYER(l) do { \
        phase<1>(l, smem, wid);  if (l == 0) REP(1, l); xcd_barrier(bar); \
        phase<2>(l, smem, wid);  REP(2, l); xcd_barrier(bar); \
        phase<3>(l, smem, wid);  REP(3, l); xcd_barrier(bar); \
        phase<4>(l, smem, wid);  REP(4, l); phase<12>(l, smem, wid);  REP(12, l); phase<13>(l, smem, wid);  REP(13, l); xcd_barrier(bar); \
        phase<5>(l, smem, wid);  REP(5, l); xcd_barrier(bar); \
        phase<6>(l, smem, wid);  xcd_barrier(bar); \
        phase<7>(l, smem, wid);  REP(7, l); xcd_barrier(bar); \
        phase<8>(l, smem, wid);  REP(8, l); xcd_barrier(bar); \
        phase<9>(l, smem, wid);  REP(9, l); xcd_barrier(bar); } while (0)
    LAYER(0);
    LAYER(1);
#ifdef REP_BAR
    for (int rb = 0; rb < REP_BAR; ++rb) xcd_barrier(bar);
#endif
    phase<10>(1, smem, wid);
}
}

extern "C" void kernel_launch(void* const* d_in, const int* in_sizes, int n_in, void* d_out, int out_size, void* d_ws, size_t ws_size,
                              hipStream_t stream) {
    KArgs a{};
    for (int i = 0; i < 20; ++i) a.in[i] = (const float*)d_in[i];
    a.xo = (float*)d_out; a.ws = (char*)d_ws;
    if (WS_NEED > ws_size) return;

    static int grid = 0;
    if (!grid) {
        int dev = 0, cus = 0, per_cu = 0;
        (void)hipGetDevice(&dev);
        (void)hipDeviceGetAttribute(&cus, hipDeviceAttributeMultiprocessorCount, dev);
        (void)hipFuncSetAttribute((const void*)fwd, hipFuncAttributeMaxDynamicSharedMemorySize, LDS_BYTES);
        (void)hipOccupancyMaxActiveBlocksPerMultiprocessor(&per_cu, (const void*)fwd, NTHREADS, LDS_BYTES);
        grid = cus > 0 ? cus : 256;
    }
    (void)hipMemsetAsync(a.ws + WS_CTL, 0, (size_t)CW_WORDS * 4, stream);
    fwd<<<dim3(grid), dim3(NTHREADS), LDS_BYTES, stream>>>(a);
}
```

```cpp
#include <hip/hip_runtime.h>
#include <stdint.h>
#define XB_TMO      128
#define XB_XCNT(j)  (256  + 64 * (j))
#define XB_XSUB(j)  (1280 + 64 * (j))
#define XB_XGEN(j)  (2304 + 64 * (j))
#define XB_TOP      3328
#define XB_TOPGEN   3392
#define XCD_BAR_WORDS 3456
#define XB_SPIN_CAP (1u << 20)
#define LAS __attribute__((address_space(3)))

__device__ __forceinline__ unsigned xb_ld(unsigned* p)              { return __hip_atomic_load(p, __ATOMIC_RELAXED, __HIP_MEMORY_SCOPE_AGENT); }
__device__ __forceinline__ unsigned xb_add(unsigned* p, unsigned v) { return __hip_atomic_fetch_add(p, v, __ATOMIC_RELAXED, __HIP_MEMORY_SCOPE_AGENT); }
__device__ __forceinline__ unsigned xb_xcc_id() { return (unsigned)__builtin_amdgcn_s_getreg((3 << 11) | 20) & 0xFu; }
#define XB_SPIN(cond, bar) do { unsigned _sp = 0; while (cond) { __builtin_amdgcn_s_sleep(1); \
    if ((++_sp & 255u) == 0u) { if (xb_ld(&(bar)[XB_TMO])) break; if (_sp > XB_SPIN_CAP) { atomicAdd(&(bar)[XB_TMO], 1u); break; } } } } while (0)

struct XcdBarrier { unsigned* bar; unsigned x; volatile LAS unsigned* st; int wid; };
__device__ __forceinline__ bool xb_leader(int wid) { return wid == 0 && __builtin_amdgcn_mbcnt_hi(~0u, __builtin_amdgcn_mbcnt_lo(~0u, 0u)) == 0u; }

__device__ __forceinline__ XcdBarrier xcd_barrier_post(unsigned* bar, volatile LAS unsigned* st, int wid) {
    XcdBarrier b; b.bar = bar; b.x = xb_xcc_id(); b.st = st; b.wid = wid;
    if (xb_leader(wid)) (void)xb_add(&bar[XB_XCNT(b.x)], 1u);
    return b;
}
__device__ __forceinline__ void xcd_barrier_complete(unsigned* bar, unsigned x, unsigned& nloc, unsigned& nx) {
    const unsigned G = gridDim.x * gridDim.y * gridDim.z;
    unsigned sum, cnt, mine, sp = 0u;
    for (;;) {
        sum = 0u; cnt = 0u; mine = 0u;
#pragma unroll
        for (unsigned j = 0; j < 16; ++j) { const unsigned c = xb_ld(&bar[XB_XCNT(j)]); sum += c; cnt += (c > 0u) ? 1u : 0u; mine = (j == x) ? c : mine; }
        if (sum == G) break;
        __builtin_amdgcn_s_sleep(1);
        if ((++sp & 255u) == 0u) { if (xb_ld(&bar[XB_TMO])) break; if (sp > XB_SPIN_CAP) { atomicAdd(&bar[XB_TMO], 1u); break; } }
    }
    nloc = mine > 0u ? mine : 1u; nx = cnt > 0u ? cnt : 1u;
}
__device__ __forceinline__ void xcd_barrier(const XcdBarrier& b) {
    asm volatile("s_waitcnt vmcnt(0)" ::: "memory");
    __syncthreads();
    if (xb_leader(b.wid)) {
        unsigned* bar = b.bar;
        __builtin_amdgcn_s_waitcnt(0);
        unsigned nloc = b.st[0], nx = b.st[1];
        if (nloc == 0u) { xcd_barrier_complete(bar, b.x, nloc, nx); b.st[0] = nloc; b.st[1] = nx; }
        const unsigned old = xb_add(&bar[XB_XSUB(b.x)], 1u);
        const unsigned gen = old / nloc;
        if (old + 1u == (gen + 1u) * nloc) {
            __builtin_amdgcn_fence(__ATOMIC_RELEASE, "agent");
            asm volatile("s_waitcnt vmcnt(0)" ::: "memory");
            const unsigned og = xb_add(&bar[XB_TOP], 1u);
            const unsigned tg = og / nx;
            if (og + 1u == (tg + 1u) * nx) xb_add(&bar[XB_TOPGEN], 1u);
            else XB_SPIN(xb_ld(&bar[XB_TOPGEN]) == tg, bar);
            __builtin_amdgcn_fence(__ATOMIC_ACQUIRE, "agent");
            xb_add(&bar[XB_XGEN(b.x)], 1u);
            asm volatile("s_waitcnt vmcnt(0)" ::: "memory");
        } else {
            XB_SPIN(xb_ld(&bar[XB_XGEN(b.x)]) == gen, bar);
            __builtin_amdgcn_fence(__ATOMIC_ACQUIRE, "agent");
            asm volatile("s_waitcnt vmcnt(0)" ::: "memory");
        }
    }
    __syncthreads();
}

#define LAS3 __attribute__((address_space(3)))
namespace {
typedef unsigned short bf16_t;
typedef short bf16x8 __attribute__((ext_vector_type(8)));
typedef short bf16x4 __attribute__((ext_vector_type(4)));
typedef float f32x4 __attribute__((ext_vector_type(4)));
typedef float f32x2 __attribute__((ext_vector_type(2)));
typedef unsigned u32x4 __attribute__((ext_vector_type(4)));
typedef unsigned u32x2 __attribute__((ext_vector_type(2)));

constexpr int D = 1024, NB = 32, S = 2048, T = NB * S, NIN = 2380, NP = 2560, NMOD = 6144;
constexpr int OFF_AQ = 0, OFF_AK = 256, OFF_AV = 512, OFF_AF = 768, OFF_BCQ = 772, OFF_BCKV = 1028, OFF_BKR = 1156,
              OFF_CQ = 1188, OFF_CK = 1444, OFF_CV = 1572, OFF_DQ = 1700, OFF_DK = 1956, OFF_DV = 2020,
              OFF_DQI = 2084, OFF_DKI = 2340, OFF_DWI = 2372;
constexpr int PC_AQ = 0, PC_AK = 256, PC_AV = 512, PC_BCQ = 768, PC_BCKV = 1024, PC_BKR = 1152, PC_CQ = 1184, PC_CK = 1440, PC_CV = 1568,
              PC_DQ = 1696, PC_DK = 1952, PC_DV = 2016, PC_DQI = 2080, PC_DKI = 2336, PC_DWI = 2368, PC_AF = 2376;
constexpr float EPS = 1e-6f;
constexpr float LOG2E = 1.4426950408889634f;
constexpr int ECAP = T;
constexpr int HIDROWS = 2 * T + 16 * 256;

__host__ __device__ __forceinline__ int orig_col(int n) { return n < 768 ? n : (n < 2376 ? n + 4 : (n < 2380 ? n - 1608 : -1)); }
__device__ __forceinline__ int opaque_tid(int wid) {
    int t = wid * 64 + (int)__builtin_amdgcn_mbcnt_hi(~0u, __builtin_amdgcn_mbcnt_lo(~0u, 0u));
    asm volatile("" : "+v"(t)); return t; }
__device__ __forceinline__ float bf2f(bf16_t v) { return __uint_as_float((unsigned)v << 16); }
__device__ __forceinline__ bf16_t f2bf(float f) { unsigned u = __float_as_uint(f); u += 0x7FFFu + ((u >> 16) & 1u); return (bf16_t)(u >> 16); }
typedef __bf16 bf16x2_native __attribute__((ext_vector_type(2)));
__device__ __forceinline__ unsigned cvt_pk_bf16(float lo, float hi) { const f32x2 v = {lo, hi}; return __builtin_bit_cast(unsigned, __builtin_convertvector(v, bf16x2_native)); }
__device__ __forceinline__ float bflo(unsigned w) { return __uint_as_float(w << 16); }
__device__ __forceinline__ float bfhi(unsigned w) { return __uint_as_float(w & 0xFFFF0000u); }
__device__ __forceinline__ float wave_sum(float v) {
#pragma unroll
    for (int o = 32; o > 0; o >>= 1) v += __shfl_xor(v, o);
    return v;
}
__device__ __forceinline__ float xor32_max(float x) {
    float a = x, b = x;
    asm volatile("s_nop 1\n\tv_permlane32_swap_b32 %0, %1\n\ts_nop 1" : "+v"(a), "+v"(b));
    return fmaxf(a, b);
}
__device__ __forceinline__ int wave_reduce_add(int v) {
    v += __builtin_amdgcn_update_dpp(0, v, 0xB1, 0xF, 0xF, true);
    v += __builtin_amdgcn_update_dpp(0, v, 0x4E, 0xF, 0xF, true);
    v += __builtin_amdgcn_update_dpp(0, v, 0x141, 0xF, 0xF, true);
    v += __builtin_amdgcn_update_dpp(0, v, 0x140, 0xF, 0xF, true);
    return __builtin_amdgcn_readlane(v, 0) + __builtin_amdgcn_readlane(v, 16) + __builtin_amdgcn_readlane(v, 32) + __builtin_amdgcn_readlane(v, 48);
}
}

namespace pg8 {
#define PG8_LAS __attribute__((address_space(3)))
constexpr int BM = 256, BK = 64, HALF = 128, HTB = HALF * BK * 2, STAGE_BYTES = 8 * HTB, NXCD = 8, WGM = 8;

__host__ __device__ __forceinline__ int lds_byte(int r, int c) { const int st = (r >> 4) * 2 + (c >> 5), rr = r & 15, cc = c & 31, ob = rr * 64 + cc * 2; return st * 1024 + (ob ^ (((ob >> 9) & 1) << 5)); }
__host__ __device__ __forceinline__ void stage_rc(int b, int& R, int& C) { const int st = b / 1024, sb = b % 1024, swz = sb ^ (((sb >> 9) & 1) << 5); R = (st >> 1) * 16 + swz / 64; C = (st & 1) * 32 + (swz % 64) / 2; }
__host__ __device__ __forceinline__ int perm32(int rho) { const int n = rho >> 4, i = rho & 15; return 8 * (i >> 2) + 4 * n + (i & 3); }

struct Unit { int pm, pn, e, mt; };
struct Gemm { const bf16_t* A; const bf16_t* Bt; int K; int lda; size_t bstride; };

struct StaticOrder {
    int nM, nN, nwg, G, c;
    __host__ __device__ void init(int M, int N, int G_, int c_) { nM = M / BM; nN = N / BM; nwg = nM * nN; G = G_; c = c_; }
    __host__ __device__ bool next(int i, Unit& u) const {
        const long L = (long)i * G + c; if (L >= nwg) return false;
        int wgid = (int)L; { const int q = nwg / NXCD, r = nwg % NXCD, xcd = wgid % NXCD, off = wgid / NXCD; wgid = (xcd < r ? xcd * (q + 1) : r * (q + 1) + (xcd - r) * q) + off; }
        const int nig = WGM * nN, gid = wgid / nig, fm = gid * WGM, gsz = (nM - fm) < WGM ? (nM - fm) : WGM;
        u.pm = fm + ((wgid % nig) % gsz); u.pn = (wgid % nig) / gsz; u.e = 0; u.mt = 0; return true;
    }
    __device__ __forceinline__ int arow(const Unit& u, int r) const { return u.pm * BM + r; }
};

template <class Epi, class Sched, bool GATHER>
__device__ __forceinline__ void gemm_phase(PG8_LAS unsigned char* lds, const Gemm g, const Sched& S, const Epi& E, int wave_index) {
    const int tid = opaque_tid(wave_index), wid = __builtin_amdgcn_readfirstlane(tid >> 6), lane = tid & 63, wr = wid >> 2, wc = wid & 3, fr = lane & 15, fq = lane >> 4;
    int K_ = g.K; asm volatile("" : "+s"(K_));
    const int K = K_, nt = K / BK, lda = g.lda;
    int Ra[2], Ca[2]; unsigned voffB[2], voffA[2];
#pragma unroll
    for (int i = 0; i < 2; ++i) { int R, C; stage_rc(tid * 16 + i * 8192, R, C); const int Rb = Epi::PERM ? ((R & ~31) + perm32(R & 31)) : R;
        Ra[i] = R; Ca[i] = C; voffB[i] = (unsigned)(Rb * K + C) * 2u; voffA[i] = (unsigned)(R * lda + C) * 2u; }
    const size_t kstep = (size_t)(BK * 2);
    const size_t hstepB = (size_t)HALF * K * 2;
    const size_t tstepB = 2 * hstepB;
    const size_t hstepA = (size_t)HALF * lda * 2, tstepA = 2 * hstepA;
    const unsigned ldsw = (unsigned)wid * 1024u;
    const int aoff = lds_byte(wr * 64 + fr, fq * 8), boff = lds_byte(wc * 32 + fr, fq * 8);
#define PG8_SA(b, h) (((b) * 2 + (h)) * HTB)
#define PG8_SB(b, h) ((4 + (b) * 2 + (h)) * HTB)
#define PG8_STAGE(bufoff, gbase, voff) do { _Pragma("unroll") for (int _i = 0; _i < 2; ++_i) \
        __builtin_amdgcn_global_load_lds((const unsigned*)((const char*)(gbase) + (voff)[_i]), (PG8_LAS unsigned*)(lds + (bufoff) + ldsw + _i * 8192), 16, 0, 0); } while (0)
#define PG8_STAGEA(bufoff, kptr, VO, h) do { _Pragma("unroll") for (int _i = 0; _i < 2; ++_i) { \
        const char* _src; if constexpr (GATHER) _src = (const char*)(kptr) + (VO)[_i][h]; else _src = (const char*)(kptr) + (size_t)(h) * hstepA + voffA[_i]; \
        __builtin_amdgcn_global_load_lds((const unsigned*)_src, (PG8_LAS unsigned*)(lds + (bufoff) + ldsw + _i * 8192), 16, 0, 0); } } while (0)
#define PG8_LDA(dst, b, h) do { _Pragma("unroll") for (int m = 0; m < 4; ++m) _Pragma("unroll") for (int k = 0; k < 2; ++k) dst[m][k] = *(const PG8_LAS bf16x8*)(lds + PG8_SA(b, h) + aoff + m * 2048 + k * 1024); } while (0)
#define PG8_LDB(dst, b, h) do { _Pragma("unroll") for (int n = 0; n < 2; ++n) _Pragma("unroll") for (int k = 0; k < 2; ++k) dst[n][k] = *(const PG8_LAS bf16x8*)(lds + PG8_SB(b, h) + boff + n * 2048 + k * 1024); } while (0)
#define PG8_MMA(ai, bj, At, Bt) do { __builtin_amdgcn_s_setprio(1); _Pragma("unroll") for (int m = 0; m < 4; ++m) _Pragma("unroll") for (int n = 0; n < 2; ++n) _Pragma("unroll") for (int k = 0; k < 2; ++k) \
        acc[ai][bj][m][n] = __builtin_amdgcn_mfma_f32_16x16x32_bf16(Bt[n][k], At[m][k], acc[ai][bj][m][n], 0, 0, 0); __builtin_amdgcn_s_setprio(0); } while (0)
#define PG8_WAIT_V(n) asm volatile("s_waitcnt vmcnt(" #n ")" ::: "memory")
#define PG8_WAIT_L(n) asm volatile("s_waitcnt lgkmcnt(" #n ")" ::: "memory")
#define PG8_BAR __builtin_amdgcn_s_barrier()
#define PG8_SCHED __builtin_amdgcn_sched_barrier(0)
#define PG8_SETV(V, u) do { _Pragma("unroll") for (int _i = 0; _i < 2; ++_i) _Pragma("unroll") for (int _h = 0; _h < 2; ++_h) { \
        const int _row = GATHER ? S.arow(u, _h * HALF + Ra[_i]) : ((u).pm * BM + _h * HALF + Ra[_i]); V[_i][_h] = (unsigned)(((size_t)_row * lda + Ca[_i]) * 2); } } while (0)
    Unit cur, nxt; int ui = 0;
    if (!S.next(0, cur)) return;
    f32x4 acc[2][2][4][2];
#pragma unroll
    for (int a = 0; a < 2; ++a)
#pragma unroll
        for (int b = 0; b < 2; ++b)
#pragma unroll
            for (int m = 0; m < 4; ++m)
#pragma unroll
                for (int n = 0; n < 2; ++n) acc[a][b][m][n] = (f32x4){0.f, 0.f, 0.f, 0.f};
    bf16x8 At[4][2], B0[2][2], B1[2][2];
    unsigned vA[2][2], vN[2][2];
    if constexpr (GATHER) { PG8_SETV(vA, cur); }
    const char* cA = (const char*)g.A + (GATHER ? (size_t)0 : (size_t)cur.pm * tstepA);
    const char* cB = (const char*)g.Bt + ((size_t)cur.e * g.bstride) * 2 + (size_t)cur.pn * tstepB;
    PG8_STAGE(PG8_SB(0, 0), cB, voffB); PG8_STAGE(PG8_SB(0, 1), cB + hstepB, voffB); PG8_STAGEA(PG8_SA(0, 0), cA, vA, 0); PG8_STAGEA(PG8_SA(0, 1), cA, vA, 1);
    if (wr == 1) PG8_BAR;
    PG8_WAIT_V(2); PG8_BAR;
    PG8_STAGE(PG8_SB(1, 0), cB + kstep, voffB); PG8_STAGEA(PG8_SA(1, 0), cA + kstep, vA, 0); PG8_STAGE(PG8_SB(1, 1), cB + hstepB + kstep, voffB);
    PG8_WAIT_V(6); PG8_BAR;
    for (;;) {
        const bool has_next = S.next(ui + 1, nxt);
        if constexpr (GATHER) { if (has_next) { PG8_SETV(vN, nxt); }
        else {
#pragma unroll
            for (int _i = 0; _i < 2; ++_i)
#pragma unroll
                for (int _h = 0; _h < 2; ++_h) vN[_i][_h] = vA[_i][_h];
        } }
        const char* nA = (!GATHER && has_next) ? (const char*)g.A + (size_t)nxt.pm * tstepA : cA;
        const char* nB = has_next ? (const char*)g.Bt + ((size_t)nxt.e * g.bstride) * 2 + (size_t)nxt.pn * tstepB : cB;
#pragma unroll 1
        for (int t = 0; t < nt; t += 2) {
            const bool last = (t == nt - 2);
            const char* a1 = cA + (size_t)(t + 1) * kstep;
            const char* a2 = last ? nA : cA + (size_t)(t + 2) * kstep; const char* b2 = last ? nB : cB + (size_t)(t + 2) * kstep;
            const char* a3 = a2 + kstep; const char* b3 = b2 + kstep;
            unsigned v2[2][2];
            if constexpr (GATHER) {
#pragma unroll
            for (int _i = 0; _i < 2; ++_i)
#pragma unroll
                for (int _h = 0; _h < 2; ++_h) v2[_i][_h] = last ? vN[_i][_h] : vA[_i][_h];
            }
            PG8_LDB(B0, 0, 0); PG8_LDB(B1, 0, 1); PG8_SCHED; PG8_LDA(At, 0, 0); PG8_STAGEA(PG8_SA(1, 1), a1, vA, 1);
            PG8_WAIT_V(8); PG8_WAIT_L(0); PG8_BAR; PG8_MMA(0, 0, At, B0); PG8_MMA(0, 1, At, B1); PG8_BAR; PG8_SCHED;
            PG8_LDA(At, 0, 1); PG8_STAGE(PG8_SB(0, 0), b2, voffB); PG8_STAGE(PG8_SB(0, 1), b2 + hstepB, voffB); PG8_STAGEA(PG8_SA(0, 0), a2, v2, 0);
            PG8_WAIT_V(8); PG8_WAIT_L(0); PG8_BAR; PG8_MMA(1, 0, At, B0); PG8_MMA(1, 1, At, B1); PG8_BAR; PG8_SCHED;
            PG8_LDB(B0, 1, 0); PG8_LDB(B1, 1, 1); PG8_SCHED; PG8_LDA(At, 1, 0); PG8_STAGEA(PG8_SA(0, 1), a2, v2, 1);
            PG8_WAIT_V(8); PG8_WAIT_L(0); PG8_BAR; PG8_MMA(0, 0, At, B0); PG8_MMA(0, 1, At, B1); PG8_BAR; PG8_SCHED;
            PG8_LDA(At, 1, 1); PG8_STAGE(PG8_SB(1, 0), b3, voffB); PG8_STAGE(PG8_SB(1, 1), b3 + hstepB, voffB); PG8_STAGEA(PG8_SA(1, 0), a3, v2, 0);
            PG8_WAIT_V(8); PG8_WAIT_L(0); PG8_BAR; PG8_MMA(1, 0, At, B0); PG8_MMA(1, 1, At, B1); PG8_BAR; PG8_SCHED;
        }
        if (wr == 0) PG8_BAR;
        E(acc, cur, wr, wc, fr, fq);
        if (!has_next) break;
#pragma unroll
        for (int a = 0; a < 2; ++a)
#pragma unroll
            for (int b = 0; b < 2; ++b)
#pragma unroll
                for (int m = 0; m < 4; ++m)
#pragma unroll
                    for (int n = 0; n < 2; ++n) acc[a][b][m][n] = (f32x4){0.f, 0.f, 0.f, 0.f};
        cur = nxt; cB = nB; cA = nA; ++ui;
        if constexpr (GATHER) {
#pragma unroll
        for (int _i = 0; _i < 2; ++_i)
#pragma unroll
            for (int _h = 0; _h < 2; ++_h) vA[_i][_h] = vN[_i][_h];
        }
        if (wr == 1) PG8_BAR;
    }
    PG8_WAIT_V(0);
    PG8_BAR;
#undef PG8_SA
#undef PG8_SB
#undef PG8_STAGE
#undef PG8_STAGEA
#undef PG8_LDA
#undef PG8_LDB
#undef PG8_MMA
#undef PG8_WAIT_V
#undef PG8_WAIT_L
#undef PG8_BAR
#undef PG8_SCHED
#undef PG8_SETV
}
}

namespace {
struct Params {
    const float *x, *c, *w_ada, *b_ada, *g_norm1, *w_in, *b_forget, *g_q_mla, *w_q_up, *g_kv_mla, *w_kv_up, *sinks, *w_out, *g_norm2,
                *w_router, *b_router, *w_gate, *w_up, *w_down, *g_final;
    float* xo;
    bf16_t* xb;
    unsigned* ctl;
    float* mod;
    bf16_t* WinT;
    bf16_t* WoutT;
    bf16_t* WqT;
    bf16_t* WkvT;
    bf16_t* WguT;
    bf16_t* WdT;
    float* ropetab;
    float* rq; float* rkv;
    float* cbF;
    bf16_t* kidx;
    uint32_t* mask;
    bf16_t* h;
    bf16_t* proj;
    bf16_t* qm; bf16_t* km; bf16_t* vm;
    bf16_t* merged;
    bf16_t* hid;
    bf16_t* ys;
    int* list;
    float* rw;
    float* wl;
    int wid;
    int qslot;
    int qslot_host;
};
constexpr int CW_BAR = 0;
constexpr int CW_CNT = 3584;
constexpr int CW_QA = 3648;
constexpr int CW_QD = 4288;
constexpr int CW_KN2 = 4992;
constexpr int CW_QN2 = CW_KN2 + 2 * NB * 4 * 32;
constexpr int CW_WORDS = CW_QN2 + 2 * NB * 4 * 8;
}

namespace {
constexpr long P0_B1 = 2l * NP * 128, P0_B2 = P0_B1 + 2l * 1024 * 128, P0_B3 = P0_B2 + 2l * 512 * 32, P0_B4 = P0_B3 + 2l * 512 * 16,
               P0_B5 = P0_B4 + 32l * 512 * 128, P0_B6 = P0_B5 + 32l * 1024 * 32;
__device__ __forceinline__ bf16_t* p0_fetch(const Params& p, long it, float (&v)[8]) {
    if (it < P0_B1) {
        const int l = (int)(it / (NP * 128)), r = (int)(it % (NP * 128)), n = r % NP, k0 = (r / NP) * 8, o = orig_col(n);
        const float* w = p.w_in + (size_t)l * D * NIN;
#pragma unroll
        for (int j = 0; j < 8; ++j) v[j] = o >= 0 ? w[(size_t)(k0 + j) * NIN + o] : 0.f;
        return p.WinT + ((size_t)l * NP + n) * D + k0;
    } else if (it < P0_B2) {
        const long s = it - P0_B1; const int l = (int)(s / (1024 * 128)), r = (int)(s % (1024 * 128)), n = r & 1023, k0 = (r >> 10) * 8;
        const float* w = p.w_out + (size_t)l * D * D;
#pragma unroll
        for (int j = 0; j < 8; ++j) v[j] = w[(size_t)(k0 + j) * D + n];
        return p.WoutT + ((size_t)l * D + n) * D + k0;
    } else if (it < P0_B3) {
        const long s = it - P0_B2; const int l = (int)(s / (512 * 32)), r = (int)(s % (512 * 32)), n = r & 511, k0 = (r >> 9) * 8;
        const float* w = p.w_q_up + (size_t)l * 256 * 384; const float* g = p.g_q_mla + l * 256;
#pragma unroll
        for (int j = 0; j < 8; ++j) v[j] = n < 384 ? g[k0 + j] * w[(size_t)(k0 + j) * 384 + n] : 0.f;
        return p.WqT + ((size_t)l * 512 + n) * 256 + k0;
    } else if (it < P0_B4) {
        const long s = it - P0_B3; const int l = (int)(s / (512 * 16)), r = (int)(s % (512 * 16)), n = r & 511, k0 = (r >> 9) * 8;
        const float* w = p.w_kv_up + (size_t)l * 128 * 512; const float* g = p.g_kv_mla + l * 128;
#pragma unroll
        for (int j = 0; j < 8; ++j) v[j] = g[k0 + j] * w[(size_t)(k0 + j) * 512 + n];
        return p.WkvT + ((size_t)l * 512 + n) * 128 + k0;
    } else if (it < P0_B5) {
        const long s = it - P0_B4; const int le = (int)(s >> 16), r = (int)(s & 65535), n = r & 511, k0 = (r >> 9) * 8;
        const int q = n >> 5, rr = n & 31, col = 16 * q + (rr & 15);
        const float* w = (rr < 16 ? p.w_gate : p.w_up) + (size_t)le * 1024 * 256;
#pragma unroll
        for (int j = 0; j < 8; ++j) v[j] = w[(size_t)(k0 + j) * 256 + col];
        return p.WguT + ((size_t)le * 512 + n) * 1024 + k0;
    } else {
        const long s = it - P0_B5; const int le = (int)(s >> 15), r = (int)(s & 32767), n = r & 1023, k0 = (r >> 10) * 8;
        const float* w = p.w_down + (size_t)le * 256 * 1024;
#pragma unroll
        for (int j = 0; j < 8; ++j) v[j] = w[(size_t)(k0 + j) * 1024 + n];
        return p.WdT + ((size_t)le * 1024 + n) * 256 + k0;
    }
}
__device__ __forceinline__ void p0_store(bf16_t* dst, const float (&v)[8]) {
    u32x4 w; w.x = cvt_pk_bf16(v[0], v[1]); w.y = cvt_pk_bf16(v[2], v[3]); w.z = cvt_pk_bf16(v[4], v[5]); w.w = cvt_pk_bf16(v[6], v[7]);
    *(u32x4*)dst = w;
}

__device__ __forceinline__ void phase_p0(const Params& p, char* lds) {
    const int tid = opaque_tid(p.wid), gtid = blockIdx.x * blockDim.x + tid, gthreads = gridDim.x * blockDim.x;
    for (long it0 = gtid; it0 < P0_B6; it0 += 2l * gthreads) {
        float va[8], vb[8];
        const bool hb = it0 + gthreads < P0_B6;
        bf16_t* da = p0_fetch(p, it0, va);
        bf16_t* db = hb ? p0_fetch(p, it0 + gthreads, vb) : da;
        p0_store(da, va);
        if (hb) p0_store(db, vb);
    }
    for (int it = gtid; it < 2048 * 16; it += gthreads) {
        const int pos = it >> 4, i = it & 15;
        const float inv = powf(10000.0f, -(float)i / 16.0f), ang = (float)pos * inv;
        p.ropetab[it * 2] = cosf(ang); p.ropetab[it * 2 + 1] = sinf(ang);
    }
    float* ca = (float*)lds;
    for (int i = tid; i < NB * 1024; i += 512) { const float v = p.c[i]; ca[i] = v / (1.f + __expf(-v)); }
    __syncthreads();
    for (int u = blockIdx.x; u < 2 * (NMOD / 64); u += gridDim.x) {
        const int l = u / (NMOD / 64), n = (u % (NMOD / 64)) * 64 + (tid & 63), bg = tid >> 6;
        const float* w = p.w_ada + (size_t)l * 1024 * NMOD + n;
        float acc[4] = {0.f, 0.f, 0.f, 0.f};
        for (int d0 = 0; d0 < 1024; d0 += 8) {
            float wv[8];
#pragma unroll
            for (int q = 0; q < 8; ++q) wv[q] = w[(size_t)(d0 + q) * NMOD];
#pragma unroll
            for (int q = 0; q < 8; ++q)
#pragma unroll
                for (int j = 0; j < 4; ++j) acc[j] += ca[(bg * 4 + j) * 1024 + d0 + q] * wv[q];
        }
        const float bias = p.b_ada[l * NMOD + n];
#pragma unroll
        for (int j = 0; j < 4; ++j) p.mod[((size_t)l * NB + bg * 4 + j) * NMOD + n] = acc[j] + bias;
    }
    __syncthreads();
}

template <int MODE>
__device__ __forceinline__ void phase_norm1(const Params& p, int l) {
#ifndef NORM_NT
#define NORM_NT 2
#endif
    constexpr int NT = NORM_NT;
    const int tid = opaque_tid(p.wid), w = tid >> 6, lane = tid & 63;
    const float* g = (MODE == 2) ? p.g_final : p.g_norm1 + l * D;
    const float* modl = p.mod + (size_t)(MODE == 2 ? 1 : l) * NB * NMOD;
    const float* modp = p.mod + (size_t)(MODE == 2 ? 1 : (l > 0 ? l - 1 : 0)) * NB * NMOD;
    f32x4 gg4[4];
#pragma unroll
    for (int k = 0; k < 4; ++k) gg4[k] = *(const f32x4*)(g + 4 * lane + 256 * k);
    for (int t0 = (blockIdx.x * 8 + w) * NT; t0 < T; t0 += gridDim.x * 8 * NT) {
        const int b0 = t0 >> 11;
        f32x4 sc4[4], sh4[4], gt4[4];
        if (MODE != 2) {
#pragma unroll
            for (int k = 0; k < 4; ++k) { sc4[k] = *(const f32x4*)(modl + (size_t)b0 * NMOD + 1024 + 4 * lane + 256 * k); sh4[k] = *(const f32x4*)(modl + (size_t)b0 * NMOD + 4 * lane + 256 * k); }
        }
        if (MODE >= 1) {
#pragma unroll
            for (int k = 0; k < 4; ++k) gt4[k] = *(const f32x4*)(modp + (size_t)b0 * NMOD + 5 * 1024 + 4 * lane + 256 * k);
        }
        f32x4 v[NT][4];
#pragma unroll
        for (int u = 0; u < NT; ++u)
#pragma unroll
            for (int k = 0; k < 4; ++k) {
                if (MODE == 0) v[u][k] = *(const f32x4*)(p.x + (size_t)(t0 + u) * D + 4 * lane + 256 * k);
                else { const u32x2 w2 = *(const u32x2*)(p.xb + (size_t)(t0 + u) * D + 4 * lane + 256 * k); v[u][k] = (f32x4){bflo(w2.x), bfhi(w2.x), bflo(w2.y), bfhi(w2.y)}; }
            }
        if (MODE >= 1) {
            u32x2 y0[NT][4], y1[NT][4];
#pragma unroll
            for (int u = 0; u < NT; ++u)
#pragma unroll
                for (int k = 0; k < 4; ++k) { const int col = 4 * lane + 256 * k;
                    y0[u][k] = *(const u32x2*)(p.ys + ((size_t)(t0 + u) * 2 + 0) * D + col); y1[u][k] = *(const u32x2*)(p.ys + ((size_t)(t0 + u) * 2 + 1) * D + col); }
#pragma unroll
            for (int u = 0; u < NT; ++u) {
                const int b = (t0 + u) >> 11;
#pragma unroll
                for (int k = 0; k < 4; ++k) {
                    const int col = 4 * lane + 256 * k;
                    const f32x4 gt = gt4[k];
                    v[u][k][0] += gt[0] * (bflo(y0[u][k].x) + bflo(y1[u][k].x)); v[u][k][1] += gt[1] * (bfhi(y0[u][k].x) + bfhi(y1[u][k].x));
                    v[u][k][2] += gt[2] * (bflo(y0[u][k].y) + bflo(y1[u][k].y)); v[u][k][3] += gt[3] * (bfhi(y0[u][k].y) + bfhi(y1[u][k].y));
                }
            }
        }
#pragma unroll
        for (int u = 0; u < NT; ++u) {
            const int t = t0 + u, b = t >> 11;
            float ss = 0.f;
#pragma unroll
            for (int k = 0; k < 4; ++k) ss += v[u][k][0] * v[u][k][0] + v[u][k][1] * v[u][k][1] + v[u][k][2] * v[u][k][2] + v[u][k][3] * v[u][k][3];
            ss = wave_sum(ss);
            const float r = rsqrtf(ss * (1.0f / D) + EPS);
#pragma unroll
            for (int k = 0; k < 4; ++k) {
                const int col = 4 * lane + 256 * k;
                f32x4 y = v[u][k] * r * gg4[k];
                if (MODE == 2) { *(f32x4*)(p.xo + (size_t)t * D + col) = y; }
                else {
                    if (MODE == 1) { u32x2 xw; xw.x = cvt_pk_bf16(v[u][k][0], v[u][k][1]); xw.y = cvt_pk_bf16(v[u][k][2], v[u][k][3]); *(u32x2*)(p.xb + (size_t)t * D + col) = xw; }
                    y = y * (1.f + sc4[k]) + sh4[k];
                    u32x2 o; o.x = cvt_pk_bf16(y[0], y[1]); o.y = cvt_pk_bf16(y[2], y[3]);
                    *(u32x2*)(p.h + (size_t)t * D + col) = o;
                }
            }
        }
    }
}
}

namespace {
using pg8::Unit;
struct EpiStoreBf16 {
    static constexpr bool PERM = true;
    bf16_t* O; int ldc;
    __device__ __forceinline__ void operator()(const f32x4 (&acc)[2][2][4][2], const Unit& u, int wr, int wc, int fr_, int fq_) const {
        int fr = fr_, fq = fq_; asm volatile("" : "+v"(fr), "+v"(fq));
        const int row0 = u.pm * 256 + wr * 64 + fr, col0 = u.pn * 256 + wc * 32 + 8 * fq;
#pragma unroll
        for (int ai = 0; ai < 2; ++ai)
#pragma unroll
            for (int m = 0; m < 4; ++m) { bf16_t* rowp = O + (size_t)(row0 + ai * 128 + m * 16) * ldc + col0;
#pragma unroll
                for (int bj = 0; bj < 2; ++bj) { const f32x4 v0 = acc[ai][bj][m][0], v1 = acc[ai][bj][m][1];
                    u32x4 w; w.x = cvt_pk_bf16(v0[0], v0[1]); w.y = cvt_pk_bf16(v0[2], v0[3]); w.z = cvt_pk_bf16(v1[0], v1[1]); w.w = cvt_pk_bf16(v1[2], v1[3]);
                    *(u32x4*)(rowp + bj * 128) = w; } }
    }
};
struct EpiResidual {
    static constexpr bool PERM = false;
    const float* xin32; bf16_t* xb; const float* gate;
    __device__ __forceinline__ void operator()(const f32x4 (&acc)[2][2][4][2], const Unit& u, int wr, int wc, int fr_, int fq_) const {
        int fr = fr_, fq = fq_; asm volatile("" : "+v"(fr), "+v"(fq));
        const int row0 = u.pm * 256 + wr * 64 + fr, col0 = u.pn * 256 + wc * 32 + 4 * fq;
        const int b = (u.pm * 256) >> 11;
        f32x4 gv[2][2];
#pragma unroll
        for (int bj = 0; bj < 2; ++bj)
#pragma unroll
            for (int n = 0; n < 2; ++n) gv[bj][n] = *(const f32x4*)(gate + (size_t)b * NMOD + col0 + bj * 128 + n * 16);
#pragma unroll
        for (int ai = 0; ai < 2; ++ai)
#pragma unroll
            for (int m = 0; m < 4; ++m) { const size_t ro = (size_t)(row0 + ai * 128 + m * 16) * D + col0;
#pragma unroll
                for (int bj = 0; bj < 2; ++bj)
#pragma unroll
                    for (int n = 0; n < 2; ++n) { const size_t o = ro + bj * 128 + n * 16;
                        f32x4 xv;
                        if (xin32) xv = *(const f32x4*)(xin32 + o);
                        else { const u32x2 w = *(const u32x2*)(xb + o); xv = (f32x4){bflo(w.x), bfhi(w.x), bflo(w.y), bfhi(w.y)}; }
                        const f32x4 r = xv + gv[bj][n] * acc[ai][bj][m][n];
                        u32x2 ow; ow.x = cvt_pk_bf16(r[0], r[1]); ow.y = cvt_pk_bf16(r[2], r[3]);
                        *(u32x2*)(xb + o) = ow; } }
    }
};
struct EpiMlaQ {
    static constexpr bool PERM = true;
    bf16_t* qm;
    __device__ __forceinline__ void operator()(const f32x4 (&acc)[2][2][4][2], const Unit& u, int wr, int wc, int fr_, int fq_) const {
        int fr = fr_, fq = fq_; asm volatile("" : "+v"(fr), "+v"(fq));
        const int row0 = u.pm * 256 + wr * 64 + fr;
#pragma unroll
        for (int bj = 0; bj < 2; ++bj) {
            const int col0 = u.pn * 256 + bj * 128 + wc * 32;
            if (col0 >= 384) continue;
#pragma unroll
            for (int ai = 0; ai < 2; ++ai)
#pragma unroll
                for (int m = 0; m < 4; ++m) { const f32x4 v0 = acc[ai][bj][m][0], v1 = acc[ai][bj][m][1];
                    u32x4 w; w.x = cvt_pk_bf16(v0[0], v0[1]); w.y = cvt_pk_bf16(v0[2], v0[3]); w.z = cvt_pk_bf16(v1[0], v1[1]); w.w = cvt_pk_bf16(v1[2], v1[3]);
                    *(u32x4*)(qm + (size_t)(row0 + ai * 128 + m * 16) * 384 + col0 + 8 * fq) = w; }
        }
    }
};
struct EpiMlaKV {
    static constexpr bool PERM = true;
    bf16_t* km; bf16_t* vm;
    __device__ __forceinline__ void operator()(const f32x4 (&acc)[2][2][4][2], const Unit& u, int wr, int wc, int fr_, int fq_) const {
        int fr = fr_, fq = fq_; asm volatile("" : "+v"(fr), "+v"(fq));
        const int row0 = u.pm * 256 + wr * 64 + fr;
#pragma unroll
        for (int bj = 0; bj < 2; ++bj) {
            const int head = u.pn * 2 + bj, wcol = wc * 32 + 8 * fq;
#pragma unroll
            for (int ai = 0; ai < 2; ++ai)
#pragma unroll
                for (int m = 0; m < 4; ++m) {
                    const int row = row0 + ai * 128 + m * 16;
                    const f32x4 v0 = acc[ai][bj][m][0], v1 = acc[ai][bj][m][1];
                    u32x4 w; w.x = cvt_pk_bf16(v0[0], v0[1]); w.y = cvt_pk_bf16(v0[2], v0[3]); w.z = cvt_pk_bf16(v1[0], v1[1]); w.w = cvt_pk_bf16(v1[2], v1[3]);
                    bf16_t* q = (wcol < 64) ? km + (size_t)row * 384 + head * 96 + wcol : vm + (size_t)row * 256 + head * 64 + (wcol - 64);
                    *(u32x4*)q = w;
                    asm volatile("" ::: "memory");
                }
        }
    }
};
struct EpiGateUp {
    static constexpr bool PERM = false;
    bf16_t* hid;
    __device__ __forceinline__ void operator()(const f32x4 (&acc)[2][2][4][2], const Unit& u, int wr, int wc, int fr_, int fq_) const {
        int fr = fr_, fq = fq_; asm volatile("" : "+v"(fr), "+v"(fq));
        const int row0 = u.pm * 256 + wr * 64 + fr;
#pragma unroll
        for (int ai = 0; ai < 2; ++ai)
#pragma unroll
            for (int m = 0; m < 4; ++m) { bf16_t* rowp = hid + (size_t)(row0 + ai * 128 + m * 16) * 256;
#pragma unroll
                for (int bj = 0; bj < 2; ++bj) { const f32x4 gt = acc[ai][bj][m][0], up = acc[ai][bj][m][1];
                    f32x4 o;
#pragma unroll
                    for (int j = 0; j < 4; ++j) o[j] = gt[j] / (1.f + __expf(-gt[j])) * up[j];
                    u32x2 w; w.x = cvt_pk_bf16(o[0], o[1]); w.y = cvt_pk_bf16(o[2], o[3]);
                    *(u32x2*)(rowp + 16 * (u.pn * 8 + bj * 4 + wc) + 4 * fq) = w; } }
    }
};
struct EpiDown {
    static constexpr bool PERM = true;
    bf16_t* ys; const int* list; const float* wl; const int* cnt;
    __device__ __forceinline__ void operator()(const f32x4 (&acc)[2][2][4][2], const Unit& u, int wr, int wc, int fr_, int fq_) const {
        int fr = fr_, fq = fq_; asm volatile("" : "+v"(fr), "+v"(fq));
        const int n = cnt[u.e]; const int* le = list + (size_t)u.e * ECAP; const float* we = wl + (size_t)u.e * ECAP;
        const int col0 = u.pn * 256 + wc * 32 + 8 * fq;
        int slot[8]; float w8[8];
#pragma unroll
        for (int q = 0; q < 8; ++q) { const int lr = u.mt * 256 + (q >> 2) * 128 + wr * 64 + (q & 3) * 16 + fr; slot[q] = lr < n ? le[lr] : -1; w8[q] = lr < n ? we[lr] : 0.f; }
#pragma unroll
        for (int ai = 0; ai < 2; ++ai)
#pragma unroll
            for (int m = 0; m < 4; ++m) {
                const int q = ai * 4 + m;
                if (slot[q] >= 0) {
                    bf16_t* rowp = ys + (size_t)slot[q] * D + col0;
#pragma unroll
                    for (int bj = 0; bj < 2; ++bj) { const f32x4 v0 = acc[ai][bj][m][0] * w8[q], v1 = acc[ai][bj][m][1] * w8[q];
                        u32x4 w; w.x = cvt_pk_bf16(v0[0], v0[1]); w.y = cvt_pk_bf16(v0[2], v0[3]); w.z = cvt_pk_bf16(v1[0], v1[1]); w.w = cvt_pk_bf16(v1[2], v1[3]);
                        *(u32x4*)(rowp + bj * 128) = w; }
                }
            }
    }
};
struct MoeOrder {
    int pre[17];
    int NT, G, c; const int* list; const int* cnt;
    __device__ __forceinline__ void init(const int* cnt_, const int* list_, int NT_, int G_, int c_) {
        cnt = cnt_; list = list_; NT = NT_; G = G_; c = c_; int a = 0;
#pragma unroll
        for (int e = 0; e < 16; ++e) { pre[e] = a; a += (cnt_[e] + 255) >> 8; }
        pre[16] = a;
    }
    __device__ __forceinline__ bool next(int i, Unit& u) const {
        const int L = i * G + c; if (L >= pre[16] * NT) return false;
        const int t = L / NT; int e = 0;
#pragma unroll
        for (int k = 1; k < 16; ++k) e += (t >= pre[k]) ? 1 : 0;
        int pe = 0;
#pragma unroll
        for (int k = 0; k < 16; ++k) pe = (k == e) ? pre[k] : pe;
        u.e = e; u.mt = t - pe; u.pm = t; u.pn = L - t * NT; return true;
    }
    __device__ __forceinline__ int arow(const Unit& u, int r) const { const int lr = u.mt * 256 + r; return lr < cnt[u.e] ? (list[(size_t)u.e * ECAP + lr] >> 1) : 0; }
};
}

namespace {
__device__ __forceinline__ void phase_prep(const Params& p, int l) {
    const int tid = opaque_tid(p.wid), w = tid >> 6, lane = tid & 63;
    const int gw = blockIdx.x * 8 + w, nw = gridDim.x * 8;
    for (int sq = gw; sq < NB * 4; sq += nw) {
        const int b = sq >> 2, hh = sq & 3; const float bias = p.b_forget[l * 4 + hh];
        float lf[32]; float run = 0.f;
#pragma unroll
        for (int j = 0; j < 32; ++j) {
            const float z = bf2f(p.proj[(size_t)(b * S + lane * 32 + j) * NP + PC_AF + hh]) + bias;
            run += fminf(z, 0.f) - log1pf(__expf(-fabsf(z)));
            lf[j] = run;
        }
        float incl = run;
#pragma unroll
        for (int o = 1; o < 64; o <<= 1) { const float t2 = __shfl_up(incl, o); if (lane >= o) incl += t2; }
        const float excl = incl - run;
#pragma unroll
        for (int j = 0; j < 32; ++j) p.cbF[(size_t)sq * S + lane * 32 + j] = -(excl + lf[j]) * LOG2E;
    }
    for (int c32 = gw; c32 < T / 32; c32 += nw) {
    float mxq = 0.f, mxk = 0.f;
#define PREP_LOAD(tt) do { const bf16_t* _row = p.proj + (size_t)(tt) * NP; \
        n_cq = *(const u32x2*)(_row + PC_BCQ + 4 * lane); n_ck = *(const unsigned*)(_row + PC_BCKV + 2 * lane); \
        n_aq = *(const u32x2*)(_row + PC_AQ + 4 * lane); n_ak = *(const u32x2*)(_row + PC_AK + 4 * lane); \
        n_ki = *(const u32x4*)(_row + PC_DKI + 8 * (lane & 3)); n_kr = _row[PC_BKR + (lane & 31)]; } while (0)
    u32x2 n_cq, n_aq, n_ak; unsigned n_ck; u32x4 n_ki; bf16_t n_kr;
    PREP_LOAD(c32 * 32);
    for (int it = 0; it < 32; ++it) {
        const int t = c32 * 32 + it;
        const u32x2 cq = n_cq, aq = n_aq, ak = n_ak; const unsigned ck = n_ck; const u32x4 ki = n_ki; const bf16_t krb = n_kr;
        if (it < 31) PREP_LOAD(t + 1);
        float s1 = bflo(cq.x) * bflo(cq.x) + bfhi(cq.x) * bfhi(cq.x) + bflo(cq.y) * bflo(cq.y) + bfhi(cq.y) * bfhi(cq.y);
        float s2 = bflo(ck) * bflo(ck) + bfhi(ck) * bfhi(ck);
        s1 = wave_sum(s1); s2 = wave_sum(s2);
        if (lane < 4) *(u32x4*)(p.kidx + (size_t)t * 32 + 8 * lane) = ki;
        {
            float nq = bflo(aq.x) * bflo(aq.x) + bfhi(aq.x) * bfhi(aq.x) + bflo(aq.y) * bflo(aq.y) + bfhi(aq.y) * bfhi(aq.y);
            float nk = bflo(ak.x) * bflo(ak.x) + bfhi(ak.x) * bfhi(ak.x) + bflo(ak.y) * bflo(ak.y) + bfhi(ak.y) * bfhi(ak.y);
#pragma unroll
            for (int o = 8; o > 0; o >>= 1) { nq += __shfl_xor(nq, o); nk += __shfl_xor(nk, o); }
            mxq = fmaxf(mxq, nq); mxk = fmaxf(mxk, nk);
        }
        const float kr = (lane < 32) ? bf2f(krb) : 0.f;
        const float kr2 = __shfl(kr, (lane + 16) & 63);
        {
            const float r1 = rsqrtf(s1 * (1.f / 256.f) + EPS), r2 = rsqrtf(s2 * (1.f / 128.f) + EPS);
            u32x2 o; o.x = cvt_pk_bf16(bflo(cq.x) * r1, bfhi(cq.x) * r1); o.y = cvt_pk_bf16(bflo(cq.y) * r1, bfhi(cq.y) * r1);
            *(u32x2*)(p.proj + (size_t)t * NP + PC_BCQ + 4 * lane) = o;
            *(unsigned*)(p.proj + (size_t)t * NP + PC_BCKV + 2 * lane) = cvt_pk_bf16(bflo(ck) * r2, bfhi(ck) * r2);
        }
        if (lane < 16) {
            const int pos = t & (S - 1);
            const float cs = p.ropetab[(pos * 16 + lane) * 2], sn = p.ropetab[(pos * 16 + lane) * 2 + 1];
            const bf16_t o1 = f2bf(kr * cs - kr2 * sn), o2 = f2bf(kr2 * cs + kr * sn);
            bf16_t* kmr = p.km + (size_t)t * 384;
#pragma unroll
            for (int hh = 0; hh < 4; ++hh) { kmr[hh * 96 + 64 + lane] = o1; kmr[hh * 96 + 80 + lane] = o2; }
        }
    }
#undef PREP_LOAD
    if ((lane & 15) == 0) {
        const int t = c32 * 32, bb = t >> 11, pos = t & (S - 1), hh = lane >> 4;
        atomicMax(p.ctl + CW_KN2 + ((l * NB + bb) * 4 + hh) * 32 + (pos >> 6), __float_as_uint(mxk));
        atomicMax(p.ctl + CW_QN2 + ((l * NB + bb) * 4 + hh) * 8 + (pos >> 8), __float_as_uint(mxq));
    }
    }
}

__device__ __forceinline__ void phase_route(const Params& p, int l, char* lds) {
    const int tid = opaque_tid(p.wid), w = tid >> 6, lane = tid & 63;
    float* wrT = (float*)lds;
    int* lcnt = (int*)(lds + 65536);
    int* lbase = (int*)(lds + 65536 + 64);
    int* tsel = (int*)(lds + 65536 + 128);
    float* twt = (float*)(lds + 65536 + 128 + 2048);
    for (int i = tid; i < 16 * 1024; i += 512) { const int e = i >> 10, d = i & 1023; wrT[i] = p.w_router[d * 16 + e]; }
    const float* g = p.g_norm2 + l * D;
    const float* modl = p.mod + (size_t)l * NB * NMOD;
    int* cnt = (int*)(p.ctl + CW_CNT) + l * 16 + 32 * p.qslot;
    int* list = p.list + (size_t)p.qslot * 16 * ECAP;
    for (int chunk = blockIdx.x; chunk < T / 256; chunk += gridDim.x) {
        if (tid < 16) lcnt[tid] = 0;
        __syncthreads();
        const int b = (chunk * 256) >> 11;
        f32x4 gg4[4], sc4[4], sh4[4];
#pragma unroll
        for (int k = 0; k < 4; ++k) { const int col = 4 * lane + 256 * k; gg4[k] = *(const f32x4*)(g + col);
            sc4[k] = *(const f32x4*)(modl + (size_t)b * NMOD + 4 * 1024 + col); sh4[k] = *(const f32x4*)(modl + (size_t)b * NMOD + 3 * 1024 + col); }
        const int eown = ((lane >> 5) & 1) * 8 + ((lane >> 4) & 1) * 4 + ((lane >> 3) & 1) * 2 + ((lane >> 2) & 1);
        const float brown = p.b_router[eown];
        f32x4 vn[4];
#pragma unroll
        for (int k = 0; k < 4; ++k) { const u32x2 w2 = *(const u32x2*)(p.xb + (size_t)(chunk * 256 + w * 32) * D + 4 * lane + 256 * k); vn[k] = (f32x4){bflo(w2.x), bfhi(w2.x), bflo(w2.y), bfhi(w2.y)}; }
        for (int it = 0; it < 32; ++it) {
            const int li = w * 32 + it, t = chunk * 256 + li;
            f32x4 v[4];
#pragma unroll
            for (int k = 0; k < 4; ++k) v[k] = vn[k];
            if (it < 31) {
#pragma unroll
                for (int k = 0; k < 4; ++k) { const u32x2 w2 = *(const u32x2*)(p.xb + (size_t)(t + 1) * D + 4 * lane + 256 * k); vn[k] = (f32x4){bflo(w2.x), bfhi(w2.x), bflo(w2.y), bfhi(w2.y)}; }
            }
            float ss = 0.f;
#pragma unroll
            for (int k = 0; k < 4; ++k) ss += v[k][0] * v[k][0] + v[k][1] * v[k][1] + v[k][2] * v[k][2] + v[k][3] * v[k][3];
            ss = wave_sum(ss);
            const float r = rsqrtf(ss * (1.0f / D) + EPS);
            float lg[16];
#pragma unroll
            for (int e = 0; e < 16; ++e) lg[e] = 0.f;
#pragma unroll
            for (int k = 0; k < 4; ++k) {
                const int col = 4 * lane + 256 * k;
                const f32x4 y = v[k] * r * gg4[k] * (1.f + sc4[k]) + sh4[k];
                u32x2 o; o.x = cvt_pk_bf16(y[0], y[1]); o.y = cvt_pk_bf16(y[2], y[3]);
                *(u32x2*)(p.h + (size_t)t * D + col) = o;
#pragma unroll
                for (int e = 0; e < 16; ++e) { const f32x4 wv = *(const f32x4*)(wrT + e * 1024 + col); lg[e] += y[0] * wv[0] + y[1] * wv[1] + y[2] * wv[2] + y[3] * wv[3]; }
                asm volatile("" ::: "memory");
            }
            float a8[8], a4[4], a2[2], a1;
            { const bool hi = (lane & 32) != 0;
#pragma unroll
              for (int e = 0; e < 8; ++e) { const float send = hi ? lg[e] : lg[e + 8], keep = hi ? lg[e + 8] : lg[e]; a8[e] = keep + __shfl_xor(send, 32); } }
            { const bool hi = (lane & 16) != 0;
#pragma unroll
              for (int e = 0; e < 4; ++e) { const float send = hi ? a8[e] : a8[e + 4], keep = hi ? a8[e + 4] : a8[e]; a4[e] = keep + __shfl_xor(send, 16); } }
            { const bool hi = (lane & 8) != 0;
#pragma unroll
              for (int e = 0; e < 2; ++e) { const float send = hi ? a4[e] : a4[e + 2], keep = hi ? a4[e + 2] : a4[e]; a2[e] = keep + __shfl_xor(send, 8); } }
            { const bool hi = (lane & 4) != 0; const float send = hi ? a2[0] : a2[1], keep = hi ? a2[1] : a2[0]; a1 = keep + __shfl_xor(send, 4); }
            a1 += __shfl_xor(a1, 2); a1 += __shfl_xor(a1, 1);
            const float sown = 1.f / (1.f + expf(-a1)), bown = sown + brown;
            float sc[16], bi[16];
#pragma unroll
            for (int e = 0; e < 16; ++e) { const int src = ((e >> 3) & 1) * 32 + ((e >> 2) & 1) * 16 + ((e >> 1) & 1) * 8 + (e & 1) * 4;
                sc[e] = __builtin_bit_cast(float, __builtin_amdgcn_readlane(__builtin_bit_cast(int, sown), src));
                bi[e] = __builtin_bit_cast(float, __builtin_amdgcn_readlane(__builtin_bit_cast(int, bown), src)); }
            int bg = 0; float bgs = -INFINITY;
#pragma unroll
            for (int gi = 0; gi < 4; ++gi) {
                float m1 = -INFINITY, m2 = -INFINITY;
#pragma unroll
                for (int j = 0; j < 4; ++j) { const float vv = bi[gi * 4 + j]; if (vv > m1) { m2 = m1; m1 = vv; } else if (vv > m2) m2 = vv; }
                const float gs = m1 + m2; if (gs > bgs) { bgs = gs; bg = gi; }
            }
            float b4[4], s4[4];
#pragma unroll
            for (int gi = 0; gi < 4; ++gi)
#pragma unroll
                for (int j = 0; j < 4; ++j) if (gi == bg) { b4[j] = bi[gi * 4 + j]; s4[j] = sc[gi * 4 + j]; }
            int i1 = 0; float v1 = -INFINITY;
#pragma unroll
            for (int j = 0; j < 4; ++j) { if (b4[j] > v1) { v1 = b4[j]; i1 = j; } }
            int i2 = 0; float v2 = -INFINITY;
#pragma unroll
            for (int j = 0; j < 4; ++j) { if (j != i1 && b4[j] > v2) { v2 = b4[j]; i2 = j; } }
            float w1 = 0.f, w2 = 0.f;
#pragma unroll
            for (int j = 0; j < 4; ++j) { if (j == i1) w1 = s4[j]; if (j == i2) w2 = s4[j]; }
            if (lane == 0) {
                const int e1 = bg * 4 + i1, e2 = bg * 4 + i2; const float ws = w1 + w2;
                const int r1 = atomicAdd(&lcnt[e1], 1), r2 = atomicAdd(&lcnt[e2], 1);
                tsel[li * 2 + 0] = (e1 << 16) | r1; tsel[li * 2 + 1] = (e2 << 16) | r2;
                twt[li * 2 + 0] = w1 / ws; twt[li * 2 + 1] = w2 / ws;
            }
        }
        __syncthreads();
        if (tid < 16) lbase[tid] = atomicAdd(&cnt[tid], lcnt[tid]);
        __syncthreads();
        { const int v = tsel[tid], e = v >> 16, rk = v & 0xFFFF; const size_t pos = (size_t)e * ECAP + lbase[e] + rk;
          list[pos] = (chunk * 256 + (tid >> 1)) * 2 + (tid & 1); p.wl[pos + (size_t)p.qslot * 16 * ECAP] = twt[tid]; }
        __syncthreads();
    }
}
}

#ifndef ATTN_VMASK
#define ATTN_VMASK 15
#endif
#ifndef REPK_VMASK
#define REPK_VMASK 15
#endif
#ifndef ATTN_DMA
#define ATTN_DMA 1
#endif
#ifndef ATTN_EXP
#define ATTN_EXP 0
#endif
#define AEXP(k) (ATTN_EXP == (k) && xq)
namespace {
constexpr int AT_KB = 0;
constexpr int AT_KR = 16384;
constexpr int AT_VB = 24576;
constexpr int AT_CB = 40960;
constexpr int AT_CTL = 41472;
constexpr int AT_LDS = 41984;
constexpr float NEGBIG = -1.0e30f;

template <int VAR, int KC>
__device__ __forceinline__ void attn_tile(LAS3 char* lds, const int buf, const int j, const int q0, const int i, const int g, const int swk, const float slope2,
                                          const bf16x8 (&qf)[2][KC], f32x4 (&o)[2][4], float (&mrow)[2], float (&lsum)[2], const u32x4 (&mwd)[2][4], const bool xq) {
    typedef LAS3 bf16x4 lds_bf16x4;
    bool need = (64 * j <= q0 + 31);
    if (VAR == 2) need = need && (64 * j + 63 >= q0 - 127);
    if (need) {
        const LAS3 char* Kb = lds + AT_KB + buf * 8192; const LAS3 char* Vb = lds + AT_VB + buf * 8192;
        bool full = (64 * j + 63 <= q0);
        if (VAR == 2) full = full && (64 * j >= q0 - 96);
        if (VAR == 3) full = false;
        f32x4 s[2][4];
#pragma unroll
        for (int qt = 0; qt < 2; ++qt) {
            const int t = q0 + 16 * qt + i;
            const int dbase = 64 * j + 4 * g - t;
            const float sb = slope2 * ((VAR == 2) ? (float)dbase : (float)(64 * j + 4 * g));
#pragma unroll
            for (int mt = 0; mt < 4; ++mt) {
                f32x4 ini = {0.f, 0.f, 0.f, 0.f};
                if (VAR == 0) ini = *(const LAS3 f32x4*)(lds + AT_CB + buf * 256 + (16 * mt + 4 * g) * 4);
#pragma unroll
                for (int r = 0; r < 4; ++r) {
                    const int c = 16 * mt + r;
                    float v = ini[r];
                    if (VAR >= 2) v = sb + slope2 * (float)c;
                    if (VAR == 3) {
                        const int m = ((int)(mwd[qt][mt][r] << (31 - j))) >> 31;
                        v = __uint_as_float((__float_as_uint(v) & (unsigned)m) | (__float_as_uint(NEGBIG) & ~(unsigned)m));
                    } else if (!full) {
                        bool ok;
                        if (VAR == 2) ok = (unsigned)(dbase + c + 127) < 128u;
                        else ok = (dbase + c) <= 0;
                        v = ok ? v : NEGBIG;
                    }
                    ini[r] = v;
                }
                s[qt][mt] = ini;
            }
        }
        if (!AEXP(2))
#pragma unroll
        for (int mt = 0; mt < 4; ++mt) {
#pragma unroll
            for (int kc = 0; kc < 2; ++kc) {
                const bf16x8 kf = *(const LAS3 bf16x8*)(Kb + (mt * 16 + i) * 128 + (((kc * 4 + g) ^ swk) << 4));
                s[0][mt] = __builtin_amdgcn_mfma_f32_16x16x32_bf16(kf, qf[0][kc], s[0][mt], 0, 0, 0);
                s[1][mt] = __builtin_amdgcn_mfma_f32_16x16x32_bf16(kf, qf[1][kc], s[1][mt], 0, 0, 0);
            }
            if (VAR == 1) {
                const bf16x8 kf = *(const LAS3 bf16x8*)(lds + AT_KR + buf * 4096 + (mt * 16 + i) * 64 + ((g ^ (swk & 3)) << 4));
                s[0][mt] = __builtin_amdgcn_mfma_f32_16x16x32_bf16(kf, qf[0][KC - 1], s[0][mt], 0, 0, 0);
                s[1][mt] = __builtin_amdgcn_mfma_f32_16x16x32_bf16(kf, qf[1][KC - 1], s[1][mt], 0, 0, 0);
            }
        }
        bf16x8 pf[2][2];
#pragma unroll
        for (int qt = 0; qt < 2; ++qt) {
            float mx = fmaxf(fmaxf(s[qt][0][0], s[qt][0][1]), fmaxf(s[qt][0][2], s[qt][0][3]));
#pragma unroll
            for (int mt = 1; mt < 4; ++mt) mx = fmaxf(mx, fmaxf(fmaxf(s[qt][mt][0], s[qt][mt][1]), fmaxf(s[qt][mt][2], s[qt][mt][3])));
            mx = fmaxf(mx, __builtin_bit_cast(float, __builtin_amdgcn_ds_swizzle(__builtin_bit_cast(int, mx), 0x401F)));
            mx = xor32_max(mx);
            if (__any(mx > mrow[qt])) {
                const float mn = fmaxf(mrow[qt], mx), alpha = __builtin_amdgcn_exp2f(mrow[qt] - mn);
                mrow[qt] = mn; lsum[qt] *= alpha;
#pragma unroll
                for (int dt = 0; dt < 4; ++dt) o[qt][dt] = o[qt][dt] * alpha;
            }
            const float mn = mrow[qt];
            const f32x4 mn4 = {mn, mn, mn, mn};
            f32x4 ps4 = {0.f, 0.f, 0.f, 0.f};
            float x[4][4];
#pragma unroll
            for (int mt = 0; mt < 4; ++mt) {
                const f32x4 d4 = s[qt][mt] - mn4;
                f32x4 e4;
#pragma unroll
                for (int r = 0; r < 4; ++r) { e4[r] = AEXP(3) ? d4[r] : __builtin_amdgcn_exp2f(d4[r]); x[mt][r] = e4[r]; }
                ps4 += e4;
            }
            lsum[qt] += (ps4[0] + ps4[1]) + (ps4[2] + ps4[3]);
#pragma unroll
            for (int c = 0; c < 2; ++c) {
                u32x4 pk; pk.x = cvt_pk_bf16(x[2 * c][0], x[2 * c][1]); pk.y = cvt_pk_bf16(x[2 * c][2], x[2 * c][3]);
                pk.z = cvt_pk_bf16(x[2 * c + 1][0], x[2 * c + 1][1]); pk.w = cvt_pk_bf16(x[2 * c + 1][2], x[2 * c + 1][3]);
                pf[qt][c] = __builtin_bit_cast(bf16x8, pk);
            }
        }
        const int q4 = i >> 2, p4 = i & 3;
        if (!AEXP(4))
#pragma unroll
        for (int c = 0; c < 2; ++c) {
            const int row0 = 32 * c + 4 * g + q4, swv = (row0 >> 1) & 3;
#pragma unroll
            for (int dt = 0; dt < 4; ++dt) {
                const LAS3 char* a0 = Vb + row0 * 128 + ((dt ^ swv) << 5) + p4 * 8;
                const bf16x4 v0 = __builtin_amdgcn_ds_read_tr16_b64_v4i16((lds_bf16x4*)(a0));
                const bf16x4 v1 = __builtin_amdgcn_ds_read_tr16_b64_v4i16((lds_bf16x4*)(a0 + 16 * 128));
                const bf16x8 vf = {v0[0], v0[1], v0[2], v0[3], v1[0], v1[1], v1[2], v1[3]};
                o[0][dt] = __builtin_amdgcn_mfma_f32_16x16x32_bf16(vf, pf[0][c], o[0][dt], 0, 0, 0);
                o[1][dt] = __builtin_amdgcn_mfma_f32_16x16x32_bf16(vf, pf[1][c], o[1][dt], 0, 0, 0);
            }
        }
    }
}

template <int VAR>
__device__ __forceinline__ void attn_unit(const Params& p, int l, int b, int hx, int qb, LAS3 char* lds) {
    typedef LAS3 bf16x4 lds_bf16x4;
    constexpr int KC = (VAR == 1) ? 3 : 2;
    const int tid = opaque_tid(p.wid), w = __builtin_amdgcn_readfirstlane(tid >> 6), lane = tid & 63, i = lane & 15, g = lane >> 4;
    const bf16_t *Qp, *Kp, *Vp; int ldq, ldk, ldv, q0, j0, j1, ocol; float c1, slope2 = 0.f;
    if (VAR == 0) { Qp = p.proj + PC_AQ + hx * 64; Kp = p.proj + PC_AK + hx * 64; Vp = p.proj + PC_AV + hx * 64; ldq = ldk = ldv = NP;
                    q0 = qb * 256 + 32 * w; j0 = 0; j1 = 4 * qb + 3; ocol = hx * 64; c1 = 0.125f * LOG2E; }
    else if (VAR == 1) { Qp = p.qm + hx * 96; Kp = p.km + hx * 96; Vp = p.vm + hx * 64; ldq = 384; ldk = 384; ldv = 256;
                    q0 = qb * 256 + 32 * w; j0 = 0; j1 = 4 * qb + 3; ocol = 256 + hx * 64; c1 = 0.10206207261596577f * LOG2E; }
    else if (VAR == 2) { const int qh = hx * 2 + (w >> 2); Qp = p.proj + PC_CQ + qh * 64; Kp = p.proj + PC_CK + hx * 64; Vp = p.proj + PC_CV + hx * 64; ldq = ldk = ldv = NP;
                    q0 = qb * 128 + 32 * (w & 3); j0 = 2 * qb - 2 > 0 ? 2 * qb - 2 : 0; j1 = 2 * qb + 1; ocol = 512 + qh * 64; c1 = 0.125f * LOG2E;
                    slope2 = exp2f(-(float)(qh + 1)) * LOG2E; }
    else { const int hd = w >> 1; Qp = p.proj + PC_DQ + hd * 64; Kp = p.proj + PC_DK; Vp = p.proj + PC_DV; ldq = ldk = ldv = NP;
                    q0 = qb * 64 + 32 * (w & 1); j0 = 0; j1 = qb; ocol = 768 + hd * 64; c1 = 0.125f * LOG2E; slope2 = exp2f(-(float)(hd + 5)) * LOG2E; }
    const size_t tok0 = (size_t)b * S;
    const bool xq = p.qslot > 0;
    if (VAR == 0 && qb > 0) {
        constexpr float FOX_DROP = 64.0f;
        const unsigned* kn2 = p.ctl + CW_KN2 + ((l * NB + b) * 4 + hx) * 32;
        const float* cbh = p.cbF + ((size_t)b * 4 + hx) * S;
        const float qn = c1 * sqrtf(__uint_as_float(p.ctl[CW_QN2 + ((l * NB + b) * 4 + hx) * 8 + qb]));
        float knu = 0.f;
        for (int jj = 4 * qb; jj < 4 * qb + 4; ++jj) knu = fmaxf(knu, __uint_as_float(kn2[jj]));
        const float lower = cbh[256 * qb] - qn * sqrtf(knu);
        const int jl = lane & 31;
        const bool keep = qn * sqrtf(__uint_as_float(kn2[jl])) + cbh[64 * jl + 63] - lower >= -FOX_DROP || jl >= 4 * qb;
        const unsigned long long kb = __ballot(keep) & 0xFFFFFFFFull;
        j0 = kb ? (int)__builtin_ctzll(kb) : 4 * qb;
    }
    bf16x8 qf[2][KC];
#pragma unroll
    for (int qt = 0; qt < 2; ++qt)
#pragma unroll
        for (int kc = 0; kc < KC; ++kc) qf[qt][kc] = *(const bf16x8*)(Qp + (tok0 + q0 + 16 * qt + i) * ldq + kc * 32 + 8 * g);
    u32x4 mwd[2][4];
#pragma unroll
    for (int qt = 0; qt < 2; ++qt)
#pragma unroll
        for (int mt = 0; mt < 4; ++mt) mwd[qt][mt] = (VAR == 3) ? *(const u32x4*)(p.mask + (tok0 + q0 + 16 * qt + i) * 64 + 16 * mt + 4 * g) : (u32x4){0u, 0u, 0u, 0u};
#if ATTN_DMA
    const int drow = 8 * w + (lane >> 3), dch = lane & 7;
    const int ksc = dch ^ ((drow >> 1) & 7);
    const int vsc = ((((dch >> 1) ^ ((drow >> 1) & 3)) << 1) | (dch & 1));
    const int rrow = 16 * (w & 3) + (lane >> 2), rsc = (lane & 3) ^ ((rrow >> 1) & 3);
#define AT_DMA(j, buf) do { \
        __builtin_amdgcn_global_load_lds((const unsigned*)(Kp + (tok0 + 64 * (j) + drow) * ldk + ksc * 8), (LAS3 unsigned*)(lds + AT_KB + (buf) * 8192 + w * 1024), 16, 0, 0); \
        __builtin_amdgcn_global_load_lds((const unsigned*)(Vp + (tok0 + 64 * (j) + drow) * ldv + vsc * 8), (LAS3 unsigned*)(lds + AT_VB + (buf) * 8192 + w * 1024), 16, 0, 0); \
        if (VAR == 1 && w < 4) __builtin_amdgcn_global_load_lds((const unsigned*)(Kp + (tok0 + 64 * (j) + rrow) * ldk + 64 + rsc * 8), (LAS3 unsigned*)(lds + AT_KR + (buf) * 4096 + w * 1024), 16, 0, 0); \
        if (VAR == 0 && w == 0) __builtin_amdgcn_global_load_lds((const unsigned*)(p.cbF + ((size_t)b * 4 + hx) * S + 64 * (j) + lane), (LAS3 unsigned*)(lds + AT_CB + (buf) * 256), 4, 0, 0); \
    } while (0)
    AT_DMA(j0, j0 & 1);
#else
    const int sr = tid >> 3, sc8 = tid & 7;
    const int kdst = sr * 128 + ((sc8 ^ ((sr >> 1) & 7)) << 4);
    const int vdst = sr * 128 + (((((sc8 >> 1) ^ ((sr >> 1) & 3)) << 1) | (sc8 & 1)) << 4);
    const int rr = (tid & 255) >> 2, rc4 = tid & 3;
    const int rdst = rr * 64 + ((rc4 ^ ((rr >> 1) & 3)) << 4);
    u32x4 kstA, vstA, rstA = {0u, 0u, 0u, 0u}, kstB, vstB, rstB = {0u, 0u, 0u, 0u}; float cstA = 0.f, cstB = 0.f;
#define AT_LOAD(ZZ, j) do { if (AEXP(1)) break; const size_t _kr = tok0 + 64 * (j) + sr; \
        kst##ZZ = *(const u32x4*)(Kp + _kr * ldk + sc8 * 8); vst##ZZ = *(const u32x4*)(Vp + _kr * ldv + sc8 * 8); \
        if (VAR == 1) rst##ZZ = *(const u32x4*)(Kp + (tok0 + 64 * (j) + rr) * ldk + 64 + rc4 * 8); \
        if (VAR == 0) cst##ZZ = p.cbF[((size_t)b * 4 + hx) * S + 64 * (j) + (tid & 63)]; } while (0)
#define AT_WRITE(ZZ, buf) do { if (AEXP(1)) break; *(LAS3 u32x4*)(lds + AT_KB + (buf) * 8192 + kdst) = kst##ZZ; *(LAS3 u32x4*)(lds + AT_VB + (buf) * 8192 + vdst) = vst##ZZ; \
        if (VAR == 1 && tid < 256) *(LAS3 u32x4*)(lds + AT_KR + (buf) * 4096 + rdst) = rst##ZZ; \
        if (VAR == 0 && tid < 64) *(LAS3 float*)(lds + AT_CB + (buf) * 256 + tid * 4) = cst##ZZ; } while (0)
    AT_LOAD(A, j0);
    AT_LOAD(B, (j0 + 1 <= j1 ? j0 + 1 : j1));
#endif
    if (VAR == 1) {
#pragma unroll
        for (int qt = 0; qt < 2; ++qt) {
            const int pos = q0 + 16 * qt + i;
            const u32x4 mine = __builtin_bit_cast(u32x4, qf[qt][KC - 1]);
            u32x4 oth; oth.x = __shfl_xor(mine.x, 32); oth.y = __shfl_xor(mine.y, 32); oth.z = __shfl_xor(mine.z, 32); oth.w = __shfl_xor(mine.w, 32);
            const float* rt = p.ropetab + (size_t)(pos * 16 + (g & 1) * 8) * 2;
            const float sg = (g < 2) ? -1.f : 1.f;
            u32x4 res;
#pragma unroll
            for (int e2 = 0; e2 < 4; ++e2) {
                const f32x4 cs = *(const f32x4*)(rt + e2 * 4);
                const unsigned mw_ = e2 == 0 ? mine.x : e2 == 1 ? mine.y : e2 == 2 ? mine.z : mine.w, ow_ = e2 == 0 ? oth.x : e2 == 1 ? oth.y : e2 == 2 ? oth.z : oth.w;
                const float r0 = bflo(mw_) * cs[0] + sg * bflo(ow_) * cs[1], r1 = bfhi(mw_) * cs[2] + sg * bfhi(ow_) * cs[3];
                const unsigned pk = cvt_pk_bf16(r0, r1);
                if (e2 == 0) res.x = pk; else if (e2 == 1) res.y = pk; else if (e2 == 2) res.z = pk; else res.w = pk;
            }
            qf[qt][KC - 1] = __builtin_bit_cast(bf16x8, res);
        }
    }
#pragma unroll
    for (int qt = 0; qt < 2; ++qt)
#pragma unroll
        for (int kc = 0; kc < KC; ++kc) {
            u32x4 qq = __builtin_bit_cast(u32x4, qf[qt][kc]);
            qq.x = cvt_pk_bf16(bflo(qq.x) * c1, bfhi(qq.x) * c1); qq.y = cvt_pk_bf16(bflo(qq.y) * c1, bfhi(qq.y) * c1);
            qq.z = cvt_pk_bf16(bflo(qq.z) * c1, bfhi(qq.z) * c1); qq.w = cvt_pk_bf16(bflo(qq.w) * c1, bfhi(qq.w) * c1);
            qf[qt][kc] = __builtin_bit_cast(bf16x8, qq);
        }
    f32x4 o[2][4];
#pragma unroll
    for (int qt = 0; qt < 2; ++qt)
#pragma unroll
        for (int dt = 0; dt < 4; ++dt) o[qt][dt] = (f32x4){0.f, 0.f, 0.f, 0.f};
    float mrow[2] = {NEGBIG, NEGBIG}, lsum[2] = {0.f, 0.f};
#if ATTN_DMA
    const int swk = (i >> 1) & 7;
    asm volatile("s_waitcnt vmcnt(0)" ::: "memory");
    __syncthreads();
    for (int j = j0; j <= j1; ++j) {
        if (j < j1) AT_DMA(j + 1, (j + 1) & 1);
        attn_tile<VAR, KC>(lds, j & 1, j, q0, i, g, swk, slope2, qf, o, mrow, lsum, mwd, xq);
        asm volatile("s_waitcnt vmcnt(0)" ::: "memory");
        __syncthreads();
    }
#undef AT_DMA
#else
    AT_WRITE(A, j0 & 1);
    __syncthreads();
    const int swk = (i >> 1) & 7;
    for (int j = j0; j <= j1; j += 2) {
        AT_LOAD(A, (j + 2 <= j1 ? j + 2 : j1));
        attn_tile<VAR, KC>(lds, j & 1, j, q0, i, g, swk, slope2, qf, o, mrow, lsum, mwd, xq);
        if (j + 1 <= j1) AT_WRITE(B, (j + 1) & 1);
        if (!AEXP(5)) __syncthreads();
        if (j + 1 > j1) break;
        AT_LOAD(B, (j + 3 <= j1 ? j + 3 : j1));
        attn_tile<VAR, KC>(lds, (j + 1) & 1, j + 1, q0, i, g, swk, slope2, qf, o, mrow, lsum, mwd, xq);
        if (j + 2 <= j1) AT_WRITE(A, j & 1);
        if (!AEXP(5)) __syncthreads();
    }
#undef AT_LOAD
#undef AT_WRITE
#endif
#pragma unroll
    for (int qt = 0; qt < 2; ++qt) {
        float lt = lsum[qt]; lt += __shfl_xor(lt, 16); lt += __shfl_xor(lt, 32);
        if (VAR == 2) lt += __builtin_amdgcn_exp2f(p.sinks[l * 4 + hx * 2 + (w >> 2)] * LOG2E - mrow[qt]);
        const float inv = 1.f / lt;
        bf16_t* op = p.merged + (tok0 + q0 + 16 * qt + i) * D + ocol + 4 * g;
        if (!(ATTN_EXP != 0 && xq))
#pragma unroll
        for (int dt = 0; dt < 4; ++dt) { const f32x4 v = o[qt][dt] * inv; u32x2 w2; w2.x = cvt_pk_bf16(v[0], v[1]); w2.y = cvt_pk_bf16(v[2], v[3]); *(u32x2*)(op + 16 * dt) = w2; }
    }
}

__device__ __forceinline__ void phase_attn(const Params& p, int l, LAS3 char* lds) {
    const int tid = opaque_tid(p.wid);
    unsigned* qhead = p.ctl + CW_QA + 64 * (l + 2 * p.qslot);
    volatile LAS3 int* bc = (volatile LAS3 int*)(lds + AT_CTL);
    int nxt = 0;
    if (tid == 0) nxt = (int)__hip_atomic_fetch_add(qhead, 1u, __ATOMIC_RELAXED, __HIP_MEMORY_SCOPE_AGENT);
    for (;;) {
        if (tid == 0) *bc = nxt;
        __syncthreads();
        const int idx = __builtin_amdgcn_readfirstlane(*bc);
        __syncthreads();
        if (idx >= 4096) break;
        if (tid == 0) nxt = (int)__hip_atomic_fetch_add(qhead, 1u, __ATOMIC_RELAXED, __HIP_MEMORY_SCOPE_AGENT);
        const int vmask = p.qslot ? REPK_VMASK : ATTN_VMASK;
        if (idx < 3072) {
            const int lvl = 7 - idx / 384, rem = idx % 384;
            if (rem < 128) { if (vmask & 2) attn_unit<1>(p, l, rem >> 2, rem & 3, lvl, lds); }
            else if (rem < 256) { if (vmask & 1) attn_unit<0>(p, l, (rem - 128) >> 2, rem & 3, lvl, lds); }
            else { const int d = rem - 256; if (vmask & 8) attn_unit<3>(p, l, d & 31, 0, 4 * lvl + 3 - (d >> 5), lds); }
        } else { const int c = idx - 3072; if (vmask & 4) attn_unit<2>(p, l, c >> 5, (c >> 4) & 1, c & 15, lds); }
    }
}
}

namespace {
constexpr int DS_LD = 2052;
constexpr int DS_CTL = 16 * DS_LD * 4;
constexpr int DS_LDS = DS_CTL + 64;

__device__ __forceinline__ void dsa_unit(const Params& p, int u, LAS3 char* lds) {
    const int tid = opaque_tid(p.wid), w = __builtin_amdgcn_readfirstlane(tid >> 6), lane = tid & 63, i = lane & 15, g = lane >> 4;
    const int b = u >> 7, t0 = (u & 127) * 16;
    const size_t tok0 = (size_t)b * S;
    uint32_t* mbase = p.mask + (tok0 + t0) * 64;
    if (t0 + 16 <= 256) {
#pragma unroll
        for (int qq = 0; qq < 2; ++qq) {
            const int q = 2 * w + qq, n = t0 + q + 1;
            const int cnt = n > lane ? ((n - lane + 63) >> 6) : 0;
            mbase[q * 64 + lane] = cnt >= 32 ? 0xFFFFFFFFu : ((1u << cnt) - 1u);
        }
        return;
    }
    const int nreg = (t0 + 16 + 63) >> 6;
    const int ntile = nreg * 4;
    bf16x8 qf[8]; float wq[8];
    {
        const bf16_t* qrow = p.proj + (tok0 + t0 + i) * NP;
#pragma unroll
        for (int h = 0; h < 8; ++h) qf[h] = *(const bf16x8*)(qrow + PC_DQI + h * 32 + 8 * g);
        const u32x4 ww = *(const u32x4*)(qrow + PC_DWI);
        const float sc = 0.35355339059327373f * 0.17677669529663687f;
        wq[0] = bflo(ww.x) * sc; wq[1] = bfhi(ww.x) * sc; wq[2] = bflo(ww.y) * sc; wq[3] = bfhi(ww.y) * sc;
        wq[4] = bflo(ww.z) * sc; wq[5] = bfhi(ww.z) * sc; wq[6] = bflo(ww.w) * sc; wq[7] = bfhi(ww.w) * sc;
    }
    const int tq = t0 + i;
#ifndef DSA_EXP
#define DSA_EXP 0
#endif
    const bool exp_skip_score = (DSA_EXP == 2) && p.qslot > 0, exp_skip_sel = (DSA_EXP == 1) && p.qslot > 0, exp_nostore = (DSA_EXP != 0) && p.qslot > 0;
    if (!exp_skip_score)
    for (int base = w; base < ntile; base += 32) {
        bf16x8 kf4[4];
#pragma unroll
        for (int uu = 0; uu < 4; ++uu) { const int kt = base + 8 * uu; if (kt < ntile) kf4[uu] = *(const bf16x8*)(p.kidx + (tok0 + 16 * kt + i) * 32 + 8 * g); }
#pragma unroll
        for (int uu = 0; uu < 4; ++uu) {
            const int kt = base + 8 * uu;
            if (kt < ntile) {
                f32x4 sc4 = {0.f, 0.f, 0.f, 0.f};
#pragma unroll
                for (int h = 0; h < 8; ++h) {
                    const f32x4 c = __builtin_amdgcn_mfma_f32_16x16x32_bf16(kf4[uu], qf[h], (f32x4){0.f, 0.f, 0.f, 0.f}, 0, 0, 0);
#pragma unroll
                    for (int r = 0; r < 4; ++r) { const int ci = __float_as_int(c[r]); sc4[r] += wq[h] * __int_as_float(ci > 0 ? ci : 0); }
                }
                u32x4 ko;
#pragma unroll
                for (int r = 0; r < 4; ++r) {
                    const int key = 16 * kt + 4 * g + r;
                    unsigned uu2 = __float_as_uint(sc4[r]); if (uu2 == 0x80000000u) uu2 = 0u;
                    uu2 = (uu2 & 0x80000000u) ? ~uu2 : (uu2 | 0x80000000u);
                    ko[r] = (key <= tq) ? uu2 : 0u;
                }
                *(LAS3 u32x4*)(lds + ((size_t)i * DS_LD + 16 * kt + 4 * g) * 4) = ko;
            }
        }
    }
    __syncthreads();
    if (!exp_skip_sel)
    {
        const int qA = 2 * w, qB = 2 * w + 1;
        const LAS3 unsigned* kpA = (const LAS3 unsigned*)(lds + (size_t)qA * DS_LD * 4);
        const LAS3 unsigned* kpB = (const LAS3 unsigned*)(lds + (size_t)qB * DS_LD * 4);
        unsigned PA[32], PB[32];
        const int nv = nreg * 64;
#pragma unroll
        for (int r = 0; r < 32; ++r) {
            int idx = r * 64 + lane; asm volatile("" : "+v"(idx));
            const unsigned va = kpA[r * 64 + lane], vb = kpB[r * 64 + lane];
            PA[r] = (idx < nv) ? va : 0u; PB[r] = (idx < nv) ? vb : 0u;
        }
#define DSA_TR(P, j, m) do { _Pragma("unroll") for (int k = 0; k < 32; ++k) if ((k & (j)) == 0) { const unsigned x = P[k], y = P[k + (j)]; \
            P[k] = (x & (m)) | ((y << (j)) & ~(m)); P[k + (j)] = ((x >> (j)) & (m)) | (y & ~(m)); } } while (0)
        DSA_TR(PA, 16, 0x0000FFFFu); DSA_TR(PB, 16, 0x0000FFFFu); DSA_TR(PA, 8, 0x00FF00FFu); DSA_TR(PB, 8, 0x00FF00FFu);
        DSA_TR(PA, 4, 0x0F0F0F0Fu); DSA_TR(PB, 4, 0x0F0F0F0Fu); DSA_TR(PA, 2, 0x33333333u); DSA_TR(PB, 2, 0x33333333u);
        DSA_TR(PA, 1, 0x55555555u); DSA_TR(PB, 1, 0x55555555u);
#undef DSA_TR
        unsigned alA = 0xFFFFFFFFu, abA = 0u, selA = 0u, alB = 0xFFFFFFFFu, abB = 0u, selB = 0u;
        bool exA = false, exB = false;
#pragma unroll
        for (int bit = 31; bit >= 0; --bit) {
            if (!(exA && exB)) {
                const unsigned cA = abA | (alA & PA[bit]), cB = abB | (alB & PB[bit]);
                const int na = exA ? 0 : wave_reduce_add(__builtin_popcount(cA)), nb = exB ? 0 : wave_reduce_add(__builtin_popcount(cB));
                if (!exA) { if (na >= 256) { if (na == 256) { exA = true; selA = cA; } alA &= PA[bit]; } else { abA |= alA & PA[bit]; alA &= ~PA[bit]; } }
                if (!exB) { if (nb >= 256) { if (nb == 256) { exB = true; selB = cB; } alB &= PB[bit]; } else { abB |= alB & PB[bit]; alB &= ~PB[bit]; } }
            }
        }
        const unsigned long long lt = (lane == 0) ? 0ull : (~0ull >> (64 - lane));
#pragma unroll 1
        for (int qq = 0; qq < 2; ++qq) {
            const bool exact = qq ? exB : exA;
            unsigned sel = qq ? selB : selA;
            if (!exact) {
                const unsigned al = qq ? alB : alA, ab = qq ? abB : abA;
                const int need = 256 - wave_reduce_add(__builtin_popcount(ab));
                int running = 0; sel = ab;
                for (int r = 0; r < 32; ++r) {
                    const bool eq = ((al >> r) & 1u) != 0u;
                    const unsigned long long be = __ballot(eq);
                    if (eq && running + __popcll(be & lt) < need) sel |= 1u << r;
                    running += __popcll(be);
                }
            }
            if (!exp_nostore) mbase[(2 * w + qq) * 64 + lane] = sel;
        }
    }
    __syncthreads();
}

__device__ __forceinline__ void phase_dsa(const Params& p, int l, LAS3 char* lds) {
    const int tid = opaque_tid(p.wid);
    unsigned* qhead = p.ctl + CW_QD + 64 * (l + 2 * p.qslot);
    volatile LAS3 int* bc = (volatile LAS3 int*)(lds + DS_CTL);
    int nxt = 0;
    if (tid == 0) nxt = (int)__hip_atomic_fetch_add(qhead, 1u, __ATOMIC_RELAXED, __HIP_MEMORY_SCOPE_AGENT);
    for (;;) {
        if (tid == 0) *bc = nxt;
        __syncthreads();
        const int idx = __builtin_amdgcn_readfirstlane(*bc);
        __syncthreads();
        if (idx >= 4096) break;
        if (tid == 0) nxt = (int)__hip_atomic_fetch_add(qhead, 1u, __ATOMIC_RELAXED, __HIP_MEMORY_SCOPE_AGENT);
        const int pb = 127 - (idx >> 5), b = idx & 31;
        dsa_unit(p, b * 128 + pb, lds);
    }
}
}

namespace {
constexpr int LDS_BYTES = 147456;
constexpr int NTHREADS = 512;

template <int PH>
__device__ __forceinline__ void run_phase(const Params& p, int l, unsigned char* smem) {
    LAS3 char* lds = (LAS3 char*)smem;
    PG8_LAS unsigned char* glds = (PG8_LAS unsigned char*)smem;
    const int G = gridDim.x, c = blockIdx.x;
    if constexpr (PH == 0) phase_p0(p, (char*)smem);
    if constexpr (PH == 1) { if (l == 0) phase_norm1<0>(p, 0); else phase_norm1<1>(p, l); }
    if constexpr (PH == 2) { pg8::Gemm g{p.h, p.WinT + (size_t)l * NP * D, D, D, 0}; pg8::StaticOrder S; S.init(T, NP, G, c);
        EpiStoreBf16 E{p.proj, NP}; pg8::gemm_phase<EpiStoreBf16, pg8::StaticOrder, false>(glds, g, S, E, p.wid); }
    if constexpr (PH == 3) phase_prep(p, l);
    if constexpr (PH == 4) { pg8::Gemm g{p.proj + PC_BCQ, p.WqT + (size_t)l * 512 * 256, 256, NP, 0}; pg8::StaticOrder S; S.init(T, 512, G, c);
          EpiMlaQ E{p.qm}; pg8::gemm_phase<EpiMlaQ, pg8::StaticOrder, false>(glds, g, S, E, p.wid); }
    if constexpr (PH == 12) { pg8::Gemm g{p.proj + PC_BCKV, p.WkvT + (size_t)l * 512 * 128, 128, NP, 0}; pg8::StaticOrder S; S.init(T, 512, G, c);
          EpiMlaKV E{p.km, p.vm}; pg8::gemm_phase<EpiMlaKV, pg8::StaticOrder, false>(glds, g, S, E, p.wid); }
    if constexpr (PH == 13) phase_dsa(p, l, lds);
    if constexpr (PH == 5) phase_attn(p, l, lds);
    if constexpr (PH == 6) { pg8::Gemm g{p.merged, p.WoutT + (size_t)l * D * D, D, D, 0}; pg8::StaticOrder S; S.init(T, D, G, c);
        EpiResidual E{l == 0 ? p.x : nullptr, p.xb, p.mod + (size_t)l * NB * NMOD + 2 * 1024}; pg8::gemm_phase<EpiResidual, pg8::StaticOrder, false>(glds, g, S, E, p.wid); }
    if constexpr (PH == 7) phase_route(p, l, (char*)smem);
    if constexpr (PH == 8) { const int* cnt = (const int*)(p.ctl + CW_CNT) + l * 16;
        pg8::Gemm g{p.h, p.WguT + (size_t)l * 16 * 512 * 1024, 1024, D, (size_t)512 * 1024}; MoeOrder S; S.init(cnt, p.list, 2, G, c);
        EpiGateUp E{p.hid}; pg8::gemm_phase<EpiGateUp, MoeOrder, true>(glds, g, S, E, p.wid); }
    if constexpr (PH == 9) { const int* cnt = (const int*)(p.ctl + CW_CNT) + l * 16;
        pg8::Gemm g{p.hid, p.WdT + (size_t)l * 16 * 1024 * 256, 256, 256, (size_t)1024 * 256}; MoeOrder S; S.init(cnt, p.list, 4, G, c);
        EpiDown E{p.ys, p.list, p.wl, cnt}; pg8::gemm_phase<EpiDown, MoeOrder, false>(glds, g, S, E, p.wid); }
    if constexpr (PH == 10) phase_norm1<2>(p, 1);
    if constexpr (PH == 11) phase_norm1<0>(p, l);
}
template <int PH>
__global__ void __launch_bounds__(NTHREADS, 2) k_ph(Params p, int l) {
    extern __shared__ __attribute__((aligned(16))) unsigned char smem[];
    p.wid = __builtin_amdgcn_readfirstlane(threadIdx.x >> 6); p.qslot = p.qslot_host;
    run_phase<PH>(p, l, smem);
}
}


namespace {
#ifndef REP_PH
#define REP_PH -1
#endif
#define REP(X, l) do { if (REP_PH == X) { xcd_barrier(bar); phase<X>(l, smem, wid, 1); } } while (0)
struct KArgs { const float* in[20]; float* xo; char* ws; };
constexpr size_t al256(size_t b) { return (b + 255) & ~(size_t)255; }
constexpr size_t WS_CTL = 0;
constexpr size_t WS_MOD = WS_CTL + al256((size_t)CW_WORDS * 4);
constexpr size_t WS_WIN = WS_MOD + al256((size_t)2 * NB * NMOD * 4);
constexpr size_t WS_WOUT = WS_WIN + al256((size_t)2 * NP * D * 2);
constexpr size_t WS_WQ = WS_WOUT + al256((size_t)2 * D * D * 2);
constexpr size_t WS_WKV = WS_WQ + al256((size_t)2 * 512 * 256 * 2);
constexpr size_t WS_WGU = WS_WKV + al256((size_t)2 * 512 * 128 * 2);
constexpr size_t WS_WD = WS_WGU + al256((size_t)2 * 16 * 512 * 1024 * 2);
constexpr size_t WS_ROPE = WS_WD + al256((size_t)2 * 16 * 1024 * 256 * 2);
constexpr size_t WS_RQ = WS_ROPE + al256((size_t)2048 * 16 * 2 * 4);
constexpr size_t WS_RKV = WS_RQ + al256((size_t)T * 4);
constexpr size_t WS_CBF = WS_RKV + al256((size_t)T * 4);
constexpr size_t WS_KIDX = WS_CBF + al256((size_t)NB * 4 * S * 4);
constexpr size_t WS_MASK = WS_KIDX + al256((size_t)T * 32 * 2);
constexpr size_t WS_LIST = WS_MASK + al256((size_t)T * 64 * 4);
constexpr size_t WS_RW = WS_LIST + al256((size_t)2 * 16 * ECAP * 4);
constexpr size_t WS_WL = WS_RW + al256((size_t)T * 2 * 4);
constexpr size_t WS_H = WS_WL + al256((size_t)2 * 16 * ECAP * 4);
constexpr size_t WS_PROJ = WS_H + al256((size_t)T * D * 2);
constexpr size_t WS_QM = WS_PROJ + al256((size_t)T * NP * 2);
constexpr size_t WS_KM = WS_QM + al256((size_t)T * 384 * 2);
constexpr size_t WS_VM = WS_KM + al256((size_t)T * 384 * 2);
constexpr size_t WS_MERGED = WS_VM + al256((size_t)T * 256 * 2);
constexpr size_t WS_XB = WS_MERGED + al256((size_t)T * D * 2);
constexpr size_t WS_END1 = WS_XB + al256((size_t)T * D * 2);
constexpr size_t WS_HID = WS_PROJ;
constexpr size_t WS_YS = WS_HID + al256((size_t)HIDROWS * 256 * 2);
constexpr size_t WS_END2 = WS_YS + al256((size_t)T * 2 * D * 2);
constexpr size_t WS_NEED = WS_END1 > WS_END2 ? WS_END1 : WS_END2;
static_assert(WS_END2 <= WS_MERGED, "MoE overlay must not reach the merged buffer");

__device__ __forceinline__ Params make_params(const KArgs& a) {
    Params p;
    p.x = a.in[0]; p.c = a.in[1]; p.w_ada = a.in[2]; p.b_ada = a.in[3]; p.g_norm1 = a.in[4]; p.w_in = a.in[5]; p.b_forget = a.in[6]; p.g_q_mla = a.in[7];
    p.w_q_up = a.in[8]; p.g_kv_mla = a.in[9]; p.w_kv_up = a.in[10]; p.sinks = a.in[11]; p.w_out = a.in[12]; p.g_norm2 = a.in[13]; p.w_router = a.in[14];
    p.b_router = a.in[15]; p.w_gate = a.in[16]; p.w_up = a.in[17]; p.w_down = a.in[18]; p.g_final = a.in[19];
    p.xo = a.xo; char* ws = a.ws;
    p.ctl = (unsigned*)(ws + WS_CTL); p.mod = (float*)(ws + WS_MOD); p.WinT = (bf16_t*)(ws + WS_WIN); p.WoutT = (bf16_t*)(ws + WS_WOUT);
    p.WqT = (bf16_t*)(ws + WS_WQ); p.WkvT = (bf16_t*)(ws + WS_WKV); p.WguT = (bf16_t*)(ws + WS_WGU); p.WdT = (bf16_t*)(ws + WS_WD);
    p.ropetab = (float*)(ws + WS_ROPE); p.rq = (float*)(ws + WS_RQ); p.rkv = (float*)(ws + WS_RKV); p.cbF = (float*)(ws + WS_CBF); p.kidx = (bf16_t*)(ws + WS_KIDX);
    p.mask = (uint32_t*)(ws + WS_MASK); p.list = (int*)(ws + WS_LIST); p.rw = (float*)(ws + WS_RW); p.wl = (float*)(ws + WS_WL); p.h = (bf16_t*)(ws + WS_H);
    p.proj = (bf16_t*)(ws + WS_PROJ); p.qm = (bf16_t*)(ws + WS_QM); p.km = (bf16_t*)(ws + WS_KM); p.vm = (bf16_t*)(ws + WS_VM);
    p.merged = (bf16_t*)(ws + WS_MERGED); p.xb = (bf16_t*)(ws + WS_XB); p.hid = (bf16_t*)(ws + WS_HID); p.ys = (bf16_t*)(ws + WS_YS);
    return p;
}
template <int PH>
__device__ __forceinline__ void phase(int l, unsigned char* smem, int wid, int qslot = 0) {
    typedef const __attribute__((address_space(4))) KArgs* KA4;
    KA4 ka = (KA4)__builtin_amdgcn_kernarg_segment_ptr();
    asm volatile("" : "+s"(ka));
    KArgs a;
#pragma unroll
    for (int i = 0; i < 20; ++i) a.in[i] = ka->in[i];
    a.xo = ka->xo; a.ws = ka->ws;
    Params p = make_params(a); p.wid = wid; p.qslot = qslot; p.qslot_host = 0;
    run_phase<PH>(p, l, smem);
}
__global__ void __launch_bounds__(NTHREADS, 2) fwd(KArgs args) {
    extern __shared__ __attribute__((aligned(16))) unsigned char smem[];
    volatile LAS unsigned* st = (volatile LAS unsigned*)(smem + LDS_BYTES - 16);
    const int wid = __builtin_amdgcn_readfirstlane(threadIdx.x >> 6);
    if (xb_leader(wid)) { st[0] = 0u; st[1] = 0u; st[2] = 0u; st[3] = 0u; }
    __syncthreads();
    XcdBarrier bar = xcd_barrier_post((unsigned*)(args.ws + WS_CTL) + CW_BAR, st, wid);
    phase<0>(0, smem, wid);  REP(0, 0);
    xcd_barrier(bar);
#define LAYER(l) do { \
        phase<1>(l, smem, wid);  if (l == 0) REP(1, l); xcd_barrier(bar); \
        phase<2>(l, smem, wid);  REP(2, l); xcd_barrier(bar); \
        phase<3>(l, smem, wid);  REP(3, l); xcd_barrier(bar); \
        phase<4>(l, smem, wid);  REP(4, l); phase<12>(l, smem, wid);  REP(12, l); phase<13>(l, smem, wid);  REP(13, l); xcd_barrier(bar); \
        phase<5>(l, smem, wid);  REP(5, l); xcd_barrier(bar); \
        phase<6>(l, smem, wid);  xcd_barrier(bar); \
        phase<7>(l, smem, wid);  REP(7, l); xcd_barrier(bar); \
        phase<8>(l, smem, wid);  REP(8, l); xcd_barrier(bar); \
        phase<9>(l, smem, wid);  REP(9, l); xcd_barrier(bar); } while (0)
    LAYER(0);
    LAYER(1);
#ifdef REP_BAR
    for (int rb = 0; rb < REP_BAR; ++rb) xcd_barrier(bar);
#endif
    phase<10>(1, smem, wid);
}
}

extern "C" void kernel_launch(void* const* d_in, const int* in_sizes, int n_in, void* d_out, int out_size, void* d_ws, size_t ws_size,
                              hipStream_t stream) {
    KArgs a{};
    for (int i = 0; i < 20; ++i) a.in[i] = (const float*)d_in[i];
    a.xo = (float*)d_out; a.ws = (char*)d_ws;
    if (WS_NEED > ws_size) return;

    static int grid = 0;
    if (!grid) {
        int dev = 0, cus = 0, per_cu = 0;
        (void)hipGetDevice(&dev);
        (void)hipDeviceGetAttribute(&cus, hipDeviceAttributeMultiprocessorCount, dev);
        (void)hipFuncSetAttribute((const void*)fwd, hipFuncAttributeMaxDynamicSharedMemorySize, LDS_BYTES);
        (void)hipOccupancyMaxActiveBlocksPerMultiprocessor(&per_cu, (const void*)fwd, NTHREADS, LDS_BYTES);
        grid = cus > 0 ? cus : 256;
    }
    (void)hipMemsetAsync(a.ws + WS_CTL, 0, (size_t)CW_WORDS * 4, stream);
    fwd<<<dim3(grid), dim3(NTHREADS), LDS_BYTES, stream>>>(a);
}
```

```cpp
#include <hip/hip_runtime.h>
#include <stdint.h>
#define XB_TMO      128
#define XB_XCNT(j)  (256  + 64 * (j))
#define XB_XSUB(j)  (1280 + 64 * (j))
#define XB_XGEN(j)  (2304 + 64 * (j))
#define XB_TOP      3328
#define XB_TOPGEN   3392
#define XCD_BAR_WORDS 3456
#define XB_SPIN_CAP (1u << 20)
#define LAS __attribute__((address_space(3)))

__device__ __forceinline__ unsigned xb_ld(unsigned* p)              { return __hip_atomic_load(p, __ATOMIC_RELAXED, __HIP_MEMORY_SCOPE_AGENT); }
__device__ __forceinline__ unsigned xb_add(unsigned* p, unsigned v) { return __hip_atomic_fetch_add(p, v, __ATOMIC_RELAXED, __HIP_MEMORY_SCOPE_AGENT); }
__device__ __forceinline__ unsigned xb_xcc_id() { return (unsigned)__builtin_amdgcn_s_getreg((3 << 11) | 20) & 0xFu; }
#define XB_SPIN(cond, bar) do { unsigned _sp = 0; while (cond) { __builtin_amdgcn_s_sleep(1); \
    if ((++_sp & 255u) == 0u) { if (xb_ld(&(bar)[XB_TMO])) break; if (_sp > XB_SPIN_CAP) { atomicAdd(&(bar)[XB_TMO], 1u); break; } } } } while (0)

struct XcdBarrier { unsigned* bar; unsigned x; volatile LAS unsigned* st; int wid; };
__device__ __forceinline__ bool xb_leader(int wid) { return wid == 0 && __builtin_amdgcn_mbcnt_hi(~0u, __builtin_amdgcn_mbcnt_lo(~0u, 0u)) == 0u; }

__device__ __forceinline__ XcdBarrier xcd_barrier_post(unsigned* bar, volatile LAS unsigned* st, int wid) {
    XcdBarrier b; b.bar = bar; b.x = xb_xcc_id(); b.st = st; b.wid = wid;
    if (xb_leader(wid)) (void)xb_add(&bar[XB_XCNT(b.x)], 1u);
    return b;
}
__device__ __forceinline__ void xcd_barrier_complete(unsigned* bar, unsigned x, unsigned& nloc, unsigned& nx) {
    const unsigned G = gridDim.x * gridDim.y * gridDim.z;
    unsigned sum, cnt, mine, sp = 0u;
    for (;;) {
        sum = 0u; cnt = 0u; mine = 0u;
#pragma unroll
        for (unsigned j = 0; j < 16; ++j) { const unsigned c = xb_ld(&bar[XB_XCNT(j)]); sum += c; cnt += (c > 0u) ? 1u : 0u; mine = (j == x) ? c : mine; }
        if (sum == G) break;
        __builtin_amdgcn_s_sleep(1);
        if ((++sp & 255u) == 0u) { if (xb_ld(&bar[XB_TMO])) break; if (sp > XB_SPIN_CAP) { atomicAdd(&bar[XB_TMO], 1u); break; } }
    }
    nloc = mine > 0u ? mine : 1u; nx = cnt > 0u ? cnt : 1u;
}
__device__ __forceinline__ void xcd_barrier(const XcdBarrier& b) {
    asm volatile("s_waitcnt vmcnt(0)" ::: "memory");
    __syncthreads();
    if (xb_leader(b.wid)) {
        unsigned* bar = b.bar;
        __builtin_amdgcn_s_waitcnt(0);
        unsigned nloc = b.st[0], nx = b.st[1];
        if (nloc == 0u) { xcd_barrier_complete(bar, b.x, nloc, nx); b.st[0] = nloc; b.st[1] = nx; }
        const unsigned old = xb_add(&bar[XB_XSUB(b.x)], 1u);
        const unsigned gen = old / nloc;
        if (old + 1u == (gen + 1u) * nloc) {
            __builtin_amdgcn_fence(__ATOMIC_RELEASE, "agent");
            asm volatile("s_waitcnt vmcnt(0)" ::: "memory");
            const unsigned og = xb_add(&bar[XB_TOP], 1u);
            const unsigned tg = og / nx;
            if (og + 1u == (tg + 1u) * nx) xb_add(&bar[XB_TOPGEN], 1u);
            else XB_SPIN(xb_ld(&bar[XB_TOPGEN]) == tg, bar);
            __builtin_amdgcn_fence(__ATOMIC_ACQUIRE, "agent");
            xb_add(&bar[XB_XGEN(b.x)], 1u);
            asm volatile("s_waitcnt vmcnt(0)" ::: "memory");
        } else {
            XB_SPIN(xb_ld(&bar[XB_XGEN(b.x)]) == gen, bar);
            __builtin_amdgcn_fence(__ATOMIC_ACQUIRE, "agent");
            asm volatile("s_waitcnt vmcnt(0)" ::: "memory");
        }
    }
    __syncthreads();
}

#define LAS3 __attribute__((address_space(3)))
namespace {
typedef unsigned short bf16_t;
typedef short bf16x8 __attribute__((ext_vector_type(8)));
typedef short bf16x4 __attribute__((ext_vector_type(4)));
typedef float f32x4 __attribute__((ext_vector_type(4)));
typedef float f32x2 __attribute__((ext_vector_type(2)));
typedef unsigned u32x4 __attribute__((ext_vector_type(4)));
typedef unsigned u32x2 __attribute__((ext_vector_type(2)));

constexpr int D = 1024, NB = 32, S = 2048, T = NB * S, NIN = 2380, NP = 2560, NMOD = 6144;
constexpr int OFF_AQ = 0, OFF_AK = 256, OFF_AV = 512, OFF_AF = 768, OFF_BCQ = 772, OFF_BCKV = 1028, OFF_BKR = 1156,
              OFF_CQ = 1188, OFF_CK = 1444, OFF_CV = 1572, OFF_DQ = 1700, OFF_DK = 1956, OFF_DV = 2020,
              OFF_DQI = 2084, OFF_DKI = 2340, OFF_DWI = 2372;
constexpr int PC_AQ = 0, PC_AK = 256, PC_AV = 512, PC_BCQ = 768, PC_BCKV = 1024, PC_BKR = 1152, PC_CQ = 1184, PC_CK = 1440, PC_CV = 1568,
              PC_DQ = 1696, PC_DK = 1952, PC_DV = 2016, PC_DQI = 2080, PC_DKI = 2336, PC_DWI = 2368, PC_AF = 2376;
constexpr float EPS = 1e-6f;
constexpr float LOG2E = 1.4426950408889634f;
constexpr int ECAP = T;
constexpr int HIDROWS = 2 * T + 16 * 256;

__host__ __device__ __forceinline__ int orig_col(int n) { return n < 768 ? n : (n < 2376 ? n + 4 : (n < 2380 ? n - 1608 : -1)); }
__device__ __forceinline__ int opaque_tid(int wid) {
    int t = wid * 64 + (int)__builtin_amdgcn_mbcnt_hi(~0u, __builtin_amdgcn_mbcnt_lo(~0u, 0u));
    asm volatile("" : "+v"(t)); return t; }
__device__ __forceinline__ float bf2f(bf16_t v) { return __uint_as_float((unsigned)v << 16); }
__device__ __forceinline__ bf16_t f2bf(float f) { unsigned u = __float_as_uint(f); u += 0x7FFFu + ((u >> 16) & 1u); return (bf16_t)(u >> 16); }
typedef __bf16 bf16x2_native __attribute__((ext_vector_type(2)));
__device__ __forceinline__ unsigned cvt_pk_bf16(float lo, float hi) { const f32x2 v = {lo, hi}; return __builtin_bit_cast(unsigned, __builtin_convertvector(v, bf16x2_native)); }
__device__ __forceinline__ float bflo(unsigned w) { return __uint_as_float(w << 16); }
__device__ __forceinline__ float bfhi(unsigned w) { return __uint_as_float(w & 0xFFFF0000u); }
__device__ __forceinline__ float wave_sum(float v) {
#pragma unroll
    for (int o = 32; o > 0; o >>= 1) v += __shfl_xor(v, o);
    return v;
}
__device__ __forceinline__ float xor32_max(float x) {
    float a = x, b = x;
    asm volatile("s_nop 1\n\tv_permlane32_swap_b32 %0, %1\n\ts_nop 1" : "+v"(a), "+v"(b));
    return fmaxf(a, b);
}
__device__ __forceinline__ int wave_reduce_add(int v) {
    v += __builtin_amdgcn_update_dpp(0, v, 0xB1, 0xF, 0xF, true);
    v += __builtin_amdgcn_update_dpp(0, v, 0x4E, 0xF, 0xF, true);
    v += __builtin_amdgcn_update_dpp(0, v, 0x141, 0xF, 0xF, true);
    v += __builtin_amdgcn_update_dpp(0, v, 0x140, 0xF, 0xF, true);
    return __builtin_amdgcn_readlane(v, 0) + __builtin_amdgcn_readlane(v, 16) + __builtin_amdgcn_readlane(v, 32) + __builtin_amdgcn_readlane(v, 48);
}
}

namespace pg8 {
#define PG8_LAS __attribute__((address_space(3)))
constexpr int BM = 256, BK = 64, HALF = 128, HTB = HALF * BK * 2, STAGE_BYTES = 8 * HTB, NXCD = 8, WGM = 8;

__host__ __device__ __forceinline__ int lds_byte(int r, int c) { const int st = (r >> 4) * 2 + (c >> 5), rr = r & 15, cc = c & 31, ob = rr * 64 + cc * 2; return st * 1024 + (ob ^ (((ob >> 9) & 1) << 5)); }
__host__ __device__ __forceinline__ void stage_rc(int b, int& R, int& C) { const int st = b / 1024, sb = b % 1024, swz = sb ^ (((sb >> 9) & 1) << 5); R = (st >> 1) * 16 + swz / 64; C = (st & 1) * 32 + (swz % 64) / 2; }
__host__ __device__ __forceinline__ int perm32(int rho) { const int n = rho >> 4, i = rho & 15; return 8 * (i >> 2) + 4 * n + (i & 3); }

struct Unit { int pm, pn, e, mt; };
struct Gemm { const bf16_t* A; const bf16_t* Bt; int K; int lda; size_t bstride; };

struct StaticOrder {
    int nM, nN, nwg, G, c;
    __host__ __device__ void init(int M, int N, int G_, int c_) { nM = M / BM; nN = N / BM; nwg = nM * nN; G = G_; c = c_; }
    __host__ __device__ bool next(int i, Unit& u) const {
        const long L = (long)i * G + c; if (L >= nwg) return false;
        int wgid = (int)L; { const int q = nwg / NXCD, r = nwg % NXCD, xcd = wgid % NXCD, off = wgid / NXCD; wgid = (xcd < r ? xcd * (q + 1) : r * (q + 1) + (xcd - r) * q) + off; }
        const int nig = WGM * nN, gid = wgid / nig, fm = gid * WGM, gsz = (nM - fm) < WGM ? (nM - fm) : WGM;
        u.pm = fm + ((wgid % nig) % gsz); u.pn = (wgid % nig) / gsz; u.e = 0; u.mt = 0; return true;
    }
    __device__ __forceinline__ int arow(const Unit& u, int r) const { return u.pm * BM + r; }
};

template <class Epi, class Sched, bool GATHER>
__device__ __forceinline__ void gemm_phase(PG8_LAS unsigned char* lds, const Gemm g, const Sched& S, const Epi& E, int wave_index) {
    const int tid = opaque_tid(wave_index), wid = __builtin_amdgcn_readfirstlane(tid >> 6), lane = tid & 63, wr = wid >> 2, wc = wid & 3, fr = lane & 15, fq = lane >> 4;
    int K_ = g.K; asm volatile("" : "+s"(K_));
    const int K = K_, nt = K / BK, lda = g.lda;
    int Ra[2], Ca[2]; unsigned voffB[2], voffA[2];
#pragma unroll
    for (int i = 0; i < 2; ++i) { int R, C; stage_rc(tid * 16 + i * 8192, R, C); const int Rb = Epi::PERM ? ((R & ~31) + perm32(R & 31)) : R;
        Ra[i] = R; Ca[i] = C; voffB[i] = (unsigned)(Rb * K + C) * 2u; voffA[i] = (unsigned)(R * lda + C) * 2u; }
    const size_t kstep = (size_t)(BK * 2);
    const size_t hstepB = (size_t)HALF * K * 2;
    const size_t tstepB = 2 * hstepB;
    const size_t hstepA = (size_t)HALF * lda * 2, tstepA = 2 * hstepA;
    const unsigned ldsw = (unsigned)wid * 1024u;
    const int aoff = lds_byte(wr * 64 + fr, fq * 8), boff = lds_byte(wc * 32 + fr, fq * 8);
#define PG8_SA(b, h) (((b) * 2 + (h)) * HTB)
#define PG8_SB(b, h) ((4 + (b) * 2 + (h)) * HTB)
#define PG8_STAGE(bufoff, gbase, voff) do { _Pragma("unroll") for (int _i = 0; _i < 2; ++_i) \
        __builtin_amdgcn_global_load_lds((const unsigned*)((const char*)(gbase) + (voff)[_i]), (PG8_LAS unsigned*)(lds + (bufoff) + ldsw + _i * 8192), 16, 0, 0); } while (0)
#define PG8_STAGEA(bufoff, kptr, VO, h) do { _Pragma("unroll") for (int _i = 0; _i < 2; ++_i) { \
        const char* _src; if constexpr (GATHER) _src = (const char*)(kptr) + (VO)[_i][h]; else _src = (const char*)(kptr) + (size_t)(h) * hstepA + voffA[_i]; \
        __builtin_amdgcn_global_load_lds((const unsigned*)_src, (PG8_LAS unsigned*)(lds + (bufoff) + ldsw + _i * 8192), 16, 0, 0); } } while (0)
#define PG8_LDA(dst, b, h) do { _Pragma("unroll") for (int m = 0; m < 4; ++m) _Pragma("unroll") for (int k = 0; k < 2; ++k) dst[m][k] = *(const PG8_LAS bf16x8*)(lds + PG8_SA(b, h) + aoff + m * 2048 + k * 1024); } while (0)
#define PG8_LDB(dst, b, h) do { _Pragma("unroll") for (int n = 0; n < 2; ++n) _Pragma("unroll") for (int k = 0; k < 2; ++k) dst[n][k] = *(const PG8_LAS bf16x8*)(lds + PG8_SB(b, h) + boff + n * 2048 + k * 1024); } while (0)
#define PG8_MMA(ai, bj, At, Bt) do { __builtin_amdgcn_s_setprio(1); _Pragma("unroll") for (int m = 0; m < 4; ++m) _Pragma("unroll") for (int n = 0; n < 2; ++n) _Pragma("unroll") for (int k = 0; k < 2; ++k) \
        acc[ai][bj][m][n] = __builtin_amdgcn_mfma_f32_16x16x32_bf16(Bt[n][k], At[m][k], acc[ai][bj][m][n], 0, 0, 0); __builtin_amdgcn_s_setprio(0); } while (0)
#define PG8_WAIT_V(n) asm volatile("s_waitcnt vmcnt(" #n ")" ::: "memory")
#define PG8_WAIT_L(n) asm volatile("s_waitcnt lgkmcnt(" #n ")" ::: "memory")
#define PG8_BAR __builtin_amdgcn_s_barrier()
#define PG8_SCHED __builtin_amdgcn_sched_barrier(0)
#define PG8_SETV(V, u) do { _Pragma("unroll") for (int _i = 0; _i < 2; ++_i) _Pragma("unroll") for (int _h = 0; _h < 2; ++_h) { \
        const int _row = GATHER ? S.arow(u, _h * HALF + Ra[_i]) : ((u).pm * BM + _h * HALF + Ra[_i]); V[_i][_h] = (unsigned)(((size_t)_row * lda + Ca[_i]) * 2); } } while (0)
    Unit cur, nxt; int ui = 0;
    if (!S.next(0, cur)) return;
    f32x4 acc[2][2][4][2];
#pragma unroll
    for (int a = 0; a < 2; ++a)
#pragma unroll
        for (int b = 0; b < 2; ++b)
#pragma unroll
            for (int m = 0; m < 4; ++m)
#pragma unroll
                for (int n = 0; n < 2; ++n) acc[a][b][m][n] = (f32x4){0.f, 0.f, 0.f, 0.f};
    bf16x8 At[4][2], B0[2][2], B1[2][2];
    unsigned vA[2][2], vN[2][2];
    if constexpr (GATHER) { PG8_SETV(vA, cur); }
    const char* cA = (const char*)g.A + (GATHER ? (size_t)0 : (size_t)cur.pm * tstepA);
    const char* cB = (const char*)g.Bt + ((size_t)cur.e * g.bstride) * 2 + (size_t)cur.pn * tstepB;
    PG8_STAGE(PG8_SB(0, 0), cB, voffB); PG8_STAGE(PG8_SB(0, 1), cB + hstepB, voffB); PG8_STAGEA(PG8_SA(0, 0), cA, vA, 0); PG8_STAGEA(PG8_SA(0, 1), cA, vA, 1);
    if (wr == 1) PG8_BAR;
    PG8_WAIT_V(2); PG8_BAR;
    PG8_STAGE(PG8_SB(1, 0), cB + kstep, voffB); PG8_STAGEA(PG8_SA(1, 0), cA + kstep, vA, 0); PG8_STAGE(PG8_SB(1, 1), cB + hstepB + kstep, voffB);
    PG8_WAIT_V(6); PG8_BAR;
    for (;;) {
        const bool has_next = S.next(ui + 1, nxt);
        if constexpr (GATHER) { if (has_next) { PG8_SETV(vN, nxt); }
        else {
#pragma unroll
            for (int _i = 0; _i < 2; ++_i)
#pragma unroll
                for (int _h = 0; _h < 2; ++_h) vN[_i][_h] = vA[_i][_h];
        } }
        const char* nA = (!GATHER && has_next) ? (const char*)g.A + (size_t)nxt.pm * tstepA : cA;
        const char* nB = has_next ? (const char*)g.Bt + ((size_t)nxt.e * g.bstride) * 2 + (size_t)nxt.pn * tstepB : cB;
#pragma unroll 1
        for (int t = 0; t < nt; t += 2) {
            const bool last = (t == nt - 2);
            const char* a1 = cA + (size_t)(t + 1) * kstep;
            const char* a2 = last ? nA : cA + (size_t)(t + 2) * kstep; const char* b2 = last ? nB : cB + (size_t)(t + 2) * kstep;
            const char* a3 = a2 + kstep; const char* b3 = b2 + kstep;
            unsigned v2[2][2];
            if constexpr (GATHER) {
#pragma unroll
            for (int _i = 0; _i < 2; ++_i)
#pragma unroll
                for (int _h = 0; _h < 2; ++_h) v2[_i][_h] = last ? vN[_i][_h] : vA[_i][_h];
            }
            PG8_LDB(B0, 0, 0); PG8_LDB(B1, 0, 1); PG8_SCHED; PG8_LDA(At, 0, 0); PG8_STAGEA(PG8_SA(1, 1), a1, vA, 1);
            PG8_WAIT_V(8); PG8_WAIT_L(0); PG8_BAR; PG8_MMA(0, 0, At, B0); PG8_MMA(0, 1, At, B1); PG8_BAR; PG8_SCHED;
            PG8_LDA(At, 0, 1); PG8_STAGE(PG8_SB(0, 0), b2, voffB); PG8_STAGE(PG8_SB(0, 1), b2 + hstepB, voffB); PG8_STAGEA(PG8_SA(0, 0), a2, v2, 0);
            PG8_WAIT_V(8); PG8_WAIT_L(0); PG8_BAR; PG8_MMA(1, 0, At, B0); PG8_MMA(1, 1, At, B1); PG8_BAR; PG8_SCHED;
            PG8_LDB(B0, 1, 0); PG8_LDB(B1, 1, 1); PG8_SCHED; PG8_LDA(At, 1, 0); PG8_STAGEA(PG8_SA(0, 1), a2, v2, 1);
            PG8_WAIT_V(8); PG8_WAIT_L(0); PG8_BAR; PG8_MMA(0, 0, At, B0); PG8_MMA(0, 1, At, B1); PG8_BAR; PG8_SCHED;
            PG8_LDA(At, 1, 1); PG8_STAGE(PG8_SB(1, 0), b3, voffB); PG8_STAGE(PG8_SB(1, 1), b3 + hstepB, voffB); PG8_STAGEA(PG8_SA(1, 0), a3, v2, 0);
            PG8_WAIT_V(8); PG8_WAIT_L(0); PG8_BAR; PG8_MMA(1, 0, At, B0); PG8_MMA(1, 1, At, B1); PG8_BAR; PG8_SCHED;
        }
        if (wr == 0) PG8_BAR;
        E(acc, cur, wr, wc, fr, fq);
        if (!has_next) break;
#pragma unroll
        for (int a = 0; a < 2; ++a)
#pragma unroll
            for (int b = 0; b < 2; ++b)
#pragma unroll
                for (int m = 0; m < 4; ++m)
#pragma unroll
                    for (int n = 0; n < 2; ++n) acc[a][b][m][n] = (f32x4){0.f, 0.f, 0.f, 0.f};
        cur = nxt; cB = nB; cA = nA; ++ui;
        if constexpr (GATHER) {
#pragma unroll
        for (int _i = 0; _i < 2; ++_i)
#pragma unroll
            for (int _h = 0; _h < 2; ++_h) vA[_i][_h] = vN[_i][_h];
        }
        if (wr == 1) PG8_BAR;
    }
    PG8_WAIT_V(0);
    PG8_BAR;
#undef PG8_SA
#undef PG8_SB
#undef PG8_STAGE
#undef PG8_STAGEA
#undef PG8_LDA
#undef PG8_LDB
#undef PG8_MMA
#undef PG8_WAIT_V
#undef PG8_WAIT_L
#undef PG8_BAR
#undef PG8_SCHED
#undef PG8_SETV
}
}

namespace {
struct Params {
    const float *x, *c, *w_ada, *b_ada, *g_norm1, *w_in, *b_forget, *g_q_mla, *w_q_up, *g_kv_mla, *w_kv_up, *sinks, *w_out, *g_norm2,
                *w_router, *b_router, *w_gate, *w_up, *w_down, *g_final;
    float* xo;
    bf16_t* xb;
    unsigned* ctl;
    float* mod;
    bf16_t* WinT;
    bf16_t* WoutT;
    bf16_t* WqT;
    bf16_t* WkvT;
    bf16_t* WguT;
    bf16_t* WdT;
    float* ropetab;
    float* rq; float* rkv;
    float* cbF;
    bf16_t* kidx;
    uint32_t* mask;
    bf16_t* h;
    bf16_t* proj;
    bf16_t* qm; bf16_t* km; bf16_t* vm;
    bf16_t* merged;
    bf16_t* hid;
    bf16_t* ys;
    int* list;
    float* rw;
    float* wl;
    int wid;
    int qslot;
    int qslot_host;
};
constexpr int CW_BAR = 0;
constexpr int CW_CNT = 3584;
constexpr int CW_QA = 3648;
constexpr int CW_QD = 4288;
constexpr int CW_KN2 = 4992;
constexpr int CW_QN2 = CW_KN2 + 2 * NB * 4 * 32;
constexpr int CW_WORDS = CW_QN2 + 2 * NB * 4 * 8;
}

namespace {
constexpr long P0_B1 = 2l * NP * 128, P0_B2 = P0_B1 + 2l * 1024 * 128, P0_B3 = P0_B2 + 2l * 512 * 32, P0_B4 = P0_B3 + 2l * 512 * 16,
               P0_B5 = P0_B4 + 32l * 512 * 128, P0_B6 = P0_B5 + 32l * 1024 * 32;
__device__ __forceinline__ bf16_t* p0_fetch(const Params& p, long it, float (&v)[8]) {
    if (it < P0_B1) {
        const int l = (int)(it / (NP * 128)), r = (int)(it % (NP * 128)), n = r % NP, k0 = (r / NP) * 8, o = orig_col(n);
        const float* w = p.w_in + (size_t)l * D * NIN;
#pragma unroll
        for (int j = 0; j < 8; ++j) v[j] = o >= 0 ? w[(size_t)(k0 + j) * NIN + o] : 0.f;
        return p.WinT + ((size_t)l * NP + n) * D + k0;
    } else if (it < P0_B2) {
        const long s = it - P0_B1; const int l = (int)(s / (1024 * 128)), r = (int)(s % (1024 * 128)), n = r & 1023, k0 = (r >> 10) * 8;
        const float* w = p.w_out + (size_t)l * D * D;
#pragma unroll
        for (int j = 0; j < 8; ++j) v[j] = w[(size_t)(k0 + j) * D + n];
        return p.WoutT + ((size_t)l * D + n) * D + k0;
    } else if (it < P0_B3) {
        const long s = it - P0_B2; const int l = (int)(s / (512 * 32)), r = (int)(s % (512 * 32)), n = r & 511, k0 = (r >> 9) * 8;
        const float* w = p.w_q_up + (size_t)l * 256 * 384; const float* g = p.g_q_mla + l * 256;
#pragma unroll
        for (int j = 0; j < 8; ++j) v[j] = n < 384 ? g[k0 + j] * w[(size_t)(k0 + j) * 384 + n] : 0.f;
        return p.WqT + ((size_t)l * 512 + n) * 256 + k0;
    } else if (it < P0_B4) {
        const long s = it - P0_B3; const int l = (int)(s / (512 * 16)), r = (int)(s % (512 * 16)), n = r & 511, k0 = (r >> 9) * 8;
        const float* w = p.w_kv_up + (size_t)l * 128 * 512; const float* g = p.g_kv_mla + l * 128;
#pragma unroll
        for (int j = 0; j < 8; ++j) v[j] = g[k0 + j] * w[(size_t)(k0 + j) * 512 + n];
        return p.WkvT + ((size_t)l * 512 + n) * 128 + k0;
    } else if (it < P0_B5) {
        const long s = it - P0_B4; const int le = (int)(s >> 16), r = (int)(s & 65535), n = r & 511, k0 = (r >> 9) * 8;
        const int q = n >> 5, rr = n & 31, col = 16 * q + (rr & 15);
        const float* w = (rr < 16 ? p.w_gate : p.w_up) + (size_t)le * 1024 * 256;
#pragma unroll
        for (int j = 0; j < 8; ++j) v[j] = w[(size_t)(k0 + j) * 256 + col];
        return p.WguT + ((size_t)le * 512 + n) * 1024 + k0;
    } else {
        const long s = it - P0_B5; const int le = (int)(s >> 15), r = (int)(s & 32767), n = r & 1023, k0 = (r >> 10) * 8;
        const float* w = p.w_down + (size_t)le * 256 * 1024;
#pragma unroll
        for (int j = 0; j < 8; ++j) v[j] = w[(size_t)(k0 + j) * 1024 + n];
        return p.WdT + ((size_t)le * 1024 + n) * 256 + k0;
    }
}
__device__ __forceinline__ void p0_store(bf16_t* dst, const float (&v)[8]) {
    u32x4 w; w.x = cvt_pk_bf16(v[0], v[1]); w.y = cvt_pk_bf16(v[2], v[3]); w.z = cvt_pk_bf16(v[4], v[5]); w.w = cvt_pk_bf16(v[6], v[7]);
    *(u32x4*)dst = w;
}

__device__ __forceinline__ void phase_p0(const Params& p, char* lds) {
    const int tid = opaque_tid(p.wid), gtid = blockIdx.x * blockDim.x + tid, gthreads = gridDim.x * blockDim.x;
    for (long it0 = gtid; it0 < P0_B6; it0 += 4l * gthreads) {
        float va[8], vb[8], vc[8], vd[8];
        const bool hb = it0 + gthreads < P0_B6, hc = it0 + 2l * gthreads < P0_B6, hd = it0 + 3l * gthreads < P0_B6;
        bf16_t* da = p0_fetch(p, it0, va);
        bf16_t* db = hb ? p0_fetch(p, it0 + gthreads, vb) : da;
        bf16_t* dc = hc ? p0_fetch(p, it0 + 2l * gthreads, vc) : da;
        bf16_t* dd = hd ? p0_fetch(p, it0 + 3l * gthreads, vd) : da;
        p0_store(da, va);
        if (hb) p0_store(db, vb);
        if (hc) p0_store(dc, vc);
        if (hd) p0_store(dd, vd);
    }
    for (int it = gtid; it < 2048 * 16; it += gthreads) {
        const int pos = it >> 4, i = it & 15;
        const float inv = powf(10000.0f, -(float)i / 16.0f), ang = (float)pos * inv;
        p.ropetab[it * 2] = cosf(ang); p.ropetab[it * 2 + 1] = sinf(ang);
    }
    float* ca = (float*)lds;
    for (int i = tid; i < NB * 1024; i += 512) { const float v = p.c[i]; ca[i] = v / (1.f + __expf(-v)); }
    __syncthreads();
    for (int u = blockIdx.x; u < 2 * (NMOD / 64); u += gridDim.x) {
        const int l = u / (NMOD / 64), n = (u % (NMOD / 64)) * 64 + (tid & 63), bg = tid >> 6;
        const float* w = p.w_ada + (size_t)l * 1024 * NMOD + n;
        float acc[4] = {0.f, 0.f, 0.f, 0.f};
        for (int d0 = 0; d0 < 1024; d0 += 8) {
            float wv[8];
#pragma unroll
            for (int q = 0; q < 8; ++q) wv[q] = w[(size_t)(d0 + q) * NMOD];
#pragma unroll
            for (int q = 0; q < 8; ++q)
#pragma unroll
                for (int j = 0; j < 4; ++j) acc[j] += ca[(bg * 4 + j) * 1024 + d0 + q] * wv[q];
        }
        const float bias = p.b_ada[l * NMOD + n];
#pragma unroll
        for (int j = 0; j < 4; ++j) p.mod[((size_t)l * NB + bg * 4 + j) * NMOD + n] = acc[j] + bias;
    }
    __syncthreads();
}

template <int MODE>
__device__ __forceinline__ void phase_norm1(const Params& p, int l) {
#ifndef NORM_NT
#define NORM_NT 2
#endif
    constexpr int NT = NORM_NT;
    const int tid = opaque_tid(p.wid), w = tid >> 6, lane = tid & 63;
    const float* g = (MODE == 2) ? p.g_final : p.g_norm1 + l * D;
    const float* modl = p.mod + (size_t)(MODE == 2 ? 1 : l) * NB * NMOD;
    const float* modp = p.mod + (size_t)(MODE == 2 ? 1 : (l > 0 ? l - 1 : 0)) * NB * NMOD;
    f32x4 gg4[4];
#pragma unroll
    for (int k = 0; k < 4; ++k) gg4[k] = *(const f32x4*)(g + 4 * lane + 256 * k);
    for (int t0 = (blockIdx.x * 8 + w) * NT; t0 < T; t0 += gridDim.x * 8 * NT) {
        const int b0 = t0 >> 11;
        f32x4 sc4[4], sh4[4], gt4[4];
        if (MODE != 2) {
#pragma unroll
            for (int k = 0; k < 4; ++k) { sc4[k] = *(const f32x4*)(modl + (size_t)b0 * NMOD + 1024 + 4 * lane + 256 * k); sh4[k] = *(const f32x4*)(modl + (size_t)b0 * NMOD + 4 * lane + 256 * k); }
        }
        if (MODE >= 1) {
#pragma unroll
            for (int k = 0; k < 4; ++k) gt4[k] = *(const f32x4*)(modp + (size_t)b0 * NMOD + 5 * 1024 + 4 * lane + 256 * k);
        }
        f32x4 v[NT][4];
#pragma unroll
        for (int u = 0; u < NT; ++u)
#pragma unroll
            for (int k = 0; k < 4; ++k) {
                if (MODE == 0) v[u][k] = *(const f32x4*)(p.x + (size_t)(t0 + u) * D + 4 * lane + 256 * k);
                else { const u32x2 w2 = *(const u32x2*)(p.xb + (size_t)(t0 + u) * D + 4 * lane + 256 * k); v[u][k] = (f32x4){bflo(w2.x), bfhi(w2.x), bflo(w2.y), bfhi(w2.y)}; }
            }
        if (MODE >= 1) {
            u32x2 y0[NT][4], y1[NT][4];
#pragma unroll
            for (int u = 0; u < NT; ++u)
#pragma unroll
                for (int k = 0; k < 4; ++k) { const int col = 4 * lane + 256 * k;
                    y0[u][k] = *(const u32x2*)(p.ys + ((size_t)(t0 + u) * 2 + 0) * D + col); y1[u][k] = *(const u32x2*)(p.ys + ((size_t)(t0 + u) * 2 + 1) * D + col); }
#pragma unroll
            for (int u = 0; u < NT; ++u) {
                const int b = (t0 + u) >> 11;
#pragma unroll
                for (int k = 0; k < 4; ++k) {
                    const int col = 4 * lane + 256 * k;
                    const f32x4 gt = gt4[k];
                    v[u][k][0] += gt[0] * (bflo(y0[u][k].x) + bflo(y1[u][k].x)); v[u][k][1] += gt[1] * (bfhi(y0[u][k].x) + bfhi(y1[u][k].x));
                    v[u][k][2] += gt[2] * (bflo(y0[u][k].y) + bflo(y1[u][k].y)); v[u][k][3] += gt[3] * (bfhi(y0[u][k].y) + bfhi(y1[u][k].y));
                }
            }
        }
#pragma unroll
        for (int u = 0; u < NT; ++u) {
            const int t = t0 + u, b = t >> 11;
            float ss = 0.f;
#pragma unroll
            for (int k = 0; k < 4; ++k) ss += v[u][k][0] * v[u][k][0] + v[u][k][1] * v[u][k][1] + v[u][k][2] * v[u][k][2] + v[u][k][3] * v[u][k][3];
            ss = wave_sum(ss);
            const float r = rsqrtf(ss * (1.0f / D) + EPS);
#pragma unroll
            for (int k = 0; k < 4; ++k) {
                const int col = 4 * lane + 256 * k;
                f32x4 y = v[u][k] * r * gg4[k];
                if (MODE == 2) { *(f32x4*)(p.xo + (size_t)t * D + col) = y; }
                else {
                    if (MODE == 1) { u32x2 xw; xw.x = cvt_pk_bf16(v[u][k][0], v[u][k][1]); xw.y = cvt_pk_bf16(v[u][k][2], v[u][k][3]); *(u32x2*)(p.xb + (size_t)t * D + col) = xw; }
                    y = y * (1.f + sc4[k]) + sh4[k];
                    u32x2 o; o.x = cvt_pk_bf16(y[0], y[1]); o.y = cvt_pk_bf16(y[2], y[3]);
                    *(u32x2*)(p.h + (size_t)t * D + col) = o;
                }
            }
        }
    }
}
}

namespace {
using pg8::Unit;
struct EpiStoreBf16 {
    static constexpr bool PERM = true;
    bf16_t* O; int ldc;
    __device__ __forceinline__ void operator()(const f32x4 (&acc)[2][2][4][2], const Unit& u, int wr, int wc, int fr_, int fq_) const {
        int fr = fr_, fq = fq_; asm volatile("" : "+v"(fr), "+v"(fq));
        const int row0 = u.pm * 256 + wr * 64 + fr, col0 = u.pn * 256 + wc * 32 + 8 * fq;
#pragma unroll
        for (int ai = 0; ai < 2; ++ai)
#pragma unroll
            for (int m = 0; m < 4; ++m) { bf16_t* rowp = O + (size_t)(row0 + ai * 128 + m * 16) * ldc + col0;
#pragma unroll
                for (int bj = 0; bj < 2; ++bj) { const f32x4 v0 = acc[ai][bj][m][0], v1 = acc[ai][bj][m][1];
                    u32x4 w; w.x = cvt_pk_bf16(v0[0], v0[1]); w.y = cvt_pk_bf16(v0[2], v0[3]); w.z = cvt_pk_bf16(v1[0], v1[1]); w.w = cvt_pk_bf16(v1[2], v1[3]);
                    *(u32x4*)(rowp + bj * 128) = w; } }
    }
};
struct EpiResidual {
    static constexpr bool PERM = false;
    const float* xin32; bf16_t* xb; const float* gate;
    __device__ __forceinline__ void operator()(const f32x4 (&acc)[2][2][4][2], const Unit& u, int wr, int wc, int fr_, int fq_) const {
        int fr = fr_, fq = fq_; asm volatile("" : "+v"(fr), "+v"(fq));
        const int row0 = u.pm * 256 + wr * 64 + fr, col0 = u.pn * 256 + wc * 32 + 4 * fq;
        const int b = (u.pm * 256) >> 11;
        f32x4 gv[2][2];
#pragma unroll
        for (int bj = 0; bj < 2; ++bj)
#pragma unroll
            for (int n = 0; n < 2; ++n) gv[bj][n] = *(const f32x4*)(gate + (size_t)b * NMOD + col0 + bj * 128 + n * 16);
#pragma unroll
        for (int ai = 0; ai < 2; ++ai)
#pragma unroll
            for (int m = 0; m < 4; ++m) { const size_t ro = (size_t)(row0 + ai * 128 + m * 16) * D + col0;
#pragma unroll
                for (int bj = 0; bj < 2; ++bj)
#pragma unroll
                    for (int n = 0; n < 2; ++n) { const size_t o = ro + bj * 128 + n * 16;
                        f32x4 xv;
                        if (xin32) xv = *(const f32x4*)(xin32 + o);
                        else { const u32x2 w = *(const u32x2*)(xb + o); xv = (f32x4){bflo(w.x), bfhi(w.x), bflo(w.y), bfhi(w.y)}; }
                        const f32x4 r = xv + gv[bj][n] * acc[ai][bj][m][n];
                        u32x2 ow; ow.x = cvt_pk_bf16(r[0], r[1]); ow.y = cvt_pk_bf16(r[2], r[3]);
                        *(u32x2*)(xb + o) = ow; } }
    }
};
struct EpiMlaQ {
    static constexpr bool PERM = true;
    bf16_t* qm;
    __device__ __forceinline__ void operator()(const f32x4 (&acc)[2][2][4][2], const Unit& u, int wr, int wc, int fr_, int fq_) const {
        int fr = fr_, fq = fq_; asm volatile("" : "+v"(fr), "+v"(fq));
        const int row0 = u.pm * 256 + wr * 64 + fr;
#pragma unroll
        for (int bj = 0; bj < 2; ++bj) {
            const int col0 = u.pn * 256 + bj * 128 + wc * 32;
            if (col0 >= 384) continue;
#pragma unroll
            for (int ai = 0; ai < 2; ++ai)
#pragma unroll
                for (int m = 0; m < 4; ++m) { const f32x4 v0 = acc[ai][bj][m][0], v1 = acc[ai][bj][m][1];
                    u32x4 w; w.x = cvt_pk_bf16(v0[0], v0[1]); w.y = cvt_pk_bf16(v0[2], v0[3]); w.z = cvt_pk_bf16(v1[0], v1[1]); w.w = cvt_pk_bf16(v1[2], v1[3]);
                    *(u32x4*)(qm + (size_t)(row0 + ai * 128 + m * 16) * 384 + col0 + 8 * fq) = w; }
        }
    }
};
struct EpiMlaKV {
    static constexpr bool PERM = true;
    bf16_t* km; bf16_t* vm;
    __device__ __forceinline__ void operator()(const f32x4 (&acc)[2][2][4][2], const Unit& u, int wr, int wc, int fr_, int fq_) const {
        int fr = fr_, fq = fq_; asm volatile("" : "+v"(fr), "+v"(fq));
        const int row0 = u.pm * 256 + wr * 64 + fr;
#pragma unroll
        for (int bj = 0; bj < 2; ++bj) {
            const int head = u.pn * 2 + bj, wcol = wc * 32 + 8 * fq;
#pragma unroll
            for (int ai = 0; ai < 2; ++ai)
#pragma unroll
                for (int m = 0; m < 4; ++m) {
                    const int row = row0 + ai * 128 + m * 16;
                    const f32x4 v0 = acc[ai][bj][m][0], v1 = acc[ai][bj][m][1];
                    u32x4 w; w.x = cvt_pk_bf16(v0[0], v0[1]); w.y = cvt_pk_bf16(v0[2], v0[3]); w.z = cvt_pk_bf16(v1[0], v1[1]); w.w = cvt_pk_bf16(v1[2], v1[3]);
                    bf16_t* q = (wcol < 64) ? km + (size_t)row * 384 + head * 96 + wcol : vm + (size_t)row * 256 + head * 64 + (wcol - 64);
                    *(u32x4*)q = w;
                    asm volatile("" ::: "memory");
                }
        }
    }
};
struct EpiGateUp {
    static constexpr bool PERM = false;
    bf16_t* hid;
    __device__ __forceinline__ void operator()(const f32x4 (&acc)[2][2][4][2], const Unit& u, int wr, int wc, int fr_, int fq_) const {
        int fr = fr_, fq = fq_; asm volatile("" : "+v"(fr), "+v"(fq));
        const int row0 = u.pm * 256 + wr * 64 + fr;
#pragma unroll
        for (int ai = 0; ai < 2; ++ai)
#pragma unroll
            for (int m = 0; m < 4; ++m) { bf16_t* rowp = hid + (size_t)(row0 + ai * 128 + m * 16) * 256;
#pragma unroll
                for (int bj = 0; bj < 2; ++bj) { const f32x4 gt = acc[ai][bj][m][0], up = acc[ai][bj][m][1];
                    f32x4 o;
#pragma unroll
                    for (int j = 0; j < 4; ++j) o[j] = gt[j] / (1.f + __expf(-gt[j])) * up[j];
                    u32x2 w; w.x = cvt_pk_bf16(o[0], o[1]); w.y = cvt_pk_bf16(o[2], o[3]);
                    *(u32x2*)(rowp + 16 * (u.pn * 8 + bj * 4 + wc) + 4 * fq) = w; } }
    }
};
struct EpiDown {
    static constexpr bool PERM = true;
    bf16_t* ys; const int* list; const float* wl; const int* cnt;
    __device__ __forceinline__ void operator()(const f32x4 (&acc)[2][2][4][2], const Unit& u, int wr, int wc, int fr_, int fq_) const {
        int fr = fr_, fq = fq_; asm volatile("" : "+v"(fr), "+v"(fq));
        const int n = cnt[u.e]; const int* le = list + (size_t)u.e * ECAP; const float* we = wl + (size_t)u.e * ECAP;
        const int col0 = u.pn * 256 + wc * 32 + 8 * fq;
        int slot[8]; float w8[8];
#pragma unroll
        for (int q = 0; q < 8; ++q) { const int lr = u.mt * 256 + (q >> 2) * 128 + wr * 64 + (q & 3) * 16 + fr; slot[q] = lr < n ? le[lr] : -1; w8[q] = lr < n ? we[lr] : 0.f; }
#pragma unroll
        for (int ai = 0; ai < 2; ++ai)
#pragma unroll
            for (int m = 0; m < 4; ++m) {
                const int q = ai * 4 + m;
                if (slot[q] >= 0) {
                    bf16_t* rowp = ys + (size_t)slot[q] * D + col0;
#pragma unroll
                    for (int bj = 0; bj < 2; ++bj) { const f32x4 v0 = acc[ai][bj][m][0] * w8[q], v1 = acc[ai][bj][m][1] * w8[q];
                        u32x4 w; w.x = cvt_pk_bf16(v0[0], v0[1]); w.y = cvt_pk_bf16(v0[2], v0[3]); w.z = cvt_pk_bf16(v1[0], v1[1]); w.w = cvt_pk_bf16(v1[2], v1[3]);
                        *(u32x4*)(rowp + bj * 128) = w; }
                }
            }
    }
};
struct MoeOrder {
    int pre[17];
    int NT, G, c; const int* list; const int* cnt;
    __device__ __forceinline__ void init(const int* cnt_, const int* list_, int NT_, int G_, int c_) {
        cnt = cnt_; list = list_; NT = NT_; G = G_; c = c_; int a = 0;
#pragma unroll
        for (int e = 0; e < 16; ++e) { pre[e] = a; a += (cnt_[e] + 255) >> 8; }
        pre[16] = a;
    }
    __device__ __forceinline__ bool next(int i, Unit& u) const {
        const int L = i * G + c; if (L >= pre[16] * NT) return false;
        const int t = L / NT; int e = 0;
#pragma unroll
        for (int k = 1; k < 16; ++k) e += (t >= pre[k]) ? 1 : 0;
        int pe = 0;
#pragma unroll
        for (int k = 0; k < 16; ++k) pe = (k == e) ? pre[k] : pe;
        u.e = e; u.mt = t - pe; u.pm = t; u.pn = L - t * NT; return true;
    }
    __device__ __forceinline__ int arow(const Unit& u, int r) const { const int lr = u.mt * 256 + r; return lr < cnt[u.e] ? (list[(size_t)u.e * ECAP + lr] >> 1) : 0; }
};
}

namespace {
__device__ __forceinline__ void phase_prep(const Params& p, int l) {
    const int tid = opaque_tid(p.wid), w = tid >> 6, lane = tid & 63;
    const int gw = blockIdx.x * 8 + w, nw = gridDim.x * 8;
    for (int sq = gw; sq < NB * 4; sq += nw) {
        const int b = sq >> 2, hh = sq & 3; const float bias = p.b_forget[l * 4 + hh];
        float lf[32]; float run = 0.f;
#pragma unroll
        for (int j = 0; j < 32; ++j) {
            const float z = bf2f(p.proj[(size_t)(b * S + lane * 32 + j) * NP + PC_AF + hh]) + bias;
            run += fminf(z, 0.f) - log1pf(__expf(-fabsf(z)));
            lf[j] = run;
        }
        float incl = run;
#pragma unroll
        for (int o = 1; o < 64; o <<= 1) { const float t2 = __shfl_up(incl, o); if (lane >= o) incl += t2; }
        const float excl = incl - run;
#pragma unroll
        for (int j = 0; j < 32; ++j) p.cbF[(size_t)sq * S + lane * 32 + j] = -(excl + lf[j]) * LOG2E;
    }
    for (int c32 = gw; c32 < T / 32; c32 += nw) {
    float mxq = 0.f, mxk = 0.f;
#define PREP_LOAD(tt) do { const bf16_t* _row = p.proj + (size_t)(tt) * NP; \
        n_cq = *(const u32x2*)(_row + PC_BCQ + 4 * lane); n_ck = *(const unsigned*)(_row + PC_BCKV + 2 * lane); \
        n_aq = *(const u32x2*)(_row + PC_AQ + 4 * lane); n_ak = *(const u32x2*)(_row + PC_AK + 4 * lane); \
        n_ki = *(const u32x4*)(_row + PC_DKI + 8 * (lane & 3)); n_kr = _row[PC_BKR + (lane & 31)]; } while (0)
    u32x2 n_cq, n_aq, n_ak; unsigned n_ck; u32x4 n_ki; bf16_t n_kr;
    PREP_LOAD(c32 * 32);
    for (int it = 0; it < 32; ++it) {
        const int t = c32 * 32 + it;
        const u32x2 cq = n_cq, aq = n_aq, ak = n_ak; const unsigned ck = n_ck; const u32x4 ki = n_ki; const bf16_t krb = n_kr;
        if (it < 31) PREP_LOAD(t + 1);
        float s1 = bflo(cq.x) * bflo(cq.x) + bfhi(cq.x) * bfhi(cq.x) + bflo(cq.y) * bflo(cq.y) + bfhi(cq.y) * bfhi(cq.y);
        float s2 = bflo(ck) * bflo(ck) + bfhi(ck) * bfhi(ck);
        s1 = wave_sum(s1); s2 = wave_sum(s2);
        if (lane < 4) *(u32x4*)(p.kidx + (size_t)t * 32 + 8 * lane) = ki;
        {
            float nq = bflo(aq.x) * bflo(aq.x) + bfhi(aq.x) * bfhi(aq.x) + bflo(aq.y) * bflo(aq.y) + bfhi(aq.y) * bfhi(aq.y);
            float nk = bflo(ak.x) * bflo(ak.x) + bfhi(ak.x) * bfhi(ak.x) + bflo(ak.y) * bflo(ak.y) + bfhi(ak.y) * bfhi(ak.y);
#pragma unroll
            for (int o = 8; o > 0; o >>= 1) { nq += __shfl_xor(nq, o); nk += __shfl_xor(nk, o); }
            mxq = fmaxf(mxq, nq); mxk = fmaxf(mxk, nk);
        }
        const float kr = (lane < 32) ? bf2f(krb) : 0.f;
        const float kr2 = __shfl(kr, (lane + 16) & 63);
        {
            const float r1 = rsqrtf(s1 * (1.f / 256.f) + EPS), r2 = rsqrtf(s2 * (1.f / 128.f) + EPS);
            u32x2 o; o.x = cvt_pk_bf16(bflo(cq.x) * r1, bfhi(cq.x) * r1); o.y = cvt_pk_bf16(bflo(cq.y) * r1, bfhi(cq.y) * r1);
            *(u32x2*)(p.proj + (size_t)t * NP + PC_BCQ + 4 * lane) = o;
            *(unsigned*)(p.proj + (size_t)t * NP + PC_BCKV + 2 * lane) = cvt_pk_bf16(bflo(ck) * r2, bfhi(ck) * r2);
        }
        if (lane < 16) {
            const int pos = t & (S - 1);
            const float cs = p.ropetab[(pos * 16 + lane) * 2], sn = p.ropetab[(pos * 16 + lane) * 2 + 1];
            const bf16_t o1 = f2bf(kr * cs - kr2 * sn), o2 = f2bf(kr2 * cs + kr * sn);
            bf16_t* kmr = p.km + (size_t)t * 384;
#pragma unroll
            for (int hh = 0; hh < 4; ++hh) { kmr[hh * 96 + 64 + lane] = o1; kmr[hh * 96 + 80 + lane] = o2; }
        }
    }
#undef PREP_LOAD
    if ((lane & 15) == 0) {
        const int t = c32 * 32, bb = t >> 11, pos = t & (S - 1), hh = lane >> 4;
        atomicMax(p.ctl + CW_KN2 + ((l * NB + bb) * 4 + hh) * 32 + (pos >> 6), __float_as_uint(mxk));
        atomicMax(p.ctl + CW_QN2 + ((l * NB + bb) * 4 + hh) * 8 + (pos >> 8), __float_as_uint(mxq));
    }
    }
}

__device__ __forceinline__ void phase_route(const Params& p, int l, char* lds) {
    const int tid = opaque_tid(p.wid), w = tid >> 6, lane = tid & 63;
    float* wrT = (float*)lds;
    int* lcnt = (int*)(lds + 65536);
    int* lbase = (int*)(lds + 65536 + 64);
    int* tsel = (int*)(lds + 65536 + 128);
    float* twt = (float*)(lds + 65536 + 128 + 2048);
    for (int i = tid; i < 16 * 1024; i += 512) { const int e = i >> 10, d = i & 1023; wrT[i] = p.w_router[d * 16 + e]; }
    const float* g = p.g_norm2 + l * D;
    const float* modl = p.mod + (size_t)l * NB * NMOD;
    int* cnt = (int*)(p.ctl + CW_CNT) + l * 16 + 32 * p.qslot;
    int* list = p.list + (size_t)p.qslot * 16 * ECAP;
    for (int chunk = blockIdx.x; chunk < T / 256; chunk += gridDim.x) {
        if (tid < 16) lcnt[tid] = 0;
        __syncthreads();
        const int b = (chunk * 256) >> 11;
        f32x4 gg4[4], sc4[4], sh4[4];
#pragma unroll
        for (int k = 0; k < 4; ++k) { const int col = 4 * lane + 256 * k; gg4[k] = *(const f32x4*)(g + col);
            sc4[k] = *(const f32x4*)(modl + (size_t)b * NMOD + 4 * 1024 + col); sh4[k] = *(const f32x4*)(modl + (size_t)b * NMOD + 3 * 1024 + col); }
        const int eown = ((lane >> 5) & 1) * 8 + ((lane >> 4) & 1) * 4 + ((lane >> 3) & 1) * 2 + ((lane >> 2) & 1);
        const float brown = p.b_router[eown];
        f32x4 vn[4];
#pragma unroll
        for (int k = 0; k < 4; ++k) { const u32x2 w2 = *(const u32x2*)(p.xb + (size_t)(chunk * 256 + w * 32) * D + 4 * lane + 256 * k); vn[k] = (f32x4){bflo(w2.x), bfhi(w2.x), bflo(w2.y), bfhi(w2.y)}; }
        for (int it = 0; it < 32; ++it) {
            const int li = w * 32 + it, t = chunk * 256 + li;
            f32x4 v[4];
#pragma unroll
            for (int k = 0; k < 4; ++k) v[k] = vn[k];
            if (it < 31) {
#pragma unroll
                for (int k = 0; k < 4; ++k) { const u32x2 w2 = *(const u32x2*)(p.xb + (size_t)(t + 1) * D + 4 * lane + 256 * k); vn[k] = (f32x4){bflo(w2.x), bfhi(w2.x), bflo(w2.y), bfhi(w2.y)}; }
            }
            float ss = 0.f;
#pragma unroll
            for (int k = 0; k < 4; ++k) ss += v[k][0] * v[k][0] + v[k][1] * v[k][1] + v[k][2] * v[k][2] + v[k][3] * v[k][3];
            ss = wave_sum(ss);
            const float r = rsqrtf(ss * (1.0f / D) + EPS);
            float lg[16];
#pragma unroll
            for (int e = 0; e < 16; ++e) lg[e] = 0.f;
#pragma unroll
            for (int k = 0; k < 4; ++k) {
                const int col = 4 * lane + 256 * k;
                const f32x4 y = v[k] * r * gg4[k] * (1.f + sc4[k]) + sh4[k];
                u32x2 o; o.x = cvt_pk_bf16(y[0], y[1]); o.y = cvt_pk_bf16(y[2], y[3]);
                *(u32x2*)(p.h + (size_t)t * D + col) = o;
#pragma unroll
                for (int e = 0; e < 16; ++e) { const f32x4 wv = *(const f32x4*)(wrT + e * 1024 + col); lg[e] += y[0] * wv[0] + y[1] * wv[1] + y[2] * wv[2] + y[3] * wv[3]; }
                asm volatile("" ::: "memory");
            }
            float a8[8], a4[4], a2[2], a1;
            { const bool hi = (lane & 32) != 0;
#pragma unroll
              for (int e = 0; e < 8; ++e) { const float send = hi ? lg[e] : lg[e + 8], keep = hi ? lg[e + 8] : lg[e]; a8[e] = keep + __shfl_xor(send, 32); } }
            { const bool hi = (lane & 16) != 0;
#pragma unroll
              for (int e = 0; e < 4; ++e) { const float send = hi ? a8[e] : a8[e + 4], keep = hi ? a8[e + 4] : a8[e]; a4[e] = keep + __shfl_xor(send, 16); } }
            { const bool hi = (lane & 8) != 0;
#pragma unroll
              for (int e = 0; e < 2; ++e) { const float send = hi ? a4[e] : a4[e + 2], keep = hi ? a4[e + 2] : a4[e]; a2[e] = keep + __shfl_xor(send, 8); } }
            { const bool hi = (lane & 4) != 0; const float send = hi ? a2[0] : a2[1], keep = hi ? a2[1] : a2[0]; a1 = keep + __shfl_xor(send, 4); }
            a1 += __shfl_xor(a1, 2); a1 += __shfl_xor(a1, 1);
            const float sown = 1.f / (1.f + expf(-a1)), bown = sown + brown;
            float sc[16], bi[16];
#pragma unroll
            for (int e = 0; e < 16; ++e) { const int src = ((e >> 3) & 1) * 32 + ((e >> 2) & 1) * 16 + ((e >> 1) & 1) * 8 + (e & 1) * 4;
                sc[e] = __builtin_bit_cast(float, __builtin_amdgcn_readlane(__builtin_bit_cast(int, sown), src));
                bi[e] = __builtin_bit_cast(float, __builtin_amdgcn_readlane(__builtin_bit_cast(int, bown), src)); }
            int bg = 0; float bgs = -INFINITY;
#pragma unroll
            for (int gi = 0; gi < 4; ++gi) {
                float m1 = -INFINITY, m2 = -INFINITY;
#pragma unroll
                for (int j = 0; j < 4; ++j) { const float vv = bi[gi * 4 + j]; if (vv > m1) { m2 = m1; m1 = vv; } else if (vv > m2) m2 = vv; }
                const float gs = m1 + m2; if (gs > bgs) { bgs = gs; bg = gi; }
            }
            float b4[4], s4[4];
#pragma unroll
            for (int gi = 0; gi < 4; ++gi)
#pragma unroll
                for (int j = 0; j < 4; ++j) if (gi == bg) { b4[j] = bi[gi * 4 + j]; s4[j] = sc[gi * 4 + j]; }
            int i1 = 0; float v1 = -INFINITY;
#pragma unroll
            for (int j = 0; j < 4; ++j) { if (b4[j] > v1) { v1 = b4[j]; i1 = j; } }
            int i2 = 0; float v2 = -INFINITY;
#pragma unroll
            for (int j = 0; j < 4; ++j) { if (j != i1 && b4[j] > v2) { v2 = b4[j]; i2 = j; } }
            float w1 = 0.f, w2 = 0.f;
#pragma unroll
            for (int j = 0; j < 4; ++j) { if (j == i1) w1 = s4[j]; if (j == i2) w2 = s4[j]; }
            if (lane == 0) {
                const int e1 = bg * 4 + i1, e2 = bg * 4 + i2; const float ws = w1 + w2;
                const int r1 = atomicAdd(&lcnt[e1], 1), r2 = atomicAdd(&lcnt[e2], 1);
                tsel[li * 2 + 0] = (e1 << 16) | r1; tsel[li * 2 + 1] = (e2 << 16) | r2;
                twt[li * 2 + 0] = w1 / ws; twt[li * 2 + 1] = w2 / ws;
            }
        }
        __syncthreads();
        if (tid < 16) lbase[tid] = atomicAdd(&cnt[tid], lcnt[tid]);
        __syncthreads();
        { const int v = tsel[tid], e = v >> 16, rk = v & 0xFFFF; const size_t pos = (size_t)e * ECAP + lbase[e] + rk;
          list[pos] = (chunk * 256 + (tid >> 1)) * 2 + (tid & 1); p.wl[pos + (size_t)p.qslot * 16 * ECAP] = twt[tid]; }
        __syncthreads();
    }
}
}

#ifndef ATTN_VMASK
#define ATTN_VMASK 15
#endif
#ifndef REPK_VMASK
#define REPK_VMASK 15
#endif
#ifndef ATTN_DMA
#define ATTN_DMA 1
#endif
#ifndef ATTN_EXP
#define ATTN_EXP 0
#endif
#define AEXP(k) (ATTN_EXP == (k) && xq)
namespace {
constexpr int AT_KB = 0;
constexpr int AT_KR = 16384;
constexpr int AT_VB = 24576;
constexpr int AT_CB = 40960;
constexpr int AT_CTL = 41472;
constexpr int AT_LDS = 41984;
constexpr float NEGBIG = -1.0e30f;

template <int VAR, int KC>
__device__ __forceinline__ void attn_tile(LAS3 char* lds, const int buf, const int j, const int q0, const int i, const int g, const int swk, const float slope2,
                                          const bf16x8 (&qf)[2][KC], f32x4 (&o)[2][4], float (&mrow)[2], float (&lsum)[2], const u32x4 (&mwd)[2][4], const bool xq) {
    typedef LAS3 bf16x4 lds_bf16x4;
    bool need = (64 * j <= q0 + 31);
    if (VAR == 2) need = need && (64 * j + 63 >= q0 - 127);
    if (need) {
        const LAS3 char* Kb = lds + AT_KB + buf * 8192; const LAS3 char* Vb = lds + AT_VB + buf * 8192;
        bool full = (64 * j + 63 <= q0);
        if (VAR == 2) full = full && (64 * j >= q0 - 96);
        if (VAR == 3) full = false;
        f32x4 s[2][4];
#pragma unroll
        for (int qt = 0; qt < 2; ++qt) {
            const int t = q0 + 16 * qt + i;
            const int dbase = 64 * j + 4 * g - t;
            const float sb = slope2 * ((VAR == 2) ? (float)dbase : (float)(64 * j + 4 * g));
#pragma unroll
            for (int mt = 0; mt < 4; ++mt) {
                f32x4 ini = {0.f, 0.f, 0.f, 0.f};
                if (VAR == 0) ini = *(const LAS3 f32x4*)(lds + AT_CB + buf * 256 + (16 * mt + 4 * g) * 4);
#pragma unroll
                for (int r = 0; r < 4; ++r) {
                    const int c = 16 * mt + r;
                    float v = ini[r];
                    if (VAR >= 2) v = sb + slope2 * (float)c;
                    if (VAR == 3) {
                        const int m = ((int)(mwd[qt][mt][r] << (31 - j))) >> 31;
                        v = __uint_as_float((__float_as_uint(v) & (unsigned)m) | (__float_as_uint(NEGBIG) & ~(unsigned)m));
                    } else if (!full) {
                        bool ok;
                        if (VAR == 2) ok = (unsigned)(dbase + c + 127) < 128u;
                        else ok = (dbase + c) <= 0;
                        v = ok ? v : NEGBIG;
                    }
                    ini[r] = v;
                }
                s[qt][mt] = ini;
            }
        }
        if (!AEXP(2))
#pragma unroll
        for (int mt = 0; mt < 4; ++mt) {
#pragma unroll
            for (int kc = 0; kc < 2; ++kc) {
                const bf16x8 kf = *(const LAS3 bf16x8*)(Kb + (mt * 16 + i) * 128 + (((kc * 4 + g) ^ swk) << 4));
                s[0][mt] = __builtin_amdgcn_mfma_f32_16x16x32_bf16(kf, qf[0][kc], s[0][mt], 0, 0, 0);
                s[1][mt] = __builtin_amdgcn_mfma_f32_16x16x32_bf16(kf, qf[1][kc], s[1][mt], 0, 0, 0);
            }
            if (VAR == 1) {
                const bf16x8 kf = *(const LAS3 bf16x8*)(lds + AT_KR + buf * 4096 + (mt * 16 + i) * 64 + ((g ^ (swk & 3)) << 4));
                s[0][mt] = __builtin_amdgcn_mfma_f32_16x16x32_bf16(kf, qf[0][KC - 1], s[0][mt], 0, 0, 0);
                s[1][mt] = __builtin_amdgcn_mfma_f32_16x16x32_bf16(kf, qf[1][KC - 1], s[1][mt], 0, 0, 0);
            }
        }
        bf16x8 pf[2][2];
#pragma unroll
        for (int qt = 0; qt < 2; ++qt) {
            float mx = fmaxf(fmaxf(s[qt][0][0], s[qt][0][1]), fmaxf(s[qt][0][2], s[qt][0][3]));
#pragma unroll
            for (int mt = 1; mt < 4; ++mt) mx = fmaxf(mx, fmaxf(fmaxf(s[qt][mt][0], s[qt][mt][1]), fmaxf(s[qt][mt][2], s[qt][mt][3])));
            mx = fmaxf(mx, __builtin_bit_cast(float, __builtin_amdgcn_ds_swizzle(__builtin_bit_cast(int, mx), 0x401F)));
            mx = xor32_max(mx);
            if (__any(mx > mrow[qt])) {
                const float mn = fmaxf(mrow[qt], mx), alpha = __builtin_amdgcn_exp2f(mrow[qt] - mn);
                mrow[qt] = mn; lsum[qt] *= alpha;
#pragma unroll
                for (int dt = 0; dt < 4; ++dt) o[qt][dt] = o[qt][dt] * alpha;
            }
            const float mn = mrow[qt];
            const f32x4 mn4 = {mn, mn, mn, mn};
            f32x4 ps4 = {0.f, 0.f, 0.f, 0.f};
            float x[4][4];
#pragma unroll
            for (int mt = 0; mt < 4; ++mt) {
                const f32x4 d4 = s[qt][mt] - mn4;
                f32x4 e4;
#pragma unroll
                for (int r = 0; r < 4; ++r) { e4[r] = AEXP(3) ? d4[r] : __builtin_amdgcn_exp2f(d4[r]); x[mt][r] = e4[r]; }
                ps4 += e4;
            }
            lsum[qt] += (ps4[0] + ps4[1]) + (ps4[2] + ps4[3]);
#pragma unroll
            for (int c = 0; c < 2; ++c) {
                u32x4 pk; pk.x = cvt_pk_bf16(x[2 * c][0], x[2 * c][1]); pk.y = cvt_pk_bf16(x[2 * c][2], x[2 * c][3]);
                pk.z = cvt_pk_bf16(x[2 * c + 1][0], x[2 * c + 1][1]); pk.w = cvt_pk_bf16(x[2 * c + 1][2], x[2 * c + 1][3]);
                pf[qt][c] = __builtin_bit_cast(bf16x8, pk);
            }
        }
        const int q4 = i >> 2, p4 = i & 3;
        if (!AEXP(4))
#pragma unroll
        for (int c = 0; c < 2; ++c) {
            const int row0 = 32 * c + 4 * g + q4, swv = (row0 >> 1) & 3;
#pragma unroll
            for (int dt = 0; dt < 4; ++dt) {
                const LAS3 char* a0 = Vb + row0 * 128 + ((dt ^ swv) << 5) + p4 * 8;
                const bf16x4 v0 = __builtin_amdgcn_ds_read_tr16_b64_v4i16((lds_bf16x4*)(a0));
                const bf16x4 v1 = __builtin_amdgcn_ds_read_tr16_b64_v4i16((lds_bf16x4*)(a0 + 16 * 128));
                const bf16x8 vf = {v0[0], v0[1], v0[2], v0[3], v1[0], v1[1], v1[2], v1[3]};
                o[0][dt] = __builtin_amdgcn_mfma_f32_16x16x32_bf16(vf, pf[0][c], o[0][dt], 0, 0, 0);
                o[1][dt] = __builtin_amdgcn_mfma_f32_16x16x32_bf16(vf, pf[1][c], o[1][dt], 0, 0, 0);
            }
        }
    }
}

template <int VAR>
__device__ __forceinline__ void attn_unit(const Params& p, int l, int b, int hx, int qb, LAS3 char* lds) {
    typedef LAS3 bf16x4 lds_bf16x4;
    constexpr int KC = (VAR == 1) ? 3 : 2;
    const int tid = opaque_tid(p.wid), w = __builtin_amdgcn_readfirstlane(tid >> 6), lane = tid & 63, i = lane & 15, g = lane >> 4;
    const bf16_t *Qp, *Kp, *Vp; int ldq, ldk, ldv, q0, j0, j1, ocol; float c1, slope2 = 0.f;
    if (VAR == 0) { Qp = p.proj + PC_AQ + hx * 64; Kp = p.proj + PC_AK + hx * 64; Vp = p.proj + PC_AV + hx * 64; ldq = ldk = ldv = NP;
                    q0 = qb * 256 + 32 * w; j0 = 0; j1 = 4 * qb + 3; ocol = hx * 64; c1 = 0.125f * LOG2E; }
    else if (VAR == 1) { Qp = p.qm + hx * 96; Kp = p.km + hx * 96; Vp = p.vm + hx * 64; ldq = 384; ldk = 384; ldv = 256;
                    q0 = qb * 256 + 32 * w; j0 = 0; j1 = 4 * qb + 3; ocol = 256 + hx * 64; c1 = 0.10206207261596577f * LOG2E; }
    else if (VAR == 2) { const int qh = hx * 2 + (w >> 2); Qp = p.proj + PC_CQ + qh * 64; Kp = p.proj + PC_CK + hx * 64; Vp = p.proj + PC_CV + hx * 64; ldq = ldk = ldv = NP;
                    q0 = qb * 128 + 32 * (w & 3); j0 = 2 * qb - 2 > 0 ? 2 * qb - 2 : 0; j1 = 2 * qb + 1; ocol = 512 + qh * 64; c1 = 0.125f * LOG2E;
                    slope2 = exp2f(-(float)(qh + 1)) * LOG2E; }
    else { const int hd = w >> 1; Qp = p.proj + PC_DQ + hd * 64; Kp = p.proj + PC_DK; Vp = p.proj + PC_DV; ldq = ldk = ldv = NP;
                    q0 = qb * 64 + 32 * (w & 1); j0 = 0; j1 = qb; ocol = 768 + hd * 64; c1 = 0.125f * LOG2E; slope2 = exp2f(-(float)(hd + 5)) * LOG2E; }
    const size_t tok0 = (size_t)b * S;
    const bool xq = p.qslot > 0;
    if (VAR == 0 && qb > 0) {
        constexpr float FOX_DROP = 64.0f;
        const unsigned* kn2 = p.ctl + CW_KN2 + ((l * NB + b) * 4 + hx) * 32;
        const float* cbh = p.cbF + ((size_t)b * 4 + hx) * S;
        const float qn = c1 * sqrtf(__uint_as_float(p.ctl[CW_QN2 + ((l * NB + b) * 4 + hx) * 8 + qb]));
        float knu = 0.f;
        for (int jj = 4 * qb; jj < 4 * qb + 4; ++jj) knu = fmaxf(knu, __uint_as_float(kn2[jj]));
        const float lower = cbh[256 * qb] - qn * sqrtf(knu);
        const int jl = lane & 31;
        const bool keep = qn * sqrtf(__uint_as_float(kn2[jl])) + cbh[64 * jl + 63] - lower >= -FOX_DROP || jl >= 4 * qb;
        const unsigned long long kb = __ballot(keep) & 0xFFFFFFFFull;
        j0 = kb ? (int)__builtin_ctzll(kb) : 4 * qb;
    }
    bf16x8 qf[2][KC];
#pragma unroll
    for (int qt = 0; qt < 2; ++qt)
#pragma unroll
        for (int kc = 0; kc < KC; ++kc) qf[qt][kc] = *(const bf16x8*)(Qp + (tok0 + q0 + 16 * qt + i) * ldq + kc * 32 + 8 * g);
    u32x4 mwd[2][4];
#pragma unroll
    for (int qt = 0; qt < 2; ++qt)
#pragma unroll
        for (int mt = 0; mt < 4; ++mt) mwd[qt][mt] = (VAR == 3) ? *(const u32x4*)(p.mask + (tok0 + q0 + 16 * qt + i) * 64 + 16 * mt + 4 * g) : (u32x4){0u, 0u, 0u, 0u};
#if ATTN_DMA
    const int drow = 8 * w + (lane >> 3), dch = lane & 7;
    const int ksc = dch ^ ((drow >> 1) & 7);
    const int vsc = ((((dch >> 1) ^ ((drow >> 1) & 3)) << 1) | (dch & 1));
    const int rrow = 16 * (w & 3) + (lane >> 2), rsc = (lane & 3) ^ ((rrow >> 1) & 3);
#define AT_DMA(j, buf) do { \
        __builtin_amdgcn_global_load_lds((const unsigned*)(Kp + (tok0 + 64 * (j) + drow) * ldk + ksc * 8), (LAS3 unsigned*)(lds + AT_KB + (buf) * 8192 + w * 1024), 16, 0, 0); \
        __builtin_amdgcn_global_load_lds((const unsigned*)(Vp + (tok0 + 64 * (j) + drow) * ldv + vsc * 8), (LAS3 unsigned*)(lds + AT_VB + (buf) * 8192 + w * 1024), 16, 0, 0); \
        if (VAR == 1 && w < 4) __builtin_amdgcn_global_load_lds((const unsigned*)(Kp + (tok0 + 64 * (j) + rrow) * ldk + 64 + rsc * 8), (LAS3 unsigned*)(lds + AT_KR + (buf) * 4096 + w * 1024), 16, 0, 0); \
        if (VAR == 0 && w == 0) __builtin_amdgcn_global_load_lds((const unsigned*)(p.cbF + ((size_t)b * 4 + hx) * S + 64 * (j) + lane), (LAS3 unsigned*)(lds + AT_CB + (buf) * 256), 4, 0, 0); \
    } while (0)
    AT_DMA(j0, j0 & 1);
#else
    const int sr = tid >> 3, sc8 = tid & 7;
    const int kdst = sr * 128 + ((sc8 ^ ((sr >> 1) & 7)) << 4);
    const int vdst = sr * 128 + (((((sc8 >> 1) ^ ((sr >> 1) & 3)) << 1) | (sc8 & 1)) << 4);
    const int rr = (tid & 255) >> 2, rc4 = tid & 3;
    const int rdst = rr * 64 + ((rc4 ^ ((rr >> 1) & 3)) << 4);
    u32x4 kstA, vstA, rstA = {0u, 0u, 0u, 0u}, kstB, vstB, rstB = {0u, 0u, 0u, 0u}; float cstA = 0.f, cstB = 0.f;
#define AT_LOAD(ZZ, j) do { if (AEXP(1)) break; const size_t _kr = tok0 + 64 * (j) + sr; \
        kst##ZZ = *(const u32x4*)(Kp + _kr * ldk + sc8 * 8); vst##ZZ = *(const u32x4*)(Vp + _kr * ldv + sc8 * 8); \
        if (VAR == 1) rst##ZZ = *(const u32x4*)(Kp + (tok0 + 64 * (j) + rr) * ldk + 64 + rc4 * 8); \
        if (VAR == 0) cst##ZZ = p.cbF[((size_t)b * 4 + hx) * S + 64 * (j) + (tid & 63)]; } while (0)
#define AT_WRITE(ZZ, buf) do { if (AEXP(1)) break; *(LAS3 u32x4*)(lds + AT_KB + (buf) * 8192 + kdst) = kst##ZZ; *(LAS3 u32x4*)(lds + AT_VB + (buf) * 8192 + vdst) = vst##ZZ; \
        if (VAR == 1 && tid < 256) *(LAS3 u32x4*)(lds + AT_KR + (buf) * 4096 + rdst) = rst##ZZ; \
        if (VAR == 0 && tid < 64) *(LAS3 float*)(lds + AT_CB + (buf) * 256 + tid * 4) = cst##ZZ; } while (0)
    AT_LOAD(A, j0);
    AT_LOAD(B, (j0 + 1 <= j1 ? j0 + 1 : j1));
#endif
    if (VAR == 1) {
#pragma unroll
        for (int qt = 0; qt < 2; ++qt) {
            const int pos = q0 + 16 * qt + i;
            const u32x4 mine = __builtin_bit_cast(u32x4, qf[qt][KC - 1]);
            u32x4 oth; oth.x = __shfl_xor(mine.x, 32); oth.y = __shfl_xor(mine.y, 32); oth.z = __shfl_xor(mine.z, 32); oth.w = __shfl_xor(mine.w, 32);
            const float* rt = p.ropetab + (size_t)(pos * 16 + (g & 1) * 8) * 2;
            const float sg = (g < 2) ? -1.f : 1.f;
            u32x4 res;
#pragma unroll
            for (int e2 = 0; e2 < 4; ++e2) {
                const f32x4 cs = *(const f32x4*)(rt + e2 * 4);
                const unsigned mw_ = e2 == 0 ? mine.x : e2 == 1 ? mine.y : e2 == 2 ? mine.z : mine.w, ow_ = e2 == 0 ? oth.x : e2 == 1 ? oth.y : e2 == 2 ? oth.z : oth.w;
                const float r0 = bflo(mw_) * cs[0] + sg * bflo(ow_) * cs[1], r1 = bfhi(mw_) * cs[2] + sg * bfhi(ow_) * cs[3];
                const unsigned pk = cvt_pk_bf16(r0, r1);
                if (e2 == 0) res.x = pk; else if (e2 == 1) res.y = pk; else if (e2 == 2) res.z = pk; else res.w = pk;
            }
            qf[qt][KC - 1] = __builtin_bit_cast(bf16x8, res);
        }
    }
#pragma unroll
    for (int qt = 0; qt < 2; ++qt)
#pragma unroll
        for (int kc = 0; kc < KC; ++kc) {
            u32x4 qq = __builtin_bit_cast(u32x4, qf[qt][kc]);
            qq.x = cvt_pk_bf16(bflo(qq.x) * c1, bfhi(qq.x) * c1); qq.y = cvt_pk_bf16(bflo(qq.y) * c1, bfhi(qq.y) * c1);
            qq.z = cvt_pk_bf16(bflo(qq.z) * c1, bfhi(qq.z) * c1); qq.w = cvt_pk_bf16(bflo(qq.w) * c1, bfhi(qq.w) * c1);
            qf[qt][kc] = __builtin_bit_cast(bf16x8, qq);
        }
    f32x4 o[2][4];
#pragma unroll
    for (int qt = 0; qt < 2; ++qt)
#pragma unroll
        for (int dt = 0; dt < 4; ++dt) o[qt][dt] = (f32x4){0.f, 0.f, 0.f, 0.f};
    float mrow[2] = {NEGBIG, NEGBIG}, lsum[2] = {0.f, 0.f};
#if ATTN_DMA
    const int swk = (i >> 1) & 7;
    asm volatile("s_waitcnt vmcnt(0)" ::: "memory");
    __syncthreads();
    for (int j = j0; j <= j1; ++j) {
        if (j < j1) AT_DMA(j + 1, (j + 1) & 1);
        attn_tile<VAR, KC>(lds, j & 1, j, q0, i, g, swk, slope2, qf, o, mrow, lsum, mwd, xq);
        asm volatile("s_waitcnt vmcnt(0)" ::: "memory");
        __syncthreads();
    }
#undef AT_DMA
#else
    AT_WRITE(A, j0 & 1);
    __syncthreads();
    const int swk = (i >> 1) & 7;
    for (int j = j0; j <= j1; j += 2) {
        AT_LOAD(A, (j + 2 <= j1 ? j + 2 : j1));
        attn_tile<VAR, KC>(lds, j & 1, j, q0, i, g, swk, slope2, qf, o, mrow, lsum, mwd, xq);
        if (j + 1 <= j1) AT_WRITE(B, (j + 1) & 1);
        if (!AEXP(5)) __syncthreads();
        if (j + 1 > j1) break;
        AT_LOAD(B, (j + 3 <= j1 ? j + 3 : j1));
        attn_tile<VAR, KC>(lds, (j + 1) & 1, j + 1, q0, i, g, swk, slope2, qf, o, mrow, lsum, mwd, xq);
        if (j + 2 <= j1) AT_WRITE(A, j & 1);
        if (!AEXP(5)) __syncthreads();
    }
#undef AT_LOAD
#undef AT_WRITE
#endif
#pragma unroll
    for (int qt = 0; qt < 2; ++qt) {
        float lt = lsum[qt]; lt += __shfl_xor(lt, 16); lt += __shfl_xor(lt, 32);
        if (VAR == 2) lt += __builtin_amdgcn_exp2f(p.sinks[l * 4 + hx * 2 + (w >> 2)] * LOG2E - mrow[qt]);
        const float inv = 1.f / lt;
        bf16_t* op = p.merged + (tok0 + q0 + 16 * qt + i) * D + ocol + 4 * g;
        if (!(ATTN_EXP != 0 && xq))
#pragma unroll
        for (int dt = 0; dt < 4; ++dt) { const f32x4 v = o[qt][dt] * inv; u32x2 w2; w2.x = cvt_pk_bf16(v[0], v[1]); w2.y = cvt_pk_bf16(v[2], v[3]); *(u32x2*)(op + 16 * dt) = w2; }
    }
}

__device__ __forceinline__ void phase_attn(const Params& p, int l, LAS3 char* lds) {
    const int tid = opaque_tid(p.wid);
    unsigned* qhead = p.ctl + CW_QA + 64 * (l + 2 * p.qslot);
    volatile LAS3 int* bc = (volatile LAS3 int*)(lds + AT_CTL);
    int nxt = 0;
    if (tid == 0) nxt = (int)__hip_atomic_fetch_add(qhead, 1u, __ATOMIC_RELAXED, __HIP_MEMORY_SCOPE_AGENT);
    for (;;) {
        if (tid == 0) *bc = nxt;
        __syncthreads();
        const int idx = __builtin_amdgcn_readfirstlane(*bc);
        __syncthreads();
        if (idx >= 4096) break;
        if (tid == 0) nxt = (int)__hip_atomic_fetch_add(qhead, 1u, __ATOMIC_RELAXED, __HIP_MEMORY_SCOPE_AGENT);
        const int vmask = p.qslot ? REPK_VMASK : ATTN_VMASK;
        if (idx < 3072) {
            const int lvl = 7 - idx / 384, rem = idx % 384;
            if (rem < 128) { if (vmask & 2) attn_unit<1>(p, l, rem >> 2, rem & 3, lvl, lds); }
            else if (rem < 256) { if (vmask & 1) attn_unit<0>(p, l, (rem - 128) >> 2, rem & 3, lvl, lds); }
            else { const int d = rem - 256; if (vmask & 8) attn_unit<3>(p, l, d & 31, 0, 4 * lvl + 3 - (d >> 5), lds); }
        } else { const int c = idx - 3072; if (vmask & 4) attn_unit<2>(p, l, c >> 5, (c >> 4) & 1, c & 15, lds); }
    }
}
}

namespace {
constexpr int DS_LD = 2052;
constexpr int DS_CTL = 16 * DS_LD * 4;
constexpr int DS_LDS = DS_CTL + 64;

__device__ __forceinline__ void dsa_unit(const Params& p, int u, LAS3 char* lds) {
    const int tid = opaque_tid(p.wid), w = __builtin_amdgcn_readfirstlane(tid >> 6), lane = tid & 63, i = lane & 15, g = lane >> 4;
    const int b = u >> 7, t0 = (u & 127) * 16;
    const size_t tok0 = (size_t)b * S;
    uint32_t* mbase = p.mask + (tok0 + t0) * 64;
    if (t0 + 16 <= 256) {
#pragma unroll
        for (int qq = 0; qq < 2; ++qq) {
            const int q = 2 * w + qq, n = t0 + q + 1;
            const int cnt = n > lane ? ((n - lane + 63) >> 6) : 0;
            mbase[q * 64 + lane] = cnt >= 32 ? 0xFFFFFFFFu : ((1u << cnt) - 1u);
        }
        return;
    }
    const int nreg = (t0 + 16 + 63) >> 6;
    const int ntile = nreg * 4;
    bf16x8 qf[8]; float wq[8];
    {
        const bf16_t* qrow = p.proj + (tok0 + t0 + i) * NP;
#pragma unroll
        for (int h = 0; h < 8; ++h) qf[h] = *(const bf16x8*)(qrow + PC_DQI + h * 32 + 8 * g);
        const u32x4 ww = *(const u32x4*)(qrow + PC_DWI);
        const float sc = 0.35355339059327373f * 0.17677669529663687f;
        wq[0] = bflo(ww.x) * sc; wq[1] = bfhi(ww.x) * sc; wq[2] = bflo(ww.y) * sc; wq[3] = bfhi(ww.y) * sc;
        wq[4] = bflo(ww.z) * sc; wq[5] = bfhi(ww.z) * sc; wq[6] = bflo(ww.w) * sc; wq[7] = bfhi(ww.w) * sc;
    }
    const int tq = t0 + i;
#ifndef DSA_EXP
#define DSA_EXP 0
#endif
    const bool exp_skip_score = (DSA_EXP == 2) && p.qslot > 0, exp_skip_sel = (DSA_EXP == 1) && p.qslot > 0, exp_nostore = (DSA_EXP != 0) && p.qslot > 0;
    if (!exp_skip_score)
    for (int base = w; base < ntile; base += 32) {
        bf16x8 kf4[4];
#pragma unroll
        for (int uu = 0; uu < 4; ++uu) { const int kt = base + 8 * uu; if (kt < ntile) kf4[uu] = *(const bf16x8*)(p.kidx + (tok0 + 16 * kt + i) * 32 + 8 * g); }
#pragma unroll
        for (int uu = 0; uu < 4; ++uu) {
            const int kt = base + 8 * uu;
            if (kt < ntile) {
                f32x4 sc4 = {0.f, 0.f, 0.f, 0.f};
#pragma unroll
                for (int h = 0; h < 8; ++h) {
                    const f32x4 c = __builtin_amdgcn_mfma_f32_16x16x32_bf16(kf4[uu], qf[h], (f32x4){0.f, 0.f, 0.f, 0.f}, 0, 0, 0);
#pragma unroll
                    for (int r = 0; r < 4; ++r) { const int ci = __float_as_int(c[r]); sc4[r] += wq[h] * __int_as_float(ci > 0 ? ci : 0); }
                }
                u32x4 ko;
#pragma unroll
                for (int r = 0; r < 4; ++r) {
                    const int key = 16 * kt + 4 * g + r;
                    unsigned uu2 = __float_as_uint(sc4[r]); if (uu2 == 0x80000000u) uu2 = 0u;
                    uu2 = (uu2 & 0x80000000u) ? ~uu2 : (uu2 | 0x80000000u);
                    ko[r] = (key <= tq) ? uu2 : 0u;
                }
                *(LAS3 u32x4*)(lds + ((size_t)i * DS_LD + 16 * kt + 4 * g) * 4) = ko;
            }
        }
    }
    __syncthreads();
    if (!exp_skip_sel)
    {
        const int qA = 2 * w, qB = 2 * w + 1;
        const LAS3 unsigned* kpA = (const LAS3 unsigned*)(lds + (size_t)qA * DS_LD * 4);
        const LAS3 unsigned* kpB = (const LAS3 unsigned*)(lds + (size_t)qB * DS_LD * 4);
        unsigned PA[32], PB[32];
        const int nv = nreg * 64;
#pragma unroll
        for (int r = 0; r < 32; ++r) {
            int idx = r * 64 + lane; asm volatile("" : "+v"(idx));
            const unsigned va = kpA[r * 64 + lane], vb = kpB[r * 64 + lane];
            PA[r] = (idx < nv) ? va : 0u; PB[r] = (idx < nv) ? vb : 0u;
        }
#define DSA_TR(P, j, m) do { _Pragma("unroll") for (int k = 0; k < 32; ++k) if ((k & (j)) == 0) { const unsigned x = P[k], y = P[k + (j)]; \
            P[k] = (x & (m)) | ((y << (j)) & ~(m)); P[k + (j)] = ((x >> (j)) & (m)) | (y & ~(m)); } } while (0)
        DSA_TR(PA, 16, 0x0000FFFFu); DSA_TR(PB, 16, 0x0000FFFFu); DSA_TR(PA, 8, 0x00FF00FFu); DSA_TR(PB, 8, 0x00FF00FFu);
        DSA_TR(PA, 4, 0x0F0F0F0Fu); DSA_TR(PB, 4, 0x0F0F0F0Fu); DSA_TR(PA, 2, 0x33333333u); DSA_TR(PB, 2, 0x33333333u);
        DSA_TR(PA, 1, 0x55555555u); DSA_TR(PB, 1, 0x55555555u);
#undef DSA_TR
        unsigned alA = 0xFFFFFFFFu, abA = 0u, selA = 0u, alB = 0xFFFFFFFFu, abB = 0u, selB = 0u;
        bool exA = false, exB = false;
#pragma unroll
        for (int bit = 31; bit >= 0; --bit) {
            if (!(exA && exB)) {
                const unsigned cA = abA | (alA & PA[bit]), cB = abB | (alB & PB[bit]);
                const int na = exA ? 0 : wave_reduce_add(__builtin_popcount(cA)), nb = exB ? 0 : wave_reduce_add(__builtin_popcount(cB));
                if (!exA) { if (na >= 256) { if (na == 256) { exA = true; selA = cA; } alA &= PA[bit]; } else { abA |= alA & PA[bit]; alA &= ~PA[bit]; } }
                if (!exB) { if (nb >= 256) { if (nb == 256) { exB = true; selB = cB; } alB &= PB[bit]; } else { abB |= alB & PB[bit]; alB &= ~PB[bit]; } }
            }
        }
        const unsigned long long lt = (lane == 0) ? 0ull : (~0ull >> (64 - lane));
#pragma unroll 1
        for (int qq = 0; qq < 2; ++qq) {
            const bool exact = qq ? exB : exA;
            unsigned sel = qq ? selB : selA;
            if (!exact) {
                const unsigned al = qq ? alB : alA, ab = qq ? abB : abA;
                const int need = 256 - wave_reduce_add(__builtin_popcount(ab));
                int running = 0; sel = ab;
                for (int r = 0; r < 32; ++r) {
                    const bool eq = ((al >> r) & 1u) != 0u;
                    const unsigned long long be = __ballot(eq);
                    if (eq && running + __popcll(be & lt) < need) sel |= 1u << r;
                    running += __popcll(be);
                }
            }
            if (!exp_nostore) mbase[(2 * w + qq) * 64 + lane] = sel;
        }
    }
    __syncthreads();
}

__device__ __forceinline__ void phase_dsa(const Params& p, int l, LAS3 char* lds) {
    const int tid = opaque_tid(p.wid);
    unsigned* qhead = p.ctl + CW_QD + 64 * (l + 2 * p.qslot);
    volatile LAS3 int* bc = (volatile LAS3 int*)(lds + DS_CTL);
    int nxt = 0;
    if (tid == 0) nxt = (int)__hip_atomic_fetch_add(qhead, 1u, __ATOMIC_RELAXED, __HIP_MEMORY_SCOPE_AGENT);
    for (;;) {
        if (tid == 0) *bc = nxt;
        __syncthreads();
        const int idx = __builtin_amdgcn_readfirstlane(*bc);
        __syncthreads();
        if (idx >= 4096) break;
        if (tid == 0) nxt = (int)__hip_atomic_fetch_add(qhead, 1u, __ATOMIC_RELAXED, __HIP_MEMORY_SCOPE_AGENT);
        const int pb = 127 - (idx >> 5), b = idx & 31;
        dsa_unit(p, b * 128 + pb, lds);
    }
}
}

namespace {
constexpr int LDS_BYTES = 147456;
constexpr int NTHREADS = 512;

template <int PH>
__device__ __forceinline__ void run_phase(const Params& p, int l, unsigned char* smem) {
    LAS3 char* lds = (LAS3 char*)smem;
    PG8_LAS unsigned char* glds = (PG8_LAS unsigned char*)smem;
    const int G = gridDim.x, c = blockIdx.x;
    if constexpr (PH == 0) phase_p0(p, (char*)smem);
    if constexpr (PH == 1) { if (l == 0) phase_norm1<0>(p, 0); else phase_norm1<1>(p, l); }
    if constexpr (PH == 2) { pg8::Gemm g{p.h, p.WinT + (size_t)l * NP * D, D, D, 0}; pg8::StaticOrder S; S.init(T, NP, G, c);
        EpiStoreBf16 E{p.proj, NP}; pg8::gemm_phase<EpiStoreBf16, pg8::StaticOrder, false>(glds, g, S, E, p.wid); }
    if constexpr (PH == 3) phase_prep(p, l);
    if constexpr (PH == 4) { pg8::Gemm g{p.proj + PC_BCQ, p.WqT + (size_t)l * 512 * 256, 256, NP, 0}; pg8::StaticOrder S; S.init(T, 512, G, c);
          EpiMlaQ E{p.qm}; pg8::gemm_phase<EpiMlaQ, pg8::StaticOrder, false>(glds, g, S, E, p.wid); }
    if constexpr (PH == 12) { pg8::Gemm g{p.proj + PC_BCKV, p.WkvT + (size_t)l * 512 * 128, 128, NP, 0}; pg8::StaticOrder S; S.init(T, 512, G, c);
          EpiMlaKV E{p.km, p.vm}; pg8::gemm_phase<EpiMlaKV, pg8::StaticOrder, false>(glds, g, S, E, p.wid); }
    if constexpr (PH == 13) phase_dsa(p, l, lds);
    if constexpr (PH == 5) phase_attn(p, l, lds);
    if constexpr (PH == 6) { pg8::Gemm g{p.merged, p.WoutT + (size_t)l * D * D, D, D, 0}; pg8::StaticOrder S; S.init(T, D, G, c);
        EpiResidual E{l == 0 ? p.x : nullptr, p.xb, p.mod + (size_t)l * NB * NMOD + 2 * 1024}; pg8::gemm_phase<EpiResidual, pg8::StaticOrder, false>(glds, g, S, E, p.wid); }
    if constexpr (PH == 7) phase_route(p, l, (char*)smem);
    if constexpr (PH == 8) { const int* cnt = (const int*)(p.ctl + CW_CNT) + l * 16;
        pg8::Gemm g{p.h, p.WguT + (size_t)l * 16 * 512 * 1024, 1024, D, (size_t)512 * 1024}; MoeOrder S; S.init(cnt, p.list, 2, G, c);
        EpiGateUp E{p.hid}; pg8::gemm_phase<EpiGateUp, MoeOrder, true>(glds, g, S, E, p.wid); }
    if constexpr (PH == 9) { const int* cnt = (const int*)(p.ctl + CW_CNT) + l * 16;
        pg8::Gemm g{p.hid, p.WdT + (size_t)l * 16 * 1024 * 256, 256, 256, (size_t)1024 * 256}; MoeOrder S; S.init(cnt, p.list, 4, G, c);
        EpiDown E{p.ys, p.list, p.wl, cnt}; pg8::gemm_phase<EpiDown, MoeOrder, false>(glds, g, S, E, p.wid); }
    if constexpr (PH == 10) phase_norm1<2>(p, 1);
    if constexpr (PH == 11) phase_norm1<0>(p, l);
}
template <int PH>
__global__ void __launch_bounds__(NTHREADS, 2) k_ph(Params p, int l) {
    extern __shared__ __attribute__((aligned(16))) unsigned char smem[];
    p.wid = __builtin_amdgcn_readfirstlane(threadIdx.x >> 6); p.qslot = p.qslot_host;
    run_phase<PH>(p, l, smem);
}
}


namespace {
#ifndef REP_PH
#define REP_PH -1
#endif
#define REP(X, l) do { if (REP_PH == X) { xcd_barrier(bar); phase<X>(l, smem, wid, 1); } } while (0)
struct KArgs { const float* in[20]; float* xo; char* ws; };
constexpr size_t al256(size_t b) { return (b + 255) & ~(size_t)255; }
constexpr size_t WS_CTL = 0;
constexpr size_t WS_MOD = WS_CTL + al256((size_t)CW_WORDS * 4);
constexpr size_t WS_WIN = WS_MOD + al256((size_t)2 * NB * NMOD * 4);
constexpr size_t WS_WOUT = WS_WIN + al256((size_t)2 * NP * D * 2);
constexpr size_t WS_WQ = WS_WOUT + al256((size_t)2 * D * D * 2);
constexpr size_t WS_WKV = WS_WQ + al256((size_t)2 * 512 * 256 * 2);
constexpr size_t WS_WGU = WS_WKV + al256((size_t)2 * 512 * 128 * 2);
constexpr size_t WS_WD = WS_WGU + al256((size_t)2 * 16 * 512 * 1024 * 2);
constexpr size_t WS_ROPE = WS_WD + al256((size_t)2 * 16 * 1024 * 256 * 2);
constexpr size_t WS_RQ = WS_ROPE + al256((size_t)2048 * 16 * 2 * 4);
constexpr size_t WS_RKV = WS_RQ + al256((size_t)T * 4);
constexpr size_t WS_CBF = WS_RKV + al256((size_t)T * 4);
constexpr size_t WS_KIDX = WS_CBF + al256((size_t)NB * 4 * S * 4);
constexpr size_t WS_MASK = WS_KIDX + al256((size_t)T * 32 * 2);
constexpr size_t WS_LIST = WS_MASK + al256((size_t)T * 64 * 4);
constexpr size_t WS_RW = WS_LIST + al256((size_t)2 * 16 * ECAP * 4);
constexpr size_t WS_WL = WS_RW + al256((size_t)T * 2 * 4);
constexpr size_t WS_H = WS_WL + al256((size_t)2 * 16 * ECAP * 4);
constexpr size_t WS_PROJ = WS_H + al256((size_t)T * D * 2);
constexpr size_t WS_QM = WS_PROJ + al256((size_t)T * NP * 2);
constexpr size_t WS_KM = WS_QM + al256((size_t)T * 384 * 2);
constexpr size_t WS_VM = WS_KM + al256((size_t)T * 384 * 2);
constexpr size_t WS_MERGED = WS_VM + al256((size_t)T * 256 * 2);
constexpr size_t WS_XB = WS_MERGED + al256((size_t)T * D * 2);
constexpr size_t WS_END1 = WS_XB + al256((size_t)T * D * 2);
constexpr size_t WS_HID = WS_PROJ;
constexpr size_t WS_YS = WS_HID + al256((size_t)HIDROWS * 256 * 2);
constexpr size_t WS_END2 = WS_YS + al256((size_t)T * 2 * D * 2);
constexpr size_t WS_NEED = WS_END1 > WS_END2 ? WS_END1 : WS_END2;
static_assert(WS_END2 <= WS_MERGED, "MoE overlay must not reach the merged buffer");

__device__ __forceinline__ Params make_params(const KArgs& a) {
    Params p;
    p.x = a.in[0]; p.c = a.in[1]; p.w_ada = a.in[2]; p.b_ada = a.in[3]; p.g_norm1 = a.in[4]; p.w_in = a.in[5]; p.b_forget = a.in[6]; p.g_q_mla = a.in[7];
    p.w_q_up = a.in[8]; p.g_kv_mla = a.in[9]; p.w_kv_up = a.in[10]; p.sinks = a.in[11]; p.w_out = a.in[12]; p.g_norm2 = a.in[13]; p.w_router = a.in[14];
    p.b_router = a.in[15]; p.w_gate = a.in[16]; p.w_up = a.in[17]; p.w_down = a.in[18]; p.g_final = a.in[19];
    p.xo = a.xo; char* ws = a.ws;
    p.ctl = (unsigned*)(ws + WS_CTL); p.mod = (float*)(ws + WS_MOD); p.WinT = (bf16_t*)(ws + WS_WIN); p.WoutT = (bf16_t*)(ws + WS_WOUT);
    p.WqT = (bf16_t*)(ws + WS_WQ); p.WkvT = (bf16_t*)(ws + WS_WKV); p.WguT = (bf16_t*)(ws + WS_WGU); p.WdT = (bf16_t*)(ws + WS_WD);
    p.ropetab = (float*)(ws + WS_ROPE); p.rq = (float*)(ws + WS_RQ); p.rkv = (float*)(ws + WS_RKV); p.cbF = (float*)(ws + WS_CBF); p.kidx = (bf16_t*)(ws + WS_KIDX);
    p.mask = (uint32_t*)(ws + WS_MASK); p.list = (int*)(ws + WS_LIST); p.rw = (float*)(ws + WS_RW); p.wl = (float*)(ws + WS_WL); p.h = (bf16_t*)(ws + WS_H);
    p.proj = (bf16_t*)(ws + WS_PROJ); p.qm = (bf16_t*)(ws + WS_QM); p.km = (bf16_t*)(ws + WS_KM); p.vm = (bf16_t*)(ws + WS_VM);
    p.merged = (bf16_t*)(ws + WS_MERGED); p.xb = (bf16_t*)(ws + WS_XB); p.hid = (bf16_t*)(ws + WS_HID); p.ys = (bf16_t*)(ws + WS_YS);
    return p;
}
template <int PH>
__device__ __forceinline__ void phase(int l, unsigned char* smem, int wid, int qslot = 0) {
    typedef const __attribute__((address_space(4))) KArgs* KA4;
    KA4 ka = (KA4)__builtin_amdgcn_kernarg_segment_ptr();
    asm volatile("" : "+s"(ka));
    KArgs a;
#pragma unroll
    for (int i = 0; i < 20; ++i) a.in[i] = ka->in[i];
    a.xo = ka->xo; a.ws = ka->ws;
    Params p = make_params(a); p.wid = wid; p.qslot = qslot; p.qslot_host = 0;
    run_phase<PH>(p, l, smem);
}
__global__ void __launch_bounds__(NTHREADS, 2) fwd(KArgs args) {
    extern __shared__ __attribute__((aligned(16))) unsigned char smem[];
    volatile LAS unsigned* st = (volatile LAS unsigned*)(smem + LDS_BYTES - 16);
    const int wid = __builtin_amdgcn_readfirstlane(threadIdx.x >> 6);
    if (xb_leader(wid)) { st[0] = 0u; st[1] = 0u; st[2] = 0u; st[3] = 0u; }
    __syncthreads();
    XcdBarrier bar = xcd_barrier_post((unsigned*)(args.ws + WS_CTL) + CW_BAR, st, wid);
    phase<0>(0, smem, wid);  REP(0, 0);
    xcd_barrier(bar);
#define LAYER(l) do { \
        phase<1>(l, smem, wid);  if (l == 0) REP(1, l); xcd_barrier(bar); \
        phase<2>(l, smem, wid);  REP(2, l); xcd_barrier(bar); \
        phase<3>(l, smem, wid);  REP(3, l); xcd_barrier(bar); \
        phase<4>(l, smem, wid);  REP(4, l); phase<12>(l, smem, wid);  REP(12, l); phase<13>(l, smem, wid);  REP(13, l); xcd_barrier(bar); \
        phase<5>(l, smem, wid);  REP(5, l); xcd_barrier(bar); \
        phase<6>(l, smem, wid);  xcd_barrier(bar); \
        phase<7>(l, smem, wid);  REP(7, l); xcd_barrier(bar); \
        phase<8>(l, smem, wid);  REP(8, l); xcd_barrier(bar); \
        phase<9>(l, smem, wid);  REP(9, l); xcd_barrier(bar); } while (0)
    LAYER(0);
    LAYER(1);
#ifdef REP_BAR
    for (int rb = 0; rb < REP_BAR; ++rb) xcd_barrier(bar);
#endif
    phase<10>(1, smem, wid);
}
}

extern "C" void kernel_launch(void* const* d_in, const int* in_sizes, int n_in, void* d_out, int out_size, void* d_ws, size_t ws_size,
                              hipStream_t stream) {
    KArgs a{};
    for (int i = 0; i < 20; ++i) a.in[i] = (const float*)d_in[i];
    a.xo = (float*)d_out; a.ws = (char*)d_ws;
    if (WS_NEED > ws_size) return;

    static int grid = 0;
    if (!grid) {
        int dev = 0, cus = 0, per_cu = 0;
        (void)hipGetDevice(&dev);
        (void)hipDeviceGetAttribute(&cus, hipDeviceAttributeMultiprocessorCount, dev);
        (void)hipFuncSetAttribute((const void*)fwd, hipFuncAttributeMaxDynamicSharedMemorySize, LDS_BYTES);
        (void)hipOccupancyMaxActiveBlocksPerMultiprocessor(&per_cu, (const void*)fwd, NTHREADS, LDS_BYTES);
        grid = cus > 0 ? cus : 256;
    }
    (void)hipMemsetAsync(a.ws + WS_CTL, 0, (size_t)CW_WORDS * 4, stream);
    fwd<<<dim3(grid), dim3(NTHREADS), LDS_BYTES, stream>>>(a);
}
```

```cpp
#include <hip/hip_runtime.h>
#include <stdint.h>
#define XB_TMO      128
#define XB_XCNT(j)  (256  + 64 * (j))
#define XB_XSUB(j)  (1280 + 64 * (j))
#define XB_XGEN(j)  (2304 + 64 * (j))
#define XB_TOP      3328
#define XB_TOPGEN   3392
#define XCD_BAR_WORDS 3456
#define XB_SPIN_CAP (1u << 20)
#define LAS __attribute__((address_space(3)))

__device__ __forceinline__ unsigned xb_ld(unsigned* p)              { return __hip_atomic_load(p, __ATOMIC_RELAXED, __HIP_MEMORY_SCOPE_AGENT); }
__device__ __forceinline__ unsigned xb_add(unsigned* p, unsigned v) { return __hip_atomic_fetch_add(p, v, __ATOMIC_RELAXED, __HIP_MEMORY_SCOPE_AGENT); }
__device__ __forceinline__ unsigned xb_xcc_id() { return (unsigned)__builtin_amdgcn_s_getreg((3 << 11) | 20) & 0xFu; }
#define XB_SPIN(cond, bar) do { unsigned _sp = 0; while (cond) { __builtin_amdgcn_s_sleep(1); \
    if ((++_sp & 255u) == 0u) { if (xb_ld(&(bar)[XB_TMO])) break; if (_sp > XB_SPIN_CAP) { atomicAdd(&(bar)[XB_TMO], 1u); break; } } } } while (0)

struct XcdBarrier { unsigned* bar; unsigned x; volatile LAS unsigned* st; int wid; };
__device__ __forceinline__ bool xb_leader(int wid) { return wid == 0 && __builtin_amdgcn_mbcnt_hi(~0u, __builtin_amdgcn_mbcnt_lo(~0u, 0u)) == 0u; }

__device__ __forceinline__ XcdBarrier xcd_barrier_post(unsigned* bar, volatile LAS unsigned* st, int wid) {
    XcdBarrier b; b.bar = bar; b.x = xb_xcc_id(); b.st = st; b.wid = wid;
    if (xb_leader(wid)) (void)xb_add(&bar[XB_XCNT(b.x)], 1u);
    return b;
}
__device__ __forceinline__ void xcd_barrier_complete(unsigned* bar, unsigned x, unsigned& nloc, unsigned& nx) {
    const unsigned G = gridDim.x * gridDim.y * gridDim.z;
    unsigned sum, cnt, mine, sp = 0u;
    for (;;) {
        sum = 0u; cnt = 0u; mine = 0u;
#pragma unroll
        for (unsigned j = 0; j < 16; ++j) { const unsigned c = xb_ld(&bar[XB_XCNT(j)]); sum += c; cnt += (c > 0u) ? 1u : 0u; mine = (j == x) ? c : mine; }
        if (sum == G) break;
        __builtin_amdgcn_s_sleep(1);
        if ((++sp & 255u) == 0u) { if (xb_ld(&bar[XB_TMO])) break; if (sp > XB_SPIN_CAP) { atomicAdd(&bar[XB_TMO], 1u); break; } }
    }
    nloc = mine > 0u ? mine : 1u; nx = cnt > 0u ? cnt : 1u;
}
__device__ __forceinline__ void xcd_barrier(const XcdBarrier& b) {
    asm volatile("s_waitcnt vmcnt(0)" ::: "memory");
    __syncthreads();
    if (xb_leader(b.wid)) {
        unsigned* bar = b.bar;
        __builtin_amdgcn_s_waitcnt(0);
        unsigned nloc = b.st[0], nx = b.st[1];
        if (nloc == 0u) { xcd_barrier_complete(bar, b.x, nloc, nx); b.st[0] = nloc; b.st[1] = nx; }
        const unsigned old = xb_add(&bar[XB_XSUB(b.x)], 1u);
        const unsigned gen = old / nloc;
        if (old + 1u == (gen + 1u) * nloc) {
            __builtin_amdgcn_fence(__ATOMIC_RELEASE, "agent");
            asm volatile("s_waitcnt vmcnt(0)" ::: "memory");
            const unsigned og = xb_add(&bar[XB_TOP], 1u);
            const unsigned tg = og / nx;
            if (og + 1u == (tg + 1u) * nx) xb_add(&bar[XB_TOPGEN], 1u);
            else XB_SPIN(xb_ld(&bar[XB_TOPGEN]) == tg, bar);
            __builtin_amdgcn_fence(__ATOMIC_ACQUIRE, "agent");
            xb_add(&bar[XB_XGEN(b.x)], 1u);
            asm volatile("s_waitcnt vmcnt(0)" ::: "memory");
        } else {
            XB_SPIN(xb_ld(&bar[XB_XGEN(b.x)]) == gen, bar);
            __builtin_amdgcn_fence(__ATOMIC_ACQUIRE, "agent");
            asm volatile("s_waitcnt vmcnt(0)" ::: "memory");
        }
    }
    __syncthreads();
}

#define LAS3 __attribute__((address_space(3)))
namespace {
typedef unsigned short bf16_t;
typedef short bf16x8 __attribute__((ext_vector_type(8)));
typedef short bf16x4 __attribute__((ext_vector_type(4)));
typedef float f32x4 __attribute__((ext_vector_type(4)));
typedef float f32x2 __attribute__((ext_vector_type(2)));
typedef unsigned u32x4 __attribute__((ext_vector_type(4)));
typedef unsigned u32x2 __attribute__((ext_vector_type(2)));

constexpr int D = 1024, NB = 32, S = 2048, T = NB * S, NIN = 2380, NP = 2560, NMOD = 6144;
constexpr int OFF_AQ = 0, OFF_AK = 256, OFF_AV = 512, OFF_AF = 768, OFF_BCQ = 772, OFF_BCKV = 1028, OFF_BKR = 1156,
              OFF_CQ = 1188, OFF_CK = 1444, OFF_CV = 1572, OFF_DQ = 1700, OFF_DK = 1956, OFF_DV = 2020,
              OFF_DQI = 2084, OFF_DKI = 2340, OFF_DWI = 2372;
constexpr int PC_AQ = 0, PC_AK = 256, PC_AV = 512, PC_BCQ = 768, PC_BCKV = 1024, PC_BKR = 1152, PC_CQ = 1184, PC_CK = 1440, PC_CV = 1568,
              PC_DQ = 1696, PC_DK = 1952, PC_DV = 2016, PC_DQI = 2080, PC_DKI = 2336, PC_DWI = 2368, PC_AF = 2376;
constexpr float EPS = 1e-6f;
constexpr float LOG2E = 1.4426950408889634f;
constexpr int ECAP = T;
constexpr int HIDROWS = 2 * T + 16 * 256;

__host__ __device__ __forceinline__ int orig_col(int n) { return n < 768 ? n : (n < 2376 ? n + 4 : (n < 2380 ? n - 1608 : -1)); }
__device__ __forceinline__ int opaque_tid(int wid) {
    int t = wid * 64 + (int)__builtin_amdgcn_mbcnt_hi(~0u, __builtin_amdgcn_mbcnt_lo(~0u, 0u));
    asm volatile("" : "+v"(t)); return t; }
__device__ __forceinline__ float bf2f(bf16_t v) { return __uint_as_float((unsigned)v << 16); }
__device__ __forceinline__ bf16_t f2bf(float f) { unsigned u = __float_as_uint(f); u += 0x7FFFu + ((u >> 16) & 1u); return (bf16_t)(u >> 16); }
typedef __bf16 bf16x2_native __attribute__((ext_vector_type(2)));
__device__ __forceinline__ unsigned cvt_pk_bf16(float lo, float hi) { const f32x2 v = {lo, hi}; return __builtin_bit_cast(unsigned, __builtin_convertvector(v, bf16x2_native)); }
__device__ __forceinline__ float bflo(unsigned w) { return __uint_as_float(w << 16); }
__device__ __forceinline__ float bfhi(unsigned w) { return __uint_as_float(w & 0xFFFF0000u); }
__device__ __forceinline__ float wave_sum(float v) {
#pragma unroll
    for (int o = 32; o > 0; o >>= 1) v += __shfl_xor(v, o);
    return v;
}
__device__ __forceinline__ float xor32_max(float x) {
    float a = x, b = x;
    asm volatile("s_nop 1\n\tv_permlane32_swap_b32 %0, %1\n\ts_nop 1" : "+v"(a), "+v"(b));
    return fmaxf(a, b);
}
__device__ __forceinline__ int wave_reduce_add(int v) {
    v += __builtin_amdgcn_update_dpp(0, v, 0xB1, 0xF, 0xF, true);
    v += __builtin_amdgcn_update_dpp(0, v, 0x4E, 0xF, 0xF, true);
    v += __builtin_amdgcn_update_dpp(0, v, 0x141, 0xF, 0xF, true);
    v += __builtin_amdgcn_update_dpp(0, v, 0x140, 0xF, 0xF, true);
    return __builtin_amdgcn_readlane(v, 0) + __builtin_amdgcn_readlane(v, 16) + __builtin_amdgcn_readlane(v, 32) + __builtin_amdgcn_readlane(v, 48);
}
}

namespace pg8 {
#define PG8_LAS __attribute__((address_space(3)))
constexpr int BM = 256, BK = 64, HALF = 128, HTB = HALF * BK * 2, STAGE_BYTES = 8 * HTB, NXCD = 8, WGM = 8;

__host__ __device__ __forceinline__ int lds_byte(int r, int c) { const int st = (r >> 4) * 2 + (c >> 5), rr = r & 15, cc = c & 31, ob = rr * 64 + cc * 2; return st * 1024 + (ob ^ (((ob >> 9) & 1) << 5)); }
__host__ __device__ __forceinline__ void stage_rc(int b, int& R, int& C) { const int st = b / 1024, sb = b % 1024, swz = sb ^ (((sb >> 9) & 1) << 5); R = (st >> 1) * 16 + swz / 64; C = (st & 1) * 32 + (swz % 64) / 2; }
__host__ __device__ __forceinline__ int perm32(int rho) { const int n = rho >> 4, i = rho & 15; return 8 * (i >> 2) + 4 * n + (i & 3); }

struct Unit { int pm, pn, e, mt; };
struct Gemm { const bf16_t* A; const bf16_t* Bt; int K; int lda; size_t bstride; };

struct StaticOrder {
    int nM, nN, nwg, G, c;
    __host__ __device__ void init(int M, int N, int G_, int c_) { nM = M / BM; nN = N / BM; nwg = nM * nN; G = G_; c = c_; }
    __host__ __device__ bool next(int i, Unit& u) const {
        const long L = (long)i * G + c; if (L >= nwg) return false;
        int wgid = (int)L; { const int q = nwg / NXCD, r = nwg % NXCD, xcd = wgid % NXCD, off = wgid / NXCD; wgid = (xcd < r ? xcd * (q + 1) : r * (q + 1) + (xcd - r) * q) + off; }
        const int nig = WGM * nN, gid = wgid / nig, fm = gid * WGM, gsz = (nM - fm) < WGM ? (nM - fm) : WGM;
        u.pm = fm + ((wgid % nig) % gsz); u.pn = (wgid % nig) / gsz; u.e = 0; u.mt = 0; return true;
    }
    __device__ __forceinline__ int arow(const Unit& u, int r) const { return u.pm * BM + r; }
};

template <class Epi, class Sched, bool GATHER>
__device__ __forceinline__ void gemm_phase(PG8_LAS unsigned char* lds, const Gemm g, const Sched& S, const Epi& E, int wave_index) {
    const int tid = opaque_tid(wave_index), wid = __builtin_amdgcn_readfirstlane(tid >> 6), lane = tid & 63, wr = wid >> 2, wc = wid & 3, fr = lane & 15, fq = lane >> 4;
    int K_ = g.K; asm volatile("" : "+s"(K_));
    const int K = K_, nt = K / BK, lda = g.lda;
    int Ra[2], Ca[2]; unsigned voffB[2], voffA[2];
#pragma unroll
    for (int i = 0; i < 2; ++i) { int R, C; stage_rc(tid * 16 + i * 8192, R, C); const int Rb = Epi::PERM ? ((R & ~31) + perm32(R & 31)) : R;
        Ra[i] = R; Ca[i] = C; voffB[i] = (unsigned)(Rb * K + C) * 2u; voffA[i] = (unsigned)(R * lda + C) * 2u; }
    const size_t kstep = (size_t)(BK * 2);
    const size_t hstepB = (size_t)HALF * K * 2;
    const size_t tstepB = 2 * hstepB;
    const size_t hstepA = (size_t)HALF * lda * 2, tstepA = 2 * hstepA;
    const unsigned ldsw = (unsigned)wid * 1024u;
    const int aoff = lds_byte(wr * 64 + fr, fq * 8), boff = lds_byte(wc * 32 + fr, fq * 8);
#define PG8_SA(b, h) (((b) * 2 + (h)) * HTB)
#define PG8_SB(b, h) ((4 + (b) * 2 + (h)) * HTB)
#define PG8_STAGE(bufoff, gbase, voff) do { _Pragma("unroll") for (int _i = 0; _i < 2; ++_i) \
        __builtin_amdgcn_global_load_lds((const unsigned*)((const char*)(gbase) + (voff)[_i]), (PG8_LAS unsigned*)(lds + (bufoff) + ldsw + _i * 8192), 16, 0, 0); } while (0)
#define PG8_STAGEA(bufoff, kptr, VO, h) do { _Pragma("unroll") for (int _i = 0; _i < 2; ++_i) { \
        const char* _src; if constexpr (GATHER) _src = (const char*)(kptr) + (VO)[_i][h]; else _src = (const char*)(kptr) + (size_t)(h) * hstepA + voffA[_i]; \
        __builtin_amdgcn_global_load_lds((const unsigned*)_src, (PG8_LAS unsigned*)(lds + (bufoff) + ldsw + _i * 8192), 16, 0, 0); } } while (0)
#define PG8_LDA(dst, b, h) do { _Pragma("unroll") for (int m = 0; m < 4; ++m) _Pragma("unroll") for (int k = 0; k < 2; ++k) dst[m][k] = *(const PG8_LAS bf16x8*)(lds + PG8_SA(b, h) + aoff + m * 2048 + k * 1024); } while (0)
#define PG8_LDB(dst, b, h) do { _Pragma("unroll") for (int n = 0; n < 2; ++n) _Pragma("unroll") for (int k = 0; k < 2; ++k) dst[n][k] = *(const PG8_LAS bf16x8*)(lds + PG8_SB(b, h) + boff + n * 2048 + k * 1024); } while (0)
#define PG8_MMA(ai, bj, At, Bt) do { __builtin_amdgcn_s_setprio(1); _Pragma("unroll") for (int m = 0; m < 4; ++m) _Pragma("unroll") for (int n = 0; n < 2; ++n) _Pragma("unroll") for (int k = 0; k < 2; ++k) \
        acc[ai][bj][m][n] = __builtin_amdgcn_mfma_f32_16x16x32_bf16(Bt[n][k], At[m][k], acc[ai][bj][m][n], 0, 0, 0); __builtin_amdgcn_s_setprio(0); } while (0)
#define PG8_WAIT_V(n) asm volatile("s_waitcnt vmcnt(" #n ")" ::: "memory")
#define PG8_WAIT_L(n) asm volatile("s_waitcnt lgkmcnt(" #n ")" ::: "memory")
#define PG8_BAR __builtin_amdgcn_s_barrier()
#define PG8_SCHED __builtin_amdgcn_sched_barrier(0)
#define PG8_SETV(V, u) do { _Pragma("unroll") for (int _i = 0; _i < 2; ++_i) _Pragma("unroll") for (int _h = 0; _h < 2; ++_h) { \
        const int _row = GATHER ? S.arow(u, _h * HALF + Ra[_i]) : ((u).pm * BM + _h * HALF + Ra[_i]); V[_i][_h] = (unsigned)(((size_t)_row * lda + Ca[_i]) * 2); } } while (0)
    Unit cur, nxt; int ui = 0;
    if (!S.next(0, cur)) return;
    f32x4 acc[2][2][4][2];
#pragma unroll
    for (int a = 0; a < 2; ++a)
#pragma unroll
        for (int b = 0; b < 2; ++b)
#pragma unroll
            for (int m = 0; m < 4; ++m)
#pragma unroll
                for (int n = 0; n < 2; ++n) acc[a][b][m][n] = (f32x4){0.f, 0.f, 0.f, 0.f};
    bf16x8 At[4][2], B0[2][2], B1[2][2];
    unsigned vA[2][2], vN[2][2];
    if constexpr (GATHER) { PG8_SETV(vA, cur); }
    const char* cA = (const char*)g.A + (GATHER ? (size_t)0 : (size_t)cur.pm * tstepA);
    const char* cB = (const char*)g.Bt + ((size_t)cur.e * g.bstride) * 2 + (size_t)cur.pn * tstepB;
    PG8_STAGE(PG8_SB(0, 0), cB, voffB); PG8_STAGE(PG8_SB(0, 1), cB + hstepB, voffB); PG8_STAGEA(PG8_SA(0, 0), cA, vA, 0); PG8_STAGEA(PG8_SA(0, 1), cA, vA, 1);
    if (wr == 1) PG8_BAR;
    PG8_WAIT_V(2); PG8_BAR;
    PG8_STAGE(PG8_SB(1, 0), cB + kstep, voffB); PG8_STAGEA(PG8_SA(1, 0), cA + kstep, vA, 0); PG8_STAGE(PG8_SB(1, 1), cB + hstepB + kstep, voffB);
    PG8_WAIT_V(6); PG8_BAR;
    for (;;) {
        const bool has_next = S.next(ui + 1, nxt);
        if constexpr (GATHER) { if (has_next) { PG8_SETV(vN, nxt); }
        else {
#pragma unroll
            for (int _i = 0; _i < 2; ++_i)
#pragma unroll
                for (int _h = 0; _h < 2; ++_h) vN[_i][_h] = vA[_i][_h];
        } }
        const char* nA = (!GATHER && has_next) ? (const char*)g.A + (size_t)nxt.pm * tstepA : cA;
        const char* nB = has_next ? (const char*)g.Bt + ((size_t)nxt.e * g.bstride) * 2 + (size_t)nxt.pn * tstepB : cB;
#pragma unroll 1
        for (int t = 0; t < nt; t += 2) {
            const bool last = (t == nt - 2);
            const char* a1 = cA + (size_t)(t + 1) * kstep;
            const char* a2 = last ? nA : cA + (size_t)(t + 2) * kstep; const char* b2 = last ? nB : cB + (size_t)(t + 2) * kstep;
            const char* a3 = a2 + kstep; const char* b3 = b2 + kstep;
            unsigned v2[2][2];
            if constexpr (GATHER) {
#pragma unroll
            for (int _i = 0; _i < 2; ++_i)
#pragma unroll
                for (int _h = 0; _h < 2; ++_h) v2[_i][_h] = last ? vN[_i][_h] : vA[_i][_h];
            }
            PG8_LDB(B0, 0, 0); PG8_LDB(B1, 0, 1); PG8_SCHED; PG8_LDA(At, 0, 0); PG8_STAGEA(PG8_SA(1, 1), a1, vA, 1);
            PG8_WAIT_V(8); PG8_WAIT_L(0); PG8_BAR; PG8_MMA(0, 0, At, B0); PG8_MMA(0, 1, At, B1); PG8_BAR; PG8_SCHED;
            PG8_LDA(At, 0, 1); PG8_STAGE(PG8_SB(0, 0), b2, voffB); PG8_STAGE(PG8_SB(0, 1), b2 + hstepB, voffB); PG8_STAGEA(PG8_SA(0, 0), a2, v2, 0);
            PG8_WAIT_V(8); PG8_WAIT_L(0); PG8_BAR; PG8_MMA(1, 0, At, B0); PG8_MMA(1, 1, At, B1); PG8_BAR; PG8_SCHED;
            PG8_LDB(B0, 1, 0); PG8_LDB(B1, 1, 1); PG8_SCHED; PG8_LDA(At, 1, 0); PG8_STAGEA(PG8_SA(0, 1), a2, v2, 1);
            PG8_WAIT_V(8); PG8_WAIT_L(0); PG8_BAR; PG8_MMA(0, 0, At, B0); PG8_MMA(0, 1, At, B1); PG8_BAR; PG8_SCHED;
            PG8_LDA(At, 1, 1); PG8_STAGE(PG8_SB(1, 0), b3, voffB); PG8_STAGE(PG8_SB(1, 1), b3 + hstepB, voffB); PG8_STAGEA(PG8_SA(1, 0), a3, v2, 0);
            PG8_WAIT_V(8); PG8_WAIT_L(0); PG8_BAR; PG8_MMA(1, 0, At, B0); PG8_MMA(1, 1, At, B1); PG8_BAR; PG8_SCHED;
        }
        if (wr == 0) PG8_BAR;
        E(acc, cur, wr, wc, fr, fq);
        if (!has_next) break;
#pragma unroll
        for (int a = 0; a < 2; ++a)
#pragma unroll
            for (int b = 0; b < 2; ++b)
#pragma unroll
                for (int m = 0; m < 4; ++m)
#pragma unroll
                    for (int n = 0; n < 2; ++n) acc[a][b][m][n] = (f32x4){0.f, 0.f, 0.f, 0.f};
        cur = nxt; cB = nB; cA = nA; ++ui;
        if constexpr (GATHER) {
#pragma unroll
        for (int _i = 0; _i < 2; ++_i)
#pragma unroll
            for (int _h = 0; _h < 2; ++_h) vA[_i][_h] = vN[_i][_h];
        }
        if (wr == 1) PG8_BAR;
    }
    PG8_WAIT_V(0);
    PG8_BAR;
#undef PG8_SA
#undef PG8_SB
#undef PG8_STAGE
#undef PG8_STAGEA
#undef PG8_LDA
#undef PG8_LDB
#undef PG8_MMA
#undef PG8_WAIT_V
#undef PG8_WAIT_L
#undef PG8_BAR
#undef PG8_SCHED
#undef PG8_SETV
}
}

namespace {
struct Params {
    const float *x, *c, *w_ada, *b_ada, *g_norm1, *w_in, *b_forget, *g_q_mla, *w_q_up, *g_kv_mla, *w_kv_up, *sinks, *w_out, *g_norm2,
                *w_router, *b_router, *w_gate, *w_up, *w_down, *g_final;
    float* xo;
    bf16_t* xb;
    unsigned* ctl;
    float* mod;
    bf16_t* WinT;
    bf16_t* WoutT;
    bf16_t* WqT;
    bf16_t* WkvT;
    bf16_t* WguT;
    bf16_t* WdT;
    float* ropetab;
    float* rq; float* rkv;
    float* cbF;
    bf16_t* kidx;
    uint32_t* mask;
    bf16_t* h;
    bf16_t* proj;
    bf16_t* qm; bf16_t* km; bf16_t* vm;
    bf16_t* merged;
    bf16_t* hid;
    bf16_t* ys;
    int* list;
    float* rw;
    float* wl;
    int wid;
    int qslot;
    int qslot_host;
};
constexpr int CW_BAR = 0;
constexpr int CW_CNT = 3584;
constexpr int CW_QA = 3648;
constexpr int CW_QD = 4288;
constexpr int CW_KN2 = 4992;
constexpr int CW_QN2 = CW_KN2 + 2 * NB * 4 * 32;
constexpr int CW_WORDS = CW_QN2 + 2 * NB * 4 * 8;
}

namespace {
constexpr long P0_B1 = 2l * NP * 128, P0_B2 = P0_B1 + 2l * 1024 * 128, P0_B3 = P0_B2 + 2l * 512 * 32, P0_B4 = P0_B3 + 2l * 512 * 16,
               P0_B5 = P0_B4 + 32l * 512 * 128, P0_B6 = P0_B5 + 32l * 1024 * 32;
__device__ __forceinline__ bf16_t* p0_fetch(const Params& p, long it, float (&v)[8]) {
    if (it < P0_B1) {
        const int l = (int)(it / (NP * 128)), r = (int)(it % (NP * 128)), n = r % NP, k0 = (r / NP) * 8, o = orig_col(n);
        const float* w = p.w_in + (size_t)l * D * NIN;
#pragma unroll
        for (int j = 0; j < 8; ++j) v[j] = o >= 0 ? w[(size_t)(k0 + j) * NIN + o] : 0.f;
        return p.WinT + ((size_t)l * NP + n) * D + k0;
    } else if (it < P0_B2) {
        const long s = it - P0_B1; const int l = (int)(s / (1024 * 128)), r = (int)(s % (1024 * 128)), n = r & 1023, k0 = (r >> 10) * 8;
        const float* w = p.w_out + (size_t)l * D * D;
#pragma unroll
        for (int j = 0; j < 8; ++j) v[j] = w[(size_t)(k0 + j) * D + n];
        return p.WoutT + ((size_t)l * D + n) * D + k0;
    } else if (it < P0_B3) {
        const long s = it - P0_B2; const int l = (int)(s / (512 * 32)), r = (int)(s % (512 * 32)), n = r & 511, k0 = (r >> 9) * 8;
        const float* w = p.w_q_up + (size_t)l * 256 * 384; const float* g = p.g_q_mla + l * 256;
#pragma unroll
        for (int j = 0; j < 8; ++j) v[j] = n < 384 ? g[k0 + j] * w[(size_t)(k0 + j) * 384 + n] : 0.f;
        return p.WqT + ((size_t)l * 512 + n) * 256 + k0;
    } else if (it < P0_B4) {
        const long s = it - P0_B3; const int l = (int)(s / (512 * 16)), r = (int)(s % (512 * 16)), n = r & 511, k0 = (r >> 9) * 8;
        const float* w = p.w_kv_up + (size_t)l * 128 * 512; const float* g = p.g_kv_mla + l * 128;
#pragma unroll
        for (int j = 0; j < 8; ++j) v[j] = g[k0 + j] * w[(size_t)(k0 + j) * 512 + n];
        return p.WkvT + ((size_t)l * 512 + n) * 128 + k0;
    } else if (it < P0_B5) {
        const long s = it - P0_B4; const int le = (int)(s >> 16), r = (int)(s & 65535), n = r & 511, k0 = (r >> 9) * 8;
        const int q = n >> 5, rr = n & 31, col = 16 * q + (rr & 15);
        const float* w = (rr < 16 ? p.w_gate : p.w_up) + (size_t)le * 1024 * 256;
#pragma unroll
        for (int j = 0; j < 8; ++j) v[j] = w[(size_t)(k0 + j) * 256 + col];
        return p.WguT + ((size_t)le * 512 + n) * 1024 + k0;
    } else {
        const long s = it - P0_B5; const int le = (int)(s >> 15), r = (int)(s & 32767), n = r & 1023, k0 = (r >> 10) * 8;
        const float* w = p.w_down + (size_t)le * 256 * 1024;
#pragma unroll
        for (int j = 0; j < 8; ++j) v[j] = w[(size_t)(k0 + j) * 1024 + n];
        return p.WdT + ((size_t)le * 1024 + n) * 256 + k0;
    }
}
__device__ __forceinline__ void p0_store(bf16_t* dst, const float (&v)[8]) {
    u32x4 w; w.x = cvt_pk_bf16(v[0], v[1]); w.y = cvt_pk_bf16(v[2], v[3]); w.z = cvt_pk_bf16(v[4], v[5]); w.w = cvt_pk_bf16(v[6], v[7]);
    *(u32x4*)dst = w;
}

__device__ __forceinline__ void phase_p0(const Params& p, char* lds) {
    const int tid = opaque_tid(p.wid), gtid = blockIdx.x * blockDim.x + tid, gthreads = gridDim.x * blockDim.x;
    for (long it0 = gtid; it0 < P0_B6; it0 += 4l * gthreads) {
        float va[8], vb[8], vc[8], vd[8];
        const bool hb = it0 + gthreads < P0_B6, hc = it0 + 2l * gthreads < P0_B6, hd = it0 + 3l * gthreads < P0_B6;
        bf16_t* da = p0_fetch(p, it0, va);
        bf16_t* db = hb ? p0_fetch(p, it0 + gthreads, vb) : da;
        bf16_t* dc = hc ? p0_fetch(p, it0 + 2l * gthreads, vc) : da;
        bf16_t* dd = hd ? p0_fetch(p, it0 + 3l * gthreads, vd) : da;
        p0_store(da, va);
        if (hb) p0_store(db, vb);
        if (hc) p0_store(dc, vc);
        if (hd) p0_store(dd, vd);
    }
    for (int it = gtid; it < 2048 * 16; it += gthreads) {
        const int pos = it >> 4, i = it & 15;
        const float inv = powf(10000.0f, -(float)i / 16.0f), ang = (float)pos * inv;
        p.ropetab[it * 2] = cosf(ang); p.ropetab[it * 2 + 1] = sinf(ang);
    }
    float* ca = (float*)lds;
    for (int i = tid; i < NB * 1024; i += 512) { const float v = p.c[i]; ca[i] = v / (1.f + __expf(-v)); }
    __syncthreads();
    for (int u = blockIdx.x; u < 2 * (NMOD / 64); u += gridDim.x) {
        const int l = u / (NMOD / 64), n = (u % (NMOD / 64)) * 64 + (tid & 63), bg = tid >> 6;
        const float* w = p.w_ada + (size_t)l * 1024 * NMOD + n;
        float acc[4] = {0.f, 0.f, 0.f, 0.f};
        for (int d0 = 0; d0 < 1024; d0 += 8) {
            float wv[8];
#pragma unroll
            for (int q = 0; q < 8; ++q) wv[q] = w[(size_t)(d0 + q) * NMOD];
#pragma unroll
            for (int q = 0; q < 8; ++q)
#pragma unroll
                for (int j = 0; j < 4; ++j) acc[j] += ca[(bg * 4 + j) * 1024 + d0 + q] * wv[q];
        }
        const float bias = p.b_ada[l * NMOD + n];
#pragma unroll
        for (int j = 0; j < 4; ++j) p.mod[((size_t)l * NB + bg * 4 + j) * NMOD + n] = acc[j] + bias;
    }
    __syncthreads();
}

template <int MODE>
__device__ __forceinline__ void phase_norm1(const Params& p, int l) {
#ifndef NORM_NT
#define NORM_NT 2
#endif
    constexpr int NT = NORM_NT;
    const int tid = opaque_tid(p.wid), w = tid >> 6, lane = tid & 63;
    const float* g = (MODE == 2) ? p.g_final : p.g_norm1 + l * D;
    const float* modl = p.mod + (size_t)(MODE == 2 ? 1 : l) * NB * NMOD;
    const float* modp = p.mod + (size_t)(MODE == 2 ? 1 : (l > 0 ? l - 1 : 0)) * NB * NMOD;
    f32x4 gg4[4];
#pragma unroll
    for (int k = 0; k < 4; ++k) gg4[k] = *(const f32x4*)(g + 4 * lane + 256 * k);
    for (int t0 = (blockIdx.x * 8 + w) * NT; t0 < T; t0 += gridDim.x * 8 * NT) {
        const int b0 = t0 >> 11;
        f32x4 sc4[4], sh4[4], gt4[4];
        if (MODE != 2) {
#pragma unroll
            for (int k = 0; k < 4; ++k) { sc4[k] = *(const f32x4*)(modl + (size_t)b0 * NMOD + 1024 + 4 * lane + 256 * k); sh4[k] = *(const f32x4*)(modl + (size_t)b0 * NMOD + 4 * lane + 256 * k); }
        }
        if (MODE >= 1) {
#pragma unroll
            for (int k = 0; k < 4; ++k) gt4[k] = *(const f32x4*)(modp + (size_t)b0 * NMOD + 5 * 1024 + 4 * lane + 256 * k);
        }
        f32x4 v[NT][4];
#pragma unroll
        for (int u = 0; u < NT; ++u)
#pragma unroll
            for (int k = 0; k < 4; ++k) {
                if (MODE == 0) v[u][k] = *(const f32x4*)(p.x + (size_t)(t0 + u) * D + 4 * lane + 256 * k);
                else { const u32x2 w2 = *(const u32x2*)(p.xb + (size_t)(t0 + u) * D + 4 * lane + 256 * k); v[u][k] = (f32x4){bflo(w2.x), bfhi(w2.x), bflo(w2.y), bfhi(w2.y)}; }
            }
        if (MODE >= 1) {
            u32x2 y0[NT][4], y1[NT][4];
#pragma unroll
            for (int u = 0; u < NT; ++u)
#pragma unroll
                for (int k = 0; k < 4; ++k) { const int col = 4 * lane + 256 * k;
                    y0[u][k] = *(const u32x2*)(p.ys + ((size_t)(t0 + u) * 2 + 0) * D + col); y1[u][k] = *(const u32x2*)(p.ys + ((size_t)(t0 + u) * 2 + 1) * D + col); }
#pragma unroll
            for (int u = 0; u < NT; ++u) {
                const int b = (t0 + u) >> 11;
#pragma unroll
                for (int k = 0; k < 4; ++k) {
                    const int col = 4 * lane + 256 * k;
                    const f32x4 gt = gt4[k];
                    v[u][k][0] += gt[0] * (bflo(y0[u][k].x) + bflo(y1[u][k].x)); v[u][k][1] += gt[1] * (bfhi(y0[u][k].x) + bfhi(y1[u][k].x));
                    v[u][k][2] += gt[2] * (bflo(y0[u][k].y) + bflo(y1[u][k].y)); v[u][k][3] += gt[3] * (bfhi(y0[u][k].y) + bfhi(y1[u][k].y));
                }
            }
        }
#pragma unroll
        for (int u = 0; u < NT; ++u) {
            const int t = t0 + u, b = t >> 11;
            float ss = 0.f;
#pragma unroll
            for (int k = 0; k < 4; ++k) ss += v[u][k][0] * v[u][k][0] + v[u][k][1] * v[u][k][1] + v[u][k][2] * v[u][k][2] + v[u][k][3] * v[u][k][3];
            ss = wave_sum(ss);
            const float r = rsqrtf(ss * (1.0f / D) + EPS);
#pragma unroll
            for (int k = 0; k < 4; ++k) {
                const int col = 4 * lane + 256 * k;
                f32x4 y = v[u][k] * r * gg4[k];
                if (MODE == 2) { *(f32x4*)(p.xo + (size_t)t * D + col) = y; }
                else {
                    if (MODE == 1) { u32x2 xw; xw.x = cvt_pk_bf16(v[u][k][0], v[u][k][1]); xw.y = cvt_pk_bf16(v[u][k][2], v[u][k][3]); *(u32x2*)(p.xb + (size_t)t * D + col) = xw; }
                    y = y * (1.f + sc4[k]) + sh4[k];
                    u32x2 o; o.x = cvt_pk_bf16(y[0], y[1]); o.y = cvt_pk_bf16(y[2], y[3]);
                    *(u32x2*)(p.h + (size_t)t * D + col) = o;
                }
            }
        }
    }
}
}

namespace {
using pg8::Unit;
struct EpiStoreBf16 {
    static constexpr bool PERM = true;
    bf16_t* O; int ldc;
    __device__ __forceinline__ void operator()(const f32x4 (&acc)[2][2][4][2], const Unit& u, int wr, int wc, int fr_, int fq_) const {
        int fr = fr_, fq = fq_; asm volatile("" : "+v"(fr), "+v"(fq));
        const int row0 = u.pm * 256 + wr * 64 + fr, col0 = u.pn * 256 + wc * 32 + 8 * fq;
#pragma unroll
        for (int ai = 0; ai < 2; ++ai)
#pragma unroll
            for (int m = 0; m < 4; ++m) { bf16_t* rowp = O + (size_t)(row0 + ai * 128 + m * 16) * ldc + col0;
#pragma unroll
                for (int bj = 0; bj < 2; ++bj) { const f32x4 v0 = acc[ai][bj][m][0], v1 = acc[ai][bj][m][1];
                    u32x4 w; w.x = cvt_pk_bf16(v0[0], v0[1]); w.y = cvt_pk_bf16(v0[2], v0[3]); w.z = cvt_pk_bf16(v1[0], v1[1]); w.w = cvt_pk_bf16(v1[2], v1[3]);
                    *(u32x4*)(rowp + bj * 128) = w; } }
    }
};
struct EpiResidual {
    static constexpr bool PERM = false;
    const float* xin32; bf16_t* xb; const float* gate;
    __device__ __forceinline__ void operator()(const f32x4 (&acc)[2][2][4][2], const Unit& u, int wr, int wc, int fr_, int fq_) const {
        int fr = fr_, fq = fq_; asm volatile("" : "+v"(fr), "+v"(fq));
        const int row0 = u.pm * 256 + wr * 64 + fr, col0 = u.pn * 256 + wc * 32 + 4 * fq;
        const int b = (u.pm * 256) >> 11;
        f32x4 gv[2][2];
#pragma unroll
        for (int bj = 0; bj < 2; ++bj)
#pragma unroll
            for (int n = 0; n < 2; ++n) gv[bj][n] = *(const f32x4*)(gate + (size_t)b * NMOD + col0 + bj * 128 + n * 16);
#pragma unroll
        for (int ai = 0; ai < 2; ++ai)
#pragma unroll
            for (int m = 0; m < 4; ++m) { const size_t ro = (size_t)(row0 + ai * 128 + m * 16) * D + col0;
#pragma unroll
                for (int bj = 0; bj < 2; ++bj)
#pragma unroll
                    for (int n = 0; n < 2; ++n) { const size_t o = ro + bj * 128 + n * 16;
                        f32x4 xv;
                        if (xin32) xv = *(const f32x4*)(xin32 + o);
                        else { const u32x2 w = *(const u32x2*)(xb + o); xv = (f32x4){bflo(w.x), bfhi(w.x), bflo(w.y), bfhi(w.y)}; }
                        const f32x4 r = xv + gv[bj][n] * acc[ai][bj][m][n];
                        u32x2 ow; ow.x = cvt_pk_bf16(r[0], r[1]); ow.y = cvt_pk_bf16(r[2], r[3]);
                        *(u32x2*)(xb + o) = ow; } }
    }
};
struct EpiMlaQ {
    static constexpr bool PERM = true;
    bf16_t* qm;
    __device__ __forceinline__ void operator()(const f32x4 (&acc)[2][2][4][2], const Unit& u, int wr, int wc, int fr_, int fq_) const {
        int fr = fr_, fq = fq_; asm volatile("" : "+v"(fr), "+v"(fq));
        const int row0 = u.pm * 256 + wr * 64 + fr;
#pragma unroll
        for (int bj = 0; bj < 2; ++bj) {
            const int col0 = u.pn * 256 + bj * 128 + wc * 32;
            if (col0 >= 384) continue;
#pragma unroll
            for (int ai = 0; ai < 2; ++ai)
#pragma unroll
                for (int m = 0; m < 4; ++m) { const f32x4 v0 = acc[ai][bj][m][0], v1 = acc[ai][bj][m][1];
                    u32x4 w; w.x = cvt_pk_bf16(v0[0], v0[1]); w.y = cvt_pk_bf16(v0[2], v0[3]); w.z = cvt_pk_bf16(v1[0], v1[1]); w.w = cvt_pk_bf16(v1[2], v1[3]);
                    *(u32x4*)(qm + (size_t)(row0 + ai * 128 + m * 16) * 384 + col0 + 8 * fq) = w; }
        }
    }
};
struct EpiMlaKV {
    static constexpr bool PERM = true;
    bf16_t* km; bf16_t* vm;
    __device__ __forceinline__ void operator()(const f32x4 (&acc)[2][2][4][2], const Unit& u, int wr, int wc, int fr_, int fq_) const {
        int fr = fr_, fq = fq_; asm volatile("" : "+v"(fr), "+v"(fq));
        const int row0 = u.pm * 256 + wr * 64 + fr;
#pragma unroll
        for (int bj = 0; bj < 2; ++bj) {
            const int head = u.pn * 2 + bj, wcol = wc * 32 + 8 * fq;
#pragma unroll
            for (int ai = 0; ai < 2; ++ai)
#pragma unroll
                for (int m = 0; m < 4; ++m) {
                    const int row = row0 + ai * 128 + m * 16;
                    const f32x4 v0 = acc[ai][bj][m][0], v1 = acc[ai][bj][m][1];
                    u32x4 w; w.x = cvt_pk_bf16(v0[0], v0[1]); w.y = cvt_pk_bf16(v0[2], v0[3]); w.z = cvt_pk_bf16(v1[0], v1[1]); w.w = cvt_pk_bf16(v1[2], v1[3]);
                    bf16_t* q = (wcol < 64) ? km + (size_t)row * 384 + head * 96 + wcol : vm + (size_t)row * 256 + head * 64 + (wcol - 64);
                    *(u32x4*)q = w;
                    asm volatile("" ::: "memory");
                }
        }
    }
};
struct EpiGateUp {
    static constexpr bool PERM = false;
    bf16_t* hid;
    __device__ __forceinline__ void operator()(const f32x4 (&acc)[2][2][4][2], const Unit& u, int wr, int wc, int fr_, int fq_) const {
        int fr = fr_, fq = fq_; asm volatile("" : "+v"(fr), "+v"(fq));
        const int row0 = u.pm * 256 + wr * 64 + fr;
#pragma unroll
        for (int ai = 0; ai < 2; ++ai)
#pragma unroll
            for (int m = 0; m < 4; ++m) { bf16_t* rowp = hid + (size_t)(row0 + ai * 128 + m * 16) * 256;
#pragma unroll
                for (int bj = 0; bj < 2; ++bj) { const f32x4 gt = acc[ai][bj][m][0], up = acc[ai][bj][m][1];
                    f32x4 o;
#pragma unroll
                    for (int j = 0; j < 4; ++j) o[j] = gt[j] / (1.f + __expf(-gt[j])) * up[j];
                    u32x2 w; w.x = cvt_pk_bf16(o[0], o[1]); w.y = cvt_pk_bf16(o[2], o[3]);
                    *(u32x2*)(rowp + 16 * (u.pn * 8 + bj * 4 + wc) + 4 * fq) = w; } }
    }
};
struct EpiDown {
    static constexpr bool PERM = true;
    bf16_t* ys; const int* list; const float* wl; const int* cnt;
    __device__ __forceinline__ void operator()(const f32x4 (&acc)[2][2][4][2], const Unit& u, int wr, int wc, int fr_, int fq_) const {
        int fr = fr_, fq = fq_; asm volatile("" : "+v"(fr), "+v"(fq));
        const int n = cnt[u.e]; const int* le = list + (size_t)u.e * ECAP; const float* we = wl + (size_t)u.e * ECAP;
        const int col0 = u.pn * 256 + wc * 32 + 8 * fq;
        int slot[8]; float w8[8];
#pragma unroll
        for (int q = 0; q < 8; ++q) { const int lr = u.mt * 256 + (q >> 2) * 128 + wr * 64 + (q & 3) * 16 + fr; slot[q] = lr < n ? le[lr] : -1; w8[q] = lr < n ? we[lr] : 0.f; }
#pragma unroll
        for (int ai = 0; ai < 2; ++ai)
#pragma unroll
            for (int m = 0; m < 4; ++m) {
                const int q = ai * 4 + m;
                if (slot[q] >= 0) {
                    bf16_t* rowp = ys + (size_t)slot[q] * D + col0;
#pragma unroll
                    for (int bj = 0; bj < 2; ++bj) { const f32x4 v0 = acc[ai][bj][m][0] * w8[q], v1 = acc[ai][bj][m][1] * w8[q];
                        u32x4 w; w.x = cvt_pk_bf16(v0[0], v0[1]); w.y = cvt_pk_bf16(v0[2], v0[3]); w.z = cvt_pk_bf16(v1[0], v1[1]); w.w = cvt_pk_bf16(v1[2], v1[3]);
                        *(u32x4*)(rowp + bj * 128) = w; }
                }
            }
    }
};
struct MoeOrder {
    int pre[17];
    int NT, G, c; const int* list; const int* cnt;
    __device__ __forceinline__ void init(const int* cnt_, const int* list_, int NT_, int G_, int c_) {
        cnt = cnt_; list = list_; NT = NT_; G = G_; c = c_; int a = 0;
#pragma unroll
        for (int e = 0; e < 16; ++e) { pre[e] = a; a += (cnt_[e] + 255) >> 8; }
        pre[16] = a;
    }
    __device__ __forceinline__ bool next(int i, Unit& u) const {
        const int L = i * G + c; if (L >= pre[16] * NT) return false;
        const int t = L / NT; int e = 0;
#pragma unroll
        for (int k = 1; k < 16; ++k) e += (t >= pre[k]) ? 1 : 0;
        int pe = 0;
#pragma unroll
        for (int k = 0; k < 16; ++k) pe = (k == e) ? pre[k] : pe;
        u.e = e; u.mt = t - pe; u.pm = t; u.pn = L - t * NT; return true;
    }
    __device__ __forceinline__ int arow(const Unit& u, int r) const { const int lr = u.mt * 256 + r; return lr < cnt[u.e] ? (list[(size_t)u.e * ECAP + lr] >> 1) : 0; }
};
}

namespace {
__device__ __forceinline__ void phase_prep(const Params& p, int l) {
    const int tid = opaque_tid(p.wid), w = tid >> 6, lane = tid & 63;
    const int gw = blockIdx.x * 8 + w, nw = gridDim.x * 8;
    for (int sq = gw; sq < NB * 4; sq += nw) {
        const int b = sq >> 2, hh = sq & 3; const float bias = p.b_forget[l * 4 + hh];
        float lf[32]; float run = 0.f;
#pragma unroll
        for (int j = 0; j < 32; ++j) {
            const float z = bf2f(p.proj[(size_t)(b * S + lane * 32 + j) * NP + PC_AF + hh]) + bias;
            run += fminf(z, 0.f) - log1pf(__expf(-fabsf(z)));
            lf[j] = run;
        }
        float incl = run;
#pragma unroll
        for (int o = 1; o < 64; o <<= 1) { const float t2 = __shfl_up(incl, o); if (lane >= o) incl += t2; }
        const float excl = incl - run;
#pragma unroll
        for (int j = 0; j < 32; ++j) p.cbF[(size_t)sq * S + lane * 32 + j] = -(excl + lf[j]) * LOG2E;
    }
    for (int c32 = gw; c32 < T / 32; c32 += nw) {
    float mxq = 0.f, mxk = 0.f;
#define PREP_LOAD(tt) do { const bf16_t* _row = p.proj + (size_t)(tt) * NP; \
        n_cq = *(const u32x2*)(_row + PC_BCQ + 4 * lane); n_ck = *(const unsigned*)(_row + PC_BCKV + 2 * lane); \
        n_aq = *(const u32x2*)(_row + PC_AQ + 4 * lane); n_ak = *(const u32x2*)(_row + PC_AK + 4 * lane); \
        n_ki = *(const u32x4*)(_row + PC_DKI + 8 * (lane & 3)); n_kr = _row[PC_BKR + (lane & 31)]; } while (0)
    u32x2 n_cq, n_aq, n_ak; unsigned n_ck; u32x4 n_ki; bf16_t n_kr;
    PREP_LOAD(c32 * 32);
    for (int it = 0; it < 32; ++it) {
        const int t = c32 * 32 + it;
        const u32x2 cq = n_cq, aq = n_aq, ak = n_ak; const unsigned ck = n_ck; const u32x4 ki = n_ki; const bf16_t krb = n_kr;
        if (it < 31) PREP_LOAD(t + 1);
        float s1 = bflo(cq.x) * bflo(cq.x) + bfhi(cq.x) * bfhi(cq.x) + bflo(cq.y) * bflo(cq.y) + bfhi(cq.y) * bfhi(cq.y);
        float s2 = bflo(ck) * bflo(ck) + bfhi(ck) * bfhi(ck);
        s1 = wave_sum(s1); s2 = wave_sum(s2);
        if (lane < 4) *(u32x4*)(p.kidx + (size_t)t * 32 + 8 * lane) = ki;
        {
            float nq = bflo(aq.x) * bflo(aq.x) + bfhi(aq.x) * bfhi(aq.x) + bflo(aq.y) * bflo(aq.y) + bfhi(aq.y) * bfhi(aq.y);
            float nk = bflo(ak.x) * bflo(ak.x) + bfhi(ak.x) * bfhi(ak.x) + bflo(ak.y) * bflo(ak.y) + bfhi(ak.y) * bfhi(ak.y);
#pragma unroll
            for (int o = 8; o > 0; o >>= 1) { nq += __shfl_xor(nq, o); nk += __shfl_xor(nk, o); }
            mxq = fmaxf(mxq, nq); mxk = fmaxf(mxk, nk);
        }
        const float kr = (lane < 32) ? bf2f(krb) : 0.f;
        const float kr2 = __shfl(kr, (lane + 16) & 63);
        {
            const float r1 = rsqrtf(s1 * (1.f / 256.f) + EPS), r2 = rsqrtf(s2 * (1.f / 128.f) + EPS);
            u32x2 o; o.x = cvt_pk_bf16(bflo(cq.x) * r1, bfhi(cq.x) * r1); o.y = cvt_pk_bf16(bflo(cq.y) * r1, bfhi(cq.y) * r1);
            *(u32x2*)(p.proj + (size_t)t * NP + PC_BCQ + 4 * lane) = o;
            *(unsigned*)(p.proj + (size_t)t * NP + PC_BCKV + 2 * lane) = cvt_pk_bf16(bflo(ck) * r2, bfhi(ck) * r2);
        }
        if (lane < 16) {
            const int pos = t & (S - 1);
            const float cs = p.ropetab[(pos * 16 + lane) * 2], sn = p.ropetab[(pos * 16 + lane) * 2 + 1];
            const bf16_t o1 = f2bf(kr * cs - kr2 * sn), o2 = f2bf(kr2 * cs + kr * sn);
            bf16_t* kmr = p.km + (size_t)t * 384;
#pragma unroll
            for (int hh = 0; hh < 4; ++hh) { kmr[hh * 96 + 64 + lane] = o1; kmr[hh * 96 + 80 + lane] = o2; }
        }
    }
#undef PREP_LOAD
    if ((lane & 15) == 0) {
        const int t = c32 * 32, bb = t >> 11, pos = t & (S - 1), hh = lane >> 4;
        atomicMax(p.ctl + CW_KN2 + ((l * NB + bb) * 4 + hh) * 32 + (pos >> 6), __float_as_uint(mxk));
        atomicMax(p.ctl + CW_QN2 + ((l * NB + bb) * 4 + hh) * 8 + (pos >> 8), __float_as_uint(mxq));
    }
    }
}

__device__ __forceinline__ void phase_route(const Params& p, int l, char* lds) {
    const int tid = opaque_tid(p.wid), w = tid >> 6, lane = tid & 63;
    float* wrT = (float*)lds;
    int* lcnt = (int*)(lds + 65536);
    int* lbase = (int*)(lds + 65536 + 64);
    int* tsel = (int*)(lds + 65536 + 128);
    float* twt = (float*)(lds + 65536 + 128 + 2048);
    float* lgt = (float*)(lds + 65536 + 8192);
    for (int i = tid; i < 16 * 1024; i += 512) { const int e = i >> 10, d = i & 1023; wrT[i] = p.w_router[d * 16 + e]; }
    const float* g = p.g_norm2 + l * D;
    const float* modl = p.mod + (size_t)l * NB * NMOD;
    int* cnt = (int*)(p.ctl + CW_CNT) + l * 16 + 32 * p.qslot;
    int* list = p.list + (size_t)p.qslot * 16 * ECAP;
    for (int chunk = blockIdx.x; chunk < T / 256; chunk += gridDim.x) {
        if (tid < 16) lcnt[tid] = 0;
        __syncthreads();
        const int b = (chunk * 256) >> 11;
        f32x4 gs4[4], sh4[4];
#pragma unroll
        for (int k = 0; k < 4; ++k) { const int col = 4 * lane + 256 * k; const f32x4 gg = *(const f32x4*)(g + col);
            const f32x4 sc = *(const f32x4*)(modl + (size_t)b * NMOD + 4 * 1024 + col); gs4[k] = gg * (1.f + sc); sh4[k] = *(const f32x4*)(modl + (size_t)b * NMOD + 3 * 1024 + col); }
        const int eown = ((lane >> 5) & 1) * 8 + ((lane >> 4) & 1) * 4 + ((lane >> 3) & 1) * 2 + ((lane >> 2) & 1);
        u32x2 raw[2][4];
#pragma unroll
        for (int q = 0; q < 2; ++q)
#pragma unroll
            for (int k = 0; k < 4; ++k) raw[q][k] = *(const u32x2*)(p.xb + (size_t)(chunk * 256 + w * 32 + q) * D + 4 * lane + 256 * k);
        for (int it = 0; it < 32; it += 2) {
            const int li = w * 32 + it, t = chunk * 256 + li;
            f32x4 v[2][4];
#pragma unroll
            for (int q = 0; q < 2; ++q)
#pragma unroll
                for (int k = 0; k < 4; ++k) v[q][k] = (f32x4){bflo(raw[q][k].x), bfhi(raw[q][k].x), bflo(raw[q][k].y), bfhi(raw[q][k].y)};
            if (it < 30) {
#pragma unroll
                for (int q = 0; q < 2; ++q)
#pragma unroll
                    for (int k = 0; k < 4; ++k) raw[q][k] = *(const u32x2*)(p.xb + (size_t)(t + 2 + q) * D + 4 * lane + 256 * k);
            }
            float ss0 = 0.f, ss1 = 0.f;
#pragma unroll
            for (int k = 0; k < 4; ++k) { ss0 += v[0][k][0] * v[0][k][0] + v[0][k][1] * v[0][k][1] + v[0][k][2] * v[0][k][2] + v[0][k][3] * v[0][k][3];
                                          ss1 += v[1][k][0] * v[1][k][0] + v[1][k][1] * v[1][k][1] + v[1][k][2] * v[1][k][2] + v[1][k][3] * v[1][k][3]; }
            ss0 = wave_sum(ss0); ss1 = wave_sum(ss1);
            const float r0 = rsqrtf(ss0 * (1.0f / D) + EPS), r1 = rsqrtf(ss1 * (1.0f / D) + EPS);
            f32x2 lgp[16];
#pragma unroll
            for (int e = 0; e < 16; ++e) lgp[e] = (f32x2){0.f, 0.f};
#pragma unroll
            for (int k = 0; k < 4; ++k) {
                const int col = 4 * lane + 256 * k;
                const f32x4 y0 = v[0][k] * r0 * gs4[k] + sh4[k], y1 = v[1][k] * r1 * gs4[k] + sh4[k];
                u32x2 o0, o1; o0.x = cvt_pk_bf16(y0[0], y0[1]); o0.y = cvt_pk_bf16(y0[2], y0[3]); o1.x = cvt_pk_bf16(y1[0], y1[1]); o1.y = cvt_pk_bf16(y1[2], y1[3]);
                *(u32x2*)(p.h + (size_t)t * D + col) = o0; *(u32x2*)(p.h + (size_t)(t + 1) * D + col) = o1;
                const f32x2 yp0 = {y0[0], y1[0]}, yp1 = {y0[1], y1[1]}, yp2 = {y0[2], y1[2]}, yp3 = {y0[3], y1[3]};
#pragma unroll
                for (int e = 0; e < 16; ++e) { const f32x4 wv = *(const f32x4*)(wrT + e * 1024 + col);
                    lgp[e] = __builtin_elementwise_fma(yp0, (f32x2){wv[0], wv[0]}, lgp[e]); lgp[e] = __builtin_elementwise_fma(yp1, (f32x2){wv[1], wv[1]}, lgp[e]);
                    lgp[e] = __builtin_elementwise_fma(yp2, (f32x2){wv[2], wv[2]}, lgp[e]); lgp[e] = __builtin_elementwise_fma(yp3, (f32x2){wv[3], wv[3]}, lgp[e]); }
                asm volatile("" ::: "memory");
            }
#pragma unroll
            for (int q = 0; q < 2; ++q) {
                float lg[16];
#pragma unroll
                for (int e = 0; e < 16; ++e) lg[e] = lgp[e][q];
                float a8[8], a4[4], a2[2], a1;
                { const bool hi = (lane & 32) != 0;
#pragma unroll
                  for (int e = 0; e < 8; ++e) { const float send = hi ? lg[e] : lg[e + 8], keep = hi ? lg[e + 8] : lg[e]; a8[e] = keep + __shfl_xor(send, 32); } }
                { const bool hi = (lane & 16) != 0;
#pragma unroll
                  for (int e = 0; e < 4; ++e) { const float send = hi ? a8[e] : a8[e + 4], keep = hi ? a8[e + 4] : a8[e]; a4[e] = keep + __shfl_xor(send, 16); } }
                { const bool hi = (lane & 8) != 0;
#pragma unroll
                  for (int e = 0; e < 2; ++e) { const float send = hi ? a4[e] : a4[e + 2], keep = hi ? a4[e + 2] : a4[e]; a2[e] = keep + __shfl_xor(send, 8); } }
                { const bool hi = (lane & 4) != 0; const float send = hi ? a2[0] : a2[1], keep = hi ? a2[1] : a2[0]; a1 = keep + __shfl_xor(send, 4); }
                a1 += __shfl_xor(a1, 2); a1 += __shfl_xor(a1, 1);
                if ((lane & 3) == 0) lgt[(li + q) * 16 + eown] = a1;
            }
        }
        asm volatile("s_waitcnt lgkmcnt(0)" ::: "memory");
        __builtin_amdgcn_wave_barrier();
        if (lane < 32) {
            const int li = w * 32 + lane;
            float sc[16], bi[16];
#pragma unroll
            for (int e4 = 0; e4 < 4; ++e4) { const f32x4 a = *(const f32x4*)(lgt + li * 16 + 4 * e4);
#pragma unroll
                for (int j = 0; j < 4; ++j) { const float sg = 1.f / (1.f + expf(-a[j])); sc[4 * e4 + j] = sg; bi[4 * e4 + j] = sg + p.b_router[4 * e4 + j]; } }
            int bg = 0; float bgs = -INFINITY;
#pragma unroll
            for (int gi = 0; gi < 4; ++gi) {
                float m1 = -INFINITY, m2 = -INFINITY;
#pragma unroll
                for (int j = 0; j < 4; ++j) { const float vv = bi[gi * 4 + j]; if (vv > m1) { m2 = m1; m1 = vv; } else if (vv > m2) m2 = vv; }
                const float gs = m1 + m2; if (gs > bgs) { bgs = gs; bg = gi; }
            }
            float b4[4], s4[4];
#pragma unroll
            for (int j = 0; j < 4; ++j) { b4[j] = bi[j]; s4[j] = sc[j]; }
#pragma unroll
            for (int gi = 1; gi < 4; ++gi)
#pragma unroll
                for (int j = 0; j < 4; ++j) { b4[j] = (gi == bg) ? bi[gi * 4 + j] : b4[j]; s4[j] = (gi == bg) ? sc[gi * 4 + j] : s4[j]; }
            int i1 = 0; float v1 = -INFINITY;
#pragma unroll
            for (int j = 0; j < 4; ++j) { if (b4[j] > v1) { v1 = b4[j]; i1 = j; } }
            int i2 = 0; float v2 = -INFINITY;
#pragma unroll
            for (int j = 0; j < 4; ++j) { if (j != i1 && b4[j] > v2) { v2 = b4[j]; i2 = j; } }
            float w1 = 0.f, w2 = 0.f;
#pragma unroll
            for (int j = 0; j < 4; ++j) { w1 = (j == i1) ? s4[j] : w1; w2 = (j == i2) ? s4[j] : w2; }
            const int e1 = bg * 4 + i1, e2 = bg * 4 + i2; const float ws = w1 + w2;
            const int r1 = atomicAdd(&lcnt[e1], 1), r2 = atomicAdd(&lcnt[e2], 1);
            tsel[li * 2 + 0] = (e1 << 16) | r1; tsel[li * 2 + 1] = (e2 << 16) | r2;
            twt[li * 2 + 0] = w1 / ws; twt[li * 2 + 1] = w2 / ws;
        }
        __syncthreads();
        if (tid < 16) lbase[tid] = atomicAdd(&cnt[tid], lcnt[tid]);
        __syncthreads();
        { const int v = tsel[tid], e = v >> 16, rk = v & 0xFFFF; const size_t pos = (size_t)e * ECAP + lbase[e] + rk;
          list[pos] = (chunk * 256 + (tid >> 1)) * 2 + (tid & 1); p.wl[pos + (size_t)p.qslot * 16 * ECAP] = twt[tid]; }
        __syncthreads();
    }
}
}

#ifndef ATTN_VMASK
#define ATTN_VMASK 15
#endif
#ifndef REPK_VMASK
#define REPK_VMASK 15
#endif
#ifndef ATTN_DMA
#define ATTN_DMA 1
#endif
#ifndef ATTN_EXP
#define ATTN_EXP 0
#endif
#define AEXP(k) (ATTN_EXP == (k) && xq)
namespace {
constexpr int AT_KB = 0;
constexpr int AT_KR = 16384;
constexpr int AT_VB = 24576;
constexpr int AT_CB = 40960;
constexpr int AT_CTL = 41472;
constexpr int AT_LDS = 41984;
constexpr float NEGBIG = -1.0e30f;

template <int VAR, int KC, bool FULL>
__device__ __forceinline__ void attn_tile_impl(LAS3 char* lds, const int buf, const int j, const int q0, const int i, const int g, const int swk, const float slope2,
                                          const bf16x8 (&qf)[2][KC], f32x4 (&o)[2][4], float (&mrow)[2], float (&lsum)[2], const u32x4 (&mwd)[2][4], const bool xq) {
    typedef LAS3 bf16x4 lds_bf16x4;
    bool need = (64 * j <= q0 + 31);
    if (VAR == 2) need = need && (64 * j + 63 >= q0 - 127);
    if (need) {
        const LAS3 char* Kb = lds + AT_KB + buf * 8192; const LAS3 char* Vb = lds + AT_VB + buf * 8192;
        constexpr bool full = FULL;
        f32x4 s[2][4];
#pragma unroll
        for (int qt = 0; qt < 2; ++qt) {
            const int t = q0 + 16 * qt + i;
            const int dbase = 64 * j + 4 * g - t;
            const float sb = slope2 * ((VAR == 2) ? (float)dbase : (float)(64 * j + 4 * g));
#pragma unroll
            for (int mt = 0; mt < 4; ++mt) {
                f32x4 ini = {0.f, 0.f, 0.f, 0.f};
                if (VAR == 0) ini = *(const LAS3 f32x4*)(lds + AT_CB + buf * 256 + (16 * mt + 4 * g) * 4);
#pragma unroll
                for (int r = 0; r < 4; ++r) {
                    const int c = 16 * mt + r;
                    float v = ini[r];
                    if (VAR >= 2) v = sb + slope2 * (float)c;
                    if (VAR == 3) {
                        const int m = ((int)(mwd[qt][mt][r] << (31 - j))) >> 31;
                        v = __uint_as_float((__float_as_uint(v) & (unsigned)m) | (__float_as_uint(NEGBIG) & ~(unsigned)m));
                    } else if (!full) {
                        bool ok;
                        if (VAR == 2) ok = (unsigned)(dbase + c + 127) < 128u;
                        else ok = (dbase + c) <= 0;
                        v = ok ? v : NEGBIG;
                    }
                    ini[r] = v;
                }
                s[qt][mt] = ini;
            }
        }
        if (!AEXP(2))
#pragma unroll
        for (int mt = 0; mt < 4; ++mt) {
#pragma unroll
            for (int kc = 0; kc < 2; ++kc) {
                const bf16x8 kf = AEXP(7) ? qf[0][kc] : *(const LAS3 bf16x8*)(Kb + (mt * 16 + i) * 128 + (((kc * 4 + g) ^ swk) << 4));
                s[0][mt] = __builtin_amdgcn_mfma_f32_16x16x32_bf16(kf, qf[0][kc], s[0][mt], 0, 0, 0);
                s[1][mt] = __builtin_amdgcn_mfma_f32_16x16x32_bf16(kf, qf[1][kc], s[1][mt], 0, 0, 0);
            }
            if (VAR == 1) {
                const bf16x8 kf = *(const LAS3 bf16x8*)(lds + AT_KR + buf * 4096 + (mt * 16 + i) * 64 + ((g ^ (swk & 3)) << 4));
                s[0][mt] = __builtin_amdgcn_mfma_f32_16x16x32_bf16(kf, qf[0][KC - 1], s[0][mt], 0, 0, 0);
                s[1][mt] = __builtin_amdgcn_mfma_f32_16x16x32_bf16(kf, qf[1][KC - 1], s[1][mt], 0, 0, 0);
            }
        }
        bf16x8 pf[2][2];
#pragma unroll
        for (int qt = 0; qt < 2; ++qt) {
            float mx = AEXP(6) ? 0.f : fmaxf(fmaxf(s[qt][0][0], s[qt][0][1]), fmaxf(s[qt][0][2], s[qt][0][3]));
            if (!AEXP(6)) {
#pragma unroll
            for (int mt = 1; mt < 4; ++mt) mx = fmaxf(mx, fmaxf(fmaxf(s[qt][mt][0], s[qt][mt][1]), fmaxf(s[qt][mt][2], s[qt][mt][3])));
            mx = fmaxf(mx, __builtin_bit_cast(float, __builtin_amdgcn_ds_swizzle(__builtin_bit_cast(int, mx), 0x401F)));
            mx = xor32_max(mx);
            if (__any(mx > mrow[qt])) {
                const float mn = fmaxf(mrow[qt], mx), alpha = __builtin_amdgcn_exp2f(mrow[qt] - mn);
                mrow[qt] = mn; lsum[qt] *= alpha;
#pragma unroll
                for (int dt = 0; dt < 4; ++dt) o[qt][dt] = o[qt][dt] * alpha;
            }
            }
            const float mn = mrow[qt];
            const f32x4 mn4 = {mn, mn, mn, mn};
            f32x4 ps4 = {0.f, 0.f, 0.f, 0.f};
            float x[4][4];
#pragma unroll
            for (int mt = 0; mt < 4; ++mt) {
                const f32x4 d4 = s[qt][mt] - mn4;
                f32x4 e4;
#pragma unroll
                for (int r = 0; r < 4; ++r) { e4[r] = (AEXP(3) || AEXP(6)) ? d4[r] : __builtin_amdgcn_exp2f(d4[r]); x[mt][r] = e4[r]; }
                ps4 += e4;
            }
            lsum[qt] += (ps4[0] + ps4[1]) + (ps4[2] + ps4[3]);
#pragma unroll
            for (int c = 0; c < 2; ++c) {
                u32x4 pk; pk.x = cvt_pk_bf16(x[2 * c][0], x[2 * c][1]); pk.y = cvt_pk_bf16(x[2 * c][2], x[2 * c][3]);
                pk.z = cvt_pk_bf16(x[2 * c + 1][0], x[2 * c + 1][1]); pk.w = cvt_pk_bf16(x[2 * c + 1][2], x[2 * c + 1][3]);
                pf[qt][c] = __builtin_bit_cast(bf16x8, pk);
            }
        }
        const int q4 = i >> 2, p4 = i & 3;
        if (!AEXP(4))
#pragma unroll
        for (int c = 0; c < 2; ++c) {
            const int row0 = 32 * c + 4 * g + q4, swv = (row0 >> 1) & 3;
#pragma unroll
            for (int dt = 0; dt < 4; ++dt) {
                const LAS3 char* a0 = Vb + row0 * 128 + ((dt ^ swv) << 5) + p4 * 8;
                bf16x4 v0, v1;
                if (AEXP(7)) { v0 = (bf16x4){1, 2, 3, 4}; v1 = v0; } else {
                v0 = __builtin_amdgcn_ds_read_tr16_b64_v4i16((lds_bf16x4*)(a0));
                v1 = __builtin_amdgcn_ds_read_tr16_b64_v4i16((lds_bf16x4*)(a0 + 16 * 128)); }
                const bf16x8 vf = {v0[0], v0[1], v0[2], v0[3], v1[0], v1[1], v1[2], v1[3]};
                o[0][dt] = __builtin_amdgcn_mfma_f32_16x16x32_bf16(vf, pf[0][c], o[0][dt], 0, 0, 0);
                o[1][dt] = __builtin_amdgcn_mfma_f32_16x16x32_bf16(vf, pf[1][c], o[1][dt], 0, 0, 0);
            }
        }
    }
}

template <int VAR, int KC>
__device__ __forceinline__ void attn_tile(LAS3 char* lds, const int buf, const int j, const int q0, const int i, const int g, const int swk, const float slope2,
                                          const bf16x8 (&qf)[2][KC], f32x4 (&o)[2][4], float (&mrow)[2], float (&lsum)[2], const u32x4 (&mwd)[2][4], const bool xq) {
    bool full = (64 * j + 63 <= q0);
    if (VAR == 2) full = full && (64 * j >= q0 - 96);
    if (VAR == 3) full = false;
    if (VAR != 3 && full) attn_tile_impl<VAR, KC, true>(lds, buf, j, q0, i, g, swk, slope2, qf, o, mrow, lsum, mwd, xq);
    else attn_tile_impl<VAR, KC, false>(lds, buf, j, q0, i, g, swk, slope2, qf, o, mrow, lsum, mwd, xq);
}

template <int VAR>
__device__ __forceinline__ void attn_unit(const Params& p, int l, int b, int hx, int qb, LAS3 char* lds) {
    typedef LAS3 bf16x4 lds_bf16x4;
    constexpr int KC = (VAR == 1) ? 3 : 2;
    const int tid = opaque_tid(p.wid), w = __builtin_amdgcn_readfirstlane(tid >> 6), lane = tid & 63, i = lane & 15, g = lane >> 4;
    const bf16_t *Qp, *Kp, *Vp; int ldq, ldk, ldv, q0, j0, j1, ocol; float c1, slope2 = 0.f;
    if (VAR == 0) { Qp = p.proj + PC_AQ + hx * 64; Kp = p.proj + PC_AK + hx * 64; Vp = p.proj + PC_AV + hx * 64; ldq = ldk = ldv = NP;
                    q0 = qb * 256 + 32 * w; j0 = 0; j1 = 4 * qb + 3; ocol = hx * 64; c1 = 0.125f * LOG2E; }
    else if (VAR == 1) { Qp = p.qm + hx * 96; Kp = p.km + hx * 96; Vp = p.vm + hx * 64; ldq = 384; ldk = 384; ldv = 256;
                    q0 = qb * 256 + 32 * w; j0 = 0; j1 = 4 * qb + 3; ocol = 256 + hx * 64; c1 = 0.10206207261596577f * LOG2E; }
    else if (VAR == 2) { const int qh = hx * 2 + (w >> 2); Qp = p.proj + PC_CQ + qh * 64; Kp = p.proj + PC_CK + hx * 64; Vp = p.proj + PC_CV + hx * 64; ldq = ldk = ldv = NP;
                    q0 = qb * 128 + 32 * (w & 3); j0 = 2 * qb - 2 > 0 ? 2 * qb - 2 : 0; j1 = 2 * qb + 1; ocol = 512 + qh * 64; c1 = 0.125f * LOG2E;
                    slope2 = exp2f(-(float)(qh + 1)) * LOG2E; }
    else { const int hd = w >> 1; Qp = p.proj + PC_DQ + hd * 64; Kp = p.proj + PC_DK; Vp = p.proj + PC_DV; ldq = ldk = ldv = NP;
                    q0 = qb * 64 + 32 * (w & 1); j0 = 0; j1 = qb; ocol = 768 + hd * 64; c1 = 0.125f * LOG2E; slope2 = exp2f(-(float)(hd + 5)) * LOG2E; }
    const size_t tok0 = (size_t)b * S;
    const bool xq = p.qslot > 0;
    if (VAR == 0 && qb > 0) {
        constexpr float FOX_DROP = 64.0f;
        const unsigned* kn2 = p.ctl + CW_KN2 + ((l * NB + b) * 4 + hx) * 32;
        const float* cbh = p.cbF + ((size_t)b * 4 + hx) * S;
        const float qn = c1 * sqrtf(__uint_as_float(p.ctl[CW_QN2 + ((l * NB + b) * 4 + hx) * 8 + qb]));
        float knu = 0.f;
        for (int jj = 4 * qb; jj < 4 * qb + 4; ++jj) knu = fmaxf(knu, __uint_as_float(kn2[jj]));
        const float lower = cbh[256 * qb] - qn * sqrtf(knu);
        const int jl = lane & 31;
        const bool keep = qn * sqrtf(__uint_as_float(kn2[jl])) + cbh[64 * jl + 63] - lower >= -FOX_DROP || jl >= 4 * qb;
        const unsigned long long kb = __ballot(keep) & 0xFFFFFFFFull;
        j0 = kb ? (int)__builtin_ctzll(kb) : 4 * qb;
    }
    bf16x8 qf[2][KC];
#pragma unroll
    for (int qt = 0; qt < 2; ++qt)
#pragma unroll
        for (int kc = 0; kc < KC; ++kc) qf[qt][kc] = *(const bf16x8*)(Qp + (tok0 + q0 + 16 * qt + i) * ldq + kc * 32 + 8 * g);
    u32x4 mwd[2][4];
#pragma unroll
    for (int qt = 0; qt < 2; ++qt)
#pragma unroll
        for (int mt = 0; mt < 4; ++mt) mwd[qt][mt] = (VAR == 3) ? *(const u32x4*)(p.mask + (tok0 + q0 + 16 * qt + i) * 64 + 16 * mt + 4 * g) : (u32x4){0u, 0u, 0u, 0u};
#if ATTN_DMA
    const int drow = 8 * w + (lane >> 3), dch = lane & 7;
    const int ksc = dch ^ ((drow >> 1) & 7);
    const int vsc = ((((dch >> 1) ^ ((drow >> 1) & 3)) << 1) | (dch & 1));
    const int rrow = 16 * (w & 3) + (lane >> 2), rsc = (lane & 3) ^ ((rrow >> 1) & 3);
#define AT_DMA(j, buf) do { \
        __builtin_amdgcn_global_load_lds((const unsigned*)(Kp + (tok0 + 64 * (j) + drow) * ldk + ksc * 8), (LAS3 unsigned*)(lds + AT_KB + (buf) * 8192 + w * 1024), 16, 0, 0); \
        __builtin_amdgcn_global_load_lds((const unsigned*)(Vp + (tok0 + 64 * (j) + drow) * ldv + vsc * 8), (LAS3 unsigned*)(lds + AT_VB + (buf) * 8192 + w * 1024), 16, 0, 0); \
        if (VAR == 1 && w < 4) __builtin_amdgcn_global_load_lds((const unsigned*)(Kp + (tok0 + 64 * (j) + rrow) * ldk + 64 + rsc * 8), (LAS3 unsigned*)(lds + AT_KR + (buf) * 4096 + w * 1024), 16, 0, 0); \
        if (VAR == 0 && w == 0) __builtin_amdgcn_global_load_lds((const unsigned*)(p.cbF + ((size_t)b * 4 + hx) * S + 64 * (j) + lane), (LAS3 unsigned*)(lds + AT_CB + (buf) * 256), 4, 0, 0); \
    } while (0)
    AT_DMA(j0, j0 & 1);
#else
    const int sr = tid >> 3, sc8 = tid & 7;
    const int kdst = sr * 128 + ((sc8 ^ ((sr >> 1) & 7)) << 4);
    const int vdst = sr * 128 + (((((sc8 >> 1) ^ ((sr >> 1) & 3)) << 1) | (sc8 & 1)) << 4);
    const int rr = (tid & 255) >> 2, rc4 = tid & 3;
    const int rdst = rr * 64 + ((rc4 ^ ((rr >> 1) & 3)) << 4);
    u32x4 kstA, vstA, rstA = {0u, 0u, 0u, 0u}, kstB, vstB, rstB = {0u, 0u, 0u, 0u}; float cstA = 0.f, cstB = 0.f;
#define AT_LOAD(ZZ, j) do { if (AEXP(1)) break; const size_t _kr = tok0 + 64 * (j) + sr; \
        kst##ZZ = *(const u32x4*)(Kp + _kr * ldk + sc8 * 8); vst##ZZ = *(const u32x4*)(Vp + _kr * ldv + sc8 * 8); \
        if (VAR == 1) rst##ZZ = *(const u32x4*)(Kp + (tok0 + 64 * (j) + rr) * ldk + 64 + rc4 * 8); \
        if (VAR == 0) cst##ZZ = p.cbF[((size_t)b * 4 + hx) * S + 64 * (j) + (tid & 63)]; } while (0)
#define AT_WRITE(ZZ, buf) do { if (AEXP(1)) break; *(LAS3 u32x4*)(lds + AT_KB + (buf) * 8192 + kdst) = kst##ZZ; *(LAS3 u32x4*)(lds + AT_VB + (buf) * 8192 + vdst) = vst##ZZ; \
        if (VAR == 1 && tid < 256) *(LAS3 u32x4*)(lds + AT_KR + (buf) * 4096 + rdst) = rst##ZZ; \
        if (VAR == 0 && tid < 64) *(LAS3 float*)(lds + AT_CB + (buf) * 256 + tid * 4) = cst##ZZ; } while (0)
    AT_LOAD(A, j0);
    AT_LOAD(B, (j0 + 1 <= j1 ? j0 + 1 : j1));
#endif
    if (VAR == 1) {
#pragma unroll
        for (int qt = 0; qt < 2; ++qt) {
            const int pos = q0 + 16 * qt + i;
            const u32x4 mine = __builtin_bit_cast(u32x4, qf[qt][KC - 1]);
            u32x4 oth; oth.x = __shfl_xor(mine.x, 32); oth.y = __shfl_xor(mine.y, 32); oth.z = __shfl_xor(mine.z, 32); oth.w = __shfl_xor(mine.w, 32);
            const float* rt = p.ropetab + (size_t)(pos * 16 + (g & 1) * 8) * 2;
            const float sg = (g < 2) ? -1.f : 1.f;
            u32x4 res;
#pragma unroll
            for (int e2 = 0; e2 < 4; ++e2) {
                const f32x4 cs = *(const f32x4*)(rt + e2 * 4);
                const unsigned mw_ = e2 == 0 ? mine.x : e2 == 1 ? mine.y : e2 == 2 ? mine.z : mine.w, ow_ = e2 == 0 ? oth.x : e2 == 1 ? oth.y : e2 == 2 ? oth.z : oth.w;
                const float r0 = bflo(mw_) * cs[0] + sg * bflo(ow_) * cs[1], r1 = bfhi(mw_) * cs[2] + sg * bfhi(ow_) * cs[3];
                const unsigned pk = cvt_pk_bf16(r0, r1);
                if (e2 == 0) res.x = pk; else if (e2 == 1) res.y = pk; else if (e2 == 2) res.z = pk; else res.w = pk;
            }
            qf[qt][KC - 1] = __builtin_bit_cast(bf16x8, res);
        }
    }
#pragma unroll
    for (int qt = 0; qt < 2; ++qt)
#pragma unroll
        for (int kc = 0; kc < KC; ++kc) {
            u32x4 qq = __builtin_bit_cast(u32x4, qf[qt][kc]);
            qq.x = cvt_pk_bf16(bflo(qq.x) * c1, bfhi(qq.x) * c1); qq.y = cvt_pk_bf16(bflo(qq.y) * c1, bfhi(qq.y) * c1);
            qq.z = cvt_pk_bf16(bflo(qq.z) * c1, bfhi(qq.z) * c1); qq.w = cvt_pk_bf16(bflo(qq.w) * c1, bfhi(qq.w) * c1);
            qf[qt][kc] = __builtin_bit_cast(bf16x8, qq);
        }
    f32x4 o[2][4];
#pragma unroll
    for (int qt = 0; qt < 2; ++qt)
#pragma unroll
        for (int dt = 0; dt < 4; ++dt) o[qt][dt] = (f32x4){0.f, 0.f, 0.f, 0.f};
    float mrow[2] = {NEGBIG, NEGBIG}, lsum[2] = {0.f, 0.f};
#if ATTN_DMA
    const int swk = (i >> 1) & 7;
    asm volatile("s_waitcnt vmcnt(0)" ::: "memory");
    __syncthreads();
    for (int j = j0; j <= j1; ++j) {
        if (j < j1) AT_DMA(j + 1, (j + 1) & 1);
        attn_tile<VAR, KC>(lds, j & 1, j, q0, i, g, swk, slope2, qf, o, mrow, lsum, mwd, xq);
        asm volatile("s_waitcnt vmcnt(0)" ::: "memory");
        __syncthreads();
    }
#undef AT_DMA
#else
    AT_WRITE(A, j0 & 1);
    __syncthreads();
    const int swk = (i >> 1) & 7;
    for (int j = j0; j <= j1; j += 2) {
        AT_LOAD(A, (j + 2 <= j1 ? j + 2 : j1));
        attn_tile<VAR, KC>(lds, j & 1, j, q0, i, g, swk, slope2, qf, o, mrow, lsum, mwd, xq);
        if (j + 1 <= j1) AT_WRITE(B, (j + 1) & 1);
        if (!AEXP(5)) __syncthreads();
        if (j + 1 > j1) break;
        AT_LOAD(B, (j + 3 <= j1 ? j + 3 : j1));
        attn_tile<VAR, KC>(lds, (j + 1) & 1, j + 1, q0, i, g, swk, slope2, qf, o, mrow, lsum, mwd, xq);
        if (j + 2 <= j1) AT_WRITE(A, j & 1);
        if (!AEXP(5)) __syncthreads();
    }
#undef AT_LOAD
#undef AT_WRITE
#endif
#pragma unroll
    for (int qt = 0; qt < 2; ++qt) {
        float lt = lsum[qt]; lt += __shfl_xor(lt, 16); lt += __shfl_xor(lt, 32);
        if (VAR == 2) lt += __builtin_amdgcn_exp2f(p.sinks[l * 4 + hx * 2 + (w >> 2)] * LOG2E - mrow[qt]);
        const float inv = 1.f / lt;
        bf16_t* op = p.merged + (tok0 + q0 + 16 * qt + i) * D + ocol + 4 * g;
        if (!(ATTN_EXP != 0 && xq))
#pragma unroll
        for (int dt = 0; dt < 4; ++dt) { const f32x4 v = o[qt][dt] * inv; u32x2 w2; w2.x = cvt_pk_bf16(v[0], v[1]); w2.y = cvt_pk_bf16(v[2], v[3]); *(u32x2*)(op + 16 * dt) = w2; }
    }
}

__device__ __forceinline__ void phase_attn(const Params& p, int l, LAS3 char* lds) {
    const int tid = opaque_tid(p.wid);
    unsigned* qhead = p.ctl + CW_QA + 64 * (l + 2 * p.qslot);
    volatile LAS3 int* bc = (volatile LAS3 int*)(lds + AT_CTL);
    int nxt = 0;
    if (tid == 0) nxt = (int)__hip_atomic_fetch_add(qhead, 1u, __ATOMIC_RELAXED, __HIP_MEMORY_SCOPE_AGENT);
    for (;;) {
        if (tid == 0) *bc = nxt;
        __syncthreads();
        const int idx = __builtin_amdgcn_readfirstlane(*bc);
        __syncthreads();
        if (idx >= 4096) break;
        if (tid == 0) nxt = (int)__hip_atomic_fetch_add(qhead, 1u, __ATOMIC_RELAXED, __HIP_MEMORY_SCOPE_AGENT);
        const int vmask = p.qslot ? REPK_VMASK : ATTN_VMASK;
        if (idx < 3072) {
            const int lvl = 7 - idx / 384, rem = idx % 384;
            if (rem < 128) { if (vmask & 2) attn_unit<1>(p, l, rem >> 2, rem & 3, lvl, lds); }
            else if (rem < 256) { if (vmask & 1) attn_unit<0>(p, l, (rem - 128) >> 2, rem & 3, lvl, lds); }
            else { const int d = rem - 256; if (vmask & 8) attn_unit<3>(p, l, d & 31, 0, 4 * lvl + 3 - (d >> 5), lds); }
        } else { const int c = idx - 3072; if (vmask & 4) attn_unit<2>(p, l, c >> 5, (c >> 4) & 1, c & 15, lds); }
    }
}
}

namespace {
constexpr int DS_LD = 2052;
constexpr int DS_CTL = 16 * DS_LD * 4;
constexpr int DS_LDS = DS_CTL + 64;

__device__ __forceinline__ void dsa_unit(const Params& p, int u, LAS3 char* lds) {
    const int tid = opaque_tid(p.wid), w = __builtin_amdgcn_readfirstlane(tid >> 6), lane = tid & 63, i = lane & 15, g = lane >> 4;
    const int b = u >> 7, t0 = (u & 127) * 16;
    const size_t tok0 = (size_t)b * S;
    uint32_t* mbase = p.mask + (tok0 + t0) * 64;
    if (t0 + 16 <= 256) {
#pragma unroll
        for (int qq = 0; qq < 2; ++qq) {
            const int q = 2 * w + qq, n = t0 + q + 1;
            const int cnt = n > lane ? ((n - lane + 63) >> 6) : 0;
            mbase[q * 64 + lane] = cnt >= 32 ? 0xFFFFFFFFu : ((1u << cnt) - 1u);
        }
        return;
    }
    const int nreg = (t0 + 16 + 63) >> 6;
    const int ntile = nreg * 4;
    bf16x8 qf[8]; float wq[8];
    {
        const bf16_t* qrow = p.proj + (tok0 + t0 + i) * NP;
#pragma unroll
        for (int h = 0; h < 8; ++h) qf[h] = *(const bf16x8*)(qrow + PC_DQI + h * 32 + 8 * g);
        const u32x4 ww = *(const u32x4*)(qrow + PC_DWI);
        const float sc = 0.35355339059327373f * 0.17677669529663687f;
        wq[0] = bflo(ww.x) * sc; wq[1] = bfhi(ww.x) * sc; wq[2] = bflo(ww.y) * sc; wq[3] = bfhi(ww.y) * sc;
        wq[4] = bflo(ww.z) * sc; wq[5] = bfhi(ww.z) * sc; wq[6] = bflo(ww.w) * sc; wq[7] = bfhi(ww.w) * sc;
    }
    const int tq = t0 + i;
#ifndef DSA_EXP
#define DSA_EXP 0
#endif
    const bool exp_skip_score = (DSA_EXP == 2) && p.qslot > 0, exp_skip_sel = (DSA_EXP == 1) && p.qslot > 0, exp_nostore = (DSA_EXP != 0) && p.qslot > 0;
    if (!exp_skip_score)
    for (int base = w; base < ntile; base += 32) {
        bf16x8 kf4[4];
#pragma unroll
        for (int uu = 0; uu < 4; ++uu) { const int kt = base + 8 * uu; if (kt < ntile) kf4[uu] = *(const bf16x8*)(p.kidx + (tok0 + 16 * kt + i) * 32 + 8 * g); }
#pragma unroll
        for (int uu = 0; uu < 4; ++uu) {
            const int kt = base + 8 * uu;
            if (kt < ntile) {
                f32x4 sc4 = {0.f, 0.f, 0.f, 0.f};
#pragma unroll
                for (int h = 0; h < 8; ++h) {
                    const f32x4 c = __builtin_amdgcn_mfma_f32_16x16x32_bf16(kf4[uu], qf[h], (f32x4){0.f, 0.f, 0.f, 0.f}, 0, 0, 0);
#pragma unroll
                    for (int r = 0; r < 4; ++r) { const int ci = __float_as_int(c[r]); sc4[r] += wq[h] * __int_as_float(ci > 0 ? ci : 0); }
                }
                u32x4 ko;
#pragma unroll
                for (int r = 0; r < 4; ++r) {
                    const int key = 16 * kt + 4 * g + r;
                    unsigned uu2 = __float_as_uint(sc4[r]); if (uu2 == 0x80000000u) uu2 = 0u;
                    uu2 = (uu2 & 0x80000000u) ? ~uu2 : (uu2 | 0x80000000u);
                    ko[r] = (key <= tq) ? uu2 : 0u;
                }
                *(LAS3 u32x4*)(lds + ((size_t)i * DS_LD + 16 * kt + 4 * g) * 4) = ko;
            }
        }
    }
    __syncthreads();
    if (!exp_skip_sel)
    {
        const int qA = 2 * w, qB = 2 * w + 1;
        const LAS3 unsigned* kpA = (const LAS3 unsigned*)(lds + (size_t)qA * DS_LD * 4);
        const LAS3 unsigned* kpB = (const LAS3 unsigned*)(lds + (size_t)qB * DS_LD * 4);
        unsigned PA[32], PB[32];
        const int nv = nreg * 64;
#pragma unroll
        for (int r = 0; r < 32; ++r) {
            int idx = r * 64 + lane; asm volatile("" : "+v"(idx));
            const unsigned va = kpA[r * 64 + lane], vb = kpB[r * 64 + lane];
            PA[r] = (idx < nv) ? va : 0u; PB[r] = (idx < nv) ? vb : 0u;
        }
#define DSA_TR(P, j, m) do { _Pragma("unroll") for (int k = 0; k < 32; ++k) if ((k & (j)) == 0) { const unsigned x = P[k], y = P[k + (j)]; \
            P[k] = (x & (m)) | ((y << (j)) & ~(m)); P[k + (j)] = ((x >> (j)) & (m)) | (y & ~(m)); } } while (0)
        DSA_TR(PA, 16, 0x0000FFFFu); DSA_TR(PB, 16, 0x0000FFFFu); DSA_TR(PA, 8, 0x00FF00FFu); DSA_TR(PB, 8, 0x00FF00FFu);
        DSA_TR(PA, 4, 0x0F0F0F0Fu); DSA_TR(PB, 4, 0x0F0F0F0Fu); DSA_TR(PA, 2, 0x33333333u); DSA_TR(PB, 2, 0x33333333u);
        DSA_TR(PA, 1, 0x55555555u); DSA_TR(PB, 1, 0x55555555u);
#undef DSA_TR
        unsigned alA = 0xFFFFFFFFu, abA = 0u, selA = 0u, alB = 0xFFFFFFFFu, abB = 0u, selB = 0u;
        bool exA = false, exB = false;
#pragma unroll
        for (int bit = 31; bit >= 0; --bit) {
            if (!(exA && exB)) {
                const unsigned cA = abA | (alA & PA[bit]), cB = abB | (alB & PB[bit]);
                const int na = exA ? 0 : wave_reduce_add(__builtin_popcount(cA)), nb = exB ? 0 : wave_reduce_add(__builtin_popcount(cB));
                if (!exA) { if (na >= 256) { if (na == 256) { exA = true; selA = cA; } alA &= PA[bit]; } else { abA |= alA & PA[bit]; alA &= ~PA[bit]; } }
                if (!exB) { if (nb >= 256) { if (nb == 256) { exB = true; selB = cB; } alB &= PB[bit]; } else { abB |= alB & PB[bit]; alB &= ~PB[bit]; } }
            }
        }
        const unsigned long long lt = (lane == 0) ? 0ull : (~0ull >> (64 - lane));
#pragma unroll 1
        for (int qq = 0; qq < 2; ++qq) {
            const bool exact = qq ? exB : exA;
            unsigned sel = qq ? selB : selA;
            if (!exact) {
                const unsigned al = qq ? alB : alA, ab = qq ? abB : abA;
                const int need = 256 - wave_reduce_add(__builtin_popcount(ab));
                int running = 0; sel = ab;
                for (int r = 0; r < 32; ++r) {
                    const bool eq = ((al >> r) & 1u) != 0u;
                    const unsigned long long be = __ballot(eq);
                    if (eq && running + __popcll(be & lt) < need) sel |= 1u << r;
                    running += __popcll(be);
                }
            }
            if (!exp_nostore) mbase[(2 * w + qq) * 64 + lane] = sel;
        }
    }
    __syncthreads();
}

__device__ __forceinline__ void phase_dsa(const Params& p, int l, LAS3 char* lds) {
    const int tid = opaque_tid(p.wid);
    unsigned* qhead = p.ctl + CW_QD + 64 * (l + 2 * p.qslot);
    volatile LAS3 int* bc = (volatile LAS3 int*)(lds + DS_CTL);
    int nxt = 0;
    if (tid == 0) nxt = (int)__hip_atomic_fetch_add(qhead, 1u, __ATOMIC_RELAXED, __HIP_MEMORY_SCOPE_AGENT);
    for (;;) {
        if (tid == 0) *bc = nxt;
        __syncthreads();
        const int idx = __builtin_amdgcn_readfirstlane(*bc);
        __syncthreads();
        if (idx >= 4096) break;
        if (tid == 0) nxt = (int)__hip_atomic_fetch_add(qhead, 1u, __ATOMIC_RELAXED, __HIP_MEMORY_SCOPE_AGENT);
        const int pb = 127 - (idx >> 5), b = idx & 31;
        dsa_unit(p, b * 128 + pb, lds);
    }
}
}

namespace {
constexpr int LDS_BYTES = 147456;
constexpr int NTHREADS = 512;

template <int PH>
__device__ __forceinline__ void run_phase(const Params& p, int l, unsigned char* smem) {
    LAS3 char* lds = (LAS3 char*)smem;
    PG8_LAS unsigned char* glds = (PG8_LAS unsigned char*)smem;
    const int G = gridDim.x, c = blockIdx.x;
    if constexpr (PH == 0) phase_p0(p, (char*)smem);
    if constexpr (PH == 1) { if (l == 0) phase_norm1<0>(p, 0); else phase_norm1<1>(p, l); }
    if constexpr (PH == 2) { pg8::Gemm g{p.h, p.WinT + (size_t)l * NP * D, D, D, 0}; pg8::StaticOrder S; S.init(T, NP, G, c);
        EpiStoreBf16 E{p.proj, NP}; pg8::gemm_phase<EpiStoreBf16, pg8::StaticOrder, false>(glds, g, S, E, p.wid); }
    if constexpr (PH == 3) phase_prep(p, l);
    if constexpr (PH == 4) { pg8::Gemm g{p.proj + PC_BCQ, p.WqT + (size_t)l * 512 * 256, 256, NP, 0}; pg8::StaticOrder S; S.init(T, 512, G, c);
          EpiMlaQ E{p.qm}; pg8::gemm_phase<EpiMlaQ, pg8::StaticOrder, false>(glds, g, S, E, p.wid); }
    if constexpr (PH == 12) { pg8::Gemm g{p.proj + PC_BCKV, p.WkvT + (size_t)l * 512 * 128, 128, NP, 0}; pg8::StaticOrder S; S.init(T, 512, G, c);
          EpiMlaKV E{p.km, p.vm}; pg8::gemm_phase<EpiMlaKV, pg8::StaticOrder, false>(glds, g, S, E, p.wid); }
    if constexpr (PH == 13) phase_dsa(p, l, lds);
    if constexpr (PH == 5) phase_attn(p, l, lds);
    if constexpr (PH == 6) { pg8::Gemm g{p.merged, p.WoutT + (size_t)l * D * D, D, D, 0}; pg8::StaticOrder S; S.init(T, D, G, c);
        EpiResidual E{l == 0 ? p.x : nullptr, p.xb, p.mod + (size_t)l * NB * NMOD + 2 * 1024}; pg8::gemm_phase<EpiResidual, pg8::StaticOrder, false>(glds, g, S, E, p.wid); }
    if constexpr (PH == 7) phase_route(p, l, (char*)smem);
    if constexpr (PH == 8) { const int* cnt = (const int*)(p.ctl + CW_CNT) + l * 16;
        pg8::Gemm g{p.h, p.WguT + (size_t)l * 16 * 512 * 1024, 1024, D, (size_t)512 * 1024}; MoeOrder S; S.init(cnt, p.list, 2, G, c);
        EpiGateUp E{p.hid}; pg8::gemm_phase<EpiGateUp, MoeOrder, true>(glds, g, S, E, p.wid); }
    if constexpr (PH == 9) { const int* cnt = (const int*)(p.ctl + CW_CNT) + l * 16;
        pg8::Gemm g{p.hid, p.WdT + (size_t)l * 16 * 1024 * 256, 256, 256, (size_t)1024 * 256}; MoeOrder S; S.init(cnt, p.list, 4, G, c);
        EpiDown E{p.ys, p.list, p.wl, cnt}; pg8::gemm_phase<EpiDown, MoeOrder, false>(glds, g, S, E, p.wid); }
    if constexpr (PH == 10) phase_norm1<2>(p, 1);
    if constexpr (PH == 11) phase_norm1<0>(p, l);
}
template <int PH>
__global__ void __launch_bounds__(NTHREADS, 2) k_ph(Params p, int l) {
    extern __shared__ __attribute__((aligned(16))) unsigned char smem[];
    p.wid = __builtin_amdgcn_readfirstlane(threadIdx.x >> 6); p.qslot = p.qslot_host;
    run_phase<PH>(p, l, smem);
}
}


namespace {
#ifndef REP_PH
#define REP_PH -1
#endif
#define REP(X, l) do { if (REP_PH == X) { xcd_barrier(bar); phase<X>(l, smem, wid, 1); } } while (0)
struct KArgs { const float* in[20]; float* xo; char* ws; };
constexpr size_t al256(size_t b) { return (b + 255) & ~(size_t)255; }
constexpr size_t WS_CTL = 0;
constexpr size_t WS_MOD = WS_CTL + al256((size_t)CW_WORDS * 4);
constexpr size_t WS_WIN = WS_MOD + al256((size_t)2 * NB * NMOD * 4);
constexpr size_t WS_WOUT = WS_WIN + al256((size_t)2 * NP * D * 2);
constexpr size_t WS_WQ = WS_WOUT + al256((size_t)2 * D * D * 2);
constexpr size_t WS_WKV = WS_WQ + al256((size_t)2 * 512 * 256 * 2);
constexpr size_t WS_WGU = WS_WKV + al256((size_t)2 * 512 * 128 * 2);
constexpr size_t WS_WD = WS_WGU + al256((size_t)2 * 16 * 512 * 1024 * 2);
constexpr size_t WS_ROPE = WS_WD + al256((size_t)2 * 16 * 1024 * 256 * 2);
constexpr size_t WS_RQ = WS_ROPE + al256((size_t)2048 * 16 * 2 * 4);
constexpr size_t WS_RKV = WS_RQ + al256((size_t)T * 4);
constexpr size_t WS_CBF = WS_RKV + al256((size_t)T * 4);
constexpr size_t WS_KIDX = WS_CBF + al256((size_t)NB * 4 * S * 4);
constexpr size_t WS_MASK = WS_KIDX + al256((size_t)T * 32 * 2);
constexpr size_t WS_LIST = WS_MASK + al256((size_t)T * 64 * 4);
constexpr size_t WS_RW = WS_LIST + al256((size_t)2 * 16 * ECAP * 4);
constexpr size_t WS_WL = WS_RW + al256((size_t)T * 2 * 4);
constexpr size_t WS_H = WS_WL + al256((size_t)2 * 16 * ECAP * 4);
constexpr size_t WS_PROJ = WS_H + al256((size_t)T * D * 2);
constexpr size_t WS_QM = WS_PROJ + al256((size_t)T * NP * 2);
constexpr size_t WS_KM = WS_QM + al256((size_t)T * 384 * 2);
constexpr size_t WS_VM = WS_KM + al256((size_t)T * 384 * 2);
constexpr size_t WS_MERGED = WS_VM + al256((size_t)T * 256 * 2);
constexpr size_t WS_XB = WS_MERGED + al256((size_t)T * D * 2);
constexpr size_t WS_END1 = WS_XB + al256((size_t)T * D * 2);
constexpr size_t WS_HID = WS_PROJ;
constexpr size_t WS_YS = WS_HID + al256((size_t)HIDROWS * 256 * 2);
constexpr size_t WS_END2 = WS_YS + al256((size_t)T * 2 * D * 2);
constexpr size_t WS_NEED = WS_END1 > WS_END2 ? WS_END1 : WS_END2;
static_assert(WS_END2 <= WS_MERGED, "MoE overlay must not reach the merged buffer");

__device__ __forceinline__ Params make_params(const KArgs& a) {
    Params p;
    p.x = a.in[0]; p.c = a.in[1]; p.w_ada = a.in[2]; p.b_ada = a.in[3]; p.g_norm1 = a.in[4]; p.w_in = a.in[5]; p.b_forget = a.in[6]; p.g_q_mla = a.in[7];
    p.w_q_up = a.in[8]; p.g_kv_mla = a.in[9]; p.w_kv_up = a.in[10]; p.sinks = a.in[11]; p.w_out = a.in[12]; p.g_norm2 = a.in[13]; p.w_router = a.in[14];
    p.b_router = a.in[15]; p.w_gate = a.in[16]; p.w_up = a.in[17]; p.w_down = a.in[18]; p.g_final = a.in[19];
    p.xo = a.xo; char* ws = a.ws;
    p.ctl = (unsigned*)(ws + WS_CTL); p.mod = (float*)(ws + WS_MOD); p.WinT = (bf16_t*)(ws + WS_WIN); p.WoutT = (bf16_t*)(ws + WS_WOUT);
    p.WqT = (bf16_t*)(ws + WS_WQ); p.WkvT = (bf16_t*)(ws + WS_WKV); p.WguT = (bf16_t*)(ws + WS_WGU); p.WdT = (bf16_t*)(ws + WS_WD);
    p.ropetab = (float*)(ws + WS_ROPE); p.rq = (float*)(ws + WS_RQ); p.rkv = (float*)(ws + WS_RKV); p.cbF = (float*)(ws + WS_CBF); p.kidx = (bf16_t*)(ws + WS_KIDX);
    p.mask = (uint32_t*)(ws + WS_MASK); p.list = (int*)(ws + WS_LIST); p.rw = (float*)(ws + WS_RW); p.wl = (float*)(ws + WS_WL); p.h = (bf16_t*)(ws + WS_H);
    p.proj = (bf16_t*)(ws + WS_PROJ); p.qm = (bf16_t*)(ws + WS_QM); p.km = (bf16_t*)(ws + WS_KM); p.vm = (bf16_t*)(ws + WS_VM);
    p.merged = (bf16_t*)(ws + WS_MERGED); p.xb = (bf16_t*)(ws + WS_XB); p.hid = (bf16_t*)(ws + WS_HID); p.ys = (bf16_t*)(ws + WS_YS);
    return p;
}
template <int PH>
__device__ __forceinline__ void phase(int l, unsigned char* smem, int wid, int qslot = 0) {
    typedef const __attribute__((address_space(4))) KArgs* KA4;
    KA4 ka = (KA4)__builtin_amdgcn_kernarg_segment_ptr();
    asm volatile("" : "+s"(ka));
    KArgs a;
#pragma unroll
    for (int i = 0; i < 20; ++i) a.in[i] = ka->in[i];
    a.xo = ka->xo; a.ws = ka->ws;
    Params p = make_params(a); p.wid = wid; p.qslot = qslot; p.qslot_host = 0;
    run_phase<PH>(p, l, smem);
}
__global__ void __launch_bounds__(NTHREADS, 2) fwd(KArgs args) {
    extern __shared__ __attribute__((aligned(16))) unsigned char smem[];
    volatile LAS unsigned* st = (volatile LAS unsigned*)(smem + LDS_BYTES - 16);
    const int wid = __builtin_amdgcn_readfirstlane(threadIdx.x >> 6);
    if (xb_leader(wid)) { st[0] = 0u; st[1] = 0u; st[2] = 0u; st[3] = 0u; }
    __syncthreads();
    XcdBarrier bar = xcd_barrier_post((unsigned*)(args.ws + WS_CTL) + CW_BAR, st, wid);
    phase<0>(0, smem, wid);  REP(0, 0);
    xcd_barrier(bar);
#define LAYER(l) do { \
        phase<1>(l, smem, wid);  if (l == 0) REP(1, l); xcd_barrier(bar); \
        phase<2>(l, smem, wid);  REP(2, l); xcd_barrier(bar); \
        phase<3>(l, smem, wid);  REP(3, l); xcd_barrier(bar); \
        phase<4>(l, smem, wid);  REP(4, l); phase<12>(l, smem, wid);  REP(12, l); phase<13>(l, smem, wid);  REP(13, l); xcd_barrier(bar); \
        phase<5>(l, smem, wid);  REP(5, l); xcd_barrier(bar); \
        phase<6>(l, smem, wid);  xcd_barrier(bar); \
        phase<7>(l, smem, wid);  REP(7, l); xcd_barrier(bar); \
        phase<8>(l, smem, wid);  REP(8, l); xcd_barrier(bar); \
        phase<9>(l, smem, wid);  REP(9, l); xcd_barrier(bar); } while (0)
    LAYER(0);
    LAYER(1);
#ifdef REP_BAR
    for (int rb = 0; rb < REP_BAR; ++rb) xcd_barrier(bar);
#endif
    phase<10>(1, smem, wid);
}
}

extern "C" void kernel_launch(void* const* d_in, const int* in_sizes, int n_in, void* d_out, int out_size, void* d_ws, size_t ws_size,
                              hipStream_t stream) {
    KArgs a{};
    for (int i = 0; i < 20; ++i) a.in[i] = (const float*)d_in[i];
    a.xo = (float*)d_out; a.ws = (char*)d_ws;
    if (WS_NEED > ws_size) return;

    static int grid = 0;
    if (!grid) {
        int dev = 0, cus = 0, per_cu = 0;
        (void)hipGetDevice(&dev);
        (void)hipDeviceGetAttribute(&cus, hipDeviceAttributeMultiprocessorCount, dev);
        (void)hipFuncSetAttribute((const void*)fwd, hipFuncAttributeMaxDynamicSharedMemorySize, LDS_BYTES);
        (void)hipOccupancyMaxActiveBlocksPerMultiprocessor(&per_cu, (const void*)fwd, NTHREADS, LDS_BYTES);
        grid = cus > 0 ? cus : 256;
    }
    (void)hipMemsetAsync(a.ws + WS_CTL, 0, (size_t)CW_WORDS * 4, stream);
    fwd<<<dim3(grid), dim3(NTHREADS), LDS_BYTES, stream>>>(a);
}
```

```cpp
#include <hip/hip_runtime.h>
#include <stdint.h>
#define XB_TMO      128
#define XB_XCNT(j)  (256  + 64 * (j))
#define XB_XSUB(j)  (1280 + 64 * (j))
#define XB_XGEN(j)  (2304 + 64 * (j))
#define XB_TOP      3328
#define XB_TOPGEN   3392
#define XCD_BAR_WORDS 3456
#define XB_SPIN_CAP (1u << 20)
#define LAS __attribute__((address_space(3)))

__device__ __forceinline__ unsigned xb_ld(unsigned* p)              { return __hip_atomic_load(p, __ATOMIC_RELAXED, __HIP_MEMORY_SCOPE_AGENT); }
__device__ __forceinline__ unsigned xb_add(unsigned* p, unsigned v) { return __hip_atomic_fetch_add(p, v, __ATOMIC_RELAXED, __HIP_MEMORY_SCOPE_AGENT); }
__device__ __forceinline__ unsigned xb_xcc_id() { return (unsigned)__builtin_amdgcn_s_getreg((3 << 11) | 20) & 0xFu; }
#define XB_SPIN(cond, bar) do { unsigned _sp = 0; while (cond) { __builtin_amdgcn_s_sleep(1); \
    if ((++_sp & 255u) == 0u) { if (xb_ld(&(bar)[XB_TMO])) break; if (_sp > XB_SPIN_CAP) { atomicAdd(&(bar)[XB_TMO], 1u); break; } } } } while (0)

struct XcdBarrier { unsigned* bar; unsigned x; volatile LAS unsigned* st; int wid; };
__device__ __forceinline__ bool xb_leader(int wid) { return wid == 0 && __builtin_amdgcn_mbcnt_hi(~0u, __builtin_amdgcn_mbcnt_lo(~0u, 0u)) == 0u; }

__device__ __forceinline__ XcdBarrier xcd_barrier_post(unsigned* bar, volatile LAS unsigned* st, int wid) {
    XcdBarrier b; b.bar = bar; b.x = xb_xcc_id(); b.st = st; b.wid = wid;
    if (xb_leader(wid)) (void)xb_add(&bar[XB_XCNT(b.x)], 1u);
    return b;
}
__device__ __forceinline__ void xcd_barrier_complete(unsigned* bar, unsigned x, unsigned& nloc, unsigned& nx) {
    const unsigned G = gridDim.x * gridDim.y * gridDim.z;
    unsigned sum, cnt, mine, sp = 0u;
    for (;;) {
        sum = 0u; cnt = 0u; mine = 0u;
#pragma unroll
        for (unsigned j = 0; j < 16; ++j) { const unsigned c = xb_ld(&bar[XB_XCNT(j)]); sum += c; cnt += (c > 0u) ? 1u : 0u; mine = (j == x) ? c : mine; }
        if (sum == G) break;
        __builtin_amdgcn_s_sleep(1);
        if ((++sp & 255u) == 0u) { if (xb_ld(&bar[XB_TMO])) break; if (sp > XB_SPIN_CAP) { atomicAdd(&bar[XB_TMO], 1u); break; } }
    }
    nloc = mine > 0u ? mine : 1u; nx = cnt > 0u ? cnt : 1u;
}
__device__ __forceinline__ void xcd_barrier(const XcdBarrier& b) {
    asm volatile("s_waitcnt vmcnt(0)" ::: "memory");
    __syncthreads();
    if (xb_leader(b.wid)) {
        unsigned* bar = b.bar;
        __builtin_amdgcn_s_waitcnt(0);
        unsigned nloc = b.st[0], nx = b.st[1];
        if (nloc == 0u) { xcd_barrier_complete(bar, b.x, nloc, nx); b.st[0] = nloc; b.st[1] = nx; }
        const unsigned old = xb_add(&bar[XB_XSUB(b.x)], 1u);
        const unsigned gen = old / nloc;
        if (old + 1u == (gen + 1u) * nloc) {
            __builtin_amdgcn_fence(__ATOMIC_RELEASE, "agent");
            asm volatile("s_waitcnt vmcnt(0)" ::: "memory");
            const unsigned og = xb_add(&bar[XB_TOP], 1u);
            const unsigned tg = og / nx;
            if (og + 1u == (tg + 1u) * nx) xb_add(&bar[XB_TOPGEN], 1u);
            else XB_SPIN(xb_ld(&bar[XB_TOPGEN]) == tg, bar);
            __builtin_amdgcn_fence(__ATOMIC_ACQUIRE, "agent");
            xb_add(&bar[XB_XGEN(b.x)], 1u);
            asm volatile("s_waitcnt vmcnt(0)" ::: "memory");
        } else {
            XB_SPIN(xb_ld(&bar[XB_XGEN(b.x)]) == gen, bar);
            __builtin_amdgcn_fence(__ATOMIC_ACQUIRE, "agent");
            asm volatile("s_waitcnt vmcnt(0)" ::: "memory");
        }
    }
    __syncthreads();
}

#define LAS3 __attribute__((address_space(3)))
namespace {
typedef unsigned short bf16_t;
typedef short bf16x8 __attribute__((ext_vector_type(8)));
typedef short bf16x4 __attribute__((ext_vector_type(4)));
typedef float f32x4 __attribute__((ext_vector_type(4)));
typedef float f32x2 __attribute__((ext_vector_type(2)));
typedef unsigned u32x4 __attribute__((ext_vector_type(4)));
typedef unsigned u32x2 __attribute__((ext_vector_type(2)));

constexpr int D = 1024, NB = 32, S = 2048, T = NB * S, NIN = 2380, NP = 2560, NMOD = 6144;
constexpr int OFF_AQ = 0, OFF_AK = 256, OFF_AV = 512, OFF_AF = 768, OFF_BCQ = 772, OFF_BCKV = 1028, OFF_BKR = 1156,
              OFF_CQ = 1188, OFF_CK = 1444, OFF_CV = 1572, OFF_DQ = 1700, OFF_DK = 1956, OFF_DV = 2020,
              OFF_DQI = 2084, OFF_DKI = 2340, OFF_DWI = 2372;
constexpr int PC_AQ = 0, PC_AK = 256, PC_AV = 512, PC_BCQ = 768, PC_BCKV = 1024, PC_BKR = 1152, PC_CQ = 1184, PC_CK = 1440, PC_CV = 1568,
              PC_DQ = 1696, PC_DK = 1952, PC_DV = 2016, PC_DQI = 2080, PC_DKI = 2336, PC_DWI = 2368, PC_AF = 2376;
constexpr float EPS = 1e-6f;
constexpr float LOG2E = 1.4426950408889634f;
constexpr int ECAP = T;
constexpr int HIDROWS = 2 * T + 16 * 256;

__host__ __device__ __forceinline__ int orig_col(int n) { return n < 768 ? n : (n < 2376 ? n + 4 : (n < 2380 ? n - 1608 : -1)); }
__device__ __forceinline__ int opaque_tid(int wid) {
    int t = wid * 64 + (int)__builtin_amdgcn_mbcnt_hi(~0u, __builtin_amdgcn_mbcnt_lo(~0u, 0u));
    asm volatile("" : "+v"(t)); return t; }
__device__ __forceinline__ float bf2f(bf16_t v) { return __uint_as_float((unsigned)v << 16); }
__device__ __forceinline__ bf16_t f2bf(float f) { unsigned u = __float_as_uint(f); u += 0x7FFFu + ((u >> 16) & 1u); return (bf16_t)(u >> 16); }
typedef __bf16 bf16x2_native __attribute__((ext_vector_type(2)));
__device__ __forceinline__ unsigned cvt_pk_bf16(float lo, float hi) { const f32x2 v = {lo, hi}; return __builtin_bit_cast(unsigned, __builtin_convertvector(v, bf16x2_native)); }
__device__ __forceinline__ float bflo(unsigned w) { return __uint_as_float(w << 16); }
__device__ __forceinline__ float bfhi(unsigned w) { return __uint_as_float(w & 0xFFFF0000u); }
__device__ __forceinline__ float wave_sum(float v) {
#pragma unroll
    for (int o = 32; o > 0; o >>= 1) v += __shfl_xor(v, o);
    return v;
}
__device__ __forceinline__ float xor32_max(float x) {
    float a = x, b = x;
    asm volatile("s_nop 1\n\tv_permlane32_swap_b32 %0, %1\n\ts_nop 1" : "+v"(a), "+v"(b));
    return fmaxf(a, b);
}
__device__ __forceinline__ int wave_reduce_add(int v) {
    v += __builtin_amdgcn_update_dpp(0, v, 0xB1, 0xF, 0xF, true);
    v += __builtin_amdgcn_update_dpp(0, v, 0x4E, 0xF, 0xF, true);
    v += __builtin_amdgcn_update_dpp(0, v, 0x141, 0xF, 0xF, true);
    v += __builtin_amdgcn_update_dpp(0, v, 0x140, 0xF, 0xF, true);
    return __builtin_amdgcn_readlane(v, 0) + __builtin_amdgcn_readlane(v, 16) + __builtin_amdgcn_readlane(v, 32) + __builtin_amdgcn_readlane(v, 48);
}
}

namespace pg8 {
#define PG8_LAS __attribute__((address_space(3)))
constexpr int BM = 256, BK = 64, HALF = 128, HTB = HALF * BK * 2, STAGE_BYTES = 8 * HTB, NXCD = 8, WGM = 8;

__host__ __device__ __forceinline__ int lds_byte(int r, int c) { const int st = (r >> 4) * 2 + (c >> 5), rr = r & 15, cc = c & 31, ob = rr * 64 + cc * 2; return st * 1024 + (ob ^ (((ob >> 9) & 1) << 5)); }
__host__ __device__ __forceinline__ void stage_rc(int b, int& R, int& C) { const int st = b / 1024, sb = b % 1024, swz = sb ^ (((sb >> 9) & 1) << 5); R = (st >> 1) * 16 + swz / 64; C = (st & 1) * 32 + (swz % 64) / 2; }
__host__ __device__ __forceinline__ int perm32(int rho) { const int n = rho >> 4, i = rho & 15; return 8 * (i >> 2) + 4 * n + (i & 3); }

struct Unit { int pm, pn, e, mt; };
struct Gemm { const bf16_t* A; const bf16_t* Bt; int K; int lda; size_t bstride; };

struct StaticOrder {
    int nM, nN, nwg, G, c;
    __host__ __device__ void init(int M, int N, int G_, int c_) { nM = M / BM; nN = N / BM; nwg = nM * nN; G = G_; c = c_; }
    __host__ __device__ bool next(int i, Unit& u) const {
        const long L = (long)i * G + c; if (L >= nwg) return false;
        int wgid = (int)L; { const int q = nwg / NXCD, r = nwg % NXCD, xcd = wgid % NXCD, off = wgid / NXCD; wgid = (xcd < r ? xcd * (q + 1) : r * (q + 1) + (xcd - r) * q) + off; }
        const int nig = WGM * nN, gid = wgid / nig, fm = gid * WGM, gsz = (nM - fm) < WGM ? (nM - fm) : WGM;
        u.pm = fm + ((wgid % nig) % gsz); u.pn = (wgid % nig) / gsz; u.e = 0; u.mt = 0; return true;
    }
    __device__ __forceinline__ int arow(const Unit& u, int r) const { return u.pm * BM + r; }
};

template <class Epi, class Sched, bool GATHER>
__device__ __forceinline__ void gemm_phase(PG8_LAS unsigned char* lds, const Gemm g, const Sched& S, const Epi& E, int wave_index) {
    const int tid = opaque_tid(wave_index), wid = __builtin_amdgcn_readfirstlane(tid >> 6), lane = tid & 63, wr = wid >> 2, wc = wid & 3, fr = lane & 15, fq = lane >> 4;
    int K_ = g.K; asm volatile("" : "+s"(K_));
    const int K = K_, nt = K / BK, lda = g.lda;
    int Ra[2], Ca[2]; unsigned voffB[2], voffA[2];
#pragma unroll
    for (int i = 0; i < 2; ++i) { int R, C; stage_rc(tid * 16 + i * 8192, R, C); const int Rb = Epi::PERM ? ((R & ~31) + perm32(R & 31)) : R;
        Ra[i] = R; Ca[i] = C; voffB[i] = (unsigned)(Rb * K + C) * 2u; voffA[i] = (unsigned)(R * lda + C) * 2u; }
    const size_t kstep = (size_t)(BK * 2);
    const size_t hstepB = (size_t)HALF * K * 2;
    const size_t tstepB = 2 * hstepB;
    const size_t hstepA = (size_t)HALF * lda * 2, tstepA = 2 * hstepA;
    const unsigned ldsw = (unsigned)wid * 1024u;
    const int aoff = lds_byte(wr * 64 + fr, fq * 8), boff = lds_byte(wc * 32 + fr, fq * 8);
#define PG8_SA(b, h) (((b) * 2 + (h)) * HTB)
#define PG8_SB(b, h) ((4 + (b) * 2 + (h)) * HTB)
#define PG8_STAGE(bufoff, gbase, voff) do { _Pragma("unroll") for (int _i = 0; _i < 2; ++_i) \
        __builtin_amdgcn_global_load_lds((const unsigned*)((const char*)(gbase) + (voff)[_i]), (PG8_LAS unsigned*)(lds + (bufoff) + ldsw + _i * 8192), 16, 0, 0); } while (0)
#define PG8_STAGEA(bufoff, kptr, VO, h) do { _Pragma("unroll") for (int _i = 0; _i < 2; ++_i) { \
        const char* _src; if constexpr (GATHER) _src = (const char*)(kptr) + (VO)[_i][h]; else _src = (const char*)(kptr) + (size_t)(h) * hstepA + voffA[_i]; \
        __builtin_amdgcn_global_load_lds((const unsigned*)_src, (PG8_LAS unsigned*)(lds + (bufoff) + ldsw + _i * 8192), 16, 0, 0); } } while (0)
#define PG8_LDA(dst, b, h) do { _Pragma("unroll") for (int m = 0; m < 4; ++m) _Pragma("unroll") for (int k = 0; k < 2; ++k) dst[m][k] = *(const PG8_LAS bf16x8*)(lds + PG8_SA(b, h) + aoff + m * 2048 + k * 1024); } while (0)
#define PG8_LDB(dst, b, h) do { _Pragma("unroll") for (int n = 0; n < 2; ++n) _Pragma("unroll") for (int k = 0; k < 2; ++k) dst[n][k] = *(const PG8_LAS bf16x8*)(lds + PG8_SB(b, h) + boff + n * 2048 + k * 1024); } while (0)
#define PG8_MMA(ai, bj, At, Bt) do { __builtin_amdgcn_s_setprio(1); _Pragma("unroll") for (int m = 0; m < 4; ++m) _Pragma("unroll") for (int n = 0; n < 2; ++n) _Pragma("unroll") for (int k = 0; k < 2; ++k) \
        acc[ai][bj][m][n] = __builtin_amdgcn_mfma_f32_16x16x32_bf16(Bt[n][k], At[m][k], acc[ai][bj][m][n], 0, 0, 0); __builtin_amdgcn_s_setprio(0); } while (0)
#define PG8_WAIT_V(n) asm volatile("s_waitcnt vmcnt(" #n ")" ::: "memory")
#define PG8_WAIT_L(n) asm volatile("s_waitcnt lgkmcnt(" #n ")" ::: "memory")
#define PG8_BAR __builtin_amdgcn_s_barrier()
#define PG8_SCHED __builtin_amdgcn_sched_barrier(0)
#define PG8_SETV(V, u) do { _Pragma("unroll") for (int _i = 0; _i < 2; ++_i) _Pragma("unroll") for (int _h = 0; _h < 2; ++_h) { \
        const int _row = GATHER ? S.arow(u, _h * HALF + Ra[_i]) : ((u).pm * BM + _h * HALF + Ra[_i]); V[_i][_h] = (unsigned)(((size_t)_row * lda + Ca[_i]) * 2); } } while (0)
    Unit cur, nxt; int ui = 0;
    if (!S.next(0, cur)) return;
    f32x4 acc[2][2][4][2];
#pragma unroll
    for (int a = 0; a < 2; ++a)
#pragma unroll
        for (int b = 0; b < 2; ++b)
#pragma unroll
            for (int m = 0; m < 4; ++m)
#pragma unroll
                for (int n = 0; n < 2; ++n) acc[a][b][m][n] = (f32x4){0.f, 0.f, 0.f, 0.f};
    bf16x8 At[4][2], B0[2][2], B1[2][2];
    unsigned vA[2][2], vN[2][2];
    if constexpr (GATHER) { PG8_SETV(vA, cur); }
    const char* cA = (const char*)g.A + (GATHER ? (size_t)0 : (size_t)cur.pm * tstepA);
    const char* cB = (const char*)g.Bt + ((size_t)cur.e * g.bstride) * 2 + (size_t)cur.pn * tstepB;
    PG8_STAGE(PG8_SB(0, 0), cB, voffB); PG8_STAGE(PG8_SB(0, 1), cB + hstepB, voffB); PG8_STAGEA(PG8_SA(0, 0), cA, vA, 0); PG8_STAGEA(PG8_SA(0, 1), cA, vA, 1);
    if (wr == 1) PG8_BAR;
    PG8_WAIT_V(2); PG8_BAR;
    PG8_STAGE(PG8_SB(1, 0), cB + kstep, voffB); PG8_STAGEA(PG8_SA(1, 0), cA + kstep, vA, 0); PG8_STAGE(PG8_SB(1, 1), cB + hstepB + kstep, voffB);
    PG8_WAIT_V(6); PG8_BAR;
    for (;;) {
        const bool has_next = S.next(ui + 1, nxt);
        if constexpr (GATHER) { if (has_next) { PG8_SETV(vN, nxt); }
        else {
#pragma unroll
            for (int _i = 0; _i < 2; ++_i)
#pragma unroll
                for (int _h = 0; _h < 2; ++_h) vN[_i][_h] = vA[_i][_h];
        } }
        const char* nA = (!GATHER && has_next) ? (const char*)g.A + (size_t)nxt.pm * tstepA : cA;
        const char* nB = has_next ? (const char*)g.Bt + ((size_t)nxt.e * g.bstride) * 2 + (size_t)nxt.pn * tstepB : cB;
#pragma unroll 1
        for (int t = 0; t < nt; t += 2) {
            const bool last = (t == nt - 2);
            const char* a1 = cA + (size_t)(t + 1) * kstep;
            const char* a2 = last ? nA : cA + (size_t)(t + 2) * kstep; const char* b2 = last ? nB : cB + (size_t)(t + 2) * kstep;
            const char* a3 = a2 + kstep; const char* b3 = b2 + kstep;
            unsigned v2[2][2];
            if constexpr (GATHER) {
#pragma unroll
            for (int _i = 0; _i < 2; ++_i)
#pragma unroll
                for (int _h = 0; _h < 2; ++_h) v2[_i][_h] = last ? vN[_i][_h] : vA[_i][_h];
            }
            PG8_LDB(B0, 0, 0); PG8_LDB(B1, 0, 1); PG8_SCHED; PG8_LDA(At, 0, 0); PG8_STAGEA(PG8_SA(1, 1), a1, vA, 1);
            PG8_WAIT_V(8); PG8_WAIT_L(0); PG8_BAR; PG8_MMA(0, 0, At, B0); PG8_MMA(0, 1, At, B1); PG8_BAR; PG8_SCHED;
            PG8_LDA(At, 0, 1); PG8_STAGE(PG8_SB(0, 0), b2, voffB); PG8_STAGE(PG8_SB(0, 1), b2 + hstepB, voffB); PG8_STAGEA(PG8_SA(0, 0), a2, v2, 0);
            PG8_WAIT_V(8); PG8_WAIT_L(0); PG8_BAR; PG8_MMA(1, 0, At, B0); PG8_MMA(1, 1, At, B1); PG8_BAR; PG8_SCHED;
            PG8_LDB(B0, 1, 0); PG8_LDB(B1, 1, 1); PG8_SCHED; PG8_LDA(At, 1, 0); PG8_STAGEA(PG8_SA(0, 1), a2, v2, 1);
            PG8_WAIT_V(8); PG8_WAIT_L(0); PG8_BAR; PG8_MMA(0, 0, At, B0); PG8_MMA(0, 1, At, B1); PG8_BAR; PG8_SCHED;
            PG8_LDA(At, 1, 1); PG8_STAGE(PG8_SB(1, 0), b3, voffB); PG8_STAGE(PG8_SB(1, 1), b3 + hstepB, voffB); PG8_STAGEA(PG8_SA(1, 0), a3, v2, 0);
            PG8_WAIT_V(8); PG8_WAIT_L(0); PG8_BAR; PG8_MMA(1, 0, At, B0); PG8_MMA(1, 1, At, B1); PG8_BAR; PG8_SCHED;
        }
        if (wr == 0) PG8_BAR;
        E(acc, cur, wr, wc, fr, fq);
        if (!has_next) break;
#pragma unroll
        for (int a = 0; a < 2; ++a)
#pragma unroll
            for (int b = 0; b < 2; ++b)
#pragma unroll
                for (int m = 0; m < 4; ++m)
#pragma unroll
                    for (int n = 0; n < 2; ++n) acc[a][b][m][n] = (f32x4){0.f, 0.f, 0.f, 0.f};
        cur = nxt; cB = nB; cA = nA; ++ui;
        if constexpr (GATHER) {
#pragma unroll
        for (int _i = 0; _i < 2; ++_i)
#pragma unroll
            for (int _h = 0; _h < 2; ++_h) vA[_i][_h] = vN[_i][_h];
        }
        if (wr == 1) PG8_BAR;
    }
    PG8_WAIT_V(0);
    PG8_BAR;
#undef PG8_SA
#undef PG8_SB
#undef PG8_STAGE
#undef PG8_STAGEA
#undef PG8_LDA
#undef PG8_LDB
#undef PG8_MMA
#undef PG8_WAIT_V
#undef PG8_WAIT_L
#undef PG8_BAR
#undef PG8_SCHED
#undef PG8_SETV
}
}

namespace {
struct Params {
    const float *x, *c, *w_ada, *b_ada, *g_norm1, *w_in, *b_forget, *g_q_mla, *w_q_up, *g_kv_mla, *w_kv_up, *sinks, *w_out, *g_norm2,
                *w_router, *b_router, *w_gate, *w_up, *w_down, *g_final;
    float* xo;
    bf16_t* xb;
    unsigned* ctl;
    float* mod;
    bf16_t* WinT;
    bf16_t* WoutT;
    bf16_t* WqT;
    bf16_t* WkvT;
    bf16_t* WguT;
    bf16_t* WdT;
    float* ropetab;
    float* rq; float* rkv;
    float* cbF;
    bf16_t* kidx;
    uint32_t* mask;
    bf16_t* h;
    bf16_t* proj;
    bf16_t* qm; bf16_t* km; bf16_t* vm;
    bf16_t* merged;
    bf16_t* hid;
    bf16_t* ys;
    int* list;
    float* rw;
    float* wl;
    int wid;
    int qslot;
    int qslot_host;
};
constexpr int CW_BAR = 0;
constexpr int CW_CNT = 3584;
constexpr int CW_QA = 3648;
constexpr int CW_QD = 4288;
constexpr int CW_KN2 = 4992;
constexpr int CW_QN2 = CW_KN2 + 2 * NB * 4 * 32;
constexpr int CW_WORDS = CW_QN2 + 2 * NB * 4 * 8;
}

namespace {
constexpr long P0_B1 = 2l * NP * 128, P0_B2 = P0_B1 + 2l * 1024 * 128, P0_B3 = P0_B2 + 2l * 512 * 32, P0_B4 = P0_B3 + 2l * 512 * 16,
               P0_B5 = P0_B4 + 32l * 512 * 128, P0_B6 = P0_B5 + 32l * 1024 * 32;
__device__ __forceinline__ bf16_t* p0_fetch(const Params& p, long it, float (&v)[8]) {
    if (it < P0_B1) {
        const int l = (int)(it / (NP * 128)), r = (int)(it % (NP * 128)), n = r % NP, k0 = (r / NP) * 8, o = orig_col(n);
        const float* w = p.w_in + (size_t)l * D * NIN;
#pragma unroll
        for (int j = 0; j < 8; ++j) v[j] = o >= 0 ? w[(size_t)(k0 + j) * NIN + o] : 0.f;
        return p.WinT + ((size_t)l * NP + n) * D + k0;
    } else if (it < P0_B2) {
        const long s = it - P0_B1; const int l = (int)(s / (1024 * 128)), r = (int)(s % (1024 * 128)), n = r & 1023, k0 = (r >> 10) * 8;
        const float* w = p.w_out + (size_t)l * D * D;
#pragma unroll
        for (int j = 0; j < 8; ++j) v[j] = w[(size_t)(k0 + j) * D + n];
        return p.WoutT + ((size_t)l * D + n) * D + k0;
    } else if (it < P0_B3) {
        const long s = it - P0_B2; const int l = (int)(s / (512 * 32)), r = (int)(s % (512 * 32)), n = r & 511, k0 = (r >> 9) * 8;
        const float* w = p.w_q_up + (size_t)l * 256 * 384; const float* g = p.g_q_mla + l * 256;
#pragma unroll
        for (int j = 0; j < 8; ++j) v[j] = n < 384 ? g[k0 + j] * w[(size_t)(k0 + j) * 384 + n] : 0.f;
        return p.WqT + ((size_t)l * 512 + n) * 256 + k0;
    } else if (it < P0_B4) {
        const long s = it - P0_B3; const int l = (int)(s / (512 * 16)), r = (int)(s % (512 * 16)), n = r & 511, k0 = (r >> 9) * 8;
        const float* w = p.w_kv_up + (size_t)l * 128 * 512; const float* g = p.g_kv_mla + l * 128;
#pragma unroll
        for (int j = 0; j < 8; ++j) v[j] = g[k0 + j] * w[(size_t)(k0 + j) * 512 + n];
        return p.WkvT + ((size_t)l * 512 + n) * 128 + k0;
    } else if (it < P0_B5) {
        const long s = it - P0_B4; const int le = (int)(s >> 16), r = (int)(s & 65535), n = r & 511, k0 = (r >> 9) * 8;
        const int q = n >> 5, rr = n & 31, col = 16 * q + (rr & 15);
        const float* w = (rr < 16 ? p.w_gate : p.w_up) + (size_t)le * 1024 * 256;
#pragma unroll
        for (int j = 0; j < 8; ++j) v[j] = w[(size_t)(k0 + j) * 256 + col];
        return p.WguT + ((size_t)le * 512 + n) * 1024 + k0;
    } else {
        const long s = it - P0_B5; const int le = (int)(s >> 15), r = (int)(s & 32767), n = r & 1023, k0 = (r >> 10) * 8;
        const float* w = p.w_down + (size_t)le * 256 * 1024;
#pragma unroll
        for (int j = 0; j < 8; ++j) v[j] = w[(size_t)(k0 + j) * 1024 + n];
        return p.WdT + ((size_t)le * 1024 + n) * 256 + k0;
    }
}
__device__ __forceinline__ void p0_store(bf16_t* dst, const float (&v)[8]) {
    u32x4 w; w.x = cvt_pk_bf16(v[0], v[1]); w.y = cvt_pk_bf16(v[2], v[3]); w.z = cvt_pk_bf16(v[4], v[5]); w.w = cvt_pk_bf16(v[6], v[7]);
    *(u32x4*)dst = w;
}

__device__ __forceinline__ void phase_p0(const Params& p, char* lds) {
    const int tid = opaque_tid(p.wid), gtid = blockIdx.x * blockDim.x + tid, gthreads = gridDim.x * blockDim.x;
    for (long it0 = gtid; it0 < P0_B6; it0 += 4l * gthreads) {
        float va[8], vb[8], vc[8], vd[8];
        const bool hb = it0 + gthreads < P0_B6, hc = it0 + 2l * gthreads < P0_B6, hd = it0 + 3l * gthreads < P0_B6;
        bf16_t* da = p0_fetch(p, it0, va);
        bf16_t* db = hb ? p0_fetch(p, it0 + gthreads, vb) : da;
        bf16_t* dc = hc ? p0_fetch(p, it0 + 2l * gthreads, vc) : da;
        bf16_t* dd = hd ? p0_fetch(p, it0 + 3l * gthreads, vd) : da;
        p0_store(da, va);
        if (hb) p0_store(db, vb);
        if (hc) p0_store(dc, vc);
        if (hd) p0_store(dd, vd);
    }
    for (int it = gtid; it < 2048 * 16; it += gthreads) {
        const int pos = it >> 4, i = it & 15;
        const float inv = powf(10000.0f, -(float)i / 16.0f), ang = (float)pos * inv;
        p.ropetab[it * 2] = cosf(ang); p.ropetab[it * 2 + 1] = sinf(ang);
    }
    const int w = __builtin_amdgcn_readfirstlane(tid >> 6), lane = tid & 63;
    for (int u = blockIdx.x; u < 2 * (NMOD / 64); u += gridDim.x) {
        float* ca = (float*)lds;
        for (int i = tid; i < NB * 1024; i += 512) { const int bb = i >> 10, d = i & 1023; const float v = p.c[i]; ca[d * 32 + ((bb + 4 * (d & 7)) & 31)] = v / (1.f + __expf(-v)); }
        __syncthreads();
        const int l = u / (NMOD / 64), n0 = (u % (NMOD / 64)) * 64;
        const float* wp = p.w_ada + (size_t)l * 1024 * NMOD + n0 + lane;
        float acc[32];
#pragma unroll
        for (int j = 0; j < 32; ++j) acc[j] = 0.f;
        for (int d0 = 128 * w; d0 < 128 * w + 128; d0 += 16) {
            float wv[16];
#pragma unroll
            for (int q = 0; q < 16; ++q) wv[q] = wp[(size_t)(d0 + q) * NMOD];
#pragma unroll
            for (int q = 0; q < 16; ++q) {
                const int d = d0 + q;
#pragma unroll
                for (int i = 0; i < 8; ++i) {
                    const f32x4 cv = *(const f32x4*)(ca + d * 32 + (((i + (d & 7)) & 7) << 2));
                    acc[4 * i + 0] += cv[0] * wv[q]; acc[4 * i + 1] += cv[1] * wv[q]; acc[4 * i + 2] += cv[2] * wv[q]; acc[4 * i + 3] += cv[3] * wv[q];
                }
            }
        }
        __syncthreads();
        float* part = (float*)lds;
#pragma unroll
        for (int j = 0; j < 32; ++j) part[(w * 32 + j) * 64 + lane] = acc[j];
        __syncthreads();
        for (int o = tid; o < NB * 64; o += 512) {
            const int bb = o >> 6, col = o & 63;
            float sm = 0.f;
#pragma unroll
            for (int ww = 0; ww < 8; ++ww) sm += part[(ww * 32 + bb) * 64 + col];
            p.mod[((size_t)l * NB + bb) * NMOD + n0 + col] = sm + p.b_ada[l * NMOD + n0 + col];
        }
        __syncthreads();
    }
    __syncthreads();
}

template <int MODE>
__device__ __forceinline__ void phase_norm1(const Params& p, int l) {
#ifndef NORM_NT
#define NORM_NT 2
#endif
    constexpr int NT = NORM_NT;
    const int tid = opaque_tid(p.wid), w = tid >> 6, lane = tid & 63;
    const float* g = (MODE == 2) ? p.g_final : p.g_norm1 + l * D;
    const float* modl = p.mod + (size_t)(MODE == 2 ? 1 : l) * NB * NMOD;
    const float* modp = p.mod + (size_t)(MODE == 2 ? 1 : (l > 0 ? l - 1 : 0)) * NB * NMOD;
    f32x4 gg4[4];
#pragma unroll
    for (int k = 0; k < 4; ++k) gg4[k] = *(const f32x4*)(g + 4 * lane + 256 * k);
    for (int t0 = (blockIdx.x * 8 + w) * NT; t0 < T; t0 += gridDim.x * 8 * NT) {
        const int b0 = t0 >> 11;
        f32x4 sc4[4], sh4[4], gt4[4];
        if (MODE != 2) {
#pragma unroll
            for (int k = 0; k < 4; ++k) { sc4[k] = *(const f32x4*)(modl + (size_t)b0 * NMOD + 1024 + 4 * lane + 256 * k); sh4[k] = *(const f32x4*)(modl + (size_t)b0 * NMOD + 4 * lane + 256 * k); }
        }
        if (MODE >= 1) {
#pragma unroll
            for (int k = 0; k < 4; ++k) gt4[k] = *(const f32x4*)(modp + (size_t)b0 * NMOD + 5 * 1024 + 4 * lane + 256 * k);
        }
        f32x4 v[NT][4];
#pragma unroll
        for (int u = 0; u < NT; ++u)
#pragma unroll
            for (int k = 0; k < 4; ++k) {
                if (MODE == 0) v[u][k] = *(const f32x4*)(p.x + (size_t)(t0 + u) * D + 4 * lane + 256 * k);
                else { const u32x2 w2 = *(const u32x2*)(p.xb + (size_t)(t0 + u) * D + 4 * lane + 256 * k); v[u][k] = (f32x4){bflo(w2.x), bfhi(w2.x), bflo(w2.y), bfhi(w2.y)}; }
            }
        if (MODE >= 1) {
            u32x2 y0[NT][4], y1[NT][4];
#pragma unroll
            for (int u = 0; u < NT; ++u)
#pragma unroll
                for (int k = 0; k < 4; ++k) { const int col = 4 * lane + 256 * k;
                    y0[u][k] = *(const u32x2*)(p.ys + ((size_t)(t0 + u) * 2 + 0) * D + col); y1[u][k] = *(const u32x2*)(p.ys + ((size_t)(t0 + u) * 2 + 1) * D + col); }
#pragma unroll
            for (int u = 0; u < NT; ++u) {
                const int b = (t0 + u) >> 11;
#pragma unroll
                for (int k = 0; k < 4; ++k) {
                    const int col = 4 * lane + 256 * k;
                    const f32x4 gt = gt4[k];
                    v[u][k][0] += gt[0] * (bflo(y0[u][k].x) + bflo(y1[u][k].x)); v[u][k][1] += gt[1] * (bfhi(y0[u][k].x) + bfhi(y1[u][k].x));
                    v[u][k][2] += gt[2] * (bflo(y0[u][k].y) + bflo(y1[u][k].y)); v[u][k][3] += gt[3] * (bfhi(y0[u][k].y) + bfhi(y1[u][k].y));
                }
            }
        }
#pragma unroll
        for (int u = 0; u < NT; ++u) {
            const int t = t0 + u, b = t >> 11;
            float ss = 0.f;
#pragma unroll
            for (int k = 0; k < 4; ++k) ss += v[u][k][0] * v[u][k][0] + v[u][k][1] * v[u][k][1] + v[u][k][2] * v[u][k][2] + v[u][k][3] * v[u][k][3];
            ss = wave_sum(ss);
            const float r = rsqrtf(ss * (1.0f / D) + EPS);
#pragma unroll
            for (int k = 0; k < 4; ++k) {
                const int col = 4 * lane + 256 * k;
                f32x4 y = v[u][k] * r * gg4[k];
                if (MODE == 2) { *(f32x4*)(p.xo + (size_t)t * D + col) = y; }
                else {
                    if (MODE == 1) { u32x2 xw; xw.x = cvt_pk_bf16(v[u][k][0], v[u][k][1]); xw.y = cvt_pk_bf16(v[u][k][2], v[u][k][3]); *(u32x2*)(p.xb + (size_t)t * D + col) = xw; }
                    y = y * (1.f + sc4[k]) + sh4[k];
                    u32x2 o; o.x = cvt_pk_bf16(y[0], y[1]); o.y = cvt_pk_bf16(y[2], y[3]);
                    *(u32x2*)(p.h + (size_t)t * D + col) = o;
                }
            }
        }
    }
}
}

namespace {
using pg8::Unit;
struct EpiStoreBf16 {
    static constexpr bool PERM = true;
    bf16_t* O; int ldc;
    __device__ __forceinline__ void operator()(const f32x4 (&acc)[2][2][4][2], const Unit& u, int wr, int wc, int fr_, int fq_) const {
        int fr = fr_, fq = fq_; asm volatile("" : "+v"(fr), "+v"(fq));
        const int row0 = u.pm * 256 + wr * 64 + fr, col0 = u.pn * 256 + wc * 32 + 8 * fq;
#pragma unroll
        for (int ai = 0; ai < 2; ++ai)
#pragma unroll
            for (int m = 0; m < 4; ++m) { bf16_t* rowp = O + (size_t)(row0 + ai * 128 + m * 16) * ldc + col0;
#pragma unroll
                for (int bj = 0; bj < 2; ++bj) { const f32x4 v0 = acc[ai][bj][m][0], v1 = acc[ai][bj][m][1];
                    u32x4 w; w.x = cvt_pk_bf16(v0[0], v0[1]); w.y = cvt_pk_bf16(v0[2], v0[3]); w.z = cvt_pk_bf16(v1[0], v1[1]); w.w = cvt_pk_bf16(v1[2], v1[3]);
                    *(u32x4*)(rowp + bj * 128) = w; } }
    }
};
struct EpiResidual {
    static constexpr bool PERM = false;
    const float* xin32; bf16_t* xb; const float* gate;
    __device__ __forceinline__ void operator()(const f32x4 (&acc)[2][2][4][2], const Unit& u, int wr, int wc, int fr_, int fq_) const {
        int fr = fr_, fq = fq_; asm volatile("" : "+v"(fr), "+v"(fq));
        const int row0 = u.pm * 256 + wr * 64 + fr, col0 = u.pn * 256 + wc * 32 + 4 * fq;
        const int b = (u.pm * 256) >> 11;
        f32x4 gv[2][2];
#pragma unroll
        for (int bj = 0; bj < 2; ++bj)
#pragma unroll
            for (int n = 0; n < 2; ++n) gv[bj][n] = *(const f32x4*)(gate + (size_t)b * NMOD + col0 + bj * 128 + n * 16);
#pragma unroll
        for (int ai = 0; ai < 2; ++ai)
#pragma unroll
            for (int m = 0; m < 4; ++m) { const size_t ro = (size_t)(row0 + ai * 128 + m * 16) * D + col0;
#pragma unroll
                for (int bj = 0; bj < 2; ++bj)
#pragma unroll
                    for (int n = 0; n < 2; ++n) { const size_t o = ro + bj * 128 + n * 16;
                        f32x4 xv;
                        if (xin32) xv = *(const f32x4*)(xin32 + o);
                        else { const u32x2 w = *(const u32x2*)(xb + o); xv = (f32x4){bflo(w.x), bfhi(w.x), bflo(w.y), bfhi(w.y)}; }
                        const f32x4 r = xv + gv[bj][n] * acc[ai][bj][m][n];
                        u32x2 ow; ow.x = cvt_pk_bf16(r[0], r[1]); ow.y = cvt_pk_bf16(r[2], r[3]);
                        *(u32x2*)(xb + o) = ow; } }
    }
};
struct EpiMlaQ {
    static constexpr bool PERM = true;
    bf16_t* qm;
    __device__ __forceinline__ void operator()(const f32x4 (&acc)[2][2][4][2], const Unit& u, int wr, int wc, int fr_, int fq_) const {
        int fr = fr_, fq = fq_; asm volatile("" : "+v"(fr), "+v"(fq));
        const int row0 = u.pm * 256 + wr * 64 + fr;
#pragma unroll
        for (int bj = 0; bj < 2; ++bj) {
            const int col0 = u.pn * 256 + bj * 128 + wc * 32;
            if (col0 >= 384) continue;
#pragma unroll
            for (int ai = 0; ai < 2; ++ai)
#pragma unroll
                for (int m = 0; m < 4; ++m) { const f32x4 v0 = acc[ai][bj][m][0], v1 = acc[ai][bj][m][1];
                    u32x4 w; w.x = cvt_pk_bf16(v0[0], v0[1]); w.y = cvt_pk_bf16(v0[2], v0[3]); w.z = cvt_pk_bf16(v1[0], v1[1]); w.w = cvt_pk_bf16(v1[2], v1[3]);
                    *(u32x4*)(qm + (size_t)(row0 + ai * 128 + m * 16) * 384 + col0 + 8 * fq) = w; }
        }
    }
};
struct EpiMlaKV {
    static constexpr bool PERM = true;
    bf16_t* km; bf16_t* vm;
    __device__ __forceinline__ void operator()(const f32x4 (&acc)[2][2][4][2], const Unit& u, int wr, int wc, int fr_, int fq_) const {
        int fr = fr_, fq = fq_; asm volatile("" : "+v"(fr), "+v"(fq));
        const int row0 = u.pm * 256 + wr * 64 + fr;
#pragma unroll
        for (int bj = 0; bj < 2; ++bj) {
            const int head = u.pn * 2 + bj, wcol = wc * 32 + 8 * fq;
#pragma unroll
            for (int ai = 0; ai < 2; ++ai)
#pragma unroll
                for (int m = 0; m < 4; ++m) {
                    const int row = row0 + ai * 128 + m * 16;
                    const f32x4 v0 = acc[ai][bj][m][0], v1 = acc[ai][bj][m][1];
                    u32x4 w; w.x = cvt_pk_bf16(v0[0], v0[1]); w.y = cvt_pk_bf16(v0[2], v0[3]); w.z = cvt_pk_bf16(v1[0], v1[1]); w.w = cvt_pk_bf16(v1[2], v1[3]);
                    bf16_t* q = (wcol < 64) ? km + (size_t)row * 384 + head * 96 + wcol : vm + (size_t)row * 256 + head * 64 + (wcol - 64);
                    *(u32x4*)q = w;
                    asm volatile("" ::: "memory");
                }
        }
    }
};
struct EpiGateUp {
    static constexpr bool PERM = false;
    bf16_t* hid;
    __device__ __forceinline__ void operator()(const f32x4 (&acc)[2][2][4][2], const Unit& u, int wr, int wc, int fr_, int fq_) const {
        int fr = fr_, fq = fq_; asm volatile("" : "+v"(fr), "+v"(fq));
        const int row0 = u.pm * 256 + wr * 64 + fr;
#pragma unroll
        for (int ai = 0; ai < 2; ++ai)
#pragma unroll
            for (int m = 0; m < 4; ++m) { bf16_t* rowp = hid + (size_t)(row0 + ai * 128 + m * 16) * 256;
#pragma unroll
                for (int bj = 0; bj < 2; ++bj) { const f32x4 gt = acc[ai][bj][m][0], up = acc[ai][bj][m][1];
                    f32x4 o;
#pragma unroll
                    for (int j = 0; j < 4; ++j) o[j] = gt[j] / (1.f + __expf(-gt[j])) * up[j];
                    u32x2 w; w.x = cvt_pk_bf16(o[0], o[1]); w.y = cvt_pk_bf16(o[2], o[3]);
                    *(u32x2*)(rowp + 16 * (u.pn * 8 + bj * 4 + wc) + 4 * fq) = w; } }
    }
};
struct EpiDown {
    static constexpr bool PERM = true;
    bf16_t* ys; const int* list; const float* wl; const int* cnt;
    __device__ __forceinline__ void operator()(const f32x4 (&acc)[2][2][4][2], const Unit& u, int wr, int wc, int fr_, int fq_) const {
        int fr = fr_, fq = fq_; asm volatile("" : "+v"(fr), "+v"(fq));
        const int n = cnt[u.e]; const int* le = list + (size_t)u.e * ECAP; const float* we = wl + (size_t)u.e * ECAP;
        const int col0 = u.pn * 256 + wc * 32 + 8 * fq;
        int slot[8]; float w8[8];
#pragma unroll
        for (int q = 0; q < 8; ++q) { const int lr = u.mt * 256 + (q >> 2) * 128 + wr * 64 + (q & 3) * 16 + fr; slot[q] = lr < n ? le[lr] : -1; w8[q] = lr < n ? we[lr] : 0.f; }
#pragma unroll
        for (int ai = 0; ai < 2; ++ai)
#pragma unroll
            for (int m = 0; m < 4; ++m) {
                const int q = ai * 4 + m;
                if (slot[q] >= 0) {
                    bf16_t* rowp = ys + (size_t)slot[q] * D + col0;
#pragma unroll
                    for (int bj = 0; bj < 2; ++bj) { const f32x4 v0 = acc[ai][bj][m][0] * w8[q], v1 = acc[ai][bj][m][1] * w8[q];
                        u32x4 w; w.x = cvt_pk_bf16(v0[0], v0[1]); w.y = cvt_pk_bf16(v0[2], v0[3]); w.z = cvt_pk_bf16(v1[0], v1[1]); w.w = cvt_pk_bf16(v1[2], v1[3]);
                        *(u32x4*)(rowp + bj * 128) = w; }
                }
            }
    }
};
struct MoeOrder {
    int pre[17];
    int NT, G, c; const int* list; const int* cnt;
    __device__ __forceinline__ void init(const int* cnt_, const int* list_, int NT_, int G_, int c_) {
        cnt = cnt_; list = list_; NT = NT_; G = G_; c = c_; int a = 0;
#pragma unroll
        for (int e = 0; e < 16; ++e) { pre[e] = a; a += (cnt_[e] + 255) >> 8; }
        pre[16] = a;
    }
    __device__ __forceinline__ bool next(int i, Unit& u) const {
        const int L = i * G + c; if (L >= pre[16] * NT) return false;
        const int t = L / NT; int e = 0;
#pragma unroll
        for (int k = 1; k < 16; ++k) e += (t >= pre[k]) ? 1 : 0;
        int pe = 0;
#pragma unroll
        for (int k = 0; k < 16; ++k) pe = (k == e) ? pre[k] : pe;
        u.e = e; u.mt = t - pe; u.pm = t; u.pn = L - t * NT; return true;
    }
    __device__ __forceinline__ int arow(const Unit& u, int r) const { const int lr = u.mt * 256 + r; return lr < cnt[u.e] ? (list[(size_t)u.e * ECAP + lr] >> 1) : 0; }
};
}

namespace {
__device__ __forceinline__ void phase_prep(const Params& p, int l) {
    const int tid = opaque_tid(p.wid), w = tid >> 6, lane = tid & 63;
    const int gw = blockIdx.x * 8 + w, nw = gridDim.x * 8;
    for (int sq = gw; sq < NB * 4; sq += nw) {
        const int b = sq >> 2, hh = sq & 3; const float bias = p.b_forget[l * 4 + hh];
        float lf[32]; float run = 0.f;
#pragma unroll
        for (int j = 0; j < 32; ++j) {
            const float z = bf2f(p.proj[(size_t)(b * S + lane * 32 + j) * NP + PC_AF + hh]) + bias;
            run += fminf(z, 0.f) - log1pf(__expf(-fabsf(z)));
            lf[j] = run;
        }
        float incl = run;
#pragma unroll
        for (int o = 1; o < 64; o <<= 1) { const float t2 = __shfl_up(incl, o); if (lane >= o) incl += t2; }
        const float excl = incl - run;
#pragma unroll
        for (int j = 0; j < 32; ++j) p.cbF[(size_t)sq * S + lane * 32 + j] = -(excl + lf[j]) * LOG2E;
    }
    for (int c32 = gw; c32 < T / 32; c32 += nw) {
    float mxq = 0.f, mxk = 0.f;
#define PREP_LOAD(tt) do { const bf16_t* _row = p.proj + (size_t)(tt) * NP; \
        n_cq = *(const u32x2*)(_row + PC_BCQ + 4 * lane); n_ck = *(const unsigned*)(_row + PC_BCKV + 2 * lane); \
        n_aq = *(const u32x2*)(_row + PC_AQ + 4 * lane); n_ak = *(const u32x2*)(_row + PC_AK + 4 * lane); \
        n_ki = *(const u32x4*)(_row + PC_DKI + 8 * (lane & 3)); n_kr = _row[PC_BKR + (lane & 31)]; } while (0)
    u32x2 n_cq, n_aq, n_ak; unsigned n_ck; u32x4 n_ki; bf16_t n_kr;
    PREP_LOAD(c32 * 32);
    for (int it = 0; it < 32; ++it) {
        const int t = c32 * 32 + it;
        const u32x2 cq = n_cq, aq = n_aq, ak = n_ak; const unsigned ck = n_ck; const u32x4 ki = n_ki; const bf16_t krb = n_kr;
        if (it < 31) PREP_LOAD(t + 1);
        float s1 = bflo(cq.x) * bflo(cq.x) + bfhi(cq.x) * bfhi(cq.x) + bflo(cq.y) * bflo(cq.y) + bfhi(cq.y) * bfhi(cq.y);
        float s2 = bflo(ck) * bflo(ck) + bfhi(ck) * bfhi(ck);
        s1 = wave_sum(s1); s2 = wave_sum(s2);
        if (lane < 4) *(u32x4*)(p.kidx + (size_t)t * 32 + 8 * lane) = ki;
        {
            float nq = bflo(aq.x) * bflo(aq.x) + bfhi(aq.x) * bfhi(aq.x) + bflo(aq.y) * bflo(aq.y) + bfhi(aq.y) * bfhi(aq.y);
            float nk = bflo(ak.x) * bflo(ak.x) + bfhi(ak.x) * bfhi(ak.x) + bflo(ak.y) * bflo(ak.y) + bfhi(ak.y) * bfhi(ak.y);
#pragma unroll
            for (int o = 8; o > 0; o >>= 1) { nq += __shfl_xor(nq, o); nk += __shfl_xor(nk, o); }
            mxq = fmaxf(mxq, nq); mxk = fmaxf(mxk, nk);
        }
        const float kr = (lane < 32) ? bf2f(krb) : 0.f;
        const float kr2 = __shfl(kr, (lane + 16) & 63);
        {
            const float r1 = rsqrtf(s1 * (1.f / 256.f) + EPS), r2 = rsqrtf(s2 * (1.f / 128.f) + EPS);
            u32x2 o; o.x = cvt_pk_bf16(bflo(cq.x) * r1, bfhi(cq.x) * r1); o.y = cvt_pk_bf16(bflo(cq.y) * r1, bfhi(cq.y) * r1);
            *(u32x2*)(p.proj + (size_t)t * NP + PC_BCQ + 4 * lane) = o;
            *(unsigned*)(p.proj + (size_t)t * NP + PC_BCKV + 2 * lane) = cvt_pk_bf16(bflo(ck) * r2, bfhi(ck) * r2);
        }
        if (lane < 16) {
            const int pos = t & (S - 1);
            const float cs = p.ropetab[(pos * 16 + lane) * 2], sn = p.ropetab[(pos * 16 + lane) * 2 + 1];
            const bf16_t o1 = f2bf(kr * cs - kr2 * sn), o2 = f2bf(kr2 * cs + kr * sn);
            bf16_t* kmr = p.km + (size_t)t * 384;
#pragma unroll
            for (int hh = 0; hh < 4; ++hh) { kmr[hh * 96 + 64 + lane] = o1; kmr[hh * 96 + 80 + lane] = o2; }
        }
    }
#undef PREP_LOAD
    if ((lane & 15) == 0) {
        const int t = c32 * 32, bb = t >> 11, pos = t & (S - 1), hh = lane >> 4;
        atomicMax(p.ctl + CW_KN2 + ((l * NB + bb) * 4 + hh) * 32 + (pos >> 6), __float_as_uint(mxk));
        atomicMax(p.ctl + CW_QN2 + ((l * NB + bb) * 4 + hh) * 8 + (pos >> 8), __float_as_uint(mxq));
    }
    }
}

__device__ __forceinline__ void phase_route(const Params& p, int l, char* lds) {
    const int tid = opaque_tid(p.wid), w = tid >> 6, lane = tid & 63;
    float* wrT = (float*)lds;
    int* lcnt = (int*)(lds + 65536);
    int* lbase = (int*)(lds + 65536 + 64);
    int* tsel = (int*)(lds + 65536 + 128);
    float* twt = (float*)(lds + 65536 + 128 + 2048);
    float* lgt = (float*)(lds + 65536 + 8192);
    for (int i = tid; i < 16 * 1024; i += 512) { const int e = i >> 10, d = i & 1023; wrT[i] = p.w_router[d * 16 + e]; }
    const float* g = p.g_norm2 + l * D;
    const float* modl = p.mod + (size_t)l * NB * NMOD;
    int* cnt = (int*)(p.ctl + CW_CNT) + l * 16 + 32 * p.qslot;
    int* list = p.list + (size_t)p.qslot * 16 * ECAP;
    for (int chunk = blockIdx.x; chunk < T / 256; chunk += gridDim.x) {
        if (tid < 16) lcnt[tid] = 0;
        __syncthreads();
        const int b = (chunk * 256) >> 11;
        f32x4 gs4[4], sh4[4];
#pragma unroll
        for (int k = 0; k < 4; ++k) { const int col = 4 * lane + 256 * k; const f32x4 gg = *(const f32x4*)(g + col);
            const f32x4 sc = *(const f32x4*)(modl + (size_t)b * NMOD + 4 * 1024 + col); gs4[k] = gg * (1.f + sc); sh4[k] = *(const f32x4*)(modl + (size_t)b * NMOD + 3 * 1024 + col); }
        const int eown = ((lane >> 5) & 1) * 8 + ((lane >> 4) & 1) * 4 + ((lane >> 3) & 1) * 2 + ((lane >> 2) & 1);
        u32x2 raw[2][4];
#pragma unroll
        for (int q = 0; q < 2; ++q)
#pragma unroll
            for (int k = 0; k < 4; ++k) raw[q][k] = *(const u32x2*)(p.xb + (size_t)(chunk * 256 + w * 32 + q) * D + 4 * lane + 256 * k);
        for (int it = 0; it < 32; it += 2) {
            const int li = w * 32 + it, t = chunk * 256 + li;
            f32x4 v[2][4];
#pragma unroll
            for (int q = 0; q < 2; ++q)
#pragma unroll
                for (int k = 0; k < 4; ++k) v[q][k] = (f32x4){bflo(raw[q][k].x), bfhi(raw[q][k].x), bflo(raw[q][k].y), bfhi(raw[q][k].y)};
            if (it < 30) {
#pragma unroll
                for (int q = 0; q < 2; ++q)
#pragma unroll
                    for (int k = 0; k < 4; ++k) raw[q][k] = *(const u32x2*)(p.xb + (size_t)(t + 2 + q) * D + 4 * lane + 256 * k);
            }
            float ss0 = 0.f, ss1 = 0.f;
#pragma unroll
            for (int k = 0; k < 4; ++k) { ss0 += v[0][k][0] * v[0][k][0] + v[0][k][1] * v[0][k][1] + v[0][k][2] * v[0][k][2] + v[0][k][3] * v[0][k][3];
                                          ss1 += v[1][k][0] * v[1][k][0] + v[1][k][1] * v[1][k][1] + v[1][k][2] * v[1][k][2] + v[1][k][3] * v[1][k][3]; }
            ss0 = wave_sum(ss0); ss1 = wave_sum(ss1);
            const float r0 = rsqrtf(ss0 * (1.0f / D) + EPS), r1 = rsqrtf(ss1 * (1.0f / D) + EPS);
            f32x2 lgp[16];
#pragma unroll
            for (int e = 0; e < 16; ++e) lgp[e] = (f32x2){0.f, 0.f};
#pragma unroll
            for (int k = 0; k < 4; ++k) {
                const int col = 4 * lane + 256 * k;
                const f32x4 y0 = v[0][k] * r0 * gs4[k] + sh4[k], y1 = v[1][k] * r1 * gs4[k] + sh4[k];
                u32x2 o0, o1; o0.x = cvt_pk_bf16(y0[0], y0[1]); o0.y = cvt_pk_bf16(y0[2], y0[3]); o1.x = cvt_pk_bf16(y1[0], y1[1]); o1.y = cvt_pk_bf16(y1[2], y1[3]);
                *(u32x2*)(p.h + (size_t)t * D + col) = o0; *(u32x2*)(p.h + (size_t)(t + 1) * D + col) = o1;
                const f32x2 yp0 = {y0[0], y1[0]}, yp1 = {y0[1], y1[1]}, yp2 = {y0[2], y1[2]}, yp3 = {y0[3], y1[3]};
#pragma unroll
                for (int e = 0; e < 16; ++e) { const f32x4 wv = *(const f32x4*)(wrT + e * 1024 + col);
                    lgp[e] = __builtin_elementwise_fma(yp0, (f32x2){wv[0], wv[0]}, lgp[e]); lgp[e] = __builtin_elementwise_fma(yp1, (f32x2){wv[1], wv[1]}, lgp[e]);
                    lgp[e] = __builtin_elementwise_fma(yp2, (f32x2){wv[2], wv[2]}, lgp[e]); lgp[e] = __builtin_elementwise_fma(yp3, (f32x2){wv[3], wv[3]}, lgp[e]); }
                asm volatile("" ::: "memory");
            }
#pragma unroll
            for (int q = 0; q < 2; ++q) {
                float lg[16];
#pragma unroll
                for (int e = 0; e < 16; ++e) lg[e] = lgp[e][q];
                float a8[8], a4[4], a2[2], a1;
                { const bool hi = (lane & 32) != 0;
#pragma unroll
                  for (int e = 0; e < 8; ++e) { const float send = hi ? lg[e] : lg[e + 8], keep = hi ? lg[e + 8] : lg[e]; a8[e] = keep + __shfl_xor(send, 32); } }
                { const bool hi = (lane & 16) != 0;
#pragma unroll
                  for (int e = 0; e < 4; ++e) { const float send = hi ? a8[e] : a8[e + 4], keep = hi ? a8[e + 4] : a8[e]; a4[e] = keep + __shfl_xor(send, 16); } }
                { const bool hi = (lane & 8) != 0;
#pragma unroll
                  for (int e = 0; e < 2; ++e) { const float send = hi ? a4[e] : a4[e + 2], keep = hi ? a4[e + 2] : a4[e]; a2[e] = keep + __shfl_xor(send, 8); } }
                { const bool hi = (lane & 4) != 0; const float send = hi ? a2[0] : a2[1], keep = hi ? a2[1] : a2[0]; a1 = keep + __shfl_xor(send, 4); }
                a1 += __shfl_xor(a1, 2); a1 += __shfl_xor(a1, 1);
                if ((lane & 3) == 0) lgt[(li + q) * 16 + eown] = a1;
            }
        }
        asm volatile("s_waitcnt lgkmcnt(0)" ::: "memory");
        __builtin_amdgcn_wave_barrier();
        if (lane < 32) {
            const int li = w * 32 + lane;
            float sc[16], bi[16];
#pragma unroll
            for (int e4 = 0; e4 < 4; ++e4) { const f32x4 a = *(const f32x4*)(lgt + li * 16 + 4 * e4);
#pragma unroll
                for (int j = 0; j < 4; ++j) { const float sg = 1.f / (1.f + expf(-a[j])); sc[4 * e4 + j] = sg; bi[4 * e4 + j] = sg + p.b_router[4 * e4 + j]; } }
            int bg = 0; float bgs = -INFINITY;
#pragma unroll
            for (int gi = 0; gi < 4; ++gi) {
                float m1 = -INFINITY, m2 = -INFINITY;
#pragma unroll
                for (int j = 0; j < 4; ++j) { const float vv = bi[gi * 4 + j]; if (vv > m1) { m2 = m1; m1 = vv; } else if (vv > m2) m2 = vv; }
                const float gs = m1 + m2; if (gs > bgs) { bgs = gs; bg = gi; }
            }
            float b4[4], s4[4];
#pragma unroll
            for (int j = 0; j < 4; ++j) { b4[j] = bi[j]; s4[j] = sc[j]; }
#pragma unroll
            for (int gi = 1; gi < 4; ++gi)
#pragma unroll
                for (int j = 0; j < 4; ++j) { b4[j] = (gi == bg) ? bi[gi * 4 + j] : b4[j]; s4[j] = (gi == bg) ? sc[gi * 4 + j] : s4[j]; }
            int i1 = 0; float v1 = -INFINITY;
#pragma unroll
            for (int j = 0; j < 4; ++j) { if (b4[j] > v1) { v1 = b4[j]; i1 = j; } }
            int i2 = 0; float v2 = -INFINITY;
#pragma unroll
            for (int j = 0; j < 4; ++j) { if (j != i1 && b4[j] > v2) { v2 = b4[j]; i2 = j; } }
            float w1 = 0.f, w2 = 0.f;
#pragma unroll
            for (int j = 0; j < 4; ++j) { w1 = (j == i1) ? s4[j] : w1; w2 = (j == i2) ? s4[j] : w2; }
            const int e1 = bg * 4 + i1, e2 = bg * 4 + i2; const float ws = w1 + w2;
            const int r1 = atomicAdd(&lcnt[e1], 1), r2 = atomicAdd(&lcnt[e2], 1);
            tsel[li * 2 + 0] = (e1 << 16) | r1; tsel[li * 2 + 1] = (e2 << 16) | r2;
            twt[li * 2 + 0] = w1 / ws; twt[li * 2 + 1] = w2 / ws;
        }
        __syncthreads();
        if (tid < 16) lbase[tid] = atomicAdd(&cnt[tid], lcnt[tid]);
        __syncthreads();
        { const int v = tsel[tid], e = v >> 16, rk = v & 0xFFFF; const size_t pos = (size_t)e * ECAP + lbase[e] + rk;
          list[pos] = (chunk * 256 + (tid >> 1)) * 2 + (tid & 1); p.wl[pos + (size_t)p.qslot * 16 * ECAP] = twt[tid]; }
        __syncthreads();
    }
}
}

#ifndef ATTN_VMASK
#define ATTN_VMASK 15
#endif
#ifndef REPK_VMASK
#define REPK_VMASK 15
#endif
#ifndef ATTN_DMA
#define ATTN_DMA 1
#endif
#ifndef ATTN_EXP
#define ATTN_EXP 0
#endif
#define AEXP(k) (ATTN_EXP == (k) && xq)
namespace {
constexpr int AT_KB = 0;
constexpr int AT_KR = 16384;
constexpr int AT_VB = 24576;
constexpr int AT_CB = 40960;
constexpr int AT_CTL = 41472;
constexpr int AT_LDS = 41984;
constexpr float NEGBIG = -1.0e30f;

template <int VAR, int KC, bool FULL>
__device__ __forceinline__ void attn_tile_impl(LAS3 char* lds, const int buf, const int j, const int q0, const int i, const int g, const int swk, const float slope2,
                                          const bf16x8 (&qf)[2][KC], f32x4 (&o)[2][4], float (&mrow)[2], float (&lsum)[2], const u32x4 (&mwd)[2][4], const bool xq) {
    typedef LAS3 bf16x4 lds_bf16x4;
    bool need = (64 * j <= q0 + 31);
    if (VAR == 2) need = need && (64 * j + 63 >= q0 - 127);
    if (need) {
        const LAS3 char* Kb = lds + AT_KB + buf * 8192; const LAS3 char* Vb = lds + AT_VB + buf * 8192;
        constexpr bool full = FULL;
        f32x4 s[2][4];
#pragma unroll
        for (int qt = 0; qt < 2; ++qt) {
            const int t = q0 + 16 * qt + i;
            const int dbase = 64 * j + 4 * g - t;
            const float sb = slope2 * ((VAR == 2) ? (float)dbase : (float)(64 * j + 4 * g));
#pragma unroll
            for (int mt = 0; mt < 4; ++mt) {
                f32x4 ini = {0.f, 0.f, 0.f, 0.f};
                if (VAR == 0) ini = *(const LAS3 f32x4*)(lds + AT_CB + buf * 256 + (16 * mt + 4 * g) * 4);
#pragma unroll
                for (int r = 0; r < 4; ++r) {
                    const int c = 16 * mt + r;
                    float v = ini[r];
                    if (VAR >= 2) v = sb + slope2 * (float)c;
                    if (VAR == 3) {
                        const int m = ((int)(mwd[qt][mt][r] << (31 - j))) >> 31;
                        v = __uint_as_float((__float_as_uint(v) & (unsigned)m) | (__float_as_uint(NEGBIG) & ~(unsigned)m));
                    } else if (!full) {
                        bool ok;
                        if (VAR == 2) ok = (unsigned)(dbase + c + 127) < 128u;
                        else ok = (dbase + c) <= 0;
                        v = ok ? v : NEGBIG;
                    }
                    ini[r] = v;
                }
                s[qt][mt] = ini;
            }
        }
        if (!AEXP(2))
#pragma unroll
        for (int mt = 0; mt < 4; ++mt) {
#pragma unroll
            for (int kc = 0; kc < 2; ++kc) {
                const bf16x8 kf = AEXP(7) ? qf[0][kc] : *(const LAS3 bf16x8*)(Kb + (mt * 16 + i) * 128 + (((kc * 4 + g) ^ swk) << 4));
                s[0][mt] = __builtin_amdgcn_mfma_f32_16x16x32_bf16(kf, qf[0][kc], s[0][mt], 0, 0, 0);
                s[1][mt] = __builtin_amdgcn_mfma_f32_16x16x32_bf16(kf, qf[1][kc], s[1][mt], 0, 0, 0);
            }
            if (VAR == 1) {
                const bf16x8 kf = *(const LAS3 bf16x8*)(lds + AT_KR + buf * 4096 + (mt * 16 + i) * 64 + ((g ^ (swk & 3)) << 4));
                s[0][mt] = __builtin_amdgcn_mfma_f32_16x16x32_bf16(kf, qf[0][KC - 1], s[0][mt], 0, 0, 0);
                s[1][mt] = __builtin_amdgcn_mfma_f32_16x16x32_bf16(kf, qf[1][KC - 1], s[1][mt], 0, 0, 0);
            }
        }
        bf16x8 pf[2][2];
#pragma unroll
        for (int qt = 0; qt < 2; ++qt) {
            float mx = AEXP(6) ? 0.f : fmaxf(fmaxf(s[qt][0][0], s[qt][0][1]), fmaxf(s[qt][0][2], s[qt][0][3]));
            if (!AEXP(6)) {
#pragma unroll
            for (int mt = 1; mt < 4; ++mt) mx = fmaxf(mx, fmaxf(fmaxf(s[qt][mt][0], s[qt][mt][1]), fmaxf(s[qt][mt][2], s[qt][mt][3])));
            mx = fmaxf(mx, __builtin_bit_cast(float, __builtin_amdgcn_ds_swizzle(__builtin_bit_cast(int, mx), 0x401F)));
            mx = xor32_max(mx);
            if (__any(mx > mrow[qt])) {
                const float mn = fmaxf(mrow[qt], mx), alpha = __builtin_amdgcn_exp2f(mrow[qt] - mn);
                mrow[qt] = mn; lsum[qt] *= alpha;
#pragma unroll
                for (int dt = 0; dt < 4; ++dt) o[qt][dt] = o[qt][dt] * alpha;
            }
            }
            const float mn = mrow[qt];
            const f32x4 mn4 = {mn, mn, mn, mn};
            f32x4 ps4 = {0.f, 0.f, 0.f, 0.f};
            float x[4][4];
#pragma unroll
            for (int mt = 0; mt < 4; ++mt) {
                const f32x4 d4 = s[qt][mt] - mn4;
                f32x4 e4;
#pragma unroll
                for (int r = 0; r < 4; ++r) { e4[r] = (AEXP(3) || AEXP(6)) ? d4[r] : __builtin_amdgcn_exp2f(d4[r]); x[mt][r] = e4[r]; }
                ps4 += e4;
            }
            lsum[qt] += (ps4[0] + ps4[1]) + (ps4[2] + ps4[3]);
#pragma unroll
            for (int c = 0; c < 2; ++c) {
                u32x4 pk; pk.x = cvt_pk_bf16(x[2 * c][0], x[2 * c][1]); pk.y = cvt_pk_bf16(x[2 * c][2], x[2 * c][3]);
                pk.z = cvt_pk_bf16(x[2 * c + 1][0], x[2 * c + 1][1]); pk.w = cvt_pk_bf16(x[2 * c + 1][2], x[2 * c + 1][3]);
                pf[qt][c] = __builtin_bit_cast(bf16x8, pk);
            }
        }
        const int q4 = i >> 2, p4 = i & 3;
        if (!AEXP(4))
#pragma unroll
        for (int c = 0; c < 2; ++c) {
            const int row0 = 32 * c + 4 * g + q4, swv = (row0 >> 1) & 3;
#pragma unroll
            for (int dt = 0; dt < 4; ++dt) {
                const LAS3 char* a0 = Vb + row0 * 128 + ((dt ^ swv) << 5) + p4 * 8;
                bf16x4 v0, v1;
                if (AEXP(7)) { v0 = (bf16x4){1, 2, 3, 4}; v1 = v0; } else {
                v0 = __builtin_amdgcn_ds_read_tr16_b64_v4i16((lds_bf16x4*)(a0));
                v1 = __builtin_amdgcn_ds_read_tr16_b64_v4i16((lds_bf16x4*)(a0 + 16 * 128)); }
                const bf16x8 vf = {v0[0], v0[1], v0[2], v0[3], v1[0], v1[1], v1[2], v1[3]};
                o[0][dt] = __builtin_amdgcn_mfma_f32_16x16x32_bf16(vf, pf[0][c], o[0][dt], 0, 0, 0);
                o[1][dt] = __builtin_amdgcn_mfma_f32_16x16x32_bf16(vf, pf[1][c], o[1][dt], 0, 0, 0);
            }
        }
    }
}

template <int VAR, int KC>
__device__ __forceinline__ void attn_tile(LAS3 char* lds, const int buf, const int j, const int q0, const int i, const int g, const int swk, const float slope2,
                                          const bf16x8 (&qf)[2][KC], f32x4 (&o)[2][4], float (&mrow)[2], float (&lsum)[2], const u32x4 (&mwd)[2][4], const bool xq) {
    bool full = (64 * j + 63 <= q0);
    if (VAR == 2) full = full && (64 * j >= q0 - 96);
    if (VAR == 3) full = false;
    if (VAR != 3 && full) attn_tile_impl<VAR, KC, true>(lds, buf, j, q0, i, g, swk, slope2, qf, o, mrow, lsum, mwd, xq);
    else attn_tile_impl<VAR, KC, false>(lds, buf, j, q0, i, g, swk, slope2, qf, o, mrow, lsum, mwd, xq);
}

template <int VAR>
__device__ __forceinline__ void attn_unit(const Params& p, int l, int b, int hx, int qb, LAS3 char* lds) {
    typedef LAS3 bf16x4 lds_bf16x4;
    constexpr int KC = (VAR == 1) ? 3 : 2;
    const int tid = opaque_tid(p.wid), w = __builtin_amdgcn_readfirstlane(tid >> 6), lane = tid & 63, i = lane & 15, g = lane >> 4;
    const bf16_t *Qp, *Kp, *Vp; int ldq, ldk, ldv, q0, j0, j1, ocol; float c1, slope2 = 0.f;
    if (VAR == 0) { Qp = p.proj + PC_AQ + hx * 64; Kp = p.proj + PC_AK + hx * 64; Vp = p.proj + PC_AV + hx * 64; ldq = ldk = ldv = NP;
                    q0 = qb * 256 + 32 * w; j0 = 0; j1 = 4 * qb + 3; ocol = hx * 64; c1 = 0.125f * LOG2E; }
    else if (VAR == 1) { Qp = p.qm + hx * 96; Kp = p.km + hx * 96; Vp = p.vm + hx * 64; ldq = 384; ldk = 384; ldv = 256;
                    q0 = qb * 256 + 32 * w; j0 = 0; j1 = 4 * qb + 3; ocol = 256 + hx * 64; c1 = 0.10206207261596577f * LOG2E; }
    else if (VAR == 2) { const int qh = hx * 2 + (w >> 2); Qp = p.proj + PC_CQ + qh * 64; Kp = p.proj + PC_CK + hx * 64; Vp = p.proj + PC_CV + hx * 64; ldq = ldk = ldv = NP;
                    q0 = qb * 128 + 32 * (w & 3); j0 = 2 * qb - 2 > 0 ? 2 * qb - 2 : 0; j1 = 2 * qb + 1; ocol = 512 + qh * 64; c1 = 0.125f * LOG2E;
                    slope2 = exp2f(-(float)(qh + 1)) * LOG2E; }
    else { const int hd = w >> 1; Qp = p.proj + PC_DQ + hd * 64; Kp = p.proj + PC_DK; Vp = p.proj + PC_DV; ldq = ldk = ldv = NP;
                    q0 = qb * 64 + 32 * (w & 1); j0 = 0; j1 = qb; ocol = 768 + hd * 64; c1 = 0.125f * LOG2E; slope2 = exp2f(-(float)(hd + 5)) * LOG2E; }
    const size_t tok0 = (size_t)b * S;
    const bool xq = p.qslot > 0;
    if (VAR == 0 && qb > 0) {
        constexpr float FOX_DROP = 64.0f;
        const unsigned* kn2 = p.ctl + CW_KN2 + ((l * NB + b) * 4 + hx) * 32;
        const float* cbh = p.cbF + ((size_t)b * 4 + hx) * S;
        const float qn = c1 * sqrtf(__uint_as_float(p.ctl[CW_QN2 + ((l * NB + b) * 4 + hx) * 8 + qb]));
        float knu = 0.f;
        for (int jj = 4 * qb; jj < 4 * qb + 4; ++jj) knu = fmaxf(knu, __uint_as_float(kn2[jj]));
        const float lower = cbh[256 * qb] - qn * sqrtf(knu);
        const int jl = lane & 31;
        const bool keep = qn * sqrtf(__uint_as_float(kn2[jl])) + cbh[64 * jl + 63] - lower >= -FOX_DROP || jl >= 4 * qb;
        const unsigned long long kb = __ballot(keep) & 0xFFFFFFFFull;
        j0 = kb ? (int)__builtin_ctzll(kb) : 4 * qb;
    }
    bf16x8 qf[2][KC];
#pragma unroll
    for (int qt = 0; qt < 2; ++qt)
#pragma unroll
        for (int kc = 0; kc < KC; ++kc) qf[qt][kc] = *(const bf16x8*)(Qp + (tok0 + q0 + 16 * qt + i) * ldq + kc * 32 + 8 * g);
    u32x4 mwd[2][4];
#pragma unroll
    for (int qt = 0; qt < 2; ++qt)
#pragma unroll
        for (int mt = 0; mt < 4; ++mt) mwd[qt][mt] = (VAR == 3) ? *(const u32x4*)(p.mask + (tok0 + q0 + 16 * qt + i) * 64 + 16 * mt + 4 * g) : (u32x4){0u, 0u, 0u, 0u};
#if ATTN_DMA
    const int drow = 8 * w + (lane >> 3), dch = lane & 7;
    const int ksc = dch ^ ((drow >> 1) & 7);
    const int vsc = ((((dch >> 1) ^ ((drow >> 1) & 3)) << 1) | (dch & 1));
    const int rrow = 16 * (w & 3) + (lane >> 2), rsc = (lane & 3) ^ ((rrow >> 1) & 3);
#define AT_DMA(j, buf) do { \
        __builtin_amdgcn_global_load_lds((const unsigned*)(Kp + (tok0 + 64 * (j) + drow) * ldk + ksc * 8), (LAS3 unsigned*)(lds + AT_KB + (buf) * 8192 + w * 1024), 16, 0, 0); \
        __builtin_amdgcn_global_load_lds((const unsigned*)(Vp + (tok0 + 64 * (j) + drow) * ldv + vsc * 8), (LAS3 unsigned*)(lds + AT_VB + (buf) * 8192 + w * 1024), 16, 0, 0); \
        if (VAR == 1 && w < 4) __builtin_amdgcn_global_load_lds((const unsigned*)(Kp + (tok0 + 64 * (j) + rrow) * ldk + 64 + rsc * 8), (LAS3 unsigned*)(lds + AT_KR + (buf) * 4096 + w * 1024), 16, 0, 0); \
        if (VAR == 0 && w == 0) __builtin_amdgcn_global_load_lds((const unsigned*)(p.cbF + ((size_t)b * 4 + hx) * S + 64 * (j) + lane), (LAS3 unsigned*)(lds + AT_CB + (buf) * 256), 4, 0, 0); \
    } while (0)
    AT_DMA(j0, j0 & 1);
#else
    const int sr = tid >> 3, sc8 = tid & 7;
    const int kdst = sr * 128 + ((sc8 ^ ((sr >> 1) & 7)) << 4);
    const int vdst = sr * 128 + (((((sc8 >> 1) ^ ((sr >> 1) & 3)) << 1) | (sc8 & 1)) << 4);
    const int rr = (tid & 255) >> 2, rc4 = tid & 3;
    const int rdst = rr * 64 + ((rc4 ^ ((rr >> 1) & 3)) << 4);
    u32x4 kstA, vstA, rstA = {0u, 0u, 0u, 0u}, kstB, vstB, rstB = {0u, 0u, 0u, 0u}; float cstA = 0.f, cstB = 0.f;
#define AT_LOAD(ZZ, j) do { if (AEXP(1)) break; const size_t _kr = tok0 + 64 * (j) + sr; \
        kst##ZZ = *(const u32x4*)(Kp + _kr * ldk + sc8 * 8); vst##ZZ = *(const u32x4*)(Vp + _kr * ldv + sc8 * 8); \
        if (VAR == 1) rst##ZZ = *(const u32x4*)(Kp + (tok0 + 64 * (j) + rr) * ldk + 64 + rc4 * 8); \
        if (VAR == 0) cst##ZZ = p.cbF[((size_t)b * 4 + hx) * S + 64 * (j) + (tid & 63)]; } while (0)
#define AT_WRITE(ZZ, buf) do { if (AEXP(1)) break; *(LAS3 u32x4*)(lds + AT_KB + (buf) * 8192 + kdst) = kst##ZZ; *(LAS3 u32x4*)(lds + AT_VB + (buf) * 8192 + vdst) = vst##ZZ; \
        if (VAR == 1 && tid < 256) *(LAS3 u32x4*)(lds + AT_KR + (buf) * 4096 + rdst) = rst##ZZ; \
        if (VAR == 0 && tid < 64) *(LAS3 float*)(lds + AT_CB + (buf) * 256 + tid * 4) = cst##ZZ; } while (0)
    AT_LOAD(A, j0);
    AT_LOAD(B, (j0 + 1 <= j1 ? j0 + 1 : j1));
#endif
    if (VAR == 1) {
#pragma unroll
        for (int qt = 0; qt < 2; ++qt) {
            const int pos = q0 + 16 * qt + i;
            const u32x4 mine = __builtin_bit_cast(u32x4, qf[qt][KC - 1]);
            u32x4 oth; oth.x = __shfl_xor(mine.x, 32); oth.y = __shfl_xor(mine.y, 32); oth.z = __shfl_xor(mine.z, 32); oth.w = __shfl_xor(mine.w, 32);
            const float* rt = p.ropetab + (size_t)(pos * 16 + (g & 1) * 8) * 2;
            const float sg = (g < 2) ? -1.f : 1.f;
            u32x4 res;
#pragma unroll
            for (int e2 = 0; e2 < 4; ++e2) {
                const f32x4 cs = *(const f32x4*)(rt + e2 * 4);
                const unsigned mw_ = e2 == 0 ? mine.x : e2 == 1 ? mine.y : e2 == 2 ? mine.z : mine.w, ow_ = e2 == 0 ? oth.x : e2 == 1 ? oth.y : e2 == 2 ? oth.z : oth.w;
                const float r0 = bflo(mw_) * cs[0] + sg * bflo(ow_) * cs[1], r1 = bfhi(mw_) * cs[2] + sg * bfhi(ow_) * cs[3];
                const unsigned pk = cvt_pk_bf16(r0, r1);
                if (e2 == 0) res.x = pk; else if (e2 == 1) res.y = pk; else if (e2 == 2) res.z = pk; else res.w = pk;
            }
            qf[qt][KC - 1] = __builtin_bit_cast(bf16x8, res);
        }
    }
#pragma unroll
    for (int qt = 0; qt < 2; ++qt)
#pragma unroll
        for (int kc = 0; kc < KC; ++kc) {
            u32x4 qq = __builtin_bit_cast(u32x4, qf[qt][kc]);
            qq.x = cvt_pk_bf16(bflo(qq.x) * c1, bfhi(qq.x) * c1); qq.y = cvt_pk_bf16(bflo(qq.y) * c1, bfhi(qq.y) * c1);
            qq.z = cvt_pk_bf16(bflo(qq.z) * c1, bfhi(qq.z) * c1); qq.w = cvt_pk_bf16(bflo(qq.w) * c1, bfhi(qq.w) * c1);
            qf[qt][kc] = __builtin_bit_cast(bf16x8, qq);
        }
    f32x4 o[2][4];
#pragma unroll
    for (int qt = 0; qt < 2; ++qt)
#pragma unroll
        for (int dt = 0; dt < 4; ++dt) o[qt][dt] = (f32x4){0.f, 0.f, 0.f, 0.f};
    float mrow[2] = {NEGBIG, NEGBIG}, lsum[2] = {0.f, 0.f};
#if ATTN_DMA
    const int swk = (i >> 1) & 7;
    asm volatile("s_waitcnt vmcnt(0)" ::: "memory");
    __syncthreads();
    for (int j = j0; j <= j1; ++j) {
        if (j < j1) AT_DMA(j + 1, (j + 1) & 1);
        attn_tile<VAR, KC>(lds, j & 1, j, q0, i, g, swk, slope2, qf, o, mrow, lsum, mwd, xq);
        asm volatile("s_waitcnt vmcnt(0)" ::: "memory");
        __syncthreads();
    }
#undef AT_DMA
#else
    AT_WRITE(A, j0 & 1);
    __syncthreads();
    const int swk = (i >> 1) & 7;
    for (int j = j0; j <= j1; j += 2) {
        AT_LOAD(A, (j + 2 <= j1 ? j + 2 : j1));
        attn_tile<VAR, KC>(lds, j & 1, j, q0, i, g, swk, slope2, qf, o, mrow, lsum, mwd, xq);
        if (j + 1 <= j1) AT_WRITE(B, (j + 1) & 1);
        if (!AEXP(5)) __syncthreads();
        if (j + 1 > j1) break;
        AT_LOAD(B, (j + 3 <= j1 ? j + 3 : j1));
        attn_tile<VAR, KC>(lds, (j + 1) & 1, j + 1, q0, i, g, swk, slope2, qf, o, mrow, lsum, mwd, xq);
        if (j + 2 <= j1) AT_WRITE(A, j & 1);
        if (!AEXP(5)) __syncthreads();
    }
#undef AT_LOAD
#undef AT_WRITE
#endif
#pragma unroll
    for (int qt = 0; qt < 2; ++qt) {
        float lt = lsum[qt]; lt += __shfl_xor(lt, 16); lt += __shfl_xor(lt, 32);
        if (VAR == 2) lt += __builtin_amdgcn_exp2f(p.sinks[l * 4 + hx * 2 + (w >> 2)] * LOG2E - mrow[qt]);
        const float inv = 1.f / lt;
        bf16_t* op = p.merged + (tok0 + q0 + 16 * qt + i) * D + ocol + 4 * g;
        if (!(ATTN_EXP != 0 && xq))
#pragma unroll
        for (int dt = 0; dt < 4; ++dt) { const f32x4 v = o[qt][dt] * inv; u32x2 w2; w2.x = cvt_pk_bf16(v[0], v[1]); w2.y = cvt_pk_bf16(v[2], v[3]); *(u32x2*)(op + 16 * dt) = w2; }
    }
}

__device__ __forceinline__ void phase_attn(const Params& p, int l, LAS3 char* lds) {
    const int tid = opaque_tid(p.wid);
    unsigned* qhead = p.ctl + CW_QA + 64 * (l + 2 * p.qslot);
    volatile LAS3 int* bc = (volatile LAS3 int*)(lds + AT_CTL);
    int nxt = 0;
    if (tid == 0) nxt = (int)__hip_atomic_fetch_add(qhead, 1u, __ATOMIC_RELAXED, __HIP_MEMORY_SCOPE_AGENT);
    for (;;) {
        if (tid == 0) *bc = nxt;
        __syncthreads();
        const int idx = __builtin_amdgcn_readfirstlane(*bc);
        __syncthreads();
        if (idx >= 4096) break;
        if (tid == 0) nxt = (int)__hip_atomic_fetch_add(qhead, 1u, __ATOMIC_RELAXED, __HIP_MEMORY_SCOPE_AGENT);
        const int vmask = p.qslot ? REPK_VMASK : ATTN_VMASK;
        if (idx < 3072) {
            const int lvl = 7 - idx / 384, rem = idx % 384;
            if (rem < 128) { if (vmask & 2) attn_unit<1>(p, l, rem >> 2, rem & 3, lvl, lds); }
            else if (rem < 256) { if (vmask & 1) attn_unit<0>(p, l, (rem - 128) >> 2, rem & 3, lvl, lds); }
            else { const int d = rem - 256; if (vmask & 8) attn_unit<3>(p, l, d & 31, 0, 4 * lvl + 3 - (d >> 5), lds); }
        } else { const int c = idx - 3072; if (vmask & 4) attn_unit<2>(p, l, c >> 5, (c >> 4) & 1, c & 15, lds); }
    }
}
}

namespace {
constexpr int DS_LD = 2052;
constexpr int DS_CTL = 16 * DS_LD * 4;
constexpr int DS_LDS = DS_CTL + 64;

__device__ __forceinline__ void dsa_unit(const Params& p, int u, LAS3 char* lds) {
    const int tid = opaque_tid(p.wid), w = __builtin_amdgcn_readfirstlane(tid >> 6), lane = tid & 63, i = lane & 15, g = lane >> 4;
    const int b = u >> 7, t0 = (u & 127) * 16;
    const size_t tok0 = (size_t)b * S;
    uint32_t* mbase = p.mask + (tok0 + t0) * 64;
    if (t0 + 16 <= 256) {
#pragma unroll
        for (int qq = 0; qq < 2; ++qq) {
            const int q = 2 * w + qq, n = t0 + q + 1;
            const int cnt = n > lane ? ((n - lane + 63) >> 6) : 0;
            mbase[q * 64 + lane] = cnt >= 32 ? 0xFFFFFFFFu : ((1u << cnt) - 1u);
        }
        return;
    }
    const int nreg = (t0 + 16 + 63) >> 6;
    const int ntile = nreg * 4;
    bf16x8 qf[8]; float wq[8];
    {
        const bf16_t* qrow = p.proj + (tok0 + t0 + i) * NP;
#pragma unroll
        for (int h = 0; h < 8; ++h) qf[h] = *(const bf16x8*)(qrow + PC_DQI + h * 32 + 8 * g);
        const u32x4 ww = *(const u32x4*)(qrow + PC_DWI);
        const float sc = 0.35355339059327373f * 0.17677669529663687f;
        wq[0] = bflo(ww.x) * sc; wq[1] = bfhi(ww.x) * sc; wq[2] = bflo(ww.y) * sc; wq[3] = bfhi(ww.y) * sc;
        wq[4] = bflo(ww.z) * sc; wq[5] = bfhi(ww.z) * sc; wq[6] = bflo(ww.w) * sc; wq[7] = bfhi(ww.w) * sc;
    }
    const int tq = t0 + i;
#ifndef DSA_EXP
#define DSA_EXP 0
#endif
    const bool exp_skip_score = (DSA_EXP == 2) && p.qslot > 0, exp_skip_sel = (DSA_EXP == 1) && p.qslot > 0, exp_nostore = (DSA_EXP != 0) && p.qslot > 0;
    if (!exp_skip_score)
    for (int base = w; base < ntile; base += 32) {
        bf16x8 kf4[4];
#pragma unroll
        for (int uu = 0; uu < 4; ++uu) { const int kt = base + 8 * uu; if (kt < ntile) kf4[uu] = *(const bf16x8*)(p.kidx + (tok0 + 16 * kt + i) * 32 + 8 * g); }
#pragma unroll
        for (int uu = 0; uu < 4; ++uu) {
            const int kt = base + 8 * uu;
            if (kt < ntile) {
                f32x4 sc4 = {0.f, 0.f, 0.f, 0.f};
#pragma unroll
                for (int h = 0; h < 8; ++h) {
                    const f32x4 c = __builtin_amdgcn_mfma_f32_16x16x32_bf16(kf4[uu], qf[h], (f32x4){0.f, 0.f, 0.f, 0.f}, 0, 0, 0);
#pragma unroll
                    for (int r = 0; r < 4; ++r) { const int ci = __float_as_int(c[r]); sc4[r] += wq[h] * __int_as_float(ci > 0 ? ci : 0); }
                }
                u32x4 ko;
#pragma unroll
                for (int r = 0; r < 4; ++r) {
                    const int key = 16 * kt + 4 * g + r;
                    unsigned uu2 = __float_as_uint(sc4[r]); if (uu2 == 0x80000000u) uu2 = 0u;
                    uu2 = (uu2 & 0x80000000u) ? ~uu2 : (uu2 | 0x80000000u);
                    ko[r] = (key <= tq) ? uu2 : 0u;
                }
                *(LAS3 u32x4*)(lds + ((size_t)i * DS_LD + 16 * kt + 4 * g) * 4) = ko;
            }
        }
    }
    __syncthreads();
    if (!exp_skip_sel)
    {
        const int qA = 2 * w, qB = 2 * w + 1;
        const LAS3 unsigned* kpA = (const LAS3 unsigned*)(lds + (size_t)qA * DS_LD * 4);
        const LAS3 unsigned* kpB = (const LAS3 unsigned*)(lds + (size_t)qB * DS_LD * 4);
        unsigned PA[32], PB[32];
        const int nv = nreg * 64;
#pragma unroll
        for (int r = 0; r < 32; ++r) {
            int idx = r * 64 + lane; asm volatile("" : "+v"(idx));
            const unsigned va = kpA[r * 64 + lane], vb = kpB[r * 64 + lane];
            PA[r] = (idx < nv) ? va : 0u; PB[r] = (idx < nv) ? vb : 0u;
        }
#define DSA_TR(P, j, m) do { _Pragma("unroll") for (int k = 0; k < 32; ++k) if ((k & (j)) == 0) { const unsigned x = P[k], y = P[k + (j)]; \
            P[k] = (x & (m)) | ((y << (j)) & ~(m)); P[k + (j)] = ((x >> (j)) & (m)) | (y & ~(m)); } } while (0)
        DSA_TR(PA, 16, 0x0000FFFFu); DSA_TR(PB, 16, 0x0000FFFFu); DSA_TR(PA, 8, 0x00FF00FFu); DSA_TR(PB, 8, 0x00FF00FFu);
        DSA_TR(PA, 4, 0x0F0F0F0Fu); DSA_TR(PB, 4, 0x0F0F0F0Fu); DSA_TR(PA, 2, 0x33333333u); DSA_TR(PB, 2, 0x33333333u);
        DSA_TR(PA, 1, 0x55555555u); DSA_TR(PB, 1, 0x55555555u);
#undef DSA_TR
        unsigned alA = 0xFFFFFFFFu, abA = 0u, selA = 0u, alB = 0xFFFFFFFFu, abB = 0u, selB = 0u;
        bool exA = false, exB = false;
#pragma unroll
        for (int bit = 31; bit >= 0; --bit) {
            if (!(exA && exB)) {
                const unsigned cA = abA | (alA & PA[bit]), cB = abB | (alB & PB[bit]);
                const int na = exA ? 0 : wave_reduce_add(__builtin_popcount(cA)), nb = exB ? 0 : wave_reduce_add(__builtin_popcount(cB));
                if (!exA) { if (na >= 256) { if (na == 256) { exA = true; selA = cA; } alA &= PA[bit]; } else { abA |= alA & PA[bit]; alA &= ~PA[bit]; } }
                if (!exB) { if (nb >= 256) { if (nb == 256) { exB = true; selB = cB; } alB &= PB[bit]; } else { abB |= alB & PB[bit]; alB &= ~PB[bit]; } }
            }
        }
        const unsigned long long lt = (lane == 0) ? 0ull : (~0ull >> (64 - lane));
#pragma unroll 1
        for (int qq = 0; qq < 2; ++qq) {
            const bool exact = qq ? exB : exA;
            unsigned sel = qq ? selB : selA;
            if (!exact) {
                const unsigned al = qq ? alB : alA, ab = qq ? abB : abA;
                const int need = 256 - wave_reduce_add(__builtin_popcount(ab));
                int running = 0; sel = ab;
                for (int r = 0; r < 32; ++r) {
                    const bool eq = ((al >> r) & 1u) != 0u;
                    const unsigned long long be = __ballot(eq);
                    if (eq && running + __popcll(be & lt) < need) sel |= 1u << r;
                    running += __popcll(be);
                }
            }
            if (!exp_nostore) mbase[(2 * w + qq) * 64 + lane] = sel;
        }
    }
    __syncthreads();
}

__device__ __forceinline__ void phase_dsa(const Params& p, int l, LAS3 char* lds) {
    const int tid = opaque_tid(p.wid);
    unsigned* qhead = p.ctl + CW_QD + 64 * (l + 2 * p.qslot);
    volatile LAS3 int* bc = (volatile LAS3 int*)(lds + DS_CTL);
    int nxt = 0;
    if (tid == 0) nxt = (int)__hip_atomic_fetch_add(qhead, 1u, __ATOMIC_RELAXED, __HIP_MEMORY_SCOPE_AGENT);
    for (;;) {
        if (tid == 0) *bc = nxt;
        __syncthreads();
        const int idx = __builtin_amdgcn_readfirstlane(*bc);
        __syncthreads();
        if (idx >= 4096) break;
        if (tid == 0) nxt = (int)__hip_atomic_fetch_add(qhead, 1u, __ATOMIC_RELAXED, __HIP_MEMORY_SCOPE_AGENT);
        const int pb = 127 - (idx >> 5), b = idx & 31;
        dsa_unit(p, b * 128 + pb, lds);
    }
}
}

namespace {
constexpr int LDS_BYTES = 147456;
constexpr int NTHREADS = 512;

template <int PH>
__device__ __forceinline__ void run_phase(const Params& p, int l, unsigned char* smem) {
    LAS3 char* lds = (LAS3 char*)smem;
    PG8_LAS unsigned char* glds = (PG8_LAS unsigned char*)smem;
    const int G = gridDim.x, c = blockIdx.x;
    if constexpr (PH == 0) phase_p0(p, (char*)smem);
    if constexpr (PH == 1) { if (l == 0) phase_norm1<0>(p, 0); else phase_norm1<1>(p, l); }
    if constexpr (PH == 2) { pg8::Gemm g{p.h, p.WinT + (size_t)l * NP * D, D, D, 0}; pg8::StaticOrder S; S.init(T, NP, G, c);
        EpiStoreBf16 E{p.proj, NP}; pg8::gemm_phase<EpiStoreBf16, pg8::StaticOrder, false>(glds, g, S, E, p.wid); }
    if constexpr (PH == 3) phase_prep(p, l);
    if constexpr (PH == 4) { pg8::Gemm g{p.proj + PC_BCQ, p.WqT + (size_t)l * 512 * 256, 256, NP, 0}; pg8::StaticOrder S; S.init(T, 512, G, c);
          EpiMlaQ E{p.qm}; pg8::gemm_phase<EpiMlaQ, pg8::StaticOrder, false>(glds, g, S, E, p.wid); }
    if constexpr (PH == 12) { pg8::Gemm g{p.proj + PC_BCKV, p.WkvT + (size_t)l * 512 * 128, 128, NP, 0}; pg8::StaticOrder S; S.init(T, 512, G, c);
          EpiMlaKV E{p.km, p.vm}; pg8::gemm_phase<EpiMlaKV, pg8::StaticOrder, false>(glds, g, S, E, p.wid); }
    if constexpr (PH == 13) phase_dsa(p, l, lds);
    if constexpr (PH == 5) phase_attn(p, l, lds);
    if constexpr (PH == 6) { pg8::Gemm g{p.merged, p.WoutT + (size_t)l * D * D, D, D, 0}; pg8::StaticOrder S; S.init(T, D, G, c);
        EpiResidual E{l == 0 ? p.x : nullptr, p.xb, p.mod + (size_t)l * NB * NMOD + 2 * 1024}; pg8::gemm_phase<EpiResidual, pg8::StaticOrder, false>(glds, g, S, E, p.wid); }
    if constexpr (PH == 7) phase_route(p, l, (char*)smem);
    if constexpr (PH == 8) { const int* cnt = (const int*)(p.ctl + CW_CNT) + l * 16;
        pg8::Gemm g{p.h, p.WguT + (size_t)l * 16 * 512 * 1024, 1024, D, (size_t)512 * 1024}; MoeOrder S; S.init(cnt, p.list, 2, G, c);
        EpiGateUp E{p.hid}; pg8::gemm_phase<EpiGateUp, MoeOrder, true>(glds, g, S, E, p.wid); }
    if constexpr (PH == 9) { const int* cnt = (const int*)(p.ctl + CW_CNT) + l * 16;
        pg8::Gemm g{p.hid, p.WdT + (size_t)l * 16 * 1024 * 256, 256, 256, (size_t)1024 * 256}; MoeOrder S; S.init(cnt, p.list, 4, G, c);
        EpiDown E{p.ys, p.list, p.wl, cnt}; pg8::gemm_phase<EpiDown, MoeOrder, false>(glds, g, S, E, p.wid); }
    if constexpr (PH == 10) phase_norm1<2>(p, 1);
    if constexpr (PH == 11) phase_norm1<0>(p, l);
}
template <int PH>
__global__ void __launch_bounds__(NTHREADS, 2) k_ph(Params p, int l) {
    extern __shared__ __attribute__((aligned(16))) unsigned char smem[];
    p.wid = __builtin_amdgcn_readfirstlane(threadIdx.x >> 6); p.qslot = p.qslot_host;
    run_phase<PH>(p, l, smem);
}
}


namespace {
#ifndef REP_PH
#define REP_PH -1
#endif
#define REP(X, l) do { if (REP_PH == X) { xcd_barrier(bar); phase<X>(l, smem, wid, 1); } } while (0)
struct KArgs { const float* in[20]; float* xo; char* ws; };
constexpr size_t al256(size_t b) { return (b + 255) & ~(size_t)255; }
constexpr size_t WS_CTL = 0;
constexpr size_t WS_MOD = WS_CTL + al256((size_t)CW_WORDS * 4);
constexpr size_t WS_WIN = WS_MOD + al256((size_t)2 * NB * NMOD * 4);
constexpr size_t WS_WOUT = WS_WIN + al256((size_t)2 * NP * D * 2);
constexpr size_t WS_WQ = WS_WOUT + al256((size_t)2 * D * D * 2);
constexpr size_t WS_WKV = WS_WQ + al256((size_t)2 * 512 * 256 * 2);
constexpr size_t WS_WGU = WS_WKV + al256((size_t)2 * 512 * 128 * 2);
constexpr size_t WS_WD = WS_WGU + al256((size_t)2 * 16 * 512 * 1024 * 2);
constexpr size_t WS_ROPE = WS_WD + al256((size_t)2 * 16 * 1024 * 256 * 2);
constexpr size_t WS_RQ = WS_ROPE + al256((size_t)2048 * 16 * 2 * 4);
constexpr size_t WS_RKV = WS_RQ + al256((size_t)T * 4);
constexpr size_t WS_CBF = WS_RKV + al256((size_t)T * 4);
constexpr size_t WS_KIDX = WS_CBF + al256((size_t)NB * 4 * S * 4);
constexpr size_t WS_MASK = WS_KIDX + al256((size_t)T * 32 * 2);
constexpr size_t WS_LIST = WS_MASK + al256((size_t)T * 64 * 4);
constexpr size_t WS_RW = WS_LIST + al256((size_t)2 * 16 * ECAP * 4);
constexpr size_t WS_WL = WS_RW + al256((size_t)T * 2 * 4);
constexpr size_t WS_H = WS_WL + al256((size_t)2 * 16 * ECAP * 4);
constexpr size_t WS_PROJ = WS_H + al256((size_t)T * D * 2);
constexpr size_t WS_QM = WS_PROJ + al256((size_t)T * NP * 2);
constexpr size_t WS_KM = WS_QM + al256((size_t)T * 384 * 2);
constexpr size_t WS_VM = WS_KM + al256((size_t)T * 384 * 2);
constexpr size_t WS_MERGED = WS_VM + al256((size_t)T * 256 * 2);
constexpr size_t WS_XB = WS_MERGED + al256((size_t)T * D * 2);
constexpr size_t WS_END1 = WS_XB + al256((size_t)T * D * 2);
constexpr size_t WS_HID = WS_PROJ;
constexpr size_t WS_YS = WS_HID + al256((size_t)HIDROWS * 256 * 2);
constexpr size_t WS_END2 = WS_YS + al256((size_t)T * 2 * D * 2);
constexpr size_t WS_NEED = WS_END1 > WS_END2 ? WS_END1 : WS_END2;
static_assert(WS_END2 <= WS_MERGED, "MoE overlay must not reach the merged buffer");

__device__ __forceinline__ Params make_params(const KArgs& a) {
    Params p;
    p.x = a.in[0]; p.c = a.in[1]; p.w_ada = a.in[2]; p.b_ada = a.in[3]; p.g_norm1 = a.in[4]; p.w_in = a.in[5]; p.b_forget = a.in[6]; p.g_q_mla = a.in[7];
    p.w_q_up = a.in[8]; p.g_kv_mla = a.in[9]; p.w_kv_up = a.in[10]; p.sinks = a.in[11]; p.w_out = a.in[12]; p.g_norm2 = a.in[13]; p.w_router = a.in[14];
    p.b_router = a.in[15]; p.w_gate = a.in[16]; p.w_up = a.in[17]; p.w_down = a.in[18]; p.g_final = a.in[19];
    p.xo = a.xo; char* ws = a.ws;
    p.ctl = (unsigned*)(ws + WS_CTL); p.mod = (float*)(ws + WS_MOD); p.WinT = (bf16_t*)(ws + WS_WIN); p.WoutT = (bf16_t*)(ws + WS_WOUT);
    p.WqT = (bf16_t*)(ws + WS_WQ); p.WkvT = (bf16_t*)(ws + WS_WKV); p.WguT = (bf16_t*)(ws + WS_WGU); p.WdT = (bf16_t*)(ws + WS_WD);
    p.ropetab = (float*)(ws + WS_ROPE); p.rq = (float*)(ws + WS_RQ); p.rkv = (float*)(ws + WS_RKV); p.cbF = (float*)(ws + WS_CBF); p.kidx = (bf16_t*)(ws + WS_KIDX);
    p.mask = (uint32_t*)(ws + WS_MASK); p.list = (int*)(ws + WS_LIST); p.rw = (float*)(ws + WS_RW); p.wl = (float*)(ws + WS_WL); p.h = (bf16_t*)(ws + WS_H);
    p.proj = (bf16_t*)(ws + WS_PROJ); p.qm = (bf16_t*)(ws + WS_QM); p.km = (bf16_t*)(ws + WS_KM); p.vm = (bf16_t*)(ws + WS_VM);
    p.merged = (bf16_t*)(ws + WS_MERGED); p.xb = (bf16_t*)(ws + WS_XB); p.hid = (bf16_t*)(ws + WS_HID); p.ys = (bf16_t*)(ws + WS_YS);
    return p;
}
template <int PH>
__device__ __forceinline__ void phase(int l, unsigned char* smem, int wid, int qslot = 0) {
    typedef const __attribute__((address_space(4))) KArgs* KA4;
    KA4 ka = (KA4)__builtin_amdgcn_kernarg_segment_ptr();
    asm volatile("" : "+s"(ka));
    KArgs a;
#pragma unroll
    for (int i = 0; i < 20; ++i) a.in[i] = ka->in[i];
    a.xo = ka->xo; a.ws = ka->ws;
    Params p = make_params(a); p.wid = wid; p.qslot = qslot; p.qslot_host = 0;
    run_phase<PH>(p, l, smem);
}
__global__ void __launch_bounds__(NTHREADS, 2) fwd(KArgs args) {
    extern __shared__ __attribute__((aligned(16))) unsigned char smem[];
    volatile LAS unsigned* st = (volatile LAS unsigned*)(smem + LDS_BYTES - 16);
    const int wid = __builtin_amdgcn_readfirstlane(threadIdx.x >> 6);
    if (xb_leader(wid)) { st[0] = 0u; st[1] = 0u; st[2] = 0u; st[3] = 0u; }
    __syncthreads();
    XcdBarrier bar = xcd_barrier_post((unsigned*)(args.ws + WS_CTL) + CW_BAR, st, wid);
    phase<0>(0, smem, wid);  REP(0, 0);
    xcd_barrier(bar);
#define LAYER(l) do { \
        phase<1>(l, smem, wid);  if (l == 0) REP(1, l); xcd_barrier(bar); \
        phase<2>(l, smem, wid);  REP(2, l); xcd_barrier(bar); \
        phase<3>(l, smem, wid);  REP(3, l); xcd_barrier(bar); \
        phase<4>(l, smem, wid);  REP(4, l); phase<12>(l, smem, wid);  REP(12, l); phase<13>(l, smem, wid);  REP(13, l); xcd_barrier(bar); \
        phase<5>(l, smem, wid);  REP(5, l); xcd_barrier(bar); \
        phase<6>(l, smem, wid);  xcd_barrier(bar); \
        phase<7>(l, smem, wid);  REP(7, l); xcd_barrier(bar); \
        phase<8>(l, smem, wid);  REP(8, l); xcd_barrier(bar); \
        phase<9>(l, smem, wid);  REP(9, l); xcd_barrier(bar); } while (0)
    LAYER(0);
    LAYER(1);
#ifdef REP_BAR
    for (int rb = 0; rb < REP_BAR; ++rb) xcd_barrier(bar);
#endif
    phase<10>(1, smem, wid);
}
}

extern "C" void kernel_launch(void* const* d_in, const int* in_sizes, int n_in, void* d_out, int out_size, void* d_ws, size_t ws_size,
                              hipStream_t stream) {
    KArgs a{};
    for (int i = 0; i < 20; ++i) a.in[i] = (const float*)d_in[i];
    a.xo = (float*)d_out; a.ws = (char*)d_ws;
    if (WS_NEED > ws_size) return;

    static int grid = 0;
    if (!grid) {
        int dev = 0, cus = 0, per_cu = 0;
        (void)hipGetDevice(&dev);
        (void)hipDeviceGetAttribute(&cus, hipDeviceAttributeMultiprocessorCount, dev);
        (void)hipFuncSetAttribute((const void*)fwd, hipFuncAttributeMaxDynamicSharedMemorySize, LDS_BYTES);
        (void)hipOccupancyMaxActiveBlocksPerMultiprocessor(&per_cu, (const void*)fwd, NTHREADS, LDS_BYTES);
        grid = cus > 0 ? cus : 256;
    }
    (void)hipMemsetAsync(a.ws + WS_CTL, 0, (size_t)CW_WORDS * 4, stream);
    fwd<<<dim3(grid), dim3(NTHREADS), LDS_BYTES, stream>>>(a);
}
```

```cpp
#include <hip/hip_runtime.h>
#include <stdint.h>
#define XB_TMO      128
#define XB_XCNT(j)  (256  + 64 * (j))
#define XB_XSUB(j)  (1280 + 64 * (j))
#define XB_XGEN(j)  (2304 + 64 * (j))
#define XB_TOP      3328
#define XB_TOPGEN   3392
#define XCD_BAR_WORDS 3456
#define XB_SPIN_CAP (1u << 20)
#define LAS __attribute__((address_space(3)))

__device__ __forceinline__ unsigned xb_ld(unsigned* p)              { return __hip_atomic_load(p, __ATOMIC_RELAXED, __HIP_MEMORY_SCOPE_AGENT); }
__device__ __forceinline__ unsigned xb_add(unsigned* p, unsigned v) { return __hip_atomic_fetch_add(p, v, __ATOMIC_RELAXED, __HIP_MEMORY_SCOPE_AGENT); }
__device__ __forceinline__ unsigned xb_xcc_id() { return (unsigned)__builtin_amdgcn_s_getreg((3 << 11) | 20) & 0xFu; }
#define XB_SPIN(cond, bar) do { unsigned _sp = 0; while (cond) { __builtin_amdgcn_s_sleep(1); \
    if ((++_sp & 255u) == 0u) { if (xb_ld(&(bar)[XB_TMO])) break; if (_sp > XB_SPIN_CAP) { atomicAdd(&(bar)[XB_TMO], 1u); break; } } } } while (0)

struct XcdBarrier { unsigned* bar; unsigned x; volatile LAS unsigned* st; int wid; };
__device__ __forceinline__ bool xb_leader(int wid) { return wid == 0 && __builtin_amdgcn_mbcnt_hi(~0u, __builtin_amdgcn_mbcnt_lo(~0u, 0u)) == 0u; }

__device__ __forceinline__ XcdBarrier xcd_barrier_post(unsigned* bar, volatile LAS unsigned* st, int wid) {
    XcdBarrier b; b.bar = bar; b.x = xb_xcc_id(); b.st = st; b.wid = wid;
    if (xb_leader(wid)) (void)xb_add(&bar[XB_XCNT(b.x)], 1u);
    return b;
}
__device__ __forceinline__ void xcd_barrier_complete(unsigned* bar, unsigned x, unsigned& nloc, unsigned& nx) {
    const unsigned G = gridDim.x * gridDim.y * gridDim.z;
    unsigned sum, cnt, mine, sp = 0u;
    for (;;) {
        sum = 0u; cnt = 0u; mine = 0u;
#pragma unroll
        for (unsigned j = 0; j < 16; ++j) { const unsigned c = xb_ld(&bar[XB_XCNT(j)]); sum += c; cnt += (c > 0u) ? 1u : 0u; mine = (j == x) ? c : mine; }
        if (sum == G) break;
        __builtin_amdgcn_s_sleep(1);
        if ((++sp & 255u) == 0u) { if (xb_ld(&bar[XB_TMO])) break; if (sp > XB_SPIN_CAP) { atomicAdd(&bar[XB_TMO], 1u); break; } }
    }
    nloc = mine > 0u ? mine : 1u; nx = cnt > 0u ? cnt : 1u;
}
__device__ __forceinline__ void xcd_barrier(const XcdBarrier& b) {
    asm volatile("s_waitcnt vmcnt(0)" ::: "memory");
    __syncthreads();
    if (xb_leader(b.wid)) {
        unsigned* bar = b.bar;
        __builtin_amdgcn_s_waitcnt(0);
        unsigned nloc = b.st[0], nx = b.st[1];
        if (nloc == 0u) { xcd_barrier_complete(bar, b.x, nloc, nx); b.st[0] = nloc; b.st[1] = nx; }
        const unsigned old = xb_add(&bar[XB_XSUB(b.x)], 1u);
        const unsigned gen = old / nloc;
        if (old + 1u == (gen + 1u) * nloc) {
            __builtin_amdgcn_fence(__ATOMIC_RELEASE, "agent");
            asm volatile("s_waitcnt vmcnt(0)" ::: "memory");
            const unsigned og = xb_add(&bar[XB_TOP], 1u);
            const unsigned tg = og / nx;
            if (og + 1u == (tg + 1u) * nx) xb_add(&bar[XB_TOPGEN], 1u);
            else XB_SPIN(xb_ld(&bar[XB_TOPGEN]) == tg, bar);
            __builtin_amdgcn_fence(__ATOMIC_ACQUIRE, "agent");
            xb_add(&bar[XB_XGEN(b.x)], 1u);
            asm volatile("s_waitcnt vmcnt(0)" ::: "memory");
        } else {
            XB_SPIN(xb_ld(&bar[XB_XGEN(b.x)]) == gen, bar);
            __builtin_amdgcn_fence(__ATOMIC_ACQUIRE, "agent");
            asm volatile("s_waitcnt vmcnt(0)" ::: "memory");
        }
    }
    __syncthreads();
}

#define LAS3 __attribute__((address_space(3)))
namespace {
typedef unsigned short bf16_t;
typedef short bf16x8 __attribute__((ext_vector_type(8)));
typedef short bf16x4 __attribute__((ext_vector_type(4)));
typedef float f32x4 __attribute__((ext_vector_type(4)));
typedef float f32x2 __attribute__((ext_vector_type(2)));
typedef unsigned u32x4 __attribute__((ext_vector_type(4)));
typedef unsigned u32x2 __attribute__((ext_vector_type(2)));

constexpr int D = 1024, NB = 32, S = 2048, T = NB * S, NIN = 2380, NP = 2560, NMOD = 6144;
constexpr int OFF_AQ = 0, OFF_AK = 256, OFF_AV = 512, OFF_AF = 768, OFF_BCQ = 772, OFF_BCKV = 1028, OFF_BKR = 1156,
              OFF_CQ = 1188, OFF_CK = 1444, OFF_CV = 1572, OFF_DQ = 1700, OFF_DK = 1956, OFF_DV = 2020,
              OFF_DQI = 2084, OFF_DKI = 2340, OFF_DWI = 2372;
constexpr int PC_AQ = 0, PC_AK = 256, PC_AV = 512, PC_BCQ = 768, PC_BCKV = 1024, PC_BKR = 1152, PC_CQ = 1184, PC_CK = 1440, PC_CV = 1568,
              PC_DQ = 1696, PC_DK = 1952, PC_DV = 2016, PC_DQI = 2080, PC_DKI = 2336, PC_DWI = 2368, PC_AF = 2376;
constexpr float EPS = 1e-6f;
constexpr float LOG2E = 1.4426950408889634f;
constexpr int ECAP = T;
constexpr int HIDROWS = 2 * T + 16 * 256;

__host__ __device__ __forceinline__ int orig_col(int n) { return n < 768 ? n : (n < 2376 ? n + 4 : (n < 2380 ? n - 1608 : -1)); }
__device__ __forceinline__ int opaque_tid(int wid) {
    int t = wid * 64 + (int)__builtin_amdgcn_mbcnt_hi(~0u, __builtin_amdgcn_mbcnt_lo(~0u, 0u));
    asm volatile("" : "+v"(t)); return t; }
__device__ __forceinline__ float bf2f(bf16_t v) { return __uint_as_float((unsigned)v << 16); }
__device__ __forceinline__ bf16_t f2bf(float f) { unsigned u = __float_as_uint(f); u += 0x7FFFu + ((u >> 16) & 1u); return (bf16_t)(u >> 16); }
typedef __bf16 bf16x2_native __attribute__((ext_vector_type(2)));
__device__ __forceinline__ unsigned cvt_pk_bf16(float lo, float hi) { const f32x2 v = {lo, hi}; return __builtin_bit_cast(unsigned, __builtin_convertvector(v, bf16x2_native)); }
__device__ __forceinline__ float bflo(unsigned w) { return __uint_as_float(w << 16); }
__device__ __forceinline__ float bfhi(unsigned w) { return __uint_as_float(w & 0xFFFF0000u); }
__device__ __forceinline__ float wave_sum(float v) {
#pragma unroll
    for (int o = 32; o > 0; o >>= 1) v += __shfl_xor(v, o);
    return v;
}
__device__ __forceinline__ float xor32_max(float x) {
    float a = x, b = x;
    asm volatile("s_nop 1\n\tv_permlane32_swap_b32 %0, %1\n\ts_nop 1" : "+v"(a), "+v"(b));
    return fmaxf(a, b);
}
__device__ __forceinline__ int wave_reduce_add(int v) {
    v += __builtin_amdgcn_update_dpp(0, v, 0xB1, 0xF, 0xF, true);
    v += __builtin_amdgcn_update_dpp(0, v, 0x4E, 0xF, 0xF, true);
    v += __builtin_amdgcn_update_dpp(0, v, 0x141, 0xF, 0xF, true);
    v += __builtin_amdgcn_update_dpp(0, v, 0x140, 0xF, 0xF, true);
    return __builtin_amdgcn_readlane(v, 0) + __builtin_amdgcn_readlane(v, 16) + __builtin_amdgcn_readlane(v, 32) + __builtin_amdgcn_readlane(v, 48);
}
}

namespace pg8 {
#define PG8_LAS __attribute__((address_space(3)))
constexpr int BM = 256, BK = 64, HALF = 128, HTB = HALF * BK * 2, STAGE_BYTES = 8 * HTB, NXCD = 8, WGM = 8;

__host__ __device__ __forceinline__ int lds_byte(int r, int c) { const int st = (r >> 4) * 2 + (c >> 5), rr = r & 15, cc = c & 31, ob = rr * 64 + cc * 2; return st * 1024 + (ob ^ (((ob >> 9) & 1) << 5)); }
__host__ __device__ __forceinline__ void stage_rc(int b, int& R, int& C) { const int st = b / 1024, sb = b % 1024, swz = sb ^ (((sb >> 9) & 1) << 5); R = (st >> 1) * 16 + swz / 64; C = (st & 1) * 32 + (swz % 64) / 2; }
__host__ __device__ __forceinline__ int perm32(int rho) { const int n = rho >> 4, i = rho & 15; return 8 * (i >> 2) + 4 * n + (i & 3); }

struct Unit { int pm, pn, e, mt; };
struct Gemm { const bf16_t* A; const bf16_t* Bt; int K; int lda; size_t bstride; };

struct StaticOrder {
    int nM, nN, nwg, G, c;
    __host__ __device__ void init(int M, int N, int G_, int c_) { nM = M / BM; nN = N / BM; nwg = nM * nN; G = G_; c = c_; }
    __host__ __device__ bool next(int i, Unit& u) const {
        const long L = (long)i * G + c; if (L >= nwg) return false;
        int wgid = (int)L; { const int q = nwg / NXCD, r = nwg % NXCD, xcd = wgid % NXCD, off = wgid / NXCD; wgid = (xcd < r ? xcd * (q + 1) : r * (q + 1) + (xcd - r) * q) + off; }
        const int nig = WGM * nN, gid = wgid / nig, fm = gid * WGM, gsz = (nM - fm) < WGM ? (nM - fm) : WGM;
        u.pm = fm + ((wgid % nig) % gsz); u.pn = (wgid % nig) / gsz; u.e = 0; u.mt = 0; return true;
    }
    __device__ __forceinline__ int arow(const Unit& u, int r) const { return u.pm * BM + r; }
};

template <class Epi, class Sched, bool GATHER>
__device__ __forceinline__ void gemm_phase(PG8_LAS unsigned char* lds, const Gemm g, const Sched& S, const Epi& E, int wave_index) {
    const int tid = opaque_tid(wave_index), wid = __builtin_amdgcn_readfirstlane(tid >> 6), lane = tid & 63, wr = wid >> 2, wc = wid & 3, fr = lane & 15, fq = lane >> 4;
    int K_ = g.K; asm volatile("" : "+s"(K_));
    const int K = K_, nt = K / BK, lda = g.lda;
    int Ra[2], Ca[2]; unsigned voffB[2], voffA[2];
#pragma unroll
    for (int i = 0; i < 2; ++i) { int R, C; stage_rc(tid * 16 + i * 8192, R, C); const int Rb = Epi::PERM ? ((R & ~31) + perm32(R & 31)) : R;
        Ra[i] = R; Ca[i] = C; voffB[i] = (unsigned)(Rb * K + C) * 2u; voffA[i] = (unsigned)(R * lda + C) * 2u; }
    const size_t kstep = (size_t)(BK * 2);
    const size_t hstepB = (size_t)HALF * K * 2;
    const size_t tstepB = 2 * hstepB;
    const size_t hstepA = (size_t)HALF * lda * 2, tstepA = 2 * hstepA;
    const unsigned ldsw = (unsigned)wid * 1024u;
    const int aoff = lds_byte(wr * 64 + fr, fq * 8), boff = lds_byte(wc * 32 + fr, fq * 8);
#define PG8_SA(b, h) (((b) * 2 + (h)) * HTB)
#define PG8_SB(b, h) ((4 + (b) * 2 + (h)) * HTB)
#define PG8_STAGE(bufoff, gbase, voff) do { _Pragma("unroll") for (int _i = 0; _i < 2; ++_i) \
        __builtin_amdgcn_global_load_lds((const unsigned*)((const char*)(gbase) + (voff)[_i]), (PG8_LAS unsigned*)(lds + (bufoff) + ldsw + _i * 8192), 16, 0, 0); } while (0)
#define PG8_STAGEA(bufoff, kptr, VO, h) do { _Pragma("unroll") for (int _i = 0; _i < 2; ++_i) { \
        const char* _src; if constexpr (GATHER) _src = (const char*)(kptr) + (VO)[_i][h]; else _src = (const char*)(kptr) + (size_t)(h) * hstepA + voffA[_i]; \
        __builtin_amdgcn_global_load_lds((const unsigned*)_src, (PG8_LAS unsigned*)(lds + (bufoff) + ldsw + _i * 8192), 16, 0, 0); } } while (0)
#define PG8_LDA(dst, b, h) do { _Pragma("unroll") for (int m = 0; m < 4; ++m) _Pragma("unroll") for (int k = 0; k < 2; ++k) dst[m][k] = *(const PG8_LAS bf16x8*)(lds + PG8_SA(b, h) + aoff + m * 2048 + k * 1024); } while (0)
#define PG8_LDB(dst, b, h) do { _Pragma("unroll") for (int n = 0; n < 2; ++n) _Pragma("unroll") for (int k = 0; k < 2; ++k) dst[n][k] = *(const PG8_LAS bf16x8*)(lds + PG8_SB(b, h) + boff + n * 2048 + k * 1024); } while (0)
#define PG8_MMA(ai, bj, At, Bt) do { __builtin_amdgcn_s_setprio(1); _Pragma("unroll") for (int m = 0; m < 4; ++m) _Pragma("unroll") for (int n = 0; n < 2; ++n) _Pragma("unroll") for (int k = 0; k < 2; ++k) \
        acc[ai][bj][m][n] = __builtin_amdgcn_mfma_f32_16x16x32_bf16(Bt[n][k], At[m][k], acc[ai][bj][m][n], 0, 0, 0); __builtin_amdgcn_s_setprio(0); } while (0)
#define PG8_WAIT_V(n) asm volatile("s_waitcnt vmcnt(" #n ")" ::: "memory")
#define PG8_WAIT_L(n) asm volatile("s_waitcnt lgkmcnt(" #n ")" ::: "memory")
#define PG8_BAR __builtin_amdgcn_s_barrier()
#define PG8_SCHED __builtin_amdgcn_sched_barrier(0)
#define PG8_SETV(V, u) do { _Pragma("unroll") for (int _i = 0; _i < 2; ++_i) _Pragma("unroll") for (int _h = 0; _h < 2; ++_h) { \
        const int _row = GATHER ? S.arow(u, _h * HALF + Ra[_i]) : ((u).pm * BM + _h * HALF + Ra[_i]); V[_i][_h] = (unsigned)(((size_t)_row * lda + Ca[_i]) * 2); } } while (0)
    Unit cur, nxt; int ui = 0;
    if (!S.next(0, cur)) return;
    f32x4 acc[2][2][4][2];
#pragma unroll
    for (int a = 0; a < 2; ++a)
#pragma unroll
        for (int b = 0; b < 2; ++b)
#pragma unroll
            for (int m = 0; m < 4; ++m)
#pragma unroll
                for (int n = 0; n < 2; ++n) acc[a][b][m][n] = (f32x4){0.f, 0.f, 0.f, 0.f};
    bf16x8 At[4][2], B0[2][2], B1[2][2];
    unsigned vA[2][2], vN[2][2];
    if constexpr (GATHER) { PG8_SETV(vA, cur); }
    const char* cA = (const char*)g.A + (GATHER ? (size_t)0 : (size_t)cur.pm * tstepA);
    const char* cB = (const char*)g.Bt + ((size_t)cur.e * g.bstride) * 2 + (size_t)cur.pn * tstepB;
    PG8_STAGE(PG8_SB(0, 0), cB, voffB); PG8_STAGE(PG8_SB(0, 1), cB + hstepB, voffB); PG8_STAGEA(PG8_SA(0, 0), cA, vA, 0); PG8_STAGEA(PG8_SA(0, 1), cA, vA, 1);
    if (wr == 1) PG8_BAR;
    PG8_WAIT_V(2); PG8_BAR;
    PG8_STAGE(PG8_SB(1, 0), cB + kstep, voffB); PG8_STAGEA(PG8_SA(1, 0), cA + kstep, vA, 0); PG8_STAGE(PG8_SB(1, 1), cB + hstepB + kstep, voffB);
    PG8_WAIT_V(6); PG8_BAR;
    for (;;) {
        const bool has_next = S.next(ui + 1, nxt);
        if constexpr (GATHER) { if (has_next) { PG8_SETV(vN, nxt); }
        else {
#pragma unroll
            for (int _i = 0; _i < 2; ++_i)
#pragma unroll
                for (int _h = 0; _h < 2; ++_h) vN[_i][_h] = vA[_i][_h];
        } }
        const char* nA = (!GATHER && has_next) ? (const char*)g.A + (size_t)nxt.pm * tstepA : cA;
        const char* nB = has_next ? (const char*)g.Bt + ((size_t)nxt.e * g.bstride) * 2 + (size_t)nxt.pn * tstepB : cB;
#pragma unroll 1
        for (int t = 0; t < nt; t += 2) {
            const bool last = (t == nt - 2);
            const char* a1 = cA + (size_t)(t + 1) * kstep;
            const char* a2 = last ? nA : cA + (size_t)(t + 2) * kstep; const char* b2 = last ? nB : cB + (size_t)(t + 2) * kstep;
            const char* a3 = a2 + kstep; const char* b3 = b2 + kstep;
            unsigned v2[2][2];
            if constexpr (GATHER) {
#pragma unroll
            for (int _i = 0; _i < 2; ++_i)
#pragma unroll
                for (int _h = 0; _h < 2; ++_h) v2[_i][_h] = last ? vN[_i][_h] : vA[_i][_h];
            }
            PG8_LDB(B0, 0, 0); PG8_LDB(B1, 0, 1); PG8_SCHED; PG8_LDA(At, 0, 0); PG8_STAGEA(PG8_SA(1, 1), a1, vA, 1);
            PG8_WAIT_V(8); PG8_WAIT_L(0); PG8_BAR; PG8_MMA(0, 0, At, B0); PG8_MMA(0, 1, At, B1); PG8_BAR; PG8_SCHED;
            PG8_LDA(At, 0, 1); PG8_STAGE(PG8_SB(0, 0), b2, voffB); PG8_STAGE(PG8_SB(0, 1), b2 + hstepB, voffB); PG8_STAGEA(PG8_SA(0, 0), a2, v2, 0);
            PG8_WAIT_V(8); PG8_WAIT_L(0); PG8_BAR; PG8_MMA(1, 0, At, B0); PG8_MMA(1, 1, At, B1); PG8_BAR; PG8_SCHED;
            PG8_LDB(B0, 1, 0); PG8_LDB(B1, 1, 1); PG8_SCHED; PG8_LDA(At, 1, 0); PG8_STAGEA(PG8_SA(0, 1), a2, v2, 1);
            PG8_WAIT_V(8); PG8_WAIT_L(0); PG8_BAR; PG8_MMA(0, 0, At, B0); PG8_MMA(0, 1, At, B1); PG8_BAR; PG8_SCHED;
            PG8_LDA(At, 1, 1); PG8_STAGE(PG8_SB(1, 0), b3, voffB); PG8_STAGE(PG8_SB(1, 1), b3 + hstepB, voffB); PG8_STAGEA(PG8_SA(1, 0), a3, v2, 0);
            PG8_WAIT_V(8); PG8_WAIT_L(0); PG8_BAR; PG8_MMA(1, 0, At, B0); PG8_MMA(1, 1, At, B1); PG8_BAR; PG8_SCHED;
        }
        if (wr == 0) PG8_BAR;
        E(acc, cur, wr, wc, fr, fq);
        if (!has_next) break;
#pragma unroll
        for (int a = 0; a < 2; ++a)
#pragma unroll
            for (int b = 0; b < 2; ++b)
#pragma unroll
                for (int m = 0; m < 4; ++m)
#pragma unroll
                    for (int n = 0; n < 2; ++n) acc[a][b][m][n] = (f32x4){0.f, 0.f, 0.f, 0.f};
        cur = nxt; cB = nB; cA = nA; ++ui;
        if constexpr (GATHER) {
#pragma unroll
        for (int _i = 0; _i < 2; ++_i)
#pragma unroll
            for (int _h = 0; _h < 2; ++_h) vA[_i][_h] = vN[_i][_h];
        }
        if (wr == 1) PG8_BAR;
    }
    PG8_WAIT_V(0);
    PG8_BAR;
#undef PG8_SA
#undef PG8_SB
#undef PG8_STAGE
#undef PG8_STAGEA
#undef PG8_LDA
#undef PG8_LDB
#undef PG8_MMA
#undef PG8_WAIT_V
#undef PG8_WAIT_L
#undef PG8_BAR
#undef PG8_SCHED
#undef PG8_SETV
}
}

namespace {
struct Params {
    const float *x, *c, *w_ada, *b_ada, *g_norm1, *w_in, *b_forget, *g_q_mla, *w_q_up, *g_kv_mla, *w_kv_up, *sinks, *w_out, *g_norm2,
                *w_router, *b_router, *w_gate, *w_up, *w_down, *g_final;
    float* xo;
    bf16_t* xb;
    unsigned* ctl;
    float* mod;
    bf16_t* WinT;
    bf16_t* WoutT;
    bf16_t* WqT;
    bf16_t* WkvT;
    bf16_t* WguT;
    bf16_t* WdT;
    float* ropetab;
    float* rq; float* rkv;
    float* cbF;
    bf16_t* kidx;
    uint32_t* mask;
    bf16_t* h;
    bf16_t* proj;
    bf16_t* qm; bf16_t* km; bf16_t* vm;
    bf16_t* merged;
    bf16_t* hid;
    bf16_t* ys;
    int* list;
    float* rw;
    float* wl;
    int wid;
    int qslot;
    int qslot_host;
};
constexpr int CW_BAR = 0;
constexpr int CW_CNT = 3584;
constexpr int CW_QA = 3648;
constexpr int CW_QD = 4288;
constexpr int CW_KN2 = 4992;
constexpr int CW_QN2 = CW_KN2 + 2 * NB * 4 * 32;
constexpr int CW_WORDS = CW_QN2 + 2 * NB * 4 * 8;
}

namespace {
constexpr long P0_B1 = 2l * NP * 128, P0_B2 = P0_B1 + 2l * 1024 * 128, P0_B3 = P0_B2 + 2l * 512 * 32, P0_B4 = P0_B3 + 2l * 512 * 16,
               P0_B5 = P0_B4 + 32l * 512 * 128, P0_B6 = P0_B5 + 32l * 1024 * 32;
__device__ __forceinline__ bf16_t* p0_fetch(const Params& p, long it, float (&v)[8]) {
    if (it < P0_B1) {
        const int l = (int)(it / (NP * 128)), r = (int)(it % (NP * 128)), n = r % NP, k0 = (r / NP) * 8, o = orig_col(n);
        const float* w = p.w_in + (size_t)l * D * NIN;
#pragma unroll
        for (int j = 0; j < 8; ++j) v[j] = o >= 0 ? w[(size_t)(k0 + j) * NIN + o] : 0.f;
        return p.WinT + ((size_t)l * NP + n) * D + k0;
    } else if (it < P0_B2) {
        const long s = it - P0_B1; const int l = (int)(s / (1024 * 128)), r = (int)(s % (1024 * 128)), n = r & 1023, k0 = (r >> 10) * 8;
        const float* w = p.w_out + (size_t)l * D * D;
#pragma unroll
        for (int j = 0; j < 8; ++j) v[j] = w[(size_t)(k0 + j) * D + n];
        return p.WoutT + ((size_t)l * D + n) * D + k0;
    } else if (it < P0_B3) {
        const long s = it - P0_B2; const int l = (int)(s / (512 * 32)), r = (int)(s % (512 * 32)), n = r & 511, k0 = (r >> 9) * 8;
        const float* w = p.w_q_up + (size_t)l * 256 * 384; const float* g = p.g_q_mla + l * 256;
#pragma unroll
        for (int j = 0; j < 8; ++j) v[j] = n < 384 ? g[k0 + j] * w[(size_t)(k0 + j) * 384 + n] : 0.f;
        return p.WqT + ((size_t)l * 512 + n) * 256 + k0;
    } else if (it < P0_B4) {
        const long s = it - P0_B3; const int l = (int)(s / (512 * 16)), r = (int)(s % (512 * 16)), n = r & 511, k0 = (r >> 9) * 8;
        const float* w = p.w_kv_up + (size_t)l * 128 * 512; const float* g = p.g_kv_mla + l * 128;
#pragma unroll
        for (int j = 0; j < 8; ++j) v[j] = g[k0 + j] * w[(size_t)(k0 + j) * 512 + n];
        return p.WkvT + ((size_t)l * 512 + n) * 128 + k0;
    } else if (it < P0_B5) {
        const long s = it - P0_B4; const int le = (int)(s >> 16), r = (int)(s & 65535), n = r & 511, k0 = (r >> 9) * 8;
        const int q = n >> 5, rr = n & 31, col = 16 * q + (rr & 15);
        const float* w = (rr < 16 ? p.w_gate : p.w_up) + (size_t)le * 1024 * 256;
#pragma unroll
        for (int j = 0; j < 8; ++j) v[j] = w[(size_t)(k0 + j) * 256 + col];
        return p.WguT + ((size_t)le * 512 + n) * 1024 + k0;
    } else {
        const long s = it - P0_B5; const int le = (int)(s >> 15), r = (int)(s & 32767), n = r & 1023, k0 = (r >> 10) * 8;
        const float* w = p.w_down + (size_t)le * 256 * 1024;
#pragma unroll
        for (int j = 0; j < 8; ++j) v[j] = w[(size_t)(k0 + j) * 1024 + n];
        return p.WdT + ((size_t)le * 1024 + n) * 256 + k0;
    }
}
__device__ __forceinline__ void p0_store(bf16_t* dst, const float (&v)[8]) {
    u32x4 w; w.x = cvt_pk_bf16(v[0], v[1]); w.y = cvt_pk_bf16(v[2], v[3]); w.z = cvt_pk_bf16(v[4], v[5]); w.w = cvt_pk_bf16(v[6], v[7]);
    *(u32x4*)dst = w;
}

__device__ __forceinline__ void phase_p0(const Params& p, char* lds) {
    const int tid = opaque_tid(p.wid), gtid = blockIdx.x * blockDim.x + tid, gthreads = gridDim.x * blockDim.x;
    for (long it0 = gtid; it0 < P0_B6; it0 += 4l * gthreads) {
        float va[8], vb[8], vc[8], vd[8];
        const bool hb = it0 + gthreads < P0_B6, hc = it0 + 2l * gthreads < P0_B6, hd = it0 + 3l * gthreads < P0_B6;
        bf16_t* da = p0_fetch(p, it0, va);
        bf16_t* db = hb ? p0_fetch(p, it0 + gthreads, vb) : da;
        bf16_t* dc = hc ? p0_fetch(p, it0 + 2l * gthreads, vc) : da;
        bf16_t* dd = hd ? p0_fetch(p, it0 + 3l * gthreads, vd) : da;
        p0_store(da, va);
        if (hb) p0_store(db, vb);
        if (hc) p0_store(dc, vc);
        if (hd) p0_store(dd, vd);
    }
    for (int it = gtid; it < 2048 * 16; it += gthreads) {
        const int pos = it >> 4, i = it & 15;
        const float inv = powf(10000.0f, -(float)i / 16.0f), ang = (float)pos * inv;
        p.ropetab[it * 2] = cosf(ang); p.ropetab[it * 2 + 1] = sinf(ang);
    }
    const int w = __builtin_amdgcn_readfirstlane(tid >> 6), lane = tid & 63;
    for (int u = blockIdx.x; u < 2 * (NMOD / 64); u += gridDim.x) {
        float* ca = (float*)lds;
        for (int i = tid; i < NB * 1024; i += 512) { const int bb = i >> 10, d = i & 1023; const float v = p.c[i]; ca[d * 32 + ((bb + 4 * (d & 7)) & 31)] = v / (1.f + __expf(-v)); }
        __syncthreads();
        const int l = u / (NMOD / 64), n0 = (u % (NMOD / 64)) * 64;
        const float* wp = p.w_ada + (size_t)l * 1024 * NMOD + n0 + lane;
        float acc[32];
#pragma unroll
        for (int j = 0; j < 32; ++j) acc[j] = 0.f;
        for (int d0 = 128 * w; d0 < 128 * w + 128; d0 += 16) {
            float wv[16];
#pragma unroll
            for (int q = 0; q < 16; ++q) wv[q] = wp[(size_t)(d0 + q) * NMOD];
#pragma unroll
            for (int q = 0; q < 16; ++q) {
                const int d = d0 + q;
#pragma unroll
                for (int i = 0; i < 8; ++i) {
                    const f32x4 cv = *(const f32x4*)(ca + d * 32 + (((i + (d & 7)) & 7) << 2));
                    acc[4 * i + 0] += cv[0] * wv[q]; acc[4 * i + 1] += cv[1] * wv[q]; acc[4 * i + 2] += cv[2] * wv[q]; acc[4 * i + 3] += cv[3] * wv[q];
                }
            }
        }
        __syncthreads();
        float* part = (float*)lds;
#pragma unroll
        for (int j = 0; j < 32; ++j) part[(w * 32 + j) * 64 + lane] = acc[j];
        __syncthreads();
        for (int o = tid; o < NB * 64; o += 512) {
            const int bb = o >> 6, col = o & 63;
            float sm = 0.f;
#pragma unroll
            for (int ww = 0; ww < 8; ++ww) sm += part[(ww * 32 + bb) * 64 + col];
            p.mod[((size_t)l * NB + bb) * NMOD + n0 + col] = sm + p.b_ada[l * NMOD + n0 + col];
        }
        __syncthreads();
    }
    __syncthreads();
}

template <int MODE>
__device__ __forceinline__ void phase_norm1(const Params& p, int l) {
#ifndef NORM_NT
#define NORM_NT 2
#endif
    constexpr int NT = NORM_NT;
    const int tid = opaque_tid(p.wid), w = tid >> 6, lane = tid & 63;
    const float* g = (MODE == 2) ? p.g_final : p.g_norm1 + l * D;
    const float* modl = p.mod + (size_t)(MODE == 2 ? 1 : l) * NB * NMOD;
    const float* modp = p.mod + (size_t)(MODE == 2 ? 1 : (l > 0 ? l - 1 : 0)) * NB * NMOD;
    f32x4 gg4[4];
#pragma unroll
    for (int k = 0; k < 4; ++k) gg4[k] = *(const f32x4*)(g + 4 * lane + 256 * k);
    for (int t0 = (blockIdx.x * 8 + w) * NT; t0 < T; t0 += gridDim.x * 8 * NT) {
        const int b0 = t0 >> 11;
        f32x4 sc4[4], sh4[4], gt4[4];
        if (MODE != 2) {
#pragma unroll
            for (int k = 0; k < 4; ++k) { sc4[k] = *(const f32x4*)(modl + (size_t)b0 * NMOD + 1024 + 4 * lane + 256 * k); sh4[k] = *(const f32x4*)(modl + (size_t)b0 * NMOD + 4 * lane + 256 * k); }
        }
        if (MODE >= 1) {
#pragma unroll
            for (int k = 0; k < 4; ++k) gt4[k] = *(const f32x4*)(modp + (size_t)b0 * NMOD + 5 * 1024 + 4 * lane + 256 * k);
        }
        f32x4 v[NT][4];
#pragma unroll
        for (int u = 0; u < NT; ++u)
#pragma unroll
            for (int k = 0; k < 4; ++k) {
                if (MODE == 0) v[u][k] = *(const f32x4*)(p.x + (size_t)(t0 + u) * D + 4 * lane + 256 * k);
                else { const u32x2 w2 = *(const u32x2*)(p.xb + (size_t)(t0 + u) * D + 4 * lane + 256 * k); v[u][k] = (f32x4){bflo(w2.x), bfhi(w2.x), bflo(w2.y), bfhi(w2.y)}; }
            }
        if (MODE >= 1) {
            u32x2 y0[NT][4], y1[NT][4];
#pragma unroll
            for (int u = 0; u < NT; ++u)
#pragma unroll
                for (int k = 0; k < 4; ++k) { const int col = 4 * lane + 256 * k;
                    y0[u][k] = *(const u32x2*)(p.ys + ((size_t)(t0 + u) * 2 + 0) * D + col); y1[u][k] = *(const u32x2*)(p.ys + ((size_t)(t0 + u) * 2 + 1) * D + col); }
#pragma unroll
            for (int u = 0; u < NT; ++u) {
                const int b = (t0 + u) >> 11;
#pragma unroll
                for (int k = 0; k < 4; ++k) {
                    const int col = 4 * lane + 256 * k;
                    const f32x4 gt = gt4[k];
                    v[u][k][0] += gt[0] * (bflo(y0[u][k].x) + bflo(y1[u][k].x)); v[u][k][1] += gt[1] * (bfhi(y0[u][k].x) + bfhi(y1[u][k].x));
                    v[u][k][2] += gt[2] * (bflo(y0[u][k].y) + bflo(y1[u][k].y)); v[u][k][3] += gt[3] * (bfhi(y0[u][k].y) + bfhi(y1[u][k].y));
                }
            }
        }
#pragma unroll
        for (int u = 0; u < NT; ++u) {
            const int t = t0 + u, b = t >> 11;
            float ss = 0.f;
#pragma unroll
            for (int k = 0; k < 4; ++k) ss += v[u][k][0] * v[u][k][0] + v[u][k][1] * v[u][k][1] + v[u][k][2] * v[u][k][2] + v[u][k][3] * v[u][k][3];
            ss = wave_sum(ss);
            const float r = rsqrtf(ss * (1.0f / D) + EPS);
#pragma unroll
            for (int k = 0; k < 4; ++k) {
                const int col = 4 * lane + 256 * k;
                f32x4 y = v[u][k] * r * gg4[k];
                if (MODE == 2) { *(f32x4*)(p.xo + (size_t)t * D + col) = y; }
                else {
                    if (MODE == 1) { u32x2 xw; xw.x = cvt_pk_bf16(v[u][k][0], v[u][k][1]); xw.y = cvt_pk_bf16(v[u][k][2], v[u][k][3]); *(u32x2*)(p.xb + (size_t)t * D + col) = xw; }
                    y = y * (1.f + sc4[k]) + sh4[k];
                    u32x2 o; o.x = cvt_pk_bf16(y[0], y[1]); o.y = cvt_pk_bf16(y[2], y[3]);
                    *(u32x2*)(p.h + (size_t)t * D + col) = o;
                }
            }
        }
    }
}
}

namespace {
using pg8::Unit;
struct EpiStoreBf16 {
    static constexpr bool PERM = true;
    bf16_t* O; int ldc;
    __device__ __forceinline__ void operator()(const f32x4 (&acc)[2][2][4][2], const Unit& u, int wr, int wc, int fr_, int fq_) const {
        int fr = fr_, fq = fq_; asm volatile("" : "+v"(fr), "+v"(fq));
        const int row0 = u.pm * 256 + wr * 64 + fr, col0 = u.pn * 256 + wc * 32 + 8 * fq;
#pragma unroll
        for (int ai = 0; ai < 2; ++ai)
#pragma unroll
            for (int m = 0; m < 4; ++m) { bf16_t* rowp = O + (size_t)(row0 + ai * 128 + m * 16) * ldc + col0;
#pragma unroll
                for (int bj = 0; bj < 2; ++bj) { const f32x4 v0 = acc[ai][bj][m][0], v1 = acc[ai][bj][m][1];
                    u32x4 w; w.x = cvt_pk_bf16(v0[0], v0[1]); w.y = cvt_pk_bf16(v0[2], v0[3]); w.z = cvt_pk_bf16(v1[0], v1[1]); w.w = cvt_pk_bf16(v1[2], v1[3]);
                    *(u32x4*)(rowp + bj * 128) = w; } }
    }
};
struct EpiResidual {
    static constexpr bool PERM = false;
    const float* xin32; bf16_t* xb; const float* gate;
    __device__ __forceinline__ void operator()(const f32x4 (&acc)[2][2][4][2], const Unit& u, int wr, int wc, int fr_, int fq_) const {
        int fr = fr_, fq = fq_; asm volatile("" : "+v"(fr), "+v"(fq));
        const int row0 = u.pm * 256 + wr * 64 + fr, col0 = u.pn * 256 + wc * 32 + 4 * fq;
        const int b = (u.pm * 256) >> 11;
        f32x4 gv[2][2];
#pragma unroll
        for (int bj = 0; bj < 2; ++bj)
#pragma unroll
            for (int n = 0; n < 2; ++n) gv[bj][n] = *(const f32x4*)(gate + (size_t)b * NMOD + col0 + bj * 128 + n * 16);
#pragma unroll
        for (int ai = 0; ai < 2; ++ai)
#pragma unroll
            for (int m = 0; m < 4; ++m) { const size_t ro = (size_t)(row0 + ai * 128 + m * 16) * D + col0;
#pragma unroll
                for (int bj = 0; bj < 2; ++bj)
#pragma unroll
                    for (int n = 0; n < 2; ++n) { const size_t o = ro + bj * 128 + n * 16;
                        f32x4 xv;
                        if (xin32) xv = *(const f32x4*)(xin32 + o);
                        else { const u32x2 w = *(const u32x2*)(xb + o); xv = (f32x4){bflo(w.x), bfhi(w.x), bflo(w.y), bfhi(w.y)}; }
                        const f32x4 r = xv + gv[bj][n] * acc[ai][bj][m][n];
                        u32x2 ow; ow.x = cvt_pk_bf16(r[0], r[1]); ow.y = cvt_pk_bf16(r[2], r[3]);
                        *(u32x2*)(xb + o) = ow; } }
    }
};
struct EpiMlaQ {
    static constexpr bool PERM = true;
    bf16_t* qm;
    __device__ __forceinline__ void operator()(const f32x4 (&acc)[2][2][4][2], const Unit& u, int wr, int wc, int fr_, int fq_) const {
        int fr = fr_, fq = fq_; asm volatile("" : "+v"(fr), "+v"(fq));
        const int row0 = u.pm * 256 + wr * 64 + fr;
#pragma unroll
        for (int bj = 0; bj < 2; ++bj) {
            const int col0 = u.pn * 256 + bj * 128 + wc * 32;
            if (col0 >= 384) continue;
#pragma unroll
            for (int ai = 0; ai < 2; ++ai)
#pragma unroll
                for (int m = 0; m < 4; ++m) { const f32x4 v0 = acc[ai][bj][m][0], v1 = acc[ai][bj][m][1];
                    u32x4 w; w.x = cvt_pk_bf16(v0[0], v0[1]); w.y = cvt_pk_bf16(v0[2], v0[3]); w.z = cvt_pk_bf16(v1[0], v1[1]); w.w = cvt_pk_bf16(v1[2], v1[3]);
                    *(u32x4*)(qm + (size_t)(row0 + ai * 128 + m * 16) * 384 + col0 + 8 * fq) = w; }
        }
    }
};
struct EpiMlaKV {
    static constexpr bool PERM = true;
    bf16_t* km; bf16_t* vm;
    __device__ __forceinline__ void operator()(const f32x4 (&acc)[2][2][4][2], const Unit& u, int wr, int wc, int fr_, int fq_) const {
        int fr = fr_, fq = fq_; asm volatile("" : "+v"(fr), "+v"(fq));
        const int row0 = u.pm * 256 + wr * 64 + fr;
#pragma unroll
        for (int bj = 0; bj < 2; ++bj) {
            const int head = u.pn * 2 + bj, wcol = wc * 32 + 8 * fq;
#pragma unroll
            for (int ai = 0; ai < 2; ++ai)
#pragma unroll
                for (int m = 0; m < 4; ++m) {
                    const int row = row0 + ai * 128 + m * 16;
                    const f32x4 v0 = acc[ai][bj][m][0], v1 = acc[ai][bj][m][1];
                    u32x4 w; w.x = cvt_pk_bf16(v0[0], v0[1]); w.y = cvt_pk_bf16(v0[2], v0[3]); w.z = cvt_pk_bf16(v1[0], v1[1]); w.w = cvt_pk_bf16(v1[2], v1[3]);
                    bf16_t* q = (wcol < 64) ? km + (size_t)row * 384 + head * 96 + wcol : vm + (size_t)row * 256 + head * 64 + (wcol - 64);
                    *(u32x4*)q = w;
                    asm volatile("" ::: "memory");
                }
        }
    }
};
struct EpiGateUp {
    static constexpr bool PERM = false;
    bf16_t* hid;
    __device__ __forceinline__ void operator()(const f32x4 (&acc)[2][2][4][2], const Unit& u, int wr, int wc, int fr_, int fq_) const {
        int fr = fr_, fq = fq_; asm volatile("" : "+v"(fr), "+v"(fq));
        const int row0 = u.pm * 256 + wr * 64 + fr;
#pragma unroll
        for (int ai = 0; ai < 2; ++ai)
#pragma unroll
            for (int m = 0; m < 4; ++m) { bf16_t* rowp = hid + (size_t)(row0 + ai * 128 + m * 16) * 256;
#pragma unroll
                for (int bj = 0; bj < 2; ++bj) { const f32x4 gt = acc[ai][bj][m][0], up = acc[ai][bj][m][1];
                    f32x4 o;
#pragma unroll
                    for (int j = 0; j < 4; ++j) o[j] = gt[j] / (1.f + __expf(-gt[j])) * up[j];
                    u32x2 w; w.x = cvt_pk_bf16(o[0], o[1]); w.y = cvt_pk_bf16(o[2], o[3]);
                    *(u32x2*)(rowp + 16 * (u.pn * 8 + bj * 4 + wc) + 4 * fq) = w; } }
    }
};
struct EpiDown {
    static constexpr bool PERM = true;
    bf16_t* ys; const int* list; const float* wl; const int* cnt;
    __device__ __forceinline__ void operator()(const f32x4 (&acc)[2][2][4][2], const Unit& u, int wr, int wc, int fr_, int fq_) const {
        int fr = fr_, fq = fq_; asm volatile("" : "+v"(fr), "+v"(fq));
        const int n = cnt[u.e]; const int* le = list + (size_t)u.e * ECAP; const float* we = wl + (size_t)u.e * ECAP;
        const int col0 = u.pn * 256 + wc * 32 + 8 * fq;
        int slot[8]; float w8[8];
#pragma unroll
        for (int q = 0; q < 8; ++q) { const int lr = u.mt * 256 + (q >> 2) * 128 + wr * 64 + (q & 3) * 16 + fr; slot[q] = lr < n ? le[lr] : -1; w8[q] = lr < n ? we[lr] : 0.f; }
#pragma unroll
        for (int ai = 0; ai < 2; ++ai)
#pragma unroll
            for (int m = 0; m < 4; ++m) {
                const int q = ai * 4 + m;
                if (slot[q] >= 0) {
                    bf16_t* rowp = ys + (size_t)slot[q] * D + col0;
#pragma unroll
                    for (int bj = 0; bj < 2; ++bj) { const f32x4 v0 = acc[ai][bj][m][0] * w8[q], v1 = acc[ai][bj][m][1] * w8[q];
                        u32x4 w; w.x = cvt_pk_bf16(v0[0], v0[1]); w.y = cvt_pk_bf16(v0[2], v0[3]); w.z = cvt_pk_bf16(v1[0], v1[1]); w.w = cvt_pk_bf16(v1[2], v1[3]);
                        *(u32x4*)(rowp + bj * 128) = w; }
                }
            }
    }
};
struct MoeOrder {
    int pre[17];
    int NT, G, c; const int* list; const int* cnt;
    __device__ __forceinline__ void init(const int* cnt_, const int* list_, int NT_, int G_, int c_) {
        cnt = cnt_; list = list_; NT = NT_; G = G_; c = c_; int a = 0;
#pragma unroll
        for (int e = 0; e < 16; ++e) { pre[e] = a; a += (cnt_[e] + 255) >> 8; }
        pre[16] = a;
    }
    __device__ __forceinline__ bool next(int i, Unit& u) const {
        const int L = i * G + c; if (L >= pre[16] * NT) return false;
        const int t = L / NT; int e = 0;
#pragma unroll
        for (int k = 1; k < 16; ++k) e += (t >= pre[k]) ? 1 : 0;
        int pe = 0;
#pragma unroll
        for (int k = 0; k < 16; ++k) pe = (k == e) ? pre[k] : pe;
        u.e = e; u.mt = t - pe; u.pm = t; u.pn = L - t * NT; return true;
    }
    __device__ __forceinline__ int arow(const Unit& u, int r) const { const int lr = u.mt * 256 + r; return lr < cnt[u.e] ? (list[(size_t)u.e * ECAP + lr] >> 1) : 0; }
};
}

namespace {
__device__ __forceinline__ void phase_prep(const Params& p, int l) {
    const int tid = opaque_tid(p.wid), w = tid >> 6, lane = tid & 63;
    const int gw = blockIdx.x * 8 + w, nw = gridDim.x * 8;
    for (int sq = gw; sq < NB * 4; sq += nw) {
        const int b = sq >> 2, hh = sq & 3; const float bias = p.b_forget[l * 4 + hh];
        float lf[32]; float run = 0.f;
#pragma unroll
        for (int j = 0; j < 32; ++j) {
            const float z = bf2f(p.proj[(size_t)(b * S + lane * 32 + j) * NP + PC_AF + hh]) + bias;
            run += fminf(z, 0.f) - log1pf(__expf(-fabsf(z)));
            lf[j] = run;
        }
        float incl = run;
#pragma unroll
        for (int o = 1; o < 64; o <<= 1) { const float t2 = __shfl_up(incl, o); if (lane >= o) incl += t2; }
        const float excl = incl - run;
#pragma unroll
        for (int j = 0; j < 32; ++j) p.cbF[(size_t)sq * S + lane * 32 + j] = -(excl + lf[j]) * LOG2E;
    }
    for (int c32 = gw; c32 < T / 32; c32 += nw) {
    float mxq = 0.f, mxk = 0.f;
#define PREP_LOAD(u, tt) do { const bf16_t* _row = p.proj + (size_t)(tt) * NP; \
        n_cq[u] = *(const u32x2*)(_row + PC_BCQ + 4 * lane); n_ck[u] = *(const unsigned*)(_row + PC_BCKV + 2 * lane); \
        n_aq[u] = *(const u32x2*)(_row + PC_AQ + 4 * lane); n_ak[u] = *(const u32x2*)(_row + PC_AK + 4 * lane); \
        n_ki[u] = *(const u32x4*)(_row + PC_DKI + 8 * (lane & 3)); n_kr[u] = _row[PC_BKR + (lane & 31)]; } while (0)
    u32x2 n_cq[4], n_aq[4], n_ak[4]; unsigned n_ck[4]; u32x4 n_ki[4]; bf16_t n_kr[4];
#pragma unroll
    for (int u = 0; u < 4; ++u) PREP_LOAD(u, c32 * 32 + u);
    for (int it = 0; it < 32; it += 4) {
        u32x2 c_cq[4], c_aq[4], c_ak[4]; unsigned c_ck[4]; u32x4 c_ki[4]; bf16_t c_kr[4];
#pragma unroll
        for (int u = 0; u < 4; ++u) { c_cq[u] = n_cq[u]; c_aq[u] = n_aq[u]; c_ak[u] = n_ak[u]; c_ck[u] = n_ck[u]; c_ki[u] = n_ki[u]; c_kr[u] = n_kr[u]; }
        if (it < 28) {
#pragma unroll
            for (int u = 0; u < 4; ++u) PREP_LOAD(u, c32 * 32 + it + 4 + u);
        }
#pragma unroll
        for (int u = 0; u < 4; ++u) {
        const int t = c32 * 32 + it + u;
        const u32x2 cq = c_cq[u], aq = c_aq[u], ak = c_ak[u]; const unsigned ck = c_ck[u]; const u32x4 ki = c_ki[u]; const bf16_t krb = c_kr[u];
        float s1 = bflo(cq.x) * bflo(cq.x) + bfhi(cq.x) * bfhi(cq.x) + bflo(cq.y) * bflo(cq.y) + bfhi(cq.y) * bfhi(cq.y);
        float s2 = bflo(ck) * bflo(ck) + bfhi(ck) * bfhi(ck);
        s1 = wave_sum(s1); s2 = wave_sum(s2);
        if (lane < 4) *(u32x4*)(p.kidx + (size_t)t * 32 + 8 * lane) = ki;
        {
            float nq = bflo(aq.x) * bflo(aq.x) + bfhi(aq.x) * bfhi(aq.x) + bflo(aq.y) * bflo(aq.y) + bfhi(aq.y) * bfhi(aq.y);
            float nk = bflo(ak.x) * bflo(ak.x) + bfhi(ak.x) * bfhi(ak.x) + bflo(ak.y) * bflo(ak.y) + bfhi(ak.y) * bfhi(ak.y);
#pragma unroll
            for (int o = 8; o > 0; o >>= 1) { nq += __shfl_xor(nq, o); nk += __shfl_xor(nk, o); }
            mxq = fmaxf(mxq, nq); mxk = fmaxf(mxk, nk);
        }
        const float kr = (lane < 32) ? bf2f(krb) : 0.f;
        const float kr2 = __shfl(kr, (lane + 16) & 63);
        {
            const float r1 = rsqrtf(s1 * (1.f / 256.f) + EPS), r2 = rsqrtf(s2 * (1.f / 128.f) + EPS);
            u32x2 o; o.x = cvt_pk_bf16(bflo(cq.x) * r1, bfhi(cq.x) * r1); o.y = cvt_pk_bf16(bflo(cq.y) * r1, bfhi(cq.y) * r1);
            *(u32x2*)(p.proj + (size_t)t * NP + PC_BCQ + 4 * lane) = o;
            *(unsigned*)(p.proj + (size_t)t * NP + PC_BCKV + 2 * lane) = cvt_pk_bf16(bflo(ck) * r2, bfhi(ck) * r2);
        }
        if (lane < 16) {
            const int pos = t & (S - 1);
            const float cs = p.ropetab[(pos * 16 + lane) * 2], sn = p.ropetab[(pos * 16 + lane) * 2 + 1];
            const bf16_t o1 = f2bf(kr * cs - kr2 * sn), o2 = f2bf(kr2 * cs + kr * sn);
            bf16_t* kmr = p.km + (size_t)t * 384;
#pragma unroll
            for (int hh = 0; hh < 4; ++hh) { kmr[hh * 96 + 64 + lane] = o1; kmr[hh * 96 + 80 + lane] = o2; }
        }
        }
    }
#undef PREP_LOAD
    if ((lane & 15) == 0) {
        const int t = c32 * 32, bb = t >> 11, pos = t & (S - 1), hh = lane >> 4;
        atomicMax(p.ctl + CW_KN2 + ((l * NB + bb) * 4 + hh) * 32 + (pos >> 6), __float_as_uint(mxk));
        atomicMax(p.ctl + CW_QN2 + ((l * NB + bb) * 4 + hh) * 8 + (pos >> 8), __float_as_uint(mxq));
    }
    }
}

__device__ __forceinline__ void phase_route(const Params& p, int l, char* lds) {
    const int tid = opaque_tid(p.wid), w = tid >> 6, lane = tid & 63;
    float* wrT = (float*)lds;
    int* lcnt = (int*)(lds + 65536);
    int* lbase = (int*)(lds + 65536 + 64);
    int* tsel = (int*)(lds + 65536 + 128);
    float* twt = (float*)(lds + 65536 + 128 + 2048);
    float* lgt = (float*)(lds + 65536 + 8192);
    for (int i = tid; i < 16 * 1024; i += 512) { const int e = i >> 10, d = i & 1023; wrT[i] = p.w_router[d * 16 + e]; }
    const float* g = p.g_norm2 + l * D;
    const float* modl = p.mod + (size_t)l * NB * NMOD;
    int* cnt = (int*)(p.ctl + CW_CNT) + l * 16 + 32 * p.qslot;
    int* list = p.list + (size_t)p.qslot * 16 * ECAP;
    for (int chunk = blockIdx.x; chunk < T / 256; chunk += gridDim.x) {
        if (tid < 16) lcnt[tid] = 0;
        __syncthreads();
        const int b = (chunk * 256) >> 11;
        f32x4 gs4[4], sh4[4];
#pragma unroll
        for (int k = 0; k < 4; ++k) { const int col = 4 * lane + 256 * k; const f32x4 gg = *(const f32x4*)(g + col);
            const f32x4 sc = *(const f32x4*)(modl + (size_t)b * NMOD + 4 * 1024 + col); gs4[k] = gg * (1.f + sc); sh4[k] = *(const f32x4*)(modl + (size_t)b * NMOD + 3 * 1024 + col); }
        const int eown = ((lane >> 5) & 1) * 8 + ((lane >> 4) & 1) * 4 + ((lane >> 3) & 1) * 2 + ((lane >> 2) & 1);
        u32x2 raw[2][4];
#pragma unroll
        for (int q = 0; q < 2; ++q)
#pragma unroll
            for (int k = 0; k < 4; ++k) raw[q][k] = *(const u32x2*)(p.xb + (size_t)(chunk * 256 + w * 32 + q) * D + 4 * lane + 256 * k);
        for (int it = 0; it < 32; it += 2) {
            const int li = w * 32 + it, t = chunk * 256 + li;
            f32x4 v[2][4];
#pragma unroll
            for (int q = 0; q < 2; ++q)
#pragma unroll
                for (int k = 0; k < 4; ++k) v[q][k] = (f32x4){bflo(raw[q][k].x), bfhi(raw[q][k].x), bflo(raw[q][k].y), bfhi(raw[q][k].y)};
            if (it < 30) {
#pragma unroll
                for (int q = 0; q < 2; ++q)
#pragma unroll
                    for (int k = 0; k < 4; ++k) raw[q][k] = *(const u32x2*)(p.xb + (size_t)(t + 2 + q) * D + 4 * lane + 256 * k);
            }
            float ss0 = 0.f, ss1 = 0.f;
#pragma unroll
            for (int k = 0; k < 4; ++k) { ss0 += v[0][k][0] * v[0][k][0] + v[0][k][1] * v[0][k][1] + v[0][k][2] * v[0][k][2] + v[0][k][3] * v[0][k][3];
                                          ss1 += v[1][k][0] * v[1][k][0] + v[1][k][1] * v[1][k][1] + v[1][k][2] * v[1][k][2] + v[1][k][3] * v[1][k][3]; }
            ss0 = wave_sum(ss0); ss1 = wave_sum(ss1);
            const float r0 = rsqrtf(ss0 * (1.0f / D) + EPS), r1 = rsqrtf(ss1 * (1.0f / D) + EPS);
            f32x2 lgp[16];
#pragma unroll
            for (int e = 0; e < 16; ++e) lgp[e] = (f32x2){0.f, 0.f};
#pragma unroll
            for (int k = 0; k < 4; ++k) {
                const int col = 4 * lane + 256 * k;
                const f32x4 y0 = v[0][k] * r0 * gs4[k] + sh4[k], y1 = v[1][k] * r1 * gs4[k] + sh4[k];
                u32x2 o0, o1; o0.x = cvt_pk_bf16(y0[0], y0[1]); o0.y = cvt_pk_bf16(y0[2], y0[3]); o1.x = cvt_pk_bf16(y1[0], y1[1]); o1.y = cvt_pk_bf16(y1[2], y1[3]);
                *(u32x2*)(p.h + (size_t)t * D + col) = o0; *(u32x2*)(p.h + (size_t)(t + 1) * D + col) = o1;
                const f32x2 yp0 = {y0[0], y1[0]}, yp1 = {y0[1], y1[1]}, yp2 = {y0[2], y1[2]}, yp3 = {y0[3], y1[3]};
#pragma unroll
                for (int e = 0; e < 16; ++e) { const f32x4 wv = *(const f32x4*)(wrT + e * 1024 + col);
                    lgp[e] = __builtin_elementwise_fma(yp0, (f32x2){wv[0], wv[0]}, lgp[e]); lgp[e] = __builtin_elementwise_fma(yp1, (f32x2){wv[1], wv[1]}, lgp[e]);
                    lgp[e] = __builtin_elementwise_fma(yp2, (f32x2){wv[2], wv[2]}, lgp[e]); lgp[e] = __builtin_elementwise_fma(yp3, (f32x2){wv[3], wv[3]}, lgp[e]); }
                asm volatile("" ::: "memory");
            }
#pragma unroll
            for (int q = 0; q < 2; ++q) {
                float lg[16];
#pragma unroll
                for (int e = 0; e < 16; ++e) lg[e] = lgp[e][q];
                float a8[8], a4[4], a2[2], a1;
                { const bool hi = (lane & 32) != 0;
#pragma unroll
                  for (int e = 0; e < 8; ++e) { const float send = hi ? lg[e] : lg[e + 8], keep = hi ? lg[e + 8] : lg[e]; a8[e] = keep + __shfl_xor(send, 32); } }
                { const bool hi = (lane & 16) != 0;
#pragma unroll
                  for (int e = 0; e < 4; ++e) { const float send = hi ? a8[e] : a8[e + 4], keep = hi ? a8[e + 4] : a8[e]; a4[e] = keep + __shfl_xor(send, 16); } }
                { const bool hi = (lane & 8) != 0;
#pragma unroll
                  for (int e = 0; e < 2; ++e) { const float send = hi ? a4[e] : a4[e + 2], keep = hi ? a4[e + 2] : a4[e]; a2[e] = keep + __shfl_xor(send, 8); } }
                { const bool hi = (lane & 4) != 0; const float send = hi ? a2[0] : a2[1], keep = hi ? a2[1] : a2[0]; a1 = keep + __shfl_xor(send, 4); }
                a1 += __shfl_xor(a1, 2); a1 += __shfl_xor(a1, 1);
                if ((lane & 3) == 0) lgt[(li + q) * 16 + eown] = a1;
            }
        }
        asm volatile("s_waitcnt lgkmcnt(0)" ::: "memory");
        __builtin_amdgcn_wave_barrier();
        if (lane < 32) {
            const int li = w * 32 + lane;
            float sc[16], bi[16];
#pragma unroll
            for (int e4 = 0; e4 < 4; ++e4) { const f32x4 a = *(const f32x4*)(lgt + li * 16 + 4 * e4);
#pragma unroll
                for (int j = 0; j < 4; ++j) { const float sg = 1.f / (1.f + expf(-a[j])); sc[4 * e4 + j] = sg; bi[4 * e4 + j] = sg + p.b_router[4 * e4 + j]; } }
            int bg = 0; float bgs = -INFINITY;
#pragma unroll
            for (int gi = 0; gi < 4; ++gi) {
                float m1 = -INFINITY, m2 = -INFINITY;
#pragma unroll
                for (int j = 0; j < 4; ++j) { const float vv = bi[gi * 4 + j]; if (vv > m1) { m2 = m1; m1 = vv; } else if (vv > m2) m2 = vv; }
                const float gs = m1 + m2; if (gs > bgs) { bgs = gs; bg = gi; }
            }
            float b4[4], s4[4];
#pragma unroll
            for (int j = 0; j < 4; ++j) { b4[j] = bi[j]; s4[j] = sc[j]; }
#pragma unroll
            for (int gi = 1; gi < 4; ++gi)
#pragma unroll
                for (int j = 0; j < 4; ++j) { b4[j] = (gi == bg) ? bi[gi * 4 + j] : b4[j]; s4[j] = (gi == bg) ? sc[gi * 4 + j] : s4[j]; }
            int i1 = 0; float v1 = -INFINITY;
#pragma unroll
            for (int j = 0; j < 4; ++j) { if (b4[j] > v1) { v1 = b4[j]; i1 = j; } }
            int i2 = 0; float v2 = -INFINITY;
#pragma unroll
            for (int j = 0; j < 4; ++j) { if (j != i1 && b4[j] > v2) { v2 = b4[j]; i2 = j; } }
            float w1 = 0.f, w2 = 0.f;
#pragma unroll
            for (int j = 0; j < 4; ++j) { w1 = (j == i1) ? s4[j] : w1; w2 = (j == i2) ? s4[j] : w2; }
            const int e1 = bg * 4 + i1, e2 = bg * 4 + i2; const float ws = w1 + w2;
            const int r1 = atomicAdd(&lcnt[e1], 1), r2 = atomicAdd(&lcnt[e2], 1);
            tsel[li * 2 + 0] = (e1 << 16) | r1; tsel[li * 2 + 1] = (e2 << 16) | r2;
            twt[li * 2 + 0] = w1 / ws; twt[li * 2 + 1] = w2 / ws;
        }
        __syncthreads();
        if (tid < 16) lbase[tid] = atomicAdd(&cnt[tid], lcnt[tid]);
        __syncthreads();
        { const int v = tsel[tid], e = v >> 16, rk = v & 0xFFFF; const size_t pos = (size_t)e * ECAP + lbase[e] + rk;
          list[pos] = (chunk * 256 + (tid >> 1)) * 2 + (tid & 1); p.wl[pos + (size_t)p.qslot * 16 * ECAP] = twt[tid]; }
        __syncthreads();
    }
}
}

#ifndef ATTN_VMASK
#define ATTN_VMASK 15
#endif
#ifndef REPK_VMASK
#define REPK_VMASK 15
#endif
#ifndef ATTN_DMA
#define ATTN_DMA 1
#endif
#ifndef ATTN_EXP
#define ATTN_EXP 0
#endif
#define AEXP(k) (ATTN_EXP == (k) && xq)
namespace {
constexpr int AT_KB = 0;
constexpr int AT_KR = 16384;
constexpr int AT_VB = 24576;
constexpr int AT_CB = 40960;
constexpr int AT_CTL = 41472;
constexpr int AT_LDS = 41984;
constexpr float NEGBIG = -1.0e30f;

template <int VAR, int KC, bool FULL>
__device__ __forceinline__ void attn_tile_impl(LAS3 char* lds, const int buf, const int j, const int q0, const int i, const int g, const int swk, const float slope2,
                                          const bf16x8 (&qf)[2][KC], f32x4 (&o)[2][4], float (&mrow)[2], float (&lsum)[2], const u32x4 (&mwd)[2][4], const bool xq) {
    typedef LAS3 bf16x4 lds_bf16x4;
    bool need = (64 * j <= q0 + 31);
    if (VAR == 2) need = need && (64 * j + 63 >= q0 - 127);
    if (need) {
        const LAS3 char* Kb = lds + AT_KB + buf * 8192; const LAS3 char* Vb = lds + AT_VB + buf * 8192;
        constexpr bool full = FULL;
        f32x4 s[2][4];
#pragma unroll
        for (int qt = 0; qt < 2; ++qt) {
            const int t = q0 + 16 * qt + i;
            const int dbase = 64 * j + 4 * g - t;
            const float sb = slope2 * ((VAR == 2) ? (float)dbase : (float)(64 * j + 4 * g));
#pragma unroll
            for (int mt = 0; mt < 4; ++mt) {
                f32x4 ini = {0.f, 0.f, 0.f, 0.f};
                if (VAR == 0) ini = *(const LAS3 f32x4*)(lds + AT_CB + buf * 256 + (16 * mt + 4 * g) * 4);
#pragma unroll
                for (int r = 0; r < 4; ++r) {
                    const int c = 16 * mt + r;
                    float v = ini[r];
                    if (VAR >= 2) v = sb + slope2 * (float)c;
                    if (VAR == 3) {
                        const int m = ((int)(mwd[qt][mt][r] << (31 - j))) >> 31;
                        v = __uint_as_float((__float_as_uint(v) & (unsigned)m) | (__float_as_uint(NEGBIG) & ~(unsigned)m));
                    } else if (!full) {
                        bool ok;
                        if (VAR == 2) ok = (unsigned)(dbase + c + 127) < 128u;
                        else ok = (dbase + c) <= 0;
                        v = ok ? v : NEGBIG;
                    }
                    ini[r] = v;
                }
                s[qt][mt] = ini;
            }
        }
        if (!AEXP(2))
#pragma unroll
        for (int mt = 0; mt < 4; ++mt) {
#pragma unroll
            for (int kc = 0; kc < 2; ++kc) {
                const bf16x8 kf = AEXP(7) ? qf[0][kc] : *(const LAS3 bf16x8*)(Kb + (mt * 16 + i) * 128 + (((kc * 4 + g) ^ swk) << 4));
                s[0][mt] = __builtin_amdgcn_mfma_f32_16x16x32_bf16(kf, qf[0][kc], s[0][mt], 0, 0, 0);
                s[1][mt] = __builtin_amdgcn_mfma_f32_16x16x32_bf16(kf, qf[1][kc], s[1][mt], 0, 0, 0);
            }
            if (VAR == 1) {
                const bf16x8 kf = *(const LAS3 bf16x8*)(lds + AT_KR + buf * 4096 + (mt * 16 + i) * 64 + ((g ^ (swk & 3)) << 4));
                s[0][mt] = __builtin_amdgcn_mfma_f32_16x16x32_bf16(kf, qf[0][KC - 1], s[0][mt], 0, 0, 0);
                s[1][mt] = __builtin_amdgcn_mfma_f32_16x16x32_bf16(kf, qf[1][KC - 1], s[1][mt], 0, 0, 0);
            }
        }
        bf16x8 pf[2][2];
#pragma unroll
        for (int qt = 0; qt < 2; ++qt) {
            float mx = AEXP(6) ? 0.f : fmaxf(fmaxf(s[qt][0][0], s[qt][0][1]), fmaxf(s[qt][0][2], s[qt][0][3]));
            if (!AEXP(6)) {
#pragma unroll
            for (int mt = 1; mt < 4; ++mt) mx = fmaxf(mx, fmaxf(fmaxf(s[qt][mt][0], s[qt][mt][1]), fmaxf(s[qt][mt][2], s[qt][mt][3])));
            mx = fmaxf(mx, __builtin_bit_cast(float, __builtin_amdgcn_ds_swizzle(__builtin_bit_cast(int, mx), 0x401F)));
            mx = xor32_max(mx);
            if (__any(mx > mrow[qt])) {
                const float mn = fmaxf(mrow[qt], mx), alpha = __builtin_amdgcn_exp2f(mrow[qt] - mn);
                mrow[qt] = mn; lsum[qt] *= alpha;
#pragma unroll
                for (int dt = 0; dt < 4; ++dt) o[qt][dt] = o[qt][dt] * alpha;
            }
            }
            const float mn = mrow[qt];
            const f32x4 mn4 = {mn, mn, mn, mn};
            f32x4 ps4 = {0.f, 0.f, 0.f, 0.f};
            float x[4][4];
#pragma unroll
            for (int mt = 0; mt < 4; ++mt) {
                const f32x4 d4 = s[qt][mt] - mn4;
                f32x4 e4;
#pragma unroll
                for (int r = 0; r < 4; ++r) { e4[r] = (AEXP(3) || AEXP(6)) ? d4[r] : __builtin_amdgcn_exp2f(d4[r]); x[mt][r] = e4[r]; }
                ps4 += e4;
            }
            lsum[qt] += (ps4[0] + ps4[1]) + (ps4[2] + ps4[3]);
#pragma unroll
            for (int c = 0; c < 2; ++c) {
                u32x4 pk; pk.x = cvt_pk_bf16(x[2 * c][0], x[2 * c][1]); pk.y = cvt_pk_bf16(x[2 * c][2], x[2 * c][3]);
                pk.z = cvt_pk_bf16(x[2 * c + 1][0], x[2 * c + 1][1]); pk.w = cvt_pk_bf16(x[2 * c + 1][2], x[2 * c + 1][3]);
                pf[qt][c] = __builtin_bit_cast(bf16x8, pk);
            }
        }
        const int q4 = i >> 2, p4 = i & 3;
        if (!AEXP(4))
#pragma unroll
        for (int c = 0; c < 2; ++c) {
            const int row0 = 32 * c + 4 * g + q4, swv = (row0 >> 1) & 3;
#pragma unroll
            for (int dt = 0; dt < 4; ++dt) {
                const LAS3 char* a0 = Vb + row0 * 128 + ((dt ^ swv) << 5) + p4 * 8;
                bf16x4 v0, v1;
                if (AEXP(7)) { v0 = (bf16x4){1, 2, 3, 4}; v1 = v0; } else {
                v0 = __builtin_amdgcn_ds_read_tr16_b64_v4i16((lds_bf16x4*)(a0));
                v1 = __builtin_amdgcn_ds_read_tr16_b64_v4i16((lds_bf16x4*)(a0 + 16 * 128)); }
                const bf16x8 vf = {v0[0], v0[1], v0[2], v0[3], v1[0], v1[1], v1[2], v1[3]};
                o[0][dt] = __builtin_amdgcn_mfma_f32_16x16x32_bf16(vf, pf[0][c], o[0][dt], 0, 0, 0);
                o[1][dt] = __builtin_amdgcn_mfma_f32_16x16x32_bf16(vf, pf[1][c], o[1][dt], 0, 0, 0);
            }
        }
    }
}

template <int VAR, int KC>
__device__ __forceinline__ void attn_tile(LAS3 char* lds, const int buf, const int j, const int q0, const int i, const int g, const int swk, const float slope2,
                                          const bf16x8 (&qf)[2][KC], f32x4 (&o)[2][4], float (&mrow)[2], float (&lsum)[2], const u32x4 (&mwd)[2][4], const bool xq) {
    bool full = (64 * j + 63 <= q0);
    if (VAR == 2) full = full && (64 * j >= q0 - 96);
    if (VAR == 3) full = false;
    if (VAR != 3 && full) attn_tile_impl<VAR, KC, true>(lds, buf, j, q0, i, g, swk, slope2, qf, o, mrow, lsum, mwd, xq);
    else attn_tile_impl<VAR, KC, false>(lds, buf, j, q0, i, g, swk, slope2, qf, o, mrow, lsum, mwd, xq);
}

template <int VAR>
__device__ __forceinline__ void attn_unit(const Params& p, int l, int b, int hx, int qb, LAS3 char* lds) {
    typedef LAS3 bf16x4 lds_bf16x4;
    constexpr int KC = (VAR == 1) ? 3 : 2;
    const int tid = opaque_tid(p.wid), w = __builtin_amdgcn_readfirstlane(tid >> 6), lane = tid & 63, i = lane & 15, g = lane >> 4;
    const bf16_t *Qp, *Kp, *Vp; int ldq, ldk, ldv, q0, j0, j1, ocol; float c1, slope2 = 0.f;
    if (VAR == 0) { Qp = p.proj + PC_AQ + hx * 64; Kp = p.proj + PC_AK + hx * 64; Vp = p.proj + PC_AV + hx * 64; ldq = ldk = ldv = NP;
                    q0 = qb * 256 + 32 * w; j0 = 0; j1 = 4 * qb + 3; ocol = hx * 64; c1 = 0.125f * LOG2E; }
    else if (VAR == 1) { Qp = p.qm + hx * 96; Kp = p.km + hx * 96; Vp = p.vm + hx * 64; ldq = 384; ldk = 384; ldv = 256;
                    q0 = qb * 256 + 32 * w; j0 = 0; j1 = 4 * qb + 3; ocol = 256 + hx * 64; c1 = 0.10206207261596577f * LOG2E; }
    else if (VAR == 2) { const int qh = hx * 2 + (w >> 2); Qp = p.proj + PC_CQ + qh * 64; Kp = p.proj + PC_CK + hx * 64; Vp = p.proj + PC_CV + hx * 64; ldq = ldk = ldv = NP;
                    q0 = qb * 128 + 32 * (w & 3); j0 = 2 * qb - 2 > 0 ? 2 * qb - 2 : 0; j1 = 2 * qb + 1; ocol = 512 + qh * 64; c1 = 0.125f * LOG2E;
                    slope2 = exp2f(-(float)(qh + 1)) * LOG2E; }
    else { const int hd = w >> 1; Qp = p.proj + PC_DQ + hd * 64; Kp = p.proj + PC_DK; Vp = p.proj + PC_DV; ldq = ldk = ldv = NP;
                    q0 = qb * 64 + 32 * (w & 1); j0 = 0; j1 = qb; ocol = 768 + hd * 64; c1 = 0.125f * LOG2E; slope2 = exp2f(-(float)(hd + 5)) * LOG2E; }
    const size_t tok0 = (size_t)b * S;
    const bool xq = p.qslot > 0;
    if (VAR == 0 && qb > 0) {
        constexpr float FOX_DROP = 64.0f;
        const unsigned* kn2 = p.ctl + CW_KN2 + ((l * NB + b) * 4 + hx) * 32;
        const float* cbh = p.cbF + ((size_t)b * 4 + hx) * S;
        const float qn = c1 * sqrtf(__uint_as_float(p.ctl[CW_QN2 + ((l * NB + b) * 4 + hx) * 8 + qb]));
        float knu = 0.f;
        for (int jj = 4 * qb; jj < 4 * qb + 4; ++jj) knu = fmaxf(knu, __uint_as_float(kn2[jj]));
        const float lower = cbh[256 * qb] - qn * sqrtf(knu);
        const int jl = lane & 31;
        const bool keep = qn * sqrtf(__uint_as_float(kn2[jl])) + cbh[64 * jl + 63] - lower >= -FOX_DROP || jl >= 4 * qb;
        const unsigned long long kb = __ballot(keep) & 0xFFFFFFFFull;
        j0 = kb ? (int)__builtin_ctzll(kb) : 4 * qb;
    }
    bf16x8 qf[2][KC];
#pragma unroll
    for (int qt = 0; qt < 2; ++qt)
#pragma unroll
        for (int kc = 0; kc < KC; ++kc) qf[qt][kc] = *(const bf16x8*)(Qp + (tok0 + q0 + 16 * qt + i) * ldq + kc * 32 + 8 * g);
    u32x4 mwd[2][4];
#pragma unroll
    for (int qt = 0; qt < 2; ++qt)
#pragma unroll
        for (int mt = 0; mt < 4; ++mt) mwd[qt][mt] = (VAR == 3) ? *(const u32x4*)(p.mask + (tok0 + q0 + 16 * qt + i) * 64 + 16 * mt + 4 * g) : (u32x4){0u, 0u, 0u, 0u};
#if ATTN_DMA
    const int drow = 8 * w + (lane >> 3), dch = lane & 7;
    const int ksc = dch ^ ((drow >> 1) & 7);
    const int vsc = ((((dch >> 1) ^ ((drow >> 1) & 3)) << 1) | (dch & 1));
    const int rrow = 16 * (w & 3) + (lane >> 2), rsc = (lane & 3) ^ ((rrow >> 1) & 3);
#define AT_DMA(j, buf) do { \
        __builtin_amdgcn_global_load_lds((const unsigned*)(Kp + (tok0 + 64 * (j) + drow) * ldk + ksc * 8), (LAS3 unsigned*)(lds + AT_KB + (buf) * 8192 + w * 1024), 16, 0, 0); \
        __builtin_amdgcn_global_load_lds((const unsigned*)(Vp + (tok0 + 64 * (j) + drow) * ldv + vsc * 8), (LAS3 unsigned*)(lds + AT_VB + (buf) * 8192 + w * 1024), 16, 0, 0); \
        if (VAR == 1 && w < 4) __builtin_amdgcn_global_load_lds((const unsigned*)(Kp + (tok0 + 64 * (j) + rrow) * ldk + 64 + rsc * 8), (LAS3 unsigned*)(lds + AT_KR + (buf) * 4096 + w * 1024), 16, 0, 0); \
        if (VAR == 0 && w == 0) __builtin_amdgcn_global_load_lds((const unsigned*)(p.cbF + ((size_t)b * 4 + hx) * S + 64 * (j) + lane), (LAS3 unsigned*)(lds + AT_CB + (buf) * 256), 4, 0, 0); \
    } while (0)
    AT_DMA(j0, j0 & 1);
#else
    const int sr = tid >> 3, sc8 = tid & 7;
    const int kdst = sr * 128 + ((sc8 ^ ((sr >> 1) & 7)) << 4);
    const int vdst = sr * 128 + (((((sc8 >> 1) ^ ((sr >> 1) & 3)) << 1) | (sc8 & 1)) << 4);
    const int rr = (tid & 255) >> 2, rc4 = tid & 3;
    const int rdst = rr * 64 + ((rc4 ^ ((rr >> 1) & 3)) << 4);
    u32x4 kstA, vstA, rstA = {0u, 0u, 0u, 0u}, kstB, vstB, rstB = {0u, 0u, 0u, 0u}; float cstA = 0.f, cstB = 0.f;
#define AT_LOAD(ZZ, j) do { if (AEXP(1)) break; const size_t _kr = tok0 + 64 * (j) + sr; \
        kst##ZZ = *(const u32x4*)(Kp + _kr * ldk + sc8 * 8); vst##ZZ = *(const u32x4*)(Vp + _kr * ldv + sc8 * 8); \
        if (VAR == 1) rst##ZZ = *(const u32x4*)(Kp + (tok0 + 64 * (j) + rr) * ldk + 64 + rc4 * 8); \
        if (VAR == 0) cst##ZZ = p.cbF[((size_t)b * 4 + hx) * S + 64 * (j) + (tid & 63)]; } while (0)
#define AT_WRITE(ZZ, buf) do { if (AEXP(1)) break; *(LAS3 u32x4*)(lds + AT_KB + (buf) * 8192 + kdst) = kst##ZZ; *(LAS3 u32x4*)(lds + AT_VB + (buf) * 8192 + vdst) = vst##ZZ; \
        if (VAR == 1 && tid < 256) *(LAS3 u32x4*)(lds + AT_KR + (buf) * 4096 + rdst) = rst##ZZ; \
        if (VAR == 0 && tid < 64) *(LAS3 float*)(lds + AT_CB + (buf) * 256 + tid * 4) = cst##ZZ; } while (0)
    AT_LOAD(A, j0);
    AT_LOAD(B, (j0 + 1 <= j1 ? j0 + 1 : j1));
#endif
    if (VAR == 1) {
#pragma unroll
        for (int qt = 0; qt < 2; ++qt) {
            const int pos = q0 + 16 * qt + i;
            const u32x4 mine = __builtin_bit_cast(u32x4, qf[qt][KC - 1]);
            u32x4 oth; oth.x = __shfl_xor(mine.x, 32); oth.y = __shfl_xor(mine.y, 32); oth.z = __shfl_xor(mine.z, 32); oth.w = __shfl_xor(mine.w, 32);
            const float* rt = p.ropetab + (size_t)(pos * 16 + (g & 1) * 8) * 2;
            const float sg = (g < 2) ? -1.f : 1.f;
            u32x4 res;
#pragma unroll
            for (int e2 = 0; e2 < 4; ++e2) {
                const f32x4 cs = *(const f32x4*)(rt + e2 * 4);
                const unsigned mw_ = e2 == 0 ? mine.x : e2 == 1 ? mine.y : e2 == 2 ? mine.z : mine.w, ow_ = e2 == 0 ? oth.x : e2 == 1 ? oth.y : e2 == 2 ? oth.z : oth.w;
                const float r0 = bflo(mw_) * cs[0] + sg * bflo(ow_) * cs[1], r1 = bfhi(mw_) * cs[2] + sg * bfhi(ow_) * cs[3];
                const unsigned pk = cvt_pk_bf16(r0, r1);
                if (e2 == 0) res.x = pk; else if (e2 == 1) res.y = pk; else if (e2 == 2) res.z = pk; else res.w = pk;
            }
            qf[qt][KC - 1] = __builtin_bit_cast(bf16x8, res);
        }
    }
#pragma unroll
    for (int qt = 0; qt < 2; ++qt)
#pragma unroll
        for (int kc = 0; kc < KC; ++kc) {
            u32x4 qq = __builtin_bit_cast(u32x4, qf[qt][kc]);
            qq.x = cvt_pk_bf16(bflo(qq.x) * c1, bfhi(qq.x) * c1); qq.y = cvt_pk_bf16(bflo(qq.y) * c1, bfhi(qq.y) * c1);
            qq.z = cvt_pk_bf16(bflo(qq.z) * c1, bfhi(qq.z) * c1); qq.w = cvt_pk_bf16(bflo(qq.w) * c1, bfhi(qq.w) * c1);
            qf[qt][kc] = __builtin_bit_cast(bf16x8, qq);
        }
    f32x4 o[2][4];
#pragma unroll
    for (int qt = 0; qt < 2; ++qt)
#pragma unroll
        for (int dt = 0; dt < 4; ++dt) o[qt][dt] = (f32x4){0.f, 0.f, 0.f, 0.f};
    float mrow[2] = {NEGBIG, NEGBIG}, lsum[2] = {0.f, 0.f};
#if ATTN_DMA
    const int swk = (i >> 1) & 7;
    asm volatile("s_waitcnt vmcnt(0)" ::: "memory");
    __syncthreads();
    for (int j = j0; j <= (AEXP(8) ? j0 - 1 : j1); ++j) {
        if (j < j1) AT_DMA(j + 1, (j + 1) & 1);
        attn_tile<VAR, KC>(lds, j & 1, j, q0, i, g, swk, slope2, qf, o, mrow, lsum, mwd, xq);
        asm volatile("s_waitcnt vmcnt(0)" ::: "memory");
        __syncthreads();
    }
#undef AT_DMA
#else
    AT_WRITE(A, j0 & 1);
    __syncthreads();
    const int swk = (i >> 1) & 7;
    for (int j = j0; j <= j1; j += 2) {
        AT_LOAD(A, (j + 2 <= j1 ? j + 2 : j1));
        attn_tile<VAR, KC>(lds, j & 1, j, q0, i, g, swk, slope2, qf, o, mrow, lsum, mwd, xq);
        if (j + 1 <= j1) AT_WRITE(B, (j + 1) & 1);
        if (!AEXP(5)) __syncthreads();
        if (j + 1 > j1) break;
        AT_LOAD(B, (j + 3 <= j1 ? j + 3 : j1));
        attn_tile<VAR, KC>(lds, (j + 1) & 1, j + 1, q0, i, g, swk, slope2, qf, o, mrow, lsum, mwd, xq);
        if (j + 2 <= j1) AT_WRITE(A, j & 1);
        if (!AEXP(5)) __syncthreads();
    }
#undef AT_LOAD
#undef AT_WRITE
#endif
#pragma unroll
    for (int qt = 0; qt < 2; ++qt) {
        float lt = lsum[qt]; lt += __shfl_xor(lt, 16); lt += __shfl_xor(lt, 32);
        if (VAR == 2) lt += __builtin_amdgcn_exp2f(p.sinks[l * 4 + hx * 2 + (w >> 2)] * LOG2E - mrow[qt]);
        const float inv = 1.f / lt;
        bf16_t* op = p.merged + (tok0 + q0 + 16 * qt + i) * D + ocol + 4 * g;
        if (!(ATTN_EXP != 0 && xq))
#pragma unroll
        for (int dt = 0; dt < 4; ++dt) { const f32x4 v = o[qt][dt] * inv; u32x2 w2; w2.x = cvt_pk_bf16(v[0], v[1]); w2.y = cvt_pk_bf16(v[2], v[3]); *(u32x2*)(op + 16 * dt) = w2; }
    }
}

__device__ __forceinline__ void phase_attn(const Params& p, int l, LAS3 char* lds) {
    const int tid = opaque_tid(p.wid);
    unsigned* qhead = p.ctl + CW_QA + 64 * (l + 2 * p.qslot);
    volatile LAS3 int* bc = (volatile LAS3 int*)(lds + AT_CTL);
    int nxt = 0;
    if (tid == 0) nxt = (int)__hip_atomic_fetch_add(qhead, 1u, __ATOMIC_RELAXED, __HIP_MEMORY_SCOPE_AGENT);
    for (;;) {
        if (tid == 0) *bc = nxt;
        __syncthreads();
        const int idx = __builtin_amdgcn_readfirstlane(*bc);
        __syncthreads();
        if (idx >= 4096) break;
        if (tid == 0) nxt = (int)__hip_atomic_fetch_add(qhead, 1u, __ATOMIC_RELAXED, __HIP_MEMORY_SCOPE_AGENT);
        const int vmask = p.qslot ? REPK_VMASK : ATTN_VMASK;
        if (idx < 3072) {
            const int lvl = 7 - idx / 384, rem = idx % 384;
            if (rem < 128) { if (vmask & 2) attn_unit<1>(p, l, rem >> 2, rem & 3, lvl, lds); }
            else if (rem < 256) { if (vmask & 1) attn_unit<0>(p, l, (rem - 128) >> 2, rem & 3, lvl, lds); }
            else { const int d = rem - 256; if (vmask & 8) attn_unit<3>(p, l, d & 31, 0, 4 * lvl + 3 - (d >> 5), lds); }
        } else { const int c = idx - 3072; if (vmask & 4) attn_unit<2>(p, l, c >> 5, (c >> 4) & 1, c & 15, lds); }
    }
}
}

namespace {
constexpr int DS_LD = 2052;
constexpr int DS_CTL = 16 * DS_LD * 4;
constexpr int DS_LDS = DS_CTL + 64;

__device__ __forceinline__ void dsa_unit(const Params& p, int u, LAS3 char* lds) {
    const int tid = opaque_tid(p.wid), w = __builtin_amdgcn_readfirstlane(tid >> 6), lane = tid & 63, i = lane & 15, g = lane >> 4;
    const int b = u >> 7, t0 = (u & 127) * 16;
    const size_t tok0 = (size_t)b * S;
    uint32_t* mbase = p.mask + (tok0 + t0) * 64;
    if (t0 + 16 <= 256) {
#pragma unroll
        for (int qq = 0; qq < 2; ++qq) {
            const int q = 2 * w + qq, n = t0 + q + 1;
            const int cnt = n > lane ? ((n - lane + 63) >> 6) : 0;
            mbase[q * 64 + lane] = cnt >= 32 ? 0xFFFFFFFFu : ((1u << cnt) - 1u);
        }
        return;
    }
    const int nreg = (t0 + 16 + 63) >> 6;
    const int ntile = nreg * 4;
    bf16x8 qf[8]; float wq[8];
    {
        const bf16_t* qrow = p.proj + (tok0 + t0 + i) * NP;
#pragma unroll
        for (int h = 0; h < 8; ++h) qf[h] = *(const bf16x8*)(qrow + PC_DQI + h * 32 + 8 * g);
        const u32x4 ww = *(const u32x4*)(qrow + PC_DWI);
        const float sc = 0.35355339059327373f * 0.17677669529663687f;
        wq[0] = bflo(ww.x) * sc; wq[1] = bfhi(ww.x) * sc; wq[2] = bflo(ww.y) * sc; wq[3] = bfhi(ww.y) * sc;
        wq[4] = bflo(ww.z) * sc; wq[5] = bfhi(ww.z) * sc; wq[6] = bflo(ww.w) * sc; wq[7] = bfhi(ww.w) * sc;
    }
    const int tq = t0 + i;
#ifndef DSA_EXP
#define DSA_EXP 0
#endif
    const bool exp_skip_score = (DSA_EXP == 2) && p.qslot > 0, exp_skip_sel = (DSA_EXP == 1) && p.qslot > 0, exp_nostore = (DSA_EXP != 0) && p.qslot > 0;
    if (!exp_skip_score)
    for (int base = w; base < ntile; base += 32) {
        bf16x8 kf4[4];
#pragma unroll
        for (int uu = 0; uu < 4; ++uu) { const int kt = base + 8 * uu; if (kt < ntile) kf4[uu] = *(const bf16x8*)(p.kidx + (tok0 + 16 * kt + i) * 32 + 8 * g); }
#pragma unroll
        for (int uu = 0; uu < 4; ++uu) {
            const int kt = base + 8 * uu;
            if (kt < ntile) {
                f32x4 sc4 = {0.f, 0.f, 0.f, 0.f};
#pragma unroll
                for (int h = 0; h < 8; ++h) {
                    const f32x4 c = __builtin_amdgcn_mfma_f32_16x16x32_bf16(kf4[uu], qf[h], (f32x4){0.f, 0.f, 0.f, 0.f}, 0, 0, 0);
#pragma unroll
                    for (int r = 0; r < 4; ++r) { const int ci = __float_as_int(c[r]); sc4[r] += wq[h] * __int_as_float(ci > 0 ? ci : 0); }
                }
                u32x4 ko;
#pragma unroll
                for (int r = 0; r < 4; ++r) {
                    const int key = 16 * kt + 4 * g + r;
                    unsigned uu2 = __float_as_uint(sc4[r]); if (uu2 == 0x80000000u) uu2 = 0u;
                    uu2 = (uu2 & 0x80000000u) ? ~uu2 : (uu2 | 0x80000000u);
                    ko[r] = (key <= tq) ? uu2 : 0u;
                }
                *(LAS3 u32x4*)(lds + ((size_t)i * DS_LD + 16 * kt + 4 * g) * 4) = ko;
            }
        }
    }
    __syncthreads();
    if (!exp_skip_sel)
    {
        const int qA = 2 * w, qB = 2 * w + 1;
        const LAS3 unsigned* kpA = (const LAS3 unsigned*)(lds + (size_t)qA * DS_LD * 4);
        const LAS3 unsigned* kpB = (const LAS3 unsigned*)(lds + (size_t)qB * DS_LD * 4);
        unsigned PA[32], PB[32];
        const int nv = nreg * 64;
#pragma unroll
        for (int r = 0; r < 32; ++r) {
            int idx = r * 64 + lane; asm volatile("" : "+v"(idx));
            const unsigned va = kpA[r * 64 + lane], vb = kpB[r * 64 + lane];
            PA[r] = (idx < nv) ? va : 0u; PB[r] = (idx < nv) ? vb : 0u;
        }
#define DSA_TR(P, j, m) do { _Pragma("unroll") for (int k = 0; k < 32; ++k) if ((k & (j)) == 0) { const unsigned x = P[k], y = P[k + (j)]; \
            P[k] = (x & (m)) | ((y << (j)) & ~(m)); P[k + (j)] = ((x >> (j)) & (m)) | (y & ~(m)); } } while (0)
        DSA_TR(PA, 16, 0x0000FFFFu); DSA_TR(PB, 16, 0x0000FFFFu); DSA_TR(PA, 8, 0x00FF00FFu); DSA_TR(PB, 8, 0x00FF00FFu);
        DSA_TR(PA, 4, 0x0F0F0F0Fu); DSA_TR(PB, 4, 0x0F0F0F0Fu); DSA_TR(PA, 2, 0x33333333u); DSA_TR(PB, 2, 0x33333333u);
        DSA_TR(PA, 1, 0x55555555u); DSA_TR(PB, 1, 0x55555555u);
#undef DSA_TR
        unsigned alA = 0xFFFFFFFFu, abA = 0u, selA = 0u, alB = 0xFFFFFFFFu, abB = 0u, selB = 0u;
        bool exA = false, exB = false;
#pragma unroll
        for (int bit = 31; bit >= 1; bit -= 2) {
            if (!(exA && exB)) {
                const unsigned p1A = PA[bit], p0A = PA[bit - 1], p1B = PB[bit], p0B = PB[bit - 1];
                const unsigned t1A = alA & p1A, c3A = abA | (t1A & p0A), c2A = abA | t1A, c1A = abA | (alA & (p1A | p0A));
                const unsigned t1B = alB & p1B, c3B = abB | (t1B & p0B), c2B = abB | t1B, c1B = abB | (alB & (p1B | p0B));
                const int rA = wave_reduce_add(__builtin_popcount(c3A) | (__builtin_popcount(c2A) << 16));
                const int rB = wave_reduce_add(__builtin_popcount(c3B) | (__builtin_popcount(c2B) << 16));
                const int rC = wave_reduce_add(__builtin_popcount(c1A) | (__builtin_popcount(c1B) << 16));
                const int n3A = rA & 0xFFFF, n2A = rA >> 16, n1A = rC & 0xFFFF, n3B = rB & 0xFFFF, n2B = rB >> 16, n1B = rC >> 16;
                if (!exA) {
                    if (n3A >= 256) { if (n3A == 256) { exA = true; selA = c3A; } alA = t1A & p0A; }
                    else if (n2A >= 256) { if (n2A == 256) { exA = true; selA = c2A; } abA = c3A; alA = t1A & ~p0A; }
                    else if (n1A >= 256) { if (n1A == 256) { exA = true; selA = c1A; } abA = c2A; alA = alA & ~p1A & p0A; }
                    else { abA = c1A; alA = alA & ~(p1A | p0A); }
                }
                if (!exB) {
                    if (n3B >= 256) { if (n3B == 256) { exB = true; selB = c3B; } alB = t1B & p0B; }
                    else if (n2B >= 256) { if (n2B == 256) { exB = true; selB = c2B; } abB = c3B; alB = t1B & ~p0B; }
                    else if (n1B >= 256) { if (n1B == 256) { exB = true; selB = c1B; } abB = c2B; alB = alB & ~p1B & p0B; }
                    else { abB = c1B; alB = alB & ~(p1B | p0B); }
                }
            }
        }
        const unsigned long long lt = (lane == 0) ? 0ull : (~0ull >> (64 - lane));
#pragma unroll 1
        for (int qq = 0; qq < 2; ++qq) {
            const bool exact = qq ? exB : exA;
            unsigned sel = qq ? selB : selA;
            if (!exact) {
                const unsigned al = qq ? alB : alA, ab = qq ? abB : abA;
                const int need = 256 - wave_reduce_add(__builtin_popcount(ab));
                int running = 0; sel = ab;
                for (int r = 0; r < 32; ++r) {
                    const bool eq = ((al >> r) & 1u) != 0u;
                    const unsigned long long be = __ballot(eq);
                    if (eq && running + __popcll(be & lt) < need) sel |= 1u << r;
                    running += __popcll(be);
                }
            }
            if (!exp_nostore) mbase[(2 * w + qq) * 64 + lane] = sel;
        }
    }
    __syncthreads();
}

__device__ __forceinline__ void phase_dsa(const Params& p, int l, LAS3 char* lds) {
    const int tid = opaque_tid(p.wid);
    unsigned* qhead = p.ctl + CW_QD + 64 * (l + 2 * p.qslot);
    volatile LAS3 int* bc = (volatile LAS3 int*)(lds + DS_CTL);
    int nxt = 0;
    if (tid == 0) nxt = (int)__hip_atomic_fetch_add(qhead, 1u, __ATOMIC_RELAXED, __HIP_MEMORY_SCOPE_AGENT);
    for (;;) {
        if (tid == 0) *bc = nxt;
        __syncthreads();
        const int idx = __builtin_amdgcn_readfirstlane(*bc);
        __syncthreads();
        if (idx >= 4096) break;
        if (tid == 0) nxt = (int)__hip_atomic_fetch_add(qhead, 1u, __ATOMIC_RELAXED, __HIP_MEMORY_SCOPE_AGENT);
        const int pb = 127 - (idx >> 5), b = idx & 31;
        dsa_unit(p, b * 128 + pb, lds);
    }
}
}

namespace {
constexpr int LDS_BYTES = 147456;
constexpr int NTHREADS = 512;

template <int PH>
__device__ __forceinline__ void run_phase(const Params& p, int l, unsigned char* smem) {
    LAS3 char* lds = (LAS3 char*)smem;
    PG8_LAS unsigned char* glds = (PG8_LAS unsigned char*)smem;
    const int G = gridDim.x, c = blockIdx.x;
    if constexpr (PH == 0) phase_p0(p, (char*)smem);
    if constexpr (PH == 1) { if (l == 0) phase_norm1<0>(p, 0); else phase_norm1<1>(p, l); }
    if constexpr (PH == 2) { pg8::Gemm g{p.h, p.WinT + (size_t)l * NP * D, D, D, 0}; pg8::StaticOrder S; S.init(T, NP, G, c);
        EpiStoreBf16 E{p.proj, NP}; pg8::gemm_phase<EpiStoreBf16, pg8::StaticOrder, false>(glds, g, S, E, p.wid); }
    if constexpr (PH == 3) phase_prep(p, l);
    if constexpr (PH == 4) { pg8::Gemm g{p.proj + PC_BCQ, p.WqT + (size_t)l * 512 * 256, 256, NP, 0}; pg8::StaticOrder S; S.init(T, 512, G, c);
          EpiMlaQ E{p.qm}; pg8::gemm_phase<EpiMlaQ, pg8::StaticOrder, false>(glds, g, S, E, p.wid); }
    if constexpr (PH == 12) { pg8::Gemm g{p.proj + PC_BCKV, p.WkvT + (size_t)l * 512 * 128, 128, NP, 0}; pg8::StaticOrder S; S.init(T, 512, G, c);
          EpiMlaKV E{p.km, p.vm}; pg8::gemm_phase<EpiMlaKV, pg8::StaticOrder, false>(glds, g, S, E, p.wid); }
    if constexpr (PH == 13) phase_dsa(p, l, lds);
    if constexpr (PH == 5) phase_attn(p, l, lds);
    if constexpr (PH == 6) { pg8::Gemm g{p.merged, p.WoutT + (size_t)l * D * D, D, D, 0}; pg8::StaticOrder S; S.init(T, D, G, c);
        EpiResidual E{l == 0 ? p.x : nullptr, p.xb, p.mod + (size_t)l * NB * NMOD + 2 * 1024}; pg8::gemm_phase<EpiResidual, pg8::StaticOrder, false>(glds, g, S, E, p.wid); }
    if constexpr (PH == 7) phase_route(p, l, (char*)smem);
    if constexpr (PH == 8) { const int* cnt = (const int*)(p.ctl + CW_CNT) + l * 16;
        pg8::Gemm g{p.h, p.WguT + (size_t)l * 16 * 512 * 1024, 1024, D, (size_t)512 * 1024}; MoeOrder S; S.init(cnt, p.list, 2, G, c);
        EpiGateUp E{p.hid}; pg8::gemm_phase<EpiGateUp, MoeOrder, true>(glds, g, S, E, p.wid); }
    if constexpr (PH == 9) { const int* cnt = (const int*)(p.ctl + CW_CNT) + l * 16;
        pg8::Gemm g{p.hid, p.WdT + (size_t)l * 16 * 1024 * 256, 256, 256, (size_t)1024 * 256}; MoeOrder S; S.init(cnt, p.list, 4, G, c);
        EpiDown E{p.ys, p.list, p.wl, cnt}; pg8::gemm_phase<EpiDown, MoeOrder, false>(glds, g, S, E, p.wid); }
    if constexpr (PH == 10) phase_norm1<2>(p, 1);
    if constexpr (PH == 11) phase_norm1<0>(p, l);
}
template <int PH>
__global__ void __launch_bounds__(NTHREADS, 2) k_ph(Params p, int l) {
    extern __shared__ __attribute__((aligned(16))) unsigned char smem[];
    p.wid = __builtin_amdgcn_readfirstlane(threadIdx.x >> 6); p.qslot = p.qslot_host;
    run_phase<PH>(p, l, smem);
}
}


namespace {
#ifndef REP_PH
#define REP_PH -1
#endif
#define REP(X, l) do { if (REP_PH == X) { xcd_barrier(bar); phase<X>(l, smem, wid, 1); } } while (0)
struct KArgs { const float* in[20]; float* xo; char* ws; };
constexpr size_t al256(size_t b) { return (b + 255) & ~(size_t)255; }
constexpr size_t WS_CTL = 0;
constexpr size_t WS_MOD = WS_CTL + al256((size_t)CW_WORDS * 4);
constexpr size_t WS_WIN = WS_MOD + al256((size_t)2 * NB * NMOD * 4);
constexpr size_t WS_WOUT = WS_WIN + al256((size_t)2 * NP * D * 2);
constexpr size_t WS_WQ = WS_WOUT + al256((size_t)2 * D * D * 2);
constexpr size_t WS_WKV = WS_WQ + al256((size_t)2 * 512 * 256 * 2);
constexpr size_t WS_WGU = WS_WKV + al256((size_t)2 * 512 * 128 * 2);
constexpr size_t WS_WD = WS_WGU + al256((size_t)2 * 16 * 512 * 1024 * 2);
constexpr size_t WS_ROPE = WS_WD + al256((size_t)2 * 16 * 1024 * 256 * 2);
constexpr size_t WS_RQ = WS_ROPE + al256((size_t)2048 * 16 * 2 * 4);
constexpr size_t WS_RKV = WS_RQ + al256((size_t)T * 4);
constexpr size_t WS_CBF = WS_RKV + al256((size_t)T * 4);
constexpr size_t WS_KIDX = WS_CBF + al256((size_t)NB * 4 * S * 4);
constexpr size_t WS_MASK = WS_KIDX + al256((size_t)T * 32 * 2);
constexpr size_t WS_LIST = WS_MASK + al256((size_t)T * 64 * 4);
constexpr size_t WS_RW = WS_LIST + al256((size_t)2 * 16 * ECAP * 4);
constexpr size_t WS_WL = WS_RW + al256((size_t)T * 2 * 4);
constexpr size_t WS_H = WS_WL + al256((size_t)2 * 16 * ECAP * 4);
constexpr size_t WS_PROJ = WS_H + al256((size_t)T * D * 2);
constexpr size_t WS_QM = WS_PROJ + al256((size_t)T * NP * 2);
constexpr size_t WS_KM = WS_QM + al256((size_t)T * 384 * 2);
constexpr size_t WS_VM = WS_KM + al256((size_t)T * 384 * 2);
constexpr size_t WS_MERGED = WS_VM + al256((size_t)T * 256 * 2);
constexpr size_t WS_XB = WS_MERGED + al256((size_t)T * D * 2);
constexpr size_t WS_END1 = WS_XB + al256((size_t)T * D * 2);
constexpr size_t WS_HID = WS_PROJ;
constexpr size_t WS_YS = WS_HID + al256((size_t)HIDROWS * 256 * 2);
constexpr size_t WS_END2 = WS_YS + al256((size_t)T * 2 * D * 2);
constexpr size_t WS_NEED = WS_END1 > WS_END2 ? WS_END1 : WS_END2;
static_assert(WS_END2 <= WS_MERGED, "MoE overlay must not reach the merged buffer");

__device__ __forceinline__ Params make_params(const KArgs& a) {
    Params p;
    p.x = a.in[0]; p.c = a.in[1]; p.w_ada = a.in[2]; p.b_ada = a.in[3]; p.g_norm1 = a.in[4]; p.w_in = a.in[5]; p.b_forget = a.in[6]; p.g_q_mla = a.in[7];
    p.w_q_up = a.in[8]; p.g_kv_mla = a.in[9]; p.w_kv_up = a.in[10]; p.sinks = a.in[11]; p.w_out = a.in[12]; p.g_norm2 = a.in[13]; p.w_router = a.in[14];
    p.b_router = a.in[15]; p.w_gate = a.in[16]; p.w_up = a.in[17]; p.w_down = a.in[18]; p.g_final = a.in[19];
    p.xo = a.xo; char* ws = a.ws;
    p.ctl = (unsigned*)(ws + WS_CTL); p.mod = (float*)(ws + WS_MOD); p.WinT = (bf16_t*)(ws + WS_WIN); p.WoutT = (bf16_t*)(ws + WS_WOUT);
    p.WqT = (bf16_t*)(ws + WS_WQ); p.WkvT = (bf16_t*)(ws + WS_WKV); p.WguT = (bf16_t*)(ws + WS_WGU); p.WdT = (bf16_t*)(ws + WS_WD);
    p.ropetab = (float*)(ws + WS_ROPE); p.rq = (float*)(ws + WS_RQ); p.rkv = (float*)(ws + WS_RKV); p.cbF = (float*)(ws + WS_CBF); p.kidx = (bf16_t*)(ws + WS_KIDX);
    p.mask = (uint32_t*)(ws + WS_MASK); p.list = (int*)(ws + WS_LIST); p.rw = (float*)(ws + WS_RW); p.wl = (float*)(ws + WS_WL); p.h = (bf16_t*)(ws + WS_H);
    p.proj = (bf16_t*)(ws + WS_PROJ); p.qm = (bf16_t*)(ws + WS_QM); p.km = (bf16_t*)(ws + WS_KM); p.vm = (bf16_t*)(ws + WS_VM);
    p.merged = (bf16_t*)(ws + WS_MERGED); p.xb = (bf16_t*)(ws + WS_XB); p.hid = (bf16_t*)(ws + WS_HID); p.ys = (bf16_t*)(ws + WS_YS);
    return p;
}
template <int PH>
__device__ __forceinline__ void phase(int l, unsigned char* smem, int wid, int qslot = 0) {
    typedef const __attribute__((address_space(4))) KArgs* KA4;
    KA4 ka = (KA4)__builtin_amdgcn_kernarg_segment_ptr();
    asm volatile("" : "+s"(ka));
    KArgs a;
#pragma unroll
    for (int i = 0; i < 20; ++i) a.in[i] = ka->in[i];
    a.xo = ka->xo; a.ws = ka->ws;
    Params p = make_params(a); p.wid = wid; p.qslot = qslot; p.qslot_host = 0;
    run_phase<PH>(p, l, smem);
}
__global__ void __launch_bounds__(NTHREADS, 2) fwd(KArgs args) {
    extern __shared__ __attribute__((aligned(16))) unsigned char smem[];
    volatile LAS unsigned* st = (volatile LAS unsigned*)(smem + LDS_BYTES - 16);
    const int wid = __builtin_amdgcn_readfirstlane(threadIdx.x >> 6);
    if (xb_leader(wid)) { st[0] = 0u; st[1] = 0u; st[2] = 0u; st[3] = 0u; }
    __syncthreads();
    XcdBarrier bar = xcd_barrier_post((unsigned*)(args.ws + WS_CTL) + CW_BAR, st, wid);
    phase<0>(0, smem, wid);  REP(0, 0);
    xcd_barrier(bar);
#define LAYER(l) do { \
        phase<1>(l, smem, wid);  if (l == 0) REP(1, l); xcd_barrier(bar); \
        phase<2>(l, smem, wid);  REP(2, l); xcd_barrier(bar); \
        phase<3>(l, smem, wid);  REP(3, l); xcd_barrier(bar); \
        phase<4>(l, smem, wid);  REP(4, l); phase<12>(l, smem, wid);  REP(12, l); phase<13>(l, smem, wid);  REP(13, l); xcd_barrier(bar); \
        phase<5>(l, smem, wid);  REP(5, l); xcd_barrier(bar); \
        phase<6>(l, smem, wid);  xcd_barrier(bar); \
        phase<7>(l, smem, wid);  REP(7, l); xcd_barrier(bar); \
        phase<8>(l, smem, wid);  REP(8, l); xcd_barrier(bar); \
        phase<9>(l, smem, wid);  REP(9, l); xcd_barrier(bar); } while (0)
    LAYER(0);
    LAYER(1);
#ifdef REP_BAR
    for (int rb = 0; rb < REP_BAR; ++rb) xcd_barrier(bar);
#endif
    phase<10>(1, smem, wid);
}
}

extern "C" void kernel_launch(void* const* d_in, const int* in_sizes, int n_in, void* d_out, int out_size, void* d_ws, size_t ws_size,
                              hipStream_t stream) {
    KArgs a{};
    for (int i = 0; i < 20; ++i) a.in[i] = (const float*)d_in[i];
    a.xo = (float*)d_out; a.ws = (char*)d_ws;
    if (WS_NEED > ws_size) return;

    static int grid = 0;
    if (!grid) {
        int dev = 0, cus = 0, per_cu = 0;
        (void)hipGetDevice(&dev);
        (void)hipDeviceGetAttribute(&cus, hipDeviceAttributeMultiprocessorCount, dev);
        (void)hipFuncSetAttribute((const void*)fwd, hipFuncAttributeMaxDynamicSharedMemorySize, LDS_BYTES);
        (void)hipOccupancyMaxActiveBlocksPerMultiprocessor(&per_cu, (const void*)fwd, NTHREADS, LDS_BYTES);
        grid = cus > 0 ? cus : 256;
    }
    (void)hipMemsetAsync(a.ws + WS_CTL, 0, (size_t)CW_WORDS * 4, stream);
    fwd<<<dim3(grid), dim3(NTHREADS), LDS_BYTES, stream>>>(a);
}
```

```cpp
#include <hip/hip_runtime.h>
#include <stdint.h>
#define XB_TMO      128
#define XB_XCNT(j)  (256  + 64 * (j))
#define XB_XSUB(j)  (1280 + 64 * (j))
#define XB_XGEN(j)  (2304 + 64 * (j))
#define XB_TOP      3328
#define XB_TOPGEN   3392
#define XCD_BAR_WORDS 3456
#define XB_SPIN_CAP (1u << 20)
#define LAS __attribute__((address_space(3)))

__device__ __forceinline__ unsigned xb_ld(unsigned* p)              { return __hip_atomic_load(p, __ATOMIC_RELAXED, __HIP_MEMORY_SCOPE_AGENT); }
__device__ __forceinline__ unsigned xb_add(unsigned* p, unsigned v) { return __hip_atomic_fetch_add(p, v, __ATOMIC_RELAXED, __HIP_MEMORY_SCOPE_AGENT); }
__device__ __forceinline__ unsigned xb_xcc_id() { return (unsigned)__builtin_amdgcn_s_getreg((3 << 11) | 20) & 0xFu; }
#define XB_SPIN(cond, bar) do { unsigned _sp = 0; while (cond) { __builtin_amdgcn_s_sleep(1); \
    if ((++_sp & 255u) == 0u) { if (xb_ld(&(bar)[XB_TMO])) break; if (_sp > XB_SPIN_CAP) { atomicAdd(&(bar)[XB_TMO], 1u); break; } } } } while (0)

struct XcdBarrier { unsigned* bar; unsigned x; volatile LAS unsigned* st; int wid; };
__device__ __forceinline__ bool xb_leader(int wid) { return wid == 0 && __builtin_amdgcn_mbcnt_hi(~0u, __builtin_amdgcn_mbcnt_lo(~0u, 0u)) == 0u; }

__device__ __forceinline__ XcdBarrier xcd_barrier_post(unsigned* bar, volatile LAS unsigned* st, int wid) {
    XcdBarrier b; b.bar = bar; b.x = xb_xcc_id(); b.st = st; b.wid = wid;
    if (xb_leader(wid)) (void)xb_add(&bar[XB_XCNT(b.x)], 1u);
    return b;
}
__device__ __forceinline__ void xcd_barrier_complete(unsigned* bar, unsigned x, unsigned& nloc, unsigned& nx) {
    const unsigned G = gridDim.x * gridDim.y * gridDim.z;
    unsigned sum, cnt, mine, sp = 0u;
    for (;;) {
        sum = 0u; cnt = 0u; mine = 0u;
#pragma unroll
        for (unsigned j = 0; j < 16; ++j) { const unsigned c = xb_ld(&bar[XB_XCNT(j)]); sum += c; cnt += (c > 0u) ? 1u : 0u; mine = (j == x) ? c : mine; }
        if (sum == G) break;
        __builtin_amdgcn_s_sleep(1);
        if ((++sp & 255u) == 0u) { if (xb_ld(&bar[XB_TMO])) break; if (sp > XB_SPIN_CAP) { atomicAdd(&bar[XB_TMO], 1u); break; } }
    }
    nloc = mine > 0u ? mine : 1u; nx = cnt > 0u ? cnt : 1u;
}
__device__ __forceinline__ void xcd_barrier(const XcdBarrier& b) {
    asm volatile("s_waitcnt vmcnt(0)" ::: "memory");
    __syncthreads();
    if (xb_leader(b.wid)) {
        unsigned* bar = b.bar;
        __builtin_amdgcn_s_waitcnt(0);
        unsigned nloc = b.st[0], nx = b.st[1];
        if (nloc == 0u) { xcd_barrier_complete(bar, b.x, nloc, nx); b.st[0] = nloc; b.st[1] = nx; }
        const unsigned old = xb_add(&bar[XB_XSUB(b.x)], 1u);
        const unsigned gen = old / nloc;
        if (old + 1u == (gen + 1u) * nloc) {
            __builtin_amdgcn_fence(__ATOMIC_RELEASE, "agent");
            asm volatile("s_waitcnt vmcnt(0)" ::: "memory");
            const unsigned og = xb_add(&bar[XB_TOP], 1u);
            const unsigned tg = og / nx;
            if (og + 1u == (tg + 1u) * nx) xb_add(&bar[XB_TOPGEN], 1u);
            else XB_SPIN(xb_ld(&bar[XB_TOPGEN]) == tg, bar);
            __builtin_amdgcn_fence(__ATOMIC_ACQUIRE, "agent");
            xb_add(&bar[XB_XGEN(b.x)], 1u);
            asm volatile("s_waitcnt vmcnt(0)" ::: "memory");
        } else {
            XB_SPIN(xb_ld(&bar[XB_XGEN(b.x)]) == gen, bar);
            __builtin_amdgcn_fence(__ATOMIC_ACQUIRE, "agent");
            asm volatile("s_waitcnt vmcnt(0)" ::: "memory");
        }
    }
    __syncthreads();
}

#define LAS3 __attribute__((address_space(3)))
namespace {
typedef unsigned short bf16_t;
typedef short bf16x8 __attribute__((ext_vector_type(8)));
typedef short bf16x4 __attribute__((ext_vector_type(4)));
typedef float f32x4 __attribute__((ext_vector_type(4)));
typedef float f32x2 __attribute__((ext_vector_type(2)));
typedef unsigned u32x4 __attribute__((ext_vector_type(4)));
typedef unsigned u32x2 __attribute__((ext_vector_type(2)));

constexpr int D = 1024, NB = 32, S = 2048, T = NB * S, NIN = 2380, NP = 2560, NMOD = 6144;
constexpr int OFF_AQ = 0, OFF_AK = 256, OFF_AV = 512, OFF_AF = 768, OFF_BCQ = 772, OFF_BCKV = 1028, OFF_BKR = 1156,
              OFF_CQ = 1188, OFF_CK = 1444, OFF_CV = 1572, OFF_DQ = 1700, OFF_DK = 1956, OFF_DV = 2020,
              OFF_DQI = 2084, OFF_DKI = 2340, OFF_DWI = 2372;
constexpr int PC_AQ = 0, PC_AK = 256, PC_AV = 512, PC_BCQ = 768, PC_BCKV = 1024, PC_BKR = 1152, PC_CQ = 1184, PC_CK = 1440, PC_CV = 1568,
              PC_DQ = 1696, PC_DK = 1952, PC_DV = 2016, PC_DQI = 2080, PC_DKI = 2336, PC_DWI = 2368, PC_AF = 2376;
constexpr float EPS = 1e-6f;
constexpr float LOG2E = 1.4426950408889634f;
constexpr int ECAP = T;
constexpr int HIDROWS = 2 * T + 16 * 256;

__host__ __device__ __forceinline__ int orig_col(int n) { return n < 768 ? n : (n < 2376 ? n + 4 : (n < 2380 ? n - 1608 : -1)); }
__device__ __forceinline__ int opaque_tid(int wid) {
    int t = wid * 64 + (int)__builtin_amdgcn_mbcnt_hi(~0u, __builtin_amdgcn_mbcnt_lo(~0u, 0u));
    asm volatile("" : "+v"(t)); return t; }
__device__ __forceinline__ float bf2f(bf16_t v) { return __uint_as_float((unsigned)v << 16); }
__device__ __forceinline__ bf16_t f2bf(float f) { unsigned u = __float_as_uint(f); u += 0x7FFFu + ((u >> 16) & 1u); return (bf16_t)(u >> 16); }
typedef __bf16 bf16x2_native __attribute__((ext_vector_type(2)));
__device__ __forceinline__ unsigned cvt_pk_bf16(float lo, float hi) { const f32x2 v = {lo, hi}; return __builtin_bit_cast(unsigned, __builtin_convertvector(v, bf16x2_native)); }
__device__ __forceinline__ float bflo(unsigned w) { return __uint_as_float(w << 16); }
__device__ __forceinline__ float bfhi(unsigned w) { return __uint_as_float(w & 0xFFFF0000u); }
__device__ __forceinline__ float wave_sum(float v) {
#pragma unroll
    for (int o = 32; o > 0; o >>= 1) v += __shfl_xor(v, o);
    return v;
}
__device__ __forceinline__ float xor32_max(float x) {
    float a = x, b = x;
    asm volatile("s_nop 1\n\tv_permlane32_swap_b32 %0, %1\n\ts_nop 1" : "+v"(a), "+v"(b));
    return fmaxf(a, b);
}
__device__ __forceinline__ int wave_reduce_add(int v) {
    v += __builtin_amdgcn_update_dpp(0, v, 0xB1, 0xF, 0xF, true);
    v += __builtin_amdgcn_update_dpp(0, v, 0x4E, 0xF, 0xF, true);
    v += __builtin_amdgcn_update_dpp(0, v, 0x141, 0xF, 0xF, true);
    v += __builtin_amdgcn_update_dpp(0, v, 0x140, 0xF, 0xF, true);
    return __builtin_amdgcn_readlane(v, 0) + __builtin_amdgcn_readlane(v, 16) + __builtin_amdgcn_readlane(v, 32) + __builtin_amdgcn_readlane(v, 48);
}
}

namespace pg8 {
#define PG8_LAS __attribute__((address_space(3)))
constexpr int BM = 256, BK = 64, HALF = 128, HTB = HALF * BK * 2, STAGE_BYTES = 8 * HTB, NXCD = 8, WGM = 8;

__host__ __device__ __forceinline__ int lds_byte(int r, int c) { const int st = (r >> 4) * 2 + (c >> 5), rr = r & 15, cc = c & 31, ob = rr * 64 + cc * 2; return st * 1024 + (ob ^ (((ob >> 9) & 1) << 5)); }
__host__ __device__ __forceinline__ void stage_rc(int b, int& R, int& C) { const int st = b / 1024, sb = b % 1024, swz = sb ^ (((sb >> 9) & 1) << 5); R = (st >> 1) * 16 + swz / 64; C = (st & 1) * 32 + (swz % 64) / 2; }
__host__ __device__ __forceinline__ int perm32(int rho) { const int n = rho >> 4, i = rho & 15; return 8 * (i >> 2) + 4 * n + (i & 3); }

struct Unit { int pm, pn, e, mt; };
struct Gemm { const bf16_t* A; const bf16_t* Bt; int K; int lda; size_t bstride; };

struct StaticOrder {
    int nM, nN, nwg, G, c;
    __host__ __device__ void init(int M, int N, int G_, int c_) { nM = M / BM; nN = N / BM; nwg = nM * nN; G = G_; c = c_; }
    __host__ __device__ bool next(int i, Unit& u) const {
        const long L = (long)i * G + c; if (L >= nwg) return false;
        int wgid = (int)L; { const int q = nwg / NXCD, r = nwg % NXCD, xcd = wgid % NXCD, off = wgid / NXCD; wgid = (xcd < r ? xcd * (q + 1) : r * (q + 1) + (xcd - r) * q) + off; }
        const int nig = WGM * nN, gid = wgid / nig, fm = gid * WGM, gsz = (nM - fm) < WGM ? (nM - fm) : WGM;
        u.pm = fm + ((wgid % nig) % gsz); u.pn = (wgid % nig) / gsz; u.e = 0; u.mt = 0; return true;
    }
    __device__ __forceinline__ int arow(const Unit& u, int r) const { return u.pm * BM + r; }
};

template <class Epi, class Sched, bool GATHER>
__device__ __forceinline__ void gemm_phase(PG8_LAS unsigned char* lds, const Gemm g, const Sched& S, const Epi& E, int wave_index) {
    const int tid = opaque_tid(wave_index), wid = __builtin_amdgcn_readfirstlane(tid >> 6), lane = tid & 63, wr = wid >> 2, wc = wid & 3, fr = lane & 15, fq = lane >> 4;
    int K_ = g.K; asm volatile("" : "+s"(K_));
    const int K = K_, nt = K / BK, lda = g.lda;
    int Ra[2], Ca[2]; unsigned voffB[2], voffA[2];
#pragma unroll
    for (int i = 0; i < 2; ++i) { int R, C; stage_rc(tid * 16 + i * 8192, R, C); const int Rb = Epi::PERM ? ((R & ~31) + perm32(R & 31)) : R;
        Ra[i] = R; Ca[i] = C; voffB[i] = (unsigned)(Rb * K + C) * 2u; voffA[i] = (unsigned)(R * lda + C) * 2u; }
    const size_t kstep = (size_t)(BK * 2);
    const size_t hstepB = (size_t)HALF * K * 2;
    const size_t tstepB = 2 * hstepB;
    const size_t hstepA = (size_t)HALF * lda * 2, tstepA = 2 * hstepA;
    const unsigned ldsw = (unsigned)wid * 1024u;
    const int aoff = lds_byte(wr * 64 + fr, fq * 8), boff = lds_byte(wc * 32 + fr, fq * 8);
#define PG8_SA(b, h) (((b) * 2 + (h)) * HTB)
#define PG8_SB(b, h) ((4 + (b) * 2 + (h)) * HTB)
#define PG8_STAGE(bufoff, gbase, voff) do { _Pragma("unroll") for (int _i = 0; _i < 2; ++_i) \
        __builtin_amdgcn_global_load_lds((const unsigned*)((const char*)(gbase) + (voff)[_i]), (PG8_LAS unsigned*)(lds + (bufoff) + ldsw + _i * 8192), 16, 0, 0); } while (0)
#define PG8_STAGEA(bufoff, kptr, VO, h) do { _Pragma("unroll") for (int _i = 0; _i < 2; ++_i) { \
        const char* _src; if constexpr (GATHER) _src = (const char*)(kptr) + (VO)[_i][h]; else _src = (const char*)(kptr) + (size_t)(h) * hstepA + voffA[_i]; \
        __builtin_amdgcn_global_load_lds((const unsigned*)_src, (PG8_LAS unsigned*)(lds + (bufoff) + ldsw + _i * 8192), 16, 0, 0); } } while (0)
#define PG8_LDA(dst, b, h) do { _Pragma("unroll") for (int m = 0; m < 4; ++m) _Pragma("unroll") for (int k = 0; k < 2; ++k) dst[m][k] = *(const PG8_LAS bf16x8*)(lds + PG8_SA(b, h) + aoff + m * 2048 + k * 1024); } while (0)
#define PG8_LDB(dst, b, h) do { _Pragma("unroll") for (int n = 0; n < 2; ++n) _Pragma("unroll") for (int k = 0; k < 2; ++k) dst[n][k] = *(const PG8_LAS bf16x8*)(lds + PG8_SB(b, h) + boff + n * 2048 + k * 1024); } while (0)
#define PG8_MMA(ai, bj, At, Bt) do { __builtin_amdgcn_s_setprio(1); _Pragma("unroll") for (int m = 0; m < 4; ++m) _Pragma("unroll") for (int n = 0; n < 2; ++n) _Pragma("unroll") for (int k = 0; k < 2; ++k) \
        acc[ai][bj][m][n] = __builtin_amdgcn_mfma_f32_16x16x32_bf16(Bt[n][k], At[m][k], acc[ai][bj][m][n], 0, 0, 0); __builtin_amdgcn_s_setprio(0); } while (0)
#define PG8_WAIT_V(n) asm volatile("s_waitcnt vmcnt(" #n ")" ::: "memory")
#define PG8_WAIT_L(n) asm volatile("s_waitcnt lgkmcnt(" #n ")" ::: "memory")
#define PG8_BAR __builtin_amdgcn_s_barrier()
#define PG8_SCHED __builtin_amdgcn_sched_barrier(0)
#define PG8_SETV(V, u) do { _Pragma("unroll") for (int _i = 0; _i < 2; ++_i) _Pragma("unroll") for (int _h = 0; _h < 2; ++_h) { \
        const int _row = GATHER ? S.arow(u, _h * HALF + Ra[_i]) : ((u).pm * BM + _h * HALF + Ra[_i]); V[_i][_h] = (unsigned)(((size_t)_row * lda + Ca[_i]) * 2); } } while (0)
    Unit cur, nxt; int ui = 0;
    if (!S.next(0, cur)) return;
    f32x4 acc[2][2][4][2];
#pragma unroll
    for (int a = 0; a < 2; ++a)
#pragma unroll
        for (int b = 0; b < 2; ++b)
#pragma unroll
            for (int m = 0; m < 4; ++m)
#pragma unroll
                for (int n = 0; n < 2; ++n) acc[a][b][m][n] = (f32x4){0.f, 0.f, 0.f, 0.f};
    bf16x8 At[4][2], B0[2][2], B1[2][2];
    unsigned vA[2][2], vN[2][2];
    if constexpr (GATHER) { PG8_SETV(vA, cur); }
    const char* cA = (const char*)g.A + (GATHER ? (size_t)0 : (size_t)cur.pm * tstepA);
    const char* cB = (const char*)g.Bt + ((size_t)cur.e * g.bstride) * 2 + (size_t)cur.pn * tstepB;
    PG8_STAGE(PG8_SB(0, 0), cB, voffB); PG8_STAGE(PG8_SB(0, 1), cB + hstepB, voffB); PG8_STAGEA(PG8_SA(0, 0), cA, vA, 0); PG8_STAGEA(PG8_SA(0, 1), cA, vA, 1);
    if (wr == 1) PG8_BAR;
    PG8_WAIT_V(2); PG8_BAR;
    PG8_STAGE(PG8_SB(1, 0), cB + kstep, voffB); PG8_STAGEA(PG8_SA(1, 0), cA + kstep, vA, 0); PG8_STAGE(PG8_SB(1, 1), cB + hstepB + kstep, voffB);
    PG8_WAIT_V(6); PG8_BAR;
    for (;;) {
        const bool has_next = S.next(ui + 1, nxt);
        if constexpr (GATHER) { if (has_next) { PG8_SETV(vN, nxt); }
        else {
#pragma unroll
            for (int _i = 0; _i < 2; ++_i)
#pragma unroll
                for (int _h = 0; _h < 2; ++_h) vN[_i][_h] = vA[_i][_h];
        } }
        const char* nA = (!GATHER && has_next) ? (const char*)g.A + (size_t)nxt.pm * tstepA : cA;
        const char* nB = has_next ? (const char*)g.Bt + ((size_t)nxt.e * g.bstride) * 2 + (size_t)nxt.pn * tstepB : cB;
#pragma unroll 1
        for (int t = 0; t < nt; t += 2) {
            const bool last = (t == nt - 2);
            const char* a1 = cA + (size_t)(t + 1) * kstep;
            const char* a2 = last ? nA : cA + (size_t)(t + 2) * kstep; const char* b2 = last ? nB : cB + (size_t)(t + 2) * kstep;
            const char* a3 = a2 + kstep; const char* b3 = b2 + kstep;
            unsigned v2[2][2];
            if constexpr (GATHER) {
#pragma unroll
            for (int _i = 0; _i < 2; ++_i)
#pragma unroll
                for (int _h = 0; _h < 2; ++_h) v2[_i][_h] = last ? vN[_i][_h] : vA[_i][_h];
            }
            PG8_LDB(B0, 0, 0); PG8_LDB(B1, 0, 1); PG8_SCHED; PG8_LDA(At, 0, 0); PG8_STAGEA(PG8_SA(1, 1), a1, vA, 1);
            PG8_WAIT_V(8); PG8_WAIT_L(0); PG8_BAR; PG8_MMA(0, 0, At, B0); PG8_MMA(0, 1, At, B1); PG8_BAR; PG8_SCHED;
            PG8_LDA(At, 0, 1); PG8_STAGE(PG8_SB(0, 0), b2, voffB); PG8_STAGE(PG8_SB(0, 1), b2 + hstepB, voffB); PG8_STAGEA(PG8_SA(0, 0), a2, v2, 0);
            PG8_WAIT_V(8); PG8_WAIT_L(0); PG8_BAR; PG8_MMA(1, 0, At, B0); PG8_MMA(1, 1, At, B1); PG8_BAR; PG8_SCHED;
            PG8_LDB(B0, 1, 0); PG8_LDB(B1, 1, 1); PG8_SCHED; PG8_LDA(At, 1, 0); PG8_STAGEA(PG8_SA(0, 1), a2, v2, 1);
            PG8_WAIT_V(8); PG8_WAIT_L(0); PG8_BAR; PG8_MMA(0, 0, At, B0); PG8_MMA(0, 1, At, B1); PG8_BAR; PG8_SCHED;
            PG8_LDA(At, 1, 1); PG8_STAGE(PG8_SB(1, 0), b3, voffB); PG8_STAGE(PG8_SB(1, 1), b3 + hstepB, voffB); PG8_STAGEA(PG8_SA(1, 0), a3, v2, 0);
            PG8_WAIT_V(8); PG8_WAIT_L(0); PG8_BAR; PG8_MMA(1, 0, At, B0); PG8_MMA(1, 1, At, B1); PG8_BAR; PG8_SCHED;
        }
        if (wr == 0) PG8_BAR;
        E(acc, cur, wr, wc, fr, fq);
        if (!has_next) break;
#pragma unroll
        for (int a = 0; a < 2; ++a)
#pragma unroll
            for (int b = 0; b < 2; ++b)
#pragma unroll
                for (int m = 0; m < 4; ++m)
#pragma unroll
                    for (int n = 0; n < 2; ++n) acc[a][b][m][n] = (f32x4){0.f, 0.f, 0.f, 0.f};
        cur = nxt; cB = nB; cA = nA; ++ui;
        if constexpr (GATHER) {
#pragma unroll
        for (int _i = 0; _i < 2; ++_i)
#pragma unroll
            for (int _h = 0; _h < 2; ++_h) vA[_i][_h] = vN[_i][_h];
        }
        if (wr == 1) PG8_BAR;
    }
    PG8_WAIT_V(0);
    PG8_BAR;
#undef PG8_SA
#undef PG8_SB
#undef PG8_STAGE
#undef PG8_STAGEA
#undef PG8_LDA
#undef PG8_LDB
#undef PG8_MMA
#undef PG8_WAIT_V
#undef PG8_WAIT_L
#undef PG8_BAR
#undef PG8_SCHED
#undef PG8_SETV
}
}

namespace {
struct Params {
    const float *x, *c, *w_ada, *b_ada, *g_norm1, *w_in, *b_forget, *g_q_mla, *w_q_up, *g_kv_mla, *w_kv_up, *sinks, *w_out, *g_norm2,
                *w_router, *b_router, *w_gate, *w_up, *w_down, *g_final;
    float* xo;
    bf16_t* xb;
    unsigned* ctl;
    float* mod;
    bf16_t* WinT;
    bf16_t* WoutT;
    bf16_t* WqT;
    bf16_t* WkvT;
    bf16_t* WguT;
    bf16_t* WdT;
    float* ropetab;
    float* rq; float* rkv;
    float* cbF;
    bf16_t* kidx;
    uint32_t* mask;
    bf16_t* h;
    bf16_t* proj;
    bf16_t* qm; bf16_t* km; bf16_t* vm;
    bf16_t* merged;
    bf16_t* hid;
    bf16_t* ys;
    int* list;
    float* rw;
    float* wl;
    int wid;
    int qslot;
    int qslot_host;
};
constexpr int CW_BAR = 0;
constexpr int CW_CNT = 3584;
constexpr int CW_QA = 3648;
constexpr int CW_QD = 4288;
constexpr int CW_KN2 = 4992;
constexpr int CW_QN2 = CW_KN2 + 2 * NB * 4 * 32;
constexpr int CW_WORDS = CW_QN2 + 2 * NB * 4 * 8;
}

namespace {
constexpr long P0_B1 = 2l * NP * 128, P0_B2 = P0_B1 + 2l * 1024 * 128, P0_B3 = P0_B2 + 2l * 512 * 32, P0_B4 = P0_B3 + 2l * 512 * 16,
               P0_B5 = P0_B4 + 32l * 512 * 128, P0_B6 = P0_B5 + 32l * 1024 * 32;
__device__ __forceinline__ bf16_t* p0_fetch(const Params& p, long it, float (&v)[8]) {
    if (it < P0_B1) {
        const int l = (int)(it / (NP * 128)), r = (int)(it % (NP * 128)), n = r % NP, k0 = (r / NP) * 8, o = orig_col(n);
        const float* w = p.w_in + (size_t)l * D * NIN;
#pragma unroll
        for (int j = 0; j < 8; ++j) v[j] = o >= 0 ? w[(size_t)(k0 + j) * NIN + o] : 0.f;
        return p.WinT + ((size_t)l * NP + n) * D + k0;
    } else if (it < P0_B2) {
        const long s = it - P0_B1; const int l = (int)(s / (1024 * 128)), r = (int)(s % (1024 * 128)), n = r & 1023, k0 = (r >> 10) * 8;
        const float* w = p.w_out + (size_t)l * D * D;
#pragma unroll
        for (int j = 0; j < 8; ++j) v[j] = w[(size_t)(k0 + j) * D + n];
        return p.WoutT + ((size_t)l * D + n) * D + k0;
    } else if (it < P0_B3) {
        const long s = it - P0_B2; const int l = (int)(s / (512 * 32)), r = (int)(s % (512 * 32)), n = r & 511, k0 = (r >> 9) * 8;
        const float* w = p.w_q_up + (size_t)l * 256 * 384; const float* g = p.g_q_mla + l * 256;
#pragma unroll
        for (int j = 0; j < 8; ++j) v[j] = n < 384 ? g[k0 + j] * w[(size_t)(k0 + j) * 384 + n] : 0.f;
        return p.WqT + ((size_t)l * 512 + n) * 256 + k0;
    } else if (it < P0_B4) {
        const long s = it - P0_B3; const int l = (int)(s / (512 * 16)), r = (int)(s % (512 * 16)), n = r & 511, k0 = (r >> 9) * 8;
        const float* w = p.w_kv_up + (size_t)l * 128 * 512; const float* g = p.g_kv_mla + l * 128;
#pragma unroll
        for (int j = 0; j < 8; ++j) v[j] = g[k0 + j] * w[(size_t)(k0 + j) * 512 + n];
        return p.WkvT + ((size_t)l * 512 + n) * 128 + k0;
    } else if (it < P0_B5) {
        const long s = it - P0_B4; const int le = (int)(s >> 16), r = (int)(s & 65535), n = r & 511, k0 = (r >> 9) * 8;
        const int q = n >> 5, rr = n & 31, col = 16 * q + (rr & 15);
        const float* w = (rr < 16 ? p.w_gate : p.w_up) + (size_t)le * 1024 * 256;
#pragma unroll
        for (int j = 0; j < 8; ++j) v[j] = w[(size_t)(k0 + j) * 256 + col];
        return p.WguT + ((size_t)le * 512 + n) * 1024 + k0;
    } else {
        const long s = it - P0_B5; const int le = (int)(s >> 15), r = (int)(s & 32767), n = r & 1023, k0 = (r >> 10) * 8;
        const float* w = p.w_down + (size_t)le * 256 * 1024;
#pragma unroll
        for (int j = 0; j < 8; ++j) v[j] = w[(size_t)(k0 + j) * 1024 + n];
        return p.WdT + ((size_t)le * 1024 + n) * 256 + k0;
    }
}
__device__ __forceinline__ void p0_store(bf16_t* dst, const float (&v)[8]) {
    u32x4 w; w.x = cvt_pk_bf16(v[0], v[1]); w.y = cvt_pk_bf16(v[2], v[3]); w.z = cvt_pk_bf16(v[4], v[5]); w.w = cvt_pk_bf16(v[6], v[7]);
    *(u32x4*)dst = w;
}

__device__ __forceinline__ void phase_p0(const Params& p, char* lds) {
    const int tid = opaque_tid(p.wid), gtid = blockIdx.x * blockDim.x + tid, gthreads = gridDim.x * blockDim.x;
    for (long it0 = gtid; it0 < P0_B6; it0 += 4l * gthreads) {
        float va[8], vb[8], vc[8], vd[8];
        const bool hb = it0 + gthreads < P0_B6, hc = it0 + 2l * gthreads < P0_B6, hd = it0 + 3l * gthreads < P0_B6;
        bf16_t* da = p0_fetch(p, it0, va);
        bf16_t* db = hb ? p0_fetch(p, it0 + gthreads, vb) : da;
        bf16_t* dc = hc ? p0_fetch(p, it0 + 2l * gthreads, vc) : da;
        bf16_t* dd = hd ? p0_fetch(p, it0 + 3l * gthreads, vd) : da;
        p0_store(da, va);
        if (hb) p0_store(db, vb);
        if (hc) p0_store(dc, vc);
        if (hd) p0_store(dd, vd);
    }
    for (int it = gtid; it < 2048 * 16; it += gthreads) {
        const int pos = it >> 4, i = it & 15;
        const float inv = powf(10000.0f, -(float)i / 16.0f), ang = (float)pos * inv;
        p.ropetab[it * 2] = cosf(ang); p.ropetab[it * 2 + 1] = sinf(ang);
    }
    const int w = __builtin_amdgcn_readfirstlane(tid >> 6), lane = tid & 63;
    for (int u = blockIdx.x; u < 2 * (NMOD / 64); u += gridDim.x) {
        float* ca = (float*)lds;
        for (int i = tid; i < NB * 1024; i += 512) { const int bb = i >> 10, d = i & 1023; const float v = p.c[i]; ca[d * 32 + ((bb + 4 * (d & 7)) & 31)] = v / (1.f + __expf(-v)); }
        __syncthreads();
        const int l = u / (NMOD / 64), n0 = (u % (NMOD / 64)) * 64;
        const float* wp = p.w_ada + (size_t)l * 1024 * NMOD + n0 + lane;
        float acc[32];
#pragma unroll
        for (int j = 0; j < 32; ++j) acc[j] = 0.f;
        for (int d0 = 128 * w; d0 < 128 * w + 128; d0 += 16) {
            float wv[16];
#pragma unroll
            for (int q = 0; q < 16; ++q) wv[q] = wp[(size_t)(d0 + q) * NMOD];
#pragma unroll
            for (int q = 0; q < 16; ++q) {
                const int d = d0 + q;
#pragma unroll
                for (int i = 0; i < 8; ++i) {
                    const f32x4 cv = *(const f32x4*)(ca + d * 32 + (((i + (d & 7)) & 7) << 2));
                    acc[4 * i + 0] += cv[0] * wv[q]; acc[4 * i + 1] += cv[1] * wv[q]; acc[4 * i + 2] += cv[2] * wv[q]; acc[4 * i + 3] += cv[3] * wv[q];
                }
            }
        }
        __syncthreads();
        float* part = (float*)lds;
#pragma unroll
        for (int j = 0; j < 32; ++j) part[(w * 32 + j) * 64 + lane] = acc[j];
        __syncthreads();
        for (int o = tid; o < NB * 64; o += 512) {
            const int bb = o >> 6, col = o & 63;
            float sm = 0.f;
#pragma unroll
            for (int ww = 0; ww < 8; ++ww) sm += part[(ww * 32 + bb) * 64 + col];
            p.mod[((size_t)l * NB + bb) * NMOD + n0 + col] = sm + p.b_ada[l * NMOD + n0 + col];
        }
        __syncthreads();
    }
    __syncthreads();
}

template <int MODE>
__device__ __forceinline__ void phase_norm1(const Params& p, int l) {
#ifndef NORM_NT
#define NORM_NT 2
#endif
    constexpr int NT = NORM_NT;
    const int tid = opaque_tid(p.wid), w = tid >> 6, lane = tid & 63;
    const float* g = (MODE == 2) ? p.g_final : p.g_norm1 + l * D;
    const float* modl = p.mod + (size_t)(MODE == 2 ? 1 : l) * NB * NMOD;
    const float* modp = p.mod + (size_t)(MODE == 2 ? 1 : (l > 0 ? l - 1 : 0)) * NB * NMOD;
    f32x4 gg4[4];
#pragma unroll
    for (int k = 0; k < 4; ++k) gg4[k] = *(const f32x4*)(g + 4 * lane + 256 * k);
    for (int t0 = (blockIdx.x * 8 + w) * NT; t0 < T; t0 += gridDim.x * 8 * NT) {
        const int b0 = t0 >> 11;
        f32x4 sc4[4], sh4[4], gt4[4];
        if (MODE != 2) {
#pragma unroll
            for (int k = 0; k < 4; ++k) { sc4[k] = *(const f32x4*)(modl + (size_t)b0 * NMOD + 1024 + 4 * lane + 256 * k); sh4[k] = *(const f32x4*)(modl + (size_t)b0 * NMOD + 4 * lane + 256 * k); }
        }
        if (MODE >= 1) {
#pragma unroll
            for (int k = 0; k < 4; ++k) gt4[k] = *(const f32x4*)(modp + (size_t)b0 * NMOD + 5 * 1024 + 4 * lane + 256 * k);
        }
        f32x4 v[NT][4];
#pragma unroll
        for (int u = 0; u < NT; ++u)
#pragma unroll
            for (int k = 0; k < 4; ++k) {
                if (MODE == 0) v[u][k] = *(const f32x4*)(p.x + (size_t)(t0 + u) * D + 4 * lane + 256 * k);
                else { const u32x2 w2 = *(const u32x2*)(p.xb + (size_t)(t0 + u) * D + 4 * lane + 256 * k); v[u][k] = (f32x4){bflo(w2.x), bfhi(w2.x), bflo(w2.y), bfhi(w2.y)}; }
            }
        if (MODE >= 1) {
            u32x2 y0[NT][4], y1[NT][4];
#pragma unroll
            for (int u = 0; u < NT; ++u)
#pragma unroll
                for (int k = 0; k < 4; ++k) { const int col = 4 * lane + 256 * k;
                    y0[u][k] = *(const u32x2*)(p.ys + ((size_t)(t0 + u) * 2 + 0) * D + col); y1[u][k] = *(const u32x2*)(p.ys + ((size_t)(t0 + u) * 2 + 1) * D + col); }
#pragma unroll
            for (int u = 0; u < NT; ++u) {
                const int b = (t0 + u) >> 11;
#pragma unroll
                for (int k = 0; k < 4; ++k) {
                    const int col = 4 * lane + 256 * k;
                    const f32x4 gt = gt4[k];
                    v[u][k][0] += gt[0] * (bflo(y0[u][k].x) + bflo(y1[u][k].x)); v[u][k][1] += gt[1] * (bfhi(y0[u][k].x) + bfhi(y1[u][k].x));
                    v[u][k][2] += gt[2] * (bflo(y0[u][k].y) + bflo(y1[u][k].y)); v[u][k][3] += gt[3] * (bfhi(y0[u][k].y) + bfhi(y1[u][k].y));
                }
            }
        }
#pragma unroll
        for (int u = 0; u < NT; ++u) {
            const int t = t0 + u, b = t >> 11;
            float ss = 0.f;
#pragma unroll
            for (int k = 0; k < 4; ++k) ss += v[u][k][0] * v[u][k][0] + v[u][k][1] * v[u][k][1] + v[u][k][2] * v[u][k][2] + v[u][k][3] * v[u][k][3];
            ss = wave_sum(ss);
            const float r = rsqrtf(ss * (1.0f / D) + EPS);
#pragma unroll
            for (int k = 0; k < 4; ++k) {
                const int col = 4 * lane + 256 * k;
                f32x4 y = v[u][k] * r * gg4[k];
                if (MODE == 2) { *(f32x4*)(p.xo + (size_t)t * D + col) = y; }
                else {
                    if (MODE == 1) { u32x2 xw; xw.x = cvt_pk_bf16(v[u][k][0], v[u][k][1]); xw.y = cvt_pk_bf16(v[u][k][2], v[u][k][3]); *(u32x2*)(p.xb + (size_t)t * D + col) = xw; }
                    y = y * (1.f + sc4[k]) + sh4[k];
                    u32x2 o; o.x = cvt_pk_bf16(y[0], y[1]); o.y = cvt_pk_bf16(y[2], y[3]);
                    *(u32x2*)(p.h + (size_t)t * D + col) = o;
                }
            }
        }
    }
}
}

namespace {
using pg8::Unit;
struct EpiStoreBf16 {
    static constexpr bool PERM = true;
    bf16_t* O; int ldc;
    __device__ __forceinline__ void operator()(const f32x4 (&acc)[2][2][4][2], const Unit& u, int wr, int wc, int fr_, int fq_) const {
        int fr = fr_, fq = fq_; asm volatile("" : "+v"(fr), "+v"(fq));
        const int row0 = u.pm * 256 + wr * 64 + fr, col0 = u.pn * 256 + wc * 32 + 8 * fq;
#pragma unroll
        for (int ai = 0; ai < 2; ++ai)
#pragma unroll
            for (int m = 0; m < 4; ++m) { bf16_t* rowp = O + (size_t)(row0 + ai * 128 + m * 16) * ldc + col0;
#pragma unroll
                for (int bj = 0; bj < 2; ++bj) { const f32x4 v0 = acc[ai][bj][m][0], v1 = acc[ai][bj][m][1];
                    u32x4 w; w.x = cvt_pk_bf16(v0[0], v0[1]); w.y = cvt_pk_bf16(v0[2], v0[3]); w.z = cvt_pk_bf16(v1[0], v1[1]); w.w = cvt_pk_bf16(v1[2], v1[3]);
                    *(u32x4*)(rowp + bj * 128) = w; } }
    }
};
struct EpiResidual {
    static constexpr bool PERM = false;
    const float* xin32; bf16_t* xb; const float* gate;
    __device__ __forceinline__ void operator()(const f32x4 (&acc)[2][2][4][2], const Unit& u, int wr, int wc, int fr_, int fq_) const {
        int fr = fr_, fq = fq_; asm volatile("" : "+v"(fr), "+v"(fq));
        const int row0 = u.pm * 256 + wr * 64 + fr, col0 = u.pn * 256 + wc * 32 + 4 * fq;
        const int b = (u.pm * 256) >> 11;
        f32x4 gv[2][2];
#pragma unroll
        for (int bj = 0; bj < 2; ++bj)
#pragma unroll
            for (int n = 0; n < 2; ++n) gv[bj][n] = *(const f32x4*)(gate + (size_t)b * NMOD + col0 + bj * 128 + n * 16);
#pragma unroll
        for (int ai = 0; ai < 2; ++ai)
#pragma unroll
            for (int m = 0; m < 4; ++m) { const size_t ro = (size_t)(row0 + ai * 128 + m * 16) * D + col0;
#pragma unroll
                for (int bj = 0; bj < 2; ++bj)
#pragma unroll
                    for (int n = 0; n < 2; ++n) { const size_t o = ro + bj * 128 + n * 16;
                        f32x4 xv;
                        if (xin32) xv = *(const f32x4*)(xin32 + o);
                        else { const u32x2 w = *(const u32x2*)(xb + o); xv = (f32x4){bflo(w.x), bfhi(w.x), bflo(w.y), bfhi(w.y)}; }
                        const f32x4 r = xv + gv[bj][n] * acc[ai][bj][m][n];
                        u32x2 ow; ow.x = cvt_pk_bf16(r[0], r[1]); ow.y = cvt_pk_bf16(r[2], r[3]);
                        *(u32x2*)(xb + o) = ow; } }
    }
};
struct EpiMlaQ {
    static constexpr bool PERM = true;
    bf16_t* qm;
    __device__ __forceinline__ void operator()(const f32x4 (&acc)[2][2][4][2], const Unit& u, int wr, int wc, int fr_, int fq_) const {
        int fr = fr_, fq = fq_; asm volatile("" : "+v"(fr), "+v"(fq));
        const int row0 = u.pm * 256 + wr * 64 + fr;
#pragma unroll
        for (int bj = 0; bj < 2; ++bj) {
            const int col0 = u.pn * 256 + bj * 128 + wc * 32;
            if (col0 >= 384) continue;
#pragma unroll
            for (int ai = 0; ai < 2; ++ai)
#pragma unroll
                for (int m = 0; m < 4; ++m) { const f32x4 v0 = acc[ai][bj][m][0], v1 = acc[ai][bj][m][1];
                    u32x4 w; w.x = cvt_pk_bf16(v0[0], v0[1]); w.y = cvt_pk_bf16(v0[2], v0[3]); w.z = cvt_pk_bf16(v1[0], v1[1]); w.w = cvt_pk_bf16(v1[2], v1[3]);
                    *(u32x4*)(qm + (size_t)(row0 + ai * 128 + m * 16) * 384 + col0 + 8 * fq) = w; }
        }
    }
};
struct EpiMlaKV {
    static constexpr bool PERM = true;
    bf16_t* km; bf16_t* vm;
    __device__ __forceinline__ void operator()(const f32x4 (&acc)[2][2][4][2], const Unit& u, int wr, int wc, int fr_, int fq_) const {
        int fr = fr_, fq = fq_; asm volatile("" : "+v"(fr), "+v"(fq));
        const int row0 = u.pm * 256 + wr * 64 + fr;
#pragma unroll
        for (int bj = 0; bj < 2; ++bj) {
            const int head = u.pn * 2 + bj, wcol = wc * 32 + 8 * fq;
#pragma unroll
            for (int ai = 0; ai < 2; ++ai)
#pragma unroll
                for (int m = 0; m < 4; ++m) {
                    const int row = row0 + ai * 128 + m * 16;
                    const f32x4 v0 = acc[ai][bj][m][0], v1 = acc[ai][bj][m][1];
                    u32x4 w; w.x = cvt_pk_bf16(v0[0], v0[1]); w.y = cvt_pk_bf16(v0[2], v0[3]); w.z = cvt_pk_bf16(v1[0], v1[1]); w.w = cvt_pk_bf16(v1[2], v1[3]);
                    bf16_t* q = (wcol < 64) ? km + (size_t)row * 384 + head * 96 + wcol : vm + (size_t)row * 256 + head * 64 + (wcol - 64);
                    *(u32x4*)q = w;
                    asm volatile("" ::: "memory");
                }
        }
    }
};
struct EpiGateUp {
    static constexpr bool PERM = false;
    bf16_t* hid;
    __device__ __forceinline__ void operator()(const f32x4 (&acc)[2][2][4][2], const Unit& u, int wr, int wc, int fr_, int fq_) const {
        int fr = fr_, fq = fq_; asm volatile("" : "+v"(fr), "+v"(fq));
        const int row0 = u.pm * 256 + wr * 64 + fr;
#pragma unroll
        for (int ai = 0; ai < 2; ++ai)
#pragma unroll
            for (int m = 0; m < 4; ++m) { bf16_t* rowp = hid + (size_t)(row0 + ai * 128 + m * 16) * 256;
#pragma unroll
                for (int bj = 0; bj < 2; ++bj) { const f32x4 gt = acc[ai][bj][m][0], up = acc[ai][bj][m][1];
                    f32x4 o;
#pragma unroll
                    for (int j = 0; j < 4; ++j) o[j] = gt[j] / (1.f + __expf(-gt[j])) * up[j];
                    u32x2 w; w.x = cvt_pk_bf16(o[0], o[1]); w.y = cvt_pk_bf16(o[2], o[3]);
                    *(u32x2*)(rowp + 16 * (u.pn * 8 + bj * 4 + wc) + 4 * fq) = w; } }
    }
};
struct EpiDown {
    static constexpr bool PERM = true;
    bf16_t* ys; const int* list; const float* wl; const int* cnt;
    __device__ __forceinline__ void operator()(const f32x4 (&acc)[2][2][4][2], const Unit& u, int wr, int wc, int fr_, int fq_) const {
        int fr = fr_, fq = fq_; asm volatile("" : "+v"(fr), "+v"(fq));
        const int n = cnt[u.e]; const int* le = list + (size_t)u.e * ECAP; const float* we = wl + (size_t)u.e * ECAP;
        const int col0 = u.pn * 256 + wc * 32 + 8 * fq;
        int slot[8]; float w8[8];
#pragma unroll
        for (int q = 0; q < 8; ++q) { const int lr = u.mt * 256 + (q >> 2) * 128 + wr * 64 + (q & 3) * 16 + fr; slot[q] = lr < n ? le[lr] : -1; w8[q] = lr < n ? we[lr] : 0.f; }
#pragma unroll
        for (int ai = 0; ai < 2; ++ai)
#pragma unroll
            for (int m = 0; m < 4; ++m) {
                const int q = ai * 4 + m;
                if (slot[q] >= 0) {
                    bf16_t* rowp = ys + (size_t)slot[q] * D + col0;
#pragma unroll
                    for (int bj = 0; bj < 2; ++bj) { const f32x4 v0 = acc[ai][bj][m][0] * w8[q], v1 = acc[ai][bj][m][1] * w8[q];
                        u32x4 w; w.x = cvt_pk_bf16(v0[0], v0[1]); w.y = cvt_pk_bf16(v0[2], v0[3]); w.z = cvt_pk_bf16(v1[0], v1[1]); w.w = cvt_pk_bf16(v1[2], v1[3]);
                        *(u32x4*)(rowp + bj * 128) = w; }
                }
            }
    }
};
struct MoeOrder {
    int pre[17];
    int NT, G, c; const int* list; const int* cnt;
    __device__ __forceinline__ void init(const int* cnt_, const int* list_, int NT_, int G_, int c_) {
        cnt = cnt_; list = list_; NT = NT_; G = G_; c = c_; int a = 0;
#pragma unroll
        for (int e = 0; e < 16; ++e) { pre[e] = a; a += (cnt_[e] + 255) >> 8; }
        pre[16] = a;
    }
    __device__ __forceinline__ bool next(int i, Unit& u) const {
        const int L = i * G + c; if (L >= pre[16] * NT) return false;
        const int t = L / NT; int e = 0;
#pragma unroll
        for (int k = 1; k < 16; ++k) e += (t >= pre[k]) ? 1 : 0;
        int pe = 0;
#pragma unroll
        for (int k = 0; k < 16; ++k) pe = (k == e) ? pre[k] : pe;
        u.e = e; u.mt = t - pe; u.pm = t; u.pn = L - t * NT; return true;
    }
    __device__ __forceinline__ int arow(const Unit& u, int r) const { const int lr = u.mt * 256 + r; return lr < cnt[u.e] ? (list[(size_t)u.e * ECAP + lr] >> 1) : 0; }
};
}

namespace {
__device__ __forceinline__ void phase_prep(const Params& p, int l) {
    const int tid = opaque_tid(p.wid), w = tid >> 6, lane = tid & 63;
    const int gw = blockIdx.x * 8 + w, nw = gridDim.x * 8;
    for (int sq = gw; sq < NB * 4; sq += nw) {
        const int b = sq >> 2, hh = sq & 3; const float bias = p.b_forget[l * 4 + hh];
        float lf[32]; float run = 0.f;
#pragma unroll
        for (int j = 0; j < 32; ++j) {
            const float z = bf2f(p.proj[(size_t)(b * S + lane * 32 + j) * NP + PC_AF + hh]) + bias;
            run += fminf(z, 0.f) - log1pf(__expf(-fabsf(z)));
            lf[j] = run;
        }
        float incl = run;
#pragma unroll
        for (int o = 1; o < 64; o <<= 1) { const float t2 = __shfl_up(incl, o); if (lane >= o) incl += t2; }
        const float excl = incl - run;
#pragma unroll
        for (int j = 0; j < 32; ++j) p.cbF[(size_t)sq * S + lane * 32 + j] = -(excl + lf[j]) * LOG2E;
    }
    for (int c32 = gw; c32 < T / 32; c32 += nw) {
    float mxq = 0.f, mxk = 0.f;
#define PREP_LOAD(u, tt) do { const bf16_t* _row = p.proj + (size_t)(tt) * NP; \
        n_cq[u] = *(const u32x2*)(_row + PC_BCQ + 4 * lane); n_ck[u] = *(const unsigned*)(_row + PC_BCKV + 2 * lane); \
        n_aq[u] = *(const u32x2*)(_row + PC_AQ + 4 * lane); n_ak[u] = *(const u32x2*)(_row + PC_AK + 4 * lane); \
        n_ki[u] = *(const u32x4*)(_row + PC_DKI + 8 * (lane & 3)); n_kr[u] = _row[PC_BKR + (lane & 31)]; } while (0)
    u32x2 n_cq[4], n_aq[4], n_ak[4]; unsigned n_ck[4]; u32x4 n_ki[4]; bf16_t n_kr[4];
#pragma unroll
    for (int u = 0; u < 4; ++u) PREP_LOAD(u, c32 * 32 + u);
    for (int it = 0; it < 32; it += 4) {
        u32x2 c_cq[4], c_aq[4], c_ak[4]; unsigned c_ck[4]; u32x4 c_ki[4]; bf16_t c_kr[4];
#pragma unroll
        for (int u = 0; u < 4; ++u) { c_cq[u] = n_cq[u]; c_aq[u] = n_aq[u]; c_ak[u] = n_ak[u]; c_ck[u] = n_ck[u]; c_ki[u] = n_ki[u]; c_kr[u] = n_kr[u]; }
        if (it < 28) {
#pragma unroll
            for (int u = 0; u < 4; ++u) PREP_LOAD(u, c32 * 32 + it + 4 + u);
        }
#pragma unroll
        for (int u = 0; u < 4; ++u) {
        const int t = c32 * 32 + it + u;
        const u32x2 cq = c_cq[u], aq = c_aq[u], ak = c_ak[u]; const unsigned ck = c_ck[u]; const u32x4 ki = c_ki[u]; const bf16_t krb = c_kr[u];
        float s1 = bflo(cq.x) * bflo(cq.x) + bfhi(cq.x) * bfhi(cq.x) + bflo(cq.y) * bflo(cq.y) + bfhi(cq.y) * bfhi(cq.y);
        float s2 = bflo(ck) * bflo(ck) + bfhi(ck) * bfhi(ck);
        s1 = wave_sum(s1); s2 = wave_sum(s2);
        if (lane < 4) *(u32x4*)(p.kidx + (size_t)t * 32 + 8 * lane) = ki;
        {
            float nq = bflo(aq.x) * bflo(aq.x) + bfhi(aq.x) * bfhi(aq.x) + bflo(aq.y) * bflo(aq.y) + bfhi(aq.y) * bfhi(aq.y);
            float nk = bflo(ak.x) * bflo(ak.x) + bfhi(ak.x) * bfhi(ak.x) + bflo(ak.y) * bflo(ak.y) + bfhi(ak.y) * bfhi(ak.y);
#pragma unroll
            for (int o = 8; o > 0; o >>= 1) { nq += __shfl_xor(nq, o); nk += __shfl_xor(nk, o); }
            mxq = fmaxf(mxq, nq); mxk = fmaxf(mxk, nk);
        }
        const float kr = (lane < 32) ? bf2f(krb) : 0.f;
        const float kr2 = __shfl(kr, (lane + 16) & 63);
        {
            const float r1 = rsqrtf(s1 * (1.f / 256.f) + EPS), r2 = rsqrtf(s2 * (1.f / 128.f) + EPS);
            u32x2 o; o.x = cvt_pk_bf16(bflo(cq.x) * r1, bfhi(cq.x) * r1); o.y = cvt_pk_bf16(bflo(cq.y) * r1, bfhi(cq.y) * r1);
            *(u32x2*)(p.proj + (size_t)t * NP + PC_BCQ + 4 * lane) = o;
            *(unsigned*)(p.proj + (size_t)t * NP + PC_BCKV + 2 * lane) = cvt_pk_bf16(bflo(ck) * r2, bfhi(ck) * r2);
        }
        if (lane < 16) {
            const int pos = t & (S - 1);
            const float cs = p.ropetab[(pos * 16 + lane) * 2], sn = p.ropetab[(pos * 16 + lane) * 2 + 1];
            const bf16_t o1 = f2bf(kr * cs - kr2 * sn), o2 = f2bf(kr2 * cs + kr * sn);
            bf16_t* kmr = p.km + (size_t)t * 384;
#pragma unroll
            for (int hh = 0; hh < 4; ++hh) { kmr[hh * 96 + 64 + lane] = o1; kmr[hh * 96 + 80 + lane] = o2; }
        }
        }
    }
#undef PREP_LOAD
    if ((lane & 15) == 0) {
        const int t = c32 * 32, bb = t >> 11, pos = t & (S - 1), hh = lane >> 4;
        atomicMax(p.ctl + CW_KN2 + ((l * NB + bb) * 4 + hh) * 32 + (pos >> 6), __float_as_uint(mxk));
        atomicMax(p.ctl + CW_QN2 + ((l * NB + bb) * 4 + hh) * 8 + (pos >> 8), __float_as_uint(mxq));
    }
    }
}

__device__ __forceinline__ void phase_route(const Params& p, int l, char* lds) {
    const int tid = opaque_tid(p.wid), w = tid >> 6, lane = tid & 63;
    float* wrT = (float*)lds;
    int* lcnt = (int*)(lds + 65536);
    int* lbase = (int*)(lds + 65536 + 64);
    int* tsel = (int*)(lds + 65536 + 128);
    float* twt = (float*)(lds + 65536 + 128 + 2048);
    float* lgt = (float*)(lds + 65536 + 8192);
    for (int i = tid; i < 16 * 1024; i += 512) { const int e = i >> 10, d = i & 1023; wrT[i] = p.w_router[d * 16 + e]; }
    const float* g = p.g_norm2 + l * D;
    const float* modl = p.mod + (size_t)l * NB * NMOD;
    int* cnt = (int*)(p.ctl + CW_CNT) + l * 16 + 32 * p.qslot;
    int* list = p.list + (size_t)p.qslot * 16 * ECAP;
    for (int chunk = blockIdx.x; chunk < T / 256; chunk += gridDim.x) {
        if (tid < 16) lcnt[tid] = 0;
        __syncthreads();
        const int b = (chunk * 256) >> 11;
        f32x4 gs4[4], sh4[4];
#pragma unroll
        for (int k = 0; k < 4; ++k) { const int col = 4 * lane + 256 * k; const f32x4 gg = *(const f32x4*)(g + col);
            const f32x4 sc = *(const f32x4*)(modl + (size_t)b * NMOD + 4 * 1024 + col); gs4[k] = gg * (1.f + sc); sh4[k] = *(const f32x4*)(modl + (size_t)b * NMOD + 3 * 1024 + col); }
        const int eown = ((lane >> 5) & 1) * 8 + ((lane >> 4) & 1) * 4 + ((lane >> 3) & 1) * 2 + ((lane >> 2) & 1);
        u32x2 raw[2][4];
#pragma unroll
        for (int q = 0; q < 2; ++q)
#pragma unroll
            for (int k = 0; k < 4; ++k) raw[q][k] = *(const u32x2*)(p.xb + (size_t)(chunk * 256 + w * 32 + q) * D + 4 * lane + 256 * k);
        for (int it = 0; it < 32; it += 2) {
            const int li = w * 32 + it, t = chunk * 256 + li;
            f32x4 v[2][4];
#pragma unroll
            for (int q = 0; q < 2; ++q)
#pragma unroll
                for (int k = 0; k < 4; ++k) v[q][k] = (f32x4){bflo(raw[q][k].x), bfhi(raw[q][k].x), bflo(raw[q][k].y), bfhi(raw[q][k].y)};
            if (it < 30) {
#pragma unroll
                for (int q = 0; q < 2; ++q)
#pragma unroll
                    for (int k = 0; k < 4; ++k) raw[q][k] = *(const u32x2*)(p.xb + (size_t)(t + 2 + q) * D + 4 * lane + 256 * k);
            }
            float ss0 = 0.f, ss1 = 0.f;
#pragma unroll
            for (int k = 0; k < 4; ++k) { ss0 += v[0][k][0] * v[0][k][0] + v[0][k][1] * v[0][k][1] + v[0][k][2] * v[0][k][2] + v[0][k][3] * v[0][k][3];
                                          ss1 += v[1][k][0] * v[1][k][0] + v[1][k][1] * v[1][k][1] + v[1][k][2] * v[1][k][2] + v[1][k][3] * v[1][k][3]; }
            ss0 = wave_sum(ss0); ss1 = wave_sum(ss1);
            const float r0 = rsqrtf(ss0 * (1.0f / D) + EPS), r1 = rsqrtf(ss1 * (1.0f / D) + EPS);
            f32x2 lgp[16];
#pragma unroll
            for (int e = 0; e < 16; ++e) lgp[e] = (f32x2){0.f, 0.f};
#pragma unroll
            for (int k = 0; k < 4; ++k) {
                const int col = 4 * lane + 256 * k;
                const f32x4 y0 = v[0][k] * r0 * gs4[k] + sh4[k], y1 = v[1][k] * r1 * gs4[k] + sh4[k];
                u32x2 o0, o1; o0.x = cvt_pk_bf16(y0[0], y0[1]); o0.y = cvt_pk_bf16(y0[2], y0[3]); o1.x = cvt_pk_bf16(y1[0], y1[1]); o1.y = cvt_pk_bf16(y1[2], y1[3]);
                *(u32x2*)(p.h + (size_t)t * D + col) = o0; *(u32x2*)(p.h + (size_t)(t + 1) * D + col) = o1;
                const f32x2 yp0 = {y0[0], y1[0]}, yp1 = {y0[1], y1[1]}, yp2 = {y0[2], y1[2]}, yp3 = {y0[3], y1[3]};
#pragma unroll
                for (int e = 0; e < 16; ++e) { const f32x4 wv = *(const f32x4*)(wrT + e * 1024 + col);
                    lgp[e] = __builtin_elementwise_fma(yp0, (f32x2){wv[0], wv[0]}, lgp[e]); lgp[e] = __builtin_elementwise_fma(yp1, (f32x2){wv[1], wv[1]}, lgp[e]);
                    lgp[e] = __builtin_elementwise_fma(yp2, (f32x2){wv[2], wv[2]}, lgp[e]); lgp[e] = __builtin_elementwise_fma(yp3, (f32x2){wv[3], wv[3]}, lgp[e]); }
                asm volatile("" ::: "memory");
            }
#pragma unroll
            for (int q = 0; q < 2; ++q) {
                float lg[16];
#pragma unroll
                for (int e = 0; e < 16; ++e) lg[e] = lgp[e][q];
                float a8[8], a4[4], a2[2], a1;
                { const bool hi = (lane & 32) != 0;
#pragma unroll
                  for (int e = 0; e < 8; ++e) { const float send = hi ? lg[e] : lg[e + 8], keep = hi ? lg[e + 8] : lg[e]; a8[e] = keep + __shfl_xor(send, 32); } }
                { const bool hi = (lane & 16) != 0;
#pragma unroll
                  for (int e = 0; e < 4; ++e) { const float send = hi ? a8[e] : a8[e + 4], keep = hi ? a8[e + 4] : a8[e]; a4[e] = keep + __shfl_xor(send, 16); } }
                { const bool hi = (lane & 8) != 0;
#pragma unroll
                  for (int e = 0; e < 2; ++e) { const float send = hi ? a4[e] : a4[e + 2], keep = hi ? a4[e + 2] : a4[e]; a2[e] = keep + __shfl_xor(send, 8); } }
                { const bool hi = (lane & 4) != 0; const float send = hi ? a2[0] : a2[1], keep = hi ? a2[1] : a2[0]; a1 = keep + __shfl_xor(send, 4); }
                a1 += __shfl_xor(a1, 2); a1 += __shfl_xor(a1, 1);
                if ((lane & 3) == 0) lgt[(li + q) * 16 + eown] = a1;
            }
        }
        asm volatile("s_waitcnt lgkmcnt(0)" ::: "memory");
        __builtin_amdgcn_wave_barrier();
        if (lane < 32) {
            const int li = w * 32 + lane;
            float sc[16], bi[16];
#pragma unroll
            for (int e4 = 0; e4 < 4; ++e4) { const f32x4 a = *(const f32x4*)(lgt + li * 16 + 4 * e4);
#pragma unroll
                for (int j = 0; j < 4; ++j) { const float sg = 1.f / (1.f + expf(-a[j])); sc[4 * e4 + j] = sg; bi[4 * e4 + j] = sg + p.b_router[4 * e4 + j]; } }
            int bg = 0; float bgs = -INFINITY;
#pragma unroll
            for (int gi = 0; gi < 4; ++gi) {
                float m1 = -INFINITY, m2 = -INFINITY;
#pragma unroll
                for (int j = 0; j < 4; ++j) { const float vv = bi[gi * 4 + j]; if (vv > m1) { m2 = m1; m1 = vv; } else if (vv > m2) m2 = vv; }
                const float gs = m1 + m2; if (gs > bgs) { bgs = gs; bg = gi; }
            }
            float b4[4], s4[4];
#pragma unroll
            for (int j = 0; j < 4; ++j) { b4[j] = bi[j]; s4[j] = sc[j]; }
#pragma unroll
            for (int gi = 1; gi < 4; ++gi)
#pragma unroll
                for (int j = 0; j < 4; ++j) { b4[j] = (gi == bg) ? bi[gi * 4 + j] : b4[j]; s4[j] = (gi == bg) ? sc[gi * 4 + j] : s4[j]; }
            int i1 = 0; float v1 = -INFINITY;
#pragma unroll
            for (int j = 0; j < 4; ++j) { if (b4[j] > v1) { v1 = b4[j]; i1 = j; } }
            int i2 = 0; float v2 = -INFINITY;
#pragma unroll
            for (int j = 0; j < 4; ++j) { if (j != i1 && b4[j] > v2) { v2 = b4[j]; i2 = j; } }
            float w1 = 0.f, w2 = 0.f;
#pragma unroll
            for (int j = 0; j < 4; ++j) { w1 = (j == i1) ? s4[j] : w1; w2 = (j == i2) ? s4[j] : w2; }
            const int e1 = bg * 4 + i1, e2 = bg * 4 + i2; const float ws = w1 + w2;
            const int r1 = atomicAdd(&lcnt[e1], 1), r2 = atomicAdd(&lcnt[e2], 1);
            tsel[li * 2 + 0] = (e1 << 16) | r1; tsel[li * 2 + 1] = (e2 << 16) | r2;
            twt[li * 2 + 0] = w1 / ws; twt[li * 2 + 1] = w2 / ws;
        }
        __syncthreads();
        if (tid < 16) lbase[tid] = atomicAdd(&cnt[tid], lcnt[tid]);
        __syncthreads();
        { const int v = tsel[tid], e = v >> 16, rk = v & 0xFFFF; const size_t pos = (size_t)e * ECAP + lbase[e] + rk;
          list[pos] = (chunk * 256 + (tid >> 1)) * 2 + (tid & 1); p.wl[pos + (size_t)p.qslot * 16 * ECAP] = twt[tid]; }
        __syncthreads();
    }
}
}

#ifndef ATTN_VMASK
#define ATTN_VMASK 15
#endif
#ifndef REPK_VMASK
#define REPK_VMASK 15
#endif
namespace {
constexpr int AT_NS = 4;
constexpr int AT_SLOT = 21504;
constexpr int AT_K = 0;
constexpr int AT_V = 8192;
constexpr int AT_R = 16384;
constexpr int AT_C = 20480;
constexpr int AT_CTL = AT_NS * AT_SLOT;
constexpr int AT_MW = AT_CTL + 512;
constexpr int AT_LDS = AT_MW + 64 * 272;
constexpr float NEGBIG = -1.0e30f;

#define AT_TR(dst, a, off) asm volatile("ds_read_b64_tr_b16 %0, %1 offset:%2" : "=v"(dst) : "v"(a), "n"(off))
#define AT_TR2(c, dt) { const unsigned a_ = vaddr + (unsigned)((((dt) ^ swv)) << 5); AT_TR(vt[c][dt][0], a_, AT_V + (c) * 4096); AT_TR(vt[c][dt][1], a_, AT_V + (c) * 4096 + 2048); }
#define AT_TIE(n, c) asm volatile("s_waitcnt lgkmcnt(" #n ")" : "+v"(vt[c][0][0]), "+v"(vt[c][0][1]), "+v"(vt[c][1][0]), "+v"(vt[c][1][1]), \
                                                                  "+v"(vt[c][2][0]), "+v"(vt[c][2][1]), "+v"(vt[c][3][0]), "+v"(vt[c][3][1]))

#define AT_PIN(x) asm volatile("" : "+v"(x))
#define AT_BAR() do { __builtin_amdgcn_sched_barrier(0); __builtin_amdgcn_s_barrier(); asm volatile("" ::: "memory"); __builtin_amdgcn_sched_barrier(0); } while (0)

template <int VAR, bool FULL>
__device__ __forceinline__ void at_cinit(const LAS3 char* sb, const int j, const int q0, const int i, const int g, const float slope2, const LAS3 char* mwl, f32x4 (&s)[2][4], const int qa = 0, const int qb_ = 2) {
#pragma unroll
    for (int qt = 0; qt < 2; ++qt) if (qt >= qa && qt < qb_) {
        const int t = q0 + 16 * qt + i;
        const int dbase = 64 * j + 4 * g - t;
        const float sb2 = slope2 * ((VAR == 2) ? (float)dbase : (float)(64 * j + 4 * g));
#pragma unroll
        for (int mt = 0; mt < 4; ++mt) {
            f32x4 ini = {0.f, 0.f, 0.f, 0.f};
            if (VAR == 0) ini = *(const LAS3 f32x4*)(sb + AT_C + (16 * mt + 4 * g) * 4);
            u32x4 mw4 = {0u, 0u, 0u, 0u};
            if (VAR == 3) mw4 = *(const LAS3 u32x4*)(mwl + qt * (16 * 272) + mt * 64);
#pragma unroll
            for (int r = 0; r < 4; ++r) {
                const int c = 16 * mt + r;
                float v = ini[r];
                if (VAR >= 2) v = sb2 + slope2 * (float)c;
                if (VAR == 3) {
                    const int m = ((int)(mw4[r] << (31 - j))) >> 31;
                    v = __uint_as_float((__float_as_uint(v) & (unsigned)m) | (__float_as_uint(NEGBIG) & ~(unsigned)m));
                } else if (!FULL) {
                    bool ok;
                    if (VAR == 2) ok = (unsigned)(dbase + c + 127) < 128u;
                    else ok = (dbase + c) <= 0;
                    v = ok ? v : NEGBIG;
                }
                ini[r] = v;
            }
            s[qt][mt] = ini;
        }
    }
}
template <int VAR, int KC>
__device__ __forceinline__ void at_qk(const LAS3 char* sb, const int i, const int g, const int swk, const bf16x8 (&qf)[2][KC], f32x4 (&s)[2][4], const int qa = 0, const int qb_ = 2) {
    const LAS3 char* Kb = sb + AT_K;
#pragma unroll
    for (int mt = 0; mt < 4; ++mt) {
#pragma unroll
        for (int kc = 0; kc < 2; ++kc) {
            const bf16x8 kf = *(const LAS3 bf16x8*)(Kb + (mt * 16 + i) * 128 + (((kc * 4 + g) ^ swk) << 4));
#pragma unroll
            for (int qt = 0; qt < 2; ++qt) if (qt >= qa && qt < qb_) s[qt][mt] = __builtin_amdgcn_mfma_f32_16x16x32_bf16(kf, qf[qt][kc], s[qt][mt], 0, 0, 0);
        }
        if (VAR == 1) {
            const bf16x8 kf = *(const LAS3 bf16x8*)(sb + AT_R + (mt * 16 + i) * 64 + ((g ^ (swk & 3)) << 4));
#pragma unroll
            for (int qt = 0; qt < 2; ++qt) if (qt >= qa && qt < qb_) s[qt][mt] = __builtin_amdgcn_mfma_f32_16x16x32_bf16(kf, qf[qt][KC - 1], s[qt][mt], 0, 0, 0);
        }
    }
}
__device__ __forceinline__ void at_max(const f32x4 (&s)[2][4], float (&mx)[2]) {
#pragma unroll
    for (int qt = 0; qt < 2; ++qt) {
        float m = fmaxf(fmaxf(s[qt][0][0], s[qt][0][1]), fmaxf(s[qt][0][2], s[qt][0][3]));
#pragma unroll
        for (int mt = 1; mt < 4; ++mt) m = fmaxf(m, fmaxf(fmaxf(s[qt][mt][0], s[qt][mt][1]), fmaxf(s[qt][mt][2], s[qt][mt][3])));
        m = fmaxf(m, __builtin_bit_cast(float, __builtin_amdgcn_ds_swizzle(__builtin_bit_cast(int, m), 0x401F)));
        mx[qt] = xor32_max(m);
    }
}
__device__ __forceinline__ void at_rescale(const float (&mx)[2], f32x4 (&o)[2][4], float (&mrow)[2], float (&lsum)[2]) {
#pragma unroll
    for (int qt = 0; qt < 2; ++qt) {
        if (__any(mx[qt] > mrow[qt])) {
            const float mn = fmaxf(mrow[qt], mx[qt]), alpha = __builtin_amdgcn_exp2f(mrow[qt] - mn);
            mrow[qt] = mn; lsum[qt] *= alpha;
#pragma unroll
            for (int dt = 0; dt < 4; ++dt) o[qt][dt] = o[qt][dt] * alpha;
        }
    }
}
__device__ __forceinline__ void at_exp(const f32x4 (&s)[2][4], const float (&mrow)[2], float (&lsum)[2], bf16x8 (&pf)[2][2], const int qa = 0, const int qb_ = 2) {
#pragma unroll
    for (int qt = 0; qt < 2; ++qt) if (qt >= qa && qt < qb_) {
        const float mn = mrow[qt];
        const f32x4 mn4 = {mn, mn, mn, mn};
        f32x4 ps4 = {0.f, 0.f, 0.f, 0.f};
        float x[4][4];
#pragma unroll
        for (int mt = 0; mt < 4; ++mt) {
            const f32x4 d4 = s[qt][mt] - mn4;
            f32x4 e4;
#pragma unroll
            for (int r = 0; r < 4; ++r) { e4[r] = __builtin_amdgcn_exp2f(d4[r]); x[mt][r] = e4[r]; }
            ps4 += e4;
        }
        lsum[qt] += (ps4[0] + ps4[1]) + (ps4[2] + ps4[3]);
#pragma unroll
        for (int c = 0; c < 2; ++c) {
            u32x4 pk; pk.x = cvt_pk_bf16(x[2 * c][0], x[2 * c][1]); pk.y = cvt_pk_bf16(x[2 * c][2], x[2 * c][3]);
            pk.z = cvt_pk_bf16(x[2 * c + 1][0], x[2 * c + 1][1]); pk.w = cvt_pk_bf16(x[2 * c + 1][2], x[2 * c + 1][3]);
            pf[qt][c] = __builtin_bit_cast(bf16x8, pk);
        }
    }
}
__device__ __forceinline__ void at_vread(const unsigned vaddr, const int swv, u32x2 (&vt)[2][4][2]) {
    AT_TR2(0, 0) AT_TR2(0, 1) AT_TR2(0, 2) AT_TR2(0, 3) AT_TR2(1, 0) AT_TR2(1, 1) AT_TR2(1, 2) AT_TR2(1, 3)
}
__device__ __forceinline__ void at_pv(u32x2 (&vt)[2][4][2], const bf16x8 (&pf)[2][2], f32x4 (&o)[2][4]) {
    AT_TIE(8, 0);
#pragma unroll
    for (int dt = 0; dt < 4; ++dt) {
        const u32x4 vw = {vt[0][dt][0].x, vt[0][dt][0].y, vt[0][dt][1].x, vt[0][dt][1].y};
        const bf16x8 vf = __builtin_bit_cast(bf16x8, vw);
        o[0][dt] = __builtin_amdgcn_mfma_f32_16x16x32_bf16(vf, pf[0][0], o[0][dt], 0, 0, 0);
        o[1][dt] = __builtin_amdgcn_mfma_f32_16x16x32_bf16(vf, pf[1][0], o[1][dt], 0, 0, 0);
    }
    AT_TIE(0, 1);
#pragma unroll
    for (int dt = 0; dt < 4; ++dt) {
        const u32x4 vw = {vt[1][dt][0].x, vt[1][dt][0].y, vt[1][dt][1].x, vt[1][dt][1].y};
        const bf16x8 vf = __builtin_bit_cast(bf16x8, vw);
        o[0][dt] = __builtin_amdgcn_mfma_f32_16x16x32_bf16(vf, pf[0][1], o[0][dt], 0, 0, 0);
        o[1][dt] = __builtin_amdgcn_mfma_f32_16x16x32_bf16(vf, pf[1][1], o[1][dt], 0, 0, 0);
    }
}

template <int VAR>
__device__ __forceinline__ void attn_unit(const Params& p, int l, int b, int hx, int qb, LAS3 char* lds) {
    typedef LAS3 bf16x4 lds_bf16x4;
    constexpr int KC = (VAR == 1) ? 3 : 2;
    const int tid = opaque_tid(p.wid), w = __builtin_amdgcn_readfirstlane(tid >> 6), lane = tid & 63, i = lane & 15, g = lane >> 4;
    const bf16_t *Qp, *Kp, *Vp; int ldq, ldk, ldv, q0, j0, j1, ocol; float c1, slope2 = 0.f;
    if (VAR == 0) { Qp = p.proj + PC_AQ + hx * 64; Kp = p.proj + PC_AK + hx * 64; Vp = p.proj + PC_AV + hx * 64; ldq = ldk = ldv = NP;
                    q0 = qb * 256 + 32 * w; j0 = 0; j1 = 4 * qb + 3; ocol = hx * 64; c1 = 0.125f * LOG2E; }
    else if (VAR == 1) { Qp = p.qm + hx * 96; Kp = p.km + hx * 96; Vp = p.vm + hx * 64; ldq = 384; ldk = 384; ldv = 256;
                    q0 = qb * 256 + 32 * w; j0 = 0; j1 = 4 * qb + 3; ocol = 256 + hx * 64; c1 = 0.10206207261596577f * LOG2E; }
    else if (VAR == 2) { const int qh = hx * 2 + (w >> 2); Qp = p.proj + PC_CQ + qh * 64; Kp = p.proj + PC_CK + hx * 64; Vp = p.proj + PC_CV + hx * 64; ldq = ldk = ldv = NP;
                    q0 = qb * 128 + 32 * (w & 3); j0 = 2 * qb - 2 > 0 ? 2 * qb - 2 : 0; j1 = 2 * qb + 1; ocol = 512 + qh * 64; c1 = 0.125f * LOG2E;
                    slope2 = exp2f(-(float)(qh + 1)) * LOG2E; }
    else { const int hd = w >> 1; Qp = p.proj + PC_DQ + hd * 64; Kp = p.proj + PC_DK; Vp = p.proj + PC_DV; ldq = ldk = ldv = NP;
                    q0 = qb * 64 + 32 * (w & 1); j0 = 0; j1 = qb; ocol = 768 + hd * 64; c1 = 0.125f * LOG2E; slope2 = exp2f(-(float)(hd + 5)) * LOG2E; }
    const size_t tok0 = (size_t)b * S;
    if (VAR == 0 && qb > 0) {
        constexpr float FOX_DROP = 64.0f;
        const unsigned* kn2 = p.ctl + CW_KN2 + ((l * NB + b) * 4 + hx) * 32;
        const float* cbh = p.cbF + ((size_t)b * 4 + hx) * S;
        const float qn = c1 * sqrtf(__uint_as_float(p.ctl[CW_QN2 + ((l * NB + b) * 4 + hx) * 8 + qb]));
        float knu = 0.f;
        for (int jj = 4 * qb; jj < 4 * qb + 4; ++jj) knu = fmaxf(knu, __uint_as_float(kn2[jj]));
        const float lower = cbh[256 * qb] - qn * sqrtf(knu);
        const int jl = lane & 31;
        const bool keep = qn * sqrtf(__uint_as_float(kn2[jl])) + cbh[64 * jl + 63] - lower >= -FOX_DROP || jl >= 4 * qb;
        const unsigned long long kb = __ballot(keep) & 0xFFFFFFFFull;
        j0 = kb ? (int)__builtin_ctzll(kb) : 4 * qb;
    }
    bf16x8 qf[2][KC];
#pragma unroll
    for (int qt = 0; qt < 2; ++qt)
#pragma unroll
        for (int kc = 0; kc < KC; ++kc) qf[qt][kc] = *(const bf16x8*)(Qp + (tok0 + q0 + 16 * qt + i) * ldq + kc * 32 + 8 * g);
    if (VAR == 3) {
        const int r_ = tid >> 3, c8 = tid & 7;
        const u32x4* src = (const u32x4*)(p.mask + (tok0 + qb * 64 + r_) * 64 + c8 * 8);
        const u32x4 m0 = src[0], m1 = src[1];
        *(LAS3 u32x4*)(lds + AT_MW + r_ * 272 + c8 * 32) = m0; *(LAS3 u32x4*)(lds + AT_MW + r_ * 272 + c8 * 32 + 16) = m1;
        asm volatile("s_waitcnt lgkmcnt(0)" ::: "memory");
    }
    const LAS3 char* mwl = lds + AT_MW + (32 * (w & 1) + i) * 272 + 16 * g;
    const int drow = 8 * w + (lane >> 3), dch = lane & 7;
    const int ksc = dch ^ ((drow >> 1) & 7);
    const int vsc = ((((dch >> 1) ^ ((drow >> 1) & 3)) << 1) | (dch & 1));
    const int rrow = 16 * (w & 3) + (lane >> 2), rsc = (lane & 3) ^ ((rrow >> 1) & 3);
    const bool extra = (VAR == 1 && w < 4) || (VAR == 0 && w == 0);
#define AT_DMA(j) do { LAS3 char* _sb = lds + ((j) & (AT_NS - 1)) * AT_SLOT; \
        __builtin_amdgcn_global_load_lds((const unsigned*)(Kp + (tok0 + 64 * (j) + drow) * ldk + ksc * 8), (LAS3 unsigned*)(_sb + AT_K + w * 1024), 16, 0, 0); \
        __builtin_amdgcn_global_load_lds((const unsigned*)(Vp + (tok0 + 64 * (j) + drow) * ldv + vsc * 8), (LAS3 unsigned*)(_sb + AT_V + w * 1024), 16, 0, 0); \
        if (VAR == 1 && w < 4) __builtin_amdgcn_global_load_lds((const unsigned*)(Kp + (tok0 + 64 * (j) + rrow) * ldk + 64 + rsc * 8), (LAS3 unsigned*)(_sb + AT_R + w * 1024), 16, 0, 0); \
        if (VAR == 0 && w == 0) __builtin_amdgcn_global_load_lds((const unsigned*)(p.cbF + ((size_t)b * 4 + hx) * S + 64 * (j) + lane), (LAS3 unsigned*)(_sb + AT_C), 4, 0, 0); \
    } while (0)
    AT_DMA(j0);
    if (j0 + 1 <= j1) AT_DMA(j0 + 1);
    if (j0 + 2 <= j1) AT_DMA(j0 + 2);
    if (VAR == 1) {
#pragma unroll
        for (int qt = 0; qt < 2; ++qt) {
            const int pos = q0 + 16 * qt + i;
            const u32x4 mine = __builtin_bit_cast(u32x4, qf[qt][KC - 1]);
            u32x4 oth; oth.x = __shfl_xor(mine.x, 32); oth.y = __shfl_xor(mine.y, 32); oth.z = __shfl_xor(mine.z, 32); oth.w = __shfl_xor(mine.w, 32);
            const float* rt = p.ropetab + (size_t)(pos * 16 + (g & 1) * 8) * 2;
            const float sg = (g < 2) ? -1.f : 1.f;
            u32x4 res;
#pragma unroll
            for (int e2 = 0; e2 < 4; ++e2) {
                const f32x4 cs = *(const f32x4*)(rt + e2 * 4);
                const unsigned mw_ = e2 == 0 ? mine.x : e2 == 1 ? mine.y : e2 == 2 ? mine.z : mine.w, ow_ = e2 == 0 ? oth.x : e2 == 1 ? oth.y : e2 == 2 ? oth.z : oth.w;
                const float r0 = bflo(mw_) * cs[0] + sg * bflo(ow_) * cs[1], r1 = bfhi(mw_) * cs[2] + sg * bfhi(ow_) * cs[3];
                const unsigned pk = cvt_pk_bf16(r0, r1);
                if (e2 == 0) res.x = pk; else if (e2 == 1) res.y = pk; else if (e2 == 2) res.z = pk; else res.w = pk;
            }
            qf[qt][KC - 1] = __builtin_bit_cast(bf16x8, res);
        }
    }
#pragma unroll
    for (int qt = 0; qt < 2; ++qt)
#pragma unroll
        for (int kc = 0; kc < KC; ++kc) {
            u32x4 qq = __builtin_bit_cast(u32x4, qf[qt][kc]);
            qq.x = cvt_pk_bf16(bflo(qq.x) * c1, bfhi(qq.x) * c1); qq.y = cvt_pk_bf16(bflo(qq.y) * c1, bfhi(qq.y) * c1);
            qq.z = cvt_pk_bf16(bflo(qq.z) * c1, bfhi(qq.z) * c1); qq.w = cvt_pk_bf16(bflo(qq.w) * c1, bfhi(qq.w) * c1);
            qf[qt][kc] = __builtin_bit_cast(bf16x8, qq);
        }
    f32x4 o[2][4];
#pragma unroll
    for (int qt = 0; qt < 2; ++qt)
#pragma unroll
        for (int dt = 0; dt < 4; ++dt) o[qt][dt] = (f32x4){0.f, 0.f, 0.f, 0.f};
    float mrow[2] = {NEGBIG, NEGBIG}, lsum[2] = {0.f, 0.f};
    const int swk = (i >> 1) & 7;
    const int q4 = i >> 2, p4 = i & 3, vrow = 4 * g + q4, swv = (vrow >> 1) & 3;
    const unsigned vbase = (unsigned)(size_t)lds + (unsigned)(vrow * 128 + p4 * 8);
#define AT_WAITV(n) asm volatile("s_waitcnt vmcnt(" #n ")" ::: "memory")
#define AT_WAIT_TILES(k) do { if ((k) >= 2) { if (extra) AT_WAITV(6); else AT_WAITV(4); } else if ((k) == 1) { if (extra) AT_WAITV(3); else AT_WAITV(2); } else AT_WAITV(0); } while (0)
    u32x2 vt[2][4][2]; bf16x8 pf[2][2]; f32x4 s[2][4], sn[2][4]; float mx[2] = {NEGBIG, NEGBIG};
#define AT_NEED(jj) ((64 * (jj) <= q0 + 31) && (VAR != 2 || (64 * (jj) + 63 >= q0 - 127)))
#define AT_FULL(jj) ((64 * (jj) + 63 <= q0) && (VAR != 2 || (64 * (jj) >= q0 - 96)))
#define AT_LOGITS_Q(jj, S_, qa_, qe_) do { const LAS3 char* sb_ = lds + ((jj) & (AT_NS - 1)) * AT_SLOT; \
        if (VAR != 3 && AT_FULL(jj)) at_cinit<VAR, true>(sb_, (jj), q0, i, g, slope2, mwl, S_, qa_, qe_); else at_cinit<VAR, false>(sb_, (jj), q0, i, g, slope2, mwl, S_, qa_, qe_); \
        at_qk<VAR, KC>(sb_, i, g, swk, qf, S_, qa_, qe_); } while (0)
#define AT_LOGITS(jj, S_) AT_LOGITS_Q(jj, S_, 0, 2)
#ifndef ATTN_PIPE
#define ATTN_PIPE 0
#endif
    constexpr bool PIPE = ((ATTN_PIPE >> VAR) & 1) != 0;
    if (PIPE) {
    { const int k = j1 - j0; AT_WAIT_TILES(k); }
    AT_BAR();
    if (AT_NEED(j0)) { AT_LOGITS(j0, s); at_max(s, mx); }
    for (int j = j0; j <= j1; ++j) {
        { const int k = j1 - j - 1; if (k >= 0) AT_WAIT_TILES(k); }
        AT_BAR();
        if (j + 3 <= j1) AT_DMA(j + 3);
        const bool nd = AT_NEED(j), ndn = (j + 1 <= j1) && AT_NEED(j + 1);
        if (nd) {
            at_rescale(mx, o, mrow, lsum);
            __builtin_amdgcn_sched_barrier(0);
            if (ndn) {
                AT_LOGITS(j + 1, sn);
                at_exp(s, mrow, lsum, pf);
                __builtin_amdgcn_sched_barrier(0);
                at_vread(vbase + (unsigned)((j & (AT_NS - 1)) * AT_SLOT), swv, vt);
                at_max(sn, mx);
                at_pv(vt, pf, o);
                __builtin_amdgcn_sched_barrier(0);
#pragma unroll
                for (int qt = 0; qt < 2; ++qt)
#pragma unroll
                    for (int mt = 0; mt < 4; ++mt) s[qt][mt] = sn[qt][mt];
            } else {
                at_vread(vbase + (unsigned)((j & (AT_NS - 1)) * AT_SLOT), swv, vt);
                at_exp(s, mrow, lsum, pf);
                at_pv(vt, pf, o);
            }
        } else if (ndn) { AT_LOGITS(j + 1, s); at_max(s, mx); }
    }
    } else {
    for (int j = j0; j <= j1; ++j) {
        { const int k = j1 - j; AT_WAIT_TILES(k); }
        AT_BAR();
        if (j + 3 <= j1) AT_DMA(j + 3);
        if (AT_NEED(j)) {
            AT_LOGITS(j, s);
            at_vread(vbase + (unsigned)((j & (AT_NS - 1)) * AT_SLOT), swv, vt);
            at_max(s, mx);
            at_rescale(mx, o, mrow, lsum);
            at_exp(s, mrow, lsum, pf);
            at_pv(vt, pf, o);
        }
    }
    }
#undef AT_LOGITS
#undef AT_LOGITS_Q
#undef AT_NEED
#undef AT_FULL
#undef AT_WAIT_TILES
#undef AT_WAITV
#undef AT_DMA
#pragma unroll
    for (int qt = 0; qt < 2; ++qt) {
        float lt = lsum[qt]; lt += __shfl_xor(lt, 16); lt += __shfl_xor(lt, 32);
        if (VAR == 2) lt += __builtin_amdgcn_exp2f(p.sinks[l * 4 + hx * 2 + (w >> 2)] * LOG2E - mrow[qt]);
        const float inv = 1.f / lt;
        bf16_t* op = p.merged + (tok0 + q0 + 16 * qt + i) * D + ocol + 4 * g;
#pragma unroll
        for (int dt = 0; dt < 4; ++dt) { const f32x4 v = o[qt][dt] * inv; u32x2 w2; w2.x = cvt_pk_bf16(v[0], v[1]); w2.y = cvt_pk_bf16(v[2], v[3]); *(u32x2*)(op + 16 * dt) = w2; }
    }
}

__device__ __forceinline__ void phase_attn(const Params& p, int l, LAS3 char* lds) {
    const int tid = opaque_tid(p.wid);
    unsigned* qhead = p.ctl + CW_QA + 64 * (l + 2 * p.qslot);
    volatile LAS3 int* bc = (volatile LAS3 int*)(lds + AT_CTL);
    int nxt = 0;
    if (tid == 0) nxt = (int)__hip_atomic_fetch_add(qhead, 1u, __ATOMIC_RELAXED, __HIP_MEMORY_SCOPE_AGENT);
    for (;;) {
        if (tid == 0) *bc = nxt;
        __syncthreads();
        const int idx = __builtin_amdgcn_readfirstlane(*bc);
        __syncthreads();
        if (idx >= 4096) break;
        if (tid == 0) nxt = (int)__hip_atomic_fetch_add(qhead, 1u, __ATOMIC_RELAXED, __HIP_MEMORY_SCOPE_AGENT);
        const int vmask = p.qslot ? REPK_VMASK : ATTN_VMASK;
        if (idx < 3072) {
            const int lvl = 7 - idx / 384, rem = idx % 384;
            if (rem < 128) { if (vmask & 2) attn_unit<1>(p, l, rem >> 2, rem & 3, lvl, lds); }
            else if (rem < 256) { if (vmask & 1) attn_unit<0>(p, l, (rem - 128) >> 2, rem & 3, lvl, lds); }
            else { const int d = rem - 256; if (vmask & 8) attn_unit<3>(p, l, d & 31, 0, 4 * lvl + 3 - (d >> 5), lds); }
        } else { const int c = idx - 3072; if (vmask & 4) attn_unit<2>(p, l, c >> 5, (c >> 4) & 1, c & 15, lds); }
    }
}
}

namespace {
constexpr int DS_LD = 2052;
constexpr int DS_CTL = 16 * DS_LD * 4;
constexpr int DS_LDS = DS_CTL + 64;

__device__ __forceinline__ void dsa_unit(const Params& p, int u, LAS3 char* lds) {
    const int tid = opaque_tid(p.wid), w = __builtin_amdgcn_readfirstlane(tid >> 6), lane = tid & 63, i = lane & 15, g = lane >> 4;
    const int b = u >> 7, t0 = (u & 127) * 16;
    const size_t tok0 = (size_t)b * S;
    uint32_t* mbase = p.mask + (tok0 + t0) * 64;
    if (t0 + 16 <= 256) {
#pragma unroll
        for (int qq = 0; qq < 2; ++qq) {
            const int q = 2 * w + qq, n = t0 + q + 1;
            const int cnt = n > lane ? ((n - lane + 63) >> 6) : 0;
            mbase[q * 64 + lane] = cnt >= 32 ? 0xFFFFFFFFu : ((1u << cnt) - 1u);
        }
        return;
    }
    const int nreg = (t0 + 16 + 63) >> 6;
    const int ntile = nreg * 4;
    bf16x8 qf[8]; float wq[8];
    {
        const bf16_t* qrow = p.proj + (tok0 + t0 + i) * NP;
#pragma unroll
        for (int h = 0; h < 8; ++h) qf[h] = *(const bf16x8*)(qrow + PC_DQI + h * 32 + 8 * g);
        const u32x4 ww = *(const u32x4*)(qrow + PC_DWI);
        const float sc = 0.35355339059327373f * 0.17677669529663687f;
        wq[0] = bflo(ww.x) * sc; wq[1] = bfhi(ww.x) * sc; wq[2] = bflo(ww.y) * sc; wq[3] = bfhi(ww.y) * sc;
        wq[4] = bflo(ww.z) * sc; wq[5] = bfhi(ww.z) * sc; wq[6] = bflo(ww.w) * sc; wq[7] = bfhi(ww.w) * sc;
    }
    const int tq = t0 + i;
#ifndef DSA_EXP
#define DSA_EXP 0
#endif
    const bool exp_skip_score = (DSA_EXP == 2) && p.qslot > 0, exp_skip_sel = (DSA_EXP == 1) && p.qslot > 0, exp_nostore = (DSA_EXP != 0) && p.qslot > 0;
    if (!exp_skip_score)
    for (int base = w; base < ntile; base += 32) {
        bf16x8 kf4[4];
#pragma unroll
        for (int uu = 0; uu < 4; ++uu) { const int kt = base + 8 * uu; if (kt < ntile) kf4[uu] = *(const bf16x8*)(p.kidx + (tok0 + 16 * kt + i) * 32 + 8 * g); }
#pragma unroll
        for (int uu = 0; uu < 4; ++uu) {
            const int kt = base + 8 * uu;
            if (kt < ntile) {
                f32x4 sc4 = {0.f, 0.f, 0.f, 0.f};
#pragma unroll
                for (int h = 0; h < 8; ++h) {
                    const f32x4 c = __builtin_amdgcn_mfma_f32_16x16x32_bf16(kf4[uu], qf[h], (f32x4){0.f, 0.f, 0.f, 0.f}, 0, 0, 0);
#pragma unroll
                    for (int r = 0; r < 4; ++r) { const int ci = __float_as_int(c[r]); sc4[r] += wq[h] * __int_as_float(ci > 0 ? ci : 0); }
                }
                u32x4 ko;
#pragma unroll
                for (int r = 0; r < 4; ++r) {
                    const int key = 16 * kt + 4 * g + r;
                    unsigned uu2 = __float_as_uint(sc4[r]); if (uu2 == 0x80000000u) uu2 = 0u;
                    uu2 = (uu2 & 0x80000000u) ? ~uu2 : (uu2 | 0x80000000u);
                    ko[r] = (key <= tq) ? uu2 : 0u;
                }
                *(LAS3 u32x4*)(lds + ((size_t)i * DS_LD + 16 * kt + 4 * g) * 4) = ko;
            }
        }
    }
    __syncthreads();
    if (!exp_skip_sel)
    {
        const int qA = 2 * w, qB = 2 * w + 1;
        const LAS3 unsigned* kpA = (const LAS3 unsigned*)(lds + (size_t)qA * DS_LD * 4);
        const LAS3 unsigned* kpB = (const LAS3 unsigned*)(lds + (size_t)qB * DS_LD * 4);
        unsigned PA[32], PB[32];
        const int nv = nreg * 64;
#pragma unroll
        for (int r = 0; r < 32; ++r) {
            int idx = r * 64 + lane; asm volatile("" : "+v"(idx));
            const unsigned va = kpA[r * 64 + lane], vb = kpB[r * 64 + lane];
            PA[r] = (idx < nv) ? va : 0u; PB[r] = (idx < nv) ? vb : 0u;
        }
#define DSA_TR(P, j, m) do { _Pragma("unroll") for (int k = 0; k < 32; ++k) if ((k & (j)) == 0) { const unsigned x = P[k], y = P[k + (j)]; \
            P[k] = (x & (m)) | ((y << (j)) & ~(m)); P[k + (j)] = ((x >> (j)) & (m)) | (y & ~(m)); } } while (0)
        DSA_TR(PA, 16, 0x0000FFFFu); DSA_TR(PB, 16, 0x0000FFFFu); DSA_TR(PA, 8, 0x00FF00FFu); DSA_TR(PB, 8, 0x00FF00FFu);
        DSA_TR(PA, 4, 0x0F0F0F0Fu); DSA_TR(PB, 4, 0x0F0F0F0Fu); DSA_TR(PA, 2, 0x33333333u); DSA_TR(PB, 2, 0x33333333u);
        DSA_TR(PA, 1, 0x55555555u); DSA_TR(PB, 1, 0x55555555u);
#undef DSA_TR
        unsigned alA = 0xFFFFFFFFu, abA = 0u, selA = 0u, alB = 0xFFFFFFFFu, abB = 0u, selB = 0u;
        bool exA = false, exB = false;
#pragma unroll
        for (int bit = 31; bit >= 1; bit -= 2) {
            if (!(exA && exB)) {
                const unsigned p1A = PA[bit], p0A = PA[bit - 1], p1B = PB[bit], p0B = PB[bit - 1];
                const unsigned t1A = alA & p1A, c3A = abA | (t1A & p0A), c2A = abA | t1A, c1A = abA | (alA & (p1A | p0A));
                const unsigned t1B = alB & p1B, c3B = abB | (t1B & p0B), c2B = abB | t1B, c1B = abB | (alB & (p1B | p0B));
                const int rA = wave_reduce_add(__builtin_popcount(c3A) | (__builtin_popcount(c2A) << 16));
                const int rB = wave_reduce_add(__builtin_popcount(c3B) | (__builtin_popcount(c2B) << 16));
                const int rC = wave_reduce_add(__builtin_popcount(c1A) | (__builtin_popcount(c1B) << 16));
                const int n3A = rA & 0xFFFF, n2A = rA >> 16, n1A = rC & 0xFFFF, n3B = rB & 0xFFFF, n2B = rB >> 16, n1B = rC >> 16;
                if (!exA) {
                    if (n3A >= 256) { if (n3A == 256) { exA = true; selA = c3A; } alA = t1A & p0A; }
                    else if (n2A >= 256) { if (n2A == 256) { exA = true; selA = c2A; } abA = c3A; alA = t1A & ~p0A; }
                    else if (n1A >= 256) { if (n1A == 256) { exA = true; selA = c1A; } abA = c2A; alA = alA & ~p1A & p0A; }
                    else { abA = c1A; alA = alA & ~(p1A | p0A); }
                }
                if (!exB) {
                    if (n3B >= 256) { if (n3B == 256) { exB = true; selB = c3B; } alB = t1B & p0B; }
                    else if (n2B >= 256) { if (n2B == 256) { exB = true; selB = c2B; } abB = c3B; alB = t1B & ~p0B; }
                    else if (n1B >= 256) { if (n1B == 256) { exB = true; selB = c1B; } abB = c2B; alB = alB & ~p1B & p0B; }
                    else { abB = c1B; alB = alB & ~(p1B | p0B); }
                }
            }
        }
        const unsigned long long lt = (lane == 0) ? 0ull : (~0ull >> (64 - lane));
#pragma unroll 1
        for (int qq = 0; qq < 2; ++qq) {
            const bool exact = qq ? exB : exA;
            unsigned sel = qq ? selB : selA;
            if (!exact) {
                const unsigned al = qq ? alB : alA, ab = qq ? abB : abA;
                const int need = 256 - wave_reduce_add(__builtin_popcount(ab));
                int running = 0; sel = ab;
                for (int r = 0; r < 32; ++r) {
                    const bool eq = ((al >> r) & 1u) != 0u;
                    const unsigned long long be = __ballot(eq);
                    if (eq && running + __popcll(be & lt) < need) sel |= 1u << r;
                    running += __popcll(be);
                }
            }
            if (!exp_nostore) mbase[(2 * w + qq) * 64 + lane] = sel;
        }
    }
    __syncthreads();
}

__device__ __forceinline__ void phase_dsa(const Params& p, int l, LAS3 char* lds) {
    const int tid = opaque_tid(p.wid);
    unsigned* qhead = p.ctl + CW_QD + 64 * (l + 2 * p.qslot);
    volatile LAS3 int* bc = (volatile LAS3 int*)(lds + DS_CTL);
    int nxt = 0;
    if (tid == 0) nxt = (int)__hip_atomic_fetch_add(qhead, 1u, __ATOMIC_RELAXED, __HIP_MEMORY_SCOPE_AGENT);
    for (;;) {
        if (tid == 0) *bc = nxt;
        __syncthreads();
        const int idx = __builtin_amdgcn_readfirstlane(*bc);
        __syncthreads();
        if (idx >= 4096) break;
        if (tid == 0) nxt = (int)__hip_atomic_fetch_add(qhead, 1u, __ATOMIC_RELAXED, __HIP_MEMORY_SCOPE_AGENT);
        const int pb = 127 - (idx >> 5), b = idx & 31;
        dsa_unit(p, b * 128 + pb, lds);
    }
}
}

namespace {
constexpr int LDS_BYTES = 147456;
constexpr int NTHREADS = 512;

template <int PH>
__device__ __forceinline__ void run_phase(const Params& p, int l, unsigned char* smem) {
    LAS3 char* lds = (LAS3 char*)smem;
    PG8_LAS unsigned char* glds = (PG8_LAS unsigned char*)smem;
    const int G = gridDim.x, c = blockIdx.x;
    if constexpr (PH == 0) phase_p0(p, (char*)smem);
    if constexpr (PH == 1) { if (l == 0) phase_norm1<0>(p, 0); else phase_norm1<1>(p, l); }
    if constexpr (PH == 2) { pg8::Gemm g{p.h, p.WinT + (size_t)l * NP * D, D, D, 0}; pg8::StaticOrder S; S.init(T, NP, G, c);
        EpiStoreBf16 E{p.proj, NP}; pg8::gemm_phase<EpiStoreBf16, pg8::StaticOrder, false>(glds, g, S, E, p.wid); }
    if constexpr (PH == 3) phase_prep(p, l);
    if constexpr (PH == 4) { pg8::Gemm g{p.proj + PC_BCQ, p.WqT + (size_t)l * 512 * 256, 256, NP, 0}; pg8::StaticOrder S; S.init(T, 512, G, c);
          EpiMlaQ E{p.qm}; pg8::gemm_phase<EpiMlaQ, pg8::StaticOrder, false>(glds, g, S, E, p.wid); }
    if constexpr (PH == 12) { pg8::Gemm g{p.proj + PC_BCKV, p.WkvT + (size_t)l * 512 * 128, 128, NP, 0}; pg8::StaticOrder S; S.init(T, 512, G, c);
          EpiMlaKV E{p.km, p.vm}; pg8::gemm_phase<EpiMlaKV, pg8::StaticOrder, false>(glds, g, S, E, p.wid); }
    if constexpr (PH == 13) phase_dsa(p, l, lds);
    if constexpr (PH == 5) phase_attn(p, l, lds);
    if constexpr (PH == 6) { pg8::Gemm g{p.merged, p.WoutT + (size_t)l * D * D, D, D, 0}; pg8::StaticOrder S; S.init(T, D, G, c);
        EpiResidual E{l == 0 ? p.x : nullptr, p.xb, p.mod + (size_t)l * NB * NMOD + 2 * 1024}; pg8::gemm_phase<EpiResidual, pg8::StaticOrder, false>(glds, g, S, E, p.wid); }
    if constexpr (PH == 7) phase_route(p, l, (char*)smem);
    if constexpr (PH == 8) { const int* cnt = (const int*)(p.ctl + CW_CNT) + l * 16;
        pg8::Gemm g{p.h, p.WguT + (size_t)l * 16 * 512 * 1024, 1024, D, (size_t)512 * 1024}; MoeOrder S; S.init(cnt, p.list, 2, G, c);
        EpiGateUp E{p.hid}; pg8::gemm_phase<EpiGateUp, MoeOrder, true>(glds, g, S, E, p.wid); }
    if constexpr (PH == 9) { const int* cnt = (const int*)(p.ctl + CW_CNT) + l * 16;
        pg8::Gemm g{p.hid, p.WdT + (size_t)l * 16 * 1024 * 256, 256, 256, (size_t)1024 * 256}; MoeOrder S; S.init(cnt, p.list, 4, G, c);
        EpiDown E{p.ys, p.list, p.wl, cnt}; pg8::gemm_phase<EpiDown, MoeOrder, false>(glds, g, S, E, p.wid); }
    if constexpr (PH == 10) phase_norm1<2>(p, 1);
    if constexpr (PH == 11) phase_norm1<0>(p, l);
}
template <int PH>
__global__ void __launch_bounds__(NTHREADS, 2) k_ph(Params p, int l) {
    extern __shared__ __attribute__((aligned(16))) unsigned char smem[];
    p.wid = __builtin_amdgcn_readfirstlane(threadIdx.x >> 6); p.qslot = p.qslot_host;
    run_phase<PH>(p, l, smem);
}
}


namespace {
#ifndef REP_PH
#define REP_PH -1
#endif
#define REP(X, l) do { if (REP_PH == X) { xcd_barrier(bar); phase<X>(l, smem, wid, 1); } } while (0)
struct KArgs { const float* in[20]; float* xo; char* ws; };
constexpr size_t al256(size_t b) { return (b + 255) & ~(size_t)255; }
constexpr size_t WS_CTL = 0;
constexpr size_t WS_MOD = WS_CTL + al256((size_t)CW_WORDS * 4);
constexpr size_t WS_WIN = WS_MOD + al256((size_t)2 * NB * NMOD * 4);
constexpr size_t WS_WOUT = WS_WIN + al256((size_t)2 * NP * D * 2);
constexpr size_t WS_WQ = WS_WOUT + al256((size_t)2 * D * D * 2);
constexpr size_t WS_WKV = WS_WQ + al256((size_t)2 * 512 * 256 * 2);
constexpr size_t WS_WGU = WS_WKV + al256((size_t)2 * 512 * 128 * 2);
constexpr size_t WS_WD = WS_WGU + al256((size_t)2 * 16 * 512 * 1024 * 2);
constexpr size_t WS_ROPE = WS_WD + al256((size_t)2 * 16 * 1024 * 256 * 2);
constexpr size_t WS_RQ = WS_ROPE + al256((size_t)2048 * 16 * 2 * 4);
constexpr size_t WS_RKV = WS_RQ + al256((size_t)T * 4);
constexpr size_t WS_CBF = WS_RKV + al256((size_t)T * 4);
constexpr size_t WS_KIDX = WS_CBF + al256((size_t)NB * 4 * S * 4);
constexpr size_t WS_MASK = WS_KIDX + al256((size_t)T * 32 * 2);
constexpr size_t WS_LIST = WS_MASK + al256((size_t)T * 64 * 4);
constexpr size_t WS_RW = WS_LIST + al256((size_t)2 * 16 * ECAP * 4);
constexpr size_t WS_WL = WS_RW + al256((size_t)T * 2 * 4);
constexpr size_t WS_H = WS_WL + al256((size_t)2 * 16 * ECAP * 4);
constexpr size_t WS_PROJ = WS_H + al256((size_t)T * D * 2);
constexpr size_t WS_QM = WS_PROJ + al256((size_t)T * NP * 2);
constexpr size_t WS_KM = WS_QM + al256((size_t)T * 384 * 2);
constexpr size_t WS_VM = WS_KM + al256((size_t)T * 384 * 2);
constexpr size_t WS_MERGED = WS_VM + al256((size_t)T * 256 * 2);
constexpr size_t WS_XB = WS_MERGED + al256((size_t)T * D * 2);
constexpr size_t WS_END1 = WS_XB + al256((size_t)T * D * 2);
constexpr size_t WS_HID = WS_PROJ;
constexpr size_t WS_YS = WS_HID + al256((size_t)HIDROWS * 256 * 2);
constexpr size_t WS_END2 = WS_YS + al256((size_t)T * 2 * D * 2);
constexpr size_t WS_NEED = WS_END1 > WS_END2 ? WS_END1 : WS_END2;
static_assert(WS_END2 <= WS_MERGED, "MoE overlay must not reach the merged buffer");

__device__ __forceinline__ Params make_params(const KArgs& a) {
    Params p;
    p.x = a.in[0]; p.c = a.in[1]; p.w_ada = a.in[2]; p.b_ada = a.in[3]; p.g_norm1 = a.in[4]; p.w_in = a.in[5]; p.b_forget = a.in[6]; p.g_q_mla = a.in[7];
    p.w_q_up = a.in[8]; p.g_kv_mla = a.in[9]; p.w_kv_up = a.in[10]; p.sinks = a.in[11]; p.w_out = a.in[12]; p.g_norm2 = a.in[13]; p.w_router = a.in[14];
    p.b_router = a.in[15]; p.w_gate = a.in[16]; p.w_up = a.in[17]; p.w_down = a.in[18]; p.g_final = a.in[19];
    p.xo = a.xo; char* ws = a.ws;
    p.ctl = (unsigned*)(ws + WS_CTL); p.mod = (float*)(ws + WS_MOD); p.WinT = (bf16_t*)(ws + WS_WIN); p.WoutT = (bf16_t*)(ws + WS_WOUT);
    p.WqT = (bf16_t*)(ws + WS_WQ); p.WkvT = (bf16_t*)(ws + WS_WKV); p.WguT = (bf16_t*)(ws + WS_WGU); p.WdT = (bf16_t*)(ws + WS_WD);
    p.ropetab = (float*)(ws + WS_ROPE); p.rq = (float*)(ws + WS_RQ); p.rkv = (float*)(ws + WS_RKV); p.cbF = (float*)(ws + WS_CBF); p.kidx = (bf16_t*)(ws + WS_KIDX);
    p.mask = (uint32_t*)(ws + WS_MASK); p.list = (int*)(ws + WS_LIST); p.rw = (float*)(ws + WS_RW); p.wl = (float*)(ws + WS_WL); p.h = (bf16_t*)(ws + WS_H);
    p.proj = (bf16_t*)(ws + WS_PROJ); p.qm = (bf16_t*)(ws + WS_QM); p.km = (bf16_t*)(ws + WS_KM); p.vm = (bf16_t*)(ws + WS_VM);
    p.merged = (bf16_t*)(ws + WS_MERGED); p.xb = (bf16_t*)(ws + WS_XB); p.hid = (bf16_t*)(ws + WS_HID); p.ys = (bf16_t*)(ws + WS_YS);
    return p;
}
template <int PH>
__device__ __forceinline__ void phase(int l, unsigned char* smem, int wid, int qslot = 0) {
    typedef const __attribute__((address_space(4))) KArgs* KA4;
    KA4 ka = (KA4)__builtin_amdgcn_kernarg_segment_ptr();
    asm volatile("" : "+s"(ka));
    KArgs a;
#pragma unroll
    for (int i = 0; i < 20; ++i) a.in[i] = ka->in[i];
    a.xo = ka->xo; a.ws = ka->ws;
    Params p = make_params(a); p.wid = wid; p.qslot = qslot; p.qslot_host = 0;
    run_phase<PH>(p, l, smem);
}
__global__ void __launch_bounds__(NTHREADS, 2) fwd(KArgs args) {
    extern __shared__ __attribute__((aligned(16))) unsigned char smem[];
    volatile LAS unsigned* st = (volatile LAS unsigned*)(smem + LDS_BYTES - 16);
    const int wid = __builtin_amdgcn_readfirstlane(threadIdx.x >> 6);
    if (xb_leader(wid)) { st[0] = 0u; st[1] = 0u; st[2] = 0u; st[3] = 0u; }
    __syncthreads();
    XcdBarrier bar = xcd_barrier_post((unsigned*)(args.ws + WS_CTL) + CW_BAR, st, wid);
    phase<0>(0, smem, wid);  REP(0, 0);
    xcd_barrier(bar);
#define LAYER(l) do { \
        phase<1>(l, smem, wid);  if (l == 0) REP(1, l); xcd_barrier(bar); \
        phase<2>(l, smem, wid);  REP(2, l); xcd_barrier(bar); \
        phase<3>(l, smem, wid);  REP(3, l); xcd_barrier(bar); \
        phase<4>(l, smem, wid);  REP(4, l); phase<12>(l, smem, wid);  REP(12, l); phase<13>(l, smem, wid);  REP(13, l); xcd_barrier(bar); \
        phase<5>(l, smem, wid);  REP(5, l); xcd_barrier(bar); \
        phase<6>(l, smem, wid);  xcd_barrier(bar); \
        phase<7>(l, smem, wid);  REP(7, l); xcd_barrier(bar); \
        phase<8>(l, smem, wid);  REP(8, l); xcd_barrier(bar); \
        phase<9>(l, smem, wid);  REP(9, l); xcd_barrier(bar); } while (0)
    LAYER(0);
    LAYER(1);
#ifdef REP_BAR
    for (int rb = 0; rb < REP_BAR; ++rb) xcd_barrier(bar);
#endif
    phase<10>(1, smem, wid);
}
}

extern "C" void kernel_launch(void* const* d_in, const int* in_sizes, int n_in, void* d_out, int out_size, void* d_ws, size_t ws_size,
                              hipStream_t stream) {
    KArgs a{};
    for (int i = 0; i < 20; ++i) a.in[i] = (const float*)d_in[i];
    a.xo = (float*)d_out; a.ws = (char*)d_ws;
    if (WS_NEED > ws_size) return;

    static int grid = 0;
    if (!grid) {
        int dev = 0, cus = 0, per_cu = 0;
        (void)hipGetDevice(&dev);
        (void)hipDeviceGetAttribute(&cus, hipDeviceAttributeMultiprocessorCount, dev);
        (void)hipFuncSetAttribute((const void*)fwd, hipFuncAttributeMaxDynamicSharedMemorySize, LDS_BYTES);
        (void)hipOccupancyMaxActiveBlocksPerMultiprocessor(&per_cu, (const void*)fwd, NTHREADS, LDS_BYTES);
        grid = cus > 0 ? cus : 256;
    }
    (void)hipMemsetAsync(a.ws + WS_CTL, 0, (size_t)CW_WORDS * 4, stream);
    fwd<<<dim3(grid), dim3(NTHREADS), LDS_BYTES, stream>>>(a);
}
```

```cpp
#include <hip/hip_runtime.h>
#include <stdint.h>
#define XB_TMO      128
#define XB_XCNT(j)  (256  + 64 * (j))
#define XB_XSUB(j)  (1280 + 64 * (j))
#define XB_XGEN(j)  (2304 + 64 * (j))
#define XB_TOP      3328
#define XB_TOPGEN   3392
#define XCD_BAR_WORDS 3456
#define XB_SPIN_CAP (1u << 20)
#define LAS __attribute__((address_space(3)))

__device__ __forceinline__ unsigned xb_ld(unsigned* p)              { return __hip_atomic_load(p, __ATOMIC_RELAXED, __HIP_MEMORY_SCOPE_AGENT); }
__device__ __forceinline__ unsigned xb_add(unsigned* p, unsigned v) { return __hip_atomic_fetch_add(p, v, __ATOMIC_RELAXED, __HIP_MEMORY_SCOPE_AGENT); }
__device__ __forceinline__ unsigned xb_xcc_id() { return (unsigned)__builtin_amdgcn_s_getreg((3 << 11) | 20) & 0xFu; }
#define XB_SPIN(cond, bar) do { unsigned _sp = 0; while (cond) { __builtin_amdgcn_s_sleep(1); \
    if ((++_sp & 255u) == 0u) { if (xb_ld(&(bar)[XB_TMO])) break; if (_sp > XB_SPIN_CAP) { atomicAdd(&(bar)[XB_TMO], 1u); break; } } } } while (0)

struct XcdBarrier { unsigned* bar; unsigned x; volatile LAS unsigned* st; int wid; };
__device__ __forceinline__ bool xb_leader(int wid) { return wid == 0 && __builtin_amdgcn_mbcnt_hi(~0u, __builtin_amdgcn_mbcnt_lo(~0u, 0u)) == 0u; }

__device__ __forceinline__ XcdBarrier xcd_barrier_post(unsigned* bar, volatile LAS unsigned* st, int wid) {
    XcdBarrier b; b.bar = bar; b.x = xb_xcc_id(); b.st = st; b.wid = wid;
    if (xb_leader(wid)) (void)xb_add(&bar[XB_XCNT(b.x)], 1u);
    return b;
}
__device__ __forceinline__ void xcd_barrier_complete(unsigned* bar, unsigned x, unsigned& nloc, unsigned& nx) {
    const unsigned G = gridDim.x * gridDim.y * gridDim.z;
    unsigned sum, cnt, mine, sp = 0u;
    for (;;) {
        sum = 0u; cnt = 0u; mine = 0u;
#pragma unroll
        for (unsigned j = 0; j < 16; ++j) { const unsigned c = xb_ld(&bar[XB_XCNT(j)]); sum += c; cnt += (c > 0u) ? 1u : 0u; mine = (j == x) ? c : mine; }
        if (sum == G) break;
        __builtin_amdgcn_s_sleep(1);
        if ((++sp & 255u) == 0u) { if (xb_ld(&bar[XB_TMO])) break; if (sp > XB_SPIN_CAP) { atomicAdd(&bar[XB_TMO], 1u); break; } }
    }
    nloc = mine > 0u ? mine : 1u; nx = cnt > 0u ? cnt : 1u;
}
__device__ __forceinline__ void xcd_barrier(const XcdBarrier& b) {
    asm volatile("s_waitcnt vmcnt(0)" ::: "memory");
    __syncthreads();
    if (xb_leader(b.wid)) {
        unsigned* bar = b.bar;
        __builtin_amdgcn_s_waitcnt(0);
        unsigned nloc = b.st[0], nx = b.st[1];
        if (nloc == 0u) { xcd_barrier_complete(bar, b.x, nloc, nx); b.st[0] = nloc; b.st[1] = nx; }
        const unsigned old = xb_add(&bar[XB_XSUB(b.x)], 1u);
        const unsigned gen = old / nloc;
        if (old + 1u == (gen + 1u) * nloc) {
            __builtin_amdgcn_fence(__ATOMIC_RELEASE, "agent");
            asm volatile("s_waitcnt vmcnt(0)" ::: "memory");
            const unsigned og = xb_add(&bar[XB_TOP], 1u);
            const unsigned tg = og / nx;
            if (og + 1u == (tg + 1u) * nx) xb_add(&bar[XB_TOPGEN], 1u);
            else XB_SPIN(xb_ld(&bar[XB_TOPGEN]) == tg, bar);
            __builtin_amdgcn_fence(__ATOMIC_ACQUIRE, "agent");
            xb_add(&bar[XB_XGEN(b.x)], 1u);
            asm volatile("s_waitcnt vmcnt(0)" ::: "memory");
        } else {
            XB_SPIN(xb_ld(&bar[XB_XGEN(b.x)]) == gen, bar);
            __builtin_amdgcn_fence(__ATOMIC_ACQUIRE, "agent");
            asm volatile("s_waitcnt vmcnt(0)" ::: "memory");
        }
    }
    __syncthreads();
}

#define LAS3 __attribute__((address_space(3)))
namespace {
typedef unsigned short bf16_t;
typedef short bf16x8 __attribute__((ext_vector_type(8)));
typedef short bf16x4 __attribute__((ext_vector_type(4)));
typedef float f32x4 __attribute__((ext_vector_type(4)));
typedef float f32x2 __attribute__((ext_vector_type(2)));
typedef unsigned u32x4 __attribute__((ext_vector_type(4)));
typedef unsigned u32x2 __attribute__((ext_vector_type(2)));

constexpr int D = 1024, NB = 32, S = 2048, T = NB * S, NIN = 2380, NP = 2560, NMOD = 6144;
constexpr int OFF_AQ = 0, OFF_AK = 256, OFF_AV = 512, OFF_AF = 768, OFF_BCQ = 772, OFF_BCKV = 1028, OFF_BKR = 1156,
              OFF_CQ = 1188, OFF_CK = 1444, OFF_CV = 1572, OFF_DQ = 1700, OFF_DK = 1956, OFF_DV = 2020,
              OFF_DQI = 2084, OFF_DKI = 2340, OFF_DWI = 2372;
constexpr int PC_AQ = 0, PC_AK = 256, PC_AV = 512, PC_BCQ = 768, PC_BCKV = 1024, PC_BKR = 1152, PC_CQ = 1184, PC_CK = 1440, PC_CV = 1568,
              PC_DQ = 1696, PC_DK = 1952, PC_DV = 2016, PC_DQI = 2080, PC_DKI = 2336, PC_DWI = 2368, PC_AF = 2376;
constexpr float EPS = 1e-6f;
constexpr float LOG2E = 1.4426950408889634f;
constexpr int ECAP = T;
constexpr int HIDROWS = 2 * T + 16 * 256;

__host__ __device__ __forceinline__ int orig_col(int n) { return n < 768 ? n : (n < 2376 ? n + 4 : (n < 2380 ? n - 1608 : -1)); }
__device__ __forceinline__ int opaque_tid(int wid) {
    int t = wid * 64 + (int)__builtin_amdgcn_mbcnt_hi(~0u, __builtin_amdgcn_mbcnt_lo(~0u, 0u));
    asm volatile("" : "+v"(t)); return t; }
__device__ __forceinline__ float bf2f(bf16_t v) { return __uint_as_float((unsigned)v << 16); }
__device__ __forceinline__ bf16_t f2bf(float f) { unsigned u = __float_as_uint(f); u += 0x7FFFu + ((u >> 16) & 1u); return (bf16_t)(u >> 16); }
typedef __bf16 bf16x2_native __attribute__((ext_vector_type(2)));
__device__ __forceinline__ unsigned cvt_pk_bf16(float lo, float hi) { const f32x2 v = {lo, hi}; return __builtin_bit_cast(unsigned, __builtin_convertvector(v, bf16x2_native)); }
__device__ __forceinline__ float bflo(unsigned w) { return __uint_as_float(w << 16); }
__device__ __forceinline__ float bfhi(unsigned w) { return __uint_as_float(w & 0xFFFF0000u); }
__device__ __forceinline__ float wave_sum(float v) {
#pragma unroll
    for (int o = 32; o > 0; o >>= 1) v += __shfl_xor(v, o);
    return v;
}
__device__ __forceinline__ float xor32_max(float x) {
    float a = x, b = x;
    asm volatile("s_nop 1\n\tv_permlane32_swap_b32 %0, %1\n\ts_nop 1" : "+v"(a), "+v"(b));
    return fmaxf(a, b);
}
__device__ __forceinline__ float xor16_max(float x) {
    float a = x, b = x;
    asm volatile("s_nop 1\n\tv_permlane16_swap_b32 %0, %1\n\ts_nop 1" : "+v"(a), "+v"(b));
    return fmaxf(a, b);
}
__device__ __forceinline__ float xor16_sum(float x) {
    float a = x, b = x;
    asm volatile("s_nop 1\n\tv_permlane16_swap_b32 %0, %1\n\ts_nop 1" : "+v"(a), "+v"(b));
    return a + b;
}
__device__ __forceinline__ int wave_reduce_add(int v) {
    v += __builtin_amdgcn_update_dpp(0, v, 0xB1, 0xF, 0xF, true);
    v += __builtin_amdgcn_update_dpp(0, v, 0x4E, 0xF, 0xF, true);
    v += __builtin_amdgcn_update_dpp(0, v, 0x141, 0xF, 0xF, true);
    v += __builtin_amdgcn_update_dpp(0, v, 0x140, 0xF, 0xF, true);
    return __builtin_amdgcn_readlane(v, 0) + __builtin_amdgcn_readlane(v, 16) + __builtin_amdgcn_readlane(v, 32) + __builtin_amdgcn_readlane(v, 48);
}
}

namespace pg8 {
#define PG8_LAS __attribute__((address_space(3)))
constexpr int BM = 256, BK = 64, HALF = 128, HTB = HALF * BK * 2, STAGE_BYTES = 8 * HTB, NXCD = 8, WGM = 8;

__host__ __device__ __forceinline__ int lds_byte(int r, int c) { const int st = (r >> 4) * 2 + (c >> 5), rr = r & 15, cc = c & 31, ob = rr * 64 + cc * 2; return st * 1024 + (ob ^ (((ob >> 9) & 1) << 5)); }
__host__ __device__ __forceinline__ void stage_rc(int b, int& R, int& C) { const int st = b / 1024, sb = b % 1024, swz = sb ^ (((sb >> 9) & 1) << 5); R = (st >> 1) * 16 + swz / 64; C = (st & 1) * 32 + (swz % 64) / 2; }
__host__ __device__ __forceinline__ int perm32(int rho) { const int n = rho >> 4, i = rho & 15; return 8 * (i >> 2) + 4 * n + (i & 3); }

struct Unit { int pm, pn, e, mt; };
struct Gemm { const bf16_t* A; const bf16_t* Bt; int K; int lda; size_t bstride; };

struct StaticOrder {
    int nM, nN, nwg, G, c;
    __host__ __device__ void init(int M, int N, int G_, int c_) { nM = M / BM; nN = N / BM; nwg = nM * nN; G = G_; c = c_; }
    __host__ __device__ bool next(int i, Unit& u) const {
        const long L = (long)i * G + c; if (L >= nwg) return false;
        int wgid = (int)L; { const int q = nwg / NXCD, r = nwg % NXCD, xcd = wgid % NXCD, off = wgid / NXCD; wgid = (xcd < r ? xcd * (q + 1) : r * (q + 1) + (xcd - r) * q) + off; }
        const int nig = WGM * nN, gid = wgid / nig, fm = gid * WGM, gsz = (nM - fm) < WGM ? (nM - fm) : WGM;
        u.pm = fm + ((wgid % nig) % gsz); u.pn = (wgid % nig) / gsz; u.e = 0; u.mt = 0; return true;
    }
    __device__ __forceinline__ int arow(const Unit& u, int r) const { return u.pm * BM + r; }
};

template <class Epi, class Sched, bool GATHER>
__device__ __forceinline__ void gemm_phase(PG8_LAS unsigned char* lds, const Gemm g, const Sched& S, const Epi& E, int wave_index) {
    const int tid = opaque_tid(wave_index), wid = __builtin_amdgcn_readfirstlane(tid >> 6), lane = tid & 63, wr = wid >> 2, wc = wid & 3, fr = lane & 15, fq = lane >> 4;
    int K_ = g.K; asm volatile("" : "+s"(K_));
    const int K = K_, nt = K / BK, lda = g.lda;
    int Ra[2], Ca[2]; unsigned voffB[2], voffA[2];
#pragma unroll
    for (int i = 0; i < 2; ++i) { int R, C; stage_rc(tid * 16 + i * 8192, R, C); const int Rb = Epi::PERM ? ((R & ~31) + perm32(R & 31)) : R;
        Ra[i] = R; Ca[i] = C; voffB[i] = (unsigned)(Rb * K + C) * 2u; voffA[i] = (unsigned)(R * lda + C) * 2u; }
    const size_t kstep = (size_t)(BK * 2);
    const size_t hstepB = (size_t)HALF * K * 2;
    const size_t tstepB = 2 * hstepB;
    const size_t hstepA = (size_t)HALF * lda * 2, tstepA = 2 * hstepA;
    const unsigned ldsw = (unsigned)wid * 1024u;
    const int aoff = lds_byte(wr * 64 + fr, fq * 8), boff = lds_byte(wc * 32 + fr, fq * 8);
#define PG8_SA(b, h) (((b) * 2 + (h)) * HTB)
#define PG8_SB(b, h) ((4 + (b) * 2 + (h)) * HTB)
#define PG8_STAGE(bufoff, gbase, voff) do { _Pragma("unroll") for (int _i = 0; _i < 2; ++_i) \
        __builtin_amdgcn_global_load_lds((const unsigned*)((const char*)(gbase) + (voff)[_i]), (PG8_LAS unsigned*)(lds + (bufoff) + ldsw + _i * 8192), 16, 0, 0); } while (0)
#define PG8_STAGEA(bufoff, kptr, VO, h) do { _Pragma("unroll") for (int _i = 0; _i < 2; ++_i) { \
        const char* _src; if constexpr (GATHER) _src = (const char*)(kptr) + (VO)[_i][h]; else _src = (const char*)(kptr) + (size_t)(h) * hstepA + voffA[_i]; \
        __builtin_amdgcn_global_load_lds((const unsigned*)_src, (PG8_LAS unsigned*)(lds + (bufoff) + ldsw + _i * 8192), 16, 0, 0); } } while (0)
#define PG8_LDA(dst, b, h) do { _Pragma("unroll") for (int m = 0; m < 4; ++m) _Pragma("unroll") for (int k = 0; k < 2; ++k) dst[m][k] = *(const PG8_LAS bf16x8*)(lds + PG8_SA(b, h) + aoff + m * 2048 + k * 1024); } while (0)
#define PG8_LDB(dst, b, h) do { _Pragma("unroll") for (int n = 0; n < 2; ++n) _Pragma("unroll") for (int k = 0; k < 2; ++k) dst[n][k] = *(const PG8_LAS bf16x8*)(lds + PG8_SB(b, h) + boff + n * 2048 + k * 1024); } while (0)
#define PG8_MMA(ai, bj, At, Bt) do { __builtin_amdgcn_s_setprio(1); _Pragma("unroll") for (int m = 0; m < 4; ++m) _Pragma("unroll") for (int n = 0; n < 2; ++n) _Pragma("unroll") for (int k = 0; k < 2; ++k) \
        acc[ai][bj][m][n] = __builtin_amdgcn_mfma_f32_16x16x32_bf16(Bt[n][k], At[m][k], acc[ai][bj][m][n], 0, 0, 0); __builtin_amdgcn_s_setprio(0); } while (0)
#define PG8_WAIT_V(n) asm volatile("s_waitcnt vmcnt(" #n ")" ::: "memory")
#define PG8_WAIT_L(n) asm volatile("s_waitcnt lgkmcnt(" #n ")" ::: "memory")
#define PG8_BAR __builtin_amdgcn_s_barrier()
#define PG8_SCHED __builtin_amdgcn_sched_barrier(0)
#define PG8_SETV(V, u) do { _Pragma("unroll") for (int _i = 0; _i < 2; ++_i) _Pragma("unroll") for (int _h = 0; _h < 2; ++_h) { \
        const int _row = GATHER ? S.arow(u, _h * HALF + Ra[_i]) : ((u).pm * BM + _h * HALF + Ra[_i]); V[_i][_h] = (unsigned)(((size_t)_row * lda + Ca[_i]) * 2); } } while (0)
    Unit cur, nxt; int ui = 0;
    if (!S.next(0, cur)) return;
    f32x4 acc[2][2][4][2];
#pragma unroll
    for (int a = 0; a < 2; ++a)
#pragma unroll
        for (int b = 0; b < 2; ++b)
#pragma unroll
            for (int m = 0; m < 4; ++m)
#pragma unroll
                for (int n = 0; n < 2; ++n) acc[a][b][m][n] = (f32x4){0.f, 0.f, 0.f, 0.f};
    bf16x8 At[4][2], B0[2][2], B1[2][2];
    unsigned vA[2][2], vN[2][2];
    if constexpr (GATHER) { PG8_SETV(vA, cur); }
    const char* cA = (const char*)g.A + (GATHER ? (size_t)0 : (size_t)cur.pm * tstepA);
    const char* cB = (const char*)g.Bt + ((size_t)cur.e * g.bstride) * 2 + (size_t)cur.pn * tstepB;
    PG8_STAGE(PG8_SB(0, 0), cB, voffB); PG8_STAGE(PG8_SB(0, 1), cB + hstepB, voffB); PG8_STAGEA(PG8_SA(0, 0), cA, vA, 0); PG8_STAGEA(PG8_SA(0, 1), cA, vA, 1);
    if (wr == 1) PG8_BAR;
    PG8_WAIT_V(2); PG8_BAR;
    PG8_STAGE(PG8_SB(1, 0), cB + kstep, voffB); PG8_STAGEA(PG8_SA(1, 0), cA + kstep, vA, 0); PG8_STAGE(PG8_SB(1, 1), cB + hstepB + kstep, voffB);
    PG8_WAIT_V(6); PG8_BAR;
    for (;;) {
        const bool has_next = S.next(ui + 1, nxt);
        if constexpr (GATHER) { if (has_next) { PG8_SETV(vN, nxt); }
        else {
#pragma unroll
            for (int _i = 0; _i < 2; ++_i)
#pragma unroll
                for (int _h = 0; _h < 2; ++_h) vN[_i][_h] = vA[_i][_h];
        } }
        const char* nA = (!GATHER && has_next) ? (const char*)g.A + (size_t)nxt.pm * tstepA : cA;
        const char* nB = has_next ? (const char*)g.Bt + ((size_t)nxt.e * g.bstride) * 2 + (size_t)nxt.pn * tstepB : cB;
#pragma unroll 1
        for (int t = 0; t < nt; t += 2) {
            const bool last = (t == nt - 2);
            const char* a1 = cA + (size_t)(t + 1) * kstep;
            const char* a2 = last ? nA : cA + (size_t)(t + 2) * kstep; const char* b2 = last ? nB : cB + (size_t)(t + 2) * kstep;
            const char* a3 = a2 + kstep; const char* b3 = b2 + kstep;
            unsigned v2[2][2];
            if constexpr (GATHER) {
#pragma unroll
            for (int _i = 0; _i < 2; ++_i)
#pragma unroll
                for (int _h = 0; _h < 2; ++_h) v2[_i][_h] = last ? vN[_i][_h] : vA[_i][_h];
            }
            PG8_LDB(B0, 0, 0); PG8_LDB(B1, 0, 1); PG8_SCHED; PG8_LDA(At, 0, 0); PG8_STAGEA(PG8_SA(1, 1), a1, vA, 1);
            PG8_WAIT_V(8); PG8_WAIT_L(0); PG8_BAR; PG8_MMA(0, 0, At, B0); PG8_MMA(0, 1, At, B1); PG8_BAR; PG8_SCHED;
            PG8_LDA(At, 0, 1); PG8_STAGE(PG8_SB(0, 0), b2, voffB); PG8_STAGE(PG8_SB(0, 1), b2 + hstepB, voffB); PG8_STAGEA(PG8_SA(0, 0), a2, v2, 0);
            PG8_WAIT_V(8); PG8_WAIT_L(0); PG8_BAR; PG8_MMA(1, 0, At, B0); PG8_MMA(1, 1, At, B1); PG8_BAR; PG8_SCHED;
            PG8_LDB(B0, 1, 0); PG8_LDB(B1, 1, 1); PG8_SCHED; PG8_LDA(At, 1, 0); PG8_STAGEA(PG8_SA(0, 1), a2, v2, 1);
            PG8_WAIT_V(8); PG8_WAIT_L(0); PG8_BAR; PG8_MMA(0, 0, At, B0); PG8_MMA(0, 1, At, B1); PG8_BAR; PG8_SCHED;
            PG8_LDA(At, 1, 1); PG8_STAGE(PG8_SB(1, 0), b3, voffB); PG8_STAGE(PG8_SB(1, 1), b3 + hstepB, voffB); PG8_STAGEA(PG8_SA(1, 0), a3, v2, 0);
            PG8_WAIT_V(8); PG8_WAIT_L(0); PG8_BAR; PG8_MMA(1, 0, At, B0); PG8_MMA(1, 1, At, B1); PG8_BAR; PG8_SCHED;
        }
        if (wr == 0) PG8_BAR;
        E(acc, cur, wr, wc, fr, fq);
        if (!has_next) break;
#pragma unroll
        for (int a = 0; a < 2; ++a)
#pragma unroll
            for (int b = 0; b < 2; ++b)
#pragma unroll
                for (int m = 0; m < 4; ++m)
#pragma unroll
                    for (int n = 0; n < 2; ++n) acc[a][b][m][n] = (f32x4){0.f, 0.f, 0.f, 0.f};
        cur = nxt; cB = nB; cA = nA; ++ui;
        if constexpr (GATHER) {
#pragma unroll
        for (int _i = 0; _i < 2; ++_i)
#pragma unroll
            for (int _h = 0; _h < 2; ++_h) vA[_i][_h] = vN[_i][_h];
        }
        if (wr == 1) PG8_BAR;
    }
    PG8_WAIT_V(0);
    PG8_BAR;
#undef PG8_SA
#undef PG8_SB
#undef PG8_STAGE
#undef PG8_STAGEA
#undef PG8_LDA
#undef PG8_LDB
#undef PG8_MMA
#undef PG8_WAIT_V
#undef PG8_WAIT_L
#undef PG8_BAR
#undef PG8_SCHED
#undef PG8_SETV
}
}

namespace {
struct Params {
    const float *x, *c, *w_ada, *b_ada, *g_norm1, *w_in, *b_forget, *g_q_mla, *w_q_up, *g_kv_mla, *w_kv_up, *sinks, *w_out, *g_norm2,
                *w_router, *b_router, *w_gate, *w_up, *w_down, *g_final;
    float* xo;
    bf16_t* xb;
    unsigned* ctl;
    float* mod;
    bf16_t* WinT;
    bf16_t* WoutT;
    bf16_t* WqT;
    bf16_t* WkvT;
    bf16_t* WguT;
    bf16_t* WdT;
    float* ropetab;
    float* rq; float* rkv;
    float* cbF;
    bf16_t* kidx;
    uint32_t* mask;
    bf16_t* h;
    bf16_t* proj;
    bf16_t* qm; bf16_t* km; bf16_t* vm;
    bf16_t* merged;
    bf16_t* hid;
    bf16_t* ys;
    int* list;
    float* rw;
    float* wl;
    int wid;
    int qslot;
    int qslot_host;
};
constexpr int CW_BAR = 0;
constexpr int CW_CNT = 3584;
constexpr int CW_QA = 3648;
constexpr int CW_QD = 4288;
constexpr int CW_KN2 = 4992;
constexpr int CW_QN2 = CW_KN2 + 2 * NB * 4 * 32;
constexpr int CW_WORDS = CW_QN2 + 2 * NB * 4 * 8;
}

namespace {
constexpr long P0_B1 = 2l * NP * 128, P0_B2 = P0_B1 + 2l * 1024 * 128, P0_B3 = P0_B2 + 2l * 512 * 32, P0_B4 = P0_B3 + 2l * 512 * 16,
               P0_B5 = P0_B4 + 32l * 512 * 128, P0_B6 = P0_B5 + 32l * 1024 * 32;
__device__ __forceinline__ bf16_t* p0_fetch(const Params& p, long it, float (&v)[8]) {
    if (it < P0_B1) {
        const int l = (int)(it / (NP * 128)), r = (int)(it % (NP * 128)), n = r % NP, k0 = (r / NP) * 8, o = orig_col(n);
        const float* w = p.w_in + (size_t)l * D * NIN;
#pragma unroll
        for (int j = 0; j < 8; ++j) v[j] = o >= 0 ? w[(size_t)(k0 + j) * NIN + o] : 0.f;
        return p.WinT + ((size_t)l * NP + n) * D + k0;
    } else if (it < P0_B2) {
        const long s = it - P0_B1; const int l = (int)(s / (1024 * 128)), r = (int)(s % (1024 * 128)), n = r & 1023, k0 = (r >> 10) * 8;
        const float* w = p.w_out + (size_t)l * D * D;
#pragma unroll
        for (int j = 0; j < 8; ++j) v[j] = w[(size_t)(k0 + j) * D + n];
        return p.WoutT + ((size_t)l * D + n) * D + k0;
    } else if (it < P0_B3) {
        const long s = it - P0_B2; const int l = (int)(s / (512 * 32)), r = (int)(s % (512 * 32)), n = r & 511, k0 = (r >> 9) * 8;
        const float* w = p.w_q_up + (size_t)l * 256 * 384; const float* g = p.g_q_mla + l * 256;
#pragma unroll
        for (int j = 0; j < 8; ++j) v[j] = n < 384 ? g[k0 + j] * w[(size_t)(k0 + j) * 384 + n] : 0.f;
        return p.WqT + ((size_t)l * 512 + n) * 256 + k0;
    } else if (it < P0_B4) {
        const long s = it - P0_B3; const int l = (int)(s / (512 * 16)), r = (int)(s % (512 * 16)), n = r & 511, k0 = (r >> 9) * 8;
        const float* w = p.w_kv_up + (size_t)l * 128 * 512; const float* g = p.g_kv_mla + l * 128;
#pragma unroll
        for (int j = 0; j < 8; ++j) v[j] = g[k0 + j] * w[(size_t)(k0 + j) * 512 + n];
        return p.WkvT + ((size_t)l * 512 + n) * 128 + k0;
    } else if (it < P0_B5) {
        const long s = it - P0_B4; const int le = (int)(s >> 16), r = (int)(s & 65535), n = r & 511, k0 = (r >> 9) * 8;
        const int q = n >> 5, rr = n & 31, col = 16 * q + (rr & 15);
        const float* w = (rr < 16 ? p.w_gate : p.w_up) + (size_t)le * 1024 * 256;
#pragma unroll
        for (int j = 0; j < 8; ++j) v[j] = w[(size_t)(k0 + j) * 256 + col];
        return p.WguT + ((size_t)le * 512 + n) * 1024 + k0;
    } else {
        const long s = it - P0_B5; const int le = (int)(s >> 15), r = (int)(s & 32767), n = r & 1023, k0 = (r >> 10) * 8;
        const float* w = p.w_down + (size_t)le * 256 * 1024;
#pragma unroll
        for (int j = 0; j < 8; ++j) v[j] = w[(size_t)(k0 + j) * 1024 + n];
        return p.WdT + ((size_t)le * 1024 + n) * 256 + k0;
    }
}
__device__ __forceinline__ void p0_store(bf16_t* dst, const float (&v)[8]) {
    u32x4 w; w.x = cvt_pk_bf16(v[0], v[1]); w.y = cvt_pk_bf16(v[2], v[3]); w.z = cvt_pk_bf16(v[4], v[5]); w.w = cvt_pk_bf16(v[6], v[7]);
    *(u32x4*)dst = w;
}

__device__ __forceinline__ void phase_p0(const Params& p, char* lds) {
    const int tid = opaque_tid(p.wid), gtid = blockIdx.x * blockDim.x + tid, gthreads = gridDim.x * blockDim.x;
    for (long it0 = gtid; it0 < P0_B6; it0 += 4l * gthreads) {
        float va[8], vb[8], vc[8], vd[8];
        const bool hb = it0 + gthreads < P0_B6, hc = it0 + 2l * gthreads < P0_B6, hd = it0 + 3l * gthreads < P0_B6;
        bf16_t* da = p0_fetch(p, it0, va);
        bf16_t* db = hb ? p0_fetch(p, it0 + gthreads, vb) : da;
        bf16_t* dc = hc ? p0_fetch(p, it0 + 2l * gthreads, vc) : da;
        bf16_t* dd = hd ? p0_fetch(p, it0 + 3l * gthreads, vd) : da;
        p0_store(da, va);
        if (hb) p0_store(db, vb);
        if (hc) p0_store(dc, vc);
        if (hd) p0_store(dd, vd);
    }
    for (int it = gtid; it < 2048 * 16; it += gthreads) {
        const int pos = it >> 4, i = it & 15;
        const float inv = powf(10000.0f, -(float)i / 16.0f), ang = (float)pos * inv;
        p.ropetab[it * 2] = cosf(ang); p.ropetab[it * 2 + 1] = sinf(ang);
    }
    const int w = __builtin_amdgcn_readfirstlane(tid >> 6), lane = tid & 63;
    for (int u = blockIdx.x; u < 2 * (NMOD / 64); u += gridDim.x) {
        float* ca = (float*)lds;
        for (int i = tid; i < NB * 1024; i += 512) { const int bb = i >> 10, d = i & 1023; const float v = p.c[i]; ca[d * 32 + ((bb + 4 * (d & 7)) & 31)] = v / (1.f + __expf(-v)); }
        __syncthreads();
        const int l = u / (NMOD / 64), n0 = (u % (NMOD / 64)) * 64;
        const float* wp = p.w_ada + (size_t)l * 1024 * NMOD + n0 + lane;
        float acc[32];
#pragma unroll
        for (int j = 0; j < 32; ++j) acc[j] = 0.f;
        for (int d0 = 128 * w; d0 < 128 * w + 128; d0 += 16) {
            float wv[16];
#pragma unroll
            for (int q = 0; q < 16; ++q) wv[q] = wp[(size_t)(d0 + q) * NMOD];
#pragma unroll
            for (int q = 0; q < 16; ++q) {
                const int d = d0 + q;
#pragma unroll
                for (int i = 0; i < 8; ++i) {
                    const f32x4 cv = *(const f32x4*)(ca + d * 32 + (((i + (d & 7)) & 7) << 2));
                    acc[4 * i + 0] += cv[0] * wv[q]; acc[4 * i + 1] += cv[1] * wv[q]; acc[4 * i + 2] += cv[2] * wv[q]; acc[4 * i + 3] += cv[3] * wv[q];
                }
            }
        }
        __syncthreads();
        float* part = (float*)lds;
#pragma unroll
        for (int j = 0; j < 32; ++j) part[(w * 32 + j) * 64 + lane] = acc[j];
        __syncthreads();
        for (int o = tid; o < NB * 64; o += 512) {
            const int bb = o >> 6, col = o & 63;
            float sm = 0.f;
#pragma unroll
            for (int ww = 0; ww < 8; ++ww) sm += part[(ww * 32 + bb) * 64 + col];
            p.mod[((size_t)l * NB + bb) * NMOD + n0 + col] = sm + p.b_ada[l * NMOD + n0 + col];
        }
        __syncthreads();
    }
    __syncthreads();
}

template <int MODE>
__device__ __forceinline__ void phase_norm1(const Params& p, int l) {
#ifndef NORM_NT
#define NORM_NT 2
#endif
    constexpr int NT = NORM_NT;
    const int tid = opaque_tid(p.wid), w = tid >> 6, lane = tid & 63;
    const float* g = (MODE == 2) ? p.g_final : p.g_norm1 + l * D;
    const float* modl = p.mod + (size_t)(MODE == 2 ? 1 : l) * NB * NMOD;
    const float* modp = p.mod + (size_t)(MODE == 2 ? 1 : (l > 0 ? l - 1 : 0)) * NB * NMOD;
    f32x4 gg4[4];
#pragma unroll
    for (int k = 0; k < 4; ++k) gg4[k] = *(const f32x4*)(g + 4 * lane + 256 * k);
    for (int t0 = (blockIdx.x * 8 + w) * NT; t0 < T; t0 += gridDim.x * 8 * NT) {
        const int b0 = t0 >> 11;
        f32x4 sc4[4], sh4[4], gt4[4];
        if (MODE != 2) {
#pragma unroll
            for (int k = 0; k < 4; ++k) { sc4[k] = *(const f32x4*)(modl + (size_t)b0 * NMOD + 1024 + 4 * lane + 256 * k); sh4[k] = *(const f32x4*)(modl + (size_t)b0 * NMOD + 4 * lane + 256 * k); }
        }
        if (MODE >= 1) {
#pragma unroll
            for (int k = 0; k < 4; ++k) gt4[k] = *(const f32x4*)(modp + (size_t)b0 * NMOD + 5 * 1024 + 4 * lane + 256 * k);
        }
        f32x4 v[NT][4];
#pragma unroll
        for (int u = 0; u < NT; ++u)
#pragma unroll
            for (int k = 0; k < 4; ++k) {
                if (MODE == 0) v[u][k] = *(const f32x4*)(p.x + (size_t)(t0 + u) * D + 4 * lane + 256 * k);
                else { const u32x2 w2 = *(const u32x2*)(p.xb + (size_t)(t0 + u) * D + 4 * lane + 256 * k); v[u][k] = (f32x4){bflo(w2.x), bfhi(w2.x), bflo(w2.y), bfhi(w2.y)}; }
            }
        if (MODE >= 1) {
            u32x2 y0[NT][4], y1[NT][4];
#pragma unroll
            for (int u = 0; u < NT; ++u)
#pragma unroll
                for (int k = 0; k < 4; ++k) { const int col = 4 * lane + 256 * k;
                    y0[u][k] = *(const u32x2*)(p.ys + ((size_t)(t0 + u) * 2 + 0) * D + col); y1[u][k] = *(const u32x2*)(p.ys + ((size_t)(t0 + u) * 2 + 1) * D + col); }
#pragma unroll
            for (int u = 0; u < NT; ++u) {
                const int b = (t0 + u) >> 11;
#pragma unroll
                for (int k = 0; k < 4; ++k) {
                    const int col = 4 * lane + 256 * k;
                    const f32x4 gt = gt4[k];
                    v[u][k][0] += gt[0] * (bflo(y0[u][k].x) + bflo(y1[u][k].x)); v[u][k][1] += gt[1] * (bfhi(y0[u][k].x) + bfhi(y1[u][k].x));
                    v[u][k][2] += gt[2] * (bflo(y0[u][k].y) + bflo(y1[u][k].y)); v[u][k][3] += gt[3] * (bfhi(y0[u][k].y) + bfhi(y1[u][k].y));
                }
            }
        }
#pragma unroll
        for (int u = 0; u < NT; ++u) {
            const int t = t0 + u, b = t >> 11;
            float ss = 0.f;
#pragma unroll
            for (int k = 0; k < 4; ++k) ss += v[u][k][0] * v[u][k][0] + v[u][k][1] * v[u][k][1] + v[u][k][2] * v[u][k][2] + v[u][k][3] * v[u][k][3];
            ss = wave_sum(ss);
            const float r = rsqrtf(ss * (1.0f / D) + EPS);
#pragma unroll
            for (int k = 0; k < 4; ++k) {
                const int col = 4 * lane + 256 * k;
                f32x4 y = v[u][k] * r * gg4[k];
                if (MODE == 2) { *(f32x4*)(p.xo + (size_t)t * D + col) = y; }
                else {
                    if (MODE == 1) { u32x2 xw; xw.x = cvt_pk_bf16(v[u][k][0], v[u][k][1]); xw.y = cvt_pk_bf16(v[u][k][2], v[u][k][3]); *(u32x2*)(p.xb + (size_t)t * D + col) = xw; }
                    y = y * (1.f + sc4[k]) + sh4[k];
                    u32x2 o; o.x = cvt_pk_bf16(y[0], y[1]); o.y = cvt_pk_bf16(y[2], y[3]);
                    *(u32x2*)(p.h + (size_t)t * D + col) = o;
                }
            }
        }
    }
}
}

namespace {
using pg8::Unit;
struct EpiStoreBf16 {
    static constexpr bool PERM = true;
    bf16_t* O; int ldc;
    __device__ __forceinline__ void operator()(const f32x4 (&acc)[2][2][4][2], const Unit& u, int wr, int wc, int fr_, int fq_) const {
        int fr = fr_, fq = fq_; asm volatile("" : "+v"(fr), "+v"(fq));
        const int row0 = u.pm * 256 + wr * 64 + fr, col0 = u.pn * 256 + wc * 32 + 8 * fq;
#pragma unroll
        for (int ai = 0; ai < 2; ++ai)
#pragma unroll
            for (int m = 0; m < 4; ++m) { bf16_t* rowp = O + (size_t)(row0 + ai * 128 + m * 16) * ldc + col0;
#pragma unroll
                for (int bj = 0; bj < 2; ++bj) { const f32x4 v0 = acc[ai][bj][m][0], v1 = acc[ai][bj][m][1];
                    u32x4 w; w.x = cvt_pk_bf16(v0[0], v0[1]); w.y = cvt_pk_bf16(v0[2], v0[3]); w.z = cvt_pk_bf16(v1[0], v1[1]); w.w = cvt_pk_bf16(v1[2], v1[3]);
                    *(u32x4*)(rowp + bj * 128) = w; } }
    }
};
struct EpiResidual {
    static constexpr bool PERM = false;
    const float* xin32; bf16_t* xb; const float* gate;
    __device__ __forceinline__ void operator()(const f32x4 (&acc)[2][2][4][2], const Unit& u, int wr, int wc, int fr_, int fq_) const {
        int fr = fr_, fq = fq_; asm volatile("" : "+v"(fr), "+v"(fq));
        const int row0 = u.pm * 256 + wr * 64 + fr, col0 = u.pn * 256 + wc * 32 + 4 * fq;
        const int b = (u.pm * 256) >> 11;
        f32x4 gv[2][2];
#pragma unroll
        for (int bj = 0; bj < 2; ++bj)
#pragma unroll
            for (int n = 0; n < 2; ++n) gv[bj][n] = *(const f32x4*)(gate + (size_t)b * NMOD + col0 + bj * 128 + n * 16);
#pragma unroll
        for (int ai = 0; ai < 2; ++ai)
#pragma unroll
            for (int m = 0; m < 4; ++m) { const size_t ro = (size_t)(row0 + ai * 128 + m * 16) * D + col0;
#pragma unroll
                for (int bj = 0; bj < 2; ++bj)
#pragma unroll
                    for (int n = 0; n < 2; ++n) { const size_t o = ro + bj * 128 + n * 16;
                        f32x4 xv;
                        if (xin32) xv = *(const f32x4*)(xin32 + o);
                        else { const u32x2 w = *(const u32x2*)(xb + o); xv = (f32x4){bflo(w.x), bfhi(w.x), bflo(w.y), bfhi(w.y)}; }
                        const f32x4 r = xv + gv[bj][n] * acc[ai][bj][m][n];
                        u32x2 ow; ow.x = cvt_pk_bf16(r[0], r[1]); ow.y = cvt_pk_bf16(r[2], r[3]);
                        *(u32x2*)(xb + o) = ow; } }
    }
};
struct EpiMlaQ {
    static constexpr bool PERM = true;
    bf16_t* qm;
    __device__ __forceinline__ void operator()(const f32x4 (&acc)[2][2][4][2], const Unit& u, int wr, int wc, int fr_, int fq_) const {
        int fr = fr_, fq = fq_; asm volatile("" : "+v"(fr), "+v"(fq));
        const int row0 = u.pm * 256 + wr * 64 + fr;
#pragma unroll
        for (int bj = 0; bj < 2; ++bj) {
            const int col0 = u.pn * 256 + bj * 128 + wc * 32;
            if (col0 >= 384) continue;
#pragma unroll
            for (int ai = 0; ai < 2; ++ai)
#pragma unroll
                for (int m = 0; m < 4; ++m) { const f32x4 v0 = acc[ai][bj][m][0], v1 = acc[ai][bj][m][1];
                    u32x4 w; w.x = cvt_pk_bf16(v0[0], v0[1]); w.y = cvt_pk_bf16(v0[2], v0[3]); w.z = cvt_pk_bf16(v1[0], v1[1]); w.w = cvt_pk_bf16(v1[2], v1[3]);
                    *(u32x4*)(qm + (size_t)(row0 + ai * 128 + m * 16) * 384 + col0 + 8 * fq) = w; }
        }
    }
};
struct EpiMlaKV {
    static constexpr bool PERM = true;
    bf16_t* km; bf16_t* vm;
    __device__ __forceinline__ void operator()(const f32x4 (&acc)[2][2][4][2], const Unit& u, int wr, int wc, int fr_, int fq_) const {
        int fr = fr_, fq = fq_; asm volatile("" : "+v"(fr), "+v"(fq));
        const int row0 = u.pm * 256 + wr * 64 + fr;
#pragma unroll
        for (int bj = 0; bj < 2; ++bj) {
            const int head = u.pn * 2 + bj, wcol = wc * 32 + 8 * fq;
#pragma unroll
            for (int ai = 0; ai < 2; ++ai)
#pragma unroll
                for (int m = 0; m < 4; ++m) {
                    const int row = row0 + ai * 128 + m * 16;
                    const f32x4 v0 = acc[ai][bj][m][0], v1 = acc[ai][bj][m][1];
                    u32x4 w; w.x = cvt_pk_bf16(v0[0], v0[1]); w.y = cvt_pk_bf16(v0[2], v0[3]); w.z = cvt_pk_bf16(v1[0], v1[1]); w.w = cvt_pk_bf16(v1[2], v1[3]);
                    bf16_t* q = (wcol < 64) ? km + (size_t)row * 384 + head * 96 + wcol : vm + (size_t)row * 256 + head * 64 + (wcol - 64);
                    *(u32x4*)q = w;
                    asm volatile("" ::: "memory");
                }
        }
    }
};
struct EpiGateUp {
    static constexpr bool PERM = false;
    bf16_t* hid;
    __device__ __forceinline__ void operator()(const f32x4 (&acc)[2][2][4][2], const Unit& u, int wr, int wc, int fr_, int fq_) const {
        int fr = fr_, fq = fq_; asm volatile("" : "+v"(fr), "+v"(fq));
        const int row0 = u.pm * 256 + wr * 64 + fr;
#pragma unroll
        for (int ai = 0; ai < 2; ++ai)
#pragma unroll
            for (int m = 0; m < 4; ++m) { bf16_t* rowp = hid + (size_t)(row0 + ai * 128 + m * 16) * 256;
#pragma unroll
                for (int bj = 0; bj < 2; ++bj) { const f32x4 gt = acc[ai][bj][m][0], up = acc[ai][bj][m][1];
                    f32x4 o;
#pragma unroll
                    for (int j = 0; j < 4; ++j) o[j] = gt[j] / (1.f + __expf(-gt[j])) * up[j];
                    u32x2 w; w.x = cvt_pk_bf16(o[0], o[1]); w.y = cvt_pk_bf16(o[2], o[3]);
                    *(u32x2*)(rowp + 16 * (u.pn * 8 + bj * 4 + wc) + 4 * fq) = w; } }
    }
};
struct EpiDown {
    static constexpr bool PERM = true;
    bf16_t* ys; const int* list; const float* wl; const int* cnt;
    __device__ __forceinline__ void operator()(const f32x4 (&acc)[2][2][4][2], const Unit& u, int wr, int wc, int fr_, int fq_) const {
        int fr = fr_, fq = fq_; asm volatile("" : "+v"(fr), "+v"(fq));
        const int n = cnt[u.e]; const int* le = list + (size_t)u.e * ECAP; const float* we = wl + (size_t)u.e * ECAP;
        const int col0 = u.pn * 256 + wc * 32 + 8 * fq;
        int slot[8]; float w8[8];
#pragma unroll
        for (int q = 0; q < 8; ++q) { const int lr = u.mt * 256 + (q >> 2) * 128 + wr * 64 + (q & 3) * 16 + fr; slot[q] = lr < n ? le[lr] : -1; w8[q] = lr < n ? we[lr] : 0.f; }
#pragma unroll
        for (int ai = 0; ai < 2; ++ai)
#pragma unroll
            for (int m = 0; m < 4; ++m) {
                const int q = ai * 4 + m;
                if (slot[q] >= 0) {
                    bf16_t* rowp = ys + (size_t)slot[q] * D + col0;
#pragma unroll
                    for (int bj = 0; bj < 2; ++bj) { const f32x4 v0 = acc[ai][bj][m][0] * w8[q], v1 = acc[ai][bj][m][1] * w8[q];
                        u32x4 w; w.x = cvt_pk_bf16(v0[0], v0[1]); w.y = cvt_pk_bf16(v0[2], v0[3]); w.z = cvt_pk_bf16(v1[0], v1[1]); w.w = cvt_pk_bf16(v1[2], v1[3]);
                        *(u32x4*)(rowp + bj * 128) = w; }
                }
            }
    }
};
struct MoeOrder {
    int pre[17];
    int NT, G, c; const int* list; const int* cnt;
    __device__ __forceinline__ void init(const int* cnt_, const int* list_, int NT_, int G_, int c_) {
        cnt = cnt_; list = list_; NT = NT_; G = G_; c = c_; int a = 0;
#pragma unroll
        for (int e = 0; e < 16; ++e) { pre[e] = a; a += (cnt_[e] + 255) >> 8; }
        pre[16] = a;
    }
    __device__ __forceinline__ bool next(int i, Unit& u) const {
        const int L = i * G + c; if (L >= pre[16] * NT) return false;
        const int t = L / NT; int e = 0;
#pragma unroll
        for (int k = 1; k < 16; ++k) e += (t >= pre[k]) ? 1 : 0;
        int pe = 0;
#pragma unroll
        for (int k = 0; k < 16; ++k) pe = (k == e) ? pre[k] : pe;
        u.e = e; u.mt = t - pe; u.pm = t; u.pn = L - t * NT; return true;
    }
    __device__ __forceinline__ int arow(const Unit& u, int r) const { const int lr = u.mt * 256 + r; return lr < cnt[u.e] ? (list[(size_t)u.e * ECAP + lr] >> 1) : 0; }
};
}

namespace {
__device__ __forceinline__ void phase_prep(const Params& p, int l) {
    const int tid = opaque_tid(p.wid), w = tid >> 6, lane = tid & 63;
    const int gw = blockIdx.x * 8 + w, nw = gridDim.x * 8;
    for (int sq = gw; sq < NB * 4; sq += nw) {
        const int b = sq >> 2, hh = sq & 3; const float bias = p.b_forget[l * 4 + hh];
        float lf[32]; float run = 0.f;
#pragma unroll
        for (int j = 0; j < 32; ++j) {
            const float z = bf2f(p.proj[(size_t)(b * S + lane * 32 + j) * NP + PC_AF + hh]) + bias;
            run += fminf(z, 0.f) - log1pf(__expf(-fabsf(z)));
            lf[j] = run;
        }
        float incl = run;
#pragma unroll
        for (int o = 1; o < 64; o <<= 1) { const float t2 = __shfl_up(incl, o); if (lane >= o) incl += t2; }
        const float excl = incl - run;
#pragma unroll
        for (int j = 0; j < 32; ++j) p.cbF[(size_t)sq * S + lane * 32 + j] = -(excl + lf[j]) * LOG2E;
    }
    for (int c32 = gw; c32 < T / 32; c32 += nw) {
    float mxq = 0.f, mxk = 0.f;
#define PREP_LOAD(u, tt) do { const bf16_t* _row = p.proj + (size_t)(tt) * NP; \
        n_cq[u] = *(const u32x2*)(_row + PC_BCQ + 4 * lane); n_ck[u] = *(const unsigned*)(_row + PC_BCKV + 2 * lane); \
        n_aq[u] = *(const u32x2*)(_row + PC_AQ + 4 * lane); n_ak[u] = *(const u32x2*)(_row + PC_AK + 4 * lane); \
        n_ki[u] = *(const u32x4*)(_row + PC_DKI + 8 * (lane & 3)); n_kr[u] = _row[PC_BKR + (lane & 31)]; } while (0)
    u32x2 n_cq[4], n_aq[4], n_ak[4]; unsigned n_ck[4]; u32x4 n_ki[4]; bf16_t n_kr[4];
#pragma unroll
    for (int u = 0; u < 4; ++u) PREP_LOAD(u, c32 * 32 + u);
    for (int it = 0; it < 32; it += 4) {
        u32x2 c_cq[4], c_aq[4], c_ak[4]; unsigned c_ck[4]; u32x4 c_ki[4]; bf16_t c_kr[4];
#pragma unroll
        for (int u = 0; u < 4; ++u) { c_cq[u] = n_cq[u]; c_aq[u] = n_aq[u]; c_ak[u] = n_ak[u]; c_ck[u] = n_ck[u]; c_ki[u] = n_ki[u]; c_kr[u] = n_kr[u]; }
        if (it < 28) {
#pragma unroll
            for (int u = 0; u < 4; ++u) PREP_LOAD(u, c32 * 32 + it + 4 + u);
        }
#pragma unroll
        for (int u = 0; u < 4; ++u) {
        const int t = c32 * 32 + it + u;
        const u32x2 cq = c_cq[u], aq = c_aq[u], ak = c_ak[u]; const unsigned ck = c_ck[u]; const u32x4 ki = c_ki[u]; const bf16_t krb = c_kr[u];
        float s1 = bflo(cq.x) * bflo(cq.x) + bfhi(cq.x) * bfhi(cq.x) + bflo(cq.y) * bflo(cq.y) + bfhi(cq.y) * bfhi(cq.y);
        float s2 = bflo(ck) * bflo(ck) + bfhi(ck) * bfhi(ck);
        s1 = wave_sum(s1); s2 = wave_sum(s2);
        if (lane < 4) *(u32x4*)(p.kidx + (size_t)t * 32 + 8 * lane) = ki;
        {
            float nq = bflo(aq.x) * bflo(aq.x) + bfhi(aq.x) * bfhi(aq.x) + bflo(aq.y) * bflo(aq.y) + bfhi(aq.y) * bfhi(aq.y);
            float nk = bflo(ak.x) * bflo(ak.x) + bfhi(ak.x) * bfhi(ak.x) + bflo(ak.y) * bflo(ak.y) + bfhi(ak.y) * bfhi(ak.y);
#pragma unroll
            for (int o = 8; o > 0; o >>= 1) { nq += __shfl_xor(nq, o); nk += __shfl_xor(nk, o); }
            mxq = fmaxf(mxq, nq); mxk = fmaxf(mxk, nk);
        }
        const float kr = (lane < 32) ? bf2f(krb) : 0.f;
        const float kr2 = __shfl(kr, (lane + 16) & 63);
        {
            const float r1 = rsqrtf(s1 * (1.f / 256.f) + EPS), r2 = rsqrtf(s2 * (1.f / 128.f) + EPS);
            u32x2 o; o.x = cvt_pk_bf16(bflo(cq.x) * r1, bfhi(cq.x) * r1); o.y = cvt_pk_bf16(bflo(cq.y) * r1, bfhi(cq.y) * r1);
            *(u32x2*)(p.proj + (size_t)t * NP + PC_BCQ + 4 * lane) = o;
            *(unsigned*)(p.proj + (size_t)t * NP + PC_BCKV + 2 * lane) = cvt_pk_bf16(bflo(ck) * r2, bfhi(ck) * r2);
        }
        if (lane < 16) {
            const int pos = t & (S - 1);
            const float cs = p.ropetab[(pos * 16 + lane) * 2], sn = p.ropetab[(pos * 16 + lane) * 2 + 1];
            const bf16_t o1 = f2bf(kr * cs - kr2 * sn), o2 = f2bf(kr2 * cs + kr * sn);
            bf16_t* kmr = p.km + (size_t)t * 384;
#pragma unroll
            for (int hh = 0; hh < 4; ++hh) { kmr[hh * 96 + 64 + lane] = o1; kmr[hh * 96 + 80 + lane] = o2; }
        }
        }
    }
#undef PREP_LOAD
    if ((lane & 15) == 0) {
        const int t = c32 * 32, bb = t >> 11, pos = t & (S - 1), hh = lane >> 4;
        atomicMax(p.ctl + CW_KN2 + ((l * NB + bb) * 4 + hh) * 32 + (pos >> 6), __float_as_uint(mxk));
        atomicMax(p.ctl + CW_QN2 + ((l * NB + bb) * 4 + hh) * 8 + (pos >> 8), __float_as_uint(mxq));
    }
    }
}

__device__ __forceinline__ void phase_route(const Params& p, int l, char* lds) {
    const int tid = opaque_tid(p.wid), w = tid >> 6, lane = tid & 63;
    float* wrT = (float*)lds;
    int* lcnt = (int*)(lds + 65536);
    int* lbase = (int*)(lds + 65536 + 64);
    int* tsel = (int*)(lds + 65536 + 128);
    float* twt = (float*)(lds + 65536 + 128 + 2048);
    float* lgt = (float*)(lds + 65536 + 8192);
    for (int i = tid; i < 16 * 1024; i += 512) { const int e = i >> 10, d = i & 1023; wrT[i] = p.w_router[d * 16 + e]; }
    const float* g = p.g_norm2 + l * D;
    const float* modl = p.mod + (size_t)l * NB * NMOD;
    int* cnt = (int*)(p.ctl + CW_CNT) + l * 16 + 32 * p.qslot;
    int* list = p.list + (size_t)p.qslot * 16 * ECAP;
    for (int chunk = blockIdx.x; chunk < T / 256; chunk += gridDim.x) {
        if (tid < 16) lcnt[tid] = 0;
        __syncthreads();
        const int b = (chunk * 256) >> 11;
        f32x4 gs4[4], sh4[4];
#pragma unroll
        for (int k = 0; k < 4; ++k) { const int col = 4 * lane + 256 * k; const f32x4 gg = *(const f32x4*)(g + col);
            const f32x4 sc = *(const f32x4*)(modl + (size_t)b * NMOD + 4 * 1024 + col); gs4[k] = gg * (1.f + sc); sh4[k] = *(const f32x4*)(modl + (size_t)b * NMOD + 3 * 1024 + col); }
        const int eown = ((lane >> 5) & 1) * 8 + ((lane >> 4) & 1) * 4 + ((lane >> 3) & 1) * 2 + ((lane >> 2) & 1);
        u32x2 raw[2][4];
#pragma unroll
        for (int q = 0; q < 2; ++q)
#pragma unroll
            for (int k = 0; k < 4; ++k) raw[q][k] = *(const u32x2*)(p.xb + (size_t)(chunk * 256 + w * 32 + q) * D + 4 * lane + 256 * k);
        for (int it = 0; it < 32; it += 2) {
            const int li = w * 32 + it, t = chunk * 256 + li;
            f32x4 v[2][4];
#pragma unroll
            for (int q = 0; q < 2; ++q)
#pragma unroll
                for (int k = 0; k < 4; ++k) v[q][k] = (f32x4){bflo(raw[q][k].x), bfhi(raw[q][k].x), bflo(raw[q][k].y), bfhi(raw[q][k].y)};
            if (it < 30) {
#pragma unroll
                for (int q = 0; q < 2; ++q)
#pragma unroll
                    for (int k = 0; k < 4; ++k) raw[q][k] = *(const u32x2*)(p.xb + (size_t)(t + 2 + q) * D + 4 * lane + 256 * k);
            }
            float ss0 = 0.f, ss1 = 0.f;
#pragma unroll
            for (int k = 0; k < 4; ++k) { ss0 += v[0][k][0] * v[0][k][0] + v[0][k][1] * v[0][k][1] + v[0][k][2] * v[0][k][2] + v[0][k][3] * v[0][k][3];
                                          ss1 += v[1][k][0] * v[1][k][0] + v[1][k][1] * v[1][k][1] + v[1][k][2] * v[1][k][2] + v[1][k][3] * v[1][k][3]; }
            ss0 = wave_sum(ss0); ss1 = wave_sum(ss1);
            const float r0 = rsqrtf(ss0 * (1.0f / D) + EPS), r1 = rsqrtf(ss1 * (1.0f / D) + EPS);
            f32x2 lgp[16];
#pragma unroll
            for (int e = 0; e < 16; ++e) lgp[e] = (f32x2){0.f, 0.f};
#pragma unroll
            for (int k = 0; k < 4; ++k) {
                const int col = 4 * lane + 256 * k;
                const f32x4 y0 = v[0][k] * r0 * gs4[k] + sh4[k], y1 = v[1][k] * r1 * gs4[k] + sh4[k];
                u32x2 o0, o1; o0.x = cvt_pk_bf16(y0[0], y0[1]); o0.y = cvt_pk_bf16(y0[2], y0[3]); o1.x = cvt_pk_bf16(y1[0], y1[1]); o1.y = cvt_pk_bf16(y1[2], y1[3]);
                *(u32x2*)(p.h + (size_t)t * D + col) = o0; *(u32x2*)(p.h + (size_t)(t + 1) * D + col) = o1;
                const f32x2 yp0 = {y0[0], y1[0]}, yp1 = {y0[1], y1[1]}, yp2 = {y0[2], y1[2]}, yp3 = {y0[3], y1[3]};
#pragma unroll
                for (int e = 0; e < 16; ++e) { const f32x4 wv = *(const f32x4*)(wrT + e * 1024 + col);
                    lgp[e] = __builtin_elementwise_fma(yp0, (f32x2){wv[0], wv[0]}, lgp[e]); lgp[e] = __builtin_elementwise_fma(yp1, (f32x2){wv[1], wv[1]}, lgp[e]);
                    lgp[e] = __builtin_elementwise_fma(yp2, (f32x2){wv[2], wv[2]}, lgp[e]); lgp[e] = __builtin_elementwise_fma(yp3, (f32x2){wv[3], wv[3]}, lgp[e]); }
                asm volatile("" ::: "memory");
            }
#pragma unroll
            for (int q = 0; q < 2; ++q) {
                float lg[16];
#pragma unroll
                for (int e = 0; e < 16; ++e) lg[e] = lgp[e][q];
                float a8[8], a4[4], a2[2], a1;
                { const bool hi = (lane & 32) != 0;
#pragma unroll
                  for (int e = 0; e < 8; ++e) { const float send = hi ? lg[e] : lg[e + 8], keep = hi ? lg[e + 8] : lg[e]; a8[e] = keep + __shfl_xor(send, 32); } }
                { const bool hi = (lane & 16) != 0;
#pragma unroll
                  for (int e = 0; e < 4; ++e) { const float send = hi ? a8[e] : a8[e + 4], keep = hi ? a8[e + 4] : a8[e]; a4[e] = keep + __shfl_xor(send, 16); } }
                { const bool hi = (lane & 8) != 0;
#pragma unroll
                  for (int e = 0; e < 2; ++e) { const float send = hi ? a4[e] : a4[e + 2], keep = hi ? a4[e + 2] : a4[e]; a2[e] = keep + __shfl_xor(send, 8); } }
                { const bool hi = (lane & 4) != 0; const float send = hi ? a2[0] : a2[1], keep = hi ? a2[1] : a2[0]; a1 = keep + __shfl_xor(send, 4); }
                a1 += __shfl_xor(a1, 2); a1 += __shfl_xor(a1, 1);
                if ((lane & 3) == 0) lgt[(li + q) * 16 + eown] = a1;
            }
        }
        asm volatile("s_waitcnt lgkmcnt(0)" ::: "memory");
        __builtin_amdgcn_wave_barrier();
        if (lane < 32) {
            const int li = w * 32 + lane;
            float sc[16], bi[16];
#pragma unroll
            for (int e4 = 0; e4 < 4; ++e4) { const f32x4 a = *(const f32x4*)(lgt + li * 16 + 4 * e4);
#pragma unroll
                for (int j = 0; j < 4; ++j) { const float sg = 1.f / (1.f + expf(-a[j])); sc[4 * e4 + j] = sg; bi[4 * e4 + j] = sg + p.b_router[4 * e4 + j]; } }
            int bg = 0; float bgs = -INFINITY;
#pragma unroll
            for (int gi = 0; gi < 4; ++gi) {
                float m1 = -INFINITY, m2 = -INFINITY;
#pragma unroll
                for (int j = 0; j < 4; ++j) { const float vv = bi[gi * 4 + j]; if (vv > m1) { m2 = m1; m1 = vv; } else if (vv > m2) m2 = vv; }
                const float gs = m1 + m2; if (gs > bgs) { bgs = gs; bg = gi; }
            }
            float b4[4], s4[4];
#pragma unroll
            for (int j = 0; j < 4; ++j) { b4[j] = bi[j]; s4[j] = sc[j]; }
#pragma unroll
            for (int gi = 1; gi < 4; ++gi)
#pragma unroll
                for (int j = 0; j < 4; ++j) { b4[j] = (gi == bg) ? bi[gi * 4 + j] : b4[j]; s4[j] = (gi == bg) ? sc[gi * 4 + j] : s4[j]; }
            int i1 = 0; float v1 = -INFINITY;
#pragma unroll
            for (int j = 0; j < 4; ++j) { if (b4[j] > v1) { v1 = b4[j]; i1 = j; } }
            int i2 = 0; float v2 = -INFINITY;
#pragma unroll
            for (int j = 0; j < 4; ++j) { if (j != i1 && b4[j] > v2) { v2 = b4[j]; i2 = j; } }
            float w1 = 0.f, w2 = 0.f;
#pragma unroll
            for (int j = 0; j < 4; ++j) { w1 = (j == i1) ? s4[j] : w1; w2 = (j == i2) ? s4[j] : w2; }
            const int e1 = bg * 4 + i1, e2 = bg * 4 + i2; const float ws = w1 + w2;
            const int r1 = atomicAdd(&lcnt[e1], 1), r2 = atomicAdd(&lcnt[e2], 1);
            tsel[li * 2 + 0] = (e1 << 16) | r1; tsel[li * 2 + 1] = (e2 << 16) | r2;
            twt[li * 2 + 0] = w1 / ws; twt[li * 2 + 1] = w2 / ws;
        }
        __syncthreads();
        if (tid < 16) lbase[tid] = atomicAdd(&cnt[tid], lcnt[tid]);
        __syncthreads();
        { const int v = tsel[tid], e = v >> 16, rk = v & 0xFFFF; const size_t pos = (size_t)e * ECAP + lbase[e] + rk;
          list[pos] = (chunk * 256 + (tid >> 1)) * 2 + (tid & 1); p.wl[pos + (size_t)p.qslot * 16 * ECAP] = twt[tid]; }
        __syncthreads();
    }
}
}

#ifndef ATTN_VMASK
#define ATTN_VMASK 15
#endif
#ifndef REPK_VMASK
#define REPK_VMASK 15
#endif
namespace {
constexpr int AT_NS = 4;
constexpr int AT_SLOT = 21504;
constexpr int AT_K = 0;
constexpr int AT_V = 8192;
constexpr int AT_R = 16384;
constexpr int AT_C = 20480;
constexpr int AT_CTL = AT_NS * AT_SLOT;
constexpr int AT_MW = AT_CTL + 512;
constexpr int AT_LDS = AT_MW + 64 * 272;
constexpr float NEGBIG = -1.0e30f;

#define AT_TR(dst, a, off) asm volatile("ds_read_b64_tr_b16 %0, %1 offset:%2" : "=v"(dst) : "v"(a), "n"(off))
#define AT_TR2(c, dt) { const unsigned a_ = vaddr + (unsigned)((((dt) ^ swv)) << 5); AT_TR(vt[c][dt][0], a_, AT_V + (c) * 4096); AT_TR(vt[c][dt][1], a_, AT_V + (c) * 4096 + 2048); }
#define AT_TIE(n, c) asm volatile("s_waitcnt lgkmcnt(" #n ")" : "+v"(vt[c][0][0]), "+v"(vt[c][0][1]), "+v"(vt[c][1][0]), "+v"(vt[c][1][1]), \
                                                                  "+v"(vt[c][2][0]), "+v"(vt[c][2][1]), "+v"(vt[c][3][0]), "+v"(vt[c][3][1]))

#define AT_PIN(x) asm volatile("" : "+v"(x))
#define AT_BAR() do { __builtin_amdgcn_sched_barrier(0); __builtin_amdgcn_s_barrier(); asm volatile("" ::: "memory"); __builtin_amdgcn_sched_barrier(0); } while (0)

template <int VAR, bool FULL>
__device__ __forceinline__ void at_cinit(const LAS3 char* sb, const int j, const int q0, const int i, const int g, const float slope2, const LAS3 char* mwl, f32x4 (&s)[2][4], const int qa = 0, const int qb_ = 2) {
#pragma unroll
    for (int qt = 0; qt < 2; ++qt) if (qt >= qa && qt < qb_) {
        const int t = q0 + 16 * qt + i;
        const int dbase = 64 * j + 4 * g - t;
        const float sb2 = slope2 * ((VAR == 2) ? (float)dbase : (float)(64 * j + 4 * g));
#pragma unroll
        for (int mt = 0; mt < 4; ++mt) {
            f32x4 ini = {0.f, 0.f, 0.f, 0.f};
            if (VAR == 0) ini = *(const LAS3 f32x4*)(sb + AT_C + (16 * mt + 4 * g) * 4);
            u32x4 mw4 = {0u, 0u, 0u, 0u};
            if (VAR == 3) mw4 = *(const LAS3 u32x4*)(mwl + qt * (16 * 272) + mt * 64);
#pragma unroll
            for (int r = 0; r < 4; ++r) {
                const int c = 16 * mt + r;
                float v = ini[r];
                if (VAR >= 2) v = sb2 + slope2 * (float)c;
                if (VAR == 3) {
                    const int m = ((int)(mw4[r] << (31 - j))) >> 31;
                    v = __uint_as_float((__float_as_uint(v) & (unsigned)m) | (__float_as_uint(NEGBIG) & ~(unsigned)m));
                } else if (!FULL) {
                    bool ok;
                    if (VAR == 2) ok = (unsigned)(dbase + c + 127) < 128u;
                    else ok = (dbase + c) <= 0;
                    v = ok ? v : NEGBIG;
                }
                ini[r] = v;
            }
            s[qt][mt] = ini;
        }
    }
}
template <int VAR, int KC>
__device__ __forceinline__ void at_qk(const LAS3 char* sb, const int i, const int g, const int swk, const bf16x8 (&qf)[2][KC], f32x4 (&s)[2][4], const int qa = 0, const int qb_ = 2) {
    const LAS3 char* Kb = sb + AT_K;
#pragma unroll
    for (int mt = 0; mt < 4; ++mt) {
#pragma unroll
        for (int kc = 0; kc < 2; ++kc) {
            const bf16x8 kf = *(const LAS3 bf16x8*)(Kb + (mt * 16 + i) * 128 + (((kc * 4 + g) ^ swk) << 4));
#pragma unroll
            for (int qt = 0; qt < 2; ++qt) if (qt >= qa && qt < qb_) s[qt][mt] = __builtin_amdgcn_mfma_f32_16x16x32_bf16(kf, qf[qt][kc], s[qt][mt], 0, 0, 0);
        }
        if (VAR == 1) {
            const bf16x8 kf = *(const LAS3 bf16x8*)(sb + AT_R + (mt * 16 + i) * 64 + ((g ^ (swk & 3)) << 4));
#pragma unroll
            for (int qt = 0; qt < 2; ++qt) if (qt >= qa && qt < qb_) s[qt][mt] = __builtin_amdgcn_mfma_f32_16x16x32_bf16(kf, qf[qt][KC - 1], s[qt][mt], 0, 0, 0);
        }
    }
}
__device__ __forceinline__ void at_max(const f32x4 (&s)[2][4], float (&mx)[2]) {
#pragma unroll
    for (int qt = 0; qt < 2; ++qt) {
        float m = fmaxf(fmaxf(s[qt][0][0], s[qt][0][1]), fmaxf(s[qt][0][2], s[qt][0][3]));
#pragma unroll
        for (int mt = 1; mt < 4; ++mt) m = fmaxf(m, fmaxf(fmaxf(s[qt][mt][0], s[qt][mt][1]), fmaxf(s[qt][mt][2], s[qt][mt][3])));
        mx[qt] = xor32_max(xor16_max(m));
    }
}
__device__ __forceinline__ void at_max2(const f32x4 (&sa)[2][4], const f32x4 (&sb_)[2][4], float (&mx)[2]) {
#pragma unroll
    for (int qt = 0; qt < 2; ++qt) {
        float m = fmaxf(fmaxf(sa[qt][0][0], sa[qt][0][1]), fmaxf(sa[qt][0][2], sa[qt][0][3]));
        float n = fmaxf(fmaxf(sb_[qt][0][0], sb_[qt][0][1]), fmaxf(sb_[qt][0][2], sb_[qt][0][3]));
#pragma unroll
        for (int mt = 1; mt < 4; ++mt) { m = fmaxf(m, fmaxf(fmaxf(sa[qt][mt][0], sa[qt][mt][1]), fmaxf(sa[qt][mt][2], sa[qt][mt][3])));
                                         n = fmaxf(n, fmaxf(fmaxf(sb_[qt][mt][0], sb_[qt][mt][1]), fmaxf(sb_[qt][mt][2], sb_[qt][mt][3]))); }
        mx[qt] = xor32_max(xor16_max(fmaxf(m, n)));
    }
}
__device__ __forceinline__ void at_rescale(const float (&mx)[2], f32x4 (&o)[2][4], float (&mrow)[2], float (&lsum)[2]) {
    if (__any(mx[0] > mrow[0] || mx[1] > mrow[1])) {
#pragma unroll
        for (int qt = 0; qt < 2; ++qt) {
            const float mn = fmaxf(mrow[qt], mx[qt]), alpha = __builtin_amdgcn_exp2f(mrow[qt] - mn);
            mrow[qt] = mn; lsum[qt] *= alpha;
#pragma unroll
            for (int dt = 0; dt < 4; ++dt) o[qt][dt] = o[qt][dt] * alpha;
        }
    }
}
__device__ __forceinline__ void at_exp(const f32x4 (&s)[2][4], const float (&mrow)[2], float (&lsum)[2], bf16x8 (&pf)[2][2], const int qa = 0, const int qb_ = 2) {
#pragma unroll
    for (int qt = 0; qt < 2; ++qt) if (qt >= qa && qt < qb_) {
        const float mn = mrow[qt];
        const f32x4 mn4 = {mn, mn, mn, mn};
        f32x4 ps4 = {0.f, 0.f, 0.f, 0.f};
        float x[4][4];
#pragma unroll
        for (int mt = 0; mt < 4; ++mt) {
            const f32x4 d4 = s[qt][mt] - mn4;
            f32x4 e4;
#pragma unroll
            for (int r = 0; r < 4; ++r) { e4[r] = __builtin_amdgcn_exp2f(d4[r]); x[mt][r] = e4[r]; }
            ps4 += e4;
        }
        lsum[qt] += (ps4[0] + ps4[1]) + (ps4[2] + ps4[3]);
#pragma unroll
        for (int c = 0; c < 2; ++c) {
            u32x4 pk; pk.x = cvt_pk_bf16(x[2 * c][0], x[2 * c][1]); pk.y = cvt_pk_bf16(x[2 * c][2], x[2 * c][3]);
            pk.z = cvt_pk_bf16(x[2 * c + 1][0], x[2 * c + 1][1]); pk.w = cvt_pk_bf16(x[2 * c + 1][2], x[2 * c + 1][3]);
            pf[qt][c] = __builtin_bit_cast(bf16x8, pk);
        }
    }
}
__device__ __forceinline__ void at_vread(const unsigned vaddr, const int swv, u32x2 (&vt)[2][4][2]) {
    AT_TR2(0, 0) AT_TR2(0, 1) AT_TR2(0, 2) AT_TR2(0, 3) AT_TR2(1, 0) AT_TR2(1, 1) AT_TR2(1, 2) AT_TR2(1, 3)
}
__device__ __forceinline__ void at_pv(u32x2 (&vt)[2][4][2], const bf16x8 (&pf)[2][2], f32x4 (&o)[2][4]) {
    AT_TIE(8, 0);
#pragma unroll
    for (int dt = 0; dt < 4; ++dt) {
        const u32x4 vw = {vt[0][dt][0].x, vt[0][dt][0].y, vt[0][dt][1].x, vt[0][dt][1].y};
        const bf16x8 vf = __builtin_bit_cast(bf16x8, vw);
        o[0][dt] = __builtin_amdgcn_mfma_f32_16x16x32_bf16(vf, pf[0][0], o[0][dt], 0, 0, 0);
        o[1][dt] = __builtin_amdgcn_mfma_f32_16x16x32_bf16(vf, pf[1][0], o[1][dt], 0, 0, 0);
    }
    AT_TIE(0, 1);
#pragma unroll
    for (int dt = 0; dt < 4; ++dt) {
        const u32x4 vw = {vt[1][dt][0].x, vt[1][dt][0].y, vt[1][dt][1].x, vt[1][dt][1].y};
        const bf16x8 vf = __builtin_bit_cast(bf16x8, vw);
        o[0][dt] = __builtin_amdgcn_mfma_f32_16x16x32_bf16(vf, pf[0][1], o[0][dt], 0, 0, 0);
        o[1][dt] = __builtin_amdgcn_mfma_f32_16x16x32_bf16(vf, pf[1][1], o[1][dt], 0, 0, 0);
    }
}

template <int VAR>
__device__ __forceinline__ void attn_unit(const Params& p, int l, int b, int hx, int qb, LAS3 char* lds) {
    typedef LAS3 bf16x4 lds_bf16x4;
    constexpr int KC = (VAR == 1) ? 3 : 2;
    const int tid = opaque_tid(p.wid), w = __builtin_amdgcn_readfirstlane(tid >> 6), lane = tid & 63, i = lane & 15, g = lane >> 4;
    const bf16_t *Qp, *Kp, *Vp; int ldq, ldk, ldv, q0, j0, j1, ocol; float c1, slope2 = 0.f;
    if (VAR == 0) { Qp = p.proj + PC_AQ + hx * 64; Kp = p.proj + PC_AK + hx * 64; Vp = p.proj + PC_AV + hx * 64; ldq = ldk = ldv = NP;
                    q0 = qb * 256 + 32 * w; j0 = 0; j1 = 4 * qb + 3; ocol = hx * 64; c1 = 0.125f * LOG2E; }
    else if (VAR == 1) { Qp = p.qm + hx * 96; Kp = p.km + hx * 96; Vp = p.vm + hx * 64; ldq = 384; ldk = 384; ldv = 256;
                    q0 = qb * 256 + 32 * w; j0 = 0; j1 = 4 * qb + 3; ocol = 256 + hx * 64; c1 = 0.10206207261596577f * LOG2E; }
    else if (VAR == 2) { const int qh = hx * 2 + (w >> 2); Qp = p.proj + PC_CQ + qh * 64; Kp = p.proj + PC_CK + hx * 64; Vp = p.proj + PC_CV + hx * 64; ldq = ldk = ldv = NP;
                    q0 = qb * 128 + 32 * (w & 3); j0 = 2 * qb - 2 > 0 ? 2 * qb - 2 : 0; j1 = 2 * qb + 1; ocol = 512 + qh * 64; c1 = 0.125f * LOG2E;
                    slope2 = exp2f(-(float)(qh + 1)) * LOG2E; }
    else { const int hd = w >> 1; Qp = p.proj + PC_DQ + hd * 64; Kp = p.proj + PC_DK; Vp = p.proj + PC_DV; ldq = ldk = ldv = NP;
                    q0 = qb * 64 + 32 * (w & 1); j0 = 0; j1 = qb; ocol = 768 + hd * 64; c1 = 0.125f * LOG2E; slope2 = exp2f(-(float)(hd + 5)) * LOG2E; }
    const size_t tok0 = (size_t)b * S;
    if (VAR == 0 && qb > 0) {
        constexpr float FOX_DROP = 64.0f;
        const unsigned* kn2 = p.ctl + CW_KN2 + ((l * NB + b) * 4 + hx) * 32;
        const float* cbh = p.cbF + ((size_t)b * 4 + hx) * S;
        const float qn = c1 * sqrtf(__uint_as_float(p.ctl[CW_QN2 + ((l * NB + b) * 4 + hx) * 8 + qb]));
        float knu = 0.f;
        for (int jj = 4 * qb; jj < 4 * qb + 4; ++jj) knu = fmaxf(knu, __uint_as_float(kn2[jj]));
        const float lower = cbh[256 * qb] - qn * sqrtf(knu);
        const int jl = lane & 31;
        const bool keep = qn * sqrtf(__uint_as_float(kn2[jl])) + cbh[64 * jl + 63] - lower >= -FOX_DROP || jl >= 4 * qb;
        const unsigned long long kb = __ballot(keep) & 0xFFFFFFFFull;
        j0 = kb ? (int)__builtin_ctzll(kb) : 4 * qb;
    }
    bf16x8 qf[2][KC];
#pragma unroll
    for (int qt = 0; qt < 2; ++qt)
#pragma unroll
        for (int kc = 0; kc < KC; ++kc) qf[qt][kc] = *(const bf16x8*)(Qp + (tok0 + q0 + 16 * qt + i) * ldq + kc * 32 + 8 * g);
    if (VAR == 3) {
        const int r_ = tid >> 3, c8 = tid & 7;
        const u32x4* src = (const u32x4*)(p.mask + (tok0 + qb * 64 + r_) * 64 + c8 * 8);
        const u32x4 m0 = src[0], m1 = src[1];
        *(LAS3 u32x4*)(lds + AT_MW + r_ * 272 + c8 * 32) = m0; *(LAS3 u32x4*)(lds + AT_MW + r_ * 272 + c8 * 32 + 16) = m1;
        asm volatile("s_waitcnt lgkmcnt(0)" ::: "memory");
    }
    const LAS3 char* mwl = lds + AT_MW + (32 * (w & 1) + i) * 272 + 16 * g;
    const int drow = 8 * w + (lane >> 3), dch = lane & 7;
    const int ksc = dch ^ ((drow >> 1) & 7);
    const int vsc = ((((dch >> 1) ^ ((drow >> 1) & 3)) << 1) | (dch & 1));
    const int rrow = 16 * (w & 3) + (lane >> 2), rsc = (lane & 3) ^ ((rrow >> 1) & 3);
#ifndef ATTN_PIPE
#define ATTN_PIPE 0
#endif
    constexpr bool PIPE_ = ((ATTN_PIPE >> VAR) & 1) != 0;
    const bool extra = (VAR == 1 && w < 4) || (VAR == 0 && w == 0);
#define AT_DMA(j) do { LAS3 char* _sb = lds + ((j) & (AT_NS - 1)) * AT_SLOT; \
        __builtin_amdgcn_global_load_lds((const unsigned*)(Kp + (tok0 + 64 * (j) + drow) * ldk + ksc * 8), (LAS3 unsigned*)(_sb + AT_K + w * 1024), 16, 0, 0); \
        __builtin_amdgcn_global_load_lds((const unsigned*)(Vp + (tok0 + 64 * (j) + drow) * ldv + vsc * 8), (LAS3 unsigned*)(_sb + AT_V + w * 1024), 16, 0, 0); \
        if (VAR == 1 && w < 4) __builtin_amdgcn_global_load_lds((const unsigned*)(Kp + (tok0 + 64 * (j) + rrow) * ldk + 64 + rsc * 8), (LAS3 unsigned*)(_sb + AT_R + w * 1024), 16, 0, 0); \
        if (VAR == 0 && w == 0) __builtin_amdgcn_global_load_lds((const unsigned*)(p.cbF + ((size_t)b * 4 + hx) * S + 64 * (j) + lane), (LAS3 unsigned*)(_sb + AT_C), 4, 0, 0); \
    } while (0)
    AT_DMA(j0);
    if (j0 + 1 <= j1) AT_DMA(j0 + 1);
    if (PIPE_ && j0 + 2 <= j1) AT_DMA(j0 + 2);
    if (VAR == 1) {
#pragma unroll
        for (int qt = 0; qt < 2; ++qt) {
            const int pos = q0 + 16 * qt + i;
            const u32x4 mine = __builtin_bit_cast(u32x4, qf[qt][KC - 1]);
            u32x4 oth; oth.x = __shfl_xor(mine.x, 32); oth.y = __shfl_xor(mine.y, 32); oth.z = __shfl_xor(mine.z, 32); oth.w = __shfl_xor(mine.w, 32);
            const float* rt = p.ropetab + (size_t)(pos * 16 + (g & 1) * 8) * 2;
            const float sg = (g < 2) ? -1.f : 1.f;
            u32x4 res;
#pragma unroll
            for (int e2 = 0; e2 < 4; ++e2) {
                const f32x4 cs = *(const f32x4*)(rt + e2 * 4);
                const unsigned mw_ = e2 == 0 ? mine.x : e2 == 1 ? mine.y : e2 == 2 ? mine.z : mine.w, ow_ = e2 == 0 ? oth.x : e2 == 1 ? oth.y : e2 == 2 ? oth.z : oth.w;
                const float r0 = bflo(mw_) * cs[0] + sg * bflo(ow_) * cs[1], r1 = bfhi(mw_) * cs[2] + sg * bfhi(ow_) * cs[3];
                const unsigned pk = cvt_pk_bf16(r0, r1);
                if (e2 == 0) res.x = pk; else if (e2 == 1) res.y = pk; else if (e2 == 2) res.z = pk; else res.w = pk;
            }
            qf[qt][KC - 1] = __builtin_bit_cast(bf16x8, res);
        }
    }
#pragma unroll
    for (int qt = 0; qt < 2; ++qt)
#pragma unroll
        for (int kc = 0; kc < KC; ++kc) {
            u32x4 qq = __builtin_bit_cast(u32x4, qf[qt][kc]);
            qq.x = cvt_pk_bf16(bflo(qq.x) * c1, bfhi(qq.x) * c1); qq.y = cvt_pk_bf16(bflo(qq.y) * c1, bfhi(qq.y) * c1);
            qq.z = cvt_pk_bf16(bflo(qq.z) * c1, bfhi(qq.z) * c1); qq.w = cvt_pk_bf16(bflo(qq.w) * c1, bfhi(qq.w) * c1);
            qf[qt][kc] = __builtin_bit_cast(bf16x8, qq);
        }
    f32x4 o[2][4];
#pragma unroll
    for (int qt = 0; qt < 2; ++qt)
#pragma unroll
        for (int dt = 0; dt < 4; ++dt) o[qt][dt] = (f32x4){0.f, 0.f, 0.f, 0.f};
    float mrow[2] = {NEGBIG, NEGBIG}, lsum[2] = {0.f, 0.f};
    const int swk = (i >> 1) & 7;
    const int q4 = i >> 2, p4 = i & 3, vrow = 4 * g + q4, swv = (vrow >> 1) & 3;
    const unsigned vbase = (unsigned)(size_t)lds + (unsigned)(vrow * 128 + p4 * 8);
#define AT_WAITV(n) asm volatile("s_waitcnt vmcnt(" #n ")" ::: "memory")
#define AT_WAIT_TILES(k) do { if ((k) >= 2) { if (extra) AT_WAITV(6); else AT_WAITV(4); } else if ((k) == 1) { if (extra) AT_WAITV(3); else AT_WAITV(2); } else AT_WAITV(0); } while (0)
    u32x2 vt[2][4][2]; bf16x8 pf[2][2]; f32x4 s[2][4], sn[2][4]; float mx[2] = {NEGBIG, NEGBIG};
#define AT_NEED(jj) ((64 * (jj) <= q0 + 31) && (VAR != 2 || (64 * (jj) + 63 >= q0 - 127)))
#define AT_FULL(jj) ((64 * (jj) + 63 <= q0) && (VAR != 2 || (64 * (jj) >= q0 - 96)))
#define AT_LOGITS_Q(jj, S_, qa_, qe_) do { const LAS3 char* sb_ = lds + ((jj) & (AT_NS - 1)) * AT_SLOT; \
        if (VAR != 3 && AT_FULL(jj)) at_cinit<VAR, true>(sb_, (jj), q0, i, g, slope2, mwl, S_, qa_, qe_); else at_cinit<VAR, false>(sb_, (jj), q0, i, g, slope2, mwl, S_, qa_, qe_); \
        at_qk<VAR, KC>(sb_, i, g, swk, qf, S_, qa_, qe_); } while (0)
#define AT_LOGITS(jj, S_) AT_LOGITS_Q(jj, S_, 0, 2)
#ifndef ATTN_PIPE
#define ATTN_PIPE 0
#endif
    constexpr bool PIPE = ((ATTN_PIPE >> VAR) & 1) != 0;
    if (PIPE) {
    { const int k = j1 - j0; AT_WAIT_TILES(k); }
    AT_BAR();
    if (AT_NEED(j0)) { AT_LOGITS(j0, s); at_max(s, mx); }
    for (int j = j0; j <= j1; ++j) {
        { const int k = j1 - j - 1; if (k >= 0) AT_WAIT_TILES(k); }
        AT_BAR();
        if (j + 3 <= j1) AT_DMA(j + 3);
        const bool nd = AT_NEED(j), ndn = (j + 1 <= j1) && AT_NEED(j + 1);
        if (nd) {
            at_rescale(mx, o, mrow, lsum);
            __builtin_amdgcn_sched_barrier(0);
            if (ndn) {
                AT_LOGITS(j + 1, sn);
                at_exp(s, mrow, lsum, pf);
                __builtin_amdgcn_sched_barrier(0);
                at_vread(vbase + (unsigned)((j & (AT_NS - 1)) * AT_SLOT), swv, vt);
                at_max(sn, mx);
                at_pv(vt, pf, o);
                __builtin_amdgcn_sched_barrier(0);
#pragma unroll
                for (int qt = 0; qt < 2; ++qt)
#pragma unroll
                    for (int mt = 0; mt < 4; ++mt) s[qt][mt] = sn[qt][mt];
            } else {
                at_vread(vbase + (unsigned)((j & (AT_NS - 1)) * AT_SLOT), swv, vt);
                at_exp(s, mrow, lsum, pf);
                at_pv(vt, pf, o);
            }
        } else if (ndn) { AT_LOGITS(j + 1, s); at_max(s, mx); }
    }
    } else {
    for (int j = j0; j <= j1; j += 2) {
        AT_WAITV(0);
        AT_BAR();
        if (j + 2 <= j1) AT_DMA(j + 2);
        if (j + 3 <= j1) AT_DMA(j + 3);
        if (VAR != 2 && j + 1 <= j1 && AT_NEED(j) && AT_NEED(j + 1)) {
            AT_LOGITS(j, s);
            AT_LOGITS(j + 1, sn);
            at_vread(vbase + (unsigned)((j & (AT_NS - 1)) * AT_SLOT), swv, vt);
            at_max2(s, sn, mx);
            at_rescale(mx, o, mrow, lsum);
            bf16x8 pg[2][2];
            at_exp(s, mrow, lsum, pf);
            at_exp(sn, mrow, lsum, pg);
            at_pv(vt, pf, o);
            at_vread(vbase + (unsigned)(((j + 1) & (AT_NS - 1)) * AT_SLOT), swv, vt);
            at_pv(vt, pg, o);
        } else
#pragma unroll
        for (int u = 0; u < 2; ++u) {
            const int jj = j + u;
            if (jj <= j1 && AT_NEED(jj)) {
                AT_LOGITS(jj, s);
                at_vread(vbase + (unsigned)((jj & (AT_NS - 1)) * AT_SLOT), swv, vt);
                at_max(s, mx);
                at_rescale(mx, o, mrow, lsum);
                at_exp(s, mrow, lsum, pf);
                at_pv(vt, pf, o);
            }
        }
    }
    }
#undef AT_LOGITS
#undef AT_LOGITS_Q
#undef AT_NEED
#undef AT_FULL
#undef AT_WAIT_TILES
#undef AT_WAITV
#undef AT_DMA
#pragma unroll
    for (int qt = 0; qt < 2; ++qt) {
        float lt = xor16_sum(lsum[qt]); lt += __shfl_xor(lt, 32);
        if (VAR == 2) lt += __builtin_amdgcn_exp2f(p.sinks[l * 4 + hx * 2 + (w >> 2)] * LOG2E - mrow[qt]);
        const float inv = 1.f / lt;
        bf16_t* op = p.merged + (tok0 + q0 + 16 * qt + i) * D + ocol + 4 * g;
#pragma unroll
        for (int dt = 0; dt < 4; ++dt) { const f32x4 v = o[qt][dt] * inv; u32x2 w2; w2.x = cvt_pk_bf16(v[0], v[1]); w2.y = cvt_pk_bf16(v[2], v[3]); *(u32x2*)(op + 16 * dt) = w2; }
    }
}

__device__ __forceinline__ void phase_attn(const Params& p, int l, LAS3 char* lds) {
    const int tid = opaque_tid(p.wid);
    unsigned* qhead = p.ctl + CW_QA + 64 * (l + 2 * p.qslot);
    volatile LAS3 int* bc = (volatile LAS3 int*)(lds + AT_CTL);
    int nxt = 0;
    if (tid == 0) nxt = (int)__hip_atomic_fetch_add(qhead, 1u, __ATOMIC_RELAXED, __HIP_MEMORY_SCOPE_AGENT);
    for (;;) {
        if (tid == 0) *bc = nxt;
        __syncthreads();
        const int idx = __builtin_amdgcn_readfirstlane(*bc);
        __syncthreads();
        if (idx >= 4096) break;
        if (tid == 0) nxt = (int)__hip_atomic_fetch_add(qhead, 1u, __ATOMIC_RELAXED, __HIP_MEMORY_SCOPE_AGENT);
        const int vmask = p.qslot ? REPK_VMASK : ATTN_VMASK;
        if (idx < 3072) {
            const int lvl = 7 - idx / 384, rem = idx % 384;
            if (rem < 128) { if (vmask & 2) attn_unit<1>(p, l, rem >> 2, rem & 3, lvl, lds); }
            else if (rem < 256) { if (vmask & 1) attn_unit<0>(p, l, (rem - 128) >> 2, rem & 3, lvl, lds); }
            else { const int d = rem - 256; if (vmask & 8) attn_unit<3>(p, l, d & 31, 0, 4 * lvl + 3 - (d >> 5), lds); }
        } else { const int c = idx - 3072; if (vmask & 4) attn_unit<2>(p, l, c >> 5, (c >> 4) & 1, c & 15, lds); }
    }
}
}

namespace {
constexpr int DS_LD = 2052;
constexpr int DS_CTL = 16 * DS_LD * 4;
constexpr int DS_LDS = DS_CTL + 64;

__device__ __forceinline__ void dsa_unit(const Params& p, int u, LAS3 char* lds) {
    const int tid = opaque_tid(p.wid), w = __builtin_amdgcn_readfirstlane(tid >> 6), lane = tid & 63, i = lane & 15, g = lane >> 4;
    const int b = u >> 7, t0 = (u & 127) * 16;
    const size_t tok0 = (size_t)b * S;
    uint32_t* mbase = p.mask + (tok0 + t0) * 64;
    if (t0 + 16 <= 256) {
#pragma unroll
        for (int qq = 0; qq < 2; ++qq) {
            const int q = 2 * w + qq, n = t0 + q + 1;
            const int cnt = n > lane ? ((n - lane + 63) >> 6) : 0;
            mbase[q * 64 + lane] = cnt >= 32 ? 0xFFFFFFFFu : ((1u << cnt) - 1u);
        }
        return;
    }
    const int nreg = (t0 + 16 + 63) >> 6;
    const int ntile = nreg * 4;
    bf16x8 qf[8]; float wq[8];
    {
        const bf16_t* qrow = p.proj + (tok0 + t0 + i) * NP;
#pragma unroll
        for (int h = 0; h < 8; ++h) qf[h] = *(const bf16x8*)(qrow + PC_DQI + h * 32 + 8 * g);
        const u32x4 ww = *(const u32x4*)(qrow + PC_DWI);
        const float sc = 0.35355339059327373f * 0.17677669529663687f;
        wq[0] = bflo(ww.x) * sc; wq[1] = bfhi(ww.x) * sc; wq[2] = bflo(ww.y) * sc; wq[3] = bfhi(ww.y) * sc;
        wq[4] = bflo(ww.z) * sc; wq[5] = bfhi(ww.z) * sc; wq[6] = bflo(ww.w) * sc; wq[7] = bfhi(ww.w) * sc;
    }
    const int tq = t0 + i;
#ifndef DSA_EXP
#define DSA_EXP 0
#endif
    const bool exp_skip_score = (DSA_EXP == 2) && p.qslot > 0, exp_skip_sel = (DSA_EXP == 1) && p.qslot > 0, exp_nostore = (DSA_EXP != 0) && p.qslot > 0;
    if (!exp_skip_score)
    for (int base = w; base < ntile; base += 32) {
        bf16x8 kf4[4];
#pragma unroll
        for (int uu = 0; uu < 4; ++uu) { const int kt = base + 8 * uu; if (kt < ntile) kf4[uu] = *(const bf16x8*)(p.kidx + (tok0 + 16 * kt + i) * 32 + 8 * g); }
#pragma unroll
        for (int uu = 0; uu < 4; ++uu) {
            const int kt = base + 8 * uu;
            if (kt < ntile) {
                f32x4 sc4 = {0.f, 0.f, 0.f, 0.f};
#pragma unroll
                for (int h = 0; h < 8; ++h) {
                    const f32x4 c = __builtin_amdgcn_mfma_f32_16x16x32_bf16(kf4[uu], qf[h], (f32x4){0.f, 0.f, 0.f, 0.f}, 0, 0, 0);
#pragma unroll
                    for (int r = 0; r < 4; ++r) { const int ci = __float_as_int(c[r]); sc4[r] += wq[h] * __int_as_float(ci > 0 ? ci : 0); }
                }
                u32x4 ko;
#pragma unroll
                for (int r = 0; r < 4; ++r) {
                    const int key = 16 * kt + 4 * g + r;
                    unsigned uu2 = __float_as_uint(sc4[r]); if (uu2 == 0x80000000u) uu2 = 0u;
                    uu2 = (uu2 & 0x80000000u) ? ~uu2 : (uu2 | 0x80000000u);
                    ko[r] = (key <= tq) ? uu2 : 0u;
                }
                *(LAS3 u32x4*)(lds + ((size_t)i * DS_LD + 16 * kt + 4 * g) * 4) = ko;
            }
        }
    }
    __syncthreads();
    if (!exp_skip_sel)
    {
        const int qA = 2 * w, qB = 2 * w + 1;
        const LAS3 unsigned* kpA = (const LAS3 unsigned*)(lds + (size_t)qA * DS_LD * 4);
        const LAS3 unsigned* kpB = (const LAS3 unsigned*)(lds + (size_t)qB * DS_LD * 4);
        unsigned PA[32], PB[32];
        const int nv = nreg * 64;
#pragma unroll
        for (int r = 0; r < 32; ++r) {
            int idx = r * 64 + lane; asm volatile("" : "+v"(idx));
            const unsigned va = kpA[r * 64 + lane], vb = kpB[r * 64 + lane];
            PA[r] = (idx < nv) ? va : 0u; PB[r] = (idx < nv) ? vb : 0u;
        }
#define DSA_TR(P, j, m) do { _Pragma("unroll") for (int k = 0; k < 32; ++k) if ((k & (j)) == 0) { const unsigned x = P[k], y = P[k + (j)]; \
            P[k] = (x & (m)) | ((y << (j)) & ~(m)); P[k + (j)] = ((x >> (j)) & (m)) | (y & ~(m)); } } while (0)
        DSA_TR(PA, 16, 0x0000FFFFu); DSA_TR(PB, 16, 0x0000FFFFu); DSA_TR(PA, 8, 0x00FF00FFu); DSA_TR(PB, 8, 0x00FF00FFu);
        DSA_TR(PA, 4, 0x0F0F0F0Fu); DSA_TR(PB, 4, 0x0F0F0F0Fu); DSA_TR(PA, 2, 0x33333333u); DSA_TR(PB, 2, 0x33333333u);
        DSA_TR(PA, 1, 0x55555555u); DSA_TR(PB, 1, 0x55555555u);
#undef DSA_TR
        unsigned alA = 0xFFFFFFFFu, abA = 0u, selA = 0u, alB = 0xFFFFFFFFu, abB = 0u, selB = 0u;
        bool exA = false, exB = false;
#pragma unroll
        for (int bit = 31; bit >= 1; bit -= 2) {
            if (!(exA && exB)) {
                const unsigned p1A = PA[bit], p0A = PA[bit - 1], p1B = PB[bit], p0B = PB[bit - 1];
                const unsigned t1A = alA & p1A, c3A = abA | (t1A & p0A), c2A = abA | t1A, c1A = abA | (alA & (p1A | p0A));
                const unsigned t1B = alB & p1B, c3B = abB | (t1B & p0B), c2B = abB | t1B, c1B = abB | (alB & (p1B | p0B));
                const int rA = wave_reduce_add(__builtin_popcount(c3A) | (__builtin_popcount(c2A) << 16));
                const int rB = wave_reduce_add(__builtin_popcount(c3B) | (__builtin_popcount(c2B) << 16));
                const int rC = wave_reduce_add(__builtin_popcount(c1A) | (__builtin_popcount(c1B) << 16));
                const int n3A = rA & 0xFFFF, n2A = rA >> 16, n1A = rC & 0xFFFF, n3B = rB & 0xFFFF, n2B = rB >> 16, n1B = rC >> 16;
                if (!exA) {
                    if (n3A >= 256) { if (n3A == 256) { exA = true; selA = c3A; } alA = t1A & p0A; }
                    else if (n2A >= 256) { if (n2A == 256) { exA = true; selA = c2A; } abA = c3A; alA = t1A & ~p0A; }
                    else if (n1A >= 256) { if (n1A == 256) { exA = true; selA = c1A; } abA = c2A; alA = alA & ~p1A & p0A; }
                    else { abA = c1A; alA = alA & ~(p1A | p0A); }
                }
                if (!exB) {
                    if (n3B >= 256) { if (n3B == 256) { exB = true; selB = c3B; } alB = t1B & p0B; }
                    else if (n2B >= 256) { if (n2B == 256) { exB = true; selB = c2B; } abB = c3B; alB = t1B & ~p0B; }
                    else if (n1B >= 256) { if (n1B == 256) { exB = true; selB = c1B; } abB = c2B; alB = alB & ~p1B & p0B; }
                    else { abB = c1B; alB = alB & ~(p1B | p0B); }
                }
            }
        }
        const unsigned long long lt = (lane == 0) ? 0ull : (~0ull >> (64 - lane));
#pragma unroll 1
        for (int qq = 0; qq < 2; ++qq) {
            const bool exact = qq ? exB : exA;
            unsigned sel = qq ? selB : selA;
            if (!exact) {
                const unsigned al = qq ? alB : alA, ab = qq ? abB : abA;
                const int need = 256 - wave_reduce_add(__builtin_popcount(ab));
                int running = 0; sel = ab;
                for (int r = 0; r < 32; ++r) {
                    const bool eq = ((al >> r) & 1u) != 0u;
                    const unsigned long long be = __ballot(eq);
                    if (eq && running + __popcll(be & lt) < need) sel |= 1u << r;
                    running += __popcll(be);
                }
            }
            if (!exp_nostore) mbase[(2 * w + qq) * 64 + lane] = sel;
        }
    }
    __syncthreads();
}

__device__ __forceinline__ void phase_dsa(const Params& p, int l, LAS3 char* lds) {
    const int tid = opaque_tid(p.wid);
    unsigned* qhead = p.ctl + CW_QD + 64 * (l + 2 * p.qslot);
    volatile LAS3 int* bc = (volatile LAS3 int*)(lds + DS_CTL);
    int nxt = 0;
    if (tid == 0) nxt = (int)__hip_atomic_fetch_add(qhead, 1u, __ATOMIC_RELAXED, __HIP_MEMORY_SCOPE_AGENT);
    for (;;) {
        if (tid == 0) *bc = nxt;
        __syncthreads();
        const int idx = __builtin_amdgcn_readfirstlane(*bc);
        __syncthreads();
        if (idx >= 4096) break;
        if (tid == 0) nxt = (int)__hip_atomic_fetch_add(qhead, 1u, __ATOMIC_RELAXED, __HIP_MEMORY_SCOPE_AGENT);
        const int pb = 127 - (idx >> 5), b = idx & 31;
        dsa_unit(p, b * 128 + pb, lds);
    }
}
}

namespace {
constexpr int LDS_BYTES = 147456;
constexpr int NTHREADS = 512;

template <int PH>
__device__ __forceinline__ void run_phase(const Params& p, int l, unsigned char* smem) {
    LAS3 char* lds = (LAS3 char*)smem;
    PG8_LAS unsigned char* glds = (PG8_LAS unsigned char*)smem;
    const int G = gridDim.x, c = blockIdx.x;
    if constexpr (PH == 0) phase_p0(p, (char*)smem);
    if constexpr (PH == 1) { if (l == 0) phase_norm1<0>(p, 0); else phase_norm1<1>(p, l); }
    if constexpr (PH == 2) { pg8::Gemm g{p.h, p.WinT + (size_t)l * NP * D, D, D, 0}; pg8::StaticOrder S; S.init(T, NP, G, c);
        EpiStoreBf16 E{p.proj, NP}; pg8::gemm_phase<EpiStoreBf16, pg8::StaticOrder, false>(glds, g, S, E, p.wid); }
    if constexpr (PH == 3) phase_prep(p, l);
    if constexpr (PH == 4) { pg8::Gemm g{p.proj + PC_BCQ, p.WqT + (size_t)l * 512 * 256, 256, NP, 0}; pg8::StaticOrder S; S.init(T, 512, G, c);
          EpiMlaQ E{p.qm}; pg8::gemm_phase<EpiMlaQ, pg8::StaticOrder, false>(glds, g, S, E, p.wid); }
    if constexpr (PH == 12) { pg8::Gemm g{p.proj + PC_BCKV, p.WkvT + (size_t)l * 512 * 128, 128, NP, 0}; pg8::StaticOrder S; S.init(T, 512, G, c);
          EpiMlaKV E{p.km, p.vm}; pg8::gemm_phase<EpiMlaKV, pg8::StaticOrder, false>(glds, g, S, E, p.wid); }
    if constexpr (PH == 13) phase_dsa(p, l, lds);
    if constexpr (PH == 5) phase_attn(p, l, lds);
    if constexpr (PH == 6) { pg8::Gemm g{p.merged, p.WoutT + (size_t)l * D * D, D, D, 0}; pg8::StaticOrder S; S.init(T, D, G, c);
        EpiResidual E{l == 0 ? p.x : nullptr, p.xb, p.mod + (size_t)l * NB * NMOD + 2 * 1024}; pg8::gemm_phase<EpiResidual, pg8::StaticOrder, false>(glds, g, S, E, p.wid); }
    if constexpr (PH == 7) phase_route(p, l, (char*)smem);
    if constexpr (PH == 8) { const int* cnt = (const int*)(p.ctl + CW_CNT) + l * 16;
        pg8::Gemm g{p.h, p.WguT + (size_t)l * 16 * 512 * 1024, 1024, D, (size_t)512 * 1024}; MoeOrder S; S.init(cnt, p.list, 2, G, c);
        EpiGateUp E{p.hid}; pg8::gemm_phase<EpiGateUp, MoeOrder, true>(glds, g, S, E, p.wid); }
    if constexpr (PH == 9) { const int* cnt = (const int*)(p.ctl + CW_CNT) + l * 16;
        pg8::Gemm g{p.hid, p.WdT + (size_t)l * 16 * 1024 * 256, 256, 256, (size_t)1024 * 256}; MoeOrder S; S.init(cnt, p.list, 4, G, c);
        EpiDown E{p.ys, p.list, p.wl, cnt}; pg8::gemm_phase<EpiDown, MoeOrder, false>(glds, g, S, E, p.wid); }
    if constexpr (PH == 10) phase_norm1<2>(p, 1);
    if constexpr (PH == 11) phase_norm1<0>(p, l);
}
template <int PH>
__global__ void __launch_bounds__(NTHREADS, 2) k_ph(Params p, int l) {
    extern __shared__ __attribute__((aligned(16))) unsigned char smem[];
    p.wid = __builtin_amdgcn_readfirstlane(threadIdx.x >> 6); p.qslot = p.qslot_host;
    run_phase<PH>(p, l, smem);
}
}


namespace {
#ifndef REP_PH
#define REP_PH -1
#endif
#define REP(X, l) do { if (REP_PH == X) { xcd_barrier(bar); phase<X>(l, smem, wid, 1); } } while (0)
struct KArgs { const float* in[20]; float* xo; char* ws; };
constexpr size_t al256(size_t b) { return (b + 255) & ~(size_t)255; }
constexpr size_t WS_CTL = 0;
constexpr size_t WS_MOD = WS_CTL + al256((size_t)CW_WORDS * 4);
constexpr size_t WS_WIN = WS_MOD + al256((size_t)2 * NB * NMOD * 4);
constexpr size_t WS_WOUT = WS_WIN + al256((size_t)2 * NP * D * 2);
constexpr size_t WS_WQ = WS_WOUT + al256((size_t)2 * D * D * 2);
constexpr size_t WS_WKV = WS_WQ + al256((size_t)2 * 512 * 256 * 2);
constexpr size_t WS_WGU = WS_WKV + al256((size_t)2 * 512 * 128 * 2);
constexpr size_t WS_WD = WS_WGU + al256((size_t)2 * 16 * 512 * 1024 * 2);
constexpr size_t WS_ROPE = WS_WD + al256((size_t)2 * 16 * 1024 * 256 * 2);
constexpr size_t WS_RQ = WS_ROPE + al256((size_t)2048 * 16 * 2 * 4);
constexpr size_t WS_RKV = WS_RQ + al256((size_t)T * 4);
constexpr size_t WS_CBF = WS_RKV + al256((size_t)T * 4);
constexpr size_t WS_KIDX = WS_CBF + al256((size_t)NB * 4 * S * 4);
constexpr size_t WS_MASK = WS_KIDX + al256((size_t)T * 32 * 2);
constexpr size_t WS_LIST = WS_MASK + al256((size_t)T * 64 * 4);
constexpr size_t WS_RW = WS_LIST + al256((size_t)2 * 16 * ECAP * 4);
constexpr size_t WS_WL = WS_RW + al256((size_t)T * 2 * 4);
constexpr size_t WS_H = WS_WL + al256((size_t)2 * 16 * ECAP * 4);
constexpr size_t WS_PROJ = WS_H + al256((size_t)T * D * 2);
constexpr size_t WS_QM = WS_PROJ + al256((size_t)T * NP * 2);
constexpr size_t WS_KM = WS_QM + al256((size_t)T * 384 * 2);
constexpr size_t WS_VM = WS_KM + al256((size_t)T * 384 * 2);
constexpr size_t WS_MERGED = WS_VM + al256((size_t)T * 256 * 2);
constexpr size_t WS_XB = WS_MERGED + al256((size_t)T * D * 2);
constexpr size_t WS_END1 = WS_XB + al256((size_t)T * D * 2);
constexpr size_t WS_HID = WS_PROJ;
constexpr size_t WS_YS = WS_HID + al256((size_t)HIDROWS * 256 * 2);
constexpr size_t WS_END2 = WS_YS + al256((size_t)T * 2 * D * 2);
constexpr size_t WS_NEED = WS_END1 > WS_END2 ? WS_END1 : WS_END2;
static_assert(WS_END2 <= WS_MERGED, "MoE overlay must not reach the merged buffer");

__device__ __forceinline__ Params make_params(const KArgs& a) {
    Params p;
    p.x = a.in[0]; p.c = a.in[1]; p.w_ada = a.in[2]; p.b_ada = a.in[3]; p.g_norm1 = a.in[4]; p.w_in = a.in[5]; p.b_forget = a.in[6]; p.g_q_mla = a.in[7];
    p.w_q_up = a.in[8]; p.g_kv_mla = a.in[9]; p.w_kv_up = a.in[10]; p.sinks = a.in[11]; p.w_out = a.in[12]; p.g_norm2 = a.in[13]; p.w_router = a.in[14];
    p.b_router = a.in[15]; p.w_gate = a.in[16]; p.w_up = a.in[17]; p.w_down = a.in[18]; p.g_final = a.in[19];
    p.xo = a.xo; char* ws = a.ws;
    p.ctl = (unsigned*)(ws + WS_CTL); p.mod = (float*)(ws + WS_MOD); p.WinT = (bf16_t*)(ws + WS_WIN); p.WoutT = (bf16_t*)(ws + WS_WOUT);
    p.WqT = (bf16_t*)(ws + WS_WQ); p.WkvT = (bf16_t*)(ws + WS_WKV); p.WguT = (bf16_t*)(ws + WS_WGU); p.WdT = (bf16_t*)(ws + WS_WD);
    p.ropetab = (float*)(ws + WS_ROPE); p.rq = (float*)(ws + WS_RQ); p.rkv = (float*)(ws + WS_RKV); p.cbF = (float*)(ws + WS_CBF); p.kidx = (bf16_t*)(ws + WS_KIDX);
    p.mask = (uint32_t*)(ws + WS_MASK); p.list = (int*)(ws + WS_LIST); p.rw = (float*)(ws + WS_RW); p.wl = (float*)(ws + WS_WL); p.h = (bf16_t*)(ws + WS_H);
    p.proj = (bf16_t*)(ws + WS_PROJ); p.qm = (bf16_t*)(ws + WS_QM); p.km = (bf16_t*)(ws + WS_KM); p.vm = (bf16_t*)(ws + WS_VM);
    p.merged = (bf16_t*)(ws + WS_MERGED); p.xb = (bf16_t*)(ws + WS_XB); p.hid = (bf16_t*)(ws + WS_HID); p.ys = (bf16_t*)(ws + WS_YS);
    return p;
}
template <int PH>
__device__ __forceinline__ void phase(int l, unsigned char* smem, int wid, int qslot = 0) {
    typedef const __attribute__((address_space(4))) KArgs* KA4;
    KA4 ka = (KA4)__builtin_amdgcn_kernarg_segment_ptr();
    asm volatile("" : "+s"(ka));
    KArgs a;
#pragma unroll
    for (int i = 0; i < 20; ++i) a.in[i] = ka->in[i];
    a.xo = ka->xo; a.ws = ka->ws;
    Params p = make_params(a); p.wid = wid; p.qslot = qslot; p.qslot_host = 0;
    run_phase<PH>(p, l, smem);
}
__global__ void __launch_bounds__(NTHREADS, 2) fwd(KArgs args) {
    extern __shared__ __attribute__((aligned(16))) unsigned char smem[];
    volatile LAS unsigned* st = (volatile LAS unsigned*)(smem + LDS_BYTES - 16);
    const int wid = __builtin_amdgcn_readfirstlane(threadIdx.x >> 6);
    if (xb_leader(wid)) { st[0] = 0u; st[1] = 0u; st[2] = 0u; st[3] = 0u; }
    __syncthreads();
    XcdBarrier bar = xcd_barrier_post((unsigned*)(args.ws + WS_CTL) + CW_BAR, st, wid);
    phase<0>(0, smem, wid);  REP(0, 0);
    xcd_barrier(bar);
#define LAYER(l) do { \
        phase<1>(l, smem, wid);  if (l == 0) REP(1, l); xcd_barrier(bar); \
        phase<2>(l, smem, wid);  REP(2, l); xcd_barrier(bar); \
        phase<3>(l, smem, wid);  REP(3, l); xcd_barrier(bar); \
        phase<4>(l, smem, wid);  REP(4, l); phase<12>(l, smem, wid);  REP(12, l); phase<13>(l, smem, wid);  REP(13, l); xcd_barrier(bar); \
        phase<5>(l, smem, wid);  REP(5, l); xcd_barrier(bar); \
        phase<6>(l, smem, wid);  xcd_barrier(bar); \
        phase<7>(l, smem, wid);  REP(7, l); xcd_barrier(bar); \
        phase<8>(l, smem, wid);  REP(8, l); xcd_barrier(bar); \
        phase<9>(l, smem, wid);  REP(9, l); xcd_barrier(bar); } while (0)
    LAYER(0);
    LAYER(1);
#ifdef REP_BAR
    for (int rb = 0; rb < REP_BAR; ++rb) xcd_barrier(bar);
#endif
    phase<10>(1, smem, wid);
}
}

extern "C" void kernel_launch(void* const* d_in, const int* in_sizes, int n_in, void* d_out, int out_size, void* d_ws, size_t ws_size,
                              hipStream_t stream) {
    KArgs a{};
    for (int i = 0; i < 20; ++i) a.in[i] = (const float*)d_in[i];
    a.xo = (float*)d_out; a.ws = (char*)d_ws;
    if (WS_NEED > ws_size) return;

    static int grid = 0;
    if (!grid) {
        int dev = 0, cus = 0, per_cu = 0;
        (void)hipGetDevice(&dev);
        (void)hipDeviceGetAttribute(&cus, hipDeviceAttributeMultiprocessorCount, dev);
        (void)hipFuncSetAttribute((const void*)fwd, hipFuncAttributeMaxDynamicSharedMemorySize, LDS_BYTES);
        (void)hipOccupancyMaxActiveBlocksPerMultiprocessor(&per_cu, (const void*)fwd, NTHREADS, LDS_BYTES);
        grid = cus > 0 ? cus : 256;
    }
    (void)hipMemsetAsync(a.ws + WS_CTL, 0, (size_t)CW_WORDS * 4, stream);
    fwd<<<dim3(grid), dim3(NTHREADS), LDS_BYTES, stream>>>(a);
}
```

```cpp
#define NORM_NT 4
#include <hip/hip_runtime.h>
#include <stdint.h>
#define XB_TMO      128
#define XB_XCNT(j)  (256  + 64 * (j))
#define XB_XSUB(j)  (1280 + 64 * (j))
#define XB_XGEN(j)  (2304 + 64 * (j))
#define XB_TOP      3328
#define XB_TOPGEN   3392
#define XCD_BAR_WORDS 3456
#define XB_SPIN_CAP (1u << 20)
#define LAS __attribute__((address_space(3)))

__device__ __forceinline__ unsigned xb_ld(unsigned* p)              { return __hip_atomic_load(p, __ATOMIC_RELAXED, __HIP_MEMORY_SCOPE_AGENT); }
__device__ __forceinline__ unsigned xb_add(unsigned* p, unsigned v) { return __hip_atomic_fetch_add(p, v, __ATOMIC_RELAXED, __HIP_MEMORY_SCOPE_AGENT); }
__device__ __forceinline__ unsigned xb_xcc_id() { return (unsigned)__builtin_amdgcn_s_getreg((3 << 11) | 20) & 0xFu; }
#define XB_SPIN(cond, bar) do { unsigned _sp = 0; while (cond) { __builtin_amdgcn_s_sleep(1); \
    if ((++_sp & 255u) == 0u) { if (xb_ld(&(bar)[XB_TMO])) break; if (_sp > XB_SPIN_CAP) { atomicAdd(&(bar)[XB_TMO], 1u); break; } } } } while (0)

struct XcdBarrier { unsigned* bar; unsigned x; volatile LAS unsigned* st; int wid; };
__device__ __forceinline__ bool xb_leader(int wid) { return wid == 0 && __builtin_amdgcn_mbcnt_hi(~0u, __builtin_amdgcn_mbcnt_lo(~0u, 0u)) == 0u; }

__device__ __forceinline__ XcdBarrier xcd_barrier_post(unsigned* bar, volatile LAS unsigned* st, int wid) {
    XcdBarrier b; b.bar = bar; b.x = xb_xcc_id(); b.st = st; b.wid = wid;
    if (xb_leader(wid)) (void)xb_add(&bar[XB_XCNT(b.x)], 1u);
    return b;
}
__device__ __forceinline__ void xcd_barrier_complete(unsigned* bar, unsigned x, unsigned& nloc, unsigned& nx) {
    const unsigned G = gridDim.x * gridDim.y * gridDim.z;
    unsigned sum, cnt, mine, sp = 0u;
    for (;;) {
        sum = 0u; cnt = 0u; mine = 0u;
#pragma unroll
        for (unsigned j = 0; j < 16; ++j) { const unsigned c = xb_ld(&bar[XB_XCNT(j)]); sum += c; cnt += (c > 0u) ? 1u : 0u; mine = (j == x) ? c : mine; }
        if (sum == G) break;
        __builtin_amdgcn_s_sleep(1);
        if ((++sp & 255u) == 0u) { if (xb_ld(&bar[XB_TMO])) break; if (sp > XB_SPIN_CAP) { atomicAdd(&bar[XB_TMO], 1u); break; } }
    }
    nloc = mine > 0u ? mine : 1u; nx = cnt > 0u ? cnt : 1u;
}
__device__ __forceinline__ void xcd_barrier(const XcdBarrier& b) {
    asm volatile("s_waitcnt vmcnt(0)" ::: "memory");
    __syncthreads();
    if (xb_leader(b.wid)) {
        unsigned* bar = b.bar;
        __builtin_amdgcn_s_waitcnt(0);
        unsigned nloc = b.st[0], nx = b.st[1];
        if (nloc == 0u) { xcd_barrier_complete(bar, b.x, nloc, nx); b.st[0] = nloc; b.st[1] = nx; }
        const unsigned old = xb_add(&bar[XB_XSUB(b.x)], 1u);
        const unsigned gen = old / nloc;
        if (old + 1u == (gen + 1u) * nloc) {
            __builtin_amdgcn_fence(__ATOMIC_RELEASE, "agent");
            asm volatile("s_waitcnt vmcnt(0)" ::: "memory");
            const unsigned og = xb_add(&bar[XB_TOP], 1u);
            const unsigned tg = og / nx;
            if (og + 1u == (tg + 1u) * nx) xb_add(&bar[XB_TOPGEN], 1u);
            else XB_SPIN(xb_ld(&bar[XB_TOPGEN]) == tg, bar);
            __builtin_amdgcn_fence(__ATOMIC_ACQUIRE, "agent");
            xb_add(&bar[XB_XGEN(b.x)], 1u);
            asm volatile("s_waitcnt vmcnt(0)" ::: "memory");
        } else {
            XB_SPIN(xb_ld(&bar[XB_XGEN(b.x)]) == gen, bar);
            __builtin_amdgcn_fence(__ATOMIC_ACQUIRE, "agent");
            asm volatile("s_waitcnt vmcnt(0)" ::: "memory");
        }
    }
    __syncthreads();
}

#define LAS3 __attribute__((address_space(3)))
namespace {
typedef unsigned short bf16_t;
typedef short bf16x8 __attribute__((ext_vector_type(8)));
typedef short bf16x4 __attribute__((ext_vector_type(4)));
typedef float f32x4 __attribute__((ext_vector_type(4)));
typedef float f32x2 __attribute__((ext_vector_type(2)));
typedef unsigned u32x4 __attribute__((ext_vector_type(4)));
typedef unsigned u32x2 __attribute__((ext_vector_type(2)));

constexpr int D = 1024, NB = 32, S = 2048, T = NB * S, NIN = 2380, NP = 2560, NMOD = 6144;
constexpr int OFF_AQ = 0, OFF_AK = 256, OFF_AV = 512, OFF_AF = 768, OFF_BCQ = 772, OFF_BCKV = 1028, OFF_BKR = 1156,
              OFF_CQ = 1188, OFF_CK = 1444, OFF_CV = 1572, OFF_DQ = 1700, OFF_DK = 1956, OFF_DV = 2020,
              OFF_DQI = 2084, OFF_DKI = 2340, OFF_DWI = 2372;
constexpr int PC_AQ = 0, PC_AK = 256, PC_AV = 512, PC_BCQ = 768, PC_BCKV = 1024, PC_BKR = 1152, PC_CQ = 1184, PC_CK = 1440, PC_CV = 1568,
              PC_DQ = 1696, PC_DK = 1952, PC_DV = 2016, PC_DQI = 2080, PC_DKI = 2336, PC_DWI = 2368, PC_AF = 2376;
constexpr float EPS = 1e-6f;
constexpr float LOG2E = 1.4426950408889634f;
constexpr int ECAP = T;
constexpr int HIDROWS = 2 * T + 16 * 256;

__host__ __device__ __forceinline__ int orig_col(int n) { return n < 768 ? n : (n < 2376 ? n + 4 : (n < 2380 ? n - 1608 : -1)); }
__device__ __forceinline__ int opaque_tid(int wid) {
    int t = wid * 64 + (int)__builtin_amdgcn_mbcnt_hi(~0u, __builtin_amdgcn_mbcnt_lo(~0u, 0u));
    asm volatile("" : "+v"(t)); return t; }
__device__ __forceinline__ float bf2f(bf16_t v) { return __uint_as_float((unsigned)v << 16); }
__device__ __forceinline__ bf16_t f2bf(float f) { unsigned u = __float_as_uint(f); u += 0x7FFFu + ((u >> 16) & 1u); return (bf16_t)(u >> 16); }
typedef __bf16 bf16x2_native __attribute__((ext_vector_type(2)));
__device__ __forceinline__ unsigned cvt_pk_bf16(float lo, float hi) { const f32x2 v = {lo, hi}; return __builtin_bit_cast(unsigned, __builtin_convertvector(v, bf16x2_native)); }
__device__ __forceinline__ float bflo(unsigned w) { return __uint_as_float(w << 16); }
__device__ __forceinline__ float bfhi(unsigned w) { return __uint_as_float(w & 0xFFFF0000u); }
__device__ __forceinline__ float row_sum16(float v) {
    v += __int_as_float(__builtin_amdgcn_update_dpp(0, __float_as_int(v), 0xB1, 0xF, 0xF, true));
    v += __int_as_float(__builtin_amdgcn_update_dpp(0, __float_as_int(v), 0x4E, 0xF, 0xF, true));
    v += __int_as_float(__builtin_amdgcn_update_dpp(0, __float_as_int(v), 0x141, 0xF, 0xF, true));
    v += __int_as_float(__builtin_amdgcn_update_dpp(0, __float_as_int(v), 0x140, 0xF, 0xF, true));
    return v;
}
__device__ __forceinline__ float wave_sum(float v) {
    v += __int_as_float(__builtin_amdgcn_update_dpp(0, __float_as_int(v), 0xB1, 0xF, 0xF, true));
    v += __int_as_float(__builtin_amdgcn_update_dpp(0, __float_as_int(v), 0x4E, 0xF, 0xF, true));
    v += __int_as_float(__builtin_amdgcn_update_dpp(0, __float_as_int(v), 0x141, 0xF, 0xF, true));
    v += __int_as_float(__builtin_amdgcn_update_dpp(0, __float_as_int(v), 0x140, 0xF, 0xF, true));
    v += __int_as_float(__builtin_amdgcn_update_dpp(0, __float_as_int(v), 0x142, 0xA, 0xF, false));
    v += __int_as_float(__builtin_amdgcn_update_dpp(0, __float_as_int(v), 0x143, 0xC, 0xF, false));
    return __int_as_float(__builtin_amdgcn_readlane(__float_as_int(v), 63));
}
__device__ __forceinline__ float xor32_max(float x) {
    float a = x, b = x;
    asm volatile("s_nop 1\n\tv_permlane32_swap_b32 %0, %1\n\ts_nop 1" : "+v"(a), "+v"(b));
    return fmaxf(a, b);
}
__device__ __forceinline__ float xor16_max(float x) {
    float a = x, b = x;
    asm volatile("s_nop 1\n\tv_permlane16_swap_b32 %0, %1\n\ts_nop 1" : "+v"(a), "+v"(b));
    return fmaxf(a, b);
}
__device__ __forceinline__ float xor16_sum(float x) {
    float a = x, b = x;
    asm volatile("s_nop 1\n\tv_permlane16_swap_b32 %0, %1\n\ts_nop 1" : "+v"(a), "+v"(b));
    return a + b;
}
__device__ __forceinline__ int wave_reduce_add(int v) {
    v += __builtin_amdgcn_update_dpp(0, v, 0xB1, 0xF, 0xF, true);
    v += __builtin_amdgcn_update_dpp(0, v, 0x4E, 0xF, 0xF, true);
    v += __builtin_amdgcn_update_dpp(0, v, 0x141, 0xF, 0xF, true);
    v += __builtin_amdgcn_update_dpp(0, v, 0x140, 0xF, 0xF, true);
#if 1
    v += __builtin_amdgcn_update_dpp(0, v, 0x142, 0xA, 0xF, false);
    v += __builtin_amdgcn_update_dpp(0, v, 0x143, 0xC, 0xF, false);
    return __builtin_amdgcn_readlane(v, 63);
#else
    return __builtin_amdgcn_readlane(v, 0) + __builtin_amdgcn_readlane(v, 16) + __builtin_amdgcn_readlane(v, 32) + __builtin_amdgcn_readlane(v, 48);
#endif
}
}

namespace pg8 {
#define PG8_LAS __attribute__((address_space(3)))
constexpr int BM = 256, BK = 64, HALF = 128, HTB = HALF * BK * 2, STAGE_BYTES = 8 * HTB, NXCD = 8, WGM = 8;

__host__ __device__ __forceinline__ int lds_byte(int r, int c) { const int st = (r >> 4) * 2 + (c >> 5), rr = r & 15, cc = c & 31, ob = rr * 64 + cc * 2; return st * 1024 + (ob ^ (((ob >> 9) & 1) << 5)); }
__host__ __device__ __forceinline__ void stage_rc(int b, int& R, int& C) { const int st = b / 1024, sb = b % 1024, swz = sb ^ (((sb >> 9) & 1) << 5); R = (st >> 1) * 16 + swz / 64; C = (st & 1) * 32 + (swz % 64) / 2; }
__host__ __device__ __forceinline__ int perm32(int rho) { const int n = rho >> 4, i = rho & 15; return 8 * (i >> 2) + 4 * n + (i & 3); }

struct Unit { int pm, pn, e, mt, half; };
struct Gemm { const bf16_t* A; const bf16_t* Bt; int K; int lda; size_t bstride; };

struct StaticOrder {
    static constexpr bool HALF_UNITS = false;
    int nM, nN, nwg, G, c;
    __host__ __device__ void init(int M, int N, int G_, int c_) { nM = M / BM; nN = N / BM; nwg = nM * nN; G = G_; c = c_; }
    __host__ __device__ bool next(int i, Unit& u) const {
        const long L = (long)i * G + c; if (L >= nwg) return false;
        int wgid = (int)L; { const int q = nwg / NXCD, r = nwg % NXCD, xcd = wgid % NXCD, off = wgid / NXCD; wgid = (xcd < r ? xcd * (q + 1) : r * (q + 1) + (xcd - r) * q) + off; }
        const int nig = WGM * nN, gid = wgid / nig, fm = gid * WGM, gsz = (nM - fm) < WGM ? (nM - fm) : WGM;
        u.pm = fm + ((wgid % nig) % gsz); u.pn = (wgid % nig) / gsz; u.e = 0; u.mt = 0; u.half = 0; return true;
    }
    __device__ __forceinline__ int arow(const Unit& u, int r) const { return u.pm * BM + r; }
};

template <class Epi, class Sched, bool GATHER>
__device__ __forceinline__ void gemm_phase(PG8_LAS unsigned char* lds, const Gemm g, const Sched& S, const Epi& E, int wave_index) {
    const int tid = opaque_tid(wave_index), wid = __builtin_amdgcn_readfirstlane(tid >> 6), lane = tid & 63, wr = wid >> 2, wc = wid & 3, fr = lane & 15, fq = lane >> 4;
    int K_ = g.K; asm volatile("" : "+s"(K_));
    const int K = K_, nt = K / BK, lda = g.lda;
    int Ra[2], Ca[2]; unsigned voffB[2], voffA[2];
#pragma unroll
    for (int i = 0; i < 2; ++i) { int R, C; stage_rc(tid * 16 + i * 8192, R, C); const int Rb = Epi::PERM ? ((R & ~31) + perm32(R & 31)) : R;
        Ra[i] = R; Ca[i] = C; voffB[i] = (unsigned)(Rb * K + C) * 2u; voffA[i] = (unsigned)(R * lda + C) * 2u; }
    const size_t kstep = (size_t)(BK * 2);
    const size_t hstepB = (size_t)HALF * K * 2;
    const size_t tstepB = 2 * hstepB;
    const size_t hstepA = (size_t)HALF * lda * 2, tstepA = 2 * hstepA;
    const unsigned ldsw = (unsigned)wid * 1024u;
    const int aoff = lds_byte(wr * 64 + fr, fq * 8), boff = lds_byte(wc * 32 + fr, fq * 8);
#define PG8_SA(b, h) (((b) * 2 + (h)) * HTB)
#define PG8_SB(b, h) ((4 + (b) * 2 + (h)) * HTB)
#define PG8_STAGE(bufoff, gbase, voff) do { _Pragma("unroll") for (int _i = 0; _i < 2; ++_i) \
        __builtin_amdgcn_global_load_lds((const unsigned*)((const char*)(gbase) + (voff)[_i]), (PG8_LAS unsigned*)(lds + (bufoff) + ldsw + _i * 8192), 16, 0, 0); } while (0)
#define PG8_STAGEA(bufoff, kptr, VO, h) do { _Pragma("unroll") for (int _i = 0; _i < 2; ++_i) { \
        const char* _src; if constexpr (GATHER) _src = (const char*)(kptr) + (VO)[_i][h]; else _src = (const char*)(kptr) + (size_t)(h) * hstepA + voffA[_i]; \
        __builtin_amdgcn_global_load_lds((const unsigned*)_src, (PG8_LAS unsigned*)(lds + (bufoff) + ldsw + _i * 8192), 16, 0, 0); } } while (0)
#define PG8_LDA(dst, b, h) do { _Pragma("unroll") for (int m = 0; m < 4; ++m) _Pragma("unroll") for (int k = 0; k < 2; ++k) dst[m][k] = *(const PG8_LAS bf16x8*)(lds + PG8_SA(b, h) + aoff + m * 2048 + k * 1024); } while (0)
#define PG8_LDB(dst, b, h) do { _Pragma("unroll") for (int n = 0; n < 2; ++n) _Pragma("unroll") for (int k = 0; k < 2; ++k) dst[n][k] = *(const PG8_LAS bf16x8*)(lds + PG8_SB(b, h) + boff + n * 2048 + k * 1024); } while (0)
#define PG8_MMA(ai, bj, At, Bt) do { __builtin_amdgcn_s_setprio(1); _Pragma("unroll") for (int m = 0; m < 4; ++m) _Pragma("unroll") for (int n = 0; n < 2; ++n) _Pragma("unroll") for (int k = 0; k < 2; ++k) \
        acc[ai][bj][m][n] = __builtin_amdgcn_mfma_f32_16x16x32_bf16(Bt[n][k], At[m][k], acc[ai][bj][m][n], 0, 0, 0); __builtin_amdgcn_s_setprio(0); } while (0)
#define PG8_WAIT_V(n) asm volatile("s_waitcnt vmcnt(" #n ")" ::: "memory")
#define PG8_WAIT_L(n) asm volatile("s_waitcnt lgkmcnt(" #n ")" ::: "memory")
#define PG8_BAR __builtin_amdgcn_s_barrier()
#define PG8_SCHED __builtin_amdgcn_sched_barrier(0)
#define PG8_SETV(V, u) do { _Pragma("unroll") for (int _i = 0; _i < 2; ++_i) _Pragma("unroll") for (int _h = 0; _h < 2; ++_h) { \
        const int _row = GATHER ? S.arow(u, _h * HALF + Ra[_i]) : ((u).pm * BM + _h * HALF + Ra[_i]); V[_i][_h] = (unsigned)(((size_t)_row * lda + Ca[_i]) * 2); } } while (0)
    Unit cur, nxt; int ui = 0;
    if (!S.next(0, cur)) return;
    bool do0 = !Sched::HALF_UNITS || cur.half != 2, do1 = !Sched::HALF_UNITS || cur.half != 1;
    f32x4 acc[2][2][4][2];
#pragma unroll
    for (int a = 0; a < 2; ++a)
#pragma unroll
        for (int b = 0; b < 2; ++b)
#pragma unroll
            for (int m = 0; m < 4; ++m)
#pragma unroll
                for (int n = 0; n < 2; ++n) acc[a][b][m][n] = (f32x4){0.f, 0.f, 0.f, 0.f};
    bf16x8 At[4][2], B0[2][2], B1[2][2];
    unsigned vA[2][2], vN[2][2];
    if constexpr (GATHER) { PG8_SETV(vA, cur); }
    const char* cA = (const char*)g.A + (GATHER ? (size_t)0 : (size_t)cur.pm * tstepA);
    const char* cB = (const char*)g.Bt + ((size_t)cur.e * g.bstride) * 2 + (size_t)cur.pn * tstepB;
    PG8_STAGE(PG8_SB(0, 0), cB, voffB); PG8_STAGE(PG8_SB(0, 1), cB + hstepB, voffB); PG8_STAGEA(PG8_SA(0, 0), cA, vA, 0); PG8_STAGEA(PG8_SA(0, 1), cA, vA, 1);
    if (wr == 1) PG8_BAR;
    PG8_WAIT_V(2); PG8_BAR;
    PG8_STAGE(PG8_SB(1, 0), cB + kstep, voffB); PG8_STAGEA(PG8_SA(1, 0), cA + kstep, vA, 0); PG8_STAGE(PG8_SB(1, 1), cB + hstepB + kstep, voffB);
    PG8_WAIT_V(6); PG8_BAR;
    for (;;) {
        const bool has_next = S.next(ui + 1, nxt);
        if constexpr (GATHER) { if (has_next) { PG8_SETV(vN, nxt); }
        else {
#pragma unroll
            for (int _i = 0; _i < 2; ++_i)
#pragma unroll
                for (int _h = 0; _h < 2; ++_h) vN[_i][_h] = vA[_i][_h];
        } }
        const char* nA = (!GATHER && has_next) ? (const char*)g.A + (size_t)nxt.pm * tstepA : cA;
        const char* nB = has_next ? (const char*)g.Bt + ((size_t)nxt.e * g.bstride) * 2 + (size_t)nxt.pn * tstepB : cB;
#pragma unroll 1
        for (int t = 0; t < nt; t += 2) {
            const bool last = (t == nt - 2);
            const char* a1 = cA + (size_t)(t + 1) * kstep;
            const char* a2 = last ? nA : cA + (size_t)(t + 2) * kstep; const char* b2 = last ? nB : cB + (size_t)(t + 2) * kstep;
            const char* a3 = a2 + kstep; const char* b3 = b2 + kstep;
            unsigned v2[2][2];
            if constexpr (GATHER) {
#pragma unroll
            for (int _i = 0; _i < 2; ++_i)
#pragma unroll
                for (int _h = 0; _h < 2; ++_h) v2[_i][_h] = last ? vN[_i][_h] : vA[_i][_h];
            }
            PG8_LDB(B0, 0, 0); PG8_LDB(B1, 0, 1); PG8_SCHED; PG8_LDA(At, 0, 0); PG8_STAGEA(PG8_SA(1, 1), a1, vA, 1);
            PG8_WAIT_V(8); PG8_WAIT_L(0); PG8_BAR; if (do0) PG8_MMA(0, 0, At, B0); if (do1) PG8_MMA(0, 1, At, B1); PG8_BAR; PG8_SCHED;
            PG8_LDA(At, 0, 1); PG8_STAGE(PG8_SB(0, 0), b2, voffB); PG8_STAGE(PG8_SB(0, 1), b2 + hstepB, voffB); PG8_STAGEA(PG8_SA(0, 0), a2, v2, 0);
            PG8_WAIT_V(8); PG8_WAIT_L(0); PG8_BAR; if (do0) PG8_MMA(1, 0, At, B0); if (do1) PG8_MMA(1, 1, At, B1); PG8_BAR; PG8_SCHED;
            PG8_LDB(B0, 1, 0); PG8_LDB(B1, 1, 1); PG8_SCHED; PG8_LDA(At, 1, 0); PG8_STAGEA(PG8_SA(0, 1), a2, v2, 1);
            PG8_WAIT_V(8); PG8_WAIT_L(0); PG8_BAR; if (do0) PG8_MMA(0, 0, At, B0); if (do1) PG8_MMA(0, 1, At, B1); PG8_BAR; PG8_SCHED;
            PG8_LDA(At, 1, 1); PG8_STAGE(PG8_SB(1, 0), b3, voffB); PG8_STAGE(PG8_SB(1, 1), b3 + hstepB, voffB); PG8_STAGEA(PG8_SA(1, 0), a3, v2, 0);
            PG8_WAIT_V(8); PG8_WAIT_L(0); PG8_BAR; if (do0) PG8_MMA(1, 0, At, B0); if (do1) PG8_MMA(1, 1, At, B1); PG8_BAR; PG8_SCHED;
        }
        if (wr == 0) PG8_BAR;
        E(acc, cur, wr, wc, fr, fq);
        if (!has_next) break;
#pragma unroll
        for (int a = 0; a < 2; ++a)
#pragma unroll
            for (int b = 0; b < 2; ++b)
#pragma unroll
                for (int m = 0; m < 4; ++m)
#pragma unroll
                    for (int n = 0; n < 2; ++n) acc[a][b][m][n] = (f32x4){0.f, 0.f, 0.f, 0.f};
        cur = nxt; cB = nB; cA = nA; ++ui;
        do0 = !Sched::HALF_UNITS || cur.half != 2; do1 = !Sched::HALF_UNITS || cur.half != 1;
        if constexpr (GATHER) {
#pragma unroll
        for (int _i = 0; _i < 2; ++_i)
#pragma unroll
            for (int _h = 0; _h < 2; ++_h) vA[_i][_h] = vN[_i][_h];
        }
        if (wr == 1) PG8_BAR;
    }
    PG8_WAIT_V(0);
    PG8_BAR;
#undef PG8_SA
#undef PG8_SB
#undef PG8_STAGE
#undef PG8_STAGEA
#undef PG8_LDA
#undef PG8_LDB
#undef PG8_MMA
#undef PG8_WAIT_V
#undef PG8_WAIT_L
#undef PG8_BAR
#undef PG8_SCHED
#undef PG8_SETV
}
}

namespace {
struct Params {
    const float *x, *c, *w_ada, *b_ada, *g_norm1, *w_in, *b_forget, *g_q_mla, *w_q_up, *g_kv_mla, *w_kv_up, *sinks, *w_out, *g_norm2,
                *w_router, *b_router, *w_gate, *w_up, *w_down, *g_final;
    float* xo;
    bf16_t* xb;
    unsigned* ctl;
    float* mod;
    bf16_t* WinT;
    bf16_t* WoutT;
    bf16_t* WqT;
    bf16_t* WkvT;
    bf16_t* WguT;
    bf16_t* WdT;
    float* ropetab;
    float* rq; float* rkv;
    float* cbF;
    bf16_t* kidx;
    uint32_t* mask;
    bf16_t* h;
    bf16_t* proj;
    bf16_t* qm; bf16_t* km; bf16_t* vm;
    bf16_t* merged;
    bf16_t* hid;
    bf16_t* ys;
    int* list;
    float* rw;
    float* wl;
    int wid;
    int qslot;
    int qslot_host;
};
constexpr int CW_BAR = 0;
constexpr int CW_CNT = 3584;
constexpr int CW_QA = 3648;
constexpr int CW_QD = 4288;
constexpr int CW_KN2 = 4992;
constexpr int CW_QN2 = CW_KN2 + 2 * NB * 4 * 32;
constexpr int CW_WORDS = CW_QN2 + 2 * NB * 4 * 8;
}

namespace {
constexpr long P0_B1 = 2l * NP * 128, P0_B2 = P0_B1 + 2l * 1024 * 128, P0_B3 = P0_B2 + 2l * 512 * 32, P0_B4 = P0_B3 + 2l * 512 * 16,
               P0_B5 = P0_B4 + 32l * 512 * 128, P0_B6 = P0_B5 + 32l * 1024 * 32;
__device__ __forceinline__ bf16_t* p0_fetch(const Params& p, long it, float (&v)[8]) {
    if (it < P0_B1) {
        const int l = (int)(it / (NP * 128)), r = (int)(it % (NP * 128)), n = r % NP, k0 = (r / NP) * 8, o = orig_col(n);
        const float* w = p.w_in + (size_t)l * D * NIN;
#pragma unroll
        for (int j = 0; j < 8; ++j) v[j] = o >= 0 ? __builtin_nontemporal_load(w + (size_t)(k0 + j) * NIN + o) : 0.f;
        return p.WinT + ((size_t)l * NP + n) * D + k0;
    } else if (it < P0_B2) {
        const long s = it - P0_B1; const int l = (int)(s / (1024 * 128)), r = (int)(s % (1024 * 128)), n = r & 1023, k0 = (r >> 10) * 8;
        const float* w = p.w_out + (size_t)l * D * D;
#pragma unroll
        for (int j = 0; j < 8; ++j) v[j] = __builtin_nontemporal_load(w + (size_t)(k0 + j) * D + n);
        return p.WoutT + ((size_t)l * D + n) * D + k0;
    } else if (it < P0_B3) {
        const long s = it - P0_B2; const int l = (int)(s / (512 * 32)), r = (int)(s % (512 * 32)), n = r & 511, k0 = (r >> 9) * 8;
        const float* w = p.w_q_up + (size_t)l * 256 * 384; const float* g = p.g_q_mla + l * 256;
#pragma unroll
        for (int j = 0; j < 8; ++j) v[j] = n < 384 ? g[k0 + j] * w[(size_t)(k0 + j) * 384 + n] : 0.f;
        return p.WqT + ((size_t)l * 512 + n) * 256 + k0;
    } else if (it < P0_B4) {
        const long s = it - P0_B3; const int l = (int)(s / (512 * 16)), r = (int)(s % (512 * 16)), n = r & 511, k0 = (r >> 9) * 8;
        const float* w = p.w_kv_up + (size_t)l * 128 * 512; const float* g = p.g_kv_mla + l * 128;
#pragma unroll
        for (int j = 0; j < 8; ++j) v[j] = g[k0 + j] * w[(size_t)(k0 + j) * 512 + n];
        return p.WkvT + ((size_t)l * 512 + n) * 128 + k0;
    } else if (it < P0_B5) {
        const long s = it - P0_B4; const int le = (int)(s >> 16), r = (int)(s & 65535), n = r & 511, k0 = (r >> 9) * 8;
        const int q = n >> 5, rr = n & 31, col = 16 * q + (rr & 15);
        const float* w = (rr < 16 ? p.w_gate : p.w_up) + (size_t)le * 1024 * 256;
#pragma unroll
        for (int j = 0; j < 8; ++j) v[j] = __builtin_nontemporal_load(w + (size_t)(k0 + j) * 256 + col);
        return p.WguT + ((size_t)le * 512 + n) * 1024 + k0;
    } else {
        const long s = it - P0_B5; const int le = (int)(s >> 15), r = (int)(s & 32767), n = r & 1023, k0 = (r >> 10) * 8;
        const float* w = p.w_down + (size_t)le * 256 * 1024;
#pragma unroll
        for (int j = 0; j < 8; ++j) v[j] = __builtin_nontemporal_load(w + (size_t)(k0 + j) * 1024 + n);
        return p.WdT + ((size_t)le * 1024 + n) * 256 + k0;
    }
}
__device__ __forceinline__ void p0_store(bf16_t* dst, const float (&v)[8]) {
    u32x4 w; w.x = cvt_pk_bf16(v[0], v[1]); w.y = cvt_pk_bf16(v[2], v[3]); w.z = cvt_pk_bf16(v[4], v[5]); w.w = cvt_pk_bf16(v[6], v[7]);
    *(u32x4*)dst = w;
}

__device__ __forceinline__ void phase_p0(const Params& p, char* lds) {
    const int tid = opaque_tid(p.wid), gtid = blockIdx.x * blockDim.x + tid, gthreads = gridDim.x * blockDim.x;
    for (long it0 = gtid; it0 < P0_B6; it0 += 4l * gthreads) {
        float va[8], vb[8], vc[8], vd[8];
        const bool hb = it0 + gthreads < P0_B6, hc = it0 + 2l * gthreads < P0_B6, hd = it0 + 3l * gthreads < P0_B6;
        bf16_t* da = p0_fetch(p, it0, va);
        bf16_t* db = hb ? p0_fetch(p, it0 + gthreads, vb) : da;
        bf16_t* dc = hc ? p0_fetch(p, it0 + 2l * gthreads, vc) : da;
        bf16_t* dd = hd ? p0_fetch(p, it0 + 3l * gthreads, vd) : da;
        p0_store(da, va);
        if (hb) p0_store(db, vb);
        if (hc) p0_store(dc, vc);
        if (hd) p0_store(dd, vd);
    }
    for (int it = gtid; it < 2048 * 16; it += gthreads) {
        const int pos = it >> 4, i = it & 15;
        const float inv = powf(10000.0f, -(float)i / 16.0f), ang = (float)pos * inv;
        p.ropetab[it * 2] = cosf(ang); p.ropetab[it * 2 + 1] = sinf(ang);
    }
    const int w = __builtin_amdgcn_readfirstlane(tid >> 6), lane = tid & 63;
    for (int u = blockIdx.x; u < 2 * (NMOD / 64); u += gridDim.x) {
        float* ca = (float*)lds;
        for (int i = tid; i < NB * 1024; i += 512) { const int bb = i >> 10, d = i & 1023; const float v = p.c[i]; ca[d * 32 + ((bb + 4 * (d & 7)) & 31)] = v / (1.f + __expf(-v)); }
        __syncthreads();
        const int l = u / (NMOD / 64), n0 = (u % (NMOD / 64)) * 64;
        const float* wp = p.w_ada + (size_t)l * 1024 * NMOD + n0 + lane;
        float acc[32];
#pragma unroll
        for (int j = 0; j < 32; ++j) acc[j] = 0.f;
        for (int d0 = 128 * w; d0 < 128 * w + 128; d0 += 16) {
            float wv[16];
#pragma unroll
            for (int q = 0; q < 16; ++q) wv[q] = wp[(size_t)(d0 + q) * NMOD];
#pragma unroll
            for (int q = 0; q < 16; ++q) {
                const int d = d0 + q;
#pragma unroll
                for (int i = 0; i < 8; ++i) {
                    const f32x4 cv = *(const f32x4*)(ca + d * 32 + (((i + (d & 7)) & 7) << 2));
                    acc[4 * i + 0] += cv[0] * wv[q]; acc[4 * i + 1] += cv[1] * wv[q]; acc[4 * i + 2] += cv[2] * wv[q]; acc[4 * i + 3] += cv[3] * wv[q];
                }
            }
        }
        __syncthreads();
        float* part = (float*)lds;
#pragma unroll
        for (int j = 0; j < 32; ++j) part[(w * 32 + j) * 64 + lane] = acc[j];
        __syncthreads();
        for (int o = tid; o < NB * 64; o += 512) {
            const int bb = o >> 6, col = o & 63;
            float sm = 0.f;
#pragma unroll
            for (int ww = 0; ww < 8; ++ww) sm += part[(ww * 32 + bb) * 64 + col];
            p.mod[((size_t)l * NB + bb) * NMOD + n0 + col] = sm + p.b_ada[l * NMOD + n0 + col];
        }
        __syncthreads();
    }
    __syncthreads();
}

template <int MODE>
__device__ __forceinline__ void phase_norm1(const Params& p, int l) {
#ifndef NORM_NT
#define NORM_NT 2
#endif
    constexpr int NT = NORM_NT;
    const int tid = opaque_tid(p.wid), w = tid >> 6, lane = tid & 63;
    const float* g = (MODE == 2) ? p.g_final : p.g_norm1 + l * D;
    const float* modl = p.mod + (size_t)(MODE == 2 ? 1 : l) * NB * NMOD;
    const float* modp = p.mod + (size_t)(MODE == 2 ? 1 : (l > 0 ? l - 1 : 0)) * NB * NMOD;
    f32x4 gg4[4];
#pragma unroll
    for (int k = 0; k < 4; ++k) gg4[k] = *(const f32x4*)(g + 4 * lane + 256 * k);
    const int nwv = gridDim.x * 8;
    const bool contig = (T % nwv == 0) && (2048 % (T / nwv) == 0) && ((T / nwv) % NT == 0);
    const int span = contig ? T / nwv : NT;
    for (int s0 = (blockIdx.x * 8 + w) * span; s0 < T; s0 += nwv * span) {
        const int b0 = s0 >> 11;
        f32x4 sc4[4], sh4[4], gt4[4];
        if (MODE != 2) {
#pragma unroll
            for (int k = 0; k < 4; ++k) { sc4[k] = *(const f32x4*)(modl + (size_t)b0 * NMOD + 1024 + 4 * lane + 256 * k); sh4[k] = *(const f32x4*)(modl + (size_t)b0 * NMOD + 4 * lane + 256 * k); }
        }
        if (MODE >= 1) {
#pragma unroll
            for (int k = 0; k < 4; ++k) gt4[k] = *(const f32x4*)(modp + (size_t)b0 * NMOD + 5 * 1024 + 4 * lane + 256 * k);
        }
        for (int t0 = s0; t0 < s0 + span; t0 += NT) {
        f32x4 v[NT][4];
#pragma unroll
        for (int u = 0; u < NT; ++u)
#pragma unroll
            for (int k = 0; k < 4; ++k) {
                if (MODE == 0) v[u][k] = __builtin_nontemporal_load((const f32x4*)(p.x + (size_t)(t0 + u) * D + 4 * lane + 256 * k));
                else { const u32x2 w2 = __builtin_nontemporal_load((const u32x2*)(p.xb + (size_t)(t0 + u) * D + 4 * lane + 256 * k)); v[u][k] = (f32x4){bflo(w2.x), bfhi(w2.x), bflo(w2.y), bfhi(w2.y)}; }
            }
        if (MODE >= 1) {
            u32x2 y0[NT][4], y1[NT][4];
#pragma unroll
            for (int u = 0; u < NT; ++u)
#pragma unroll
                for (int k = 0; k < 4; ++k) { const int col = 4 * lane + 256 * k;
                    y0[u][k] = __builtin_nontemporal_load((const u32x2*)(p.ys + ((size_t)(t0 + u) * 2 + 0) * D + col)); y1[u][k] = __builtin_nontemporal_load((const u32x2*)(p.ys + ((size_t)(t0 + u) * 2 + 1) * D + col)); }
#pragma unroll
            for (int u = 0; u < NT; ++u) {
                const int b = (t0 + u) >> 11;
#pragma unroll
                for (int k = 0; k < 4; ++k) {
                    const int col = 4 * lane + 256 * k;
                    const f32x4 gt = gt4[k];
                    v[u][k][0] += gt[0] * (bflo(y0[u][k].x) + bflo(y1[u][k].x)); v[u][k][1] += gt[1] * (bfhi(y0[u][k].x) + bfhi(y1[u][k].x));
                    v[u][k][2] += gt[2] * (bflo(y0[u][k].y) + bflo(y1[u][k].y)); v[u][k][3] += gt[3] * (bfhi(y0[u][k].y) + bfhi(y1[u][k].y));
                }
            }
        }
#pragma unroll
        for (int u = 0; u < NT; ++u) {
            const int t = t0 + u, b = t >> 11;
            float ss = 0.f;
#pragma unroll
            for (int k = 0; k < 4; ++k) ss += v[u][k][0] * v[u][k][0] + v[u][k][1] * v[u][k][1] + v[u][k][2] * v[u][k][2] + v[u][k][3] * v[u][k][3];
            ss = wave_sum(ss);
            const float r = rsqrtf(ss * (1.0f / D) + EPS);
#pragma unroll
            for (int k = 0; k < 4; ++k) {
                const int col = 4 * lane + 256 * k;
                f32x4 y = v[u][k] * r * gg4[k];
                if (MODE == 2) { __builtin_nontemporal_store(y, (f32x4*)(p.xo + (size_t)t * D + col)); }
                else {
                    if (MODE == 1) { u32x2 xw; xw.x = cvt_pk_bf16(v[u][k][0], v[u][k][1]); xw.y = cvt_pk_bf16(v[u][k][2], v[u][k][3]); *(u32x2*)(p.xb + (size_t)t * D + col) = xw; }
                    y = y * (1.f + sc4[k]) + sh4[k];
                    u32x2 o; o.x = cvt_pk_bf16(y[0], y[1]); o.y = cvt_pk_bf16(y[2], y[3]);
                    *(u32x2*)(p.h + (size_t)t * D + col) = o;
                }
            }
        }
        }
    }
}
}

namespace {
using pg8::Unit;
struct EpiStoreBf16 {
    static constexpr bool PERM = true;
    bf16_t* O; int ldc;
    __device__ __forceinline__ void operator()(const f32x4 (&acc)[2][2][4][2], const Unit& u, int wr, int wc, int fr_, int fq_) const {
        int fr = fr_, fq = fq_; asm volatile("" : "+v"(fr), "+v"(fq));
        const int row0 = u.pm * 256 + wr * 64 + fr, col0 = u.pn * 256 + wc * 32 + 8 * fq;
#pragma unroll
        for (int ai = 0; ai < 2; ++ai)
#pragma unroll
            for (int m = 0; m < 4; ++m) { bf16_t* rowp = O + (size_t)(row0 + ai * 128 + m * 16) * ldc + col0;
#pragma unroll
                for (int bj = 0; bj < 2; ++bj) { const f32x4 v0 = acc[ai][bj][m][0], v1 = acc[ai][bj][m][1];
                    u32x4 w; w.x = cvt_pk_bf16(v0[0], v0[1]); w.y = cvt_pk_bf16(v0[2], v0[3]); w.z = cvt_pk_bf16(v1[0], v1[1]); w.w = cvt_pk_bf16(v1[2], v1[3]);
                    *(u32x4*)(rowp + bj * 128) = w; } }
    }
};
struct EpiResidual {
    static constexpr bool PERM = false;
    const float* xin32; bf16_t* xb; const float* gate;
    __device__ __forceinline__ void operator()(const f32x4 (&acc)[2][2][4][2], const Unit& u, int wr, int wc, int fr_, int fq_) const {
        int fr = fr_, fq = fq_; asm volatile("" : "+v"(fr), "+v"(fq));
        const int row0 = u.pm * 256 + wr * 64 + fr, col0 = u.pn * 256 + wc * 32 + 4 * fq;
        const int b = (u.pm * 256) >> 11;
        f32x4 gv[2][2];
#pragma unroll
        for (int bj = 0; bj < 2; ++bj)
#pragma unroll
            for (int n = 0; n < 2; ++n) gv[bj][n] = *(const f32x4*)(gate + (size_t)b * NMOD + col0 + bj * 128 + n * 16);
#pragma unroll
        for (int ai = 0; ai < 2; ++ai)
#pragma unroll
            for (int m = 0; m < 4; ++m) { const size_t ro = (size_t)(row0 + ai * 128 + m * 16) * D + col0;
#pragma unroll
                for (int bj = 0; bj < 2; ++bj)
#pragma unroll
                    for (int n = 0; n < 2; ++n) { const size_t o = ro + bj * 128 + n * 16;
                        f32x4 xv;
                        if (xin32) xv = *(const f32x4*)(xin32 + o);
                        else { const u32x2 w = *(const u32x2*)(xb + o); xv = (f32x4){bflo(w.x), bfhi(w.x), bflo(w.y), bfhi(w.y)}; }
                        const f32x4 r = xv + gv[bj][n] * acc[ai][bj][m][n];
                        u32x2 ow; ow.x = cvt_pk_bf16(r[0], r[1]); ow.y = cvt_pk_bf16(r[2], r[3]);
                        *(u32x2*)(xb + o) = ow; } }
    }
};
struct EpiMlaQ {
    static constexpr bool PERM = true;
    bf16_t* qm;
    __device__ __forceinline__ void operator()(const f32x4 (&acc)[2][2][4][2], const Unit& u, int wr, int wc, int fr_, int fq_) const {
        int fr = fr_, fq = fq_; asm volatile("" : "+v"(fr), "+v"(fq));
        const int row0 = u.pm * 256 + wr * 64 + fr;
#pragma unroll
        for (int bj = 0; bj < 2; ++bj) {
            const int col0 = u.pn * 256 + bj * 128 + wc * 32;
            if (col0 >= 384) continue;
#pragma unroll
            for (int ai = 0; ai < 2; ++ai)
#pragma unroll
                for (int m = 0; m < 4; ++m) { const f32x4 v0 = acc[ai][bj][m][0], v1 = acc[ai][bj][m][1];
                    u32x4 w; w.x = cvt_pk_bf16(v0[0], v0[1]); w.y = cvt_pk_bf16(v0[2], v0[3]); w.z = cvt_pk_bf16(v1[0], v1[1]); w.w = cvt_pk_bf16(v1[2], v1[3]);
                    *(u32x4*)(qm + (size_t)(row0 + ai * 128 + m * 16) * 384 + col0 + 8 * fq) = w; }
        }
    }
};
struct EpiMlaKV {
    static constexpr bool PERM = true;
    bf16_t* km; bf16_t* vm;
    __device__ __forceinline__ void operator()(const f32x4 (&acc)[2][2][4][2], const Unit& u, int wr, int wc, int fr_, int fq_) const {
        int fr = fr_, fq = fq_; asm volatile("" : "+v"(fr), "+v"(fq));
        const int row0 = u.pm * 256 + wr * 64 + fr;
#pragma unroll
        for (int bj = 0; bj < 2; ++bj) {
            const int head = u.pn * 2 + bj, wcol = wc * 32 + 8 * fq;
#pragma unroll
            for (int ai = 0; ai < 2; ++ai)
#pragma unroll
                for (int m = 0; m < 4; ++m) {
                    const int row = row0 + ai * 128 + m * 16;
                    const f32x4 v0 = acc[ai][bj][m][0], v1 = acc[ai][bj][m][1];
                    u32x4 w; w.x = cvt_pk_bf16(v0[0], v0[1]); w.y = cvt_pk_bf16(v0[2], v0[3]); w.z = cvt_pk_bf16(v1[0], v1[1]); w.w = cvt_pk_bf16(v1[2], v1[3]);
                    bf16_t* q = (wcol < 64) ? km + (size_t)row * 384 + head * 96 + wcol : vm + (size_t)row * 256 + head * 64 + (wcol - 64);
                    *(u32x4*)q = w;
                    asm volatile("" ::: "memory");
                }
        }
    }
};
struct EpiGateUp {
    static constexpr bool PERM = false;
    bf16_t* hid;
    __device__ __forceinline__ void operator()(const f32x4 (&acc)[2][2][4][2], const Unit& u, int wr, int wc, int fr_, int fq_) const {
        int fr = fr_, fq = fq_; asm volatile("" : "+v"(fr), "+v"(fq));
        const int row0 = u.pm * 256 + wr * 64 + fr;
#pragma unroll
        for (int ai = 0; ai < 2; ++ai)
#pragma unroll
            for (int m = 0; m < 4; ++m) { bf16_t* rowp = hid + (size_t)(row0 + ai * 128 + m * 16) * 256;
#pragma unroll
                for (int bj = 0; bj < 2; ++bj) { if (u.half != 0 && u.half != bj + 1) continue;
                    const f32x4 gt = acc[ai][bj][m][0], up = acc[ai][bj][m][1];
                    f32x4 o;
#pragma unroll
                    for (int j = 0; j < 4; ++j) o[j] = gt[j] / (1.f + __expf(-gt[j])) * up[j];
                    u32x2 w; w.x = cvt_pk_bf16(o[0], o[1]); w.y = cvt_pk_bf16(o[2], o[3]);
                    *(u32x2*)(rowp + 16 * (u.pn * 8 + bj * 4 + wc) + 4 * fq) = w; } }
    }
};
struct EpiDown {
    static constexpr bool PERM = true;
    bf16_t* ys; const int* list; const float* wl; const int* cnt;
    __device__ __forceinline__ void operator()(const f32x4 (&acc)[2][2][4][2], const Unit& u, int wr, int wc, int fr_, int fq_) const {
        int fr = fr_, fq = fq_; asm volatile("" : "+v"(fr), "+v"(fq));
        const int n = cnt[u.e]; const int* le = list + (size_t)u.e * ECAP; const float* we = wl + (size_t)u.e * ECAP;
        const int col0 = u.pn * 256 + wc * 32 + 8 * fq;
        int slot[8]; float w8[8];
#pragma unroll
        for (int q = 0; q < 8; ++q) { const int lr = u.mt * 256 + (q >> 2) * 128 + wr * 64 + (q & 3) * 16 + fr; slot[q] = lr < n ? le[lr] : -1; w8[q] = lr < n ? we[lr] : 0.f; }
#pragma unroll
        for (int ai = 0; ai < 2; ++ai)
#pragma unroll
            for (int m = 0; m < 4; ++m) {
                const int q = ai * 4 + m;
                if (slot[q] >= 0) {
                    bf16_t* rowp = ys + (size_t)slot[q] * D + col0;
#pragma unroll
                    for (int bj = 0; bj < 2; ++bj) { if (u.half != 0 && u.half != bj + 1) continue;
                        const f32x4 v0 = acc[ai][bj][m][0] * w8[q], v1 = acc[ai][bj][m][1] * w8[q];
                        u32x4 w; w.x = cvt_pk_bf16(v0[0], v0[1]); w.y = cvt_pk_bf16(v0[2], v0[3]); w.z = cvt_pk_bf16(v1[0], v1[1]); w.w = cvt_pk_bf16(v1[2], v1[3]);
                        *(u32x4*)(rowp + bj * 128) = w; }
                }
            }
    }
};
struct MoeOrder {
    static constexpr bool HALF_UNITS = true;
    int pre[17];
    int NT, G, c; const int* list; const int* cnt;
    __device__ __forceinline__ void init(const int* cnt_, const int* list_, int NT_, int G_, int c_) {
        cnt = cnt_; list = list_; NT = NT_; G = G_; c = c_; int a = 0;
#pragma unroll
        for (int e = 0; e < 16; ++e) { pre[e] = a; a += (cnt_[e] + 255) >> 8; }
        pre[16] = a;
    }
    __device__ __forceinline__ bool next(int i, Unit& u) const {
        int t, pn, hf = 0;
        if ((G & 7) == 0 && ((G >> 3) % (2 * NT)) == 0) {
            const int per = (G >> 3) / NT, xcd = c & 7, j = c >> 3, R = 8 * per, F = pre[16] / R, rem = pre[16] - F * R;
            if (i < F || rem > 4 * per) { t = (i * 8 + xcd) * per + j / NT; pn = j % NT; if (t >= pre[16]) return false; }
            else {
                if (i > F) return false;
                t = F * R + (j / (2 * NT)) * 8 + xcd; if (t >= pre[16]) return false;
                const int piece = j % (2 * NT); pn = piece >> 1; hf = 1 + (piece & 1);
            }
        }
        else { const int L = i * G + c; if (L >= pre[16] * NT) return false; t = L / NT; pn = L - t * NT; }
        int e = 0;
#pragma unroll
        for (int k = 1; k < 16; ++k) e += (t >= pre[k]) ? 1 : 0;
        int pe = 0;
#pragma unroll
        for (int k = 0; k < 16; ++k) pe = (k == e) ? pre[k] : pe;
        u.e = e; u.mt = t - pe; u.pm = t; u.pn = pn; u.half = hf; return true;
    }
    __device__ __forceinline__ int arow(const Unit& u, int r) const { const int lr = u.mt * 256 + r; return lr < cnt[u.e] ? (list[(size_t)u.e * ECAP + lr] >> 1) : 0; }
};
}

namespace {
__device__ __forceinline__ void phase_prep(const Params& p, int l) {
    const int tid = opaque_tid(p.wid), w = tid >> 6, lane = tid & 63;
    const int gw = blockIdx.x * 8 + w, nw = gridDim.x * 8;
    for (int sq = gw; sq < NB * 4; sq += nw) {
        const int b = sq >> 2, hh = sq & 3; const float bias = p.b_forget[l * 4 + hh];
        float lf[32]; float run = 0.f;
#pragma unroll
        for (int j = 0; j < 32; ++j) {
            const float z = bf2f(p.proj[(size_t)(b * S + lane * 32 + j) * NP + PC_AF + hh]) + bias;
            run += fminf(z, 0.f) - log1pf(__expf(-fabsf(z)));
            lf[j] = run;
        }
        float incl = run;
#pragma unroll
        for (int o = 1; o < 64; o <<= 1) { const float t2 = __shfl_up(incl, o); if (lane >= o) incl += t2; }
        const float excl = incl - run;
#pragma unroll
        for (int j = 0; j < 32; ++j) p.cbF[(size_t)sq * S + lane * 32 + j] = -(excl + lf[j]) * LOG2E;
    }
    for (int c32 = gw; c32 < T / 32; c32 += nw) {
    float mxq = 0.f, mxk = 0.f;
#define PREP_LOAD(u, tt) do { const bf16_t* _row = p.proj + (size_t)(tt) * NP; \
        n_cq[u] = *(const u32x2*)(_row + PC_BCQ + 4 * lane); n_ck[u] = *(const unsigned*)(_row + PC_BCKV + 2 * lane); \
        n_aq[u] = *(const u32x2*)(_row + PC_AQ + 4 * lane); n_ak[u] = *(const u32x2*)(_row + PC_AK + 4 * lane); \
        n_ki[u] = *(const u32x4*)(_row + PC_DKI + 8 * (lane & 3)); n_kr[u] = _row[PC_BKR + (lane & 31)]; } while (0)
    u32x2 n_cq[4], n_aq[4], n_ak[4]; unsigned n_ck[4]; u32x4 n_ki[4]; bf16_t n_kr[4];
#pragma unroll
    for (int u = 0; u < 4; ++u) PREP_LOAD(u, c32 * 32 + u);
    for (int it = 0; it < 32; it += 4) {
        u32x2 c_cq[4], c_aq[4], c_ak[4]; unsigned c_ck[4]; u32x4 c_ki[4]; bf16_t c_kr[4];
#pragma unroll
        for (int u = 0; u < 4; ++u) { c_cq[u] = n_cq[u]; c_aq[u] = n_aq[u]; c_ak[u] = n_ak[u]; c_ck[u] = n_ck[u]; c_ki[u] = n_ki[u]; c_kr[u] = n_kr[u]; }
        if (it < 28) {
#pragma unroll
            for (int u = 0; u < 4; ++u) PREP_LOAD(u, c32 * 32 + it + 4 + u);
        }
#pragma unroll
        for (int u = 0; u < 4; ++u) {
        const int t = c32 * 32 + it + u;
        const u32x2 cq = c_cq[u], aq = c_aq[u], ak = c_ak[u]; const unsigned ck = c_ck[u]; const u32x4 ki = c_ki[u]; const bf16_t krb = c_kr[u];
        float s1 = bflo(cq.x) * bflo(cq.x) + bfhi(cq.x) * bfhi(cq.x) + bflo(cq.y) * bflo(cq.y) + bfhi(cq.y) * bfhi(cq.y);
        float s2 = bflo(ck) * bflo(ck) + bfhi(ck) * bfhi(ck);
        s1 = wave_sum(s1); s2 = wave_sum(s2);
        if (lane < 4) *(u32x4*)(p.kidx + (size_t)t * 32 + 8 * lane) = ki;
        {
            float nq = bflo(aq.x) * bflo(aq.x) + bfhi(aq.x) * bfhi(aq.x) + bflo(aq.y) * bflo(aq.y) + bfhi(aq.y) * bfhi(aq.y);
            float nk = bflo(ak.x) * bflo(ak.x) + bfhi(ak.x) * bfhi(ak.x) + bflo(ak.y) * bflo(ak.y) + bfhi(ak.y) * bfhi(ak.y);
            nq = row_sum16(nq); nk = row_sum16(nk);
            mxq = fmaxf(mxq, nq); mxk = fmaxf(mxk, nk);
        }
        const float kr = (lane < 32) ? bf2f(krb) : 0.f;
        const float kr2 = __shfl(kr, (lane + 16) & 63);
        {
            const float r1 = rsqrtf(s1 * (1.f / 256.f) + EPS), r2 = rsqrtf(s2 * (1.f / 128.f) + EPS);
            u32x2 o; o.x = cvt_pk_bf16(bflo(cq.x) * r1, bfhi(cq.x) * r1); o.y = cvt_pk_bf16(bflo(cq.y) * r1, bfhi(cq.y) * r1);
            *(u32x2*)(p.proj + (size_t)t * NP + PC_BCQ + 4 * lane) = o;
            *(unsigned*)(p.proj + (size_t)t * NP + PC_BCKV + 2 * lane) = cvt_pk_bf16(bflo(ck) * r2, bfhi(ck) * r2);
        }
        if (lane < 16) {
            const int pos = t & (S - 1);
            const float cs = p.ropetab[(pos * 16 + lane) * 2], sn = p.ropetab[(pos * 16 + lane) * 2 + 1];
            const bf16_t o1 = f2bf(kr * cs - kr2 * sn), o2 = f2bf(kr2 * cs + kr * sn);
            bf16_t* kmr = p.km + (size_t)t * 384;
            kmr[64 + lane] = o1; kmr[80 + lane] = o2;
        }
        }
    }
#undef PREP_LOAD
    if ((lane & 15) == 0) {
        const int t = c32 * 32, bb = t >> 11, pos = t & (S - 1), hh = lane >> 4;
        atomicMax(p.ctl + CW_KN2 + ((l * NB + bb) * 4 + hh) * 32 + (pos >> 6), __float_as_uint(mxk));
        atomicMax(p.ctl + CW_QN2 + ((l * NB + bb) * 4 + hh) * 8 + (pos >> 8), __float_as_uint(mxq));
    }
    }
}

__device__ __forceinline__ void phase_route(const Params& p, int l, char* lds) {
    const int tid = opaque_tid(p.wid), w = tid >> 6, lane = tid & 63;
    float* wrT = (float*)lds;
    int* lcnt = (int*)(lds + 65536);
    int* lbase = (int*)(lds + 65536 + 64);
    int* tsel = (int*)(lds + 65536 + 128);
    float* twt = (float*)(lds + 65536 + 128 + 2048);
    float* lgt = (float*)(lds + 65536 + 8192);
    for (int i = tid; i < 16 * 1024; i += 512) { const int e = i >> 10, d = i & 1023; wrT[i] = p.w_router[d * 16 + e]; }
    const float* g = p.g_norm2 + l * D;
    const float* modl = p.mod + (size_t)l * NB * NMOD;
    int* cnt = (int*)(p.ctl + CW_CNT) + l * 16 + 32 * p.qslot;
    int* list = p.list + (size_t)p.qslot * 16 * ECAP;
    for (int chunk = blockIdx.x; chunk < T / 256; chunk += gridDim.x) {
        if (tid < 16) lcnt[tid] = 0;
        __syncthreads();
        const int b = (chunk * 256) >> 11;
        f32x4 gs4[4], sh4[4];
#pragma unroll
        for (int k = 0; k < 4; ++k) { const int col = 4 * lane + 256 * k; const f32x4 gg = *(const f32x4*)(g + col);
            const f32x4 sc = *(const f32x4*)(modl + (size_t)b * NMOD + 4 * 1024 + col); gs4[k] = gg * (1.f + sc); sh4[k] = *(const f32x4*)(modl + (size_t)b * NMOD + 3 * 1024 + col); }
        const int eown = ((lane >> 5) & 1) * 8 + ((lane >> 4) & 1) * 4 + ((lane >> 3) & 1) * 2 + ((lane >> 2) & 1);
        u32x2 raw[2][4];
#pragma unroll
        for (int q = 0; q < 2; ++q)
#pragma unroll
            for (int k = 0; k < 4; ++k) raw[q][k] = __builtin_nontemporal_load((const u32x2*)(p.xb + (size_t)(chunk * 256 + w * 32 + q) * D + 4 * lane + 256 * k));
        for (int it = 0; it < 32; it += 2) {
            const int li = w * 32 + it, t = chunk * 256 + li;
            f32x4 v[2][4];
#pragma unroll
            for (int q = 0; q < 2; ++q)
#pragma unroll
                for (int k = 0; k < 4; ++k) v[q][k] = (f32x4){bflo(raw[q][k].x), bfhi(raw[q][k].x), bflo(raw[q][k].y), bfhi(raw[q][k].y)};
            if (it < 30) {
#pragma unroll
                for (int q = 0; q < 2; ++q)
#pragma unroll
                    for (int k = 0; k < 4; ++k) raw[q][k] = __builtin_nontemporal_load((const u32x2*)(p.xb + (size_t)(t + 2 + q) * D + 4 * lane + 256 * k));
            }
            float ss0 = 0.f, ss1 = 0.f;
#pragma unroll
            for (int k = 0; k < 4; ++k) { ss0 += v[0][k][0] * v[0][k][0] + v[0][k][1] * v[0][k][1] + v[0][k][2] * v[0][k][2] + v[0][k][3] * v[0][k][3];
                                          ss1 += v[1][k][0] * v[1][k][0] + v[1][k][1] * v[1][k][1] + v[1][k][2] * v[1][k][2] + v[1][k][3] * v[1][k][3]; }
            ss0 = wave_sum(ss0); ss1 = wave_sum(ss1);
            const float r0 = rsqrtf(ss0 * (1.0f / D) + EPS), r1 = rsqrtf(ss1 * (1.0f / D) + EPS);
            f32x2 lgp[16];
#pragma unroll
            for (int e = 0; e < 16; ++e) lgp[e] = (f32x2){0.f, 0.f};
#pragma unroll
            for (int k = 0; k < 4; ++k) {
                const int col = 4 * lane + 256 * k;
                const f32x4 y0 = v[0][k] * r0 * gs4[k] + sh4[k], y1 = v[1][k] * r1 * gs4[k] + sh4[k];
                u32x2 o0, o1; o0.x = cvt_pk_bf16(y0[0], y0[1]); o0.y = cvt_pk_bf16(y0[2], y0[3]); o1.x = cvt_pk_bf16(y1[0], y1[1]); o1.y = cvt_pk_bf16(y1[2], y1[3]);
                *(u32x2*)(p.h + (size_t)t * D + col) = o0; *(u32x2*)(p.h + (size_t)(t + 1) * D + col) = o1;
                const f32x2 yp0 = {y0[0], y1[0]}, yp1 = {y0[1], y1[1]}, yp2 = {y0[2], y1[2]}, yp3 = {y0[3], y1[3]};
#pragma unroll
                for (int e = 0; e < 16; ++e) { const f32x4 wv = *(const f32x4*)(wrT + e * 1024 + col);
                    lgp[e] = __builtin_elementwise_fma(yp0, (f32x2){wv[0], wv[0]}, lgp[e]); lgp[e] = __builtin_elementwise_fma(yp1, (f32x2){wv[1], wv[1]}, lgp[e]);
                    lgp[e] = __builtin_elementwise_fma(yp2, (f32x2){wv[2], wv[2]}, lgp[e]); lgp[e] = __builtin_elementwise_fma(yp3, (f32x2){wv[3], wv[3]}, lgp[e]); }
                asm volatile("" ::: "memory");
            }
#pragma unroll
            for (int q = 0; q < 2; ++q) {
                float lg[16];
#pragma unroll
                for (int e = 0; e < 16; ++e) lg[e] = lgp[e][q];
                float a8[8], a4[4], a2[2], a1;
                { const bool hi = (lane & 32) != 0;
#pragma unroll
                  for (int e = 0; e < 8; ++e) { const float send = hi ? lg[e] : lg[e + 8], keep = hi ? lg[e + 8] : lg[e]; a8[e] = keep + __shfl_xor(send, 32); } }
                { const bool hi = (lane & 16) != 0;
#pragma unroll
                  for (int e = 0; e < 4; ++e) { const float send = hi ? a8[e] : a8[e + 4], keep = hi ? a8[e + 4] : a8[e]; a4[e] = keep + __shfl_xor(send, 16); } }
                { const bool hi = (lane & 8) != 0;
#pragma unroll
                  for (int e = 0; e < 2; ++e) { const float send = hi ? a4[e] : a4[e + 2], keep = hi ? a4[e + 2] : a4[e]; a2[e] = keep + __shfl_xor(send, 8); } }
                { const bool hi = (lane & 4) != 0; const float send = hi ? a2[0] : a2[1], keep = hi ? a2[1] : a2[0]; a1 = keep + __shfl_xor(send, 4); }
                a1 += __shfl_xor(a1, 2); a1 += __shfl_xor(a1, 1);
                if ((lane & 3) == 0) lgt[(li + q) * 16 + eown] = a1;
            }
        }
        asm volatile("s_waitcnt lgkmcnt(0)" ::: "memory");
        __builtin_amdgcn_wave_barrier();
        if (lane < 32) {
            const int li = w * 32 + lane;
            float sc[16], bi[16];
#pragma unroll
            for (int e4 = 0; e4 < 4; ++e4) { const f32x4 a = *(const f32x4*)(lgt + li * 16 + 4 * e4);
#pragma unroll
                for (int j = 0; j < 4; ++j) { const float sg = 1.f / (1.f + expf(-a[j])); sc[4 * e4 + j] = sg; bi[4 * e4 + j] = sg + p.b_router[4 * e4 + j]; } }
            int bg = 0; float bgs = -INFINITY;
#pragma unroll
            for (int gi = 0; gi < 4; ++gi) {
                float m1 = -INFINITY, m2 = -INFINITY;
#pragma unroll
                for (int j = 0; j < 4; ++j) { const float vv = bi[gi * 4 + j]; if (vv > m1) { m2 = m1; m1 = vv; } else if (vv > m2) m2 = vv; }
                const float gs = m1 + m2; if (gs > bgs) { bgs = gs; bg = gi; }
            }
            float b4[4], s4[4];
#pragma unroll
            for (int j = 0; j < 4; ++j) { b4[j] = bi[j]; s4[j] = sc[j]; }
#pragma unroll
            for (int gi = 1; gi < 4; ++gi)
#pragma unroll
                for (int j = 0; j < 4; ++j) { b4[j] = (gi == bg) ? bi[gi * 4 + j] : b4[j]; s4[j] = (gi == bg) ? sc[gi * 4 + j] : s4[j]; }
            int i1 = 0; float v1 = -INFINITY;
#pragma unroll
            for (int j = 0; j < 4; ++j) { if (b4[j] > v1) { v1 = b4[j]; i1 = j; } }
            int i2 = 0; float v2 = -INFINITY;
#pragma unroll
            for (int j = 0; j < 4; ++j) { if (j != i1 && b4[j] > v2) { v2 = b4[j]; i2 = j; } }
            float w1 = 0.f, w2 = 0.f;
#pragma unroll
            for (int j = 0; j < 4; ++j) { w1 = (j == i1) ? s4[j] : w1; w2 = (j == i2) ? s4[j] : w2; }
            const int e1 = bg * 4 + i1, e2 = bg * 4 + i2; const float ws = w1 + w2;
            const int r1 = atomicAdd(&lcnt[e1], 1), r2 = atomicAdd(&lcnt[e2], 1);
            tsel[li * 2 + 0] = (e1 << 16) | r1; tsel[li * 2 + 1] = (e2 << 16) | r2;
            twt[li * 2 + 0] = w1 / ws; twt[li * 2 + 1] = w2 / ws;
        }
        __syncthreads();
        if (tid < 16) lbase[tid] = atomicAdd(&cnt[tid], lcnt[tid]);
        __syncthreads();
        { const int v = tsel[tid], e = v >> 16, rk = v & 0xFFFF; const size_t pos = (size_t)e * ECAP + lbase[e] + rk;
          list[pos] = (chunk * 256 + (tid >> 1)) * 2 + (tid & 1); p.wl[pos + (size_t)p.qslot * 16 * ECAP] = twt[tid]; }
        __syncthreads();
    }
}
}

#ifndef ATTN_VMASK
#define ATTN_VMASK 15
#endif
#ifndef REPK_VMASK
#define REPK_VMASK 15
#endif
namespace {
constexpr int AT_NS = 4;
constexpr int AT_SLOT = 21504;
constexpr int AT_K = 0;
constexpr int AT_V = 8192;
constexpr int AT_R = 16384;
constexpr int AT_C = 20480;
constexpr int AT_CTL = AT_NS * AT_SLOT;
constexpr int AT_MW = AT_CTL + 512;
constexpr int AT_LDS = AT_MW + 64 * 272;
constexpr float NEGBIG = -1.0e30f;

#define AT_TR(dst, a, off) asm volatile("ds_read_b64_tr_b16 %0, %1 offset:%2" : "=v"(dst) : "v"(a), "n"(off))
#define AT_TR2(c, dt) { const unsigned a_ = vaddr + (unsigned)((((dt) ^ swv)) << 5); AT_TR(vt[c][dt][0], a_, AT_V + (c) * 4096); AT_TR(vt[c][dt][1], a_, AT_V + (c) * 4096 + 2048); }
#define AT_TIE(n, c) asm volatile("s_waitcnt lgkmcnt(" #n ")" : "+v"(vt[c][0][0]), "+v"(vt[c][0][1]), "+v"(vt[c][1][0]), "+v"(vt[c][1][1]), \
                                                                  "+v"(vt[c][2][0]), "+v"(vt[c][2][1]), "+v"(vt[c][3][0]), "+v"(vt[c][3][1]))

#define AT_PIN(x) asm volatile("" : "+v"(x))
#define AT_BAR() do { __builtin_amdgcn_sched_barrier(0); __builtin_amdgcn_s_barrier(); asm volatile("" ::: "memory"); __builtin_amdgcn_sched_barrier(0); } while (0)

template <int VAR, bool FULL>
__device__ __forceinline__ void at_cinit(const LAS3 char* sb, const int j, const int q0, const int i, const int g, const float slope2, const LAS3 char* mwl, const f32x4 (&ab0)[4], f32x4 (&s)[2][4], const int qa = 0, const int qb_ = 2) {
#pragma unroll
    for (int qt = 0; qt < 2; ++qt) if (qt >= qa && qt < qb_) {
        const int t = q0 + 16 * qt + i;
        const int dbase = 64 * j + 4 * g - t;
        const float sb2 = slope2 * ((VAR == 2) ? (float)dbase : (float)(64 * j + 4 * g));
#pragma unroll
        for (int mt = 0; mt < 4; ++mt) {
            f32x4 ini = {0.f, 0.f, 0.f, 0.f};
            if (VAR == 0) ini = *(const LAS3 f32x4*)(sb + AT_C + (16 * mt + 4 * g) * 4);
            u32x4 mw4 = {0u, 0u, 0u, 0u};
            if (VAR == 3) mw4 = *(const LAS3 u32x4*)(mwl + qt * (16 * 272) + mt * 64);
#pragma unroll
            for (int r = 0; r < 4; ++r) {
                const int c = 16 * mt + r;
                float v = ini[r];
                if (VAR == 2) v = sb2 + slope2 * (float)c;
                if (VAR == 3) v = ab0[mt][r];
                if (VAR == 3) {
                    const int m = __builtin_amdgcn_sbfe((int)mw4[r], j, 1);
                    v = __uint_as_float((__float_as_uint(v) & (unsigned)m) | (__float_as_uint(NEGBIG) & ~(unsigned)m));
                } else if (!FULL) {
                    bool ok;
                    if (VAR == 2) ok = (unsigned)(dbase + c + 127) < 128u;
                    else ok = (dbase + c) <= 0;
                    v = ok ? v : NEGBIG;
                }
                ini[r] = v;
            }
            s[qt][mt] = ini;
        }
    }
}
template <int VAR, int KC>
__device__ __forceinline__ void at_qk(const LAS3 char* sb, const int i, const int g, const int swk, const bf16x8 (&qf)[2][KC], f32x4 (&s)[2][4], const int qa = 0, const int qb_ = 2) {
    const LAS3 char* Kb = sb + AT_K;
#pragma unroll
    for (int mt = 0; mt < 4; ++mt) {
#pragma unroll
        for (int kc = 0; kc < 2; ++kc) {
            const bf16x8 kf = *(const LAS3 bf16x8*)(Kb + (mt * 16 + i) * 128 + (((kc * 4 + g) ^ swk) << 4));
#pragma unroll
            for (int qt = 0; qt < 2; ++qt) if (qt >= qa && qt < qb_) s[qt][mt] = __builtin_amdgcn_mfma_f32_16x16x32_bf16(kf, qf[qt][kc], s[qt][mt], 0, 0, 0);
        }
        if (VAR == 1) {
            const bf16x8 kf = *(const LAS3 bf16x8*)(sb + AT_R + (mt * 16 + i) * 64 + ((g ^ (swk & 3)) << 4));
#pragma unroll
            for (int qt = 0; qt < 2; ++qt) if (qt >= qa && qt < qb_) s[qt][mt] = __builtin_amdgcn_mfma_f32_16x16x32_bf16(kf, qf[qt][KC - 1], s[qt][mt], 0, 0, 0);
        }
    }
}
__device__ __forceinline__ void at_max(const f32x4 (&s)[2][4], float (&mx)[2], const float toff = 0.f) {
#pragma unroll
    for (int qt = 0; qt < 2; ++qt) {
        float m = fmaxf(fmaxf(s[qt][0][0], s[qt][0][1]), fmaxf(s[qt][0][2], s[qt][0][3]));
#pragma unroll
        for (int mt = 1; mt < 4; ++mt) m = fmaxf(m, fmaxf(fmaxf(s[qt][mt][0], s[qt][mt][1]), fmaxf(s[qt][mt][2], s[qt][mt][3])));
        mx[qt] = xor32_max(xor16_max(m)) + toff;
    }
}
__device__ __forceinline__ void at_max2(const f32x4 (&sa)[2][4], const f32x4 (&sb_)[2][4], float (&mx)[2], const float toffa = 0.f, const float toffb = 0.f) {
#pragma unroll
    for (int qt = 0; qt < 2; ++qt) {
        float m = fmaxf(fmaxf(sa[qt][0][0], sa[qt][0][1]), fmaxf(sa[qt][0][2], sa[qt][0][3]));
        float n = fmaxf(fmaxf(sb_[qt][0][0], sb_[qt][0][1]), fmaxf(sb_[qt][0][2], sb_[qt][0][3]));
#pragma unroll
        for (int mt = 1; mt < 4; ++mt) { m = fmaxf(m, fmaxf(fmaxf(sa[qt][mt][0], sa[qt][mt][1]), fmaxf(sa[qt][mt][2], sa[qt][mt][3])));
                                         n = fmaxf(n, fmaxf(fmaxf(sb_[qt][mt][0], sb_[qt][mt][1]), fmaxf(sb_[qt][mt][2], sb_[qt][mt][3]))); }
        mx[qt] = xor32_max(xor16_max(fmaxf(m + toffa, n + toffb)));
    }
}
__device__ __forceinline__ void at_rescale(const float (&mx)[2], f32x4 (&o)[2][4], float (&mrow)[2], float (&lsum)[2]) {
    if (__any(mx[0] > mrow[0] + 8.f || mx[1] > mrow[1] + 8.f)) {
#pragma unroll
        for (int qt = 0; qt < 2; ++qt) {
            const float mn = fmaxf(mrow[qt], mx[qt]), alpha = __builtin_amdgcn_exp2f(mrow[qt] - mn);
            mrow[qt] = mn; lsum[qt] *= alpha;
#pragma unroll
            for (int dt = 0; dt < 4; ++dt) o[qt][dt] = o[qt][dt] * alpha;
        }
    }
}
__device__ __forceinline__ void at_exp(const f32x4 (&s)[2][4], const float (&mrow)[2], float (&lsum)[2], bf16x8 (&pf)[2][2], const int qa = 0, const int qb_ = 2, const float toff = 0.f) {
#pragma unroll
    for (int qt = 0; qt < 2; ++qt) if (qt >= qa && qt < qb_) {
        const float mn = mrow[qt] - toff;
        const f32x4 mn4 = {mn, mn, mn, mn};
        f32x4 ps4 = {0.f, 0.f, 0.f, 0.f};
        float x[4][4];
#pragma unroll
        for (int mt = 0; mt < 4; ++mt) {
            const f32x4 d4 = s[qt][mt] - mn4;
            f32x4 e4;
#pragma unroll
            for (int r = 0; r < 4; ++r) { e4[r] = __builtin_amdgcn_exp2f(d4[r]); x[mt][r] = e4[r]; }
            ps4 += e4;
        }
        lsum[qt] += (ps4[0] + ps4[1]) + (ps4[2] + ps4[3]);
#pragma unroll
        for (int c = 0; c < 2; ++c) {
            u32x4 pk; pk.x = cvt_pk_bf16(x[2 * c][0], x[2 * c][1]); pk.y = cvt_pk_bf16(x[2 * c][2], x[2 * c][3]);
            pk.z = cvt_pk_bf16(x[2 * c + 1][0], x[2 * c + 1][1]); pk.w = cvt_pk_bf16(x[2 * c + 1][2], x[2 * c + 1][3]);
            pf[qt][c] = __builtin_bit_cast(bf16x8, pk);
        }
    }
}
__device__ __forceinline__ void at_vread(const unsigned vaddr, const int swv, u32x2 (&vt)[2][4][2]) {
    AT_TR2(0, 0) AT_TR2(0, 1) AT_TR2(0, 2) AT_TR2(0, 3) AT_TR2(1, 0) AT_TR2(1, 1) AT_TR2(1, 2) AT_TR2(1, 3)
}
__device__ __forceinline__ void at_pv(u32x2 (&vt)[2][4][2], const bf16x8 (&pf)[2][2], f32x4 (&o)[2][4]) {
    AT_TIE(8, 0);
#pragma unroll
    for (int dt = 0; dt < 4; ++dt) {
        const u32x4 vw = {vt[0][dt][0].x, vt[0][dt][0].y, vt[0][dt][1].x, vt[0][dt][1].y};
        const bf16x8 vf = __builtin_bit_cast(bf16x8, vw);
        o[0][dt] = __builtin_amdgcn_mfma_f32_16x16x32_bf16(vf, pf[0][0], o[0][dt], 0, 0, 0);
        o[1][dt] = __builtin_amdgcn_mfma_f32_16x16x32_bf16(vf, pf[1][0], o[1][dt], 0, 0, 0);
    }
    AT_TIE(0, 1);
#pragma unroll
    for (int dt = 0; dt < 4; ++dt) {
        const u32x4 vw = {vt[1][dt][0].x, vt[1][dt][0].y, vt[1][dt][1].x, vt[1][dt][1].y};
        const bf16x8 vf = __builtin_bit_cast(bf16x8, vw);
        o[0][dt] = __builtin_amdgcn_mfma_f32_16x16x32_bf16(vf, pf[0][1], o[0][dt], 0, 0, 0);
        o[1][dt] = __builtin_amdgcn_mfma_f32_16x16x32_bf16(vf, pf[1][1], o[1][dt], 0, 0, 0);
    }
}

template <int VAR>
__device__ __forceinline__ void attn_unit(const Params& p, int l, int b, int hx, int qb, LAS3 char* lds) {
    typedef LAS3 bf16x4 lds_bf16x4;
    constexpr int KC = (VAR == 1) ? 3 : 2;
    const int tid = opaque_tid(p.wid), w = __builtin_amdgcn_readfirstlane(tid >> 6), lane = tid & 63, i = lane & 15, g = lane >> 4;
    const bf16_t *Qp, *Kp, *Vp; int ldq, ldk, ldv, q0, j0, j1, ocol; float c1, slope2 = 0.f;
    if (VAR == 0) { Qp = p.proj + PC_AQ + hx * 64; Kp = p.proj + PC_AK + hx * 64; Vp = p.proj + PC_AV + hx * 64; ldq = ldk = ldv = NP;
                    q0 = qb * 256 + 32 * w; j0 = 0; j1 = 4 * qb + 3; ocol = hx * 64; c1 = 0.125f * LOG2E; }
    else if (VAR == 1) { Qp = p.qm + hx * 96; Kp = p.km + hx * 96; Vp = p.vm + hx * 64; ldq = 384; ldk = 384; ldv = 256;
                    q0 = qb * 256 + 32 * w; j0 = 0; j1 = 4 * qb + 3; ocol = 256 + hx * 64; c1 = 0.10206207261596577f * LOG2E; }
    else if (VAR == 2) { const int qh = hx * 2 + (w >> 2); Qp = p.proj + PC_CQ + qh * 64; Kp = p.proj + PC_CK + hx * 64; Vp = p.proj + PC_CV + hx * 64; ldq = ldk = ldv = NP;
                    q0 = qb * 128 + 32 * (w & 3); j0 = 2 * qb - 2 > 0 ? 2 * qb - 2 : 0; j1 = 2 * qb + 1; ocol = 512 + qh * 64; c1 = 0.125f * LOG2E;
                    slope2 = exp2f(-(float)(qh + 1)) * LOG2E; }
    else { const int hd = w >> 1; Qp = p.proj + PC_DQ + hd * 64; Kp = p.proj + PC_DK; Vp = p.proj + PC_DV; ldq = ldk = ldv = NP;
                    q0 = qb * 64 + 32 * (w & 1); j0 = 0; j1 = qb; ocol = 768 + hd * 64; c1 = 0.125f * LOG2E; slope2 = exp2f(-(float)(hd + 5)) * LOG2E; }
    const size_t tok0 = (size_t)b * S;
    if (VAR == 0 && qb > 0) {
        constexpr float FOX_DROP = 64.0f;
        const unsigned* kn2 = p.ctl + CW_KN2 + ((l * NB + b) * 4 + hx) * 32;
        const float* cbh = p.cbF + ((size_t)b * 4 + hx) * S;
        const float qn = c1 * sqrtf(__uint_as_float(p.ctl[CW_QN2 + ((l * NB + b) * 4 + hx) * 8 + qb]));
        float knu = 0.f;
        for (int jj = 4 * qb; jj < 4 * qb + 4; ++jj) knu = fmaxf(knu, __uint_as_float(kn2[jj]));
        const float lower = cbh[256 * qb] - qn * sqrtf(knu);
        const int jl = lane & 31;
        const bool keep = qn * sqrtf(__uint_as_float(kn2[jl])) + cbh[64 * jl + 63] - lower >= -FOX_DROP || jl >= 4 * qb;
        const unsigned long long kb = __ballot(keep) & 0xFFFFFFFFull;
        j0 = kb ? (int)__builtin_ctzll(kb) : 4 * qb;
    }
    bf16x8 qf[2][KC];
#pragma unroll
    for (int qt = 0; qt < 2; ++qt)
#pragma unroll
        for (int kc = 0; kc < KC; ++kc) qf[qt][kc] = *(const bf16x8*)(Qp + (tok0 + q0 + 16 * qt + i) * ldq + kc * 32 + 8 * g);
    if (VAR == 3) {
        const int r_ = tid >> 3, c8 = tid & 7;
        const u32x4* src = (const u32x4*)(p.mask + (tok0 + qb * 64 + r_) * 64 + c8 * 8);
        const u32x4 m0 = src[0], m1 = src[1];
        *(LAS3 u32x4*)(lds + AT_MW + r_ * 272 + c8 * 32) = m0; *(LAS3 u32x4*)(lds + AT_MW + r_ * 272 + c8 * 32 + 16) = m1;
        asm volatile("s_waitcnt lgkmcnt(0)" ::: "memory");
    }
    const LAS3 char* mwl = lds + AT_MW + (32 * (w & 1) + i) * 272 + 16 * g;
    f32x4 ab0[4];
#pragma unroll
    for (int mt = 0; mt < 4; ++mt)
#pragma unroll
        for (int r = 0; r < 4; ++r) ab0[mt][r] = (VAR == 3) ? slope2 * (float)(16 * mt + 4 * g + r) : 0.f;
#define AT_TOFF(jj) ((VAR == 3) ? slope2 * (float)(64 * (jj)) : 0.f)
    const int drow = 8 * w + (lane >> 3), dch = lane & 7;
    const int ksc = dch ^ ((drow >> 1) & 7);
    const int vsc = ((((dch >> 1) ^ ((drow >> 1) & 3)) << 1) | (dch & 1));
    const int rrow = 16 * (w & 3) + (lane >> 2), rsc = (lane & 3) ^ ((rrow >> 1) & 3);
#ifndef ATTN_PIPE
#define ATTN_PIPE 0
#endif
    constexpr bool PIPE_ = ((ATTN_PIPE >> VAR) & 1) != 0;
    const bool extra = (VAR == 1 && w < 4) || (VAR == 0 && w == 0);
#define AT_DMA(j) do { LAS3 char* _sb = lds + ((j) & (AT_NS - 1)) * AT_SLOT; \
        __builtin_amdgcn_global_load_lds((const unsigned*)(Kp + (tok0 + 64 * (j) + drow) * ldk + ksc * 8), (LAS3 unsigned*)(_sb + AT_K + w * 1024), 16, 0, 0); \
        __builtin_amdgcn_global_load_lds((const unsigned*)(Vp + (tok0 + 64 * (j) + drow) * ldv + vsc * 8), (LAS3 unsigned*)(_sb + AT_V + w * 1024), 16, 0, 0); \
        if (VAR == 1 && w < 4) __builtin_amdgcn_global_load_lds((const unsigned*)(p.km + (tok0 + 64 * (j) + rrow) * 384 + 64 + rsc * 8), (LAS3 unsigned*)(_sb + AT_R + w * 1024), 16, 0, 0); \
        if (VAR == 0 && w == 0) __builtin_amdgcn_global_load_lds((const unsigned*)(p.cbF + ((size_t)b * 4 + hx) * S + 64 * (j) + lane), (LAS3 unsigned*)(_sb + AT_C), 4, 0, 0); \
    } while (0)
    AT_DMA(j0);
    if (j0 + 1 <= j1) AT_DMA(j0 + 1);
    if (PIPE_ && j0 + 2 <= j1) AT_DMA(j0 + 2);
    if (VAR == 1) {
#pragma unroll
        for (int qt = 0; qt < 2; ++qt) {
            const int pos = q0 + 16 * qt + i;
            const u32x4 mine = __builtin_bit_cast(u32x4, qf[qt][KC - 1]);
            u32x4 oth; oth.x = __shfl_xor(mine.x, 32); oth.y = __shfl_xor(mine.y, 32); oth.z = __shfl_xor(mine.z, 32); oth.w = __shfl_xor(mine.w, 32);
            const float* rt = p.ropetab + (size_t)(pos * 16 + (g & 1) * 8) * 2;
            const float sg = (g < 2) ? -1.f : 1.f;
            u32x4 res;
#pragma unroll
            for (int e2 = 0; e2 < 4; ++e2) {
                const f32x4 cs = *(const f32x4*)(rt + e2 * 4);
                const unsigned mw_ = e2 == 0 ? mine.x : e2 == 1 ? mine.y : e2 == 2 ? mine.z : mine.w, ow_ = e2 == 0 ? oth.x : e2 == 1 ? oth.y : e2 == 2 ? oth.z : oth.w;
                const float r0 = bflo(mw_) * cs[0] + sg * bflo(ow_) * cs[1], r1 = bfhi(mw_) * cs[2] + sg * bfhi(ow_) * cs[3];
                const unsigned pk = cvt_pk_bf16(r0, r1);
                if (e2 == 0) res.x = pk; else if (e2 == 1) res.y = pk; else if (e2 == 2) res.z = pk; else res.w = pk;
            }
            qf[qt][KC - 1] = __builtin_bit_cast(bf16x8, res);
        }
    }
#pragma unroll
    for (int qt = 0; qt < 2; ++qt)
#pragma unroll
        for (int kc = 0; kc < KC; ++kc) {
            u32x4 qq = __builtin_bit_cast(u32x4, qf[qt][kc]);
            qq.x = cvt_pk_bf16(bflo(qq.x) * c1, bfhi(qq.x) * c1); qq.y = cvt_pk_bf16(bflo(qq.y) * c1, bfhi(qq.y) * c1);
            qq.z = cvt_pk_bf16(bflo(qq.z) * c1, bfhi(qq.z) * c1); qq.w = cvt_pk_bf16(bflo(qq.w) * c1, bfhi(qq.w) * c1);
            qf[qt][kc] = __builtin_bit_cast(bf16x8, qq);
        }
    f32x4 o[2][4];
#pragma unroll
    for (int qt = 0; qt < 2; ++qt)
#pragma unroll
        for (int dt = 0; dt < 4; ++dt) o[qt][dt] = (f32x4){0.f, 0.f, 0.f, 0.f};
    float mrow[2] = {NEGBIG, NEGBIG}, lsum[2] = {0.f, 0.f};
    const int swk = (i >> 1) & 7;
    const int q4 = i >> 2, p4 = i & 3, vrow = 4 * g + q4, swv = (vrow >> 1) & 3;
    const unsigned vbase = (unsigned)(size_t)lds + (unsigned)(vrow * 128 + p4 * 8);
#define AT_WAITV(n) asm volatile("s_waitcnt vmcnt(" #n ")" ::: "memory")
#define AT_WAIT_TILES(k) do { if ((k) >= 2) { if (extra) AT_WAITV(6); else AT_WAITV(4); } else if ((k) == 1) { if (extra) AT_WAITV(3); else AT_WAITV(2); } else AT_WAITV(0); } while (0)
    u32x2 vt[2][4][2]; bf16x8 pf[2][2]; f32x4 s[2][4], sn[2][4]; float mx[2] = {NEGBIG, NEGBIG};
#define AT_NEED(jj) ((64 * (jj) <= q0 + 31) && (VAR != 2 || (64 * (jj) + 63 >= q0 - 127)))
#define AT_FULL(jj) ((64 * (jj) + 63 <= q0) && (VAR != 2 || (64 * (jj) >= q0 - 96)))
#define AT_LOGITS_Q(jj, S_, qa_, qe_) do { const LAS3 char* sb_ = lds + ((jj) & (AT_NS - 1)) * AT_SLOT; \
        if (VAR != 3 && AT_FULL(jj)) at_cinit<VAR, true>(sb_, (jj), q0, i, g, slope2, mwl, ab0, S_, qa_, qe_); else at_cinit<VAR, false>(sb_, (jj), q0, i, g, slope2, mwl, ab0, S_, qa_, qe_); \
        at_qk<VAR, KC>(sb_, i, g, swk, qf, S_, qa_, qe_); } while (0)
#define AT_LOGITS(jj, S_) AT_LOGITS_Q(jj, S_, 0, 2)
#ifndef ATTN_PIPE
#define ATTN_PIPE 0
#endif
    constexpr bool PIPE = ((ATTN_PIPE >> VAR) & 1) != 0;
    if (PIPE) {
    { const int k = j1 - j0; AT_WAIT_TILES(k); }
    AT_BAR();
    if (AT_NEED(j0)) { AT_LOGITS(j0, s); at_max(s, mx); }
    for (int j = j0; j <= j1; ++j) {
        { const int k = j1 - j - 1; if (k >= 0) AT_WAIT_TILES(k); }
        AT_BAR();
        if (j + 3 <= j1) AT_DMA(j + 3);
        const bool nd = AT_NEED(j), ndn = (j + 1 <= j1) && AT_NEED(j + 1);
        if (nd) {
            at_rescale(mx, o, mrow, lsum);
            __builtin_amdgcn_sched_barrier(0);
            if (ndn) {
                AT_LOGITS(j + 1, sn);
                at_exp(s, mrow, lsum, pf);
                __builtin_amdgcn_sched_barrier(0);
                at_vread(vbase + (unsigned)((j & (AT_NS - 1)) * AT_SLOT), swv, vt);
                at_max(sn, mx);
                at_pv(vt, pf, o);
                __builtin_amdgcn_sched_barrier(0);
#pragma unroll
                for (int qt = 0; qt < 2; ++qt)
#pragma unroll
                    for (int mt = 0; mt < 4; ++mt) s[qt][mt] = sn[qt][mt];
            } else {
                at_vread(vbase + (unsigned)((j & (AT_NS - 1)) * AT_SLOT), swv, vt);
                at_exp(s, mrow, lsum, pf);
                at_pv(vt, pf, o);
            }
        } else if (ndn) { AT_LOGITS(j + 1, s); at_max(s, mx); }
    }
    } else {
    for (int j = j0; j <= j1; j += 2) {
        AT_WAITV(0);
        AT_BAR();
        if (j + 2 <= j1) AT_DMA(j + 2);
        if (j + 3 <= j1) AT_DMA(j + 3);
        if (VAR != 2 && j + 1 <= j1 && AT_NEED(j) && AT_NEED(j + 1)) {
            AT_LOGITS(j, s);
            AT_LOGITS(j + 1, sn);
            at_vread(vbase + (unsigned)((j & (AT_NS - 1)) * AT_SLOT), swv, vt);
            at_max2(s, sn, mx, AT_TOFF(j), AT_TOFF(j + 1));
            at_rescale(mx, o, mrow, lsum);
            bf16x8 pg[2][2];
            at_exp(s, mrow, lsum, pf, 0, 2, AT_TOFF(j));
            at_exp(sn, mrow, lsum, pg, 0, 2, AT_TOFF(j + 1));
            at_pv(vt, pf, o);
            at_vread(vbase + (unsigned)(((j + 1) & (AT_NS - 1)) * AT_SLOT), swv, vt);
            at_pv(vt, pg, o);
        } else
#pragma unroll
        for (int u = 0; u < 2; ++u) {
            const int jj = j + u;
            if (jj <= j1 && AT_NEED(jj)) {
                AT_LOGITS(jj, s);
                at_vread(vbase + (unsigned)((jj & (AT_NS - 1)) * AT_SLOT), swv, vt);
                at_max(s, mx, AT_TOFF(jj));
                at_rescale(mx, o, mrow, lsum);
                at_exp(s, mrow, lsum, pf, 0, 2, AT_TOFF(jj));
                at_pv(vt, pf, o);
            }
        }
    }
    }
#undef AT_LOGITS
#undef AT_TOFF
#undef AT_LOGITS_Q
#undef AT_NEED
#undef AT_FULL
#undef AT_WAIT_TILES
#undef AT_WAITV
#undef AT_DMA
#pragma unroll
    for (int qt = 0; qt < 2; ++qt) {
        float lt = xor16_sum(lsum[qt]); lt += __shfl_xor(lt, 32);
        if (VAR == 2) lt += __builtin_amdgcn_exp2f(p.sinks[l * 4 + hx * 2 + (w >> 2)] * LOG2E - mrow[qt]);
        const float inv = 1.f / lt;
        bf16_t* op = p.merged + (tok0 + q0 + 16 * qt + i) * D + ocol + 4 * g;
#pragma unroll
        for (int dt = 0; dt < 4; ++dt) { const f32x4 v = o[qt][dt] * inv; u32x2 w2; w2.x = cvt_pk_bf16(v[0], v[1]); w2.y = cvt_pk_bf16(v[2], v[3]); *(u32x2*)(op + 16 * dt) = w2; }
    }
}

__device__ __forceinline__ void phase_attn(const Params& p, int l, LAS3 char* lds) {
    const int tid = opaque_tid(p.wid);
    unsigned* qhead = p.ctl + CW_QA + 64 * (l + 2 * p.qslot);
    volatile LAS3 int* bc = (volatile LAS3 int*)(lds + AT_CTL);
    int nxt = 0;
    if (tid == 0) nxt = (int)__hip_atomic_fetch_add(qhead, 1u, __ATOMIC_RELAXED, __HIP_MEMORY_SCOPE_AGENT);
    for (;;) {
        if (tid == 0) *bc = nxt;
        __syncthreads();
        const int idx = __builtin_amdgcn_readfirstlane(*bc);
        __syncthreads();
        if (idx >= 4096) break;
        if (tid == 0) nxt = (int)__hip_atomic_fetch_add(qhead, 1u, __ATOMIC_RELAXED, __HIP_MEMORY_SCOPE_AGENT);
        const int vmask = p.qslot ? REPK_VMASK : ATTN_VMASK;
        if (idx < 3072) {
            const int lvl = 7 - idx / 384, rem = idx % 384;
            if (rem < 128) { if (vmask & 2) attn_unit<1>(p, l, rem >> 2, rem & 3, lvl, lds); }
            else if (rem < 256) { if (vmask & 1) attn_unit<0>(p, l, (rem - 128) >> 2, rem & 3, lvl, lds); }
            else { const int d = rem - 256; if (vmask & 8) attn_unit<3>(p, l, d & 31, 0, 4 * lvl + 3 - (d >> 5), lds); }
        } else { const int c = idx - 3072; if (vmask & 4) attn_unit<2>(p, l, c >> 5, (c >> 4) & 1, c & 15, lds); }
    }
}
}

namespace {
constexpr int DS_LD = 2052;
constexpr int DS_CTL = 16 * DS_LD * 4;
constexpr int DS_LDS = DS_CTL + 64;

__device__ __forceinline__ void dsa_unit(const Params& p, int u, LAS3 char* lds) {
    const int tid = opaque_tid(p.wid), w = __builtin_amdgcn_readfirstlane(tid >> 6), lane = tid & 63, i = lane & 15, g = lane >> 4;
    const int b = u >> 7, t0 = (u & 127) * 16;
    const size_t tok0 = (size_t)b * S;
    uint32_t* mbase = p.mask + (tok0 + t0) * 64;
    if (t0 + 16 <= 256) {
#pragma unroll
        for (int qq = 0; qq < 2; ++qq) {
            const int q = 2 * w + qq, n = t0 + q + 1;
            const int cnt = n > lane ? ((n - lane + 63) >> 6) : 0;
            mbase[q * 64 + lane] = cnt >= 32 ? 0xFFFFFFFFu : ((1u << cnt) - 1u);
        }
        return;
    }
    const int nreg = (t0 + 16 + 63) >> 6;
    const int ntile = nreg * 4;
    bf16x8 qf[8]; float wq[8];
    {
        const bf16_t* qrow = p.proj + (tok0 + t0 + i) * NP;
#pragma unroll
        for (int h = 0; h < 8; ++h) qf[h] = *(const bf16x8*)(qrow + PC_DQI + h * 32 + 8 * g);
        const u32x4 ww = *(const u32x4*)(qrow + PC_DWI);
        const float sc = 0.35355339059327373f * 0.17677669529663687f;
        wq[0] = bflo(ww.x) * sc; wq[1] = bfhi(ww.x) * sc; wq[2] = bflo(ww.y) * sc; wq[3] = bfhi(ww.y) * sc;
        wq[4] = bflo(ww.z) * sc; wq[5] = bfhi(ww.z) * sc; wq[6] = bflo(ww.w) * sc; wq[7] = bfhi(ww.w) * sc;
    }
    const int tq = t0 + i;
#ifndef DSA_EXP
#define DSA_EXP 0
#endif
    const bool exp_skip_score = (DSA_EXP == 2) && p.qslot > 0, exp_skip_sel = (DSA_EXP == 1) && p.qslot > 0, exp_nostore = (DSA_EXP != 0) && p.qslot > 0;
    if (!exp_skip_score)
    for (int base = w; base < ntile; base += 32) {
        bf16x8 kf4[4];
#pragma unroll
        for (int uu = 0; uu < 4; ++uu) { const int kt = base + 8 * uu; if (kt < ntile) kf4[uu] = *(const bf16x8*)(p.kidx + (tok0 + 16 * kt + i) * 32 + 8 * g); }
#pragma unroll
        for (int uu = 0; uu < 4; ++uu) {
            const int kt = base + 8 * uu;
            if (kt < ntile) {
                f32x4 sc4 = {0.f, 0.f, 0.f, 0.f};
#pragma unroll
                for (int h = 0; h < 8; ++h) {
                    const f32x4 c = __builtin_amdgcn_mfma_f32_16x16x32_bf16(kf4[uu], qf[h], (f32x4){0.f, 0.f, 0.f, 0.f}, 0, 0, 0);
#pragma unroll
                    for (int r = 0; r < 4; ++r) { const int ci = __float_as_int(c[r]); sc4[r] += wq[h] * __int_as_float(ci > 0 ? ci : 0); }
                }
                u32x4 ko;
#pragma unroll
                for (int r = 0; r < 4; ++r) {
                    const int b = __float_as_int(sc4[r] + 0.f);
                    ko[r] = (unsigned)b ^ ((unsigned)(b >> 31) | 0x80000000u);
                }
                if (16 * kt + 15 > t0) {
#pragma unroll
                    for (int r = 0; r < 4; ++r) ko[r] = (16 * kt + 4 * g + r <= tq) ? ko[r] : 0u;
                }
                *(LAS3 u32x4*)(lds + ((size_t)i * DS_LD + 16 * kt + 4 * g) * 4) = ko;
            }
        }
    }
    __syncthreads();
    if (!exp_skip_sel)
    {
        const int qA = 2 * w, qB = 2 * w + 1;
        const LAS3 unsigned* kpA = (const LAS3 unsigned*)(lds + (size_t)qA * DS_LD * 4);
        const LAS3 unsigned* kpB = (const LAS3 unsigned*)(lds + (size_t)qB * DS_LD * 4);
        unsigned PA[32], PB[32];
        const int nv = nreg * 64;
#pragma unroll
        for (int r = 0; r < 32; ++r) {
            int idx = r * 64 + lane; asm volatile("" : "+v"(idx));
            const unsigned va = kpA[r * 64 + lane], vb = kpB[r * 64 + lane];
            PA[r] = (idx < nv) ? va : 0u; PB[r] = (idx < nv) ? vb : 0u;
        }
#define DSA_TR(P, j, m) do { _Pragma("unroll") for (int k = 0; k < 32; ++k) if ((k & (j)) == 0) { const unsigned x = P[k], y = P[k + (j)]; \
            P[k] = (x & (m)) | ((y << (j)) & ~(m)); P[k + (j)] = ((x >> (j)) & (m)) | (y & ~(m)); } } while (0)
        DSA_TR(PA, 16, 0x0000FFFFu); DSA_TR(PB, 16, 0x0000FFFFu); DSA_TR(PA, 8, 0x00FF00FFu); DSA_TR(PB, 8, 0x00FF00FFu);
        DSA_TR(PA, 4, 0x0F0F0F0Fu); DSA_TR(PB, 4, 0x0F0F0F0Fu); DSA_TR(PA, 2, 0x33333333u); DSA_TR(PB, 2, 0x33333333u);
        DSA_TR(PA, 1, 0x55555555u); DSA_TR(PB, 1, 0x55555555u);
#undef DSA_TR
        unsigned alA = 0xFFFFFFFFu, abA = 0u, selA = 0u, alB = 0xFFFFFFFFu, abB = 0u, selB = 0u;
        bool exA = false, exB = false;
#pragma unroll
        for (int bit = 31; bit >= 1; bit -= 2) {
            if (!(exA && exB)) {
                const unsigned p1A = PA[bit], p0A = PA[bit - 1], p1B = PB[bit], p0B = PB[bit - 1];
                const unsigned t1A = alA & p1A, c3A = abA | (t1A & p0A), c2A = abA | t1A, c1A = abA | (alA & (p1A | p0A));
                const unsigned t1B = alB & p1B, c3B = abB | (t1B & p0B), c2B = abB | t1B, c1B = abB | (alB & (p1B | p0B));
                const int rA = wave_reduce_add(__builtin_popcount(c3A) | (__builtin_popcount(c2A) << 16));
                const int rB = wave_reduce_add(__builtin_popcount(c3B) | (__builtin_popcount(c2B) << 16));
                const int rC = wave_reduce_add(__builtin_popcount(c1A) | (__builtin_popcount(c1B) << 16));
                const int n3A = rA & 0xFFFF, n2A = rA >> 16, n1A = rC & 0xFFFF, n3B = rB & 0xFFFF, n2B = rB >> 16, n1B = rC >> 16;
                if (!exA) {
                    if (n3A >= 256) { if (n3A == 256) { exA = true; selA = c3A; } alA = t1A & p0A; }
                    else if (n2A >= 256) { if (n2A == 256) { exA = true; selA = c2A; } abA = c3A; alA = t1A & ~p0A; }
                    else if (n1A >= 256) { if (n1A == 256) { exA = true; selA = c1A; } abA = c2A; alA = alA & ~p1A & p0A; }
                    else { abA = c1A; alA = alA & ~(p1A | p0A); }
                }
                if (!exB) {
                    if (n3B >= 256) { if (n3B == 256) { exB = true; selB = c3B; } alB = t1B & p0B; }
                    else if (n2B >= 256) { if (n2B == 256) { exB = true; selB = c2B; } abB = c3B; alB = t1B & ~p0B; }
                    else if (n1B >= 256) { if (n1B == 256) { exB = true; selB = c1B; } abB = c2B; alB = alB & ~p1B & p0B; }
                    else { abB = c1B; alB = alB & ~(p1B | p0B); }
                }
            }
        }
        const unsigned long long lt = (lane == 0) ? 0ull : (~0ull >> (64 - lane));
#pragma unroll 1
        for (int qq = 0; qq < 2; ++qq) {
            const bool exact = qq ? exB : exA;
            unsigned sel = qq ? selB : selA;
            if (!exact) {
                const unsigned al = qq ? alB : alA, ab = qq ? abB : abA;
                const int need = 256 - wave_reduce_add(__builtin_popcount(ab));
                int running = 0; sel = ab;
                for (int r = 0; r < 32; ++r) {
                    const bool eq = ((al >> r) & 1u) != 0u;
                    const unsigned long long be = __ballot(eq);
                    if (eq && running + __popcll(be & lt) < need) sel |= 1u << r;
                    running += __popcll(be);
                }
            }
            if (!exp_nostore) mbase[(2 * w + qq) * 64 + lane] = sel;
        }
    }
    __syncthreads();
}

__device__ __forceinline__ void phase_dsa(const Params& p, int l, LAS3 char* lds) {
    const int tid = opaque_tid(p.wid);
    unsigned* qhead = p.ctl + CW_QD + 64 * (l + 2 * p.qslot);
    volatile LAS3 int* bc = (volatile LAS3 int*)(lds + DS_CTL);
    int nxt = 0;
    if (tid == 0) nxt = (int)__hip_atomic_fetch_add(qhead, 1u, __ATOMIC_RELAXED, __HIP_MEMORY_SCOPE_AGENT);
    for (;;) {
        if (tid == 0) *bc = nxt;
        __syncthreads();
        const int idx = __builtin_amdgcn_readfirstlane(*bc);
        __syncthreads();
        if (idx >= 4096) break;
        if (tid == 0) nxt = (int)__hip_atomic_fetch_add(qhead, 1u, __ATOMIC_RELAXED, __HIP_MEMORY_SCOPE_AGENT);
        const int pb = 127 - (idx >> 5), b = idx & 31;
        dsa_unit(p, b * 128 + pb, lds);
    }
}
}

namespace {
constexpr int DW_SLOT = 32768;
struct DwUnit { const bf16_t* Bp; size_t arow; int e, lr0, pn; };
__device__ __forceinline__ void phase_down2(const Params& p, int l, LAS3 char* lds) {
    const int tid = opaque_tid(p.wid), w = __builtin_amdgcn_readfirstlane(tid >> 6), lane = tid & 63, i = lane & 15, g = lane >> 4;
    const int* cnt = (const int*)(p.ctl + CW_CNT) + l * 16;
    MoeOrder S; S.init(cnt, p.list, 4, gridDim.x, blockIdx.x);
    const bf16_t* Wd = p.WdT + (size_t)l * 16 * 1024 * 256;
    const int drow = 8 * w + (lane >> 3), dch = lane & 7, ksc = dch ^ ((drow >> 1) & 7);
    const int nsrc = (drow & 32) + 8 * ((drow >> 2) & 3) + 4 * ((drow >> 4) & 1) + (drow & 3);
    const int swk = (i >> 1) & 7;
#define DW_SET(U, u_) do { (U).e = (u_).e; (U).pn = (u_).pn; (U).Bp = Wd + ((size_t)(u_).e * 1024 + (u_).pn * 256) * 256; \
        (U).arow = (size_t)(u_).pm * 256 + 32 * w + i; (U).lr0 = (u_).mt * 256 + 32 * w + i; } while (0)
#define DW_DMA(U, c, slot) do { _Pragma("unroll") for (int kq_ = 0; kq_ < 4; ++kq_) \
        __builtin_amdgcn_global_load_lds((const unsigned*)((U).Bp + (size_t)(64 * (c) + nsrc) * 256 + kq_ * 64 + ksc * 8), (LAS3 unsigned*)(lds + (slot) * DW_SLOT + kq_ * 8192 + w * 1024), 16, 0, 0); } while (0)
#define DW_LOADA(U, AF, RP, WG) do { _Pragma("unroll") for (int qt_ = 0; qt_ < 2; ++qt_) { \
        _Pragma("unroll") for (int kc_ = 0; kc_ < 8; ++kc_) AF[qt_][kc_] = *(const bf16x8*)(p.hid + ((U).arow + 16 * qt_) * 256 + kc_ * 32 + 8 * g); \
        const int lr_ = (U).lr0 + 16 * qt_; const bool ok_ = lr_ < cnt[(U).e]; \
        const int sl_ = ok_ ? p.list[(size_t)(U).e * ECAP + lr_] : 0; WG[qt_] = ok_ ? p.wl[(size_t)(U).e * ECAP + lr_] : 0.f; \
        RP[qt_] = (ok_ ? p.ys + (size_t)sl_ * D : p.merged) + (U).pn * 256 + 8 * g; } } while (0)
    pg8::Unit u;
    if (!S.next(0, u)) return;
    DwUnit cur, nxt; DW_SET(cur, u);
    bf16x8 af[2][8], afn[2][8]; bf16_t* rowp[2]; bf16_t* rowpn[2]; float wgt[2], wgtn[2];
    DW_LOADA(cur, af, rowp, wgt);
    DW_DMA(cur, 0, 0); DW_DMA(cur, 1, 1); DW_DMA(cur, 2, 2);
    bool first = true;
    for (int ui = 0;; ++ui) {
        const bool has_next = S.next(ui + 1, u);
        if (has_next) DW_SET(nxt, u); else nxt = cur;
#pragma unroll
        for (int c = 0; c < 4; ++c) {
            if (c == 0) { if (first) asm volatile("s_waitcnt vmcnt(8)" ::: "memory"); else asm volatile("s_waitcnt vmcnt(16)" ::: "memory"); }
            else if (c == 1) { if (first) asm volatile("s_waitcnt vmcnt(28)" ::: "memory"); else asm volatile("s_waitcnt vmcnt(32)" ::: "memory"); }
            else if (c == 2) asm volatile("s_waitcnt vmcnt(32)" ::: "memory");
            else asm volatile("s_waitcnt vmcnt(16)" ::: "memory");
            __builtin_amdgcn_s_barrier();
            asm volatile("" ::: "memory");
            if (c == 0) { DW_DMA(cur, 3, 3); DW_LOADA(nxt, afn, rowpn, wgtn); }
            else DW_DMA(nxt, c - 1, c - 1);
            f32x4 acc[2][4];
#pragma unroll
            for (int qt = 0; qt < 2; ++qt)
#pragma unroll
                for (int nt = 0; nt < 4; ++nt) acc[qt][nt] = (f32x4){0.f, 0.f, 0.f, 0.f};
            const LAS3 char* sb = lds + c * DW_SLOT;
            bf16x8 fr[2][8];
#pragma unroll
            for (int kc = 0; kc < 8; ++kc) fr[0][kc] = *(const LAS3 bf16x8*)(sb + (kc >> 1) * 8192 + i * 128 + ((((kc & 1) * 4 + g) ^ swk) << 4));
#pragma unroll
            for (int nt = 0; nt < 4; ++nt) {
                __builtin_amdgcn_sched_barrier(0);
                if (nt < 3) {
#pragma unroll
                    for (int kc = 0; kc < 8; ++kc) fr[(nt + 1) & 1][kc] = *(const LAS3 bf16x8*)(sb + (kc >> 1) * 8192 + ((nt + 1) * 16 + i) * 128 + ((((kc & 1) * 4 + g) ^ swk) << 4));
                }
                __builtin_amdgcn_sched_barrier(0);
#pragma unroll
                for (int kc = 0; kc < 8; ++kc) {
                    acc[0][nt] = __builtin_amdgcn_mfma_f32_16x16x32_bf16(fr[nt & 1][kc], af[0][kc], acc[0][nt], 0, 0, 0);
                    acc[1][nt] = __builtin_amdgcn_mfma_f32_16x16x32_bf16(fr[nt & 1][kc], af[1][kc], acc[1][nt], 0, 0, 0);
                }
            }
            __builtin_amdgcn_sched_barrier(0);
#pragma unroll
            for (int qt = 0; qt < 2; ++qt)
#pragma unroll
                for (int blk = 0; blk < 2; ++blk) {
                    const f32x4 v0 = acc[qt][2 * blk] * wgt[qt], v1 = acc[qt][2 * blk + 1] * wgt[qt];
                    u32x4 o; o.x = cvt_pk_bf16(v0[0], v0[1]); o.y = cvt_pk_bf16(v0[2], v0[3]); o.z = cvt_pk_bf16(v1[0], v1[1]); o.w = cvt_pk_bf16(v1[2], v1[3]);
                    *(u32x4*)(rowp[qt] + 64 * c + 32 * blk) = o;
                }
            asm volatile("" ::: "memory");
        }
        first = false;
        if (!has_next) break;
        cur = nxt;
#pragma unroll
        for (int qt = 0; qt < 2; ++qt) { rowp[qt] = rowpn[qt]; wgt[qt] = wgtn[qt];
#pragma unroll
            for (int kc = 0; kc < 8; ++kc) af[qt][kc] = afn[qt][kc]; }
    }
    asm volatile("s_waitcnt vmcnt(0) lgkmcnt(0)" ::: "memory");
    __builtin_amdgcn_s_barrier();
    asm volatile("" ::: "memory");
#undef DW_SET
#undef DW_DMA
#undef DW_LOADA
}
}

namespace {
constexpr int LDS_BYTES = 147456;
constexpr int NTHREADS = 512;

template <int PH>
__device__ __forceinline__ void run_phase(const Params& p, int l, unsigned char* smem) {
    LAS3 char* lds = (LAS3 char*)smem;
    PG8_LAS unsigned char* glds = (PG8_LAS unsigned char*)smem;
    const int G = gridDim.x, c = blockIdx.x;
    if constexpr (PH == 0) phase_p0(p, (char*)smem);
    if constexpr (PH == 1) { if (l == 0) phase_norm1<0>(p, 0); else phase_norm1<1>(p, l); }
    if constexpr (PH == 2) { pg8::Gemm g{p.h, p.WinT + (size_t)l * NP * D, D, D, 0}; pg8::StaticOrder S; S.init(T, NP, G, c);
        EpiStoreBf16 E{p.proj, NP}; pg8::gemm_phase<EpiStoreBf16, pg8::StaticOrder, false>(glds, g, S, E, p.wid); }
    if constexpr (PH == 3) phase_prep(p, l);
    if constexpr (PH == 4) { pg8::Gemm g{p.proj + PC_BCQ, p.WqT + (size_t)l * 512 * 256, 256, NP, 0}; pg8::StaticOrder S; S.init(T, 512, G, c);
          EpiMlaQ E{p.qm}; pg8::gemm_phase<EpiMlaQ, pg8::StaticOrder, false>(glds, g, S, E, p.wid); }
    if constexpr (PH == 12) { pg8::Gemm g{p.proj + PC_BCKV, p.WkvT + (size_t)l * 512 * 128, 128, NP, 0}; pg8::StaticOrder S; S.init(T, 512, G, c);
          EpiMlaKV E{p.km, p.vm}; pg8::gemm_phase<EpiMlaKV, pg8::StaticOrder, false>(glds, g, S, E, p.wid); }
    if constexpr (PH == 13) phase_dsa(p, l, lds);
    if constexpr (PH == 5) phase_attn(p, l, lds);
    if constexpr (PH == 6) { pg8::Gemm g{p.merged, p.WoutT + (size_t)l * D * D, D, D, 0}; pg8::StaticOrder S; S.init(T, D, G, c);
        EpiResidual E{l == 0 ? p.x : nullptr, p.xb, p.mod + (size_t)l * NB * NMOD + 2 * 1024}; pg8::gemm_phase<EpiResidual, pg8::StaticOrder, false>(glds, g, S, E, p.wid); }
    if constexpr (PH == 7) phase_route(p, l, (char*)smem);
    if constexpr (PH == 8) { const int* cnt = (const int*)(p.ctl + CW_CNT) + l * 16;
        pg8::Gemm g{p.h, p.WguT + (size_t)l * 16 * 512 * 1024, 1024, D, (size_t)512 * 1024}; MoeOrder S; S.init(cnt, p.list, 2, G, c);
        EpiGateUp E{p.hid}; pg8::gemm_phase<EpiGateUp, MoeOrder, true>(glds, g, S, E, p.wid); }
#ifndef DOWN2
#define DOWN2 0
#endif
    if constexpr (PH == 9 && DOWN2) phase_down2(p, l, (LAS3 char*)glds);
    if constexpr (PH == 9 && !DOWN2) { const int* cnt = (const int*)(p.ctl + CW_CNT) + l * 16;
        pg8::Gemm g{p.hid, p.WdT + (size_t)l * 16 * 1024 * 256, 256, 256, (size_t)1024 * 256}; MoeOrder S; S.init(cnt, p.list, 4, G, c);
        EpiDown E{p.ys, p.list, p.wl, cnt}; pg8::gemm_phase<EpiDown, MoeOrder, false>(glds, g, S, E, p.wid); }
    if constexpr (PH == 10) phase_norm1<2>(p, 1);
    if constexpr (PH == 11) phase_norm1<0>(p, l);
}
template <int PH>
__global__ void __launch_bounds__(NTHREADS, 2) k_ph(Params p, int l) {
    extern __shared__ __attribute__((aligned(16))) unsigned char smem[];
    p.wid = __builtin_amdgcn_readfirstlane(threadIdx.x >> 6); p.qslot = p.qslot_host;
    run_phase<PH>(p, l, smem);
}
}


namespace {
#ifndef REP_PH
#define REP_PH -1
#endif
#define REP(X, l) do { if (REP_PH == X) { xcd_barrier(bar); phase<X>(l, smem, wid, 1); } } while (0)
struct KArgs { const float* in[20]; float* xo; char* ws; };
constexpr size_t al256(size_t b) { return (b + 255) & ~(size_t)255; }
constexpr size_t WS_CTL = 0;
constexpr size_t WS_MOD = WS_CTL + al256((size_t)CW_WORDS * 4);
constexpr size_t WS_WIN = WS_MOD + al256((size_t)2 * NB * NMOD * 4);
constexpr size_t WS_WOUT = WS_WIN + al256((size_t)2 * NP * D * 2);
constexpr size_t WS_WQ = WS_WOUT + al256((size_t)2 * D * D * 2);
constexpr size_t WS_WKV = WS_WQ + al256((size_t)2 * 512 * 256 * 2);
constexpr size_t WS_WGU = WS_WKV + al256((size_t)2 * 512 * 128 * 2);
constexpr size_t WS_WD = WS_WGU + al256((size_t)2 * 16 * 512 * 1024 * 2);
constexpr size_t WS_ROPE = WS_WD + al256((size_t)2 * 16 * 1024 * 256 * 2);
constexpr size_t WS_RQ = WS_ROPE + al256((size_t)2048 * 16 * 2 * 4);
constexpr size_t WS_RKV = WS_RQ + al256((size_t)T * 4);
constexpr size_t WS_CBF = WS_RKV + al256((size_t)T * 4);
constexpr size_t WS_KIDX = WS_CBF + al256((size_t)NB * 4 * S * 4);
constexpr size_t WS_MASK = WS_KIDX + al256((size_t)T * 32 * 2);
constexpr size_t WS_LIST = WS_MASK + al256((size_t)T * 64 * 4);
constexpr size_t WS_RW = WS_LIST + al256((size_t)2 * 16 * ECAP * 4);
constexpr size_t WS_WL = WS_RW + al256((size_t)T * 2 * 4);
constexpr size_t WS_H = WS_WL + al256((size_t)2 * 16 * ECAP * 4);
constexpr size_t WS_PROJ = WS_H + al256((size_t)T * D * 2);
constexpr size_t WS_QM = WS_PROJ + al256((size_t)T * NP * 2);
constexpr size_t WS_KM = WS_QM + al256((size_t)T * 384 * 2);
constexpr size_t WS_VM = WS_KM + al256((size_t)T * 384 * 2);
constexpr size_t WS_MERGED = WS_VM + al256((size_t)T * 256 * 2);
constexpr size_t WS_XB = WS_MERGED + al256((size_t)T * D * 2);
constexpr size_t WS_END1 = WS_XB + al256((size_t)T * D * 2);
constexpr size_t WS_HID = WS_PROJ;
constexpr size_t WS_YS = WS_HID + al256((size_t)HIDROWS * 256 * 2);
constexpr size_t WS_END2 = WS_YS + al256((size_t)T * 2 * D * 2);
constexpr size_t WS_NEED = WS_END1 > WS_END2 ? WS_END1 : WS_END2;
static_assert(WS_END2 <= WS_MERGED, "MoE overlay must not reach the merged buffer");

__device__ __forceinline__ Params make_params(const KArgs& a) {
    Params p;
    p.x = a.in[0]; p.c = a.in[1]; p.w_ada = a.in[2]; p.b_ada = a.in[3]; p.g_norm1 = a.in[4]; p.w_in = a.in[5]; p.b_forget = a.in[6]; p.g_q_mla = a.in[7];
    p.w_q_up = a.in[8]; p.g_kv_mla = a.in[9]; p.w_kv_up = a.in[10]; p.sinks = a.in[11]; p.w_out = a.in[12]; p.g_norm2 = a.in[13]; p.w_router = a.in[14];
    p.b_router = a.in[15]; p.w_gate = a.in[16]; p.w_up = a.in[17]; p.w_down = a.in[18]; p.g_final = a.in[19];
    p.xo = a.xo; char* ws = a.ws;
    p.ctl = (unsigned*)(ws + WS_CTL); p.mod = (float*)(ws + WS_MOD); p.WinT = (bf16_t*)(ws + WS_WIN); p.WoutT = (bf16_t*)(ws + WS_WOUT);
    p.WqT = (bf16_t*)(ws + WS_WQ); p.WkvT = (bf16_t*)(ws + WS_WKV); p.WguT = (bf16_t*)(ws + WS_WGU); p.WdT = (bf16_t*)(ws + WS_WD);
    p.ropetab = (float*)(ws + WS_ROPE); p.rq = (float*)(ws + WS_RQ); p.rkv = (float*)(ws + WS_RKV); p.cbF = (float*)(ws + WS_CBF); p.kidx = (bf16_t*)(ws + WS_KIDX);
    p.mask = (uint32_t*)(ws + WS_MASK); p.list = (int*)(ws + WS_LIST); p.rw = (float*)(ws + WS_RW); p.wl = (float*)(ws + WS_WL); p.h = (bf16_t*)(ws + WS_H);
    p.proj = (bf16_t*)(ws + WS_PROJ); p.qm = (bf16_t*)(ws + WS_QM); p.km = (bf16_t*)(ws + WS_KM); p.vm = (bf16_t*)(ws + WS_VM);
    p.merged = (bf16_t*)(ws + WS_MERGED); p.xb = (bf16_t*)(ws + WS_XB); p.hid = (bf16_t*)(ws + WS_HID); p.ys = (bf16_t*)(ws + WS_YS);
    return p;
}
template <int PH>
__device__ __forceinline__ void phase(int l, unsigned char* smem, int wid, int qslot = 0) {
    typedef const __attribute__((address_space(4))) KArgs* KA4;
    KA4 ka = (KA4)__builtin_amdgcn_kernarg_segment_ptr();
    asm volatile("" : "+s"(ka));
    KArgs a;
#pragma unroll
    for (int i = 0; i < 20; ++i) a.in[i] = ka->in[i];
    a.xo = ka->xo; a.ws = ka->ws;
    Params p = make_params(a); p.wid = wid; p.qslot = qslot; p.qslot_host = 0;
    run_phase<PH>(p, l, smem);
}
__global__ void __launch_bounds__(NTHREADS, 2) fwd(KArgs args) {
    extern __shared__ __attribute__((aligned(16))) unsigned char smem[];
    volatile LAS unsigned* st = (volatile LAS unsigned*)(smem + LDS_BYTES - 16);
    const int wid = __builtin_amdgcn_readfirstlane(threadIdx.x >> 6);
    if (xb_leader(wid)) { st[0] = 0u; st[1] = 0u; st[2] = 0u; st[3] = 0u; }
    __syncthreads();
    XcdBarrier bar = xcd_barrier_post((unsigned*)(args.ws + WS_CTL) + CW_BAR, st, wid);
    phase<0>(0, smem, wid);  REP(0, 0);
    xcd_barrier(bar);
#define LAYER(l) do { \
        phase<1>(l, smem, wid);  if (l == 0) REP(1, l); xcd_barrier(bar); \
        phase<2>(l, smem, wid);  REP(2, l); xcd_barrier(bar); \
        phase<3>(l, smem, wid);  REP(3, l); xcd_barrier(bar); \
        phase<4>(l, smem, wid);  REP(4, l); phase<12>(l, smem, wid);  REP(12, l); phase<13>(l, smem, wid);  REP(13, l); xcd_barrier(bar); \
        phase<5>(l, smem, wid);  REP(5, l); xcd_barrier(bar); \
        phase<6>(l, smem, wid);  xcd_barrier(bar); \
        phase<7>(l, smem, wid);  REP(7, l); xcd_barrier(bar); \
        phase<8>(l, smem, wid);  REP(8, l); xcd_barrier(bar); \
        phase<9>(l, smem, wid);  REP(9, l); xcd_barrier(bar); } while (0)
    LAYER(0);
    LAYER(1);
#ifdef REP_BAR
    for (int rb = 0; rb < REP_BAR; ++rb) xcd_barrier(bar);
#endif
    phase<10>(1, smem, wid);
}
}

extern "C" void kernel_launch(void* const* d_in, const int* in_sizes, int n_in, void* d_out, int out_size, void* d_ws, size_t ws_size,
                              hipStream_t stream) {
    KArgs a{};
    for (int i = 0; i < 20; ++i) a.in[i] = (const float*)d_in[i];
    a.xo = (float*)d_out; a.ws = (char*)d_ws;
    if (WS_NEED > ws_size) return;

    static int grid = 0;
    if (!grid) {
        int dev = 0, cus = 0, per_cu = 0;
        (void)hipGetDevice(&dev);
        (void)hipDeviceGetAttribute(&cus, hipDeviceAttributeMultiprocessorCount, dev);
        (void)hipFuncSetAttribute((const void*)fwd, hipFuncAttributeMaxDynamicSharedMemorySize, LDS_BYTES);
        (void)hipOccupancyMaxActiveBlocksPerMultiprocessor(&per_cu, (const void*)fwd, NTHREADS, LDS_BYTES);
        grid = cus > 0 ? cus : 256;
    }
    (void)hipMemsetAsync(a.ws + WS_CTL, 0, (size_t)CW_WORDS * 4, stream);
    fwd<<<dim3(grid), dim3(NTHREADS), LDS_BYTES, stream>>>(a);
}
```
